# Optimizing an MI355X kernel written in HIP

```python
import math
import jax
import jax.numpy as jnp
from jax import lax
import numpy as np

D_MODEL = 1024
BATCH = 4
SEQ = 4096
DEPTH = 1

NSA_HEADS = 8
NSA_KV_GROUPS = 2
NSA_HPG = NSA_HEADS // NSA_KV_GROUPS
HEAD_DIM = 64
CMP_BLOCK = 32
CMP_STRIDE = 16
CMP_HIDDEN = 128
SLC_BLOCK = 64
SLC_TOPN = 16
WINDOW = 512
Q_BLOCK = 128
GLA_HEADS = 4
GLA_DK = 64
GLA_DV = 128
GLA_GATE_RANK = 16
GLA_TAU = 16.0
GLA_CHUNK = 64
REL_BUCKETS = 32
REL_MAX_EXACT = REL_BUCKETS // 2
REL_MAX_DIST = 128
N_GROUPS = 4
EXPERTS_PER_GROUP = 8
N_EXPERTS = N_GROUPS * EXPERTS_PER_GROUP
TOPK_IN_GROUP = 2
EXPERT_FF = 256
EPS = 1e-6

NSA_WIDTH = NSA_HEADS * HEAD_DIM
KV_WIDTH = NSA_KV_GROUPS * HEAD_DIM
GLA_K_WIDTH = GLA_HEADS * GLA_DK
GLA_V_WIDTH = GLA_HEADS * GLA_DV
IN_SPLITS = (NSA_WIDTH, KV_WIDTH, KV_WIDTH, KV_WIDTH, KV_WIDTH, KV_WIDTH, KV_WIDTH,
             3 * NSA_HEADS, GLA_K_WIDTH, GLA_K_WIDTH, GLA_V_WIDTH, GLA_GATE_RANK,
             GLA_V_WIDTH, D_MODEL, D_MODEL)

kernel_name = "hybrid_nsa_gla_hmoe_block"


def rmsnorm(x, g):
    xf = x.astype(jnp.float32)
    y = xf * lax.rsqrt(jnp.mean(xf * xf, axis=-1, keepdims=True) + EPS)
    return (y * g.astype(jnp.float32)).astype(x.dtype)


def masked_softmax(s, mask):
    s = jnp.where(mask, s.astype(jnp.float32), -jnp.inf)
    m = jnp.max(s, axis=-1, keepdims=True)
    m = jnp.where(jnp.isfinite(m), m, 0.0)
    e = jnp.where(mask, jnp.exp(s - m), 0.0)
    return e / jnp.maximum(jnp.sum(e, axis=-1, keepdims=True), jnp.finfo(jnp.float32).tiny)


def t5_bucket(rel):
    n = jnp.maximum(rel, 0)
    nf = jnp.maximum(n, 1).astype(jnp.float32)
    large = REL_MAX_EXACT + (jnp.log(nf / REL_MAX_EXACT) / math.log(REL_MAX_DIST / REL_MAX_EXACT)
                             * (REL_BUCKETS - REL_MAX_EXACT)).astype(jnp.int32)
    return jnp.where(n < REL_MAX_EXACT, n, jnp.minimum(large, REL_BUCKETS - 1))


def compress(t, pe, w1, w2):
    B, G, S, dh = t.shape
    sub = t.reshape(B, G, S // CMP_STRIDE, CMP_STRIDE, dh)
    blocks = jnp.concatenate([sub[:, :, :-1], sub[:, :, 1:]], axis=3) + pe
    flat = blocks.reshape(B, G, blocks.shape[2], CMP_BLOCK * dh)
    return jax.nn.gelu(flat @ w1) @ w2


def block_overlap(n_cmp, n_slc):
    ci = np.arange(n_cmp)[:, None] * CMP_STRIDE
    sj = np.arange(n_slc)[None, :] * SLC_BLOCK
    return ((ci < sj + SLC_BLOCK) & (ci + CMP_BLOCK > sj)).astype(np.float32)


def selected_attention(qh, ks, vs, idx, tbl):
    B, G, HPG, S, dh = qh.shape
    n_top = idx.shape[-1]
    nqb = S // Q_BLOCK
    kb = ks.reshape(B, G, S // SLC_BLOCK, SLC_BLOCK, dh)
    vb = vs.reshape(B, G, S // SLC_BLOCK, SLC_BLOCK, dh)

    def one_group(q, kb_g, vb_g, idx_g, tpos, tbl_g):
        kg = kb_g[idx_g]
        vg = vb_g[idx_g]
        s = jnp.einsum('hqd,qnld->hqnl', q, kg)
        kpos = idx_g[..., None] * SLC_BLOCK + jnp.arange(SLC_BLOCK)
        rel = tpos[:, None, None] - kpos
        s = s + tbl_g[:, t5_bucket(rel)]
        tq = idx_g.shape[0]
        p = masked_softmax(s.reshape(HPG, tq, n_top * SLC_BLOCK), (rel >= 0).reshape(tq, n_top * SLC_BLOCK))
        return jnp.einsum('hqm,qmd->hqd', p.astype(vg.dtype), vg.reshape(tq, n_top * SLC_BLOCK, dh))

    per_g = jax.vmap(one_group, in_axes=(0, 0, 0, 0, None, 0))
    per_bg = jax.vmap(per_g, in_axes=(0, 0, 0, 0, None, None))
    q_blocks = qh.reshape(B, G, HPG, nqb, Q_BLOCK, dh).transpose(3, 0, 1, 2, 4, 5)
    idx_blocks = idx.reshape(B, G, nqb, Q_BLOCK, n_top).transpose(2, 0, 1, 3, 4)
    t_blocks = jnp.arange(S).reshape(nqb, Q_BLOCK)
    out = lax.map(lambda a: per_bg(a[0], kb, vb, a[1], a[2], tbl), (q_blocks, idx_blocks, t_blocks))
    return out.transpose(1, 2, 3, 0, 4, 5).reshape(B, G, HPG, S, dh)


def window_attention(qh, kw, vw, tbl):
    B, G, HPG, S, dh = qh.shape
    nqb = S // Q_BLOCK
    nprev = WINDOW // Q_BLOCK
    span = (nprev + 1) * Q_BLOCK

    def band(t):
        tp = jnp.pad(t, ((0, 0), (0, 0), (WINDOW, 0), (0, 0))).reshape(B, G, nqb + nprev, Q_BLOCK, dh)
        return jnp.concatenate([tp[:, :, j:j + nqb] for j in range(nprev + 1)], axis=3)

    kband, vband = band(kw), band(vw)
    qb = qh.reshape(B, G, HPG, nqb, Q_BLOCK, dh)
    s = jnp.einsum('bghnqd,bgnkd->bghnqk', qb, kband)
    ql = jnp.arange(Q_BLOCK)[:, None]
    kl = jnp.arange(span)[None, :]
    rel = ql + WINDOW - kl
    kabs = jnp.arange(nqb)[:, None, None] * Q_BLOCK - WINDOW + kl[None]
    mask = (rel >= 0) & (rel < WINDOW) & (kabs >= 0)
    s = s + tbl[:, :, t5_bucket(rel)][:, :, None]
    p = masked_softmax(s, mask)
    o = jnp.einsum('bghnqk,bgnkd->bghnqd', p.astype(vband.dtype), vband)
    return o.reshape(B, G, HPG, S, dh)


def nsa_mixer(q, kc, vc, ks, vs, kw, vw, gates, pe_k, ck1, ck2, pe_v, cv1, cv2, rel_bias):
    B, S, _ = q.shape
    G, HPG, dh = NSA_KV_GROUPS, NSA_HPG, HEAD_DIM
    qh = q.reshape(B, S, G, HPG, dh).transpose(0, 2, 3, 1, 4) * (dh ** -0.5)

    def heads_kv(t):
        return t.reshape(B, S, G, dh).transpose(0, 2, 1, 3)

    tbl = rel_bias.T.reshape(G, HPG, REL_BUCKETS)
    tpos = jnp.arange(S)

    kcb = compress(heads_kv(kc), pe_k, ck1, ck2)
    vcb = compress(heads_kv(vc), pe_v, cv1, cv2)
    n_cmp = kcb.shape[2]
    cend = jnp.arange(n_cmp) * CMP_STRIDE + CMP_BLOCK - 1
    rel_c = tpos[:, None] - cend[None, :]
    s_c = jnp.einsum('bghsd,bgcd->bghsc', qh, kcb) + tbl[:, :, t5_bucket(rel_c)]
    p_c = masked_softmax(s_c, rel_c >= 0)
    o_c = jnp.einsum('bghsc,bgcd->bghsd', p_c.astype(vcb.dtype), vcb)

    n_slc = S // SLC_BLOCK
    n_top = min(SLC_TOPN, n_slc)
    imp = jnp.einsum('bghsc,cj->bgsj', p_c, jnp.asarray(block_overlap(n_cmp, n_slc)))
    j = jnp.arange(n_slc)[None, :]
    tb = (tpos // SLC_BLOCK)[:, None]
    forced = (j == 0) | (j == tb) | (j == tb - 1)
    future = j * SLC_BLOCK > tpos[:, None]
    imp = jnp.where(forced, 1e30, jnp.where(future, -1e30, imp))
    _, idx = lax.top_k(imp, n_top)
    o_s = selected_attention(qh, heads_kv(ks), heads_kv(vs), idx, tbl)

    o_w = window_attention(qh, heads_kv(kw), heads_kv(vw), tbl)

    g = jax.nn.sigmoid(gates.astype(jnp.float32)).reshape(B, S, 3, G, HPG).transpose(2, 0, 3, 4, 1)[..., None]
    o = g[0] * o_c + g[1] * o_s + g[2] * o_w
    return o.transpose(0, 3, 1, 2, 4).reshape(B, S, NSA_WIDTH).astype(q.dtype)


def gla_mixer(q, k, v, a_lr, r, w_alpha, b_alpha, norm_g):
    B, S, _ = q.shape
    H, dk, dv, C = GLA_HEADS, GLA_DK, GLA_DV, GLA_CHUNK
    nc = S // C
    f32 = jnp.float32
    log_a = jax.nn.log_sigmoid((a_lr @ w_alpha + b_alpha).astype(f32)) / GLA_TAU

    def chunks(t, d):
        return t.astype(f32).reshape(B, nc, C, H, d).transpose(0, 3, 1, 2, 4)

    qc = chunks(q, dk) * (dk ** -0.5)
    kc = chunks(k, dk)
    vc = chunks(v, dv)
    bc = jnp.cumsum(chunks(log_a, dk), axis=3)
    b_last = bc[:, :, :, -1:]
    q_in = qc * jnp.exp(bc)
    k_in = kc * jnp.exp(-bc)
    causal = jnp.tril(jnp.ones((C, C), dtype=bool))
    attn = jnp.where(causal, jnp.einsum('bhncd,bhnjd->bhncj', q_in, k_in), 0.0)
    o_intra = jnp.einsum('bhncj,bhnjv->bhncv', attn, vc)
    chunk_state = jnp.einsum('bhncd,bhncv->bhndv', kc * jnp.exp(b_last - bc), vc)
    decay = jnp.exp(b_last[:, :, :, 0])

    def step(state, xs):
        dec, upd = xs
        return dec[..., None] * state + upd, state

    _, prev = lax.scan(step, jnp.zeros((B, H, dk, dv), f32),
                       (decay.transpose(2, 0, 1, 3), chunk_state.transpose(2, 0, 1, 3, 4)))
    prev = prev.transpose(1, 2, 0, 3, 4)
    o = o_intra + jnp.einsum('bhncd,bhndv->bhncv', q_in, prev)
    o = o.transpose(0, 2, 3, 1, 4).reshape(B, S, H, dv)
    o = o * lax.rsqrt(jnp.mean(o * o, axis=-1, keepdims=True) + EPS)
    o = o.reshape(B, S, H * dv) * norm_g.astype(f32) * jax.nn.silu(r.astype(f32))
    return o.astype(q.dtype)


def hier_moe(h, w_rg, b_rg, w_re, b_re, w_gate, w_up, w_down):
    B, S, D = h.shape
    T = B * S
    t = h.reshape(T, D)
    p_group = jax.nn.softmax((t @ w_rg + b_rg).astype(jnp.float32), axis=-1)
    g_sel = jnp.argmax(p_group, axis=-1)
    g_prob = jnp.max(p_group, axis=-1)
    e_logits = (t @ w_re + b_re).astype(jnp.float32).reshape(T, N_GROUPS, EXPERTS_PER_GROUP)
    e_sel = jnp.take_along_axis(e_logits, g_sel[:, None, None], axis=1)[:, 0]
    top_v, top_i = lax.top_k(e_sel, TOPK_IN_GROUP)
    top_w = jax.nn.softmax(top_v, axis=-1) * g_prob[:, None]
    w_local = jnp.einsum('tk,tke->te', top_w, jax.nn.one_hot(top_i, EXPERTS_PER_GROUP, dtype=jnp.float32))
    combine = jax.nn.one_hot(g_sel, N_GROUPS, dtype=jnp.float32)[:, :, None] * w_local[:, None, :]
    wg = w_gate.reshape(N_GROUPS, EXPERTS_PER_GROUP, D, EXPERT_FF)
    wu = w_up.reshape(N_GROUPS, EXPERTS_PER_GROUP, D, EXPERT_FF)
    wd = w_down.reshape(N_GROUPS, EXPERTS_PER_GROUP, EXPERT_FF, D)
    y = jnp.zeros((T, D), dtype=t.dtype)
    for gi in range(N_GROUPS):
        a = jnp.einsum('td,edf->tef', t, wg[gi])
        u = jnp.einsum('td,edf->tef', t, wu[gi])
        hid = jax.nn.silu(a) * u * combine[:, gi, :, None].astype(t.dtype)
        y = y + jnp.einsum('tef,efd->td', hid, wd[gi])
    return y.reshape(B, S, D)


def setup_inputs(seed: int = 0) -> dict:
    key = jax.random.key(seed)
    ks = jax.random.split(key, 26)
    f32 = jnp.float32
    L = DEPTH
    n_in = sum(IN_SPLITS)

    def nrm(k, shape, scale):
        return jax.random.normal(k, shape, f32) * scale

    return {
        "x": nrm(ks[0], (BATCH, SEQ, D_MODEL), 1.0),
        "g_mix": 1.0 + nrm(ks[1], (L, D_MODEL), 0.02),
        "w_in": nrm(ks[2], (L, D_MODEL, n_in), D_MODEL ** -0.5),
        "nsa_pe_k": nrm(ks[3], (L, CMP_BLOCK, HEAD_DIM), 0.1),
        "nsa_cmp_k_w1": nrm(ks[4], (L, CMP_BLOCK * HEAD_DIM, CMP_HIDDEN), (CMP_BLOCK * HEAD_DIM) ** -0.5),
        "nsa_cmp_k_w2": nrm(ks[5], (L, CMP_HIDDEN, HEAD_DIM), CMP_HIDDEN ** -0.5),
        "nsa_pe_v": nrm(ks[6], (L, CMP_BLOCK, HEAD_DIM), 0.1),
        "nsa_cmp_v_w1": nrm(ks[7], (L, CMP_BLOCK * HEAD_DIM, CMP_HIDDEN), (CMP_BLOCK * HEAD_DIM) ** -0.5),
        "nsa_cmp_v_w2": nrm(ks[8], (L, CMP_HIDDEN, HEAD_DIM), CMP_HIDDEN ** -0.5),
        "rel_bias": nrm(ks[9], (REL_BUCKETS, NSA_HEADS), 0.2),
        "gla_w_alpha": nrm(ks[10], (L, GLA_GATE_RANK, GLA_K_WIDTH), GLA_GATE_RANK ** -0.5),
        "gla_b_alpha": nrm(ks[11], (L, GLA_K_WIDTH), 0.01),
        "gla_norm_g": 1.0 + nrm(ks[12], (L, GLA_V_WIDTH), 0.02),
        "w_branch_a": nrm(ks[13], (L, NSA_WIDTH, D_MODEL), NSA_WIDTH ** -0.5),
        "w_branch_b": nrm(ks[14], (L, GLA_V_WIDTH, D_MODEL), GLA_V_WIDTH ** -0.5),
        "w_out": nrm(ks[15], (L, D_MODEL, D_MODEL), D_MODEL ** -0.5),
        "g_ffn": 1.0 + nrm(ks[16], (L, D_MODEL), 0.02),
        "w_router_group": nrm(ks[17], (L, D_MODEL, N_GROUPS), D_MODEL ** -0.5),
        "b_router_group": nrm(ks[18], (L, N_GROUPS), 0.01),
        "w_router_expert": nrm(ks[19], (L, D_MODEL, N_EXPERTS), D_MODEL ** -0.5),
        "b_router_expert": nrm(ks[20], (L, N_EXPERTS), 0.01),
        "w_exp_gate": nrm(ks[21], (L, N_EXPERTS, D_MODEL, EXPERT_FF), D_MODEL ** -0.5),
        "w_exp_up": nrm(ks[22], (L, N_EXPERTS, D_MODEL, EXPERT_FF), D_MODEL ** -0.5),
        "w_exp_down": nrm(ks[23], (L, N_EXPERTS, EXPERT_FF, D_MODEL), EXPERT_FF ** -0.5),
        "g_final": 1.0 + nrm(ks[24], (D_MODEL,), 0.02),
    }


def reference(x, g_mix, w_in, nsa_pe_k, nsa_cmp_k_w1, nsa_cmp_k_w2, nsa_pe_v, nsa_cmp_v_w1,
              nsa_cmp_v_w2, rel_bias, gla_w_alpha, gla_b_alpha, gla_norm_g, w_branch_a, w_branch_b,
              w_out, g_ffn, w_router_group, b_router_group, w_router_expert, b_router_expert,
              w_exp_gate, w_exp_up, w_exp_down, g_final):
    split_at = np.cumsum(IN_SPLITS)[:-1].tolist()
    for l in range(DEPTH):
        h = rmsnorm(x, g_mix[l])
        proj = h @ w_in[l]
        (q_a, k_cmp, v_cmp, k_slc, v_slc, k_win, v_win, gate_a,
         q_b, k_b, v_b, a_b, r_b, mg_a, mg_b) = jnp.split(proj, split_at, axis=-1)
        y_a = nsa_mixer(q_a, k_cmp, v_cmp, k_slc, v_slc, k_win, v_win, gate_a,
                        nsa_pe_k[l], nsa_cmp_k_w1[l], nsa_cmp_k_w2[l],
                        nsa_pe_v[l], nsa_cmp_v_w1[l], nsa_cmp_v_w2[l], rel_bias)
        y_b = gla_mixer(q_b, k_b, v_b, a_b, r_b, gla_w_alpha[l], gla_b_alpha[l], gla_norm_g[l])
        merged = jax.nn.sigmoid(mg_a) * (y_a @ w_branch_a[l]) + jax.nn.sigmoid(mg_b) * (y_b @ w_branch_b[l])
        x = x + merged @ w_out[l]
        x = x + hier_moe(rmsnorm(x, g_ffn[l]), w_router_group[l], b_router_group[l],
                         w_router_expert[l], b_router_expert[l],
                         w_exp_gate[l], w_exp_up[l], w_exp_down[l])
    return rmsnorm(x, g_final)
```

```cpp
#include <hip/hip_runtime.h>
#include <stdint.h>

typedef unsigned short bf16_t;
__device__ __forceinline__ float bf2f(bf16_t v) { return __uint_as_float(((unsigned)v) << 16); }
__device__ __forceinline__ bf16_t f2bf(float f) { unsigned u = __float_as_uint(f); u += 0x7FFFu + ((u >> 16) & 1u); return (bf16_t)(u >> 16); }

constexpr int Bn = 4, S = 4096, T = Bn * S, D = 1024, NIN = 4904, PP = 2880;
constexpr int QA = 0, KC = 512, VC = 640, KS = 768, VS = 896, KW = 1024, VW = 1152, GA = 1280, QB = 1304, KB = 1560, VB = 1816, AB = 2328, RB = 2344, MGA = 2856, MGB = 3880;
constexpr int NPROJ = 2856;
constexpr int MSLOT = 34816;

constexpr size_t OFF_CTRL = 0;
constexpr size_t OFF_ROUTE_E = 4096;
constexpr size_t OFF_ROUTE_W = OFF_ROUTE_E + 32768 * 4;
constexpr size_t OFF_SLOT_TOK = OFF_ROUTE_W + 32768 * 4;
constexpr size_t OFF_SLOT_W = OFF_SLOT_TOK + (size_t)MSLOT * 4;
constexpr size_t OFF_R1 = 1u << 20;
constexpr size_t SZ_PROJ = (size_t)T * PP * 2;
constexpr size_t OFF_PROJ = OFF_R1;
constexpr size_t OFF_BC = OFF_PROJ + SZ_PROJ;
constexpr size_t OFF_CSTATE = OFF_BC + (size_t)T * 256 * 4;
constexpr size_t OFF_R1_END = OFF_CSTATE + (size_t)1024 * 8192 * 4;
constexpr size_t OFF_SA = OFF_R1;
constexpr size_t OFF_SB = OFF_SA + (size_t)T * 1024 * 2;
constexpr size_t OFF_H2 = OFF_R1;
constexpr size_t OFF_HID = OFF_H2 + (size_t)T * 1024 * 2;
constexpr size_t OFF_Y0 = OFF_HID + (size_t)MSLOT * 256 * 2;
constexpr size_t OFF_Y1 = OFF_Y0 + (size_t)T * 1024 * 2;
static_assert(OFF_Y1 + (size_t)T * 1024 * 2 <= OFF_R1_END, "alias overflow");
constexpr size_t OFF_YA = OFF_R1_END;
constexpr size_t OFF_YB = OFF_YA + (size_t)T * 512 * 2;
constexpr size_t OFF_KCB = OFF_YB + (size_t)T * 512 * 2;
constexpr size_t OFF_VCB = OFF_KCB + 8 * 256 * 64 * 2;
constexpr size_t OFF_HIDC = OFF_VCB + 8 * 256 * 64 * 2;
constexpr size_t OFF_END = OFF_HIDC + 2 * 2048 * 128 * 4;
static_assert(OFF_END <= (size_t)256 << 20, "workspace overflow");

__global__ void __launch_bounds__(256) k_rms_h(const float* __restrict__ x, const float* __restrict__ g, bf16_t* __restrict__ h) {
    const int row = blockIdx.x;
    float4 v = ((const float4*)(x + (size_t)row * D))[threadIdx.x];
    float s = v.x * v.x + v.y * v.y + v.z * v.z + v.w * v.w;
    for (int o = 32; o > 0; o >>= 1) s += __shfl_xor(s, o);
    __shared__ float red[4];
    if ((threadIdx.x & 63) == 0) red[threadIdx.x >> 6] = s;
    __syncthreads();
    s = red[0] + red[1] + red[2] + red[3];
    const float r = rsqrtf(s * (1.0f / D) + 1e-6f);
    float4 gg = ((const float4*)g)[threadIdx.x];
    ushort4 o; o.x = f2bf(v.x * r * gg.x); o.y = f2bf(v.y * r * gg.y); o.z = f2bf(v.z * r * gg.z); o.w = f2bf(v.w * r * gg.w);
    ((ushort4*)(h + (size_t)row * D))[threadIdx.x] = o;
}

template <class LA, class EP, int NW, bool GROUPED>
__global__ void __launch_bounds__(256) k_gemm(LA la, EP ep, const float* __restrict__ W0, const float* __restrict__ W1, int ldw, int M, int N, int K,
                                              const int* __restrict__ offs, size_t wstride) {
    __shared__ float As[16][65];
    __shared__ float Ws[NW][16][64];
    const int tid = threadIdx.x, tx = tid & 15, ty = tid >> 4;
    const int m0 = blockIdx.y * 64, n0 = blockIdx.x * 64;
    if (GROUPED) {
        if (m0 >= offs[32]) return;
        int e = 0;
        for (int i = 1; i < 32; ++i) if (offs[i] <= m0) e = i;
        W0 += (size_t)e * wstride; if (NW > 1) W1 += (size_t)e * wstride;
    }
    float acc[NW][4][4];
#pragma unroll
    for (int w = 0; w < NW; ++w)
#pragma unroll
        for (int i = 0; i < 4; ++i)
#pragma unroll
            for (int j = 0; j < 4; ++j) acc[w][i][j] = 0.f;
    for (int k0 = 0; k0 < K; k0 += 16) {
#pragma unroll
        for (int i = 0; i < 4; ++i) {
            const int e = tid + i * 256, m = e >> 4, k = e & 15;
            As[k][m] = (m0 + m < M) ? la(m0 + m, k0 + k) : 0.f;
        }
#pragma unroll
        for (int i = 0; i < 4; ++i) {
            const int e = tid + i * 256, k = e >> 6, n = e & 63;
            const bool ok = (n0 + n < N);
            Ws[0][k][n] = ok ? W0[(size_t)(k0 + k) * ldw + n0 + n] : 0.f;
            if (NW > 1) Ws[NW - 1][k][n] = ok ? W1[(size_t)(k0 + k) * ldw + n0 + n] : 0.f;
        }
        __syncthreads();
#pragma unroll
        for (int k = 0; k < 16; ++k) {
            float a[4];
#pragma unroll
            for (int i = 0; i < 4; ++i) a[i] = As[k][ty * 4 + i];
#pragma unroll
            for (int w = 0; w < NW; ++w) {
                float b[4];
#pragma unroll
                for (int j = 0; j < 4; ++j) b[j] = Ws[w][k][tx * 4 + j];
#pragma unroll
                for (int i = 0; i < 4; ++i)
#pragma unroll
                    for (int j = 0; j < 4; ++j) acc[w][i][j] += a[i] * b[j];
            }
        }
        __syncthreads();
    }
#pragma unroll
    for (int i = 0; i < 4; ++i)
#pragma unroll
        for (int j = 0; j < 4; ++j) {
            const int m = m0 + ty * 4 + i, n = n0 + tx * 4 + j;
            if (m < M && n < N) ep(m, n, acc[0][i][j], acc[NW - 1][i][j]);
        }
}

struct LA_bf16 { const bf16_t* A; int lda; int pad; __device__ float operator()(int m, int k) const { return bf2f(A[(size_t)m * lda + k]); } };
struct EP_bf16 { bf16_t* C; int ldc; int pad; __device__ void operator()(int m, int n, float a, float) const { C[(size_t)m * ldc + n] = f2bf(a); } };
struct LA_cmp { const bf16_t* proj; const float* pe; int col0; int pad;
    __device__ float operator()(int m, int k) const { const int c = m & 255, bg = m >> 8, b = bg >> 1, g = bg & 1, i = k >> 6, d = k & 63;
        if (c >= 255) return 0.f;
        return bf2f(proj[(size_t)(b * S + 16 * c + i) * PP + col0 + g * 64 + d]) + pe[k]; } };
struct EP_gelu { float* C; int ldc; int pad; __device__ void operator()(int m, int n, float a, float) const {
        const float u = 0.7978845608028654f * (a + 0.044715f * a * a * a); C[(size_t)m * ldc + n] = 0.5f * a * (1.f + tanhf(u)); } };
struct LA_f32 { const float* A; int lda; int pad; __device__ float operator()(int m, int k) const { return A[(size_t)m * lda + k]; } };
struct EP_sig { bf16_t* C; __device__ void operator()(int m, int n, float a, float) const { C[(size_t)m * 1024 + n] = f2bf(1.f / (1.f + __expf(-a))); } };
struct EP_mulinto { bf16_t* C; __device__ void operator()(int m, int n, float a, float) const { bf16_t* p = C + (size_t)m * 1024 + n; *p = f2bf(bf2f(*p) * a); } };
struct EP_merge { bf16_t* SA; const bf16_t* SB; __device__ void operator()(int m, int n, float a, float) const { bf16_t* p = SA + (size_t)m * 1024 + n; *p = f2bf(bf2f(*p) + bf2f(SB[(size_t)m * 1024 + n]) * a); } };
struct EP_resid { const float* x; float* x2; __device__ void operator()(int m, int n, float a, float) const { x2[(size_t)m * 1024 + n] = x[(size_t)m * 1024 + n] + a; } };
struct LA_moe1 { const bf16_t* h2; const int* slot_tok; __device__ float operator()(int m, int k) const { const int tk = slot_tok[m]; return tk >= 0 ? bf2f(h2[(size_t)(tk >> 1) * 1024 + k]) : 0.f; } };
struct EP_moe1 { bf16_t* hid; const int* slot_tok; const float* slot_w; __device__ void operator()(int m, int n, float a, float u) const {
        const int tk = slot_tok[m]; float v = 0.f; if (tk >= 0) v = a / (1.f + __expf(-a)) * u * slot_w[m]; hid[(size_t)m * 256 + n] = f2bf(v); } };
struct EP_moe2 { bf16_t* Y0; bf16_t* Y1; const int* slot_tok; __device__ void operator()(int m, int n, float a, float) const {
        const int tk = slot_tok[m]; if (tk >= 0) { bf16_t* Y = (tk & 1) ? Y1 : Y0; Y[(size_t)(tk >> 1) * 1024 + n] = f2bf(a); } } };

__device__ __forceinline__ int t5_bucket(int n) {
    if (n < 16) return n;
    const int l = 16 + (int)(logf((float)n / 16.0f) / logf(8.0f) * 16.0f);
    return l < 31 ? l : 31;
}
__device__ __forceinline__ float wave_max(float v) { for (int o = 32; o > 0; o >>= 1) v = fmaxf(v, __shfl_xor(v, o)); return v; }
__device__ __forceinline__ float wave_sum(float v) { for (int o = 32; o > 0; o >>= 1) v += __shfl_xor(v, o); return v; }

struct AttnState { float m[4], l[4], o[4]; };

__device__ __forceinline__ void attend_block(AttnState& st, const bf16_t* __restrict__ Kp, const bf16_t* __restrict__ Vp, int key0, bool valid, int rel,
                                             const float (*q_lds)[64], const float (*tb_lds)[128], float (*p_lds)[256], int lane) {
    float s[4] = {0.f, 0.f, 0.f, 0.f};
    const bf16_t* kr = Kp + (size_t)(key0 + lane) * PP;
#pragma unroll
    for (int d8 = 0; d8 < 8; ++d8) {
        const uint4 raw = *(const uint4*)(kr + d8 * 8);
        const unsigned w[4] = {raw.x, raw.y, raw.z, raw.w};
#pragma unroll
        for (int j = 0; j < 4; ++j) {
            const float k0 = __uint_as_float(w[j] << 16), k1 = __uint_as_float(w[j] & 0xFFFF0000u);
#pragma unroll
            for (int hp = 0; hp < 4; ++hp) s[hp] += q_lds[hp][d8 * 8 + 2 * j] * k0 + q_lds[hp][d8 * 8 + 2 * j + 1] * k1;
        }
    }
    const int rc = rel < 0 ? 0 : (rel > 127 ? 127 : rel);
#pragma unroll
    for (int hp = 0; hp < 4; ++hp) {
        const float sc = valid ? s[hp] + tb_lds[hp][rc] : -3.0e38f;
        const float bm = wave_max(sc);
        const float mn = fmaxf(st.m[hp], bm);
        const float scale = __expf(st.m[hp] - mn);
        const float p = valid ? __expf(sc - mn) : 0.f;
        st.l[hp] = st.l[hp] * scale + wave_sum(p);
        st.o[hp] *= scale; st.m[hp] = mn;
        p_lds[hp][lane] = p;
    }
    __syncthreads();
    const bf16_t* vr = Vp + (size_t)key0 * PP + lane;
    for (int k = 0; k < 64; ++k) {
        const float v = bf2f(vr[(size_t)k * PP]);
#pragma unroll
        for (int hp = 0; hp < 4; ++hp) st.o[hp] += p_lds[hp][k] * v;
    }
    __syncthreads();
}

__global__ void __launch_bounds__(64) k_nsa(const bf16_t* __restrict__ proj, const bf16_t* __restrict__ kcb, const bf16_t* __restrict__ vcb,
                                            const float* __restrict__ rel_bias, bf16_t* __restrict__ ya) {
    __shared__ float p_lds[4][256];
    __shared__ float q_lds[4][64];
    __shared__ float tb_lds[4][128];
    const int lane = threadIdx.x;
    const int idx = blockIdx.x, t = idx & (S - 1), g = (idx >> 12) & 1, b = idx >> 13;
    const size_t row = (size_t)(b * S + t) * PP;
#pragma unroll
    for (int hp = 0; hp < 4; ++hp) {
        q_lds[hp][lane] = bf2f(proj[row + QA + (g * 4 + hp) * 64 + lane]) * 0.125f;
        tb_lds[hp][lane] = rel_bias[t5_bucket(lane) * 8 + g * 4 + hp];
        tb_lds[hp][lane + 64] = rel_bias[t5_bucket(lane + 64) * 8 + g * 4 + hp];
    }
    __syncthreads();
    const int nvis = t >= 31 ? (((t - 31) >> 4) + 1 > 255 ? 255 : ((t - 31) >> 4) + 1) : 0;
    const bf16_t* kc = kcb + (size_t)(b * 2 + g) * 256 * 64;
    const bf16_t* vc = vcb + (size_t)(b * 2 + g) * 256 * 64;
    float oc[4] = {0.f, 0.f, 0.f, 0.f};
    {
        float sc[4][4];
#pragma unroll
        for (int i = 0; i < 4; ++i) {
            const int c = lane + 64 * i;
            float s[4] = {0.f, 0.f, 0.f, 0.f};
            const bf16_t* kr = kc + (size_t)c * 64;
#pragma unroll
            for (int d8 = 0; d8 < 8; ++d8) {
                const uint4 raw = *(const uint4*)(kr + d8 * 8);
                const unsigned w[4] = {raw.x, raw.y, raw.z, raw.w};
#pragma unroll
                for (int j = 0; j < 4; ++j) {
                    const float k0 = __uint_as_float(w[j] << 16), k1 = __uint_as_float(w[j] & 0xFFFF0000u);
#pragma unroll
                    for (int hp = 0; hp < 4; ++hp) s[hp] += q_lds[hp][d8 * 8 + 2 * j] * k0 + q_lds[hp][d8 * 8 + 2 * j + 1] * k1;
                }
            }
            const int rel = t - (16 * c + 31);
            const int rc = rel < 0 ? 0 : (rel > 127 ? 127 : rel);
#pragma unroll
            for (int hp = 0; hp < 4; ++hp) sc[hp][i] = (c < nvis) ? s[hp] + tb_lds[hp][rc] : -3.0e38f;
        }
#pragma unroll
        for (int hp = 0; hp < 4; ++hp) {
            float m = fmaxf(fmaxf(sc[hp][0], sc[hp][1]), fmaxf(sc[hp][2], sc[hp][3]));
            m = wave_max(m);
            float e[4], sum = 0.f;
#pragma unroll
            for (int i = 0; i < 4; ++i) { e[i] = (lane + 64 * i < nvis) ? __expf(sc[hp][i] - m) : 0.f; sum += e[i]; }
            sum = wave_sum(sum);
            const float inv = nvis > 0 ? 1.f / sum : 0.f;
#pragma unroll
            for (int i = 0; i < 4; ++i) p_lds[hp][lane + 64 * i] = e[i] * inv;
        }
        __syncthreads();
        for (int c = 0; c < nvis; ++c) {
            const float v = bf2f(vc[(size_t)c * 64 + lane]);
#pragma unroll
            for (int hp = 0; hp < 4; ++hp) oc[hp] += p_lds[hp][c] * v;
        }
    }
    const int tb = t >> 6;
    unsigned long long selmask;
    {
        float imp = 0.f;
        const int c0 = 4 * lane - 1 < 0 ? 0 : 4 * lane - 1, c1 = 4 * lane + 3 > 254 ? 254 : 4 * lane + 3;
        for (int c = c0; c <= c1; ++c)
#pragma unroll
            for (int hp = 0; hp < 4; ++hp) imp += p_lds[hp][c];
        const bool forced = (lane == 0) || (lane == tb) || (lane == tb - 1);
        const float val = forced ? 1e30f : (lane > tb ? -1e30f : imp);
        int rank = 0;
        for (int j = 0; j < 64; ++j) {
            const float o = __shfl(val, j);
            rank += (o > val || (o == val && j < lane)) ? 1 : 0;
        }
        selmask = __ballot(rank < 16);
    }
    __syncthreads();
    AttnState ss;
#pragma unroll
    for (int hp = 0; hp < 4; ++hp) { ss.m[hp] = -1e30f; ss.l[hp] = 0.f; ss.o[hp] = 0.f; }
    const bf16_t* pb = proj + (size_t)b * S * PP;
    for (int j = 0; j <= tb; ++j) {
        if (!((selmask >> j) & 1ull)) continue;
        const int rel = t - (64 * j + lane);
        attend_block(ss, pb + KS + g * 64, pb + VS + g * 64, 64 * j, rel >= 0, rel, q_lds, tb_lds, p_lds, lane);
    }
    AttnState sw;
#pragma unroll
    for (int hp = 0; hp < 4; ++hp) { sw.m[hp] = -1e30f; sw.l[hp] = 0.f; sw.o[hp] = 0.f; }
    const int kb0 = (t - 511 < 0 ? 0 : t - 511) >> 6;
    for (int j = kb0; j <= tb; ++j) {
        const int rel = t - (64 * j + lane);
        attend_block(sw, pb + KW + g * 64, pb + VW + g * 64, 64 * j, rel >= 0 && rel < 512, rel, q_lds, tb_lds, p_lds, lane);
    }
#pragma unroll
    for (int hp = 0; hp < 4; ++hp) {
        const int head = g * 4 + hp;
        const float g0 = 1.f / (1.f + __expf(-bf2f(proj[row + GA + head])));
        const float g1 = 1.f / (1.f + __expf(-bf2f(proj[row + GA + 8 + head])));
        const float g2 = 1.f / (1.f + __expf(-bf2f(proj[row + GA + 16 + head])));
        const float o = g0 * oc[hp] + g1 * ss.o[hp] / ss.l[hp] + g2 * sw.o[hp] / sw.l[hp];
        ya[(size_t)(b * S + t) * 512 + head * 64 + lane] = f2bf(o);
    }
}

__global__ void __launch_bounds__(64) k_gla_prep(const bf16_t* __restrict__ proj, const float* __restrict__ w_alpha, const float* __restrict__ b_alpha, float* __restrict__ bc) {
    const int lane = threadIdx.x, n = blockIdx.x & 63, h = (blockIdx.x >> 6) & 3, b = blockIdx.x >> 8;
    const int col = h * 64 + lane;
    float w[16];
#pragma unroll
    for (int r = 0; r < 16; ++r) w[r] = w_alpha[r * 256 + col];
    const float bias = b_alpha[col];
    float cum = 0.f;
    for (int c = 0; c < 64; ++c) {
        const size_t row = (size_t)(b * S + n * 64 + c);
        float z = bias;
#pragma unroll
        for (int r = 0; r < 16; ++r) z += bf2f(proj[row * PP + AB + r]) * w[r];
        const float ls = fminf(z, 0.f) - log1pf(__expf(-fabsf(z)));
        cum += ls * (1.0f / 16.0f);
        bc[row * 256 + col] = cum;
    }
}

__global__ void __launch_bounds__(256) k_gla_state(const bf16_t* __restrict__ proj, const float* __restrict__ bc, float* __restrict__ cstate) {
    __shared__ float kd[64][64];
    __shared__ float vs[64][128];
    const int tid = threadIdx.x, n = blockIdx.x & 63, h = (blockIdx.x >> 6) & 3, b = blockIdx.x >> 8;
    const size_t row0 = (size_t)(b * S + n * 64);
    for (int e = tid; e < 4096; e += 256) {
        const int c = e >> 6, d = e & 63;
        kd[c][d] = bf2f(proj[(row0 + c) * PP + KB + h * 64 + d]) * __expf(bc[(row0 + 63) * 256 + h * 64 + d] - bc[(row0 + c) * 256 + h * 64 + d]);
    }
    for (int e = tid; e < 8192; e += 256) {
        const int c = e >> 7, v = e & 127;
        vs[c][v] = bf2f(proj[(row0 + c) * PP + VB + h * 128 + v]);
    }
    __syncthreads();
    const int v = tid & 127, dg = tid >> 7;
    float acc[32];
#pragma unroll
    for (int i = 0; i < 32; ++i) acc[i] = 0.f;
    for (int c = 0; c < 64; ++c) {
        const float vv = vs[c][v];
#pragma unroll
        for (int i = 0; i < 32; ++i) acc[i] += kd[c][dg * 32 + i] * vv;
    }
    float* out = cstate + (size_t)blockIdx.x * 8192;
#pragma unroll
    for (int i = 0; i < 32; ++i) out[(dg * 32 + i) * 128 + v] = acc[i];
}

__global__ void __launch_bounds__(256) k_gla_scan(const float* __restrict__ bc, float* __restrict__ cstate) {
    const int idx = blockIdx.x * 256 + threadIdx.x;
    const int e = idx & 8191, bh = idx >> 13, b = bh >> 2, h = bh & 3, d = e >> 7;
    float state = 0.f;
    for (int n = 0; n < 64; ++n) {
        float* p = cstate + ((size_t)(bh * 64 + n)) * 8192 + e;
        const float upd = *p;
        *p = state;
        const float dec = __expf(bc[((size_t)(b * S + n * 64 + 63)) * 256 + h * 64 + d]);
        state = dec * state + upd;
    }
}

__global__ void __launch_bounds__(256) k_gla_out(const bf16_t* __restrict__ proj, const float* __restrict__ bc, const float* __restrict__ prev,
                                                 const float* __restrict__ norm_g, bf16_t* __restrict__ yb) {
    __shared__ float qi[64][65];
    __shared__ float ki[64][65];
    __shared__ float at[64][65];
    const int tid = threadIdx.x, n = blockIdx.x & 63, h = (blockIdx.x >> 6) & 3, b = blockIdx.x >> 8;
    const size_t row0 = (size_t)(b * S + n * 64);
    for (int e = tid; e < 4096; e += 256) {
        const int c = e >> 6, d = e & 63;
        const float bcv = bc[(row0 + c) * 256 + h * 64 + d];
        qi[c][d] = bf2f(proj[(row0 + c) * PP + QB + h * 64 + d]) * 0.125f * __expf(bcv);
        ki[c][d] = bf2f(proj[(row0 + c) * PP + KB + h * 64 + d]) * __expf(-bcv);
    }
    __syncthreads();
    for (int e = tid; e < 4096; e += 256) {
        const int c = e >> 6, j = e & 63;
        float a = 0.f;
        if (j <= c) for (int d = 0; d < 64; ++d) a += qi[c][d] * ki[j][d];
        at[c][j] = a;
    }
    __syncthreads();
    const int c = tid >> 2, vg = tid & 3;
    float acc[32];
#pragma unroll
    for (int i = 0; i < 32; ++i) acc[i] = 0.f;
    for (int j = 0; j <= c; ++j) {
        const float a = at[c][j];
        const bf16_t* vr = proj + (row0 + j) * PP + VB + h * 128 + vg * 32;
#pragma unroll
        for (int i = 0; i < 32; ++i) acc[i] += a * bf2f(vr[i]);
    }
    const float* pv = prev + (size_t)blockIdx.x * 8192 + vg * 32;
    for (int d = 0; d < 64; ++d) {
        const float qv = qi[c][d];
#pragma unroll
        for (int i = 0; i < 32; ++i) acc[i] += qv * pv[d * 128 + i];
    }
    float ss = 0.f;
#pragma unroll
    for (int i = 0; i < 32; ++i) ss += acc[i] * acc[i];
    ss += __shfl_xor(ss, 1); ss += __shfl_xor(ss, 2);
    const float r = rsqrtf(ss * (1.0f / 128.0f) + 1e-6f);
    const size_t row = row0 + c;
#pragma unroll
    for (int i = 0; i < 32; ++i) {
        const int col = h * 128 + vg * 32 + i;
        const float rv = bf2f(proj[row * PP + RB + col]);
        yb[row * 512 + col] = f2bf(acc[i] * r * norm_g[col] * (rv / (1.f + __expf(-rv))));
    }
}

__global__ void __launch_bounds__(256) k_router(const float* __restrict__ x2, const float* __restrict__ g, const float* __restrict__ w_rg, const float* __restrict__ b_rg,
                                                const float* __restrict__ w_re, const float* __restrict__ b_re, bf16_t* __restrict__ h2,
                                                int* __restrict__ route_e, float* __restrict__ route_w, int* __restrict__ cnt) {
    __shared__ float red[4];
    __shared__ float part[4][36];
    const int row = blockIdx.x, tid = threadIdx.x;
    float4 v = ((const float4*)(x2 + (size_t)row * D))[tid];
    float s = v.x * v.x + v.y * v.y + v.z * v.z + v.w * v.w;
    s = wave_sum(s);
    if ((tid & 63) == 0) red[tid >> 6] = s;
    __syncthreads();
    s = red[0] + red[1] + red[2] + red[3];
    const float r = rsqrtf(s * (1.0f / D) + 1e-6f);
    float4 gg = ((const float4*)g)[tid];
    float hn[4] = {v.x * r * gg.x, v.y * r * gg.y, v.z * r * gg.z, v.w * r * gg.w};
    ushort4 o; o.x = f2bf(hn[0]); o.y = f2bf(hn[1]); o.z = f2bf(hn[2]); o.w = f2bf(hn[3]);
    ((ushort4*)(h2 + (size_t)row * D))[tid] = o;
    float pl[36];
#pragma unroll
    for (int j = 0; j < 36; ++j) pl[j] = 0.f;
#pragma unroll
    for (int i = 0; i < 4; ++i) {
        const int k = tid * 4 + i;
#pragma unroll
        for (int j = 0; j < 4; ++j) pl[j] += hn[i] * w_rg[k * 4 + j];
#pragma unroll
        for (int j = 0; j < 32; ++j) pl[4 + j] += hn[i] * w_re[k * 32 + j];
    }
#pragma unroll
    for (int j = 0; j < 36; ++j) { const float t = wave_sum(pl[j]); if ((tid & 63) == 0) part[tid >> 6][j] = t; }
    __syncthreads();
    if (tid == 0) {
        float lg[4];
#pragma unroll
        for (int j = 0; j < 4; ++j) lg[j] = part[0][j] + part[1][j] + part[2][j] + part[3][j] + b_rg[j];
        int gs = 0; float mx = lg[0];
#pragma unroll
        for (int j = 1; j < 4; ++j) if (lg[j] > mx) { mx = lg[j]; gs = j; }
        float den = 0.f;
#pragma unroll
        for (int j = 0; j < 4; ++j) den += __expf(lg[j] - mx);
        const float gp = 1.f / den;
        float v0 = -3e38f, v1 = -3e38f; int i0 = 0, i1 = 0;
        for (int j = 0; j < 8; ++j) {
            const int c = 4 + gs * 8 + j;
            const float l = part[0][c] + part[1][c] + part[2][c] + part[3][c] + b_re[gs * 8 + j];
            if (l > v0) { v1 = v0; i1 = i0; v0 = l; i0 = j; }
            else if (l > v1) { v1 = l; i1 = j; }
        }
        const float e1 = __expf(v1 - v0);
        const float w0 = gp / (1.f + e1), w1 = gp * e1 / (1.f + e1);
        const int ea = gs * 8 + i0, eb = gs * 8 + i1;
        route_e[row * 2] = ea; route_e[row * 2 + 1] = eb;
        route_w[row * 2] = w0; route_w[row * 2 + 1] = w1;
        atomicAdd(&cnt[ea], 1); atomicAdd(&cnt[eb], 1);
    }
}

__global__ void k_offsets(int* __restrict__ ctrl) {
    if (threadIdx.x == 0) {
        int acc = 0;
        for (int e = 0; e < 32; ++e) { ctrl[64 + e] = acc; acc += (ctrl[e] + 63) & ~63; ctrl[32 + e] = 0; }
        ctrl[64 + 32] = acc;
    }
}

__global__ void __launch_bounds__(256) k_assign(const int* __restrict__ route_e, const float* __restrict__ route_w, int* __restrict__ ctrl,
                                                int* __restrict__ slot_tok, float* __restrict__ slot_w) {
    const int i = blockIdx.x * 256 + threadIdx.x;
    const int e = route_e[i];
    const int pos = atomicAdd(&ctrl[32 + e], 1);
    const int s = ctrl[64 + e] + pos;
    slot_tok[s] = i; slot_w[s] = route_w[i];
}

__global__ void __launch_bounds__(256) k_final(float* __restrict__ x2out, const bf16_t* __restrict__ Y0, const bf16_t* __restrict__ Y1, const float* __restrict__ g) {
    const int row = blockIdx.x, tid = threadIdx.x;
    float4 v = ((const float4*)(x2out + (size_t)row * D))[tid];
    const ushort4 a = ((const ushort4*)(Y0 + (size_t)row * D))[tid], c = ((const ushort4*)(Y1 + (size_t)row * D))[tid];
    v.x += bf2f(a.x) + bf2f(c.x); v.y += bf2f(a.y) + bf2f(c.y); v.z += bf2f(a.z) + bf2f(c.z); v.w += bf2f(a.w) + bf2f(c.w);
    float s = v.x * v.x + v.y * v.y + v.z * v.z + v.w * v.w;
    s = wave_sum(s);
    __shared__ float red[4];
    if ((tid & 63) == 0) red[tid >> 6] = s;
    __syncthreads();
    s = red[0] + red[1] + red[2] + red[3];
    const float r = rsqrtf(s * (1.0f / D) + 1e-6f);
    float4 gg = ((const float4*)g)[tid];
    ((float4*)(x2out + (size_t)row * D))[tid] = make_float4(v.x * r * gg.x, v.y * r * gg.y, v.z * r * gg.z, v.w * r * gg.w);
}

template <class LA, class EP, int NW, bool GROUPED>
static void gemm(hipStream_t st, LA la, EP ep, const float* W0, const float* W1, int ldw, int M, int N, int K, const int* offs = nullptr, size_t wstride = 0) {
    dim3 grid((N + 63) / 64, (M + 63) / 64);
    k_gemm<LA, EP, NW, GROUPED><<<grid, 256, 0, st>>>(la, ep, W0, W1, ldw, M, N, K, offs, wstride);
}

extern "C" void kernel_launch(void* const* d_in, const int* in_sizes, int n_in, void* d_out, int out_size, void* d_ws, size_t ws_size, hipStream_t stream) {
    const float* x = (const float*)d_in[0];
    const float* g_mix = (const float*)d_in[1];
    const float* w_in = (const float*)d_in[2];
    const float* pe_k = (const float*)d_in[3];
    const float* ck1 = (const float*)d_in[4];
    const float* ck2 = (const float*)d_in[5];
    const float* pe_v = (const float*)d_in[6];
    const float* cv1 = (const float*)d_in[7];
    const float* cv2 = (const float*)d_in[8];
    const float* rel_bias = (const float*)d_in[9];
    const float* w_alpha = (const float*)d_in[10];
    const float* b_alpha = (const float*)d_in[11];
    const float* norm_g = (const float*)d_in[12];
    const float* w_ba = (const float*)d_in[13];
    const float* w_bb = (const float*)d_in[14];
    const float* w_out = (const float*)d_in[15];
    const float* g_ffn = (const float*)d_in[16];
    const float* w_rg = (const float*)d_in[17];
    const float* b_rg = (const float*)d_in[18];
    const float* w_re = (const float*)d_in[19];
    const float* b_re = (const float*)d_in[20];
    const float* w_eg = (const float*)d_in[21];
    const float* w_eu = (const float*)d_in[22];
    const float* w_ed = (const float*)d_in[23];
    const float* g_final = (const float*)d_in[24];
    char* ws = (char*)d_ws;
    float* out = (float*)d_out;
    int* ctrl = (int*)(ws + OFF_CTRL);
    int* route_e = (int*)(ws + OFF_ROUTE_E);
    float* route_w = (float*)(ws + OFF_ROUTE_W);
    int* slot_tok = (int*)(ws + OFF_SLOT_TOK);
    float* slot_w = (float*)(ws + OFF_SLOT_W);
    bf16_t* proj = (bf16_t*)(ws + OFF_PROJ);
    float* bc = (float*)(ws + OFF_BC);
    float* cstate = (float*)(ws + OFF_CSTATE);
    bf16_t* SA = (bf16_t*)(ws + OFF_SA);
    bf16_t* SB = (bf16_t*)(ws + OFF_SB);
    bf16_t* h2 = (bf16_t*)(ws + OFF_H2);
    bf16_t* hid = (bf16_t*)(ws + OFF_HID);
    bf16_t* Y0 = (bf16_t*)(ws + OFF_Y0);
    bf16_t* Y1 = (bf16_t*)(ws + OFF_Y1);
    bf16_t* ya = (bf16_t*)(ws + OFF_YA);
    bf16_t* yb = (bf16_t*)(ws + OFF_YB);
    bf16_t* kcb = (bf16_t*)(ws + OFF_KCB);
    bf16_t* vcb = (bf16_t*)(ws + OFF_VCB);
    float* hidc = (float*)(ws + OFF_HIDC);
    bf16_t* h = (bf16_t*)d_out;

    hipMemsetAsync(ws + OFF_CTRL, 0, 4096, stream);
    hipMemsetAsync(slot_tok, 0xFF, (size_t)MSLOT * 4, stream);

    k_rms_h<<<T, 256, 0, stream>>>(x, g_mix, h);
    gemm<LA_bf16, EP_bf16, 1, false>(stream, LA_bf16{h, D, 0}, EP_bf16{proj, PP, 0}, w_in, nullptr, NIN, T, NPROJ, D);
    gemm<LA_cmp, EP_gelu, 1, false>(stream, LA_cmp{proj, pe_k, KC, 0}, EP_gelu{hidc, 128, 0}, ck1, nullptr, 128, 2048, 128, 2048);
    gemm<LA_f32, EP_bf16, 1, false>(stream, LA_f32{hidc, 128, 0}, EP_bf16{kcb, 64, 0}, ck2, nullptr, 64, 2048, 64, 128);
    gemm<LA_cmp, EP_gelu, 1, false>(stream, LA_cmp{proj, pe_v, VC, 0}, EP_gelu{hidc + 2048 * 128, 128, 0}, cv1, nullptr, 128, 2048, 128, 2048);
    gemm<LA_f32, EP_bf16, 1, false>(stream, LA_f32{hidc + 2048 * 128, 128, 0}, EP_bf16{vcb, 64, 0}, cv2, nullptr, 64, 2048, 64, 128);
    k_nsa<<<Bn * 2 * S, 64, 0, stream>>>(proj, kcb, vcb, rel_bias, ya);
    k_gla_prep<<<1024, 64, 0, stream>>>(proj, w_alpha, b_alpha, bc);
    k_gla_state<<<1024, 256, 0, stream>>>(proj, bc, cstate);
    k_gla_scan<<<16 * 8192 / 256, 256, 0, stream>>>(bc, cstate);
    k_gla_out<<<1024, 256, 0, stream>>>(proj, bc, cstate, norm_g, yb);
    gemm<LA_bf16, EP_sig, 1, false>(stream, LA_bf16{h, D, 0}, EP_sig{SA}, w_in + MGA, nullptr, NIN, T, 1024, D);
    gemm<LA_bf16, EP_mulinto, 1, false>(stream, LA_bf16{ya, 512, 0}, EP_mulinto{SA}, w_ba, nullptr, 1024, T, 1024, 512);
    gemm<LA_bf16, EP_sig, 1, false>(stream, LA_bf16{h, D, 0}, EP_sig{SB}, w_in + MGB, nullptr, NIN, T, 1024, D);
    gemm<LA_bf16, EP_merge, 1, false>(stream, LA_bf16{yb, 512, 0}, EP_merge{SA, SB}, w_bb, nullptr, 1024, T, 1024, 512);
    gemm<LA_bf16, EP_resid, 1, false>(stream, LA_bf16{SA, 1024, 0}, EP_resid{x, out}, w_out, nullptr, 1024, T, 1024, 1024);
    k_router<<<T, 256, 0, stream>>>(out, g_ffn, w_rg, b_rg, w_re, b_re, h2, route_e, route_w, ctrl);
    k_offsets<<<1, 64, 0, stream>>>(ctrl);
    k_assign<<<2 * T / 256, 256, 0, stream>>>(route_e, route_w, ctrl, slot_tok, slot_w);
    gemm<LA_moe1, EP_moe1, 2, true>(stream, LA_moe1{h2, slot_tok}, EP_moe1{hid, slot_tok, slot_w}, w_eg, w_eu, 256, MSLOT, 256, 1024, ctrl + 64, (size_t)1024 * 256);
    gemm<LA_bf16, EP_moe2, 1, true>(stream, LA_bf16{hid, 256, 0}, EP_moe2{Y0, Y1, slot_tok}, w_ed, nullptr, 1024, MSLOT, 1024, 256, ctrl + 64, (size_t)256 * 1024);
    k_final<<<T, 256, 0, stream>>>(out, Y0, Y1, g_final);
}
```

```cpp
#include <hip/hip_runtime.h>
#include <stdint.h>

typedef unsigned short bf16_t;
__device__ __forceinline__ float bf2f(bf16_t v) { return __uint_as_float(((unsigned)v) << 16); }
__device__ __forceinline__ bf16_t f2bf(float f) { unsigned u = __float_as_uint(f); u += 0x7FFFu + ((u >> 16) & 1u); return (bf16_t)(u >> 16); }

constexpr int Bn = 4, S = 4096, T = Bn * S, D = 1024, NIN = 4904, PP = 2880;
constexpr int QA = 0, KC = 512, VC = 640, KS = 768, VS = 896, KW = 1024, VW = 1152, GA = 1280, QB = 1304, KB = 1560, VB = 1816, AB = 2328, RB = 2344, MGA = 2856, MGB = 3880;
constexpr int NPROJ = 2856;
constexpr int MSLOT = 34816;

constexpr size_t OFF_CTRL = 0;
constexpr size_t OFF_ROUTE_E = 4096;
constexpr size_t OFF_ROUTE_W = OFF_ROUTE_E + 32768 * 4;
constexpr size_t OFF_SLOT_TOK = OFF_ROUTE_W + 32768 * 4;
constexpr size_t OFF_SLOT_W = OFF_SLOT_TOK + (size_t)MSLOT * 4;
constexpr size_t OFF_R1 = 1u << 20;
constexpr size_t SZ_PROJ = (size_t)T * PP * 2;
constexpr size_t OFF_PROJ = OFF_R1;
constexpr size_t OFF_BC = OFF_PROJ + SZ_PROJ;
constexpr size_t OFF_CSTATE = OFF_BC + (size_t)T * 256 * 4;
constexpr size_t OFF_R1_END = OFF_CSTATE + (size_t)1024 * 8192 * 4;
constexpr size_t OFF_SA = OFF_R1;
constexpr size_t OFF_SB = OFF_SA + (size_t)T * 1024 * 2;
constexpr size_t OFF_H2 = OFF_R1;
constexpr size_t OFF_HID = OFF_H2 + (size_t)T * 1024 * 2;
constexpr size_t OFF_Y0 = OFF_HID + (size_t)MSLOT * 256 * 2;
constexpr size_t OFF_Y1 = OFF_Y0 + (size_t)T * 1024 * 2;
static_assert(OFF_Y1 + (size_t)T * 1024 * 2 <= OFF_R1_END, "alias overflow");
constexpr size_t OFF_YA = OFF_R1_END;
constexpr size_t OFF_YB = OFF_YA + (size_t)T * 512 * 2;
constexpr size_t OFF_KCB = OFF_YB + (size_t)T * 512 * 2;
constexpr size_t OFF_VCB = OFF_KCB + 8 * 256 * 64 * 2;
constexpr size_t OFF_HIDC = OFF_VCB + 8 * 256 * 64 * 2;
constexpr size_t OFF_BAR = OFF_HIDC + 2 * 2048 * 128 * 4;
constexpr size_t OFF_END = OFF_BAR + 16384;
static_assert(OFF_END <= (size_t)256 << 20, "workspace overflow");


#define XB_TMO      128
#define XB_XCNT(j)  (256  + 64 * (j))
#define XB_XSUB(j)  (1280 + 64 * (j))
#define XB_XGEN(j)  (2304 + 64 * (j))
#define XB_TOP      3328
#define XB_TOPGEN   3392
#define XCD_BAR_WORDS 3456
#define XB_SPIN_CAP (1u << 18)
#define LAS __attribute__((address_space(3)))

__device__ __forceinline__ unsigned xb_ld(unsigned* p)              { return __hip_atomic_load(p, __ATOMIC_RELAXED, __HIP_MEMORY_SCOPE_AGENT); }
__device__ __forceinline__ unsigned xb_add(unsigned* p, unsigned v) { return __hip_atomic_fetch_add(p, v, __ATOMIC_RELAXED, __HIP_MEMORY_SCOPE_AGENT); }
__device__ __forceinline__ unsigned xb_xcc_id() { return (unsigned)__builtin_amdgcn_s_getreg((3 << 11) | 20) & 0xFu; }
#define XB_SPIN(cond, bar) do { unsigned _sp = 0; while (cond) { __builtin_amdgcn_s_sleep(1); \
    if ((++_sp & 255u) == 0u) { if (xb_ld(&(bar)[XB_TMO])) break; if (_sp > XB_SPIN_CAP) { atomicAdd(&(bar)[XB_TMO], 1u); break; } } } } while (0)

struct XcdBarrier { unsigned* bar; unsigned x; volatile LAS unsigned* st; };

__device__ __forceinline__ XcdBarrier xcd_barrier_post(unsigned* bar, volatile LAS unsigned* st) {
    XcdBarrier b; b.bar = bar; b.x = xb_xcc_id(); b.st = st;
    if (threadIdx.x == 0) (void)xb_add(&bar[XB_XCNT(b.x)], 1u);
    return b;
}
__device__ __forceinline__ void xcd_barrier_complete(unsigned* bar, unsigned x, unsigned& nloc, unsigned& nx) {
    const unsigned G = gridDim.x * gridDim.y * gridDim.z;
    unsigned sum, cnt, mine, sp = 0u;
    for (;;) {
        sum = 0u; cnt = 0u; mine = 0u;
#pragma unroll
        for (unsigned j = 0; j < 16; ++j) { const unsigned c = xb_ld(&bar[XB_XCNT(j)]); sum += c; cnt += (c > 0u) ? 1u : 0u; mine = (j == x) ? c : mine; }
        if (sum == G) break;
        __builtin_amdgcn_s_sleep(1);
        if ((++sp & 255u) == 0u) { if (xb_ld(&bar[XB_TMO])) break; if (sp > XB_SPIN_CAP) { atomicAdd(&bar[XB_TMO], 1u); break; } }
    }
    nloc = mine > 0u ? mine : 1u; nx = cnt > 0u ? cnt : 1u;
}
__device__ __forceinline__ void xcd_barrier(const XcdBarrier& b) {
    asm volatile("s_waitcnt vmcnt(0)" ::: "memory");
    __syncthreads();
    if (threadIdx.x == 0) {
        unsigned* bar = b.bar;
        __builtin_amdgcn_s_waitcnt(0);
        unsigned nloc = b.st[0], nx = b.st[1];
        if (nloc == 0u) { xcd_barrier_complete(bar, b.x, nloc, nx); b.st[0] = nloc; b.st[1] = nx; }
        const unsigned old = xb_add(&bar[XB_XSUB(b.x)], 1u);
        const unsigned gen = old / nloc;
        if (old + 1u == (gen + 1u) * nloc) {
            __builtin_amdgcn_fence(__ATOMIC_RELEASE, "agent");
            asm volatile("s_waitcnt vmcnt(0)" ::: "memory");
            const unsigned og = xb_add(&bar[XB_TOP], 1u);
            const unsigned tg = og / nx;
            if (og + 1u == (tg + 1u) * nx) xb_add(&bar[XB_TOPGEN], 1u);
            else XB_SPIN(xb_ld(&bar[XB_TOPGEN]) == tg, bar);
            __builtin_amdgcn_fence(__ATOMIC_ACQUIRE, "agent");
            xb_add(&bar[XB_XGEN(b.x)], 1u);
            asm volatile("s_waitcnt vmcnt(0)" ::: "memory");
        } else {
            XB_SPIN(xb_ld(&bar[XB_XGEN(b.x)]) == gen, bar);
            __builtin_amdgcn_fence(__ATOMIC_ACQUIRE, "agent");
            asm volatile("s_waitcnt vmcnt(0)" ::: "memory");
        }
    }
    __syncthreads();
}

struct Params {
    const float *x, *g_mix, *w_in, *pe_k, *ck1, *ck2, *pe_v, *cv1, *cv2, *rel_bias, *w_alpha, *b_alpha, *norm_g, *w_ba, *w_bb, *w_out, *g_ffn,
                *w_rg, *b_rg, *w_re, *b_re, *w_eg, *w_eu, *w_ed, *g_final;
    float* out; char* ws;
};

__device__ __forceinline__ float wave_max(float v) { for (int o = 32; o > 0; o >>= 1) v = fmaxf(v, __shfl_xor(v, o)); return v; }
__device__ __forceinline__ float wave_sum(float v) { for (int o = 32; o > 0; o >>= 1) v += __shfl_xor(v, o); return v; }
__device__ __forceinline__ void wave_lds_sync() { asm volatile("s_waitcnt lgkmcnt(0)" ::: "memory"); }

__device__ __forceinline__ void ph_rms_h(int row, const float* __restrict__ x, const float* __restrict__ g, bf16_t* __restrict__ h, char* smem) {
    float* red = (float*)smem;
    float4 v = ((const float4*)(x + (size_t)row * D))[threadIdx.x];
    float s = v.x * v.x + v.y * v.y + v.z * v.z + v.w * v.w;
    s = wave_sum(s);
    if ((threadIdx.x & 63) == 0) red[threadIdx.x >> 6] = s;
    __syncthreads();
    s = red[0] + red[1] + red[2] + red[3];
    __syncthreads();
    const float r = rsqrtf(s * (1.0f / D) + 1e-6f);
    float4 gg = ((const float4*)g)[threadIdx.x];
    ushort4 o; o.x = f2bf(v.x * r * gg.x); o.y = f2bf(v.y * r * gg.y); o.z = f2bf(v.z * r * gg.z); o.w = f2bf(v.w * r * gg.w);
    ((ushort4*)(h + (size_t)row * D))[threadIdx.x] = o;
}

template <class LA, class EP, int NW>
__device__ __forceinline__ void gemm_tile(int bx, int by, const LA la, const EP ep, const float* __restrict__ W0, const float* __restrict__ W1, int ldw, int M, int N, int K, char* smem) {
    float (*As)[65] = (float (*)[65])smem;
    float (*Ws)[16][64] = (float (*)[16][64])(smem + 16 * 65 * 4);
    const int tid = threadIdx.x, tx = tid & 15, ty = tid >> 4;
    const int m0 = by * 64, n0 = bx * 64;
    float acc[NW][4][4];
#pragma unroll
    for (int w = 0; w < NW; ++w)
#pragma unroll
        for (int i = 0; i < 4; ++i)
#pragma unroll
            for (int j = 0; j < 4; ++j) acc[w][i][j] = 0.f;
    for (int k0 = 0; k0 < K; k0 += 16) {
#pragma unroll
        for (int i = 0; i < 4; ++i) {
            const int e = tid + i * 256, m = e >> 4, k = e & 15;
            As[k][m] = (m0 + m < M) ? la(m0 + m, k0 + k) : 0.f;
        }
#pragma unroll
        for (int i = 0; i < 4; ++i) {
            const int e = tid + i * 256, k = e >> 6, n = e & 63;
            const bool ok = (n0 + n < N);
            Ws[0][k][n] = ok ? W0[(size_t)(k0 + k) * ldw + n0 + n] : 0.f;
            if (NW > 1) Ws[NW - 1][k][n] = ok ? W1[(size_t)(k0 + k) * ldw + n0 + n] : 0.f;
        }
        __syncthreads();
#pragma unroll
        for (int k = 0; k < 16; ++k) {
            float a[4];
#pragma unroll
            for (int i = 0; i < 4; ++i) a[i] = As[k][ty * 4 + i];
#pragma unroll
            for (int w = 0; w < NW; ++w) {
                float b[4];
#pragma unroll
                for (int j = 0; j < 4; ++j) b[j] = Ws[w][k][tx * 4 + j];
#pragma unroll
                for (int i = 0; i < 4; ++i)
#pragma unroll
                    for (int j = 0; j < 4; ++j) acc[w][i][j] += a[i] * b[j];
            }
        }
        __syncthreads();
    }
#pragma unroll
    for (int i = 0; i < 4; ++i)
#pragma unroll
        for (int j = 0; j < 4; ++j) {
            const int m = m0 + ty * 4 + i, n = n0 + tx * 4 + j;
            if (m < M && n < N) ep(m, n, acc[0][i][j], acc[NW - 1][i][j]);
        }
}
template <class LA, class EP, int NW>
__device__ __forceinline__ void ph_gemm(const LA la, const EP ep, const float* W0, const float* W1, int ldw, int M, int N, int K, char* smem) {
    const int nx = (N + 63) / 64, ny = (M + 63) / 64;
    for (int vb = blockIdx.x; vb < nx * ny; vb += gridDim.x) gemm_tile<LA, EP, NW>(vb % nx, vb / nx, la, ep, W0, W1, ldw, M, N, K, smem);
}
template <class LA, class EP, int NW>
__device__ __forceinline__ void ph_gemm_grouped(const LA la, const EP ep, const float* W0, const float* W1, int ldw, int N, int K, const int* __restrict__ cnt, size_t wstride, char* smem) {
    const int nx = (N + 63) / 64;
    int total = 0;
    for (int e = 0; e < 32; ++e) total += (cnt[e] + 63) & ~63;
    const int ny = total / 64;
    for (int vb = blockIdx.x; vb < nx * ny; vb += gridDim.x) {
        const int bx = vb % nx, by = vb / nx, m0 = by * 64;
        int e = 0, acc = 0;
        for (int i = 0; i < 32; ++i) { const int nacc = acc + ((cnt[i] + 63) & ~63); if (m0 >= acc && m0 < nacc) e = i; acc = nacc; }
        gemm_tile<LA, EP, NW>(bx, by, la, ep, W0 + (size_t)e * wstride, NW > 1 ? W1 + (size_t)e * wstride : W1, ldw, total, N, K, smem);
    }
}

struct LA_bf16 { const bf16_t* A; int lda; int pad; __device__ __forceinline__ float operator()(int m, int k) const { return bf2f(A[(size_t)m * lda + k]); } };
struct LA_sum2 { const bf16_t* A; const bf16_t* B; __device__ __forceinline__ float operator()(int m, int k) const { return bf2f(A[(size_t)m * 1024 + k]) + bf2f(B[(size_t)m * 1024 + k]); } };
struct EP_bf16 { bf16_t* C; int ldc; int pad; __device__ __forceinline__ void operator()(int m, int n, float a, float) const { C[(size_t)m * ldc + n] = f2bf(a); } };
struct LA_cmp { const bf16_t* proj; const float* pe; int col0; int pad;
    __device__ __forceinline__ float operator()(int m, int k) const { const int c = m & 255, bg = m >> 8, b = bg >> 1, g = bg & 1, i = k >> 6, d = k & 63;
        if (c >= 255) return 0.f;
        return bf2f(proj[(size_t)(b * S + 16 * c + i) * PP + col0 + g * 64 + d]) + pe[k]; } };
struct EP_gelu { float* C; int ldc; int pad; __device__ __forceinline__ void operator()(int m, int n, float a, float) const {
        const float u = 0.7978845608028654f * (a + 0.044715f * a * a * a); C[(size_t)m * ldc + n] = 0.5f * a * (1.f + tanhf(u)); } };
struct LA_f32 { const float* A; int lda; int pad; __device__ __forceinline__ float operator()(int m, int k) const { return A[(size_t)m * lda + k]; } };
struct EP_sig { bf16_t* C; __device__ __forceinline__ void operator()(int m, int n, float a, float) const { C[(size_t)m * 1024 + n] = f2bf(1.f / (1.f + __expf(-a))); } };
struct EP_mulinto { bf16_t* C; __device__ __forceinline__ void operator()(int m, int n, float a, float) const { bf16_t* p = C + (size_t)m * 1024 + n; *p = f2bf(bf2f(*p) * a); } };
struct EP_resid { const float* x; float* x2; __device__ __forceinline__ void operator()(int m, int n, float a, float) const { x2[(size_t)m * 1024 + n] = x[(size_t)m * 1024 + n] + a; } };
struct LA_moe1 { const bf16_t* h2; const int* slot_tok; __device__ __forceinline__ float operator()(int m, int k) const { const int tk = slot_tok[m]; return tk >= 0 ? bf2f(h2[(size_t)(tk >> 1) * 1024 + k]) : 0.f; } };
struct EP_moe1 { bf16_t* hid; const int* slot_tok; const float* slot_w; __device__ __forceinline__ void operator()(int m, int n, float a, float u) const {
        const int tk = slot_tok[m]; float v = 0.f; if (tk >= 0) v = a / (1.f + __expf(-a)) * u * slot_w[m]; hid[(size_t)m * 256 + n] = f2bf(v); } };
struct EP_moe2 { bf16_t* Y; const int* slot_tok; __device__ __forceinline__ void operator()(int m, int n, float a, float) const {
        const int tk = slot_tok[m]; if (tk >= 0) Y[((size_t)(tk & 1) * T + (size_t)(tk >> 1)) * 1024 + n] = f2bf(a); } };

__device__ __forceinline__ int t5_bucket(int n) {
    if (n < 16) return n;
    const int l = 16 + (int)(logf((float)n / 16.0f) / logf(8.0f) * 16.0f);
    return l < 31 ? l : 31;
}
struct AttnState { float m[4], l[4], o[4]; };

__device__ __forceinline__ void attend_block(AttnState& st, const bf16_t* __restrict__ Kp, const bf16_t* __restrict__ Vp, int key0, bool valid, int rel,
                                             const float (*q_lds)[64], const float (*tb_lds)[128], float (*p_lds)[256], int lane) {
    float s[4] = {0.f, 0.f, 0.f, 0.f};
    const bf16_t* kr = Kp + (size_t)(key0 + lane) * PP;
#pragma unroll
    for (int d8 = 0; d8 < 8; ++d8) {
        const uint4 raw = *(const uint4*)(kr + d8 * 8);
        const unsigned w[4] = {raw.x, raw.y, raw.z, raw.w};
#pragma unroll
        for (int j = 0; j < 4; ++j) {
            const float k0 = __uint_as_float(w[j] << 16), k1 = __uint_as_float(w[j] & 0xFFFF0000u);
#pragma unroll
            for (int hp = 0; hp < 4; ++hp) s[hp] += q_lds[hp][d8 * 8 + 2 * j] * k0 + q_lds[hp][d8 * 8 + 2 * j + 1] * k1;
        }
    }
    const int rc = rel < 0 ? 0 : (rel > 127 ? 127 : rel);
#pragma unroll
    for (int hp = 0; hp < 4; ++hp) {
        const float sc = valid ? s[hp] + tb_lds[hp][rc] : -3.0e38f;
        const float bm = wave_max(sc);
        const float mn = fmaxf(st.m[hp], bm);
        const float scale = __expf(st.m[hp] - mn);
        const float p = valid ? __expf(sc - mn) : 0.f;
        st.l[hp] = st.l[hp] * scale + wave_sum(p);
        st.o[hp] *= scale; st.m[hp] = mn;
        p_lds[hp][lane] = p;
    }
    wave_lds_sync();
    const bf16_t* vr = Vp + (size_t)key0 * PP + lane;
    for (int k = 0; k < 64; ++k) {
        const float v = bf2f(vr[(size_t)k * PP]);
#pragma unroll
        for (int hp = 0; hp < 4; ++hp) st.o[hp] += p_lds[hp][k] * v;
    }
    wave_lds_sync();
}

__device__ __forceinline__ void nsa_task(int idx, const bf16_t* __restrict__ proj, const bf16_t* __restrict__ kcb, const bf16_t* __restrict__ vcb,
                                         const float* __restrict__ rel_bias, bf16_t* __restrict__ ya, char* wsm, int lane) {
    float (*p_lds)[256] = (float (*)[256])wsm;
    float (*q_lds)[64] = (float (*)[64])(wsm + 4096);
    float (*tb_lds)[128] = (float (*)[128])(wsm + 4096 + 1024);
    const int t = idx & (S - 1), g = (idx >> 12) & 1, b = idx >> 13;
    const size_t row = (size_t)(b * S + t) * PP;
    wave_lds_sync();
#pragma unroll
    for (int hp = 0; hp < 4; ++hp) {
        q_lds[hp][lane] = bf2f(proj[row + QA + (g * 4 + hp) * 64 + lane]) * 0.125f;
        tb_lds[hp][lane] = rel_bias[t5_bucket(lane) * 8 + g * 4 + hp];
        tb_lds[hp][lane + 64] = rel_bias[t5_bucket(lane + 64) * 8 + g * 4 + hp];
    }
    wave_lds_sync();
    const int nvis = t >= 31 ? (((t - 31) >> 4) + 1 > 255 ? 255 : ((t - 31) >> 4) + 1) : 0;
    const bf16_t* kc = kcb + (size_t)(b * 2 + g) * 256 * 64;
    const bf16_t* vc = vcb + (size_t)(b * 2 + g) * 256 * 64;
    float oc[4] = {0.f, 0.f, 0.f, 0.f};
    {
        float sc[4][4];
#pragma unroll
        for (int i = 0; i < 4; ++i) {
            const int c = lane + 64 * i;
            float s[4] = {0.f, 0.f, 0.f, 0.f};
            const bf16_t* kr = kc + (size_t)c * 64;
#pragma unroll
            for (int d8 = 0; d8 < 8; ++d8) {
                const uint4 raw = *(const uint4*)(kr + d8 * 8);
                const unsigned w[4] = {raw.x, raw.y, raw.z, raw.w};
#pragma unroll
                for (int j = 0; j < 4; ++j) {
                    const float k0 = __uint_as_float(w[j] << 16), k1 = __uint_as_float(w[j] & 0xFFFF0000u);
#pragma unroll
                    for (int hp = 0; hp < 4; ++hp) s[hp] += q_lds[hp][d8 * 8 + 2 * j] * k0 + q_lds[hp][d8 * 8 + 2 * j + 1] * k1;
                }
            }
            const int rel = t - (16 * c + 31);
            const int rc = rel < 0 ? 0 : (rel > 127 ? 127 : rel);
#pragma unroll
            for (int hp = 0; hp < 4; ++hp) sc[hp][i] = (c < nvis) ? s[hp] + tb_lds[hp][rc] : -3.0e38f;
        }
#pragma unroll
        for (int hp = 0; hp < 4; ++hp) {
            float m = fmaxf(fmaxf(sc[hp][0], sc[hp][1]), fmaxf(sc[hp][2], sc[hp][3]));
            m = wave_max(m);
            float e[4], sum = 0.f;
#pragma unroll
            for (int i = 0; i < 4; ++i) { e[i] = (lane + 64 * i < nvis) ? __expf(sc[hp][i] - m) : 0.f; sum += e[i]; }
            sum = wave_sum(sum);
            const float inv = nvis > 0 ? 1.f / sum : 0.f;
#pragma unroll
            for (int i = 0; i < 4; ++i) p_lds[hp][lane + 64 * i] = e[i] * inv;
        }
        wave_lds_sync();
        for (int c = 0; c < nvis; ++c) {
            const float v = bf2f(vc[(size_t)c * 64 + lane]);
#pragma unroll
            for (int hp = 0; hp < 4; ++hp) oc[hp] += p_lds[hp][c] * v;
        }
    }
    const int tb = t >> 6;
    unsigned long long selmask;
    {
        float imp = 0.f;
        const int c0 = 4 * lane - 1 < 0 ? 0 : 4 * lane - 1, c1 = 4 * lane + 3 > 254 ? 254 : 4 * lane + 3;
        for (int c = c0; c <= c1; ++c)
#pragma unroll
            for (int hp = 0; hp < 4; ++hp) imp += p_lds[hp][c];
        const bool forced = (lane == 0) || (lane == tb) || (lane == tb - 1);
        const float val = forced ? 1e30f : (lane > tb ? -1e30f : imp);
        int rank = 0;
        for (int j = 0; j < 64; ++j) {
            const float o = __shfl(val, j);
            rank += (o > val || (o == val && j < lane)) ? 1 : 0;
        }
        selmask = __ballot(rank < 16);
    }
    wave_lds_sync();
    AttnState ss;
#pragma unroll
    for (int hp = 0; hp < 4; ++hp) { ss.m[hp] = -1e30f; ss.l[hp] = 0.f; ss.o[hp] = 0.f; }
    const bf16_t* pb = proj + (size_t)b * S * PP;
    for (int j = 0; j <= tb; ++j) {
        if (!((selmask >> j) & 1ull)) continue;
        const int rel = t - (64 * j + lane);
        attend_block(ss, pb + KS + g * 64, pb + VS + g * 64, 64 * j, rel >= 0, rel, q_lds, tb_lds, p_lds, lane);
    }
    AttnState sw;
#pragma unroll
    for (int hp = 0; hp < 4; ++hp) { sw.m[hp] = -1e30f; sw.l[hp] = 0.f; sw.o[hp] = 0.f; }
    const int kb0 = (t - 511 < 0 ? 0 : t - 511) >> 6;
    for (int j = kb0; j <= tb; ++j) {
        const int rel = t - (64 * j + lane);
        attend_block(sw, pb + KW + g * 64, pb + VW + g * 64, 64 * j, rel >= 0 && rel < 512, rel, q_lds, tb_lds, p_lds, lane);
    }
#pragma unroll
    for (int hp = 0; hp < 4; ++hp) {
        const int head = g * 4 + hp;
        const float g0 = 1.f / (1.f + __expf(-bf2f(proj[row + GA + head])));
        const float g1 = 1.f / (1.f + __expf(-bf2f(proj[row + GA + 8 + head])));
        const float g2 = 1.f / (1.f + __expf(-bf2f(proj[row + GA + 16 + head])));
        const float o = g0 * oc[hp] + g1 * ss.o[hp] / ss.l[hp] + g2 * sw.o[hp] / sw.l[hp];
        ya[(size_t)(b * S + t) * 512 + head * 64 + lane] = f2bf(o);
    }
}

__device__ __forceinline__ void gla_prep_task(int vb, const bf16_t* __restrict__ proj, const float* __restrict__ w_alpha, const float* __restrict__ b_alpha, float* __restrict__ bc, int lane) {
    const int n = vb & 63, h = (vb >> 6) & 3, b = vb >> 8;
    const int col = h * 64 + lane;
    float w[16];
#pragma unroll
    for (int r = 0; r < 16; ++r) w[r] = w_alpha[r * 256 + col];
    const float bias = b_alpha[col];
    float cum = 0.f;
    for (int c = 0; c < 64; ++c) {
        const size_t row = (size_t)(b * S + n * 64 + c);
        float z = bias;
#pragma unroll
        for (int r = 0; r < 16; ++r) z += bf2f(proj[row * PP + AB + r]) * w[r];
        const float ls = fminf(z, 0.f) - log1pf(__expf(-fabsf(z)));
        cum += ls * (1.0f / 16.0f);
        bc[row * 256 + col] = cum;
    }
}

__device__ __forceinline__ void gla_state_vb(int vb, const bf16_t* __restrict__ proj, const float* __restrict__ bc, float* __restrict__ cstate, char* smem) {
    float (*kd)[64] = (float (*)[64])smem;
    float (*vs)[128] = (float (*)[128])(smem + 16384);
    const int tid = threadIdx.x, n = vb & 63, h = (vb >> 6) & 3, b = vb >> 8;
    const size_t row0 = (size_t)(b * S + n * 64);
    for (int e = tid; e < 4096; e += 256) {
        const int c = e >> 6, d = e & 63;
        kd[c][d] = bf2f(proj[(row0 + c) * PP + KB + h * 64 + d]) * __expf(bc[(row0 + 63) * 256 + h * 64 + d] - bc[(row0 + c) * 256 + h * 64 + d]);
    }
    for (int e = tid; e < 8192; e += 256) {
        const int c = e >> 7, v = e & 127;
        vs[c][v] = bf2f(proj[(row0 + c) * PP + VB + h * 128 + v]);
    }
    __syncthreads();
    const int v = tid & 127, dg = tid >> 7;
    float acc[32];
#pragma unroll
    for (int i = 0; i < 32; ++i) acc[i] = 0.f;
    for (int c = 0; c < 64; ++c) {
        const float vv = vs[c][v];
#pragma unroll
        for (int i = 0; i < 32; ++i) acc[i] += kd[c][dg * 32 + i] * vv;
    }
    float* out = cstate + (size_t)vb * 8192;
#pragma unroll
    for (int i = 0; i < 32; ++i) out[(dg * 32 + i) * 128 + v] = acc[i];
    __syncthreads();
}

__device__ __forceinline__ void gla_scan_vb(int vb, const float* __restrict__ bc, float* __restrict__ cstate) {
    const int idx = vb * 256 + threadIdx.x;
    const int e = idx & 8191, bh = idx >> 13, b = bh >> 2, h = bh & 3, d = e >> 7;
    float state = 0.f;
    for (int n = 0; n < 64; ++n) {
        float* p = cstate + ((size_t)(bh * 64 + n)) * 8192 + e;
        const float upd = *p;
        *p = state;
        const float dec = __expf(bc[((size_t)(b * S + n * 64 + 63)) * 256 + h * 64 + d]);
        state = dec * state + upd;
    }
}

__device__ __forceinline__ void gla_out_vb(int vb, const bf16_t* __restrict__ proj, const float* __restrict__ bc, const float* __restrict__ prev,
                                           const float* __restrict__ norm_g, bf16_t* __restrict__ yb, char* smem) {
    float (*qi)[65] = (float (*)[65])smem;
    float (*ki)[65] = (float (*)[65])(smem + 64 * 65 * 4);
    float (*at)[65] = (float (*)[65])(smem + 2 * 64 * 65 * 4);
    const int tid = threadIdx.x, n = vb & 63, h = (vb >> 6) & 3, b = vb >> 8;
    const size_t row0 = (size_t)(b * S + n * 64);
    for (int e = tid; e < 4096; e += 256) {
        const int c = e >> 6, d = e & 63;
        const float bcv = bc[(row0 + c) * 256 + h * 64 + d];
        qi[c][d] = bf2f(proj[(row0 + c) * PP + QB + h * 64 + d]) * 0.125f * __expf(bcv);
        ki[c][d] = bf2f(proj[(row0 + c) * PP + KB + h * 64 + d]) * __expf(-bcv);
    }
    __syncthreads();
    for (int e = tid; e < 4096; e += 256) {
        const int c = e >> 6, j = e & 63;
        float a = 0.f;
        if (j <= c) for (int d = 0; d < 64; ++d) a += qi[c][d] * ki[j][d];
        at[c][j] = a;
    }
    __syncthreads();
    const int c = tid >> 2, vg = tid & 3;
    float acc[32];
#pragma unroll
    for (int i = 0; i < 32; ++i) acc[i] = 0.f;
    for (int j = 0; j <= c; ++j) {
        const float a = at[c][j];
        const bf16_t* vr = proj + (row0 + j) * PP + VB + h * 128 + vg * 32;
#pragma unroll
        for (int i = 0; i < 32; ++i) acc[i] += a * bf2f(vr[i]);
    }
    const float* pv = prev + (size_t)vb * 8192 + vg * 32;
    for (int d = 0; d < 64; ++d) {
        const float qv = qi[c][d];
#pragma unroll
        for (int i = 0; i < 32; ++i) acc[i] += qv * pv[d * 128 + i];
    }
    float ss = 0.f;
#pragma unroll
    for (int i = 0; i < 32; ++i) ss += acc[i] * acc[i];
    ss += __shfl_xor(ss, 1); ss += __shfl_xor(ss, 2);
    const float r = rsqrtf(ss * (1.0f / 128.0f) + 1e-6f);
    const size_t row = row0 + c;
#pragma unroll
    for (int i = 0; i < 32; ++i) {
        const int col = h * 128 + vg * 32 + i;
        const float rv = bf2f(proj[row * PP + RB + col]);
        yb[row * 512 + col] = f2bf(acc[i] * r * norm_g[col] * (rv / (1.f + __expf(-rv))));
    }
    __syncthreads();
}

__device__ __forceinline__ void router_vb(int row, const float* __restrict__ x2, const float* __restrict__ g, const float* __restrict__ w_rg, const float* __restrict__ b_rg,
                                          const float* __restrict__ w_re, const float* __restrict__ b_re, bf16_t* __restrict__ h2,
                                          int* __restrict__ route_e, float* __restrict__ route_w, int* __restrict__ cnt, char* smem) {
    float* red = (float*)smem;
    float (*part)[36] = (float (*)[36])(smem + 64);
    const int tid = threadIdx.x;
    float4 v = ((const float4*)(x2 + (size_t)row * D))[tid];
    float s = v.x * v.x + v.y * v.y + v.z * v.z + v.w * v.w;
    s = wave_sum(s);
    if ((tid & 63) == 0) red[tid >> 6] = s;
    __syncthreads();
    s = red[0] + red[1] + red[2] + red[3];
    const float r = rsqrtf(s * (1.0f / D) + 1e-6f);
    float4 gg = ((const float4*)g)[tid];
    float hn[4] = {v.x * r * gg.x, v.y * r * gg.y, v.z * r * gg.z, v.w * r * gg.w};
    ushort4 o; o.x = f2bf(hn[0]); o.y = f2bf(hn[1]); o.z = f2bf(hn[2]); o.w = f2bf(hn[3]);
    ((ushort4*)(h2 + (size_t)row * D))[tid] = o;
    float pl[36];
#pragma unroll
    for (int j = 0; j < 36; ++j) pl[j] = 0.f;
#pragma unroll
    for (int i = 0; i < 4; ++i) {
        const int k = tid * 4 + i;
#pragma unroll
        for (int j = 0; j < 4; ++j) pl[j] += hn[i] * w_rg[k * 4 + j];
#pragma unroll
        for (int j = 0; j < 32; ++j) pl[4 + j] += hn[i] * w_re[k * 32 + j];
    }
#pragma unroll
    for (int j = 0; j < 36; ++j) { const float t = wave_sum(pl[j]); if ((tid & 63) == 0) part[tid >> 6][j] = t; }
    __syncthreads();
    if (tid == 0) {
        float lg[4];
#pragma unroll
        for (int j = 0; j < 4; ++j) lg[j] = part[0][j] + part[1][j] + part[2][j] + part[3][j] + b_rg[j];
        int gs = 0; float mx = lg[0];
#pragma unroll
        for (int j = 1; j < 4; ++j) if (lg[j] > mx) { mx = lg[j]; gs = j; }
        float den = 0.f;
#pragma unroll
        for (int j = 0; j < 4; ++j) den += __expf(lg[j] - mx);
        const float gp = 1.f / den;
        float v0 = -3e38f, v1 = -3e38f; int i0 = 0, i1 = 0;
        for (int j = 0; j < 8; ++j) {
            const int c = 4 + gs * 8 + j;
            const float l = part[0][c] + part[1][c] + part[2][c] + part[3][c] + b_re[gs * 8 + j];
            if (l > v0) { v1 = v0; i1 = i0; v0 = l; i0 = j; }
            else if (l > v1) { v1 = l; i1 = j; }
        }
        const float e1 = __expf(v1 - v0);
        const float w0 = gp / (1.f + e1), w1 = gp * e1 / (1.f + e1);
        const int ea = gs * 8 + i0, eb = gs * 8 + i1;
        route_e[row * 2] = ea; route_e[row * 2 + 1] = eb;
        route_w[row * 2] = w0; route_w[row * 2 + 1] = w1;
        atomicAdd(&cnt[ea], 1); atomicAdd(&cnt[eb], 1);
    }
    __syncthreads();
}

__device__ __forceinline__ void final_vb(int row, float* __restrict__ x2out, const bf16_t* __restrict__ Y0, const bf16_t* __restrict__ Y1, const float* __restrict__ g, char* smem) {
    float* red = (float*)smem;
    const int tid = threadIdx.x;
    float4 v = ((const float4*)(x2out + (size_t)row * D))[tid];
    const ushort4 a = ((const ushort4*)(Y0 + (size_t)row * D))[tid], c = ((const ushort4*)(Y1 + (size_t)row * D))[tid];
    v.x += bf2f(a.x) + bf2f(c.x); v.y += bf2f(a.y) + bf2f(c.y); v.z += bf2f(a.z) + bf2f(c.z); v.w += bf2f(a.w) + bf2f(c.w);
    float s = v.x * v.x + v.y * v.y + v.z * v.z + v.w * v.w;
    s = wave_sum(s);
    if ((tid & 63) == 0) red[tid >> 6] = s;
    __syncthreads();
    s = red[0] + red[1] + red[2] + red[3];
    __syncthreads();
    const float r = rsqrtf(s * (1.0f / D) + 1e-6f);
    float4 gg = ((const float4*)g)[tid];
    ((float4*)(x2out + (size_t)row * D))[tid] = make_float4(v.x * r * gg.x, v.y * r * gg.y, v.z * r * gg.z, v.w * r * gg.w);
}

constexpr int SMEM_BYTES = 51200;

__global__ void __launch_bounds__(256, 1) k_fwd(Params p) {
    __shared__ __attribute__((aligned(16))) char smem[SMEM_BYTES];
    __shared__ uint4 xb_words;
    if (threadIdx.x == 0) xb_words = make_uint4(0u, 0u, 0u, 0u);
    __syncthreads();
    char* ws = p.ws;
    XcdBarrier bar = xcd_barrier_post((unsigned*)(ws + OFF_BAR), (volatile LAS unsigned*)&xb_words);
    int* ctrl = (int*)(ws + OFF_CTRL);
    int* route_e = (int*)(ws + OFF_ROUTE_E);
    float* route_w = (float*)(ws + OFF_ROUTE_W);
    int* slot_tok = (int*)(ws + OFF_SLOT_TOK);
    float* slot_w = (float*)(ws + OFF_SLOT_W);
    bf16_t* proj = (bf16_t*)(ws + OFF_PROJ);
    float* bc = (float*)(ws + OFF_BC);
    float* cstate = (float*)(ws + OFF_CSTATE);
    bf16_t* SA = (bf16_t*)(ws + OFF_SA);
    bf16_t* SB = (bf16_t*)(ws + OFF_SB);
    bf16_t* h2 = (bf16_t*)(ws + OFF_H2);
    bf16_t* hid = (bf16_t*)(ws + OFF_HID);
    bf16_t* Y0 = (bf16_t*)(ws + OFF_Y0);
    bf16_t* Y1 = (bf16_t*)(ws + OFF_Y1);
    bf16_t* ya = (bf16_t*)(ws + OFF_YA);
    bf16_t* yb = (bf16_t*)(ws + OFF_YB);
    bf16_t* kcb = (bf16_t*)(ws + OFF_KCB);
    bf16_t* vcb = (bf16_t*)(ws + OFF_VCB);
    float* hidc = (float*)(ws + OFF_HIDC);
    bf16_t* h = (bf16_t*)p.out;
    const int wid = threadIdx.x >> 6, lane = threadIdx.x & 63;
    const int G = gridDim.x;

    for (int vb = blockIdx.x; vb < T; vb += G) ph_rms_h(vb, p.x, p.g_mix, h, smem);
    xcd_barrier(bar);
    ph_gemm<LA_bf16, EP_bf16, 1>(LA_bf16{h, D, 0}, EP_bf16{proj, PP, 0}, p.w_in, nullptr, NIN, T, NPROJ, D, smem);
    xcd_barrier(bar);
    ph_gemm<LA_cmp, EP_gelu, 1>(LA_cmp{proj, p.pe_k, KC, 0}, EP_gelu{hidc, 128, 0}, p.ck1, nullptr, 128, 2048, 128, 2048, smem);
    ph_gemm<LA_cmp, EP_gelu, 1>(LA_cmp{proj, p.pe_v, VC, 0}, EP_gelu{hidc + 2048 * 128, 128, 0}, p.cv1, nullptr, 128, 2048, 128, 2048, smem);
    for (int task = blockIdx.x * 4 + wid; task < 1024; task += G * 4) gla_prep_task(task, proj, p.w_alpha, p.b_alpha, bc, lane);
    xcd_barrier(bar);
    ph_gemm<LA_f32, EP_bf16, 1>(LA_f32{hidc, 128, 0}, EP_bf16{kcb, 64, 0}, p.ck2, nullptr, 64, 2048, 64, 128, smem);
    ph_gemm<LA_f32, EP_bf16, 1>(LA_f32{hidc + 2048 * 128, 128, 0}, EP_bf16{vcb, 64, 0}, p.cv2, nullptr, 64, 2048, 64, 128, smem);
    for (int vb = blockIdx.x; vb < 1024; vb += G) gla_state_vb(vb, proj, bc, cstate, smem);
    xcd_barrier(bar);
    for (int vb = blockIdx.x; vb < 512; vb += G) gla_scan_vb(vb, bc, cstate);
    for (int task = blockIdx.x * 4 + wid; task < Bn * 2 * S; task += G * 4) nsa_task(task, proj, kcb, vcb, p.rel_bias, ya, smem + wid * 8192, lane);
    xcd_barrier(bar);
    for (int vb = blockIdx.x; vb < 1024; vb += G) gla_out_vb(vb, proj, bc, cstate, p.norm_g, yb, smem);
    xcd_barrier(bar);
    ph_gemm<LA_bf16, EP_sig, 1>(LA_bf16{h, D, 0}, EP_sig{SA}, p.w_in + MGA, nullptr, NIN, T, 1024, D, smem);
    ph_gemm<LA_bf16, EP_sig, 1>(LA_bf16{h, D, 0}, EP_sig{SB}, p.w_in + MGB, nullptr, NIN, T, 1024, D, smem);
    xcd_barrier(bar);
    ph_gemm<LA_bf16, EP_mulinto, 1>(LA_bf16{ya, 512, 0}, EP_mulinto{SA}, p.w_ba, nullptr, 1024, T, 1024, 512, smem);
    ph_gemm<LA_bf16, EP_mulinto, 1>(LA_bf16{yb, 512, 0}, EP_mulinto{SB}, p.w_bb, nullptr, 1024, T, 1024, 512, smem);
    xcd_barrier(bar);
    ph_gemm<LA_sum2, EP_resid, 1>(LA_sum2{SA, SB}, EP_resid{p.x, p.out}, p.w_out, nullptr, 1024, T, 1024, 1024, smem);
    xcd_barrier(bar);
    for (int vb = blockIdx.x; vb < T; vb += G) router_vb(vb, p.out, p.g_ffn, p.w_rg, p.b_rg, p.w_re, p.b_re, h2, route_e, route_w, ctrl, smem);
    xcd_barrier(bar);
    for (int i = blockIdx.x * 256 + threadIdx.x; i < 2 * T; i += G * 256) {
        const int e = route_e[i];
        int off = 0;
        for (int j = 0; j < e; ++j) off += (ctrl[j] + 63) & ~63;
        const int pos = atomicAdd(&ctrl[32 + e], 1);
        slot_tok[off + pos] = i; slot_w[off + pos] = route_w[i];
    }
    xcd_barrier(bar);
    ph_gemm_grouped<LA_moe1, EP_moe1, 2>(LA_moe1{h2, slot_tok}, EP_moe1{hid, slot_tok, slot_w}, p.w_eg, p.w_eu, 256, 256, 1024, ctrl, (size_t)1024 * 256, smem);
    xcd_barrier(bar);
    ph_gemm_grouped<LA_bf16, EP_moe2, 1>(LA_bf16{hid, 256, 0}, EP_moe2{Y0, slot_tok}, p.w_ed, nullptr, 1024, 1024, 256, ctrl, (size_t)256 * 1024, smem);
    xcd_barrier(bar);
    for (int vb = blockIdx.x; vb < T; vb += G) final_vb(vb, p.out, Y0, Y1, p.g_final, smem);
}

extern "C" void kernel_launch(void* const* d_in, const int* in_sizes, int n_in, void* d_out, int out_size, void* d_ws, size_t ws_size, hipStream_t stream) {
    static int grid = 0;
    if (!grid) {
        int dev = 0, cus = 0, per_cu = 0;
        (void)hipGetDevice(&dev);
        (void)hipDeviceGetAttribute(&cus, hipDeviceAttributeMultiprocessorCount, dev);
        (void)hipOccupancyMaxActiveBlocksPerMultiprocessor(&per_cu, k_fwd, 256, 0);
        if (per_cu > 1) per_cu = 1;
        if (per_cu < 1) per_cu = 1;
        grid = cus * per_cu;
    }
    char* ws = (char*)d_ws;
    (void)hipMemsetAsync(ws + OFF_CTRL, 0, 4096, stream);
    (void)hipMemsetAsync(ws + OFF_SLOT_TOK, 0xFF, (size_t)MSLOT * 4, stream);
    (void)hipMemsetAsync(ws + OFF_BAR, 0, 16384, stream);
    Params p{};
    const float** pf = (const float**)&p;
    for (int i = 0; i < 25; ++i) pf[i] = (const float*)d_in[i];
    p.out = (float*)d_out; p.ws = ws;
    k_fwd<<<grid, 256, 0, stream>>>(p);
}
```

```cpp
#include <hip/hip_runtime.h>
#include <stdint.h>

typedef unsigned short bf16_t;
typedef short bf16x8 __attribute__((ext_vector_type(8)));
typedef float f32x4 __attribute__((ext_vector_type(4)));
typedef unsigned u32x4 __attribute__((ext_vector_type(4)));
__device__ __forceinline__ float bf2f(bf16_t v) { return __uint_as_float(((unsigned)v) << 16); }
__device__ __forceinline__ bf16_t f2bf(float f) { unsigned u = __float_as_uint(f); u += 0x7FFFu + ((u >> 16) & 1u); return (bf16_t)(u >> 16); }
__device__ __forceinline__ unsigned pack_bf16(float lo, float hi) { unsigned r; asm volatile("v_cvt_pk_bf16_f32 %0, %1, %2" : "=v"(r) : "v"(lo), "v"(hi)); return r; }

constexpr int Bn = 4, S = 4096, T = Bn * S, D = 1024, NIN = 4904, PP = 2880;
constexpr int QA = 0, KC = 512, VC = 640, KS = 768, VS = 896, KW = 1024, VW = 1152, GA = 1280, QB = 1304, KB = 1560, VB = 1816, AB = 2328, RB = 2344, MGA = 2856, MGB = 3880;
constexpr int NPROJ = 2856;
constexpr int MSLOT = 36864;

constexpr size_t OFF_CTRL = 0;
constexpr size_t OFF_ROUTE_E = 4096;
constexpr size_t OFF_ROUTE_W = OFF_ROUTE_E + 32768 * 4;
constexpr size_t OFF_SLOT_TOK = OFF_ROUTE_W + 32768 * 4;
constexpr size_t OFF_SLOT_W = OFF_SLOT_TOK + (size_t)MSLOT * 4;
constexpr size_t OFF_BAR = OFF_SLOT_W + (size_t)MSLOT * 4;
constexpr size_t OFF_BIAS1 = OFF_BAR + 16384;
static_assert(OFF_BIAS1 + 1024 <= (1u << 20), "ctrl overflow");
constexpr size_t OFF_R1 = 1u << 20;
constexpr size_t SZ_PROJ = (size_t)T * PP * 2;
constexpr size_t OFF_PROJ = OFF_R1;
constexpr size_t OFF_BC = OFF_PROJ + SZ_PROJ;
constexpr size_t OFF_CSTATE = OFF_BC + (size_t)T * 256 * 4;
constexpr size_t OFF_R1_END = OFF_CSTATE + (size_t)1024 * 8192 * 4;
constexpr size_t OFF_SAB = OFF_R1;
constexpr size_t OFF_MRG = OFF_SAB + (size_t)T * 2048 * 2;
constexpr size_t OFF_H2 = OFF_R1;
constexpr size_t OFF_HID = OFF_H2 + (size_t)T * 1024 * 2;
constexpr size_t OFF_Y0 = OFF_HID + (size_t)MSLOT * 256 * 2;
constexpr size_t OFF_Y1 = OFF_Y0 + (size_t)T * 1024 * 2;
static_assert(OFF_MRG + (size_t)T * 1024 * 2 <= OFF_R1_END, "alias overflow");
static_assert(OFF_Y1 + (size_t)T * 1024 * 2 <= OFF_R1_END, "alias overflow");
constexpr size_t OFF_YA = OFF_R1_END;
constexpr size_t OFF_YB = OFF_YA + (size_t)T * 512 * 2;
constexpr size_t OFF_KCB = OFF_YB + (size_t)T * 512 * 2;
constexpr size_t OFF_VCB = OFF_KCB + 8 * 256 * 64 * 2;
constexpr size_t OFF_VCBT = OFF_VCB + 8 * 256 * 64 * 2;
constexpr size_t OFF_HIDC = OFF_VCBT + 8 * 256 * 64 * 2;
constexpr size_t OFF_VST = OFF_HIDC + 2 * 2048 * 128 * 2;
constexpr size_t OFF_VWT = OFF_VST + (size_t)8 * 64 * S * 2;
constexpr size_t OFF_WINT = OFF_VWT + (size_t)8 * 64 * S * 2;
constexpr size_t OFF_CK1T = OFF_WINT + (size_t)NIN * 1024 * 2;
constexpr size_t OFF_CV1T = OFF_CK1T + 128 * 2048 * 2;
constexpr size_t OFF_CK2T = OFF_CV1T + 128 * 2048 * 2;
constexpr size_t OFF_CV2T = OFF_CK2T + 128 * 128 * 2;
constexpr size_t OFF_WAT = OFF_CV2T + 128 * 128 * 2;
constexpr size_t OFF_WBT = OFF_WAT + 1024 * 512 * 2;
constexpr size_t OFF_WOT = OFF_WBT + 1024 * 512 * 2;
constexpr size_t OFF_WGT = OFF_WOT + 1024 * 1024 * 2;
constexpr size_t OFF_WUT = OFF_WGT + (size_t)32 * 256 * 1024 * 2;
constexpr size_t OFF_WDT = OFF_WUT + (size_t)32 * 256 * 1024 * 2;
constexpr size_t OFF_END = OFF_WDT + (size_t)32 * 1024 * 256 * 2;
static_assert(OFF_END <= (size_t)256 << 20, "workspace overflow");

#define XB_TMO      128
#define XB_XCNT(j)  (256  + 64 * (j))
#define XB_XSUB(j)  (1280 + 64 * (j))
#define XB_XGEN(j)  (2304 + 64 * (j))
#define XB_TOP      3328
#define XB_TOPGEN   3392
#define XCD_BAR_WORDS 3456
#define XB_SPIN_CAP (1u << 18)
#define LAS __attribute__((address_space(3)))

__device__ __forceinline__ unsigned xb_ld(unsigned* p)              { return __hip_atomic_load(p, __ATOMIC_RELAXED, __HIP_MEMORY_SCOPE_AGENT); }
__device__ __forceinline__ unsigned xb_add(unsigned* p, unsigned v) { return __hip_atomic_fetch_add(p, v, __ATOMIC_RELAXED, __HIP_MEMORY_SCOPE_AGENT); }
__device__ __forceinline__ unsigned xb_xcc_id() { return (unsigned)__builtin_amdgcn_s_getreg((3 << 11) | 20) & 0xFu; }
#define XB_SPIN(cond, bar) do { unsigned _sp = 0; while (cond) { __builtin_amdgcn_s_sleep(1); \
    if ((++_sp & 255u) == 0u) { if (xb_ld(&(bar)[XB_TMO])) break; if (_sp > XB_SPIN_CAP) { atomicAdd(&(bar)[XB_TMO], 1u); break; } } } } while (0)

struct XcdBarrier { unsigned* bar; unsigned x; volatile LAS unsigned* st; };

__device__ __forceinline__ XcdBarrier xcd_barrier_post(unsigned* bar, volatile LAS unsigned* st) {
    XcdBarrier b; b.bar = bar; b.x = xb_xcc_id(); b.st = st;
    if (threadIdx.x == 0) (void)xb_add(&bar[XB_XCNT(b.x)], 1u);
    return b;
}
__device__ __forceinline__ void xcd_barrier_complete(unsigned* bar, unsigned x, unsigned& nloc, unsigned& nx) {
    const unsigned G = gridDim.x * gridDim.y * gridDim.z;
    unsigned sum, cnt, mine, sp = 0u;
    for (;;) {
        sum = 0u; cnt = 0u; mine = 0u;
#pragma unroll
        for (unsigned j = 0; j < 16; ++j) { const unsigned c = xb_ld(&bar[XB_XCNT(j)]); sum += c; cnt += (c > 0u) ? 1u : 0u; mine = (j == x) ? c : mine; }
        if (sum == G) break;
        __builtin_amdgcn_s_sleep(1);
        if ((++sp & 255u) == 0u) { if (xb_ld(&bar[XB_TMO])) break; if (sp > XB_SPIN_CAP) { atomicAdd(&bar[XB_TMO], 1u); break; } }
    }
    nloc = mine > 0u ? mine : 1u; nx = cnt > 0u ? cnt : 1u;
}
__device__ __forceinline__ void xcd_barrier(const XcdBarrier& b) {
    asm volatile("s_waitcnt vmcnt(0)" ::: "memory");
    __syncthreads();
    if (threadIdx.x == 0) {
        unsigned* bar = b.bar;
        __builtin_amdgcn_s_waitcnt(0);
        unsigned nloc = b.st[0], nx = b.st[1];
        if (nloc == 0u) { xcd_barrier_complete(bar, b.x, nloc, nx); b.st[0] = nloc; b.st[1] = nx; }
        const unsigned old = xb_add(&bar[XB_XSUB(b.x)], 1u);
        const unsigned gen = old / nloc;
        if (old + 1u == (gen + 1u) * nloc) {
            __builtin_amdgcn_fence(__ATOMIC_RELEASE, "agent");
            asm volatile("s_waitcnt vmcnt(0)" ::: "memory");
            const unsigned og = xb_add(&bar[XB_TOP], 1u);
            const unsigned tg = og / nx;
            if (og + 1u == (tg + 1u) * nx) xb_add(&bar[XB_TOPGEN], 1u);
            else XB_SPIN(xb_ld(&bar[XB_TOPGEN]) == tg, bar);
            __builtin_amdgcn_fence(__ATOMIC_ACQUIRE, "agent");
            xb_add(&bar[XB_XGEN(b.x)], 1u);
            asm volatile("s_waitcnt vmcnt(0)" ::: "memory");
        } else {
            XB_SPIN(xb_ld(&bar[XB_XGEN(b.x)]) == gen, bar);
            __builtin_amdgcn_fence(__ATOMIC_ACQUIRE, "agent");
            asm volatile("s_waitcnt vmcnt(0)" ::: "memory");
        }
    }
    __syncthreads();
}


struct Params {
    const float *x, *g_mix, *w_in, *pe_k, *ck1, *ck2, *pe_v, *cv1, *cv2, *rel_bias, *w_alpha, *b_alpha, *norm_g, *w_ba, *w_bb, *w_out, *g_ffn,
                *w_rg, *b_rg, *w_re, *b_re, *w_eg, *w_eu, *w_ed, *g_final;
    float* out; char* ws;
};

__device__ __forceinline__ float wave_max(float v) { for (int o = 32; o > 0; o >>= 1) v = fmaxf(v, __shfl_xor(v, o)); return v; }
__device__ __forceinline__ float wave_sum(float v) { for (int o = 32; o > 0; o >>= 1) v += __shfl_xor(v, o); return v; }
__device__ __forceinline__ void wave_lds_sync() { asm volatile("s_waitcnt lgkmcnt(0)" ::: "memory"); }

__device__ __forceinline__ void ph_rms_h(int row, const float* __restrict__ x, const float* __restrict__ g, bf16_t* __restrict__ h, char* smem) {
    float* red = (float*)smem;
    float4 v = ((const float4*)(x + (size_t)row * D))[threadIdx.x];
    float s = v.x * v.x + v.y * v.y + v.z * v.z + v.w * v.w;
    s = wave_sum(s);
    if ((threadIdx.x & 63) == 0) red[threadIdx.x >> 6] = s;
    __syncthreads();
    s = red[0] + red[1] + red[2] + red[3];
    __syncthreads();
    const float r = rsqrtf(s * (1.0f / D) + 1e-6f);
    float4 gg = ((const float4*)g)[threadIdx.x];
    uint2 o; o.x = pack_bf16(v.x * r * gg.x, v.y * r * gg.y); o.y = pack_bf16(v.z * r * gg.z, v.w * r * gg.w);
    ((uint2*)(h + (size_t)row * D))[threadIdx.x] = o;
}

__device__ __forceinline__ void transpose_tile(const float* __restrict__ src, int ld_src, int N, bf16_t* __restrict__ dst, int ld_dst, int kt, int nt, char* smem) {
    float (*tl)[65] = (float (*)[65])smem;
    const int tid = threadIdx.x;
    const int c4 = (tid & 15) * 4, r0 = tid >> 4;
#pragma unroll
    for (int i = 0; i < 4; ++i) {
        const int k = r0 + 16 * i, n = nt * 64 + c4;
        float4 v = make_float4(0.f, 0.f, 0.f, 0.f);
        if (n < N) v = *(const float4*)(src + (size_t)(kt * 64 + k) * ld_src + n);
        tl[k][c4] = v.x; tl[k][c4 + 1] = v.y; tl[k][c4 + 2] = v.z; tl[k][c4 + 3] = v.w;
    }
    __syncthreads();
    const int kc = (tid & 7) * 8, n0 = tid >> 3;
#pragma unroll
    for (int i = 0; i < 2; ++i) {
        const int nl = n0 + 32 * i, n = nt * 64 + nl;
        if (n < N) {
            uint4 o;
            o.x = pack_bf16(tl[kc][nl], tl[kc + 1][nl]); o.y = pack_bf16(tl[kc + 2][nl], tl[kc + 3][nl]);
            o.z = pack_bf16(tl[kc + 4][nl], tl[kc + 5][nl]); o.w = pack_bf16(tl[kc + 6][nl], tl[kc + 7][nl]);
            *(uint4*)(dst + (size_t)n * ld_dst + kt * 64 + kc) = o;
        }
    }
    __syncthreads();
}

__device__ __forceinline__ void ph_prep(const Params& p, char* smem) {
    char* ws = p.ws;
    constexpr int N0 = 16 * 77, N1 = N0 + 64, N2 = N1 + 64, N3 = N2 + 2, N4 = N3 + 2, N5 = N4 + 128, N6 = N5 + 128, N7 = N6 + 256, N8 = N7 + 2048, N9 = N8 + 2048, N10 = N9 + 2048;
    for (int t = blockIdx.x; t < N10; t += gridDim.x) {
        if (t < N0) transpose_tile(p.w_in, NIN, NIN, (bf16_t*)(ws + OFF_WINT), 1024, t / 77, t % 77, smem);
        else if (t < N1) { const int q = t - N0; transpose_tile(p.ck1, 128, 128, (bf16_t*)(ws + OFF_CK1T), 2048, q >> 1, q & 1, smem); }
        else if (t < N2) { const int q = t - N1; transpose_tile(p.cv1, 128, 128, (bf16_t*)(ws + OFF_CV1T), 2048, q >> 1, q & 1, smem); }
        else if (t < N3) { const int q = t - N2; transpose_tile(p.ck2, 64, 64, (bf16_t*)(ws + OFF_CK2T), 128, q, 0, smem); }
        else if (t < N4) { const int q = t - N3; transpose_tile(p.cv2, 64, 64, (bf16_t*)(ws + OFF_CV2T), 128, q, 0, smem); }
        else if (t < N5) { const int q = t - N4; transpose_tile(p.w_ba, 1024, 1024, (bf16_t*)(ws + OFF_WAT), 512, q >> 4, q & 15, smem); }
        else if (t < N6) { const int q = t - N5; transpose_tile(p.w_bb, 1024, 1024, (bf16_t*)(ws + OFF_WBT), 512, q >> 4, q & 15, smem); }
        else if (t < N7) { const int q = t - N6; transpose_tile(p.w_out, 1024, 1024, (bf16_t*)(ws + OFF_WOT), 1024, q >> 4, q & 15, smem); }
        else if (t < N8) { const int q = t - N7, e = q >> 6, r = q & 63; transpose_tile(p.w_eg + (size_t)e * 1024 * 256, 256, 256, (bf16_t*)(ws + OFF_WGT) + (size_t)e * 256 * 1024, 1024, r >> 2, r & 3, smem); }
        else if (t < N9) { const int q = t - N8, e = q >> 6, r = q & 63; transpose_tile(p.w_eu + (size_t)e * 1024 * 256, 256, 256, (bf16_t*)(ws + OFF_WUT) + (size_t)e * 256 * 1024, 1024, r >> 2, r & 3, smem); }
        else { const int q = t - N9, e = q >> 6, r = q & 63; transpose_tile(p.w_ed + (size_t)e * 256 * 1024, 1024, 1024, (bf16_t*)(ws + OFF_WDT) + (size_t)e * 1024 * 256, 256, r >> 4, r & 15, smem); }
    }
    for (int t = blockIdx.x; t < 8; t += gridDim.x) {
        const int which = t >> 2, n = (t & 3) * 32 + (threadIdx.x & 31), ksp = threadIdx.x >> 5;
        const float* pe = which ? p.pe_v : p.pe_k; const float* w1 = which ? p.cv1 : p.ck1;
        float a = 0.f;
        for (int k = ksp * 256; k < ksp * 256 + 256; ++k) a += pe[k] * w1[(size_t)k * 128 + n];
        float* red = (float*)smem;
        red[threadIdx.x] = a;
        __syncthreads();
        if (threadIdx.x < 32) {
            float s = 0.f;
#pragma unroll
            for (int j = 0; j < 8; ++j) s += red[j * 32 + threadIdx.x];
            ((float*)(ws + OFF_BIAS1))[which * 128 + n] = s;
        }
        __syncthreads();
    }
    for (int vb = blockIdx.x; vb < T; vb += gridDim.x) ph_rms_h(vb, p.x, p.g_mix, (bf16_t*)p.out, smem);
}

__device__ __forceinline__ int tile_off(int row, int chunk) { return row * 128 + ((chunk ^ (row & 7)) << 4); }

__device__ __forceinline__ void gemm_kloop(f32x4 (&acc)[4][4], const bf16_t* const (&pa)[4], const bf16_t* const (&pb)[4], int ka, int kb, int nk, char* smem) {
    const int tid = threadIdx.x, lane = tid & 63, wid = tid >> 6, wr = wid >> 1, wc = wid & 1, fr = lane & 15, fq = lane >> 4;
    const int so = tile_off(tid >> 3, tid & 7);
    const int offA = (wr * 64 + fr) * 128, offB = 16384 + (wc * 64 + fr) * 128, x = fr & 7;
    u32x4 ra[4], rb[4];
#pragma unroll
    for (int i = 0; i < 4; ++i) { ra[i] = *(const u32x4*)pa[i]; rb[i] = *(const u32x4*)pb[i]; }
    __syncthreads();
#pragma unroll
    for (int i = 0; i < 4; ++i) { *(u32x4*)(smem + so + i * 4096) = ra[i]; *(u32x4*)(smem + 16384 + so + i * 4096) = rb[i]; }
    __syncthreads();
    for (int kt = 0; kt < nk; ++kt) {
        const int cur = kt & 1;
        if (kt + 1 < nk) {
#pragma unroll
            for (int i = 0; i < 4; ++i) { ra[i] = *(const u32x4*)(pa[i] + (size_t)(kt + 1) * ka); rb[i] = *(const u32x4*)(pb[i] + (size_t)(kt + 1) * kb); }
        }
        const char* sa = smem + cur * 32768 + offA;
        const char* sb = smem + cur * 32768 + offB;
#pragma unroll
        for (int ks = 0; ks < 2; ++ks) {
            const int ch = ((ks * 4 + fq) ^ x) << 4;
            bf16x8 af[4], bfr[4];
#pragma unroll
            for (int mi = 0; mi < 4; ++mi) af[mi] = *(const bf16x8*)(sa + mi * 2048 + ch);
#pragma unroll
            for (int ni = 0; ni < 4; ++ni) bfr[ni] = *(const bf16x8*)(sb + ni * 2048 + ch);
#pragma unroll
            for (int mi = 0; mi < 4; ++mi)
#pragma unroll
                for (int ni = 0; ni < 4; ++ni) acc[mi][ni] = __builtin_amdgcn_mfma_f32_16x16x32_bf16(bfr[ni], af[mi], acc[mi][ni], 0, 0, 0);
        }
        if (kt + 1 < nk) {
            char* st = smem + (cur ^ 1) * 32768 + so;
#pragma unroll
            for (int i = 0; i < 4; ++i) { *(u32x4*)(st + i * 4096) = ra[i]; *(u32x4*)(st + 16384 + i * 4096) = rb[i]; }
        }
        __syncthreads();
    }
}
__device__ __forceinline__ void acc_zero(f32x4 (&acc)[4][4]) {
#pragma unroll
    for (int mi = 0; mi < 4; ++mi)
#pragma unroll
        for (int ni = 0; ni < 4; ++ni) acc[mi][ni] = (f32x4){0.f, 0.f, 0.f, 0.f};
}
#define GEMM_LANE_VARS const int tid = threadIdx.x, lane = tid & 63, wid = tid >> 6, wr = wid >> 1, wc = wid & 1, fr = lane & 15, fq = lane >> 4, lrow = tid >> 3, lch8 = (tid & 7) * 8; (void)wr; (void)wc; (void)fr; (void)fq; (void)lrow; (void)lch8;
__device__ __forceinline__ uint2 pack4(f32x4 v) { uint2 o; o.x = pack_bf16(v[0], v[1]); o.y = pack_bf16(v[2], v[3]); return o; }
__device__ __forceinline__ float sigmoidf_(float a) { return 1.f / (1.f + __expf(-a)); }

__device__ __forceinline__ void ph_proj(const bf16_t* __restrict__ h, const bf16_t* __restrict__ WinT, bf16_t* __restrict__ proj, char* smem) {
    GEMM_LANE_VARS
    for (int u = blockIdx.x; u < 128 * 23; u += gridDim.x) {
        const int xg = u & 7, v = u >> 3, tn = v % 23, tm = (v / 23) * 8 + xg;
        const bf16_t* pa[4]; const bf16_t* pb[4];
#pragma unroll
        for (int i = 0; i < 4; ++i) { pa[i] = h + (size_t)(tm * 128 + lrow + 32 * i) * 1024 + lch8; pb[i] = WinT + (size_t)(tn * 128 + lrow + 32 * i) * 1024 + lch8; }
        f32x4 acc[4][4]; acc_zero(acc);
        gemm_kloop(acc, pa, pb, 64, 64, 16, smem);
#pragma unroll
        for (int mi = 0; mi < 4; ++mi)
#pragma unroll
            for (int ni = 0; ni < 4; ++ni) {
                const int m = tm * 128 + wr * 64 + mi * 16 + fr, n = tn * 128 + wc * 64 + ni * 16 + 4 * fq;
                if (n < NPROJ) *(uint2*)(proj + (size_t)m * PP + n) = pack4(acc[mi][ni]);
            }
    }
}

__device__ __forceinline__ void ph_cmp1(const bf16_t* __restrict__ proj, const char* ws, char* smem) {
    GEMM_LANE_VARS
    for (int u = blockIdx.x; u < 32; u += gridDim.x) {
        const int which = u >> 4, tm = u & 15;
        const bf16_t* W1T = (const bf16_t*)(ws + (which ? OFF_CV1T : OFF_CK1T));
        const float* bias1 = (const float*)(ws + OFF_BIAS1) + which * 128;
        bf16_t* hid = (bf16_t*)(ws + OFF_HIDC) + (size_t)which * 2048 * 128;
        const int col0 = which ? VC : KC;
        const bf16_t* pa[4]; const bf16_t* pb[4];
#pragma unroll
        for (int i = 0; i < 4; ++i) {
            const int m = tm * 128 + lrow + 32 * i, bg = m >> 8, c = (m & 255) > 254 ? 254 : (m & 255), b = bg >> 1, g = bg & 1;
            pa[i] = proj + (size_t)(b * S + 16 * c) * PP + col0 + g * 64 + lch8;
            pb[i] = W1T + (size_t)(lrow + 32 * i) * 2048 + lch8;
        }
        f32x4 acc[4][4]; acc_zero(acc);
        gemm_kloop(acc, pa, pb, PP, 64, 32, smem);
#pragma unroll
        for (int mi = 0; mi < 4; ++mi)
#pragma unroll
            for (int ni = 0; ni < 4; ++ni) {
                const int m = tm * 128 + wr * 64 + mi * 16 + fr, n = wc * 64 + ni * 16 + 4 * fq;
                f32x4 v = acc[mi][ni];
#pragma unroll
                for (int j = 0; j < 4; ++j) { const float a = v[j] + bias1[n + j]; const float t = 0.7978845608028654f * (a + 0.044715f * a * a * a); v[j] = 0.5f * a * (1.f + tanhf(t)); }
                *(uint2*)(hid + (size_t)m * 128 + n) = pack4(v);
            }
    }
}

__device__ __forceinline__ void ph_cmp2(const char* ws_c, char* ws, char* smem) {
    GEMM_LANE_VARS
    for (int u = blockIdx.x; u < 32; u += gridDim.x) {
        const int which = u >> 4, tm = u & 15;
        const bf16_t* W2T = (const bf16_t*)(ws_c + (which ? OFF_CV2T : OFF_CK2T));
        const bf16_t* hid = (const bf16_t*)(ws_c + OFF_HIDC) + (size_t)which * 2048 * 128;
        const bf16_t* pa[4]; const bf16_t* pb[4];
#pragma unroll
        for (int i = 0; i < 4; ++i) { pa[i] = hid + (size_t)(tm * 128 + lrow + 32 * i) * 128 + lch8; pb[i] = W2T + (size_t)(lrow + 32 * i) * 128 + lch8; }
        f32x4 acc[4][4]; acc_zero(acc);
        gemm_kloop(acc, pa, pb, 64, 64, 2, smem);
        if (wc == 0) {
            bf16_t* outp = (bf16_t*)(ws + (which ? OFF_VCB : OFF_KCB));
            bf16_t* outT = (bf16_t*)(ws + OFF_VCBT);
#pragma unroll
            for (int mi = 0; mi < 4; ++mi)
#pragma unroll
                for (int ni = 0; ni < 4; ++ni) {
                    const int m = tm * 128 + wr * 64 + mi * 16 + fr, n = ni * 16 + 4 * fq, c = m & 255, bg = m >> 8;
                    f32x4 v = acc[mi][ni];
                    if (c == 255) v = (f32x4){0.f, 0.f, 0.f, 0.f};
                    *(uint2*)(outp + (size_t)m * 64 + n) = pack4(v);
                    if (which) {
#pragma unroll
                        for (int j = 0; j < 4; ++j) outT[((size_t)bg * 64 + n + j) * 256 + c] = f2bf(v[j]);
                    }
                }
        }
    }
}

__device__ __forceinline__ void ph_gates(const bf16_t* __restrict__ h, const bf16_t* __restrict__ WinT, bf16_t* __restrict__ SAB, char* smem) {
    GEMM_LANE_VARS
    for (int u = blockIdx.x; u < 128 * 16; u += gridDim.x) {
        const int xg = u & 7, v = u >> 3, tn = v & 15, tm = (v >> 4) * 8 + xg;
        const bf16_t* pa[4]; const bf16_t* pb[4];
#pragma unroll
        for (int i = 0; i < 4; ++i) { pa[i] = h + (size_t)(tm * 128 + lrow + 32 * i) * 1024 + lch8; pb[i] = WinT + (size_t)(MGA + tn * 128 + lrow + 32 * i) * 1024 + lch8; }
        f32x4 acc[4][4]; acc_zero(acc);
        gemm_kloop(acc, pa, pb, 64, 64, 16, smem);
#pragma unroll
        for (int mi = 0; mi < 4; ++mi)
#pragma unroll
            for (int ni = 0; ni < 4; ++ni) {
                const int m = tm * 128 + wr * 64 + mi * 16 + fr, n = tn * 128 + wc * 64 + ni * 16 + 4 * fq;
                f32x4 v = acc[mi][ni];
#pragma unroll
                for (int j = 0; j < 4; ++j) v[j] = sigmoidf_(v[j]);
                *(uint2*)(SAB + (size_t)m * 2048 + n) = pack4(v);
            }
    }
}

__device__ __forceinline__ void ph_merge(const bf16_t* __restrict__ ya, const bf16_t* __restrict__ yb, const bf16_t* __restrict__ WaT, const bf16_t* __restrict__ WbT,
                                         const bf16_t* __restrict__ SAB, bf16_t* __restrict__ mrg, char* smem) {
    GEMM_LANE_VARS
    for (int u = blockIdx.x; u < 128 * 8; u += gridDim.x) {
        const int xg = u & 7, v = u >> 3, tn = v & 7, tm = (v >> 3) * 8 + xg;
        const bf16_t* pa[4]; const bf16_t* pb[4];
#pragma unroll
        for (int i = 0; i < 4; ++i) { pa[i] = ya + (size_t)(tm * 128 + lrow + 32 * i) * 512 + lch8; pb[i] = WaT + (size_t)(tn * 128 + lrow + 32 * i) * 512 + lch8; }
        f32x4 acc1[4][4]; acc_zero(acc1);
        gemm_kloop(acc1, pa, pb, 64, 64, 8, smem);
#pragma unroll
        for (int i = 0; i < 4; ++i) { pa[i] = yb + (size_t)(tm * 128 + lrow + 32 * i) * 512 + lch8; pb[i] = WbT + (size_t)(tn * 128 + lrow + 32 * i) * 512 + lch8; }
        f32x4 acc2[4][4]; acc_zero(acc2);
        gemm_kloop(acc2, pa, pb, 64, 64, 8, smem);
#pragma unroll
        for (int mi = 0; mi < 4; ++mi)
#pragma unroll
            for (int ni = 0; ni < 4; ++ni) {
                const int m = tm * 128 + wr * 64 + mi * 16 + fr, n = tn * 128 + wc * 64 + ni * 16 + 4 * fq;
                const uint2 sa = *(const uint2*)(SAB + (size_t)m * 2048 + n), sb = *(const uint2*)(SAB + (size_t)m * 2048 + 1024 + n);
                f32x4 v;
                v[0] = __uint_as_float(sa.x << 16) * acc1[mi][ni][0] + __uint_as_float(sb.x << 16) * acc2[mi][ni][0];
                v[1] = __uint_as_float(sa.x & 0xFFFF0000u) * acc1[mi][ni][1] + __uint_as_float(sb.x & 0xFFFF0000u) * acc2[mi][ni][1];
                v[2] = __uint_as_float(sa.y << 16) * acc1[mi][ni][2] + __uint_as_float(sb.y << 16) * acc2[mi][ni][2];
                v[3] = __uint_as_float(sa.y & 0xFFFF0000u) * acc1[mi][ni][3] + __uint_as_float(sb.y & 0xFFFF0000u) * acc2[mi][ni][3];
                *(uint2*)(mrg + (size_t)m * 1024 + n) = pack4(v);
            }
    }
}

__device__ __forceinline__ void ph_outproj(const bf16_t* __restrict__ mrg, const bf16_t* __restrict__ WoT, const float* __restrict__ x, float* __restrict__ x2, char* smem) {
    GEMM_LANE_VARS
    for (int u = blockIdx.x; u < 128 * 8; u += gridDim.x) {
        const int xg = u & 7, v = u >> 3, tn = v & 7, tm = (v >> 3) * 8 + xg;
        const bf16_t* pa[4]; const bf16_t* pb[4];
#pragma unroll
        for (int i = 0; i < 4; ++i) { pa[i] = mrg + (size_t)(tm * 128 + lrow + 32 * i) * 1024 + lch8; pb[i] = WoT + (size_t)(tn * 128 + lrow + 32 * i) * 1024 + lch8; }
        f32x4 acc[4][4]; acc_zero(acc);
        gemm_kloop(acc, pa, pb, 64, 64, 16, smem);
#pragma unroll
        for (int mi = 0; mi < 4; ++mi)
#pragma unroll
            for (int ni = 0; ni < 4; ++ni) {
                const int m = tm * 128 + wr * 64 + mi * 16 + fr, n = tn * 128 + wc * 64 + ni * 16 + 4 * fq;
                const float4 xv = *(const float4*)(x + (size_t)m * 1024 + n);
                *(float4*)(x2 + (size_t)m * 1024 + n) = make_float4(xv.x + acc[mi][ni][0], xv.y + acc[mi][ni][1], xv.z + acc[mi][ni][2], xv.w + acc[mi][ni][3]);
            }
    }
}

__device__ __forceinline__ int moe_expert_of(const int* __restrict__ cnt, int m0, int& total) {
    int e = 0, acc = 0;
    for (int i = 0; i < 32; ++i) { const int nacc = acc + ((cnt[i] + 127) & ~127); if (m0 >= acc && m0 < nacc) e = i; acc = nacc; }
    total = acc; return e;
}

__device__ __forceinline__ void ph_moe1(const bf16_t* __restrict__ h2, const bf16_t* __restrict__ WgT, const bf16_t* __restrict__ WuT, const int* __restrict__ cnt,
                                        const int* __restrict__ slot_tok, const float* __restrict__ slot_w, bf16_t* __restrict__ hid, char* smem) {
    GEMM_LANE_VARS
    int total; (void)moe_expert_of(cnt, 0, total);
    const int nu = (total >> 7) * 4;
    for (int u = blockIdx.x; u < nu; u += gridDim.x) {
        const int ft = u & 3, tm = u >> 2; int tt;
        const int e = moe_expert_of(cnt, tm * 128, tt);
        const bf16_t* pa[4]; const bf16_t* pb[4];
#pragma unroll
        for (int i = 0; i < 4; ++i) {
            const int rr = lrow + 32 * i;
            const int tk = slot_tok[tm * 128 + rr];
            pa[i] = h2 + (size_t)(tk >= 0 ? (tk >> 1) : 0) * 1024 + lch8;
            const int bwc = rr >> 6, bni = (rr >> 4) & 3, bj = rr & 15;
            const int f = ft * 64 + bwc * 32 + (bni >> 1) * 16 + bj;
            pb[i] = ((bni & 1) ? WuT : WgT) + ((size_t)e * 256 + f) * 1024 + lch8;
        }
        f32x4 acc[4][4]; acc_zero(acc);
        gemm_kloop(acc, pa, pb, 64, 64, 16, smem);
#pragma unroll
        for (int mi = 0; mi < 4; ++mi) {
            const int m = tm * 128 + wr * 64 + mi * 16 + fr;
            const float w = slot_tok[m] >= 0 ? slot_w[m] : 0.f;
#pragma unroll
            for (int q = 0; q < 2; ++q) {
                const int f = ft * 64 + wc * 32 + q * 16 + 4 * fq;
                f32x4 v;
#pragma unroll
                for (int j = 0; j < 4; ++j) { const float a = acc[mi][2 * q][j], uu = acc[mi][2 * q + 1][j]; v[j] = a * sigmoidf_(a) * uu * w; }
                *(uint2*)(hid + (size_t)m * 256 + f) = pack4(v);
            }
        }
    }
}

__device__ __forceinline__ void ph_moe2(const bf16_t* __restrict__ hid, const bf16_t* __restrict__ WdT, const int* __restrict__ cnt, const int* __restrict__ slot_tok,
                                        bf16_t* __restrict__ Y, char* smem) {
    GEMM_LANE_VARS
    int total; (void)moe_expert_of(cnt, 0, total);
    const int nu = (total >> 7) * 8;
    for (int u = blockIdx.x; u < nu; u += gridDim.x) {
        const int tn = u & 7, tm = u >> 3; int tt;
        const int e = moe_expert_of(cnt, tm * 128, tt);
        const bf16_t* pa[4]; const bf16_t* pb[4];
#pragma unroll
        for (int i = 0; i < 4; ++i) { pa[i] = hid + (size_t)(tm * 128 + lrow + 32 * i) * 256 + lch8; pb[i] = WdT + ((size_t)e * 1024 + tn * 128 + lrow + 32 * i) * 256 + lch8; }
        f32x4 acc[4][4]; acc_zero(acc);
        gemm_kloop(acc, pa, pb, 64, 64, 4, smem);
#pragma unroll
        for (int mi = 0; mi < 4; ++mi) {
            const int m = tm * 128 + wr * 64 + mi * 16 + fr;
            const int tk = slot_tok[m];
            if (tk >= 0) {
                bf16_t* yr = Y + ((size_t)(tk & 1) * T + (size_t)(tk >> 1)) * 1024 + tn * 128 + wc * 64 + 4 * fq;
#pragma unroll
                for (int ni = 0; ni < 4; ++ni) *(uint2*)(yr + ni * 16) = pack4(acc[mi][ni]);
            }
        }
    }
}
__device__ __forceinline__ int t5_bucket(int n) {
    if (n < 16) return n;
    const int l = 16 + (int)(logf((float)n / 16.0f) / logf(8.0f) * 16.0f);
    return l < 31 ? l : 31;
}
struct AttnState { float m[4], l[4], o[4]; };

__device__ __forceinline__ void attend_block(AttnState& st, const bf16_t* __restrict__ Kp, const bf16_t* __restrict__ Vp, int key0, bool valid, int rel,
                                             const float (*q_lds)[64], const float (*tb_lds)[128], float (*p_lds)[256], int lane) {
    float s[4] = {0.f, 0.f, 0.f, 0.f};
    const bf16_t* kr = Kp + (size_t)(key0 + lane) * PP;
#pragma unroll
    for (int d8 = 0; d8 < 8; ++d8) {
        const uint4 raw = *(const uint4*)(kr + d8 * 8);
        const unsigned w[4] = {raw.x, raw.y, raw.z, raw.w};
#pragma unroll
        for (int j = 0; j < 4; ++j) {
            const float k0 = __uint_as_float(w[j] << 16), k1 = __uint_as_float(w[j] & 0xFFFF0000u);
#pragma unroll
            for (int hp = 0; hp < 4; ++hp) s[hp] += q_lds[hp][d8 * 8 + 2 * j] * k0 + q_lds[hp][d8 * 8 + 2 * j + 1] * k1;
        }
    }
    const int rc = rel < 0 ? 0 : (rel > 127 ? 127 : rel);
#pragma unroll
    for (int hp = 0; hp < 4; ++hp) {
        const float sc = valid ? s[hp] + tb_lds[hp][rc] : -3.0e38f;
        const float bm = wave_max(sc);
        const float mn = fmaxf(st.m[hp], bm);
        const float scale = __expf(st.m[hp] - mn);
        const float p = valid ? __expf(sc - mn) : 0.f;
        st.l[hp] = st.l[hp] * scale + wave_sum(p);
        st.o[hp] *= scale; st.m[hp] = mn;
        p_lds[hp][lane] = p;
    }
    wave_lds_sync();
    const bf16_t* vr = Vp + (size_t)key0 * PP + lane;
    for (int k = 0; k < 64; ++k) {
        const float v = bf2f(vr[(size_t)k * PP]);
#pragma unroll
        for (int hp = 0; hp < 4; ++hp) st.o[hp] += p_lds[hp][k] * v;
    }
    wave_lds_sync();
}

__device__ __forceinline__ void nsa_task(int idx, const bf16_t* __restrict__ proj, const bf16_t* __restrict__ kcb, const bf16_t* __restrict__ vcb,
                                         const float* __restrict__ rel_bias, bf16_t* __restrict__ ya, char* wsm, int lane) {
    float (*p_lds)[256] = (float (*)[256])wsm;
    float (*q_lds)[64] = (float (*)[64])(wsm + 4096);
    float (*tb_lds)[128] = (float (*)[128])(wsm + 4096 + 1024);
    const int t = idx & (S - 1), g = (idx >> 12) & 1, b = idx >> 13;
    const size_t row = (size_t)(b * S + t) * PP;
    wave_lds_sync();
#pragma unroll
    for (int hp = 0; hp < 4; ++hp) {
        q_lds[hp][lane] = bf2f(proj[row + QA + (g * 4 + hp) * 64 + lane]) * 0.125f;
        tb_lds[hp][lane] = rel_bias[t5_bucket(lane) * 8 + g * 4 + hp];
        tb_lds[hp][lane + 64] = rel_bias[t5_bucket(lane + 64) * 8 + g * 4 + hp];
    }
    wave_lds_sync();
    const int nvis = t >= 31 ? (((t - 31) >> 4) + 1 > 255 ? 255 : ((t - 31) >> 4) + 1) : 0;
    const bf16_t* kc = kcb + (size_t)(b * 2 + g) * 256 * 64;
    const bf16_t* vc = vcb + (size_t)(b * 2 + g) * 256 * 64;
    float oc[4] = {0.f, 0.f, 0.f, 0.f};
    {
        float sc[4][4];
#pragma unroll
        for (int i = 0; i < 4; ++i) {
            const int c = lane + 64 * i;
            float s[4] = {0.f, 0.f, 0.f, 0.f};
            const bf16_t* kr = kc + (size_t)c * 64;
#pragma unroll
            for (int d8 = 0; d8 < 8; ++d8) {
                const uint4 raw = *(const uint4*)(kr + d8 * 8);
                const unsigned w[4] = {raw.x, raw.y, raw.z, raw.w};
#pragma unroll
                for (int j = 0; j < 4; ++j) {
                    const float k0 = __uint_as_float(w[j] << 16), k1 = __uint_as_float(w[j] & 0xFFFF0000u);
#pragma unroll
                    for (int hp = 0; hp < 4; ++hp) s[hp] += q_lds[hp][d8 * 8 + 2 * j] * k0 + q_lds[hp][d8 * 8 + 2 * j + 1] * k1;
                }
            }
            const int rel = t - (16 * c + 31);
            const int rc = rel < 0 ? 0 : (rel > 127 ? 127 : rel);
#pragma unroll
            for (int hp = 0; hp < 4; ++hp) sc[hp][i] = (c < nvis) ? s[hp] + tb_lds[hp][rc] : -3.0e38f;
        }
#pragma unroll
        for (int hp = 0; hp < 4; ++hp) {
            float m = fmaxf(fmaxf(sc[hp][0], sc[hp][1]), fmaxf(sc[hp][2], sc[hp][3]));
            m = wave_max(m);
            float e[4], sum = 0.f;
#pragma unroll
            for (int i = 0; i < 4; ++i) { e[i] = (lane + 64 * i < nvis) ? __expf(sc[hp][i] - m) : 0.f; sum += e[i]; }
            sum = wave_sum(sum);
            const float inv = nvis > 0 ? 1.f / sum : 0.f;
#pragma unroll
            for (int i = 0; i < 4; ++i) p_lds[hp][lane + 64 * i] = e[i] * inv;
        }
        wave_lds_sync();
        for (int c = 0; c < nvis; ++c) {
            const float v = bf2f(vc[(size_t)c * 64 + lane]);
#pragma unroll
            for (int hp = 0; hp < 4; ++hp) oc[hp] += p_lds[hp][c] * v;
        }
    }
    const int tb = t >> 6;
    unsigned long long selmask;
    {
        float imp = 0.f;
        const int c0 = 4 * lane - 1 < 0 ? 0 : 4 * lane - 1, c1 = 4 * lane + 3 > 254 ? 254 : 4 * lane + 3;
        for (int c = c0; c <= c1; ++c)
#pragma unroll
            for (int hp = 0; hp < 4; ++hp) imp += p_lds[hp][c];
        const bool forced = (lane == 0) || (lane == tb) || (lane == tb - 1);
        const float val = forced ? 1e30f : (lane > tb ? -1e30f : imp);
        int rank = 0;
        for (int j = 0; j < 64; ++j) {
            const float o = __shfl(val, j);
            rank += (o > val || (o == val && j < lane)) ? 1 : 0;
        }
        selmask = __ballot(rank < 16);
    }
    wave_lds_sync();
    AttnState ss;
#pragma unroll
    for (int hp = 0; hp < 4; ++hp) { ss.m[hp] = -1e30f; ss.l[hp] = 0.f; ss.o[hp] = 0.f; }
    const bf16_t* pb = proj + (size_t)b * S * PP;
    for (int j = 0; j <= tb; ++j) {
        if (!((selmask >> j) & 1ull)) continue;
        const int rel = t - (64 * j + lane);
        attend_block(ss, pb + KS + g * 64, pb + VS + g * 64, 64 * j, rel >= 0, rel, q_lds, tb_lds, p_lds, lane);
    }
    AttnState sw;
#pragma unroll
    for (int hp = 0; hp < 4; ++hp) { sw.m[hp] = -1e30f; sw.l[hp] = 0.f; sw.o[hp] = 0.f; }
    const int kb0 = (t - 511 < 0 ? 0 : t - 511) >> 6;
    for (int j = kb0; j <= tb; ++j) {
        const int rel = t - (64 * j + lane);
        attend_block(sw, pb + KW + g * 64, pb + VW + g * 64, 64 * j, rel >= 0 && rel < 512, rel, q_lds, tb_lds, p_lds, lane);
    }
#pragma unroll
    for (int hp = 0; hp < 4; ++hp) {
        const int head = g * 4 + hp;
        const float g0 = 1.f / (1.f + __expf(-bf2f(proj[row + GA + head])));
        const float g1 = 1.f / (1.f + __expf(-bf2f(proj[row + GA + 8 + head])));
        const float g2 = 1.f / (1.f + __expf(-bf2f(proj[row + GA + 16 + head])));
        const float o = g0 * oc[hp] + g1 * ss.o[hp] / ss.l[hp] + g2 * sw.o[hp] / sw.l[hp];
        ya[(size_t)(b * S + t) * 512 + head * 64 + lane] = f2bf(o);
    }
}

__device__ __forceinline__ void gla_prep_task(int vb, const bf16_t* __restrict__ proj, const float* __restrict__ w_alpha, const float* __restrict__ b_alpha, float* __restrict__ bc, int lane) {
    const int n = vb & 63, h = (vb >> 6) & 3, b = vb >> 8;
    const int col = h * 64 + lane;
    float w[16];
#pragma unroll
    for (int r = 0; r < 16; ++r) w[r] = w_alpha[r * 256 + col];
    const float bias = b_alpha[col];
    float cum = 0.f;
    for (int c = 0; c < 64; ++c) {
        const size_t row = (size_t)(b * S + n * 64 + c);
        float z = bias;
#pragma unroll
        for (int r = 0; r < 16; ++r) z += bf2f(proj[row * PP + AB + r]) * w[r];
        const float ls = fminf(z, 0.f) - log1pf(__expf(-fabsf(z)));
        cum += ls * (1.0f / 16.0f);
        bc[row * 256 + col] = cum;
    }
}

__device__ __forceinline__ void gla_state_vb(int vb, const bf16_t* __restrict__ proj, const float* __restrict__ bc, float* __restrict__ cstate, char* smem) {
    float (*kd)[64] = (float (*)[64])smem;
    float (*vs)[128] = (float (*)[128])(smem + 16384);
    const int tid = threadIdx.x, n = vb & 63, h = (vb >> 6) & 3, b = vb >> 8;
    const size_t row0 = (size_t)(b * S + n * 64);
    for (int e = tid; e < 4096; e += 256) {
        const int c = e >> 6, d = e & 63;
        kd[c][d] = bf2f(proj[(row0 + c) * PP + KB + h * 64 + d]) * __expf(bc[(row0 + 63) * 256 + h * 64 + d] - bc[(row0 + c) * 256 + h * 64 + d]);
    }
    for (int e = tid; e < 8192; e += 256) {
        const int c = e >> 7, v = e & 127;
        vs[c][v] = bf2f(proj[(row0 + c) * PP + VB + h * 128 + v]);
    }
    __syncthreads();
    const int v = tid & 127, dg = tid >> 7;
    float acc[32];
#pragma unroll
    for (int i = 0; i < 32; ++i) acc[i] = 0.f;
    for (int c = 0; c < 64; ++c) {
        const float vv = vs[c][v];
#pragma unroll
        for (int i = 0; i < 32; ++i) acc[i] += kd[c][dg * 32 + i] * vv;
    }
    float* out = cstate + (size_t)vb * 8192;
#pragma unroll
    for (int i = 0; i < 32; ++i) out[(dg * 32 + i) * 128 + v] = acc[i];
    __syncthreads();
}

__device__ __forceinline__ void gla_scan_vb(int vb, const float* __restrict__ bc, float* __restrict__ cstate) {
    const int idx = vb * 256 + threadIdx.x;
    const int e = idx & 8191, bh = idx >> 13, b = bh >> 2, h = bh & 3, d = e >> 7;
    float state = 0.f;
    for (int n = 0; n < 64; ++n) {
        float* p = cstate + ((size_t)(bh * 64 + n)) * 8192 + e;
        const float upd = *p;
        *p = state;
        const float dec = __expf(bc[((size_t)(b * S + n * 64 + 63)) * 256 + h * 64 + d]);
        state = dec * state + upd;
    }
}

__device__ __forceinline__ void gla_out_vb(int vb, const bf16_t* __restrict__ proj, const float* __restrict__ bc, const float* __restrict__ prev,
                                           const float* __restrict__ norm_g, bf16_t* __restrict__ yb, char* smem) {
    float (*qi)[65] = (float (*)[65])smem;
    float (*ki)[65] = (float (*)[65])(smem + 64 * 65 * 4);
    float (*at)[65] = (float (*)[65])(smem + 2 * 64 * 65 * 4);
    const int tid = threadIdx.x, n = vb & 63, h = (vb >> 6) & 3, b = vb >> 8;
    const size_t row0 = (size_t)(b * S + n * 64);
    for (int e = tid; e < 4096; e += 256) {
        const int c = e >> 6, d = e & 63;
        const float bcv = bc[(row0 + c) * 256 + h * 64 + d];
        qi[c][d] = bf2f(proj[(row0 + c) * PP + QB + h * 64 + d]) * 0.125f * __expf(bcv);
        ki[c][d] = bf2f(proj[(row0 + c) * PP + KB + h * 64 + d]) * __expf(-bcv);
    }
    __syncthreads();
    for (int e = tid; e < 4096; e += 256) {
        const int c = e >> 6, j = e & 63;
        float a = 0.f;
        if (j <= c) for (int d = 0; d < 64; ++d) a += qi[c][d] * ki[j][d];
        at[c][j] = a;
    }
    __syncthreads();
    const int c = tid >> 2, vg = tid & 3;
    float acc[32];
#pragma unroll
    for (int i = 0; i < 32; ++i) acc[i] = 0.f;
    for (int j = 0; j <= c; ++j) {
        const float a = at[c][j];
        const bf16_t* vr = proj + (row0 + j) * PP + VB + h * 128 + vg * 32;
#pragma unroll
        for (int i = 0; i < 32; ++i) acc[i] += a * bf2f(vr[i]);
    }
    const float* pv = prev + (size_t)vb * 8192 + vg * 32;
    for (int d = 0; d < 64; ++d) {
        const float qv = qi[c][d];
#pragma unroll
        for (int i = 0; i < 32; ++i) acc[i] += qv * pv[d * 128 + i];
    }
    float ss = 0.f;
#pragma unroll
    for (int i = 0; i < 32; ++i) ss += acc[i] * acc[i];
    ss += __shfl_xor(ss, 1); ss += __shfl_xor(ss, 2);
    const float r = rsqrtf(ss * (1.0f / 128.0f) + 1e-6f);
    const size_t row = row0 + c;
#pragma unroll
    for (int i = 0; i < 32; ++i) {
        const int col = h * 128 + vg * 32 + i;
        const float rv = bf2f(proj[row * PP + RB + col]);
        yb[row * 512 + col] = f2bf(acc[i] * r * norm_g[col] * (rv / (1.f + __expf(-rv))));
    }
    __syncthreads();
}

__device__ __forceinline__ void router_vb(int row, const float* __restrict__ x2, const float* __restrict__ g, const float* __restrict__ w_rg, const float* __restrict__ b_rg,
                                          const float* __restrict__ w_re, const float* __restrict__ b_re, bf16_t* __restrict__ h2,
                                          int* __restrict__ route_e, float* __restrict__ route_w, int* __restrict__ cnt, char* smem) {
    float* red = (float*)smem;
    float (*part)[36] = (float (*)[36])(smem + 64);
    const int tid = threadIdx.x;
    float4 v = ((const float4*)(x2 + (size_t)row * D))[tid];
    float s = v.x * v.x + v.y * v.y + v.z * v.z + v.w * v.w;
    s = wave_sum(s);
    if ((tid & 63) == 0) red[tid >> 6] = s;
    __syncthreads();
    s = red[0] + red[1] + red[2] + red[3];
    const float r = rsqrtf(s * (1.0f / D) + 1e-6f);
    float4 gg = ((const float4*)g)[tid];
    float hn[4] = {v.x * r * gg.x, v.y * r * gg.y, v.z * r * gg.z, v.w * r * gg.w};
    ushort4 o; o.x = f2bf(hn[0]); o.y = f2bf(hn[1]); o.z = f2bf(hn[2]); o.w = f2bf(hn[3]);
    ((ushort4*)(h2 + (size_t)row * D))[tid] = o;
    float pl[36];
#pragma unroll
    for (int j = 0; j < 36; ++j) pl[j] = 0.f;
#pragma unroll
    for (int i = 0; i < 4; ++i) {
        const int k = tid * 4 + i;
#pragma unroll
        for (int j = 0; j < 4; ++j) pl[j] += hn[i] * w_rg[k * 4 + j];
#pragma unroll
        for (int j = 0; j < 32; ++j) pl[4 + j] += hn[i] * w_re[k * 32 + j];
    }
#pragma unroll
    for (int j = 0; j < 36; ++j) { const float t = wave_sum(pl[j]); if ((tid & 63) == 0) part[tid >> 6][j] = t; }
    __syncthreads();
    if (tid == 0) {
        float lg[4];
#pragma unroll
        for (int j = 0; j < 4; ++j) lg[j] = part[0][j] + part[1][j] + part[2][j] + part[3][j] + b_rg[j];
        int gs = 0; float mx = lg[0];
#pragma unroll
        for (int j = 1; j < 4; ++j) if (lg[j] > mx) { mx = lg[j]; gs = j; }
        float den = 0.f;
#pragma unroll
        for (int j = 0; j < 4; ++j) den += __expf(lg[j] - mx);
        const float gp = 1.f / den;
        float v0 = -3e38f, v1 = -3e38f; int i0 = 0, i1 = 0;
        for (int j = 0; j < 8; ++j) {
            const int c = 4 + gs * 8 + j;
            const float l = part[0][c] + part[1][c] + part[2][c] + part[3][c] + b_re[gs * 8 + j];
            if (l > v0) { v1 = v0; i1 = i0; v0 = l; i0 = j; }
            else if (l > v1) { v1 = l; i1 = j; }
        }
        const float e1 = __expf(v1 - v0);
        const float w0 = gp / (1.f + e1), w1 = gp * e1 / (1.f + e1);
        const int ea = gs * 8 + i0, eb = gs * 8 + i1;
        route_e[row * 2] = ea; route_e[row * 2 + 1] = eb;
        route_w[row * 2] = w0; route_w[row * 2 + 1] = w1;
        atomicAdd(&cnt[ea], 1); atomicAdd(&cnt[eb], 1);
    }
    __syncthreads();
}

__device__ __forceinline__ void final_vb(int row, float* __restrict__ x2out, const bf16_t* __restrict__ Y0, const bf16_t* __restrict__ Y1, const float* __restrict__ g, char* smem) {
    float* red = (float*)smem;
    const int tid = threadIdx.x;
    float4 v = ((const float4*)(x2out + (size_t)row * D))[tid];
    const ushort4 a = ((const ushort4*)(Y0 + (size_t)row * D))[tid], c = ((const ushort4*)(Y1 + (size_t)row * D))[tid];
    v.x += bf2f(a.x) + bf2f(c.x); v.y += bf2f(a.y) + bf2f(c.y); v.z += bf2f(a.z) + bf2f(c.z); v.w += bf2f(a.w) + bf2f(c.w);
    float s = v.x * v.x + v.y * v.y + v.z * v.z + v.w * v.w;
    s = wave_sum(s);
    if ((tid & 63) == 0) red[tid >> 6] = s;
    __syncthreads();
    s = red[0] + red[1] + red[2] + red[3];
    __syncthreads();
    const float r = rsqrtf(s * (1.0f / D) + 1e-6f);
    float4 gg = ((const float4*)g)[tid];
    ((float4*)(x2out + (size_t)row * D))[tid] = make_float4(v.x * r * gg.x, v.y * r * gg.y, v.z * r * gg.z, v.w * r * gg.w);
}


constexpr int SMEM_BYTES = 65536;

__global__ void __launch_bounds__(256, 1) k_fwd(Params p) {
    extern __shared__ __attribute__((aligned(16))) char smem_dyn[];
    char* smem = smem_dyn + 16;
    if (threadIdx.x == 0) *(uint4*)smem_dyn = make_uint4(0u, 0u, 0u, 0u);
    __syncthreads();
    char* ws = p.ws;
    XcdBarrier bar = xcd_barrier_post((unsigned*)(ws + OFF_BAR), (volatile LAS unsigned*)smem_dyn);
    int* ctrl = (int*)(ws + OFF_CTRL);
    int* route_e = (int*)(ws + OFF_ROUTE_E);
    float* route_w = (float*)(ws + OFF_ROUTE_W);
    int* slot_tok = (int*)(ws + OFF_SLOT_TOK);
    float* slot_w = (float*)(ws + OFF_SLOT_W);
    bf16_t* proj = (bf16_t*)(ws + OFF_PROJ);
    float* bc = (float*)(ws + OFF_BC);
    float* cstate = (float*)(ws + OFF_CSTATE);
    bf16_t* SAB = (bf16_t*)(ws + OFF_SAB);
    bf16_t* mrg = (bf16_t*)(ws + OFF_MRG);
    bf16_t* h2 = (bf16_t*)(ws + OFF_H2);
    bf16_t* hid = (bf16_t*)(ws + OFF_HID);
    bf16_t* Y0 = (bf16_t*)(ws + OFF_Y0);
    bf16_t* Y1 = (bf16_t*)(ws + OFF_Y1);
    bf16_t* ya = (bf16_t*)(ws + OFF_YA);
    bf16_t* yb = (bf16_t*)(ws + OFF_YB);
    bf16_t* kcb = (bf16_t*)(ws + OFF_KCB);
    bf16_t* vcb = (bf16_t*)(ws + OFF_VCB);
    bf16_t* h = (bf16_t*)p.out;
    const int wid = threadIdx.x >> 6, lane = threadIdx.x & 63;
    const int G = gridDim.x;

    ph_prep(p, smem);
    xcd_barrier(bar);
    ph_proj(h, (const bf16_t*)(ws + OFF_WINT), proj, smem);
    xcd_barrier(bar);
    ph_cmp1(proj, ws, smem);
    for (int task = blockIdx.x * 4 + wid; task < 1024; task += G * 4) gla_prep_task(task, proj, p.w_alpha, p.b_alpha, bc, lane);
    xcd_barrier(bar);
    ph_cmp2(ws, ws, smem);
    for (int vb = blockIdx.x; vb < 1024; vb += G) gla_state_vb(vb, proj, bc, cstate, smem);
    xcd_barrier(bar);
    for (int vb = blockIdx.x; vb < 512; vb += G) gla_scan_vb(vb, bc, cstate);
    for (int task = blockIdx.x * 4 + wid; task < Bn * 2 * S; task += G * 4) nsa_task(task, proj, kcb, vcb, p.rel_bias, ya, smem + wid * 8192, lane);
    xcd_barrier(bar);
    for (int vb = blockIdx.x; vb < 1024; vb += G) gla_out_vb(vb, proj, bc, cstate, p.norm_g, yb, smem);
    xcd_barrier(bar);
    ph_gates(h, (const bf16_t*)(ws + OFF_WINT), SAB, smem);
    xcd_barrier(bar);
    ph_merge(ya, yb, (const bf16_t*)(ws + OFF_WAT), (const bf16_t*)(ws + OFF_WBT), SAB, mrg, smem);
    xcd_barrier(bar);
    ph_outproj(mrg, (const bf16_t*)(ws + OFF_WOT), p.x, p.out, smem);
    xcd_barrier(bar);
    for (int vb = blockIdx.x; vb < T; vb += G) router_vb(vb, p.out, p.g_ffn, p.w_rg, p.b_rg, p.w_re, p.b_re, h2, route_e, route_w, ctrl, smem);
    xcd_barrier(bar);
    for (int i = blockIdx.x * 256 + threadIdx.x; i < 2 * T; i += G * 256) {
        const int e = route_e[i];
        int off = 0;
        for (int j = 0; j < e; ++j) off += (ctrl[j] + 127) & ~127;
        const int pos = atomicAdd(&ctrl[32 + e], 1);
        slot_tok[off + pos] = i; slot_w[off + pos] = route_w[i];
    }
    xcd_barrier(bar);
    ph_moe1(h2, (const bf16_t*)(ws + OFF_WGT), (const bf16_t*)(ws + OFF_WUT), ctrl, slot_tok, slot_w, hid, smem);
    xcd_barrier(bar);
    ph_moe2(hid, (const bf16_t*)(ws + OFF_WDT), ctrl, slot_tok, Y0, smem);
    xcd_barrier(bar);
    for (int vb = blockIdx.x; vb < T; vb += G) final_vb(vb, p.out, Y0, Y1, p.g_final, smem);
}

extern "C" void kernel_launch(void* const* d_in, const int* in_sizes, int n_in, void* d_out, int out_size, void* d_ws, size_t ws_size, hipStream_t stream) {
    static int grid = 0;
    constexpr int kDynLds = SMEM_BYTES + 16;
    if (!grid) {
        int dev = 0, cus = 0, per_cu = 0;
        (void)hipGetDevice(&dev);
        (void)hipDeviceGetAttribute(&cus, hipDeviceAttributeMultiprocessorCount, dev);
        (void)hipFuncSetAttribute((const void*)k_fwd, hipFuncAttributeMaxDynamicSharedMemorySize, kDynLds);
        (void)hipOccupancyMaxActiveBlocksPerMultiprocessor(&per_cu, k_fwd, 256, kDynLds);
        if (per_cu > 1) per_cu = 1;
        if (per_cu < 1) per_cu = 1;
        grid = cus * per_cu;
    }
    char* ws = (char*)d_ws;
    (void)hipMemsetAsync(ws + OFF_CTRL, 0, 4096, stream);
    (void)hipMemsetAsync(ws + OFF_SLOT_TOK, 0xFF, (size_t)MSLOT * 4, stream);
    (void)hipMemsetAsync(ws + OFF_BAR, 0, 16384, stream);
    Params p{};
    const float** pf = (const float**)&p;
    for (int i = 0; i < 25; ++i) pf[i] = (const float*)d_in[i];
    p.out = (float*)d_out; p.ws = ws;
    k_fwd<<<grid, 256, kDynLds, stream>>>(p);
}
```

```cpp
#include <hip/hip_runtime.h>
#include <stdint.h>

typedef unsigned short bf16_t;
typedef short bf16x8 __attribute__((ext_vector_type(8)));
typedef float f32x4 __attribute__((ext_vector_type(4)));
typedef unsigned u32x4 __attribute__((ext_vector_type(4)));
__device__ __forceinline__ float bf2f(bf16_t v) { return __uint_as_float(((unsigned)v) << 16); }
__device__ __forceinline__ bf16_t f2bf(float f) { unsigned u = __float_as_uint(f); u += 0x7FFFu + ((u >> 16) & 1u); return (bf16_t)(u >> 16); }
__device__ __forceinline__ unsigned pack_bf16(float lo, float hi) { unsigned r; asm volatile("v_cvt_pk_bf16_f32 %0, %1, %2" : "=v"(r) : "v"(lo), "v"(hi)); return r; }

constexpr int Bn = 4, S = 4096, T = Bn * S, D = 1024, NIN = 4904, PP = 2880;
constexpr int QA = 0, KC = 512, VC = 640, KS = 768, VS = 896, KW = 1024, VW = 1152, GA = 1280, QB = 1304, KB = 1560, VB = 1816, AB = 2328, RB = 2344, MGA = 2856, MGB = 3880;
constexpr int NPROJ = 2856;
constexpr int MSLOT = 36864;

constexpr size_t OFF_CTRL = 0;
constexpr size_t OFF_ROUTE_E = 4096;
constexpr size_t OFF_ROUTE_W = OFF_ROUTE_E + 32768 * 4;
constexpr size_t OFF_SLOT_TOK = OFF_ROUTE_W + 32768 * 4;
constexpr size_t OFF_SLOT_W = OFF_SLOT_TOK + (size_t)MSLOT * 4;
constexpr size_t OFF_BAR = OFF_SLOT_W + (size_t)MSLOT * 4;
constexpr size_t OFF_BIAS1 = OFF_BAR + 16384;
static_assert(OFF_BIAS1 + 1024 <= (1u << 20), "ctrl overflow");
constexpr size_t OFF_R1 = 1u << 20;
constexpr size_t SZ_PROJ = (size_t)T * PP * 2;
constexpr size_t OFF_PROJ = OFF_R1;
constexpr size_t OFF_BC = OFF_PROJ + SZ_PROJ;
constexpr size_t OFF_CSTATE = OFF_BC + (size_t)T * 256 * 4;
constexpr size_t OFF_R1_END = OFF_CSTATE + (size_t)1024 * 8192 * 4;
constexpr size_t OFF_SAB = OFF_R1;
constexpr size_t OFF_MRG = OFF_SAB + (size_t)T * 2048 * 2;
constexpr size_t OFF_H2 = OFF_R1;
constexpr size_t OFF_HID = OFF_H2 + (size_t)T * 1024 * 2;
constexpr size_t OFF_Y0 = OFF_HID + (size_t)MSLOT * 256 * 2;
constexpr size_t OFF_Y1 = OFF_Y0 + (size_t)T * 1024 * 2;
static_assert(OFF_MRG + (size_t)T * 1024 * 2 <= OFF_R1_END, "alias overflow");
static_assert(OFF_Y1 + (size_t)T * 1024 * 2 <= OFF_R1_END, "alias overflow");
constexpr size_t OFF_YA = OFF_R1_END;
constexpr size_t OFF_YB = OFF_YA + (size_t)T * 512 * 2;
constexpr size_t OFF_KCB = OFF_YB + (size_t)T * 512 * 2;
constexpr size_t OFF_VCB = OFF_KCB + 8 * 256 * 64 * 2;
constexpr size_t OFF_VCBT = OFF_VCB + 8 * 256 * 64 * 2;
constexpr size_t OFF_HIDC = OFF_VCBT + 8 * 256 * 64 * 2;
constexpr size_t OFF_VST = OFF_HIDC + 2 * 2048 * 128 * 2;
constexpr size_t OFF_VWT = OFF_VST + (size_t)8 * 64 * S * 2;
constexpr size_t OFF_WINT = OFF_VWT + (size_t)8 * 64 * S * 2;
constexpr size_t OFF_CK1T = OFF_WINT + (size_t)NIN * 1024 * 2;
constexpr size_t OFF_CV1T = OFF_CK1T + 128 * 2048 * 2;
constexpr size_t OFF_CK2T = OFF_CV1T + 128 * 2048 * 2;
constexpr size_t OFF_CV2T = OFF_CK2T + 128 * 128 * 2;
constexpr size_t OFF_WAT = OFF_CV2T + 128 * 128 * 2;
constexpr size_t OFF_WBT = OFF_WAT + 1024 * 512 * 2;
constexpr size_t OFF_WOT = OFF_WBT + 1024 * 512 * 2;
constexpr size_t OFF_WGT = OFF_WOT + 1024 * 1024 * 2;
constexpr size_t OFF_WUT = OFF_WGT + (size_t)32 * 256 * 1024 * 2;
constexpr size_t OFF_WDT = OFF_WUT + (size_t)32 * 256 * 1024 * 2;
constexpr size_t OFF_END = OFF_WDT + (size_t)32 * 1024 * 256 * 2;
static_assert(OFF_END <= (size_t)256 << 20, "workspace overflow");

#define XB_TMO      128
#define XB_XCNT(j)  (256  + 64 * (j))
#define XB_XSUB(j)  (1280 + 64 * (j))
#define XB_XGEN(j)  (2304 + 64 * (j))
#define XB_TOP      3328
#define XB_TOPGEN   3392
#define XCD_BAR_WORDS 3456
#define XB_SPIN_CAP (1u << 18)
#define LAS __attribute__((address_space(3)))

__device__ __forceinline__ unsigned xb_ld(unsigned* p)              { return __hip_atomic_load(p, __ATOMIC_RELAXED, __HIP_MEMORY_SCOPE_AGENT); }
__device__ __forceinline__ unsigned xb_add(unsigned* p, unsigned v) { return __hip_atomic_fetch_add(p, v, __ATOMIC_RELAXED, __HIP_MEMORY_SCOPE_AGENT); }
__device__ __forceinline__ unsigned xb_xcc_id() { return (unsigned)__builtin_amdgcn_s_getreg((3 << 11) | 20) & 0xFu; }
#define XB_SPIN(cond, bar) do { unsigned _sp = 0; while (cond) { __builtin_amdgcn_s_sleep(1); \
    if ((++_sp & 255u) == 0u) { if (xb_ld(&(bar)[XB_TMO])) break; if (_sp > XB_SPIN_CAP) { atomicAdd(&(bar)[XB_TMO], 1u); break; } } } } while (0)

struct XcdBarrier { unsigned* bar; unsigned x; volatile LAS unsigned* st; };

__device__ __forceinline__ XcdBarrier xcd_barrier_post(unsigned* bar, volatile LAS unsigned* st) {
    XcdBarrier b; b.bar = bar; b.x = xb_xcc_id(); b.st = st;
    if (threadIdx.x == 0) (void)xb_add(&bar[XB_XCNT(b.x)], 1u);
    return b;
}
__device__ __forceinline__ void xcd_barrier_complete(unsigned* bar, unsigned x, unsigned& nloc, unsigned& nx) {
    const unsigned G = gridDim.x * gridDim.y * gridDim.z;
    unsigned sum, cnt, mine, sp = 0u;
    for (;;) {
        sum = 0u; cnt = 0u; mine = 0u;
#pragma unroll
        for (unsigned j = 0; j < 16; ++j) { const unsigned c = xb_ld(&bar[XB_XCNT(j)]); sum += c; cnt += (c > 0u) ? 1u : 0u; mine = (j == x) ? c : mine; }
        if (sum == G) break;
        __builtin_amdgcn_s_sleep(1);
        if ((++sp & 255u) == 0u) { if (xb_ld(&bar[XB_TMO])) break; if (sp > XB_SPIN_CAP) { atomicAdd(&bar[XB_TMO], 1u); break; } }
    }
    nloc = mine > 0u ? mine : 1u; nx = cnt > 0u ? cnt : 1u;
}
__device__ __forceinline__ void xcd_barrier(const XcdBarrier& b) {
    asm volatile("s_waitcnt vmcnt(0)" ::: "memory");
    __syncthreads();
    if (threadIdx.x == 0) {
        unsigned* bar = b.bar;
        __builtin_amdgcn_s_waitcnt(0);
        unsigned nloc = b.st[0], nx = b.st[1];
        if (nloc == 0u) { xcd_barrier_complete(bar, b.x, nloc, nx); b.st[0] = nloc; b.st[1] = nx; }
        const unsigned old = xb_add(&bar[XB_XSUB(b.x)], 1u);
        const unsigned gen = old / nloc;
        if (old + 1u == (gen + 1u) * nloc) {
            __builtin_amdgcn_fence(__ATOMIC_RELEASE, "agent");
            asm volatile("s_waitcnt vmcnt(0)" ::: "memory");
            const unsigned og = xb_add(&bar[XB_TOP], 1u);
            const unsigned tg = og / nx;
            if (og + 1u == (tg + 1u) * nx) xb_add(&bar[XB_TOPGEN], 1u);
            else XB_SPIN(xb_ld(&bar[XB_TOPGEN]) == tg, bar);
            __builtin_amdgcn_fence(__ATOMIC_ACQUIRE, "agent");
            xb_add(&bar[XB_XGEN(b.x)], 1u);
            asm volatile("s_waitcnt vmcnt(0)" ::: "memory");
        } else {
            XB_SPIN(xb_ld(&bar[XB_XGEN(b.x)]) == gen, bar);
            __builtin_amdgcn_fence(__ATOMIC_ACQUIRE, "agent");
            asm volatile("s_waitcnt vmcnt(0)" ::: "memory");
        }
    }
    __syncthreads();
}


struct Params {
    const float *x, *g_mix, *w_in, *pe_k, *ck1, *ck2, *pe_v, *cv1, *cv2, *rel_bias, *w_alpha, *b_alpha, *norm_g, *w_ba, *w_bb, *w_out, *g_ffn,
                *w_rg, *b_rg, *w_re, *b_re, *w_eg, *w_eu, *w_ed, *g_final;
    float* out; char* ws;
};

__device__ __forceinline__ float wave_max(float v) { for (int o = 32; o > 0; o >>= 1) v = fmaxf(v, __shfl_xor(v, o)); return v; }
__device__ __forceinline__ float wave_sum(float v) { for (int o = 32; o > 0; o >>= 1) v += __shfl_xor(v, o); return v; }
__device__ __forceinline__ void wave_lds_sync() { asm volatile("s_waitcnt lgkmcnt(0)" ::: "memory"); }

__device__ __forceinline__ void ph_rms_h(int row, const float* __restrict__ x, const float* __restrict__ g, bf16_t* __restrict__ h, char* smem) {
    float* red = (float*)smem;
    float4 v = ((const float4*)(x + (size_t)row * D))[threadIdx.x];
    float s = v.x * v.x + v.y * v.y + v.z * v.z + v.w * v.w;
    s = wave_sum(s);
    if ((threadIdx.x & 63) == 0) red[threadIdx.x >> 6] = s;
    __syncthreads();
    s = red[0] + red[1] + red[2] + red[3];
    __syncthreads();
    const float r = rsqrtf(s * (1.0f / D) + 1e-6f);
    float4 gg = ((const float4*)g)[threadIdx.x];
    uint2 o; o.x = pack_bf16(v.x * r * gg.x, v.y * r * gg.y); o.y = pack_bf16(v.z * r * gg.z, v.w * r * gg.w);
    ((uint2*)(h + (size_t)row * D))[threadIdx.x] = o;
}

__device__ __forceinline__ void transpose_tile(const float* __restrict__ src, int ld_src, int N, bf16_t* __restrict__ dst, int ld_dst, int kt, int nt, char* smem) {
    float (*tl)[65] = (float (*)[65])smem;
    const int tid = threadIdx.x;
    const int c4 = (tid & 15) * 4, r0 = tid >> 4;
#pragma unroll
    for (int i = 0; i < 4; ++i) {
        const int k = r0 + 16 * i, n = nt * 64 + c4;
        float4 v = make_float4(0.f, 0.f, 0.f, 0.f);
        if (n < N) v = *(const float4*)(src + (size_t)(kt * 64 + k) * ld_src + n);
        tl[k][c4] = v.x; tl[k][c4 + 1] = v.y; tl[k][c4 + 2] = v.z; tl[k][c4 + 3] = v.w;
    }
    __syncthreads();
    const int kc = (tid & 7) * 8, n0 = tid >> 3;
#pragma unroll
    for (int i = 0; i < 2; ++i) {
        const int nl = n0 + 32 * i, n = nt * 64 + nl;
        if (n < N) {
            uint4 o;
            o.x = pack_bf16(tl[kc][nl], tl[kc + 1][nl]); o.y = pack_bf16(tl[kc + 2][nl], tl[kc + 3][nl]);
            o.z = pack_bf16(tl[kc + 4][nl], tl[kc + 5][nl]); o.w = pack_bf16(tl[kc + 6][nl], tl[kc + 7][nl]);
            *(uint4*)(dst + (size_t)n * ld_dst + kt * 64 + kc) = o;
        }
    }
    __syncthreads();
}

__device__ __forceinline__ void ph_prep(const Params& p, char* smem) {
    char* ws = p.ws;
    constexpr int N0 = 16 * 77, N1 = N0 + 64, N2 = N1 + 64, N3 = N2 + 2, N4 = N3 + 2, N5 = N4 + 128, N6 = N5 + 128, N7 = N6 + 256, N8 = N7 + 2048, N9 = N8 + 2048, N10 = N9 + 2048;
    for (int t = blockIdx.x; t < N10; t += gridDim.x) {
        if (t < N0) transpose_tile(p.w_in, NIN, NIN, (bf16_t*)(ws + OFF_WINT), 1024, t / 77, t % 77, smem);
        else if (t < N1) { const int q = t - N0; transpose_tile(p.ck1, 128, 128, (bf16_t*)(ws + OFF_CK1T), 2048, q >> 1, q & 1, smem); }
        else if (t < N2) { const int q = t - N1; transpose_tile(p.cv1, 128, 128, (bf16_t*)(ws + OFF_CV1T), 2048, q >> 1, q & 1, smem); }
        else if (t < N3) { const int q = t - N2; transpose_tile(p.ck2, 64, 64, (bf16_t*)(ws + OFF_CK2T), 128, q, 0, smem); }
        else if (t < N4) { const int q = t - N3; transpose_tile(p.cv2, 64, 64, (bf16_t*)(ws + OFF_CV2T), 128, q, 0, smem); }
        else if (t < N5) { const int q = t - N4; transpose_tile(p.w_ba, 1024, 1024, (bf16_t*)(ws + OFF_WAT), 512, q >> 4, q & 15, smem); }
        else if (t < N6) { const int q = t - N5; transpose_tile(p.w_bb, 1024, 1024, (bf16_t*)(ws + OFF_WBT), 512, q >> 4, q & 15, smem); }
        else if (t < N7) { const int q = t - N6; transpose_tile(p.w_out, 1024, 1024, (bf16_t*)(ws + OFF_WOT), 1024, q >> 4, q & 15, smem); }
        else if (t < N8) { const int q = t - N7, e = q >> 6, r = q & 63; transpose_tile(p.w_eg + (size_t)e * 1024 * 256, 256, 256, (bf16_t*)(ws + OFF_WGT) + (size_t)e * 256 * 1024, 1024, r >> 2, r & 3, smem); }
        else if (t < N9) { const int q = t - N8, e = q >> 6, r = q & 63; transpose_tile(p.w_eu + (size_t)e * 1024 * 256, 256, 256, (bf16_t*)(ws + OFF_WUT) + (size_t)e * 256 * 1024, 1024, r >> 2, r & 3, smem); }
        else { const int q = t - N9, e = q >> 6, r = q & 63; transpose_tile(p.w_ed + (size_t)e * 256 * 1024, 1024, 1024, (bf16_t*)(ws + OFF_WDT) + (size_t)e * 1024 * 256, 256, r >> 4, r & 15, smem); }
    }
    for (int t = blockIdx.x; t < 8; t += gridDim.x) {
        const int which = t >> 2, n = (t & 3) * 32 + (threadIdx.x & 31), ksp = threadIdx.x >> 5;
        const float* pe = which ? p.pe_v : p.pe_k; const float* w1 = which ? p.cv1 : p.ck1;
        float a = 0.f;
        for (int k = ksp * 256; k < ksp * 256 + 256; ++k) a += pe[k] * w1[(size_t)k * 128 + n];
        float* red = (float*)smem;
        red[threadIdx.x] = a;
        __syncthreads();
        if (threadIdx.x < 32) {
            float s = 0.f;
#pragma unroll
            for (int j = 0; j < 8; ++j) s += red[j * 32 + threadIdx.x];
            ((float*)(ws + OFF_BIAS1))[which * 128 + n] = s;
        }
        __syncthreads();
    }
    for (int vb = blockIdx.x; vb < T; vb += gridDim.x) ph_rms_h(vb, p.x, p.g_mix, (bf16_t*)p.out, smem);
}

__device__ __forceinline__ int tile_off(int row, int chunk) { return row * 128 + ((chunk ^ (row & 7)) << 4); }

__device__ __forceinline__ void gemm_kloop(f32x4 (&acc)[4][4], const bf16_t* const (&pa)[4], const bf16_t* const (&pb)[4], int ka, int kb, int nk, char* smem) {
    const int tid = threadIdx.x, lane = tid & 63, wid = tid >> 6, wr = wid >> 1, wc = wid & 1, fr = lane & 15, fq = lane >> 4;
    const int so = tile_off(tid >> 3, tid & 7);
    const int offA = (wr * 64 + fr) * 128, offB = 16384 + (wc * 64 + fr) * 128, x = fr & 7;
    u32x4 ra[4], rb[4];
#pragma unroll
    for (int i = 0; i < 4; ++i) { ra[i] = *(const u32x4*)pa[i]; rb[i] = *(const u32x4*)pb[i]; }
    __syncthreads();
#pragma unroll
    for (int i = 0; i < 4; ++i) { *(u32x4*)(smem + so + i * 4096) = ra[i]; *(u32x4*)(smem + 16384 + so + i * 4096) = rb[i]; }
    __syncthreads();
    for (int kt = 0; kt < nk; ++kt) {
        const int cur = kt & 1;
        if (kt + 1 < nk) {
#pragma unroll
            for (int i = 0; i < 4; ++i) { ra[i] = *(const u32x4*)(pa[i] + (size_t)(kt + 1) * ka); rb[i] = *(const u32x4*)(pb[i] + (size_t)(kt + 1) * kb); }
        }
        const char* sa = smem + cur * 32768 + offA;
        const char* sb = smem + cur * 32768 + offB;
#pragma unroll
        for (int ks = 0; ks < 2; ++ks) {
            const int ch = ((ks * 4 + fq) ^ x) << 4;
            bf16x8 af[4], bfr[4];
#pragma unroll
            for (int mi = 0; mi < 4; ++mi) af[mi] = *(const bf16x8*)(sa + mi * 2048 + ch);
#pragma unroll
            for (int ni = 0; ni < 4; ++ni) bfr[ni] = *(const bf16x8*)(sb + ni * 2048 + ch);
#pragma unroll
            for (int mi = 0; mi < 4; ++mi)
#pragma unroll
                for (int ni = 0; ni < 4; ++ni) acc[mi][ni] = __builtin_amdgcn_mfma_f32_16x16x32_bf16(bfr[ni], af[mi], acc[mi][ni], 0, 0, 0);
        }
        if (kt + 1 < nk) {
            char* st = smem + (cur ^ 1) * 32768 + so;
#pragma unroll
            for (int i = 0; i < 4; ++i) { *(u32x4*)(st + i * 4096) = ra[i]; *(u32x4*)(st + 16384 + i * 4096) = rb[i]; }
        }
        __syncthreads();
    }
}
__device__ __forceinline__ void acc_zero(f32x4 (&acc)[4][4]) {
#pragma unroll
    for (int mi = 0; mi < 4; ++mi)
#pragma unroll
        for (int ni = 0; ni < 4; ++ni) acc[mi][ni] = (f32x4){0.f, 0.f, 0.f, 0.f};
}
#define GEMM_LANE_VARS const int tid = threadIdx.x, lane = tid & 63, wid = tid >> 6, wr = wid >> 1, wc = wid & 1, fr = lane & 15, fq = lane >> 4, lrow = tid >> 3, lch8 = (tid & 7) * 8; (void)wr; (void)wc; (void)fr; (void)fq; (void)lrow; (void)lch8;
__device__ __forceinline__ uint2 pack4(f32x4 v) { uint2 o; o.x = pack_bf16(v[0], v[1]); o.y = pack_bf16(v[2], v[3]); return o; }
__device__ __forceinline__ float sigmoidf_(float a) { return 1.f / (1.f + __expf(-a)); }

__device__ __forceinline__ void ph_proj(const bf16_t* __restrict__ h, const bf16_t* __restrict__ WinT, bf16_t* __restrict__ proj, char* smem) {
    GEMM_LANE_VARS
    for (int u = blockIdx.x; u < 128 * 23; u += gridDim.x) {
        const int xg = u & 7, v = u >> 3, tn = v % 23, tm = (v / 23) * 8 + xg;
        const bf16_t* pa[4]; const bf16_t* pb[4];
#pragma unroll
        for (int i = 0; i < 4; ++i) { pa[i] = h + (size_t)(tm * 128 + lrow + 32 * i) * 1024 + lch8; pb[i] = WinT + (size_t)(tn * 128 + lrow + 32 * i) * 1024 + lch8; }
        f32x4 acc[4][4]; acc_zero(acc);
        gemm_kloop(acc, pa, pb, 64, 64, 16, smem);
#pragma unroll
        for (int mi = 0; mi < 4; ++mi)
#pragma unroll
            for (int ni = 0; ni < 4; ++ni) {
                const int m = tm * 128 + wr * 64 + mi * 16 + fr, n = tn * 128 + wc * 64 + ni * 16 + 4 * fq;
                if (n < NPROJ) *(uint2*)(proj + (size_t)m * PP + n) = pack4(acc[mi][ni]);
            }
    }
}

__device__ __forceinline__ void ph_cmp1(const bf16_t* __restrict__ proj, const char* ws, char* smem) {
    GEMM_LANE_VARS
    for (int u = blockIdx.x; u < 32; u += gridDim.x) {
        const int which = u >> 4, tm = u & 15;
        const bf16_t* W1T = (const bf16_t*)(ws + (which ? OFF_CV1T : OFF_CK1T));
        const float* bias1 = (const float*)(ws + OFF_BIAS1) + which * 128;
        bf16_t* hid = (bf16_t*)(ws + OFF_HIDC) + (size_t)which * 2048 * 128;
        const int col0 = which ? VC : KC;
        const bf16_t* pa[4]; const bf16_t* pb[4];
#pragma unroll
        for (int i = 0; i < 4; ++i) {
            const int m = tm * 128 + lrow + 32 * i, bg = m >> 8, c = (m & 255) > 254 ? 254 : (m & 255), b = bg >> 1, g = bg & 1;
            pa[i] = proj + (size_t)(b * S + 16 * c) * PP + col0 + g * 64 + lch8;
            pb[i] = W1T + (size_t)(lrow + 32 * i) * 2048 + lch8;
        }
        f32x4 acc[4][4]; acc_zero(acc);
        gemm_kloop(acc, pa, pb, PP, 64, 32, smem);
#pragma unroll
        for (int mi = 0; mi < 4; ++mi)
#pragma unroll
            for (int ni = 0; ni < 4; ++ni) {
                const int m = tm * 128 + wr * 64 + mi * 16 + fr, n = wc * 64 + ni * 16 + 4 * fq;
                f32x4 v = acc[mi][ni];
#pragma unroll
                for (int j = 0; j < 4; ++j) { const float a = v[j] + bias1[n + j]; const float t = 0.7978845608028654f * (a + 0.044715f * a * a * a); v[j] = 0.5f * a * (1.f + tanhf(t)); }
                *(uint2*)(hid + (size_t)m * 128 + n) = pack4(v);
            }
    }
}

__device__ __forceinline__ void ph_cmp2(const char* ws_c, char* ws, char* smem) {
    GEMM_LANE_VARS
    for (int u = blockIdx.x; u < 32; u += gridDim.x) {
        const int which = u >> 4, tm = u & 15;
        const bf16_t* W2T = (const bf16_t*)(ws_c + (which ? OFF_CV2T : OFF_CK2T));
        const bf16_t* hid = (const bf16_t*)(ws_c + OFF_HIDC) + (size_t)which * 2048 * 128;
        const bf16_t* pa[4]; const bf16_t* pb[4];
#pragma unroll
        for (int i = 0; i < 4; ++i) { pa[i] = hid + (size_t)(tm * 128 + lrow + 32 * i) * 128 + lch8; pb[i] = W2T + (size_t)(lrow + 32 * i) * 128 + lch8; }
        f32x4 acc[4][4]; acc_zero(acc);
        gemm_kloop(acc, pa, pb, 64, 64, 2, smem);
        if (wc == 0) {
            bf16_t* outp = (bf16_t*)(ws + (which ? OFF_VCB : OFF_KCB));
            bf16_t* outT = (bf16_t*)(ws + OFF_VCBT);
#pragma unroll
            for (int mi = 0; mi < 4; ++mi)
#pragma unroll
                for (int ni = 0; ni < 4; ++ni) {
                    const int m = tm * 128 + wr * 64 + mi * 16 + fr, n = ni * 16 + 4 * fq, c = m & 255, bg = m >> 8;
                    f32x4 v = acc[mi][ni];
                    if (c == 255) v = (f32x4){0.f, 0.f, 0.f, 0.f};
                    *(uint2*)(outp + (size_t)m * 64 + n) = pack4(v);
                    if (which) {
#pragma unroll
                        for (int j = 0; j < 4; ++j) outT[((size_t)bg * 64 + n + j) * 256 + c] = f2bf(v[j]);
                    }
                }
        }
    }
}

__device__ __forceinline__ void ph_gates(const bf16_t* __restrict__ h, const bf16_t* __restrict__ WinT, bf16_t* __restrict__ SAB, char* smem) {
    GEMM_LANE_VARS
    for (int u = blockIdx.x; u < 128 * 16; u += gridDim.x) {
        const int xg = u & 7, v = u >> 3, tn = v & 15, tm = (v >> 4) * 8 + xg;
        const bf16_t* pa[4]; const bf16_t* pb[4];
#pragma unroll
        for (int i = 0; i < 4; ++i) { pa[i] = h + (size_t)(tm * 128 + lrow + 32 * i) * 1024 + lch8; pb[i] = WinT + (size_t)(MGA + tn * 128 + lrow + 32 * i) * 1024 + lch8; }
        f32x4 acc[4][4]; acc_zero(acc);
        gemm_kloop(acc, pa, pb, 64, 64, 16, smem);
#pragma unroll
        for (int mi = 0; mi < 4; ++mi)
#pragma unroll
            for (int ni = 0; ni < 4; ++ni) {
                const int m = tm * 128 + wr * 64 + mi * 16 + fr, n = tn * 128 + wc * 64 + ni * 16 + 4 * fq;
                f32x4 v = acc[mi][ni];
#pragma unroll
                for (int j = 0; j < 4; ++j) v[j] = sigmoidf_(v[j]);
                *(uint2*)(SAB + (size_t)m * 2048 + n) = pack4(v);
            }
    }
}

__device__ __forceinline__ void ph_merge(const bf16_t* __restrict__ ya, const bf16_t* __restrict__ yb, const bf16_t* __restrict__ WaT, const bf16_t* __restrict__ WbT,
                                         const bf16_t* __restrict__ SAB, bf16_t* __restrict__ mrg, char* smem) {
    GEMM_LANE_VARS
    for (int u = blockIdx.x; u < 128 * 8; u += gridDim.x) {
        const int xg = u & 7, v = u >> 3, tn = v & 7, tm = (v >> 3) * 8 + xg;
        const bf16_t* pa[4]; const bf16_t* pb[4];
#pragma unroll
        for (int i = 0; i < 4; ++i) { pa[i] = ya + (size_t)(tm * 128 + lrow + 32 * i) * 512 + lch8; pb[i] = WaT + (size_t)(tn * 128 + lrow + 32 * i) * 512 + lch8; }
        f32x4 acc1[4][4]; acc_zero(acc1);
        gemm_kloop(acc1, pa, pb, 64, 64, 8, smem);
#pragma unroll
        for (int i = 0; i < 4; ++i) { pa[i] = yb + (size_t)(tm * 128 + lrow + 32 * i) * 512 + lch8; pb[i] = WbT + (size_t)(tn * 128 + lrow + 32 * i) * 512 + lch8; }
        f32x4 acc2[4][4]; acc_zero(acc2);
        gemm_kloop(acc2, pa, pb, 64, 64, 8, smem);
#pragma unroll
        for (int mi = 0; mi < 4; ++mi)
#pragma unroll
            for (int ni = 0; ni < 4; ++ni) {
                const int m = tm * 128 + wr * 64 + mi * 16 + fr, n = tn * 128 + wc * 64 + ni * 16 + 4 * fq;
                const uint2 sa = *(const uint2*)(SAB + (size_t)m * 2048 + n), sb = *(const uint2*)(SAB + (size_t)m * 2048 + 1024 + n);
                f32x4 v;
                v[0] = __uint_as_float(sa.x << 16) * acc1[mi][ni][0] + __uint_as_float(sb.x << 16) * acc2[mi][ni][0];
                v[1] = __uint_as_float(sa.x & 0xFFFF0000u) * acc1[mi][ni][1] + __uint_as_float(sb.x & 0xFFFF0000u) * acc2[mi][ni][1];
                v[2] = __uint_as_float(sa.y << 16) * acc1[mi][ni][2] + __uint_as_float(sb.y << 16) * acc2[mi][ni][2];
                v[3] = __uint_as_float(sa.y & 0xFFFF0000u) * acc1[mi][ni][3] + __uint_as_float(sb.y & 0xFFFF0000u) * acc2[mi][ni][3];
                *(uint2*)(mrg + (size_t)m * 1024 + n) = pack4(v);
            }
    }
}

__device__ __forceinline__ void ph_outproj(const bf16_t* __restrict__ mrg, const bf16_t* __restrict__ WoT, const float* __restrict__ x, float* __restrict__ x2, char* smem) {
    GEMM_LANE_VARS
    for (int u = blockIdx.x; u < 128 * 8; u += gridDim.x) {
        const int xg = u & 7, v = u >> 3, tn = v & 7, tm = (v >> 3) * 8 + xg;
        const bf16_t* pa[4]; const bf16_t* pb[4];
#pragma unroll
        for (int i = 0; i < 4; ++i) { pa[i] = mrg + (size_t)(tm * 128 + lrow + 32 * i) * 1024 + lch8; pb[i] = WoT + (size_t)(tn * 128 + lrow + 32 * i) * 1024 + lch8; }
        f32x4 acc[4][4]; acc_zero(acc);
        gemm_kloop(acc, pa, pb, 64, 64, 16, smem);
#pragma unroll
        for (int mi = 0; mi < 4; ++mi)
#pragma unroll
            for (int ni = 0; ni < 4; ++ni) {
                const int m = tm * 128 + wr * 64 + mi * 16 + fr, n = tn * 128 + wc * 64 + ni * 16 + 4 * fq;
                const float4 xv = *(const float4*)(x + (size_t)m * 1024 + n);
                *(float4*)(x2 + (size_t)m * 1024 + n) = make_float4(xv.x + acc[mi][ni][0], xv.y + acc[mi][ni][1], xv.z + acc[mi][ni][2], xv.w + acc[mi][ni][3]);
            }
    }
}

__device__ __forceinline__ int moe_expert_of(const int* __restrict__ cnt, int m0, int& total) {
    int e = 0, acc = 0;
    for (int i = 0; i < 32; ++i) { const int nacc = acc + ((cnt[i] + 127) & ~127); if (m0 >= acc && m0 < nacc) e = i; acc = nacc; }
    total = acc; return e;
}

__device__ __forceinline__ void ph_moe1(const bf16_t* __restrict__ h2, const bf16_t* __restrict__ WgT, const bf16_t* __restrict__ WuT, const int* __restrict__ cnt,
                                        const int* __restrict__ slot_tok, const float* __restrict__ slot_w, bf16_t* __restrict__ hid, char* smem) {
    GEMM_LANE_VARS
    int total; (void)moe_expert_of(cnt, 0, total);
    const int nu = (total >> 7) * 4;
    for (int u = blockIdx.x; u < nu; u += gridDim.x) {
        const int ft = u & 3, tm = u >> 2; int tt;
        const int e = moe_expert_of(cnt, tm * 128, tt);
        const bf16_t* pa[4]; const bf16_t* pb[4];
#pragma unroll
        for (int i = 0; i < 4; ++i) {
            const int rr = lrow + 32 * i;
            const int tk = slot_tok[tm * 128 + rr];
            pa[i] = h2 + (size_t)(tk >= 0 ? (tk >> 1) : 0) * 1024 + lch8;
            const int bwc = rr >> 6, bni = (rr >> 4) & 3, bj = rr & 15;
            const int f = ft * 64 + bwc * 32 + (bni >> 1) * 16 + bj;
            pb[i] = ((bni & 1) ? WuT : WgT) + ((size_t)e * 256 + f) * 1024 + lch8;
        }
        f32x4 acc[4][4]; acc_zero(acc);
        gemm_kloop(acc, pa, pb, 64, 64, 16, smem);
#pragma unroll
        for (int mi = 0; mi < 4; ++mi) {
            const int m = tm * 128 + wr * 64 + mi * 16 + fr;
            const float w = slot_tok[m] >= 0 ? slot_w[m] : 0.f;
#pragma unroll
            for (int q = 0; q < 2; ++q) {
                const int f = ft * 64 + wc * 32 + q * 16 + 4 * fq;
                f32x4 v;
#pragma unroll
                for (int j = 0; j < 4; ++j) { const float a = acc[mi][2 * q][j], uu = acc[mi][2 * q + 1][j]; v[j] = a * sigmoidf_(a) * uu * w; }
                *(uint2*)(hid + (size_t)m * 256 + f) = pack4(v);
            }
        }
    }
}

__device__ __forceinline__ void ph_moe2(const bf16_t* __restrict__ hid, const bf16_t* __restrict__ WdT, const int* __restrict__ cnt, const int* __restrict__ slot_tok,
                                        bf16_t* __restrict__ Y, char* smem) {
    GEMM_LANE_VARS
    int total; (void)moe_expert_of(cnt, 0, total);
    const int nu = (total >> 7) * 8;
    for (int u = blockIdx.x; u < nu; u += gridDim.x) {
        const int tn = u & 7, tm = u >> 3; int tt;
        const int e = moe_expert_of(cnt, tm * 128, tt);
        const bf16_t* pa[4]; const bf16_t* pb[4];
#pragma unroll
        for (int i = 0; i < 4; ++i) { pa[i] = hid + (size_t)(tm * 128 + lrow + 32 * i) * 256 + lch8; pb[i] = WdT + ((size_t)e * 1024 + tn * 128 + lrow + 32 * i) * 256 + lch8; }
        f32x4 acc[4][4]; acc_zero(acc);
        gemm_kloop(acc, pa, pb, 64, 64, 4, smem);
#pragma unroll
        for (int mi = 0; mi < 4; ++mi) {
            const int m = tm * 128 + wr * 64 + mi * 16 + fr;
            const int tk = slot_tok[m];
            if (tk >= 0) {
                bf16_t* yr = Y + ((size_t)(tk & 1) * T + (size_t)(tk >> 1)) * 1024 + tn * 128 + wc * 64 + 4 * fq;
#pragma unroll
                for (int ni = 0; ni < 4; ++ni) *(uint2*)(yr + ni * 16) = pack4(acc[mi][ni]);
            }
        }
    }
}

constexpr float LOG2E = 1.4426950408889634f;
constexpr float NEGV = -3.0e38f;
constexpr int NSA_TB = 32768;
constexpr int NSA_IMPA = 34816;
constexpr int NSA_IMPB = NSA_IMPA + 8448;
constexpr int NSA_SELM = NSA_IMPB + 8448;

__device__ __forceinline__ int t5_bucket2(int n) {
    if (n < 16) return n;
    const int l = 16 + (int)(logf((float)n / 16.0f) / logf(8.0f) * 16.0f);
    return l < 31 ? l : 31;
}

template <int MODE>
__device__ __forceinline__ void nsa_branch(const bf16_t* __restrict__ Kb, size_t kstride, const bf16_t* __restrict__ Vb, size_t vstride, int j0, int ntiles, int t0,
                                           const bf16x8 (&qf)[2][2], const int (&qidx)[2], const unsigned long long (&selq)[2], unsigned long long selor,
                                           f32x4 (&O)[4][2], float (&m)[2], float (&l)[2], const float (&invl)[2], char* smem) {
    const int tid = threadIdx.x, lane = tid & 63, wid = tid >> 6, fr = lane & 15, fq = lane >> 4, hp = fr & 3;
    const int lrow = tid >> 3, lch8 = (tid & 7) * 8;
    const int so = tile_off(lrow, tid & 7);
    const float* tbias = (const float*)(smem + NSA_TB) + hp * 128;
    const bf16_t* kp[2]; const bf16_t* vp[2];
#pragma unroll
    for (int i = 0; i < 2; ++i) { kp[i] = Kb + (size_t)(lrow + 32 * i) * kstride + lch8; vp[i] = Vb + (size_t)(lrow + 32 * i) * vstride + lch8; }
    u32x4 rk[2], rv[2];
#pragma unroll
    for (int i = 0; i < 2; ++i) { rk[i] = *(const u32x4*)kp[i]; if (MODE != 3) rv[i] = *(const u32x4*)vp[i]; }
    __syncthreads();
#pragma unroll
    for (int i = 0; i < 2; ++i) { *(u32x4*)(smem + so + i * 4096) = rk[i]; if (MODE != 3) *(u32x4*)(smem + 8192 + so + i * 4096) = rv[i]; }
    __syncthreads();
    for (int it = 0; it < ntiles; ++it) {
        const int cur = it & 1, j = j0 + it;
        if (it + 1 < ntiles) {
#pragma unroll
            for (int i = 0; i < 2; ++i) { rk[i] = *(const u32x4*)(kp[i] + (size_t)(it + 1) * 64 * kstride); if (MODE != 3) rv[i] = *(const u32x4*)(vp[i] + (size_t)(it + 1) * 64); }
        }
        const char* Kst = smem + cur * 16384;
        const char* Vst = Kst + 8192;
        bool active = true;
        if (MODE == 1) active = ((selor >> j) & 1ull) != 0ull;
        if (active) {
            f32x4 sacc[2][2][2];
#pragma unroll
            for (int p = 0; p < 2; ++p)
#pragma unroll
                for (int s = 0; s < 2; ++s) {
                    const int row = 32 * p + 8 * (fr >> 2) + 4 * s + (fr & 3);
                    const bf16x8 k0 = *(const bf16x8*)(Kst + tile_off(row, fq)), k1 = *(const bf16x8*)(Kst + tile_off(row, 4 + fq));
#pragma unroll
                    for (int ct = 0; ct < 2; ++ct) {
                        f32x4 a = (f32x4){0.f, 0.f, 0.f, 0.f};
                        a = __builtin_amdgcn_mfma_f32_16x16x32_bf16(k0, qf[ct][0], a, 0, 0, 0);
                        a = __builtin_amdgcn_mfma_f32_16x16x32_bf16(k1, qf[ct][1], a, 0, 0, 0);
                        sacc[p][s][ct] = a;
                    }
                }
            bf16x8 pf[2][2];
#pragma unroll
            for (int ct = 0; ct < 2; ++ct) {
                const int q = qidx[ct];
                const bool sel = (MODE == 1) ? (((selq[ct] >> j) & 1ull) != 0ull) : true;
                float mloc = NEGV;
#pragma unroll
                for (int p = 0; p < 2; ++p)
#pragma unroll
                    for (int s = 0; s < 2; ++s)
#pragma unroll
                        for (int i = 0; i < 4; ++i) {
                            const int kk = 64 * j + 32 * p + 8 * fq + 4 * s + i;
                            int rel; bool valid;
                            if (MODE == 0 || MODE == 3) { rel = q - (16 * kk + 31); valid = rel >= 0; }
                            else if (MODE == 1) { rel = q - kk; valid = (rel >= 0) && sel; }
                            else { rel = q - kk; valid = (rel >= 0) && (rel < 512); }
                            const int rc = rel < 0 ? 0 : (rel > 127 ? 127 : rel);
                            const float sv = valid ? sacc[p][s][ct][i] * (0.125f * LOG2E) + tbias[rc] : NEGV;
                            sacc[p][s][ct][i] = sv;
                            mloc = fmaxf(mloc, sv);
                        }
                if (MODE != 3) {
                    mloc = fmaxf(mloc, __shfl_xor(mloc, 16)); mloc = fmaxf(mloc, __shfl_xor(mloc, 32));
                    const float mnew = fmaxf(m[ct], mloc);
                    const float alpha = __builtin_amdgcn_exp2f(m[ct] - mnew);
                    m[ct] = mnew;
                    float psum = 0.f;
#pragma unroll
                    for (int p = 0; p < 2; ++p) {
                        float pv[8];
#pragma unroll
                        for (int s = 0; s < 2; ++s)
#pragma unroll
                            for (int i = 0; i < 4; ++i) { pv[s * 4 + i] = __builtin_amdgcn_exp2f(sacc[p][s][ct][i] - mnew); psum += pv[s * 4 + i]; }
                        u32x4 w; w[0] = pack_bf16(pv[0], pv[1]); w[1] = pack_bf16(pv[2], pv[3]); w[2] = pack_bf16(pv[4], pv[5]); w[3] = pack_bf16(pv[6], pv[7]);
                        pf[ct][p] = __builtin_bit_cast(bf16x8, w);
                    }
                    l[ct] = l[ct] * alpha + psum;
#pragma unroll
                    for (int dt = 0; dt < 4; ++dt) O[dt][ct] = O[dt][ct] * alpha;
                } else {
                    float* impA = (float*)(smem + NSA_IMPA); float* impB = (float*)(smem + NSA_IMPB);
                    const int ql = wid * 8 + ct * 4 + (fr >> 2);
#pragma unroll
                    for (int p = 0; p < 2; ++p)
#pragma unroll
                        for (int s = 0; s < 2; ++s) {
                            float p3 = __builtin_amdgcn_exp2f(sacc[p][s][ct][3] - m[ct]) * invl[ct];
                            float pa = __builtin_amdgcn_exp2f(sacc[p][s][ct][0] - m[ct]) * invl[ct] + __builtin_amdgcn_exp2f(sacc[p][s][ct][1] - m[ct]) * invl[ct]
                                     + __builtin_amdgcn_exp2f(sacc[p][s][ct][2] - m[ct]) * invl[ct] + p3;
                            pa += __shfl_xor(pa, 1); pa += __shfl_xor(pa, 2);
                            p3 += __shfl_xor(p3, 1); p3 += __shfl_xor(p3, 2);
                            const int jj = 16 * j + 8 * p + 2 * fq + s;
                            if (hp == 0) { impA[ql * 65 + jj] = pa; impB[ql * 65 + jj + 1] = p3; }
                        }
                }
            }
            if (MODE != 3) {
#pragma unroll
                for (int dt = 0; dt < 4; ++dt)
#pragma unroll
                    for (int p = 0; p < 2; ++p) {
                        const bf16x8 vf = *(const bf16x8*)(Vst + tile_off(dt * 16 + fr, p * 4 + fq));
#pragma unroll
                        for (int ct = 0; ct < 2; ++ct) O[dt][ct] = __builtin_amdgcn_mfma_f32_16x16x32_bf16(vf, pf[ct][p], O[dt][ct], 0, 0, 0);
                    }
            }
        }
        if (it + 1 < ntiles) {
            char* st = smem + (cur ^ 1) * 16384 + so;
#pragma unroll
            for (int i = 0; i < 2; ++i) { *(u32x4*)(st + i * 4096) = rk[i]; if (MODE != 3) *(u32x4*)(st + 8192 + i * 4096) = rv[i]; }
        }
        __syncthreads();
    }
}

__device__ __forceinline__ void osum_add(uint2& acc, f32x4 o, float sc) {
    f32x4 v;
    v[0] = __uint_as_float(acc.x << 16) + o[0] * sc; v[1] = __uint_as_float(acc.x & 0xFFFF0000u) + o[1] * sc;
    v[2] = __uint_as_float(acc.y << 16) + o[2] * sc; v[3] = __uint_as_float(acc.y & 0xFFFF0000u) + o[3] * sc;
    acc = pack4(v);
}
__device__ __forceinline__ float nsa_gate(const bf16_t* __restrict__ pb, int q, int br, int head) { return sigmoidf_(bf2f(pb[(size_t)q * PP + GA + br * 8 + head])); }

__device__ __forceinline__ void nsa_unit(int u, const bf16_t* __restrict__ proj, const char* __restrict__ ws, const float* __restrict__ rel_bias, bf16_t* __restrict__ ya, char* smem) {
    const int tid = threadIdx.x, lane = tid & 63, wid = tid >> 6, fr = lane & 15, fq = lane >> 4, hp = fr & 3;
    const int bg = u & 7, qt = 127 - (u >> 3), b = bg >> 1, g = bg & 1, t0 = qt * 32, tb = t0 >> 6;
    const bf16_t* kcb = (const bf16_t*)(ws + OFF_KCB) + (size_t)bg * 256 * 64;
    const bf16_t* vcbT = (const bf16_t*)(ws + OFF_VCBT) + (size_t)bg * 64 * 256;
    const bf16_t* VsT = (const bf16_t*)(ws + OFF_VST) + (size_t)bg * 64 * S;
    const bf16_t* VwT = (const bf16_t*)(ws + OFF_VWT) + (size_t)bg * 64 * S;
    const bf16_t* pb = proj + (size_t)b * S * PP;
    __syncthreads();
    {
        float* tbl = (float*)(smem + NSA_TB);
        for (int e = tid; e < 512; e += 256) { const int h4 = e >> 7, n = e & 127; tbl[e] = rel_bias[t5_bucket2(n) * 8 + g * 4 + h4] * LOG2E; }
        float* imp = (float*)(smem + NSA_IMPA);
        for (int e = tid; e < 2 * 32 * 66; e += 256) if (e < 4224) imp[e] = 0.f;
    }
    int qidx[2]; bf16x8 qf[2][2];
    const int head = g * 4 + hp;
#pragma unroll
    for (int ct = 0; ct < 2; ++ct) {
        qidx[ct] = t0 + wid * 8 + ct * 4 + (fr >> 2);
        const bf16_t* qr = pb + (size_t)qidx[ct] * PP;
        qf[ct][0] = *(const bf16x8*)(qr + QA + head * 64 + fq * 8);
        qf[ct][1] = *(const bf16x8*)(qr + QA + head * 64 + 32 + fq * 8);
    }
    uint2 osum[4][2];
#pragma unroll
    for (int dt = 0; dt < 4; ++dt)
#pragma unroll
        for (int ct = 0; ct < 2; ++ct) osum[dt][ct] = make_uint2(0u, 0u);
    unsigned long long selq[2] = {0ull, 0ull};
    float invl0[2] = {0.f, 0.f};
    const int ntc = ((t0 >> 4) + 1 + 63) >> 6;
    float mC[2], invC[2];
    {
        f32x4 O[4][2]; float m[2] = {-1e30f, -1e30f}, l[2] = {0.f, 0.f};
#pragma unroll
        for (int dt = 0; dt < 4; ++dt)
#pragma unroll
            for (int ct = 0; ct < 2; ++ct) O[dt][ct] = (f32x4){0.f, 0.f, 0.f, 0.f};
        nsa_branch<0>(kcb, 64, vcbT, 256, 0, ntc, t0, qf, qidx, selq, 0ull, O, m, l, invl0, smem);
#pragma unroll
        for (int ct = 0; ct < 2; ++ct) {
            float lt = l[ct]; lt += __shfl_xor(lt, 16); lt += __shfl_xor(lt, 32);
            invC[ct] = lt > 0.f ? 1.f / lt : 0.f; mC[ct] = m[ct];
#pragma unroll
            for (int dt = 0; dt < 4; ++dt) osum_add(osum[dt][ct], O[dt][ct], nsa_gate(pb, qidx[ct], 0, head) * invC[ct]);
        }
        nsa_branch<3>(kcb, 64, vcbT, 256, 0, ntc, t0, qf, qidx, selq, 0ull, O, mC, l, invC, smem);
    }
    {
        const float* impA = (const float*)(smem + NSA_IMPA); const float* impB = (const float*)(smem + NSA_IMPB);
        unsigned long long* selm = (unsigned long long*)(smem + NSA_SELM);
#pragma unroll 1
        for (int qq = 0; qq < 8; ++qq) {
            const int ql = wid * 8 + qq;
            const float val = impA[ql * 65 + lane] + impB[ql * 65 + lane];
            const bool forced = (lane == 0) || (lane == tb) || (lane == tb - 1);
            unsigned key = forced ? 0xFFFFFFC0u : (lane > tb ? 0u : (__float_as_uint(val) & 0xFFFFFFC0u));
            key |= (unsigned)(63 - lane);
            int rank = 0;
#pragma unroll
            for (int jp = 0; jp < 64; ++jp) rank += ((unsigned)__builtin_amdgcn_readlane((int)key, jp) > key) ? 1 : 0;
            const unsigned long long msk = __ballot(rank < 16);
            if (lane == 0) selm[ql] = msk;
        }
        wave_lds_sync();
        unsigned long long selor = 0ull;
#pragma unroll
        for (int qq = 0; qq < 8; ++qq) selor |= selm[wid * 8 + qq];
        selq[0] = selm[wid * 8 + (fr >> 2)]; selq[1] = selm[wid * 8 + 4 + (fr >> 2)];
        {
            f32x4 O[4][2]; float m[2] = {-1e30f, -1e30f}, l[2] = {0.f, 0.f};
#pragma unroll
            for (int dt = 0; dt < 4; ++dt)
#pragma unroll
                for (int ct = 0; ct < 2; ++ct) O[dt][ct] = (f32x4){0.f, 0.f, 0.f, 0.f};
            nsa_branch<1>(pb + KS + g * 64, PP, VsT, S, 0, tb + 1, t0, qf, qidx, selq, selor, O, m, l, invl0, smem);
#pragma unroll
            for (int ct = 0; ct < 2; ++ct) {
                float lt = l[ct]; lt += __shfl_xor(lt, 16); lt += __shfl_xor(lt, 32);
                const float inv = lt > 0.f ? 1.f / lt : 0.f;
#pragma unroll
                for (int dt = 0; dt < 4; ++dt) osum_add(osum[dt][ct], O[dt][ct], nsa_gate(pb, qidx[ct], 1, head) * inv);
            }
        }
    }
    {
        f32x4 O[4][2]; float m[2] = {-1e30f, -1e30f}, l[2] = {0.f, 0.f};
#pragma unroll
        for (int dt = 0; dt < 4; ++dt)
#pragma unroll
            for (int ct = 0; ct < 2; ++ct) O[dt][ct] = (f32x4){0.f, 0.f, 0.f, 0.f};
        const int jw0 = (t0 - 511 < 0 ? 0 : t0 - 511) >> 6;
        nsa_branch<2>(pb + (size_t)jw0 * 64 * PP + KW + g * 64, PP, VwT + jw0 * 64, S, jw0, tb - jw0 + 1, t0, qf, qidx, selq, 0ull, O, m, l, invl0, smem);
#pragma unroll
        for (int ct = 0; ct < 2; ++ct) {
            float lt = l[ct]; lt += __shfl_xor(lt, 16); lt += __shfl_xor(lt, 32);
            const float inv = lt > 0.f ? 1.f / lt : 0.f;
#pragma unroll
            for (int dt = 0; dt < 4; ++dt) osum_add(osum[dt][ct], O[dt][ct], nsa_gate(pb, qidx[ct], 2, head) * inv);
        }
    }
#pragma unroll
    for (int ct = 0; ct < 2; ++ct) {
        bf16_t* yr = ya + (size_t)(b * S + qidx[ct]) * 512 + head * 64 + 4 * fq;
#pragma unroll
        for (int dt = 0; dt < 4; ++dt) *(uint2*)(yr + dt * 16) = osum[dt][ct];
    }
}

__device__ __forceinline__ void vtrans_tile(int task, const bf16_t* __restrict__ proj, char* ws, char* smem) {
    unsigned short (*tl)[66] = (unsigned short (*)[66])smem;
    const int tid = threadIdx.x, which = task >> 9, bg = (task >> 6) & 7, tt = task & 63, b = bg >> 1, g = bg & 1;
    const int r = tid >> 2, q4 = tid & 3;
    const bf16_t* src = proj + (size_t)(b * S + tt * 64 + r) * PP + (which ? VW : VS) + g * 64 + q4 * 16;
    const uint4 a0 = *(const uint4*)src, a1 = *(const uint4*)(src + 8);
    unsigned* trow = (unsigned*)&tl[r][q4 * 16];
    trow[0] = a0.x; trow[1] = a0.y; trow[2] = a0.z; trow[3] = a0.w; trow[4] = a1.x; trow[5] = a1.y; trow[6] = a1.z; trow[7] = a1.w;
    __syncthreads();
    bf16_t* dst = (bf16_t*)(ws + (which ? OFF_VWT : OFF_VST)) + ((size_t)bg * 64 + r) * S + tt * 64 + q4 * 16;
    unsigned o[8];
#pragma unroll
    for (int k = 0; k < 8; ++k) o[k] = (unsigned)tl[q4 * 16 + 2 * k][r] | ((unsigned)tl[q4 * 16 + 2 * k + 1][r] << 16);
    *(uint4*)dst = make_uint4(o[0], o[1], o[2], o[3]);
    *(uint4*)(dst + 8) = make_uint4(o[4], o[5], o[6], o[7]);
    __syncthreads();
}
__device__ __forceinline__ void gla_prep_task(int vb, const bf16_t* __restrict__ proj, const float* __restrict__ w_alpha, const float* __restrict__ b_alpha, float* __restrict__ bc, int lane) {
    const int n = vb & 63, h = (vb >> 6) & 3, b = vb >> 8;
    const int col = h * 64 + lane;
    float w[16];
#pragma unroll
    for (int r = 0; r < 16; ++r) w[r] = w_alpha[r * 256 + col];
    const float bias = b_alpha[col];
    float cum = 0.f;
    for (int c = 0; c < 64; ++c) {
        const size_t row = (size_t)(b * S + n * 64 + c);
        float z = bias;
#pragma unroll
        for (int r = 0; r < 16; ++r) z += bf2f(proj[row * PP + AB + r]) * w[r];
        const float ls = fminf(z, 0.f) - log1pf(__expf(-fabsf(z)));
        cum += ls * (1.0f / 16.0f);
        bc[row * 256 + col] = cum;
    }
}

__device__ __forceinline__ void gla_state_vb(int vb, const bf16_t* __restrict__ proj, const float* __restrict__ bc, float* __restrict__ cstate, char* smem) {
    float (*kd)[64] = (float (*)[64])smem;
    float (*vs)[128] = (float (*)[128])(smem + 16384);
    const int tid = threadIdx.x, n = vb & 63, h = (vb >> 6) & 3, b = vb >> 8;
    const size_t row0 = (size_t)(b * S + n * 64);
    for (int e = tid; e < 4096; e += 256) {
        const int c = e >> 6, d = e & 63;
        kd[c][d] = bf2f(proj[(row0 + c) * PP + KB + h * 64 + d]) * __expf(bc[(row0 + 63) * 256 + h * 64 + d] - bc[(row0 + c) * 256 + h * 64 + d]);
    }
    for (int e = tid; e < 8192; e += 256) {
        const int c = e >> 7, v = e & 127;
        vs[c][v] = bf2f(proj[(row0 + c) * PP + VB + h * 128 + v]);
    }
    __syncthreads();
    const int v = tid & 127, dg = tid >> 7;
    float acc[32];
#pragma unroll
    for (int i = 0; i < 32; ++i) acc[i] = 0.f;
    for (int c = 0; c < 64; ++c) {
        const float vv = vs[c][v];
#pragma unroll
        for (int i = 0; i < 32; ++i) acc[i] += kd[c][dg * 32 + i] * vv;
    }
    float* out = cstate + (size_t)vb * 8192;
#pragma unroll
    for (int i = 0; i < 32; ++i) out[(dg * 32 + i) * 128 + v] = acc[i];
    __syncthreads();
}

__device__ __forceinline__ void gla_scan_vb(int vb, const float* __restrict__ bc, float* __restrict__ cstate) {
    const int idx = vb * 256 + threadIdx.x;
    const int e = idx & 8191, bh = idx >> 13, b = bh >> 2, h = bh & 3, d = e >> 7;
    float state = 0.f;
    for (int n = 0; n < 64; ++n) {
        float* p = cstate + ((size_t)(bh * 64 + n)) * 8192 + e;
        const float upd = *p;
        *p = state;
        const float dec = __expf(bc[((size_t)(b * S + n * 64 + 63)) * 256 + h * 64 + d]);
        state = dec * state + upd;
    }
}

__device__ __forceinline__ void gla_out_vb(int vb, const bf16_t* __restrict__ proj, const float* __restrict__ bc, const float* __restrict__ prev,
                                           const float* __restrict__ norm_g, bf16_t* __restrict__ yb, char* smem) {
    float (*qi)[65] = (float (*)[65])smem;
    float (*ki)[65] = (float (*)[65])(smem + 64 * 65 * 4);
    float (*at)[65] = (float (*)[65])(smem + 2 * 64 * 65 * 4);
    const int tid = threadIdx.x, n = vb & 63, h = (vb >> 6) & 3, b = vb >> 8;
    const size_t row0 = (size_t)(b * S + n * 64);
    for (int e = tid; e < 4096; e += 256) {
        const int c = e >> 6, d = e & 63;
        const float bcv = bc[(row0 + c) * 256 + h * 64 + d];
        qi[c][d] = bf2f(proj[(row0 + c) * PP + QB + h * 64 + d]) * 0.125f * __expf(bcv);
        ki[c][d] = bf2f(proj[(row0 + c) * PP + KB + h * 64 + d]) * __expf(-bcv);
    }
    __syncthreads();
    for (int e = tid; e < 4096; e += 256) {
        const int c = e >> 6, j = e & 63;
        float a = 0.f;
        if (j <= c) for (int d = 0; d < 64; ++d) a += qi[c][d] * ki[j][d];
        at[c][j] = a;
    }
    __syncthreads();
    const int c = tid >> 2, vg = tid & 3;
    float acc[32];
#pragma unroll
    for (int i = 0; i < 32; ++i) acc[i] = 0.f;
    for (int j = 0; j <= c; ++j) {
        const float a = at[c][j];
        const bf16_t* vr = proj + (row0 + j) * PP + VB + h * 128 + vg * 32;
#pragma unroll
        for (int i = 0; i < 32; ++i) acc[i] += a * bf2f(vr[i]);
    }
    const float* pv = prev + (size_t)vb * 8192 + vg * 32;
    for (int d = 0; d < 64; ++d) {
        const float qv = qi[c][d];
#pragma unroll
        for (int i = 0; i < 32; ++i) acc[i] += qv * pv[d * 128 + i];
    }
    float ss = 0.f;
#pragma unroll
    for (int i = 0; i < 32; ++i) ss += acc[i] * acc[i];
    ss += __shfl_xor(ss, 1); ss += __shfl_xor(ss, 2);
    const float r = rsqrtf(ss * (1.0f / 128.0f) + 1e-6f);
    const size_t row = row0 + c;
#pragma unroll
    for (int i = 0; i < 32; ++i) {
        const int col = h * 128 + vg * 32 + i;
        const float rv = bf2f(proj[row * PP + RB + col]);
        yb[row * 512 + col] = f2bf(acc[i] * r * norm_g[col] * (rv / (1.f + __expf(-rv))));
    }
    __syncthreads();
}

__device__ __forceinline__ void router_vb(int row, const float* __restrict__ x2, const float* __restrict__ g, const float* __restrict__ w_rg, const float* __restrict__ b_rg,
                                          const float* __restrict__ w_re, const float* __restrict__ b_re, bf16_t* __restrict__ h2,
                                          int* __restrict__ route_e, float* __restrict__ route_w, int* __restrict__ cnt, char* smem) {
    float* red = (float*)smem;
    float (*part)[36] = (float (*)[36])(smem + 64);
    const int tid = threadIdx.x;
    float4 v = ((const float4*)(x2 + (size_t)row * D))[tid];
    float s = v.x * v.x + v.y * v.y + v.z * v.z + v.w * v.w;
    s = wave_sum(s);
    if ((tid & 63) == 0) red[tid >> 6] = s;
    __syncthreads();
    s = red[0] + red[1] + red[2] + red[3];
    const float r = rsqrtf(s * (1.0f / D) + 1e-6f);
    float4 gg = ((const float4*)g)[tid];
    float hn[4] = {v.x * r * gg.x, v.y * r * gg.y, v.z * r * gg.z, v.w * r * gg.w};
    ushort4 o; o.x = f2bf(hn[0]); o.y = f2bf(hn[1]); o.z = f2bf(hn[2]); o.w = f2bf(hn[3]);
    ((ushort4*)(h2 + (size_t)row * D))[tid] = o;
    float pl[36];
#pragma unroll
    for (int j = 0; j < 36; ++j) pl[j] = 0.f;
#pragma unroll
    for (int i = 0; i < 4; ++i) {
        const int k = tid * 4 + i;
#pragma unroll
        for (int j = 0; j < 4; ++j) pl[j] += hn[i] * w_rg[k * 4 + j];
#pragma unroll
        for (int j = 0; j < 32; ++j) pl[4 + j] += hn[i] * w_re[k * 32 + j];
    }
#pragma unroll
    for (int j = 0; j < 36; ++j) { const float t = wave_sum(pl[j]); if ((tid & 63) == 0) part[tid >> 6][j] = t; }
    __syncthreads();
    if (tid == 0) {
        float lg[4];
#pragma unroll
        for (int j = 0; j < 4; ++j) lg[j] = part[0][j] + part[1][j] + part[2][j] + part[3][j] + b_rg[j];
        int gs = 0; float mx = lg[0];
#pragma unroll
        for (int j = 1; j < 4; ++j) if (lg[j] > mx) { mx = lg[j]; gs = j; }
        float den = 0.f;
#pragma unroll
        for (int j = 0; j < 4; ++j) den += __expf(lg[j] - mx);
        const float gp = 1.f / den;
        float v0 = -3e38f, v1 = -3e38f; int i0 = 0, i1 = 0;
        for (int j = 0; j < 8; ++j) {
            const int c = 4 + gs * 8 + j;
            const float l = part[0][c] + part[1][c] + part[2][c] + part[3][c] + b_re[gs * 8 + j];
            if (l > v0) { v1 = v0; i1 = i0; v0 = l; i0 = j; }
            else if (l > v1) { v1 = l; i1 = j; }
        }
        const float e1 = __expf(v1 - v0);
        const float w0 = gp / (1.f + e1), w1 = gp * e1 / (1.f + e1);
        const int ea = gs * 8 + i0, eb = gs * 8 + i1;
        route_e[row * 2] = ea; route_e[row * 2 + 1] = eb;
        route_w[row * 2] = w0; route_w[row * 2 + 1] = w1;
        atomicAdd(&cnt[ea], 1); atomicAdd(&cnt[eb], 1);
    }
    __syncthreads();
}

__device__ __forceinline__ void final_vb(int row, float* __restrict__ x2out, const bf16_t* __restrict__ Y0, const bf16_t* __restrict__ Y1, const float* __restrict__ g, char* smem) {
    float* red = (float*)smem;
    const int tid = threadIdx.x;
    float4 v = ((const float4*)(x2out + (size_t)row * D))[tid];
    const ushort4 a = ((const ushort4*)(Y0 + (size_t)row * D))[tid], c = ((const ushort4*)(Y1 + (size_t)row * D))[tid];
    v.x += bf2f(a.x) + bf2f(c.x); v.y += bf2f(a.y) + bf2f(c.y); v.z += bf2f(a.z) + bf2f(c.z); v.w += bf2f(a.w) + bf2f(c.w);
    float s = v.x * v.x + v.y * v.y + v.z * v.z + v.w * v.w;
    s = wave_sum(s);
    if ((tid & 63) == 0) red[tid >> 6] = s;
    __syncthreads();
    s = red[0] + red[1] + red[2] + red[3];
    __syncthreads();
    const float r = rsqrtf(s * (1.0f / D) + 1e-6f);
    float4 gg = ((const float4*)g)[tid];
    ((float4*)(x2out + (size_t)row * D))[tid] = make_float4(v.x * r * gg.x, v.y * r * gg.y, v.z * r * gg.z, v.w * r * gg.w);
}


constexpr int SMEM_BYTES = 65536;

__global__ void __launch_bounds__(256, 2) k_fwd(Params p) {
    extern __shared__ __attribute__((aligned(16))) char smem_dyn[];
    char* smem = smem_dyn + 16;
    if (threadIdx.x == 0) *(uint4*)smem_dyn = make_uint4(0u, 0u, 0u, 0u);
    __syncthreads();
    char* ws = p.ws;
    XcdBarrier bar = xcd_barrier_post((unsigned*)(ws + OFF_BAR), (volatile LAS unsigned*)smem_dyn);
    int* ctrl = (int*)(ws + OFF_CTRL);
    int* route_e = (int*)(ws + OFF_ROUTE_E);
    float* route_w = (float*)(ws + OFF_ROUTE_W);
    int* slot_tok = (int*)(ws + OFF_SLOT_TOK);
    float* slot_w = (float*)(ws + OFF_SLOT_W);
    bf16_t* proj = (bf16_t*)(ws + OFF_PROJ);
    float* bc = (float*)(ws + OFF_BC);
    float* cstate = (float*)(ws + OFF_CSTATE);
    bf16_t* SAB = (bf16_t*)(ws + OFF_SAB);
    bf16_t* mrg = (bf16_t*)(ws + OFF_MRG);
    bf16_t* h2 = (bf16_t*)(ws + OFF_H2);
    bf16_t* hid = (bf16_t*)(ws + OFF_HID);
    bf16_t* Y0 = (bf16_t*)(ws + OFF_Y0);
    bf16_t* Y1 = (bf16_t*)(ws + OFF_Y1);
    bf16_t* ya = (bf16_t*)(ws + OFF_YA);
    bf16_t* yb = (bf16_t*)(ws + OFF_YB);
    bf16_t* kcb = (bf16_t*)(ws + OFF_KCB);
    bf16_t* vcb = (bf16_t*)(ws + OFF_VCB);
    bf16_t* h = (bf16_t*)p.out;
    const int wid = threadIdx.x >> 6, lane = threadIdx.x & 63;
    const int G = gridDim.x;

    ph_prep(p, smem);
    xcd_barrier(bar);
    ph_proj(h, (const bf16_t*)(ws + OFF_WINT), proj, smem);
    xcd_barrier(bar);
    ph_cmp1(proj, ws, smem);
    for (int task = blockIdx.x; task < 1024; task += G) vtrans_tile(task, proj, ws, smem);
    for (int task = blockIdx.x * 4 + wid; task < 1024; task += G * 4) gla_prep_task(task, proj, p.w_alpha, p.b_alpha, bc, lane);
    xcd_barrier(bar);
    ph_cmp2(ws, ws, smem);
    for (int vb = blockIdx.x; vb < 1024; vb += G) gla_state_vb(vb, proj, bc, cstate, smem);
    xcd_barrier(bar);
    for (int vb = blockIdx.x; vb < 512; vb += G) gla_scan_vb(vb, bc, cstate);
    for (int r = 0; r * G < 1024; ++r) {
        const int u = r * G + ((r & 1) ? (G - 1 - (int)blockIdx.x) : (int)blockIdx.x);
        if (u < 1024) nsa_unit(u, proj, ws, p.rel_bias, ya, smem);
    }
    xcd_barrier(bar);
    for (int vb = blockIdx.x; vb < 1024; vb += G) gla_out_vb(vb, proj, bc, cstate, p.norm_g, yb, smem);
    xcd_barrier(bar);
    ph_gates(h, (const bf16_t*)(ws + OFF_WINT), SAB, smem);
    xcd_barrier(bar);
    ph_merge(ya, yb, (const bf16_t*)(ws + OFF_WAT), (const bf16_t*)(ws + OFF_WBT), SAB, mrg, smem);
    xcd_barrier(bar);
    ph_outproj(mrg, (const bf16_t*)(ws + OFF_WOT), p.x, p.out, smem);
    xcd_barrier(bar);
    for (int vb = blockIdx.x; vb < T; vb += G) router_vb(vb, p.out, p.g_ffn, p.w_rg, p.b_rg, p.w_re, p.b_re, h2, route_e, route_w, ctrl, smem);
    xcd_barrier(bar);
    for (int i = blockIdx.x * 256 + threadIdx.x; i < 2 * T; i += G * 256) {
        const int e = route_e[i];
        int off = 0;
        for (int j = 0; j < e; ++j) off += (ctrl[j] + 127) & ~127;
        const int pos = atomicAdd(&ctrl[32 + e], 1);
        slot_tok[off + pos] = i; slot_w[off + pos] = route_w[i];
    }
    xcd_barrier(bar);
    ph_moe1(h2, (const bf16_t*)(ws + OFF_WGT), (const bf16_t*)(ws + OFF_WUT), ctrl, slot_tok, slot_w, hid, smem);
    xcd_barrier(bar);
    ph_moe2(hid, (const bf16_t*)(ws + OFF_WDT), ctrl, slot_tok, Y0, smem);
    xcd_barrier(bar);
    for (int vb = blockIdx.x; vb < T; vb += G) final_vb(vb, p.out, Y0, Y1, p.g_final, smem);
}

extern "C" void kernel_launch(void* const* d_in, const int* in_sizes, int n_in, void* d_out, int out_size, void* d_ws, size_t ws_size, hipStream_t stream) {
    static int grid = 0;
    constexpr int kDynLds = SMEM_BYTES + 16;
    if (!grid) {
        int dev = 0, cus = 0, per_cu = 0;
        (void)hipGetDevice(&dev);
        (void)hipDeviceGetAttribute(&cus, hipDeviceAttributeMultiprocessorCount, dev);
        (void)hipFuncSetAttribute((const void*)k_fwd, hipFuncAttributeMaxDynamicSharedMemorySize, kDynLds);
        (void)hipOccupancyMaxActiveBlocksPerMultiprocessor(&per_cu, k_fwd, 256, kDynLds);
        if (per_cu > 2) per_cu = 2;
        if (per_cu < 1) per_cu = 1;
        grid = cus * per_cu;
    }
    char* ws = (char*)d_ws;
    (void)hipMemsetAsync(ws + OFF_CTRL, 0, 4096, stream);
    (void)hipMemsetAsync(ws + OFF_SLOT_TOK, 0xFF, (size_t)MSLOT * 4, stream);
    (void)hipMemsetAsync(ws + OFF_BAR, 0, 16384, stream);
    Params p{};
    const float** pf = (const float**)&p;
    for (int i = 0; i < 25; ++i) pf[i] = (const float*)d_in[i];
    p.out = (float*)d_out; p.ws = ws;
    k_fwd<<<grid, 256, kDynLds, stream>>>(p);
}
```

```cpp
#include <hip/hip_runtime.h>
#include <stdint.h>

typedef unsigned short bf16_t;
typedef short bf16x8 __attribute__((ext_vector_type(8)));
typedef float f32x4 __attribute__((ext_vector_type(4)));
typedef unsigned u32x4 __attribute__((ext_vector_type(4)));
__device__ __forceinline__ float bf2f(bf16_t v) { return __uint_as_float(((unsigned)v) << 16); }
__device__ __forceinline__ bf16_t f2bf(float f) { unsigned u = __float_as_uint(f); u += 0x7FFFu + ((u >> 16) & 1u); return (bf16_t)(u >> 16); }
__device__ __forceinline__ unsigned pack_bf16(float lo, float hi) { unsigned r; asm volatile("v_cvt_pk_bf16_f32 %0, %1, %2" : "=v"(r) : "v"(lo), "v"(hi)); return r; }

constexpr int Bn = 4, S = 4096, T = Bn * S, D = 1024, NIN = 4904, PP = 2880;
constexpr int QA = 0, KC = 512, VC = 640, KS = 768, VS = 896, KW = 1024, VW = 1152, GA = 1280, QB = 1304, KB = 1560, VB = 1816, AB = 2328, RB = 2344, MGA = 2856, MGB = 3880;
constexpr int NPROJ = 2856;
constexpr int MSLOT = 36864;

constexpr size_t OFF_CTRL = 0;
constexpr size_t OFF_ROUTE_E = 4096;
constexpr size_t OFF_ROUTE_W = OFF_ROUTE_E + 32768 * 4;
constexpr size_t OFF_SLOT_TOK = OFF_ROUTE_W + 32768 * 4;
constexpr size_t OFF_SLOT_W = OFF_SLOT_TOK + (size_t)MSLOT * 4;
constexpr size_t OFF_BAR = OFF_SLOT_W + (size_t)MSLOT * 4;
constexpr size_t OFF_BIAS1 = OFF_BAR + 16384;
constexpr size_t OFF_RSTD = OFF_BIAS1 + 1024;
constexpr size_t OFF_SLOT_RS = OFF_RSTD + (size_t)T * 4;
constexpr size_t OFF_WRT = OFF_SLOT_RS + (size_t)MSLOT * 4;
static_assert(OFF_WRT + 2 * 48 * 1024 * 2 <= (1u << 20), "ctrl overflow");
constexpr size_t OFF_R1 = 1u << 20;
constexpr size_t SZ_PROJ = (size_t)T * PP * 2;
constexpr size_t OFF_PROJ = OFF_R1;
constexpr size_t OFF_BC = OFF_PROJ + SZ_PROJ;
constexpr size_t OFF_CSTATE = OFF_BC + (size_t)T * 256 * 4;
constexpr size_t OFF_R1_END = OFF_CSTATE + (size_t)1024 * 8192 * 4;
constexpr size_t OFF_SAB = OFF_R1;
constexpr size_t OFF_MRG = OFF_SAB + (size_t)T * 2048 * 2;
constexpr size_t OFF_H2 = OFF_R1;
constexpr size_t OFF_HID = OFF_H2 + (size_t)T * 1024 * 2;
constexpr size_t OFF_Y0 = OFF_HID + (size_t)MSLOT * 256 * 2;
constexpr size_t OFF_Y1 = OFF_Y0 + (size_t)T * 1024 * 2;
static_assert(OFF_MRG + (size_t)T * 1024 * 2 <= OFF_R1_END, "alias overflow");
static_assert(OFF_Y1 + (size_t)T * 1024 * 2 <= OFF_R1_END, "alias overflow");
constexpr size_t OFF_YA = OFF_R1_END;
constexpr size_t OFF_YB = OFF_YA + (size_t)T * 512 * 2;
constexpr size_t OFF_KCB = OFF_YB + (size_t)T * 512 * 2;
constexpr size_t OFF_VCB = OFF_KCB + 8 * 256 * 64 * 2;
constexpr size_t OFF_VCBT = OFF_VCB + 8 * 256 * 64 * 2;
constexpr size_t OFF_HIDC = OFF_VCBT + 8 * 256 * 64 * 2;
constexpr size_t OFF_VST = OFF_HIDC + 2 * 2048 * 128 * 2;
constexpr size_t OFF_VWT = OFF_VST + (size_t)8 * 64 * S * 2;
constexpr size_t OFF_WINT = OFF_VWT + (size_t)8 * 64 * S * 2;
constexpr size_t OFF_CK1T = OFF_WINT + (size_t)NIN * 1024 * 2;
constexpr size_t OFF_CV1T = OFF_CK1T + 128 * 2048 * 2;
constexpr size_t OFF_CK2T = OFF_CV1T + 128 * 2048 * 2;
constexpr size_t OFF_CV2T = OFF_CK2T + 128 * 128 * 2;
constexpr size_t OFF_WAT = OFF_CV2T + 128 * 128 * 2;
constexpr size_t OFF_WBT = OFF_WAT + 1024 * 512 * 2;
constexpr size_t OFF_WOT = OFF_WBT + 1024 * 512 * 2;
constexpr size_t OFF_WGT = OFF_WOT + 1024 * 1024 * 2;
constexpr size_t OFF_WUT = OFF_WGT + (size_t)32 * 256 * 1024 * 2;
constexpr size_t OFF_WDT = OFF_WUT + (size_t)32 * 256 * 1024 * 2;
constexpr size_t OFF_END = OFF_WDT + (size_t)32 * 1024 * 256 * 2;
static_assert(OFF_END <= (size_t)256 << 20, "workspace overflow");

#define XB_TMO      128
#define XB_XCNT(j)  (256  + 64 * (j))
#define XB_XSUB(j)  (1280 + 64 * (j))
#define XB_XGEN(j)  (2304 + 64 * (j))
#define XB_TOP      3328
#define XB_TOPGEN   3392
#define XCD_BAR_WORDS 3456
#define XB_SPIN_CAP (1u << 18)
#define LAS __attribute__((address_space(3)))

__device__ __forceinline__ unsigned xb_ld(unsigned* p)              { return __hip_atomic_load(p, __ATOMIC_RELAXED, __HIP_MEMORY_SCOPE_AGENT); }
__device__ __forceinline__ unsigned xb_add(unsigned* p, unsigned v) { return __hip_atomic_fetch_add(p, v, __ATOMIC_RELAXED, __HIP_MEMORY_SCOPE_AGENT); }
__device__ __forceinline__ unsigned xb_xcc_id() { return (unsigned)__builtin_amdgcn_s_getreg((3 << 11) | 20) & 0xFu; }
#define XB_SPIN(cond, bar) do { unsigned _sp = 0; while (cond) { __builtin_amdgcn_s_sleep(1); \
    if ((++_sp & 255u) == 0u) { if (xb_ld(&(bar)[XB_TMO])) break; if (_sp > XB_SPIN_CAP) { atomicAdd(&(bar)[XB_TMO], 1u); break; } } } } while (0)

struct XcdBarrier { unsigned* bar; unsigned x; volatile LAS unsigned* st; };

__device__ __forceinline__ XcdBarrier xcd_barrier_post(unsigned* bar, volatile LAS unsigned* st) {
    XcdBarrier b; b.bar = bar; b.x = xb_xcc_id(); b.st = st;
    if (threadIdx.x == 0) (void)xb_add(&bar[XB_XCNT(b.x)], 1u);
    return b;
}
__device__ __forceinline__ void xcd_barrier_complete(unsigned* bar, unsigned x, unsigned& nloc, unsigned& nx) {
    const unsigned G = gridDim.x * gridDim.y * gridDim.z;
    unsigned sum, cnt, mine, sp = 0u;
    for (;;) {
        sum = 0u; cnt = 0u; mine = 0u;
#pragma unroll
        for (unsigned j = 0; j < 16; ++j) { const unsigned c = xb_ld(&bar[XB_XCNT(j)]); sum += c; cnt += (c > 0u) ? 1u : 0u; mine = (j == x) ? c : mine; }
        if (sum == G) break;
        __builtin_amdgcn_s_sleep(1);
        if ((++sp & 255u) == 0u) { if (xb_ld(&bar[XB_TMO])) break; if (sp > XB_SPIN_CAP) { atomicAdd(&bar[XB_TMO], 1u); break; } }
    }
    nloc = mine > 0u ? mine : 1u; nx = cnt > 0u ? cnt : 1u;
}
__device__ __forceinline__ void xcd_barrier(const XcdBarrier& b) {
    asm volatile("s_waitcnt vmcnt(0)" ::: "memory");
    __syncthreads();
    if (threadIdx.x == 0) {
        unsigned* bar = b.bar;
        __builtin_amdgcn_s_waitcnt(0);
        unsigned nloc = b.st[0], nx = b.st[1];
        if (nloc == 0u) { xcd_barrier_complete(bar, b.x, nloc, nx); b.st[0] = nloc; b.st[1] = nx; }
        const unsigned old = xb_add(&bar[XB_XSUB(b.x)], 1u);
        const unsigned gen = old / nloc;
        if (old + 1u == (gen + 1u) * nloc) {
            __builtin_amdgcn_fence(__ATOMIC_RELEASE, "agent");
            asm volatile("s_waitcnt vmcnt(0)" ::: "memory");
            const unsigned og = xb_add(&bar[XB_TOP], 1u);
            const unsigned tg = og / nx;
            if (og + 1u == (tg + 1u) * nx) xb_add(&bar[XB_TOPGEN], 1u);
            else XB_SPIN(xb_ld(&bar[XB_TOPGEN]) == tg, bar);
            __builtin_amdgcn_fence(__ATOMIC_ACQUIRE, "agent");
            xb_add(&bar[XB_XGEN(b.x)], 1u);
            asm volatile("s_waitcnt vmcnt(0)" ::: "memory");
        } else {
            XB_SPIN(xb_ld(&bar[XB_XGEN(b.x)]) == gen, bar);
            __builtin_amdgcn_fence(__ATOMIC_ACQUIRE, "agent");
            asm volatile("s_waitcnt vmcnt(0)" ::: "memory");
        }
    }
    __syncthreads();
}


struct Params {
    const float *x, *g_mix, *w_in, *pe_k, *ck1, *ck2, *pe_v, *cv1, *cv2, *rel_bias, *w_alpha, *b_alpha, *norm_g, *w_ba, *w_bb, *w_out, *g_ffn,
                *w_rg, *b_rg, *w_re, *b_re, *w_eg, *w_eu, *w_ed, *g_final;
    float* out; char* ws;
};

__device__ __forceinline__ float wave_max(float v) { for (int o = 32; o > 0; o >>= 1) v = fmaxf(v, __shfl_xor(v, o)); return v; }
__device__ __forceinline__ float wave_sum(float v) { for (int o = 32; o > 0; o >>= 1) v += __shfl_xor(v, o); return v; }
__device__ __forceinline__ void wave_lds_sync() { asm volatile("s_waitcnt lgkmcnt(0)" ::: "memory"); }


__device__ __forceinline__ void rms_h_row(int row, const float* __restrict__ x, const float* __restrict__ g, bf16_t* __restrict__ h, int lane) {
    const float* xr = x + (size_t)row * D + lane * 4;
    f32x4 v[4]; float s = 0.f;
#pragma unroll
    for (int i = 0; i < 4; ++i) { v[i] = *(const f32x4*)(xr + 256 * i); s += v[i][0] * v[i][0] + v[i][1] * v[i][1] + v[i][2] * v[i][2] + v[i][3] * v[i][3]; }
    s = wave_sum(s);
    const float r = rsqrtf(s * (1.0f / D) + 1e-6f);
#pragma unroll
    for (int i = 0; i < 4; ++i) {
        const f32x4 gg = *(const f32x4*)(g + lane * 4 + 256 * i);
        uint2 o; o.x = pack_bf16(v[i][0] * r * gg[0], v[i][1] * r * gg[1]); o.y = pack_bf16(v[i][2] * r * gg[2], v[i][3] * r * gg[3]);
        *(uint2*)(h + (size_t)row * D + lane * 4 + 256 * i) = o;
    }
}
__device__ __forceinline__ void final_row(int row, float* __restrict__ x2out, const bf16_t* __restrict__ Y0, const bf16_t* __restrict__ Y1, const float* __restrict__ g, int lane) {
    float* xr = x2out + (size_t)row * D + lane * 4;
    f32x4 v[4]; float s = 0.f;
#pragma unroll
    for (int i = 0; i < 4; ++i) {
        v[i] = *(const f32x4*)(xr + 256 * i);
        const uint2 a = *(const uint2*)(Y0 + (size_t)row * D + lane * 4 + 256 * i), c = *(const uint2*)(Y1 + (size_t)row * D + lane * 4 + 256 * i);
        v[i][0] += __uint_as_float(a.x << 16) + __uint_as_float(c.x << 16);
        v[i][1] += __uint_as_float(a.x & 0xFFFF0000u) + __uint_as_float(c.x & 0xFFFF0000u);
        v[i][2] += __uint_as_float(a.y << 16) + __uint_as_float(c.y << 16);
        v[i][3] += __uint_as_float(a.y & 0xFFFF0000u) + __uint_as_float(c.y & 0xFFFF0000u);
        s += v[i][0] * v[i][0] + v[i][1] * v[i][1] + v[i][2] * v[i][2] + v[i][3] * v[i][3];
    }
    s = wave_sum(s);
    const float r = rsqrtf(s * (1.0f / D) + 1e-6f);
#pragma unroll
    for (int i = 0; i < 4; ++i) {
        const f32x4 gg = *(const f32x4*)(g + lane * 4 + 256 * i);
        *(f32x4*)(xr + 256 * i) = (f32x4){v[i][0] * r * gg[0], v[i][1] * r * gg[1], v[i][2] * r * gg[2], v[i][3] * r * gg[3]};
    }
}

__device__ __forceinline__ void prep_router_w(const float* __restrict__ w_rg, const float* __restrict__ w_re, bf16_t* __restrict__ WrT) {
    for (int idx = blockIdx.x * 256 + threadIdx.x; idx < 48 * 1024; idx += gridDim.x * 256) {
        const int n = idx >> 10, k = idx & 1023;
        const float w = n < 4 ? w_rg[k * 4 + n] : (n < 36 ? w_re[k * 32 + n - 4] : 0.f);
        const bf16_t hi = f2bf(w);
        WrT[idx] = hi; WrT[48 * 1024 + idx] = f2bf(w - bf2f(hi));
    }
}

__device__ __forceinline__ void router_task(int task, const float* __restrict__ x2, const float* __restrict__ g, const bf16_t* __restrict__ WrT,
                                            const float* __restrict__ b_rg, const float* __restrict__ b_re, bf16_t* __restrict__ h2, float* __restrict__ rstd_out,
                                            int* __restrict__ route_e, float* __restrict__ route_w, int* __restrict__ cnt, char* wsm, int lane) {
    float (*lg)[49] = (float (*)[49])wsm;
    float* rs = (float*)(wsm + 16 * 49 * 4);
    const int fr = lane & 15, fq = lane >> 4, r0 = task * 16;
    const float* xr = x2 + (size_t)(r0 + fr) * D + fq * 8;
    bf16_t* hr = h2 + (size_t)(r0 + fr) * D + fq * 8;
    const bf16_t* wh = WrT + (size_t)fr * 1024 + fq * 8;
    f32x4 acc[3];
#pragma unroll
    for (int nt = 0; nt < 3; ++nt) acc[nt] = (f32x4){0.f, 0.f, 0.f, 0.f};
    float ssq = 0.f;
#pragma unroll 2
    for (int ks = 0; ks < 32; ++ks) {
        const f32x4 x0 = *(const f32x4*)(xr + ks * 32), x1 = *(const f32x4*)(xr + ks * 32 + 4);
        const f32x4 g0 = *(const f32x4*)(g + ks * 32 + fq * 8), g1 = *(const f32x4*)(g + ks * 32 + fq * 8 + 4);
        float xg[8];
#pragma unroll
        for (int e = 0; e < 4; ++e) { xg[e] = x0[e] * g0[e]; xg[4 + e] = x1[e] * g1[e]; ssq += x0[e] * x0[e] + x1[e] * x1[e]; }
        u32x4 hi, lo;
#pragma unroll
        for (int e = 0; e < 4; ++e) {
            hi[e] = pack_bf16(xg[2 * e], xg[2 * e + 1]);
            lo[e] = pack_bf16(xg[2 * e] - __uint_as_float(hi[e] << 16), xg[2 * e + 1] - __uint_as_float(hi[e] & 0xFFFF0000u));
        }
        *(u32x4*)(hr + ks * 32) = hi;
        const bf16x8 ah = __builtin_bit_cast(bf16x8, hi), al = __builtin_bit_cast(bf16x8, lo);
#pragma unroll
        for (int nt = 0; nt < 3; ++nt) {
            const bf16x8 bh = *(const bf16x8*)(wh + (size_t)nt * 16 * 1024 + ks * 32), bl = *(const bf16x8*)(wh + (size_t)(48 + nt * 16) * 1024 + ks * 32);
            acc[nt] = __builtin_amdgcn_mfma_f32_16x16x32_bf16(ah, bh, acc[nt], 0, 0, 0);
            acc[nt] = __builtin_amdgcn_mfma_f32_16x16x32_bf16(al, bh, acc[nt], 0, 0, 0);
            acc[nt] = __builtin_amdgcn_mfma_f32_16x16x32_bf16(ah, bl, acc[nt], 0, 0, 0);
        }
    }
    ssq += __shfl_xor(ssq, 16); ssq += __shfl_xor(ssq, 32);
    const float rstd = rsqrtf(ssq * (1.0f / D) + 1e-6f);
    wave_lds_sync();
    if (fq == 0) { rs[fr] = rstd; rstd_out[r0 + fr] = rstd; }
#pragma unroll
    for (int nt = 0; nt < 3; ++nt)
#pragma unroll
        for (int i = 0; i < 4; ++i) lg[4 * fq + i][nt * 16 + fr] = acc[nt][i];
    wave_lds_sync();
    if (lane < 16) {
        const int row = r0 + lane; const float rsv = rs[lane];
        float l4[4];
#pragma unroll
        for (int j = 0; j < 4; ++j) l4[j] = lg[lane][j] * rsv + b_rg[j];
        int gs = 0; float mx = l4[0];
#pragma unroll
        for (int j = 1; j < 4; ++j) if (l4[j] > mx) { mx = l4[j]; gs = j; }
        float den = 0.f;
#pragma unroll
        for (int j = 0; j < 4; ++j) den += __expf(l4[j] - mx);
        const float gp = 1.f / den;
        float v0 = -3e38f, v1 = -3e38f; int i0 = 0, i1 = 0;
        for (int j = 0; j < 8; ++j) {
            const float l = lg[lane][4 + gs * 8 + j] * rsv + b_re[gs * 8 + j];
            if (l > v0) { v1 = v0; i1 = i0; v0 = l; i0 = j; }
            else if (l > v1) { v1 = l; i1 = j; }
        }
        const float e1 = __expf(v1 - v0);
        const float w0 = gp / (1.f + e1), w1 = gp * e1 / (1.f + e1);
        const int ea = gs * 8 + i0, eb = gs * 8 + i1;
        route_e[row * 2] = ea; route_e[row * 2 + 1] = eb;
        route_w[row * 2] = w0; route_w[row * 2 + 1] = w1;
        atomicAdd(&cnt[ea], 1); atomicAdd(&cnt[eb], 1);
    }
    wave_lds_sync();
}
__device__ __forceinline__ void transpose_tile(const float* __restrict__ src, int ld_src, int N, bf16_t* __restrict__ dst, int ld_dst, int kt, int nt, char* smem) {
    float (*tl)[65] = (float (*)[65])smem;
    const int tid = threadIdx.x;
    const int c4 = (tid & 15) * 4, r0 = tid >> 4;
#pragma unroll
    for (int i = 0; i < 4; ++i) {
        const int k = r0 + 16 * i, n = nt * 64 + c4;
        float4 v = make_float4(0.f, 0.f, 0.f, 0.f);
        if (n < N) v = *(const float4*)(src + (size_t)(kt * 64 + k) * ld_src + n);
        tl[k][c4] = v.x; tl[k][c4 + 1] = v.y; tl[k][c4 + 2] = v.z; tl[k][c4 + 3] = v.w;
    }
    __syncthreads();
    const int kc = (tid & 7) * 8, n0 = tid >> 3;
#pragma unroll
    for (int i = 0; i < 2; ++i) {
        const int nl = n0 + 32 * i, n = nt * 64 + nl;
        if (n < N) {
            uint4 o;
            o.x = pack_bf16(tl[kc][nl], tl[kc + 1][nl]); o.y = pack_bf16(tl[kc + 2][nl], tl[kc + 3][nl]);
            o.z = pack_bf16(tl[kc + 4][nl], tl[kc + 5][nl]); o.w = pack_bf16(tl[kc + 6][nl], tl[kc + 7][nl]);
            *(uint4*)(dst + (size_t)n * ld_dst + kt * 64 + kc) = o;
        }
    }
    __syncthreads();
}

__device__ __forceinline__ void ph_prep(const Params& p, char* smem) {
    char* ws = p.ws;
    constexpr int N0 = 16 * 77, N1 = N0 + 64, N2 = N1 + 64, N3 = N2 + 2, N4 = N3 + 2, N5 = N4 + 128, N6 = N5 + 128, N7 = N6 + 256, N8 = N7 + 2048, N9 = N8 + 2048, N10 = N9 + 2048;
    for (int t = blockIdx.x; t < N10; t += gridDim.x) {
        if (t < N0) transpose_tile(p.w_in, NIN, NIN, (bf16_t*)(ws + OFF_WINT), 1024, t / 77, t % 77, smem);
        else if (t < N1) { const int q = t - N0; transpose_tile(p.ck1, 128, 128, (bf16_t*)(ws + OFF_CK1T), 2048, q >> 1, q & 1, smem); }
        else if (t < N2) { const int q = t - N1; transpose_tile(p.cv1, 128, 128, (bf16_t*)(ws + OFF_CV1T), 2048, q >> 1, q & 1, smem); }
        else if (t < N3) { const int q = t - N2; transpose_tile(p.ck2, 64, 64, (bf16_t*)(ws + OFF_CK2T), 128, q, 0, smem); }
        else if (t < N4) { const int q = t - N3; transpose_tile(p.cv2, 64, 64, (bf16_t*)(ws + OFF_CV2T), 128, q, 0, smem); }
        else if (t < N5) { const int q = t - N4; transpose_tile(p.w_ba, 1024, 1024, (bf16_t*)(ws + OFF_WAT), 512, q >> 4, q & 15, smem); }
        else if (t < N6) { const int q = t - N5; transpose_tile(p.w_bb, 1024, 1024, (bf16_t*)(ws + OFF_WBT), 512, q >> 4, q & 15, smem); }
        else if (t < N7) { const int q = t - N6; transpose_tile(p.w_out, 1024, 1024, (bf16_t*)(ws + OFF_WOT), 1024, q >> 4, q & 15, smem); }
        else if (t < N8) { const int q = t - N7, e = q >> 6, r = q & 63; transpose_tile(p.w_eg + (size_t)e * 1024 * 256, 256, 256, (bf16_t*)(ws + OFF_WGT) + (size_t)e * 256 * 1024, 1024, r >> 2, r & 3, smem); }
        else if (t < N9) { const int q = t - N8, e = q >> 6, r = q & 63; transpose_tile(p.w_eu + (size_t)e * 1024 * 256, 256, 256, (bf16_t*)(ws + OFF_WUT) + (size_t)e * 256 * 1024, 1024, r >> 2, r & 3, smem); }
        else { const int q = t - N9, e = q >> 6, r = q & 63; transpose_tile(p.w_ed + (size_t)e * 256 * 1024, 1024, 1024, (bf16_t*)(ws + OFF_WDT) + (size_t)e * 1024 * 256, 256, r >> 4, r & 15, smem); }
    }
    for (int t = blockIdx.x; t < 8; t += gridDim.x) {
        const int which = t >> 2, n = (t & 3) * 32 + (threadIdx.x & 31), ksp = threadIdx.x >> 5;
        const float* pe = which ? p.pe_v : p.pe_k; const float* w1 = which ? p.cv1 : p.ck1;
        float a = 0.f;
        for (int k = ksp * 256; k < ksp * 256 + 256; ++k) a += pe[k] * w1[(size_t)k * 128 + n];
        float* red = (float*)smem;
        red[threadIdx.x] = a;
        __syncthreads();
        if (threadIdx.x < 32) {
            float s = 0.f;
#pragma unroll
            for (int j = 0; j < 8; ++j) s += red[j * 32 + threadIdx.x];
            ((float*)(ws + OFF_BIAS1))[which * 128 + n] = s;
        }
        __syncthreads();
    }
    prep_router_w(p.w_rg, p.w_re, (bf16_t*)(ws + OFF_WRT));
    for (int row = blockIdx.x * 4 + (threadIdx.x >> 6); row < T; row += gridDim.x * 4) rms_h_row(row, p.x, p.g_mix, (bf16_t*)p.out, threadIdx.x & 63);
}

__device__ __forceinline__ int tile_off(int row, int chunk) { return row * 128 + ((chunk ^ (row & 7)) << 4); }

__device__ __forceinline__ void gemm_kloop(f32x4 (&acc)[4][4], const bf16_t* const (&pa)[4], const bf16_t* const (&pb)[4], int ka, int kb, int nk, char* smem) {
    const int tid = threadIdx.x, lane = tid & 63, wid = tid >> 6, wr = wid >> 1, wc = wid & 1, fr = lane & 15, fq = lane >> 4;
    const int so = tile_off(tid >> 3, tid & 7);
    const int offA = (wr * 64 + fr) * 128, offB = 16384 + (wc * 64 + fr) * 128, x = fr & 7;
    u32x4 ra[4], rb[4];
#pragma unroll
    for (int i = 0; i < 4; ++i) { ra[i] = *(const u32x4*)pa[i]; rb[i] = *(const u32x4*)pb[i]; }
    __syncthreads();
#pragma unroll
    for (int i = 0; i < 4; ++i) { *(u32x4*)(smem + so + i * 4096) = ra[i]; *(u32x4*)(smem + 16384 + so + i * 4096) = rb[i]; }
    __syncthreads();
    for (int kt = 0; kt < nk; ++kt) {
        const int cur = kt & 1;
        if (kt + 1 < nk) {
#pragma unroll
            for (int i = 0; i < 4; ++i) { ra[i] = *(const u32x4*)(pa[i] + (size_t)(kt + 1) * ka); rb[i] = *(const u32x4*)(pb[i] + (size_t)(kt + 1) * kb); }
        }
        const char* sa = smem + cur * 32768 + offA;
        const char* sb = smem + cur * 32768 + offB;
#pragma unroll
        for (int ks = 0; ks < 2; ++ks) {
            const int ch = ((ks * 4 + fq) ^ x) << 4;
            bf16x8 af[4], bfr[4];
#pragma unroll
            for (int mi = 0; mi < 4; ++mi) af[mi] = *(const bf16x8*)(sa + mi * 2048 + ch);
#pragma unroll
            for (int ni = 0; ni < 4; ++ni) bfr[ni] = *(const bf16x8*)(sb + ni * 2048 + ch);
#pragma unroll
            for (int mi = 0; mi < 4; ++mi)
#pragma unroll
                for (int ni = 0; ni < 4; ++ni) acc[mi][ni] = __builtin_amdgcn_mfma_f32_16x16x32_bf16(bfr[ni], af[mi], acc[mi][ni], 0, 0, 0);
        }
        if (kt + 1 < nk) {
            char* st = smem + (cur ^ 1) * 32768 + so;
#pragma unroll
            for (int i = 0; i < 4; ++i) { *(u32x4*)(st + i * 4096) = ra[i]; *(u32x4*)(st + 16384 + i * 4096) = rb[i]; }
        }
        __syncthreads();
    }
}
__device__ __forceinline__ void acc_zero(f32x4 (&acc)[4][4]) {
#pragma unroll
    for (int mi = 0; mi < 4; ++mi)
#pragma unroll
        for (int ni = 0; ni < 4; ++ni) acc[mi][ni] = (f32x4){0.f, 0.f, 0.f, 0.f};
}
#define GEMM_LANE_VARS const int tid = threadIdx.x, lane = tid & 63, wid = tid >> 6, wr = wid >> 1, wc = wid & 1, fr = lane & 15, fq = lane >> 4, lrow = tid >> 3, lch8 = (tid & 7) * 8; (void)wr; (void)wc; (void)fr; (void)fq; (void)lrow; (void)lch8;
__device__ __forceinline__ uint2 pack4(f32x4 v) { uint2 o; o.x = pack_bf16(v[0], v[1]); o.y = pack_bf16(v[2], v[3]); return o; }
__device__ __forceinline__ float sigmoidf_(float a) { return 1.f / (1.f + __expf(-a)); }

__device__ __forceinline__ void ph_proj(const bf16_t* __restrict__ h, const bf16_t* __restrict__ WinT, bf16_t* __restrict__ proj, char* smem) {
    GEMM_LANE_VARS
    for (int u = blockIdx.x; u < 128 * 23; u += gridDim.x) {
        const int xg = u & 7, v = u >> 3, tn = v % 23, tm = (v / 23) * 8 + xg;
        const bf16_t* pa[4]; const bf16_t* pb[4];
#pragma unroll
        for (int i = 0; i < 4; ++i) { pa[i] = h + (size_t)(tm * 128 + lrow + 32 * i) * 1024 + lch8; pb[i] = WinT + (size_t)(tn * 128 + lrow + 32 * i) * 1024 + lch8; }
        f32x4 acc[4][4]; acc_zero(acc);
        gemm_kloop(acc, pa, pb, 64, 64, 16, smem);
#pragma unroll
        for (int mi = 0; mi < 4; ++mi)
#pragma unroll
            for (int ni = 0; ni < 4; ++ni) {
                const int m = tm * 128 + wr * 64 + mi * 16 + fr, n = tn * 128 + wc * 64 + ni * 16 + 4 * fq;
                if (n < NPROJ) *(uint2*)(proj + (size_t)m * PP + n) = pack4(acc[mi][ni]);
            }
    }
}

__device__ __forceinline__ void ph_cmp1(const bf16_t* __restrict__ proj, const char* ws, char* smem) {
    GEMM_LANE_VARS
    for (int u = blockIdx.x; u < 32; u += gridDim.x) {
        const int which = u >> 4, tm = u & 15;
        const bf16_t* W1T = (const bf16_t*)(ws + (which ? OFF_CV1T : OFF_CK1T));
        const float* bias1 = (const float*)(ws + OFF_BIAS1) + which * 128;
        bf16_t* hid = (bf16_t*)(ws + OFF_HIDC) + (size_t)which * 2048 * 128;
        const int col0 = which ? VC : KC;
        const bf16_t* pa[4]; const bf16_t* pb[4];
#pragma unroll
        for (int i = 0; i < 4; ++i) {
            const int m = tm * 128 + lrow + 32 * i, bg = m >> 8, c = (m & 255) > 254 ? 254 : (m & 255), b = bg >> 1, g = bg & 1;
            pa[i] = proj + (size_t)(b * S + 16 * c) * PP + col0 + g * 64 + lch8;
            pb[i] = W1T + (size_t)(lrow + 32 * i) * 2048 + lch8;
        }
        f32x4 acc[4][4]; acc_zero(acc);
        gemm_kloop(acc, pa, pb, PP, 64, 32, smem);
#pragma unroll
        for (int mi = 0; mi < 4; ++mi)
#pragma unroll
            for (int ni = 0; ni < 4; ++ni) {
                const int m = tm * 128 + wr * 64 + mi * 16 + fr, n = wc * 64 + ni * 16 + 4 * fq;
                f32x4 v = acc[mi][ni];
#pragma unroll
                for (int j = 0; j < 4; ++j) { const float a = v[j] + bias1[n + j]; const float t = 0.7978845608028654f * (a + 0.044715f * a * a * a); v[j] = 0.5f * a * (1.f + tanhf(t)); }
                *(uint2*)(hid + (size_t)m * 128 + n) = pack4(v);
            }
    }
}

__device__ __forceinline__ void ph_cmp2(const char* ws_c, char* ws, char* smem) {
    GEMM_LANE_VARS
    for (int u = blockIdx.x; u < 32; u += gridDim.x) {
        const int which = u >> 4, tm = u & 15;
        const bf16_t* W2T = (const bf16_t*)(ws_c + (which ? OFF_CV2T : OFF_CK2T));
        const bf16_t* hid = (const bf16_t*)(ws_c + OFF_HIDC) + (size_t)which * 2048 * 128;
        const bf16_t* pa[4]; const bf16_t* pb[4];
#pragma unroll
        for (int i = 0; i < 4; ++i) { pa[i] = hid + (size_t)(tm * 128 + lrow + 32 * i) * 128 + lch8; pb[i] = W2T + (size_t)(lrow + 32 * i) * 128 + lch8; }
        f32x4 acc[4][4]; acc_zero(acc);
        gemm_kloop(acc, pa, pb, 64, 64, 2, smem);
        if (wc == 0) {
            bf16_t* outp = (bf16_t*)(ws + (which ? OFF_VCB : OFF_KCB));
            bf16_t* outT = (bf16_t*)(ws + OFF_VCBT);
#pragma unroll
            for (int mi = 0; mi < 4; ++mi)
#pragma unroll
                for (int ni = 0; ni < 4; ++ni) {
                    const int m = tm * 128 + wr * 64 + mi * 16 + fr, n = ni * 16 + 4 * fq, c = m & 255, bg = m >> 8;
                    f32x4 v = acc[mi][ni];
                    if (c == 255) v = (f32x4){0.f, 0.f, 0.f, 0.f};
                    *(uint2*)(outp + (size_t)m * 64 + n) = pack4(v);
                    if (which) {
#pragma unroll
                        for (int j = 0; j < 4; ++j) outT[((size_t)bg * 64 + n + j) * 256 + c] = f2bf(v[j]);
                    }
                }
        }
    }
}

__device__ __forceinline__ void ph_gates(const bf16_t* __restrict__ h, const bf16_t* __restrict__ WinT, bf16_t* __restrict__ SAB, char* smem) {
    GEMM_LANE_VARS
    for (int u = blockIdx.x; u < 128 * 16; u += gridDim.x) {
        const int xg = u & 7, v = u >> 3, tn = v & 15, tm = (v >> 4) * 8 + xg;
        const bf16_t* pa[4]; const bf16_t* pb[4];
#pragma unroll
        for (int i = 0; i < 4; ++i) { pa[i] = h + (size_t)(tm * 128 + lrow + 32 * i) * 1024 + lch8; pb[i] = WinT + (size_t)(MGA + tn * 128 + lrow + 32 * i) * 1024 + lch8; }
        f32x4 acc[4][4]; acc_zero(acc);
        gemm_kloop(acc, pa, pb, 64, 64, 16, smem);
#pragma unroll
        for (int mi = 0; mi < 4; ++mi)
#pragma unroll
            for (int ni = 0; ni < 4; ++ni) {
                const int m = tm * 128 + wr * 64 + mi * 16 + fr, n = tn * 128 + wc * 64 + ni * 16 + 4 * fq;
                f32x4 v = acc[mi][ni];
#pragma unroll
                for (int j = 0; j < 4; ++j) v[j] = sigmoidf_(v[j]);
                *(uint2*)(SAB + (size_t)m * 2048 + n) = pack4(v);
            }
    }
}

__device__ __forceinline__ void ph_merge(const bf16_t* __restrict__ ya, const bf16_t* __restrict__ yb, const bf16_t* __restrict__ WaT, const bf16_t* __restrict__ WbT,
                                         const bf16_t* __restrict__ SAB, bf16_t* __restrict__ mrg, char* smem) {
    GEMM_LANE_VARS
    for (int u = blockIdx.x; u < 128 * 8; u += gridDim.x) {
        const int xg = u & 7, v = u >> 3, tn = v & 7, tm = (v >> 3) * 8 + xg;
        const bf16_t* pa[4]; const bf16_t* pb[4];
#pragma unroll
        for (int i = 0; i < 4; ++i) { pa[i] = ya + (size_t)(tm * 128 + lrow + 32 * i) * 512 + lch8; pb[i] = WaT + (size_t)(tn * 128 + lrow + 32 * i) * 512 + lch8; }
        f32x4 acc1[4][4]; acc_zero(acc1);
        gemm_kloop(acc1, pa, pb, 64, 64, 8, smem);
#pragma unroll
        for (int i = 0; i < 4; ++i) { pa[i] = yb + (size_t)(tm * 128 + lrow + 32 * i) * 512 + lch8; pb[i] = WbT + (size_t)(tn * 128 + lrow + 32 * i) * 512 + lch8; }
        f32x4 acc2[4][4]; acc_zero(acc2);
        gemm_kloop(acc2, pa, pb, 64, 64, 8, smem);
#pragma unroll
        for (int mi = 0; mi < 4; ++mi)
#pragma unroll
            for (int ni = 0; ni < 4; ++ni) {
                const int m = tm * 128 + wr * 64 + mi * 16 + fr, n = tn * 128 + wc * 64 + ni * 16 + 4 * fq;
                const uint2 sa = *(const uint2*)(SAB + (size_t)m * 2048 + n), sb = *(const uint2*)(SAB + (size_t)m * 2048 + 1024 + n);
                f32x4 v;
                v[0] = __uint_as_float(sa.x << 16) * acc1[mi][ni][0] + __uint_as_float(sb.x << 16) * acc2[mi][ni][0];
                v[1] = __uint_as_float(sa.x & 0xFFFF0000u) * acc1[mi][ni][1] + __uint_as_float(sb.x & 0xFFFF0000u) * acc2[mi][ni][1];
                v[2] = __uint_as_float(sa.y << 16) * acc1[mi][ni][2] + __uint_as_float(sb.y << 16) * acc2[mi][ni][2];
                v[3] = __uint_as_float(sa.y & 0xFFFF0000u) * acc1[mi][ni][3] + __uint_as_float(sb.y & 0xFFFF0000u) * acc2[mi][ni][3];
                *(uint2*)(mrg + (size_t)m * 1024 + n) = pack4(v);
            }
    }
}

__device__ __forceinline__ void ph_outproj(const bf16_t* __restrict__ mrg, const bf16_t* __restrict__ WoT, const float* __restrict__ x, float* __restrict__ x2, char* smem) {
    GEMM_LANE_VARS
    for (int u = blockIdx.x; u < 128 * 8; u += gridDim.x) {
        const int xg = u & 7, v = u >> 3, tn = v & 7, tm = (v >> 3) * 8 + xg;
        const bf16_t* pa[4]; const bf16_t* pb[4];
#pragma unroll
        for (int i = 0; i < 4; ++i) { pa[i] = mrg + (size_t)(tm * 128 + lrow + 32 * i) * 1024 + lch8; pb[i] = WoT + (size_t)(tn * 128 + lrow + 32 * i) * 1024 + lch8; }
        f32x4 acc[4][4]; acc_zero(acc);
        gemm_kloop(acc, pa, pb, 64, 64, 16, smem);
#pragma unroll
        for (int mi = 0; mi < 4; ++mi)
#pragma unroll
            for (int ni = 0; ni < 4; ++ni) {
                const int m = tm * 128 + wr * 64 + mi * 16 + fr, n = tn * 128 + wc * 64 + ni * 16 + 4 * fq;
                const float4 xv = *(const float4*)(x + (size_t)m * 1024 + n);
                *(float4*)(x2 + (size_t)m * 1024 + n) = make_float4(xv.x + acc[mi][ni][0], xv.y + acc[mi][ni][1], xv.z + acc[mi][ni][2], xv.w + acc[mi][ni][3]);
            }
    }
}

__device__ __forceinline__ int moe_expert_of(const int* __restrict__ cnt, int m0, int& total) {
    int e = 0, acc = 0;
    for (int i = 0; i < 32; ++i) { const int nacc = acc + ((cnt[i] + 127) & ~127); if (m0 >= acc && m0 < nacc) e = i; acc = nacc; }
    total = acc; return e;
}

__device__ __forceinline__ void ph_moe1(const bf16_t* __restrict__ h2, const bf16_t* __restrict__ WgT, const bf16_t* __restrict__ WuT, const int* __restrict__ cnt,
                                        const int* __restrict__ slot_tok, const float* __restrict__ slot_w, const float* __restrict__ slot_rs, bf16_t* __restrict__ hid, char* smem) {
    GEMM_LANE_VARS
    int total; (void)moe_expert_of(cnt, 0, total);
    const int nu = (total >> 7) * 4;
    for (int u = blockIdx.x; u < nu; u += gridDim.x) {
        const int ft = u & 3, tm = u >> 2; int tt;
        const int e = moe_expert_of(cnt, tm * 128, tt);
        const bf16_t* pa[4]; const bf16_t* pb[4];
#pragma unroll
        for (int i = 0; i < 4; ++i) {
            const int rr = lrow + 32 * i;
            const int tk = slot_tok[tm * 128 + rr];
            pa[i] = h2 + (size_t)(tk >= 0 ? (tk >> 1) : 0) * 1024 + lch8;
            const int bwc = rr >> 6, bni = (rr >> 4) & 3, bj = rr & 15;
            const int f = ft * 64 + bwc * 32 + (bni >> 1) * 16 + bj;
            pb[i] = ((bni & 1) ? WuT : WgT) + ((size_t)e * 256 + f) * 1024 + lch8;
        }
        f32x4 acc[4][4]; acc_zero(acc);
        gemm_kloop(acc, pa, pb, 64, 64, 16, smem);
#pragma unroll
        for (int mi = 0; mi < 4; ++mi) {
            const int m = tm * 128 + wr * 64 + mi * 16 + fr;
            const float w = slot_tok[m] >= 0 ? slot_w[m] : 0.f;
            const float rsv = slot_tok[m] >= 0 ? slot_rs[m] : 0.f;
#pragma unroll
            for (int q = 0; q < 2; ++q) {
                const int f = ft * 64 + wc * 32 + q * 16 + 4 * fq;
                f32x4 v;
#pragma unroll
                for (int j = 0; j < 4; ++j) { const float a = acc[mi][2 * q][j] * rsv, uu = acc[mi][2 * q + 1][j] * rsv; v[j] = a * sigmoidf_(a) * uu * w; }
                *(uint2*)(hid + (size_t)m * 256 + f) = pack4(v);
            }
        }
    }
}

__device__ __forceinline__ void ph_moe2(const bf16_t* __restrict__ hid, const bf16_t* __restrict__ WdT, const int* __restrict__ cnt, const int* __restrict__ slot_tok,
                                        bf16_t* __restrict__ Y, char* smem) {
    GEMM_LANE_VARS
    int total; (void)moe_expert_of(cnt, 0, total);
    const int nu = (total >> 7) * 8;
    for (int u = blockIdx.x; u < nu; u += gridDim.x) {
        const int tn = u & 7, tm = u >> 3; int tt;
        const int e = moe_expert_of(cnt, tm * 128, tt);
        const bf16_t* pa[4]; const bf16_t* pb[4];
#pragma unroll
        for (int i = 0; i < 4; ++i) { pa[i] = hid + (size_t)(tm * 128 + lrow + 32 * i) * 256 + lch8; pb[i] = WdT + ((size_t)e * 1024 + tn * 128 + lrow + 32 * i) * 256 + lch8; }
        f32x4 acc[4][4]; acc_zero(acc);
        gemm_kloop(acc, pa, pb, 64, 64, 4, smem);
#pragma unroll
        for (int mi = 0; mi < 4; ++mi) {
            const int m = tm * 128 + wr * 64 + mi * 16 + fr;
            const int tk = slot_tok[m];
            if (tk >= 0) {
                bf16_t* yr = Y + ((size_t)(tk & 1) * T + (size_t)(tk >> 1)) * 1024 + tn * 128 + wc * 64 + 4 * fq;
#pragma unroll
                for (int ni = 0; ni < 4; ++ni) *(uint2*)(yr + ni * 16) = pack4(acc[mi][ni]);
            }
        }
    }
}

__device__ __forceinline__ void glds16(const void* g, char* l) {
    __builtin_amdgcn_global_load_lds((const __attribute__((address_space(1))) unsigned*)g, (__attribute__((address_space(3))) unsigned*)l, 16, 0, 0);
}
constexpr float LOG2E = 1.4426950408889634f;
constexpr float NEGV = -3.0e38f;
constexpr int NSA_TB = 32768;
constexpr int NSA_IMPA = 34816;
constexpr int NSA_IMPB = NSA_IMPA + 8448;
constexpr int NSA_SELM = NSA_IMPB + 8448;

__device__ __forceinline__ int t5_bucket2(int n) {
    if (n < 16) return n;
    const int l = 16 + (int)(logf((float)n / 16.0f) / logf(8.0f) * 16.0f);
    return l < 31 ? l : 31;
}

template <int MODE>
__device__ __forceinline__ void nsa_branch(const bf16_t* __restrict__ Kb, size_t kstride, const bf16_t* __restrict__ Vb, size_t vstride, int j0, int ntiles, int t0,
                                           const bf16x8 (&qf)[2][2], const int (&qidx)[2], const unsigned long long (&selq)[2], unsigned long long selor,
                                           f32x4 (&O)[4][2], float (&m)[2], float (&l)[2], const float (&invl)[2], char* smem) {
    int tid_ = threadIdx.x; asm volatile("" : "+v"(tid_));
    const int tid = tid_, lane = tid & 63, wid = tid >> 6, fr = lane & 15, fq = lane >> 4, hp = fr & 3;
    const int lrow = tid >> 3, lch8 = (tid & 7) * 8;
    const float* tbias = (const float*)(smem + NSA_TB) + hp * 128;
    const bf16_t* kp[2]; const bf16_t* vp[2];
    const int sch8 = ((tid & 7) ^ (lrow & 7)) * 8;
#pragma unroll
    for (int i = 0; i < 2; ++i) { kp[i] = Kb + (size_t)(lrow + 32 * i) * kstride + sch8; vp[i] = Vb + (size_t)(lrow + 32 * i) * vstride + sch8; }
    __syncthreads();
#pragma unroll
    for (int i = 0; i < 2; ++i) { glds16(kp[i], smem + i * 4096 + tid * 16); if (MODE != 3) glds16(vp[i], smem + 8192 + i * 4096 + tid * 16); }
    asm volatile("s_waitcnt vmcnt(0)" ::: "memory");
    __syncthreads();
    for (int it = 0; it < ntiles; ++it) {
        const int cur = it & 1, j = j0 + it;
        if (it + 1 < ntiles) {
            char* st = smem + (cur ^ 1) * 16384 + tid * 16;
#pragma unroll
            for (int i = 0; i < 2; ++i) { glds16(kp[i] + (size_t)(it + 1) * 64 * kstride, st + i * 4096); if (MODE != 3) glds16(vp[i] + (size_t)(it + 1) * 64, st + 8192 + i * 4096); }
        }
        const char* Kst = smem + cur * 16384;
        const char* Vst = Kst + 8192;
        bool active = true;
        if (MODE == 1) active = ((selor >> j) & 1ull) != 0ull;
        if (active) {
            f32x4 sacc[2][2][2];
#pragma unroll
            for (int p = 0; p < 2; ++p)
#pragma unroll
                for (int s = 0; s < 2; ++s) {
                    const int row = 32 * p + 8 * (fr >> 2) + 4 * s + (fr & 3);
                    const bf16x8 k0 = *(const bf16x8*)(Kst + tile_off(row, fq)), k1 = *(const bf16x8*)(Kst + tile_off(row, 4 + fq));
#pragma unroll
                    for (int ct = 0; ct < 2; ++ct) {
                        f32x4 a = (f32x4){0.f, 0.f, 0.f, 0.f};
                        a = __builtin_amdgcn_mfma_f32_16x16x32_bf16(k0, qf[ct][0], a, 0, 0, 0);
                        a = __builtin_amdgcn_mfma_f32_16x16x32_bf16(k1, qf[ct][1], a, 0, 0, 0);
                        sacc[p][s][ct] = a;
                    }
                }
            bf16x8 pf[2][2];
#pragma unroll
            for (int ct = 0; ct < 2; ++ct) {
                const int q = qidx[ct];
                const bool sel = (MODE == 1) ? (((selq[ct] >> j) & 1ull) != 0ull) : true;
                float mloc = NEGV;
#pragma unroll
                for (int p = 0; p < 2; ++p)
#pragma unroll
                    for (int s = 0; s < 2; ++s)
#pragma unroll
                        for (int i = 0; i < 4; ++i) {
                            const int kk = 64 * j + 32 * p + 8 * fq + 4 * s + i;
                            int rel; bool valid;
                            if (MODE == 0 || MODE == 3) { rel = q - (16 * kk + 31); valid = rel >= 0; }
                            else if (MODE == 1) { rel = q - kk; valid = (rel >= 0) && sel; }
                            else { rel = q - kk; valid = (rel >= 0) && (rel < 512); }
                            const int rc = rel < 0 ? 0 : (rel > 127 ? 127 : rel);
                            const float sv = valid ? sacc[p][s][ct][i] * (0.125f * LOG2E) + tbias[rc] : NEGV;
                            sacc[p][s][ct][i] = sv;
                            mloc = fmaxf(mloc, sv);
                        }
                if (MODE != 3) {
                    mloc = fmaxf(mloc, __shfl_xor(mloc, 16)); mloc = fmaxf(mloc, __shfl_xor(mloc, 32));
                    const float mnew = fmaxf(m[ct], mloc);
                    const float alpha = __builtin_amdgcn_exp2f(m[ct] - mnew);
                    m[ct] = mnew;
                    float psum = 0.f;
#pragma unroll
                    for (int p = 0; p < 2; ++p) {
                        float pv[8];
#pragma unroll
                        for (int s = 0; s < 2; ++s)
#pragma unroll
                            for (int i = 0; i < 4; ++i) { pv[s * 4 + i] = __builtin_amdgcn_exp2f(sacc[p][s][ct][i] - mnew); psum += pv[s * 4 + i]; }
                        u32x4 w; w[0] = pack_bf16(pv[0], pv[1]); w[1] = pack_bf16(pv[2], pv[3]); w[2] = pack_bf16(pv[4], pv[5]); w[3] = pack_bf16(pv[6], pv[7]);
                        pf[ct][p] = __builtin_bit_cast(bf16x8, w);
                    }
                    l[ct] = l[ct] * alpha + psum;
#pragma unroll
                    for (int dt = 0; dt < 4; ++dt) O[dt][ct] = O[dt][ct] * alpha;
                } else {
                    float* impA = (float*)(smem + NSA_IMPA); float* impB = (float*)(smem + NSA_IMPB);
                    const int ql = wid * 8 + ct * 4 + (fr >> 2);
#pragma unroll
                    for (int p = 0; p < 2; ++p)
#pragma unroll
                        for (int s = 0; s < 2; ++s) {
                            float p3 = __builtin_amdgcn_exp2f(sacc[p][s][ct][3] - m[ct]) * invl[ct];
                            float pa = __builtin_amdgcn_exp2f(sacc[p][s][ct][0] - m[ct]) * invl[ct] + __builtin_amdgcn_exp2f(sacc[p][s][ct][1] - m[ct]) * invl[ct]
                                     + __builtin_amdgcn_exp2f(sacc[p][s][ct][2] - m[ct]) * invl[ct] + p3;
                            pa += __shfl_xor(pa, 1); pa += __shfl_xor(pa, 2);
                            p3 += __shfl_xor(p3, 1); p3 += __shfl_xor(p3, 2);
                            const int jj = 16 * j + 8 * p + 2 * fq + s;
                            if (hp == 0) { impA[ql * 65 + jj] = pa; impB[ql * 65 + jj + 1] = p3; }
                        }
                }
            }
            if (MODE != 3) {
#pragma unroll
                for (int dt = 0; dt < 4; ++dt)
#pragma unroll
                    for (int p = 0; p < 2; ++p) {
                        const bf16x8 vf = *(const bf16x8*)(Vst + tile_off(dt * 16 + fr, p * 4 + fq));
#pragma unroll
                        for (int ct = 0; ct < 2; ++ct) O[dt][ct] = __builtin_amdgcn_mfma_f32_16x16x32_bf16(vf, pf[ct][p], O[dt][ct], 0, 0, 0);
                    }
            }
        }
        asm volatile("s_waitcnt vmcnt(0)" ::: "memory");
        __syncthreads();
    }
}

__device__ __forceinline__ void osum_add(uint2& acc, f32x4 o, float sc) {
    f32x4 v;
    v[0] = __uint_as_float(acc.x << 16) + o[0] * sc; v[1] = __uint_as_float(acc.x & 0xFFFF0000u) + o[1] * sc;
    v[2] = __uint_as_float(acc.y << 16) + o[2] * sc; v[3] = __uint_as_float(acc.y & 0xFFFF0000u) + o[3] * sc;
    acc = pack4(v);
}
__device__ __forceinline__ float nsa_gate(const bf16_t* __restrict__ pb, int q, int br, int head) { return sigmoidf_(bf2f(pb[(size_t)q * PP + GA + br * 8 + head])); }

__device__ __forceinline__ void nsa_unit(int u, const bf16_t* __restrict__ proj, const char* __restrict__ ws, const float* __restrict__ rel_bias, bf16_t* __restrict__ ya, char* smem) {
    int tid_ = threadIdx.x; asm volatile("" : "+v"(tid_));
    const int tid = tid_, lane = tid & 63, wid = tid >> 6, fr = lane & 15, fq = lane >> 4, hp = fr & 3;
    const int bg = u & 7, qt = 127 - (u >> 3), b = bg >> 1, g = bg & 1, t0 = qt * 32, tb = t0 >> 6;
    const bf16_t* kcb = (const bf16_t*)(ws + OFF_KCB) + (size_t)bg * 256 * 64;
    const bf16_t* vcbT = (const bf16_t*)(ws + OFF_VCBT) + (size_t)bg * 64 * 256;
    const bf16_t* VsT = (const bf16_t*)(ws + OFF_VST) + (size_t)bg * 64 * S;
    const bf16_t* VwT = (const bf16_t*)(ws + OFF_VWT) + (size_t)bg * 64 * S;
    const bf16_t* pb = proj + (size_t)b * S * PP;
    __syncthreads();
    {
        float* tbl = (float*)(smem + NSA_TB);
        for (int e = tid; e < 512; e += 256) { const int h4 = e >> 7, n = e & 127; tbl[e] = rel_bias[t5_bucket2(n) * 8 + g * 4 + h4] * LOG2E; }
        float* imp = (float*)(smem + NSA_IMPA);
        for (int e = tid; e < 2 * 32 * 66; e += 256) if (e < 4224) imp[e] = 0.f;
    }
    int qidx[2]; bf16x8 qf[2][2];
    const int head = g * 4 + hp;
#pragma unroll
    for (int ct = 0; ct < 2; ++ct) {
        qidx[ct] = t0 + wid * 8 + ct * 4 + (fr >> 2);
        const bf16_t* qr = pb + (size_t)qidx[ct] * PP;
        qf[ct][0] = *(const bf16x8*)(qr + QA + head * 64 + fq * 8);
        qf[ct][1] = *(const bf16x8*)(qr + QA + head * 64 + 32 + fq * 8);
    }
    uint2 osum[4][2];
#pragma unroll
    for (int dt = 0; dt < 4; ++dt)
#pragma unroll
        for (int ct = 0; ct < 2; ++ct) osum[dt][ct] = make_uint2(0u, 0u);
    unsigned long long selq[2] = {0ull, 0ull};
    float invl0[2] = {0.f, 0.f};
    const int ntc = ((t0 >> 4) + 1 + 63) >> 6;
    float mC[2], invC[2];
    {
        f32x4 O[4][2]; float m[2] = {-1e30f, -1e30f}, l[2] = {0.f, 0.f};
#pragma unroll
        for (int dt = 0; dt < 4; ++dt)
#pragma unroll
            for (int ct = 0; ct < 2; ++ct) O[dt][ct] = (f32x4){0.f, 0.f, 0.f, 0.f};
        nsa_branch<0>(kcb, 64, vcbT, 256, 0, ntc, t0, qf, qidx, selq, 0ull, O, m, l, invl0, smem);
#pragma unroll
        for (int ct = 0; ct < 2; ++ct) {
            float lt = l[ct]; lt += __shfl_xor(lt, 16); lt += __shfl_xor(lt, 32);
            invC[ct] = lt > 0.f ? 1.f / lt : 0.f; mC[ct] = m[ct];
#pragma unroll
            for (int dt = 0; dt < 4; ++dt) osum_add(osum[dt][ct], O[dt][ct], nsa_gate(pb, qidx[ct], 0, head) * invC[ct]);
        }
        nsa_branch<3>(kcb, 64, vcbT, 256, 0, ntc, t0, qf, qidx, selq, 0ull, O, mC, l, invC, smem);
    }
    {
        const float* impA = (const float*)(smem + NSA_IMPA); const float* impB = (const float*)(smem + NSA_IMPB);
        unsigned long long* selm = (unsigned long long*)(smem + NSA_SELM);
#pragma unroll 1
        for (int qq = 0; qq < 8; ++qq) {
            const int ql = wid * 8 + qq;
            const float val = impA[ql * 65 + lane] + impB[ql * 65 + lane];
            const bool forced = (lane == 0) || (lane == tb) || (lane == tb - 1);
            unsigned key = forced ? 0xFFFFFFC0u : (lane > tb ? 0u : (__float_as_uint(val) & 0xFFFFFFC0u));
            key |= (unsigned)(63 - lane);
            int rank = 0;
#pragma unroll
            for (int jp = 0; jp < 64; ++jp) rank += ((unsigned)__builtin_amdgcn_readlane((int)key, jp) > key) ? 1 : 0;
            const unsigned long long msk = __ballot(rank < 16);
            if (lane == 0) selm[ql] = msk;
        }
        wave_lds_sync();
        unsigned long long selor = 0ull;
#pragma unroll
        for (int qq = 0; qq < 8; ++qq) selor |= selm[wid * 8 + qq];
        selq[0] = selm[wid * 8 + (fr >> 2)]; selq[1] = selm[wid * 8 + 4 + (fr >> 2)];
        {
            f32x4 O[4][2]; float m[2] = {-1e30f, -1e30f}, l[2] = {0.f, 0.f};
#pragma unroll
            for (int dt = 0; dt < 4; ++dt)
#pragma unroll
                for (int ct = 0; ct < 2; ++ct) O[dt][ct] = (f32x4){0.f, 0.f, 0.f, 0.f};
            nsa_branch<1>(pb + KS + g * 64, PP, VsT, S, 0, tb + 1, t0, qf, qidx, selq, selor, O, m, l, invl0, smem);
#pragma unroll
            for (int ct = 0; ct < 2; ++ct) {
                float lt = l[ct]; lt += __shfl_xor(lt, 16); lt += __shfl_xor(lt, 32);
                const float inv = lt > 0.f ? 1.f / lt : 0.f;
#pragma unroll
                for (int dt = 0; dt < 4; ++dt) osum_add(osum[dt][ct], O[dt][ct], nsa_gate(pb, qidx[ct], 1, head) * inv);
            }
        }
    }
    {
        f32x4 O[4][2]; float m[2] = {-1e30f, -1e30f}, l[2] = {0.f, 0.f};
#pragma unroll
        for (int dt = 0; dt < 4; ++dt)
#pragma unroll
            for (int ct = 0; ct < 2; ++ct) O[dt][ct] = (f32x4){0.f, 0.f, 0.f, 0.f};
        const int jw0 = (t0 - 511 < 0 ? 0 : t0 - 511) >> 6;
        nsa_branch<2>(pb + (size_t)jw0 * 64 * PP + KW + g * 64, PP, VwT + jw0 * 64, S, jw0, tb - jw0 + 1, t0, qf, qidx, selq, 0ull, O, m, l, invl0, smem);
#pragma unroll
        for (int ct = 0; ct < 2; ++ct) {
            float lt = l[ct]; lt += __shfl_xor(lt, 16); lt += __shfl_xor(lt, 32);
            const float inv = lt > 0.f ? 1.f / lt : 0.f;
#pragma unroll
            for (int dt = 0; dt < 4; ++dt) osum_add(osum[dt][ct], O[dt][ct], nsa_gate(pb, qidx[ct], 2, head) * inv);
        }
    }
#pragma unroll
    for (int ct = 0; ct < 2; ++ct) {
        bf16_t* yr = ya + (size_t)(b * S + qidx[ct]) * 512 + head * 64 + 4 * fq;
#pragma unroll
        for (int dt = 0; dt < 4; ++dt) *(uint2*)(yr + dt * 16) = osum[dt][ct];
    }
}

__device__ __forceinline__ void vtrans_tile(int task, const bf16_t* __restrict__ proj, char* ws, char* smem) {
    unsigned short (*tl)[66] = (unsigned short (*)[66])smem;
    const int tid = threadIdx.x, which = task >> 9, bg = (task >> 6) & 7, tt = task & 63, b = bg >> 1, g = bg & 1;
    const int r = tid >> 2, q4 = tid & 3;
    const bf16_t* src = proj + (size_t)(b * S + tt * 64 + r) * PP + (which ? VW : VS) + g * 64 + q4 * 16;
    const uint4 a0 = *(const uint4*)src, a1 = *(const uint4*)(src + 8);
    unsigned* trow = (unsigned*)&tl[r][q4 * 16];
    trow[0] = a0.x; trow[1] = a0.y; trow[2] = a0.z; trow[3] = a0.w; trow[4] = a1.x; trow[5] = a1.y; trow[6] = a1.z; trow[7] = a1.w;
    __syncthreads();
    bf16_t* dst = (bf16_t*)(ws + (which ? OFF_VWT : OFF_VST)) + ((size_t)bg * 64 + r) * S + tt * 64 + q4 * 16;
    unsigned o[8];
#pragma unroll
    for (int k = 0; k < 8; ++k) o[k] = (unsigned)tl[q4 * 16 + 2 * k][r] | ((unsigned)tl[q4 * 16 + 2 * k + 1][r] << 16);
    *(uint4*)dst = make_uint4(o[0], o[1], o[2], o[3]);
    *(uint4*)(dst + 8) = make_uint4(o[4], o[5], o[6], o[7]);
    __syncthreads();
}

__device__ __forceinline__ int tile_el(int row, int col) { return tile_off(row, col >> 3) + ((col & 7) << 1); }

__device__ __forceinline__ void gla_stage_vt(const bf16_t* __restrict__ proj, size_t row0, int h, char* vt_base) {
    const int tid = threadIdx.x, c = tid >> 2, vq = tid & 3;
    const bf16_t* src = proj + (row0 + c) * PP + VB + h * 128 + vq * 32;
#pragma unroll
    for (int k = 0; k < 4; ++k) {
        const u32x4 a = *(const u32x4*)(src + k * 8);
#pragma unroll
        for (int e = 0; e < 4; ++e) {
            const int v = vq * 32 + k * 8 + 2 * e;
            *(unsigned short*)(vt_base + tile_el(v, c)) = (unsigned short)(a[e] & 0xFFFFu);
            *(unsigned short*)(vt_base + tile_el(v + 1, c)) = (unsigned short)(a[e] >> 16);
        }
    }
}

__device__ __forceinline__ void gla_a_unit(int vb, const bf16_t* __restrict__ proj, const float* __restrict__ w_alpha, const float* __restrict__ b_alpha,
                                           float* __restrict__ bc, float* __restrict__ cstate, char* smem) {
    float (*bcS)[64] = (float (*)[64])smem;
    float (*tot)[64] = (float (*)[64])(smem + 16384);
    char* KDT = smem + 17408;
    char* VT = smem + 17408 + 8192;
    const int tid = threadIdx.x, lane = tid & 63, wid = tid >> 6, fr = lane & 15, fq = lane >> 4;
    const int n = vb & 63, h = (vb >> 6) & 3, b = vb >> 8;
    const size_t row0 = (size_t)(b * S + n * 64);
    __syncthreads();
    {
        const int d = tid & 63, cq = tid >> 6, col = h * 64 + d;
        float w[16];
#pragma unroll
        for (int r = 0; r < 16; ++r) w[r] = w_alpha[r * 256 + col];
        const float bias = b_alpha[col];
        float cum = 0.f;
        for (int i = 0; i < 16; ++i) {
            const int c = cq * 16 + i;
            const u32x4 a0 = *(const u32x4*)(proj + (row0 + c) * PP + AB), a1 = *(const u32x4*)(proj + (row0 + c) * PP + AB + 8);
            float z = bias;
#pragma unroll
            for (int e = 0; e < 4; ++e) {
                z += __uint_as_float(a0[e] << 16) * w[2 * e] + __uint_as_float(a0[e] & 0xFFFF0000u) * w[2 * e + 1];
                z += __uint_as_float(a1[e] << 16) * w[8 + 2 * e] + __uint_as_float(a1[e] & 0xFFFF0000u) * w[8 + 2 * e + 1];
            }
            const float ls = fminf(z, 0.f) - log1pf(__expf(-fabsf(z)));
            cum += ls * (1.0f / 16.0f);
            bcS[c][d] = cum;
        }
        tot[cq][d] = cum;
        __syncthreads();
        float pre = 0.f;
        for (int q = 0; q < cq; ++q) pre += tot[q][d];
        for (int i = 0; i < 16; ++i) {
            const int c = cq * 16 + i;
            const float v = bcS[c][d] + pre;
            bcS[c][d] = v;
            bc[(row0 + c) * 256 + col] = v;
        }
    }
    __syncthreads();
    {
        const int c = tid >> 2, dq = tid & 3;
        const bf16_t* src = proj + (row0 + c) * PP + KB + h * 64 + dq * 16;
#pragma unroll
        for (int k = 0; k < 2; ++k) {
            const u32x4 a = *(const u32x4*)(src + k * 8);
#pragma unroll
            for (int e = 0; e < 4; ++e) {
                const int d = dq * 16 + k * 8 + 2 * e;
                const float k0 = __uint_as_float(a[e] << 16) * __expf(bcS[63][d] - bcS[c][d]);
                const float k1 = __uint_as_float(a[e] & 0xFFFF0000u) * __expf(bcS[63][d + 1] - bcS[c][d + 1]);
                *(unsigned short*)(KDT + tile_el(d, c)) = f2bf(k0);
                *(unsigned short*)(KDT + tile_el(d + 1, c)) = f2bf(k1);
            }
        }
    }
    gla_stage_vt(proj, row0, h, VT);
    __syncthreads();
    float* outp = cstate + (size_t)vb * 8192;
#pragma unroll
    for (int vi = 0; vi < 2; ++vi) {
        const int vt = wid * 2 + vi;
        const bf16x8 a0 = *(const bf16x8*)(VT + tile_off(vt * 16 + fr, fq)), a1 = *(const bf16x8*)(VT + tile_off(vt * 16 + fr, 4 + fq));
#pragma unroll
        for (int dt = 0; dt < 4; ++dt) {
            const bf16x8 b0 = *(const bf16x8*)(KDT + tile_off(dt * 16 + fr, fq)), b1 = *(const bf16x8*)(KDT + tile_off(dt * 16 + fr, 4 + fq));
            f32x4 acc = (f32x4){0.f, 0.f, 0.f, 0.f};
            acc = __builtin_amdgcn_mfma_f32_16x16x32_bf16(a0, b0, acc, 0, 0, 0);
            acc = __builtin_amdgcn_mfma_f32_16x16x32_bf16(a1, b1, acc, 0, 0, 0);
#pragma unroll
            for (int i = 0; i < 4; ++i) outp[(vt * 16 + 4 * fq + i) * 64 + dt * 16 + fr] = acc[i];
        }
    }
}

__device__ __forceinline__ void gla_scan_vb2(int vb, const float* __restrict__ bc, float* __restrict__ cstate) {
    const int idx = vb * 256 + threadIdx.x;
    const int e = idx & 8191, bh = idx >> 13, b = bh >> 2, h = bh & 3, d = e & 63;
    float state = 0.f;
    float* base = cstate + (size_t)bh * 64 * 8192 + e;
    const float* bcp = bc + ((size_t)(b * S + 63)) * 256 + h * 64 + d;
#pragma unroll 1
    for (int n0 = 0; n0 < 64; n0 += 16) {
        float upd[16], dec[16];
#pragma unroll
        for (int i = 0; i < 16; ++i) { upd[i] = base[(size_t)(n0 + i) * 8192]; dec[i] = bcp[(size_t)(n0 + i) * 64 * 256]; }
#pragma unroll
        for (int i = 0; i < 16; ++i) { base[(size_t)(n0 + i) * 8192] = state; state = __expf(dec[i]) * state + upd[i]; }
    }
}

__device__ __forceinline__ void gla_c_unit(int vb, const bf16_t* __restrict__ proj, const float* __restrict__ bc, const float* __restrict__ prev,
                                           const float* __restrict__ norm_g, bf16_t* __restrict__ yb, char* smem) {
    char* QI = smem;
    char* KI = smem + 8192;
    char* VT = smem + 16384;
    char* PT = smem + 32768;
    const int tid = threadIdx.x, lane = tid & 63, wid = tid >> 6, fr = lane & 15, fq = lane >> 4;
    const int n = vb & 63, h = (vb >> 6) & 3, b = vb >> 8;
    const size_t row0 = (size_t)(b * S + n * 64);
    __syncthreads();
    {
        const int c = tid >> 2, dq = tid & 3;
        const bf16_t* qs = proj + (row0 + c) * PP + QB + h * 64 + dq * 16;
        const bf16_t* ks = proj + (row0 + c) * PP + KB + h * 64 + dq * 16;
        const float* bs = bc + (row0 + c) * 256 + h * 64 + dq * 16;
#pragma unroll
        for (int k = 0; k < 2; ++k) {
            const u32x4 qa = *(const u32x4*)(qs + k * 8), ka = *(const u32x4*)(ks + k * 8);
            const f32x4 b0 = *(const f32x4*)(bs + k * 8), b1 = *(const f32x4*)(bs + k * 8 + 4);
            const float bv[8] = {b0[0], b0[1], b0[2], b0[3], b1[0], b1[1], b1[2], b1[3]};
            u32x4 qo, ko;
#pragma unroll
            for (int e = 0; e < 4; ++e) {
                const float e0 = __expf(bv[2 * e]), e1 = __expf(bv[2 * e + 1]);
                qo[e] = pack_bf16(__uint_as_float(qa[e] << 16) * 0.125f * e0, __uint_as_float(qa[e] & 0xFFFF0000u) * 0.125f * e1);
                ko[e] = pack_bf16(__uint_as_float(ka[e] << 16) / e0, __uint_as_float(ka[e] & 0xFFFF0000u) / e1);
            }
            *(u32x4*)(QI + tile_off(c, dq * 2 + k)) = qo;
            *(u32x4*)(KI + tile_off(c, dq * 2 + k)) = ko;
        }
    }
    gla_stage_vt(proj, row0, h, VT);
    {
        const int v = tid >> 1, half = tid & 1;
        const float* ps = prev + (size_t)vb * 8192 + v * 64 + half * 32;
#pragma unroll
        for (int k = 0; k < 4; ++k) {
            const f32x4 a = *(const f32x4*)(ps + k * 8), c2 = *(const f32x4*)(ps + k * 8 + 4);
            u32x4 o; o[0] = pack_bf16(a[0], a[1]); o[1] = pack_bf16(a[2], a[3]); o[2] = pack_bf16(c2[0], c2[1]); o[3] = pack_bf16(c2[2], c2[3]);
            *(u32x4*)(PT + tile_off(v, half * 4 + k)) = o;
        }
    }
    __syncthreads();
    const bf16x8 qf0 = *(const bf16x8*)(QI + tile_off(wid * 16 + fr, fq)), qf1 = *(const bf16x8*)(QI + tile_off(wid * 16 + fr, 4 + fq));
    bf16x8 pf[2];
    const int c = wid * 16 + fr;
#pragma unroll
    for (int p = 0; p < 2; ++p) {
        u32x4 w;
#pragma unroll
        for (int s = 0; s < 2; ++s) {
            const int row = 32 * p + 8 * (fr >> 2) + 4 * s + (fr & 3);
            const bf16x8 k0 = *(const bf16x8*)(KI + tile_off(row, fq)), k1 = *(const bf16x8*)(KI + tile_off(row, 4 + fq));
            f32x4 a = (f32x4){0.f, 0.f, 0.f, 0.f};
            a = __builtin_amdgcn_mfma_f32_16x16x32_bf16(k0, qf0, a, 0, 0, 0);
            a = __builtin_amdgcn_mfma_f32_16x16x32_bf16(k1, qf1, a, 0, 0, 0);
#pragma unroll
            for (int i = 0; i < 4; ++i) { const int j = 32 * p + 8 * fq + 4 * s + i; if (j > c) a[i] = 0.f; }
            w[2 * s] = pack_bf16(a[0], a[1]); w[2 * s + 1] = pack_bf16(a[2], a[3]);
        }
        pf[p] = __builtin_bit_cast(bf16x8, w);
    }
    f32x4 acc[8];
    float ss = 0.f;
#pragma unroll
    for (int vt = 0; vt < 8; ++vt) {
        f32x4 a = (f32x4){0.f, 0.f, 0.f, 0.f};
        a = __builtin_amdgcn_mfma_f32_16x16x32_bf16(*(const bf16x8*)(VT + tile_off(vt * 16 + fr, fq)), pf[0], a, 0, 0, 0);
        a = __builtin_amdgcn_mfma_f32_16x16x32_bf16(*(const bf16x8*)(VT + tile_off(vt * 16 + fr, 4 + fq)), pf[1], a, 0, 0, 0);
        a = __builtin_amdgcn_mfma_f32_16x16x32_bf16(*(const bf16x8*)(PT + tile_off(vt * 16 + fr, fq)), qf0, a, 0, 0, 0);
        a = __builtin_amdgcn_mfma_f32_16x16x32_bf16(*(const bf16x8*)(PT + tile_off(vt * 16 + fr, 4 + fq)), qf1, a, 0, 0, 0);
        acc[vt] = a;
        ss += a[0] * a[0] + a[1] * a[1] + a[2] * a[2] + a[3] * a[3];
    }
    ss += __shfl_xor(ss, 16); ss += __shfl_xor(ss, 32);
    const float r = rsqrtf(ss * (1.0f / 128.0f) + 1e-6f);
    const size_t row = row0 + c;
#pragma unroll
    for (int vt = 0; vt < 8; ++vt) {
        const int col = h * 128 + vt * 16 + 4 * fq;
        const uint2 rr = *(const uint2*)(proj + row * PP + RB + col);
        const f32x4 g4 = *(const f32x4*)(norm_g + col);
        const float r0 = __uint_as_float(rr.x << 16), r1 = __uint_as_float(rr.x & 0xFFFF0000u), r2 = __uint_as_float(rr.y << 16), r3 = __uint_as_float(rr.y & 0xFFFF0000u);
        f32x4 o;
        o[0] = acc[vt][0] * r * g4[0] * (r0 * sigmoidf_(r0)); o[1] = acc[vt][1] * r * g4[1] * (r1 * sigmoidf_(r1));
        o[2] = acc[vt][2] * r * g4[2] * (r2 * sigmoidf_(r2)); o[3] = acc[vt][3] * r * g4[3] * (r3 * sigmoidf_(r3));
        *(uint2*)(yb + row * 512 + col) = pack4(o);
    }
}

constexpr int SMEM_BYTES = 65536;

__global__ void __launch_bounds__(256, 2) k_fwd(Params p) {
    extern __shared__ __attribute__((aligned(16))) char smem_dyn[];
    char* smem = smem_dyn + 16;
    if (threadIdx.x == 0) *(uint4*)smem_dyn = make_uint4(0u, 0u, 0u, 0u);
    __syncthreads();
    char* ws = p.ws;
    XcdBarrier bar = xcd_barrier_post((unsigned*)(ws + OFF_BAR), (volatile LAS unsigned*)smem_dyn);
    int* ctrl = (int*)(ws + OFF_CTRL);
    int* route_e = (int*)(ws + OFF_ROUTE_E);
    float* route_w = (float*)(ws + OFF_ROUTE_W);
    int* slot_tok = (int*)(ws + OFF_SLOT_TOK);
    float* slot_w = (float*)(ws + OFF_SLOT_W);
    bf16_t* proj = (bf16_t*)(ws + OFF_PROJ);
    float* bc = (float*)(ws + OFF_BC);
    float* cstate = (float*)(ws + OFF_CSTATE);
    bf16_t* SAB = (bf16_t*)(ws + OFF_SAB);
    bf16_t* mrg = (bf16_t*)(ws + OFF_MRG);
    bf16_t* h2 = (bf16_t*)(ws + OFF_H2);
    bf16_t* hid = (bf16_t*)(ws + OFF_HID);
    bf16_t* Y0 = (bf16_t*)(ws + OFF_Y0);
    bf16_t* Y1 = (bf16_t*)(ws + OFF_Y1);
    bf16_t* ya = (bf16_t*)(ws + OFF_YA);
    bf16_t* yb = (bf16_t*)(ws + OFF_YB);
    bf16_t* kcb = (bf16_t*)(ws + OFF_KCB);
    bf16_t* vcb = (bf16_t*)(ws + OFF_VCB);
    bf16_t* h = (bf16_t*)p.out;
    const int wid = threadIdx.x >> 6, lane = threadIdx.x & 63;
    const int G = gridDim.x;

    ph_prep(p, smem);
    xcd_barrier(bar);
    ph_proj(h, (const bf16_t*)(ws + OFF_WINT), proj, smem);
    xcd_barrier(bar);
    ph_cmp1(proj, ws, smem);
    for (int task = blockIdx.x; task < 1024; task += G) vtrans_tile(task, proj, ws, smem);
    for (int vb = blockIdx.x; vb < 1024; vb += G) gla_a_unit(vb, proj, p.w_alpha, p.b_alpha, bc, cstate, smem);
    xcd_barrier(bar);
    ph_cmp2(ws, ws, smem);
    for (int vb = blockIdx.x; vb < 512; vb += G) gla_scan_vb2(vb, bc, cstate);
    xcd_barrier(bar);
    for (int vb = blockIdx.x; vb < 1024; vb += G) gla_c_unit(vb, proj, bc, cstate, p.norm_g, yb, smem);
    for (int r = 0; r * G < 1024; ++r) {
        const int u = r * G + ((r & 1) ? (G - 1 - (int)blockIdx.x) : (int)blockIdx.x);
        if (u < 1024) nsa_unit(u, proj, ws, p.rel_bias, ya, smem);
    }
    xcd_barrier(bar);
    ph_gates(h, (const bf16_t*)(ws + OFF_WINT), SAB, smem);
    xcd_barrier(bar);
    ph_merge(ya, yb, (const bf16_t*)(ws + OFF_WAT), (const bf16_t*)(ws + OFF_WBT), SAB, mrg, smem);
    xcd_barrier(bar);
    ph_outproj(mrg, (const bf16_t*)(ws + OFF_WOT), p.x, p.out, smem);
    xcd_barrier(bar);
    for (int task = blockIdx.x * 4 + wid; task < 1024; task += G * 4) router_task(task, p.out, p.g_ffn, (const bf16_t*)(ws + OFF_WRT), p.b_rg, p.b_re, h2, (float*)(ws + OFF_RSTD), route_e, route_w, ctrl, smem + wid * 4096, lane);
    xcd_barrier(bar);
    for (int i = blockIdx.x * 256 + threadIdx.x; i < 2 * T; i += G * 256) {
        const int e = route_e[i];
        int off = 0;
        for (int j = 0; j < e; ++j) off += (ctrl[j] + 127) & ~127;
        const int pos = atomicAdd(&ctrl[32 + e], 1);
        slot_tok[off + pos] = i; slot_w[off + pos] = route_w[i]; ((float*)(ws + OFF_SLOT_RS))[off + pos] = ((const float*)(ws + OFF_RSTD))[i >> 1];
    }
    xcd_barrier(bar);
    ph_moe1(h2, (const bf16_t*)(ws + OFF_WGT), (const bf16_t*)(ws + OFF_WUT), ctrl, slot_tok, slot_w, (const float*)(ws + OFF_SLOT_RS), hid, smem);
    xcd_barrier(bar);
    ph_moe2(hid, (const bf16_t*)(ws + OFF_WDT), ctrl, slot_tok, Y0, smem);
    xcd_barrier(bar);
    for (int row = blockIdx.x * 4 + wid; row < T; row += G * 4) final_row(row, p.out, Y0, Y1, p.g_final, lane);
}

extern "C" void kernel_launch(void* const* d_in, const int* in_sizes, int n_in, void* d_out, int out_size, void* d_ws, size_t ws_size, hipStream_t stream) {
    static int grid = 0;
    constexpr int kDynLds = SMEM_BYTES + 16;
    if (!grid) {
        int dev = 0, cus = 0, per_cu = 0;
        (void)hipGetDevice(&dev);
        (void)hipDeviceGetAttribute(&cus, hipDeviceAttributeMultiprocessorCount, dev);
        (void)hipFuncSetAttribute((const void*)k_fwd, hipFuncAttributeMaxDynamicSharedMemorySize, kDynLds);
        (void)hipOccupancyMaxActiveBlocksPerMultiprocessor(&per_cu, k_fwd, 256, kDynLds);
        if (per_cu > 2) per_cu = 2;
        if (per_cu < 1) per_cu = 1;
        grid = cus * per_cu;
    }
    char* ws = (char*)d_ws;
    (void)hipMemsetAsync(ws + OFF_CTRL, 0, 4096, stream);
    (void)hipMemsetAsync(ws + OFF_SLOT_TOK, 0xFF, (size_t)MSLOT * 4, stream);
    (void)hipMemsetAsync(ws + OFF_BAR, 0, 16384, stream);
    Params p{};
    const float** pf = (const float**)&p;
    for (int i = 0; i < 25; ++i) pf[i] = (const float*)d_in[i];
    p.out = (float*)d_out; p.ws = ws;
    k_fwd<<<grid, 256, kDynLds, stream>>>(p);
}
```

```cpp
#include <hip/hip_runtime.h>
#include <stdint.h>

typedef unsigned short bf16_t;
typedef short bf16x8 __attribute__((ext_vector_type(8)));
typedef float f32x4 __attribute__((ext_vector_type(4)));
typedef unsigned u32x4 __attribute__((ext_vector_type(4)));
__device__ __forceinline__ float bf2f(bf16_t v) { return __uint_as_float(((unsigned)v) << 16); }
__device__ __forceinline__ bf16_t f2bf(float f) { unsigned u = __float_as_uint(f); u += 0x7FFFu + ((u >> 16) & 1u); return (bf16_t)(u >> 16); }
__device__ __forceinline__ unsigned pack_bf16(float lo, float hi) { unsigned r; asm volatile("v_cvt_pk_bf16_f32 %0, %1, %2" : "=v"(r) : "v"(lo), "v"(hi)); return r; }

constexpr int Bn = 4, S = 4096, T = Bn * S, D = 1024, NIN = 4904, PP = 2880;
constexpr int QA = 0, KC = 512, VC = 640, KS = 768, VS = 896, KW = 1024, VW = 1152, GA = 1280, QB = 1304, KB = 1560, VB = 1816, AB = 2328, RB = 2344, MGA = 2856, MGB = 3880;
constexpr int NPROJ = 2856;
constexpr int MSLOT = 36864;

constexpr size_t OFF_CTRL = 0;
constexpr size_t OFF_ROUTE_E = 4096;
constexpr size_t OFF_ROUTE_W = OFF_ROUTE_E + 32768 * 4;
constexpr size_t OFF_SLOT_TOK = OFF_ROUTE_W + 32768 * 4;
constexpr size_t OFF_SLOT_W = OFF_SLOT_TOK + (size_t)MSLOT * 4;
constexpr size_t OFF_BAR = OFF_SLOT_W + (size_t)MSLOT * 4;
constexpr size_t OFF_BIAS1 = OFF_BAR + 16384;
constexpr size_t OFF_RSTD = OFF_BIAS1 + 1024;
constexpr size_t OFF_SLOT_RS = OFF_RSTD + (size_t)T * 4;
constexpr size_t OFF_WRT = OFF_SLOT_RS + (size_t)MSLOT * 4;
static_assert(OFF_WRT + 2 * 48 * 1024 * 2 <= (1u << 20), "ctrl overflow");
constexpr size_t OFF_R1 = 1u << 20;
constexpr size_t SZ_PROJ = (size_t)T * PP * 2;
constexpr size_t OFF_PROJ = OFF_R1;
constexpr size_t OFF_BC = OFF_PROJ + SZ_PROJ;
constexpr size_t OFF_CSTATE = OFF_BC + (size_t)T * 256 * 4;
constexpr size_t OFF_R1_END = OFF_CSTATE + (size_t)1024 * 8192 * 4;
constexpr size_t OFF_SAB = OFF_R1;
constexpr size_t OFF_MRG = OFF_SAB + (size_t)T * 2048 * 2;
constexpr size_t OFF_H2 = OFF_R1;
constexpr size_t OFF_HID = OFF_H2 + (size_t)T * 1024 * 2;
constexpr size_t OFF_Y0 = OFF_HID + (size_t)MSLOT * 256 * 2;
constexpr size_t OFF_Y1 = OFF_Y0 + (size_t)T * 1024 * 2;
static_assert(OFF_MRG + (size_t)T * 1024 * 2 <= OFF_R1_END, "alias overflow");
static_assert(OFF_Y1 + (size_t)T * 1024 * 2 <= OFF_R1_END, "alias overflow");
constexpr size_t OFF_YA = OFF_R1_END;
constexpr size_t OFF_YB = OFF_YA + (size_t)T * 512 * 2;
constexpr size_t OFF_KCB = OFF_YB + (size_t)T * 512 * 2;
constexpr size_t OFF_VCB = OFF_KCB + 8 * 256 * 64 * 2;
constexpr size_t OFF_VCBT = OFF_VCB + 8 * 256 * 64 * 2;
constexpr size_t OFF_HIDC = OFF_VCBT + 8 * 256 * 64 * 2;
constexpr size_t OFF_VST = OFF_HIDC + 2 * 2048 * 128 * 2;
constexpr size_t OFF_VWT = OFF_VST + (size_t)8 * 64 * S * 2;
constexpr size_t OFF_WINT = OFF_VWT + (size_t)8 * 64 * S * 2;
constexpr size_t OFF_CK1T = OFF_WINT + (size_t)NIN * 1024 * 2;
constexpr size_t OFF_CV1T = OFF_CK1T + 128 * 2048 * 2;
constexpr size_t OFF_CK2T = OFF_CV1T + 128 * 2048 * 2;
constexpr size_t OFF_CV2T = OFF_CK2T + 128 * 128 * 2;
constexpr size_t OFF_WAT = OFF_CV2T + 128 * 128 * 2;
constexpr size_t OFF_WBT = OFF_WAT + 1024 * 512 * 2;
constexpr size_t OFF_WOT = OFF_WBT + 1024 * 512 * 2;
constexpr size_t OFF_WGT = OFF_WOT + 1024 * 1024 * 2;
constexpr size_t OFF_WUT = OFF_WGT + (size_t)32 * 256 * 1024 * 2;
constexpr size_t OFF_WDT = OFF_WUT + (size_t)32 * 256 * 1024 * 2;
constexpr size_t OFF_END = OFF_WDT + (size_t)32 * 1024 * 256 * 2;
static_assert(OFF_END <= (size_t)256 << 20, "workspace overflow");

#define XB_TMO      128
#define XB_XCNT(j)  (256  + 64 * (j))
#define XB_XSUB(j)  (1280 + 64 * (j))
#define XB_XGEN(j)  (2304 + 64 * (j))
#define XB_TOP      3328
#define XB_TOPGEN   3392
#define XCD_BAR_WORDS 3456
#define XB_SPIN_CAP (1u << 18)
#define LAS __attribute__((address_space(3)))

__device__ __forceinline__ unsigned xb_ld(unsigned* p)              { return __hip_atomic_load(p, __ATOMIC_RELAXED, __HIP_MEMORY_SCOPE_AGENT); }
__device__ __forceinline__ unsigned xb_add(unsigned* p, unsigned v) { return __hip_atomic_fetch_add(p, v, __ATOMIC_RELAXED, __HIP_MEMORY_SCOPE_AGENT); }
__device__ __forceinline__ unsigned xb_xcc_id() { return (unsigned)__builtin_amdgcn_s_getreg((3 << 11) | 20) & 0xFu; }
#define XB_SPIN(cond, bar) do { unsigned _sp = 0; while (cond) { __builtin_amdgcn_s_sleep(1); \
    if ((++_sp & 255u) == 0u) { if (xb_ld(&(bar)[XB_TMO])) break; if (_sp > XB_SPIN_CAP) { atomicAdd(&(bar)[XB_TMO], 1u); break; } } } } while (0)

struct XcdBarrier { unsigned* bar; unsigned x; volatile LAS unsigned* st; };

__device__ __forceinline__ XcdBarrier xcd_barrier_post(unsigned* bar, volatile LAS unsigned* st) {
    XcdBarrier b; b.bar = bar; b.x = xb_xcc_id(); b.st = st;
    if (threadIdx.x == 0) (void)xb_add(&bar[XB_XCNT(b.x)], 1u);
    return b;
}
__device__ __forceinline__ void xcd_barrier_complete(unsigned* bar, unsigned x, unsigned& nloc, unsigned& nx) {
    const unsigned G = gridDim.x * gridDim.y * gridDim.z;
    unsigned sum, cnt, mine, sp = 0u;
    for (;;) {
        sum = 0u; cnt = 0u; mine = 0u;
#pragma unroll
        for (unsigned j = 0; j < 16; ++j) { const unsigned c = xb_ld(&bar[XB_XCNT(j)]); sum += c; cnt += (c > 0u) ? 1u : 0u; mine = (j == x) ? c : mine; }
        if (sum == G) break;
        __builtin_amdgcn_s_sleep(1);
        if ((++sp & 255u) == 0u) { if (xb_ld(&bar[XB_TMO])) break; if (sp > XB_SPIN_CAP) { atomicAdd(&bar[XB_TMO], 1u); break; } }
    }
    nloc = mine > 0u ? mine : 1u; nx = cnt > 0u ? cnt : 1u;
}
__device__ __forceinline__ void xcd_barrier(const XcdBarrier& b) {
    asm volatile("s_waitcnt vmcnt(0)" ::: "memory");
    __syncthreads();
    if (threadIdx.x == 0) {
        unsigned* bar = b.bar;
        __builtin_amdgcn_s_waitcnt(0);
        unsigned nloc = b.st[0], nx = b.st[1];
        if (nloc == 0u) { xcd_barrier_complete(bar, b.x, nloc, nx); b.st[0] = nloc; b.st[1] = nx; }
        const unsigned old = xb_add(&bar[XB_XSUB(b.x)], 1u);
        const unsigned gen = old / nloc;
        if (old + 1u == (gen + 1u) * nloc) {
            __builtin_amdgcn_fence(__ATOMIC_RELEASE, "agent");
            asm volatile("s_waitcnt vmcnt(0)" ::: "memory");
            const unsigned og = xb_add(&bar[XB_TOP], 1u);
            const unsigned tg = og / nx;
            if (og + 1u == (tg + 1u) * nx) xb_add(&bar[XB_TOPGEN], 1u);
            else XB_SPIN(xb_ld(&bar[XB_TOPGEN]) == tg, bar);
            __builtin_amdgcn_fence(__ATOMIC_ACQUIRE, "agent");
            xb_add(&bar[XB_XGEN(b.x)], 1u);
            asm volatile("s_waitcnt vmcnt(0)" ::: "memory");
        } else {
            XB_SPIN(xb_ld(&bar[XB_XGEN(b.x)]) == gen, bar);
            __builtin_amdgcn_fence(__ATOMIC_ACQUIRE, "agent");
            asm volatile("s_waitcnt vmcnt(0)" ::: "memory");
        }
    }
    __syncthreads();
}


struct Params {
    const float *x, *g_mix, *w_in, *pe_k, *ck1, *ck2, *pe_v, *cv1, *cv2, *rel_bias, *w_alpha, *b_alpha, *norm_g, *w_ba, *w_bb, *w_out, *g_ffn,
                *w_rg, *b_rg, *w_re, *b_re, *w_eg, *w_eu, *w_ed, *g_final;
    float* out; char* ws;
};

__device__ __forceinline__ float wave_max(float v) { for (int o = 32; o > 0; o >>= 1) v = fmaxf(v, __shfl_xor(v, o)); return v; }
__device__ __forceinline__ float wave_sum(float v) { for (int o = 32; o > 0; o >>= 1) v += __shfl_xor(v, o); return v; }
__device__ __forceinline__ void wave_lds_sync() { asm volatile("s_waitcnt lgkmcnt(0)" ::: "memory"); }


__device__ __forceinline__ void rms_h_row(int row, const float* __restrict__ x, const float* __restrict__ g, bf16_t* __restrict__ h, int lane) {
    const float* xr = x + (size_t)row * D + lane * 4;
    f32x4 v[4]; float s = 0.f;
#pragma unroll
    for (int i = 0; i < 4; ++i) { v[i] = *(const f32x4*)(xr + 256 * i); s += v[i][0] * v[i][0] + v[i][1] * v[i][1] + v[i][2] * v[i][2] + v[i][3] * v[i][3]; }
    s = wave_sum(s);
    const float r = rsqrtf(s * (1.0f / D) + 1e-6f);
#pragma unroll
    for (int i = 0; i < 4; ++i) {
        const f32x4 gg = *(const f32x4*)(g + lane * 4 + 256 * i);
        uint2 o; o.x = pack_bf16(v[i][0] * r * gg[0], v[i][1] * r * gg[1]); o.y = pack_bf16(v[i][2] * r * gg[2], v[i][3] * r * gg[3]);
        *(uint2*)(h + (size_t)row * D + lane * 4 + 256 * i) = o;
    }
}
__device__ __forceinline__ void final_row(int row, float* __restrict__ x2out, const bf16_t* __restrict__ Y0, const bf16_t* __restrict__ Y1, const float* __restrict__ g, int lane) {
    float* xr = x2out + (size_t)row * D + lane * 4;
    f32x4 v[4]; float s = 0.f;
#pragma unroll
    for (int i = 0; i < 4; ++i) {
        v[i] = *(const f32x4*)(xr + 256 * i);
        const uint2 a = *(const uint2*)(Y0 + (size_t)row * D + lane * 4 + 256 * i), c = *(const uint2*)(Y1 + (size_t)row * D + lane * 4 + 256 * i);
        v[i][0] += __uint_as_float(a.x << 16) + __uint_as_float(c.x << 16);
        v[i][1] += __uint_as_float(a.x & 0xFFFF0000u) + __uint_as_float(c.x & 0xFFFF0000u);
        v[i][2] += __uint_as_float(a.y << 16) + __uint_as_float(c.y << 16);
        v[i][3] += __uint_as_float(a.y & 0xFFFF0000u) + __uint_as_float(c.y & 0xFFFF0000u);
        s += v[i][0] * v[i][0] + v[i][1] * v[i][1] + v[i][2] * v[i][2] + v[i][3] * v[i][3];
    }
    s = wave_sum(s);
    const float r = rsqrtf(s * (1.0f / D) + 1e-6f);
#pragma unroll
    for (int i = 0; i < 4; ++i) {
        const f32x4 gg = *(const f32x4*)(g + lane * 4 + 256 * i);
        *(f32x4*)(xr + 256 * i) = (f32x4){v[i][0] * r * gg[0], v[i][1] * r * gg[1], v[i][2] * r * gg[2], v[i][3] * r * gg[3]};
    }
}

__device__ __forceinline__ void prep_router_w(const float* __restrict__ w_rg, const float* __restrict__ w_re, bf16_t* __restrict__ WrT) {
    for (int idx = blockIdx.x * 256 + threadIdx.x; idx < 48 * 1024; idx += gridDim.x * 256) {
        const int n = idx >> 10, k = idx & 1023;
        const float w = n < 4 ? w_rg[k * 4 + n] : (n < 36 ? w_re[k * 32 + n - 4] : 0.f);
        const bf16_t hi = f2bf(w);
        WrT[idx] = hi; WrT[48 * 1024 + idx] = f2bf(w - bf2f(hi));
    }
}

__device__ __forceinline__ void router_task(int task, const float* __restrict__ x2, const float* __restrict__ g, const bf16_t* __restrict__ WrT,
                                            const float* __restrict__ b_rg, const float* __restrict__ b_re, bf16_t* __restrict__ h2, float* __restrict__ rstd_out,
                                            int* __restrict__ route_e, float* __restrict__ route_w, int* __restrict__ cnt, char* wsm, int lane) {
    float (*lg)[49] = (float (*)[49])wsm;
    float* rs = (float*)(wsm + 16 * 49 * 4);
    const int fr = lane & 15, fq = lane >> 4, r0 = task * 16;
    const float* xr = x2 + (size_t)(r0 + fr) * D + fq * 8;
    bf16_t* hr = h2 + (size_t)(r0 + fr) * D + fq * 8;
    const bf16_t* wh = WrT + (size_t)fr * 1024 + fq * 8;
    f32x4 acc[3];
#pragma unroll
    for (int nt = 0; nt < 3; ++nt) acc[nt] = (f32x4){0.f, 0.f, 0.f, 0.f};
    float ssq = 0.f;
#pragma unroll 2
    for (int ks = 0; ks < 32; ++ks) {
        const f32x4 x0 = *(const f32x4*)(xr + ks * 32), x1 = *(const f32x4*)(xr + ks * 32 + 4);
        const f32x4 g0 = *(const f32x4*)(g + ks * 32 + fq * 8), g1 = *(const f32x4*)(g + ks * 32 + fq * 8 + 4);
        float xg[8];
#pragma unroll
        for (int e = 0; e < 4; ++e) { xg[e] = x0[e] * g0[e]; xg[4 + e] = x1[e] * g1[e]; ssq += x0[e] * x0[e] + x1[e] * x1[e]; }
        u32x4 hi, lo;
#pragma unroll
        for (int e = 0; e < 4; ++e) {
            hi[e] = pack_bf16(xg[2 * e], xg[2 * e + 1]);
            lo[e] = pack_bf16(xg[2 * e] - __uint_as_float(hi[e] << 16), xg[2 * e + 1] - __uint_as_float(hi[e] & 0xFFFF0000u));
        }
        *(u32x4*)(hr + ks * 32) = hi;
        const bf16x8 ah = __builtin_bit_cast(bf16x8, hi), al = __builtin_bit_cast(bf16x8, lo);
#pragma unroll
        for (int nt = 0; nt < 3; ++nt) {
            const bf16x8 bh = *(const bf16x8*)(wh + (size_t)nt * 16 * 1024 + ks * 32), bl = *(const bf16x8*)(wh + (size_t)(48 + nt * 16) * 1024 + ks * 32);
            acc[nt] = __builtin_amdgcn_mfma_f32_16x16x32_bf16(ah, bh, acc[nt], 0, 0, 0);
            acc[nt] = __builtin_amdgcn_mfma_f32_16x16x32_bf16(al, bh, acc[nt], 0, 0, 0);
            acc[nt] = __builtin_amdgcn_mfma_f32_16x16x32_bf16(ah, bl, acc[nt], 0, 0, 0);
        }
    }
    ssq += __shfl_xor(ssq, 16); ssq += __shfl_xor(ssq, 32);
    const float rstd = rsqrtf(ssq * (1.0f / D) + 1e-6f);
    wave_lds_sync();
    if (fq == 0) { rs[fr] = rstd; rstd_out[r0 + fr] = rstd; }
#pragma unroll
    for (int nt = 0; nt < 3; ++nt)
#pragma unroll
        for (int i = 0; i < 4; ++i) lg[4 * fq + i][nt * 16 + fr] = acc[nt][i];
    wave_lds_sync();
    if (lane < 16) {
        const int row = r0 + lane; const float rsv = rs[lane];
        float l4[4];
#pragma unroll
        for (int j = 0; j < 4; ++j) l4[j] = lg[lane][j] * rsv + b_rg[j];
        int gs = 0; float mx = l4[0];
#pragma unroll
        for (int j = 1; j < 4; ++j) if (l4[j] > mx) { mx = l4[j]; gs = j; }
        float den = 0.f;
#pragma unroll
        for (int j = 0; j < 4; ++j) den += __expf(l4[j] - mx);
        const float gp = 1.f / den;
        float v0 = -3e38f, v1 = -3e38f; int i0 = 0, i1 = 0;
        for (int j = 0; j < 8; ++j) {
            const float l = lg[lane][4 + gs * 8 + j] * rsv + b_re[gs * 8 + j];
            if (l > v0) { v1 = v0; i1 = i0; v0 = l; i0 = j; }
            else if (l > v1) { v1 = l; i1 = j; }
        }
        const float e1 = __expf(v1 - v0);
        const float w0 = gp / (1.f + e1), w1 = gp * e1 / (1.f + e1);
        const int ea = gs * 8 + i0, eb = gs * 8 + i1;
        route_e[row * 2] = ea; route_e[row * 2 + 1] = eb;
        route_w[row * 2] = w0; route_w[row * 2 + 1] = w1;
        atomicAdd(&cnt[ea], 1); atomicAdd(&cnt[eb], 1);
    }
    wave_lds_sync();
}
__device__ __forceinline__ void transpose_tile(const float* __restrict__ src, int ld_src, int N, bf16_t* __restrict__ dst, int ld_dst, int kt, int nt, char* smem) {
    float (*tl)[65] = (float (*)[65])smem;
    const int tid = threadIdx.x;
    const int c4 = (tid & 15) * 4, r0 = tid >> 4;
#pragma unroll
    for (int i = 0; i < 4; ++i) {
        const int k = r0 + 16 * i, n = nt * 64 + c4;
        float4 v = make_float4(0.f, 0.f, 0.f, 0.f);
        if (n < N) v = *(const float4*)(src + (size_t)(kt * 64 + k) * ld_src + n);
        tl[k][c4] = v.x; tl[k][c4 + 1] = v.y; tl[k][c4 + 2] = v.z; tl[k][c4 + 3] = v.w;
    }
    __syncthreads();
    const int kc = (tid & 7) * 8, n0 = tid >> 3;
#pragma unroll
    for (int i = 0; i < 2; ++i) {
        const int nl = n0 + 32 * i, n = nt * 64 + nl;
        if (n < N) {
            uint4 o;
            o.x = pack_bf16(tl[kc][nl], tl[kc + 1][nl]); o.y = pack_bf16(tl[kc + 2][nl], tl[kc + 3][nl]);
            o.z = pack_bf16(tl[kc + 4][nl], tl[kc + 5][nl]); o.w = pack_bf16(tl[kc + 6][nl], tl[kc + 7][nl]);
            *(uint4*)(dst + (size_t)n * ld_dst + kt * 64 + kc) = o;
        }
    }
    __syncthreads();
}

__device__ __forceinline__ void ph_prep(const Params& p, char* smem) {
    char* ws = p.ws;
    constexpr int N0 = 16 * 77, N1 = N0 + 64, N2 = N1 + 64, N3 = N2 + 2, N4 = N3 + 2, N5 = N4 + 128, N6 = N5 + 128, N7 = N6 + 256, N8 = N7 + 2048, N9 = N8 + 2048, N10 = N9 + 2048;
    for (int t = blockIdx.x; t < N10; t += gridDim.x) {
        if (t < N0) transpose_tile(p.w_in, NIN, NIN, (bf16_t*)(ws + OFF_WINT), 1024, t / 77, t % 77, smem);
        else if (t < N1) { const int q = t - N0; transpose_tile(p.ck1, 128, 128, (bf16_t*)(ws + OFF_CK1T), 2048, q >> 1, q & 1, smem); }
        else if (t < N2) { const int q = t - N1; transpose_tile(p.cv1, 128, 128, (bf16_t*)(ws + OFF_CV1T), 2048, q >> 1, q & 1, smem); }
        else if (t < N3) { const int q = t - N2; transpose_tile(p.ck2, 64, 64, (bf16_t*)(ws + OFF_CK2T), 128, q, 0, smem); }
        else if (t < N4) { const int q = t - N3; transpose_tile(p.cv2, 64, 64, (bf16_t*)(ws + OFF_CV2T), 128, q, 0, smem); }
        else if (t < N5) { const int q = t - N4; transpose_tile(p.w_ba, 1024, 1024, (bf16_t*)(ws + OFF_WAT), 512, q >> 4, q & 15, smem); }
        else if (t < N6) { const int q = t - N5; transpose_tile(p.w_bb, 1024, 1024, (bf16_t*)(ws + OFF_WBT), 512, q >> 4, q & 15, smem); }
        else if (t < N7) { const int q = t - N6; transpose_tile(p.w_out, 1024, 1024, (bf16_t*)(ws + OFF_WOT), 1024, q >> 4, q & 15, smem); }
        else if (t < N8) { const int q = t - N7, e = q >> 6, r = q & 63; transpose_tile(p.w_eg + (size_t)e * 1024 * 256, 256, 256, (bf16_t*)(ws + OFF_WGT) + (size_t)e * 256 * 1024, 1024, r >> 2, r & 3, smem); }
        else if (t < N9) { const int q = t - N8, e = q >> 6, r = q & 63; transpose_tile(p.w_eu + (size_t)e * 1024 * 256, 256, 256, (bf16_t*)(ws + OFF_WUT) + (size_t)e * 256 * 1024, 1024, r >> 2, r & 3, smem); }
        else { const int q = t - N9, e = q >> 6, r = q & 63; transpose_tile(p.w_ed + (size_t)e * 256 * 1024, 1024, 1024, (bf16_t*)(ws + OFF_WDT) + (size_t)e * 1024 * 256, 256, r >> 4, r & 15, smem); }
    }
    for (int t = blockIdx.x; t < 8; t += gridDim.x) {
        const int which = t >> 2, n = (t & 3) * 32 + (threadIdx.x & 31), ksp = threadIdx.x >> 5;
        const float* pe = which ? p.pe_v : p.pe_k; const float* w1 = which ? p.cv1 : p.ck1;
        float a = 0.f;
        for (int k = ksp * 256; k < ksp * 256 + 256; ++k) a += pe[k] * w1[(size_t)k * 128 + n];
        float* red = (float*)smem;
        red[threadIdx.x] = a;
        __syncthreads();
        if (threadIdx.x < 32) {
            float s = 0.f;
#pragma unroll
            for (int j = 0; j < 8; ++j) s += red[j * 32 + threadIdx.x];
            ((float*)(ws + OFF_BIAS1))[which * 128 + n] = s;
        }
        __syncthreads();
    }
    prep_router_w(p.w_rg, p.w_re, (bf16_t*)(ws + OFF_WRT));
    for (int row = blockIdx.x * 4 + (threadIdx.x >> 6); row < T; row += gridDim.x * 4) rms_h_row(row, p.x, p.g_mix, (bf16_t*)p.out, threadIdx.x & 63);
}

__device__ __forceinline__ int tile_off(int row, int chunk) { return row * 128 + ((chunk ^ (row & 7)) << 4); }

__device__ __forceinline__ void glds16(const void* g, char* l) {
    __builtin_amdgcn_global_load_lds((const __attribute__((address_space(1))) unsigned*)g, (__attribute__((address_space(3))) unsigned*)l, 16, 0, 0);
}
__device__ __forceinline__ void gemm_kloop(f32x4 (&acc)[4][4], const bf16_t* const (&pa)[4], const bf16_t* const (&pb)[4], int ka, int kb, int nk, char* smem) {
    int tid_ = threadIdx.x; asm volatile("" : "+v"(tid_));
    const int tid = tid_, lane = tid & 63, wid = tid >> 6, wr = wid >> 1, wc = wid & 1, fr = lane & 15, fq = lane >> 4;
    const int offA = (wr * 64 + fr) * 128, offB = 16384 + (wc * 64 + fr) * 128, x = fr & 7;
    __syncthreads();
#pragma unroll
    for (int i = 0; i < 4; ++i) { glds16(pa[i], smem + i * 4096 + tid * 16); glds16(pb[i], smem + 16384 + i * 4096 + tid * 16); }
    asm volatile("s_waitcnt vmcnt(0)" ::: "memory");
    __syncthreads();
    for (int kt = 0; kt < nk; ++kt) {
        const int cur = kt & 1;
        if (kt + 1 < nk) {
            char* st = smem + (cur ^ 1) * 32768 + tid * 16;
#pragma unroll
            for (int i = 0; i < 4; ++i) { glds16(pa[i] + (size_t)(kt + 1) * ka, st + i * 4096); glds16(pb[i] + (size_t)(kt + 1) * kb, st + 16384 + i * 4096); }
        }
        const char* sa = smem + cur * 32768 + offA;
        const char* sb = smem + cur * 32768 + offB;
#pragma unroll
        for (int ks = 0; ks < 2; ++ks) {
            const int ch = ((ks * 4 + fq) ^ x) << 4;
            bf16x8 af[4], bfr[4];
#pragma unroll
            for (int mi = 0; mi < 4; ++mi) af[mi] = *(const bf16x8*)(sa + mi * 2048 + ch);
#pragma unroll
            for (int ni = 0; ni < 4; ++ni) bfr[ni] = *(const bf16x8*)(sb + ni * 2048 + ch);
#pragma unroll
            for (int mi = 0; mi < 4; ++mi)
#pragma unroll
                for (int ni = 0; ni < 4; ++ni) acc[mi][ni] = __builtin_amdgcn_mfma_f32_16x16x32_bf16(bfr[ni], af[mi], acc[mi][ni], 0, 0, 0);
        }
        asm volatile("s_waitcnt vmcnt(0)" ::: "memory");
        __syncthreads();
    }
}
__device__ __forceinline__ void acc_zero(f32x4 (&acc)[4][4]) {
#pragma unroll
    for (int mi = 0; mi < 4; ++mi)
#pragma unroll
        for (int ni = 0; ni < 4; ++ni) acc[mi][ni] = (f32x4){0.f, 0.f, 0.f, 0.f};
}
#define GEMM_LANE_VARS const int tid = threadIdx.x, lane = tid & 63, wid = tid >> 6, wr = wid >> 1, wc = wid & 1, fr = lane & 15, fq = lane >> 4, lrow = tid >> 3, lch8 = ((tid & 7) ^ ((tid >> 3) & 7)) * 8; (void)wr; (void)wc; (void)fr; (void)fq; (void)lrow; (void)lch8;
__device__ __forceinline__ uint2 pack4(f32x4 v) { uint2 o; o.x = pack_bf16(v[0], v[1]); o.y = pack_bf16(v[2], v[3]); return o; }
__device__ __forceinline__ float sigmoidf_(float a) { return 1.f / (1.f + __expf(-a)); }

__device__ __forceinline__ void ph_proj(const bf16_t* __restrict__ h, const bf16_t* __restrict__ WinT, bf16_t* __restrict__ proj, char* smem) {
    GEMM_LANE_VARS
    for (int u = blockIdx.x; u < 128 * 23; u += gridDim.x) {
        const int xg = u & 7, v = u >> 3, tn = v % 23, tm = (v / 23) * 8 + xg;
        const bf16_t* pa[4]; const bf16_t* pb[4];
#pragma unroll
        for (int i = 0; i < 4; ++i) { pa[i] = h + (size_t)(tm * 128 + lrow + 32 * i) * 1024 + lch8; pb[i] = WinT + (size_t)(tn * 128 + lrow + 32 * i) * 1024 + lch8; }
        f32x4 acc[4][4]; acc_zero(acc);
        gemm_kloop(acc, pa, pb, 64, 64, 16, smem);
#pragma unroll
        for (int mi = 0; mi < 4; ++mi)
#pragma unroll
            for (int ni = 0; ni < 4; ++ni) {
                const int m = tm * 128 + wr * 64 + mi * 16 + fr, n = tn * 128 + wc * 64 + ni * 16 + 4 * fq;
                if (n < NPROJ) *(uint2*)(proj + (size_t)m * PP + n) = pack4(acc[mi][ni]);
            }
    }
}

__device__ __forceinline__ void ph_cmp1(const bf16_t* __restrict__ proj, const char* ws, char* smem) {
    GEMM_LANE_VARS
    for (int u = blockIdx.x; u < 32; u += gridDim.x) {
        const int which = u >> 4, tm = u & 15;
        const bf16_t* W1T = (const bf16_t*)(ws + (which ? OFF_CV1T : OFF_CK1T));
        const float* bias1 = (const float*)(ws + OFF_BIAS1) + which * 128;
        bf16_t* hid = (bf16_t*)(ws + OFF_HIDC) + (size_t)which * 2048 * 128;
        const int col0 = which ? VC : KC;
        const bf16_t* pa[4]; const bf16_t* pb[4];
#pragma unroll
        for (int i = 0; i < 4; ++i) {
            const int m = tm * 128 + lrow + 32 * i, bg = m >> 8, c = (m & 255) > 254 ? 254 : (m & 255), b = bg >> 1, g = bg & 1;
            pa[i] = proj + (size_t)(b * S + 16 * c) * PP + col0 + g * 64 + lch8;
            pb[i] = W1T + (size_t)(lrow + 32 * i) * 2048 + lch8;
        }
        f32x4 acc[4][4]; acc_zero(acc);
        gemm_kloop(acc, pa, pb, PP, 64, 32, smem);
#pragma unroll
        for (int mi = 0; mi < 4; ++mi)
#pragma unroll
            for (int ni = 0; ni < 4; ++ni) {
                const int m = tm * 128 + wr * 64 + mi * 16 + fr, n = wc * 64 + ni * 16 + 4 * fq;
                f32x4 v = acc[mi][ni];
#pragma unroll
                for (int j = 0; j < 4; ++j) { const float a = v[j] + bias1[n + j]; const float t = 0.7978845608028654f * (a + 0.044715f * a * a * a); v[j] = 0.5f * a * (1.f + tanhf(t)); }
                *(uint2*)(hid + (size_t)m * 128 + n) = pack4(v);
            }
    }
}

__device__ __forceinline__ void ph_cmp2(const char* ws_c, char* ws, char* smem) {
    GEMM_LANE_VARS
    for (int u = blockIdx.x; u < 32; u += gridDim.x) {
        const int which = u >> 4, tm = u & 15;
        const bf16_t* W2T = (const bf16_t*)(ws_c + (which ? OFF_CV2T : OFF_CK2T));
        const bf16_t* hid = (const bf16_t*)(ws_c + OFF_HIDC) + (size_t)which * 2048 * 128;
        const bf16_t* pa[4]; const bf16_t* pb[4];
#pragma unroll
        for (int i = 0; i < 4; ++i) { pa[i] = hid + (size_t)(tm * 128 + lrow + 32 * i) * 128 + lch8; pb[i] = W2T + (size_t)(lrow + 32 * i) * 128 + lch8; }
        f32x4 acc[4][4]; acc_zero(acc);
        gemm_kloop(acc, pa, pb, 64, 64, 2, smem);
        if (wc == 0) {
            bf16_t* outp = (bf16_t*)(ws + (which ? OFF_VCB : OFF_KCB));
            bf16_t* outT = (bf16_t*)(ws + OFF_VCBT);
#pragma unroll
            for (int mi = 0; mi < 4; ++mi)
#pragma unroll
                for (int ni = 0; ni < 4; ++ni) {
                    const int m = tm * 128 + wr * 64 + mi * 16 + fr, n = ni * 16 + 4 * fq, c = m & 255, bg = m >> 8;
                    f32x4 v = acc[mi][ni];
                    if (c == 255) v = (f32x4){0.f, 0.f, 0.f, 0.f};
                    *(uint2*)(outp + (size_t)m * 64 + n) = pack4(v);
                    if (which) {
#pragma unroll
                        for (int j = 0; j < 4; ++j) outT[((size_t)bg * 64 + n + j) * 256 + c] = f2bf(v[j]);
                    }
                }
        }
    }
}

__device__ __forceinline__ void ph_gates(const bf16_t* __restrict__ h, const bf16_t* __restrict__ WinT, bf16_t* __restrict__ SAB, char* smem) {
    GEMM_LANE_VARS
    for (int u = blockIdx.x; u < 128 * 16; u += gridDim.x) {
        const int xg = u & 7, v = u >> 3, tn = v & 15, tm = (v >> 4) * 8 + xg;
        const bf16_t* pa[4]; const bf16_t* pb[4];
#pragma unroll
        for (int i = 0; i < 4; ++i) { pa[i] = h + (size_t)(tm * 128 + lrow + 32 * i) * 1024 + lch8; pb[i] = WinT + (size_t)(MGA + tn * 128 + lrow + 32 * i) * 1024 + lch8; }
        f32x4 acc[4][4]; acc_zero(acc);
        gemm_kloop(acc, pa, pb, 64, 64, 16, smem);
#pragma unroll
        for (int mi = 0; mi < 4; ++mi)
#pragma unroll
            for (int ni = 0; ni < 4; ++ni) {
                const int m = tm * 128 + wr * 64 + mi * 16 + fr, n = tn * 128 + wc * 64 + ni * 16 + 4 * fq;
                f32x4 v = acc[mi][ni];
#pragma unroll
                for (int j = 0; j < 4; ++j) v[j] = sigmoidf_(v[j]);
                *(uint2*)(SAB + (size_t)m * 2048 + n) = pack4(v);
            }
    }
}

__device__ __forceinline__ void ph_merge(const bf16_t* __restrict__ ya, const bf16_t* __restrict__ yb, const bf16_t* __restrict__ WaT, const bf16_t* __restrict__ WbT,
                                         const bf16_t* __restrict__ SAB, bf16_t* __restrict__ mrg, char* smem) {
    GEMM_LANE_VARS
    for (int u = blockIdx.x; u < 128 * 8; u += gridDim.x) {
        const int xg = u & 7, v = u >> 3, tn = v & 7, tm = (v >> 3) * 8 + xg;
        const bf16_t* pa[4]; const bf16_t* pb[4];
#pragma unroll
        for (int i = 0; i < 4; ++i) { pa[i] = ya + (size_t)(tm * 128 + lrow + 32 * i) * 512 + lch8; pb[i] = WaT + (size_t)(tn * 128 + lrow + 32 * i) * 512 + lch8; }
        f32x4 acc1[4][4]; acc_zero(acc1);
        gemm_kloop(acc1, pa, pb, 64, 64, 8, smem);
#pragma unroll
        for (int i = 0; i < 4; ++i) { pa[i] = yb + (size_t)(tm * 128 + lrow + 32 * i) * 512 + lch8; pb[i] = WbT + (size_t)(tn * 128 + lrow + 32 * i) * 512 + lch8; }
        f32x4 acc2[4][4]; acc_zero(acc2);
        gemm_kloop(acc2, pa, pb, 64, 64, 8, smem);
#pragma unroll
        for (int mi = 0; mi < 4; ++mi)
#pragma unroll
            for (int ni = 0; ni < 4; ++ni) {
                const int m = tm * 128 + wr * 64 + mi * 16 + fr, n = tn * 128 + wc * 64 + ni * 16 + 4 * fq;
                const uint2 sa = *(const uint2*)(SAB + (size_t)m * 2048 + n), sb = *(const uint2*)(SAB + (size_t)m * 2048 + 1024 + n);
                f32x4 v;
                v[0] = __uint_as_float(sa.x << 16) * acc1[mi][ni][0] + __uint_as_float(sb.x << 16) * acc2[mi][ni][0];
                v[1] = __uint_as_float(sa.x & 0xFFFF0000u) * acc1[mi][ni][1] + __uint_as_float(sb.x & 0xFFFF0000u) * acc2[mi][ni][1];
                v[2] = __uint_as_float(sa.y << 16) * acc1[mi][ni][2] + __uint_as_float(sb.y << 16) * acc2[mi][ni][2];
                v[3] = __uint_as_float(sa.y & 0xFFFF0000u) * acc1[mi][ni][3] + __uint_as_float(sb.y & 0xFFFF0000u) * acc2[mi][ni][3];
                *(uint2*)(mrg + (size_t)m * 1024 + n) = pack4(v);
            }
    }
}

__device__ __forceinline__ void ph_outproj(const bf16_t* __restrict__ mrg, const bf16_t* __restrict__ WoT, const float* __restrict__ x, float* __restrict__ x2, char* smem) {
    GEMM_LANE_VARS
    for (int u = blockIdx.x; u < 128 * 8; u += gridDim.x) {
        const int xg = u & 7, v = u >> 3, tn = v & 7, tm = (v >> 3) * 8 + xg;
        const bf16_t* pa[4]; const bf16_t* pb[4];
#pragma unroll
        for (int i = 0; i < 4; ++i) { pa[i] = mrg + (size_t)(tm * 128 + lrow + 32 * i) * 1024 + lch8; pb[i] = WoT + (size_t)(tn * 128 + lrow + 32 * i) * 1024 + lch8; }
        f32x4 acc[4][4]; acc_zero(acc);
        gemm_kloop(acc, pa, pb, 64, 64, 16, smem);
#pragma unroll
        for (int mi = 0; mi < 4; ++mi)
#pragma unroll
            for (int ni = 0; ni < 4; ++ni) {
                const int m = tm * 128 + wr * 64 + mi * 16 + fr, n = tn * 128 + wc * 64 + ni * 16 + 4 * fq;
                const float4 xv = *(const float4*)(x + (size_t)m * 1024 + n);
                *(float4*)(x2 + (size_t)m * 1024 + n) = make_float4(xv.x + acc[mi][ni][0], xv.y + acc[mi][ni][1], xv.z + acc[mi][ni][2], xv.w + acc[mi][ni][3]);
            }
    }
}

__device__ __forceinline__ int moe_expert_of(const int* __restrict__ cnt, int m0, int& total) {
    int e = 0, acc = 0;
    for (int i = 0; i < 32; ++i) { const int nacc = acc + ((cnt[i] + 127) & ~127); if (m0 >= acc && m0 < nacc) e = i; acc = nacc; }
    total = acc; return e;
}

__device__ __forceinline__ void ph_moe1(const bf16_t* __restrict__ h2, const bf16_t* __restrict__ WgT, const bf16_t* __restrict__ WuT, const int* __restrict__ cnt,
                                        const int* __restrict__ slot_tok, const float* __restrict__ slot_w, const float* __restrict__ slot_rs, bf16_t* __restrict__ hid, char* smem) {
    GEMM_LANE_VARS
    int total; (void)moe_expert_of(cnt, 0, total);
    const int nu = (total >> 7) * 4;
    for (int u = blockIdx.x; u < nu; u += gridDim.x) {
        const int ft = u & 3, tm = u >> 2; int tt;
        const int e = moe_expert_of(cnt, tm * 128, tt);
        const bf16_t* pa[4]; const bf16_t* pb[4];
#pragma unroll
        for (int i = 0; i < 4; ++i) {
            const int rr = lrow + 32 * i;
            const int tk = slot_tok[tm * 128 + rr];
            pa[i] = h2 + (size_t)(tk >= 0 ? (tk >> 1) : 0) * 1024 + lch8;
            const int bwc = rr >> 6, bni = (rr >> 4) & 3, bj = rr & 15;
            const int f = ft * 64 + bwc * 32 + (bni >> 1) * 16 + bj;
            pb[i] = ((bni & 1) ? WuT : WgT) + ((size_t)e * 256 + f) * 1024 + lch8;
        }
        f32x4 acc[4][4]; acc_zero(acc);
        gemm_kloop(acc, pa, pb, 64, 64, 16, smem);
#pragma unroll
        for (int mi = 0; mi < 4; ++mi) {
            const int m = tm * 128 + wr * 64 + mi * 16 + fr;
            const float w = slot_tok[m] >= 0 ? slot_w[m] : 0.f;
            const float rsv = slot_tok[m] >= 0 ? slot_rs[m] : 0.f;
#pragma unroll
            for (int q = 0; q < 2; ++q) {
                const int f = ft * 64 + wc * 32 + q * 16 + 4 * fq;
                f32x4 v;
#pragma unroll
                for (int j = 0; j < 4; ++j) { const float a = acc[mi][2 * q][j] * rsv, uu = acc[mi][2 * q + 1][j] * rsv; v[j] = a * sigmoidf_(a) * uu * w; }
                *(uint2*)(hid + (size_t)m * 256 + f) = pack4(v);
            }
        }
    }
}

__device__ __forceinline__ void ph_moe2(const bf16_t* __restrict__ hid, const bf16_t* __restrict__ WdT, const int* __restrict__ cnt, const int* __restrict__ slot_tok,
                                        bf16_t* __restrict__ Y, char* smem) {
    GEMM_LANE_VARS
    int total; (void)moe_expert_of(cnt, 0, total);
    const int nu = (total >> 7) * 8;
    for (int u = blockIdx.x; u < nu; u += gridDim.x) {
        const int tn = u & 7, tm = u >> 3; int tt;
        const int e = moe_expert_of(cnt, tm * 128, tt);
        const bf16_t* pa[4]; const bf16_t* pb[4];
#pragma unroll
        for (int i = 0; i < 4; ++i) { pa[i] = hid + (size_t)(tm * 128 + lrow + 32 * i) * 256 + lch8; pb[i] = WdT + ((size_t)e * 1024 + tn * 128 + lrow + 32 * i) * 256 + lch8; }
        f32x4 acc[4][4]; acc_zero(acc);
        gemm_kloop(acc, pa, pb, 64, 64, 4, smem);
#pragma unroll
        for (int mi = 0; mi < 4; ++mi) {
            const int m = tm * 128 + wr * 64 + mi * 16 + fr;
            const int tk = slot_tok[m];
            if (tk >= 0) {
                bf16_t* yr = Y + ((size_t)(tk & 1) * T + (size_t)(tk >> 1)) * 1024 + tn * 128 + wc * 64 + 4 * fq;
#pragma unroll
                for (int ni = 0; ni < 4; ++ni) *(uint2*)(yr + ni * 16) = pack4(acc[mi][ni]);
            }
        }
    }
}

constexpr float LOG2E = 1.4426950408889634f;
constexpr float NEGV = -3.0e38f;
constexpr int NSA_TB = 32768;
constexpr int NSA_IMPA = 34816;
constexpr int NSA_IMPB = NSA_IMPA + 8448;
constexpr int NSA_SELM = NSA_IMPB + 8448;

__device__ __forceinline__ int t5_bucket2(int n) {
    if (n < 16) return n;
    const int l = 16 + (int)(logf((float)n / 16.0f) / logf(8.0f) * 16.0f);
    return l < 31 ? l : 31;
}

template <int MODE, bool A0, bool A1>
__device__ __forceinline__ void nsa_tile(const char* Kst, const char* Vst, int j, bool fast, const float* tbias, const bf16x8 (&qf)[2][2], const int (&qidx)[2],
                                         const unsigned long long (&selq)[2], f32x4 (&O)[4][2], float (&m)[2], float (&l)[2], const float (&invl)[2],
                                         char* smem, int fr, int fq, int hp, int wid) {
    const float b127 = tbias[127];
    bf16x8 pf[2][2];
#pragma unroll
    for (int ct = 0; ct < 2; ++ct) {
        if ((ct == 0 && !A0) || (ct == 1 && !A1)) continue;
        f32x4 sacc[2][2];
#pragma unroll
        for (int p = 0; p < 2; ++p)
#pragma unroll
            for (int s = 0; s < 2; ++s) {
                const int row = 32 * p + 8 * (fr >> 2) + 4 * s + (fr & 3);
                const bf16x8 k0 = *(const bf16x8*)(Kst + tile_off(row, fq)), k1 = *(const bf16x8*)(Kst + tile_off(row, 4 + fq));
                f32x4 a = (f32x4){0.f, 0.f, 0.f, 0.f};
                a = __builtin_amdgcn_mfma_f32_16x16x32_bf16(k0, qf[ct][0], a, 0, 0, 0);
                a = __builtin_amdgcn_mfma_f32_16x16x32_bf16(k1, qf[ct][1], a, 0, 0, 0);
                sacc[p][s] = a;
            }
        const int q = qidx[ct];
        const bool sel = (MODE == 1) ? (((selq[ct] >> j) & 1ull) != 0ull) : true;
        float mloc = NEGV;
        if (fast) {
#pragma unroll
            for (int p = 0; p < 2; ++p)
#pragma unroll
                for (int s = 0; s < 2; ++s)
#pragma unroll
                    for (int i = 0; i < 4; ++i) {
                        const float sv = sel ? sacc[p][s][i] * (0.125f * LOG2E) + b127 : NEGV;
                        sacc[p][s][i] = sv; mloc = fmaxf(mloc, sv);
                    }
        } else {
#pragma unroll
            for (int p = 0; p < 2; ++p)
#pragma unroll
                for (int s = 0; s < 2; ++s)
#pragma unroll
                    for (int i = 0; i < 4; ++i) {
                        const int kk = 64 * j + 32 * p + 8 * fq + 4 * s + i;
                        int rel; bool valid;
                        if (MODE == 0 || MODE == 3) { rel = q - (16 * kk + 31); valid = rel >= 0; }
                        else if (MODE == 1) { rel = q - kk; valid = (rel >= 0) && sel; }
                        else { rel = q - kk; valid = (rel >= 0) && (rel < 512); }
                        const int rc = rel < 0 ? 0 : (rel > 127 ? 127 : rel);
                        const float sv = valid ? sacc[p][s][i] * (0.125f * LOG2E) + tbias[rc] : NEGV;
                        sacc[p][s][i] = sv; mloc = fmaxf(mloc, sv);
                    }
        }
        if (MODE != 3) {
            mloc = fmaxf(mloc, __shfl_xor(mloc, 16)); mloc = fmaxf(mloc, __shfl_xor(mloc, 32));
            const float mnew = fmaxf(m[ct], mloc);
            const float alpha = __builtin_amdgcn_exp2f(m[ct] - mnew);
            m[ct] = mnew;
            float psum = 0.f;
#pragma unroll
            for (int p = 0; p < 2; ++p) {
                float pv[8];
#pragma unroll
                for (int s = 0; s < 2; ++s)
#pragma unroll
                    for (int i = 0; i < 4; ++i) { pv[s * 4 + i] = __builtin_amdgcn_exp2f(sacc[p][s][i] - mnew); psum += pv[s * 4 + i]; }
                u32x4 w; w[0] = pack_bf16(pv[0], pv[1]); w[1] = pack_bf16(pv[2], pv[3]); w[2] = pack_bf16(pv[4], pv[5]); w[3] = pack_bf16(pv[6], pv[7]);
                pf[ct][p] = __builtin_bit_cast(bf16x8, w);
            }
            l[ct] = l[ct] * alpha + psum;
#pragma unroll
            for (int dt = 0; dt < 4; ++dt) O[dt][ct] = O[dt][ct] * alpha;
        } else {
            float* impA = (float*)(smem + NSA_IMPA); float* impB = (float*)(smem + NSA_IMPB);
            const int ql = wid * 8 + ct * 4 + (fr >> 2);
#pragma unroll
            for (int p = 0; p < 2; ++p)
#pragma unroll
                for (int s = 0; s < 2; ++s) {
                    float p3 = __builtin_amdgcn_exp2f(sacc[p][s][3] - m[ct]) * invl[ct];
                    float pa = __builtin_amdgcn_exp2f(sacc[p][s][0] - m[ct]) * invl[ct] + __builtin_amdgcn_exp2f(sacc[p][s][1] - m[ct]) * invl[ct]
                             + __builtin_amdgcn_exp2f(sacc[p][s][2] - m[ct]) * invl[ct] + p3;
                    pa += __shfl_xor(pa, 1); pa += __shfl_xor(pa, 2);
                    p3 += __shfl_xor(p3, 1); p3 += __shfl_xor(p3, 2);
                    const int jj = 16 * j + 8 * p + 2 * fq + s;
                    if (hp == 0) { impA[ql * 65 + jj] = pa; impB[ql * 65 + jj + 1] = p3; }
                }
        }
    }
    if (MODE != 3) {
#pragma unroll
        for (int dt = 0; dt < 4; ++dt)
#pragma unroll
            for (int p = 0; p < 2; ++p) {
                const bf16x8 vf = *(const bf16x8*)(Vst + tile_off(dt * 16 + fr, p * 4 + fq));
                if (A0) O[dt][0] = __builtin_amdgcn_mfma_f32_16x16x32_bf16(vf, pf[0][p], O[dt][0], 0, 0, 0);
                if (A1) O[dt][1] = __builtin_amdgcn_mfma_f32_16x16x32_bf16(vf, pf[1][p], O[dt][1], 0, 0, 0);
            }
    }
}

template <int MODE>
__device__ __forceinline__ void nsa_branch(const bf16_t* __restrict__ Kb, size_t kstride, const bf16_t* __restrict__ Vb, size_t vstride, int j0, int ntiles, int t0,
                                           const bf16x8 (&qf)[2][2], const int (&qidx)[2], const unsigned long long (&selq)[2], unsigned long long selor0, unsigned long long selor1,
                                           f32x4 (&O)[4][2], float (&m)[2], float (&l)[2], const float (&invl)[2], char* smem) {
    int tid_ = threadIdx.x; asm volatile("" : "+v"(tid_));
    const int tid = tid_, lane = tid & 63, wid = tid >> 6, fr = lane & 15, fq = lane >> 4, hp = fr & 3;
    const int lrow = tid >> 3;
    const float* tbias = (const float*)(smem + NSA_TB) + hp * 128;
    const bf16_t* kp[2]; const bf16_t* vp[2];
    const int sch8 = ((tid & 7) ^ (lrow & 7)) * 8;
#pragma unroll
    for (int i = 0; i < 2; ++i) { kp[i] = Kb + (size_t)(lrow + 32 * i) * kstride + sch8; vp[i] = Vb + (size_t)(lrow + 32 * i) * vstride + sch8; }
    __syncthreads();
#pragma unroll
    for (int i = 0; i < 2; ++i) { glds16(kp[i], smem + i * 4096 + tid * 16); if (MODE != 3) glds16(vp[i], smem + 8192 + i * 4096 + tid * 16); }
    asm volatile("s_waitcnt vmcnt(0)" ::: "memory");
    __syncthreads();
    for (int it = 0; it < ntiles; ++it) {
        const int cur = it & 1, j = j0 + it;
        if (it + 1 < ntiles) {
            char* st = smem + (cur ^ 1) * 16384 + tid * 16;
#pragma unroll
            for (int i = 0; i < 2; ++i) { glds16(kp[i] + (size_t)(it + 1) * 64 * kstride, st + i * 4096); if (MODE != 3) glds16(vp[i] + (size_t)(it + 1) * 64, st + 8192 + i * 4096); }
        }
        const char* Kst = smem + cur * 16384;
        const char* Vst = Kst + 8192;
        bool fast;
        if (MODE == 0 || MODE == 3) fast = (t0 - (16 * (64 * j + 63) + 31)) >= 128;
        else if (MODE == 1) fast = (t0 - (64 * j + 63)) >= 128;
        else fast = ((t0 - (64 * j + 63)) >= 128) && ((t0 + 31 - 64 * j) < 512);
        if (MODE == 1) {
            const bool a0 = ((selor0 >> j) & 1ull) != 0ull, a1 = ((selor1 >> j) & 1ull) != 0ull;
            if (a0 && a1) nsa_tile<MODE, true, true>(Kst, Vst, j, fast, tbias, qf, qidx, selq, O, m, l, invl, smem, fr, fq, hp, wid);
            else if (a0) nsa_tile<MODE, true, false>(Kst, Vst, j, fast, tbias, qf, qidx, selq, O, m, l, invl, smem, fr, fq, hp, wid);
            else if (a1) nsa_tile<MODE, false, true>(Kst, Vst, j, fast, tbias, qf, qidx, selq, O, m, l, invl, smem, fr, fq, hp, wid);
        } else {
            nsa_tile<MODE, true, true>(Kst, Vst, j, fast, tbias, qf, qidx, selq, O, m, l, invl, smem, fr, fq, hp, wid);
        }
        asm volatile("s_waitcnt vmcnt(0)" ::: "memory");
        __syncthreads();
    }
}

__device__ __forceinline__ void osum_add(uint2& acc, f32x4 o, float sc) {
    f32x4 v;
    v[0] = __uint_as_float(acc.x << 16) + o[0] * sc; v[1] = __uint_as_float(acc.x & 0xFFFF0000u) + o[1] * sc;
    v[2] = __uint_as_float(acc.y << 16) + o[2] * sc; v[3] = __uint_as_float(acc.y & 0xFFFF0000u) + o[3] * sc;
    acc = pack4(v);
}
__device__ __forceinline__ float nsa_gate(const bf16_t* __restrict__ pb, int q, int br, int head) { return sigmoidf_(bf2f(pb[(size_t)q * PP + GA + br * 8 + head])); }

__device__ __forceinline__ void nsa_unit(int u, const bf16_t* __restrict__ proj, const char* __restrict__ ws, const float* __restrict__ rel_bias, bf16_t* __restrict__ ya, char* smem) {
    int tid_ = threadIdx.x; asm volatile("" : "+v"(tid_));
    const int tid = tid_, lane = tid & 63, wid = tid >> 6, fr = lane & 15, fq = lane >> 4, hp = fr & 3;
    const int bg = u & 7, qt = 127 - (u >> 3), b = bg >> 1, g = bg & 1, t0 = qt * 32, tb = t0 >> 6;
    const bf16_t* kcb = (const bf16_t*)(ws + OFF_KCB) + (size_t)bg * 256 * 64;
    const bf16_t* vcbT = (const bf16_t*)(ws + OFF_VCBT) + (size_t)bg * 64 * 256;
    const bf16_t* VsT = (const bf16_t*)(ws + OFF_VST) + (size_t)bg * 64 * S;
    const bf16_t* VwT = (const bf16_t*)(ws + OFF_VWT) + (size_t)bg * 64 * S;
    const bf16_t* pb = proj + (size_t)b * S * PP;
    __syncthreads();
    {
        float* tbl = (float*)(smem + NSA_TB);
        for (int e = tid; e < 512; e += 256) { const int h4 = e >> 7, n = e & 127; tbl[e] = rel_bias[t5_bucket2(n) * 8 + g * 4 + h4] * LOG2E; }
        float* imp = (float*)(smem + NSA_IMPA);
        for (int e = tid; e < 2 * 32 * 66; e += 256) if (e < 4224) imp[e] = 0.f;
    }
    int qidx[2]; bf16x8 qf[2][2];
    const int head = g * 4 + hp;
#pragma unroll
    for (int ct = 0; ct < 2; ++ct) {
        qidx[ct] = t0 + wid * 8 + ct * 4 + (fr >> 2);
        const bf16_t* qr = pb + (size_t)qidx[ct] * PP;
        qf[ct][0] = *(const bf16x8*)(qr + QA + head * 64 + fq * 8);
        qf[ct][1] = *(const bf16x8*)(qr + QA + head * 64 + 32 + fq * 8);
    }
    uint2 osum[4][2];
#pragma unroll
    for (int dt = 0; dt < 4; ++dt)
#pragma unroll
        for (int ct = 0; ct < 2; ++ct) osum[dt][ct] = make_uint2(0u, 0u);
    unsigned long long selq[2] = {0ull, 0ull};
    float invl0[2] = {0.f, 0.f};
    const int ntc = ((t0 >> 4) + 1 + 63) >> 6;
    float mC[2], invC[2];
    {
        f32x4 O[4][2]; float m[2] = {-1e30f, -1e30f}, l[2] = {0.f, 0.f};
#pragma unroll
        for (int dt = 0; dt < 4; ++dt)
#pragma unroll
            for (int ct = 0; ct < 2; ++ct) O[dt][ct] = (f32x4){0.f, 0.f, 0.f, 0.f};
        nsa_branch<0>(kcb, 64, vcbT, 256, 0, ntc, t0, qf, qidx, selq, 0ull, 0ull, O, m, l, invl0, smem);
#pragma unroll
        for (int ct = 0; ct < 2; ++ct) {
            float lt = l[ct]; lt += __shfl_xor(lt, 16); lt += __shfl_xor(lt, 32);
            invC[ct] = lt > 0.f ? 1.f / lt : 0.f; mC[ct] = m[ct];
#pragma unroll
            for (int dt = 0; dt < 4; ++dt) osum_add(osum[dt][ct], O[dt][ct], nsa_gate(pb, qidx[ct], 0, head) * invC[ct]);
        }
        nsa_branch<3>(kcb, 64, vcbT, 256, 0, ntc, t0, qf, qidx, selq, 0ull, 0ull, O, mC, l, invC, smem);
    }
    {
        const float* impA = (const float*)(smem + NSA_IMPA); const float* impB = (const float*)(smem + NSA_IMPB);
        unsigned long long* selm = (unsigned long long*)(smem + NSA_SELM);
#pragma unroll 1
        for (int qq = 0; qq < 8; ++qq) {
            const int ql = wid * 8 + qq;
            const float val = impA[ql * 65 + lane] + impB[ql * 65 + lane];
            const bool forced = (lane == 0) || (lane == tb) || (lane == tb - 1);
            unsigned key = forced ? 0xFFFFFFC0u : (lane > tb ? 0u : (__float_as_uint(val) & 0xFFFFFFC0u));
            key |= (unsigned)(63 - lane);
            int rank = 0;
#pragma unroll
            for (int jp = 0; jp < 64; ++jp) rank += ((unsigned)__builtin_amdgcn_readlane((int)key, jp) > key) ? 1 : 0;
            const unsigned long long msk = __ballot(rank < 16);
            if (lane == 0) selm[ql] = msk;
        }
        wave_lds_sync();
        unsigned long long so0 = 0ull, so1 = 0ull;
#pragma unroll
        for (int qq = 0; qq < 4; ++qq) { so0 |= selm[wid * 8 + qq]; so1 |= selm[wid * 8 + 4 + qq]; }
        const unsigned long long selor0 = ((unsigned long long)(unsigned)__builtin_amdgcn_readfirstlane((int)(unsigned)(so0 >> 32)) << 32) | (unsigned)__builtin_amdgcn_readfirstlane((int)(unsigned)so0);
        const unsigned long long selor1 = ((unsigned long long)(unsigned)__builtin_amdgcn_readfirstlane((int)(unsigned)(so1 >> 32)) << 32) | (unsigned)__builtin_amdgcn_readfirstlane((int)(unsigned)so1);
        selq[0] = selm[wid * 8 + (fr >> 2)]; selq[1] = selm[wid * 8 + 4 + (fr >> 2)];
        {
            f32x4 O[4][2]; float m[2] = {-1e30f, -1e30f}, l[2] = {0.f, 0.f};
#pragma unroll
            for (int dt = 0; dt < 4; ++dt)
#pragma unroll
                for (int ct = 0; ct < 2; ++ct) O[dt][ct] = (f32x4){0.f, 0.f, 0.f, 0.f};
            nsa_branch<1>(pb + KS + g * 64, PP, VsT, S, 0, tb + 1, t0, qf, qidx, selq, selor0, selor1, O, m, l, invl0, smem);
#pragma unroll
            for (int ct = 0; ct < 2; ++ct) {
                float lt = l[ct]; lt += __shfl_xor(lt, 16); lt += __shfl_xor(lt, 32);
                const float inv = lt > 0.f ? 1.f / lt : 0.f;
#pragma unroll
                for (int dt = 0; dt < 4; ++dt) osum_add(osum[dt][ct], O[dt][ct], nsa_gate(pb, qidx[ct], 1, head) * inv);
            }
        }
    }
    {
        f32x4 O[4][2]; float m[2] = {-1e30f, -1e30f}, l[2] = {0.f, 0.f};
#pragma unroll
        for (int dt = 0; dt < 4; ++dt)
#pragma unroll
            for (int ct = 0; ct < 2; ++ct) O[dt][ct] = (f32x4){0.f, 0.f, 0.f, 0.f};
        const int jw0 = (t0 - 511 < 0 ? 0 : t0 - 511) >> 6;
        nsa_branch<2>(pb + (size_t)jw0 * 64 * PP + KW + g * 64, PP, VwT + jw0 * 64, S, jw0, tb - jw0 + 1, t0, qf, qidx, selq, 0ull, 0ull, O, m, l, invl0, smem);
#pragma unroll
        for (int ct = 0; ct < 2; ++ct) {
            float lt = l[ct]; lt += __shfl_xor(lt, 16); lt += __shfl_xor(lt, 32);
            const float inv = lt > 0.f ? 1.f / lt : 0.f;
#pragma unroll
            for (int dt = 0; dt < 4; ++dt) osum_add(osum[dt][ct], O[dt][ct], nsa_gate(pb, qidx[ct], 2, head) * inv);
        }
    }
#pragma unroll
    for (int ct = 0; ct < 2; ++ct) {
        bf16_t* yr = ya + (size_t)(b * S + qidx[ct]) * 512 + head * 64 + 4 * fq;
#pragma unroll
        for (int dt = 0; dt < 4; ++dt) *(uint2*)(yr + dt * 16) = osum[dt][ct];
    }
}

__device__ __forceinline__ void vtrans_tile(int task, const bf16_t* __restrict__ proj, char* ws, char* smem) {
    unsigned short (*tl)[66] = (unsigned short (*)[66])smem;
    const int tid = threadIdx.x, which = task >> 9, bg = (task >> 6) & 7, tt = task & 63, b = bg >> 1, g = bg & 1;
    const int r = tid >> 2, q4 = tid & 3;
    const bf16_t* src = proj + (size_t)(b * S + tt * 64 + r) * PP + (which ? VW : VS) + g * 64 + q4 * 16;
    const uint4 a0 = *(const uint4*)src, a1 = *(const uint4*)(src + 8);
    unsigned* trow = (unsigned*)&tl[r][q4 * 16];
    trow[0] = a0.x; trow[1] = a0.y; trow[2] = a0.z; trow[3] = a0.w; trow[4] = a1.x; trow[5] = a1.y; trow[6] = a1.z; trow[7] = a1.w;
    __syncthreads();
    bf16_t* dst = (bf16_t*)(ws + (which ? OFF_VWT : OFF_VST)) + ((size_t)bg * 64 + r) * S + tt * 64 + q4 * 16;
    unsigned o[8];
#pragma unroll
    for (int k = 0; k < 8; ++k) o[k] = (unsigned)tl[q4 * 16 + 2 * k][r] | ((unsigned)tl[q4 * 16 + 2 * k + 1][r] << 16);
    *(uint4*)dst = make_uint4(o[0], o[1], o[2], o[3]);
    *(uint4*)(dst + 8) = make_uint4(o[4], o[5], o[6], o[7]);
    __syncthreads();
}

__device__ __forceinline__ int tile_el(int row, int col) { return tile_off(row, col >> 3) + ((col & 7) << 1); }

__device__ __forceinline__ void gla_stage_vt(const bf16_t* __restrict__ proj, size_t row0, int h, char* vt_base) {
    const int tid = threadIdx.x, c = tid >> 2, vq = tid & 3;
    const bf16_t* src = proj + (row0 + c) * PP + VB + h * 128 + vq * 32;
#pragma unroll
    for (int k = 0; k < 4; ++k) {
        const u32x4 a = *(const u32x4*)(src + k * 8);
#pragma unroll
        for (int e = 0; e < 4; ++e) {
            const int v = vq * 32 + k * 8 + 2 * e;
            *(unsigned short*)(vt_base + tile_el(v, c)) = (unsigned short)(a[e] & 0xFFFFu);
            *(unsigned short*)(vt_base + tile_el(v + 1, c)) = (unsigned short)(a[e] >> 16);
        }
    }
}

__device__ __forceinline__ void gla_a_unit(int vb, const bf16_t* __restrict__ proj, const float* __restrict__ w_alpha, const float* __restrict__ b_alpha,
                                           float* __restrict__ bc, float* __restrict__ cstate, char* smem) {
    float (*bcS)[64] = (float (*)[64])smem;
    float (*tot)[64] = (float (*)[64])(smem + 16384);
    char* KDT = smem + 17408;
    char* VT = smem + 17408 + 8192;
    const int tid = threadIdx.x, lane = tid & 63, wid = tid >> 6, fr = lane & 15, fq = lane >> 4;
    const int n = vb & 63, h = (vb >> 6) & 3, b = vb >> 8;
    const size_t row0 = (size_t)(b * S + n * 64);
    __syncthreads();
    {
        const int d = tid & 63, cq = tid >> 6, col = h * 64 + d;
        float w[16];
#pragma unroll
        for (int r = 0; r < 16; ++r) w[r] = w_alpha[r * 256 + col];
        const float bias = b_alpha[col];
        float cum = 0.f;
        for (int i = 0; i < 16; ++i) {
            const int c = cq * 16 + i;
            const u32x4 a0 = *(const u32x4*)(proj + (row0 + c) * PP + AB), a1 = *(const u32x4*)(proj + (row0 + c) * PP + AB + 8);
            float z = bias;
#pragma unroll
            for (int e = 0; e < 4; ++e) {
                z += __uint_as_float(a0[e] << 16) * w[2 * e] + __uint_as_float(a0[e] & 0xFFFF0000u) * w[2 * e + 1];
                z += __uint_as_float(a1[e] << 16) * w[8 + 2 * e] + __uint_as_float(a1[e] & 0xFFFF0000u) * w[8 + 2 * e + 1];
            }
            const float ls = fminf(z, 0.f) - log1pf(__expf(-fabsf(z)));
            cum += ls * (1.0f / 16.0f);
            bcS[c][d] = cum;
        }
        tot[cq][d] = cum;
        __syncthreads();
        float pre = 0.f;
        for (int q = 0; q < cq; ++q) pre += tot[q][d];
        for (int i = 0; i < 16; ++i) {
            const int c = cq * 16 + i;
            const float v = bcS[c][d] + pre;
            bcS[c][d] = v;
            bc[(row0 + c) * 256 + col] = v;
        }
    }
    __syncthreads();
    {
        const int c = tid >> 2, dq = tid & 3;
        const bf16_t* src = proj + (row0 + c) * PP + KB + h * 64 + dq * 16;
#pragma unroll
        for (int k = 0; k < 2; ++k) {
            const u32x4 a = *(const u32x4*)(src + k * 8);
#pragma unroll
            for (int e = 0; e < 4; ++e) {
                const int d = dq * 16 + k * 8 + 2 * e;
                const float k0 = __uint_as_float(a[e] << 16) * __expf(bcS[63][d] - bcS[c][d]);
                const float k1 = __uint_as_float(a[e] & 0xFFFF0000u) * __expf(bcS[63][d + 1] - bcS[c][d + 1]);
                *(unsigned short*)(KDT + tile_el(d, c)) = f2bf(k0);
                *(unsigned short*)(KDT + tile_el(d + 1, c)) = f2bf(k1);
            }
        }
    }
    gla_stage_vt(proj, row0, h, VT);
    __syncthreads();
    float* outp = cstate + (size_t)vb * 8192;
#pragma unroll
    for (int vi = 0; vi < 2; ++vi) {
        const int vt = wid * 2 + vi;
        const bf16x8 a0 = *(const bf16x8*)(VT + tile_off(vt * 16 + fr, fq)), a1 = *(const bf16x8*)(VT + tile_off(vt * 16 + fr, 4 + fq));
#pragma unroll
        for (int dt = 0; dt < 4; ++dt) {
            const bf16x8 b0 = *(const bf16x8*)(KDT + tile_off(dt * 16 + fr, fq)), b1 = *(const bf16x8*)(KDT + tile_off(dt * 16 + fr, 4 + fq));
            f32x4 acc = (f32x4){0.f, 0.f, 0.f, 0.f};
            acc = __builtin_amdgcn_mfma_f32_16x16x32_bf16(a0, b0, acc, 0, 0, 0);
            acc = __builtin_amdgcn_mfma_f32_16x16x32_bf16(a1, b1, acc, 0, 0, 0);
#pragma unroll
            for (int i = 0; i < 4; ++i) outp[(vt * 16 + 4 * fq + i) * 64 + dt * 16 + fr] = acc[i];
        }
    }
}

__device__ __forceinline__ void gla_scan_vb2(int vb, const float* __restrict__ bc, float* __restrict__ cstate) {
    const int idx = vb * 256 + threadIdx.x;
    const int e = idx & 8191, bh = idx >> 13, b = bh >> 2, h = bh & 3, d = e & 63;
    float state = 0.f;
    float* base = cstate + (size_t)bh * 64 * 8192 + e;
    const float* bcp = bc + ((size_t)(b * S + 63)) * 256 + h * 64 + d;
#pragma unroll 1
    for (int n0 = 0; n0 < 64; n0 += 16) {
        float upd[16], dec[16];
#pragma unroll
        for (int i = 0; i < 16; ++i) { upd[i] = base[(size_t)(n0 + i) * 8192]; dec[i] = bcp[(size_t)(n0 + i) * 64 * 256]; }
#pragma unroll
        for (int i = 0; i < 16; ++i) { base[(size_t)(n0 + i) * 8192] = state; state = __expf(dec[i]) * state + upd[i]; }
    }
}

__device__ __forceinline__ void gla_c_unit(int vb, const bf16_t* __restrict__ proj, const float* __restrict__ bc, const float* __restrict__ prev,
                                           const float* __restrict__ norm_g, bf16_t* __restrict__ yb, char* smem) {
    char* QI = smem;
    char* KI = smem + 8192;
    char* VT = smem + 16384;
    char* PT = smem + 32768;
    const int tid = threadIdx.x, lane = tid & 63, wid = tid >> 6, fr = lane & 15, fq = lane >> 4;
    const int n = vb & 63, h = (vb >> 6) & 3, b = vb >> 8;
    const size_t row0 = (size_t)(b * S + n * 64);
    __syncthreads();
    {
        const int c = tid >> 2, dq = tid & 3;
        const bf16_t* qs = proj + (row0 + c) * PP + QB + h * 64 + dq * 16;
        const bf16_t* ks = proj + (row0 + c) * PP + KB + h * 64 + dq * 16;
        const float* bs = bc + (row0 + c) * 256 + h * 64 + dq * 16;
#pragma unroll
        for (int k = 0; k < 2; ++k) {
            const u32x4 qa = *(const u32x4*)(qs + k * 8), ka = *(const u32x4*)(ks + k * 8);
            const f32x4 b0 = *(const f32x4*)(bs + k * 8), b1 = *(const f32x4*)(bs + k * 8 + 4);
            const float bv[8] = {b0[0], b0[1], b0[2], b0[3], b1[0], b1[1], b1[2], b1[3]};
            u32x4 qo, ko;
#pragma unroll
            for (int e = 0; e < 4; ++e) {
                const float e0 = __expf(bv[2 * e]), e1 = __expf(bv[2 * e + 1]);
                qo[e] = pack_bf16(__uint_as_float(qa[e] << 16) * 0.125f * e0, __uint_as_float(qa[e] & 0xFFFF0000u) * 0.125f * e1);
                ko[e] = pack_bf16(__uint_as_float(ka[e] << 16) / e0, __uint_as_float(ka[e] & 0xFFFF0000u) / e1);
            }
            *(u32x4*)(QI + tile_off(c, dq * 2 + k)) = qo;
            *(u32x4*)(KI + tile_off(c, dq * 2 + k)) = ko;
        }
    }
    gla_stage_vt(proj, row0, h, VT);
    {
        const int v = tid >> 1, half = tid & 1;
        const float* ps = prev + (size_t)vb * 8192 + v * 64 + half * 32;
#pragma unroll
        for (int k = 0; k < 4; ++k) {
            const f32x4 a = *(const f32x4*)(ps + k * 8), c2 = *(const f32x4*)(ps + k * 8 + 4);
            u32x4 o; o[0] = pack_bf16(a[0], a[1]); o[1] = pack_bf16(a[2], a[3]); o[2] = pack_bf16(c2[0], c2[1]); o[3] = pack_bf16(c2[2], c2[3]);
            *(u32x4*)(PT + tile_off(v, half * 4 + k)) = o;
        }
    }
    __syncthreads();
    const bf16x8 qf0 = *(const bf16x8*)(QI + tile_off(wid * 16 + fr, fq)), qf1 = *(const bf16x8*)(QI + tile_off(wid * 16 + fr, 4 + fq));
    bf16x8 pf[2];
    const int c = wid * 16 + fr;
#pragma unroll
    for (int p = 0; p < 2; ++p) {
        u32x4 w;
#pragma unroll
        for (int s = 0; s < 2; ++s) {
            const int row = 32 * p + 8 * (fr >> 2) + 4 * s + (fr & 3);
            const bf16x8 k0 = *(const bf16x8*)(KI + tile_off(row, fq)), k1 = *(const bf16x8*)(KI + tile_off(row, 4 + fq));
            f32x4 a = (f32x4){0.f, 0.f, 0.f, 0.f};
            a = __builtin_amdgcn_mfma_f32_16x16x32_bf16(k0, qf0, a, 0, 0, 0);
            a = __builtin_amdgcn_mfma_f32_16x16x32_bf16(k1, qf1, a, 0, 0, 0);
#pragma unroll
            for (int i = 0; i < 4; ++i) { const int j = 32 * p + 8 * fq + 4 * s + i; if (j > c) a[i] = 0.f; }
            w[2 * s] = pack_bf16(a[0], a[1]); w[2 * s + 1] = pack_bf16(a[2], a[3]);
        }
        pf[p] = __builtin_bit_cast(bf16x8, w);
    }
    f32x4 acc[8];
    float ss = 0.f;
#pragma unroll
    for (int vt = 0; vt < 8; ++vt) {
        f32x4 a = (f32x4){0.f, 0.f, 0.f, 0.f};
        a = __builtin_amdgcn_mfma_f32_16x16x32_bf16(*(const bf16x8*)(VT + tile_off(vt * 16 + fr, fq)), pf[0], a, 0, 0, 0);
        a = __builtin_amdgcn_mfma_f32_16x16x32_bf16(*(const bf16x8*)(VT + tile_off(vt * 16 + fr, 4 + fq)), pf[1], a, 0, 0, 0);
        a = __builtin_amdgcn_mfma_f32_16x16x32_bf16(*(const bf16x8*)(PT + tile_off(vt * 16 + fr, fq)), qf0, a, 0, 0, 0);
        a = __builtin_amdgcn_mfma_f32_16x16x32_bf16(*(const bf16x8*)(PT + tile_off(vt * 16 + fr, 4 + fq)), qf1, a, 0, 0, 0);
        acc[vt] = a;
        ss += a[0] * a[0] + a[1] * a[1] + a[2] * a[2] + a[3] * a[3];
    }
    ss += __shfl_xor(ss, 16); ss += __shfl_xor(ss, 32);
    const float r = rsqrtf(ss * (1.0f / 128.0f) + 1e-6f);
    const size_t row = row0 + c;
#pragma unroll
    for (int vt = 0; vt < 8; ++vt) {
        const int col = h * 128 + vt * 16 + 4 * fq;
        const uint2 rr = *(const uint2*)(proj + row * PP + RB + col);
        const f32x4 g4 = *(const f32x4*)(norm_g + col);
        const float r0 = __uint_as_float(rr.x << 16), r1 = __uint_as_float(rr.x & 0xFFFF0000u), r2 = __uint_as_float(rr.y << 16), r3 = __uint_as_float(rr.y & 0xFFFF0000u);
        f32x4 o;
        o[0] = acc[vt][0] * r * g4[0] * (r0 * sigmoidf_(r0)); o[1] = acc[vt][1] * r * g4[1] * (r1 * sigmoidf_(r1));
        o[2] = acc[vt][2] * r * g4[2] * (r2 * sigmoidf_(r2)); o[3] = acc[vt][3] * r * g4[3] * (r3 * sigmoidf_(r3));
        *(uint2*)(yb + row * 512 + col) = pack4(o);
    }
}

constexpr int SMEM_BYTES = 65536;

__global__ void __launch_bounds__(256, 2) k_fwd(Params p) {
    extern __shared__ __attribute__((aligned(16))) char smem_dyn[];
    char* smem = smem_dyn + 16;
    if (threadIdx.x == 0) *(uint4*)smem_dyn = make_uint4(0u, 0u, 0u, 0u);
    __syncthreads();
    char* ws = p.ws;
    XcdBarrier bar = xcd_barrier_post((unsigned*)(ws + OFF_BAR), (volatile LAS unsigned*)smem_dyn);
    int* ctrl = (int*)(ws + OFF_CTRL);
    int* route_e = (int*)(ws + OFF_ROUTE_E);
    float* route_w = (float*)(ws + OFF_ROUTE_W);
    int* slot_tok = (int*)(ws + OFF_SLOT_TOK);
    float* slot_w = (float*)(ws + OFF_SLOT_W);
    bf16_t* proj = (bf16_t*)(ws + OFF_PROJ);
    float* bc = (float*)(ws + OFF_BC);
    float* cstate = (float*)(ws + OFF_CSTATE);
    bf16_t* SAB = (bf16_t*)(ws + OFF_SAB);
    bf16_t* mrg = (bf16_t*)(ws + OFF_MRG);
    bf16_t* h2 = (bf16_t*)(ws + OFF_H2);
    bf16_t* hid = (bf16_t*)(ws + OFF_HID);
    bf16_t* Y0 = (bf16_t*)(ws + OFF_Y0);
    bf16_t* Y1 = (bf16_t*)(ws + OFF_Y1);
    bf16_t* ya = (bf16_t*)(ws + OFF_YA);
    bf16_t* yb = (bf16_t*)(ws + OFF_YB);
    bf16_t* kcb = (bf16_t*)(ws + OFF_KCB);
    bf16_t* vcb = (bf16_t*)(ws + OFF_VCB);
    bf16_t* h = (bf16_t*)p.out;
    const int wid = threadIdx.x >> 6, lane = threadIdx.x & 63;
    const int G = gridDim.x;

    ph_prep(p, smem);
    xcd_barrier(bar);
    ph_proj(h, (const bf16_t*)(ws + OFF_WINT), proj, smem);
    xcd_barrier(bar);
    ph_cmp1(proj, ws, smem);
    for (int task = blockIdx.x; task < 1024; task += G) vtrans_tile(task, proj, ws, smem);
    for (int vb = blockIdx.x; vb < 1024; vb += G) gla_a_unit(vb, proj, p.w_alpha, p.b_alpha, bc, cstate, smem);
    xcd_barrier(bar);
    ph_cmp2(ws, ws, smem);
    for (int vb = blockIdx.x; vb < 512; vb += G) gla_scan_vb2(vb, bc, cstate);
    xcd_barrier(bar);
    for (int vb = blockIdx.x; vb < 1024; vb += G) gla_c_unit(vb, proj, bc, cstate, p.norm_g, yb, smem);
    for (int r = 0; r * G < 1024; ++r) {
        const int u = r * G + ((r & 1) ? (G - 1 - (int)blockIdx.x) : (int)blockIdx.x);
        if (u < 1024) nsa_unit(u, proj, ws, p.rel_bias, ya, smem);
    }
    xcd_barrier(bar);
    ph_gates(h, (const bf16_t*)(ws + OFF_WINT), SAB, smem);
    xcd_barrier(bar);
    ph_merge(ya, yb, (const bf16_t*)(ws + OFF_WAT), (const bf16_t*)(ws + OFF_WBT), SAB, mrg, smem);
    xcd_barrier(bar);
    ph_outproj(mrg, (const bf16_t*)(ws + OFF_WOT), p.x, p.out, smem);
    xcd_barrier(bar);
    for (int task = blockIdx.x * 4 + wid; task < 1024; task += G * 4) router_task(task, p.out, p.g_ffn, (const bf16_t*)(ws + OFF_WRT), p.b_rg, p.b_re, h2, (float*)(ws + OFF_RSTD), route_e, route_w, ctrl, smem + wid * 4096, lane);
    xcd_barrier(bar);
    for (int i = blockIdx.x * 256 + threadIdx.x; i < 2 * T; i += G * 256) {
        const int e = route_e[i];
        int off = 0;
        for (int j = 0; j < e; ++j) off += (ctrl[j] + 127) & ~127;
        const int pos = atomicAdd(&ctrl[32 + e], 1);
        slot_tok[off + pos] = i; slot_w[off + pos] = route_w[i]; ((float*)(ws + OFF_SLOT_RS))[off + pos] = ((const float*)(ws + OFF_RSTD))[i >> 1];
    }
    xcd_barrier(bar);
    ph_moe1(h2, (const bf16_t*)(ws + OFF_WGT), (const bf16_t*)(ws + OFF_WUT), ctrl, slot_tok, slot_w, (const float*)(ws + OFF_SLOT_RS), hid, smem);
    xcd_barrier(bar);
    ph_moe2(hid, (const bf16_t*)(ws + OFF_WDT), ctrl, slot_tok, Y0, smem);
    xcd_barrier(bar);
    for (int row = blockIdx.x * 4 + wid; row < T; row += G * 4) final_row(row, p.out, Y0, Y1, p.g_final, lane);
}

extern "C" void kernel_launch(void* const* d_in, const int* in_sizes, int n_in, void* d_out, int out_size, void* d_ws, size_t ws_size, hipStream_t stream) {
    static int grid = 0;
    constexpr int kDynLds = SMEM_BYTES + 16;
    if (!grid) {
        int dev = 0, cus = 0, per_cu = 0;
        (void)hipGetDevice(&dev);
        (void)hipDeviceGetAttribute(&cus, hipDeviceAttributeMultiprocessorCount, dev);
        (void)hipFuncSetAttribute((const void*)k_fwd, hipFuncAttributeMaxDynamicSharedMemorySize, kDynLds);
        (void)hipOccupancyMaxActiveBlocksPerMultiprocessor(&per_cu, k_fwd, 256, kDynLds);
        if (per_cu > 2) per_cu = 2;
        if (per_cu < 1) per_cu = 1;
        grid = cus * per_cu;
    }
    char* ws = (char*)d_ws;
    (void)hipMemsetAsync(ws + OFF_CTRL, 0, 4096, stream);
    (void)hipMemsetAsync(ws + OFF_SLOT_TOK, 0xFF, (size_t)MSLOT * 4, stream);
    (void)hipMemsetAsync(ws + OFF_BAR, 0, 16384, stream);
    Params p{};
    const float** pf = (const float**)&p;
    for (int i = 0; i < 25; ++i) pf[i] = (const float*)d_in[i];
    p.out = (float*)d_out; p.ws = ws;
    k_fwd<<<grid, 256, kDynLds, stream>>>(p);
}
```

```cpp
#include <hip/hip_runtime.h>
#include <stdint.h>

typedef unsigned short bf16_t;
typedef short bf16x8 __attribute__((ext_vector_type(8)));
typedef float f32x4 __attribute__((ext_vector_type(4)));
typedef unsigned u32x4 __attribute__((ext_vector_type(4)));
__device__ __forceinline__ float bf2f(bf16_t v) { return __uint_as_float(((unsigned)v) << 16); }
__device__ __forceinline__ bf16_t f2bf(float f) { unsigned u = __float_as_uint(f); u += 0x7FFFu + ((u >> 16) & 1u); return (bf16_t)(u >> 16); }
__device__ __forceinline__ unsigned pack_bf16(float lo, float hi) { unsigned r; asm volatile("v_cvt_pk_bf16_f32 %0, %1, %2" : "=v"(r) : "v"(lo), "v"(hi)); return r; }

constexpr int Bn = 4, S = 4096, T = Bn * S, D = 1024, NIN = 4904, PP = 2880;
constexpr int QA = 0, KC = 512, VC = 640, KS = 768, VS = 896, KW = 1024, VW = 1152, GA = 1280, QB = 1304, KB = 1560, VB = 1816, AB = 2328, RB = 2344, MGA = 2856, MGB = 3880;
constexpr int NPROJ = 2856;
constexpr int MSLOT = 36864;

constexpr size_t OFF_CTRL = 0;
constexpr size_t OFF_ROUTE_E = 4096;
constexpr size_t OFF_ROUTE_W = OFF_ROUTE_E + 32768 * 4;
constexpr size_t OFF_SLOT_TOK = OFF_ROUTE_W + 32768 * 4;
constexpr size_t OFF_SLOT_W = OFF_SLOT_TOK + (size_t)MSLOT * 4;
constexpr size_t OFF_BAR = OFF_SLOT_W + (size_t)MSLOT * 4;
constexpr size_t OFF_BIAS1 = OFF_BAR + 16384;
constexpr size_t OFF_RSTD = OFF_BIAS1 + 1024;
constexpr size_t OFF_SLOT_RS = OFF_RSTD + (size_t)T * 4;
constexpr size_t OFF_WRT = OFF_SLOT_RS + (size_t)MSLOT * 4;
static_assert(OFF_WRT + 2 * 48 * 1024 * 2 <= (1u << 20), "ctrl overflow");
constexpr size_t OFF_R1 = 1u << 20;
constexpr size_t SZ_PROJ = (size_t)T * PP * 2;
constexpr size_t OFF_PROJ = OFF_R1;
constexpr size_t OFF_BC = OFF_PROJ + SZ_PROJ;
constexpr size_t OFF_CSTATE = OFF_BC + (size_t)T * 256 * 4;
constexpr size_t OFF_R1_END = OFF_CSTATE + (size_t)1024 * 8192 * 4;
constexpr size_t OFF_MRG = OFF_R1 + (size_t)T * 2048 * 2;
constexpr size_t OFF_H2 = OFF_R1;
constexpr size_t OFF_HID = OFF_H2 + (size_t)T * 1024 * 2;
constexpr size_t OFF_Y0 = OFF_HID + (size_t)2 * T * 256 * 2;
constexpr size_t OFF_Y1 = OFF_Y0 + (size_t)T * 1024 * 2;
static_assert(OFF_MRG + (size_t)T * 1024 * 2 <= OFF_R1_END, "alias overflow");
static_assert(OFF_Y1 + (size_t)T * 1024 * 2 <= OFF_R1_END, "alias overflow");
constexpr size_t OFF_YA = OFF_R1_END;
constexpr size_t OFF_YB = OFF_YA + (size_t)T * 512 * 2;
constexpr size_t OFF_KCB = OFF_YB + (size_t)T * 512 * 2;
constexpr size_t OFF_VCB = OFF_KCB + 8 * 256 * 64 * 2;
constexpr size_t OFF_VCBT = OFF_VCB + 8 * 256 * 64 * 2;
constexpr size_t OFF_HIDC = OFF_VCBT + 8 * 256 * 64 * 2;
constexpr size_t OFF_VST = OFF_HIDC + 2 * 2048 * 128 * 2;
constexpr size_t OFF_VWT = OFF_VST + (size_t)8 * 64 * S * 2;
constexpr size_t OFF_WINT = OFF_VWT + (size_t)8 * 64 * S * 2;
constexpr size_t OFF_CK1T = OFF_WINT + (size_t)NIN * 1024 * 2;
constexpr size_t OFF_CV1T = OFF_CK1T + 128 * 2048 * 2;
constexpr size_t OFF_CK2T = OFF_CV1T + 128 * 2048 * 2;
constexpr size_t OFF_CV2T = OFF_CK2T + 128 * 128 * 2;
constexpr size_t OFF_WAT = OFF_CV2T + 128 * 128 * 2;
constexpr size_t OFF_WBT = OFF_WAT + 1024 * 512 * 2;
constexpr size_t OFF_WOT = OFF_WBT + 1024 * 512 * 2;
constexpr size_t OFF_WGT = OFF_WOT + 1024 * 1024 * 2;
constexpr size_t OFF_WUT = OFF_WGT + (size_t)32 * 256 * 1024 * 2;
constexpr size_t OFF_WDT = OFF_WUT + (size_t)32 * 256 * 1024 * 2;
constexpr size_t OFF_LTOK = OFF_WDT + (size_t)32 * 1024 * 256 * 2;
constexpr size_t OFF_LW = OFF_LTOK + (size_t)32 * 16384 * 4;
constexpr size_t OFF_END = OFF_LW + (size_t)32 * 16384 * 4;
static_assert(OFF_END <= (size_t)256 << 20, "workspace overflow");

#define XB_TMO      128
#define XB_XCNT(j)  (256  + 64 * (j))
#define XB_XSUB(j)  (1280 + 64 * (j))
#define XB_XGEN(j)  (2304 + 64 * (j))
#define XB_TOP      3328
#define XB_TOPGEN   3392
#define XCD_BAR_WORDS 3456
#define XB_SPIN_CAP (1u << 18)
#define LAS __attribute__((address_space(3)))

__device__ __forceinline__ unsigned xb_ld(unsigned* p)              { return __hip_atomic_load(p, __ATOMIC_RELAXED, __HIP_MEMORY_SCOPE_AGENT); }
__device__ __forceinline__ unsigned xb_add(unsigned* p, unsigned v) { return __hip_atomic_fetch_add(p, v, __ATOMIC_RELAXED, __HIP_MEMORY_SCOPE_AGENT); }
__device__ __forceinline__ unsigned xb_xcc_id() { return (unsigned)__builtin_amdgcn_s_getreg((3 << 11) | 20) & 0xFu; }
#define XB_SPIN(cond, bar) do { unsigned _sp = 0; while (cond) { __builtin_amdgcn_s_sleep(1); \
    if ((++_sp & 255u) == 0u) { if (xb_ld(&(bar)[XB_TMO])) break; if (_sp > XB_SPIN_CAP) { atomicAdd(&(bar)[XB_TMO], 1u); break; } } } } while (0)

struct XcdBarrier { unsigned* bar; unsigned x; volatile LAS unsigned* st; };

__device__ __forceinline__ XcdBarrier xcd_barrier_post(unsigned* bar, volatile LAS unsigned* st) {
    XcdBarrier b; b.bar = bar; b.x = xb_xcc_id(); b.st = st;
    if (threadIdx.x == 0) (void)xb_add(&bar[XB_XCNT(b.x)], 1u);
    return b;
}
__device__ __forceinline__ void xcd_barrier_complete(unsigned* bar, unsigned x, unsigned& nloc, unsigned& nx) {
    const unsigned G = gridDim.x * gridDim.y * gridDim.z;
    unsigned sum, cnt, mine, sp = 0u;
    for (;;) {
        sum = 0u; cnt = 0u; mine = 0u;
#pragma unroll
        for (unsigned j = 0; j < 16; ++j) { const unsigned c = xb_ld(&bar[XB_XCNT(j)]); sum += c; cnt += (c > 0u) ? 1u : 0u; mine = (j == x) ? c : mine; }
        if (sum == G) break;
        __builtin_amdgcn_s_sleep(1);
        if ((++sp & 255u) == 0u) { if (xb_ld(&bar[XB_TMO])) break; if (sp > XB_SPIN_CAP) { atomicAdd(&bar[XB_TMO], 1u); break; } }
    }
    nloc = mine > 0u ? mine : 1u; nx = cnt > 0u ? cnt : 1u;
}
__device__ __forceinline__ void xcd_barrier(const XcdBarrier& b) {
    asm volatile("s_waitcnt vmcnt(0)" ::: "memory");
    __syncthreads();
    if (threadIdx.x == 0) {
        unsigned* bar = b.bar;
        __builtin_amdgcn_s_waitcnt(0);
        unsigned nloc = b.st[0], nx = b.st[1];
        if (nloc == 0u) { xcd_barrier_complete(bar, b.x, nloc, nx); b.st[0] = nloc; b.st[1] = nx; }
        const unsigned old = xb_add(&bar[XB_XSUB(b.x)], 1u);
        const unsigned gen = old / nloc;
        if (old + 1u == (gen + 1u) * nloc) {
            __builtin_amdgcn_fence(__ATOMIC_RELEASE, "agent");
            asm volatile("s_waitcnt vmcnt(0)" ::: "memory");
            const unsigned og = xb_add(&bar[XB_TOP], 1u);
            const unsigned tg = og / nx;
            if (og + 1u == (tg + 1u) * nx) xb_add(&bar[XB_TOPGEN], 1u);
            else XB_SPIN(xb_ld(&bar[XB_TOPGEN]) == tg, bar);
            __builtin_amdgcn_fence(__ATOMIC_ACQUIRE, "agent");
            xb_add(&bar[XB_XGEN(b.x)], 1u);
            asm volatile("s_waitcnt vmcnt(0)" ::: "memory");
        } else {
            XB_SPIN(xb_ld(&bar[XB_XGEN(b.x)]) == gen, bar);
            __builtin_amdgcn_fence(__ATOMIC_ACQUIRE, "agent");
            asm volatile("s_waitcnt vmcnt(0)" ::: "memory");
        }
    }
    __syncthreads();
}


struct Params {
    const float *x, *g_mix, *w_in, *pe_k, *ck1, *ck2, *pe_v, *cv1, *cv2, *rel_bias, *w_alpha, *b_alpha, *norm_g, *w_ba, *w_bb, *w_out, *g_ffn,
                *w_rg, *b_rg, *w_re, *b_re, *w_eg, *w_eu, *w_ed, *g_final;
    float* out; char* ws;
};

__device__ __forceinline__ float wave_max(float v) { for (int o = 32; o > 0; o >>= 1) v = fmaxf(v, __shfl_xor(v, o)); return v; }
__device__ __forceinline__ float wave_sum(float v) { for (int o = 32; o > 0; o >>= 1) v += __shfl_xor(v, o); return v; }
__device__ __forceinline__ void wave_lds_sync() { asm volatile("s_waitcnt lgkmcnt(0)" ::: "memory"); }


__device__ __forceinline__ void rms_h_row(int row, const float* __restrict__ x, const float* __restrict__ g, bf16_t* __restrict__ h, int lane) {
    const float* xr = x + (size_t)row * D + lane * 4;
    f32x4 v[4]; float s = 0.f;
#pragma unroll
    for (int i = 0; i < 4; ++i) { v[i] = *(const f32x4*)(xr + 256 * i); s += v[i][0] * v[i][0] + v[i][1] * v[i][1] + v[i][2] * v[i][2] + v[i][3] * v[i][3]; }
    s = wave_sum(s);
    const float r = rsqrtf(s * (1.0f / D) + 1e-6f);
#pragma unroll
    for (int i = 0; i < 4; ++i) {
        const f32x4 gg = *(const f32x4*)(g + lane * 4 + 256 * i);
        uint2 o; o.x = pack_bf16(v[i][0] * r * gg[0], v[i][1] * r * gg[1]); o.y = pack_bf16(v[i][2] * r * gg[2], v[i][3] * r * gg[3]);
        *(uint2*)(h + (size_t)row * D + lane * 4 + 256 * i) = o;
    }
}
__device__ __forceinline__ void final_row(int row, float* __restrict__ x2out, const bf16_t* __restrict__ Y0, const bf16_t* __restrict__ Y1, const float* __restrict__ g, int lane) {
    float* xr = x2out + (size_t)row * D + lane * 4;
    f32x4 v[4]; float s = 0.f;
#pragma unroll
    for (int i = 0; i < 4; ++i) {
        v[i] = *(const f32x4*)(xr + 256 * i);
        const uint2 a = *(const uint2*)(Y0 + (size_t)row * D + lane * 4 + 256 * i), c = *(const uint2*)(Y1 + (size_t)row * D + lane * 4 + 256 * i);
        v[i][0] += __uint_as_float(a.x << 16) + __uint_as_float(c.x << 16);
        v[i][1] += __uint_as_float(a.x & 0xFFFF0000u) + __uint_as_float(c.x & 0xFFFF0000u);
        v[i][2] += __uint_as_float(a.y << 16) + __uint_as_float(c.y << 16);
        v[i][3] += __uint_as_float(a.y & 0xFFFF0000u) + __uint_as_float(c.y & 0xFFFF0000u);
        s += v[i][0] * v[i][0] + v[i][1] * v[i][1] + v[i][2] * v[i][2] + v[i][3] * v[i][3];
    }
    s = wave_sum(s);
    const float r = rsqrtf(s * (1.0f / D) + 1e-6f);
#pragma unroll
    for (int i = 0; i < 4; ++i) {
        const f32x4 gg = *(const f32x4*)(g + lane * 4 + 256 * i);
        *(f32x4*)(xr + 256 * i) = (f32x4){v[i][0] * r * gg[0], v[i][1] * r * gg[1], v[i][2] * r * gg[2], v[i][3] * r * gg[3]};
    }
}

__device__ __forceinline__ void prep_router_w(const float* __restrict__ w_rg, const float* __restrict__ w_re, bf16_t* __restrict__ WrT) {
    for (int idx = blockIdx.x * 256 + threadIdx.x; idx < 48 * 1024; idx += gridDim.x * 256) {
        const int n = idx >> 10, k = idx & 1023;
        const float w = n < 4 ? w_rg[k * 4 + n] : (n < 36 ? w_re[k * 32 + n - 4] : 0.f);
        const bf16_t hi = f2bf(w);
        WrT[idx] = hi; WrT[48 * 1024 + idx] = f2bf(w - bf2f(hi));
    }
}

__device__ __forceinline__ void router_task(int task, const float* __restrict__ x2, const float* __restrict__ g, const bf16_t* __restrict__ WrT,
                                            const float* __restrict__ b_rg, const float* __restrict__ b_re, bf16_t* __restrict__ h2, float* __restrict__ rstd_out,
                                            int* __restrict__ ltok, float* __restrict__ lw, int* __restrict__ cnt, char* wsm, int lane) {
    float (*lg)[49] = (float (*)[49])wsm;
    float* rs = (float*)(wsm + 16 * 49 * 4);
    const int fr = lane & 15, fq = lane >> 4, r0 = task * 16;
    const float* xr = x2 + (size_t)(r0 + fr) * D + fq * 8;
    bf16_t* hr = h2 + (size_t)(r0 + fr) * D + fq * 8;
    const bf16_t* wh = WrT + (size_t)fr * 1024 + fq * 8;
    f32x4 acc[3];
#pragma unroll
    for (int nt = 0; nt < 3; ++nt) acc[nt] = (f32x4){0.f, 0.f, 0.f, 0.f};
    float ssq = 0.f;
#pragma unroll 2
    for (int ks = 0; ks < 32; ++ks) {
        const f32x4 x0 = *(const f32x4*)(xr + ks * 32), x1 = *(const f32x4*)(xr + ks * 32 + 4);
        const f32x4 g0 = *(const f32x4*)(g + ks * 32 + fq * 8), g1 = *(const f32x4*)(g + ks * 32 + fq * 8 + 4);
        float xg[8];
#pragma unroll
        for (int e = 0; e < 4; ++e) { xg[e] = x0[e] * g0[e]; xg[4 + e] = x1[e] * g1[e]; ssq += x0[e] * x0[e] + x1[e] * x1[e]; }
        u32x4 hi, lo;
#pragma unroll
        for (int e = 0; e < 4; ++e) {
            hi[e] = pack_bf16(xg[2 * e], xg[2 * e + 1]);
            lo[e] = pack_bf16(xg[2 * e] - __uint_as_float(hi[e] << 16), xg[2 * e + 1] - __uint_as_float(hi[e] & 0xFFFF0000u));
        }
        *(u32x4*)(hr + ks * 32) = hi;
        const bf16x8 ah = __builtin_bit_cast(bf16x8, hi), al = __builtin_bit_cast(bf16x8, lo);
#pragma unroll
        for (int nt = 0; nt < 3; ++nt) {
            const bf16x8 bh = *(const bf16x8*)(wh + (size_t)nt * 16 * 1024 + ks * 32), bl = *(const bf16x8*)(wh + (size_t)(48 + nt * 16) * 1024 + ks * 32);
            acc[nt] = __builtin_amdgcn_mfma_f32_16x16x32_bf16(ah, bh, acc[nt], 0, 0, 0);
            acc[nt] = __builtin_amdgcn_mfma_f32_16x16x32_bf16(al, bh, acc[nt], 0, 0, 0);
            acc[nt] = __builtin_amdgcn_mfma_f32_16x16x32_bf16(ah, bl, acc[nt], 0, 0, 0);
        }
    }
    ssq += __shfl_xor(ssq, 16); ssq += __shfl_xor(ssq, 32);
    const float rstd = rsqrtf(ssq * (1.0f / D) + 1e-6f);
    wave_lds_sync();
    if (fq == 0) { rs[fr] = rstd; rstd_out[r0 + fr] = rstd; }
#pragma unroll
    for (int nt = 0; nt < 3; ++nt)
#pragma unroll
        for (int i = 0; i < 4; ++i) lg[4 * fq + i][nt * 16 + fr] = acc[nt][i];
    wave_lds_sync();
    if (lane < 16) {
        const int row = r0 + lane; const float rsv = rs[lane];
        float l4[4];
#pragma unroll
        for (int j = 0; j < 4; ++j) l4[j] = lg[lane][j] * rsv + b_rg[j];
        int gs = 0; float mx = l4[0];
#pragma unroll
        for (int j = 1; j < 4; ++j) if (l4[j] > mx) { mx = l4[j]; gs = j; }
        float den = 0.f;
#pragma unroll
        for (int j = 0; j < 4; ++j) den += __expf(l4[j] - mx);
        const float gp = 1.f / den;
        float v0 = -3e38f, v1 = -3e38f; int i0 = 0, i1 = 0;
        for (int j = 0; j < 8; ++j) {
            const float l = lg[lane][4 + gs * 8 + j] * rsv + b_re[gs * 8 + j];
            if (l > v0) { v1 = v0; i1 = i0; v0 = l; i0 = j; }
            else if (l > v1) { v1 = l; i1 = j; }
        }
        const float e1 = __expf(v1 - v0);
        const float w0 = gp / (1.f + e1), w1 = gp * e1 / (1.f + e1);
        const int ea = gs * 8 + i0, eb = gs * 8 + i1;
        const int pa_ = atomicAdd(&cnt[ea], 1), pb_ = atomicAdd(&cnt[eb], 1);
        ltok[ea * 16384 + pa_] = row * 2; lw[ea * 16384 + pa_] = w0;
        ltok[eb * 16384 + pb_] = row * 2 + 1; lw[eb * 16384 + pb_] = w1;
    }
    wave_lds_sync();
}
__device__ __forceinline__ void transpose_tile(const float* __restrict__ src, int ld_src, int N, bf16_t* __restrict__ dst, int ld_dst, int kt, int nt, char* smem) {
    float (*tl)[65] = (float (*)[65])smem;
    const int tid = threadIdx.x;
    const int c4 = (tid & 15) * 4, r0 = tid >> 4;
#pragma unroll
    for (int i = 0; i < 4; ++i) {
        const int k = r0 + 16 * i, n = nt * 64 + c4;
        float4 v = make_float4(0.f, 0.f, 0.f, 0.f);
        if (n < N) v = *(const float4*)(src + (size_t)(kt * 64 + k) * ld_src + n);
        tl[k][c4] = v.x; tl[k][c4 + 1] = v.y; tl[k][c4 + 2] = v.z; tl[k][c4 + 3] = v.w;
    }
    __syncthreads();
    const int kc = (tid & 7) * 8, n0 = tid >> 3;
#pragma unroll
    for (int i = 0; i < 2; ++i) {
        const int nl = n0 + 32 * i, n = nt * 64 + nl;
        if (n < N) {
            uint4 o;
            o.x = pack_bf16(tl[kc][nl], tl[kc + 1][nl]); o.y = pack_bf16(tl[kc + 2][nl], tl[kc + 3][nl]);
            o.z = pack_bf16(tl[kc + 4][nl], tl[kc + 5][nl]); o.w = pack_bf16(tl[kc + 6][nl], tl[kc + 7][nl]);
            *(uint4*)(dst + (size_t)n * ld_dst + kt * 64 + kc) = o;
        }
    }
    __syncthreads();
}

__device__ __forceinline__ void ph_prep(const Params& p, char* smem) {
    char* ws = p.ws;
    constexpr int N0 = 16 * 77, N1 = N0 + 64, N2 = N1 + 64, N3 = N2 + 2, N4 = N3 + 2, N5 = N4 + 128, N6 = N5 + 128, N7 = N6 + 256, N8 = N7 + 2048, N9 = N8 + 2048, N10 = N9 + 2048;
    for (int t = blockIdx.x; t < N10; t += gridDim.x) {
        if (t < N0) transpose_tile(p.w_in, NIN, NIN, (bf16_t*)(ws + OFF_WINT), 1024, t / 77, t % 77, smem);
        else if (t < N1) { const int q = t - N0; transpose_tile(p.ck1, 128, 128, (bf16_t*)(ws + OFF_CK1T), 2048, q >> 1, q & 1, smem); }
        else if (t < N2) { const int q = t - N1; transpose_tile(p.cv1, 128, 128, (bf16_t*)(ws + OFF_CV1T), 2048, q >> 1, q & 1, smem); }
        else if (t < N3) { const int q = t - N2; transpose_tile(p.ck2, 64, 64, (bf16_t*)(ws + OFF_CK2T), 128, q, 0, smem); }
        else if (t < N4) { const int q = t - N3; transpose_tile(p.cv2, 64, 64, (bf16_t*)(ws + OFF_CV2T), 128, q, 0, smem); }
        else if (t < N5) { const int q = t - N4; transpose_tile(p.w_ba, 1024, 1024, (bf16_t*)(ws + OFF_WAT), 512, q >> 4, q & 15, smem); }
        else if (t < N6) { const int q = t - N5; transpose_tile(p.w_bb, 1024, 1024, (bf16_t*)(ws + OFF_WBT), 512, q >> 4, q & 15, smem); }
        else if (t < N7) { const int q = t - N6; transpose_tile(p.w_out, 1024, 1024, (bf16_t*)(ws + OFF_WOT), 1024, q >> 4, q & 15, smem); }
        else if (t < N8) { const int q = t - N7, e = q >> 6, r = q & 63; transpose_tile(p.w_eg + (size_t)e * 1024 * 256, 256, 256, (bf16_t*)(ws + OFF_WGT) + (size_t)e * 256 * 1024, 1024, r >> 2, r & 3, smem); }
        else if (t < N9) { const int q = t - N8, e = q >> 6, r = q & 63; transpose_tile(p.w_eu + (size_t)e * 1024 * 256, 256, 256, (bf16_t*)(ws + OFF_WUT) + (size_t)e * 256 * 1024, 1024, r >> 2, r & 3, smem); }
        else { const int q = t - N9, e = q >> 6, r = q & 63; transpose_tile(p.w_ed + (size_t)e * 256 * 1024, 1024, 1024, (bf16_t*)(ws + OFF_WDT) + (size_t)e * 1024 * 256, 256, r >> 4, r & 15, smem); }
    }
    for (int t = blockIdx.x; t < 8; t += gridDim.x) {
        const int which = t >> 2, n = (t & 3) * 32 + (threadIdx.x & 31), ksp = threadIdx.x >> 5;
        const float* pe = which ? p.pe_v : p.pe_k; const float* w1 = which ? p.cv1 : p.ck1;
        float a = 0.f;
        for (int k = ksp * 256; k < ksp * 256 + 256; ++k) a += pe[k] * w1[(size_t)k * 128 + n];
        float* red = (float*)smem;
        red[threadIdx.x] = a;
        __syncthreads();
        if (threadIdx.x < 32) {
            float s = 0.f;
#pragma unroll
            for (int j = 0; j < 8; ++j) s += red[j * 32 + threadIdx.x];
            ((float*)(ws + OFF_BIAS1))[which * 128 + n] = s;
        }
        __syncthreads();
    }
    prep_router_w(p.w_rg, p.w_re, (bf16_t*)(ws + OFF_WRT));
    for (int row = blockIdx.x * 4 + (threadIdx.x >> 6); row < T; row += gridDim.x * 4) rms_h_row(row, p.x, p.g_mix, (bf16_t*)p.out, threadIdx.x & 63);
}

__device__ __forceinline__ int tile_off(int row, int chunk) { return row * 128 + ((chunk ^ (row & 7)) << 4); }

__device__ __forceinline__ void glds16(const void* g, char* l) {
    __builtin_amdgcn_global_load_lds((const __attribute__((address_space(1))) unsigned*)g, (__attribute__((address_space(3))) unsigned*)l, 16, 0, 0);
}
__device__ __forceinline__ void gemm_kloop(f32x4 (&acc)[4][4], const bf16_t* const (&pa)[4], const bf16_t* const (&pb)[4], int ka, int kb, int nk, char* smem) {
    int tid_ = threadIdx.x; asm volatile("" : "+v"(tid_));
    const int tid = tid_, lane = tid & 63, wid = tid >> 6, wr = wid >> 1, wc = wid & 1, fr = lane & 15, fq = lane >> 4;
    const int offA = (wr * 64 + fr) * 128, offB = 16384 + (wc * 64 + fr) * 128, x = fr & 7;
    __syncthreads();
#pragma unroll
    for (int i = 0; i < 4; ++i) { glds16(pa[i], smem + i * 4096 + tid * 16); glds16(pb[i], smem + 16384 + i * 4096 + tid * 16); }
    asm volatile("s_waitcnt vmcnt(0)" ::: "memory");
    __syncthreads();
    for (int kt = 0; kt < nk; ++kt) {
        const int cur = kt & 1;
        if (kt + 1 < nk) {
            char* st = smem + (cur ^ 1) * 32768 + tid * 16;
#pragma unroll
            for (int i = 0; i < 4; ++i) { glds16(pa[i] + (size_t)(kt + 1) * ka, st + i * 4096); glds16(pb[i] + (size_t)(kt + 1) * kb, st + 16384 + i * 4096); }
        }
        const char* sa = smem + cur * 32768 + offA;
        const char* sb = smem + cur * 32768 + offB;
#pragma unroll
        for (int ks = 0; ks < 2; ++ks) {
            const int ch = ((ks * 4 + fq) ^ x) << 4;
            bf16x8 af[4], bfr[4];
#pragma unroll
            for (int mi = 0; mi < 4; ++mi) af[mi] = *(const bf16x8*)(sa + mi * 2048 + ch);
#pragma unroll
            for (int ni = 0; ni < 4; ++ni) bfr[ni] = *(const bf16x8*)(sb + ni * 2048 + ch);
#pragma unroll
            for (int mi = 0; mi < 4; ++mi)
#pragma unroll
                for (int ni = 0; ni < 4; ++ni) acc[mi][ni] = __builtin_amdgcn_mfma_f32_16x16x32_bf16(bfr[ni], af[mi], acc[mi][ni], 0, 0, 0);
        }
        asm volatile("s_waitcnt vmcnt(0)" ::: "memory");
        __syncthreads();
    }
}
__device__ __forceinline__ void acc_zero(f32x4 (&acc)[4][4]) {
#pragma unroll
    for (int mi = 0; mi < 4; ++mi)
#pragma unroll
        for (int ni = 0; ni < 4; ++ni) acc[mi][ni] = (f32x4){0.f, 0.f, 0.f, 0.f};
}
#define GEMM_LANE_VARS const int tid = threadIdx.x, lane = tid & 63, wid = tid >> 6, wr = wid >> 1, wc = wid & 1, fr = lane & 15, fq = lane >> 4, lrow = tid >> 3, lch8 = ((tid & 7) ^ ((tid >> 3) & 7)) * 8; (void)wr; (void)wc; (void)fr; (void)fq; (void)lrow; (void)lch8;
__device__ __forceinline__ uint2 pack4(f32x4 v) { uint2 o; o.x = pack_bf16(v[0], v[1]); o.y = pack_bf16(v[2], v[3]); return o; }
__device__ __forceinline__ float sigmoidf_(float a) { return 1.f / (1.f + __expf(-a)); }

__device__ __forceinline__ void ph_proj(const bf16_t* __restrict__ h, const bf16_t* __restrict__ WinT, bf16_t* __restrict__ proj, char* smem) {
    GEMM_LANE_VARS
    for (int u = blockIdx.x; u < 128 * 23; u += gridDim.x) {
        const int xg = u & 7, v = u >> 3, tn = v % 23, tm = (v / 23) * 8 + xg;
        const bf16_t* pa[4]; const bf16_t* pb[4];
#pragma unroll
        for (int i = 0; i < 4; ++i) { pa[i] = h + (size_t)(tm * 128 + lrow + 32 * i) * 1024 + lch8; pb[i] = WinT + (size_t)(tn * 128 + lrow + 32 * i) * 1024 + lch8; }
        f32x4 acc[4][4]; acc_zero(acc);
        gemm_kloop(acc, pa, pb, 64, 64, 16, smem);
#pragma unroll
        for (int mi = 0; mi < 4; ++mi)
#pragma unroll
            for (int ni = 0; ni < 4; ++ni) {
                const int m = tm * 128 + wr * 64 + mi * 16 + fr, n = tn * 128 + wc * 64 + ni * 16 + 4 * fq;
                if (n < NPROJ) *(uint2*)(proj + (size_t)m * PP + n) = pack4(acc[mi][ni]);
            }
    }
}

__device__ __forceinline__ void ph_cmp1(const bf16_t* __restrict__ proj, const char* ws, char* smem) {
    GEMM_LANE_VARS
    for (int u = blockIdx.x; u < 32; u += gridDim.x) {
        const int which = u >> 4, tm = u & 15;
        const bf16_t* W1T = (const bf16_t*)(ws + (which ? OFF_CV1T : OFF_CK1T));
        const float* bias1 = (const float*)(ws + OFF_BIAS1) + which * 128;
        bf16_t* hid = (bf16_t*)(ws + OFF_HIDC) + (size_t)which * 2048 * 128;
        const int col0 = which ? VC : KC;
        const bf16_t* pa[4]; const bf16_t* pb[4];
#pragma unroll
        for (int i = 0; i < 4; ++i) {
            const int m = tm * 128 + lrow + 32 * i, bg = m >> 8, c = (m & 255) > 254 ? 254 : (m & 255), b = bg >> 1, g = bg & 1;
            pa[i] = proj + (size_t)(b * S + 16 * c) * PP + col0 + g * 64 + lch8;
            pb[i] = W1T + (size_t)(lrow + 32 * i) * 2048 + lch8;
        }
        f32x4 acc[4][4]; acc_zero(acc);
        gemm_kloop(acc, pa, pb, PP, 64, 32, smem);
#pragma unroll
        for (int mi = 0; mi < 4; ++mi)
#pragma unroll
            for (int ni = 0; ni < 4; ++ni) {
                const int m = tm * 128 + wr * 64 + mi * 16 + fr, n = wc * 64 + ni * 16 + 4 * fq;
                f32x4 v = acc[mi][ni];
#pragma unroll
                for (int j = 0; j < 4; ++j) { const float a = v[j] + bias1[n + j]; const float t = 0.7978845608028654f * (a + 0.044715f * a * a * a); v[j] = 0.5f * a * (1.f + tanhf(t)); }
                *(uint2*)(hid + (size_t)m * 128 + n) = pack4(v);
            }
    }
}

__device__ __forceinline__ void ph_cmp2(const char* ws_c, char* ws, char* smem) {
    GEMM_LANE_VARS
    for (int u = blockIdx.x; u < 32; u += gridDim.x) {
        const int which = u >> 4, tm = u & 15;
        const bf16_t* W2T = (const bf16_t*)(ws_c + (which ? OFF_CV2T : OFF_CK2T));
        const bf16_t* hid = (const bf16_t*)(ws_c + OFF_HIDC) + (size_t)which * 2048 * 128;
        const bf16_t* pa[4]; const bf16_t* pb[4];
#pragma unroll
        for (int i = 0; i < 4; ++i) { pa[i] = hid + (size_t)(tm * 128 + lrow + 32 * i) * 128 + lch8; pb[i] = W2T + (size_t)(lrow + 32 * i) * 128 + lch8; }
        f32x4 acc[4][4]; acc_zero(acc);
        gemm_kloop(acc, pa, pb, 64, 64, 2, smem);
        if (wc == 0) {
            bf16_t* outp = (bf16_t*)(ws + (which ? OFF_VCB : OFF_KCB));
            bf16_t* outT = (bf16_t*)(ws + OFF_VCBT);
#pragma unroll
            for (int mi = 0; mi < 4; ++mi)
#pragma unroll
                for (int ni = 0; ni < 4; ++ni) {
                    const int m = tm * 128 + wr * 64 + mi * 16 + fr, n = ni * 16 + 4 * fq, c = m & 255, bg = m >> 8;
                    f32x4 v = acc[mi][ni];
                    if (c == 255) v = (f32x4){0.f, 0.f, 0.f, 0.f};
                    *(uint2*)(outp + (size_t)m * 64 + n) = pack4(v);
                    if (which) {
#pragma unroll
                        for (int j = 0; j < 4; ++j) outT[((size_t)bg * 64 + n + j) * 256 + c] = f2bf(v[j]);
                    }
                }
        }
    }
}

typedef unsigned u32x2 __attribute__((ext_vector_type(2)));
__device__ __forceinline__ u32x2 pack4v(f32x4 v) { u32x2 o; o[0] = pack_bf16(v[0], v[1]); o[1] = pack_bf16(v[2], v[3]); return o; }
__device__ __forceinline__ f32x4 unpack4v(u32x2 o) { return (f32x4){__uint_as_float(o[0] << 16), __uint_as_float(o[0] & 0xFFFF0000u), __uint_as_float(o[1] << 16), __uint_as_float(o[1] & 0xFFFF0000u)}; }
template <int HALF>
__device__ __forceinline__ void merge_half(u32x2 (&tpk)[4][4], int tm, int tn, const bf16_t* __restrict__ h, const bf16_t* __restrict__ WinT, const bf16_t* __restrict__ yy,
                                           const bf16_t* __restrict__ WT, bf16_t* __restrict__ mrg, char* smem) {
    GEMM_LANE_VARS
    u32x2 sg[4][4];
    {
        const bf16_t* pa[4]; const bf16_t* pb[4];
#pragma unroll
        for (int i = 0; i < 4; ++i) { pa[i] = h + (size_t)(tm * 128 + lrow + 32 * i) * 1024 + lch8; pb[i] = WinT + (size_t)((HALF ? MGB : MGA) + tn * 128 + lrow + 32 * i) * 1024 + lch8; }
        f32x4 gg[4][4]; acc_zero(gg);
        gemm_kloop(gg, pa, pb, 64, 64, 16, smem);
#pragma unroll
        for (int mi = 0; mi < 4; ++mi)
#pragma unroll
            for (int ni = 0; ni < 4; ++ni) {
                f32x4 t;
#pragma unroll
                for (int j = 0; j < 4; ++j) t[j] = sigmoidf_(gg[mi][ni][j]);
                sg[mi][ni] = pack4v(t);
            }
    }
    {
        const bf16_t* pa[4]; const bf16_t* pb[4];
#pragma unroll
        for (int i = 0; i < 4; ++i) { pa[i] = yy + (size_t)(tm * 128 + lrow + 32 * i) * 512 + lch8; pb[i] = WT + (size_t)(tn * 128 + lrow + 32 * i) * 512 + lch8; }
        f32x4 acc[4][4]; acc_zero(acc);
        gemm_kloop(acc, pa, pb, 64, 64, 8, smem);
#pragma unroll
        for (int mi = 0; mi < 4; ++mi)
#pragma unroll
            for (int ni = 0; ni < 4; ++ni) {
                f32x4 t = unpack4v(sg[mi][ni]) * acc[mi][ni];
                if (HALF == 0) tpk[mi][ni] = pack4v(t);
                else {
                    t += unpack4v(tpk[mi][ni]);
                    const int m = tm * 128 + wr * 64 + mi * 16 + fr, n = tn * 128 + wc * 64 + ni * 16 + 4 * fq;
                    *(u32x2*)(mrg + (size_t)m * 1024 + n) = pack4v(t);
                }
            }
    }
}
__device__ __forceinline__ void ph_merge(const bf16_t* __restrict__ h, const bf16_t* __restrict__ WinT, const bf16_t* __restrict__ ya, const bf16_t* __restrict__ yb,
                                         const bf16_t* __restrict__ WaT, const bf16_t* __restrict__ WbT, bf16_t* __restrict__ mrg, char* smem) {
    for (int u = blockIdx.x; u < 128 * 8; u += gridDim.x) {
        const int xg = u & 7, v = u >> 3, tn = v & 7, tm = (v >> 3) * 8 + xg;
        u32x2 tpk[4][4];
        merge_half<0>(tpk, tm, tn, h, WinT, ya, WaT, mrg, smem);
        merge_half<1>(tpk, tm, tn, h, WinT, yb, WbT, mrg, smem);
    }
}

__device__ __forceinline__ void ph_outproj(const bf16_t* __restrict__ mrg, const bf16_t* __restrict__ WoT, const float* __restrict__ x, float* __restrict__ x2, char* smem) {
    GEMM_LANE_VARS
    for (int u = blockIdx.x; u < 128 * 8; u += gridDim.x) {
        const int xg = u & 7, v = u >> 3, tn = v & 7, tm = (v >> 3) * 8 + xg;
        const bf16_t* pa[4]; const bf16_t* pb[4];
#pragma unroll
        for (int i = 0; i < 4; ++i) { pa[i] = mrg + (size_t)(tm * 128 + lrow + 32 * i) * 1024 + lch8; pb[i] = WoT + (size_t)(tn * 128 + lrow + 32 * i) * 1024 + lch8; }
        f32x4 acc[4][4]; acc_zero(acc);
        gemm_kloop(acc, pa, pb, 64, 64, 16, smem);
#pragma unroll
        for (int mi = 0; mi < 4; ++mi)
#pragma unroll
            for (int ni = 0; ni < 4; ++ni) {
                const int m = tm * 128 + wr * 64 + mi * 16 + fr, n = tn * 128 + wc * 64 + ni * 16 + 4 * fq;
                const float4 xv = *(const float4*)(x + (size_t)m * 1024 + n);
                *(float4*)(x2 + (size_t)m * 1024 + n) = make_float4(xv.x + acc[mi][ni][0], xv.y + acc[mi][ni][1], xv.z + acc[mi][ni][2], xv.w + acc[mi][ni][3]);
            }
    }
}

__device__ __forceinline__ int moe_tile_decode(const int* __restrict__ cnt, int t, int& e, int& i) {
    int acc = 0; e = 0; i = 0;
    for (int ee = 0; ee < 32; ++ee) { const int nt = (cnt[ee] + 127) >> 7; if (t >= acc && t < acc + nt) { e = ee; i = t - acc; } acc += nt; }
    return acc;
}

__device__ __forceinline__ void ph_moe1(const bf16_t* __restrict__ h2, const bf16_t* __restrict__ WgT, const bf16_t* __restrict__ WuT, const int* __restrict__ cnt,
                                        const int* __restrict__ ltok, const float* __restrict__ lw, const float* __restrict__ rstd, bf16_t* __restrict__ hid, char* smem) {
    GEMM_LANE_VARS
    int e, ti;
    const int nu = moe_tile_decode(cnt, 0, e, ti) * 4;
    for (int u = blockIdx.x; u < nu; u += gridDim.x) {
        const int ft = u & 3;
        (void)moe_tile_decode(cnt, u >> 2, e, ti);
        const int ne = cnt[e];
        const bf16_t* pa[4]; const bf16_t* pb[4];
#pragma unroll
        for (int i = 0; i < 4; ++i) {
            const int rr = lrow + 32 * i, idx = ti * 128 + rr;
            const int tk = idx < ne ? ltok[e * 16384 + idx] : 0;
            pa[i] = h2 + (size_t)(tk >> 1) * 1024 + lch8;
            const int bwc = rr >> 6, bni = (rr >> 4) & 3, bj = rr & 15;
            const int f = ft * 64 + bwc * 32 + (bni >> 1) * 16 + bj;
            pb[i] = ((bni & 1) ? WuT : WgT) + ((size_t)e * 256 + f) * 1024 + lch8;
        }
        f32x4 acc[4][4]; acc_zero(acc);
        gemm_kloop(acc, pa, pb, 64, 64, 16, smem);
#pragma unroll
        for (int mi = 0; mi < 4; ++mi) {
            const int idx = ti * 128 + wr * 64 + mi * 16 + fr;
            if (idx < ne) {
                const int tk = ltok[e * 16384 + idx];
                const float w = lw[e * 16384 + idx], rsv = rstd[tk >> 1];
#pragma unroll
                for (int q = 0; q < 2; ++q) {
                    const int f = ft * 64 + wc * 32 + q * 16 + 4 * fq;
                    f32x4 v;
#pragma unroll
                    for (int j = 0; j < 4; ++j) { const float a = acc[mi][2 * q][j] * rsv, uu = acc[mi][2 * q + 1][j] * rsv; v[j] = a * sigmoidf_(a) * uu * w; }
                    *(uint2*)(hid + (size_t)tk * 256 + f) = pack4(v);
                }
            }
        }
    }
}

__device__ __forceinline__ void ph_moe2(const bf16_t* __restrict__ hid, const bf16_t* __restrict__ WdT, const int* __restrict__ cnt, const int* __restrict__ ltok,
                                        bf16_t* __restrict__ Y, char* smem) {
    GEMM_LANE_VARS
    int e, ti;
    const int nu = moe_tile_decode(cnt, 0, e, ti) * 8;
    for (int u = blockIdx.x; u < nu; u += gridDim.x) {
        const int tn = u & 7;
        (void)moe_tile_decode(cnt, u >> 3, e, ti);
        const int ne = cnt[e];
        const bf16_t* pa[4]; const bf16_t* pb[4];
#pragma unroll
        for (int i = 0; i < 4; ++i) {
            const int idx = ti * 128 + lrow + 32 * i;
            const int tk = idx < ne ? ltok[e * 16384 + idx] : 0;
            pa[i] = hid + (size_t)tk * 256 + lch8;
            pb[i] = WdT + ((size_t)e * 1024 + tn * 128 + lrow + 32 * i) * 256 + lch8;
        }
        f32x4 acc[4][4]; acc_zero(acc);
        gemm_kloop(acc, pa, pb, 64, 64, 4, smem);
#pragma unroll
        for (int mi = 0; mi < 4; ++mi) {
            const int idx = ti * 128 + wr * 64 + mi * 16 + fr;
            if (idx < ne) {
                const int tk = ltok[e * 16384 + idx];
                bf16_t* yr = Y + ((size_t)(tk & 1) * T + (size_t)(tk >> 1)) * 1024 + tn * 128 + wc * 64 + 4 * fq;
#pragma unroll
                for (int ni = 0; ni < 4; ++ni) *(uint2*)(yr + ni * 16) = pack4(acc[mi][ni]);
            }
        }
    }
}

constexpr float LOG2E = 1.4426950408889634f;
constexpr float NEGV = -3.0e38f;
constexpr int NSA_TB = 32768;
constexpr int NSA_IMPA = 34816;
constexpr int NSA_IMPB = NSA_IMPA + 8448;
constexpr int NSA_SELM = NSA_IMPB + 8448;

__device__ __forceinline__ int t5_bucket2(int n) {
    if (n < 16) return n;
    const int l = 16 + (int)(logf((float)n / 16.0f) / logf(8.0f) * 16.0f);
    return l < 31 ? l : 31;
}

template <int MODE, bool A0, bool A1>
__device__ __forceinline__ void nsa_tile(const char* Kst, const char* Vst, int j, bool fast, const float* tbias, const bf16x8 (&qf)[2][2], const int (&qidx)[2],
                                         const unsigned long long (&selq)[2], f32x4 (&O)[4][2], float (&m)[2], float (&l)[2], const float (&invl)[2],
                                         char* smem, int fr, int fq, int hp, int wid) {
    const float b127 = tbias[127];
    bf16x8 pf[2][2];
#pragma unroll
    for (int ct = 0; ct < 2; ++ct) {
        if ((ct == 0 && !A0) || (ct == 1 && !A1)) continue;
        f32x4 sacc[2][2];
#pragma unroll
        for (int p = 0; p < 2; ++p)
#pragma unroll
            for (int s = 0; s < 2; ++s) {
                const int row = 32 * p + 8 * (fr >> 2) + 4 * s + (fr & 3);
                const bf16x8 k0 = *(const bf16x8*)(Kst + tile_off(row, fq)), k1 = *(const bf16x8*)(Kst + tile_off(row, 4 + fq));
                f32x4 a = (f32x4){0.f, 0.f, 0.f, 0.f};
                a = __builtin_amdgcn_mfma_f32_16x16x32_bf16(k0, qf[ct][0], a, 0, 0, 0);
                a = __builtin_amdgcn_mfma_f32_16x16x32_bf16(k1, qf[ct][1], a, 0, 0, 0);
                sacc[p][s] = a;
            }
        const int q = qidx[ct];
        const bool sel = (MODE == 1) ? (((selq[ct] >> j) & 1ull) != 0ull) : true;
        float mloc = NEGV;
        if (fast) {
#pragma unroll
            for (int p = 0; p < 2; ++p)
#pragma unroll
                for (int s = 0; s < 2; ++s)
#pragma unroll
                    for (int i = 0; i < 4; ++i) {
                        const float sv = sel ? sacc[p][s][i] * (0.125f * LOG2E) + b127 : NEGV;
                        sacc[p][s][i] = sv; mloc = fmaxf(mloc, sv);
                    }
        } else {
#pragma unroll
            for (int p = 0; p < 2; ++p)
#pragma unroll
                for (int s = 0; s < 2; ++s)
#pragma unroll
                    for (int i = 0; i < 4; ++i) {
                        const int kk = 64 * j + 32 * p + 8 * fq + 4 * s + i;
                        int rel; bool valid;
                        if (MODE == 0 || MODE == 3) { rel = q - (16 * kk + 31); valid = rel >= 0; }
                        else if (MODE == 1) { rel = q - kk; valid = (rel >= 0) && sel; }
                        else { rel = q - kk; valid = (rel >= 0) && (rel < 512); }
                        const int rc = rel < 0 ? 0 : (rel > 127 ? 127 : rel);
                        const float sv = valid ? sacc[p][s][i] * (0.125f * LOG2E) + tbias[rc] : NEGV;
                        sacc[p][s][i] = sv; mloc = fmaxf(mloc, sv);
                    }
        }
        if (MODE != 3) {
            mloc = fmaxf(mloc, __shfl_xor(mloc, 16)); mloc = fmaxf(mloc, __shfl_xor(mloc, 32));
            const float mnew = fmaxf(m[ct], mloc);
            const float alpha = __builtin_amdgcn_exp2f(m[ct] - mnew);
            m[ct] = mnew;
            float psum = 0.f;
#pragma unroll
            for (int p = 0; p < 2; ++p) {
                float pv[8];
#pragma unroll
                for (int s = 0; s < 2; ++s)
#pragma unroll
                    for (int i = 0; i < 4; ++i) { pv[s * 4 + i] = __builtin_amdgcn_exp2f(sacc[p][s][i] - mnew); psum += pv[s * 4 + i]; }
                u32x4 w; w[0] = pack_bf16(pv[0], pv[1]); w[1] = pack_bf16(pv[2], pv[3]); w[2] = pack_bf16(pv[4], pv[5]); w[3] = pack_bf16(pv[6], pv[7]);
                pf[ct][p] = __builtin_bit_cast(bf16x8, w);
            }
            l[ct] = l[ct] * alpha + psum;
#pragma unroll
            for (int dt = 0; dt < 4; ++dt) O[dt][ct] = O[dt][ct] * alpha;
        } else {
            float* impA = (float*)(smem + NSA_IMPA); float* impB = (float*)(smem + NSA_IMPB);
            const int ql = wid * 8 + ct * 4 + (fr >> 2);
#pragma unroll
            for (int p = 0; p < 2; ++p)
#pragma unroll
                for (int s = 0; s < 2; ++s) {
                    float p3 = __builtin_amdgcn_exp2f(sacc[p][s][3] - m[ct]) * invl[ct];
                    float pa = __builtin_amdgcn_exp2f(sacc[p][s][0] - m[ct]) * invl[ct] + __builtin_amdgcn_exp2f(sacc[p][s][1] - m[ct]) * invl[ct]
                             + __builtin_amdgcn_exp2f(sacc[p][s][2] - m[ct]) * invl[ct] + p3;
                    pa += __shfl_xor(pa, 1); pa += __shfl_xor(pa, 2);
                    p3 += __shfl_xor(p3, 1); p3 += __shfl_xor(p3, 2);
                    const int jj = 16 * j + 8 * p + 2 * fq + s;
                    if (hp == 0) { impA[ql * 65 + jj] = pa; impB[ql * 65 + jj + 1] = p3; }
                }
        }
    }
    if (MODE != 3) {
#pragma unroll
        for (int dt = 0; dt < 4; ++dt)
#pragma unroll
            for (int p = 0; p < 2; ++p) {
                const bf16x8 vf = *(const bf16x8*)(Vst + tile_off(dt * 16 + fr, p * 4 + fq));
                if (A0) O[dt][0] = __builtin_amdgcn_mfma_f32_16x16x32_bf16(vf, pf[0][p], O[dt][0], 0, 0, 0);
                if (A1) O[dt][1] = __builtin_amdgcn_mfma_f32_16x16x32_bf16(vf, pf[1][p], O[dt][1], 0, 0, 0);
            }
    }
}

template <int MODE>
__device__ __forceinline__ void nsa_branch(const bf16_t* __restrict__ Kb, size_t kstride, const bf16_t* __restrict__ Vb, size_t vstride, int j0, int ntiles, int t0,
                                           const bf16x8 (&qf)[2][2], const int (&qidx)[2], const unsigned long long (&selq)[2], unsigned long long selor0, unsigned long long selor1,
                                           f32x4 (&O)[4][2], float (&m)[2], float (&l)[2], const float (&invl)[2], char* smem) {
    int tid_ = threadIdx.x; asm volatile("" : "+v"(tid_));
    const int tid = tid_, lane = tid & 63, wid = tid >> 6, fr = lane & 15, fq = lane >> 4, hp = fr & 3;
    const int lrow = tid >> 3;
    const float* tbias = (const float*)(smem + NSA_TB) + hp * 128;
    const bf16_t* kp[2]; const bf16_t* vp[2];
    const int sch8 = ((tid & 7) ^ (lrow & 7)) * 8;
#pragma unroll
    for (int i = 0; i < 2; ++i) { kp[i] = Kb + (size_t)(lrow + 32 * i) * kstride + sch8; vp[i] = Vb + (size_t)(lrow + 32 * i) * vstride + sch8; }
    __syncthreads();
#pragma unroll
    for (int i = 0; i < 2; ++i) { glds16(kp[i], smem + i * 4096 + tid * 16); if (MODE != 3) glds16(vp[i], smem + 8192 + i * 4096 + tid * 16); }
    asm volatile("s_waitcnt vmcnt(0)" ::: "memory");
    __syncthreads();
    for (int it = 0; it < ntiles; ++it) {
        const int cur = it & 1, j = j0 + it;
        if (it + 1 < ntiles) {
            char* st = smem + (cur ^ 1) * 16384 + tid * 16;
#pragma unroll
            for (int i = 0; i < 2; ++i) { glds16(kp[i] + (size_t)(it + 1) * 64 * kstride, st + i * 4096); if (MODE != 3) glds16(vp[i] + (size_t)(it + 1) * 64, st + 8192 + i * 4096); }
        }
        const char* Kst = smem + cur * 16384;
        const char* Vst = Kst + 8192;
        bool fast;
        if (MODE == 0 || MODE == 3) fast = (t0 - (16 * (64 * j + 63) + 31)) >= 128;
        else if (MODE == 1) fast = (t0 - (64 * j + 63)) >= 128;
        else fast = ((t0 - (64 * j + 63)) >= 128) && ((t0 + 31 - 64 * j) < 512);
        if (MODE == 1) {
            const bool a0 = ((selor0 >> j) & 1ull) != 0ull, a1 = ((selor1 >> j) & 1ull) != 0ull;
            if (a0 && a1) nsa_tile<MODE, true, true>(Kst, Vst, j, fast, tbias, qf, qidx, selq, O, m, l, invl, smem, fr, fq, hp, wid);
            else if (a0) nsa_tile<MODE, true, false>(Kst, Vst, j, fast, tbias, qf, qidx, selq, O, m, l, invl, smem, fr, fq, hp, wid);
            else if (a1) nsa_tile<MODE, false, true>(Kst, Vst, j, fast, tbias, qf, qidx, selq, O, m, l, invl, smem, fr, fq, hp, wid);
        } else {
            nsa_tile<MODE, true, true>(Kst, Vst, j, fast, tbias, qf, qidx, selq, O, m, l, invl, smem, fr, fq, hp, wid);
        }
        asm volatile("s_waitcnt vmcnt(0)" ::: "memory");
        __syncthreads();
    }
}

__device__ __forceinline__ void osum_add(uint2& acc, f32x4 o, float sc) {
    f32x4 v;
    v[0] = __uint_as_float(acc.x << 16) + o[0] * sc; v[1] = __uint_as_float(acc.x & 0xFFFF0000u) + o[1] * sc;
    v[2] = __uint_as_float(acc.y << 16) + o[2] * sc; v[3] = __uint_as_float(acc.y & 0xFFFF0000u) + o[3] * sc;
    acc = pack4(v);
}
__device__ __forceinline__ float nsa_gate(const bf16_t* __restrict__ pb, int q, int br, int head) { return sigmoidf_(bf2f(pb[(size_t)q * PP + GA + br * 8 + head])); }

__device__ __forceinline__ void nsa_unit(int u, const bf16_t* __restrict__ proj, const char* __restrict__ ws, const float* __restrict__ rel_bias, bf16_t* __restrict__ ya, char* smem) {
    int tid_ = threadIdx.x; asm volatile("" : "+v"(tid_));
    const int tid = tid_, lane = tid & 63, wid = tid >> 6, fr = lane & 15, fq = lane >> 4, hp = fr & 3;
    const int bg = u & 7, qt = 127 - (u >> 3), b = bg >> 1, g = bg & 1, t0 = qt * 32, tb = t0 >> 6;
    const bf16_t* kcb = (const bf16_t*)(ws + OFF_KCB) + (size_t)bg * 256 * 64;
    const bf16_t* vcbT = (const bf16_t*)(ws + OFF_VCBT) + (size_t)bg * 64 * 256;
    const bf16_t* VsT = (const bf16_t*)(ws + OFF_VST) + (size_t)bg * 64 * S;
    const bf16_t* VwT = (const bf16_t*)(ws + OFF_VWT) + (size_t)bg * 64 * S;
    const bf16_t* pb = proj + (size_t)b * S * PP;
    __syncthreads();
    {
        float* tbl = (float*)(smem + NSA_TB);
        for (int e = tid; e < 512; e += 256) { const int h4 = e >> 7, n = e & 127; tbl[e] = rel_bias[t5_bucket2(n) * 8 + g * 4 + h4] * LOG2E; }
        float* imp = (float*)(smem + NSA_IMPA);
        for (int e = tid; e < 2 * 32 * 66; e += 256) if (e < 4224) imp[e] = 0.f;
    }
    int qidx[2]; bf16x8 qf[2][2];
    const int head = g * 4 + hp;
#pragma unroll
    for (int ct = 0; ct < 2; ++ct) {
        qidx[ct] = t0 + wid * 8 + ct * 4 + (fr >> 2);
        const bf16_t* qr = pb + (size_t)qidx[ct] * PP;
        qf[ct][0] = *(const bf16x8*)(qr + QA + head * 64 + fq * 8);
        qf[ct][1] = *(const bf16x8*)(qr + QA + head * 64 + 32 + fq * 8);
    }
    uint2 osum[4][2];
#pragma unroll
    for (int dt = 0; dt < 4; ++dt)
#pragma unroll
        for (int ct = 0; ct < 2; ++ct) osum[dt][ct] = make_uint2(0u, 0u);
    unsigned long long selq[2] = {0ull, 0ull};
    float invl0[2] = {0.f, 0.f};
    const int ntc = ((t0 >> 4) + 1 + 63) >> 6;
    float mC[2], invC[2];
    {
        f32x4 O[4][2]; float m[2] = {-1e30f, -1e30f}, l[2] = {0.f, 0.f};
#pragma unroll
        for (int dt = 0; dt < 4; ++dt)
#pragma unroll
            for (int ct = 0; ct < 2; ++ct) O[dt][ct] = (f32x4){0.f, 0.f, 0.f, 0.f};
        nsa_branch<0>(kcb, 64, vcbT, 256, 0, ntc, t0, qf, qidx, selq, 0ull, 0ull, O, m, l, invl0, smem);
#pragma unroll
        for (int ct = 0; ct < 2; ++ct) {
            float lt = l[ct]; lt += __shfl_xor(lt, 16); lt += __shfl_xor(lt, 32);
            invC[ct] = lt > 0.f ? 1.f / lt : 0.f; mC[ct] = m[ct];
#pragma unroll
            for (int dt = 0; dt < 4; ++dt) osum_add(osum[dt][ct], O[dt][ct], nsa_gate(pb, qidx[ct], 0, head) * invC[ct]);
        }
        nsa_branch<3>(kcb, 64, vcbT, 256, 0, ntc, t0, qf, qidx, selq, 0ull, 0ull, O, mC, l, invC, smem);
    }
    {
        const float* impA = (const float*)(smem + NSA_IMPA); const float* impB = (const float*)(smem + NSA_IMPB);
        unsigned long long* selm = (unsigned long long*)(smem + NSA_SELM);
#pragma unroll 1
        for (int qq = 0; qq < 8; ++qq) {
            const int ql = wid * 8 + qq;
            const float val = impA[ql * 65 + lane] + impB[ql * 65 + lane];
            const bool forced = (lane == 0) || (lane == tb) || (lane == tb - 1);
            unsigned key = forced ? 0xFFFFFFC0u : (lane > tb ? 0u : (__float_as_uint(val) & 0xFFFFFFC0u));
            key |= (unsigned)(63 - lane);
            int rank = 0;
#pragma unroll
            for (int jp = 0; jp < 64; ++jp) rank += ((unsigned)__builtin_amdgcn_readlane((int)key, jp) > key) ? 1 : 0;
            const unsigned long long msk = __ballot(rank < 16);
            if (lane == 0) selm[ql] = msk;
        }
        wave_lds_sync();
        unsigned long long so0 = 0ull, so1 = 0ull;
#pragma unroll
        for (int qq = 0; qq < 4; ++qq) { so0 |= selm[wid * 8 + qq]; so1 |= selm[wid * 8 + 4 + qq]; }
        const unsigned long long selor0 = ((unsigned long long)(unsigned)__builtin_amdgcn_readfirstlane((int)(unsigned)(so0 >> 32)) << 32) | (unsigned)__builtin_amdgcn_readfirstlane((int)(unsigned)so0);
        const unsigned long long selor1 = ((unsigned long long)(unsigned)__builtin_amdgcn_readfirstlane((int)(unsigned)(so1 >> 32)) << 32) | (unsigned)__builtin_amdgcn_readfirstlane((int)(unsigned)so1);
        selq[0] = selm[wid * 8 + (fr >> 2)]; selq[1] = selm[wid * 8 + 4 + (fr >> 2)];
        {
            f32x4 O[4][2]; float m[2] = {-1e30f, -1e30f}, l[2] = {0.f, 0.f};
#pragma unroll
            for (int dt = 0; dt < 4; ++dt)
#pragma unroll
                for (int ct = 0; ct < 2; ++ct) O[dt][ct] = (f32x4){0.f, 0.f, 0.f, 0.f};
            nsa_branch<1>(pb + KS + g * 64, PP, VsT, S, 0, tb + 1, t0, qf, qidx, selq, selor0, selor1, O, m, l, invl0, smem);
#pragma unroll
            for (int ct = 0; ct < 2; ++ct) {
                float lt = l[ct]; lt += __shfl_xor(lt, 16); lt += __shfl_xor(lt, 32);
                const float inv = lt > 0.f ? 1.f / lt : 0.f;
#pragma unroll
                for (int dt = 0; dt < 4; ++dt) osum_add(osum[dt][ct], O[dt][ct], nsa_gate(pb, qidx[ct], 1, head) * inv);
            }
        }
    }
    {
        f32x4 O[4][2]; float m[2] = {-1e30f, -1e30f}, l[2] = {0.f, 0.f};
#pragma unroll
        for (int dt = 0; dt < 4; ++dt)
#pragma unroll
            for (int ct = 0; ct < 2; ++ct) O[dt][ct] = (f32x4){0.f, 0.f, 0.f, 0.f};
        const int jw0 = (t0 - 511 < 0 ? 0 : t0 - 511) >> 6;
        nsa_branch<2>(pb + (size_t)jw0 * 64 * PP + KW + g * 64, PP, VwT + jw0 * 64, S, jw0, tb - jw0 + 1, t0, qf, qidx, selq, 0ull, 0ull, O, m, l, invl0, smem);
#pragma unroll
        for (int ct = 0; ct < 2; ++ct) {
            float lt = l[ct]; lt += __shfl_xor(lt, 16); lt += __shfl_xor(lt, 32);
            const float inv = lt > 0.f ? 1.f / lt : 0.f;
#pragma unroll
            for (int dt = 0; dt < 4; ++dt) osum_add(osum[dt][ct], O[dt][ct], nsa_gate(pb, qidx[ct], 2, head) * inv);
        }
    }
#pragma unroll
    for (int ct = 0; ct < 2; ++ct) {
        bf16_t* yr = ya + (size_t)(b * S + qidx[ct]) * 512 + head * 64 + 4 * fq;
#pragma unroll
        for (int dt = 0; dt < 4; ++dt) *(uint2*)(yr + dt * 16) = osum[dt][ct];
    }
}

__device__ __forceinline__ void vtrans_tile(int task, const bf16_t* __restrict__ proj, char* ws, char* smem) {
    unsigned short (*tl)[66] = (unsigned short (*)[66])smem;
    const int tid = threadIdx.x, which = task >> 9, bg = (task >> 6) & 7, tt = task & 63, b = bg >> 1, g = bg & 1;
    const int r = tid >> 2, q4 = tid & 3;
    const bf16_t* src = proj + (size_t)(b * S + tt * 64 + r) * PP + (which ? VW : VS) + g * 64 + q4 * 16;
    const uint4 a0 = *(const uint4*)src, a1 = *(const uint4*)(src + 8);
    unsigned* trow = (unsigned*)&tl[r][q4 * 16];
    trow[0] = a0.x; trow[1] = a0.y; trow[2] = a0.z; trow[3] = a0.w; trow[4] = a1.x; trow[5] = a1.y; trow[6] = a1.z; trow[7] = a1.w;
    __syncthreads();
    bf16_t* dst = (bf16_t*)(ws + (which ? OFF_VWT : OFF_VST)) + ((size_t)bg * 64 + r) * S + tt * 64 + q4 * 16;
    unsigned o[8];
#pragma unroll
    for (int k = 0; k < 8; ++k) o[k] = (unsigned)tl[q4 * 16 + 2 * k][r] | ((unsigned)tl[q4 * 16 + 2 * k + 1][r] << 16);
    *(uint4*)dst = make_uint4(o[0], o[1], o[2], o[3]);
    *(uint4*)(dst + 8) = make_uint4(o[4], o[5], o[6], o[7]);
    __syncthreads();
}

__device__ __forceinline__ int tile_el(int row, int col) { return tile_off(row, col >> 3) + ((col & 7) << 1); }

__device__ __forceinline__ void gla_stage_vt(const bf16_t* __restrict__ proj, size_t row0, int h, char* vt_base) {
    const int tid = threadIdx.x, c = tid >> 2, vq = tid & 3;
    const bf16_t* src = proj + (row0 + c) * PP + VB + h * 128 + vq * 32;
#pragma unroll
    for (int k = 0; k < 4; ++k) {
        const u32x4 a = *(const u32x4*)(src + k * 8);
#pragma unroll
        for (int e = 0; e < 4; ++e) {
            const int v = vq * 32 + k * 8 + 2 * e;
            *(unsigned short*)(vt_base + tile_el(v, c)) = (unsigned short)(a[e] & 0xFFFFu);
            *(unsigned short*)(vt_base + tile_el(v + 1, c)) = (unsigned short)(a[e] >> 16);
        }
    }
}

__device__ __forceinline__ void gla_a_unit(int vb, const bf16_t* __restrict__ proj, const float* __restrict__ w_alpha, const float* __restrict__ b_alpha,
                                           float* __restrict__ bc, float* __restrict__ cstate, char* smem) {
    float (*bcS)[64] = (float (*)[64])smem;
    float (*tot)[64] = (float (*)[64])(smem + 16384);
    char* KDT = smem + 17408;
    char* VT = smem + 17408 + 8192;
    const int tid = threadIdx.x, lane = tid & 63, wid = tid >> 6, fr = lane & 15, fq = lane >> 4;
    const int n = vb & 63, h = (vb >> 6) & 3, b = vb >> 8;
    const size_t row0 = (size_t)(b * S + n * 64);
    __syncthreads();
    {
        const int d = tid & 63, cq = tid >> 6, col = h * 64 + d;
        float w[16];
#pragma unroll
        for (int r = 0; r < 16; ++r) w[r] = w_alpha[r * 256 + col];
        const float bias = b_alpha[col];
        float cum = 0.f;
        for (int i = 0; i < 16; ++i) {
            const int c = cq * 16 + i;
            const u32x4 a0 = *(const u32x4*)(proj + (row0 + c) * PP + AB), a1 = *(const u32x4*)(proj + (row0 + c) * PP + AB + 8);
            float z = bias;
#pragma unroll
            for (int e = 0; e < 4; ++e) {
                z += __uint_as_float(a0[e] << 16) * w[2 * e] + __uint_as_float(a0[e] & 0xFFFF0000u) * w[2 * e + 1];
                z += __uint_as_float(a1[e] << 16) * w[8 + 2 * e] + __uint_as_float(a1[e] & 0xFFFF0000u) * w[8 + 2 * e + 1];
            }
            const float ls = fminf(z, 0.f) - log1pf(__expf(-fabsf(z)));
            cum += ls * (1.0f / 16.0f);
            bcS[c][d] = cum;
        }
        tot[cq][d] = cum;
        __syncthreads();
        float pre = 0.f;
        for (int q = 0; q < cq; ++q) pre += tot[q][d];
        for (int i = 0; i < 16; ++i) {
            const int c = cq * 16 + i;
            const float v = bcS[c][d] + pre;
            bcS[c][d] = v;
            bc[(row0 + c) * 256 + col] = v;
        }
    }
    __syncthreads();
    {
        const int c = tid >> 2, dq = tid & 3;
        const bf16_t* src = proj + (row0 + c) * PP + KB + h * 64 + dq * 16;
#pragma unroll
        for (int k = 0; k < 2; ++k) {
            const u32x4 a = *(const u32x4*)(src + k * 8);
#pragma unroll
            for (int e = 0; e < 4; ++e) {
                const int d = dq * 16 + k * 8 + 2 * e;
                const float k0 = __uint_as_float(a[e] << 16) * __expf(bcS[63][d] - bcS[c][d]);
                const float k1 = __uint_as_float(a[e] & 0xFFFF0000u) * __expf(bcS[63][d + 1] - bcS[c][d + 1]);
                *(unsigned short*)(KDT + tile_el(d, c)) = f2bf(k0);
                *(unsigned short*)(KDT + tile_el(d + 1, c)) = f2bf(k1);
            }
        }
    }
    gla_stage_vt(proj, row0, h, VT);
    __syncthreads();
    float* outp = cstate + (size_t)vb * 8192;
#pragma unroll
    for (int vi = 0; vi < 2; ++vi) {
        const int vt = wid * 2 + vi;
        const bf16x8 a0 = *(const bf16x8*)(VT + tile_off(vt * 16 + fr, fq)), a1 = *(const bf16x8*)(VT + tile_off(vt * 16 + fr, 4 + fq));
#pragma unroll
        for (int dt = 0; dt < 4; ++dt) {
            const bf16x8 b0 = *(const bf16x8*)(KDT + tile_off(dt * 16 + fr, fq)), b1 = *(const bf16x8*)(KDT + tile_off(dt * 16 + fr, 4 + fq));
            f32x4 acc = (f32x4){0.f, 0.f, 0.f, 0.f};
            acc = __builtin_amdgcn_mfma_f32_16x16x32_bf16(a0, b0, acc, 0, 0, 0);
            acc = __builtin_amdgcn_mfma_f32_16x16x32_bf16(a1, b1, acc, 0, 0, 0);
#pragma unroll
            for (int i = 0; i < 4; ++i) outp[(vt * 16 + 4 * fq + i) * 64 + dt * 16 + fr] = acc[i];
        }
    }
}

__device__ __forceinline__ void gla_scan_vb2(int vb, const float* __restrict__ bc, float* __restrict__ cstate) {
    const int idx = vb * 256 + threadIdx.x;
    const int e = idx & 8191, bh = idx >> 13, b = bh >> 2, h = bh & 3, d = e & 63;
    float state = 0.f;
    float* base = cstate + (size_t)bh * 64 * 8192 + e;
    const float* bcp = bc + ((size_t)(b * S + 63)) * 256 + h * 64 + d;
#pragma unroll 1
    for (int n0 = 0; n0 < 64; n0 += 16) {
        float upd[16], dec[16];
#pragma unroll
        for (int i = 0; i < 16; ++i) { upd[i] = base[(size_t)(n0 + i) * 8192]; dec[i] = bcp[(size_t)(n0 + i) * 64 * 256]; }
#pragma unroll
        for (int i = 0; i < 16; ++i) { base[(size_t)(n0 + i) * 8192] = state; state = __expf(dec[i]) * state + upd[i]; }
    }
}

__device__ __forceinline__ void gla_c_unit(int vb, const bf16_t* __restrict__ proj, const float* __restrict__ bc, const float* __restrict__ prev,
                                           const float* __restrict__ norm_g, bf16_t* __restrict__ yb, char* smem) {
    char* QI = smem;
    char* KI = smem + 8192;
    char* VT = smem + 16384;
    char* PT = smem + 32768;
    const int tid = threadIdx.x, lane = tid & 63, wid = tid >> 6, fr = lane & 15, fq = lane >> 4;
    const int n = vb & 63, h = (vb >> 6) & 3, b = vb >> 8;
    const size_t row0 = (size_t)(b * S + n * 64);
    __syncthreads();
    {
        const int c = tid >> 2, dq = tid & 3;
        const bf16_t* qs = proj + (row0 + c) * PP + QB + h * 64 + dq * 16;
        const bf16_t* ks = proj + (row0 + c) * PP + KB + h * 64 + dq * 16;
        const float* bs = bc + (row0 + c) * 256 + h * 64 + dq * 16;
#pragma unroll
        for (int k = 0; k < 2; ++k) {
            const u32x4 qa = *(const u32x4*)(qs + k * 8), ka = *(const u32x4*)(ks + k * 8);
            const f32x4 b0 = *(const f32x4*)(bs + k * 8), b1 = *(const f32x4*)(bs + k * 8 + 4);
            const float bv[8] = {b0[0], b0[1], b0[2], b0[3], b1[0], b1[1], b1[2], b1[3]};
            u32x4 qo, ko;
#pragma unroll
            for (int e = 0; e < 4; ++e) {
                const float e0 = __expf(bv[2 * e]), e1 = __expf(bv[2 * e + 1]);
                qo[e] = pack_bf16(__uint_as_float(qa[e] << 16) * 0.125f * e0, __uint_as_float(qa[e] & 0xFFFF0000u) * 0.125f * e1);
                ko[e] = pack_bf16(__uint_as_float(ka[e] << 16) / e0, __uint_as_float(ka[e] & 0xFFFF0000u) / e1);
            }
            *(u32x4*)(QI + tile_off(c, dq * 2 + k)) = qo;
            *(u32x4*)(KI + tile_off(c, dq * 2 + k)) = ko;
        }
    }
    gla_stage_vt(proj, row0, h, VT);
    {
        const int v = tid >> 1, half = tid & 1;
        const float* ps = prev + (size_t)vb * 8192 + v * 64 + half * 32;
#pragma unroll
        for (int k = 0; k < 4; ++k) {
            const f32x4 a = *(const f32x4*)(ps + k * 8), c2 = *(const f32x4*)(ps + k * 8 + 4);
            u32x4 o; o[0] = pack_bf16(a[0], a[1]); o[1] = pack_bf16(a[2], a[3]); o[2] = pack_bf16(c2[0], c2[1]); o[3] = pack_bf16(c2[2], c2[3]);
            *(u32x4*)(PT + tile_off(v, half * 4 + k)) = o;
        }
    }
    __syncthreads();
    const bf16x8 qf0 = *(const bf16x8*)(QI + tile_off(wid * 16 + fr, fq)), qf1 = *(const bf16x8*)(QI + tile_off(wid * 16 + fr, 4 + fq));
    bf16x8 pf[2];
    const int c = wid * 16 + fr;
#pragma unroll
    for (int p = 0; p < 2; ++p) {
        u32x4 w;
#pragma unroll
        for (int s = 0; s < 2; ++s) {
            const int row = 32 * p + 8 * (fr >> 2) + 4 * s + (fr & 3);
            const bf16x8 k0 = *(const bf16x8*)(KI + tile_off(row, fq)), k1 = *(const bf16x8*)(KI + tile_off(row, 4 + fq));
            f32x4 a = (f32x4){0.f, 0.f, 0.f, 0.f};
            a = __builtin_amdgcn_mfma_f32_16x16x32_bf16(k0, qf0, a, 0, 0, 0);
            a = __builtin_amdgcn_mfma_f32_16x16x32_bf16(k1, qf1, a, 0, 0, 0);
#pragma unroll
            for (int i = 0; i < 4; ++i) { const int j = 32 * p + 8 * fq + 4 * s + i; if (j > c) a[i] = 0.f; }
            w[2 * s] = pack_bf16(a[0], a[1]); w[2 * s + 1] = pack_bf16(a[2], a[3]);
        }
        pf[p] = __builtin_bit_cast(bf16x8, w);
    }
    f32x4 acc[8];
    float ss = 0.f;
#pragma unroll
    for (int vt = 0; vt < 8; ++vt) {
        f32x4 a = (f32x4){0.f, 0.f, 0.f, 0.f};
        a = __builtin_amdgcn_mfma_f32_16x16x32_bf16(*(const bf16x8*)(VT + tile_off(vt * 16 + fr, fq)), pf[0], a, 0, 0, 0);
        a = __builtin_amdgcn_mfma_f32_16x16x32_bf16(*(const bf16x8*)(VT + tile_off(vt * 16 + fr, 4 + fq)), pf[1], a, 0, 0, 0);
        a = __builtin_amdgcn_mfma_f32_16x16x32_bf16(*(const bf16x8*)(PT + tile_off(vt * 16 + fr, fq)), qf0, a, 0, 0, 0);
        a = __builtin_amdgcn_mfma_f32_16x16x32_bf16(*(const bf16x8*)(PT + tile_off(vt * 16 + fr, 4 + fq)), qf1, a, 0, 0, 0);
        acc[vt] = a;
        ss += a[0] * a[0] + a[1] * a[1] + a[2] * a[2] + a[3] * a[3];
    }
    ss += __shfl_xor(ss, 16); ss += __shfl_xor(ss, 32);
    const float r = rsqrtf(ss * (1.0f / 128.0f) + 1e-6f);
    const size_t row = row0 + c;
#pragma unroll
    for (int vt = 0; vt < 8; ++vt) {
        const int col = h * 128 + vt * 16 + 4 * fq;
        const uint2 rr = *(const uint2*)(proj + row * PP + RB + col);
        const f32x4 g4 = *(const f32x4*)(norm_g + col);
        const float r0 = __uint_as_float(rr.x << 16), r1 = __uint_as_float(rr.x & 0xFFFF0000u), r2 = __uint_as_float(rr.y << 16), r3 = __uint_as_float(rr.y & 0xFFFF0000u);
        f32x4 o;
        o[0] = acc[vt][0] * r * g4[0] * (r0 * sigmoidf_(r0)); o[1] = acc[vt][1] * r * g4[1] * (r1 * sigmoidf_(r1));
        o[2] = acc[vt][2] * r * g4[2] * (r2 * sigmoidf_(r2)); o[3] = acc[vt][3] * r * g4[3] * (r3 * sigmoidf_(r3));
        *(uint2*)(yb + row * 512 + col) = pack4(o);
    }
}

constexpr int SMEM_BYTES = 65536;

__global__ void __launch_bounds__(256, 2) k_fwd(Params p) {
    extern __shared__ __attribute__((aligned(16))) char smem_dyn[];
    char* smem = smem_dyn + 16;
    if (threadIdx.x == 0) *(uint4*)smem_dyn = make_uint4(0u, 0u, 0u, 0u);
    __syncthreads();
    char* ws = p.ws;
    XcdBarrier bar = xcd_barrier_post((unsigned*)(ws + OFF_BAR), (volatile LAS unsigned*)smem_dyn);
    int* ctrl = (int*)(ws + OFF_CTRL);
    bf16_t* proj = (bf16_t*)(ws + OFF_PROJ);
    float* bc = (float*)(ws + OFF_BC);
    float* cstate = (float*)(ws + OFF_CSTATE);
    bf16_t* mrg = (bf16_t*)(ws + OFF_MRG);
    bf16_t* h2 = (bf16_t*)(ws + OFF_H2);
    bf16_t* hid = (bf16_t*)(ws + OFF_HID);
    bf16_t* Y0 = (bf16_t*)(ws + OFF_Y0);
    bf16_t* Y1 = (bf16_t*)(ws + OFF_Y1);
    bf16_t* ya = (bf16_t*)(ws + OFF_YA);
    bf16_t* yb = (bf16_t*)(ws + OFF_YB);
    bf16_t* kcb = (bf16_t*)(ws + OFF_KCB);
    bf16_t* vcb = (bf16_t*)(ws + OFF_VCB);
    bf16_t* h = (bf16_t*)p.out;
    const int wid = threadIdx.x >> 6, lane = threadIdx.x & 63;
    const int G = gridDim.x;

    ph_prep(p, smem);
    xcd_barrier(bar);
    ph_proj(h, (const bf16_t*)(ws + OFF_WINT), proj, smem);
    xcd_barrier(bar);
    ph_cmp1(proj, ws, smem);
    for (int task = blockIdx.x; task < 1024; task += G) vtrans_tile(task, proj, ws, smem);
    for (int vb = blockIdx.x; vb < 1024; vb += G) gla_a_unit(vb, proj, p.w_alpha, p.b_alpha, bc, cstate, smem);
    xcd_barrier(bar);
    ph_cmp2(ws, ws, smem);
    for (int vb = blockIdx.x; vb < 512; vb += G) gla_scan_vb2(vb, bc, cstate);
    xcd_barrier(bar);
    for (int vb = blockIdx.x; vb < 1024; vb += G) gla_c_unit(vb, proj, bc, cstate, p.norm_g, yb, smem);
    for (int r = 0; r * G < 1024; ++r) {
        const int u = r * G + ((r & 1) ? (G - 1 - (int)blockIdx.x) : (int)blockIdx.x);
        if (u < 1024) nsa_unit(u, proj, ws, p.rel_bias, ya, smem);
    }
    xcd_barrier(bar);
    ph_merge(h, (const bf16_t*)(ws + OFF_WINT), ya, yb, (const bf16_t*)(ws + OFF_WAT), (const bf16_t*)(ws + OFF_WBT), mrg, smem);
    xcd_barrier(bar);
    ph_outproj(mrg, (const bf16_t*)(ws + OFF_WOT), p.x, p.out, smem);
    xcd_barrier(bar);
    for (int task = blockIdx.x * 4 + wid; task < 1024; task += G * 4) router_task(task, p.out, p.g_ffn, (const bf16_t*)(ws + OFF_WRT), p.b_rg, p.b_re, h2, (float*)(ws + OFF_RSTD), (int*)(ws + OFF_LTOK), (float*)(ws + OFF_LW), ctrl, smem + wid * 4096, lane);
    xcd_barrier(bar);
    ph_moe1(h2, (const bf16_t*)(ws + OFF_WGT), (const bf16_t*)(ws + OFF_WUT), ctrl, (const int*)(ws + OFF_LTOK), (const float*)(ws + OFF_LW), (const float*)(ws + OFF_RSTD), hid, smem);
    xcd_barrier(bar);
    ph_moe2(hid, (const bf16_t*)(ws + OFF_WDT), ctrl, (const int*)(ws + OFF_LTOK), Y0, smem);
    xcd_barrier(bar);
    for (int row = blockIdx.x * 4 + wid; row < T; row += G * 4) final_row(row, p.out, Y0, Y1, p.g_final, lane);
}

extern "C" void kernel_launch(void* const* d_in, const int* in_sizes, int n_in, void* d_out, int out_size, void* d_ws, size_t ws_size, hipStream_t stream) {
    static int grid = 0;
    constexpr int kDynLds = SMEM_BYTES + 16;
    if (!grid) {
        int dev = 0, cus = 0, per_cu = 0;
        (void)hipGetDevice(&dev);
        (void)hipDeviceGetAttribute(&cus, hipDeviceAttributeMultiprocessorCount, dev);
        (void)hipFuncSetAttribute((const void*)k_fwd, hipFuncAttributeMaxDynamicSharedMemorySize, kDynLds);
        (void)hipOccupancyMaxActiveBlocksPerMultiprocessor(&per_cu, k_fwd, 256, kDynLds);
        if (per_cu > 2) per_cu = 2;
        if (per_cu < 1) per_cu = 1;
        grid = cus * per_cu;
    }
    char* ws = (char*)d_ws;
    (void)hipMemsetAsync(ws + OFF_CTRL, 0, 4096, stream);
    (void)hipMemsetAsync(ws + OFF_BAR, 0, 16384, stream);
    Params p{};
    const float** pf = (const float**)&p;
    for (int i = 0; i < 25; ++i) pf[i] = (const float*)d_in[i];
    p.out = (float*)d_out; p.ws = ws;
    k_fwd<<<grid, 256, kDynLds, stream>>>(p);
}
```

```cpp
#include <hip/hip_runtime.h>
#include <stdint.h>

typedef unsigned short bf16_t;
typedef short bf16x8 __attribute__((ext_vector_type(8)));
typedef float f32x4 __attribute__((ext_vector_type(4)));
typedef unsigned u32x4 __attribute__((ext_vector_type(4)));
__device__ __forceinline__ float bf2f(bf16_t v) { return __uint_as_float(((unsigned)v) << 16); }
__device__ __forceinline__ bf16_t f2bf(float f) { unsigned u = __float_as_uint(f); u += 0x7FFFu + ((u >> 16) & 1u); return (bf16_t)(u >> 16); }
__device__ __forceinline__ unsigned pack_bf16(float lo, float hi) { unsigned r; asm volatile("v_cvt_pk_bf16_f32 %0, %1, %2" : "=v"(r) : "v"(lo), "v"(hi)); return r; }

constexpr int Bn = 4, S = 4096, T = Bn * S, D = 1024, NIN = 4904, PP = 2880;
constexpr int QA = 0, KC = 512, VC = 640, KS = 768, VS = 896, KW = 1024, VW = 1152, GA = 1280, QB = 1304, KB = 1560, VB = 1816, AB = 2328, RB = 2344, MGA = 2856, MGB = 3880;
constexpr int NPROJ = 2856;
constexpr int MSLOT = 36864;

constexpr size_t OFF_CTRL = 0;
constexpr size_t OFF_ROUTE_E = 16384;
constexpr size_t OFF_ROUTE_W = OFF_ROUTE_E + 32768 * 4;
constexpr size_t OFF_SLOT_TOK = OFF_ROUTE_W + 32768 * 4;
constexpr size_t OFF_SLOT_W = OFF_SLOT_TOK + (size_t)MSLOT * 4;
constexpr size_t OFF_BAR = OFF_SLOT_W + (size_t)MSLOT * 4;
constexpr size_t OFF_BIAS1 = OFF_BAR + 16384;
constexpr size_t OFF_RSTD = OFF_BIAS1 + 1024;
constexpr size_t OFF_SLOT_RS = OFF_RSTD + (size_t)T * 4;
constexpr size_t OFF_WRT = OFF_SLOT_RS + (size_t)MSLOT * 4;
static_assert(OFF_WRT + 2 * 48 * 1024 * 2 <= (1u << 20), "ctrl overflow");
constexpr size_t OFF_R1 = 1u << 20;
constexpr size_t SZ_PROJ = (size_t)T * PP * 2;
constexpr size_t OFF_PROJ = OFF_R1;
constexpr size_t OFF_BC = OFF_PROJ + SZ_PROJ;
constexpr size_t OFF_CSTATE = OFF_BC + (size_t)T * 256 * 4;
constexpr size_t OFF_R1_END = OFF_CSTATE + (size_t)1024 * 8192 * 4;
constexpr size_t OFF_MRG = OFF_R1 + (size_t)T * 2048 * 2;
constexpr size_t OFF_H2 = OFF_R1;
constexpr size_t OFF_HID = OFF_H2 + (size_t)T * 1024 * 2;
constexpr size_t OFF_Y0 = OFF_HID + (size_t)2 * T * 256 * 2;
constexpr size_t OFF_Y1 = OFF_Y0 + (size_t)T * 1024 * 2;
static_assert(OFF_MRG + (size_t)T * 1024 * 2 <= OFF_R1_END, "alias overflow");
static_assert(OFF_Y1 + (size_t)T * 1024 * 2 <= OFF_R1_END, "alias overflow");
constexpr size_t OFF_YA = OFF_R1_END;
constexpr size_t OFF_YB = OFF_YA + (size_t)T * 512 * 2;
constexpr size_t OFF_KCB = OFF_YB + (size_t)T * 512 * 2;
constexpr size_t OFF_VCB = OFF_KCB + 8 * 256 * 64 * 2;
constexpr size_t OFF_VCBT = OFF_VCB + 8 * 256 * 64 * 2;
constexpr size_t OFF_HIDC = OFF_VCBT + 8 * 256 * 64 * 2;
constexpr size_t OFF_VST = OFF_HIDC + 2 * 2048 * 128 * 2;
constexpr size_t OFF_VWT = OFF_VST + (size_t)8 * 64 * S * 2;
constexpr size_t OFF_WINT = OFF_VWT + (size_t)8 * 64 * S * 2;
constexpr size_t OFF_CK1T = OFF_WINT + (size_t)NIN * 1024 * 2;
constexpr size_t OFF_CV1T = OFF_CK1T + 128 * 2048 * 2;
constexpr size_t OFF_CK2T = OFF_CV1T + 128 * 2048 * 2;
constexpr size_t OFF_CV2T = OFF_CK2T + 128 * 128 * 2;
constexpr size_t OFF_WAT = OFF_CV2T + 128 * 128 * 2;
constexpr size_t OFF_WBT = OFF_WAT + 1024 * 512 * 2;
constexpr size_t OFF_WOT = OFF_WBT + 1024 * 512 * 2;
constexpr size_t OFF_WGT = OFF_WOT + 1024 * 1024 * 2;
constexpr size_t OFF_WUT = OFF_WGT + (size_t)32 * 256 * 1024 * 2;
constexpr size_t OFF_WDT = OFF_WUT + (size_t)32 * 256 * 1024 * 2;
constexpr size_t OFF_LTOK = OFF_WDT + (size_t)32 * 1024 * 256 * 2;
constexpr size_t OFF_LW = OFF_LTOK + (size_t)32 * 16384 * 4;
constexpr size_t OFF_END = OFF_LW + (size_t)32 * 16384 * 4;
static_assert(OFF_END <= (size_t)256 << 20, "workspace overflow");

#define XB_TMO      128
#define XB_XCNT(j)  (256  + 64 * (j))
#define XB_XSUB(j)  (1280 + 64 * (j))
#define XB_XGEN(j)  (2304 + 64 * (j))
#define XB_TOP      3328
#define XB_TOPGEN   3392
#define XCD_BAR_WORDS 3456
#define XB_SPIN_CAP (1u << 18)
#define LAS __attribute__((address_space(3)))

__device__ __forceinline__ unsigned xb_ld(unsigned* p)              { return __hip_atomic_load(p, __ATOMIC_RELAXED, __HIP_MEMORY_SCOPE_AGENT); }
__device__ __forceinline__ unsigned xb_add(unsigned* p, unsigned v) { return __hip_atomic_fetch_add(p, v, __ATOMIC_RELAXED, __HIP_MEMORY_SCOPE_AGENT); }
__device__ __forceinline__ unsigned xb_xcc_id() { return (unsigned)__builtin_amdgcn_s_getreg((3 << 11) | 20) & 0xFu; }
#define XB_SPIN(cond, bar) do { unsigned _sp = 0; while (cond) { __builtin_amdgcn_s_sleep(1); \
    if ((++_sp & 255u) == 0u) { if (xb_ld(&(bar)[XB_TMO])) break; if (_sp > XB_SPIN_CAP) { atomicAdd(&(bar)[XB_TMO], 1u); break; } } } } while (0)

struct XcdBarrier { unsigned* bar; unsigned x; volatile LAS unsigned* st; };

__device__ __forceinline__ XcdBarrier xcd_barrier_post(unsigned* bar, volatile LAS unsigned* st) {
    XcdBarrier b; b.bar = bar; b.x = xb_xcc_id(); b.st = st;
    if (threadIdx.x == 0) (void)xb_add(&bar[XB_XCNT(b.x)], 1u);
    return b;
}
__device__ __forceinline__ void xcd_barrier_complete(unsigned* bar, unsigned x, unsigned& nloc, unsigned& nx) {
    const unsigned G = gridDim.x * gridDim.y * gridDim.z;
    unsigned sum, cnt, mine, sp = 0u;
    for (;;) {
        sum = 0u; cnt = 0u; mine = 0u;
#pragma unroll
        for (unsigned j = 0; j < 16; ++j) { const unsigned c = xb_ld(&bar[XB_XCNT(j)]); sum += c; cnt += (c > 0u) ? 1u : 0u; mine = (j == x) ? c : mine; }
        if (sum == G) break;
        __builtin_amdgcn_s_sleep(1);
        if ((++sp & 255u) == 0u) { if (xb_ld(&bar[XB_TMO])) break; if (sp > XB_SPIN_CAP) { atomicAdd(&bar[XB_TMO], 1u); break; } }
    }
    nloc = mine > 0u ? mine : 1u; nx = cnt > 0u ? cnt : 1u;
}
__device__ __forceinline__ void xcd_barrier(const XcdBarrier& b) {
    asm volatile("s_waitcnt vmcnt(0)" ::: "memory");
    __syncthreads();
    if (threadIdx.x == 0) {
        unsigned* bar = b.bar;
        __builtin_amdgcn_s_waitcnt(0);
        unsigned nloc = b.st[0], nx = b.st[1];
        if (nloc == 0u) { xcd_barrier_complete(bar, b.x, nloc, nx); b.st[0] = nloc; b.st[1] = nx; }
        const unsigned old = xb_add(&bar[XB_XSUB(b.x)], 1u);
        const unsigned gen = old / nloc;
        if (old + 1u == (gen + 1u) * nloc) {
            __builtin_amdgcn_fence(__ATOMIC_RELEASE, "agent");
            asm volatile("s_waitcnt vmcnt(0)" ::: "memory");
            const unsigned og = xb_add(&bar[XB_TOP], 1u);
            const unsigned tg = og / nx;
            if (og + 1u == (tg + 1u) * nx) xb_add(&bar[XB_TOPGEN], 1u);
            else XB_SPIN(xb_ld(&bar[XB_TOPGEN]) == tg, bar);
            __builtin_amdgcn_fence(__ATOMIC_ACQUIRE, "agent");
            xb_add(&bar[XB_XGEN(b.x)], 1u);
            asm volatile("s_waitcnt vmcnt(0)" ::: "memory");
        } else {
            XB_SPIN(xb_ld(&bar[XB_XGEN(b.x)]) == gen, bar);
            __builtin_amdgcn_fence(__ATOMIC_ACQUIRE, "agent");
            asm volatile("s_waitcnt vmcnt(0)" ::: "memory");
        }
    }
    __syncthreads();
}


#define HB_TID ((int)(threadIdx.x & 255))
#define HB_ID ((int)(threadIdx.x >> 8))
#define HB_FIRST (2 * (int)blockIdx.x + HB_ID)
#define HB_STEP (2 * (int)gridDim.x)
struct Params {
    const float *x, *g_mix, *w_in, *pe_k, *ck1, *ck2, *pe_v, *cv1, *cv2, *rel_bias, *w_alpha, *b_alpha, *norm_g, *w_ba, *w_bb, *w_out, *g_ffn,
                *w_rg, *b_rg, *w_re, *b_re, *w_eg, *w_eu, *w_ed, *g_final;
    float* out; char* ws;
};

__device__ __forceinline__ float wave_max(float v) { for (int o = 32; o > 0; o >>= 1) v = fmaxf(v, __shfl_xor(v, o)); return v; }
__device__ __forceinline__ float wave_sum(float v) { for (int o = 32; o > 0; o >>= 1) v += __shfl_xor(v, o); return v; }
__device__ __forceinline__ void wave_lds_sync() { asm volatile("s_waitcnt lgkmcnt(0)" ::: "memory"); }


__device__ __forceinline__ void rms_h_row(int row, const float* __restrict__ x, const float* __restrict__ g, bf16_t* __restrict__ h, int lane) {
    const float* xr = x + (size_t)row * D + lane * 4;
    f32x4 v[4]; float s = 0.f;
#pragma unroll
    for (int i = 0; i < 4; ++i) { v[i] = *(const f32x4*)(xr + 256 * i); s += v[i][0] * v[i][0] + v[i][1] * v[i][1] + v[i][2] * v[i][2] + v[i][3] * v[i][3]; }
    s = wave_sum(s);
    const float r = rsqrtf(s * (1.0f / D) + 1e-6f);
#pragma unroll
    for (int i = 0; i < 4; ++i) {
        const f32x4 gg = *(const f32x4*)(g + lane * 4 + 256 * i);
        uint2 o; o.x = pack_bf16(v[i][0] * r * gg[0], v[i][1] * r * gg[1]); o.y = pack_bf16(v[i][2] * r * gg[2], v[i][3] * r * gg[3]);
        *(uint2*)(h + (size_t)row * D + lane * 4 + 256 * i) = o;
    }
}
__device__ __forceinline__ void final_row(int row, float* __restrict__ x2out, const bf16_t* __restrict__ Y0, const bf16_t* __restrict__ Y1, const float* __restrict__ g, int lane) {
    float* xr = x2out + (size_t)row * D + lane * 4;
    f32x4 v[4]; float s = 0.f;
#pragma unroll
    for (int i = 0; i < 4; ++i) {
        v[i] = *(const f32x4*)(xr + 256 * i);
        const uint2 a = *(const uint2*)(Y0 + (size_t)row * D + lane * 4 + 256 * i), c = *(const uint2*)(Y1 + (size_t)row * D + lane * 4 + 256 * i);
        v[i][0] += __uint_as_float(a.x << 16) + __uint_as_float(c.x << 16);
        v[i][1] += __uint_as_float(a.x & 0xFFFF0000u) + __uint_as_float(c.x & 0xFFFF0000u);
        v[i][2] += __uint_as_float(a.y << 16) + __uint_as_float(c.y << 16);
        v[i][3] += __uint_as_float(a.y & 0xFFFF0000u) + __uint_as_float(c.y & 0xFFFF0000u);
        s += v[i][0] * v[i][0] + v[i][1] * v[i][1] + v[i][2] * v[i][2] + v[i][3] * v[i][3];
    }
    s = wave_sum(s);
    const float r = rsqrtf(s * (1.0f / D) + 1e-6f);
#pragma unroll
    for (int i = 0; i < 4; ++i) {
        const f32x4 gg = *(const f32x4*)(g + lane * 4 + 256 * i);
        *(f32x4*)(xr + 256 * i) = (f32x4){v[i][0] * r * gg[0], v[i][1] * r * gg[1], v[i][2] * r * gg[2], v[i][3] * r * gg[3]};
    }
}

__device__ __forceinline__ void prep_router_w(const float* __restrict__ w_rg, const float* __restrict__ w_re, bf16_t* __restrict__ WrT) {
    for (int idx = blockIdx.x * 512 + threadIdx.x; idx < 48 * 1024; idx += gridDim.x * 512) {
        const int n = idx >> 10, k = idx & 1023;
        const float w = n < 4 ? w_rg[k * 4 + n] : (n < 36 ? w_re[k * 32 + n - 4] : 0.f);
        const bf16_t hi = f2bf(w);
        WrT[idx] = hi; WrT[48 * 1024 + idx] = f2bf(w - bf2f(hi));
    }
}

__device__ __forceinline__ void router_unit(int task, const float* __restrict__ x2, const float* __restrict__ g, const bf16_t* __restrict__ WrT,
                                            const float* __restrict__ b_rg, const float* __restrict__ b_re, bf16_t* __restrict__ h2, float* __restrict__ rstd_out,
                                            int* __restrict__ ltok, float* __restrict__ lw, int* __restrict__ cnt, char* smem) {
    float (*part)[16][49] = (float (*)[16][49])smem;
    float (*ssp)[16] = (float (*)[16])(smem + 4 * 16 * 49 * 4);
    const int tid = HB_TID, lane = tid & 63, w4 = tid >> 6, fr = lane & 15, fq = lane >> 4, r0 = task * 16;
    const float* xr = x2 + (size_t)(r0 + fr) * D + fq * 8 + w4 * 256;
    bf16_t* hr = h2 + (size_t)(r0 + fr) * D + fq * 8 + w4 * 256;
    const bf16_t* wh = WrT + (size_t)fr * 1024 + fq * 8 + w4 * 256;
    const float* gp = g + fq * 8 + w4 * 256;
    f32x4 acc[3];
#pragma unroll
    for (int nt = 0; nt < 3; ++nt) acc[nt] = (f32x4){0.f, 0.f, 0.f, 0.f};
    float ssq = 0.f;
#pragma unroll 4
    for (int ks = 0; ks < 8; ++ks) {
        const f32x4 x0 = *(const f32x4*)(xr + ks * 32), x1 = *(const f32x4*)(xr + ks * 32 + 4);
        const f32x4 g0 = *(const f32x4*)(gp + ks * 32), g1 = *(const f32x4*)(gp + ks * 32 + 4);
        float xg[8];
#pragma unroll
        for (int e = 0; e < 4; ++e) { xg[e] = x0[e] * g0[e]; xg[4 + e] = x1[e] * g1[e]; ssq += x0[e] * x0[e] + x1[e] * x1[e]; }
        u32x4 hi, lo;
#pragma unroll
        for (int e = 0; e < 4; ++e) {
            hi[e] = pack_bf16(xg[2 * e], xg[2 * e + 1]);
            lo[e] = pack_bf16(xg[2 * e] - __uint_as_float(hi[e] << 16), xg[2 * e + 1] - __uint_as_float(hi[e] & 0xFFFF0000u));
        }
        *(u32x4*)(hr + ks * 32) = hi;
        const bf16x8 ah = __builtin_bit_cast(bf16x8, hi), al = __builtin_bit_cast(bf16x8, lo);
#pragma unroll
        for (int nt = 0; nt < 3; ++nt) {
            const bf16x8 bh = *(const bf16x8*)(wh + (size_t)nt * 16 * 1024 + ks * 32), bl = *(const bf16x8*)(wh + (size_t)(48 + nt * 16) * 1024 + ks * 32);
            acc[nt] = __builtin_amdgcn_mfma_f32_16x16x32_bf16(ah, bh, acc[nt], 0, 0, 0);
            acc[nt] = __builtin_amdgcn_mfma_f32_16x16x32_bf16(al, bh, acc[nt], 0, 0, 0);
            acc[nt] = __builtin_amdgcn_mfma_f32_16x16x32_bf16(ah, bl, acc[nt], 0, 0, 0);
        }
    }
    ssq += __shfl_xor(ssq, 16); ssq += __shfl_xor(ssq, 32);
    __syncthreads();
    if (fq == 0) ssp[w4][fr] = ssq;
#pragma unroll
    for (int nt = 0; nt < 3; ++nt)
#pragma unroll
        for (int i = 0; i < 4; ++i) part[w4][4 * fq + i][nt * 16 + fr] = acc[nt][i];
    __syncthreads();
    if (tid < 16) {
        const int row = r0 + tid;
        const float rsv = rsqrtf((ssp[0][tid] + ssp[1][tid] + ssp[2][tid] + ssp[3][tid]) * (1.0f / D) + 1e-6f);
        rstd_out[row] = rsv;
        float l4[4];
#pragma unroll
        for (int j = 0; j < 4; ++j) l4[j] = (part[0][tid][j] + part[1][tid][j] + part[2][tid][j] + part[3][tid][j]) * rsv + b_rg[j];
        int gs = 0; float mx = l4[0];
#pragma unroll
        for (int j = 1; j < 4; ++j) if (l4[j] > mx) { mx = l4[j]; gs = j; }
        float den = 0.f;
#pragma unroll
        for (int j = 0; j < 4; ++j) den += __expf(l4[j] - mx);
        const float gpb = 1.f / den;
        float v0 = -3e38f, v1 = -3e38f; int i0 = 0, i1 = 0;
        for (int j = 0; j < 8; ++j) {
            const int c = 4 + gs * 8 + j;
            const float l = (part[0][tid][c] + part[1][tid][c] + part[2][tid][c] + part[3][tid][c]) * rsv + b_re[gs * 8 + j];
            if (l > v0) { v1 = v0; i1 = i0; v0 = l; i0 = j; }
            else if (l > v1) { v1 = l; i1 = j; }
        }
        const float e1 = __expf(v1 - v0);
        const float w0 = gpb / (1.f + e1), w1 = gpb * e1 / (1.f + e1);
        const int ea = gs * 8 + i0, eb = gs * 8 + i1;
        const int pa_ = atomicAdd(&cnt[ea * 64], 1), pb_ = atomicAdd(&cnt[eb * 64], 1);
        ltok[ea * 16384 + pa_] = row * 2; lw[ea * 16384 + pa_] = w0;
        ltok[eb * 16384 + pb_] = row * 2 + 1; lw[eb * 16384 + pb_] = w1;
    }
}

__device__ __forceinline__ void transpose_tile(const float* __restrict__ src, int ld_src, int N, bf16_t* __restrict__ dst, int ld_dst, int kt, int nt, char* smem) {
    float (*tl)[65] = (float (*)[65])smem;
    const int tid = HB_TID;
    const int c4 = (tid & 15) * 4, r0 = tid >> 4;
#pragma unroll
    for (int i = 0; i < 4; ++i) {
        const int k = r0 + 16 * i, n = nt * 64 + c4;
        float4 v = make_float4(0.f, 0.f, 0.f, 0.f);
        if (n < N) v = *(const float4*)(src + (size_t)(kt * 64 + k) * ld_src + n);
        tl[k][c4] = v.x; tl[k][c4 + 1] = v.y; tl[k][c4 + 2] = v.z; tl[k][c4 + 3] = v.w;
    }
    __syncthreads();
    const int kc = (tid & 7) * 8, n0 = tid >> 3;
#pragma unroll
    for (int i = 0; i < 2; ++i) {
        const int nl = n0 + 32 * i, n = nt * 64 + nl;
        if (n < N) {
            uint4 o;
            o.x = pack_bf16(tl[kc][nl], tl[kc + 1][nl]); o.y = pack_bf16(tl[kc + 2][nl], tl[kc + 3][nl]);
            o.z = pack_bf16(tl[kc + 4][nl], tl[kc + 5][nl]); o.w = pack_bf16(tl[kc + 6][nl], tl[kc + 7][nl]);
            *(uint4*)(dst + (size_t)n * ld_dst + kt * 64 + kc) = o;
        }
    }
    __syncthreads();
}

__device__ __forceinline__ void ph_prep_experts(const Params& p, char* smem) {
    char* ws = p.ws;
    for (int t = HB_FIRST; t < 6144; t += HB_STEP) {
        const int e = (t & 2047) >> 6, r = t & 63;
        if (t < 2048) transpose_tile(p.w_eg + (size_t)e * 1024 * 256, 256, 256, (bf16_t*)(ws + OFF_WGT) + (size_t)e * 256 * 1024, 1024, r >> 2, r & 3, smem);
        else if (t < 4096) transpose_tile(p.w_eu + (size_t)e * 1024 * 256, 256, 256, (bf16_t*)(ws + OFF_WUT) + (size_t)e * 256 * 1024, 1024, r >> 2, r & 3, smem);
        else transpose_tile(p.w_ed + (size_t)e * 256 * 1024, 1024, 1024, (bf16_t*)(ws + OFF_WDT) + (size_t)e * 1024 * 256, 256, r >> 4, r & 15, smem);
    }
}
__device__ __forceinline__ void ph_prep(const Params& p, char* smem) {
    char* ws = p.ws;
    constexpr int N0 = 16 * 77, N1 = N0 + 64, N2 = N1 + 64, N3 = N2 + 2, N4 = N3 + 2, N5 = N4 + 128, N6 = N5 + 128, N7 = N6 + 256;
    for (int t = HB_FIRST; t < N7; t += HB_STEP) {
        if (t < N0) transpose_tile(p.w_in, NIN, NIN, (bf16_t*)(ws + OFF_WINT), 1024, t / 77, t % 77, smem);
        else if (t < N1) { const int q = t - N0; transpose_tile(p.ck1, 128, 128, (bf16_t*)(ws + OFF_CK1T), 2048, q >> 1, q & 1, smem); }
        else if (t < N2) { const int q = t - N1; transpose_tile(p.cv1, 128, 128, (bf16_t*)(ws + OFF_CV1T), 2048, q >> 1, q & 1, smem); }
        else if (t < N3) { const int q = t - N2; transpose_tile(p.ck2, 64, 64, (bf16_t*)(ws + OFF_CK2T), 128, q, 0, smem); }
        else if (t < N4) { const int q = t - N3; transpose_tile(p.cv2, 64, 64, (bf16_t*)(ws + OFF_CV2T), 128, q, 0, smem); }
        else if (t < N5) { const int q = t - N4; transpose_tile(p.w_ba, 1024, 1024, (bf16_t*)(ws + OFF_WAT), 512, q >> 4, q & 15, smem); }
        else if (t < N6) { const int q = t - N5; transpose_tile(p.w_bb, 1024, 1024, (bf16_t*)(ws + OFF_WBT), 512, q >> 4, q & 15, smem); }
        else { const int q = t - N6; transpose_tile(p.w_out, 1024, 1024, (bf16_t*)(ws + OFF_WOT), 1024, q >> 4, q & 15, smem); }
    }
    for (int t = HB_FIRST; t < 8; t += HB_STEP) {
        const int which = t >> 2, n = (t & 3) * 32 + (HB_TID & 31), ksp = HB_TID >> 5;
        const float* pe = which ? p.pe_v : p.pe_k; const float* w1 = which ? p.cv1 : p.ck1;
        float a = 0.f;
        for (int k = ksp * 256; k < ksp * 256 + 256; ++k) a += pe[k] * w1[(size_t)k * 128 + n];
        float* red = (float*)smem;
        red[HB_TID] = a;
        __syncthreads();
        if (HB_TID < 32) {
            float s = 0.f;
#pragma unroll
            for (int j = 0; j < 8; ++j) s += red[j * 32 + HB_TID];
            ((float*)(ws + OFF_BIAS1))[which * 128 + n] = s;
        }
        __syncthreads();
    }
    prep_router_w(p.w_rg, p.w_re, (bf16_t*)(ws + OFF_WRT));
    for (int row = blockIdx.x * 8 + (threadIdx.x >> 6); row < T; row += gridDim.x * 8) rms_h_row(row, p.x, p.g_mix, (bf16_t*)p.out, threadIdx.x & 63);
}

__device__ __forceinline__ int tile_off(int row, int chunk) { return row * 128 + ((chunk ^ (row & 7)) << 4); }

__device__ __forceinline__ void glds16(const void* g, char* l) {
    __builtin_amdgcn_global_load_lds((const __attribute__((address_space(1))) unsigned*)g, (__attribute__((address_space(3))) unsigned*)l, 16, 0, 0);
}
__device__ __forceinline__ void gemm_kloop(f32x4 (&acc)[4][4], const bf16_t* const (&pa)[4], const bf16_t* const (&pb)[4], int ka, int kb, int nk, char* smem) {
    int tid_ = HB_TID; asm volatile("" : "+v"(tid_));
    const int tid = tid_, lane = tid & 63, wid = tid >> 6, wr = wid >> 1, wc = wid & 1, fr = lane & 15, fq = lane >> 4;
    const int offA = (wr * 64 + fr) * 128, offB = 16384 + (wc * 64 + fr) * 128, x = fr & 7;
    __syncthreads();
#pragma unroll
    for (int i = 0; i < 4; ++i) { glds16(pa[i], smem + i * 4096 + tid * 16); glds16(pb[i], smem + 16384 + i * 4096 + tid * 16); }
    asm volatile("s_waitcnt vmcnt(0)" ::: "memory");
    __syncthreads();
    for (int kt = 0; kt < nk; ++kt) {
        const int cur = kt & 1;
        if (kt + 1 < nk) {
            char* st = smem + (cur ^ 1) * 32768 + tid * 16;
#pragma unroll
            for (int i = 0; i < 4; ++i) { glds16(pa[i] + (size_t)(kt + 1) * ka, st + i * 4096); glds16(pb[i] + (size_t)(kt + 1) * kb, st + 16384 + i * 4096); }
        }
        const char* sa = smem + cur * 32768 + offA;
        const char* sb = smem + cur * 32768 + offB;
#pragma unroll
        for (int ks = 0; ks < 2; ++ks) {
            const int ch = ((ks * 4 + fq) ^ x) << 4;
            bf16x8 af[4], bfr[4];
#pragma unroll
            for (int mi = 0; mi < 4; ++mi) af[mi] = *(const bf16x8*)(sa + mi * 2048 + ch);
#pragma unroll
            for (int ni = 0; ni < 4; ++ni) bfr[ni] = *(const bf16x8*)(sb + ni * 2048 + ch);
#pragma unroll
            for (int mi = 0; mi < 4; ++mi)
#pragma unroll
                for (int ni = 0; ni < 4; ++ni) acc[mi][ni] = __builtin_amdgcn_mfma_f32_16x16x32_bf16(bfr[ni], af[mi], acc[mi][ni], 0, 0, 0);
        }
        asm volatile("s_waitcnt vmcnt(0)" ::: "memory");
        __syncthreads();
    }
}
__device__ __forceinline__ void acc_zero(f32x4 (&acc)[4][4]) {
#pragma unroll
    for (int mi = 0; mi < 4; ++mi)
#pragma unroll
        for (int ni = 0; ni < 4; ++ni) acc[mi][ni] = (f32x4){0.f, 0.f, 0.f, 0.f};
}
#define GEMM_LANE_VARS const int tid = HB_TID, lane = tid & 63, wid = tid >> 6, wr = wid >> 1, wc = wid & 1, fr = lane & 15, fq = lane >> 4, lrow = tid >> 3, lch8 = ((tid & 7) ^ ((tid >> 3) & 7)) * 8; (void)wr; (void)wc; (void)fr; (void)fq; (void)lrow; (void)lch8;
__device__ __forceinline__ uint2 pack4(f32x4 v) { uint2 o; o.x = pack_bf16(v[0], v[1]); o.y = pack_bf16(v[2], v[3]); return o; }
__device__ __forceinline__ float sigmoidf_(float a) { return 1.f / (1.f + __expf(-a)); }

__device__ __forceinline__ void ph_proj(const bf16_t* __restrict__ h, const bf16_t* __restrict__ WinT, bf16_t* __restrict__ proj, char* smem) {
    GEMM_LANE_VARS
    for (int u = HB_FIRST; u < 128 * 23; u += HB_STEP) {
        const int xg = u & 7, v = u >> 3, tn = v % 23, tm = (v / 23) * 8 + xg;
        const bf16_t* pa[4]; const bf16_t* pb[4];
#pragma unroll
        for (int i = 0; i < 4; ++i) { pa[i] = h + (size_t)(tm * 128 + lrow + 32 * i) * 1024 + lch8; pb[i] = WinT + (size_t)(tn * 128 + lrow + 32 * i) * 1024 + lch8; }
        f32x4 acc[4][4]; acc_zero(acc);
        gemm_kloop(acc, pa, pb, 64, 64, 16, smem);
#pragma unroll
        for (int mi = 0; mi < 4; ++mi)
#pragma unroll
            for (int ni = 0; ni < 4; ++ni) {
                const int m = tm * 128 + wr * 64 + mi * 16 + fr, n = tn * 128 + wc * 64 + ni * 16 + 4 * fq;
                if (n < NPROJ) *(uint2*)(proj + (size_t)m * PP + n) = pack4(acc[mi][ni]);
            }
    }
}

__device__ __forceinline__ void ph_cmp1(const bf16_t* __restrict__ proj, const char* ws, char* smem) {
    GEMM_LANE_VARS
    for (int u = HB_FIRST; u < 32; u += HB_STEP) {
        const int which = u >> 4, tm = u & 15;
        const bf16_t* W1T = (const bf16_t*)(ws + (which ? OFF_CV1T : OFF_CK1T));
        const float* bias1 = (const float*)(ws + OFF_BIAS1) + which * 128;
        bf16_t* hid = (bf16_t*)(ws + OFF_HIDC) + (size_t)which * 2048 * 128;
        const int col0 = which ? VC : KC;
        const bf16_t* pa[4]; const bf16_t* pb[4];
#pragma unroll
        for (int i = 0; i < 4; ++i) {
            const int m = tm * 128 + lrow + 32 * i, bg = m >> 8, c = (m & 255) > 254 ? 254 : (m & 255), b = bg >> 1, g = bg & 1;
            pa[i] = proj + (size_t)(b * S + 16 * c) * PP + col0 + g * 64 + lch8;
            pb[i] = W1T + (size_t)(lrow + 32 * i) * 2048 + lch8;
        }
        f32x4 acc[4][4]; acc_zero(acc);
        gemm_kloop(acc, pa, pb, PP, 64, 32, smem);
#pragma unroll
        for (int mi = 0; mi < 4; ++mi)
#pragma unroll
            for (int ni = 0; ni < 4; ++ni) {
                const int m = tm * 128 + wr * 64 + mi * 16 + fr, n = wc * 64 + ni * 16 + 4 * fq;
                f32x4 v = acc[mi][ni];
#pragma unroll
                for (int j = 0; j < 4; ++j) { const float a = v[j] + bias1[n + j]; const float t = 0.7978845608028654f * (a + 0.044715f * a * a * a); v[j] = 0.5f * a * (1.f + tanhf(t)); }
                *(uint2*)(hid + (size_t)m * 128 + n) = pack4(v);
            }
    }
}

__device__ __forceinline__ void ph_cmp2(const char* ws_c, char* ws, char* smem) {
    GEMM_LANE_VARS
    for (int u = HB_FIRST; u < 32; u += HB_STEP) {
        const int which = u >> 4, tm = u & 15;
        const bf16_t* W2T = (const bf16_t*)(ws_c + (which ? OFF_CV2T : OFF_CK2T));
        const bf16_t* hid = (const bf16_t*)(ws_c + OFF_HIDC) + (size_t)which * 2048 * 128;
        const bf16_t* pa[4]; const bf16_t* pb[4];
#pragma unroll
        for (int i = 0; i < 4; ++i) { pa[i] = hid + (size_t)(tm * 128 + lrow + 32 * i) * 128 + lch8; pb[i] = W2T + (size_t)(lrow + 32 * i) * 128 + lch8; }
        f32x4 acc[4][4]; acc_zero(acc);
        gemm_kloop(acc, pa, pb, 64, 64, 2, smem);
        if (wc == 0) {
            bf16_t* outp = (bf16_t*)(ws + (which ? OFF_VCB : OFF_KCB));
            bf16_t* outT = (bf16_t*)(ws + OFF_VCBT);
#pragma unroll
            for (int mi = 0; mi < 4; ++mi)
#pragma unroll
                for (int ni = 0; ni < 4; ++ni) {
                    const int m = tm * 128 + wr * 64 + mi * 16 + fr, n = ni * 16 + 4 * fq, c = m & 255, bg = m >> 8;
                    f32x4 v = acc[mi][ni];
                    if (c == 255) v = (f32x4){0.f, 0.f, 0.f, 0.f};
                    *(uint2*)(outp + (size_t)m * 64 + n) = pack4(v);
                    if (which) {
#pragma unroll
                        for (int j = 0; j < 4; ++j) outT[((size_t)bg * 64 + n + j) * 256 + c] = f2bf(v[j]);
                    }
                }
        }
    }
}

typedef unsigned u32x2 __attribute__((ext_vector_type(2)));
__device__ __forceinline__ u32x2 pack4v(f32x4 v) { u32x2 o; o[0] = pack_bf16(v[0], v[1]); o[1] = pack_bf16(v[2], v[3]); return o; }
__device__ __forceinline__ f32x4 unpack4v(u32x2 o) { return (f32x4){__uint_as_float(o[0] << 16), __uint_as_float(o[0] & 0xFFFF0000u), __uint_as_float(o[1] << 16), __uint_as_float(o[1] & 0xFFFF0000u)}; }
template <int HALF>
__device__ __forceinline__ void merge_half(u32x2 (&tpk)[4][4], int tm, int tn, const bf16_t* __restrict__ h, const bf16_t* __restrict__ WinT, const bf16_t* __restrict__ yy,
                                           const bf16_t* __restrict__ WT, bf16_t* __restrict__ mrg, char* smem) {
    GEMM_LANE_VARS
    u32x2 sg[4][4];
    {
        const bf16_t* pa[4]; const bf16_t* pb[4];
#pragma unroll
        for (int i = 0; i < 4; ++i) { pa[i] = h + (size_t)(tm * 128 + lrow + 32 * i) * 1024 + lch8; pb[i] = WinT + (size_t)((HALF ? MGB : MGA) + tn * 128 + lrow + 32 * i) * 1024 + lch8; }
        f32x4 gg[4][4]; acc_zero(gg);
        gemm_kloop(gg, pa, pb, 64, 64, 16, smem);
#pragma unroll
        for (int mi = 0; mi < 4; ++mi)
#pragma unroll
            for (int ni = 0; ni < 4; ++ni) {
                f32x4 t;
#pragma unroll
                for (int j = 0; j < 4; ++j) t[j] = sigmoidf_(gg[mi][ni][j]);
                sg[mi][ni] = pack4v(t);
            }
    }
    {
        const bf16_t* pa[4]; const bf16_t* pb[4];
#pragma unroll
        for (int i = 0; i < 4; ++i) { pa[i] = yy + (size_t)(tm * 128 + lrow + 32 * i) * 512 + lch8; pb[i] = WT + (size_t)(tn * 128 + lrow + 32 * i) * 512 + lch8; }
        f32x4 acc[4][4]; acc_zero(acc);
        gemm_kloop(acc, pa, pb, 64, 64, 8, smem);
#pragma unroll
        for (int mi = 0; mi < 4; ++mi)
#pragma unroll
            for (int ni = 0; ni < 4; ++ni) {
                f32x4 t = unpack4v(sg[mi][ni]) * acc[mi][ni];
                if (HALF == 0) tpk[mi][ni] = pack4v(t);
                else {
                    t += unpack4v(tpk[mi][ni]);
                    const int m = tm * 128 + wr * 64 + mi * 16 + fr, n = tn * 128 + wc * 64 + ni * 16 + 4 * fq;
                    *(u32x2*)(mrg + (size_t)m * 1024 + n) = pack4v(t);
                }
            }
    }
}
__device__ __forceinline__ void ph_merge(const bf16_t* __restrict__ h, const bf16_t* __restrict__ WinT, const bf16_t* __restrict__ ya, const bf16_t* __restrict__ yb,
                                         const bf16_t* __restrict__ WaT, const bf16_t* __restrict__ WbT, bf16_t* __restrict__ mrg, char* smem) {
    for (int u = HB_FIRST; u < 128 * 8; u += HB_STEP) {
        const int xg = u & 7, v = u >> 3, tn = v & 7, tm = (v >> 3) * 8 + xg;
        u32x2 tpk[4][4];
        merge_half<0>(tpk, tm, tn, h, WinT, ya, WaT, mrg, smem);
        merge_half<1>(tpk, tm, tn, h, WinT, yb, WbT, mrg, smem);
    }
}

__device__ __forceinline__ void ph_outproj(const bf16_t* __restrict__ mrg, const bf16_t* __restrict__ WoT, const float* __restrict__ x, float* __restrict__ x2, char* smem) {
    GEMM_LANE_VARS
    for (int u = HB_FIRST; u < 128 * 8; u += HB_STEP) {
        const int xg = u & 7, v = u >> 3, tn = v & 7, tm = (v >> 3) * 8 + xg;
        const bf16_t* pa[4]; const bf16_t* pb[4];
#pragma unroll
        for (int i = 0; i < 4; ++i) { pa[i] = mrg + (size_t)(tm * 128 + lrow + 32 * i) * 1024 + lch8; pb[i] = WoT + (size_t)(tn * 128 + lrow + 32 * i) * 1024 + lch8; }
        f32x4 acc[4][4]; acc_zero(acc);
        gemm_kloop(acc, pa, pb, 64, 64, 16, smem);
#pragma unroll
        for (int mi = 0; mi < 4; ++mi)
#pragma unroll
            for (int ni = 0; ni < 4; ++ni) {
                const int m = tm * 128 + wr * 64 + mi * 16 + fr, n = tn * 128 + wc * 64 + ni * 16 + 4 * fq;
                const float4 xv = *(const float4*)(x + (size_t)m * 1024 + n);
                *(float4*)(x2 + (size_t)m * 1024 + n) = make_float4(xv.x + acc[mi][ni][0], xv.y + acc[mi][ni][1], xv.z + acc[mi][ni][2], xv.w + acc[mi][ni][3]);
            }
    }
}

__device__ __forceinline__ int moe_tile_decode(const int* __restrict__ cnt, int t, int& e, int& i) {
    int acc = 0; e = 0; i = 0;
    for (int ee = 0; ee < 32; ++ee) { const int nt = (cnt[ee * 64] + 127) >> 7; if (t >= acc && t < acc + nt) { e = ee; i = t - acc; } acc += nt; }
    return acc;
}

__device__ __forceinline__ void ph_moe1(const bf16_t* __restrict__ h2, const bf16_t* __restrict__ WgT, const bf16_t* __restrict__ WuT, const int* __restrict__ cnt,
                                        const int* __restrict__ ltok, const float* __restrict__ lw, const float* __restrict__ rstd, bf16_t* __restrict__ hid, char* smem) {
    GEMM_LANE_VARS
    int e, ti;
    const int nu = moe_tile_decode(cnt, 0, e, ti) * 4;
    for (int u = HB_FIRST; u < nu; u += HB_STEP) {
        const int ft = u & 3;
        (void)moe_tile_decode(cnt, u >> 2, e, ti);
        const int ne = cnt[e * 64];
        const bf16_t* pa[4]; const bf16_t* pb[4];
#pragma unroll
        for (int i = 0; i < 4; ++i) {
            const int rr = lrow + 32 * i, idx = ti * 128 + rr;
            const int tk = idx < ne ? ltok[e * 16384 + idx] : 0;
            pa[i] = h2 + (size_t)(tk >> 1) * 1024 + lch8;
            const int bwc = rr >> 6, bni = (rr >> 4) & 3, bj = rr & 15;
            const int f = ft * 64 + bwc * 32 + (bni >> 1) * 16 + bj;
            pb[i] = ((bni & 1) ? WuT : WgT) + ((size_t)e * 256 + f) * 1024 + lch8;
        }
        f32x4 acc[4][4]; acc_zero(acc);
        gemm_kloop(acc, pa, pb, 64, 64, 16, smem);
#pragma unroll
        for (int mi = 0; mi < 4; ++mi) {
            const int idx = ti * 128 + wr * 64 + mi * 16 + fr;
            if (idx < ne) {
                const int tk = ltok[e * 16384 + idx];
                const float w = lw[e * 16384 + idx], rsv = rstd[tk >> 1];
#pragma unroll
                for (int q = 0; q < 2; ++q) {
                    const int f = ft * 64 + wc * 32 + q * 16 + 4 * fq;
                    f32x4 v;
#pragma unroll
                    for (int j = 0; j < 4; ++j) { const float a = acc[mi][2 * q][j] * rsv, uu = acc[mi][2 * q + 1][j] * rsv; v[j] = a * sigmoidf_(a) * uu * w; }
                    *(uint2*)(hid + (size_t)tk * 256 + f) = pack4(v);
                }
            }
        }
    }
}

__device__ __forceinline__ void ph_moe2(const bf16_t* __restrict__ hid, const bf16_t* __restrict__ WdT, const int* __restrict__ cnt, const int* __restrict__ ltok,
                                        bf16_t* __restrict__ Y, char* smem) {
    GEMM_LANE_VARS
    int e, ti;
    const int nu = moe_tile_decode(cnt, 0, e, ti) * 8;
    for (int u = HB_FIRST; u < nu; u += HB_STEP) {
        const int tn = u & 7;
        (void)moe_tile_decode(cnt, u >> 3, e, ti);
        const int ne = cnt[e * 64];
        const bf16_t* pa[4]; const bf16_t* pb[4];
#pragma unroll
        for (int i = 0; i < 4; ++i) {
            const int idx = ti * 128 + lrow + 32 * i;
            const int tk = idx < ne ? ltok[e * 16384 + idx] : 0;
            pa[i] = hid + (size_t)tk * 256 + lch8;
            pb[i] = WdT + ((size_t)e * 1024 + tn * 128 + lrow + 32 * i) * 256 + lch8;
        }
        f32x4 acc[4][4]; acc_zero(acc);
        gemm_kloop(acc, pa, pb, 64, 64, 4, smem);
#pragma unroll
        for (int mi = 0; mi < 4; ++mi) {
            const int idx = ti * 128 + wr * 64 + mi * 16 + fr;
            if (idx < ne) {
                const int tk = ltok[e * 16384 + idx];
                bf16_t* yr = Y + ((size_t)(tk & 1) * T + (size_t)(tk >> 1)) * 1024 + tn * 128 + wc * 64 + 4 * fq;
#pragma unroll
                for (int ni = 0; ni < 4; ++ni) *(uint2*)(yr + ni * 16) = pack4(acc[mi][ni]);
            }
        }
    }
}

namespace g8 {
constexpr int HTB = 128 * 64 * 2;
__device__ __forceinline__ int lds_byte(int r, int c) { const int st = (r >> 4) * 2 + (c >> 5), rr = r & 15, cc = c & 31, ob = rr * 64 + cc * 2; return st * 1024 + (ob ^ (((ob >> 9) & 1) << 5)); }
__device__ __forceinline__ void stage_rc(int b, int& R, int& C) { const int st = b / 1024, sb = b % 1024, swz = sb ^ (((sb >> 9) & 1) << 5); R = (st >> 1) * 16 + swz / 64; C = (st & 1) * 32 + (swz % 64) / 2; }
__device__ __forceinline__ int perm32(int rho) { const int n = rho >> 4, i = rho & 15; return 8 * (i >> 2) + 4 * n + (i & 3); }
struct Unit { int pm, pn, e; };
struct StaticOrder {
    int nM, nN, nwg, G, c;
    __device__ void init(int M, int N, int G_, int c_) { nM = M / 256; nN = N / 256; nwg = nM * nN; G = G_; c = c_; }
    __device__ bool next(int i, Unit& u) const {
        const long L = (long)i * G + c; if (L >= nwg) return false;
        int wgid = (int)L; { const int q = nwg / 8, r = nwg % 8, xcd = wgid % 8, off = wgid / 8; wgid = (xcd < r ? xcd * (q + 1) : r * (q + 1) + (xcd - r) * q) + off; }
        const int nig = 8 * nN, gid = wgid / nig, fm = gid * 8, gsz = (nM - fm) < 8 ? (nM - fm) : 8;
        u.pm = fm + ((wgid % nig) % gsz); u.pn = (wgid % nig) / gsz; u.e = 0; return true;
    }
};
struct AddrPlain {
    const char* A; const char* Bt; unsigned lda2, ldb2;
    __device__ __forceinline__ unsigned a_off(const Unit& u, int row) const { return (unsigned)(u.pm * 256 + row) * lda2; }
    __device__ __forceinline__ unsigned b_off(const Unit& u, int row) const { return (unsigned)(u.pn * 256 + row) * ldb2; }
};

template <class Epi, class Sched, class Addr>
__device__ __forceinline__ void gemm_phase(char* ldsc, const Sched& S, const Addr& AD, const Epi& E, int nt) {
    __attribute__((address_space(3))) unsigned char* lds = (__attribute__((address_space(3))) unsigned char*)ldsc;
    int tid_ = threadIdx.x; asm volatile("" : "+v"(tid_));
    const int tid = tid_, wid = __builtin_amdgcn_readfirstlane(tid >> 6), lane = tid & 63, wr = wid >> 2, wc = wid & 3, fr = lane & 15, fq = lane >> 4;
    int R[2], C2[2], Rb[2];
#pragma unroll
    for (int i = 0; i < 2; ++i) { int r_, c_; stage_rc(tid * 16 + i * 8192, r_, c_); R[i] = r_; C2[i] = c_ * 2; Rb[i] = Epi::PERM ? ((r_ & ~31) + perm32(r_ & 31)) : r_; }
    const unsigned ldsw = (unsigned)wid * 1024u;
    const int aoff = lds_byte(wr * 64 + fr, fq * 8), boff = lds_byte(wc * 32 + fr, fq * 8);
    const char* const Ab = AD.A; const char* const Bb = AD.Bt;
#define G8_SA(b, h) (((b) * 2 + (h)) * HTB)
#define G8_SB(b, h) ((4 + (b) * 2 + (h)) * HTB)
#define G8_SETOFF(va, vb, u) do { _Pragma("unroll") for (int h_ = 0; h_ < 2; ++h_) _Pragma("unroll") for (int i_ = 0; i_ < 2; ++i_) { \
        va[h_][i_] = AD.a_off(u, h_ * 128 + R[i_]) + (unsigned)C2[i_]; vb[h_][i_] = AD.b_off(u, h_ * 128 + Rb[i_]) + (unsigned)C2[i_]; } } while (0)
#define G8_STAGE(bufoff, base, v2, kb) do { _Pragma("unroll") for (int _i = 0; _i < 2; ++_i) \
        __builtin_amdgcn_global_load_lds((const __attribute__((address_space(1))) unsigned*)((base) + (size_t)(v2)[_i] + (size_t)(kb)), (__attribute__((address_space(3))) unsigned*)(lds + (bufoff) + ldsw + _i * 8192), 16, 0, 0); } while (0)
#define G8_LDA(dst, b, h) do { _Pragma("unroll") for (int m = 0; m < 4; ++m) _Pragma("unroll") for (int k = 0; k < 2; ++k) dst[m][k] = *(const __attribute__((address_space(3))) bf16x8*)(lds + G8_SA(b, h) + aoff + m * 2048 + k * 1024); } while (0)
#define G8_LDB(dst, b, h) do { _Pragma("unroll") for (int n = 0; n < 2; ++n) _Pragma("unroll") for (int k = 0; k < 2; ++k) dst[n][k] = *(const __attribute__((address_space(3))) bf16x8*)(lds + G8_SB(b, h) + boff + n * 2048 + k * 1024); } while (0)
#define G8_MMA(ai, bj, At, Bt) do { __builtin_amdgcn_s_setprio(1); _Pragma("unroll") for (int m = 0; m < 4; ++m) _Pragma("unroll") for (int n = 0; n < 2; ++n) _Pragma("unroll") for (int k = 0; k < 2; ++k) \
        acc[ai][bj][m][n] = __builtin_amdgcn_mfma_f32_16x16x32_bf16(Bt[n][k], At[m][k], acc[ai][bj][m][n], 0, 0, 0); __builtin_amdgcn_s_setprio(0); } while (0)
#define G8_WAIT_V(n) asm volatile("s_waitcnt vmcnt(" #n ")" ::: "memory")
#define G8_WAIT_L(n) asm volatile("s_waitcnt lgkmcnt(" #n ")" ::: "memory")
#define G8_BAR __builtin_amdgcn_s_barrier()
#define G8_SCHED __builtin_amdgcn_sched_barrier(0)
    Unit cur, nxt; int ui = 0;
    if (!S.next(0, cur)) return;
    f32x4 acc[2][2][4][2];
#pragma unroll
    for (int a = 0; a < 2; ++a)
#pragma unroll
        for (int b = 0; b < 2; ++b)
#pragma unroll
            for (int m = 0; m < 4; ++m)
#pragma unroll
                for (int n = 0; n < 2; ++n) acc[a][b][m][n] = (f32x4){0.f, 0.f, 0.f, 0.f};
    bf16x8 At[4][2], B0[2][2], B1[2][2];
    unsigned cvA[2][2], cvB[2][2];
    G8_SETOFF(cvA, cvB, cur);
    __syncthreads();
    G8_STAGE(G8_SB(0, 0), Bb, cvB[0], 0); G8_STAGE(G8_SA(0, 0), Ab, cvA[0], 0); G8_STAGE(G8_SB(0, 1), Bb, cvB[1], 0); G8_STAGE(G8_SA(0, 1), Ab, cvA[1], 0);
    if (wr == 1) G8_BAR;
    G8_WAIT_V(4); G8_BAR;
    G8_STAGE(G8_SB(1, 0), Bb, cvB[0], 128); G8_STAGE(G8_SA(1, 0), Ab, cvA[0], 128); G8_STAGE(G8_SB(1, 1), Bb, cvB[1], 128);
    G8_WAIT_V(6); G8_BAR;
    for (;;) {
        const bool has_next = S.next(ui + 1, nxt);
        for (int t = 0; t < nt; t += 2) {
            const bool last = (t == nt - 2);
            unsigned sA[2][2], sB[2][2];
            if (last && has_next) { G8_SETOFF(sA, sB, nxt); }
            else {
#pragma unroll
                for (int h_ = 0; h_ < 2; ++h_)
#pragma unroll
                    for (int i_ = 0; i_ < 2; ++i_) { sA[h_][i_] = cvA[h_][i_]; sB[h_][i_] = cvB[h_][i_]; }
            }
            const int kb1 = (t + 1) * 128, kb2 = last ? 0 : (t + 2) * 128, kb3 = kb2 + 128;
            G8_LDB(B0, 0, 0); G8_SCHED; G8_LDA(At, 0, 0); G8_STAGE(G8_SA(1, 1), Ab, cvA[1], kb1);
            G8_WAIT_L(8); G8_BAR; G8_WAIT_L(0); G8_MMA(0, 0, At, B0); G8_BAR; G8_SCHED;
            G8_LDB(B1, 0, 1); G8_STAGE(G8_SB(0, 0), Bb, sB[0], kb2);
            G8_BAR; G8_WAIT_L(0); G8_MMA(0, 1, At, B1); G8_BAR;
            G8_LDA(At, 0, 1); G8_STAGE(G8_SA(0, 0), Ab, sA[0], kb2);
            G8_BAR; G8_WAIT_L(0); G8_MMA(1, 0, At, B0); G8_BAR; G8_SCHED;
            G8_STAGE(G8_SB(0, 1), Bb, sB[1], kb2);
            G8_WAIT_V(6); G8_BAR; G8_MMA(1, 1, At, B1); G8_BAR;
            G8_LDB(B0, 1, 0); G8_SCHED; G8_LDA(At, 1, 0); G8_STAGE(G8_SA(0, 1), Ab, sA[1], kb2);
            G8_WAIT_L(8); G8_BAR; G8_WAIT_L(0); G8_MMA(0, 0, At, B0); G8_BAR; G8_SCHED;
            G8_LDB(B1, 1, 1); G8_STAGE(G8_SB(1, 0), Bb, sB[0], kb3);
            G8_BAR; G8_WAIT_L(0); G8_MMA(0, 1, At, B1); G8_BAR;
            G8_LDA(At, 1, 1); G8_STAGE(G8_SA(1, 0), Ab, sA[0], kb3);
            G8_BAR; G8_WAIT_L(0); G8_MMA(1, 0, At, B0); G8_BAR; G8_SCHED;
            G8_STAGE(G8_SB(1, 1), Bb, sB[1], kb3);
            G8_WAIT_V(6); G8_BAR; G8_MMA(1, 1, At, B1); G8_BAR;
            if (last && has_next) {
#pragma unroll
                for (int h_ = 0; h_ < 2; ++h_)
#pragma unroll
                    for (int i_ = 0; i_ < 2; ++i_) { cvA[h_][i_] = sA[h_][i_]; cvB[h_][i_] = sB[h_][i_]; }
            }
        }
        E(acc, cur, wr, wc, fr, fq);
        if (!has_next) break;
#pragma unroll
        for (int a = 0; a < 2; ++a)
#pragma unroll
            for (int b = 0; b < 2; ++b)
#pragma unroll
                for (int m = 0; m < 4; ++m)
#pragma unroll
                    for (int n = 0; n < 2; ++n) acc[a][b][m][n] = (f32x4){0.f, 0.f, 0.f, 0.f};
        cur = nxt; ++ui;
    }
    G8_WAIT_V(0);
    if (wr == 0) G8_BAR;
    G8_BAR;
#undef G8_SA
#undef G8_SB
#undef G8_SETOFF
#undef G8_STAGE
#undef G8_LDA
#undef G8_LDB
#undef G8_MMA
#undef G8_WAIT_V
#undef G8_WAIT_L
#undef G8_BAR
#undef G8_SCHED
}

struct EpiProj {
    static constexpr bool PERM = true;
    bf16_t* proj;
    __device__ __forceinline__ void operator()(const f32x4 (&acc)[2][2][4][2], const Unit& u, int wr, int wc, int fr, int fq) const {
#pragma unroll
        for (int ai = 0; ai < 2; ++ai)
#pragma unroll
            for (int m = 0; m < 4; ++m) {
                const int r = u.pm * 256 + ai * 128 + wr * 64 + m * 16 + fr;
#pragma unroll
                for (int bj = 0; bj < 2; ++bj) {
                    const int c = u.pn * 256 + bj * 128 + wc * 32 + 8 * fq;
                    if (c < NPROJ) {
                        u32x4 w; w[0] = pack_bf16(acc[ai][bj][m][0][0], acc[ai][bj][m][0][1]); w[1] = pack_bf16(acc[ai][bj][m][0][2], acc[ai][bj][m][0][3]);
                        w[2] = pack_bf16(acc[ai][bj][m][1][0], acc[ai][bj][m][1][1]); w[3] = pack_bf16(acc[ai][bj][m][1][2], acc[ai][bj][m][1][3]);
                        *(u32x4*)(proj + (size_t)r * PP + c) = w;
                    }
                }
            }
    }
};
struct EpiResid {
    static constexpr bool PERM = false;
    const float* x; float* x2;
    __device__ __forceinline__ void operator()(const f32x4 (&acc)[2][2][4][2], const Unit& u, int wr, int wc, int fr, int fq) const {
#pragma unroll
        for (int ai = 0; ai < 2; ++ai)
#pragma unroll
            for (int m = 0; m < 4; ++m) {
                const int r = u.pm * 256 + ai * 128 + wr * 64 + m * 16 + fr;
#pragma unroll
                for (int bj = 0; bj < 2; ++bj)
#pragma unroll
                    for (int n = 0; n < 2; ++n) {
                        const int c = u.pn * 256 + bj * 128 + wc * 32 + 16 * n + 4 * fq;
                        const f32x4 xv = *(const f32x4*)(x + (size_t)r * 1024 + c);
                        *(f32x4*)(x2 + (size_t)r * 1024 + c) = xv + acc[ai][bj][m][n];
                    }
            }
    }
};
}

constexpr float LOG2E = 1.4426950408889634f;
constexpr float NEGV = -3.0e38f;
constexpr int NSA_TB = 32768;
constexpr int NSA_IMPA = 34816;
constexpr int NSA_IMPB = NSA_IMPA + 16640;
constexpr int NSA_SELM = NSA_IMPB + 16640;

__device__ __forceinline__ int t5_bucket2(int n) {
    if (n < 16) return n;
    const int l = 16 + (int)(logf((float)n / 16.0f) / logf(8.0f) * 16.0f);
    return l < 31 ? l : 31;
}

template <int MODE, bool A0, bool A1>
__device__ __forceinline__ void nsa_tile(const char* Kst, const char* Vst, int j, bool fast, const float* tbias, const bf16x8 (&qf)[2][2], const int (&qidx)[2],
                                         const unsigned long long (&selq)[2], f32x4 (&O)[4][2], float (&m)[2], float (&l)[2], const float (&invl)[2],
                                         char* smem, int fr, int fq, int hp, int wid) {
    const float b127 = tbias[127];
    bf16x8 pf[2][2];
#pragma unroll
    for (int ct = 0; ct < 2; ++ct) {
        if ((ct == 0 && !A0) || (ct == 1 && !A1)) continue;
        f32x4 sacc[2][2];
#pragma unroll
        for (int p = 0; p < 2; ++p)
#pragma unroll
            for (int s = 0; s < 2; ++s) {
                const int row = 32 * p + 16 * s + fr;
                const bf16x8 k0 = *(const bf16x8*)(Kst + tile_off(row, fq)), k1 = *(const bf16x8*)(Kst + tile_off(row, 4 + fq));
                f32x4 a = (f32x4){0.f, 0.f, 0.f, 0.f};
                a = __builtin_amdgcn_mfma_f32_16x16x32_bf16(k0, qf[ct][0], a, 0, 0, 0);
                a = __builtin_amdgcn_mfma_f32_16x16x32_bf16(k1, qf[ct][1], a, 0, 0, 0);
                sacc[p][s] = a;
            }
        const int q = qidx[ct];
        const bool sel = (MODE == 1) ? (((selq[ct] >> j) & 1ull) != 0ull) : true;
        if (MODE != 3) {
            const float mct = m[ct];
            float mloc = NEGV;
            bool exact = __builtin_amdgcn_ballot_w64(mct < -1e29f) != 0ull;
            if (!exact) {
                if (fast) {
                    const float bm = (sel ? b127 : NEGV) - mct;
#pragma unroll
                    for (int p = 0; p < 2; ++p)
#pragma unroll
                        for (int s = 0; s < 2; ++s)
#pragma unroll
                            for (int i = 0; i < 4; ++i) { const float sv = sacc[p][s][i] * (0.125f * LOG2E) + bm; sacc[p][s][i] = sv; mloc = fmaxf(mloc, sv); }
                } else {
#pragma unroll
                    for (int p = 0; p < 2; ++p)
#pragma unroll
                        for (int s = 0; s < 2; ++s)
#pragma unroll
                            for (int i = 0; i < 4; ++i) {
                                const int kk = 64 * j + 32 * p + 8 * fq + 4 * s + i;
                                int rel; bool valid;
                                if (MODE == 0) { rel = q - (16 * kk + 31); valid = rel >= 0; }
                                else if (MODE == 1) { rel = q - kk; valid = (rel >= 0) && sel; }
                                else { rel = q - kk; valid = (rel >= 0) && (rel < 512); }
                                const int rc = rel < 0 ? 0 : (rel > 127 ? 127 : rel);
                                const float sv = valid ? sacc[p][s][i] * (0.125f * LOG2E) + (tbias[rc] - mct) : NEGV;
                                sacc[p][s][i] = sv; mloc = fmaxf(mloc, sv);
                            }
                }
                if (__builtin_amdgcn_ballot_w64(mloc > 8.0f) != 0ull) {
                    exact = true;
#pragma unroll
                    for (int p = 0; p < 2; ++p)
#pragma unroll
                        for (int s = 0; s < 2; ++s)
#pragma unroll
                            for (int i = 0; i < 4; ++i) sacc[p][s][i] += mct;
                    mloc += mct;
                }
            } else {
#pragma unroll
                for (int p = 0; p < 2; ++p)
#pragma unroll
                    for (int s = 0; s < 2; ++s)
#pragma unroll
                        for (int i = 0; i < 4; ++i) {
                            const int kk = 64 * j + 32 * p + 8 * fq + 4 * s + i;
                            int rel; bool valid;
                            if (MODE == 0) { rel = q - (16 * kk + 31); valid = rel >= 0; }
                            else if (MODE == 1) { rel = q - kk; valid = (rel >= 0) && sel; }
                            else { rel = q - kk; valid = (rel >= 0) && (rel < 512); }
                            const int rc = rel < 0 ? 0 : (rel > 127 ? 127 : rel);
                            const float sv = valid ? sacc[p][s][i] * (0.125f * LOG2E) + tbias[rc] : NEGV;
                            sacc[p][s][i] = sv; mloc = fmaxf(mloc, sv);
                        }
            }
            if (exact) {
                mloc = fmaxf(mloc, __shfl_xor(mloc, 16)); mloc = fmaxf(mloc, __shfl_xor(mloc, 32));
                const float mnew = fmaxf(mct, mloc);
                const float alpha = __builtin_amdgcn_exp2f(mct - mnew);
                m[ct] = mnew; l[ct] *= alpha;
#pragma unroll
                for (int dt = 0; dt < 4; ++dt) O[dt][ct] = O[dt][ct] * alpha;
#pragma unroll
                for (int p = 0; p < 2; ++p)
#pragma unroll
                    for (int s = 0; s < 2; ++s)
#pragma unroll
                        for (int i = 0; i < 4; ++i) sacc[p][s][i] -= mnew;
            }
            float psum = 0.f;
#pragma unroll
            for (int p = 0; p < 2; ++p) {
                float pv[8];
#pragma unroll
                for (int s = 0; s < 2; ++s)
#pragma unroll
                    for (int i = 0; i < 4; ++i) { pv[s * 4 + i] = __builtin_amdgcn_exp2f(sacc[p][s][i]); psum += pv[s * 4 + i]; }
                u32x4 w; w[0] = pack_bf16(pv[0], pv[1]); w[1] = pack_bf16(pv[2], pv[3]); w[2] = pack_bf16(pv[4], pv[5]); w[3] = pack_bf16(pv[6], pv[7]);
                pf[ct][p] = __builtin_bit_cast(bf16x8, w);
            }
            l[ct] += psum;
        } else {
#pragma unroll
            for (int p = 0; p < 2; ++p)
#pragma unroll
                for (int s = 0; s < 2; ++s)
#pragma unroll
                    for (int i = 0; i < 4; ++i) {
                        const int kk = 64 * j + 32 * p + 8 * fq + 4 * s + i;
                        const int rel = q - (16 * kk + 31);
                        const int rc = rel < 0 ? 0 : (rel > 127 ? 127 : rel);
                        sacc[p][s][i] = (rel >= 0) ? sacc[p][s][i] * (0.125f * LOG2E) + tbias[rc] : NEGV;
                    }
            float* impA = (float*)(smem + NSA_IMPA); float* impB = (float*)(smem + NSA_IMPB);
            const int ql = wid * 8 + ct * 4 + (fr >> 2);
#pragma unroll
            for (int p = 0; p < 2; ++p)
#pragma unroll
                for (int s = 0; s < 2; ++s) {
                    float p3 = __builtin_amdgcn_exp2f(sacc[p][s][3] - m[ct]) * invl[ct];
                    float pa = __builtin_amdgcn_exp2f(sacc[p][s][0] - m[ct]) * invl[ct] + __builtin_amdgcn_exp2f(sacc[p][s][1] - m[ct]) * invl[ct]
                             + __builtin_amdgcn_exp2f(sacc[p][s][2] - m[ct]) * invl[ct] + p3;
                    pa += __shfl_xor(pa, 1); pa += __shfl_xor(pa, 2);
                    p3 += __shfl_xor(p3, 1); p3 += __shfl_xor(p3, 2);
                    const int jj = 16 * j + 8 * p + 2 * fq + s;
                    if (hp == 0) { impA[ql * 65 + jj] = pa; impB[ql * 65 + jj + 1] = p3; }
                }
        }
    }
    if (MODE != 3) {
#pragma unroll
        for (int dt = 0; dt < 4; ++dt)
#pragma unroll
            for (int p = 0; p < 2; ++p) {
                const bf16x8 vf = *(const bf16x8*)(Vst + tile_off(dt * 16 + fr, p * 4 + fq));
                if (A0) O[dt][0] = __builtin_amdgcn_mfma_f32_16x16x32_bf16(vf, pf[0][p], O[dt][0], 0, 0, 0);
                if (A1) O[dt][1] = __builtin_amdgcn_mfma_f32_16x16x32_bf16(vf, pf[1][p], O[dt][1], 0, 0, 0);
            }
    }
}

template <int MODE>
__device__ __forceinline__ void nsa_branch(const bf16_t* __restrict__ Kb, size_t kstride, const bf16_t* __restrict__ Vb, size_t vstride, int j0, int ntiles, int t0,
                                           const bf16x8 (&qf)[2][2], const int (&qidx)[2], const unsigned long long (&selq)[2], unsigned long long selor0, unsigned long long selor1,
                                           f32x4 (&O)[4][2], float (&m)[2], float (&l)[2], const float (&invl)[2], char* smem) {
    int tid_ = threadIdx.x; asm volatile("" : "+v"(tid_));
    const int tid = tid_, lane = tid & 63, wid = tid >> 6, fr = lane & 15, fq = lane >> 4, hp = fr & 3;
    const int lrow = tid >> 3;
    const float* tbias = (const float*)(smem + NSA_TB) + hp * 128;
    const int sch8 = ((tid & 7) ^ (lrow & 7)) * 8;
    const int krow = 32 * (lrow >> 5) + 8 * ((lrow & 15) >> 2) + 4 * ((lrow >> 4) & 1) + (lrow & 3);
    const bf16_t* kp = Kb + (size_t)krow * kstride + sch8;
    const bf16_t* vp = Vb + (size_t)lrow * vstride + sch8;
    __syncthreads();
    glds16(kp, smem + tid * 16); if (MODE != 3) glds16(vp, smem + 8192 + tid * 16);
    asm volatile("s_waitcnt vmcnt(0)" ::: "memory");
    __syncthreads();
    for (int it = 0; it < ntiles; ++it) {
        const int cur = it & 1, j = j0 + it;
        if (it + 1 < ntiles) {
            char* st = smem + (cur ^ 1) * 16384 + tid * 16;
            glds16(kp + (size_t)(it + 1) * 64 * kstride, st); if (MODE != 3) glds16(vp + (size_t)(it + 1) * 64, st + 8192);
        }
        const char* Kst = smem + cur * 16384;
        const char* Vst = Kst + 8192;
        bool fast;
        if (MODE == 0 || MODE == 3) fast = (t0 - (16 * (64 * j + 63) + 31)) >= 128;
        else if (MODE == 1) fast = (t0 - (64 * j + 63)) >= 128;
        else fast = ((t0 - (64 * j + 63)) >= 128) && ((t0 + 63 - 64 * j) < 512);
        if (MODE == 1) {
            const bool a0 = ((selor0 >> j) & 1ull) != 0ull, a1 = ((selor1 >> j) & 1ull) != 0ull;
            if (a0 && a1) nsa_tile<MODE, true, true>(Kst, Vst, j, fast, tbias, qf, qidx, selq, O, m, l, invl, smem, fr, fq, hp, wid);
            else if (a0) nsa_tile<MODE, true, false>(Kst, Vst, j, fast, tbias, qf, qidx, selq, O, m, l, invl, smem, fr, fq, hp, wid);
            else if (a1) nsa_tile<MODE, false, true>(Kst, Vst, j, fast, tbias, qf, qidx, selq, O, m, l, invl, smem, fr, fq, hp, wid);
        } else {
            nsa_tile<MODE, true, true>(Kst, Vst, j, fast, tbias, qf, qidx, selq, O, m, l, invl, smem, fr, fq, hp, wid);
        }
        asm volatile("s_waitcnt vmcnt(0)" ::: "memory");
        __syncthreads();
    }
}

__device__ __forceinline__ void osum_add(uint2& acc, f32x4 o, float sc) {
    f32x4 v;
    v[0] = __uint_as_float(acc.x << 16) + o[0] * sc; v[1] = __uint_as_float(acc.x & 0xFFFF0000u) + o[1] * sc;
    v[2] = __uint_as_float(acc.y << 16) + o[2] * sc; v[3] = __uint_as_float(acc.y & 0xFFFF0000u) + o[3] * sc;
    acc = pack4(v);
}
__device__ __forceinline__ float nsa_gate(const bf16_t* __restrict__ pb, int q, int br, int head) { return sigmoidf_(bf2f(pb[(size_t)q * PP + GA + br * 8 + head])); }

__device__ __forceinline__ void nsa_unit(int u, const bf16_t* __restrict__ proj, const char* __restrict__ ws, const float* __restrict__ rel_bias, bf16_t* __restrict__ ya, char* smem) {
    int tid_ = threadIdx.x; asm volatile("" : "+v"(tid_));
    const int tid = tid_, lane = tid & 63, wid = tid >> 6, fr = lane & 15, fq = lane >> 4, hp = fr & 3;
    const int bg = u & 7, qb = 63 - (u >> 3), b = bg >> 1, g = bg & 1, t0 = qb * 64, tb = qb;
    const bf16_t* kcb = (const bf16_t*)(ws + OFF_KCB) + (size_t)bg * 256 * 64;
    const bf16_t* vcbT = (const bf16_t*)(ws + OFF_VCBT) + (size_t)bg * 64 * 256;
    const bf16_t* VsT = (const bf16_t*)(ws + OFF_VST) + (size_t)bg * 64 * S;
    const bf16_t* VwT = (const bf16_t*)(ws + OFF_VWT) + (size_t)bg * 64 * S;
    const bf16_t* pb = proj + (size_t)b * S * PP;
    __syncthreads();
    {
        float* tbl = (float*)(smem + NSA_TB);
        { const int e = tid, h4 = e >> 7, n = e & 127; tbl[e] = rel_bias[t5_bucket2(n) * 8 + g * 4 + h4] * LOG2E; }
        float* imp = (float*)(smem + NSA_IMPA);
        for (int e = tid; e < 2 * 4160; e += 512) imp[e] = 0.f;
    }
    int qidx[2]; bf16x8 qf[2][2];
    const int head = g * 4 + hp;
#pragma unroll
    for (int ct = 0; ct < 2; ++ct) {
        qidx[ct] = t0 + wid * 8 + ct * 4 + (fr >> 2);
        const bf16_t* qr = pb + (size_t)qidx[ct] * PP;
        qf[ct][0] = *(const bf16x8*)(qr + QA + head * 64 + fq * 8);
        qf[ct][1] = *(const bf16x8*)(qr + QA + head * 64 + 32 + fq * 8);
    }
    uint2 osum[4][2];
#pragma unroll
    for (int dt = 0; dt < 4; ++dt)
#pragma unroll
        for (int ct = 0; ct < 2; ++ct) osum[dt][ct] = make_uint2(0u, 0u);
    unsigned long long selq[2] = {0ull, 0ull};
    float invl0[2] = {0.f, 0.f};
    const int ntc = (((t0 + 32) >> 4) + 1 + 63) >> 6;
    float mC[2], invC[2];
    {
        f32x4 O[4][2]; float m[2] = {-1e30f, -1e30f}, l[2] = {0.f, 0.f};
#pragma unroll
        for (int dt = 0; dt < 4; ++dt)
#pragma unroll
            for (int ct = 0; ct < 2; ++ct) O[dt][ct] = (f32x4){0.f, 0.f, 0.f, 0.f};
        nsa_branch<0>(kcb, 64, vcbT, 256, 0, ntc, t0, qf, qidx, selq, 0ull, 0ull, O, m, l, invl0, smem);
#pragma unroll
        for (int ct = 0; ct < 2; ++ct) {
            float lt = l[ct]; lt += __shfl_xor(lt, 16); lt += __shfl_xor(lt, 32);
            invC[ct] = lt > 0.f ? 1.f / lt : 0.f; mC[ct] = m[ct];
#pragma unroll
            for (int dt = 0; dt < 4; ++dt) osum_add(osum[dt][ct], O[dt][ct], nsa_gate(pb, qidx[ct], 0, head) * invC[ct]);
        }
        nsa_branch<3>(kcb, 64, vcbT, 256, 0, ntc, t0, qf, qidx, selq, 0ull, 0ull, O, mC, l, invC, smem);
    }
    {
        const float* impA = (const float*)(smem + NSA_IMPA); const float* impB = (const float*)(smem + NSA_IMPB);
        unsigned long long* selm = (unsigned long long*)(smem + NSA_SELM);
#pragma unroll 1
        for (int qq = 0; qq < 8; ++qq) {
            const int ql = wid * 8 + qq;
            const float val = impA[ql * 65 + lane] + impB[ql * 65 + lane];
            const bool forced = (lane == 0) || (lane == tb) || (lane == tb - 1);
            unsigned key = forced ? 0xFFFFFFC0u : (lane > tb ? 0u : (__float_as_uint(val) & 0xFFFFFFC0u));
            key |= (unsigned)(63 - lane);
            int rank = 0;
#pragma unroll
            for (int jp = 0; jp < 64; ++jp) rank += ((unsigned)__builtin_amdgcn_readlane((int)key, jp) > key) ? 1 : 0;
            const unsigned long long msk = __ballot(rank < 16);
            if (lane == 0) selm[ql] = msk;
        }
        wave_lds_sync();
        unsigned long long so0 = 0ull, so1 = 0ull;
#pragma unroll
        for (int qq = 0; qq < 4; ++qq) { so0 |= selm[wid * 8 + qq]; so1 |= selm[wid * 8 + 4 + qq]; }
        const unsigned long long selor0 = ((unsigned long long)(unsigned)__builtin_amdgcn_readfirstlane((int)(unsigned)(so0 >> 32)) << 32) | (unsigned)__builtin_amdgcn_readfirstlane((int)(unsigned)so0);
        const unsigned long long selor1 = ((unsigned long long)(unsigned)__builtin_amdgcn_readfirstlane((int)(unsigned)(so1 >> 32)) << 32) | (unsigned)__builtin_amdgcn_readfirstlane((int)(unsigned)so1);
        selq[0] = selm[wid * 8 + (fr >> 2)]; selq[1] = selm[wid * 8 + 4 + (fr >> 2)];
        {
            f32x4 O[4][2]; float m[2] = {-1e30f, -1e30f}, l[2] = {0.f, 0.f};
#pragma unroll
            for (int dt = 0; dt < 4; ++dt)
#pragma unroll
                for (int ct = 0; ct < 2; ++ct) O[dt][ct] = (f32x4){0.f, 0.f, 0.f, 0.f};
            nsa_branch<1>(pb + KS + g * 64, PP, VsT, S, 0, tb + 1, t0, qf, qidx, selq, selor0, selor1, O, m, l, invl0, smem);
#pragma unroll
            for (int ct = 0; ct < 2; ++ct) {
                float lt = l[ct]; lt += __shfl_xor(lt, 16); lt += __shfl_xor(lt, 32);
                const float inv = lt > 0.f ? 1.f / lt : 0.f;
#pragma unroll
                for (int dt = 0; dt < 4; ++dt) osum_add(osum[dt][ct], O[dt][ct], nsa_gate(pb, qidx[ct], 1, head) * inv);
            }
        }
    }
    {
        f32x4 O[4][2]; float m[2] = {-1e30f, -1e30f}, l[2] = {0.f, 0.f};
#pragma unroll
        for (int dt = 0; dt < 4; ++dt)
#pragma unroll
            for (int ct = 0; ct < 2; ++ct) O[dt][ct] = (f32x4){0.f, 0.f, 0.f, 0.f};
        const int jw0 = (t0 - 511 < 0 ? 0 : t0 - 511) >> 6;
        nsa_branch<2>(pb + (size_t)jw0 * 64 * PP + KW + g * 64, PP, VwT + jw0 * 64, S, jw0, tb - jw0 + 1, t0, qf, qidx, selq, 0ull, 0ull, O, m, l, invl0, smem);
#pragma unroll
        for (int ct = 0; ct < 2; ++ct) {
            float lt = l[ct]; lt += __shfl_xor(lt, 16); lt += __shfl_xor(lt, 32);
            const float inv = lt > 0.f ? 1.f / lt : 0.f;
#pragma unroll
            for (int dt = 0; dt < 4; ++dt) osum_add(osum[dt][ct], O[dt][ct], nsa_gate(pb, qidx[ct], 2, head) * inv);
        }
    }
#pragma unroll
    for (int ct = 0; ct < 2; ++ct) {
        bf16_t* yr = ya + (size_t)(b * S + qidx[ct]) * 512 + head * 64 + 4 * fq;
#pragma unroll
        for (int dt = 0; dt < 4; ++dt) *(uint2*)(yr + dt * 16) = osum[dt][ct];
    }
}

__device__ __forceinline__ void vtrans_tile(int task, const bf16_t* __restrict__ proj, char* ws, char* smem) {
    unsigned short (*tl)[66] = (unsigned short (*)[66])smem;
    const int tid = HB_TID, which = task >> 9, bg = (task >> 6) & 7, tt = task & 63, b = bg >> 1, g = bg & 1;
    const int r = tid >> 2, q4 = tid & 3;
    const bf16_t* src = proj + (size_t)(b * S + tt * 64 + r) * PP + (which ? VW : VS) + g * 64 + q4 * 16;
    const uint4 a0 = *(const uint4*)src, a1 = *(const uint4*)(src + 8);
    unsigned* trow = (unsigned*)&tl[r][q4 * 16];
    trow[0] = a0.x; trow[1] = a0.y; trow[2] = a0.z; trow[3] = a0.w; trow[4] = a1.x; trow[5] = a1.y; trow[6] = a1.z; trow[7] = a1.w;
    __syncthreads();
    bf16_t* dst = (bf16_t*)(ws + (which ? OFF_VWT : OFF_VST)) + ((size_t)bg * 64 + r) * S + tt * 64 + q4 * 16;
    unsigned o[8];
#pragma unroll
    for (int k = 0; k < 8; ++k) o[k] = (unsigned)tl[q4 * 16 + 2 * k][r] | ((unsigned)tl[q4 * 16 + 2 * k + 1][r] << 16);
    *(uint4*)dst = make_uint4(o[0], o[1], o[2], o[3]);
    *(uint4*)(dst + 8) = make_uint4(o[4], o[5], o[6], o[7]);
    __syncthreads();
}

__device__ __forceinline__ int tile_el(int row, int col) { return tile_off(row, col >> 3) + ((col & 7) << 1); }

__device__ __forceinline__ void gla_stage_vt(const bf16_t* __restrict__ proj, size_t row0, int h, char* vt_base) {
    const int tid = HB_TID, c = tid >> 2, vq = tid & 3;
    const bf16_t* src = proj + (row0 + c) * PP + VB + h * 128 + vq * 32;
#pragma unroll
    for (int k = 0; k < 4; ++k) {
        const u32x4 a = *(const u32x4*)(src + k * 8);
#pragma unroll
        for (int e = 0; e < 4; ++e) {
            const int v = vq * 32 + k * 8 + 2 * e;
            *(unsigned short*)(vt_base + tile_el(v, c)) = (unsigned short)(a[e] & 0xFFFFu);
            *(unsigned short*)(vt_base + tile_el(v + 1, c)) = (unsigned short)(a[e] >> 16);
        }
    }
}

__device__ __forceinline__ void gla_a_unit(int vb, const bf16_t* __restrict__ proj, const float* __restrict__ w_alpha, const float* __restrict__ b_alpha,
                                           float* __restrict__ bc, float* __restrict__ cstate, char* smem) {
    float (*bcS)[64] = (float (*)[64])smem;
    float (*tot)[64] = (float (*)[64])(smem + 16384);
    char* KDT = smem + 17408;
    char* VT = smem + 17408 + 8192;
    const int tid = HB_TID, lane = tid & 63, wid = tid >> 6, fr = lane & 15, fq = lane >> 4;
    const int n = vb & 63, h = (vb >> 6) & 3, b = vb >> 8;
    const size_t row0 = (size_t)(b * S + n * 64);
    __syncthreads();
    {
        const int d = tid & 63, cq = tid >> 6, col = h * 64 + d;
        float w[16];
#pragma unroll
        for (int r = 0; r < 16; ++r) w[r] = w_alpha[r * 256 + col];
        const float bias = b_alpha[col];
        float cum = 0.f;
        for (int i = 0; i < 16; ++i) {
            const int c = cq * 16 + i;
            const u32x4 a0 = *(const u32x4*)(proj + (row0 + c) * PP + AB), a1 = *(const u32x4*)(proj + (row0 + c) * PP + AB + 8);
            float z = bias;
#pragma unroll
            for (int e = 0; e < 4; ++e) {
                z += __uint_as_float(a0[e] << 16) * w[2 * e] + __uint_as_float(a0[e] & 0xFFFF0000u) * w[2 * e + 1];
                z += __uint_as_float(a1[e] << 16) * w[8 + 2 * e] + __uint_as_float(a1[e] & 0xFFFF0000u) * w[8 + 2 * e + 1];
            }
            const float ls = fminf(z, 0.f) - log1pf(__expf(-fabsf(z)));
            cum += ls * (1.0f / 16.0f);
            bcS[c][d] = cum;
        }
        tot[cq][d] = cum;
        __syncthreads();
        float pre = 0.f;
        for (int q = 0; q < cq; ++q) pre += tot[q][d];
        for (int i = 0; i < 16; ++i) {
            const int c = cq * 16 + i;
            const float v = bcS[c][d] + pre;
            bcS[c][d] = v;
            bc[(row0 + c) * 256 + col] = v;
        }
    }
    __syncthreads();
    {
        const int c = tid >> 2, dq = tid & 3;
        const bf16_t* src = proj + (row0 + c) * PP + KB + h * 64 + dq * 16;
#pragma unroll
        for (int k = 0; k < 2; ++k) {
            const u32x4 a = *(const u32x4*)(src + k * 8);
#pragma unroll
            for (int e = 0; e < 4; ++e) {
                const int d = dq * 16 + k * 8 + 2 * e;
                const float k0 = __uint_as_float(a[e] << 16) * __expf(bcS[63][d] - bcS[c][d]);
                const float k1 = __uint_as_float(a[e] & 0xFFFF0000u) * __expf(bcS[63][d + 1] - bcS[c][d + 1]);
                *(unsigned short*)(KDT + tile_el(d, c)) = f2bf(k0);
                *(unsigned short*)(KDT + tile_el(d + 1, c)) = f2bf(k1);
            }
        }
    }
    gla_stage_vt(proj, row0, h, VT);
    __syncthreads();
    float* outp = cstate + (size_t)vb * 8192;
#pragma unroll
    for (int vi = 0; vi < 2; ++vi) {
        const int vt = wid * 2 + vi;
        const bf16x8 a0 = *(const bf16x8*)(VT + tile_off(vt * 16 + fr, fq)), a1 = *(const bf16x8*)(VT + tile_off(vt * 16 + fr, 4 + fq));
#pragma unroll
        for (int dt = 0; dt < 4; ++dt) {
            const bf16x8 b0 = *(const bf16x8*)(KDT + tile_off(dt * 16 + fr, fq)), b1 = *(const bf16x8*)(KDT + tile_off(dt * 16 + fr, 4 + fq));
            f32x4 acc = (f32x4){0.f, 0.f, 0.f, 0.f};
            acc = __builtin_amdgcn_mfma_f32_16x16x32_bf16(a0, b0, acc, 0, 0, 0);
            acc = __builtin_amdgcn_mfma_f32_16x16x32_bf16(a1, b1, acc, 0, 0, 0);
#pragma unroll
            for (int i = 0; i < 4; ++i) outp[(vt * 16 + 4 * fq + i) * 64 + dt * 16 + fr] = acc[i];
        }
    }
}

__device__ __forceinline__ void gla_scan_vb2(int vb, const float* __restrict__ bc, float* __restrict__ cstate) {
    const int idx = vb * 512 + threadIdx.x;
    const int e = idx & 8191, bh = idx >> 13, b = bh >> 2, h = bh & 3, d = e & 63;
    float state = 0.f;
    float* base = cstate + (size_t)bh * 64 * 8192 + e;
    const float* bcp = bc + ((size_t)(b * S + 63)) * 256 + h * 64 + d;
#pragma unroll 1
    for (int n0 = 0; n0 < 64; n0 += 16) {
        float upd[16], dec[16];
#pragma unroll
        for (int i = 0; i < 16; ++i) { upd[i] = base[(size_t)(n0 + i) * 8192]; dec[i] = bcp[(size_t)(n0 + i) * 64 * 256]; }
#pragma unroll
        for (int i = 0; i < 16; ++i) { base[(size_t)(n0 + i) * 8192] = state; state = __expf(dec[i]) * state + upd[i]; }
    }
}

__device__ __forceinline__ void gla_c_unit(int vb, const bf16_t* __restrict__ proj, const float* __restrict__ bc, const float* __restrict__ prev,
                                           const float* __restrict__ norm_g, bf16_t* __restrict__ yb, char* smem) {
    char* QI = smem;
    char* KI = smem + 8192;
    char* VT = smem + 16384;
    char* PT = smem + 32768;
    const int tid = HB_TID, lane = tid & 63, wid = tid >> 6, fr = lane & 15, fq = lane >> 4;
    const int n = vb & 63, h = (vb >> 6) & 3, b = vb >> 8;
    const size_t row0 = (size_t)(b * S + n * 64);
    __syncthreads();
    {
        const int c = tid >> 2, dq = tid & 3;
        const bf16_t* qs = proj + (row0 + c) * PP + QB + h * 64 + dq * 16;
        const bf16_t* ks = proj + (row0 + c) * PP + KB + h * 64 + dq * 16;
        const float* bs = bc + (row0 + c) * 256 + h * 64 + dq * 16;
#pragma unroll
        for (int k = 0; k < 2; ++k) {
            const u32x4 qa = *(const u32x4*)(qs + k * 8), ka = *(const u32x4*)(ks + k * 8);
            const f32x4 b0 = *(const f32x4*)(bs + k * 8), b1 = *(const f32x4*)(bs + k * 8 + 4);
            const float bv[8] = {b0[0], b0[1], b0[2], b0[3], b1[0], b1[1], b1[2], b1[3]};
            u32x4 qo, ko;
#pragma unroll
            for (int e = 0; e < 4; ++e) {
                const float e0 = __expf(bv[2 * e]), e1 = __expf(bv[2 * e + 1]);
                qo[e] = pack_bf16(__uint_as_float(qa[e] << 16) * 0.125f * e0, __uint_as_float(qa[e] & 0xFFFF0000u) * 0.125f * e1);
                ko[e] = pack_bf16(__uint_as_float(ka[e] << 16) / e0, __uint_as_float(ka[e] & 0xFFFF0000u) / e1);
            }
            *(u32x4*)(QI + tile_off(c, dq * 2 + k)) = qo;
            *(u32x4*)(KI + tile_off(c, dq * 2 + k)) = ko;
        }
    }
    gla_stage_vt(proj, row0, h, VT);
    {
        const int v = tid >> 1, half = tid & 1;
        const float* ps = prev + (size_t)vb * 8192 + v * 64 + half * 32;
#pragma unroll
        for (int k = 0; k < 4; ++k) {
            const f32x4 a = *(const f32x4*)(ps + k * 8), c2 = *(const f32x4*)(ps + k * 8 + 4);
            u32x4 o; o[0] = pack_bf16(a[0], a[1]); o[1] = pack_bf16(a[2], a[3]); o[2] = pack_bf16(c2[0], c2[1]); o[3] = pack_bf16(c2[2], c2[3]);
            *(u32x4*)(PT + tile_off(v, half * 4 + k)) = o;
        }
    }
    __syncthreads();
    const bf16x8 qf0 = *(const bf16x8*)(QI + tile_off(wid * 16 + fr, fq)), qf1 = *(const bf16x8*)(QI + tile_off(wid * 16 + fr, 4 + fq));
    bf16x8 pf[2];
    const int c = wid * 16 + fr;
#pragma unroll
    for (int p = 0; p < 2; ++p) {
        u32x4 w;
#pragma unroll
        for (int s = 0; s < 2; ++s) {
            const int row = 32 * p + 8 * (fr >> 2) + 4 * s + (fr & 3);
            const bf16x8 k0 = *(const bf16x8*)(KI + tile_off(row, fq)), k1 = *(const bf16x8*)(KI + tile_off(row, 4 + fq));
            f32x4 a = (f32x4){0.f, 0.f, 0.f, 0.f};
            a = __builtin_amdgcn_mfma_f32_16x16x32_bf16(k0, qf0, a, 0, 0, 0);
            a = __builtin_amdgcn_mfma_f32_16x16x32_bf16(k1, qf1, a, 0, 0, 0);
#pragma unroll
            for (int i = 0; i < 4; ++i) { const int j = 32 * p + 8 * fq + 4 * s + i; if (j > c) a[i] = 0.f; }
            w[2 * s] = pack_bf16(a[0], a[1]); w[2 * s + 1] = pack_bf16(a[2], a[3]);
        }
        pf[p] = __builtin_bit_cast(bf16x8, w);
    }
    f32x4 acc[8];
    float ss = 0.f;
#pragma unroll
    for (int vt = 0; vt < 8; ++vt) {
        f32x4 a = (f32x4){0.f, 0.f, 0.f, 0.f};
        a = __builtin_amdgcn_mfma_f32_16x16x32_bf16(*(const bf16x8*)(VT + tile_off(vt * 16 + fr, fq)), pf[0], a, 0, 0, 0);
        a = __builtin_amdgcn_mfma_f32_16x16x32_bf16(*(const bf16x8*)(VT + tile_off(vt * 16 + fr, 4 + fq)), pf[1], a, 0, 0, 0);
        a = __builtin_amdgcn_mfma_f32_16x16x32_bf16(*(const bf16x8*)(PT + tile_off(vt * 16 + fr, fq)), qf0, a, 0, 0, 0);
        a = __builtin_amdgcn_mfma_f32_16x16x32_bf16(*(const bf16x8*)(PT + tile_off(vt * 16 + fr, 4 + fq)), qf1, a, 0, 0, 0);
        acc[vt] = a;
        ss += a[0] * a[0] + a[1] * a[1] + a[2] * a[2] + a[3] * a[3];
    }
    ss += __shfl_xor(ss, 16); ss += __shfl_xor(ss, 32);
    const float r = rsqrtf(ss * (1.0f / 128.0f) + 1e-6f);
    const size_t row = row0 + c;
#pragma unroll
    for (int vt = 0; vt < 8; ++vt) {
        const int col = h * 128 + vt * 16 + 4 * fq;
        const uint2 rr = *(const uint2*)(proj + row * PP + RB + col);
        const f32x4 g4 = *(const f32x4*)(norm_g + col);
        const float r0 = __uint_as_float(rr.x << 16), r1 = __uint_as_float(rr.x & 0xFFFF0000u), r2 = __uint_as_float(rr.y << 16), r3 = __uint_as_float(rr.y & 0xFFFF0000u);
        f32x4 o;
        o[0] = acc[vt][0] * r * g4[0] * (r0 * sigmoidf_(r0)); o[1] = acc[vt][1] * r * g4[1] * (r1 * sigmoidf_(r1));
        o[2] = acc[vt][2] * r * g4[2] * (r2 * sigmoidf_(r2)); o[3] = acc[vt][3] * r * g4[3] * (r3 * sigmoidf_(r3));
        *(uint2*)(yb + row * 512 + col) = pack4(o);
    }
}

constexpr int SMEM_BYTES = 131072;

__global__ void __launch_bounds__(512, 2) k_fwd(Params p) {
    extern __shared__ __attribute__((aligned(16))) char smem_dyn[];
    char* smem = smem_dyn + 16;
    char* smh = smem + (threadIdx.x >> 8) * 65536;
    if (threadIdx.x == 0) *(uint4*)smem_dyn = make_uint4(0u, 0u, 0u, 0u);
    __syncthreads();
    char* ws = p.ws;
    XcdBarrier bar = xcd_barrier_post((unsigned*)(ws + OFF_BAR), (volatile LAS unsigned*)smem_dyn);
    int* ctrl = (int*)(ws + OFF_CTRL);
    bf16_t* proj = (bf16_t*)(ws + OFF_PROJ);
    float* bc = (float*)(ws + OFF_BC);
    float* cstate = (float*)(ws + OFF_CSTATE);
    bf16_t* mrg = (bf16_t*)(ws + OFF_MRG);
    bf16_t* h2 = (bf16_t*)(ws + OFF_H2);
    bf16_t* hid = (bf16_t*)(ws + OFF_HID);
    bf16_t* Y0 = (bf16_t*)(ws + OFF_Y0);
    bf16_t* Y1 = (bf16_t*)(ws + OFF_Y1);
    bf16_t* ya = (bf16_t*)(ws + OFF_YA);
    bf16_t* yb = (bf16_t*)(ws + OFF_YB);
    bf16_t* kcb = (bf16_t*)(ws + OFF_KCB);
    bf16_t* vcb = (bf16_t*)(ws + OFF_VCB);
    bf16_t* h = (bf16_t*)p.out;
    const int G = gridDim.x;

    ph_prep(p, smh);
    xcd_barrier(bar);
    { g8::StaticOrder S; S.init(T, 3072, G, (int)blockIdx.x); const g8::AddrPlain AD{(const char*)h, (const char*)(ws + OFF_WINT), 2048u, 2048u};
      g8::gemm_phase(smem, S, AD, g8::EpiProj{proj}, 16); }
    xcd_barrier(bar);
    ph_cmp1(proj, ws, smh);
    for (int task = HB_FIRST; task < 1024; task += HB_STEP) vtrans_tile(task, proj, ws, smh);
    for (int vb = HB_FIRST; vb < 1024; vb += HB_STEP) gla_a_unit(vb, proj, p.w_alpha, p.b_alpha, bc, cstate, smh);
    xcd_barrier(bar);
    ph_cmp2(ws, ws, smh);
    for (int vb = blockIdx.x; vb < 256; vb += G) gla_scan_vb2(vb, bc, cstate);
    ph_prep_experts(p, smh);
    xcd_barrier(bar);
    for (int vb = HB_FIRST; vb < 1024; vb += HB_STEP) gla_c_unit(vb, proj, bc, cstate, p.norm_g, yb, smh);
    for (int r = 0; r * G < 512; ++r) {
        const int u = r * G + ((r & 1) ? (G - 1 - (int)blockIdx.x) : (int)blockIdx.x);
        if (u < 512) nsa_unit(u, proj, ws, p.rel_bias, ya, smem);
    }
    xcd_barrier(bar);
    ph_merge(h, (const bf16_t*)(ws + OFF_WINT), ya, yb, (const bf16_t*)(ws + OFF_WAT), (const bf16_t*)(ws + OFF_WBT), mrg, smh);
    xcd_barrier(bar);
    { g8::StaticOrder S; S.init(T, 1024, G, (int)blockIdx.x); const g8::AddrPlain AD{(const char*)mrg, (const char*)(ws + OFF_WOT), 2048u, 2048u};
      g8::gemm_phase(smem, S, AD, g8::EpiResid{p.x, p.out}, 16); }
    xcd_barrier(bar);
    for (int task = HB_FIRST; task < 1024; task += HB_STEP) router_unit(task, p.out, p.g_ffn, (const bf16_t*)(ws + OFF_WRT), p.b_rg, p.b_re, h2, (float*)(ws + OFF_RSTD), (int*)(ws + OFF_LTOK), (float*)(ws + OFF_LW), ctrl, smh);
    xcd_barrier(bar);
    ph_moe1(h2, (const bf16_t*)(ws + OFF_WGT), (const bf16_t*)(ws + OFF_WUT), ctrl, (const int*)(ws + OFF_LTOK), (const float*)(ws + OFF_LW), (const float*)(ws + OFF_RSTD), hid, smh);
    xcd_barrier(bar);
    ph_moe2(hid, (const bf16_t*)(ws + OFF_WDT), ctrl, (const int*)(ws + OFF_LTOK), Y0, smh);
    xcd_barrier(bar);
    { int t_ = threadIdx.x; asm volatile("" : "+v"(t_)); for (int row = blockIdx.x * 8 + (t_ >> 6); row < T; row += G * 8) final_row(row, p.out, Y0, Y1, p.g_final, t_ & 63); }
}

extern "C" void kernel_launch(void* const* d_in, const int* in_sizes, int n_in, void* d_out, int out_size, void* d_ws, size_t ws_size, hipStream_t stream) {
    static int grid = 0;
    constexpr int kDynLds = SMEM_BYTES + 16;
    if (!grid) {
        int dev = 0, cus = 0, per_cu = 0;
        (void)hipGetDevice(&dev);
        (void)hipDeviceGetAttribute(&cus, hipDeviceAttributeMultiprocessorCount, dev);
        (void)hipFuncSetAttribute((const void*)k_fwd, hipFuncAttributeMaxDynamicSharedMemorySize, kDynLds);
        (void)hipOccupancyMaxActiveBlocksPerMultiprocessor(&per_cu, k_fwd, 512, kDynLds);
        if (per_cu > 1) per_cu = 1;
        if (per_cu < 1) per_cu = 1;
        grid = cus * per_cu;
    }
    char* ws = (char*)d_ws;
    (void)hipMemsetAsync(ws + OFF_CTRL, 0, 16384, stream);
    (void)hipMemsetAsync(ws + OFF_BAR, 0, 16384, stream);
    Params p{};
    const float** pf = (const float**)&p;
    for (int i = 0; i < 25; ++i) pf[i] = (const float*)d_in[i];
    p.out = (float*)d_out; p.ws = ws;
    k_fwd<<<grid, 512, kDynLds, stream>>>(p);
}
```

```cpp
#include <hip/hip_runtime.h>
#include <stdint.h>

typedef unsigned short bf16_t;
typedef short bf16x8 __attribute__((ext_vector_type(8)));
typedef float f32x4 __attribute__((ext_vector_type(4)));
typedef unsigned u32x4 __attribute__((ext_vector_type(4)));
__device__ __forceinline__ float bf2f(bf16_t v) { return __uint_as_float(((unsigned)v) << 16); }
__device__ __forceinline__ bf16_t f2bf(float f) { unsigned u = __float_as_uint(f); u += 0x7FFFu + ((u >> 16) & 1u); return (bf16_t)(u >> 16); }
__device__ __forceinline__ unsigned pack_bf16(float lo, float hi) { unsigned r; asm volatile("v_cvt_pk_bf16_f32 %0, %1, %2" : "=v"(r) : "v"(lo), "v"(hi)); return r; }

constexpr int Bn = 4, S = 4096, T = Bn * S, D = 1024, NIN = 4904, PP = 2880;
constexpr int QA = 0, KC = 512, VC = 640, KS = 768, VS = 896, KW = 1024, VW = 1152, GA = 1280, QB = 1304, KB = 1560, VB = 1816, AB = 2328, RB = 2344, MGA = 2856, MGB = 3880;
constexpr int NPROJ = 2856;
constexpr int MSLOT = 36864;

constexpr size_t OFF_CTRL = 0;
constexpr size_t OFF_ROUTE_E = 16384;
constexpr size_t OFF_ROUTE_W = OFF_ROUTE_E + 32768 * 4;
constexpr size_t OFF_SLOT_TOK = OFF_ROUTE_W + 32768 * 4;
constexpr size_t OFF_SLOT_W = OFF_SLOT_TOK + (size_t)MSLOT * 4;
constexpr size_t OFF_BAR = OFF_SLOT_W + (size_t)MSLOT * 4;
constexpr size_t OFF_BIAS1 = OFF_BAR + 16384;
constexpr size_t OFF_RSTD = OFF_BIAS1 + 1024;
constexpr size_t OFF_SLOT_RS = OFF_RSTD + (size_t)T * 4;
constexpr size_t OFF_WRT = OFF_SLOT_RS + (size_t)MSLOT * 4;
static_assert(OFF_WRT + 2 * 48 * 1024 * 2 <= (1u << 20), "ctrl overflow");
constexpr size_t OFF_R1 = 1u << 20;
constexpr size_t SZ_PROJ = (size_t)T * PP * 2;
constexpr size_t OFF_PROJ = OFF_R1;
constexpr size_t OFF_BC = OFF_PROJ + SZ_PROJ;
constexpr size_t OFF_CSTATE = OFF_BC + (size_t)T * 256 * 4;
constexpr size_t OFF_R1_END = OFF_CSTATE + (size_t)1024 * 8192 * 4;
constexpr size_t OFF_MRG = OFF_R1 + (size_t)T * 2048 * 2;
constexpr size_t OFF_H2 = OFF_R1;
constexpr size_t OFF_HID = OFF_H2 + (size_t)T * 1024 * 2;
constexpr size_t OFF_Y0 = OFF_HID + (size_t)2 * T * 256 * 2;
constexpr size_t OFF_Y1 = OFF_Y0 + (size_t)T * 1024 * 2;
static_assert(OFF_MRG + (size_t)T * 1024 * 2 <= OFF_R1_END, "alias overflow");
static_assert(OFF_Y1 + (size_t)T * 1024 * 2 <= OFF_R1_END, "alias overflow");
constexpr size_t OFF_YA = OFF_R1_END;
constexpr size_t OFF_YB = OFF_YA + (size_t)T * 512 * 2;
constexpr size_t OFF_KCB = OFF_YB + (size_t)T * 512 * 2;
constexpr size_t OFF_VCB = OFF_KCB + 8 * 256 * 64 * 2;
constexpr size_t OFF_VCBT = OFF_VCB + 8 * 256 * 64 * 2;
constexpr size_t OFF_HIDC = OFF_VCBT + 8 * 256 * 64 * 2;
constexpr size_t OFF_VST = OFF_HIDC + 2 * 2048 * 128 * 2;
constexpr size_t OFF_VWT = OFF_VST + (size_t)8 * 64 * S * 2;
constexpr size_t OFF_WINT = OFF_VWT + (size_t)8 * 64 * S * 2;
constexpr size_t OFF_CK1T = OFF_WINT + (size_t)NIN * 1024 * 2;
constexpr size_t OFF_CV1T = OFF_CK1T + 128 * 2048 * 2;
constexpr size_t OFF_CK2T = OFF_CV1T + 128 * 2048 * 2;
constexpr size_t OFF_CV2T = OFF_CK2T + 128 * 128 * 2;
constexpr size_t OFF_WAT = OFF_CV2T + 128 * 128 * 2;
constexpr size_t OFF_WBT = OFF_WAT + 1024 * 512 * 2;
constexpr size_t OFF_WOT = OFF_WBT + 1024 * 512 * 2;
constexpr size_t OFF_WGT = OFF_WOT + 1024 * 1024 * 2;
constexpr size_t OFF_WUT = OFF_WGT + (size_t)32 * 256 * 1024 * 2;
constexpr size_t OFF_WDT = OFF_WUT + (size_t)32 * 256 * 1024 * 2;
constexpr size_t OFF_LTOK = OFF_WDT + (size_t)32 * 1024 * 256 * 2;
constexpr size_t OFF_LW = OFF_LTOK + (size_t)32 * 16384 * 4;
constexpr size_t OFF_END = OFF_LW + (size_t)32 * 16384 * 4;
static_assert(OFF_END <= (size_t)256 << 20, "workspace overflow");

#define XB_TMO      128
#define XB_XCNT(j)  (256  + 64 * (j))
#define XB_XSUB(j)  (1280 + 64 * (j))
#define XB_XGEN(j)  (2304 + 64 * (j))
#define XB_TOP      3328
#define XB_TOPGEN   3392
#define XCD_BAR_WORDS 3456
#define XB_SPIN_CAP (1u << 18)
#define LAS __attribute__((address_space(3)))

__device__ __forceinline__ unsigned xb_ld(unsigned* p)              { return __hip_atomic_load(p, __ATOMIC_RELAXED, __HIP_MEMORY_SCOPE_AGENT); }
__device__ __forceinline__ unsigned xb_add(unsigned* p, unsigned v) { return __hip_atomic_fetch_add(p, v, __ATOMIC_RELAXED, __HIP_MEMORY_SCOPE_AGENT); }
__device__ __forceinline__ unsigned xb_xcc_id() { return (unsigned)__builtin_amdgcn_s_getreg((3 << 11) | 20) & 0xFu; }
#define XB_SPIN(cond, bar) do { unsigned _sp = 0; while (cond) { __builtin_amdgcn_s_sleep(1); \
    if ((++_sp & 255u) == 0u) { if (xb_ld(&(bar)[XB_TMO])) break; if (_sp > XB_SPIN_CAP) { atomicAdd(&(bar)[XB_TMO], 1u); break; } } } } while (0)

struct XcdBarrier { unsigned* bar; unsigned x; volatile LAS unsigned* st; };

__device__ __forceinline__ XcdBarrier xcd_barrier_post(unsigned* bar, volatile LAS unsigned* st) {
    XcdBarrier b; b.bar = bar; b.x = xb_xcc_id(); b.st = st;
    if (threadIdx.x == 0) (void)xb_add(&bar[XB_XCNT(b.x)], 1u);
    return b;
}
__device__ __forceinline__ void xcd_barrier_complete(unsigned* bar, unsigned x, unsigned& nloc, unsigned& nx) {
    const unsigned G = gridDim.x * gridDim.y * gridDim.z;
    unsigned sum, cnt, mine, sp = 0u;
    for (;;) {
        sum = 0u; cnt = 0u; mine = 0u;
#pragma unroll
        for (unsigned j = 0; j < 16; ++j) { const unsigned c = xb_ld(&bar[XB_XCNT(j)]); sum += c; cnt += (c > 0u) ? 1u : 0u; mine = (j == x) ? c : mine; }
        if (sum == G) break;
        __builtin_amdgcn_s_sleep(1);
        if ((++sp & 255u) == 0u) { if (xb_ld(&bar[XB_TMO])) break; if (sp > XB_SPIN_CAP) { atomicAdd(&bar[XB_TMO], 1u); break; } }
    }
    nloc = mine > 0u ? mine : 1u; nx = cnt > 0u ? cnt : 1u;
}
__device__ __forceinline__ void xcd_barrier(const XcdBarrier& b) {
    asm volatile("s_waitcnt vmcnt(0)" ::: "memory");
    __syncthreads();
    if (threadIdx.x == 0) {
        unsigned* bar = b.bar;
        __builtin_amdgcn_s_waitcnt(0);
        unsigned nloc = b.st[0], nx = b.st[1];
        if (nloc == 0u) { xcd_barrier_complete(bar, b.x, nloc, nx); b.st[0] = nloc; b.st[1] = nx; }
        const unsigned old = xb_add(&bar[XB_XSUB(b.x)], 1u);
        const unsigned gen = old / nloc;
        if (old + 1u == (gen + 1u) * nloc) {
            __builtin_amdgcn_fence(__ATOMIC_RELEASE, "agent");
            asm volatile("s_waitcnt vmcnt(0)" ::: "memory");
            const unsigned og = xb_add(&bar[XB_TOP], 1u);
            const unsigned tg = og / nx;
            if (og + 1u == (tg + 1u) * nx) xb_add(&bar[XB_TOPGEN], 1u);
            else XB_SPIN(xb_ld(&bar[XB_TOPGEN]) == tg, bar);
            __builtin_amdgcn_fence(__ATOMIC_ACQUIRE, "agent");
            xb_add(&bar[XB_XGEN(b.x)], 1u);
            asm volatile("s_waitcnt vmcnt(0)" ::: "memory");
        } else {
            XB_SPIN(xb_ld(&bar[XB_XGEN(b.x)]) == gen, bar);
            __builtin_amdgcn_fence(__ATOMIC_ACQUIRE, "agent");
            asm volatile("s_waitcnt vmcnt(0)" ::: "memory");
        }
    }
    __syncthreads();
}


#define HB_TID ((int)(threadIdx.x & 255))
#define HB_ID ((int)(threadIdx.x >> 8))
#define HB_FIRST (2 * (int)blockIdx.x + HB_ID)
#define HB_STEP (2 * (int)gridDim.x)
struct Params {
    const float *x, *g_mix, *w_in, *pe_k, *ck1, *ck2, *pe_v, *cv1, *cv2, *rel_bias, *w_alpha, *b_alpha, *norm_g, *w_ba, *w_bb, *w_out, *g_ffn,
                *w_rg, *b_rg, *w_re, *b_re, *w_eg, *w_eu, *w_ed, *g_final;
    float* out; char* ws;
};

__device__ __forceinline__ float wave_max(float v) { for (int o = 32; o > 0; o >>= 1) v = fmaxf(v, __shfl_xor(v, o)); return v; }
__device__ __forceinline__ float wave_sum(float v) { for (int o = 32; o > 0; o >>= 1) v += __shfl_xor(v, o); return v; }
__device__ __forceinline__ void wave_lds_sync() { asm volatile("s_waitcnt lgkmcnt(0)" ::: "memory"); }


__device__ __forceinline__ void rms_h_row(int row, const float* __restrict__ x, const float* __restrict__ g, bf16_t* __restrict__ h, int lane) {
    const float* xr = x + (size_t)row * D + lane * 4;
    f32x4 v[4]; float s = 0.f;
#pragma unroll
    for (int i = 0; i < 4; ++i) { v[i] = *(const f32x4*)(xr + 256 * i); s += v[i][0] * v[i][0] + v[i][1] * v[i][1] + v[i][2] * v[i][2] + v[i][3] * v[i][3]; }
    s = wave_sum(s);
    const float r = rsqrtf(s * (1.0f / D) + 1e-6f);
#pragma unroll
    for (int i = 0; i < 4; ++i) {
        const f32x4 gg = *(const f32x4*)(g + lane * 4 + 256 * i);
        uint2 o; o.x = pack_bf16(v[i][0] * r * gg[0], v[i][1] * r * gg[1]); o.y = pack_bf16(v[i][2] * r * gg[2], v[i][3] * r * gg[3]);
        *(uint2*)(h + (size_t)row * D + lane * 4 + 256 * i) = o;
    }
}
__device__ __forceinline__ void final_row(int row, float* __restrict__ x2out, const bf16_t* __restrict__ Y0, const bf16_t* __restrict__ Y1, const float* __restrict__ g, int lane) {
    float* xr = x2out + (size_t)row * D + lane * 4;
    f32x4 v[4]; float s = 0.f;
#pragma unroll
    for (int i = 0; i < 4; ++i) {
        v[i] = *(const f32x4*)(xr + 256 * i);
        const uint2 a = *(const uint2*)(Y0 + (size_t)row * D + lane * 4 + 256 * i), c = *(const uint2*)(Y1 + (size_t)row * D + lane * 4 + 256 * i);
        v[i][0] += __uint_as_float(a.x << 16) + __uint_as_float(c.x << 16);
        v[i][1] += __uint_as_float(a.x & 0xFFFF0000u) + __uint_as_float(c.x & 0xFFFF0000u);
        v[i][2] += __uint_as_float(a.y << 16) + __uint_as_float(c.y << 16);
        v[i][3] += __uint_as_float(a.y & 0xFFFF0000u) + __uint_as_float(c.y & 0xFFFF0000u);
        s += v[i][0] * v[i][0] + v[i][1] * v[i][1] + v[i][2] * v[i][2] + v[i][3] * v[i][3];
    }
    s = wave_sum(s);
    const float r = rsqrtf(s * (1.0f / D) + 1e-6f);
#pragma unroll
    for (int i = 0; i < 4; ++i) {
        const f32x4 gg = *(const f32x4*)(g + lane * 4 + 256 * i);
        *(f32x4*)(xr + 256 * i) = (f32x4){v[i][0] * r * gg[0], v[i][1] * r * gg[1], v[i][2] * r * gg[2], v[i][3] * r * gg[3]};
    }
}

__device__ __forceinline__ void prep_router_w(const float* __restrict__ w_rg, const float* __restrict__ w_re, bf16_t* __restrict__ WrT) {
    for (int idx = blockIdx.x * 512 + threadIdx.x; idx < 48 * 1024; idx += gridDim.x * 512) {
        const int n = idx >> 10, k = idx & 1023;
        const float w = n < 4 ? w_rg[k * 4 + n] : (n < 36 ? w_re[k * 32 + n - 4] : 0.f);
        const bf16_t hi = f2bf(w);
        WrT[idx] = hi; WrT[48 * 1024 + idx] = f2bf(w - bf2f(hi));
    }
}

__device__ __forceinline__ void router_unit(int task, const float* __restrict__ x2, const float* __restrict__ g, const bf16_t* __restrict__ WrT,
                                            const float* __restrict__ b_rg, const float* __restrict__ b_re, bf16_t* __restrict__ h2, float* __restrict__ rstd_out,
                                            int* __restrict__ ltok, float* __restrict__ lw, int* __restrict__ cnt, char* smem) {
    float (*part)[16][49] = (float (*)[16][49])smem;
    float (*ssp)[16] = (float (*)[16])(smem + 4 * 16 * 49 * 4);
    const int tid = HB_TID, lane = tid & 63, w4 = tid >> 6, fr = lane & 15, fq = lane >> 4, r0 = task * 16;
    const float* xr = x2 + (size_t)(r0 + fr) * D + fq * 8 + w4 * 256;
    bf16_t* hr = h2 + (size_t)(r0 + fr) * D + fq * 8 + w4 * 256;
    const bf16_t* wh = WrT + (size_t)fr * 1024 + fq * 8 + w4 * 256;
    const float* gp = g + fq * 8 + w4 * 256;
    f32x4 acc[3];
#pragma unroll
    for (int nt = 0; nt < 3; ++nt) acc[nt] = (f32x4){0.f, 0.f, 0.f, 0.f};
    float ssq = 0.f;
#pragma unroll 4
    for (int ks = 0; ks < 8; ++ks) {
        const f32x4 x0 = *(const f32x4*)(xr + ks * 32), x1 = *(const f32x4*)(xr + ks * 32 + 4);
        const f32x4 g0 = *(const f32x4*)(gp + ks * 32), g1 = *(const f32x4*)(gp + ks * 32 + 4);
        float xg[8];
#pragma unroll
        for (int e = 0; e < 4; ++e) { xg[e] = x0[e] * g0[e]; xg[4 + e] = x1[e] * g1[e]; ssq += x0[e] * x0[e] + x1[e] * x1[e]; }
        u32x4 hi, lo;
#pragma unroll
        for (int e = 0; e < 4; ++e) {
            hi[e] = pack_bf16(xg[2 * e], xg[2 * e + 1]);
            lo[e] = pack_bf16(xg[2 * e] - __uint_as_float(hi[e] << 16), xg[2 * e + 1] - __uint_as_float(hi[e] & 0xFFFF0000u));
        }
        *(u32x4*)(hr + ks * 32) = hi;
        const bf16x8 ah = __builtin_bit_cast(bf16x8, hi), al = __builtin_bit_cast(bf16x8, lo);
#pragma unroll
        for (int nt = 0; nt < 3; ++nt) {
            const bf16x8 bh = *(const bf16x8*)(wh + (size_t)nt * 16 * 1024 + ks * 32), bl = *(const bf16x8*)(wh + (size_t)(48 + nt * 16) * 1024 + ks * 32);
            acc[nt] = __builtin_amdgcn_mfma_f32_16x16x32_bf16(ah, bh, acc[nt], 0, 0, 0);
            acc[nt] = __builtin_amdgcn_mfma_f32_16x16x32_bf16(al, bh, acc[nt], 0, 0, 0);
            acc[nt] = __builtin_amdgcn_mfma_f32_16x16x32_bf16(ah, bl, acc[nt], 0, 0, 0);
        }
    }
    ssq += __shfl_xor(ssq, 16); ssq += __shfl_xor(ssq, 32);
    __syncthreads();
    if (fq == 0) ssp[w4][fr] = ssq;
#pragma unroll
    for (int nt = 0; nt < 3; ++nt)
#pragma unroll
        for (int i = 0; i < 4; ++i) part[w4][4 * fq + i][nt * 16 + fr] = acc[nt][i];
    __syncthreads();
    if (tid < 16) {
        const int row = r0 + tid;
        const float rsv = rsqrtf((ssp[0][tid] + ssp[1][tid] + ssp[2][tid] + ssp[3][tid]) * (1.0f / D) + 1e-6f);
        rstd_out[row] = rsv;
        float l4[4];
#pragma unroll
        for (int j = 0; j < 4; ++j) l4[j] = (part[0][tid][j] + part[1][tid][j] + part[2][tid][j] + part[3][tid][j]) * rsv + b_rg[j];
        int gs = 0; float mx = l4[0];
#pragma unroll
        for (int j = 1; j < 4; ++j) if (l4[j] > mx) { mx = l4[j]; gs = j; }
        float den = 0.f;
#pragma unroll
        for (int j = 0; j < 4; ++j) den += __expf(l4[j] - mx);
        const float gpb = 1.f / den;
        float v0 = -3e38f, v1 = -3e38f; int i0 = 0, i1 = 0;
        for (int j = 0; j < 8; ++j) {
            const int c = 4 + gs * 8 + j;
            const float l = (part[0][tid][c] + part[1][tid][c] + part[2][tid][c] + part[3][tid][c]) * rsv + b_re[gs * 8 + j];
            if (l > v0) { v1 = v0; i1 = i0; v0 = l; i0 = j; }
            else if (l > v1) { v1 = l; i1 = j; }
        }
        const float e1 = __expf(v1 - v0);
        const float w0 = gpb / (1.f + e1), w1 = gpb * e1 / (1.f + e1);
        const int ea = gs * 8 + i0, eb = gs * 8 + i1;
        const int pa_ = atomicAdd(&cnt[ea * 64], 1), pb_ = atomicAdd(&cnt[eb * 64], 1);
        ltok[ea * 16384 + pa_] = row * 2; lw[ea * 16384 + pa_] = w0;
        ltok[eb * 16384 + pb_] = row * 2 + 1; lw[eb * 16384 + pb_] = w1;
    }
}

__device__ __forceinline__ void transpose_tile(const float* __restrict__ src, int ld_src, int N, bf16_t* __restrict__ dst, int ld_dst, int kt, int nt, char* smem) {
    float (*tl)[65] = (float (*)[65])smem;
    const int tid = HB_TID;
    const int c4 = (tid & 15) * 4, r0 = tid >> 4;
#pragma unroll
    for (int i = 0; i < 4; ++i) {
        const int k = r0 + 16 * i, n = nt * 64 + c4;
        float4 v = make_float4(0.f, 0.f, 0.f, 0.f);
        if (n < N) v = *(const float4*)(src + (size_t)(kt * 64 + k) * ld_src + n);
        tl[k][c4] = v.x; tl[k][c4 + 1] = v.y; tl[k][c4 + 2] = v.z; tl[k][c4 + 3] = v.w;
    }
    __syncthreads();
    const int kc = (tid & 7) * 8, n0 = tid >> 3;
#pragma unroll
    for (int i = 0; i < 2; ++i) {
        const int nl = n0 + 32 * i, n = nt * 64 + nl;
        if (n < N) {
            uint4 o;
            o.x = pack_bf16(tl[kc][nl], tl[kc + 1][nl]); o.y = pack_bf16(tl[kc + 2][nl], tl[kc + 3][nl]);
            o.z = pack_bf16(tl[kc + 4][nl], tl[kc + 5][nl]); o.w = pack_bf16(tl[kc + 6][nl], tl[kc + 7][nl]);
            *(uint4*)(dst + (size_t)n * ld_dst + kt * 64 + kc) = o;
        }
    }
    __syncthreads();
}

__device__ __forceinline__ void ph_prep_experts(const Params& p, char* smem) {
    char* ws = p.ws;
    for (int t = HB_FIRST; t < 6144; t += HB_STEP) {
        const int e = (t & 2047) >> 6, r = t & 63;
        if (t < 2048) transpose_tile(p.w_eg + (size_t)e * 1024 * 256, 256, 256, (bf16_t*)(ws + OFF_WGT) + (size_t)e * 256 * 1024, 1024, r >> 2, r & 3, smem);
        else if (t < 4096) transpose_tile(p.w_eu + (size_t)e * 1024 * 256, 256, 256, (bf16_t*)(ws + OFF_WUT) + (size_t)e * 256 * 1024, 1024, r >> 2, r & 3, smem);
        else transpose_tile(p.w_ed + (size_t)e * 256 * 1024, 1024, 1024, (bf16_t*)(ws + OFF_WDT) + (size_t)e * 1024 * 256, 256, r >> 4, r & 15, smem);
    }
}
__device__ __forceinline__ void ph_prep(const Params& p, char* smem) {
    char* ws = p.ws;
    constexpr int N0 = 16 * 77, N1 = N0 + 64, N2 = N1 + 64, N3 = N2 + 2, N4 = N3 + 2, N5 = N4 + 128, N6 = N5 + 128, N7 = N6 + 256;
    for (int t = HB_FIRST; t < N7; t += HB_STEP) {
        if (t < N0) transpose_tile(p.w_in, NIN, NIN, (bf16_t*)(ws + OFF_WINT), 1024, t / 77, t % 77, smem);
        else if (t < N1) { const int q = t - N0; transpose_tile(p.ck1, 128, 128, (bf16_t*)(ws + OFF_CK1T), 2048, q >> 1, q & 1, smem); }
        else if (t < N2) { const int q = t - N1; transpose_tile(p.cv1, 128, 128, (bf16_t*)(ws + OFF_CV1T), 2048, q >> 1, q & 1, smem); }
        else if (t < N3) { const int q = t - N2; transpose_tile(p.ck2, 64, 64, (bf16_t*)(ws + OFF_CK2T), 128, q, 0, smem); }
        else if (t < N4) { const int q = t - N3; transpose_tile(p.cv2, 64, 64, (bf16_t*)(ws + OFF_CV2T), 128, q, 0, smem); }
        else if (t < N5) { const int q = t - N4; transpose_tile(p.w_ba, 1024, 1024, (bf16_t*)(ws + OFF_WAT), 512, q >> 4, q & 15, smem); }
        else if (t < N6) { const int q = t - N5; transpose_tile(p.w_bb, 1024, 1024, (bf16_t*)(ws + OFF_WBT), 512, q >> 4, q & 15, smem); }
        else { const int q = t - N6; transpose_tile(p.w_out, 1024, 1024, (bf16_t*)(ws + OFF_WOT), 1024, q >> 4, q & 15, smem); }
    }
    for (int t = HB_FIRST; t < 8; t += HB_STEP) {
        const int which = t >> 2, n = (t & 3) * 32 + (HB_TID & 31), ksp = HB_TID >> 5;
        const float* pe = which ? p.pe_v : p.pe_k; const float* w1 = which ? p.cv1 : p.ck1;
        float a = 0.f;
        for (int k = ksp * 256; k < ksp * 256 + 256; ++k) a += pe[k] * w1[(size_t)k * 128 + n];
        float* red = (float*)smem;
        red[HB_TID] = a;
        __syncthreads();
        if (HB_TID < 32) {
            float s = 0.f;
#pragma unroll
            for (int j = 0; j < 8; ++j) s += red[j * 32 + HB_TID];
            ((float*)(ws + OFF_BIAS1))[which * 128 + n] = s;
        }
        __syncthreads();
    }
    prep_router_w(p.w_rg, p.w_re, (bf16_t*)(ws + OFF_WRT));
    for (int row = blockIdx.x * 8 + (threadIdx.x >> 6); row < T; row += gridDim.x * 8) rms_h_row(row, p.x, p.g_mix, (bf16_t*)p.out, threadIdx.x & 63);
}

__device__ __forceinline__ int tile_off(int row, int chunk) { return row * 128 + ((chunk ^ (row & 7)) << 4); }

__device__ __forceinline__ void glds16(const void* g, char* l) {
    __builtin_amdgcn_global_load_lds((const __attribute__((address_space(1))) unsigned*)g, (__attribute__((address_space(3))) unsigned*)l, 16, 0, 0);
}
__device__ __forceinline__ void gemm_kloop(f32x4 (&acc)[4][4], const bf16_t* const (&pa)[4], const bf16_t* const (&pb)[4], int ka, int kb, int nk, char* smem) {
    int tid_ = HB_TID; asm volatile("" : "+v"(tid_));
    const int tid = tid_, lane = tid & 63, wid = tid >> 6, wr = wid >> 1, wc = wid & 1, fr = lane & 15, fq = lane >> 4;
    const int offA = (wr * 64 + fr) * 128, offB = 16384 + (wc * 64 + fr) * 128, x = fr & 7;
    __syncthreads();
#pragma unroll
    for (int i = 0; i < 4; ++i) { glds16(pa[i], smem + i * 4096 + tid * 16); glds16(pb[i], smem + 16384 + i * 4096 + tid * 16); }
    asm volatile("s_waitcnt vmcnt(0)" ::: "memory");
    __syncthreads();
    for (int kt = 0; kt < nk; ++kt) {
        const int cur = kt & 1;
        if (kt + 1 < nk) {
            char* st = smem + (cur ^ 1) * 32768 + tid * 16;
#pragma unroll
            for (int i = 0; i < 4; ++i) { glds16(pa[i] + (size_t)(kt + 1) * ka, st + i * 4096); glds16(pb[i] + (size_t)(kt + 1) * kb, st + 16384 + i * 4096); }
        }
        const char* sa = smem + cur * 32768 + offA;
        const char* sb = smem + cur * 32768 + offB;
#pragma unroll
        for (int ks = 0; ks < 2; ++ks) {
            const int ch = ((ks * 4 + fq) ^ x) << 4;
            bf16x8 af[4], bfr[4];
#pragma unroll
            for (int mi = 0; mi < 4; ++mi) af[mi] = *(const bf16x8*)(sa + mi * 2048 + ch);
#pragma unroll
            for (int ni = 0; ni < 4; ++ni) bfr[ni] = *(const bf16x8*)(sb + ni * 2048 + ch);
#pragma unroll
            for (int mi = 0; mi < 4; ++mi)
#pragma unroll
                for (int ni = 0; ni < 4; ++ni) acc[mi][ni] = __builtin_amdgcn_mfma_f32_16x16x32_bf16(bfr[ni], af[mi], acc[mi][ni], 0, 0, 0);
        }
        asm volatile("s_waitcnt vmcnt(0)" ::: "memory");
        __syncthreads();
    }
}
__device__ __forceinline__ void acc_zero(f32x4 (&acc)[4][4]) {
#pragma unroll
    for (int mi = 0; mi < 4; ++mi)
#pragma unroll
        for (int ni = 0; ni < 4; ++ni) acc[mi][ni] = (f32x4){0.f, 0.f, 0.f, 0.f};
}
#define GEMM_LANE_VARS const int tid = HB_TID, lane = tid & 63, wid = tid >> 6, wr = wid >> 1, wc = wid & 1, fr = lane & 15, fq = lane >> 4, lrow = tid >> 3, lch8 = ((tid & 7) ^ ((tid >> 3) & 7)) * 8; (void)wr; (void)wc; (void)fr; (void)fq; (void)lrow; (void)lch8;
__device__ __forceinline__ uint2 pack4(f32x4 v) { uint2 o; o.x = pack_bf16(v[0], v[1]); o.y = pack_bf16(v[2], v[3]); return o; }
__device__ __forceinline__ float sigmoidf_(float a) { return 1.f / (1.f + __expf(-a)); }

__device__ __forceinline__ void ph_proj(const bf16_t* __restrict__ h, const bf16_t* __restrict__ WinT, bf16_t* __restrict__ proj, char* smem) {
    GEMM_LANE_VARS
    for (int u = HB_FIRST; u < 128 * 23; u += HB_STEP) {
        const int xg = u & 7, v = u >> 3, tn = v % 23, tm = (v / 23) * 8 + xg;
        const bf16_t* pa[4]; const bf16_t* pb[4];
#pragma unroll
        for (int i = 0; i < 4; ++i) { pa[i] = h + (size_t)(tm * 128 + lrow + 32 * i) * 1024 + lch8; pb[i] = WinT + (size_t)(tn * 128 + lrow + 32 * i) * 1024 + lch8; }
        f32x4 acc[4][4]; acc_zero(acc);
        gemm_kloop(acc, pa, pb, 64, 64, 16, smem);
#pragma unroll
        for (int mi = 0; mi < 4; ++mi)
#pragma unroll
            for (int ni = 0; ni < 4; ++ni) {
                const int m = tm * 128 + wr * 64 + mi * 16 + fr, n = tn * 128 + wc * 64 + ni * 16 + 4 * fq;
                if (n < NPROJ) *(uint2*)(proj + (size_t)m * PP + n) = pack4(acc[mi][ni]);
            }
    }
}

__device__ __forceinline__ void ph_cmp1(const bf16_t* __restrict__ proj, const char* ws, char* smem) {
    GEMM_LANE_VARS
    for (int u = HB_FIRST; u < 32; u += HB_STEP) {
        const int which = u >> 4, tm = u & 15;
        const bf16_t* W1T = (const bf16_t*)(ws + (which ? OFF_CV1T : OFF_CK1T));
        const float* bias1 = (const float*)(ws + OFF_BIAS1) + which * 128;
        bf16_t* hid = (bf16_t*)(ws + OFF_HIDC) + (size_t)which * 2048 * 128;
        const int col0 = which ? VC : KC;
        const bf16_t* pa[4]; const bf16_t* pb[4];
#pragma unroll
        for (int i = 0; i < 4; ++i) {
            const int m = tm * 128 + lrow + 32 * i, bg = m >> 8, c = (m & 255) > 254 ? 254 : (m & 255), b = bg >> 1, g = bg & 1;
            pa[i] = proj + (size_t)(b * S + 16 * c) * PP + col0 + g * 64 + lch8;
            pb[i] = W1T + (size_t)(lrow + 32 * i) * 2048 + lch8;
        }
        f32x4 acc[4][4]; acc_zero(acc);
        gemm_kloop(acc, pa, pb, PP, 64, 32, smem);
#pragma unroll
        for (int mi = 0; mi < 4; ++mi)
#pragma unroll
            for (int ni = 0; ni < 4; ++ni) {
                const int m = tm * 128 + wr * 64 + mi * 16 + fr, n = wc * 64 + ni * 16 + 4 * fq;
                f32x4 v = acc[mi][ni];
#pragma unroll
                for (int j = 0; j < 4; ++j) { const float a = v[j] + bias1[n + j]; const float t = 0.7978845608028654f * (a + 0.044715f * a * a * a); v[j] = 0.5f * a * (1.f + tanhf(t)); }
                *(uint2*)(hid + (size_t)m * 128 + n) = pack4(v);
            }
    }
}

__device__ __forceinline__ void ph_cmp2(const char* ws_c, char* ws, char* smem) {
    GEMM_LANE_VARS
    for (int u = HB_FIRST; u < 32; u += HB_STEP) {
        const int which = u >> 4, tm = u & 15;
        const bf16_t* W2T = (const bf16_t*)(ws_c + (which ? OFF_CV2T : OFF_CK2T));
        const bf16_t* hid = (const bf16_t*)(ws_c + OFF_HIDC) + (size_t)which * 2048 * 128;
        const bf16_t* pa[4]; const bf16_t* pb[4];
#pragma unroll
        for (int i = 0; i < 4; ++i) { pa[i] = hid + (size_t)(tm * 128 + lrow + 32 * i) * 128 + lch8; pb[i] = W2T + (size_t)(lrow + 32 * i) * 128 + lch8; }
        f32x4 acc[4][4]; acc_zero(acc);
        gemm_kloop(acc, pa, pb, 64, 64, 2, smem);
        if (wc == 0) {
            bf16_t* outp = (bf16_t*)(ws + (which ? OFF_VCB : OFF_KCB));
            bf16_t* outT = (bf16_t*)(ws + OFF_VCBT);
#pragma unroll
            for (int mi = 0; mi < 4; ++mi)
#pragma unroll
                for (int ni = 0; ni < 4; ++ni) {
                    const int m = tm * 128 + wr * 64 + mi * 16 + fr, n = ni * 16 + 4 * fq, c = m & 255, bg = m >> 8;
                    f32x4 v = acc[mi][ni];
                    if (c == 255) v = (f32x4){0.f, 0.f, 0.f, 0.f};
                    *(uint2*)(outp + (size_t)m * 64 + n) = pack4(v);
                    if (which) {
#pragma unroll
                        for (int j = 0; j < 4; ++j) outT[((size_t)bg * 64 + n + j) * 256 + c] = f2bf(v[j]);
                    }
                }
        }
    }
}

typedef unsigned u32x2 __attribute__((ext_vector_type(2)));
__device__ __forceinline__ u32x2 pack4v(f32x4 v) { u32x2 o; o[0] = pack_bf16(v[0], v[1]); o[1] = pack_bf16(v[2], v[3]); return o; }
__device__ __forceinline__ f32x4 unpack4v(u32x2 o) { return (f32x4){__uint_as_float(o[0] << 16), __uint_as_float(o[0] & 0xFFFF0000u), __uint_as_float(o[1] << 16), __uint_as_float(o[1] & 0xFFFF0000u)}; }
template <int HALF>
__device__ __forceinline__ void merge_half(u32x2 (&tpk)[4][4], int tm, int tn, const bf16_t* __restrict__ h, const bf16_t* __restrict__ WinT, const bf16_t* __restrict__ yy,
                                           const bf16_t* __restrict__ WT, bf16_t* __restrict__ mrg, char* smem) {
    GEMM_LANE_VARS
    u32x2 sg[4][4];
    {
        const bf16_t* pa[4]; const bf16_t* pb[4];
#pragma unroll
        for (int i = 0; i < 4; ++i) { pa[i] = h + (size_t)(tm * 128 + lrow + 32 * i) * 1024 + lch8; pb[i] = WinT + (size_t)((HALF ? MGB : MGA) + tn * 128 + lrow + 32 * i) * 1024 + lch8; }
        f32x4 gg[4][4]; acc_zero(gg);
        gemm_kloop(gg, pa, pb, 64, 64, 16, smem);
#pragma unroll
        for (int mi = 0; mi < 4; ++mi)
#pragma unroll
            for (int ni = 0; ni < 4; ++ni) {
                f32x4 t;
#pragma unroll
                for (int j = 0; j < 4; ++j) t[j] = sigmoidf_(gg[mi][ni][j]);
                sg[mi][ni] = pack4v(t);
            }
    }
    {
        const bf16_t* pa[4]; const bf16_t* pb[4];
#pragma unroll
        for (int i = 0; i < 4; ++i) { pa[i] = yy + (size_t)(tm * 128 + lrow + 32 * i) * 512 + lch8; pb[i] = WT + (size_t)(tn * 128 + lrow + 32 * i) * 512 + lch8; }
        f32x4 acc[4][4]; acc_zero(acc);
        gemm_kloop(acc, pa, pb, 64, 64, 8, smem);
#pragma unroll
        for (int mi = 0; mi < 4; ++mi)
#pragma unroll
            for (int ni = 0; ni < 4; ++ni) {
                f32x4 t = unpack4v(sg[mi][ni]) * acc[mi][ni];
                if (HALF == 0) tpk[mi][ni] = pack4v(t);
                else {
                    t += unpack4v(tpk[mi][ni]);
                    const int m = tm * 128 + wr * 64 + mi * 16 + fr, n = tn * 128 + wc * 64 + ni * 16 + 4 * fq;
                    *(u32x2*)(mrg + (size_t)m * 1024 + n) = pack4v(t);
                }
            }
    }
}
__device__ __forceinline__ void ph_merge(const bf16_t* __restrict__ h, const bf16_t* __restrict__ WinT, const bf16_t* __restrict__ ya, const bf16_t* __restrict__ yb,
                                         const bf16_t* __restrict__ WaT, const bf16_t* __restrict__ WbT, bf16_t* __restrict__ mrg, char* smem) {
    for (int u = HB_FIRST; u < 128 * 8; u += HB_STEP) {
        const int xg = u & 7, v = u >> 3, tn = v & 7, tm = (v >> 3) * 8 + xg;
        u32x2 tpk[4][4];
        merge_half<0>(tpk, tm, tn, h, WinT, ya, WaT, mrg, smem);
        merge_half<1>(tpk, tm, tn, h, WinT, yb, WbT, mrg, smem);
    }
}

__device__ __forceinline__ void ph_outproj(const bf16_t* __restrict__ mrg, const bf16_t* __restrict__ WoT, const float* __restrict__ x, float* __restrict__ x2, char* smem) {
    GEMM_LANE_VARS
    for (int u = HB_FIRST; u < 128 * 8; u += HB_STEP) {
        const int xg = u & 7, v = u >> 3, tn = v & 7, tm = (v >> 3) * 8 + xg;
        const bf16_t* pa[4]; const bf16_t* pb[4];
#pragma unroll
        for (int i = 0; i < 4; ++i) { pa[i] = mrg + (size_t)(tm * 128 + lrow + 32 * i) * 1024 + lch8; pb[i] = WoT + (size_t)(tn * 128 + lrow + 32 * i) * 1024 + lch8; }
        f32x4 acc[4][4]; acc_zero(acc);
        gemm_kloop(acc, pa, pb, 64, 64, 16, smem);
#pragma unroll
        for (int mi = 0; mi < 4; ++mi)
#pragma unroll
            for (int ni = 0; ni < 4; ++ni) {
                const int m = tm * 128 + wr * 64 + mi * 16 + fr, n = tn * 128 + wc * 64 + ni * 16 + 4 * fq;
                const float4 xv = *(const float4*)(x + (size_t)m * 1024 + n);
                *(float4*)(x2 + (size_t)m * 1024 + n) = make_float4(xv.x + acc[mi][ni][0], xv.y + acc[mi][ni][1], xv.z + acc[mi][ni][2], xv.w + acc[mi][ni][3]);
            }
    }
}

__device__ __forceinline__ int moe_tile_decode(const int* __restrict__ cnt, int t, int& e, int& i) {
    int acc = 0; e = 0; i = 0;
    for (int ee = 0; ee < 32; ++ee) { const int nt = (cnt[ee * 64] + 127) >> 7; if (t >= acc && t < acc + nt) { e = ee; i = t - acc; } acc += nt; }
    return acc;
}

__device__ __forceinline__ void ph_moe1(const bf16_t* __restrict__ h2, const bf16_t* __restrict__ WgT, const bf16_t* __restrict__ WuT, const int* __restrict__ cnt,
                                        const int* __restrict__ ltok, const float* __restrict__ lw, const float* __restrict__ rstd, bf16_t* __restrict__ hid, char* smem) {
    GEMM_LANE_VARS
    int e, ti;
    const int nu = moe_tile_decode(cnt, 0, e, ti) * 4;
    for (int u = HB_FIRST; u < nu; u += HB_STEP) {
        const int ft = u & 3;
        (void)moe_tile_decode(cnt, u >> 2, e, ti);
        const int ne = cnt[e * 64];
        const bf16_t* pa[4]; const bf16_t* pb[4];
#pragma unroll
        for (int i = 0; i < 4; ++i) {
            const int rr = lrow + 32 * i, idx = ti * 128 + rr;
            const int tk = idx < ne ? ltok[e * 16384 + idx] : 0;
            pa[i] = h2 + (size_t)(tk >> 1) * 1024 + lch8;
            const int bwc = rr >> 6, bni = (rr >> 4) & 3, bj = rr & 15;
            const int f = ft * 64 + bwc * 32 + (bni >> 1) * 16 + bj;
            pb[i] = ((bni & 1) ? WuT : WgT) + ((size_t)e * 256 + f) * 1024 + lch8;
        }
        f32x4 acc[4][4]; acc_zero(acc);
        gemm_kloop(acc, pa, pb, 64, 64, 16, smem);
#pragma unroll
        for (int mi = 0; mi < 4; ++mi) {
            const int idx = ti * 128 + wr * 64 + mi * 16 + fr;
            if (idx < ne) {
                const int tk = ltok[e * 16384 + idx];
                const float w = lw[e * 16384 + idx], rsv = rstd[tk >> 1];
#pragma unroll
                for (int q = 0; q < 2; ++q) {
                    const int f = ft * 64 + wc * 32 + q * 16 + 4 * fq;
                    f32x4 v;
#pragma unroll
                    for (int j = 0; j < 4; ++j) { const float a = acc[mi][2 * q][j] * rsv, uu = acc[mi][2 * q + 1][j] * rsv; v[j] = a * sigmoidf_(a) * uu * w; }
                    *(uint2*)(hid + (size_t)tk * 256 + f) = pack4(v);
                }
            }
        }
    }
}

__device__ __forceinline__ void ph_moe2(const bf16_t* __restrict__ hid, const bf16_t* __restrict__ WdT, const int* __restrict__ cnt, const int* __restrict__ ltok,
                                        bf16_t* __restrict__ Y, char* smem) {
    GEMM_LANE_VARS
    int e, ti;
    const int nu = moe_tile_decode(cnt, 0, e, ti) * 8;
    for (int u = HB_FIRST; u < nu; u += HB_STEP) {
        const int tn = u & 7;
        (void)moe_tile_decode(cnt, u >> 3, e, ti);
        const int ne = cnt[e * 64];
        const bf16_t* pa[4]; const bf16_t* pb[4];
#pragma unroll
        for (int i = 0; i < 4; ++i) {
            const int idx = ti * 128 + lrow + 32 * i;
            const int tk = idx < ne ? ltok[e * 16384 + idx] : 0;
            pa[i] = hid + (size_t)tk * 256 + lch8;
            pb[i] = WdT + ((size_t)e * 1024 + tn * 128 + lrow + 32 * i) * 256 + lch8;
        }
        f32x4 acc[4][4]; acc_zero(acc);
        gemm_kloop(acc, pa, pb, 64, 64, 4, smem);
#pragma unroll
        for (int mi = 0; mi < 4; ++mi) {
            const int idx = ti * 128 + wr * 64 + mi * 16 + fr;
            if (idx < ne) {
                const int tk = ltok[e * 16384 + idx];
                bf16_t* yr = Y + ((size_t)(tk & 1) * T + (size_t)(tk >> 1)) * 1024 + tn * 128 + wc * 64 + 4 * fq;
#pragma unroll
                for (int ni = 0; ni < 4; ++ni) *(uint2*)(yr + ni * 16) = pack4(acc[mi][ni]);
            }
        }
    }
}

namespace g8 {
constexpr int HTB = 128 * 64 * 2;
__device__ __forceinline__ int lds_byte(int r, int c) { const int st = (r >> 4) * 2 + (c >> 5), rr = r & 15, cc = c & 31, ob = rr * 64 + cc * 2; return st * 1024 + (ob ^ (((ob >> 9) & 1) << 5)); }
__device__ __forceinline__ void stage_rc(int b, int& R, int& C) { const int st = b / 1024, sb = b % 1024, swz = sb ^ (((sb >> 9) & 1) << 5); R = (st >> 1) * 16 + swz / 64; C = (st & 1) * 32 + (swz % 64) / 2; }
__device__ __forceinline__ int perm32(int rho) { const int n = rho >> 4, i = rho & 15; return 8 * (i >> 2) + 4 * n + (i & 3); }
struct Unit { int pm, pn, e; };
struct StaticOrder {
    int nM, nN, nwg, G, c;
    __device__ __forceinline__ void init(int M, int N, int G_, int c_) { nM = M / 256; nN = N / 256; nwg = nM * nN; G = G_; c = c_; }
    __device__ __forceinline__ bool next(int i, Unit& u) const {
        const long L = (long)i * G + c; if (L >= nwg) return false;
        int wgid = (int)L; { const int q = nwg / 8, r = nwg % 8, xcd = wgid % 8, off = wgid / 8; wgid = (xcd < r ? xcd * (q + 1) : r * (q + 1) + (xcd - r) * q) + off; }
        const int nig = 8 * nN, gid = wgid / nig, fm = gid * 8, gsz = (nM - fm) < 8 ? (nM - fm) : 8;
        u.pm = fm + ((wgid % nig) % gsz); u.pn = (wgid % nig) / gsz; u.e = 0; return true;
    }
};
struct AddrPlain {
    const char* A; const char* Bt; unsigned lda2, ldb2;
    __device__ __forceinline__ unsigned a_off(const Unit& u, int row) const { return (unsigned)(u.pm * 256 + row) * lda2; }
    __device__ __forceinline__ unsigned b_off(const Unit& u, int row) const { return (unsigned)(u.pn * 256 + row) * ldb2; }
};

template <class Epi, class Sched, class Addr>
__device__ __forceinline__ void gemm_phase(char* ldsc, const Sched& S, const Addr& AD, const Epi& E, int nt) {
    __attribute__((address_space(3))) unsigned char* lds = (__attribute__((address_space(3))) unsigned char*)ldsc;
    int tid_ = threadIdx.x; asm volatile("" : "+v"(tid_));
    const int tid = tid_, wid = __builtin_amdgcn_readfirstlane(tid >> 6), lane = tid & 63, wr = wid >> 2, wc = wid & 3, fr = lane & 15, fq = lane >> 4;
    int R[2], C2[2], Rb[2];
#pragma unroll
    for (int i = 0; i < 2; ++i) { int r_, c_; stage_rc(tid * 16 + i * 8192, r_, c_); R[i] = r_; C2[i] = c_ * 2; Rb[i] = Epi::PERM ? ((r_ & ~31) + perm32(r_ & 31)) : r_; }
    const unsigned ldsw = (unsigned)wid * 1024u;
    const int aoff = lds_byte(wr * 64 + fr, fq * 8), boff = lds_byte(wc * 32 + fr, fq * 8);
    const char* const Ab = AD.A; const char* const Bb = AD.Bt;
#define G8_SA(b, h) (((b) * 2 + (h)) * HTB)
#define G8_SB(b, h) ((4 + (b) * 2 + (h)) * HTB)
#define G8_SETOFF(va, vb, u) do { _Pragma("unroll") for (int h_ = 0; h_ < 2; ++h_) _Pragma("unroll") for (int i_ = 0; i_ < 2; ++i_) { \
        va[h_][i_] = AD.a_off(u, h_ * 128 + R[i_]) + (unsigned)C2[i_]; vb[h_][i_] = AD.b_off(u, h_ * 128 + Rb[i_]) + (unsigned)C2[i_]; } } while (0)
#define G8_STAGE(bufoff, base, v2, kb) do { _Pragma("unroll") for (int _i = 0; _i < 2; ++_i) \
        __builtin_amdgcn_global_load_lds((const __attribute__((address_space(1))) unsigned*)((base) + (size_t)(v2)[_i] + (size_t)(kb)), (__attribute__((address_space(3))) unsigned*)(lds + (bufoff) + ldsw + _i * 8192), 16, 0, 0); } while (0)
#define G8_LDA(dst, b, h) do { _Pragma("unroll") for (int m = 0; m < 4; ++m) _Pragma("unroll") for (int k = 0; k < 2; ++k) dst[m][k] = *(const __attribute__((address_space(3))) bf16x8*)(lds + G8_SA(b, h) + aoff + m * 2048 + k * 1024); } while (0)
#define G8_LDB(dst, b, h) do { _Pragma("unroll") for (int n = 0; n < 2; ++n) _Pragma("unroll") for (int k = 0; k < 2; ++k) dst[n][k] = *(const __attribute__((address_space(3))) bf16x8*)(lds + G8_SB(b, h) + boff + n * 2048 + k * 1024); } while (0)
#define G8_MMA(ai, bj, At, Bt) do { __builtin_amdgcn_s_setprio(1); _Pragma("unroll") for (int m = 0; m < 4; ++m) _Pragma("unroll") for (int n = 0; n < 2; ++n) _Pragma("unroll") for (int k = 0; k < 2; ++k) \
        acc[ai][bj][m][n] = __builtin_amdgcn_mfma_f32_16x16x32_bf16(Bt[n][k], At[m][k], acc[ai][bj][m][n], 0, 0, 0); __builtin_amdgcn_s_setprio(0); } while (0)
#define G8_WAIT_V(n) asm volatile("s_waitcnt vmcnt(" #n ")" ::: "memory")
#define G8_WAIT_L(n) asm volatile("s_waitcnt lgkmcnt(" #n ")" ::: "memory")
#define G8_BAR __builtin_amdgcn_s_barrier()
#define G8_SCHED __builtin_amdgcn_sched_barrier(0)
    Unit cur, nxt; int ui = 0;
    if (!S.next(0, cur)) return;
    f32x4 acc[2][2][4][2];
#pragma unroll
    for (int a = 0; a < 2; ++a)
#pragma unroll
        for (int b = 0; b < 2; ++b)
#pragma unroll
            for (int m = 0; m < 4; ++m)
#pragma unroll
                for (int n = 0; n < 2; ++n) acc[a][b][m][n] = (f32x4){0.f, 0.f, 0.f, 0.f};
    bf16x8 At[4][2], B0[2][2], B1[2][2];
    unsigned cvA[2][2], cvB[2][2];
    G8_SETOFF(cvA, cvB, cur);
    __syncthreads();
    G8_STAGE(G8_SB(0, 0), Bb, cvB[0], 0); G8_STAGE(G8_SA(0, 0), Ab, cvA[0], 0); G8_STAGE(G8_SB(0, 1), Bb, cvB[1], 0); G8_STAGE(G8_SA(0, 1), Ab, cvA[1], 0);
    if (wr == 1) G8_BAR;
    G8_WAIT_V(4); G8_BAR;
    G8_STAGE(G8_SB(1, 0), Bb, cvB[0], 128); G8_STAGE(G8_SA(1, 0), Ab, cvA[0], 128); G8_STAGE(G8_SB(1, 1), Bb, cvB[1], 128);
    G8_WAIT_V(6); G8_BAR;
    for (;;) {
        const bool has_next = S.next(ui + 1, nxt);
        for (int t = 0; t < nt; t += 2) {
            const bool last = (t == nt - 2);
            unsigned sA[2][2], sB[2][2];
            if (last && has_next) { G8_SETOFF(sA, sB, nxt); }
            else {
#pragma unroll
                for (int h_ = 0; h_ < 2; ++h_)
#pragma unroll
                    for (int i_ = 0; i_ < 2; ++i_) { sA[h_][i_] = cvA[h_][i_]; sB[h_][i_] = cvB[h_][i_]; }
            }
            const int kb1 = (t + 1) * 128, kb2 = last ? 0 : (t + 2) * 128, kb3 = kb2 + 128;
            G8_LDB(B0, 0, 0); G8_SCHED; G8_LDA(At, 0, 0); G8_STAGE(G8_SA(1, 1), Ab, cvA[1], kb1);
            G8_WAIT_L(8); G8_BAR; G8_WAIT_L(0); G8_MMA(0, 0, At, B0); G8_BAR; G8_SCHED;
            G8_LDB(B1, 0, 1); G8_STAGE(G8_SB(0, 0), Bb, sB[0], kb2);
            G8_BAR; G8_WAIT_L(0); G8_MMA(0, 1, At, B1); G8_BAR;
            G8_LDA(At, 0, 1); G8_STAGE(G8_SA(0, 0), Ab, sA[0], kb2);
            G8_BAR; G8_WAIT_L(0); G8_MMA(1, 0, At, B0); G8_BAR; G8_SCHED;
            G8_STAGE(G8_SB(0, 1), Bb, sB[1], kb2);
            G8_WAIT_V(6); G8_BAR; G8_MMA(1, 1, At, B1); G8_BAR;
            G8_LDB(B0, 1, 0); G8_SCHED; G8_LDA(At, 1, 0); G8_STAGE(G8_SA(0, 1), Ab, sA[1], kb2);
            G8_WAIT_L(8); G8_BAR; G8_WAIT_L(0); G8_MMA(0, 0, At, B0); G8_BAR; G8_SCHED;
            G8_LDB(B1, 1, 1); G8_STAGE(G8_SB(1, 0), Bb, sB[0], kb3);
            G8_BAR; G8_WAIT_L(0); G8_MMA(0, 1, At, B1); G8_BAR;
            G8_LDA(At, 1, 1); G8_STAGE(G8_SA(1, 0), Ab, sA[0], kb3);
            G8_BAR; G8_WAIT_L(0); G8_MMA(1, 0, At, B0); G8_BAR; G8_SCHED;
            G8_STAGE(G8_SB(1, 1), Bb, sB[1], kb3);
            G8_WAIT_V(6); G8_BAR; G8_MMA(1, 1, At, B1); G8_BAR;
            if (last && has_next) {
#pragma unroll
                for (int h_ = 0; h_ < 2; ++h_)
#pragma unroll
                    for (int i_ = 0; i_ < 2; ++i_) { cvA[h_][i_] = sA[h_][i_]; cvB[h_][i_] = sB[h_][i_]; }
            }
        }
        E(acc, cur, wr, wc, fr, fq);
        if (!has_next) break;
#pragma unroll
        for (int a = 0; a < 2; ++a)
#pragma unroll
            for (int b = 0; b < 2; ++b)
#pragma unroll
                for (int m = 0; m < 4; ++m)
#pragma unroll
                    for (int n = 0; n < 2; ++n) acc[a][b][m][n] = (f32x4){0.f, 0.f, 0.f, 0.f};
        cur = nxt; ++ui;
    }
    G8_WAIT_V(0);
    if (wr == 0) G8_BAR;
    G8_BAR;
#undef G8_SA
#undef G8_SB
#undef G8_SETOFF
#undef G8_STAGE
#undef G8_LDA
#undef G8_LDB
#undef G8_MMA
#undef G8_WAIT_V
#undef G8_WAIT_L
#undef G8_BAR
#undef G8_SCHED
}

struct EpiProj {
    static constexpr bool PERM = true;
    bf16_t* proj;
    __device__ __forceinline__ void operator()(const f32x4 (&acc)[2][2][4][2], const Unit& u, int wr, int wc, int fr, int fq) const {
#pragma unroll
        for (int ai = 0; ai < 2; ++ai)
#pragma unroll
            for (int m = 0; m < 4; ++m) {
                const int r = u.pm * 256 + ai * 128 + wr * 64 + m * 16 + fr;
#pragma unroll
                for (int bj = 0; bj < 2; ++bj) {
                    const int c = u.pn * 256 + bj * 128 + wc * 32 + 8 * fq;
                    if (c < NPROJ) {
                        u32x4 w; w[0] = pack_bf16(acc[ai][bj][m][0][0], acc[ai][bj][m][0][1]); w[1] = pack_bf16(acc[ai][bj][m][0][2], acc[ai][bj][m][0][3]);
                        w[2] = pack_bf16(acc[ai][bj][m][1][0], acc[ai][bj][m][1][1]); w[3] = pack_bf16(acc[ai][bj][m][1][2], acc[ai][bj][m][1][3]);
                        *(u32x4*)(proj + (size_t)r * PP + c) = w;
                    }
                }
            }
    }
};
struct EpiResid {
    static constexpr bool PERM = false;
    const float* x; float* x2;
    __device__ __forceinline__ void operator()(const f32x4 (&acc)[2][2][4][2], const Unit& u, int wr, int wc, int fr, int fq) const {
#pragma unroll
        for (int ai = 0; ai < 2; ++ai)
#pragma unroll
            for (int m = 0; m < 4; ++m) {
                const int r = u.pm * 256 + ai * 128 + wr * 64 + m * 16 + fr;
#pragma unroll
                for (int bj = 0; bj < 2; ++bj)
#pragma unroll
                    for (int n = 0; n < 2; ++n) {
                        const int c = u.pn * 256 + bj * 128 + wc * 32 + 16 * n + 4 * fq;
                        const f32x4 xv = *(const f32x4*)(x + (size_t)r * 1024 + c);
                        *(f32x4*)(x2 + (size_t)r * 1024 + c) = xv + acc[ai][bj][m][n];
                    }
            }
    }
};
struct OneUnit { Unit u; __device__ __forceinline__ bool next(int i, Unit& o) const { if (i) return false; o = u; return true; } };
template <int OP>
struct EpiMerge {
    static constexpr bool PERM = true;
    bf16_t* dst; const bf16_t* src2;
    __device__ __forceinline__ void operator()(const f32x4 (&acc)[2][2][4][2], const Unit& u, int wr, int wc, int fr, int fq) const {
#pragma unroll
        for (int ai = 0; ai < 2; ++ai)
#pragma unroll
            for (int m = 0; m < 4; ++m) {
                const int r = u.pm * 256 + ai * 128 + wr * 64 + m * 16 + fr;
#pragma unroll
                for (int bj = 0; bj < 2; ++bj) {
                    const size_t o = (size_t)r * 1024 + u.pn * 256 + bj * 128 + wc * 32 + 8 * fq;
                    float v[8];
#pragma unroll
                    for (int j = 0; j < 4; ++j) { v[j] = acc[ai][bj][m][0][j]; v[4 + j] = acc[ai][bj][m][1][j]; }
                    if (OP == 0) {
#pragma unroll
                        for (int j = 0; j < 8; ++j) v[j] = sigmoidf_(v[j]);
                    } else {
                        const u32x4 d = *(const u32x4*)(dst + o);
                        float dv[8];
#pragma unroll
                        for (int j = 0; j < 4; ++j) { dv[2 * j] = __uint_as_float(d[j] << 16); dv[2 * j + 1] = __uint_as_float(d[j] & 0xFFFF0000u); }
                        if (OP == 1) {
#pragma unroll
                            for (int j = 0; j < 8; ++j) v[j] = dv[j] * v[j];
                        } else {
                            const u32x4 s = *(const u32x4*)(src2 + o);
#pragma unroll
                            for (int j = 0; j < 4; ++j) { v[2 * j] = dv[2 * j] + __uint_as_float(s[j] << 16) * v[2 * j]; v[2 * j + 1] = dv[2 * j + 1] + __uint_as_float(s[j] & 0xFFFF0000u) * v[2 * j + 1]; }
                        }
                    }
                    u32x4 w; w[0] = pack_bf16(v[0], v[1]); w[1] = pack_bf16(v[2], v[3]); w[2] = pack_bf16(v[4], v[5]); w[3] = pack_bf16(v[6], v[7]);
                    *(u32x4*)(dst + o) = w;
                }
            }
    }
};
}

constexpr float LOG2E = 1.4426950408889634f;
constexpr float NEGV = -3.0e38f;
constexpr int NSA_TB = 32768;
constexpr int NSA_IMPA = 34816;
constexpr int NSA_IMPB = NSA_IMPA + 16640;
constexpr int NSA_SELM = NSA_IMPB + 16640;

__device__ __forceinline__ int t5_bucket2(int n) {
    if (n < 16) return n;
    const int l = 16 + (int)(logf((float)n / 16.0f) / logf(8.0f) * 16.0f);
    return l < 31 ? l : 31;
}

template <int MODE, bool A0, bool A1>
__device__ __forceinline__ void nsa_tile(const char* Kst, const char* Vst, int j, bool fast, const float* tbias, const bf16x8 (&qf)[2][2], const int (&qidx)[2],
                                         const unsigned long long (&selq)[2], f32x4 (&O)[4][2], float (&m)[2], float (&l)[2], const float (&invl)[2],
                                         char* smem, int fr, int fq, int hp, int wid) {
    const float b127 = tbias[127];
    bf16x8 pf[2][2];
#pragma unroll
    for (int ct = 0; ct < 2; ++ct) {
        if ((ct == 0 && !A0) || (ct == 1 && !A1)) continue;
        f32x4 sacc[2][2];
#pragma unroll
        for (int p = 0; p < 2; ++p)
#pragma unroll
            for (int s = 0; s < 2; ++s) {
                const int row = 32 * p + 16 * s + fr;
                const bf16x8 k0 = *(const bf16x8*)(Kst + tile_off(row, fq)), k1 = *(const bf16x8*)(Kst + tile_off(row, 4 + fq));
                f32x4 a = (f32x4){0.f, 0.f, 0.f, 0.f};
                a = __builtin_amdgcn_mfma_f32_16x16x32_bf16(k0, qf[ct][0], a, 0, 0, 0);
                a = __builtin_amdgcn_mfma_f32_16x16x32_bf16(k1, qf[ct][1], a, 0, 0, 0);
                sacc[p][s] = a;
            }
        const int q = qidx[ct];
        const bool sel = (MODE == 1) ? (((selq[ct] >> j) & 1ull) != 0ull) : true;
        if (MODE != 3) {
            const float mct = m[ct];
            float mloc = NEGV;
            bool exact = __builtin_amdgcn_ballot_w64(mct < -1e29f) != 0ull;
            if (!exact) {
                if (fast) {
                    const float bm = (sel ? b127 : NEGV) - mct;
#pragma unroll
                    for (int p = 0; p < 2; ++p)
#pragma unroll
                        for (int s = 0; s < 2; ++s)
#pragma unroll
                            for (int i = 0; i < 4; ++i) { const float sv = sacc[p][s][i] * (0.125f * LOG2E) + bm; sacc[p][s][i] = sv; mloc = fmaxf(mloc, sv); }
                } else {
#pragma unroll
                    for (int p = 0; p < 2; ++p)
#pragma unroll
                        for (int s = 0; s < 2; ++s)
#pragma unroll
                            for (int i = 0; i < 4; ++i) {
                                const int kk = 64 * j + 32 * p + 8 * fq + 4 * s + i;
                                int rel; bool valid;
                                if (MODE == 0) { rel = q - (16 * kk + 31); valid = rel >= 0; }
                                else if (MODE == 1) { rel = q - kk; valid = (rel >= 0) && sel; }
                                else { rel = q - kk; valid = (rel >= 0) && (rel < 512); }
                                const int rc = rel < 0 ? 0 : (rel > 127 ? 127 : rel);
                                const float sv = valid ? sacc[p][s][i] * (0.125f * LOG2E) + (tbias[rc] - mct) : NEGV;
                                sacc[p][s][i] = sv; mloc = fmaxf(mloc, sv);
                            }
                }
                if (__builtin_amdgcn_ballot_w64(mloc > 8.0f) != 0ull) {
                    exact = true;
#pragma unroll
                    for (int p = 0; p < 2; ++p)
#pragma unroll
                        for (int s = 0; s < 2; ++s)
#pragma unroll
                            for (int i = 0; i < 4; ++i) sacc[p][s][i] += mct;
                    mloc += mct;
                }
            } else {
#pragma unroll
                for (int p = 0; p < 2; ++p)
#pragma unroll
                    for (int s = 0; s < 2; ++s)
#pragma unroll
                        for (int i = 0; i < 4; ++i) {
                            const int kk = 64 * j + 32 * p + 8 * fq + 4 * s + i;
                            int rel; bool valid;
                            if (MODE == 0) { rel = q - (16 * kk + 31); valid = rel >= 0; }
                            else if (MODE == 1) { rel = q - kk; valid = (rel >= 0) && sel; }
                            else { rel = q - kk; valid = (rel >= 0) && (rel < 512); }
                            const int rc = rel < 0 ? 0 : (rel > 127 ? 127 : rel);
                            const float sv = valid ? sacc[p][s][i] * (0.125f * LOG2E) + tbias[rc] : NEGV;
                            sacc[p][s][i] = sv; mloc = fmaxf(mloc, sv);
                        }
            }
            if (exact) {
                mloc = fmaxf(mloc, __shfl_xor(mloc, 16)); mloc = fmaxf(mloc, __shfl_xor(mloc, 32));
                const float mnew = fmaxf(mct, mloc);
                const float alpha = __builtin_amdgcn_exp2f(mct - mnew);
                m[ct] = mnew; l[ct] *= alpha;
#pragma unroll
                for (int dt = 0; dt < 4; ++dt) O[dt][ct] = O[dt][ct] * alpha;
#pragma unroll
                for (int p = 0; p < 2; ++p)
#pragma unroll
                    for (int s = 0; s < 2; ++s)
#pragma unroll
                        for (int i = 0; i < 4; ++i) sacc[p][s][i] -= mnew;
            }
            float psum = 0.f;
#pragma unroll
            for (int p = 0; p < 2; ++p) {
                float pv[8];
#pragma unroll
                for (int s = 0; s < 2; ++s)
#pragma unroll
                    for (int i = 0; i < 4; ++i) { pv[s * 4 + i] = __builtin_amdgcn_exp2f(sacc[p][s][i]); psum += pv[s * 4 + i]; }
                u32x4 w; w[0] = pack_bf16(pv[0], pv[1]); w[1] = pack_bf16(pv[2], pv[3]); w[2] = pack_bf16(pv[4], pv[5]); w[3] = pack_bf16(pv[6], pv[7]);
                pf[ct][p] = __builtin_bit_cast(bf16x8, w);
            }
            l[ct] += psum;
        } else {
#pragma unroll
            for (int p = 0; p < 2; ++p)
#pragma unroll
                for (int s = 0; s < 2; ++s)
#pragma unroll
                    for (int i = 0; i < 4; ++i) {
                        const int kk = 64 * j + 32 * p + 8 * fq + 4 * s + i;
                        const int rel = q - (16 * kk + 31);
                        const int rc = rel < 0 ? 0 : (rel > 127 ? 127 : rel);
                        sacc[p][s][i] = (rel >= 0) ? sacc[p][s][i] * (0.125f * LOG2E) + tbias[rc] : NEGV;
                    }
            float* impA = (float*)(smem + NSA_IMPA); float* impB = (float*)(smem + NSA_IMPB);
            const int ql = wid * 8 + ct * 4 + (fr >> 2);
#pragma unroll
            for (int p = 0; p < 2; ++p)
#pragma unroll
                for (int s = 0; s < 2; ++s) {
                    float p3 = __builtin_amdgcn_exp2f(sacc[p][s][3] - m[ct]) * invl[ct];
                    float pa = __builtin_amdgcn_exp2f(sacc[p][s][0] - m[ct]) * invl[ct] + __builtin_amdgcn_exp2f(sacc[p][s][1] - m[ct]) * invl[ct]
                             + __builtin_amdgcn_exp2f(sacc[p][s][2] - m[ct]) * invl[ct] + p3;
                    pa += __shfl_xor(pa, 1); pa += __shfl_xor(pa, 2);
                    p3 += __shfl_xor(p3, 1); p3 += __shfl_xor(p3, 2);
                    const int jj = 16 * j + 8 * p + 2 * fq + s;
                    if (hp == 0) { impA[ql * 65 + jj] = pa; impB[ql * 65 + jj + 1] = p3; }
                }
        }
    }
    if (MODE != 3) {
#pragma unroll
        for (int dt = 0; dt < 4; ++dt)
#pragma unroll
            for (int p = 0; p < 2; ++p) {
                const bf16x8 vf = *(const bf16x8*)(Vst + tile_off(dt * 16 + fr, p * 4 + fq));
                if (A0) O[dt][0] = __builtin_amdgcn_mfma_f32_16x16x32_bf16(vf, pf[0][p], O[dt][0], 0, 0, 0);
                if (A1) O[dt][1] = __builtin_amdgcn_mfma_f32_16x16x32_bf16(vf, pf[1][p], O[dt][1], 0, 0, 0);
            }
    }
}

template <int MODE>
__device__ __forceinline__ void nsa_branch(const bf16_t* __restrict__ Kb, size_t kstride, const bf16_t* __restrict__ Vb, size_t vstride, int j0, int ntiles, int t0,
                                           const bf16x8 (&qf)[2][2], const int (&qidx)[2], const unsigned long long (&selq)[2], unsigned long long selor0, unsigned long long selor1,
                                           f32x4 (&O)[4][2], float (&m)[2], float (&l)[2], const float (&invl)[2], char* smem) {
    int tid_ = threadIdx.x; asm volatile("" : "+v"(tid_));
    const int tid = tid_, lane = tid & 63, wid = tid >> 6, fr = lane & 15, fq = lane >> 4, hp = fr & 3;
    const int lrow = tid >> 3;
    const float* tbias = (const float*)(smem + NSA_TB) + hp * 128;
    const int sch8 = ((tid & 7) ^ (lrow & 7)) * 8;
    const int krow = 32 * (lrow >> 5) + 8 * ((lrow & 15) >> 2) + 4 * ((lrow >> 4) & 1) + (lrow & 3);
    const bf16_t* kp = Kb + (size_t)krow * kstride + sch8;
    const bf16_t* vp = Vb + (size_t)lrow * vstride + sch8;
    __syncthreads();
    glds16(kp, smem + tid * 16); if (MODE != 3) glds16(vp, smem + 8192 + tid * 16);
    asm volatile("s_waitcnt vmcnt(0)" ::: "memory");
    __syncthreads();
    for (int it = 0; it < ntiles; ++it) {
        const int cur = it & 1, j = j0 + it;
        if (it + 1 < ntiles) {
            char* st = smem + (cur ^ 1) * 16384 + tid * 16;
            glds16(kp + (size_t)(it + 1) * 64 * kstride, st); if (MODE != 3) glds16(vp + (size_t)(it + 1) * 64, st + 8192);
        }
        const char* Kst = smem + cur * 16384;
        const char* Vst = Kst + 8192;
        bool fast;
        if (MODE == 0 || MODE == 3) fast = (t0 - (16 * (64 * j + 63) + 31)) >= 128;
        else if (MODE == 1) fast = (t0 - (64 * j + 63)) >= 128;
        else fast = ((t0 - (64 * j + 63)) >= 128) && ((t0 + 63 - 64 * j) < 512);
        if (MODE == 1) {
            const bool a0 = ((selor0 >> j) & 1ull) != 0ull, a1 = ((selor1 >> j) & 1ull) != 0ull;
            if (a0 && a1) nsa_tile<MODE, true, true>(Kst, Vst, j, fast, tbias, qf, qidx, selq, O, m, l, invl, smem, fr, fq, hp, wid);
            else if (a0) nsa_tile<MODE, true, false>(Kst, Vst, j, fast, tbias, qf, qidx, selq, O, m, l, invl, smem, fr, fq, hp, wid);
            else if (a1) nsa_tile<MODE, false, true>(Kst, Vst, j, fast, tbias, qf, qidx, selq, O, m, l, invl, smem, fr, fq, hp, wid);
        } else {
            nsa_tile<MODE, true, true>(Kst, Vst, j, fast, tbias, qf, qidx, selq, O, m, l, invl, smem, fr, fq, hp, wid);
        }
        asm volatile("s_waitcnt vmcnt(0)" ::: "memory");
        __syncthreads();
    }
}

__device__ __forceinline__ void osum_add(uint2& acc, f32x4 o, float sc) {
    f32x4 v;
    v[0] = __uint_as_float(acc.x << 16) + o[0] * sc; v[1] = __uint_as_float(acc.x & 0xFFFF0000u) + o[1] * sc;
    v[2] = __uint_as_float(acc.y << 16) + o[2] * sc; v[3] = __uint_as_float(acc.y & 0xFFFF0000u) + o[3] * sc;
    acc = pack4(v);
}
__device__ __forceinline__ float nsa_gate(const bf16_t* __restrict__ pb, int q, int br, int head) { return sigmoidf_(bf2f(pb[(size_t)q * PP + GA + br * 8 + head])); }

__device__ __forceinline__ void nsa_unit(int u, const bf16_t* __restrict__ proj, const char* __restrict__ ws, const float* __restrict__ rel_bias, bf16_t* __restrict__ ya, char* smem) {
    int tid_ = threadIdx.x; asm volatile("" : "+v"(tid_));
    const int tid = tid_, lane = tid & 63, wid = tid >> 6, fr = lane & 15, fq = lane >> 4, hp = fr & 3;
    const int bg = u & 7, qb = 63 - (u >> 3), b = bg >> 1, g = bg & 1, t0 = qb * 64, tb = qb;
    const bf16_t* kcb = (const bf16_t*)(ws + OFF_KCB) + (size_t)bg * 256 * 64;
    const bf16_t* vcbT = (const bf16_t*)(ws + OFF_VCBT) + (size_t)bg * 64 * 256;
    const bf16_t* VsT = (const bf16_t*)(ws + OFF_VST) + (size_t)bg * 64 * S;
    const bf16_t* VwT = (const bf16_t*)(ws + OFF_VWT) + (size_t)bg * 64 * S;
    const bf16_t* pb = proj + (size_t)b * S * PP;
    __syncthreads();
    {
        float* tbl = (float*)(smem + NSA_TB);
        { const int e = tid, h4 = e >> 7, n = e & 127; tbl[e] = rel_bias[t5_bucket2(n) * 8 + g * 4 + h4] * LOG2E; }
        float* imp = (float*)(smem + NSA_IMPA);
        for (int e = tid; e < 2 * 4160; e += 512) imp[e] = 0.f;
    }
    int qidx[2]; bf16x8 qf[2][2];
    const int head = g * 4 + hp;
#pragma unroll
    for (int ct = 0; ct < 2; ++ct) {
        qidx[ct] = t0 + wid * 8 + ct * 4 + (fr >> 2);
        const bf16_t* qr = pb + (size_t)qidx[ct] * PP;
        qf[ct][0] = *(const bf16x8*)(qr + QA + head * 64 + fq * 8);
        qf[ct][1] = *(const bf16x8*)(qr + QA + head * 64 + 32 + fq * 8);
    }
    uint2 osum[4][2];
#pragma unroll
    for (int dt = 0; dt < 4; ++dt)
#pragma unroll
        for (int ct = 0; ct < 2; ++ct) osum[dt][ct] = make_uint2(0u, 0u);
    unsigned long long selq[2] = {0ull, 0ull};
    float invl0[2] = {0.f, 0.f};
    const int ntc = (((t0 + 32) >> 4) + 1 + 63) >> 6;
    float mC[2], invC[2];
    {
        f32x4 O[4][2]; float m[2] = {-1e30f, -1e30f}, l[2] = {0.f, 0.f};
#pragma unroll
        for (int dt = 0; dt < 4; ++dt)
#pragma unroll
            for (int ct = 0; ct < 2; ++ct) O[dt][ct] = (f32x4){0.f, 0.f, 0.f, 0.f};
        nsa_branch<0>(kcb, 64, vcbT, 256, 0, ntc, t0, qf, qidx, selq, 0ull, 0ull, O, m, l, invl0, smem);
#pragma unroll
        for (int ct = 0; ct < 2; ++ct) {
            float lt = l[ct]; lt += __shfl_xor(lt, 16); lt += __shfl_xor(lt, 32);
            invC[ct] = lt > 0.f ? 1.f / lt : 0.f; mC[ct] = m[ct];
#pragma unroll
            for (int dt = 0; dt < 4; ++dt) osum_add(osum[dt][ct], O[dt][ct], nsa_gate(pb, qidx[ct], 0, head) * invC[ct]);
        }
        nsa_branch<3>(kcb, 64, vcbT, 256, 0, ntc, t0, qf, qidx, selq, 0ull, 0ull, O, mC, l, invC, smem);
    }
    {
        const float* impA = (const float*)(smem + NSA_IMPA); const float* impB = (const float*)(smem + NSA_IMPB);
        unsigned long long* selm = (unsigned long long*)(smem + NSA_SELM);
#pragma unroll 1
        for (int qq = 0; qq < 8; ++qq) {
            const int ql = wid * 8 + qq;
            const float val = impA[ql * 65 + lane] + impB[ql * 65 + lane];
            const bool forced = (lane == 0) || (lane == tb) || (lane == tb - 1);
            unsigned key = forced ? 0xFFFFFFC0u : (lane > tb ? 0u : (__float_as_uint(val) & 0xFFFFFFC0u));
            key |= (unsigned)(63 - lane);
            int rank = 0;
#pragma unroll
            for (int jp = 0; jp < 64; ++jp) rank += ((unsigned)__builtin_amdgcn_readlane((int)key, jp) > key) ? 1 : 0;
            const unsigned long long msk = __ballot(rank < 16);
            if (lane == 0) selm[ql] = msk;
        }
        wave_lds_sync();
        unsigned long long so0 = 0ull, so1 = 0ull;
#pragma unroll
        for (int qq = 0; qq < 4; ++qq) { so0 |= selm[wid * 8 + qq]; so1 |= selm[wid * 8 + 4 + qq]; }
        const unsigned long long selor0 = ((unsigned long long)(unsigned)__builtin_amdgcn_readfirstlane((int)(unsigned)(so0 >> 32)) << 32) | (unsigned)__builtin_amdgcn_readfirstlane((int)(unsigned)so0);
        const unsigned long long selor1 = ((unsigned long long)(unsigned)__builtin_amdgcn_readfirstlane((int)(unsigned)(so1 >> 32)) << 32) | (unsigned)__builtin_amdgcn_readfirstlane((int)(unsigned)so1);
        selq[0] = selm[wid * 8 + (fr >> 2)]; selq[1] = selm[wid * 8 + 4 + (fr >> 2)];
        {
            f32x4 O[4][2]; float m[2] = {-1e30f, -1e30f}, l[2] = {0.f, 0.f};
#pragma unroll
            for (int dt = 0; dt < 4; ++dt)
#pragma unroll
                for (int ct = 0; ct < 2; ++ct) O[dt][ct] = (f32x4){0.f, 0.f, 0.f, 0.f};
            nsa_branch<1>(pb + KS + g * 64, PP, VsT, S, 0, tb + 1, t0, qf, qidx, selq, selor0, selor1, O, m, l, invl0, smem);
#pragma unroll
            for (int ct = 0; ct < 2; ++ct) {
                float lt = l[ct]; lt += __shfl_xor(lt, 16); lt += __shfl_xor(lt, 32);
                const float inv = lt > 0.f ? 1.f / lt : 0.f;
#pragma unroll
                for (int dt = 0; dt < 4; ++dt) osum_add(osum[dt][ct], O[dt][ct], nsa_gate(pb, qidx[ct], 1, head) * inv);
            }
        }
    }
    {
        f32x4 O[4][2]; float m[2] = {-1e30f, -1e30f}, l[2] = {0.f, 0.f};
#pragma unroll
        for (int dt = 0; dt < 4; ++dt)
#pragma unroll
            for (int ct = 0; ct < 2; ++ct) O[dt][ct] = (f32x4){0.f, 0.f, 0.f, 0.f};
        const int jw0 = (t0 - 511 < 0 ? 0 : t0 - 511) >> 6;
        nsa_branch<2>(pb + (size_t)jw0 * 64 * PP + KW + g * 64, PP, VwT + jw0 * 64, S, jw0, tb - jw0 + 1, t0, qf, qidx, selq, 0ull, 0ull, O, m, l, invl0, smem);
#pragma unroll
        for (int ct = 0; ct < 2; ++ct) {
            float lt = l[ct]; lt += __shfl_xor(lt, 16); lt += __shfl_xor(lt, 32);
            const float inv = lt > 0.f ? 1.f / lt : 0.f;
#pragma unroll
            for (int dt = 0; dt < 4; ++dt) osum_add(osum[dt][ct], O[dt][ct], nsa_gate(pb, qidx[ct], 2, head) * inv);
        }
    }
#pragma unroll
    for (int ct = 0; ct < 2; ++ct) {
        bf16_t* yr = ya + (size_t)(b * S + qidx[ct]) * 512 + head * 64 + 4 * fq;
#pragma unroll
        for (int dt = 0; dt < 4; ++dt) *(uint2*)(yr + dt * 16) = osum[dt][ct];
    }
}

__device__ __forceinline__ void vtrans_tile(int task, const bf16_t* __restrict__ proj, char* ws, char* smem) {
    unsigned short (*tl)[66] = (unsigned short (*)[66])smem;
    const int tid = HB_TID, which = task >> 9, bg = (task >> 6) & 7, tt = task & 63, b = bg >> 1, g = bg & 1;
    const int r = tid >> 2, q4 = tid & 3;
    const bf16_t* src = proj + (size_t)(b * S + tt * 64 + r) * PP + (which ? VW : VS) + g * 64 + q4 * 16;
    const uint4 a0 = *(const uint4*)src, a1 = *(const uint4*)(src + 8);
    unsigned* trow = (unsigned*)&tl[r][q4 * 16];
    trow[0] = a0.x; trow[1] = a0.y; trow[2] = a0.z; trow[3] = a0.w; trow[4] = a1.x; trow[5] = a1.y; trow[6] = a1.z; trow[7] = a1.w;
    __syncthreads();
    bf16_t* dst = (bf16_t*)(ws + (which ? OFF_VWT : OFF_VST)) + ((size_t)bg * 64 + r) * S + tt * 64 + q4 * 16;
    unsigned o[8];
#pragma unroll
    for (int k = 0; k < 8; ++k) o[k] = (unsigned)tl[q4 * 16 + 2 * k][r] | ((unsigned)tl[q4 * 16 + 2 * k + 1][r] << 16);
    *(uint4*)dst = make_uint4(o[0], o[1], o[2], o[3]);
    *(uint4*)(dst + 8) = make_uint4(o[4], o[5], o[6], o[7]);
    __syncthreads();
}

__device__ __forceinline__ int tile_el(int row, int col) { return tile_off(row, col >> 3) + ((col & 7) << 1); }

__device__ __forceinline__ void gla_stage_vt(const bf16_t* __restrict__ proj, size_t row0, int h, char* vt_base) {
    const int tid = HB_TID, c = tid >> 2, vq = tid & 3;
    const bf16_t* src = proj + (row0 + c) * PP + VB + h * 128 + vq * 32;
#pragma unroll
    for (int k = 0; k < 4; ++k) {
        const u32x4 a = *(const u32x4*)(src + k * 8);
#pragma unroll
        for (int e = 0; e < 4; ++e) {
            const int v = vq * 32 + k * 8 + 2 * e;
            *(unsigned short*)(vt_base + tile_el(v, c)) = (unsigned short)(a[e] & 0xFFFFu);
            *(unsigned short*)(vt_base + tile_el(v + 1, c)) = (unsigned short)(a[e] >> 16);
        }
    }
}

__device__ __forceinline__ void gla_a_unit(int vb, const bf16_t* __restrict__ proj, const float* __restrict__ w_alpha, const float* __restrict__ b_alpha,
                                           float* __restrict__ bc, float* __restrict__ cstate, char* smem) {
    float (*bcS)[64] = (float (*)[64])smem;
    float (*tot)[64] = (float (*)[64])(smem + 16384);
    char* KDT = smem + 17408;
    char* VT = smem + 17408 + 8192;
    const int tid = HB_TID, lane = tid & 63, wid = tid >> 6, fr = lane & 15, fq = lane >> 4;
    const int n = vb & 63, h = (vb >> 6) & 3, b = vb >> 8;
    const size_t row0 = (size_t)(b * S + n * 64);
    __syncthreads();
    {
        const int d = tid & 63, cq = tid >> 6, col = h * 64 + d;
        float w[16];
#pragma unroll
        for (int r = 0; r < 16; ++r) w[r] = w_alpha[r * 256 + col];
        const float bias = b_alpha[col];
        float cum = 0.f;
        for (int i = 0; i < 16; ++i) {
            const int c = cq * 16 + i;
            const u32x4 a0 = *(const u32x4*)(proj + (row0 + c) * PP + AB), a1 = *(const u32x4*)(proj + (row0 + c) * PP + AB + 8);
            float z = bias;
#pragma unroll
            for (int e = 0; e < 4; ++e) {
                z += __uint_as_float(a0[e] << 16) * w[2 * e] + __uint_as_float(a0[e] & 0xFFFF0000u) * w[2 * e + 1];
                z += __uint_as_float(a1[e] << 16) * w[8 + 2 * e] + __uint_as_float(a1[e] & 0xFFFF0000u) * w[8 + 2 * e + 1];
            }
            const float ls = fminf(z, 0.f) - log1pf(__expf(-fabsf(z)));
            cum += ls * (1.0f / 16.0f);
            bcS[c][d] = cum;
        }
        tot[cq][d] = cum;
        __syncthreads();
        float pre = 0.f;
        for (int q = 0; q < cq; ++q) pre += tot[q][d];
        for (int i = 0; i < 16; ++i) {
            const int c = cq * 16 + i;
            const float v = bcS[c][d] + pre;
            bcS[c][d] = v;
            bc[(row0 + c) * 256 + col] = v;
        }
    }
    __syncthreads();
    {
        const int c = tid >> 2, dq = tid & 3;
        const bf16_t* src = proj + (row0 + c) * PP + KB + h * 64 + dq * 16;
#pragma unroll
        for (int k = 0; k < 2; ++k) {
            const u32x4 a = *(const u32x4*)(src + k * 8);
#pragma unroll
            for (int e = 0; e < 4; ++e) {
                const int d = dq * 16 + k * 8 + 2 * e;
                const float k0 = __uint_as_float(a[e] << 16) * __expf(bcS[63][d] - bcS[c][d]);
                const float k1 = __uint_as_float(a[e] & 0xFFFF0000u) * __expf(bcS[63][d + 1] - bcS[c][d + 1]);
                *(unsigned short*)(KDT + tile_el(d, c)) = f2bf(k0);
                *(unsigned short*)(KDT + tile_el(d + 1, c)) = f2bf(k1);
            }
        }
    }
    gla_stage_vt(proj, row0, h, VT);
    __syncthreads();
    float* outp = cstate + (size_t)vb * 8192;
#pragma unroll
    for (int vi = 0; vi < 2; ++vi) {
        const int vt = wid * 2 + vi;
        const bf16x8 a0 = *(const bf16x8*)(VT + tile_off(vt * 16 + fr, fq)), a1 = *(const bf16x8*)(VT + tile_off(vt * 16 + fr, 4 + fq));
#pragma unroll
        for (int dt = 0; dt < 4; ++dt) {
            const bf16x8 b0 = *(const bf16x8*)(KDT + tile_off(dt * 16 + fr, fq)), b1 = *(const bf16x8*)(KDT + tile_off(dt * 16 + fr, 4 + fq));
            f32x4 acc = (f32x4){0.f, 0.f, 0.f, 0.f};
            acc = __builtin_amdgcn_mfma_f32_16x16x32_bf16(a0, b0, acc, 0, 0, 0);
            acc = __builtin_amdgcn_mfma_f32_16x16x32_bf16(a1, b1, acc, 0, 0, 0);
#pragma unroll
            for (int i = 0; i < 4; ++i) outp[(vt * 16 + 4 * fq + i) * 64 + dt * 16 + fr] = acc[i];
        }
    }
}

__device__ __forceinline__ void gla_scan_vb2(int vb, const float* __restrict__ bc, float* __restrict__ cstate) {
    const int idx = vb * 512 + threadIdx.x;
    const int e = idx & 8191, bh = idx >> 13, b = bh >> 2, h = bh & 3, d = e & 63;
    float state = 0.f;
    float* base = cstate + (size_t)bh * 64 * 8192 + e;
    const float* bcp = bc + ((size_t)(b * S + 63)) * 256 + h * 64 + d;
#pragma unroll 1
    for (int n0 = 0; n0 < 64; n0 += 16) {
        float upd[16], dec[16];
#pragma unroll
        for (int i = 0; i < 16; ++i) { upd[i] = base[(size_t)(n0 + i) * 8192]; dec[i] = bcp[(size_t)(n0 + i) * 64 * 256]; }
#pragma unroll
        for (int i = 0; i < 16; ++i) { base[(size_t)(n0 + i) * 8192] = state; state = __expf(dec[i]) * state + upd[i]; }
    }
}

__device__ __forceinline__ void gla_c_unit(int vb, const bf16_t* __restrict__ proj, const float* __restrict__ bc, const float* __restrict__ prev,
                                           const float* __restrict__ norm_g, bf16_t* __restrict__ yb, char* smem) {
    char* QI = smem;
    char* KI = smem + 8192;
    char* VT = smem + 16384;
    char* PT = smem + 32768;
    const int tid = HB_TID, lane = tid & 63, wid = tid >> 6, fr = lane & 15, fq = lane >> 4;
    const int n = vb & 63, h = (vb >> 6) & 3, b = vb >> 8;
    const size_t row0 = (size_t)(b * S + n * 64);
    __syncthreads();
    {
        const int c = tid >> 2, dq = tid & 3;
        const bf16_t* qs = proj + (row0 + c) * PP + QB + h * 64 + dq * 16;
        const bf16_t* ks = proj + (row0 + c) * PP + KB + h * 64 + dq * 16;
        const float* bs = bc + (row0 + c) * 256 + h * 64 + dq * 16;
#pragma unroll
        for (int k = 0; k < 2; ++k) {
            const u32x4 qa = *(const u32x4*)(qs + k * 8), ka = *(const u32x4*)(ks + k * 8);
            const f32x4 b0 = *(const f32x4*)(bs + k * 8), b1 = *(const f32x4*)(bs + k * 8 + 4);
            const float bv[8] = {b0[0], b0[1], b0[2], b0[3], b1[0], b1[1], b1[2], b1[3]};
            u32x4 qo, ko;
#pragma unroll
            for (int e = 0; e < 4; ++e) {
                const float e0 = __expf(bv[2 * e]), e1 = __expf(bv[2 * e + 1]);
                qo[e] = pack_bf16(__uint_as_float(qa[e] << 16) * 0.125f * e0, __uint_as_float(qa[e] & 0xFFFF0000u) * 0.125f * e1);
                ko[e] = pack_bf16(__uint_as_float(ka[e] << 16) / e0, __uint_as_float(ka[e] & 0xFFFF0000u) / e1);
            }
            *(u32x4*)(QI + tile_off(c, dq * 2 + k)) = qo;
            *(u32x4*)(KI + tile_off(c, dq * 2 + k)) = ko;
        }
    }
    gla_stage_vt(proj, row0, h, VT);
    {
        const int v = tid >> 1, half = tid & 1;
        const float* ps = prev + (size_t)vb * 8192 + v * 64 + half * 32;
#pragma unroll
        for (int k = 0; k < 4; ++k) {
            const f32x4 a = *(const f32x4*)(ps + k * 8), c2 = *(const f32x4*)(ps + k * 8 + 4);
            u32x4 o; o[0] = pack_bf16(a[0], a[1]); o[1] = pack_bf16(a[2], a[3]); o[2] = pack_bf16(c2[0], c2[1]); o[3] = pack_bf16(c2[2], c2[3]);
            *(u32x4*)(PT + tile_off(v, half * 4 + k)) = o;
        }
    }
    __syncthreads();
    const bf16x8 qf0 = *(const bf16x8*)(QI + tile_off(wid * 16 + fr, fq)), qf1 = *(const bf16x8*)(QI + tile_off(wid * 16 + fr, 4 + fq));
    bf16x8 pf[2];
    const int c = wid * 16 + fr;
#pragma unroll
    for (int p = 0; p < 2; ++p) {
        u32x4 w;
#pragma unroll
        for (int s = 0; s < 2; ++s) {
            const int row = 32 * p + 8 * (fr >> 2) + 4 * s + (fr & 3);
            const bf16x8 k0 = *(const bf16x8*)(KI + tile_off(row, fq)), k1 = *(const bf16x8*)(KI + tile_off(row, 4 + fq));
            f32x4 a = (f32x4){0.f, 0.f, 0.f, 0.f};
            a = __builtin_amdgcn_mfma_f32_16x16x32_bf16(k0, qf0, a, 0, 0, 0);
            a = __builtin_amdgcn_mfma_f32_16x16x32_bf16(k1, qf1, a, 0, 0, 0);
#pragma unroll
            for (int i = 0; i < 4; ++i) { const int j = 32 * p + 8 * fq + 4 * s + i; if (j > c) a[i] = 0.f; }
            w[2 * s] = pack_bf16(a[0], a[1]); w[2 * s + 1] = pack_bf16(a[2], a[3]);
        }
        pf[p] = __builtin_bit_cast(bf16x8, w);
    }
    f32x4 acc[8];
    float ss = 0.f;
#pragma unroll
    for (int vt = 0; vt < 8; ++vt) {
        f32x4 a = (f32x4){0.f, 0.f, 0.f, 0.f};
        a = __builtin_amdgcn_mfma_f32_16x16x32_bf16(*(const bf16x8*)(VT + tile_off(vt * 16 + fr, fq)), pf[0], a, 0, 0, 0);
        a = __builtin_amdgcn_mfma_f32_16x16x32_bf16(*(const bf16x8*)(VT + tile_off(vt * 16 + fr, 4 + fq)), pf[1], a, 0, 0, 0);
        a = __builtin_amdgcn_mfma_f32_16x16x32_bf16(*(const bf16x8*)(PT + tile_off(vt * 16 + fr, fq)), qf0, a, 0, 0, 0);
        a = __builtin_amdgcn_mfma_f32_16x16x32_bf16(*(const bf16x8*)(PT + tile_off(vt * 16 + fr, 4 + fq)), qf1, a, 0, 0, 0);
        acc[vt] = a;
        ss += a[0] * a[0] + a[1] * a[1] + a[2] * a[2] + a[3] * a[3];
    }
    ss += __shfl_xor(ss, 16); ss += __shfl_xor(ss, 32);
    const float r = rsqrtf(ss * (1.0f / 128.0f) + 1e-6f);
    const size_t row = row0 + c;
#pragma unroll
    for (int vt = 0; vt < 8; ++vt) {
        const int col = h * 128 + vt * 16 + 4 * fq;
        const uint2 rr = *(const uint2*)(proj + row * PP + RB + col);
        const f32x4 g4 = *(const f32x4*)(norm_g + col);
        const float r0 = __uint_as_float(rr.x << 16), r1 = __uint_as_float(rr.x & 0xFFFF0000u), r2 = __uint_as_float(rr.y << 16), r3 = __uint_as_float(rr.y & 0xFFFF0000u);
        f32x4 o;
        o[0] = acc[vt][0] * r * g4[0] * (r0 * sigmoidf_(r0)); o[1] = acc[vt][1] * r * g4[1] * (r1 * sigmoidf_(r1));
        o[2] = acc[vt][2] * r * g4[2] * (r2 * sigmoidf_(r2)); o[3] = acc[vt][3] * r * g4[3] * (r3 * sigmoidf_(r3));
        *(uint2*)(yb + row * 512 + col) = pack4(o);
    }
}

constexpr int SMEM_BYTES = 131072;

__global__ void __launch_bounds__(512, 2) k_fwd(Params p) {
    extern __shared__ __attribute__((aligned(16))) char smem_dyn[];
    char* smem = smem_dyn + 16;
    char* smh = smem + (threadIdx.x >> 8) * 65536;
    if (threadIdx.x == 0) *(uint4*)smem_dyn = make_uint4(0u, 0u, 0u, 0u);
    __syncthreads();
    char* ws = p.ws;
    XcdBarrier bar = xcd_barrier_post((unsigned*)(ws + OFF_BAR), (volatile LAS unsigned*)smem_dyn);
    int* ctrl = (int*)(ws + OFF_CTRL);
    bf16_t* proj = (bf16_t*)(ws + OFF_PROJ);
    float* bc = (float*)(ws + OFF_BC);
    float* cstate = (float*)(ws + OFF_CSTATE);
    bf16_t* mrg = (bf16_t*)(ws + OFF_MRG);
    bf16_t* h2 = (bf16_t*)(ws + OFF_H2);
    bf16_t* hid = (bf16_t*)(ws + OFF_HID);
    bf16_t* Y0 = (bf16_t*)(ws + OFF_Y0);
    bf16_t* Y1 = (bf16_t*)(ws + OFF_Y1);
    bf16_t* ya = (bf16_t*)(ws + OFF_YA);
    bf16_t* yb = (bf16_t*)(ws + OFF_YB);
    bf16_t* kcb = (bf16_t*)(ws + OFF_KCB);
    bf16_t* vcb = (bf16_t*)(ws + OFF_VCB);
    bf16_t* h = (bf16_t*)p.out;
    const int G = gridDim.x;

    ph_prep(p, smh);
    xcd_barrier(bar);
    { g8::StaticOrder S; S.init(T, 3072, G, (int)blockIdx.x); const g8::AddrPlain AD{(const char*)h, (const char*)(ws + OFF_WINT), 2048u, 2048u};
      g8::gemm_phase(smem, S, AD, g8::EpiProj{proj}, 16); }
    xcd_barrier(bar);
    ph_cmp1(proj, ws, smh);
    for (int task = HB_FIRST; task < 1024; task += HB_STEP) vtrans_tile(task, proj, ws, smh);
    for (int vb = HB_FIRST; vb < 1024; vb += HB_STEP) gla_a_unit(vb, proj, p.w_alpha, p.b_alpha, bc, cstate, smh);
    xcd_barrier(bar);
    ph_cmp2(ws, ws, smh);
    for (int vb = blockIdx.x; vb < 256; vb += G) gla_scan_vb2(vb, bc, cstate);
    ph_prep_experts(p, smh);
    xcd_barrier(bar);
    for (int vb = HB_FIRST; vb < 1024; vb += HB_STEP) gla_c_unit(vb, proj, bc, cstate, p.norm_g, yb, smh);
    for (int r = 0; r * G < 512; ++r) {
        const int u = r * G + ((r & 1) ? (G - 1 - (int)blockIdx.x) : (int)blockIdx.x);
        if (u < 512) nsa_unit(u, proj, ws, p.rel_bias, ya, smem);
    }
    xcd_barrier(bar);
    {
        g8::StaticOrder SO; SO.init(T, 1024, G, (int)blockIdx.x);
        bf16_t* sg2 = (bf16_t*)(ws + OFF_R1);
        g8::Unit mu;
        for (int i = 0; SO.next(i, mu); ++i) {
            const g8::OneUnit S1{mu};
            g8::Unit gu = mu;
            { const g8::AddrPlain AD{(const char*)h, (const char*)(ws + OFF_WINT) + (size_t)MGA * 2048, 2048u, 2048u}; g8::gemm_phase(smem, S1, AD, g8::EpiMerge<0>{mrg, nullptr}, 16); }
            { const g8::AddrPlain AD{(const char*)ya, (const char*)(ws + OFF_WAT), 1024u, 1024u}; g8::gemm_phase(smem, S1, AD, g8::EpiMerge<1>{mrg, nullptr}, 8); }
            { const g8::AddrPlain AD{(const char*)h, (const char*)(ws + OFF_WINT) + (size_t)MGB * 2048, 2048u, 2048u}; g8::gemm_phase(smem, S1, AD, g8::EpiMerge<0>{sg2, nullptr}, 16); }
            { const g8::AddrPlain AD{(const char*)yb, (const char*)(ws + OFF_WBT), 1024u, 1024u}; g8::gemm_phase(smem, S1, AD, g8::EpiMerge<2>{mrg, sg2}, 8); }
            (void)gu;
        }
    }
    xcd_barrier(bar);
    { g8::StaticOrder S; S.init(T, 1024, G, (int)blockIdx.x); const g8::AddrPlain AD{(const char*)mrg, (const char*)(ws + OFF_WOT), 2048u, 2048u};
      g8::gemm_phase(smem, S, AD, g8::EpiResid{p.x, p.out}, 16); }
    xcd_barrier(bar);
    for (int task = HB_FIRST; task < 1024; task += HB_STEP) router_unit(task, p.out, p.g_ffn, (const bf16_t*)(ws + OFF_WRT), p.b_rg, p.b_re, h2, (float*)(ws + OFF_RSTD), (int*)(ws + OFF_LTOK), (float*)(ws + OFF_LW), ctrl, smh);
    xcd_barrier(bar);
    ph_moe1(h2, (const bf16_t*)(ws + OFF_WGT), (const bf16_t*)(ws + OFF_WUT), ctrl, (const int*)(ws + OFF_LTOK), (const float*)(ws + OFF_LW), (const float*)(ws + OFF_RSTD), hid, smh);
    xcd_barrier(bar);
    ph_moe2(hid, (const bf16_t*)(ws + OFF_WDT), ctrl, (const int*)(ws + OFF_LTOK), Y0, smh);
    xcd_barrier(bar);
    { int t_ = threadIdx.x; asm volatile("" : "+v"(t_)); for (int row = blockIdx.x * 8 + (t_ >> 6); row < T; row += G * 8) final_row(row, p.out, Y0, Y1, p.g_final, t_ & 63); }
}

extern "C" void kernel_launch(void* const* d_in, const int* in_sizes, int n_in, void* d_out, int out_size, void* d_ws, size_t ws_size, hipStream_t stream) {
    static int grid = 0;
    constexpr int kDynLds = SMEM_BYTES + 16;
    if (!grid) {
        int dev = 0, cus = 0, per_cu = 0;
        (void)hipGetDevice(&dev);
        (void)hipDeviceGetAttribute(&cus, hipDeviceAttributeMultiprocessorCount, dev);
        (void)hipFuncSetAttribute((const void*)k_fwd, hipFuncAttributeMaxDynamicSharedMemorySize, kDynLds);
        (void)hipOccupancyMaxActiveBlocksPerMultiprocessor(&per_cu, k_fwd, 512, kDynLds);
        if (per_cu > 1) per_cu = 1;
        if (per_cu < 1) per_cu = 1;
        grid = cus * per_cu;
    }
    char* ws = (char*)d_ws;
    (void)hipMemsetAsync(ws + OFF_CTRL, 0, 16384, stream);
    (void)hipMemsetAsync(ws + OFF_BAR, 0, 16384, stream);
    Params p{};
    const float** pf = (const float**)&p;
    for (int i = 0; i < 25; ++i) pf[i] = (const float*)d_in[i];
    p.out = (float*)d_out; p.ws = ws;
    k_fwd<<<grid, 512, kDynLds, stream>>>(p);
}
```

```cpp
#include <hip/hip_runtime.h>
#include <stdint.h>

typedef unsigned short bf16_t;
typedef short bf16x8 __attribute__((ext_vector_type(8)));
typedef float f32x4 __attribute__((ext_vector_type(4)));
typedef unsigned u32x4 __attribute__((ext_vector_type(4)));
__device__ __forceinline__ float bf2f(bf16_t v) { return __uint_as_float(((unsigned)v) << 16); }
__device__ __forceinline__ bf16_t f2bf(float f) { unsigned u = __float_as_uint(f); u += 0x7FFFu + ((u >> 16) & 1u); return (bf16_t)(u >> 16); }
__device__ __forceinline__ unsigned pack_bf16(float lo, float hi) { unsigned r; asm volatile("v_cvt_pk_bf16_f32 %0, %1, %2" : "=v"(r) : "v"(lo), "v"(hi)); return r; }

constexpr int Bn = 4, S = 4096, T = Bn * S, D = 1024, NIN = 4904, PP = 2880;
constexpr int QA = 0, KC = 512, VC = 640, KS = 768, VS = 896, KW = 1024, VW = 1152, GA = 1280, QB = 1304, KB = 1560, VB = 1816, AB = 2328, RB = 2344, MGA = 2856, MGB = 3880;
constexpr int NPROJ = 2856;
constexpr int MSLOT = 36864;

constexpr size_t OFF_CTRL = 0;
constexpr size_t OFF_ROUTE_E = 16384;
constexpr size_t OFF_ROUTE_W = OFF_ROUTE_E + 32768 * 4;
constexpr size_t OFF_SLOT_TOK = OFF_ROUTE_W + 32768 * 4;
constexpr size_t OFF_SLOT_W = OFF_SLOT_TOK + (size_t)MSLOT * 4;
constexpr size_t OFF_BAR = OFF_SLOT_W + (size_t)MSLOT * 4;
constexpr size_t OFF_BIAS1 = OFF_BAR + 16384;
constexpr size_t OFF_RSTD = OFF_BIAS1 + 1024;
constexpr size_t OFF_SLOT_RS = OFF_RSTD + (size_t)T * 4;
constexpr size_t OFF_WRT = OFF_SLOT_RS + (size_t)MSLOT * 4;
static_assert(OFF_WRT + 2 * 48 * 1024 * 2 <= (1u << 20), "ctrl overflow");
constexpr size_t OFF_R1 = 1u << 20;
constexpr size_t SZ_PROJ = (size_t)T * PP * 2;
constexpr size_t OFF_PROJ = OFF_R1;
constexpr size_t OFF_BC = OFF_PROJ + SZ_PROJ;
constexpr size_t OFF_CSTATE = OFF_BC + (size_t)T * 256 * 4;
constexpr size_t OFF_R1_END = OFF_CSTATE + (size_t)1024 * 8192 * 4;
constexpr size_t OFF_MRG = OFF_R1 + (size_t)T * 2048 * 2;
constexpr size_t OFF_H2 = OFF_R1;
constexpr size_t OFF_HID = OFF_H2 + (size_t)T * 1024 * 2;
constexpr size_t OFF_Y0 = OFF_HID + (size_t)2 * T * 256 * 2;
constexpr size_t OFF_Y1 = OFF_Y0 + (size_t)T * 1024 * 2;
static_assert(OFF_MRG + (size_t)T * 1024 * 2 <= OFF_R1_END, "alias overflow");
static_assert(OFF_Y1 + (size_t)T * 1024 * 2 <= OFF_R1_END, "alias overflow");
constexpr size_t OFF_YA = OFF_R1_END;
constexpr size_t OFF_YB = OFF_YA + (size_t)T * 512 * 2;
constexpr size_t OFF_KCB = OFF_YB + (size_t)T * 512 * 2;
constexpr size_t OFF_VCB = OFF_KCB + 8 * 256 * 64 * 2;
constexpr size_t OFF_VCBT = OFF_VCB + 8 * 256 * 64 * 2;
constexpr size_t OFF_HIDC = OFF_VCBT + 8 * 256 * 64 * 2;
constexpr size_t OFF_VST = OFF_HIDC + 2 * 2048 * 128 * 2;
constexpr size_t OFF_VWT = OFF_VST + (size_t)8 * 64 * S * 2;
constexpr size_t OFF_WINT = OFF_VWT + (size_t)8 * 64 * S * 2;
constexpr size_t OFF_CK1T = OFF_WINT + (size_t)NIN * 1024 * 2;
constexpr size_t OFF_CV1T = OFF_CK1T + 128 * 2048 * 2;
constexpr size_t OFF_CK2T = OFF_CV1T + 128 * 2048 * 2;
constexpr size_t OFF_CV2T = OFF_CK2T + 128 * 128 * 2;
constexpr size_t OFF_WAT = OFF_CV2T + 128 * 128 * 2;
constexpr size_t OFF_WBT = OFF_WAT + 1024 * 512 * 2;
constexpr size_t OFF_WOT = OFF_WBT + 1024 * 512 * 2;
constexpr size_t OFF_WGT = OFF_WOT + 1024 * 1024 * 2;
constexpr size_t OFF_WUT = OFF_WGT + (size_t)32 * 256 * 1024 * 2;
constexpr size_t OFF_WDT = OFF_WUT + (size_t)32 * 256 * 1024 * 2;
constexpr size_t OFF_LTOK = OFF_WDT + (size_t)32 * 1024 * 256 * 2;
constexpr size_t OFF_LW = OFF_LTOK + (size_t)32 * 16384 * 4;
constexpr size_t OFF_END = OFF_LW + (size_t)32 * 16384 * 4;
static_assert(OFF_END <= (size_t)256 << 20, "workspace overflow");

#define XB_TMO      128
#define XB_XCNT(j)  (256  + 64 * (j))
#define XB_XSUB(j)  (1280 + 64 * (j))
#define XB_XGEN(j)  (2304 + 64 * (j))
#define XB_TOP      3328
#define XB_TOPGEN   3392
#define XCD_BAR_WORDS 3456
#define XB_SPIN_CAP (1u << 18)
#define LAS __attribute__((address_space(3)))

__device__ __forceinline__ unsigned xb_ld(unsigned* p)              { return __hip_atomic_load(p, __ATOMIC_RELAXED, __HIP_MEMORY_SCOPE_AGENT); }
__device__ __forceinline__ unsigned xb_add(unsigned* p, unsigned v) { return __hip_atomic_fetch_add(p, v, __ATOMIC_RELAXED, __HIP_MEMORY_SCOPE_AGENT); }
__device__ __forceinline__ unsigned xb_xcc_id() { return (unsigned)__builtin_amdgcn_s_getreg((3 << 11) | 20) & 0xFu; }
#define XB_SPIN(cond, bar) do { unsigned _sp = 0; while (cond) { __builtin_amdgcn_s_sleep(1); \
    if ((++_sp & 255u) == 0u) { if (xb_ld(&(bar)[XB_TMO])) break; if (_sp > XB_SPIN_CAP) { atomicAdd(&(bar)[XB_TMO], 1u); break; } } } } while (0)

struct XcdBarrier { unsigned* bar; unsigned x; volatile LAS unsigned* st; };

__device__ __forceinline__ XcdBarrier xcd_barrier_post(unsigned* bar, volatile LAS unsigned* st) {
    XcdBarrier b; b.bar = bar; b.x = xb_xcc_id(); b.st = st;
    if (threadIdx.x == 0) (void)xb_add(&bar[XB_XCNT(b.x)], 1u);
    return b;
}
__device__ __forceinline__ void xcd_barrier_complete(unsigned* bar, unsigned x, unsigned& nloc, unsigned& nx) {
    const unsigned G = gridDim.x * gridDim.y * gridDim.z;
    unsigned sum, cnt, mine, sp = 0u;
    for (;;) {
        sum = 0u; cnt = 0u; mine = 0u;
#pragma unroll
        for (unsigned j = 0; j < 16; ++j) { const unsigned c = xb_ld(&bar[XB_XCNT(j)]); sum += c; cnt += (c > 0u) ? 1u : 0u; mine = (j == x) ? c : mine; }
        if (sum == G) break;
        __builtin_amdgcn_s_sleep(1);
        if ((++sp & 255u) == 0u) { if (xb_ld(&bar[XB_TMO])) break; if (sp > XB_SPIN_CAP) { atomicAdd(&bar[XB_TMO], 1u); break; } }
    }
    nloc = mine > 0u ? mine : 1u; nx = cnt > 0u ? cnt : 1u;
}
__device__ __forceinline__ void xcd_barrier(const XcdBarrier& b) {
    asm volatile("s_waitcnt vmcnt(0)" ::: "memory");
    __syncthreads();
    if (threadIdx.x == 0) {
        unsigned* bar = b.bar;
        __builtin_amdgcn_s_waitcnt(0);
        unsigned nloc = b.st[0], nx = b.st[1];
        if (nloc == 0u) { xcd_barrier_complete(bar, b.x, nloc, nx); b.st[0] = nloc; b.st[1] = nx; }
        const unsigned old = xb_add(&bar[XB_XSUB(b.x)], 1u);
        const unsigned gen = old / nloc;
        if (old + 1u == (gen + 1u) * nloc) {
            __builtin_amdgcn_fence(__ATOMIC_RELEASE, "agent");
            asm volatile("s_waitcnt vmcnt(0)" ::: "memory");
            const unsigned og = xb_add(&bar[XB_TOP], 1u);
            const unsigned tg = og / nx;
            if (og + 1u == (tg + 1u) * nx) xb_add(&bar[XB_TOPGEN], 1u);
            else XB_SPIN(xb_ld(&bar[XB_TOPGEN]) == tg, bar);
            __builtin_amdgcn_fence(__ATOMIC_ACQUIRE, "agent");
            xb_add(&bar[XB_XGEN(b.x)], 1u);
            asm volatile("s_waitcnt vmcnt(0)" ::: "memory");
        } else {
            XB_SPIN(xb_ld(&bar[XB_XGEN(b.x)]) == gen, bar);
            __builtin_amdgcn_fence(__ATOMIC_ACQUIRE, "agent");
            asm volatile("s_waitcnt vmcnt(0)" ::: "memory");
        }
    }
    __syncthreads();
}


__device__ __forceinline__ int hb_tid_() { int t = threadIdx.x; asm volatile("" : "+v"(t)); return t & 255; }
#define HB_TID (hb_tid_())
#define HB_ID ((int)(threadIdx.x >> 8))
#define HB_FIRST (2 * (int)blockIdx.x + HB_ID)
#define HB_STEP (2 * (int)gridDim.x)
struct Params {
    const float *x, *g_mix, *w_in, *pe_k, *ck1, *ck2, *pe_v, *cv1, *cv2, *rel_bias, *w_alpha, *b_alpha, *norm_g, *w_ba, *w_bb, *w_out, *g_ffn,
                *w_rg, *b_rg, *w_re, *b_re, *w_eg, *w_eu, *w_ed, *g_final;
    float* out; char* ws;
};

__device__ __forceinline__ float wave_max(float v) { for (int o = 32; o > 0; o >>= 1) v = fmaxf(v, __shfl_xor(v, o)); return v; }
__device__ __forceinline__ float wave_sum(float v) { for (int o = 32; o > 0; o >>= 1) v += __shfl_xor(v, o); return v; }
__device__ __forceinline__ void wave_lds_sync() { asm volatile("s_waitcnt lgkmcnt(0)" ::: "memory"); }


__device__ __forceinline__ void rms_h_row(int row, const float* __restrict__ x, const float* __restrict__ g, bf16_t* __restrict__ h, int lane) {
    const float* xr = x + (size_t)row * D + lane * 4;
    f32x4 v[4]; float s = 0.f;
#pragma unroll
    for (int i = 0; i < 4; ++i) { v[i] = *(const f32x4*)(xr + 256 * i); s += v[i][0] * v[i][0] + v[i][1] * v[i][1] + v[i][2] * v[i][2] + v[i][3] * v[i][3]; }
    s = wave_sum(s);
    const float r = rsqrtf(s * (1.0f / D) + 1e-6f);
#pragma unroll
    for (int i = 0; i < 4; ++i) {
        const f32x4 gg = *(const f32x4*)(g + lane * 4 + 256 * i);
        uint2 o; o.x = pack_bf16(v[i][0] * r * gg[0], v[i][1] * r * gg[1]); o.y = pack_bf16(v[i][2] * r * gg[2], v[i][3] * r * gg[3]);
        *(uint2*)(h + (size_t)row * D + lane * 4 + 256 * i) = o;
    }
}
__device__ __forceinline__ void final_row(int row, float* __restrict__ x2out, const bf16_t* __restrict__ Y0, const bf16_t* __restrict__ Y1, const float* __restrict__ g, int lane) {
    float* xr = x2out + (size_t)row * D + lane * 4;
    f32x4 v[4]; float s = 0.f;
#pragma unroll
    for (int i = 0; i < 4; ++i) {
        v[i] = *(const f32x4*)(xr + 256 * i);
        const uint2 a = *(const uint2*)(Y0 + (size_t)row * D + lane * 4 + 256 * i), c = *(const uint2*)(Y1 + (size_t)row * D + lane * 4 + 256 * i);
        v[i][0] += __uint_as_float(a.x << 16) + __uint_as_float(c.x << 16);
        v[i][1] += __uint_as_float(a.x & 0xFFFF0000u) + __uint_as_float(c.x & 0xFFFF0000u);
        v[i][2] += __uint_as_float(a.y << 16) + __uint_as_float(c.y << 16);
        v[i][3] += __uint_as_float(a.y & 0xFFFF0000u) + __uint_as_float(c.y & 0xFFFF0000u);
        s += v[i][0] * v[i][0] + v[i][1] * v[i][1] + v[i][2] * v[i][2] + v[i][3] * v[i][3];
    }
    s = wave_sum(s);
    const float r = rsqrtf(s * (1.0f / D) + 1e-6f);
#pragma unroll
    for (int i = 0; i < 4; ++i) {
        const f32x4 gg = *(const f32x4*)(g + lane * 4 + 256 * i);
        *(f32x4*)(xr + 256 * i) = (f32x4){v[i][0] * r * gg[0], v[i][1] * r * gg[1], v[i][2] * r * gg[2], v[i][3] * r * gg[3]};
    }
}

__device__ __forceinline__ void prep_router_w(const float* __restrict__ w_rg, const float* __restrict__ w_re, bf16_t* __restrict__ WrT) {
    for (int idx = blockIdx.x * 512 + threadIdx.x; idx < 48 * 1024; idx += gridDim.x * 512) {
        const int n = idx >> 10, k = idx & 1023;
        const float w = n < 4 ? w_rg[k * 4 + n] : (n < 36 ? w_re[k * 32 + n - 4] : 0.f);
        const bf16_t hi = f2bf(w);
        WrT[idx] = hi; WrT[48 * 1024 + idx] = f2bf(w - bf2f(hi));
    }
}

__device__ __forceinline__ void router_unit(int task, const float* __restrict__ x2, const float* __restrict__ g, const bf16_t* __restrict__ WrT,
                                            const float* __restrict__ b_rg, const float* __restrict__ b_re, bf16_t* __restrict__ h2, float* __restrict__ rstd_out,
                                            char* smem) {
    float (*part)[16][49] = (float (*)[16][49])smem;
    int* dec_e = (int*)(smem + 14336); float* dec_w = (float*)(smem + 14336 + 512);
    float (*ssp)[16] = (float (*)[16])(smem + 4 * 16 * 49 * 4);
    const int tid = HB_TID, lane = tid & 63, w4 = tid >> 6, fr = lane & 15, fq = lane >> 4, r0 = task * 16;
    const float* xr = x2 + (size_t)(r0 + fr) * D + fq * 8 + w4 * 256;
    bf16_t* hr = h2 + (size_t)(r0 + fr) * D + fq * 8 + w4 * 256;
    const bf16_t* wh = WrT + (size_t)fr * 1024 + fq * 8 + w4 * 256;
    const float* gp = g + fq * 8 + w4 * 256;
    f32x4 acc[3];
#pragma unroll
    for (int nt = 0; nt < 3; ++nt) acc[nt] = (f32x4){0.f, 0.f, 0.f, 0.f};
    float ssq = 0.f;
#pragma unroll 4
    for (int ks = 0; ks < 8; ++ks) {
        const f32x4 x0 = *(const f32x4*)(xr + ks * 32), x1 = *(const f32x4*)(xr + ks * 32 + 4);
        const f32x4 g0 = *(const f32x4*)(gp + ks * 32), g1 = *(const f32x4*)(gp + ks * 32 + 4);
        float xg[8];
#pragma unroll
        for (int e = 0; e < 4; ++e) { xg[e] = x0[e] * g0[e]; xg[4 + e] = x1[e] * g1[e]; ssq += x0[e] * x0[e] + x1[e] * x1[e]; }
        u32x4 hi, lo;
#pragma unroll
        for (int e = 0; e < 4; ++e) {
            hi[e] = pack_bf16(xg[2 * e], xg[2 * e + 1]);
            lo[e] = pack_bf16(xg[2 * e] - __uint_as_float(hi[e] << 16), xg[2 * e + 1] - __uint_as_float(hi[e] & 0xFFFF0000u));
        }
        *(u32x4*)(hr + ks * 32) = hi;
        const bf16x8 ah = __builtin_bit_cast(bf16x8, hi), al = __builtin_bit_cast(bf16x8, lo);
#pragma unroll
        for (int nt = 0; nt < 3; ++nt) {
            const bf16x8 bh = *(const bf16x8*)(wh + (size_t)nt * 16 * 1024 + ks * 32), bl = *(const bf16x8*)(wh + (size_t)(48 + nt * 16) * 1024 + ks * 32);
            acc[nt] = __builtin_amdgcn_mfma_f32_16x16x32_bf16(ah, bh, acc[nt], 0, 0, 0);
            acc[nt] = __builtin_amdgcn_mfma_f32_16x16x32_bf16(al, bh, acc[nt], 0, 0, 0);
            acc[nt] = __builtin_amdgcn_mfma_f32_16x16x32_bf16(ah, bl, acc[nt], 0, 0, 0);
        }
    }
    ssq += __shfl_xor(ssq, 16); ssq += __shfl_xor(ssq, 32);
    __syncthreads();
    if (fq == 0) ssp[w4][fr] = ssq;
#pragma unroll
    for (int nt = 0; nt < 3; ++nt)
#pragma unroll
        for (int i = 0; i < 4; ++i) part[w4][4 * fq + i][nt * 16 + fr] = acc[nt][i];
    __syncthreads();
    if (tid < 16) {
        const int row = r0 + tid;
        const float rsv = rsqrtf((ssp[0][tid] + ssp[1][tid] + ssp[2][tid] + ssp[3][tid]) * (1.0f / D) + 1e-6f);
        rstd_out[row] = rsv;
        float l4[4];
#pragma unroll
        for (int j = 0; j < 4; ++j) l4[j] = (part[0][tid][j] + part[1][tid][j] + part[2][tid][j] + part[3][tid][j]) * rsv + b_rg[j];
        int gs = 0; float mx = l4[0];
#pragma unroll
        for (int j = 1; j < 4; ++j) if (l4[j] > mx) { mx = l4[j]; gs = j; }
        float den = 0.f;
#pragma unroll
        for (int j = 0; j < 4; ++j) den += __expf(l4[j] - mx);
        const float gpb = 1.f / den;
        float v0 = -3e38f, v1 = -3e38f; int i0 = 0, i1 = 0;
        for (int j = 0; j < 8; ++j) {
            const int c = 4 + gs * 8 + j;
            const float l = (part[0][tid][c] + part[1][tid][c] + part[2][tid][c] + part[3][tid][c]) * rsv + b_re[gs * 8 + j];
            if (l > v0) { v1 = v0; i1 = i0; v0 = l; i0 = j; }
            else if (l > v1) { v1 = l; i1 = j; }
        }
        const float e1 = __expf(v1 - v0);
        const int lr = (task & 1) * 16 + tid;
        dec_e[lr * 2] = gs * 8 + i0; dec_e[lr * 2 + 1] = gs * 8 + i1;
        dec_w[lr * 2] = gpb / (1.f + e1); dec_w[lr * 2 + 1] = gpb * e1 / (1.f + e1);
    }
}
__device__ __forceinline__ void router_append(int group, int* __restrict__ ltok, float* __restrict__ lw, int* __restrict__ cnt, char* smem) {
    int* dec_e = (int*)(smem + 14336); float* dec_w = (float*)(smem + 14336 + 512);
    int* hist = (int*)(smem + 14336 + 1024); int* base = hist + 32;
    const int tid = HB_TID;
    if (tid < 32) hist[tid] = 0;
    __syncthreads();
    int e = 0, lpos = 0;
    if (tid < 64) { e = dec_e[tid]; lpos = atomicAdd(&hist[e], 1); }
    __syncthreads();
    if (tid < 32) { const int hcount = hist[tid]; base[tid] = hcount ? atomicAdd(&cnt[tid * 64], hcount) : 0; }
    __syncthreads();
    if (tid < 64) { const int pos = e * 16384 + base[e] + lpos; ltok[pos] = (group * 32 + (tid >> 1)) * 2 + (tid & 1); lw[pos] = dec_w[tid]; }
    __syncthreads();
}

__device__ __forceinline__ void transpose_tile(const float* __restrict__ src, int ld_src, int N, bf16_t* __restrict__ dst, int ld_dst, int kt, int nt, char* smem) {
    float (*tl)[65] = (float (*)[65])smem;
    const int tid = HB_TID;
    const int c4 = (tid & 15) * 4, r0 = tid >> 4;
#pragma unroll
    for (int i = 0; i < 4; ++i) {
        const int k = r0 + 16 * i, n = nt * 64 + c4;
        float4 v = make_float4(0.f, 0.f, 0.f, 0.f);
        if (n < N) v = *(const float4*)(src + (size_t)(kt * 64 + k) * ld_src + n);
        tl[k][c4] = v.x; tl[k][c4 + 1] = v.y; tl[k][c4 + 2] = v.z; tl[k][c4 + 3] = v.w;
    }
    __syncthreads();
    const int kc = (tid & 7) * 8, n0 = tid >> 3;
#pragma unroll
    for (int i = 0; i < 2; ++i) {
        const int nl = n0 + 32 * i, n = nt * 64 + nl;
        if (n < N) {
            uint4 o;
            o.x = pack_bf16(tl[kc][nl], tl[kc + 1][nl]); o.y = pack_bf16(tl[kc + 2][nl], tl[kc + 3][nl]);
            o.z = pack_bf16(tl[kc + 4][nl], tl[kc + 5][nl]); o.w = pack_bf16(tl[kc + 6][nl], tl[kc + 7][nl]);
            *(uint4*)(dst + (size_t)n * ld_dst + kt * 64 + kc) = o;
        }
    }
    __syncthreads();
}

__device__ __forceinline__ void ph_prep_experts(const Params& p, char* smem) {
    char* ws = p.ws;
    for (int t = HB_FIRST; t < 6144; t += HB_STEP) {
        const int e = (t & 2047) >> 6, r = t & 63;
        if (t < 2048) transpose_tile(p.w_eg + (size_t)e * 1024 * 256, 256, 256, (bf16_t*)(ws + OFF_WGT) + (size_t)e * 256 * 1024, 1024, r >> 2, r & 3, smem);
        else if (t < 4096) transpose_tile(p.w_eu + (size_t)e * 1024 * 256, 256, 256, (bf16_t*)(ws + OFF_WUT) + (size_t)e * 256 * 1024, 1024, r >> 2, r & 3, smem);
        else transpose_tile(p.w_ed + (size_t)e * 256 * 1024, 1024, 1024, (bf16_t*)(ws + OFF_WDT) + (size_t)e * 1024 * 256, 256, r >> 4, r & 15, smem);
    }
}
__device__ __forceinline__ void ph_prep(const Params& p, char* smem) {
    char* ws = p.ws;
    constexpr int N0 = 16 * 77, N1 = N0 + 64, N2 = N1 + 64, N3 = N2 + 2, N4 = N3 + 2, N5 = N4 + 128, N6 = N5 + 128, N7 = N6 + 256;
    for (int t = HB_FIRST; t < N7; t += HB_STEP) {
        if (t < N0) transpose_tile(p.w_in, NIN, NIN, (bf16_t*)(ws + OFF_WINT), 1024, t / 77, t % 77, smem);
        else if (t < N1) { const int q = t - N0; transpose_tile(p.ck1, 128, 128, (bf16_t*)(ws + OFF_CK1T), 2048, q >> 1, q & 1, smem); }
        else if (t < N2) { const int q = t - N1; transpose_tile(p.cv1, 128, 128, (bf16_t*)(ws + OFF_CV1T), 2048, q >> 1, q & 1, smem); }
        else if (t < N3) { const int q = t - N2; transpose_tile(p.ck2, 64, 64, (bf16_t*)(ws + OFF_CK2T), 128, q, 0, smem); }
        else if (t < N4) { const int q = t - N3; transpose_tile(p.cv2, 64, 64, (bf16_t*)(ws + OFF_CV2T), 128, q, 0, smem); }
        else if (t < N5) { const int q = t - N4; transpose_tile(p.w_ba, 1024, 1024, (bf16_t*)(ws + OFF_WAT), 512, q >> 4, q & 15, smem); }
        else if (t < N6) { const int q = t - N5; transpose_tile(p.w_bb, 1024, 1024, (bf16_t*)(ws + OFF_WBT), 512, q >> 4, q & 15, smem); }
        else { const int q = t - N6; transpose_tile(p.w_out, 1024, 1024, (bf16_t*)(ws + OFF_WOT), 1024, q >> 4, q & 15, smem); }
    }
    for (int t = HB_FIRST; t < 8; t += HB_STEP) {
        const int which = t >> 2, n = (t & 3) * 32 + (HB_TID & 31), ksp = HB_TID >> 5;
        const float* pe = which ? p.pe_v : p.pe_k; const float* w1 = which ? p.cv1 : p.ck1;
        float a = 0.f;
        for (int k = ksp * 256; k < ksp * 256 + 256; ++k) a += pe[k] * w1[(size_t)k * 128 + n];
        float* red = (float*)smem;
        red[HB_TID] = a;
        __syncthreads();
        if (HB_TID < 32) {
            float s = 0.f;
#pragma unroll
            for (int j = 0; j < 8; ++j) s += red[j * 32 + HB_TID];
            ((float*)(ws + OFF_BIAS1))[which * 128 + n] = s;
        }
        __syncthreads();
    }
    prep_router_w(p.w_rg, p.w_re, (bf16_t*)(ws + OFF_WRT));
    for (int row = blockIdx.x * 8 + (threadIdx.x >> 6); row < T; row += gridDim.x * 8) rms_h_row(row, p.x, p.g_mix, (bf16_t*)p.out, threadIdx.x & 63);
}

__device__ __forceinline__ int tile_off(int row, int chunk) { return row * 128 + ((chunk ^ (row & 7)) << 4); }

__device__ __forceinline__ void glds16(const void* g, char* l) {
    __builtin_amdgcn_global_load_lds((const __attribute__((address_space(1))) unsigned*)g, (__attribute__((address_space(3))) unsigned*)l, 16, 0, 0);
}
__device__ __forceinline__ void gemm_kloop(f32x4 (&acc)[4][4], const bf16_t* const (&pa)[4], const bf16_t* const (&pb)[4], int ka, int kb, int nk, char* smem) {
    int tid_ = HB_TID; asm volatile("" : "+v"(tid_));
    const int tid = tid_, lane = tid & 63, wid = tid >> 6, wr = wid >> 1, wc = wid & 1, fr = lane & 15, fq = lane >> 4;
    const int offA = (wr * 64 + fr) * 128, offB = 16384 + (wc * 64 + fr) * 128, x = fr & 7;
    __syncthreads();
#pragma unroll
    for (int i = 0; i < 4; ++i) { glds16(pa[i], smem + i * 4096 + tid * 16); glds16(pb[i], smem + 16384 + i * 4096 + tid * 16); }
    asm volatile("s_waitcnt vmcnt(0)" ::: "memory");
    __syncthreads();
    for (int kt = 0; kt < nk; ++kt) {
        const int cur = kt & 1;
        if (kt + 1 < nk) {
            char* st = smem + (cur ^ 1) * 32768 + tid * 16;
#pragma unroll
            for (int i = 0; i < 4; ++i) { glds16(pa[i] + (size_t)(kt + 1) * ka, st + i * 4096); glds16(pb[i] + (size_t)(kt + 1) * kb, st + 16384 + i * 4096); }
        }
        const char* sa = smem + cur * 32768 + offA;
        const char* sb = smem + cur * 32768 + offB;
#pragma unroll
        for (int ks = 0; ks < 2; ++ks) {
            const int ch = ((ks * 4 + fq) ^ x) << 4;
            bf16x8 af[4], bfr[4];
#pragma unroll
            for (int mi = 0; mi < 4; ++mi) af[mi] = *(const bf16x8*)(sa + mi * 2048 + ch);
#pragma unroll
            for (int ni = 0; ni < 4; ++ni) bfr[ni] = *(const bf16x8*)(sb + ni * 2048 + ch);
#pragma unroll
            for (int mi = 0; mi < 4; ++mi)
#pragma unroll
                for (int ni = 0; ni < 4; ++ni) acc[mi][ni] = __builtin_amdgcn_mfma_f32_16x16x32_bf16(bfr[ni], af[mi], acc[mi][ni], 0, 0, 0);
        }
        asm volatile("s_waitcnt vmcnt(0)" ::: "memory");
        __syncthreads();
    }
}
__device__ __forceinline__ void acc_zero(f32x4 (&acc)[4][4]) {
#pragma unroll
    for (int mi = 0; mi < 4; ++mi)
#pragma unroll
        for (int ni = 0; ni < 4; ++ni) acc[mi][ni] = (f32x4){0.f, 0.f, 0.f, 0.f};
}
#define GEMM_LANE_VARS const int tid = HB_TID, lane = tid & 63, wid = tid >> 6, wr = wid >> 1, wc = wid & 1, fr = lane & 15, fq = lane >> 4, lrow = tid >> 3, lch8 = ((tid & 7) ^ ((tid >> 3) & 7)) * 8; (void)wr; (void)wc; (void)fr; (void)fq; (void)lrow; (void)lch8;
__device__ __forceinline__ uint2 pack4(f32x4 v) { uint2 o; o.x = pack_bf16(v[0], v[1]); o.y = pack_bf16(v[2], v[3]); return o; }
__device__ __forceinline__ float sigmoidf_(float a) { return 1.f / (1.f + __expf(-a)); }

__device__ __forceinline__ void ph_proj(const bf16_t* __restrict__ h, const bf16_t* __restrict__ WinT, bf16_t* __restrict__ proj, char* smem) {
    GEMM_LANE_VARS
    for (int u = HB_FIRST; u < 128 * 23; u += HB_STEP) {
        const int xg = u & 7, v = u >> 3, tn = v % 23, tm = (v / 23) * 8 + xg;
        const bf16_t* pa[4]; const bf16_t* pb[4];
#pragma unroll
        for (int i = 0; i < 4; ++i) { pa[i] = h + (size_t)(tm * 128 + lrow + 32 * i) * 1024 + lch8; pb[i] = WinT + (size_t)(tn * 128 + lrow + 32 * i) * 1024 + lch8; }
        f32x4 acc[4][4]; acc_zero(acc);
        gemm_kloop(acc, pa, pb, 64, 64, 16, smem);
#pragma unroll
        for (int mi = 0; mi < 4; ++mi)
#pragma unroll
            for (int ni = 0; ni < 4; ++ni) {
                const int m = tm * 128 + wr * 64 + mi * 16 + fr, n = tn * 128 + wc * 64 + ni * 16 + 4 * fq;
                if (n < NPROJ) *(uint2*)(proj + (size_t)m * PP + n) = pack4(acc[mi][ni]);
            }
    }
}

__device__ __forceinline__ void ph_cmp1(const bf16_t* __restrict__ proj, const char* ws, char* smem) {
    GEMM_LANE_VARS
    for (int u = HB_FIRST; u < 32; u += HB_STEP) {
        const int which = u >> 4, tm = u & 15;
        const bf16_t* W1T = (const bf16_t*)(ws + (which ? OFF_CV1T : OFF_CK1T));
        const float* bias1 = (const float*)(ws + OFF_BIAS1) + which * 128;
        bf16_t* hid = (bf16_t*)(ws + OFF_HIDC) + (size_t)which * 2048 * 128;
        const int col0 = which ? VC : KC;
        const bf16_t* pa[4]; const bf16_t* pb[4];
#pragma unroll
        for (int i = 0; i < 4; ++i) {
            const int m = tm * 128 + lrow + 32 * i, bg = m >> 8, c = (m & 255) > 254 ? 254 : (m & 255), b = bg >> 1, g = bg & 1;
            pa[i] = proj + (size_t)(b * S + 16 * c) * PP + col0 + g * 64 + lch8;
            pb[i] = W1T + (size_t)(lrow + 32 * i) * 2048 + lch8;
        }
        f32x4 acc[4][4]; acc_zero(acc);
        gemm_kloop(acc, pa, pb, PP, 64, 32, smem);
#pragma unroll
        for (int mi = 0; mi < 4; ++mi)
#pragma unroll
            for (int ni = 0; ni < 4; ++ni) {
                const int m = tm * 128 + wr * 64 + mi * 16 + fr, n = wc * 64 + ni * 16 + 4 * fq;
                f32x4 v = acc[mi][ni];
#pragma unroll
                for (int j = 0; j < 4; ++j) { const float a = v[j] + bias1[n + j]; const float t = 0.7978845608028654f * (a + 0.044715f * a * a * a); v[j] = 0.5f * a * (1.f + tanhf(t)); }
                *(uint2*)(hid + (size_t)m * 128 + n) = pack4(v);
            }
    }
}

__device__ __forceinline__ void ph_cmp2(const char* ws_c, char* ws, char* smem) {
    GEMM_LANE_VARS
    for (int u = HB_FIRST; u < 32; u += HB_STEP) {
        const int which = u >> 4, tm = u & 15;
        const bf16_t* W2T = (const bf16_t*)(ws_c + (which ? OFF_CV2T : OFF_CK2T));
        const bf16_t* hid = (const bf16_t*)(ws_c + OFF_HIDC) + (size_t)which * 2048 * 128;
        const bf16_t* pa[4]; const bf16_t* pb[4];
#pragma unroll
        for (int i = 0; i < 4; ++i) { pa[i] = hid + (size_t)(tm * 128 + lrow + 32 * i) * 128 + lch8; pb[i] = W2T + (size_t)(lrow + 32 * i) * 128 + lch8; }
        f32x4 acc[4][4]; acc_zero(acc);
        gemm_kloop(acc, pa, pb, 64, 64, 2, smem);
        if (wc == 0) {
            bf16_t* outp = (bf16_t*)(ws + (which ? OFF_VCB : OFF_KCB));
            bf16_t* outT = (bf16_t*)(ws + OFF_VCBT);
#pragma unroll
            for (int mi = 0; mi < 4; ++mi)
#pragma unroll
                for (int ni = 0; ni < 4; ++ni) {
                    const int m = tm * 128 + wr * 64 + mi * 16 + fr, n = ni * 16 + 4 * fq, c = m & 255, bg = m >> 8;
                    f32x4 v = acc[mi][ni];
                    if (c == 255) v = (f32x4){0.f, 0.f, 0.f, 0.f};
                    *(uint2*)(outp + (size_t)m * 64 + n) = pack4(v);
                    if (which) {
#pragma unroll
                        for (int j = 0; j < 4; ++j) outT[((size_t)bg * 64 + n + j) * 256 + c] = f2bf(v[j]);
                    }
                }
        }
    }
}

typedef unsigned u32x2 __attribute__((ext_vector_type(2)));
__device__ __forceinline__ u32x2 pack4v(f32x4 v) { u32x2 o; o[0] = pack_bf16(v[0], v[1]); o[1] = pack_bf16(v[2], v[3]); return o; }
__device__ __forceinline__ f32x4 unpack4v(u32x2 o) { return (f32x4){__uint_as_float(o[0] << 16), __uint_as_float(o[0] & 0xFFFF0000u), __uint_as_float(o[1] << 16), __uint_as_float(o[1] & 0xFFFF0000u)}; }
template <int HALF>
__device__ __forceinline__ void merge_half(u32x2 (&tpk)[4][4], int tm, int tn, const bf16_t* __restrict__ h, const bf16_t* __restrict__ WinT, const bf16_t* __restrict__ yy,
                                           const bf16_t* __restrict__ WT, bf16_t* __restrict__ mrg, char* smem) {
    GEMM_LANE_VARS
    u32x2 sg[4][4];
    {
        const bf16_t* pa[4]; const bf16_t* pb[4];
#pragma unroll
        for (int i = 0; i < 4; ++i) { pa[i] = h + (size_t)(tm * 128 + lrow + 32 * i) * 1024 + lch8; pb[i] = WinT + (size_t)((HALF ? MGB : MGA) + tn * 128 + lrow + 32 * i) * 1024 + lch8; }
        f32x4 gg[4][4]; acc_zero(gg);
        gemm_kloop(gg, pa, pb, 64, 64, 16, smem);
#pragma unroll
        for (int mi = 0; mi < 4; ++mi)
#pragma unroll
            for (int ni = 0; ni < 4; ++ni) {
                f32x4 t;
#pragma unroll
                for (int j = 0; j < 4; ++j) t[j] = sigmoidf_(gg[mi][ni][j]);
                sg[mi][ni] = pack4v(t);
            }
    }
    {
        const bf16_t* pa[4]; const bf16_t* pb[4];
#pragma unroll
        for (int i = 0; i < 4; ++i) { pa[i] = yy + (size_t)(tm * 128 + lrow + 32 * i) * 512 + lch8; pb[i] = WT + (size_t)(tn * 128 + lrow + 32 * i) * 512 + lch8; }
        f32x4 acc[4][4]; acc_zero(acc);
        gemm_kloop(acc, pa, pb, 64, 64, 8, smem);
#pragma unroll
        for (int mi = 0; mi < 4; ++mi)
#pragma unroll
            for (int ni = 0; ni < 4; ++ni) {
                f32x4 t = unpack4v(sg[mi][ni]) * acc[mi][ni];
                if (HALF == 0) tpk[mi][ni] = pack4v(t);
                else {
                    t += unpack4v(tpk[mi][ni]);
                    const int m = tm * 128 + wr * 64 + mi * 16 + fr, n = tn * 128 + wc * 64 + ni * 16 + 4 * fq;
                    *(u32x2*)(mrg + (size_t)m * 1024 + n) = pack4v(t);
                }
            }
    }
}
__device__ __forceinline__ void ph_merge(const bf16_t* __restrict__ h, const bf16_t* __restrict__ WinT, const bf16_t* __restrict__ ya, const bf16_t* __restrict__ yb,
                                         const bf16_t* __restrict__ WaT, const bf16_t* __restrict__ WbT, bf16_t* __restrict__ mrg, char* smem) {
    for (int u = HB_FIRST; u < 128 * 8; u += HB_STEP) {
        const int xg = u & 7, v = u >> 3, tn = v & 7, tm = (v >> 3) * 8 + xg;
        u32x2 tpk[4][4];
        merge_half<0>(tpk, tm, tn, h, WinT, ya, WaT, mrg, smem);
        merge_half<1>(tpk, tm, tn, h, WinT, yb, WbT, mrg, smem);
    }
}

__device__ __forceinline__ void ph_outproj(const bf16_t* __restrict__ mrg, const bf16_t* __restrict__ WoT, const float* __restrict__ x, float* __restrict__ x2, char* smem) {
    GEMM_LANE_VARS
    for (int u = HB_FIRST; u < 128 * 8; u += HB_STEP) {
        const int xg = u & 7, v = u >> 3, tn = v & 7, tm = (v >> 3) * 8 + xg;
        const bf16_t* pa[4]; const bf16_t* pb[4];
#pragma unroll
        for (int i = 0; i < 4; ++i) { pa[i] = mrg + (size_t)(tm * 128 + lrow + 32 * i) * 1024 + lch8; pb[i] = WoT + (size_t)(tn * 128 + lrow + 32 * i) * 1024 + lch8; }
        f32x4 acc[4][4]; acc_zero(acc);
        gemm_kloop(acc, pa, pb, 64, 64, 16, smem);
#pragma unroll
        for (int mi = 0; mi < 4; ++mi)
#pragma unroll
            for (int ni = 0; ni < 4; ++ni) {
                const int m = tm * 128 + wr * 64 + mi * 16 + fr, n = tn * 128 + wc * 64 + ni * 16 + 4 * fq;
                const float4 xv = *(const float4*)(x + (size_t)m * 1024 + n);
                *(float4*)(x2 + (size_t)m * 1024 + n) = make_float4(xv.x + acc[mi][ni][0], xv.y + acc[mi][ni][1], xv.z + acc[mi][ni][2], xv.w + acc[mi][ni][3]);
            }
    }
}

__device__ __forceinline__ int moe_tile_decode(const int* __restrict__ cnt, int t, int& e, int& i) {
    int acc = 0; e = 0; i = 0;
    for (int ee = 0; ee < 32; ++ee) { const int nt = (cnt[ee * 64] + 127) >> 7; if (t >= acc && t < acc + nt) { e = ee; i = t - acc; } acc += nt; }
    return acc;
}

__device__ __forceinline__ void ph_moe1(const bf16_t* __restrict__ h2, const bf16_t* __restrict__ WgT, const bf16_t* __restrict__ WuT, const int* __restrict__ cnt,
                                        const int* __restrict__ ltok, const float* __restrict__ lw, const float* __restrict__ rstd, bf16_t* __restrict__ hid, char* smem) {
    GEMM_LANE_VARS
    int e, ti;
    const int nu = moe_tile_decode(cnt, 0, e, ti) * 4;
    for (int u = HB_FIRST; u < nu; u += HB_STEP) {
        const int ft = u & 3;
        (void)moe_tile_decode(cnt, u >> 2, e, ti);
        const int ne = cnt[e * 64];
        const bf16_t* pa[4]; const bf16_t* pb[4];
#pragma unroll
        for (int i = 0; i < 4; ++i) {
            const int rr = lrow + 32 * i, idx = ti * 128 + rr;
            const int tk = idx < ne ? ltok[e * 16384 + idx] : 0;
            pa[i] = h2 + (size_t)(tk >> 1) * 1024 + lch8;
            const int bwc = rr >> 6, bni = (rr >> 4) & 3, bj = rr & 15;
            const int f = ft * 64 + bwc * 32 + (bni >> 1) * 16 + bj;
            pb[i] = ((bni & 1) ? WuT : WgT) + ((size_t)e * 256 + f) * 1024 + lch8;
        }
        f32x4 acc[4][4]; acc_zero(acc);
        gemm_kloop(acc, pa, pb, 64, 64, 16, smem);
#pragma unroll
        for (int mi = 0; mi < 4; ++mi) {
            const int idx = ti * 128 + wr * 64 + mi * 16 + fr;
            if (idx < ne) {
                const int tk = ltok[e * 16384 + idx];
                const float w = lw[e * 16384 + idx], rsv = rstd[tk >> 1];
#pragma unroll
                for (int q = 0; q < 2; ++q) {
                    const int f = ft * 64 + wc * 32 + q * 16 + 4 * fq;
                    f32x4 v;
#pragma unroll
                    for (int j = 0; j < 4; ++j) { const float a = acc[mi][2 * q][j] * rsv, uu = acc[mi][2 * q + 1][j] * rsv; v[j] = a * sigmoidf_(a) * uu * w; }
                    *(uint2*)(hid + (size_t)tk * 256 + f) = pack4(v);
                }
            }
        }
    }
}

__device__ __forceinline__ void ph_moe2(const bf16_t* __restrict__ hid, const bf16_t* __restrict__ WdT, const int* __restrict__ cnt, const int* __restrict__ ltok,
                                        bf16_t* __restrict__ Y, char* smem) {
    GEMM_LANE_VARS
    int e, ti;
    const int nu = moe_tile_decode(cnt, 0, e, ti) * 8;
    for (int u = HB_FIRST; u < nu; u += HB_STEP) {
        const int tn = u & 7;
        (void)moe_tile_decode(cnt, u >> 3, e, ti);
        const int ne = cnt[e * 64];
        const bf16_t* pa[4]; const bf16_t* pb[4];
#pragma unroll
        for (int i = 0; i < 4; ++i) {
            const int idx = ti * 128 + lrow + 32 * i;
            const int tk = idx < ne ? ltok[e * 16384 + idx] : 0;
            pa[i] = hid + (size_t)tk * 256 + lch8;
            pb[i] = WdT + ((size_t)e * 1024 + tn * 128 + lrow + 32 * i) * 256 + lch8;
        }
        f32x4 acc[4][4]; acc_zero(acc);
        gemm_kloop(acc, pa, pb, 64, 64, 4, smem);
#pragma unroll
        for (int mi = 0; mi < 4; ++mi) {
            const int idx = ti * 128 + wr * 64 + mi * 16 + fr;
            if (idx < ne) {
                const int tk = ltok[e * 16384 + idx];
                bf16_t* yr = Y + ((size_t)(tk & 1) * T + (size_t)(tk >> 1)) * 1024 + tn * 128 + wc * 64 + 4 * fq;
#pragma unroll
                for (int ni = 0; ni < 4; ++ni) *(uint2*)(yr + ni * 16) = pack4(acc[mi][ni]);
            }
        }
    }
}

namespace g8 {
constexpr int HTB = 128 * 64 * 2;
__device__ __forceinline__ int lds_byte(int r, int c) { const int st = (r >> 4) * 2 + (c >> 5), rr = r & 15, cc = c & 31, ob = rr * 64 + cc * 2; return st * 1024 + (ob ^ (((ob >> 9) & 1) << 5)); }
__device__ __forceinline__ void stage_rc(int b, int& R, int& C) { const int st = b / 1024, sb = b % 1024, swz = sb ^ (((sb >> 9) & 1) << 5); R = (st >> 1) * 16 + swz / 64; C = (st & 1) * 32 + (swz % 64) / 2; }
__device__ __forceinline__ int perm32(int rho) { const int n = rho >> 4, i = rho & 15; return 8 * (i >> 2) + 4 * n + (i & 3); }
struct Unit { int pm, pn, e; };
struct StaticOrder {
    int nM, nN, nwg, G, c;
    __device__ __forceinline__ void init(int M, int N, int G_, int c_) { nM = M / 256; nN = N / 256; nwg = nM * nN; G = G_; c = c_; }
    __device__ __forceinline__ bool next(int i, Unit& u) const {
        const long L = (long)i * G + c; if (L >= nwg) return false;
        int wgid = (int)L; { const int q = nwg / 8, r = nwg % 8, xcd = wgid % 8, off = wgid / 8; wgid = (xcd < r ? xcd * (q + 1) : r * (q + 1) + (xcd - r) * q) + off; }
        const int nig = 8 * nN, gid = wgid / nig, fm = gid * 8, gsz = (nM - fm) < 8 ? (nM - fm) : 8;
        u.pm = fm + ((wgid % nig) % gsz); u.pn = (wgid % nig) / gsz; u.e = 0; return true;
    }
};
struct AddrPlain {
    const char* A; const char* Bt; unsigned lda2, ldb2;
    __device__ __forceinline__ unsigned a_off(const Unit& u, int row) const { return (unsigned)(u.pm * 256 + row) * lda2; }
    __device__ __forceinline__ unsigned b_off(const Unit& u, int row) const { return (unsigned)(u.pn * 256 + row) * ldb2; }
};

template <class Epi, class Sched, class Addr>
__device__ __forceinline__ void gemm_phase(char* ldsc, const Sched& S, const Addr& AD, const Epi& E, int nt) {
    __attribute__((address_space(3))) unsigned char* lds = (__attribute__((address_space(3))) unsigned char*)ldsc;
    int tid_ = threadIdx.x; asm volatile("" : "+v"(tid_));
    const int tid = tid_, wid = __builtin_amdgcn_readfirstlane(tid >> 6), lane = tid & 63, wr = wid >> 2, wc = wid & 3, fr = lane & 15, fq = lane >> 4;
    int R[2], C2[2], Rb[2];
#pragma unroll
    for (int i = 0; i < 2; ++i) { int r_, c_; stage_rc(tid * 16 + i * 8192, r_, c_); R[i] = r_; C2[i] = c_ * 2; Rb[i] = Epi::PERM ? ((r_ & ~31) + perm32(r_ & 31)) : r_; }
    const unsigned ldsw = (unsigned)wid * 1024u;
    const int aoff = lds_byte(wr * 64 + fr, fq * 8), boff = lds_byte(wc * 32 + fr, fq * 8);
    const char* const Ab = AD.A; const char* const Bb = AD.Bt;
#define G8_SA(b, h) (((b) * 2 + (h)) * HTB)
#define G8_SB(b, h) ((4 + (b) * 2 + (h)) * HTB)
#define G8_SETOFF(va, vb, u) do { _Pragma("unroll") for (int h_ = 0; h_ < 2; ++h_) _Pragma("unroll") for (int i_ = 0; i_ < 2; ++i_) { \
        va[h_][i_] = AD.a_off(u, h_ * 128 + R[i_]) + (unsigned)C2[i_]; vb[h_][i_] = AD.b_off(u, h_ * 128 + Rb[i_]) + (unsigned)C2[i_]; } } while (0)
#define G8_STAGE(bufoff, base, v2, kb) do { _Pragma("unroll") for (int _i = 0; _i < 2; ++_i) \
        __builtin_amdgcn_global_load_lds((const __attribute__((address_space(1))) unsigned*)((base) + (size_t)(v2)[_i] + (size_t)(kb)), (__attribute__((address_space(3))) unsigned*)(lds + (bufoff) + ldsw + _i * 8192), 16, 0, 0); } while (0)
#define G8_LDA(dst, b, h) do { _Pragma("unroll") for (int m = 0; m < 4; ++m) _Pragma("unroll") for (int k = 0; k < 2; ++k) dst[m][k] = *(const __attribute__((address_space(3))) bf16x8*)(lds + G8_SA(b, h) + aoff + m * 2048 + k * 1024); } while (0)
#define G8_LDB(dst, b, h) do { _Pragma("unroll") for (int n = 0; n < 2; ++n) _Pragma("unroll") for (int k = 0; k < 2; ++k) dst[n][k] = *(const __attribute__((address_space(3))) bf16x8*)(lds + G8_SB(b, h) + boff + n * 2048 + k * 1024); } while (0)
#define G8_MMA(ai, bj, At, Bt) do { __builtin_amdgcn_s_setprio(1); _Pragma("unroll") for (int m = 0; m < 4; ++m) _Pragma("unroll") for (int n = 0; n < 2; ++n) _Pragma("unroll") for (int k = 0; k < 2; ++k) \
        acc[ai][bj][m][n] = __builtin_amdgcn_mfma_f32_16x16x32_bf16(Bt[n][k], At[m][k], acc[ai][bj][m][n], 0, 0, 0); __builtin_amdgcn_s_setprio(0); } while (0)
#define G8_WAIT_V(n) asm volatile("s_waitcnt vmcnt(" #n ")" ::: "memory")
#define G8_WAIT_L(n) asm volatile("s_waitcnt lgkmcnt(" #n ")" ::: "memory")
#define G8_BAR __builtin_amdgcn_s_barrier()
#define G8_SCHED __builtin_amdgcn_sched_barrier(0)
    Unit cur, nxt; int ui = 0;
    if (!S.next(0, cur)) return;
    f32x4 acc[2][2][4][2];
#pragma unroll
    for (int a = 0; a < 2; ++a)
#pragma unroll
        for (int b = 0; b < 2; ++b)
#pragma unroll
            for (int m = 0; m < 4; ++m)
#pragma unroll
                for (int n = 0; n < 2; ++n) acc[a][b][m][n] = (f32x4){0.f, 0.f, 0.f, 0.f};
    bf16x8 At[4][2], B0[2][2], B1[2][2];
    unsigned cvA[2][2], cvB[2][2];
    G8_SETOFF(cvA, cvB, cur);
    __syncthreads();
    G8_STAGE(G8_SB(0, 0), Bb, cvB[0], 0); G8_STAGE(G8_SA(0, 0), Ab, cvA[0], 0); G8_STAGE(G8_SB(0, 1), Bb, cvB[1], 0); G8_STAGE(G8_SA(0, 1), Ab, cvA[1], 0);
    if (wr == 1) G8_BAR;
    G8_WAIT_V(4); G8_BAR;
    G8_STAGE(G8_SB(1, 0), Bb, cvB[0], 128); G8_STAGE(G8_SA(1, 0), Ab, cvA[0], 128); G8_STAGE(G8_SB(1, 1), Bb, cvB[1], 128);
    G8_WAIT_V(6); G8_BAR;
    for (;;) {
        const bool has_next = S.next(ui + 1, nxt);
        for (int t = 0; t < nt; t += 2) {
            const bool last = (t == nt - 2);
            unsigned sA[2][2], sB[2][2];
            if (last && has_next) { G8_SETOFF(sA, sB, nxt); }
            else {
#pragma unroll
                for (int h_ = 0; h_ < 2; ++h_)
#pragma unroll
                    for (int i_ = 0; i_ < 2; ++i_) { sA[h_][i_] = cvA[h_][i_]; sB[h_][i_] = cvB[h_][i_]; }
            }
            const int kb1 = (t + 1) * 128, kb2 = last ? 0 : (t + 2) * 128, kb3 = kb2 + 128;
            G8_LDB(B0, 0, 0); G8_SCHED; G8_LDA(At, 0, 0); G8_STAGE(G8_SA(1, 1), Ab, cvA[1], kb1);
            G8_WAIT_L(8); G8_BAR; G8_WAIT_L(0); G8_MMA(0, 0, At, B0); G8_BAR; G8_SCHED;
            G8_LDB(B1, 0, 1); G8_STAGE(G8_SB(0, 0), Bb, sB[0], kb2);
            G8_BAR; G8_WAIT_L(0); G8_MMA(0, 1, At, B1); G8_BAR;
            G8_LDA(At, 0, 1); G8_STAGE(G8_SA(0, 0), Ab, sA[0], kb2);
            G8_BAR; G8_WAIT_L(0); G8_MMA(1, 0, At, B0); G8_BAR; G8_SCHED;
            G8_STAGE(G8_SB(0, 1), Bb, sB[1], kb2);
            G8_WAIT_V(6); G8_BAR; G8_MMA(1, 1, At, B1); G8_BAR;
            G8_LDB(B0, 1, 0); G8_SCHED; G8_LDA(At, 1, 0); G8_STAGE(G8_SA(0, 1), Ab, sA[1], kb2);
            G8_WAIT_L(8); G8_BAR; G8_WAIT_L(0); G8_MMA(0, 0, At, B0); G8_BAR; G8_SCHED;
            G8_LDB(B1, 1, 1); G8_STAGE(G8_SB(1, 0), Bb, sB[0], kb3);
            G8_BAR; G8_WAIT_L(0); G8_MMA(0, 1, At, B1); G8_BAR;
            G8_LDA(At, 1, 1); G8_STAGE(G8_SA(1, 0), Ab, sA[0], kb3);
            G8_BAR; G8_WAIT_L(0); G8_MMA(1, 0, At, B0); G8_BAR; G8_SCHED;
            G8_STAGE(G8_SB(1, 1), Bb, sB[1], kb3);
            G8_WAIT_V(6); G8_BAR; G8_MMA(1, 1, At, B1); G8_BAR;
            if (last && has_next) {
#pragma unroll
                for (int h_ = 0; h_ < 2; ++h_)
#pragma unroll
                    for (int i_ = 0; i_ < 2; ++i_) { cvA[h_][i_] = sA[h_][i_]; cvB[h_][i_] = sB[h_][i_]; }
            }
        }
        E(acc, cur, wr, wc, fr, fq);
        if (!has_next) break;
#pragma unroll
        for (int a = 0; a < 2; ++a)
#pragma unroll
            for (int b = 0; b < 2; ++b)
#pragma unroll
                for (int m = 0; m < 4; ++m)
#pragma unroll
                    for (int n = 0; n < 2; ++n) acc[a][b][m][n] = (f32x4){0.f, 0.f, 0.f, 0.f};
        cur = nxt; ++ui;
    }
    G8_WAIT_V(0);
    if (wr == 0) G8_BAR;
    G8_BAR;
#undef G8_SA
#undef G8_SB
#undef G8_SETOFF
#undef G8_STAGE
#undef G8_LDA
#undef G8_LDB
#undef G8_MMA
#undef G8_WAIT_V
#undef G8_WAIT_L
#undef G8_BAR
#undef G8_SCHED
}

struct EpiProj {
    static constexpr bool PERM = true;
    bf16_t* proj;
    __device__ __forceinline__ void operator()(const f32x4 (&acc)[2][2][4][2], const Unit& u, int wr, int wc, int fr, int fq) const {
#pragma unroll
        for (int ai = 0; ai < 2; ++ai)
#pragma unroll
            for (int m = 0; m < 4; ++m) {
                const int r = u.pm * 256 + ai * 128 + wr * 64 + m * 16 + fr;
#pragma unroll
                for (int bj = 0; bj < 2; ++bj) {
                    const int c = u.pn * 256 + bj * 128 + wc * 32 + 8 * fq;
                    if (c < NPROJ) {
                        u32x4 w; w[0] = pack_bf16(acc[ai][bj][m][0][0], acc[ai][bj][m][0][1]); w[1] = pack_bf16(acc[ai][bj][m][0][2], acc[ai][bj][m][0][3]);
                        w[2] = pack_bf16(acc[ai][bj][m][1][0], acc[ai][bj][m][1][1]); w[3] = pack_bf16(acc[ai][bj][m][1][2], acc[ai][bj][m][1][3]);
                        *(u32x4*)(proj + (size_t)r * PP + c) = w;
                    }
                }
            }
    }
};
struct EpiResid {
    static constexpr bool PERM = false;
    const float* x; float* x2;
    __device__ __forceinline__ void operator()(const f32x4 (&acc)[2][2][4][2], const Unit& u, int wr, int wc, int fr, int fq) const {
#pragma unroll
        for (int ai = 0; ai < 2; ++ai)
#pragma unroll
            for (int m = 0; m < 4; ++m) {
                const int r = u.pm * 256 + ai * 128 + wr * 64 + m * 16 + fr;
#pragma unroll
                for (int bj = 0; bj < 2; ++bj)
#pragma unroll
                    for (int n = 0; n < 2; ++n) {
                        const int c = u.pn * 256 + bj * 128 + wc * 32 + 16 * n + 4 * fq;
                        const f32x4 xv = *(const f32x4*)(x + (size_t)r * 1024 + c);
                        *(f32x4*)(x2 + (size_t)r * 1024 + c) = xv + acc[ai][bj][m][n];
                    }
            }
    }
};
struct OneUnit { Unit u; __device__ __forceinline__ bool next(int i, Unit& o) const { if (i) return false; o = u; return true; } };
template <int OP>
struct EpiMerge {
    static constexpr bool PERM = true;
    bf16_t* dst; const bf16_t* src2;
    __device__ __forceinline__ void operator()(const f32x4 (&acc)[2][2][4][2], const Unit& u, int wr, int wc, int fr, int fq) const {
#pragma unroll
        for (int ai = 0; ai < 2; ++ai)
#pragma unroll
            for (int m = 0; m < 4; ++m) {
                const int r = u.pm * 256 + ai * 128 + wr * 64 + m * 16 + fr;
#pragma unroll
                for (int bj = 0; bj < 2; ++bj) {
                    const size_t o = (size_t)r * 1024 + u.pn * 256 + bj * 128 + wc * 32 + 8 * fq;
                    float v[8];
#pragma unroll
                    for (int j = 0; j < 4; ++j) { v[j] = acc[ai][bj][m][0][j]; v[4 + j] = acc[ai][bj][m][1][j]; }
                    if (OP == 0) {
#pragma unroll
                        for (int j = 0; j < 8; ++j) v[j] = sigmoidf_(v[j]);
                    } else {
                        const u32x4 d = *(const u32x4*)(dst + o);
                        float dv[8];
#pragma unroll
                        for (int j = 0; j < 4; ++j) { dv[2 * j] = __uint_as_float(d[j] << 16); dv[2 * j + 1] = __uint_as_float(d[j] & 0xFFFF0000u); }
                        if (OP == 1) {
#pragma unroll
                            for (int j = 0; j < 8; ++j) v[j] = dv[j] * v[j];
                        } else {
                            const u32x4 s = *(const u32x4*)(src2 + o);
#pragma unroll
                            for (int j = 0; j < 4; ++j) { v[2 * j] = dv[2 * j] + __uint_as_float(s[j] << 16) * v[2 * j]; v[2 * j + 1] = dv[2 * j + 1] + __uint_as_float(s[j] & 0xFFFF0000u) * v[2 * j + 1]; }
                        }
                    }
                    u32x4 w; w[0] = pack_bf16(v[0], v[1]); w[1] = pack_bf16(v[2], v[3]); w[2] = pack_bf16(v[4], v[5]); w[3] = pack_bf16(v[6], v[7]);
                    *(u32x4*)(dst + o) = w;
                }
            }
    }
};
}

constexpr float LOG2E = 1.4426950408889634f;
constexpr float NEGV = -3.0e38f;
constexpr int NSA_TB = 32768;
constexpr int NSA_IMPA = 34816;
constexpr int NSA_IMPB = NSA_IMPA + 16640;
constexpr int NSA_SELM = NSA_IMPB + 16640;

__device__ __forceinline__ int t5_bucket2(int n) {
    if (n < 16) return n;
    const int l = 16 + (int)(logf((float)n / 16.0f) / logf(8.0f) * 16.0f);
    return l < 31 ? l : 31;
}

template <int MODE, bool A0, bool A1>
__device__ __forceinline__ void nsa_tile(const char* Kst, const char* Vst, int j, bool fast, const float* tbias, const bf16x8 (&qf)[2][2], const int (&qidx)[2],
                                         const unsigned long long (&selq)[2], f32x4 (&O)[4][2], float (&m)[2], float (&l)[2], const float (&invl)[2],
                                         char* smem, int fr, int fq, int hp, int wid) {
    const float b127 = tbias[127];
    bf16x8 pf[2][2];
    bool started = true;
    if (MODE != 3) started = __builtin_amdgcn_ballot_w64((A0 && m[0] < -1e29f) || (A1 && m[1] < -1e29f)) == 0ull;
    const bool quick = (MODE != 3) && fast && started;
    f32x4 sall[2][2][2];
#pragma unroll
    for (int p = 0; p < 2; ++p)
#pragma unroll
        for (int s = 0; s < 2; ++s) {
            const int row = 32 * p + 16 * s + fr;
            const bf16x8 k0 = *(const bf16x8*)(Kst + tile_off(row, fq)), k1 = *(const bf16x8*)(Kst + tile_off(row, 4 + fq));
#pragma unroll
            for (int ct = 0; ct < 2; ++ct) {
                if ((ct == 0 && !A0) || (ct == 1 && !A1)) continue;
                float i0 = 0.f;
                if (quick) { const bool sel = (MODE == 1) ? (((selq[ct] >> j) & 1ull) != 0ull) : true; i0 = (sel ? b127 : NEGV) - m[ct]; }
                f32x4 a = (f32x4){i0, i0, i0, i0};
                a = __builtin_amdgcn_mfma_f32_16x16x32_bf16(k0, qf[ct][0], a, 0, 0, 0);
                a = __builtin_amdgcn_mfma_f32_16x16x32_bf16(k1, qf[ct][1], a, 0, 0, 0);
                sall[ct][p][s] = a;
            }
        }
#pragma unroll
    for (int ct = 0; ct < 2; ++ct) {
        if ((ct == 0 && !A0) || (ct == 1 && !A1)) continue;
        f32x4 (&sacc)[2][2] = sall[ct];
        const int q = qidx[ct];
        const bool sel = (MODE == 1) ? (((selq[ct] >> j) & 1ull) != 0ull) : true;
        if (MODE != 3) {
            const float mct = m[ct];
            if (!quick) {
                const float ref = started ? mct : 0.f;
#pragma unroll
                for (int p = 0; p < 2; ++p)
#pragma unroll
                    for (int s = 0; s < 2; ++s)
#pragma unroll
                        for (int i = 0; i < 4; ++i) {
                            const int kk = 64 * j + 32 * p + 8 * fq + 4 * s + i;
                            int rel; bool valid;
                            if (MODE == 0) { rel = q - (16 * kk + 31); valid = rel >= 0; }
                            else if (MODE == 1) { rel = q - kk; valid = (rel >= 0) && sel; }
                            else { rel = q - kk; valid = (rel >= 0) && (rel < 512); }
                            const int rc = rel < 0 ? 0 : (rel > 127 ? 127 : rel);
                            sacc[p][s][i] = valid ? sacc[p][s][i] + (tbias[rc] - ref) : NEGV;
                        }
            }
            float pv[2][8]; float psum = 0.f;
            bool redo = !started;
            if (started) {
#pragma unroll
                for (int p = 0; p < 2; ++p)
#pragma unroll
                    for (int s = 0; s < 2; ++s)
#pragma unroll
                        for (int i = 0; i < 4; ++i) { pv[p][s * 4 + i] = __builtin_amdgcn_exp2f(sacc[p][s][i]); psum += pv[p][s * 4 + i]; }
                if (__builtin_amdgcn_ballot_w64(!(psum <= 256.0f)) != 0ull) {
                    redo = true;
#pragma unroll
                    for (int p = 0; p < 2; ++p)
#pragma unroll
                        for (int s = 0; s < 2; ++s)
#pragma unroll
                            for (int i = 0; i < 4; ++i) sacc[p][s][i] += mct;
                }
            }
            if (redo) {
                float mloc = NEGV;
#pragma unroll
                for (int p = 0; p < 2; ++p)
#pragma unroll
                    for (int s = 0; s < 2; ++s)
#pragma unroll
                        for (int i = 0; i < 4; ++i) mloc = fmaxf(mloc, sacc[p][s][i]);
                mloc = fmaxf(mloc, __shfl_xor(mloc, 16)); mloc = fmaxf(mloc, __shfl_xor(mloc, 32));
                const float mnew = fmaxf(mct, mloc);
                const float alpha = __builtin_amdgcn_exp2f(mct - mnew);
                m[ct] = mnew; l[ct] *= alpha;
#pragma unroll
                for (int dt = 0; dt < 4; ++dt) O[dt][ct] = O[dt][ct] * alpha;
                psum = 0.f;
#pragma unroll
                for (int p = 0; p < 2; ++p)
#pragma unroll
                    for (int s = 0; s < 2; ++s)
#pragma unroll
                        for (int i = 0; i < 4; ++i) { pv[p][s * 4 + i] = __builtin_amdgcn_exp2f(sacc[p][s][i] - mnew); psum += pv[p][s * 4 + i]; }
            }
#pragma unroll
            for (int p = 0; p < 2; ++p) {
                u32x4 w; w[0] = pack_bf16(pv[p][0], pv[p][1]); w[1] = pack_bf16(pv[p][2], pv[p][3]); w[2] = pack_bf16(pv[p][4], pv[p][5]); w[3] = pack_bf16(pv[p][6], pv[p][7]);
                pf[ct][p] = __builtin_bit_cast(bf16x8, w);
            }
            l[ct] += psum;
        } else {
#pragma unroll
            for (int p = 0; p < 2; ++p)
#pragma unroll
                for (int s = 0; s < 2; ++s)
#pragma unroll
                    for (int i = 0; i < 4; ++i) {
                        const int kk = 64 * j + 32 * p + 8 * fq + 4 * s + i;
                        const int rel = q - (16 * kk + 31);
                        const int rc = rel < 0 ? 0 : (rel > 127 ? 127 : rel);
                        sacc[p][s][i] = (rel >= 0) ? sacc[p][s][i] + tbias[rc] : NEGV;
                    }
            float* impA = (float*)(smem + NSA_IMPA); float* impB = (float*)(smem + NSA_IMPB);
            const int ql = wid * 8 + ct * 4 + (fr >> 2);
#pragma unroll
            for (int p = 0; p < 2; ++p)
#pragma unroll
                for (int s = 0; s < 2; ++s) {
                    float p3 = __builtin_amdgcn_exp2f(sacc[p][s][3] - m[ct]) * invl[ct];
                    float pa = __builtin_amdgcn_exp2f(sacc[p][s][0] - m[ct]) * invl[ct] + __builtin_amdgcn_exp2f(sacc[p][s][1] - m[ct]) * invl[ct]
                             + __builtin_amdgcn_exp2f(sacc[p][s][2] - m[ct]) * invl[ct] + p3;
                    pa += __shfl_xor(pa, 1); pa += __shfl_xor(pa, 2);
                    p3 += __shfl_xor(p3, 1); p3 += __shfl_xor(p3, 2);
                    const int jj = 16 * j + 8 * p + 2 * fq + s;
                    if (hp == 0) { impA[ql * 65 + jj] = pa; impB[ql * 65 + jj + 1] = p3; }
                }
        }
    }
    if (MODE != 3) {
#pragma unroll
        for (int dt = 0; dt < 4; ++dt)
#pragma unroll
            for (int p = 0; p < 2; ++p) {
                const bf16x8 vf = *(const bf16x8*)(Vst + tile_off(dt * 16 + fr, p * 4 + fq));
                if (A0) O[dt][0] = __builtin_amdgcn_mfma_f32_16x16x32_bf16(vf, pf[0][p], O[dt][0], 0, 0, 0);
                if (A1) O[dt][1] = __builtin_amdgcn_mfma_f32_16x16x32_bf16(vf, pf[1][p], O[dt][1], 0, 0, 0);
            }
    }
}

template <int MODE>
__device__ __forceinline__ void nsa_branch(const bf16_t* __restrict__ Kb, size_t kstride, const bf16_t* __restrict__ Vb, size_t vstride, int j0, int ntiles, int t0,
                                           const bf16x8 (&qf)[2][2], const int (&qidx)[2], const unsigned long long (&selq)[2], unsigned long long selor0, unsigned long long selor1,
                                           f32x4 (&O)[4][2], float (&m)[2], float (&l)[2], const float (&invl)[2], char* smem) {
    int tid_ = threadIdx.x; asm volatile("" : "+v"(tid_));
    const int tid = tid_, lane = tid & 63, wid = tid >> 6, fr = lane & 15, fq = lane >> 4, hp = fr & 3;
    const int lrow = tid >> 3;
    const float* tbias = (const float*)(smem + NSA_TB) + hp * 128;
    const int sch8 = ((tid & 7) ^ (lrow & 7)) * 8;
    const int krow = 32 * (lrow >> 5) + 8 * ((lrow & 15) >> 2) + 4 * ((lrow >> 4) & 1) + (lrow & 3);
    const bf16_t* kp = Kb + (size_t)krow * kstride + sch8;
    const bf16_t* vp = Vb + (size_t)lrow * vstride + sch8;
    __syncthreads();
    glds16(kp, smem + tid * 16); if (MODE != 3) glds16(vp, smem + 8192 + tid * 16);
    asm volatile("s_waitcnt vmcnt(0)" ::: "memory");
    __syncthreads();
    for (int it = 0; it < ntiles; ++it) {
        const int cur = it & 1, j = j0 + it;
        if (it + 1 < ntiles) {
            char* st = smem + (cur ^ 1) * 16384 + tid * 16;
            glds16(kp + (size_t)(it + 1) * 64 * kstride, st); if (MODE != 3) glds16(vp + (size_t)(it + 1) * 64, st + 8192);
        }
        const char* Kst = smem + cur * 16384;
        const char* Vst = Kst + 8192;
        bool fast;
        if (MODE == 0 || MODE == 3) fast = (t0 - (16 * (64 * j + 63) + 31)) >= 128;
        else if (MODE == 1) fast = (t0 - (64 * j + 63)) >= 128;
        else fast = ((t0 - (64 * j + 63)) >= 128) && ((t0 + 63 - 64 * j) < 512);
        if (MODE == 1) {
            const bool a0 = ((selor0 >> j) & 1ull) != 0ull, a1 = ((selor1 >> j) & 1ull) != 0ull;
            if (a0 && a1) nsa_tile<MODE, true, true>(Kst, Vst, j, fast, tbias, qf, qidx, selq, O, m, l, invl, smem, fr, fq, hp, wid);
            else if (a0) nsa_tile<MODE, true, false>(Kst, Vst, j, fast, tbias, qf, qidx, selq, O, m, l, invl, smem, fr, fq, hp, wid);
            else if (a1) nsa_tile<MODE, false, true>(Kst, Vst, j, fast, tbias, qf, qidx, selq, O, m, l, invl, smem, fr, fq, hp, wid);
        } else {
            nsa_tile<MODE, true, true>(Kst, Vst, j, fast, tbias, qf, qidx, selq, O, m, l, invl, smem, fr, fq, hp, wid);
        }
        asm volatile("s_waitcnt vmcnt(0)" ::: "memory");
        __syncthreads();
    }
}

__device__ __forceinline__ void osum_add(uint2& acc, f32x4 o, float sc) {
    f32x4 v;
    v[0] = __uint_as_float(acc.x << 16) + o[0] * sc; v[1] = __uint_as_float(acc.x & 0xFFFF0000u) + o[1] * sc;
    v[2] = __uint_as_float(acc.y << 16) + o[2] * sc; v[3] = __uint_as_float(acc.y & 0xFFFF0000u) + o[3] * sc;
    acc = pack4(v);
}
__device__ __forceinline__ float nsa_gate(const bf16_t* __restrict__ pb, int q, int br, int head) { return sigmoidf_(bf2f(pb[(size_t)q * PP + GA + br * 8 + head])); }

__device__ __forceinline__ void nsa_unit(int u, const bf16_t* __restrict__ proj, const char* __restrict__ ws, const float* __restrict__ rel_bias, bf16_t* __restrict__ ya, char* smem) {
    int tid_ = threadIdx.x; asm volatile("" : "+v"(tid_));
    const int tid = tid_, lane = tid & 63, wid = tid >> 6, fr = lane & 15, fq = lane >> 4, hp = fr & 3;
    const int bg = u & 7, qb = 63 - (u >> 3), b = bg >> 1, g = bg & 1, t0 = qb * 64, tb = qb;
    const bf16_t* kcb = (const bf16_t*)(ws + OFF_KCB) + (size_t)bg * 256 * 64;
    const bf16_t* vcbT = (const bf16_t*)(ws + OFF_VCBT) + (size_t)bg * 64 * 256;
    const bf16_t* VsT = (const bf16_t*)(ws + OFF_VST) + (size_t)bg * 64 * S;
    const bf16_t* VwT = (const bf16_t*)(ws + OFF_VWT) + (size_t)bg * 64 * S;
    const bf16_t* pb = proj + (size_t)b * S * PP;
    __syncthreads();
    {
        float* tbl = (float*)(smem + NSA_TB);
        { const int e = tid, h4 = e >> 7, n = e & 127; tbl[e] = rel_bias[t5_bucket2(n) * 8 + g * 4 + h4] * LOG2E; }
        float* imp = (float*)(smem + NSA_IMPA);
        for (int e = tid; e < 2 * 4160; e += 512) imp[e] = 0.f;
    }
    int qidx[2]; bf16x8 qf[2][2];
    const int head = g * 4 + hp;
#pragma unroll
    for (int ct = 0; ct < 2; ++ct) {
        qidx[ct] = t0 + wid * 8 + ct * 4 + (fr >> 2);
        const bf16_t* qr = pb + (size_t)qidx[ct] * PP;
#pragma unroll
        for (int ks = 0; ks < 2; ++ks) {
            const u32x4 raw = *(const u32x4*)(qr + QA + head * 64 + ks * 32 + fq * 8);
            u32x4 w;
#pragma unroll
            for (int e = 0; e < 4; ++e) w[e] = pack_bf16(__uint_as_float(raw[e] << 16) * (0.125f * LOG2E), __uint_as_float(raw[e] & 0xFFFF0000u) * (0.125f * LOG2E));
            qf[ct][ks] = __builtin_bit_cast(bf16x8, w);
        }
    }
    uint2 osum[4][2];
#pragma unroll
    for (int dt = 0; dt < 4; ++dt)
#pragma unroll
        for (int ct = 0; ct < 2; ++ct) osum[dt][ct] = make_uint2(0u, 0u);
    unsigned long long selq[2] = {0ull, 0ull};
    float invl0[2] = {0.f, 0.f};
    const int ntc = (((t0 + 32) >> 4) + 1 + 63) >> 6;
    float mC[2], invC[2];
    {
        f32x4 O[4][2]; float m[2] = {-1e30f, -1e30f}, l[2] = {0.f, 0.f};
#pragma unroll
        for (int dt = 0; dt < 4; ++dt)
#pragma unroll
            for (int ct = 0; ct < 2; ++ct) O[dt][ct] = (f32x4){0.f, 0.f, 0.f, 0.f};
        nsa_branch<0>(kcb, 64, vcbT, 256, 0, ntc, t0, qf, qidx, selq, 0ull, 0ull, O, m, l, invl0, smem);
#pragma unroll
        for (int ct = 0; ct < 2; ++ct) {
            float lt = l[ct]; lt += __shfl_xor(lt, 16); lt += __shfl_xor(lt, 32);
            invC[ct] = lt > 0.f ? 1.f / lt : 0.f; mC[ct] = m[ct];
#pragma unroll
            for (int dt = 0; dt < 4; ++dt) osum_add(osum[dt][ct], O[dt][ct], nsa_gate(pb, qidx[ct], 0, head) * invC[ct]);
        }
        nsa_branch<3>(kcb, 64, vcbT, 256, 0, ntc, t0, qf, qidx, selq, 0ull, 0ull, O, mC, l, invC, smem);
    }
    {
        const float* impA = (const float*)(smem + NSA_IMPA); const float* impB = (const float*)(smem + NSA_IMPB);
        unsigned long long* selm = (unsigned long long*)(smem + NSA_SELM);
#pragma unroll 1
        for (int qq = 0; qq < 8; ++qq) {
            const int ql = wid * 8 + qq;
            const float val = impA[ql * 65 + lane] + impB[ql * 65 + lane];
            const bool forced = (lane == 0) || (lane == tb) || (lane == tb - 1);
            unsigned key = forced ? 0xFFFFFFC0u : (lane > tb ? 0u : (__float_as_uint(val) & 0xFFFFFFC0u));
            key |= (unsigned)(63 - lane);
            int rank = 0;
#pragma unroll
            for (int jp = 0; jp < 64; ++jp) rank += ((unsigned)__builtin_amdgcn_readlane((int)key, jp) > key) ? 1 : 0;
            const unsigned long long msk = __ballot(rank < 16);
            if (lane == 0) selm[ql] = msk;
        }
        wave_lds_sync();
        unsigned long long so0 = 0ull, so1 = 0ull;
#pragma unroll
        for (int qq = 0; qq < 4; ++qq) { so0 |= selm[wid * 8 + qq]; so1 |= selm[wid * 8 + 4 + qq]; }
        const unsigned long long selor0 = ((unsigned long long)(unsigned)__builtin_amdgcn_readfirstlane((int)(unsigned)(so0 >> 32)) << 32) | (unsigned)__builtin_amdgcn_readfirstlane((int)(unsigned)so0);
        const unsigned long long selor1 = ((unsigned long long)(unsigned)__builtin_amdgcn_readfirstlane((int)(unsigned)(so1 >> 32)) << 32) | (unsigned)__builtin_amdgcn_readfirstlane((int)(unsigned)so1);
        selq[0] = selm[wid * 8 + (fr >> 2)]; selq[1] = selm[wid * 8 + 4 + (fr >> 2)];
        {
            f32x4 O[4][2]; float m[2] = {-1e30f, -1e30f}, l[2] = {0.f, 0.f};
#pragma unroll
            for (int dt = 0; dt < 4; ++dt)
#pragma unroll
                for (int ct = 0; ct < 2; ++ct) O[dt][ct] = (f32x4){0.f, 0.f, 0.f, 0.f};
            nsa_branch<1>(pb + KS + g * 64, PP, VsT, S, 0, tb + 1, t0, qf, qidx, selq, selor0, selor1, O, m, l, invl0, smem);
#pragma unroll
            for (int ct = 0; ct < 2; ++ct) {
                float lt = l[ct]; lt += __shfl_xor(lt, 16); lt += __shfl_xor(lt, 32);
                const float inv = lt > 0.f ? 1.f / lt : 0.f;
#pragma unroll
                for (int dt = 0; dt < 4; ++dt) osum_add(osum[dt][ct], O[dt][ct], nsa_gate(pb, qidx[ct], 1, head) * inv);
            }
        }
    }
    {
        f32x4 O[4][2]; float m[2] = {-1e30f, -1e30f}, l[2] = {0.f, 0.f};
#pragma unroll
        for (int dt = 0; dt < 4; ++dt)
#pragma unroll
            for (int ct = 0; ct < 2; ++ct) O[dt][ct] = (f32x4){0.f, 0.f, 0.f, 0.f};
        const int jw0 = (t0 - 511 < 0 ? 0 : t0 - 511) >> 6;
        nsa_branch<2>(pb + (size_t)jw0 * 64 * PP + KW + g * 64, PP, VwT + jw0 * 64, S, jw0, tb - jw0 + 1, t0, qf, qidx, selq, 0ull, 0ull, O, m, l, invl0, smem);
#pragma unroll
        for (int ct = 0; ct < 2; ++ct) {
            float lt = l[ct]; lt += __shfl_xor(lt, 16); lt += __shfl_xor(lt, 32);
            const float inv = lt > 0.f ? 1.f / lt : 0.f;
#pragma unroll
            for (int dt = 0; dt < 4; ++dt) osum_add(osum[dt][ct], O[dt][ct], nsa_gate(pb, qidx[ct], 2, head) * inv);
        }
    }
#pragma unroll
    for (int ct = 0; ct < 2; ++ct) {
        bf16_t* yr = ya + (size_t)(b * S + qidx[ct]) * 512 + head * 64 + 4 * fq;
#pragma unroll
        for (int dt = 0; dt < 4; ++dt) *(uint2*)(yr + dt * 16) = osum[dt][ct];
    }
}

__device__ __forceinline__ void vtrans_tile(int task, const bf16_t* __restrict__ proj, char* ws, char* smem) {
    unsigned short (*tl)[66] = (unsigned short (*)[66])smem;
    const int tid = HB_TID, which = task >> 9, bg = (task >> 6) & 7, tt = task & 63, b = bg >> 1, g = bg & 1;
    const int r = tid >> 2, q4 = tid & 3;
    const bf16_t* src = proj + (size_t)(b * S + tt * 64 + r) * PP + (which ? VW : VS) + g * 64 + q4 * 16;
    const uint4 a0 = *(const uint4*)src, a1 = *(const uint4*)(src + 8);
    unsigned* trow = (unsigned*)&tl[r][q4 * 16];
    trow[0] = a0.x; trow[1] = a0.y; trow[2] = a0.z; trow[3] = a0.w; trow[4] = a1.x; trow[5] = a1.y; trow[6] = a1.z; trow[7] = a1.w;
    __syncthreads();
    bf16_t* dst = (bf16_t*)(ws + (which ? OFF_VWT : OFF_VST)) + ((size_t)bg * 64 + r) * S + tt * 64 + q4 * 16;
    unsigned o[8];
#pragma unroll
    for (int k = 0; k < 8; ++k) o[k] = (unsigned)tl[q4 * 16 + 2 * k][r] | ((unsigned)tl[q4 * 16 + 2 * k + 1][r] << 16);
    *(uint4*)dst = make_uint4(o[0], o[1], o[2], o[3]);
    *(uint4*)(dst + 8) = make_uint4(o[4], o[5], o[6], o[7]);
    __syncthreads();
}

__device__ __forceinline__ int tile_el(int row, int col) { return tile_off(row, col >> 3) + ((col & 7) << 1); }

__device__ __forceinline__ void gla_stage_vt(const bf16_t* __restrict__ proj, size_t row0, int h, char* vt_base) {
    const int tid = HB_TID, c = tid >> 2, vq = tid & 3;
    const bf16_t* src = proj + (row0 + c) * PP + VB + h * 128 + vq * 32;
#pragma unroll
    for (int k = 0; k < 4; ++k) {
        const u32x4 a = *(const u32x4*)(src + k * 8);
#pragma unroll
        for (int e = 0; e < 4; ++e) {
            const int v = vq * 32 + k * 8 + 2 * e;
            *(unsigned short*)(vt_base + tile_el(v, c)) = (unsigned short)(a[e] & 0xFFFFu);
            *(unsigned short*)(vt_base + tile_el(v + 1, c)) = (unsigned short)(a[e] >> 16);
        }
    }
}

__device__ __forceinline__ void gla_a_unit(int vb, const bf16_t* __restrict__ proj, const float* __restrict__ w_alpha, const float* __restrict__ b_alpha,
                                           float* __restrict__ bc, float* __restrict__ cstate, char* smem) {
    float (*bcS)[64] = (float (*)[64])smem;
    float (*tot)[64] = (float (*)[64])(smem + 16384);
    char* KDT = smem + 17408;
    char* VT = smem + 17408 + 8192;
    const int tid = HB_TID, lane = tid & 63, wid = tid >> 6, fr = lane & 15, fq = lane >> 4;
    const int n = vb & 63, h = (vb >> 6) & 3, b = vb >> 8;
    const size_t row0 = (size_t)(b * S + n * 64);
    __syncthreads();
    {
        const int d = tid & 63, cq = tid >> 6, col = h * 64 + d;
        float w[16];
#pragma unroll
        for (int r = 0; r < 16; ++r) w[r] = w_alpha[r * 256 + col];
        const float bias = b_alpha[col];
        float cum = 0.f;
        for (int i = 0; i < 16; ++i) {
            const int c = cq * 16 + i;
            const u32x4 a0 = *(const u32x4*)(proj + (row0 + c) * PP + AB), a1 = *(const u32x4*)(proj + (row0 + c) * PP + AB + 8);
            float z = bias;
#pragma unroll
            for (int e = 0; e < 4; ++e) {
                z += __uint_as_float(a0[e] << 16) * w[2 * e] + __uint_as_float(a0[e] & 0xFFFF0000u) * w[2 * e + 1];
                z += __uint_as_float(a1[e] << 16) * w[8 + 2 * e] + __uint_as_float(a1[e] & 0xFFFF0000u) * w[8 + 2 * e + 1];
            }
            const float ls = fminf(z, 0.f) - log1pf(__expf(-fabsf(z)));
            cum += ls * (1.0f / 16.0f);
            bcS[c][d] = cum;
        }
        tot[cq][d] = cum;
        __syncthreads();
        float pre = 0.f;
        for (int q = 0; q < cq; ++q) pre += tot[q][d];
        for (int i = 0; i < 16; ++i) {
            const int c = cq * 16 + i;
            const float v = bcS[c][d] + pre;
            bcS[c][d] = v;
            bc[(row0 + c) * 256 + col] = v;
        }
    }
    __syncthreads();
    {
        const int c = tid >> 2, dq = tid & 3;
        const bf16_t* src = proj + (row0 + c) * PP + KB + h * 64 + dq * 16;
#pragma unroll
        for (int k = 0; k < 2; ++k) {
            const u32x4 a = *(const u32x4*)(src + k * 8);
#pragma unroll
            for (int e = 0; e < 4; ++e) {
                const int d = dq * 16 + k * 8 + 2 * e;
                const float k0 = __uint_as_float(a[e] << 16) * __expf(bcS[63][d] - bcS[c][d]);
                const float k1 = __uint_as_float(a[e] & 0xFFFF0000u) * __expf(bcS[63][d + 1] - bcS[c][d + 1]);
                *(unsigned short*)(KDT + tile_el(d, c)) = f2bf(k0);
                *(unsigned short*)(KDT + tile_el(d + 1, c)) = f2bf(k1);
            }
        }
    }
    gla_stage_vt(proj, row0, h, VT);
    __syncthreads();
    float* outp = cstate + (size_t)vb * 8192;
#pragma unroll
    for (int vi = 0; vi < 2; ++vi) {
        const int vt = wid * 2 + vi;
        const bf16x8 a0 = *(const bf16x8*)(VT + tile_off(vt * 16 + fr, fq)), a1 = *(const bf16x8*)(VT + tile_off(vt * 16 + fr, 4 + fq));
#pragma unroll
        for (int dt = 0; dt < 4; ++dt) {
            const bf16x8 b0 = *(const bf16x8*)(KDT + tile_off(dt * 16 + fr, fq)), b1 = *(const bf16x8*)(KDT + tile_off(dt * 16 + fr, 4 + fq));
            f32x4 acc = (f32x4){0.f, 0.f, 0.f, 0.f};
            acc = __builtin_amdgcn_mfma_f32_16x16x32_bf16(a0, b0, acc, 0, 0, 0);
            acc = __builtin_amdgcn_mfma_f32_16x16x32_bf16(a1, b1, acc, 0, 0, 0);
#pragma unroll
            for (int i = 0; i < 4; ++i) outp[(vt * 16 + 4 * fq + i) * 64 + dt * 16 + fr] = acc[i];
        }
    }
}

__device__ __forceinline__ void gla_scan_vb2(int vb, const float* __restrict__ bc, float* __restrict__ cstate) {
    const int idx = vb * 512 + threadIdx.x;
    const int e = idx & 8191, bh = idx >> 13, b = bh >> 2, h = bh & 3, d = e & 63;
    float state = 0.f;
    float* base = cstate + (size_t)bh * 64 * 8192 + e;
    const float* bcp = bc + ((size_t)(b * S + 63)) * 256 + h * 64 + d;
#pragma unroll 1
    for (int n0 = 0; n0 < 64; n0 += 16) {
        float upd[16], dec[16];
#pragma unroll
        for (int i = 0; i < 16; ++i) { upd[i] = base[(size_t)(n0 + i) * 8192]; dec[i] = bcp[(size_t)(n0 + i) * 64 * 256]; }
#pragma unroll
        for (int i = 0; i < 16; ++i) { base[(size_t)(n0 + i) * 8192] = state; state = __expf(dec[i]) * state + upd[i]; }
    }
}

__device__ __forceinline__ void gla_c_unit(int vb, const bf16_t* __restrict__ proj, const float* __restrict__ bc, const float* __restrict__ prev,
                                           const float* __restrict__ norm_g, bf16_t* __restrict__ yb, char* smem) {
    char* QI = smem;
    char* KI = smem + 8192;
    char* VT = smem + 16384;
    char* PT = smem + 32768;
    const int tid = HB_TID, lane = tid & 63, wid = tid >> 6, fr = lane & 15, fq = lane >> 4;
    const int n = vb & 63, h = (vb >> 6) & 3, b = vb >> 8;
    const size_t row0 = (size_t)(b * S + n * 64);
    __syncthreads();
    {
        const int c = tid >> 2, dq = tid & 3;
        const bf16_t* qs = proj + (row0 + c) * PP + QB + h * 64 + dq * 16;
        const bf16_t* ks = proj + (row0 + c) * PP + KB + h * 64 + dq * 16;
        const float* bs = bc + (row0 + c) * 256 + h * 64 + dq * 16;
#pragma unroll
        for (int k = 0; k < 2; ++k) {
            const u32x4 qa = *(const u32x4*)(qs + k * 8), ka = *(const u32x4*)(ks + k * 8);
            const f32x4 b0 = *(const f32x4*)(bs + k * 8), b1 = *(const f32x4*)(bs + k * 8 + 4);
            const float bv[8] = {b0[0], b0[1], b0[2], b0[3], b1[0], b1[1], b1[2], b1[3]};
            u32x4 qo, ko;
#pragma unroll
            for (int e = 0; e < 4; ++e) {
                const float e0 = __expf(bv[2 * e]), e1 = __expf(bv[2 * e + 1]);
                qo[e] = pack_bf16(__uint_as_float(qa[e] << 16) * 0.125f * e0, __uint_as_float(qa[e] & 0xFFFF0000u) * 0.125f * e1);
                ko[e] = pack_bf16(__uint_as_float(ka[e] << 16) / e0, __uint_as_float(ka[e] & 0xFFFF0000u) / e1);
            }
            *(u32x4*)(QI + tile_off(c, dq * 2 + k)) = qo;
            *(u32x4*)(KI + tile_off(c, dq * 2 + k)) = ko;
        }
    }
    gla_stage_vt(proj, row0, h, VT);
    {
        const int v = tid >> 1, half = tid & 1;
        const float* ps = prev + (size_t)vb * 8192 + v * 64 + half * 32;
#pragma unroll
        for (int k = 0; k < 4; ++k) {
            const f32x4 a = *(const f32x4*)(ps + k * 8), c2 = *(const f32x4*)(ps + k * 8 + 4);
            u32x4 o; o[0] = pack_bf16(a[0], a[1]); o[1] = pack_bf16(a[2], a[3]); o[2] = pack_bf16(c2[0], c2[1]); o[3] = pack_bf16(c2[2], c2[3]);
            *(u32x4*)(PT + tile_off(v, half * 4 + k)) = o;
        }
    }
    __syncthreads();
    const bf16x8 qf0 = *(const bf16x8*)(QI + tile_off(wid * 16 + fr, fq)), qf1 = *(const bf16x8*)(QI + tile_off(wid * 16 + fr, 4 + fq));
    bf16x8 pf[2];
    const int c = wid * 16 + fr;
#pragma unroll
    for (int p = 0; p < 2; ++p) {
        u32x4 w;
#pragma unroll
        for (int s = 0; s < 2; ++s) {
            const int row = 32 * p + 8 * (fr >> 2) + 4 * s + (fr & 3);
            const bf16x8 k0 = *(const bf16x8*)(KI + tile_off(row, fq)), k1 = *(const bf16x8*)(KI + tile_off(row, 4 + fq));
            f32x4 a = (f32x4){0.f, 0.f, 0.f, 0.f};
            a = __builtin_amdgcn_mfma_f32_16x16x32_bf16(k0, qf0, a, 0, 0, 0);
            a = __builtin_amdgcn_mfma_f32_16x16x32_bf16(k1, qf1, a, 0, 0, 0);
#pragma unroll
            for (int i = 0; i < 4; ++i) { const int j = 32 * p + 8 * fq + 4 * s + i; if (j > c) a[i] = 0.f; }
            w[2 * s] = pack_bf16(a[0], a[1]); w[2 * s + 1] = pack_bf16(a[2], a[3]);
        }
        pf[p] = __builtin_bit_cast(bf16x8, w);
    }
    f32x4 acc[8];
    float ss = 0.f;
#pragma unroll
    for (int vt = 0; vt < 8; ++vt) {
        f32x4 a = (f32x4){0.f, 0.f, 0.f, 0.f};
        a = __builtin_amdgcn_mfma_f32_16x16x32_bf16(*(const bf16x8*)(VT + tile_off(vt * 16 + fr, fq)), pf[0], a, 0, 0, 0);
        a = __builtin_amdgcn_mfma_f32_16x16x32_bf16(*(const bf16x8*)(VT + tile_off(vt * 16 + fr, 4 + fq)), pf[1], a, 0, 0, 0);
        a = __builtin_amdgcn_mfma_f32_16x16x32_bf16(*(const bf16x8*)(PT + tile_off(vt * 16 + fr, fq)), qf0, a, 0, 0, 0);
        a = __builtin_amdgcn_mfma_f32_16x16x32_bf16(*(const bf16x8*)(PT + tile_off(vt * 16 + fr, 4 + fq)), qf1, a, 0, 0, 0);
        acc[vt] = a;
        ss += a[0] * a[0] + a[1] * a[1] + a[2] * a[2] + a[3] * a[3];
    }
    ss += __shfl_xor(ss, 16); ss += __shfl_xor(ss, 32);
    const float r = rsqrtf(ss * (1.0f / 128.0f) + 1e-6f);
    const size_t row = row0 + c;
#pragma unroll
    for (int vt = 0; vt < 8; ++vt) {
        const int col = h * 128 + vt * 16 + 4 * fq;
        const uint2 rr = *(const uint2*)(proj + row * PP + RB + col);
        const f32x4 g4 = *(const f32x4*)(norm_g + col);
        const float r0 = __uint_as_float(rr.x << 16), r1 = __uint_as_float(rr.x & 0xFFFF0000u), r2 = __uint_as_float(rr.y << 16), r3 = __uint_as_float(rr.y & 0xFFFF0000u);
        f32x4 o;
        o[0] = acc[vt][0] * r * g4[0] * (r0 * sigmoidf_(r0)); o[1] = acc[vt][1] * r * g4[1] * (r1 * sigmoidf_(r1));
        o[2] = acc[vt][2] * r * g4[2] * (r2 * sigmoidf_(r2)); o[3] = acc[vt][3] * r * g4[3] * (r3 * sigmoidf_(r3));
        *(uint2*)(yb + row * 512 + col) = pack4(o);
    }
}

constexpr int SMEM_BYTES = 131072;

__global__ void __launch_bounds__(512, 2) k_fwd(Params p) {
    extern __shared__ __attribute__((aligned(16))) char smem_dyn[];
    char* smem = smem_dyn + 16;
    char* smh = smem + (threadIdx.x >> 8) * 65536;
    if (threadIdx.x == 0) *(uint4*)smem_dyn = make_uint4(0u, 0u, 0u, 0u);
    __syncthreads();
    char* ws = p.ws;
    XcdBarrier bar = xcd_barrier_post((unsigned*)(ws + OFF_BAR), (volatile LAS unsigned*)smem_dyn);
    int* ctrl = (int*)(ws + OFF_CTRL);
    bf16_t* proj = (bf16_t*)(ws + OFF_PROJ);
    float* bc = (float*)(ws + OFF_BC);
    float* cstate = (float*)(ws + OFF_CSTATE);
    bf16_t* mrg = (bf16_t*)(ws + OFF_MRG);
    bf16_t* h2 = (bf16_t*)(ws + OFF_H2);
    bf16_t* hid = (bf16_t*)(ws + OFF_HID);
    bf16_t* Y0 = (bf16_t*)(ws + OFF_Y0);
    bf16_t* Y1 = (bf16_t*)(ws + OFF_Y1);
    bf16_t* ya = (bf16_t*)(ws + OFF_YA);
    bf16_t* yb = (bf16_t*)(ws + OFF_YB);
    bf16_t* kcb = (bf16_t*)(ws + OFF_KCB);
    bf16_t* vcb = (bf16_t*)(ws + OFF_VCB);
    bf16_t* h = (bf16_t*)p.out;
    const int G = gridDim.x;

    ph_prep(p, smh);
    xcd_barrier(bar);
    { g8::StaticOrder S; S.init(T, 3072, G, (int)blockIdx.x); const g8::AddrPlain AD{(const char*)h, (const char*)(ws + OFF_WINT), 2048u, 2048u};
      g8::gemm_phase(smem, S, AD, g8::EpiProj{proj}, 16); }
    xcd_barrier(bar);
    ph_cmp1(proj, ws, smh);
    {
        const int nc = G > 32 ? 16 : 0, gb = (int)blockIdx.x - nc, gs = G - nc;
        if (gb >= 0) {
            for (int pr = gb; pr < 512; pr += gs) vtrans_tile(2 * pr + HB_ID, proj, ws, smh);
            for (int pr = gb; pr < 512; pr += gs) gla_a_unit(2 * pr + HB_ID, proj, p.w_alpha, p.b_alpha, bc, cstate, smh);
        }
    }
    xcd_barrier(bar);
    ph_cmp2(ws, ws, smh);
    for (int vb = blockIdx.x; vb < 256; vb += G) gla_scan_vb2(vb, bc, cstate);
    ph_prep_experts(p, smh);
    xcd_barrier(bar);
    for (int vb = HB_FIRST; vb < 1024; vb += HB_STEP) gla_c_unit(vb, proj, bc, cstate, p.norm_g, yb, smh);
    for (int r = 0; r * G < 512; ++r) {
        const int u = r * G + ((r & 1) ? (G - 1 - (int)blockIdx.x) : (int)blockIdx.x);
        if (u < 512) nsa_unit(u, proj, ws, p.rel_bias, ya, smem);
    }
    xcd_barrier(bar);
    {
        g8::StaticOrder SO; SO.init(T, 1024, G, (int)blockIdx.x);
        bf16_t* sg2 = (bf16_t*)(ws + OFF_R1);
        g8::Unit mu;
        for (int i = 0; SO.next(i, mu); ++i) {
            const g8::OneUnit S1{mu};
            g8::Unit gu = mu;
            { const g8::AddrPlain AD{(const char*)h, (const char*)(ws + OFF_WINT) + (size_t)MGA * 2048, 2048u, 2048u}; g8::gemm_phase(smem, S1, AD, g8::EpiMerge<0>{mrg, nullptr}, 16); }
            { const g8::AddrPlain AD{(const char*)ya, (const char*)(ws + OFF_WAT), 1024u, 1024u}; g8::gemm_phase(smem, S1, AD, g8::EpiMerge<1>{mrg, nullptr}, 8); }
            { const g8::AddrPlain AD{(const char*)h, (const char*)(ws + OFF_WINT) + (size_t)MGB * 2048, 2048u, 2048u}; g8::gemm_phase(smem, S1, AD, g8::EpiMerge<0>{sg2, nullptr}, 16); }
            { const g8::AddrPlain AD{(const char*)yb, (const char*)(ws + OFF_WBT), 1024u, 1024u}; g8::gemm_phase(smem, S1, AD, g8::EpiMerge<2>{mrg, sg2}, 8); }
            (void)gu;
        }
    }
    xcd_barrier(bar);
    { g8::StaticOrder S; S.init(T, 1024, G, (int)blockIdx.x); const g8::AddrPlain AD{(const char*)mrg, (const char*)(ws + OFF_WOT), 2048u, 2048u};
      g8::gemm_phase(smem, S, AD, g8::EpiResid{p.x, p.out}, 16); }
    xcd_barrier(bar);
    for (int grp = HB_FIRST; grp < 512; grp += HB_STEP) {
        for (int tt = 0; tt < 2; ++tt) router_unit(grp * 2 + tt, p.out, p.g_ffn, (const bf16_t*)(ws + OFF_WRT), p.b_rg, p.b_re, h2, (float*)(ws + OFF_RSTD), smh);
        router_append(grp, (int*)(ws + OFF_LTOK), (float*)(ws + OFF_LW), ctrl, smh);
    }
    xcd_barrier(bar);
    ph_moe1(h2, (const bf16_t*)(ws + OFF_WGT), (const bf16_t*)(ws + OFF_WUT), ctrl, (const int*)(ws + OFF_LTOK), (const float*)(ws + OFF_LW), (const float*)(ws + OFF_RSTD), hid, smh);
    xcd_barrier(bar);
    ph_moe2(hid, (const bf16_t*)(ws + OFF_WDT), ctrl, (const int*)(ws + OFF_LTOK), Y0, smh);
    xcd_barrier(bar);
    { int t_ = threadIdx.x; asm volatile("" : "+v"(t_)); for (int row = blockIdx.x * 8 + (t_ >> 6); row < T; row += G * 8) final_row(row, p.out, Y0, Y1, p.g_final, t_ & 63); }
}

extern "C" void kernel_launch(void* const* d_in, const int* in_sizes, int n_in, void* d_out, int out_size, void* d_ws, size_t ws_size, hipStream_t stream) {
    static int grid = 0;
    constexpr int kDynLds = SMEM_BYTES + 16;
    if (!grid) {
        int dev = 0, cus = 0, per_cu = 0;
        (void)hipGetDevice(&dev);
        (void)hipDeviceGetAttribute(&cus, hipDeviceAttributeMultiprocessorCount, dev);
        (void)hipFuncSetAttribute((const void*)k_fwd, hipFuncAttributeMaxDynamicSharedMemorySize, kDynLds);
        (void)hipOccupancyMaxActiveBlocksPerMultiprocessor(&per_cu, k_fwd, 512, kDynLds);
        if (per_cu > 1) per_cu = 1;
        if (per_cu < 1) per_cu = 1;
        grid = cus * per_cu;
    }
    char* ws = (char*)d_ws;
    (void)hipMemsetAsync(ws + OFF_CTRL, 0, 16384, stream);
    (void)hipMemsetAsync(ws + OFF_BAR, 0, 16384, stream);
    Params p{};
    const float** pf = (const float**)&p;
    for (int i = 0; i < 25; ++i) pf[i] = (const float*)d_in[i];
    p.out = (float*)d_out; p.ws = ws;
    k_fwd<<<grid, 512, kDynLds, stream>>>(p);
}
```

```cpp
#include <hip/hip_runtime.h>
#include <stdint.h>

typedef unsigned short bf16_t;
typedef short bf16x8 __attribute__((ext_vector_type(8)));
typedef float f32x4 __attribute__((ext_vector_type(4)));
typedef unsigned u32x4 __attribute__((ext_vector_type(4)));
__device__ __forceinline__ float bf2f(bf16_t v) { return __uint_as_float(((unsigned)v) << 16); }
__device__ __forceinline__ bf16_t f2bf(float f) { unsigned u = __float_as_uint(f); u += 0x7FFFu + ((u >> 16) & 1u); return (bf16_t)(u >> 16); }
__device__ __forceinline__ unsigned pack_bf16(float lo, float hi) { unsigned r; asm volatile("v_cvt_pk_bf16_f32 %0, %1, %2" : "=v"(r) : "v"(lo), "v"(hi)); return r; }

constexpr int Bn = 4, S = 4096, T = Bn * S, D = 1024, NIN = 4904, PP = 2880;
constexpr int QA = 0, KC = 512, VC = 640, KS = 768, VS = 896, KW = 1024, VW = 1152, GA = 1280, QB = 1304, KB = 1560, VB = 1816, AB = 2328, RB = 2344, MGA = 2856, MGB = 3880;
constexpr int NPROJ = 2856;
constexpr int MSLOT = 36864;

constexpr size_t OFF_CTRL = 0;
constexpr size_t OFF_ROUTE_E = 16384;
constexpr size_t OFF_ROUTE_W = OFF_ROUTE_E + 32768 * 4;
constexpr size_t OFF_SLOT_TOK = OFF_ROUTE_W + 32768 * 4;
constexpr size_t OFF_SLOT_W = OFF_SLOT_TOK + (size_t)MSLOT * 4;
constexpr size_t OFF_BAR = OFF_SLOT_W + (size_t)MSLOT * 4;
constexpr size_t OFF_BIAS1 = OFF_BAR + 16384;
constexpr size_t OFF_RSTD = OFF_BIAS1 + 1024;
constexpr size_t OFF_SLOT_RS = OFF_RSTD + (size_t)T * 4;
constexpr size_t OFF_WRT = OFF_SLOT_RS + (size_t)MSLOT * 4;
static_assert(OFF_WRT + 2 * 48 * 1024 * 2 <= (1u << 20), "ctrl overflow");
constexpr size_t OFF_R1 = 1u << 20;
constexpr size_t SZ_PROJ = (size_t)T * PP * 2;
constexpr size_t OFF_PROJ = OFF_R1;
constexpr size_t OFF_BC = OFF_PROJ + SZ_PROJ;
constexpr size_t OFF_CSTATE = OFF_BC + (size_t)T * 256 * 4;
constexpr size_t OFF_R1_END = OFF_CSTATE + (size_t)1024 * 8192 * 4;
constexpr size_t OFF_MRG = OFF_R1 + (size_t)T * 2048 * 2;
constexpr size_t OFF_H2 = OFF_R1;
constexpr size_t OFF_HID = OFF_H2 + (size_t)T * 1024 * 2;
constexpr size_t OFF_Y0 = OFF_HID + (size_t)2 * T * 256 * 2;
constexpr size_t OFF_Y1 = OFF_Y0 + (size_t)T * 1024 * 2;
static_assert(OFF_MRG + (size_t)T * 1024 * 2 <= OFF_R1_END, "alias overflow");
static_assert(OFF_Y1 + (size_t)T * 1024 * 2 <= OFF_R1_END, "alias overflow");
constexpr size_t OFF_YA = OFF_R1_END;
constexpr size_t OFF_YB = OFF_YA + (size_t)T * 512 * 2;
constexpr size_t OFF_KCB = OFF_YB + (size_t)T * 512 * 2;
constexpr size_t OFF_VCB = OFF_KCB + 8 * 256 * 64 * 2;
constexpr size_t OFF_VCBT = OFF_VCB + 8 * 256 * 64 * 2;
constexpr size_t OFF_HIDC = OFF_VCBT + 8 * 256 * 64 * 2;
constexpr size_t OFF_VST = OFF_HIDC + 2 * 2048 * 128 * 2;
constexpr size_t OFF_VWT = OFF_VST + (size_t)8 * 64 * S * 2;
constexpr size_t OFF_WINT = OFF_VWT + (size_t)8 * 64 * S * 2;
constexpr size_t OFF_CK1T = OFF_WINT + (size_t)NIN * 1024 * 2;
constexpr size_t OFF_CV1T = OFF_CK1T + 128 * 2048 * 2;
constexpr size_t OFF_CK2T = OFF_CV1T + 128 * 2048 * 2;
constexpr size_t OFF_CV2T = OFF_CK2T + 128 * 128 * 2;
constexpr size_t OFF_WAT = OFF_CV2T + 128 * 128 * 2;
constexpr size_t OFF_WBT = OFF_WAT + 1024 * 512 * 2;
constexpr size_t OFF_WOT = OFF_WBT + 1024 * 512 * 2;
constexpr size_t OFF_WGT = OFF_WOT + 1024 * 1024 * 2;
constexpr size_t OFF_WUT = OFF_WGT + (size_t)32 * 256 * 1024 * 2;
constexpr size_t OFF_WDT = OFF_WUT + (size_t)32 * 256 * 1024 * 2;
constexpr size_t OFF_LTOK = OFF_WDT + (size_t)32 * 1024 * 256 * 2;
constexpr size_t OFF_LW = OFF_LTOK + (size_t)32 * 16384 * 4;
constexpr size_t OFF_END = OFF_LW + (size_t)32 * 16384 * 4;
static_assert(OFF_END <= (size_t)256 << 20, "workspace overflow");

#define XB_TMO      128
#define XB_XCNT(j)  (256  + 64 * (j))
#define XB_XSUB(j)  (1280 + 64 * (j))
#define XB_XGEN(j)  (2304 + 64 * (j))
#define XB_TOP      3328
#define XB_TOPGEN   3392
#define XCD_BAR_WORDS 3456
#define XB_SPIN_CAP (1u << 18)
#define LAS __attribute__((address_space(3)))

__device__ __forceinline__ unsigned xb_ld(unsigned* p)              { return __hip_atomic_load(p, __ATOMIC_RELAXED, __HIP_MEMORY_SCOPE_AGENT); }
__device__ __forceinline__ unsigned xb_add(unsigned* p, unsigned v) { return __hip_atomic_fetch_add(p, v, __ATOMIC_RELAXED, __HIP_MEMORY_SCOPE_AGENT); }
__device__ __forceinline__ unsigned xb_xcc_id() { return (unsigned)__builtin_amdgcn_s_getreg((3 << 11) | 20) & 0xFu; }
#define XB_SPIN(cond, bar) do { unsigned _sp = 0; while (cond) { __builtin_amdgcn_s_sleep(1); \
    if ((++_sp & 255u) == 0u) { if (xb_ld(&(bar)[XB_TMO])) break; if (_sp > XB_SPIN_CAP) { atomicAdd(&(bar)[XB_TMO], 1u); break; } } } } while (0)

struct XcdBarrier { unsigned* bar; unsigned x; volatile LAS unsigned* st; };

__device__ __forceinline__ XcdBarrier xcd_barrier_post(unsigned* bar, volatile LAS unsigned* st) {
    XcdBarrier b; b.bar = bar; b.x = xb_xcc_id(); b.st = st;
    if (threadIdx.x == 0) (void)xb_add(&bar[XB_XCNT(b.x)], 1u);
    return b;
}
__device__ __forceinline__ void xcd_barrier_complete(unsigned* bar, unsigned x, unsigned& nloc, unsigned& nx) {
    const unsigned G = gridDim.x * gridDim.y * gridDim.z;
    unsigned sum, cnt, mine, sp = 0u;
    for (;;) {
        sum = 0u; cnt = 0u; mine = 0u;
#pragma unroll
        for (unsigned j = 0; j < 16; ++j) { const unsigned c = xb_ld(&bar[XB_XCNT(j)]); sum += c; cnt += (c > 0u) ? 1u : 0u; mine = (j == x) ? c : mine; }
        if (sum == G) break;
        __builtin_amdgcn_s_sleep(1);
        if ((++sp & 255u) == 0u) { if (xb_ld(&bar[XB_TMO])) break; if (sp > XB_SPIN_CAP) { atomicAdd(&bar[XB_TMO], 1u); break; } }
    }
    nloc = mine > 0u ? mine : 1u; nx = cnt > 0u ? cnt : 1u;
}
__device__ __forceinline__ void xcd_barrier(const XcdBarrier& b) {
    asm volatile("s_waitcnt vmcnt(0)" ::: "memory");
    __syncthreads();
    if (threadIdx.x == 0) {
        unsigned* bar = b.bar;
        __builtin_amdgcn_s_waitcnt(0);
        unsigned nloc = b.st[0], nx = b.st[1];
        if (nloc == 0u) { xcd_barrier_complete(bar, b.x, nloc, nx); b.st[0] = nloc; b.st[1] = nx; }
        const unsigned old = xb_add(&bar[XB_XSUB(b.x)], 1u);
        const unsigned gen = old / nloc;
        if (old + 1u == (gen + 1u) * nloc) {
            __builtin_amdgcn_fence(__ATOMIC_RELEASE, "agent");
            asm volatile("s_waitcnt vmcnt(0)" ::: "memory");
            const unsigned og = xb_add(&bar[XB_TOP], 1u);
            const unsigned tg = og / nx;
            if (og + 1u == (tg + 1u) * nx) xb_add(&bar[XB_TOPGEN], 1u);
            else XB_SPIN(xb_ld(&bar[XB_TOPGEN]) == tg, bar);
            __builtin_amdgcn_fence(__ATOMIC_ACQUIRE, "agent");
            xb_add(&bar[XB_XGEN(b.x)], 1u);
            asm volatile("s_waitcnt vmcnt(0)" ::: "memory");
        } else {
            XB_SPIN(xb_ld(&bar[XB_XGEN(b.x)]) == gen, bar);
            __builtin_amdgcn_fence(__ATOMIC_ACQUIRE, "agent");
            asm volatile("s_waitcnt vmcnt(0)" ::: "memory");
        }
    }
    __syncthreads();
}


__device__ __forceinline__ int hb_tid_() { int t = threadIdx.x; asm volatile("" : "+v"(t)); return t & 255; }
#define HB_TID (hb_tid_())
#define HB_ID ((int)(threadIdx.x >> 8))
#define HB_FIRST (2 * (int)blockIdx.x + HB_ID)
#define HB_STEP (2 * (int)gridDim.x)
struct Params {
    const float *x, *g_mix, *w_in, *pe_k, *ck1, *ck2, *pe_v, *cv1, *cv2, *rel_bias, *w_alpha, *b_alpha, *norm_g, *w_ba, *w_bb, *w_out, *g_ffn,
                *w_rg, *b_rg, *w_re, *b_re, *w_eg, *w_eu, *w_ed, *g_final;
    float* out; char* ws;
};

__device__ __forceinline__ float wave_max(float v) { for (int o = 32; o > 0; o >>= 1) v = fmaxf(v, __shfl_xor(v, o)); return v; }
__device__ __forceinline__ float wave_sum(float v) { for (int o = 32; o > 0; o >>= 1) v += __shfl_xor(v, o); return v; }
__device__ __forceinline__ void wave_lds_sync() { asm volatile("s_waitcnt lgkmcnt(0)" ::: "memory"); }


__device__ __forceinline__ void rms_h_row(int row, const float* __restrict__ x, const float* __restrict__ g, bf16_t* __restrict__ h, int lane) {
    const float* xr = x + (size_t)row * D + lane * 4;
    f32x4 v[4]; float s = 0.f;
#pragma unroll
    for (int i = 0; i < 4; ++i) { v[i] = *(const f32x4*)(xr + 256 * i); s += v[i][0] * v[i][0] + v[i][1] * v[i][1] + v[i][2] * v[i][2] + v[i][3] * v[i][3]; }
    s = wave_sum(s);
    const float r = rsqrtf(s * (1.0f / D) + 1e-6f);
#pragma unroll
    for (int i = 0; i < 4; ++i) {
        const f32x4 gg = *(const f32x4*)(g + lane * 4 + 256 * i);
        uint2 o; o.x = pack_bf16(v[i][0] * r * gg[0], v[i][1] * r * gg[1]); o.y = pack_bf16(v[i][2] * r * gg[2], v[i][3] * r * gg[3]);
        *(uint2*)(h + (size_t)row * D + lane * 4 + 256 * i) = o;
    }
}
__device__ __forceinline__ void final_row(int row, float* __restrict__ x2out, const bf16_t* __restrict__ Y0, const bf16_t* __restrict__ Y1, const float* __restrict__ g, int lane) {
    float* xr = x2out + (size_t)row * D + lane * 4;
    f32x4 v[4]; float s = 0.f;
#pragma unroll
    for (int i = 0; i < 4; ++i) {
        v[i] = *(const f32x4*)(xr + 256 * i);
        const uint2 a = *(const uint2*)(Y0 + (size_t)row * D + lane * 4 + 256 * i), c = *(const uint2*)(Y1 + (size_t)row * D + lane * 4 + 256 * i);
        v[i][0] += __uint_as_float(a.x << 16) + __uint_as_float(c.x << 16);
        v[i][1] += __uint_as_float(a.x & 0xFFFF0000u) + __uint_as_float(c.x & 0xFFFF0000u);
        v[i][2] += __uint_as_float(a.y << 16) + __uint_as_float(c.y << 16);
        v[i][3] += __uint_as_float(a.y & 0xFFFF0000u) + __uint_as_float(c.y & 0xFFFF0000u);
        s += v[i][0] * v[i][0] + v[i][1] * v[i][1] + v[i][2] * v[i][2] + v[i][3] * v[i][3];
    }
    s = wave_sum(s);
    const float r = rsqrtf(s * (1.0f / D) + 1e-6f);
#pragma unroll
    for (int i = 0; i < 4; ++i) {
        const f32x4 gg = *(const f32x4*)(g + lane * 4 + 256 * i);
        *(f32x4*)(xr + 256 * i) = (f32x4){v[i][0] * r * gg[0], v[i][1] * r * gg[1], v[i][2] * r * gg[2], v[i][3] * r * gg[3]};
    }
}

__device__ __forceinline__ void prep_router_w(const float* __restrict__ w_rg, const float* __restrict__ w_re, bf16_t* __restrict__ WrT) {
    for (int idx = blockIdx.x * 512 + threadIdx.x; idx < 48 * 1024; idx += gridDim.x * 512) {
        const int n = idx >> 10, k = idx & 1023;
        const float w = n < 4 ? w_rg[k * 4 + n] : (n < 36 ? w_re[k * 32 + n - 4] : 0.f);
        const bf16_t hi = f2bf(w);
        WrT[idx] = hi; WrT[48 * 1024 + idx] = f2bf(w - bf2f(hi));
    }
}

__device__ __forceinline__ void router_unit(int task, const float* __restrict__ x2, const float* __restrict__ g, const bf16_t* __restrict__ WrT,
                                            const float* __restrict__ b_rg, const float* __restrict__ b_re, bf16_t* __restrict__ h2, float* __restrict__ rstd_out,
                                            char* smem) {
    float (*part)[16][49] = (float (*)[16][49])smem;
    int* dec_e = (int*)(smem + 14336); float* dec_w = (float*)(smem + 14336 + 512);
    float (*ssp)[16] = (float (*)[16])(smem + 4 * 16 * 49 * 4);
    const int tid = HB_TID, lane = tid & 63, w4 = tid >> 6, fr = lane & 15, fq = lane >> 4, r0 = task * 16;
    const float* xr = x2 + (size_t)(r0 + fr) * D + fq * 8 + w4 * 256;
    bf16_t* hr = h2 + (size_t)(r0 + fr) * D + fq * 8 + w4 * 256;
    const bf16_t* wh = WrT + (size_t)fr * 1024 + fq * 8 + w4 * 256;
    const float* gp = g + fq * 8 + w4 * 256;
    f32x4 acc[3];
#pragma unroll
    for (int nt = 0; nt < 3; ++nt) acc[nt] = (f32x4){0.f, 0.f, 0.f, 0.f};
    float ssq = 0.f;
#pragma unroll 4
    for (int ks = 0; ks < 8; ++ks) {
        const f32x4 x0 = *(const f32x4*)(xr + ks * 32), x1 = *(const f32x4*)(xr + ks * 32 + 4);
        const f32x4 g0 = *(const f32x4*)(gp + ks * 32), g1 = *(const f32x4*)(gp + ks * 32 + 4);
        float xg[8];
#pragma unroll
        for (int e = 0; e < 4; ++e) { xg[e] = x0[e] * g0[e]; xg[4 + e] = x1[e] * g1[e]; ssq += x0[e] * x0[e] + x1[e] * x1[e]; }
        u32x4 hi, lo;
#pragma unroll
        for (int e = 0; e < 4; ++e) {
            hi[e] = pack_bf16(xg[2 * e], xg[2 * e + 1]);
            lo[e] = pack_bf16(xg[2 * e] - __uint_as_float(hi[e] << 16), xg[2 * e + 1] - __uint_as_float(hi[e] & 0xFFFF0000u));
        }
        *(u32x4*)(hr + ks * 32) = hi;
        const bf16x8 ah = __builtin_bit_cast(bf16x8, hi), al = __builtin_bit_cast(bf16x8, lo);
#pragma unroll
        for (int nt = 0; nt < 3; ++nt) {
            const bf16x8 bh = *(const bf16x8*)(wh + (size_t)nt * 16 * 1024 + ks * 32), bl = *(const bf16x8*)(wh + (size_t)(48 + nt * 16) * 1024 + ks * 32);
            acc[nt] = __builtin_amdgcn_mfma_f32_16x16x32_bf16(ah, bh, acc[nt], 0, 0, 0);
            acc[nt] = __builtin_amdgcn_mfma_f32_16x16x32_bf16(al, bh, acc[nt], 0, 0, 0);
            acc[nt] = __builtin_amdgcn_mfma_f32_16x16x32_bf16(ah, bl, acc[nt], 0, 0, 0);
        }
    }
    ssq += __shfl_xor(ssq, 16); ssq += __shfl_xor(ssq, 32);
    __syncthreads();
    if (fq == 0) ssp[w4][fr] = ssq;
#pragma unroll
    for (int nt = 0; nt < 3; ++nt)
#pragma unroll
        for (int i = 0; i < 4; ++i) part[w4][4 * fq + i][nt * 16 + fr] = acc[nt][i];
    __syncthreads();
    if (tid < 16) {
        const int row = r0 + tid;
        const float rsv = rsqrtf((ssp[0][tid] + ssp[1][tid] + ssp[2][tid] + ssp[3][tid]) * (1.0f / D) + 1e-6f);
        rstd_out[row] = rsv;
        float l4[4];
#pragma unroll
        for (int j = 0; j < 4; ++j) l4[j] = (part[0][tid][j] + part[1][tid][j] + part[2][tid][j] + part[3][tid][j]) * rsv + b_rg[j];
        int gs = 0; float mx = l4[0];
#pragma unroll
        for (int j = 1; j < 4; ++j) if (l4[j] > mx) { mx = l4[j]; gs = j; }
        float den = 0.f;
#pragma unroll
        for (int j = 0; j < 4; ++j) den += __expf(l4[j] - mx);
        const float gpb = 1.f / den;
        float v0 = -3e38f, v1 = -3e38f; int i0 = 0, i1 = 0;
        for (int j = 0; j < 8; ++j) {
            const int c = 4 + gs * 8 + j;
            const float l = (part[0][tid][c] + part[1][tid][c] + part[2][tid][c] + part[3][tid][c]) * rsv + b_re[gs * 8 + j];
            if (l > v0) { v1 = v0; i1 = i0; v0 = l; i0 = j; }
            else if (l > v1) { v1 = l; i1 = j; }
        }
        const float e1 = __expf(v1 - v0);
        const int lr = (task & 1) * 16 + tid;
        dec_e[lr * 2] = gs * 8 + i0; dec_e[lr * 2 + 1] = gs * 8 + i1;
        dec_w[lr * 2] = gpb / (1.f + e1); dec_w[lr * 2 + 1] = gpb * e1 / (1.f + e1);
    }
}
__device__ __forceinline__ void router_append(int group, int* __restrict__ ltok, float* __restrict__ lw, int* __restrict__ cnt, char* smem) {
    int* dec_e = (int*)(smem + 14336); float* dec_w = (float*)(smem + 14336 + 512);
    int* hist = (int*)(smem + 14336 + 1024); int* base = hist + 32;
    const int tid = HB_TID;
    if (tid < 32) hist[tid] = 0;
    __syncthreads();
    int e = 0, lpos = 0;
    if (tid < 64) { e = dec_e[tid]; lpos = atomicAdd(&hist[e], 1); }
    __syncthreads();
    if (tid < 32) { const int hcount = hist[tid]; base[tid] = hcount ? atomicAdd(&cnt[tid * 64], hcount) : 0; }
    __syncthreads();
    if (tid < 64) { const int pos = e * 16384 + base[e] + lpos; ltok[pos] = (group * 32 + (tid >> 1)) * 2 + (tid & 1); lw[pos] = dec_w[tid]; }
    __syncthreads();
}

__device__ __forceinline__ void transpose_tile(const float* __restrict__ src, int ld_src, int N, bf16_t* __restrict__ dst, int ld_dst, int kt, int nt, char* smem) {
    float (*tl)[65] = (float (*)[65])smem;
    const int tid = HB_TID;
    const int c4 = (tid & 15) * 4, r0 = tid >> 4;
#pragma unroll
    for (int i = 0; i < 4; ++i) {
        const int k = r0 + 16 * i, n = nt * 64 + c4;
        float4 v = make_float4(0.f, 0.f, 0.f, 0.f);
        if (n < N) v = *(const float4*)(src + (size_t)(kt * 64 + k) * ld_src + n);
        tl[k][c4] = v.x; tl[k][c4 + 1] = v.y; tl[k][c4 + 2] = v.z; tl[k][c4 + 3] = v.w;
    }
    __syncthreads();
    const int kc = (tid & 7) * 8, n0 = tid >> 3;
#pragma unroll
    for (int i = 0; i < 2; ++i) {
        const int nl = n0 + 32 * i, n = nt * 64 + nl;
        if (n < N) {
            uint4 o;
            o.x = pack_bf16(tl[kc][nl], tl[kc + 1][nl]); o.y = pack_bf16(tl[kc + 2][nl], tl[kc + 3][nl]);
            o.z = pack_bf16(tl[kc + 4][nl], tl[kc + 5][nl]); o.w = pack_bf16(tl[kc + 6][nl], tl[kc + 7][nl]);
            *(uint4*)(dst + (size_t)n * ld_dst + kt * 64 + kc) = o;
        }
    }
    __syncthreads();
}

__device__ __forceinline__ void ph_prep_experts(const Params& p, char* smem) {
    char* ws = p.ws;
    for (int t = HB_FIRST; t < 4096; t += HB_STEP) {
        const int e = (t & 2047) >> 6, r = t & 63;
        if (t < 2048) transpose_tile(p.w_eg + (size_t)e * 1024 * 256, 256, 256, (bf16_t*)(ws + OFF_WGT) + (size_t)e * 256 * 1024, 1024, r >> 2, r & 3, smem);
        else transpose_tile(p.w_eu + (size_t)e * 1024 * 256, 256, 256, (bf16_t*)(ws + OFF_WUT) + (size_t)e * 256 * 1024, 1024, r >> 2, r & 3, smem);
    }
}
__device__ __forceinline__ int moe_tile_decode(const int* __restrict__ cnt, int t, int& e, int& i);
__device__ __forceinline__ void ph_prep_experts_down(const Params& p, const int* __restrict__ cnt, char* smem) {
    char* ws = p.ws;
    int e_, ti_; const int nu = moe_tile_decode(cnt, 0, e_, ti_) * 4, rem = nu % HB_STEP, k = HB_FIRST - rem, st = HB_STEP - rem;
    if (k < 0) return;
    for (int t = k; t < 2048; t += st) {
        const int e = t >> 6, r = t & 63;
        transpose_tile(p.w_ed + (size_t)e * 256 * 1024, 1024, 1024, (bf16_t*)(ws + OFF_WDT) + (size_t)e * 1024 * 256, 256, r >> 4, r & 15, smem);
    }
}
__device__ __forceinline__ void ph_prep(const Params& p, char* smem) {
    char* ws = p.ws;
    constexpr int N0 = 16 * 77, N1 = N0 + 64, N2 = N1 + 64, N3 = N2 + 2, N4 = N3 + 2, N5 = N4 + 128, N6 = N5 + 128, N7 = N6 + 256;
    for (int t = HB_FIRST; t < N7; t += HB_STEP) {
        if (t < N0) transpose_tile(p.w_in, NIN, NIN, (bf16_t*)(ws + OFF_WINT), 1024, t / 77, t % 77, smem);
        else if (t < N1) { const int q = t - N0; transpose_tile(p.ck1, 128, 128, (bf16_t*)(ws + OFF_CK1T), 2048, q >> 1, q & 1, smem); }
        else if (t < N2) { const int q = t - N1; transpose_tile(p.cv1, 128, 128, (bf16_t*)(ws + OFF_CV1T), 2048, q >> 1, q & 1, smem); }
        else if (t < N3) { const int q = t - N2; transpose_tile(p.ck2, 64, 64, (bf16_t*)(ws + OFF_CK2T), 128, q, 0, smem); }
        else if (t < N4) { const int q = t - N3; transpose_tile(p.cv2, 64, 64, (bf16_t*)(ws + OFF_CV2T), 128, q, 0, smem); }
        else if (t < N5) { const int q = t - N4; transpose_tile(p.w_ba, 1024, 1024, (bf16_t*)(ws + OFF_WAT), 512, q >> 4, q & 15, smem); }
        else if (t < N6) { const int q = t - N5; transpose_tile(p.w_bb, 1024, 1024, (bf16_t*)(ws + OFF_WBT), 512, q >> 4, q & 15, smem); }
        else { const int q = t - N6; transpose_tile(p.w_out, 1024, 1024, (bf16_t*)(ws + OFF_WOT), 1024, q >> 4, q & 15, smem); }
    }
    for (int t = HB_FIRST; t < 8; t += HB_STEP) {
        const int which = t >> 2, n = (t & 3) * 32 + (HB_TID & 31), ksp = HB_TID >> 5;
        const float* pe = which ? p.pe_v : p.pe_k; const float* w1 = which ? p.cv1 : p.ck1;
        float a = 0.f;
        for (int k = ksp * 256; k < ksp * 256 + 256; ++k) a += pe[k] * w1[(size_t)k * 128 + n];
        float* red = (float*)smem;
        red[HB_TID] = a;
        __syncthreads();
        if (HB_TID < 32) {
            float s = 0.f;
#pragma unroll
            for (int j = 0; j < 8; ++j) s += red[j * 32 + HB_TID];
            ((float*)(ws + OFF_BIAS1))[which * 128 + n] = s;
        }
        __syncthreads();
    }
    prep_router_w(p.w_rg, p.w_re, (bf16_t*)(ws + OFF_WRT));
    for (int row = blockIdx.x * 8 + (threadIdx.x >> 6); row < T; row += gridDim.x * 8) rms_h_row(row, p.x, p.g_mix, (bf16_t*)p.out, threadIdx.x & 63);
}

__device__ __forceinline__ int tile_off(int row, int chunk) { return row * 128 + ((chunk ^ (row & 7)) << 4); }

__device__ __forceinline__ void glds16(const void* g, char* l) {
    __builtin_amdgcn_global_load_lds((const __attribute__((address_space(1))) unsigned*)g, (__attribute__((address_space(3))) unsigned*)l, 16, 0, 0);
}
__device__ __forceinline__ void gemm_kloop(f32x4 (&acc)[4][4], const bf16_t* const (&pa)[4], const bf16_t* const (&pb)[4], int ka, int kb, int nk, char* smem) {
    int tid_ = HB_TID; asm volatile("" : "+v"(tid_));
    const int tid = tid_, lane = tid & 63, wid = tid >> 6, wr = wid >> 1, wc = wid & 1, fr = lane & 15, fq = lane >> 4;
    const int offA = (wr * 64 + fr) * 128, offB = 16384 + (wc * 64 + fr) * 128, x = fr & 7;
    __syncthreads();
#pragma unroll
    for (int i = 0; i < 4; ++i) { glds16(pa[i], smem + i * 4096 + tid * 16); glds16(pb[i], smem + 16384 + i * 4096 + tid * 16); }
    asm volatile("s_waitcnt vmcnt(0)" ::: "memory");
    __syncthreads();
    for (int kt = 0; kt < nk; ++kt) {
        const int cur = kt & 1;
        if (kt + 1 < nk) {
            char* st = smem + (cur ^ 1) * 32768 + tid * 16;
#pragma unroll
            for (int i = 0; i < 4; ++i) { glds16(pa[i] + (size_t)(kt + 1) * ka, st + i * 4096); glds16(pb[i] + (size_t)(kt + 1) * kb, st + 16384 + i * 4096); }
        }
        const char* sa = smem + cur * 32768 + offA;
        const char* sb = smem + cur * 32768 + offB;
#pragma unroll
        for (int ks = 0; ks < 2; ++ks) {
            const int ch = ((ks * 4 + fq) ^ x) << 4;
            bf16x8 af[4], bfr[4];
#pragma unroll
            for (int mi = 0; mi < 4; ++mi) af[mi] = *(const bf16x8*)(sa + mi * 2048 + ch);
#pragma unroll
            for (int ni = 0; ni < 4; ++ni) bfr[ni] = *(const bf16x8*)(sb + ni * 2048 + ch);
#pragma unroll
            for (int mi = 0; mi < 4; ++mi)
#pragma unroll
                for (int ni = 0; ni < 4; ++ni) acc[mi][ni] = __builtin_amdgcn_mfma_f32_16x16x32_bf16(bfr[ni], af[mi], acc[mi][ni], 0, 0, 0);
        }
        asm volatile("s_waitcnt vmcnt(0)" ::: "memory");
        __syncthreads();
    }
}
__device__ __forceinline__ void acc_zero(f32x4 (&acc)[4][4]) {
#pragma unroll
    for (int mi = 0; mi < 4; ++mi)
#pragma unroll
        for (int ni = 0; ni < 4; ++ni) acc[mi][ni] = (f32x4){0.f, 0.f, 0.f, 0.f};
}
#define GEMM_LANE_VARS const int tid = HB_TID, lane = tid & 63, wid = tid >> 6, wr = wid >> 1, wc = wid & 1, fr = lane & 15, fq = lane >> 4, lrow = tid >> 3, lch8 = ((tid & 7) ^ ((tid >> 3) & 7)) * 8; (void)wr; (void)wc; (void)fr; (void)fq; (void)lrow; (void)lch8;
__device__ __forceinline__ uint2 pack4(f32x4 v) { uint2 o; o.x = pack_bf16(v[0], v[1]); o.y = pack_bf16(v[2], v[3]); return o; }
__device__ __forceinline__ float sigmoidf_(float a) { return 1.f / (1.f + __expf(-a)); }

__device__ __forceinline__ void ph_proj(const bf16_t* __restrict__ h, const bf16_t* __restrict__ WinT, bf16_t* __restrict__ proj, char* smem) {
    GEMM_LANE_VARS
    for (int u = HB_FIRST; u < 128 * 23; u += HB_STEP) {
        const int xg = u & 7, v = u >> 3, tn = v % 23, tm = (v / 23) * 8 + xg;
        const bf16_t* pa[4]; const bf16_t* pb[4];
#pragma unroll
        for (int i = 0; i < 4; ++i) { pa[i] = h + (size_t)(tm * 128 + lrow + 32 * i) * 1024 + lch8; pb[i] = WinT + (size_t)(tn * 128 + lrow + 32 * i) * 1024 + lch8; }
        f32x4 acc[4][4]; acc_zero(acc);
        gemm_kloop(acc, pa, pb, 64, 64, 16, smem);
#pragma unroll
        for (int mi = 0; mi < 4; ++mi)
#pragma unroll
            for (int ni = 0; ni < 4; ++ni) {
                const int m = tm * 128 + wr * 64 + mi * 16 + fr, n = tn * 128 + wc * 64 + ni * 16 + 4 * fq;
                if (n < NPROJ) *(uint2*)(proj + (size_t)m * PP + n) = pack4(acc[mi][ni]);
            }
    }
}

__device__ __forceinline__ void ph_cmp1(const bf16_t* __restrict__ proj, const char* ws, char* smem) {
    GEMM_LANE_VARS
    for (int u = HB_FIRST; u < 32; u += HB_STEP) {
        const int which = u >> 4, tm = u & 15;
        const bf16_t* W1T = (const bf16_t*)(ws + (which ? OFF_CV1T : OFF_CK1T));
        const float* bias1 = (const float*)(ws + OFF_BIAS1) + which * 128;
        bf16_t* hid = (bf16_t*)(ws + OFF_HIDC) + (size_t)which * 2048 * 128;
        const int col0 = which ? VC : KC;
        const bf16_t* pa[4]; const bf16_t* pb[4];
#pragma unroll
        for (int i = 0; i < 4; ++i) {
            const int m = tm * 128 + lrow + 32 * i, bg = m >> 8, c = (m & 255) > 254 ? 254 : (m & 255), b = bg >> 1, g = bg & 1;
            pa[i] = proj + (size_t)(b * S + 16 * c) * PP + col0 + g * 64 + lch8;
            pb[i] = W1T + (size_t)(lrow + 32 * i) * 2048 + lch8;
        }
        f32x4 acc[4][4]; acc_zero(acc);
        gemm_kloop(acc, pa, pb, PP, 64, 32, smem);
#pragma unroll
        for (int mi = 0; mi < 4; ++mi)
#pragma unroll
            for (int ni = 0; ni < 4; ++ni) {
                const int m = tm * 128 + wr * 64 + mi * 16 + fr, n = wc * 64 + ni * 16 + 4 * fq;
                f32x4 v = acc[mi][ni];
#pragma unroll
                for (int j = 0; j < 4; ++j) { const float a = v[j] + bias1[n + j]; const float t = 0.7978845608028654f * (a + 0.044715f * a * a * a); v[j] = 0.5f * a * (1.f + tanhf(t)); }
                *(uint2*)(hid + (size_t)m * 128 + n) = pack4(v);
            }
    }
}

__device__ __forceinline__ void ph_cmp2(const char* ws_c, char* ws, char* smem) {
    GEMM_LANE_VARS
    for (int u = HB_FIRST; u < 32; u += HB_STEP) {
        const int which = u >> 4, tm = u & 15;
        const bf16_t* W2T = (const bf16_t*)(ws_c + (which ? OFF_CV2T : OFF_CK2T));
        const bf16_t* hid = (const bf16_t*)(ws_c + OFF_HIDC) + (size_t)which * 2048 * 128;
        const bf16_t* pa[4]; const bf16_t* pb[4];
#pragma unroll
        for (int i = 0; i < 4; ++i) { pa[i] = hid + (size_t)(tm * 128 + lrow + 32 * i) * 128 + lch8; pb[i] = W2T + (size_t)(lrow + 32 * i) * 128 + lch8; }
        f32x4 acc[4][4]; acc_zero(acc);
        gemm_kloop(acc, pa, pb, 64, 64, 2, smem);
        if (wc == 0) {
            bf16_t* outp = (bf16_t*)(ws + (which ? OFF_VCB : OFF_KCB));
            bf16_t* outT = (bf16_t*)(ws + OFF_VCBT);
#pragma unroll
            for (int mi = 0; mi < 4; ++mi)
#pragma unroll
                for (int ni = 0; ni < 4; ++ni) {
                    const int m = tm * 128 + wr * 64 + mi * 16 + fr, n = ni * 16 + 4 * fq, c = m & 255, bg = m >> 8;
                    f32x4 v = acc[mi][ni];
                    if (c == 255) v = (f32x4){0.f, 0.f, 0.f, 0.f};
                    *(uint2*)(outp + (size_t)m * 64 + n) = pack4(v);
                    if (which) {
#pragma unroll
                        for (int j = 0; j < 4; ++j) outT[((size_t)bg * 64 + n + j) * 256 + c] = f2bf(v[j]);
                    }
                }
        }
    }
}

typedef unsigned u32x2 __attribute__((ext_vector_type(2)));
__device__ __forceinline__ u32x2 pack4v(f32x4 v) { u32x2 o; o[0] = pack_bf16(v[0], v[1]); o[1] = pack_bf16(v[2], v[3]); return o; }
__device__ __forceinline__ f32x4 unpack4v(u32x2 o) { return (f32x4){__uint_as_float(o[0] << 16), __uint_as_float(o[0] & 0xFFFF0000u), __uint_as_float(o[1] << 16), __uint_as_float(o[1] & 0xFFFF0000u)}; }
template <int HALF>
__device__ __forceinline__ void merge_half(u32x2 (&tpk)[4][4], int tm, int tn, const bf16_t* __restrict__ h, const bf16_t* __restrict__ WinT, const bf16_t* __restrict__ yy,
                                           const bf16_t* __restrict__ WT, bf16_t* __restrict__ mrg, char* smem) {
    GEMM_LANE_VARS
    u32x2 sg[4][4];
    {
        const bf16_t* pa[4]; const bf16_t* pb[4];
#pragma unroll
        for (int i = 0; i < 4; ++i) { pa[i] = h + (size_t)(tm * 128 + lrow + 32 * i) * 1024 + lch8; pb[i] = WinT + (size_t)((HALF ? MGB : MGA) + tn * 128 + lrow + 32 * i) * 1024 + lch8; }
        f32x4 gg[4][4]; acc_zero(gg);
        gemm_kloop(gg, pa, pb, 64, 64, 16, smem);
#pragma unroll
        for (int mi = 0; mi < 4; ++mi)
#pragma unroll
            for (int ni = 0; ni < 4; ++ni) {
                f32x4 t;
#pragma unroll
                for (int j = 0; j < 4; ++j) t[j] = sigmoidf_(gg[mi][ni][j]);
                sg[mi][ni] = pack4v(t);
            }
    }
    {
        const bf16_t* pa[4]; const bf16_t* pb[4];
#pragma unroll
        for (int i = 0; i < 4; ++i) { pa[i] = yy + (size_t)(tm * 128 + lrow + 32 * i) * 512 + lch8; pb[i] = WT + (size_t)(tn * 128 + lrow + 32 * i) * 512 + lch8; }
        f32x4 acc[4][4]; acc_zero(acc);
        gemm_kloop(acc, pa, pb, 64, 64, 8, smem);
#pragma unroll
        for (int mi = 0; mi < 4; ++mi)
#pragma unroll
            for (int ni = 0; ni < 4; ++ni) {
                f32x4 t = unpack4v(sg[mi][ni]) * acc[mi][ni];
                if (HALF == 0) tpk[mi][ni] = pack4v(t);
                else {
                    t += unpack4v(tpk[mi][ni]);
                    const int m = tm * 128 + wr * 64 + mi * 16 + fr, n = tn * 128 + wc * 64 + ni * 16 + 4 * fq;
                    *(u32x2*)(mrg + (size_t)m * 1024 + n) = pack4v(t);
                }
            }
    }
}
__device__ __forceinline__ void ph_merge(const bf16_t* __restrict__ h, const bf16_t* __restrict__ WinT, const bf16_t* __restrict__ ya, const bf16_t* __restrict__ yb,
                                         const bf16_t* __restrict__ WaT, const bf16_t* __restrict__ WbT, bf16_t* __restrict__ mrg, char* smem) {
    for (int u = HB_FIRST; u < 128 * 8; u += HB_STEP) {
        const int xg = u & 7, v = u >> 3, tn = v & 7, tm = (v >> 3) * 8 + xg;
        u32x2 tpk[4][4];
        merge_half<0>(tpk, tm, tn, h, WinT, ya, WaT, mrg, smem);
        merge_half<1>(tpk, tm, tn, h, WinT, yb, WbT, mrg, smem);
    }
}

__device__ __forceinline__ void ph_outproj(const bf16_t* __restrict__ mrg, const bf16_t* __restrict__ WoT, const float* __restrict__ x, float* __restrict__ x2, char* smem) {
    GEMM_LANE_VARS
    for (int u = HB_FIRST; u < 128 * 8; u += HB_STEP) {
        const int xg = u & 7, v = u >> 3, tn = v & 7, tm = (v >> 3) * 8 + xg;
        const bf16_t* pa[4]; const bf16_t* pb[4];
#pragma unroll
        for (int i = 0; i < 4; ++i) { pa[i] = mrg + (size_t)(tm * 128 + lrow + 32 * i) * 1024 + lch8; pb[i] = WoT + (size_t)(tn * 128 + lrow + 32 * i) * 1024 + lch8; }
        f32x4 acc[4][4]; acc_zero(acc);
        gemm_kloop(acc, pa, pb, 64, 64, 16, smem);
#pragma unroll
        for (int mi = 0; mi < 4; ++mi)
#pragma unroll
            for (int ni = 0; ni < 4; ++ni) {
                const int m = tm * 128 + wr * 64 + mi * 16 + fr, n = tn * 128 + wc * 64 + ni * 16 + 4 * fq;
                const float4 xv = *(const float4*)(x + (size_t)m * 1024 + n);
                *(float4*)(x2 + (size_t)m * 1024 + n) = make_float4(xv.x + acc[mi][ni][0], xv.y + acc[mi][ni][1], xv.z + acc[mi][ni][2], xv.w + acc[mi][ni][3]);
            }
    }
}

__device__ __forceinline__ int moe_tile_decode(const int* __restrict__ cnt, int t, int& e, int& i) {
    int acc = 0; e = 0; i = 0;
    for (int ee = 0; ee < 32; ++ee) { const int nt = (cnt[ee * 64] + 127) >> 7; if (t >= acc && t < acc + nt) { e = ee; i = t - acc; } acc += nt; }
    return acc;
}

__device__ __forceinline__ void ph_moe1(const bf16_t* __restrict__ h2, const bf16_t* __restrict__ WgT, const bf16_t* __restrict__ WuT, const int* __restrict__ cnt,
                                        const int* __restrict__ ltok, const float* __restrict__ lw, const float* __restrict__ rstd, bf16_t* __restrict__ hid, char* smem) {
    GEMM_LANE_VARS
    int e, ti;
    const int nu = moe_tile_decode(cnt, 0, e, ti) * 4;
    for (int u = HB_FIRST; u < nu; u += HB_STEP) {
        const int ft = u & 3;
        (void)moe_tile_decode(cnt, u >> 2, e, ti);
        const int ne = cnt[e * 64];
        const bf16_t* pa[4]; const bf16_t* pb[4];
#pragma unroll
        for (int i = 0; i < 4; ++i) {
            const int rr = lrow + 32 * i, idx = ti * 128 + rr;
            const int tk = idx < ne ? ltok[e * 16384 + idx] : 0;
            pa[i] = h2 + (size_t)(tk >> 1) * 1024 + lch8;
            const int bwc = rr >> 6, bni = (rr >> 4) & 3, bj = rr & 15;
            const int f = ft * 64 + bwc * 32 + (bni >> 1) * 16 + bj;
            pb[i] = ((bni & 1) ? WuT : WgT) + ((size_t)e * 256 + f) * 1024 + lch8;
        }
        f32x4 acc[4][4]; acc_zero(acc);
        gemm_kloop(acc, pa, pb, 64, 64, 16, smem);
#pragma unroll
        for (int mi = 0; mi < 4; ++mi) {
            const int idx = ti * 128 + wr * 64 + mi * 16 + fr;
            if (idx < ne) {
                const int tk = ltok[e * 16384 + idx];
                const float w = lw[e * 16384 + idx], rsv = rstd[tk >> 1];
#pragma unroll
                for (int q = 0; q < 2; ++q) {
                    const int f = ft * 64 + wc * 32 + q * 16 + 4 * fq;
                    f32x4 v;
#pragma unroll
                    for (int j = 0; j < 4; ++j) { const float a = acc[mi][2 * q][j] * rsv, uu = acc[mi][2 * q + 1][j] * rsv; v[j] = a * sigmoidf_(a) * uu * w; }
                    *(uint2*)(hid + (size_t)tk * 256 + f) = pack4(v);
                }
            }
        }
    }
}

__device__ __forceinline__ void ph_moe2(const bf16_t* __restrict__ hid, const bf16_t* __restrict__ WdT, const int* __restrict__ cnt, const int* __restrict__ ltok,
                                        bf16_t* __restrict__ Y, char* smem) {
    GEMM_LANE_VARS
    int e, ti;
    const int nu = moe_tile_decode(cnt, 0, e, ti) * 8;
    for (int u = HB_FIRST; u < nu; u += HB_STEP) {
        const int tn = u & 7;
        (void)moe_tile_decode(cnt, u >> 3, e, ti);
        const int ne = cnt[e * 64];
        const bf16_t* pa[4]; const bf16_t* pb[4];
#pragma unroll
        for (int i = 0; i < 4; ++i) {
            const int idx = ti * 128 + lrow + 32 * i;
            const int tk = idx < ne ? ltok[e * 16384 + idx] : 0;
            pa[i] = hid + (size_t)tk * 256 + lch8;
            pb[i] = WdT + ((size_t)e * 1024 + tn * 128 + lrow + 32 * i) * 256 + lch8;
        }
        f32x4 acc[4][4]; acc_zero(acc);
        gemm_kloop(acc, pa, pb, 64, 64, 4, smem);
#pragma unroll
        for (int mi = 0; mi < 4; ++mi) {
            const int idx = ti * 128 + wr * 64 + mi * 16 + fr;
            if (idx < ne) {
                const int tk = ltok[e * 16384 + idx];
                bf16_t* yr = Y + ((size_t)(tk & 1) * T + (size_t)(tk >> 1)) * 1024 + tn * 128 + wc * 64 + 4 * fq;
#pragma unroll
                for (int ni = 0; ni < 4; ++ni) *(uint2*)(yr + ni * 16) = pack4(acc[mi][ni]);
            }
        }
    }
}

namespace g8 {
constexpr int HTB = 128 * 64 * 2;
__device__ __forceinline__ int lds_byte(int r, int c) { const int st = (r >> 4) * 2 + (c >> 5), rr = r & 15, cc = c & 31, ob = rr * 64 + cc * 2; return st * 1024 + (ob ^ (((ob >> 9) & 1) << 5)); }
__device__ __forceinline__ void stage_rc(int b, int& R, int& C) { const int st = b / 1024, sb = b % 1024, swz = sb ^ (((sb >> 9) & 1) << 5); R = (st >> 1) * 16 + swz / 64; C = (st & 1) * 32 + (swz % 64) / 2; }
__device__ __forceinline__ int perm32(int rho) { const int n = rho >> 4, i = rho & 15; return 8 * (i >> 2) + 4 * n + (i & 3); }
struct Unit { int pm, pn, e; };
struct StaticOrder {
    int nM, nN, nwg, G, c;
    __device__ __forceinline__ void init(int M, int N, int G_, int c_) { nM = M / 256; nN = N / 256; nwg = nM * nN; G = G_; c = c_; }
    __device__ __forceinline__ bool next(int i, Unit& u) const {
        const long L = (long)i * G + c; if (L >= nwg) return false;
        int wgid = (int)L; { const int q = nwg / 8, r = nwg % 8, xcd = wgid % 8, off = wgid / 8; wgid = (xcd < r ? xcd * (q + 1) : r * (q + 1) + (xcd - r) * q) + off; }
        const int nig = 8 * nN, gid = wgid / nig, fm = gid * 8, gsz = (nM - fm) < 8 ? (nM - fm) : 8;
        u.pm = fm + ((wgid % nig) % gsz); u.pn = (wgid % nig) / gsz; u.e = 0; return true;
    }
};
struct AddrPlain {
    const char* A; const char* Bt; unsigned lda2, ldb2; int ntiles;
    __device__ __forceinline__ const char* a_base(const Unit&) const { return A; }
    __device__ __forceinline__ const char* b_base(const Unit&) const { return Bt; }
    __device__ __forceinline__ int nt(const Unit&) const { return ntiles; }
    __device__ __forceinline__ int a_row0(const Unit& u) const { return u.pm * 256; }
    __device__ __forceinline__ int b_row0(const Unit& u) const { return u.pn * 256; }
    __device__ __forceinline__ unsigned a_ld(const Unit&) const { return lda2; }
    __device__ __forceinline__ unsigned b_ld(const Unit&) const { return ldb2; }
};

template <class Epi, class Sched, class Addr>
__device__ __forceinline__ void gemm_phase(char* ldsc, const Sched& S, const Addr& AD, const Epi& E) {
    __attribute__((address_space(3))) unsigned char* lds = (__attribute__((address_space(3))) unsigned char*)ldsc;
    int tid_ = threadIdx.x; asm volatile("" : "+v"(tid_));
    const int tid = tid_, wid = __builtin_amdgcn_readfirstlane(tid >> 6), lane = tid & 63, wr = wid >> 2, wc = wid & 3, fr = lane & 15, fq = lane >> 4;
    int R[2], C2[2], Rb[2];
#pragma unroll
    for (int i = 0; i < 2; ++i) { int r_, c_; stage_rc(tid * 16 + i * 8192, r_, c_); R[i] = r_; C2[i] = c_ * 2; Rb[i] = Epi::PERM ? ((r_ & ~31) + perm32(r_ & 31)) : r_; }
    const unsigned ldsw = (unsigned)wid * 1024u;
    const int aoff = lds_byte(wr * 64 + fr, fq * 8), boff = lds_byte(wc * 32 + fr, fq * 8);
#define G8_SA(b, h) (((b) * 2 + (h)) * HTB)
#define G8_SB(b, h) ((4 + (b) * 2 + (h)) * HTB)
#define G8_STAGE(bufoff, base, rowv, row0, ld, h, kb) do { _Pragma("unroll") for (int _i = 0; _i < 2; ++_i) \
        __builtin_amdgcn_global_load_lds((const __attribute__((address_space(1))) unsigned*)((base) + (size_t)((unsigned)((row0) + (h) * 128 + (rowv)[_i]) * (ld) + (unsigned)C2[_i] + (unsigned)(kb))), \
                                         (__attribute__((address_space(3))) unsigned*)(lds + (bufoff) + ldsw + _i * 8192), 16, 0, 0); } while (0)
#define G8_LDA(dst, b, h) do { _Pragma("unroll") for (int m = 0; m < 4; ++m) _Pragma("unroll") for (int k = 0; k < 2; ++k) dst[m][k] = *(const __attribute__((address_space(3))) bf16x8*)(lds + G8_SA(b, h) + aoff + m * 2048 + k * 1024); } while (0)
#define G8_LDB(dst, b, h) do { _Pragma("unroll") for (int n = 0; n < 2; ++n) _Pragma("unroll") for (int k = 0; k < 2; ++k) dst[n][k] = *(const __attribute__((address_space(3))) bf16x8*)(lds + G8_SB(b, h) + boff + n * 2048 + k * 1024); } while (0)
#define G8_MMA(ai, bj, At, Bt) do { __builtin_amdgcn_s_setprio(1); _Pragma("unroll") for (int m = 0; m < 4; ++m) _Pragma("unroll") for (int n = 0; n < 2; ++n) _Pragma("unroll") for (int k = 0; k < 2; ++k) \
        acc[ai][bj][m][n] = __builtin_amdgcn_mfma_f32_16x16x32_bf16(Bt[n][k], At[m][k], acc[ai][bj][m][n], 0, 0, 0); __builtin_amdgcn_s_setprio(0); } while (0)
#define G8_WAIT_V(n) asm volatile("s_waitcnt vmcnt(" #n ")" ::: "memory")
#define G8_WAIT_L(n) asm volatile("s_waitcnt lgkmcnt(" #n ")" ::: "memory")
#define G8_BAR __builtin_amdgcn_s_barrier()
#define G8_SCHED __builtin_amdgcn_sched_barrier(0)
    Unit cur, nxt; int ui = 0;
    if (!S.next(0, cur)) return;
    f32x4 acc[2][2][4][2];
#pragma unroll
    for (int a = 0; a < 2; ++a)
#pragma unroll
        for (int b = 0; b < 2; ++b)
#pragma unroll
            for (int m = 0; m < 4; ++m)
#pragma unroll
                for (int n = 0; n < 2; ++n) acc[a][b][m][n] = (f32x4){0.f, 0.f, 0.f, 0.f};
    bf16x8 At[4][2], B0[2][2], B1[2][2];
    const char* Ab = AD.a_base(cur); const char* Bb = AD.b_base(cur);
    int ar0 = AD.a_row0(cur), br0 = AD.b_row0(cur); unsigned ald = AD.a_ld(cur), bld = AD.b_ld(cur);
    __syncthreads();
    G8_STAGE(G8_SB(0, 0), Bb, Rb, br0, bld, 0, 0); G8_STAGE(G8_SA(0, 0), Ab, R, ar0, ald, 0, 0); G8_STAGE(G8_SB(0, 1), Bb, Rb, br0, bld, 1, 0); G8_STAGE(G8_SA(0, 1), Ab, R, ar0, ald, 1, 0);
    if (wr == 1) G8_BAR;
    G8_WAIT_V(4); G8_BAR;
    G8_STAGE(G8_SB(1, 0), Bb, Rb, br0, bld, 0, 128); G8_STAGE(G8_SA(1, 0), Ab, R, ar0, ald, 0, 128); G8_STAGE(G8_SB(1, 1), Bb, Rb, br0, bld, 1, 128);
    G8_WAIT_V(6); G8_BAR;
    for (;;) {
        const bool has_next = S.next(ui + 1, nxt);
        const int nt = AD.nt(cur);
        const char* nAb = has_next ? AD.a_base(nxt) : Ab; const char* nBb = has_next ? AD.b_base(nxt) : Bb;
        const int nar0 = has_next ? AD.a_row0(nxt) : ar0, nbr0 = has_next ? AD.b_row0(nxt) : br0;
        const unsigned nald = has_next ? AD.a_ld(nxt) : ald, nbld = has_next ? AD.b_ld(nxt) : bld;
        for (int t = 0; t < nt; t += 2) {
            const bool last = (t == nt - 2);
            const int kb1 = (t + 1) * 128, kb2 = last ? 0 : (t + 2) * 128, kb3 = kb2 + 128;
            const char* sAb = last ? nAb : Ab; const char* sBb = last ? nBb : Bb;
            const int sar0 = last ? nar0 : ar0, sbr0 = last ? nbr0 : br0; const unsigned sald = last ? nald : ald, sbld = last ? nbld : bld;
            G8_LDB(B0, 0, 0); G8_SCHED; G8_LDA(At, 0, 0); G8_STAGE(G8_SA(1, 1), Ab, R, ar0, ald, 1, kb1);
            G8_WAIT_L(8); G8_BAR; G8_WAIT_L(0); G8_MMA(0, 0, At, B0); G8_BAR; G8_SCHED;
            G8_LDB(B1, 0, 1); G8_STAGE(G8_SB(0, 0), sBb, Rb, sbr0, sbld, 0, kb2);
            G8_BAR; G8_WAIT_L(0); G8_MMA(0, 1, At, B1); G8_BAR;
            G8_LDA(At, 0, 1); G8_STAGE(G8_SA(0, 0), sAb, R, sar0, sald, 0, kb2);
            G8_BAR; G8_WAIT_L(0); G8_MMA(1, 0, At, B0); G8_BAR; G8_SCHED;
            G8_STAGE(G8_SB(0, 1), sBb, Rb, sbr0, sbld, 1, kb2);
            G8_WAIT_V(6); G8_BAR; G8_MMA(1, 1, At, B1); G8_BAR;
            G8_LDB(B0, 1, 0); G8_SCHED; G8_LDA(At, 1, 0); G8_STAGE(G8_SA(0, 1), sAb, R, sar0, sald, 1, kb2);
            G8_WAIT_L(8); G8_BAR; G8_WAIT_L(0); G8_MMA(0, 0, At, B0); G8_BAR; G8_SCHED;
            G8_LDB(B1, 1, 1); G8_STAGE(G8_SB(1, 0), sBb, Rb, sbr0, sbld, 0, kb3);
            G8_BAR; G8_WAIT_L(0); G8_MMA(0, 1, At, B1); G8_BAR;
            G8_LDA(At, 1, 1); G8_STAGE(G8_SA(1, 0), sAb, R, sar0, sald, 0, kb3);
            G8_BAR; G8_WAIT_L(0); G8_MMA(1, 0, At, B0); G8_BAR; G8_SCHED;
            G8_STAGE(G8_SB(1, 1), sBb, Rb, sbr0, sbld, 1, kb3);
            G8_WAIT_V(6); G8_BAR; G8_MMA(1, 1, At, B1); G8_BAR;
        }
        E(acc, cur, wr, wc, fr, fq);
        if (!has_next) break;
#pragma unroll
        for (int a = 0; a < 2; ++a)
#pragma unroll
            for (int b = 0; b < 2; ++b)
#pragma unroll
                for (int m = 0; m < 4; ++m)
#pragma unroll
                    for (int n = 0; n < 2; ++n) acc[a][b][m][n] = (f32x4){0.f, 0.f, 0.f, 0.f};
        cur = nxt; Ab = nAb; Bb = nBb; ar0 = nar0; br0 = nbr0; ald = nald; bld = nbld; ++ui;
    }
    G8_WAIT_V(0);
    if (wr == 0) G8_BAR;
    G8_BAR;
#undef G8_SA
#undef G8_SB
#undef G8_STAGE
#undef G8_LDA
#undef G8_LDB
#undef G8_MMA
#undef G8_WAIT_V
#undef G8_WAIT_L
#undef G8_BAR
#undef G8_SCHED
}

struct EpiProj {
    static constexpr bool PERM = true;
    bf16_t* proj;
    __device__ __forceinline__ void operator()(const f32x4 (&acc)[2][2][4][2], const Unit& u, int wr, int wc, int fr, int fq) const {
#pragma unroll
        for (int ai = 0; ai < 2; ++ai)
#pragma unroll
            for (int m = 0; m < 4; ++m) {
                const int r = u.pm * 256 + ai * 128 + wr * 64 + m * 16 + fr;
#pragma unroll
                for (int bj = 0; bj < 2; ++bj) {
                    const int c = u.pn * 256 + bj * 128 + wc * 32 + 8 * fq;
                    if (c < NPROJ) {
                        u32x4 w; w[0] = pack_bf16(acc[ai][bj][m][0][0], acc[ai][bj][m][0][1]); w[1] = pack_bf16(acc[ai][bj][m][0][2], acc[ai][bj][m][0][3]);
                        w[2] = pack_bf16(acc[ai][bj][m][1][0], acc[ai][bj][m][1][1]); w[3] = pack_bf16(acc[ai][bj][m][1][2], acc[ai][bj][m][1][3]);
                        *(u32x4*)(proj + (size_t)r * PP + c) = w;
                    }
                }
            }
    }
};
struct EpiResid {
    static constexpr bool PERM = false;
    const float* x; float* x2;
    __device__ __forceinline__ void operator()(const f32x4 (&acc)[2][2][4][2], const Unit& u, int wr, int wc, int fr, int fq) const {
#pragma unroll
        for (int ai = 0; ai < 2; ++ai)
#pragma unroll
            for (int m = 0; m < 4; ++m) {
                const int r = u.pm * 256 + ai * 128 + wr * 64 + m * 16 + fr;
#pragma unroll
                for (int bj = 0; bj < 2; ++bj)
#pragma unroll
                    for (int n = 0; n < 2; ++n) {
                        const int c = u.pn * 256 + bj * 128 + wc * 32 + 16 * n + 4 * fq;
                        const f32x4 xv = *(const f32x4*)(x + (size_t)r * 1024 + c);
                        *(f32x4*)(x2 + (size_t)r * 1024 + c) = xv + acc[ai][bj][m][n];
                    }
            }
    }
};
struct OneUnit { Unit u; __device__ __forceinline__ bool next(int i, Unit& o) const { if (i) return false; o = u; return true; } };
template <int OP>
struct EpiMerge {
    static constexpr bool PERM = true;
    bf16_t* dst; const bf16_t* src2;
    __device__ __forceinline__ void operator()(const f32x4 (&acc)[2][2][4][2], const Unit& u, int wr, int wc, int fr, int fq) const {
#pragma unroll
        for (int ai = 0; ai < 2; ++ai)
#pragma unroll
            for (int m = 0; m < 4; ++m) {
                const int r = u.pm * 256 + ai * 128 + wr * 64 + m * 16 + fr;
#pragma unroll
                for (int bj = 0; bj < 2; ++bj) {
                    const size_t o = (size_t)r * 1024 + u.pn * 256 + bj * 128 + wc * 32 + 8 * fq;
                    float v[8];
#pragma unroll
                    for (int j = 0; j < 4; ++j) { v[j] = acc[ai][bj][m][0][j]; v[4 + j] = acc[ai][bj][m][1][j]; }
                    if (OP == 0) {
#pragma unroll
                        for (int j = 0; j < 8; ++j) v[j] = sigmoidf_(v[j]);
                    } else {
                        const u32x4 d = *(const u32x4*)(dst + o);
                        float dv[8];
#pragma unroll
                        for (int j = 0; j < 4; ++j) { dv[2 * j] = __uint_as_float(d[j] << 16); dv[2 * j + 1] = __uint_as_float(d[j] & 0xFFFF0000u); }
                        if (OP == 1) {
#pragma unroll
                            for (int j = 0; j < 8; ++j) v[j] = dv[j] * v[j];
                        } else {
                            const u32x4 s = *(const u32x4*)(src2 + o);
#pragma unroll
                            for (int j = 0; j < 4; ++j) { v[2 * j] = dv[2 * j] + __uint_as_float(s[j] << 16) * v[2 * j]; v[2 * j + 1] = dv[2 * j + 1] + __uint_as_float(s[j] & 0xFFFF0000u) * v[2 * j + 1]; }
                        }
                    }
                    u32x4 w; w[0] = pack_bf16(v[0], v[1]); w[1] = pack_bf16(v[2], v[3]); w[2] = pack_bf16(v[4], v[5]); w[3] = pack_bf16(v[6], v[7]);
                    *(u32x4*)(dst + o) = w;
                }
            }
    }
};
struct MergeOrder { StaticOrder so; __device__ __forceinline__ bool next(int i, Unit& u) const { if (!so.next(i >> 2, u)) return false; u.e = i & 3; return true; } };
struct AddrMerge {
    const char* h; const char* WinT; const char* ya; const char* yb; const char* WaT; const char* WbT;
    __device__ __forceinline__ const char* a_base(const Unit& u) const {
        const unsigned long long ph = (unsigned long long)h, pa = (unsigned long long)ya, pb = (unsigned long long)yb, o = (unsigned long long)(u.e & 1), t = (unsigned long long)((u.e >> 1) & 1);
        return (const char*)(ph + o * ((pa - ph) + t * (pb - pa))); }
    __device__ __forceinline__ const char* b_base(const Unit& u) const {
        const unsigned long long pg = (unsigned long long)(WinT + (size_t)MGA * 2048), pa = (unsigned long long)WaT, pb = (unsigned long long)WbT, o = (unsigned long long)(u.e & 1), t = (unsigned long long)((u.e >> 1) & 1);
        const unsigned long long g = pg + t * (unsigned long long)((size_t)(MGB - MGA) * 2048), y = pa + t * (pb - pa);
        return (const char*)(g + o * (y - g)); }
    __device__ __forceinline__ int nt(const Unit& u) const { return (u.e & 1) ? 8 : 16; }
    __device__ __forceinline__ int a_row0(const Unit& u) const { return u.pm * 256; }
    __device__ __forceinline__ int b_row0(const Unit& u) const { return u.pn * 256; }
    __device__ __forceinline__ unsigned a_ld(const Unit& u) const { return (u.e & 1) ? 1024u : 2048u; }
    __device__ __forceinline__ unsigned b_ld(const Unit& u) const { return (u.e & 1) ? 1024u : 2048u; }
};
struct EpiMergeAll {
    static constexpr bool PERM = true;
    bf16_t* mrg; bf16_t* sg2;
    __device__ __forceinline__ void operator()(const f32x4 (&acc)[2][2][4][2], const Unit& u, int wr, int wc, int fr, int fq) const {
        if (u.e == 0) EpiMerge<0>{mrg, nullptr}(acc, u, wr, wc, fr, fq);
        else if (u.e == 1) EpiMerge<1>{mrg, nullptr}(acc, u, wr, wc, fr, fq);
        else if (u.e == 2) EpiMerge<0>{sg2, nullptr}(acc, u, wr, wc, fr, fq);
        else EpiMerge<2>{mrg, sg2}(acc, u, wr, wc, fr, fq);
    }
};
}

constexpr float LOG2E = 1.4426950408889634f;
constexpr float NEGV = -3.0e38f;
constexpr int NSA_TB = 32768;
constexpr int NSA_IMPA = 34816;
constexpr int NSA_IMPB = NSA_IMPA + 16640;
constexpr int NSA_SELM = NSA_IMPB + 16640;

__device__ __forceinline__ int t5_bucket2(int n) {
    if (n < 16) return n;
    const int l = 16 + (int)(logf((float)n / 16.0f) / logf(8.0f) * 16.0f);
    return l < 31 ? l : 31;
}

template <int MODE, bool A0, bool A1>
__device__ __forceinline__ void nsa_tile(const char* Kst, const char* Vst, int j, bool fast, const float* tbias, const bf16x8 (&qf)[2][2], const int (&qidx)[2],
                                         const unsigned long long (&selq)[2], f32x4 (&O)[4][2], float (&m)[2], float (&l)[2], const float (&invl)[2],
                                         char* smem, int fr, int fq, int hp, int wid) {
    const float b127 = tbias[127];
    bf16x8 pf[2][2];
    bool started = true;
    if (MODE != 3) started = __builtin_amdgcn_ballot_w64((A0 && m[0] < -1e29f) || (A1 && m[1] < -1e29f)) == 0ull;
    const bool quick = (MODE != 3) && fast && started;
    f32x4 sall[2][2][2];
#pragma unroll
    for (int p = 0; p < 2; ++p)
#pragma unroll
        for (int s = 0; s < 2; ++s) {
            const int row = 32 * p + 16 * s + fr;
            const bf16x8 k0 = *(const bf16x8*)(Kst + tile_off(row, fq)), k1 = *(const bf16x8*)(Kst + tile_off(row, 4 + fq));
#pragma unroll
            for (int ct = 0; ct < 2; ++ct) {
                if ((ct == 0 && !A0) || (ct == 1 && !A1)) continue;
                float i0 = 0.f;
                if (quick) { const bool sel = (MODE == 1) ? (((selq[ct] >> j) & 1ull) != 0ull) : true; i0 = (sel ? b127 : NEGV) - m[ct]; }
                f32x4 a = (f32x4){i0, i0, i0, i0};
                a = __builtin_amdgcn_mfma_f32_16x16x32_bf16(k0, qf[ct][0], a, 0, 0, 0);
                a = __builtin_amdgcn_mfma_f32_16x16x32_bf16(k1, qf[ct][1], a, 0, 0, 0);
                sall[ct][p][s] = a;
            }
        }
#pragma unroll
    for (int ct = 0; ct < 2; ++ct) {
        if ((ct == 0 && !A0) || (ct == 1 && !A1)) continue;
        f32x4 (&sacc)[2][2] = sall[ct];
        const int q = qidx[ct];
        const bool sel = (MODE == 1) ? (((selq[ct] >> j) & 1ull) != 0ull) : true;
        if (MODE != 3) {
            const float mct = m[ct];
            if (!quick) {
                const float ref = started ? mct : 0.f;
#pragma unroll
                for (int p = 0; p < 2; ++p)
#pragma unroll
                    for (int s = 0; s < 2; ++s)
#pragma unroll
                        for (int i = 0; i < 4; ++i) {
                            const int kk = 64 * j + 32 * p + 8 * fq + 4 * s + i;
                            int rel; bool valid;
                            if (MODE == 0) { rel = q - (16 * kk + 31); valid = rel >= 0; }
                            else if (MODE == 1) { rel = q - kk; valid = (rel >= 0) && sel; }
                            else { rel = q - kk; valid = (rel >= 0) && (rel < 512); }
                            const int rc = rel < 0 ? 0 : (rel > 127 ? 127 : rel);
                            sacc[p][s][i] = valid ? sacc[p][s][i] + (tbias[rc] - ref) : NEGV;
                        }
            }
            float pv[2][8]; float psum = 0.f;
            bool redo = !started;
            if (started) {
#pragma unroll
                for (int p = 0; p < 2; ++p)
#pragma unroll
                    for (int s = 0; s < 2; ++s)
#pragma unroll
                        for (int i = 0; i < 4; ++i) { pv[p][s * 4 + i] = __builtin_amdgcn_exp2f(sacc[p][s][i]); psum += pv[p][s * 4 + i]; }
                if (__builtin_amdgcn_ballot_w64(!(psum <= 256.0f)) != 0ull) {
                    redo = true;
#pragma unroll
                    for (int p = 0; p < 2; ++p)
#pragma unroll
                        for (int s = 0; s < 2; ++s)
#pragma unroll
                            for (int i = 0; i < 4; ++i) sacc[p][s][i] += mct;
                }
            }
            if (redo) {
                float mloc = NEGV;
#pragma unroll
                for (int p = 0; p < 2; ++p)
#pragma unroll
                    for (int s = 0; s < 2; ++s)
#pragma unroll
                        for (int i = 0; i < 4; ++i) mloc = fmaxf(mloc, sacc[p][s][i]);
                mloc = fmaxf(mloc, __shfl_xor(mloc, 16)); mloc = fmaxf(mloc, __shfl_xor(mloc, 32));
                const float mnew = fmaxf(mct, mloc);
                const float alpha = __builtin_amdgcn_exp2f(mct - mnew);
                m[ct] = mnew; l[ct] *= alpha;
#pragma unroll
                for (int dt = 0; dt < 4; ++dt) O[dt][ct] = O[dt][ct] * alpha;
                psum = 0.f;
#pragma unroll
                for (int p = 0; p < 2; ++p)
#pragma unroll
                    for (int s = 0; s < 2; ++s)
#pragma unroll
                        for (int i = 0; i < 4; ++i) { pv[p][s * 4 + i] = __builtin_amdgcn_exp2f(sacc[p][s][i] - mnew); psum += pv[p][s * 4 + i]; }
            }
#pragma unroll
            for (int p = 0; p < 2; ++p) {
                u32x4 w; w[0] = pack_bf16(pv[p][0], pv[p][1]); w[1] = pack_bf16(pv[p][2], pv[p][3]); w[2] = pack_bf16(pv[p][4], pv[p][5]); w[3] = pack_bf16(pv[p][6], pv[p][7]);
                pf[ct][p] = __builtin_bit_cast(bf16x8, w);
            }
            l[ct] += psum;
        } else {
#pragma unroll
            for (int p = 0; p < 2; ++p)
#pragma unroll
                for (int s = 0; s < 2; ++s)
#pragma unroll
                    for (int i = 0; i < 4; ++i) {
                        const int kk = 64 * j + 32 * p + 8 * fq + 4 * s + i;
                        const int rel = q - (16 * kk + 31);
                        const int rc = rel < 0 ? 0 : (rel > 127 ? 127 : rel);
                        sacc[p][s][i] = (rel >= 0) ? sacc[p][s][i] + tbias[rc] : NEGV;
                    }
            float* impA = (float*)(smem + NSA_IMPA); float* impB = (float*)(smem + NSA_IMPB);
            const int ql = wid * 8 + ct * 4 + (fr >> 2);
#pragma unroll
            for (int p = 0; p < 2; ++p)
#pragma unroll
                for (int s = 0; s < 2; ++s) {
                    float p3 = __builtin_amdgcn_exp2f(sacc[p][s][3] - m[ct]) * invl[ct];
                    float pa = __builtin_amdgcn_exp2f(sacc[p][s][0] - m[ct]) * invl[ct] + __builtin_amdgcn_exp2f(sacc[p][s][1] - m[ct]) * invl[ct]
                             + __builtin_amdgcn_exp2f(sacc[p][s][2] - m[ct]) * invl[ct] + p3;
                    pa += __shfl_xor(pa, 1); pa += __shfl_xor(pa, 2);
                    p3 += __shfl_xor(p3, 1); p3 += __shfl_xor(p3, 2);
                    const int jj = 16 * j + 8 * p + 2 * fq + s;
                    if (hp == 0) { impA[ql * 65 + jj] = pa; impB[ql * 65 + jj + 1] = p3; }
                }
        }
    }
    if (MODE != 3) {
#pragma unroll
        for (int dt = 0; dt < 4; ++dt)
#pragma unroll
            for (int p = 0; p < 2; ++p) {
                const bf16x8 vf = *(const bf16x8*)(Vst + tile_off(dt * 16 + fr, p * 4 + fq));
                if (A0) O[dt][0] = __builtin_amdgcn_mfma_f32_16x16x32_bf16(vf, pf[0][p], O[dt][0], 0, 0, 0);
                if (A1) O[dt][1] = __builtin_amdgcn_mfma_f32_16x16x32_bf16(vf, pf[1][p], O[dt][1], 0, 0, 0);
            }
    }
}

template <int MODE>
__device__ __forceinline__ void nsa_branch(const bf16_t* __restrict__ Kb, size_t kstride, const bf16_t* __restrict__ Vb, size_t vstride, int j0, int ntiles, int t0,
                                           const bf16x8 (&qf)[2][2], const int (&qidx)[2], const unsigned long long (&selq)[2], unsigned long long selor0, unsigned long long selor1,
                                           f32x4 (&O)[4][2], float (&m)[2], float (&l)[2], const float (&invl)[2], char* smem) {
    int tid_ = threadIdx.x; asm volatile("" : "+v"(tid_));
    const int tid = tid_, lane = tid & 63, wid = tid >> 6, fr = lane & 15, fq = lane >> 4, hp = fr & 3;
    const int lrow = tid >> 3;
    const float* tbias = (const float*)(smem + NSA_TB) + hp * 128;
    const int sch8 = ((tid & 7) ^ (lrow & 7)) * 8;
    const int krow = 32 * (lrow >> 5) + 8 * ((lrow & 15) >> 2) + 4 * ((lrow >> 4) & 1) + (lrow & 3);
    const bf16_t* kp = Kb + (size_t)krow * kstride + sch8;
    const bf16_t* vp = Vb + (size_t)lrow * vstride + sch8;
    __syncthreads();
    glds16(kp, smem + tid * 16); if (MODE != 3) glds16(vp, smem + 8192 + tid * 16);
    asm volatile("s_waitcnt vmcnt(0)" ::: "memory");
    __syncthreads();
    for (int it = 0; it < ntiles; ++it) {
        const int cur = it & 1, j = j0 + it;
        if (it + 1 < ntiles) {
            char* st = smem + (cur ^ 1) * 16384 + tid * 16;
            glds16(kp + (size_t)(it + 1) * 64 * kstride, st); if (MODE != 3) glds16(vp + (size_t)(it + 1) * 64, st + 8192);
        }
        const char* Kst = smem + cur * 16384;
        const char* Vst = Kst + 8192;
        bool fast;
        if (MODE == 0 || MODE == 3) fast = (t0 - (16 * (64 * j + 63) + 31)) >= 128;
        else if (MODE == 1) fast = (t0 - (64 * j + 63)) >= 128;
        else fast = ((t0 - (64 * j + 63)) >= 128) && ((t0 + 63 - 64 * j) < 512);
        if (MODE == 1) {
            const bool a0 = ((selor0 >> j) & 1ull) != 0ull, a1 = ((selor1 >> j) & 1ull) != 0ull;
            if (a0 && a1) nsa_tile<MODE, true, true>(Kst, Vst, j, fast, tbias, qf, qidx, selq, O, m, l, invl, smem, fr, fq, hp, wid);
            else if (a0) nsa_tile<MODE, true, false>(Kst, Vst, j, fast, tbias, qf, qidx, selq, O, m, l, invl, smem, fr, fq, hp, wid);
            else if (a1) nsa_tile<MODE, false, true>(Kst, Vst, j, fast, tbias, qf, qidx, selq, O, m, l, invl, smem, fr, fq, hp, wid);
        } else {
            nsa_tile<MODE, true, true>(Kst, Vst, j, fast, tbias, qf, qidx, selq, O, m, l, invl, smem, fr, fq, hp, wid);
        }
        asm volatile("s_waitcnt vmcnt(0)" ::: "memory");
        __syncthreads();
    }
}

__device__ __forceinline__ void osum_add(uint2& acc, f32x4 o, float sc) {
    f32x4 v;
    v[0] = __uint_as_float(acc.x << 16) + o[0] * sc; v[1] = __uint_as_float(acc.x & 0xFFFF0000u) + o[1] * sc;
    v[2] = __uint_as_float(acc.y << 16) + o[2] * sc; v[3] = __uint_as_float(acc.y & 0xFFFF0000u) + o[3] * sc;
    acc = pack4(v);
}
__device__ __forceinline__ float nsa_gate(const bf16_t* __restrict__ pb, int q, int br, int head) { return sigmoidf_(bf2f(pb[(size_t)q * PP + GA + br * 8 + head])); }

__device__ __forceinline__ void nsa_unit(int u, const bf16_t* __restrict__ proj, const char* __restrict__ ws, const float* __restrict__ rel_bias, bf16_t* __restrict__ ya, char* smem) {
    int tid_ = threadIdx.x; asm volatile("" : "+v"(tid_));
    const int tid = tid_, lane = tid & 63, wid = tid >> 6, fr = lane & 15, fq = lane >> 4, hp = fr & 3;
    const int bg = u & 7, qb = 63 - (u >> 3), b = bg >> 1, g = bg & 1, t0 = qb * 64, tb = qb;
    const bf16_t* kcb = (const bf16_t*)(ws + OFF_KCB) + (size_t)bg * 256 * 64;
    const bf16_t* vcbT = (const bf16_t*)(ws + OFF_VCBT) + (size_t)bg * 64 * 256;
    const bf16_t* VsT = (const bf16_t*)(ws + OFF_VST) + (size_t)bg * 64 * S;
    const bf16_t* VwT = (const bf16_t*)(ws + OFF_VWT) + (size_t)bg * 64 * S;
    const bf16_t* pb = proj + (size_t)b * S * PP;
    __syncthreads();
    {
        float* tbl = (float*)(smem + NSA_TB);
        { const int e = tid, h4 = e >> 7, n = e & 127; tbl[e] = rel_bias[t5_bucket2(n) * 8 + g * 4 + h4] * LOG2E; }
        float* imp = (float*)(smem + NSA_IMPA);
        for (int e = tid; e < 2 * 4160; e += 512) imp[e] = 0.f;
    }
    int qidx[2]; bf16x8 qf[2][2];
    const int head = g * 4 + hp;
#pragma unroll
    for (int ct = 0; ct < 2; ++ct) {
        qidx[ct] = t0 + wid * 8 + ct * 4 + (fr >> 2);
        const bf16_t* qr = pb + (size_t)qidx[ct] * PP;
#pragma unroll
        for (int ks = 0; ks < 2; ++ks) {
            const u32x4 raw = *(const u32x4*)(qr + QA + head * 64 + ks * 32 + fq * 8);
            u32x4 w;
#pragma unroll
            for (int e = 0; e < 4; ++e) w[e] = pack_bf16(__uint_as_float(raw[e] << 16) * (0.125f * LOG2E), __uint_as_float(raw[e] & 0xFFFF0000u) * (0.125f * LOG2E));
            qf[ct][ks] = __builtin_bit_cast(bf16x8, w);
        }
    }
    uint2 osum[4][2];
#pragma unroll
    for (int dt = 0; dt < 4; ++dt)
#pragma unroll
        for (int ct = 0; ct < 2; ++ct) osum[dt][ct] = make_uint2(0u, 0u);
    unsigned long long selq[2] = {0ull, 0ull};
    float invl0[2] = {0.f, 0.f};
    const int ntc = (((t0 + 32) >> 4) + 1 + 63) >> 6;
    float mC[2], invC[2];
    {
        f32x4 O[4][2]; float m[2] = {-1e30f, -1e30f}, l[2] = {0.f, 0.f};
#pragma unroll
        for (int dt = 0; dt < 4; ++dt)
#pragma unroll
            for (int ct = 0; ct < 2; ++ct) O[dt][ct] = (f32x4){0.f, 0.f, 0.f, 0.f};
        nsa_branch<0>(kcb, 64, vcbT, 256, 0, ntc, t0, qf, qidx, selq, 0ull, 0ull, O, m, l, invl0, smem);
#pragma unroll
        for (int ct = 0; ct < 2; ++ct) {
            float lt = l[ct]; lt += __shfl_xor(lt, 16); lt += __shfl_xor(lt, 32);
            invC[ct] = lt > 0.f ? 1.f / lt : 0.f; mC[ct] = m[ct];
#pragma unroll
            for (int dt = 0; dt < 4; ++dt) osum_add(osum[dt][ct], O[dt][ct], nsa_gate(pb, qidx[ct], 0, head) * invC[ct]);
        }
        nsa_branch<3>(kcb, 64, vcbT, 256, 0, ntc, t0, qf, qidx, selq, 0ull, 0ull, O, mC, l, invC, smem);
    }
    {
        const float* impA = (const float*)(smem + NSA_IMPA); const float* impB = (const float*)(smem + NSA_IMPB);
        unsigned long long* selm = (unsigned long long*)(smem + NSA_SELM);
#pragma unroll 1
        for (int qq = 0; qq < 8; ++qq) {
            const int ql = wid * 8 + qq;
            const float val = impA[ql * 65 + lane] + impB[ql * 65 + lane];
            const bool forced = (lane == 0) || (lane == tb) || (lane == tb - 1);
            unsigned key = forced ? 0xFFFFFFC0u : (lane > tb ? 0u : (__float_as_uint(val) & 0xFFFFFFC0u));
            key |= (unsigned)(63 - lane);
            int rank = 0;
#pragma unroll
            for (int jp = 0; jp < 64; ++jp) rank += ((unsigned)__builtin_amdgcn_readlane((int)key, jp) > key) ? 1 : 0;
            const unsigned long long msk = __ballot(rank < 16);
            if (lane == 0) selm[ql] = msk;
        }
        wave_lds_sync();
        unsigned long long so0 = 0ull, so1 = 0ull;
#pragma unroll
        for (int qq = 0; qq < 4; ++qq) { so0 |= selm[wid * 8 + qq]; so1 |= selm[wid * 8 + 4 + qq]; }
        const unsigned long long selor0 = ((unsigned long long)(unsigned)__builtin_amdgcn_readfirstlane((int)(unsigned)(so0 >> 32)) << 32) | (unsigned)__builtin_amdgcn_readfirstlane((int)(unsigned)so0);
        const unsigned long long selor1 = ((unsigned long long)(unsigned)__builtin_amdgcn_readfirstlane((int)(unsigned)(so1 >> 32)) << 32) | (unsigned)__builtin_amdgcn_readfirstlane((int)(unsigned)so1);
        selq[0] = selm[wid * 8 + (fr >> 2)]; selq[1] = selm[wid * 8 + 4 + (fr >> 2)];
        {
            f32x4 O[4][2]; float m[2] = {-1e30f, -1e30f}, l[2] = {0.f, 0.f};
#pragma unroll
            for (int dt = 0; dt < 4; ++dt)
#pragma unroll
                for (int ct = 0; ct < 2; ++ct) O[dt][ct] = (f32x4){0.f, 0.f, 0.f, 0.f};
            nsa_branch<1>(pb + KS + g * 64, PP, VsT, S, 0, tb + 1, t0, qf, qidx, selq, selor0, selor1, O, m, l, invl0, smem);
#pragma unroll
            for (int ct = 0; ct < 2; ++ct) {
                float lt = l[ct]; lt += __shfl_xor(lt, 16); lt += __shfl_xor(lt, 32);
                const float inv = lt > 0.f ? 1.f / lt : 0.f;
#pragma unroll
                for (int dt = 0; dt < 4; ++dt) osum_add(osum[dt][ct], O[dt][ct], nsa_gate(pb, qidx[ct], 1, head) * inv);
            }
        }
    }
    {
        f32x4 O[4][2]; float m[2] = {-1e30f, -1e30f}, l[2] = {0.f, 0.f};
#pragma unroll
        for (int dt = 0; dt < 4; ++dt)
#pragma unroll
            for (int ct = 0; ct < 2; ++ct) O[dt][ct] = (f32x4){0.f, 0.f, 0.f, 0.f};
        const int jw0 = (t0 - 511 < 0 ? 0 : t0 - 511) >> 6;
        nsa_branch<2>(pb + (size_t)jw0 * 64 * PP + KW + g * 64, PP, VwT + jw0 * 64, S, jw0, tb - jw0 + 1, t0, qf, qidx, selq, 0ull, 0ull, O, m, l, invl0, smem);
#pragma unroll
        for (int ct = 0; ct < 2; ++ct) {
            float lt = l[ct]; lt += __shfl_xor(lt, 16); lt += __shfl_xor(lt, 32);
            const float inv = lt > 0.f ? 1.f / lt : 0.f;
#pragma unroll
            for (int dt = 0; dt < 4; ++dt) osum_add(osum[dt][ct], O[dt][ct], nsa_gate(pb, qidx[ct], 2, head) * inv);
        }
    }
#pragma unroll
    for (int ct = 0; ct < 2; ++ct) {
        bf16_t* yr = ya + (size_t)(b * S + qidx[ct]) * 512 + head * 64 + 4 * fq;
#pragma unroll
        for (int dt = 0; dt < 4; ++dt) *(uint2*)(yr + dt * 16) = osum[dt][ct];
    }
}

__device__ __forceinline__ void vtrans_tile(int task, const bf16_t* __restrict__ proj, char* ws, char* smem) {
    unsigned short (*tl)[66] = (unsigned short (*)[66])smem;
    const int tid = HB_TID, which = task >> 9, bg = (task >> 6) & 7, tt = task & 63, b = bg >> 1, g = bg & 1;
    const int r = tid >> 2, q4 = tid & 3;
    const bf16_t* src = proj + (size_t)(b * S + tt * 64 + r) * PP + (which ? VW : VS) + g * 64 + q4 * 16;
    const uint4 a0 = *(const uint4*)src, a1 = *(const uint4*)(src + 8);
    unsigned* trow = (unsigned*)&tl[r][q4 * 16];
    trow[0] = a0.x; trow[1] = a0.y; trow[2] = a0.z; trow[3] = a0.w; trow[4] = a1.x; trow[5] = a1.y; trow[6] = a1.z; trow[7] = a1.w;
    __syncthreads();
    bf16_t* dst = (bf16_t*)(ws + (which ? OFF_VWT : OFF_VST)) + ((size_t)bg * 64 + r) * S + tt * 64 + q4 * 16;
    unsigned o[8];
#pragma unroll
    for (int k = 0; k < 8; ++k) o[k] = (unsigned)tl[q4 * 16 + 2 * k][r] | ((unsigned)tl[q4 * 16 + 2 * k + 1][r] << 16);
    *(uint4*)dst = make_uint4(o[0], o[1], o[2], o[3]);
    *(uint4*)(dst + 8) = make_uint4(o[4], o[5], o[6], o[7]);
    __syncthreads();
}

__device__ __forceinline__ int tile_el(int row, int col) { return tile_off(row, col >> 3) + ((col & 7) << 1); }

__device__ __forceinline__ void gla_stage_vt(const bf16_t* __restrict__ proj, size_t row0, int h, char* vt_base) {
    const int tid = HB_TID, c = tid >> 2, vq = tid & 3;
    const bf16_t* src = proj + (row0 + c) * PP + VB + h * 128 + vq * 32;
#pragma unroll
    for (int k = 0; k < 4; ++k) {
        const u32x4 a = *(const u32x4*)(src + k * 8);
#pragma unroll
        for (int e = 0; e < 4; ++e) {
            const int v = vq * 32 + k * 8 + 2 * e;
            *(unsigned short*)(vt_base + tile_el(v, c)) = (unsigned short)(a[e] & 0xFFFFu);
            *(unsigned short*)(vt_base + tile_el(v + 1, c)) = (unsigned short)(a[e] >> 16);
        }
    }
}

__device__ __forceinline__ void gla_a_unit(int vb, const bf16_t* __restrict__ proj, const float* __restrict__ w_alpha, const float* __restrict__ b_alpha,
                                           float* __restrict__ bc, float* __restrict__ cstate, char* smem) {
    float (*bcS)[64] = (float (*)[64])smem;
    float (*tot)[64] = (float (*)[64])(smem + 16384);
    char* KDT = smem + 17408;
    char* VT = smem + 17408 + 8192;
    const int tid = HB_TID, lane = tid & 63, wid = tid >> 6, fr = lane & 15, fq = lane >> 4;
    const int n = vb & 63, h = (vb >> 6) & 3, b = vb >> 8;
    const size_t row0 = (size_t)(b * S + n * 64);
    __syncthreads();
    {
        const int d = tid & 63, cq = tid >> 6, col = h * 64 + d;
        float w[16];
#pragma unroll
        for (int r = 0; r < 16; ++r) w[r] = w_alpha[r * 256 + col];
        const float bias = b_alpha[col];
        float cum = 0.f;
        for (int i = 0; i < 16; ++i) {
            const int c = cq * 16 + i;
            const u32x4 a0 = *(const u32x4*)(proj + (row0 + c) * PP + AB), a1 = *(const u32x4*)(proj + (row0 + c) * PP + AB + 8);
            float z = bias;
#pragma unroll
            for (int e = 0; e < 4; ++e) {
                z += __uint_as_float(a0[e] << 16) * w[2 * e] + __uint_as_float(a0[e] & 0xFFFF0000u) * w[2 * e + 1];
                z += __uint_as_float(a1[e] << 16) * w[8 + 2 * e] + __uint_as_float(a1[e] & 0xFFFF0000u) * w[8 + 2 * e + 1];
            }
            const float ls = fminf(z, 0.f) - log1pf(__expf(-fabsf(z)));
            cum += ls * (1.0f / 16.0f);
            bcS[c][d] = cum;
        }
        tot[cq][d] = cum;
        __syncthreads();
        float pre = 0.f;
        for (int q = 0; q < cq; ++q) pre += tot[q][d];
        for (int i = 0; i < 16; ++i) {
            const int c = cq * 16 + i;
            const float v = bcS[c][d] + pre;
            bcS[c][d] = v;
            bc[(row0 + c) * 256 + col] = v;
        }
    }
    __syncthreads();
    {
        const int c = tid >> 2, dq = tid & 3;
        const bf16_t* src = proj + (row0 + c) * PP + KB + h * 64 + dq * 16;
#pragma unroll
        for (int k = 0; k < 2; ++k) {
            const u32x4 a = *(const u32x4*)(src + k * 8);
#pragma unroll
            for (int e = 0; e < 4; ++e) {
                const int d = dq * 16 + k * 8 + 2 * e;
                const float k0 = __uint_as_float(a[e] << 16) * __expf(bcS[63][d] - bcS[c][d]);
                const float k1 = __uint_as_float(a[e] & 0xFFFF0000u) * __expf(bcS[63][d + 1] - bcS[c][d + 1]);
                *(unsigned short*)(KDT + tile_el(d, c)) = f2bf(k0);
                *(unsigned short*)(KDT + tile_el(d + 1, c)) = f2bf(k1);
            }
        }
    }
    gla_stage_vt(proj, row0, h, VT);
    __syncthreads();
    float* outp = cstate + (size_t)vb * 8192;
#pragma unroll
    for (int vi = 0; vi < 2; ++vi) {
        const int vt = wid * 2 + vi;
        const bf16x8 a0 = *(const bf16x8*)(VT + tile_off(vt * 16 + fr, fq)), a1 = *(const bf16x8*)(VT + tile_off(vt * 16 + fr, 4 + fq));
#pragma unroll
        for (int dt = 0; dt < 4; ++dt) {
            const bf16x8 b0 = *(const bf16x8*)(KDT + tile_off(dt * 16 + fr, fq)), b1 = *(const bf16x8*)(KDT + tile_off(dt * 16 + fr, 4 + fq));
            f32x4 acc = (f32x4){0.f, 0.f, 0.f, 0.f};
            acc = __builtin_amdgcn_mfma_f32_16x16x32_bf16(a0, b0, acc, 0, 0, 0);
            acc = __builtin_amdgcn_mfma_f32_16x16x32_bf16(a1, b1, acc, 0, 0, 0);
#pragma unroll
            for (int i = 0; i < 4; ++i) outp[(vt * 16 + 4 * fq + i) * 64 + dt * 16 + fr] = acc[i];
        }
    }
}

__device__ __forceinline__ void gla_scan_vb2(int vb, const float* __restrict__ bc, float* __restrict__ cstate) {
    const int idx = vb * 512 + threadIdx.x;
    const int e = idx & 8191, bh = idx >> 13, b = bh >> 2, h = bh & 3, d = e & 63;
    float state = 0.f;
    float* base = cstate + (size_t)bh * 64 * 8192 + e;
    const float* bcp = bc + ((size_t)(b * S + 63)) * 256 + h * 64 + d;
#pragma unroll 1
    for (int n0 = 0; n0 < 64; n0 += 16) {
        float upd[16], dec[16];
#pragma unroll
        for (int i = 0; i < 16; ++i) { upd[i] = base[(size_t)(n0 + i) * 8192]; dec[i] = bcp[(size_t)(n0 + i) * 64 * 256]; }
#pragma unroll
        for (int i = 0; i < 16; ++i) { base[(size_t)(n0 + i) * 8192] = state; state = __expf(dec[i]) * state + upd[i]; }
    }
}

__device__ __forceinline__ void gla_c_unit(int vb, const bf16_t* __restrict__ proj, const float* __restrict__ bc, const float* __restrict__ prev,
                                           const float* __restrict__ norm_g, bf16_t* __restrict__ yb, char* smem) {
    char* QI = smem;
    char* KI = smem + 8192;
    char* VT = smem + 16384;
    char* PT = smem + 32768;
    const int tid = HB_TID, lane = tid & 63, wid = tid >> 6, fr = lane & 15, fq = lane >> 4;
    const int n = vb & 63, h = (vb >> 6) & 3, b = vb >> 8;
    const size_t row0 = (size_t)(b * S + n * 64);
    __syncthreads();
    {
        const int c = tid >> 2, dq = tid & 3;
        const bf16_t* qs = proj + (row0 + c) * PP + QB + h * 64 + dq * 16;
        const bf16_t* ks = proj + (row0 + c) * PP + KB + h * 64 + dq * 16;
        const float* bs = bc + (row0 + c) * 256 + h * 64 + dq * 16;
#pragma unroll
        for (int k = 0; k < 2; ++k) {
            const u32x4 qa = *(const u32x4*)(qs + k * 8), ka = *(const u32x4*)(ks + k * 8);
            const f32x4 b0 = *(const f32x4*)(bs + k * 8), b1 = *(const f32x4*)(bs + k * 8 + 4);
            const float bv[8] = {b0[0], b0[1], b0[2], b0[3], b1[0], b1[1], b1[2], b1[3]};
            u32x4 qo, ko;
#pragma unroll
            for (int e = 0; e < 4; ++e) {
                const float e0 = __expf(bv[2 * e]), e1 = __expf(bv[2 * e + 1]);
                qo[e] = pack_bf16(__uint_as_float(qa[e] << 16) * 0.125f * e0, __uint_as_float(qa[e] & 0xFFFF0000u) * 0.125f * e1);
                ko[e] = pack_bf16(__uint_as_float(ka[e] << 16) / e0, __uint_as_float(ka[e] & 0xFFFF0000u) / e1);
            }
            *(u32x4*)(QI + tile_off(c, dq * 2 + k)) = qo;
            *(u32x4*)(KI + tile_off(c, dq * 2 + k)) = ko;
        }
    }
    gla_stage_vt(proj, row0, h, VT);
    {
        const int v = tid >> 1, half = tid & 1;
        const float* ps = prev + (size_t)vb * 8192 + v * 64 + half * 32;
#pragma unroll
        for (int k = 0; k < 4; ++k) {
            const f32x4 a = *(const f32x4*)(ps + k * 8), c2 = *(const f32x4*)(ps + k * 8 + 4);
            u32x4 o; o[0] = pack_bf16(a[0], a[1]); o[1] = pack_bf16(a[2], a[3]); o[2] = pack_bf16(c2[0], c2[1]); o[3] = pack_bf16(c2[2], c2[3]);
            *(u32x4*)(PT + tile_off(v, half * 4 + k)) = o;
        }
    }
    __syncthreads();
    const bf16x8 qf0 = *(const bf16x8*)(QI + tile_off(wid * 16 + fr, fq)), qf1 = *(const bf16x8*)(QI + tile_off(wid * 16 + fr, 4 + fq));
    bf16x8 pf[2];
    const int c = wid * 16 + fr;
#pragma unroll
    for (int p = 0; p < 2; ++p) {
        u32x4 w;
#pragma unroll
        for (int s = 0; s < 2; ++s) {
            const int row = 32 * p + 8 * (fr >> 2) + 4 * s + (fr & 3);
            const bf16x8 k0 = *(const bf16x8*)(KI + tile_off(row, fq)), k1 = *(const bf16x8*)(KI + tile_off(row, 4 + fq));
            f32x4 a = (f32x4){0.f, 0.f, 0.f, 0.f};
            a = __builtin_amdgcn_mfma_f32_16x16x32_bf16(k0, qf0, a, 0, 0, 0);
            a = __builtin_amdgcn_mfma_f32_16x16x32_bf16(k1, qf1, a, 0, 0, 0);
#pragma unroll
            for (int i = 0; i < 4; ++i) { const int j = 32 * p + 8 * fq + 4 * s + i; if (j > c) a[i] = 0.f; }
            w[2 * s] = pack_bf16(a[0], a[1]); w[2 * s + 1] = pack_bf16(a[2], a[3]);
        }
        pf[p] = __builtin_bit_cast(bf16x8, w);
    }
    f32x4 acc[8];
    float ss = 0.f;
#pragma unroll
    for (int vt = 0; vt < 8; ++vt) {
        f32x4 a = (f32x4){0.f, 0.f, 0.f, 0.f};
        a = __builtin_amdgcn_mfma_f32_16x16x32_bf16(*(const bf16x8*)(VT + tile_off(vt * 16 + fr, fq)), pf[0], a, 0, 0, 0);
        a = __builtin_amdgcn_mfma_f32_16x16x32_bf16(*(const bf16x8*)(VT + tile_off(vt * 16 + fr, 4 + fq)), pf[1], a, 0, 0, 0);
        a = __builtin_amdgcn_mfma_f32_16x16x32_bf16(*(const bf16x8*)(PT + tile_off(vt * 16 + fr, fq)), qf0, a, 0, 0, 0);
        a = __builtin_amdgcn_mfma_f32_16x16x32_bf16(*(const bf16x8*)(PT + tile_off(vt * 16 + fr, 4 + fq)), qf1, a, 0, 0, 0);
        acc[vt] = a;
        ss += a[0] * a[0] + a[1] * a[1] + a[2] * a[2] + a[3] * a[3];
    }
    ss += __shfl_xor(ss, 16); ss += __shfl_xor(ss, 32);
    const float r = rsqrtf(ss * (1.0f / 128.0f) + 1e-6f);
    const size_t row = row0 + c;
#pragma unroll
    for (int vt = 0; vt < 8; ++vt) {
        const int col = h * 128 + vt * 16 + 4 * fq;
        const uint2 rr = *(const uint2*)(proj + row * PP + RB + col);
        const f32x4 g4 = *(const f32x4*)(norm_g + col);
        const float r0 = __uint_as_float(rr.x << 16), r1 = __uint_as_float(rr.x & 0xFFFF0000u), r2 = __uint_as_float(rr.y << 16), r3 = __uint_as_float(rr.y & 0xFFFF0000u);
        f32x4 o;
        o[0] = acc[vt][0] * r * g4[0] * (r0 * sigmoidf_(r0)); o[1] = acc[vt][1] * r * g4[1] * (r1 * sigmoidf_(r1));
        o[2] = acc[vt][2] * r * g4[2] * (r2 * sigmoidf_(r2)); o[3] = acc[vt][3] * r * g4[3] * (r3 * sigmoidf_(r3));
        *(uint2*)(yb + row * 512 + col) = pack4(o);
    }
}

constexpr int SMEM_BYTES = 131072;

__global__ void __launch_bounds__(512, 2) k_fwd(Params p) {
    extern __shared__ __attribute__((aligned(16))) char smem_dyn[];
    char* smem = smem_dyn + 16;
    char* smh = smem + (threadIdx.x >> 8) * 65536;
    if (threadIdx.x == 0) *(uint4*)smem_dyn = make_uint4(0u, 0u, 0u, 0u);
    __syncthreads();
    char* ws = p.ws;
    XcdBarrier bar = xcd_barrier_post((unsigned*)(ws + OFF_BAR), (volatile LAS unsigned*)smem_dyn);
    int* ctrl = (int*)(ws + OFF_CTRL);
    bf16_t* proj = (bf16_t*)(ws + OFF_PROJ);
    float* bc = (float*)(ws + OFF_BC);
    float* cstate = (float*)(ws + OFF_CSTATE);
    bf16_t* mrg = (bf16_t*)(ws + OFF_MRG);
    bf16_t* h2 = (bf16_t*)(ws + OFF_H2);
    bf16_t* hid = (bf16_t*)(ws + OFF_HID);
    bf16_t* Y0 = (bf16_t*)(ws + OFF_Y0);
    bf16_t* Y1 = (bf16_t*)(ws + OFF_Y1);
    bf16_t* ya = (bf16_t*)(ws + OFF_YA);
    bf16_t* yb = (bf16_t*)(ws + OFF_YB);
    bf16_t* kcb = (bf16_t*)(ws + OFF_KCB);
    bf16_t* vcb = (bf16_t*)(ws + OFF_VCB);
    bf16_t* h = (bf16_t*)p.out;
    const int G = gridDim.x;

    ph_prep(p, smh);
    xcd_barrier(bar);
    { g8::StaticOrder S; S.init(T, 3072, G, (int)blockIdx.x); const g8::AddrPlain AD{(const char*)h, (const char*)(ws + OFF_WINT), 2048u, 2048u, 16};
      g8::gemm_phase(smem, S, AD, g8::EpiProj{proj}); }
    xcd_barrier(bar);
    ph_cmp1(proj, ws, smh);
    {
        const int nc = G > 32 ? 16 : 0, gb = (int)blockIdx.x - nc, gs = G - nc;
        if (gb >= 0) {
            for (int pr = gb; pr < 512; pr += gs) vtrans_tile(2 * pr + HB_ID, proj, ws, smh);
            for (int pr = gb; pr < 512; pr += gs) gla_a_unit(2 * pr + HB_ID, proj, p.w_alpha, p.b_alpha, bc, cstate, smh);
        }
    }
    xcd_barrier(bar);
    ph_cmp2(ws, ws, smh);
    for (int vb = blockIdx.x; vb < 256; vb += G) gla_scan_vb2(vb, bc, cstate);
    ph_prep_experts(p, smh);
    xcd_barrier(bar);
    for (int vb = HB_FIRST; vb < 1024; vb += HB_STEP) gla_c_unit(vb, proj, bc, cstate, p.norm_g, yb, smh);
    for (int r = 0; r * G < 512; ++r) {
        const int u = r * G + ((r & 1) ? (G - 1 - (int)blockIdx.x) : (int)blockIdx.x);
        if (u < 512) nsa_unit(u, proj, ws, p.rel_bias, ya, smem);
    }
    xcd_barrier(bar);
    {
        g8::MergeOrder MO; MO.so.init(T, 1024, G, (int)blockIdx.x);
        const g8::AddrMerge AD{(const char*)h, (const char*)(ws + OFF_WINT), (const char*)ya, (const char*)yb, (const char*)(ws + OFF_WAT), (const char*)(ws + OFF_WBT)};
        g8::gemm_phase(smem, MO, AD, g8::EpiMergeAll{mrg, (bf16_t*)(ws + OFF_R1)});
    }
    xcd_barrier(bar);
    { g8::StaticOrder S; S.init(T, 1024, G, (int)blockIdx.x); const g8::AddrPlain AD{(const char*)mrg, (const char*)(ws + OFF_WOT), 2048u, 2048u, 16};
      g8::gemm_phase(smem, S, AD, g8::EpiResid{p.x, p.out}); }
    xcd_barrier(bar);
    for (int grp = HB_FIRST; grp < 512; grp += HB_STEP) {
        for (int tt = 0; tt < 2; ++tt) router_unit(grp * 2 + tt, p.out, p.g_ffn, (const bf16_t*)(ws + OFF_WRT), p.b_rg, p.b_re, h2, (float*)(ws + OFF_RSTD), smh);
        router_append(grp, (int*)(ws + OFF_LTOK), (float*)(ws + OFF_LW), ctrl, smh);
    }
    xcd_barrier(bar);
    ph_moe1(h2, (const bf16_t*)(ws + OFF_WGT), (const bf16_t*)(ws + OFF_WUT), ctrl, (const int*)(ws + OFF_LTOK), (const float*)(ws + OFF_LW), (const float*)(ws + OFF_RSTD), hid, smh);
    ph_prep_experts_down(p, ctrl, smh);
    xcd_barrier(bar);
    ph_moe2(hid, (const bf16_t*)(ws + OFF_WDT), ctrl, (const int*)(ws + OFF_LTOK), Y0, smh);
    xcd_barrier(bar);
    { int t_ = threadIdx.x; asm volatile("" : "+v"(t_)); for (int row = blockIdx.x * 8 + (t_ >> 6); row < T; row += G * 8) final_row(row, p.out, Y0, Y1, p.g_final, t_ & 63); }
}

extern "C" void kernel_launch(void* const* d_in, const int* in_sizes, int n_in, void* d_out, int out_size, void* d_ws, size_t ws_size, hipStream_t stream) {
    static int grid = 0;
    constexpr int kDynLds = SMEM_BYTES + 16;
    if (!grid) {
        int dev = 0, cus = 0, per_cu = 0;
        (void)hipGetDevice(&dev);
        (void)hipDeviceGetAttribute(&cus, hipDeviceAttributeMultiprocessorCount, dev);
        (void)hipFuncSetAttribute((const void*)k_fwd, hipFuncAttributeMaxDynamicSharedMemorySize, kDynLds);
        (void)hipOccupancyMaxActiveBlocksPerMultiprocessor(&per_cu, k_fwd, 512, kDynLds);
        if (per_cu > 1) per_cu = 1;
        if (per_cu < 1) per_cu = 1;
        grid = cus * per_cu;
    }
    char* ws = (char*)d_ws;
    (void)hipMemsetAsync(ws + OFF_CTRL, 0, 16384, stream);
    (void)hipMemsetAsync(ws + OFF_BAR, 0, 16384, stream);
    Params p{};
    const float** pf = (const float**)&p;
    for (int i = 0; i < 25; ++i) pf[i] = (const float*)d_in[i];
    p.out = (float*)d_out; p.ws = ws;
    k_fwd<<<grid, 512, kDynLds, stream>>>(p);
}
```

```cpp
#include <hip/hip_runtime.h>
#include <stdint.h>

typedef unsigned short bf16_t;
typedef short bf16x8 __attribute__((ext_vector_type(8)));
typedef float f32x4 __attribute__((ext_vector_type(4)));
typedef unsigned u32x4 __attribute__((ext_vector_type(4)));
__device__ __forceinline__ float bf2f(bf16_t v) { return __uint_as_float(((unsigned)v) << 16); }
__device__ __forceinline__ bf16_t f2bf(float f) { unsigned u = __float_as_uint(f); u += 0x7FFFu + ((u >> 16) & 1u); return (bf16_t)(u >> 16); }
__device__ __forceinline__ unsigned pack_bf16(float lo, float hi) { unsigned r; asm volatile("v_cvt_pk_bf16_f32 %0, %1, %2" : "=v"(r) : "v"(lo), "v"(hi)); return r; }

constexpr int Bn = 4, S = 4096, T = Bn * S, D = 1024, NIN = 4904, PP = 2880;
constexpr int QA = 0, KC = 512, VC = 640, KS = 768, VS = 896, KW = 1024, VW = 1152, GA = 1280, QB = 1304, KB = 1560, VB = 1816, AB = 2328, RB = 2344, MGA = 2856, MGB = 3880;
constexpr int NPROJ = 2856;
constexpr int MSLOT = 36864;

constexpr size_t OFF_CTRL = 0;
constexpr size_t OFF_ROUTE_E = 16384;
constexpr size_t OFF_ROUTE_W = OFF_ROUTE_E + 32768 * 4;
constexpr size_t OFF_SLOT_TOK = OFF_ROUTE_W + 32768 * 4;
constexpr size_t OFF_SLOT_W = OFF_SLOT_TOK + (size_t)MSLOT * 4;
constexpr size_t OFF_BAR = OFF_SLOT_W + (size_t)MSLOT * 4;
constexpr size_t OFF_BIAS1 = OFF_BAR + 16384;
constexpr size_t OFF_RSTD = OFF_BIAS1 + 1024;
constexpr size_t OFF_SLOT_RS = OFF_RSTD + (size_t)T * 4;
constexpr size_t OFF_WRT = OFF_SLOT_RS + (size_t)MSLOT * 4;
static_assert(OFF_WRT + 2 * 48 * 1024 * 2 <= (1u << 20), "ctrl overflow");
constexpr size_t OFF_R1 = 1u << 20;
constexpr size_t SZ_PROJ = (size_t)T * PP * 2;
constexpr size_t OFF_PROJ = OFF_R1;
constexpr size_t OFF_BC = OFF_PROJ + SZ_PROJ;
constexpr size_t OFF_CSTATE = OFF_BC + (size_t)T * 256 * 4;
constexpr size_t OFF_R1_END = OFF_CSTATE + (size_t)1024 * 8192 * 4;
constexpr size_t OFF_MRG = OFF_R1 + (size_t)T * 2048 * 2;
constexpr size_t OFF_H2 = OFF_R1;
constexpr size_t OFF_HID = OFF_H2 + (size_t)T * 1024 * 2;
constexpr size_t OFF_Y0 = OFF_HID + (size_t)2 * T * 256 * 2;
constexpr size_t OFF_Y1 = OFF_Y0 + (size_t)T * 1024 * 2;
static_assert(OFF_MRG + (size_t)T * 1024 * 2 <= OFF_R1_END, "alias overflow");
static_assert(OFF_Y1 + (size_t)T * 1024 * 2 <= OFF_R1_END, "alias overflow");
constexpr size_t OFF_YA = OFF_R1_END;
constexpr size_t OFF_YB = OFF_YA + (size_t)T * 512 * 2;
constexpr size_t OFF_KCB = OFF_YB + (size_t)T * 512 * 2;
constexpr size_t OFF_VCB = OFF_KCB + 8 * 256 * 64 * 2;
constexpr size_t OFF_VCBT = OFF_VCB + 8 * 256 * 64 * 2;
constexpr size_t OFF_HIDC = OFF_VCBT + 8 * 256 * 64 * 2;
constexpr size_t OFF_VST = OFF_HIDC + 2 * 2048 * 128 * 2;
constexpr size_t OFF_VWT = OFF_VST + (size_t)8 * 64 * S * 2;
constexpr size_t OFF_WINT = OFF_VWT + (size_t)8 * 64 * S * 2;
constexpr size_t OFF_CK1T = OFF_WINT + (size_t)NIN * 1024 * 2;
constexpr size_t OFF_CV1T = OFF_CK1T + 128 * 2048 * 2;
constexpr size_t OFF_CK2T = OFF_CV1T + 128 * 2048 * 2;
constexpr size_t OFF_CV2T = OFF_CK2T + 128 * 128 * 2;
constexpr size_t OFF_WAT = OFF_CV2T + 128 * 128 * 2;
constexpr size_t OFF_WBT = OFF_WAT + 1024 * 512 * 2;
constexpr size_t OFF_WOT = OFF_WBT + 1024 * 512 * 2;
constexpr size_t OFF_WGT = OFF_WOT + 1024 * 1024 * 2;
constexpr size_t OFF_WUT = OFF_WGT + (size_t)32 * 256 * 1024 * 2;
constexpr size_t OFF_WDT = OFF_WUT + (size_t)32 * 256 * 1024 * 2;
constexpr size_t OFF_LTOK = OFF_WDT + (size_t)32 * 1024 * 256 * 2;
constexpr size_t OFF_LW = OFF_LTOK + (size_t)32 * 16384 * 4;
constexpr size_t OFF_END = OFF_LW + (size_t)32 * 16384 * 4;
static_assert(OFF_END <= (size_t)256 << 20, "workspace overflow");

#define XB_TMO      128
#define XB_XCNT(j)  (256  + 64 * (j))
#define XB_XSUB(j)  (1280 + 64 * (j))
#define XB_XGEN(j)  (2304 + 64 * (j))
#define XB_TOP      3328
#define XB_TOPGEN   3392
#define XCD_BAR_WORDS 3456
#define XB_SPIN_CAP (1u << 18)
#define LAS __attribute__((address_space(3)))

__device__ __forceinline__ unsigned xb_ld(unsigned* p)              { return __hip_atomic_load(p, __ATOMIC_RELAXED, __HIP_MEMORY_SCOPE_AGENT); }
__device__ __forceinline__ unsigned xb_add(unsigned* p, unsigned v) { return __hip_atomic_fetch_add(p, v, __ATOMIC_RELAXED, __HIP_MEMORY_SCOPE_AGENT); }
__device__ __forceinline__ unsigned xb_xcc_id() { return (unsigned)__builtin_amdgcn_s_getreg((3 << 11) | 20) & 0xFu; }
#define XB_SPIN(cond, bar) do { unsigned _sp = 0; while (cond) { __builtin_amdgcn_s_sleep(1); \
    if ((++_sp & 255u) == 0u) { if (xb_ld(&(bar)[XB_TMO])) break; if (_sp > XB_SPIN_CAP) { atomicAdd(&(bar)[XB_TMO], 1u); break; } } } } while (0)

struct XcdBarrier { unsigned* bar; unsigned x; volatile LAS unsigned* st; };

__device__ __forceinline__ XcdBarrier xcd_barrier_post(unsigned* bar, volatile LAS unsigned* st) {
    XcdBarrier b; b.bar = bar; b.x = xb_xcc_id(); b.st = st;
    if (threadIdx.x == 0) (void)xb_add(&bar[XB_XCNT(b.x)], 1u);
    return b;
}
__device__ __forceinline__ void xcd_barrier_complete(unsigned* bar, unsigned x, unsigned& nloc, unsigned& nx) {
    const unsigned G = gridDim.x * gridDim.y * gridDim.z;
    unsigned sum, cnt, mine, sp = 0u;
    for (;;) {
        sum = 0u; cnt = 0u; mine = 0u;
#pragma unroll
        for (unsigned j = 0; j < 16; ++j) { const unsigned c = xb_ld(&bar[XB_XCNT(j)]); sum += c; cnt += (c > 0u) ? 1u : 0u; mine = (j == x) ? c : mine; }
        if (sum == G) break;
        __builtin_amdgcn_s_sleep(1);
        if ((++sp & 255u) == 0u) { if (xb_ld(&bar[XB_TMO])) break; if (sp > XB_SPIN_CAP) { atomicAdd(&bar[XB_TMO], 1u); break; } }
    }
    nloc = mine > 0u ? mine : 1u; nx = cnt > 0u ? cnt : 1u;
}
__device__ __forceinline__ void xcd_barrier(const XcdBarrier& b) {
    asm volatile("s_waitcnt vmcnt(0)" ::: "memory");
    __syncthreads();
    if (threadIdx.x == 0) {
        unsigned* bar = b.bar;
        __builtin_amdgcn_s_waitcnt(0);
        unsigned nloc = b.st[0], nx = b.st[1];
        if (nloc == 0u) { xcd_barrier_complete(bar, b.x, nloc, nx); b.st[0] = nloc; b.st[1] = nx; }
        const unsigned old = xb_add(&bar[XB_XSUB(b.x)], 1u);
        const unsigned gen = old / nloc;
        if (old + 1u == (gen + 1u) * nloc) {
            __builtin_amdgcn_fence(__ATOMIC_RELEASE, "agent");
            asm volatile("s_waitcnt vmcnt(0)" ::: "memory");
            const unsigned og = xb_add(&bar[XB_TOP], 1u);
            const unsigned tg = og / nx;
            if (og + 1u == (tg + 1u) * nx) xb_add(&bar[XB_TOPGEN], 1u);
            else XB_SPIN(xb_ld(&bar[XB_TOPGEN]) == tg, bar);
            __builtin_amdgcn_fence(__ATOMIC_ACQUIRE, "agent");
            xb_add(&bar[XB_XGEN(b.x)], 1u);
            asm volatile("s_waitcnt vmcnt(0)" ::: "memory");
        } else {
            XB_SPIN(xb_ld(&bar[XB_XGEN(b.x)]) == gen, bar);
            __builtin_amdgcn_fence(__ATOMIC_ACQUIRE, "agent");
            asm volatile("s_waitcnt vmcnt(0)" ::: "memory");
        }
    }
    __syncthreads();
}


__device__ __forceinline__ int hb_tid_() { int t = threadIdx.x; asm volatile("" : "+v"(t)); return t & 255; }
#define HB_TID (hb_tid_())
#define HB_ID ((int)(threadIdx.x >> 8))
#define HB_FIRST (2 * (int)blockIdx.x + HB_ID)
#define HB_STEP (2 * (int)gridDim.x)
struct Params {
    const float *x, *g_mix, *w_in, *pe_k, *ck1, *ck2, *pe_v, *cv1, *cv2, *rel_bias, *w_alpha, *b_alpha, *norm_g, *w_ba, *w_bb, *w_out, *g_ffn,
                *w_rg, *b_rg, *w_re, *b_re, *w_eg, *w_eu, *w_ed, *g_final;
    float* out; char* ws;
};

__device__ __forceinline__ float wave_max(float v) { for (int o = 32; o > 0; o >>= 1) v = fmaxf(v, __shfl_xor(v, o)); return v; }
__device__ __forceinline__ float wave_sum(float v) { for (int o = 32; o > 0; o >>= 1) v += __shfl_xor(v, o); return v; }
__device__ __forceinline__ void wave_lds_sync() { asm volatile("s_waitcnt lgkmcnt(0)" ::: "memory"); }


__device__ __forceinline__ void rms_h_row(int row, const float* __restrict__ x, const float* __restrict__ g, bf16_t* __restrict__ h, int lane) {
    const float* xr = x + (size_t)row * D + lane * 4;
    f32x4 v[4]; float s = 0.f;
#pragma unroll
    for (int i = 0; i < 4; ++i) { v[i] = *(const f32x4*)(xr + 256 * i); s += v[i][0] * v[i][0] + v[i][1] * v[i][1] + v[i][2] * v[i][2] + v[i][3] * v[i][3]; }
    s = wave_sum(s);
    const float r = rsqrtf(s * (1.0f / D) + 1e-6f);
#pragma unroll
    for (int i = 0; i < 4; ++i) {
        const f32x4 gg = *(const f32x4*)(g + lane * 4 + 256 * i);
        uint2 o; o.x = pack_bf16(v[i][0] * r * gg[0], v[i][1] * r * gg[1]); o.y = pack_bf16(v[i][2] * r * gg[2], v[i][3] * r * gg[3]);
        *(uint2*)(h + (size_t)row * D + lane * 4 + 256 * i) = o;
    }
}
__device__ __forceinline__ void final_row(int row, float* __restrict__ x2out, const bf16_t* __restrict__ Y0, const bf16_t* __restrict__ Y1, const float* __restrict__ g, int lane) {
    float* xr = x2out + (size_t)row * D + lane * 4;
    f32x4 v[4]; float s = 0.f;
#pragma unroll
    for (int i = 0; i < 4; ++i) {
        v[i] = *(const f32x4*)(xr + 256 * i);
        const uint2 a = *(const uint2*)(Y0 + (size_t)row * D + lane * 4 + 256 * i), c = *(const uint2*)(Y1 + (size_t)row * D + lane * 4 + 256 * i);
        v[i][0] += __uint_as_float(a.x << 16) + __uint_as_float(c.x << 16);
        v[i][1] += __uint_as_float(a.x & 0xFFFF0000u) + __uint_as_float(c.x & 0xFFFF0000u);
        v[i][2] += __uint_as_float(a.y << 16) + __uint_as_float(c.y << 16);
        v[i][3] += __uint_as_float(a.y & 0xFFFF0000u) + __uint_as_float(c.y & 0xFFFF0000u);
        s += v[i][0] * v[i][0] + v[i][1] * v[i][1] + v[i][2] * v[i][2] + v[i][3] * v[i][3];
    }
    s = wave_sum(s);
    const float r = rsqrtf(s * (1.0f / D) + 1e-6f);
#pragma unroll
    for (int i = 0; i < 4; ++i) {
        const f32x4 gg = *(const f32x4*)(g + lane * 4 + 256 * i);
        *(f32x4*)(xr + 256 * i) = (f32x4){v[i][0] * r * gg[0], v[i][1] * r * gg[1], v[i][2] * r * gg[2], v[i][3] * r * gg[3]};
    }
}

__device__ __forceinline__ void prep_router_w(const float* __restrict__ w_rg, const float* __restrict__ w_re, bf16_t* __restrict__ WrT) {
    for (int idx = blockIdx.x * 512 + threadIdx.x; idx < 48 * 1024; idx += gridDim.x * 512) {
        const int n = idx >> 10, k = idx & 1023;
        const float w = n < 4 ? w_rg[k * 4 + n] : (n < 36 ? w_re[k * 32 + n - 4] : 0.f);
        const bf16_t hi = f2bf(w);
        WrT[idx] = hi; WrT[48 * 1024 + idx] = f2bf(w - bf2f(hi));
    }
}

__device__ __forceinline__ void router_unit(int task, const float* __restrict__ x2, const float* __restrict__ g, const bf16_t* __restrict__ WrT,
                                            const float* __restrict__ b_rg, const float* __restrict__ b_re, bf16_t* __restrict__ h2, float* __restrict__ rstd_out,
                                            char* smem) {
    float (*part)[16][49] = (float (*)[16][49])smem;
    int* dec_e = (int*)(smem + 14336); float* dec_w = (float*)(smem + 14336 + 512);
    float (*ssp)[16] = (float (*)[16])(smem + 4 * 16 * 49 * 4);
    const int tid = HB_TID, lane = tid & 63, w4 = tid >> 6, fr = lane & 15, fq = lane >> 4, r0 = task * 16;
    const float* xr = x2 + (size_t)(r0 + fr) * D + fq * 8 + w4 * 256;
    bf16_t* hr = h2 + (size_t)(r0 + fr) * D + fq * 8 + w4 * 256;
    const bf16_t* wh = WrT + (size_t)fr * 1024 + fq * 8 + w4 * 256;
    const float* gp = g + fq * 8 + w4 * 256;
    f32x4 acc[3];
#pragma unroll
    for (int nt = 0; nt < 3; ++nt) acc[nt] = (f32x4){0.f, 0.f, 0.f, 0.f};
    float ssq = 0.f;
#pragma unroll 4
    for (int ks = 0; ks < 8; ++ks) {
        const f32x4 x0 = *(const f32x4*)(xr + ks * 32), x1 = *(const f32x4*)(xr + ks * 32 + 4);
        const f32x4 g0 = *(const f32x4*)(gp + ks * 32), g1 = *(const f32x4*)(gp + ks * 32 + 4);
        float xg[8];
#pragma unroll
        for (int e = 0; e < 4; ++e) { xg[e] = x0[e] * g0[e]; xg[4 + e] = x1[e] * g1[e]; ssq += x0[e] * x0[e] + x1[e] * x1[e]; }
        u32x4 hi, lo;
#pragma unroll
        for (int e = 0; e < 4; ++e) {
            hi[e] = pack_bf16(xg[2 * e], xg[2 * e + 1]);
            lo[e] = pack_bf16(xg[2 * e] - __uint_as_float(hi[e] << 16), xg[2 * e + 1] - __uint_as_float(hi[e] & 0xFFFF0000u));
        }
        *(u32x4*)(hr + ks * 32) = hi;
        const bf16x8 ah = __builtin_bit_cast(bf16x8, hi), al = __builtin_bit_cast(bf16x8, lo);
#pragma unroll
        for (int nt = 0; nt < 3; ++nt) {
            const bf16x8 bh = *(const bf16x8*)(wh + (size_t)nt * 16 * 1024 + ks * 32), bl = *(const bf16x8*)(wh + (size_t)(48 + nt * 16) * 1024 + ks * 32);
            acc[nt] = __builtin_amdgcn_mfma_f32_16x16x32_bf16(ah, bh, acc[nt], 0, 0, 0);
            acc[nt] = __builtin_amdgcn_mfma_f32_16x16x32_bf16(al, bh, acc[nt], 0, 0, 0);
            acc[nt] = __builtin_amdgcn_mfma_f32_16x16x32_bf16(ah, bl, acc[nt], 0, 0, 0);
        }
    }
    ssq += __shfl_xor(ssq, 16); ssq += __shfl_xor(ssq, 32);
    __syncthreads();
    if (fq == 0) ssp[w4][fr] = ssq;
#pragma unroll
    for (int nt = 0; nt < 3; ++nt)
#pragma unroll
        for (int i = 0; i < 4; ++i) part[w4][4 * fq + i][nt * 16 + fr] = acc[nt][i];
    __syncthreads();
    if (tid < 16) {
        const int row = r0 + tid;
        const float rsv = rsqrtf((ssp[0][tid] + ssp[1][tid] + ssp[2][tid] + ssp[3][tid]) * (1.0f / D) + 1e-6f);
        rstd_out[row] = rsv;
        float l4[4];
#pragma unroll
        for (int j = 0; j < 4; ++j) l4[j] = (part[0][tid][j] + part[1][tid][j] + part[2][tid][j] + part[3][tid][j]) * rsv + b_rg[j];
        int gs = 0; float mx = l4[0];
#pragma unroll
        for (int j = 1; j < 4; ++j) if (l4[j] > mx) { mx = l4[j]; gs = j; }
        float den = 0.f;
#pragma unroll
        for (int j = 0; j < 4; ++j) den += __expf(l4[j] - mx);
        const float gpb = 1.f / den;
        float v0 = -3e38f, v1 = -3e38f; int i0 = 0, i1 = 0;
        for (int j = 0; j < 8; ++j) {
            const int c = 4 + gs * 8 + j;
            const float l = (part[0][tid][c] + part[1][tid][c] + part[2][tid][c] + part[3][tid][c]) * rsv + b_re[gs * 8 + j];
            if (l > v0) { v1 = v0; i1 = i0; v0 = l; i0 = j; }
            else if (l > v1) { v1 = l; i1 = j; }
        }
        const float e1 = __expf(v1 - v0);
        const int lr = (task & 1) * 16 + tid;
        dec_e[lr * 2] = gs * 8 + i0; dec_e[lr * 2 + 1] = gs * 8 + i1;
        dec_w[lr * 2] = gpb / (1.f + e1); dec_w[lr * 2 + 1] = gpb * e1 / (1.f + e1);
    }
}
__device__ __forceinline__ void router_append(int group, int* __restrict__ ltok, float* __restrict__ lw, int* __restrict__ cnt, char* smem) {
    int* dec_e = (int*)(smem + 14336); float* dec_w = (float*)(smem + 14336 + 512);
    int* hist = (int*)(smem + 14336 + 1024); int* base = hist + 32;
    const int tid = HB_TID;
    if (tid < 32) hist[tid] = 0;
    __syncthreads();
    int e = 0, lpos = 0;
    if (tid < 64) { e = dec_e[tid]; lpos = atomicAdd(&hist[e], 1); }
    __syncthreads();
    if (tid < 32) { const int hcount = hist[tid]; base[tid] = hcount ? atomicAdd(&cnt[tid * 64], hcount) : 0; }
    __syncthreads();
    if (tid < 64) { const int pos = e * 16384 + base[e] + lpos; ltok[pos] = (group * 32 + (tid >> 1)) * 2 + (tid & 1); lw[pos] = dec_w[tid]; }
    __syncthreads();
}

__device__ __forceinline__ void transpose_tile(const float* __restrict__ src, int ld_src, int N, bf16_t* __restrict__ dst, int ld_dst, int kt, int nt, char* smem) {
    float (*tl)[65] = (float (*)[65])smem;
    const int tid = HB_TID;
    const int c4 = (tid & 15) * 4, r0 = tid >> 4;
#pragma unroll
    for (int i = 0; i < 4; ++i) {
        const int k = r0 + 16 * i, n = nt * 64 + c4;
        float4 v = make_float4(0.f, 0.f, 0.f, 0.f);
        if (n < N) v = *(const float4*)(src + (size_t)(kt * 64 + k) * ld_src + n);
        tl[k][c4] = v.x; tl[k][c4 + 1] = v.y; tl[k][c4 + 2] = v.z; tl[k][c4 + 3] = v.w;
    }
    __syncthreads();
    const int kc = (tid & 7) * 8, n0 = tid >> 3;
#pragma unroll
    for (int i = 0; i < 2; ++i) {
        const int nl = n0 + 32 * i, n = nt * 64 + nl;
        if (n < N) {
            uint4 o;
            o.x = pack_bf16(tl[kc][nl], tl[kc + 1][nl]); o.y = pack_bf16(tl[kc + 2][nl], tl[kc + 3][nl]);
            o.z = pack_bf16(tl[kc + 4][nl], tl[kc + 5][nl]); o.w = pack_bf16(tl[kc + 6][nl], tl[kc + 7][nl]);
            *(uint4*)(dst + (size_t)n * ld_dst + kt * 64 + kc) = o;
        }
    }
    __syncthreads();
}

__device__ __forceinline__ void ph_prep_experts(const Params& p, char* smem) {
    char* ws = p.ws;
    for (int t = HB_FIRST; t < 4096; t += HB_STEP) {
        const int e = (t & 2047) >> 6, r = t & 63;
        if (t < 2048) transpose_tile(p.w_eg + (size_t)e * 1024 * 256, 256, 256, (bf16_t*)(ws + OFF_WGT) + (size_t)e * 256 * 1024, 1024, r >> 2, r & 3, smem);
        else transpose_tile(p.w_eu + (size_t)e * 1024 * 256, 256, 256, (bf16_t*)(ws + OFF_WUT) + (size_t)e * 256 * 1024, 1024, r >> 2, r & 3, smem);
    }
}
__device__ __forceinline__ int moe_tile_decode(const int* __restrict__ cnt, int t, int& e, int& i);
__device__ __forceinline__ void ph_prep_experts_down(const Params& p, const int* __restrict__ cnt, char* smem) {
    char* ws = p.ws;
    int e_, ti_; const int nu = moe_tile_decode(cnt, 0, e_, ti_) * 4, rem = nu % HB_STEP, k = HB_FIRST - rem, st = HB_STEP - rem;
    if (k < 0) return;
    for (int t = k; t < 2048; t += st) {
        const int e = t >> 6, r = t & 63;
        transpose_tile(p.w_ed + (size_t)e * 256 * 1024, 1024, 1024, (bf16_t*)(ws + OFF_WDT) + (size_t)e * 1024 * 256, 256, r >> 4, r & 15, smem);
    }
}
__device__ __forceinline__ void ph_prep(const Params& p, char* smem) {
    char* ws = p.ws;
    constexpr int N0 = 16 * 77, N1 = N0 + 64, N2 = N1 + 64, N3 = N2 + 2, N4 = N3 + 2, N5 = N4 + 128, N6 = N5 + 128, N7 = N6 + 256;
    for (int t = HB_FIRST; t < N7; t += HB_STEP) {
        if (t < N0) transpose_tile(p.w_in, NIN, NIN, (bf16_t*)(ws + OFF_WINT), 1024, t / 77, t % 77, smem);
        else if (t < N1) { const int q = t - N0; transpose_tile(p.ck1, 128, 128, (bf16_t*)(ws + OFF_CK1T), 2048, q >> 1, q & 1, smem); }
        else if (t < N2) { const int q = t - N1; transpose_tile(p.cv1, 128, 128, (bf16_t*)(ws + OFF_CV1T), 2048, q >> 1, q & 1, smem); }
        else if (t < N3) { const int q = t - N2; transpose_tile(p.ck2, 64, 64, (bf16_t*)(ws + OFF_CK2T), 128, q, 0, smem); }
        else if (t < N4) { const int q = t - N3; transpose_tile(p.cv2, 64, 64, (bf16_t*)(ws + OFF_CV2T), 128, q, 0, smem); }
        else if (t < N5) { const int q = t - N4; transpose_tile(p.w_ba, 1024, 1024, (bf16_t*)(ws + OFF_WAT), 512, q >> 4, q & 15, smem); }
        else if (t < N6) { const int q = t - N5; transpose_tile(p.w_bb, 1024, 1024, (bf16_t*)(ws + OFF_WBT), 512, q >> 4, q & 15, smem); }
        else { const int q = t - N6; transpose_tile(p.w_out, 1024, 1024, (bf16_t*)(ws + OFF_WOT), 1024, q >> 4, q & 15, smem); }
    }
    for (int t = HB_FIRST; t < 8; t += HB_STEP) {
        const int which = t >> 2, n = (t & 3) * 32 + (HB_TID & 31), ksp = HB_TID >> 5;
        const float* pe = which ? p.pe_v : p.pe_k; const float* w1 = which ? p.cv1 : p.ck1;
        float a = 0.f;
        for (int k = ksp * 256; k < ksp * 256 + 256; ++k) a += pe[k] * w1[(size_t)k * 128 + n];
        float* red = (float*)smem;
        red[HB_TID] = a;
        __syncthreads();
        if (HB_TID < 32) {
            float s = 0.f;
#pragma unroll
            for (int j = 0; j < 8; ++j) s += red[j * 32 + HB_TID];
            ((float*)(ws + OFF_BIAS1))[which * 128 + n] = s;
        }
        __syncthreads();
    }
    prep_router_w(p.w_rg, p.w_re, (bf16_t*)(ws + OFF_WRT));
    for (int row = blockIdx.x * 8 + (threadIdx.x >> 6); row < T; row += gridDim.x * 8) rms_h_row(row, p.x, p.g_mix, (bf16_t*)p.out, threadIdx.x & 63);
}

__device__ __forceinline__ int tile_off(int row, int chunk) { return row * 128 + ((chunk ^ (row & 7)) << 4); }

__device__ __forceinline__ void glds16(const void* g, char* l) {
    __builtin_amdgcn_global_load_lds((const __attribute__((address_space(1))) unsigned*)g, (__attribute__((address_space(3))) unsigned*)l, 16, 0, 0);
}
__device__ __forceinline__ void gemm_kloop(f32x4 (&acc)[4][4], const bf16_t* const (&pa)[4], const bf16_t* const (&pb)[4], int ka, int kb, int nk, char* smem) {
    int tid_ = HB_TID; asm volatile("" : "+v"(tid_));
    const int tid = tid_, lane = tid & 63, wid = tid >> 6, wr = wid >> 1, wc = wid & 1, fr = lane & 15, fq = lane >> 4;
    const int offA = (wr * 64 + fr) * 128, offB = 16384 + (wc * 64 + fr) * 128, x = fr & 7;
    __syncthreads();
#pragma unroll
    for (int i = 0; i < 4; ++i) { glds16(pa[i], smem + i * 4096 + tid * 16); glds16(pb[i], smem + 16384 + i * 4096 + tid * 16); }
    asm volatile("s_waitcnt vmcnt(0)" ::: "memory");
    __syncthreads();
    for (int kt = 0; kt < nk; ++kt) {
        const int cur = kt & 1;
        if (kt + 1 < nk) {
            char* st = smem + (cur ^ 1) * 32768 + tid * 16;
#pragma unroll
            for (int i = 0; i < 4; ++i) { glds16(pa[i] + (size_t)(kt + 1) * ka, st + i * 4096); glds16(pb[i] + (size_t)(kt + 1) * kb, st + 16384 + i * 4096); }
        }
        const char* sa = smem + cur * 32768 + offA;
        const char* sb = smem + cur * 32768 + offB;
#pragma unroll
        for (int ks = 0; ks < 2; ++ks) {
            const int ch = ((ks * 4 + fq) ^ x) << 4;
            bf16x8 af[4], bfr[4];
#pragma unroll
            for (int mi = 0; mi < 4; ++mi) af[mi] = *(const bf16x8*)(sa + mi * 2048 + ch);
#pragma unroll
            for (int ni = 0; ni < 4; ++ni) bfr[ni] = *(const bf16x8*)(sb + ni * 2048 + ch);
#pragma unroll
            for (int mi = 0; mi < 4; ++mi)
#pragma unroll
                for (int ni = 0; ni < 4; ++ni) acc[mi][ni] = __builtin_amdgcn_mfma_f32_16x16x32_bf16(bfr[ni], af[mi], acc[mi][ni], 0, 0, 0);
        }
        asm volatile("s_waitcnt vmcnt(0)" ::: "memory");
        __syncthreads();
    }
}
__device__ __forceinline__ void acc_zero(f32x4 (&acc)[4][4]) {
#pragma unroll
    for (int mi = 0; mi < 4; ++mi)
#pragma unroll
        for (int ni = 0; ni < 4; ++ni) acc[mi][ni] = (f32x4){0.f, 0.f, 0.f, 0.f};
}
#define GEMM_LANE_VARS const int tid = HB_TID, lane = tid & 63, wid = tid >> 6, wr = wid >> 1, wc = wid & 1, fr = lane & 15, fq = lane >> 4, lrow = tid >> 3, lch8 = ((tid & 7) ^ ((tid >> 3) & 7)) * 8; (void)wr; (void)wc; (void)fr; (void)fq; (void)lrow; (void)lch8;
__device__ __forceinline__ uint2 pack4(f32x4 v) { uint2 o; o.x = pack_bf16(v[0], v[1]); o.y = pack_bf16(v[2], v[3]); return o; }
__device__ __forceinline__ float sigmoidf_(float a) { return 1.f / (1.f + __expf(-a)); }

__device__ __forceinline__ void ph_cmp1(const bf16_t* __restrict__ proj, const char* ws, char* smem) {
    GEMM_LANE_VARS
    for (int u = HB_FIRST; u < 32; u += HB_STEP) {
        const int which = u >> 4, tm = u & 15;
        const bf16_t* W1T = (const bf16_t*)(ws + (which ? OFF_CV1T : OFF_CK1T));
        const float* bias1 = (const float*)(ws + OFF_BIAS1) + which * 128;
        bf16_t* hid = (bf16_t*)(ws + OFF_HIDC) + (size_t)which * 2048 * 128;
        const int col0 = which ? VC : KC;
        const bf16_t* pa[4]; const bf16_t* pb[4];
#pragma unroll
        for (int i = 0; i < 4; ++i) {
            const int m = tm * 128 + lrow + 32 * i, bg = m >> 8, c = (m & 255) > 254 ? 254 : (m & 255), b = bg >> 1, g = bg & 1;
            pa[i] = proj + (size_t)(b * S + 16 * c) * PP + col0 + g * 64 + lch8;
            pb[i] = W1T + (size_t)(lrow + 32 * i) * 2048 + lch8;
        }
        f32x4 acc[4][4]; acc_zero(acc);
        gemm_kloop(acc, pa, pb, PP, 64, 32, smem);
#pragma unroll
        for (int mi = 0; mi < 4; ++mi)
#pragma unroll
            for (int ni = 0; ni < 4; ++ni) {
                const int m = tm * 128 + wr * 64 + mi * 16 + fr, n = wc * 64 + ni * 16 + 4 * fq;
                f32x4 v = acc[mi][ni];
#pragma unroll
                for (int j = 0; j < 4; ++j) { const float a = v[j] + bias1[n + j]; const float t = 0.7978845608028654f * (a + 0.044715f * a * a * a); v[j] = 0.5f * a * (1.f + tanhf(t)); }
                *(uint2*)(hid + (size_t)m * 128 + n) = pack4(v);
            }
    }
}

__device__ __forceinline__ void ph_cmp2(const char* ws_c, char* ws, char* smem) {
    GEMM_LANE_VARS
    for (int u = HB_FIRST; u < 32; u += HB_STEP) {
        const int which = u >> 4, tm = u & 15;
        const bf16_t* W2T = (const bf16_t*)(ws_c + (which ? OFF_CV2T : OFF_CK2T));
        const bf16_t* hid = (const bf16_t*)(ws_c + OFF_HIDC) + (size_t)which * 2048 * 128;
        const bf16_t* pa[4]; const bf16_t* pb[4];
#pragma unroll
        for (int i = 0; i < 4; ++i) { pa[i] = hid + (size_t)(tm * 128 + lrow + 32 * i) * 128 + lch8; pb[i] = W2T + (size_t)(lrow + 32 * i) * 128 + lch8; }
        f32x4 acc[4][4]; acc_zero(acc);
        gemm_kloop(acc, pa, pb, 64, 64, 2, smem);
        if (wc == 0) {
            bf16_t* outp = (bf16_t*)(ws + (which ? OFF_VCB : OFF_KCB));
            bf16_t* outT = (bf16_t*)(ws + OFF_VCBT);
#pragma unroll
            for (int mi = 0; mi < 4; ++mi)
#pragma unroll
                for (int ni = 0; ni < 4; ++ni) {
                    const int m = tm * 128 + wr * 64 + mi * 16 + fr, n = ni * 16 + 4 * fq, c = m & 255, bg = m >> 8;
                    f32x4 v = acc[mi][ni];
                    if (c == 255) v = (f32x4){0.f, 0.f, 0.f, 0.f};
                    *(uint2*)(outp + (size_t)m * 64 + n) = pack4(v);
                    if (which) {
#pragma unroll
                        for (int j = 0; j < 4; ++j) outT[((size_t)bg * 64 + n + j) * 256 + c] = f2bf(v[j]);
                    }
                }
        }
    }
}

__device__ __forceinline__ int moe_tile_decode(const int* __restrict__ cnt, int t, int& e, int& i) {
    int acc = 0; e = 0; i = 0;
    for (int ee = 0; ee < 32; ++ee) { const int nt = (cnt[ee * 64] + 127) >> 7; if (t >= acc && t < acc + nt) { e = ee; i = t - acc; } acc += nt; }
    return acc;
}

__device__ __forceinline__ void ph_moe1(const bf16_t* __restrict__ h2, const bf16_t* __restrict__ WgT, const bf16_t* __restrict__ WuT, const int* __restrict__ cnt,
                                        const int* __restrict__ ltok, const float* __restrict__ lw, const float* __restrict__ rstd, bf16_t* __restrict__ hid, char* smem) {
    GEMM_LANE_VARS
    int e, ti;
    const int nu = moe_tile_decode(cnt, 0, e, ti) * 4;
    for (int u = HB_FIRST; u < nu; u += HB_STEP) {
        const int ft = u & 3;
        (void)moe_tile_decode(cnt, u >> 2, e, ti);
        const int ne = cnt[e * 64];
        const bf16_t* pa[4]; const bf16_t* pb[4];
#pragma unroll
        for (int i = 0; i < 4; ++i) {
            const int rr = lrow + 32 * i, idx = ti * 128 + rr;
            const int tk = idx < ne ? ltok[e * 16384 + idx] : 0;
            pa[i] = h2 + (size_t)(tk >> 1) * 1024 + lch8;
            const int bwc = rr >> 6, bni = (rr >> 4) & 3, bj = rr & 15;
            const int f = ft * 64 + bwc * 32 + (bni >> 1) * 16 + bj;
            pb[i] = ((bni & 1) ? WuT : WgT) + ((size_t)e * 256 + f) * 1024 + lch8;
        }
        f32x4 acc[4][4]; acc_zero(acc);
        gemm_kloop(acc, pa, pb, 64, 64, 16, smem);
#pragma unroll
        for (int mi = 0; mi < 4; ++mi) {
            const int idx = ti * 128 + wr * 64 + mi * 16 + fr;
            if (idx < ne) {
                const int tk = ltok[e * 16384 + idx];
                const float w = lw[e * 16384 + idx], rsv = rstd[tk >> 1];
#pragma unroll
                for (int q = 0; q < 2; ++q) {
                    const int f = ft * 64 + wc * 32 + q * 16 + 4 * fq;
                    f32x4 v;
#pragma unroll
                    for (int j = 0; j < 4; ++j) { const float a = acc[mi][2 * q][j] * rsv, uu = acc[mi][2 * q + 1][j] * rsv; v[j] = a * sigmoidf_(a) * uu * w; }
                    *(uint2*)(hid + (size_t)tk * 256 + f) = pack4(v);
                }
            }
        }
    }
}

__device__ __forceinline__ void ph_moe2(const bf16_t* __restrict__ hid, const bf16_t* __restrict__ WdT, const int* __restrict__ cnt, const int* __restrict__ ltok,
                                        bf16_t* __restrict__ Y, char* smem) {
    GEMM_LANE_VARS
    int e, ti;
    const int nu = moe_tile_decode(cnt, 0, e, ti) * 8;
    for (int u = HB_FIRST; u < nu; u += HB_STEP) {
        const int tn = u & 7;
        (void)moe_tile_decode(cnt, u >> 3, e, ti);
        const int ne = cnt[e * 64];
        const bf16_t* pa[4]; const bf16_t* pb[4];
#pragma unroll
        for (int i = 0; i < 4; ++i) {
            const int idx = ti * 128 + lrow + 32 * i;
            const int tk = idx < ne ? ltok[e * 16384 + idx] : 0;
            pa[i] = hid + (size_t)tk * 256 + lch8;
            pb[i] = WdT + ((size_t)e * 1024 + tn * 128 + lrow + 32 * i) * 256 + lch8;
        }
        f32x4 acc[4][4]; acc_zero(acc);
        gemm_kloop(acc, pa, pb, 64, 64, 4, smem);
#pragma unroll
        for (int mi = 0; mi < 4; ++mi) {
            const int idx = ti * 128 + wr * 64 + mi * 16 + fr;
            if (idx < ne) {
                const int tk = ltok[e * 16384 + idx];
                bf16_t* yr = Y + ((size_t)(tk & 1) * T + (size_t)(tk >> 1)) * 1024 + tn * 128 + wc * 64 + 4 * fq;
#pragma unroll
                for (int ni = 0; ni < 4; ++ni) *(uint2*)(yr + ni * 16) = pack4(acc[mi][ni]);
            }
        }
    }
}

namespace g8 {
constexpr int HTB = 128 * 64 * 2;
__device__ __forceinline__ int lds_byte(int r, int c) { const int st = (r >> 4) * 2 + (c >> 5), rr = r & 15, cc = c & 31, ob = rr * 64 + cc * 2; return st * 1024 + (ob ^ (((ob >> 9) & 1) << 5)); }
__device__ __forceinline__ void stage_rc(int b, int& R, int& C) { const int st = b / 1024, sb = b % 1024, swz = sb ^ (((sb >> 9) & 1) << 5); R = (st >> 1) * 16 + swz / 64; C = (st & 1) * 32 + (swz % 64) / 2; }
__device__ __forceinline__ int perm32(int rho) { const int n = rho >> 4, i = rho & 15; return 8 * (i >> 2) + 4 * n + (i & 3); }
struct Unit { int pm, pn, e; };
struct StaticOrder {
    int nM, nN, nwg, G, c;
    __device__ __forceinline__ void init(int M, int N, int G_, int c_) { nM = M / 256; nN = N / 256; nwg = nM * nN; G = G_; c = c_; }
    __device__ __forceinline__ bool next(int i, Unit& u) const {
        const long L = (long)i * G + c; if (L >= nwg) return false;
        int wgid = (int)L; { const int q = nwg / 8, r = nwg % 8, xcd = wgid % 8, off = wgid / 8; wgid = (xcd < r ? xcd * (q + 1) : r * (q + 1) + (xcd - r) * q) + off; }
        const int nig = 8 * nN, gid = wgid / nig, fm = gid * 8, gsz = (nM - fm) < 8 ? (nM - fm) : 8;
        u.pm = fm + ((wgid % nig) % gsz); u.pn = (wgid % nig) / gsz; u.e = 0; return true;
    }
};
struct AddrPlain {
    const char* A; const char* Bt; unsigned lda2, ldb2; int ntiles;
    __device__ __forceinline__ const char* a_base(const Unit&) const { return A; }
    __device__ __forceinline__ const char* b_base(const Unit&) const { return Bt; }
    __device__ __forceinline__ int nt(const Unit&) const { return ntiles; }
    __device__ __forceinline__ int a_row0(const Unit& u) const { return u.pm * 256; }
    __device__ __forceinline__ int b_row0(const Unit& u) const { return u.pn * 256; }
    __device__ __forceinline__ unsigned a_ld(const Unit&) const { return lda2; }
    __device__ __forceinline__ unsigned b_ld(const Unit&) const { return ldb2; }
};

template <class Epi, class Sched, class Addr>
__device__ __forceinline__ void gemm_phase(char* ldsc, const Sched& S, const Addr& AD, const Epi& E) {
    __attribute__((address_space(3))) unsigned char* lds = (__attribute__((address_space(3))) unsigned char*)ldsc;
    int tid_ = threadIdx.x; asm volatile("" : "+v"(tid_));
    const int tid = tid_, wid = __builtin_amdgcn_readfirstlane(tid >> 6), lane = tid & 63, wr = wid >> 2, wc = wid & 3, fr = lane & 15, fq = lane >> 4;
    int R[2], C2[2], Rb[2];
#pragma unroll
    for (int i = 0; i < 2; ++i) { int r_, c_; stage_rc(tid * 16 + i * 8192, r_, c_); R[i] = r_; C2[i] = c_ * 2; Rb[i] = Epi::PERM ? ((r_ & ~31) + perm32(r_ & 31)) : r_; }
    const unsigned ldsw = (unsigned)wid * 1024u;
    const int aoff = lds_byte(wr * 64 + fr, fq * 8), boff = lds_byte(wc * 32 + fr, fq * 8);
#define G8_SA(b, h) (((b) * 2 + (h)) * HTB)
#define G8_SB(b, h) ((4 + (b) * 2 + (h)) * HTB)
#define G8_STAGE(bufoff, base, rowv, row0, ld, h, kb) do { _Pragma("unroll") for (int _i = 0; _i < 2; ++_i) \
        __builtin_amdgcn_global_load_lds((const __attribute__((address_space(1))) unsigned*)((base) + (size_t)((unsigned)((row0) + (h) * 128 + (rowv)[_i]) * (ld) + (unsigned)C2[_i] + (unsigned)(kb))), \
                                         (__attribute__((address_space(3))) unsigned*)(lds + (bufoff) + ldsw + _i * 8192), 16, 0, 0); } while (0)
#define G8_LDA(dst, b, h) do { _Pragma("unroll") for (int m = 0; m < 4; ++m) _Pragma("unroll") for (int k = 0; k < 2; ++k) dst[m][k] = *(const __attribute__((address_space(3))) bf16x8*)(lds + G8_SA(b, h) + aoff + m * 2048 + k * 1024); } while (0)
#define G8_LDB(dst, b, h) do { _Pragma("unroll") for (int n = 0; n < 2; ++n) _Pragma("unroll") for (int k = 0; k < 2; ++k) dst[n][k] = *(const __attribute__((address_space(3))) bf16x8*)(lds + G8_SB(b, h) + boff + n * 2048 + k * 1024); } while (0)
#define G8_MMA(ai, bj, At, Bt) do { __builtin_amdgcn_s_setprio(1); _Pragma("unroll") for (int m = 0; m < 4; ++m) _Pragma("unroll") for (int n = 0; n < 2; ++n) _Pragma("unroll") for (int k = 0; k < 2; ++k) \
        acc[ai][bj][m][n] = __builtin_amdgcn_mfma_f32_16x16x32_bf16(Bt[n][k], At[m][k], acc[ai][bj][m][n], 0, 0, 0); __builtin_amdgcn_s_setprio(0); } while (0)
#define G8_WAIT_V(n) asm volatile("s_waitcnt vmcnt(" #n ")" ::: "memory")
#define G8_WAIT_L(n) asm volatile("s_waitcnt lgkmcnt(" #n ")" ::: "memory")
#define G8_BAR __builtin_amdgcn_s_barrier()
#define G8_SCHED __builtin_amdgcn_sched_barrier(0)
    Unit cur, nxt; int ui = 0;
    if (!S.next(0, cur)) return;
    f32x4 acc[2][2][4][2];
#pragma unroll
    for (int a = 0; a < 2; ++a)
#pragma unroll
        for (int b = 0; b < 2; ++b)
#pragma unroll
            for (int m = 0; m < 4; ++m)
#pragma unroll
                for (int n = 0; n < 2; ++n) acc[a][b][m][n] = (f32x4){0.f, 0.f, 0.f, 0.f};
    bf16x8 At[4][2], B0[2][2], B1[2][2];
    const char* Ab = AD.a_base(cur); const char* Bb = AD.b_base(cur);
    int ar0 = AD.a_row0(cur), br0 = AD.b_row0(cur); unsigned ald = AD.a_ld(cur), bld = AD.b_ld(cur);
    __syncthreads();
    G8_STAGE(G8_SB(0, 0), Bb, Rb, br0, bld, 0, 0); G8_STAGE(G8_SA(0, 0), Ab, R, ar0, ald, 0, 0); G8_STAGE(G8_SB(0, 1), Bb, Rb, br0, bld, 1, 0); G8_STAGE(G8_SA(0, 1), Ab, R, ar0, ald, 1, 0);
    if (wr == 1) G8_BAR;
    G8_WAIT_V(4); G8_BAR;
    G8_STAGE(G8_SB(1, 0), Bb, Rb, br0, bld, 0, 128); G8_STAGE(G8_SA(1, 0), Ab, R, ar0, ald, 0, 128); G8_STAGE(G8_SB(1, 1), Bb, Rb, br0, bld, 1, 128);
    G8_WAIT_V(6); G8_BAR;
    for (;;) {
        const bool has_next = S.next(ui + 1, nxt);
        const int nt = AD.nt(cur);
        const char* nAb = has_next ? AD.a_base(nxt) : Ab; const char* nBb = has_next ? AD.b_base(nxt) : Bb;
        const int nar0 = has_next ? AD.a_row0(nxt) : ar0, nbr0 = has_next ? AD.b_row0(nxt) : br0;
        const unsigned nald = has_next ? AD.a_ld(nxt) : ald, nbld = has_next ? AD.b_ld(nxt) : bld;
        for (int t = 0; t < nt; t += 2) {
            const bool last = (t == nt - 2);
            const int kb1 = (t + 1) * 128, kb2 = last ? 0 : (t + 2) * 128, kb3 = kb2 + 128;
            const char* sAb = last ? nAb : Ab; const char* sBb = last ? nBb : Bb;
            const int sar0 = last ? nar0 : ar0, sbr0 = last ? nbr0 : br0; const unsigned sald = last ? nald : ald, sbld = last ? nbld : bld;
            G8_LDB(B0, 0, 0); G8_SCHED; G8_LDA(At, 0, 0); G8_STAGE(G8_SA(1, 1), Ab, R, ar0, ald, 1, kb1);
            G8_WAIT_L(8); G8_BAR; G8_WAIT_L(0); G8_MMA(0, 0, At, B0); G8_BAR; G8_SCHED;
            G8_LDB(B1, 0, 1); G8_STAGE(G8_SB(0, 0), sBb, Rb, sbr0, sbld, 0, kb2);
            G8_BAR; G8_WAIT_L(0); G8_MMA(0, 1, At, B1); G8_BAR;
            G8_LDA(At, 0, 1); G8_STAGE(G8_SA(0, 0), sAb, R, sar0, sald, 0, kb2);
            G8_BAR; G8_WAIT_L(0); G8_MMA(1, 0, At, B0); G8_BAR; G8_SCHED;
            G8_STAGE(G8_SB(0, 1), sBb, Rb, sbr0, sbld, 1, kb2);
            G8_WAIT_V(6); G8_BAR; G8_MMA(1, 1, At, B1); G8_BAR;
            G8_LDB(B0, 1, 0); G8_SCHED; G8_LDA(At, 1, 0); G8_STAGE(G8_SA(0, 1), sAb, R, sar0, sald, 1, kb2);
            G8_WAIT_L(8); G8_BAR; G8_WAIT_L(0); G8_MMA(0, 0, At, B0); G8_BAR; G8_SCHED;
            G8_LDB(B1, 1, 1); G8_STAGE(G8_SB(1, 0), sBb, Rb, sbr0, sbld, 0, kb3);
            G8_BAR; G8_WAIT_L(0); G8_MMA(0, 1, At, B1); G8_BAR;
            G8_LDA(At, 1, 1); G8_STAGE(G8_SA(1, 0), sAb, R, sar0, sald, 0, kb3);
            G8_BAR; G8_WAIT_L(0); G8_MMA(1, 0, At, B0); G8_BAR; G8_SCHED;
            G8_STAGE(G8_SB(1, 1), sBb, Rb, sbr0, sbld, 1, kb3);
            G8_WAIT_V(6); G8_BAR; G8_MMA(1, 1, At, B1); G8_BAR;
        }
        E(acc, cur, wr, wc, fr, fq);
        if (!has_next) break;
#pragma unroll
        for (int a = 0; a < 2; ++a)
#pragma unroll
            for (int b = 0; b < 2; ++b)
#pragma unroll
                for (int m = 0; m < 4; ++m)
#pragma unroll
                    for (int n = 0; n < 2; ++n) acc[a][b][m][n] = (f32x4){0.f, 0.f, 0.f, 0.f};
        cur = nxt; Ab = nAb; Bb = nBb; ar0 = nar0; br0 = nbr0; ald = nald; bld = nbld; ++ui;
    }
    G8_WAIT_V(0);
    if (wr == 0) G8_BAR;
    G8_BAR;
#undef G8_SA
#undef G8_SB
#undef G8_STAGE
#undef G8_LDA
#undef G8_LDB
#undef G8_MMA
#undef G8_WAIT_V
#undef G8_WAIT_L
#undef G8_BAR
#undef G8_SCHED
}

struct EpiProj {
    static constexpr bool PERM = true;
    bf16_t* proj;
    __device__ __forceinline__ void operator()(const f32x4 (&acc)[2][2][4][2], const Unit& u, int wr, int wc, int fr, int fq) const {
#pragma unroll
        for (int ai = 0; ai < 2; ++ai)
#pragma unroll
            for (int m = 0; m < 4; ++m) {
                const int r = u.pm * 256 + ai * 128 + wr * 64 + m * 16 + fr;
#pragma unroll
                for (int bj = 0; bj < 2; ++bj) {
                    const int c = u.pn * 256 + bj * 128 + wc * 32 + 8 * fq;
                    if (c < NPROJ) {
                        u32x4 w; w[0] = pack_bf16(acc[ai][bj][m][0][0], acc[ai][bj][m][0][1]); w[1] = pack_bf16(acc[ai][bj][m][0][2], acc[ai][bj][m][0][3]);
                        w[2] = pack_bf16(acc[ai][bj][m][1][0], acc[ai][bj][m][1][1]); w[3] = pack_bf16(acc[ai][bj][m][1][2], acc[ai][bj][m][1][3]);
                        *(u32x4*)(proj + (size_t)r * PP + c) = w;
                    }
                }
            }
    }
};
struct EpiResid {
    static constexpr bool PERM = false;
    const float* x; float* x2;
    __device__ __forceinline__ void operator()(const f32x4 (&acc)[2][2][4][2], const Unit& u, int wr, int wc, int fr, int fq) const {
#pragma unroll
        for (int ai = 0; ai < 2; ++ai)
#pragma unroll
            for (int m = 0; m < 4; ++m) {
                const int r = u.pm * 256 + ai * 128 + wr * 64 + m * 16 + fr;
#pragma unroll
                for (int bj = 0; bj < 2; ++bj)
#pragma unroll
                    for (int n = 0; n < 2; ++n) {
                        const int c = u.pn * 256 + bj * 128 + wc * 32 + 16 * n + 4 * fq;
                        const f32x4 xv = *(const f32x4*)(x + (size_t)r * 1024 + c);
                        *(f32x4*)(x2 + (size_t)r * 1024 + c) = xv + acc[ai][bj][m][n];
                    }
            }
    }
};
struct OneUnit { Unit u; __device__ __forceinline__ bool next(int i, Unit& o) const { if (i) return false; o = u; return true; } };
template <int OP>
struct EpiMerge {
    static constexpr bool PERM = true;
    bf16_t* dst; const bf16_t* src2;
    __device__ __forceinline__ void operator()(const f32x4 (&acc)[2][2][4][2], const Unit& u, int wr, int wc, int fr, int fq) const {
#pragma unroll
        for (int ai = 0; ai < 2; ++ai)
#pragma unroll
            for (int m = 0; m < 4; ++m) {
                const int r = u.pm * 256 + ai * 128 + wr * 64 + m * 16 + fr;
#pragma unroll
                for (int bj = 0; bj < 2; ++bj) {
                    const size_t o = (size_t)r * 1024 + u.pn * 256 + bj * 128 + wc * 32 + 8 * fq;
                    float v[8];
#pragma unroll
                    for (int j = 0; j < 4; ++j) { v[j] = acc[ai][bj][m][0][j]; v[4 + j] = acc[ai][bj][m][1][j]; }
                    if (OP == 0) {
#pragma unroll
                        for (int j = 0; j < 8; ++j) v[j] = sigmoidf_(v[j]);
                    } else {
                        const u32x4 d = *(const u32x4*)(dst + o);
                        float dv[8];
#pragma unroll
                        for (int j = 0; j < 4; ++j) { dv[2 * j] = __uint_as_float(d[j] << 16); dv[2 * j + 1] = __uint_as_float(d[j] & 0xFFFF0000u); }
                        if (OP == 1) {
#pragma unroll
                            for (int j = 0; j < 8; ++j) v[j] = dv[j] * v[j];
                        } else {
                            const u32x4 s = *(const u32x4*)(src2 + o);
#pragma unroll
                            for (int j = 0; j < 4; ++j) { v[2 * j] = dv[2 * j] + __uint_as_float(s[j] << 16) * v[2 * j]; v[2 * j + 1] = dv[2 * j + 1] + __uint_as_float(s[j] & 0xFFFF0000u) * v[2 * j + 1]; }
                        }
                    }
                    u32x4 w; w[0] = pack_bf16(v[0], v[1]); w[1] = pack_bf16(v[2], v[3]); w[2] = pack_bf16(v[4], v[5]); w[3] = pack_bf16(v[6], v[7]);
                    *(u32x4*)(dst + o) = w;
                }
            }
    }
};
struct MergeOrder { StaticOrder so; __device__ __forceinline__ bool next(int i, Unit& u) const { if (!so.next(i >> 2, u)) return false; u.e = i & 3; return true; } };
struct AddrMerge {
    const char* h; const char* WinT; const char* ya; const char* yb; const char* WaT; const char* WbT;
    __device__ __forceinline__ const char* a_base(const Unit& u) const {
        const unsigned long long ph = (unsigned long long)h, pa = (unsigned long long)ya, pb = (unsigned long long)yb, o = (unsigned long long)(u.e & 1), t = (unsigned long long)((u.e >> 1) & 1);
        return (const char*)(ph + o * ((pa - ph) + t * (pb - pa))); }
    __device__ __forceinline__ const char* b_base(const Unit& u) const {
        const unsigned long long pg = (unsigned long long)(WinT + (size_t)MGA * 2048), pa = (unsigned long long)WaT, pb = (unsigned long long)WbT, o = (unsigned long long)(u.e & 1), t = (unsigned long long)((u.e >> 1) & 1);
        const unsigned long long g = pg + t * (unsigned long long)((size_t)(MGB - MGA) * 2048), y = pa + t * (pb - pa);
        return (const char*)(g + o * (y - g)); }
    __device__ __forceinline__ int nt(const Unit& u) const { return (u.e & 1) ? 8 : 16; }
    __device__ __forceinline__ int a_row0(const Unit& u) const { return u.pm * 256; }
    __device__ __forceinline__ int b_row0(const Unit& u) const { return u.pn * 256; }
    __device__ __forceinline__ unsigned a_ld(const Unit& u) const { return (u.e & 1) ? 1024u : 2048u; }
    __device__ __forceinline__ unsigned b_ld(const Unit& u) const { return (u.e & 1) ? 1024u : 2048u; }
};
struct EpiMergeAll {
    static constexpr bool PERM = true;
    bf16_t* mrg; bf16_t* sg2;
    __device__ __forceinline__ void operator()(const f32x4 (&acc)[2][2][4][2], const Unit& u, int wr, int wc, int fr, int fq) const {
        if (u.e == 0) EpiMerge<0>{mrg, nullptr}(acc, u, wr, wc, fr, fq);
        else if (u.e == 1) EpiMerge<1>{mrg, nullptr}(acc, u, wr, wc, fr, fq);
        else if (u.e == 2) EpiMerge<0>{sg2, nullptr}(acc, u, wr, wc, fr, fq);
        else EpiMerge<2>{mrg, sg2}(acc, u, wr, wc, fr, fq);
    }
};
}

constexpr float LOG2E = 1.4426950408889634f;
constexpr float NEGV = -3.0e38f;
constexpr int NSA_TB = 32768;
constexpr int NSA_IMPA = 34816;
constexpr int NSA_IMPB = NSA_IMPA + 16640;
constexpr int NSA_SELM = NSA_IMPB + 16640;

__device__ __forceinline__ int t5_bucket2(int n) {
    if (n < 16) return n;
    const int l = 16 + (int)(logf((float)n / 16.0f) / logf(8.0f) * 16.0f);
    return l < 31 ? l : 31;
}

template <int MODE, bool A0, bool A1>
__device__ __forceinline__ void nsa_tile(const char* Kst, const char* Vst, int j, bool fast, const float* tbias, const bf16x8 (&qf)[2][2], const int (&qidx)[2],
                                         const unsigned long long (&selq)[2], f32x4 (&O)[4][2], float (&m)[2], float (&l)[2], const float (&invl)[2],
                                         char* smem, int fr, int fq, int hp, int wid) {
    const float b127 = tbias[127];
    bf16x8 pf[2][2];
    bool started = true;
    if (MODE != 3) started = __builtin_amdgcn_ballot_w64((A0 && m[0] < -1e29f) || (A1 && m[1] < -1e29f)) == 0ull;
    const bool quick = (MODE != 3) && fast && started;
    f32x4 sall[2][2][2];
#pragma unroll
    for (int p = 0; p < 2; ++p)
#pragma unroll
        for (int s = 0; s < 2; ++s) {
            const int row = 32 * p + 16 * s + fr;
            const bf16x8 k0 = *(const bf16x8*)(Kst + tile_off(row, fq)), k1 = *(const bf16x8*)(Kst + tile_off(row, 4 + fq));
#pragma unroll
            for (int ct = 0; ct < 2; ++ct) {
                if ((ct == 0 && !A0) || (ct == 1 && !A1)) continue;
                float i0 = 0.f;
                if (quick) { const bool sel = (MODE == 1) ? (((selq[ct] >> j) & 1ull) != 0ull) : true; i0 = (sel ? b127 : NEGV) - m[ct]; }
                f32x4 a = (f32x4){i0, i0, i0, i0};
                a = __builtin_amdgcn_mfma_f32_16x16x32_bf16(k0, qf[ct][0], a, 0, 0, 0);
                a = __builtin_amdgcn_mfma_f32_16x16x32_bf16(k1, qf[ct][1], a, 0, 0, 0);
                sall[ct][p][s] = a;
            }
        }
#pragma unroll
    for (int ct = 0; ct < 2; ++ct) {
        if ((ct == 0 && !A0) || (ct == 1 && !A1)) continue;
        f32x4 (&sacc)[2][2] = sall[ct];
        const int q = qidx[ct];
        const bool sel = (MODE == 1) ? (((selq[ct] >> j) & 1ull) != 0ull) : true;
        if (MODE != 3) {
            const float mct = m[ct];
            if (!quick) {
                const float ref = started ? mct : 0.f;
#pragma unroll
                for (int p = 0; p < 2; ++p)
#pragma unroll
                    for (int s = 0; s < 2; ++s)
#pragma unroll
                        for (int i = 0; i < 4; ++i) {
                            const int kk = 64 * j + 32 * p + 8 * fq + 4 * s + i;
                            int rel; bool valid;
                            if (MODE == 0) { rel = q - (16 * kk + 31); valid = rel >= 0; }
                            else if (MODE == 1) { rel = q - kk; valid = (rel >= 0) && sel; }
                            else { rel = q - kk; valid = (rel >= 0) && (rel < 512); }
                            const int rc = rel < 0 ? 0 : (rel > 127 ? 127 : rel);
                            sacc[p][s][i] = valid ? sacc[p][s][i] + (tbias[rc] - ref) : NEGV;
                        }
            }
            float pv[2][8]; float psum = 0.f;
            bool redo = !started;
            if (started) {
#pragma unroll
                for (int p = 0; p < 2; ++p)
#pragma unroll
                    for (int s = 0; s < 2; ++s)
#pragma unroll
                        for (int i = 0; i < 4; ++i) { pv[p][s * 4 + i] = __builtin_amdgcn_exp2f(sacc[p][s][i]); psum += pv[p][s * 4 + i]; }
                if (__builtin_amdgcn_ballot_w64(!(psum <= 256.0f)) != 0ull) {
                    redo = true;
#pragma unroll
                    for (int p = 0; p < 2; ++p)
#pragma unroll
                        for (int s = 0; s < 2; ++s)
#pragma unroll
                            for (int i = 0; i < 4; ++i) sacc[p][s][i] += mct;
                }
            }
            if (redo) {
                float mloc = NEGV;
#pragma unroll
                for (int p = 0; p < 2; ++p)
#pragma unroll
                    for (int s = 0; s < 2; ++s)
#pragma unroll
                        for (int i = 0; i < 4; ++i) mloc = fmaxf(mloc, sacc[p][s][i]);
                mloc = fmaxf(mloc, __shfl_xor(mloc, 16)); mloc = fmaxf(mloc, __shfl_xor(mloc, 32));
                const float mnew = fmaxf(mct, mloc);
                const float alpha = __builtin_amdgcn_exp2f(mct - mnew);
                m[ct] = mnew; l[ct] *= alpha;
#pragma unroll
                for (int dt = 0; dt < 4; ++dt) O[dt][ct] = O[dt][ct] * alpha;
                psum = 0.f;
#pragma unroll
                for (int p = 0; p < 2; ++p)
#pragma unroll
                    for (int s = 0; s < 2; ++s)
#pragma unroll
                        for (int i = 0; i < 4; ++i) { pv[p][s * 4 + i] = __builtin_amdgcn_exp2f(sacc[p][s][i] - mnew); psum += pv[p][s * 4 + i]; }
            }
#pragma unroll
            for (int p = 0; p < 2; ++p) {
                u32x4 w; w[0] = pack_bf16(pv[p][0], pv[p][1]); w[1] = pack_bf16(pv[p][2], pv[p][3]); w[2] = pack_bf16(pv[p][4], pv[p][5]); w[3] = pack_bf16(pv[p][6], pv[p][7]);
                pf[ct][p] = __builtin_bit_cast(bf16x8, w);
            }
            l[ct] += psum;
        } else {
#pragma unroll
            for (int p = 0; p < 2; ++p)
#pragma unroll
                for (int s = 0; s < 2; ++s)
#pragma unroll
                    for (int i = 0; i < 4; ++i) {
                        const int kk = 64 * j + 32 * p + 8 * fq + 4 * s + i;
                        const int rel = q - (16 * kk + 31);
                        const int rc = rel < 0 ? 0 : (rel > 127 ? 127 : rel);
                        sacc[p][s][i] = (rel >= 0) ? sacc[p][s][i] + tbias[rc] : NEGV;
                    }
            float* impA = (float*)(smem + NSA_IMPA); float* impB = (float*)(smem + NSA_IMPB);
            const int ql = wid * 8 + ct * 4 + (fr >> 2);
#pragma unroll
            for (int p = 0; p < 2; ++p)
#pragma unroll
                for (int s = 0; s < 2; ++s) {
                    float p3 = __builtin_amdgcn_exp2f(sacc[p][s][3] - m[ct]) * invl[ct];
                    float pa = __builtin_amdgcn_exp2f(sacc[p][s][0] - m[ct]) * invl[ct] + __builtin_amdgcn_exp2f(sacc[p][s][1] - m[ct]) * invl[ct]
                             + __builtin_amdgcn_exp2f(sacc[p][s][2] - m[ct]) * invl[ct] + p3;
                    pa += __shfl_xor(pa, 1); pa += __shfl_xor(pa, 2);
                    p3 += __shfl_xor(p3, 1); p3 += __shfl_xor(p3, 2);
                    const int jj = 16 * j + 8 * p + 2 * fq + s;
                    if (hp == 0) { impA[ql * 65 + jj] = pa; impB[ql * 65 + jj + 1] = p3; }
                }
        }
    }
    if (MODE != 3) {
#pragma unroll
        for (int dt = 0; dt < 4; ++dt)
#pragma unroll
            for (int p = 0; p < 2; ++p) {
                const bf16x8 vf = *(const bf16x8*)(Vst + tile_off(dt * 16 + fr, p * 4 + fq));
                if (A0) O[dt][0] = __builtin_amdgcn_mfma_f32_16x16x32_bf16(vf, pf[0][p], O[dt][0], 0, 0, 0);
                if (A1) O[dt][1] = __builtin_amdgcn_mfma_f32_16x16x32_bf16(vf, pf[1][p], O[dt][1], 0, 0, 0);
            }
    }
}

template <int MODE>
__device__ __forceinline__ void nsa_branch(const bf16_t* __restrict__ Kb, size_t kstride, const bf16_t* __restrict__ Vb, size_t vstride, int j0, int ntiles, int t0,
                                           const bf16x8 (&qf)[2][2], const int (&qidx)[2], const unsigned long long (&selq)[2], unsigned long long selor0, unsigned long long selor1,
                                           f32x4 (&O)[4][2], float (&m)[2], float (&l)[2], const float (&invl)[2], char* smem) {
    int tid_ = threadIdx.x; asm volatile("" : "+v"(tid_));
    const int tid = tid_, lane = tid & 63, wid = tid >> 6, fr = lane & 15, fq = lane >> 4, hp = fr & 3;
    const int lrow = tid >> 3;
    const float* tbias = (const float*)(smem + NSA_TB) + hp * 128;
    const int sch8 = ((tid & 7) ^ (lrow & 7)) * 8;
    const int krow = 32 * (lrow >> 5) + 8 * ((lrow & 15) >> 2) + 4 * ((lrow >> 4) & 1) + (lrow & 3);
    const bf16_t* kp = Kb + (size_t)krow * kstride + sch8;
    const bf16_t* vp = Vb + (size_t)lrow * vstride + sch8;
    __syncthreads();
    glds16(kp, smem + tid * 16); if (MODE != 3) glds16(vp, smem + 8192 + tid * 16);
    asm volatile("s_waitcnt vmcnt(0)" ::: "memory");
    __syncthreads();
    for (int it = 0; it < ntiles; ++it) {
        const int cur = it & 1, j = j0 + it;
        if (it + 1 < ntiles) {
            char* st = smem + (cur ^ 1) * 16384 + tid * 16;
            glds16(kp + (size_t)(it + 1) * 64 * kstride, st); if (MODE != 3) glds16(vp + (size_t)(it + 1) * 64, st + 8192);
        }
        const char* Kst = smem + cur * 16384;
        const char* Vst = Kst + 8192;
        bool fast;
        if (MODE == 0 || MODE == 3) fast = (t0 - (16 * (64 * j + 63) + 31)) >= 128;
        else if (MODE == 1) fast = (t0 - (64 * j + 63)) >= 128;
        else fast = ((t0 - (64 * j + 63)) >= 128) && ((t0 + 63 - 64 * j) < 512);
        if (MODE == 1) {
            const bool a0 = ((selor0 >> j) & 1ull) != 0ull, a1 = ((selor1 >> j) & 1ull) != 0ull;
            if (a0 && a1) nsa_tile<MODE, true, true>(Kst, Vst, j, fast, tbias, qf, qidx, selq, O, m, l, invl, smem, fr, fq, hp, wid);
            else if (a0) nsa_tile<MODE, true, false>(Kst, Vst, j, fast, tbias, qf, qidx, selq, O, m, l, invl, smem, fr, fq, hp, wid);
            else if (a1) nsa_tile<MODE, false, true>(Kst, Vst, j, fast, tbias, qf, qidx, selq, O, m, l, invl, smem, fr, fq, hp, wid);
        } else {
            nsa_tile<MODE, true, true>(Kst, Vst, j, fast, tbias, qf, qidx, selq, O, m, l, invl, smem, fr, fq, hp, wid);
        }
        asm volatile("s_waitcnt vmcnt(0)" ::: "memory");
        __syncthreads();
    }
}

__device__ __forceinline__ void osum_add(uint2& acc, f32x4 o, float sc) {
    f32x4 v;
    v[0] = __uint_as_float(acc.x << 16) + o[0] * sc; v[1] = __uint_as_float(acc.x & 0xFFFF0000u) + o[1] * sc;
    v[2] = __uint_as_float(acc.y << 16) + o[2] * sc; v[3] = __uint_as_float(acc.y & 0xFFFF0000u) + o[3] * sc;
    acc = pack4(v);
}
__device__ __forceinline__ float nsa_gate(const bf16_t* __restrict__ pb, int q, int br, int head) { return sigmoidf_(bf2f(pb[(size_t)q * PP + GA + br * 8 + head])); }

__device__ __forceinline__ void nsa_unit(int u, const bf16_t* __restrict__ proj, const char* __restrict__ ws, const float* __restrict__ rel_bias, bf16_t* __restrict__ ya, char* smem) {
    int tid_ = threadIdx.x; asm volatile("" : "+v"(tid_));
    const int tid = tid_, lane = tid & 63, wid = tid >> 6, fr = lane & 15, fq = lane >> 4, hp = fr & 3;
    const int bg = u & 7, qb = 63 - (u >> 3), b = bg >> 1, g = bg & 1, t0 = qb * 64, tb = qb;
    const bf16_t* kcb = (const bf16_t*)(ws + OFF_KCB) + (size_t)bg * 256 * 64;
    const bf16_t* vcbT = (const bf16_t*)(ws + OFF_VCBT) + (size_t)bg * 64 * 256;
    const bf16_t* VsT = (const bf16_t*)(ws + OFF_VST) + (size_t)bg * 64 * S;
    const bf16_t* VwT = (const bf16_t*)(ws + OFF_VWT) + (size_t)bg * 64 * S;
    const bf16_t* pb = proj + (size_t)b * S * PP;
    __syncthreads();
    {
        float* tbl = (float*)(smem + NSA_TB);
        { const int e = tid, h4 = e >> 7, n = e & 127; tbl[e] = rel_bias[t5_bucket2(n) * 8 + g * 4 + h4] * LOG2E; }
        float* imp = (float*)(smem + NSA_IMPA);
        for (int e = tid; e < 2 * 4160; e += 512) imp[e] = 0.f;
    }
    int qidx[2]; bf16x8 qf[2][2];
    const int head = g * 4 + hp;
#pragma unroll
    for (int ct = 0; ct < 2; ++ct) {
        qidx[ct] = t0 + wid * 8 + ct * 4 + (fr >> 2);
        const bf16_t* qr = pb + (size_t)qidx[ct] * PP;
#pragma unroll
        for (int ks = 0; ks < 2; ++ks) {
            const u32x4 raw = *(const u32x4*)(qr + QA + head * 64 + ks * 32 + fq * 8);
            u32x4 w;
#pragma unroll
            for (int e = 0; e < 4; ++e) w[e] = pack_bf16(__uint_as_float(raw[e] << 16) * (0.125f * LOG2E), __uint_as_float(raw[e] & 0xFFFF0000u) * (0.125f * LOG2E));
            qf[ct][ks] = __builtin_bit_cast(bf16x8, w);
        }
    }
    uint2 osum[4][2];
#pragma unroll
    for (int dt = 0; dt < 4; ++dt)
#pragma unroll
        for (int ct = 0; ct < 2; ++ct) osum[dt][ct] = make_uint2(0u, 0u);
    unsigned long long selq[2] = {0ull, 0ull};
    float invl0[2] = {0.f, 0.f};
    const int ntc = (((t0 + 32) >> 4) + 1 + 63) >> 6;
    float mC[2], invC[2];
    {
        f32x4 O[4][2]; float m[2] = {-1e30f, -1e30f}, l[2] = {0.f, 0.f};
#pragma unroll
        for (int dt = 0; dt < 4; ++dt)
#pragma unroll
            for (int ct = 0; ct < 2; ++ct) O[dt][ct] = (f32x4){0.f, 0.f, 0.f, 0.f};
        nsa_branch<0>(kcb, 64, vcbT, 256, 0, ntc, t0, qf, qidx, selq, 0ull, 0ull, O, m, l, invl0, smem);
#pragma unroll
        for (int ct = 0; ct < 2; ++ct) {
            float lt = l[ct]; lt += __shfl_xor(lt, 16); lt += __shfl_xor(lt, 32);
            invC[ct] = lt > 0.f ? 1.f / lt : 0.f; mC[ct] = m[ct];
#pragma unroll
            for (int dt = 0; dt < 4; ++dt) osum_add(osum[dt][ct], O[dt][ct], nsa_gate(pb, qidx[ct], 0, head) * invC[ct]);
        }
        nsa_branch<3>(kcb, 64, vcbT, 256, 0, ntc, t0, qf, qidx, selq, 0ull, 0ull, O, mC, l, invC, smem);
    }
    {
        const float* impA = (const float*)(smem + NSA_IMPA); const float* impB = (const float*)(smem + NSA_IMPB);
        unsigned long long* selm = (unsigned long long*)(smem + NSA_SELM);
#pragma unroll 1
        for (int qq = 0; qq < 8; ++qq) {
            const int ql = wid * 8 + qq;
            const float val = impA[ql * 65 + lane] + impB[ql * 65 + lane];
            const bool forced = (lane == 0) || (lane == tb) || (lane == tb - 1);
            unsigned key = forced ? 0xFFFFFFC0u : (lane > tb ? 0u : (__float_as_uint(val) & 0xFFFFFFC0u));
            key |= (unsigned)(63 - lane);
            int rank = 0;
#pragma unroll
            for (int jp = 0; jp < 64; ++jp) rank += ((unsigned)__builtin_amdgcn_readlane((int)key, jp) > key) ? 1 : 0;
            const unsigned long long msk = __ballot(rank < 16);
            if (lane == 0) selm[ql] = msk;
        }
        wave_lds_sync();
        unsigned long long so0 = 0ull, so1 = 0ull;
#pragma unroll
        for (int qq = 0; qq < 4; ++qq) { so0 |= selm[wid * 8 + qq]; so1 |= selm[wid * 8 + 4 + qq]; }
        const unsigned long long selor0 = ((unsigned long long)(unsigned)__builtin_amdgcn_readfirstlane((int)(unsigned)(so0 >> 32)) << 32) | (unsigned)__builtin_amdgcn_readfirstlane((int)(unsigned)so0);
        const unsigned long long selor1 = ((unsigned long long)(unsigned)__builtin_amdgcn_readfirstlane((int)(unsigned)(so1 >> 32)) << 32) | (unsigned)__builtin_amdgcn_readfirstlane((int)(unsigned)so1);
        selq[0] = selm[wid * 8 + (fr >> 2)]; selq[1] = selm[wid * 8 + 4 + (fr >> 2)];
        {
            f32x4 O[4][2]; float m[2] = {-1e30f, -1e30f}, l[2] = {0.f, 0.f};
#pragma unroll
            for (int dt = 0; dt < 4; ++dt)
#pragma unroll
                for (int ct = 0; ct < 2; ++ct) O[dt][ct] = (f32x4){0.f, 0.f, 0.f, 0.f};
            nsa_branch<1>(pb + KS + g * 64, PP, VsT, S, 0, tb + 1, t0, qf, qidx, selq, selor0, selor1, O, m, l, invl0, smem);
#pragma unroll
            for (int ct = 0; ct < 2; ++ct) {
                float lt = l[ct]; lt += __shfl_xor(lt, 16); lt += __shfl_xor(lt, 32);
                const float inv = lt > 0.f ? 1.f / lt : 0.f;
#pragma unroll
                for (int dt = 0; dt < 4; ++dt) osum_add(osum[dt][ct], O[dt][ct], nsa_gate(pb, qidx[ct], 1, head) * inv);
            }
        }
    }
    {
        f32x4 O[4][2]; float m[2] = {-1e30f, -1e30f}, l[2] = {0.f, 0.f};
#pragma unroll
        for (int dt = 0; dt < 4; ++dt)
#pragma unroll
            for (int ct = 0; ct < 2; ++ct) O[dt][ct] = (f32x4){0.f, 0.f, 0.f, 0.f};
        const int jw0 = (t0 - 511 < 0 ? 0 : t0 - 511) >> 6;
        nsa_branch<2>(pb + (size_t)jw0 * 64 * PP + KW + g * 64, PP, VwT + jw0 * 64, S, jw0, tb - jw0 + 1, t0, qf, qidx, selq, 0ull, 0ull, O, m, l, invl0, smem);
#pragma unroll
        for (int ct = 0; ct < 2; ++ct) {
            float lt = l[ct]; lt += __shfl_xor(lt, 16); lt += __shfl_xor(lt, 32);
            const float inv = lt > 0.f ? 1.f / lt : 0.f;
#pragma unroll
            for (int dt = 0; dt < 4; ++dt) osum_add(osum[dt][ct], O[dt][ct], nsa_gate(pb, qidx[ct], 2, head) * inv);
        }
    }
#pragma unroll
    for (int ct = 0; ct < 2; ++ct) {
        bf16_t* yr = ya + (size_t)(b * S + qidx[ct]) * 512 + head * 64 + 4 * fq;
#pragma unroll
        for (int dt = 0; dt < 4; ++dt) *(uint2*)(yr + dt * 16) = osum[dt][ct];
    }
}

__device__ __forceinline__ void vtrans_tile(int task, const bf16_t* __restrict__ proj, char* ws, char* smem) {
    unsigned short (*tl)[66] = (unsigned short (*)[66])smem;
    const int tid = HB_TID, which = task >> 9, bg = (task >> 6) & 7, tt = task & 63, b = bg >> 1, g = bg & 1;
    const int r = tid >> 2, q4 = tid & 3;
    const bf16_t* src = proj + (size_t)(b * S + tt * 64 + r) * PP + (which ? VW : VS) + g * 64 + q4 * 16;
    const uint4 a0 = *(const uint4*)src, a1 = *(const uint4*)(src + 8);
    unsigned* trow = (unsigned*)&tl[r][q4 * 16];
    trow[0] = a0.x; trow[1] = a0.y; trow[2] = a0.z; trow[3] = a0.w; trow[4] = a1.x; trow[5] = a1.y; trow[6] = a1.z; trow[7] = a1.w;
    __syncthreads();
    bf16_t* dst = (bf16_t*)(ws + (which ? OFF_VWT : OFF_VST)) + ((size_t)bg * 64 + r) * S + tt * 64 + q4 * 16;
    unsigned o[8];
#pragma unroll
    for (int k = 0; k < 8; ++k) o[k] = (unsigned)tl[q4 * 16 + 2 * k][r] | ((unsigned)tl[q4 * 16 + 2 * k + 1][r] << 16);
    *(uint4*)dst = make_uint4(o[0], o[1], o[2], o[3]);
    *(uint4*)(dst + 8) = make_uint4(o[4], o[5], o[6], o[7]);
    __syncthreads();
}

__device__ __forceinline__ int tile_el(int row, int col) { return tile_off(row, col >> 3) + ((col & 7) << 1); }

__device__ __forceinline__ void gla_stage_vt(const bf16_t* __restrict__ proj, size_t row0, int h, char* vt_base) {
    const int tid = HB_TID, c = tid >> 2, vq = tid & 3;
    const bf16_t* src = proj + (row0 + c) * PP + VB + h * 128 + vq * 32;
#pragma unroll
    for (int k = 0; k < 4; ++k) {
        const u32x4 a = *(const u32x4*)(src + k * 8);
#pragma unroll
        for (int e = 0; e < 4; ++e) {
            const int v = vq * 32 + k * 8 + 2 * e;
            *(unsigned short*)(vt_base + tile_el(v, c)) = (unsigned short)(a[e] & 0xFFFFu);
            *(unsigned short*)(vt_base + tile_el(v + 1, c)) = (unsigned short)(a[e] >> 16);
        }
    }
}

__device__ __forceinline__ void gla_a_unit(int vb, const bf16_t* __restrict__ proj, const float* __restrict__ w_alpha, const float* __restrict__ b_alpha,
                                           float* __restrict__ bc, float* __restrict__ cstate, char* smem) {
    float (*bcS)[64] = (float (*)[64])smem;
    float (*tot)[64] = (float (*)[64])(smem + 16384);
    char* KDT = smem + 17408;
    char* VT = smem + 17408 + 8192;
    const int tid = HB_TID, lane = tid & 63, wid = tid >> 6, fr = lane & 15, fq = lane >> 4;
    const int n = vb & 63, h = (vb >> 6) & 3, b = vb >> 8;
    const size_t row0 = (size_t)(b * S + n * 64);
    __syncthreads();
    {
        const int d = tid & 63, cq = tid >> 6, col = h * 64 + d;
        float w[16];
#pragma unroll
        for (int r = 0; r < 16; ++r) w[r] = w_alpha[r * 256 + col];
        const float bias = b_alpha[col];
        float cum = 0.f;
        for (int i = 0; i < 16; ++i) {
            const int c = cq * 16 + i;
            const u32x4 a0 = *(const u32x4*)(proj + (row0 + c) * PP + AB), a1 = *(const u32x4*)(proj + (row0 + c) * PP + AB + 8);
            float z = bias;
#pragma unroll
            for (int e = 0; e < 4; ++e) {
                z += __uint_as_float(a0[e] << 16) * w[2 * e] + __uint_as_float(a0[e] & 0xFFFF0000u) * w[2 * e + 1];
                z += __uint_as_float(a1[e] << 16) * w[8 + 2 * e] + __uint_as_float(a1[e] & 0xFFFF0000u) * w[8 + 2 * e + 1];
            }
            const float ls = fminf(z, 0.f) - log1pf(__expf(-fabsf(z)));
            cum += ls * (1.0f / 16.0f);
            bcS[c][d] = cum;
        }
        tot[cq][d] = cum;
        __syncthreads();
        float pre = 0.f;
        for (int q = 0; q < cq; ++q) pre += tot[q][d];
        for (int i = 0; i < 16; ++i) {
            const int c = cq * 16 + i;
            const float v = bcS[c][d] + pre;
            bcS[c][d] = v;
            bc[(row0 + c) * 256 + col] = v;
        }
    }
    __syncthreads();
    {
        const int c = tid >> 2, dq = tid & 3;
        const bf16_t* src = proj + (row0 + c) * PP + KB + h * 64 + dq * 16;
#pragma unroll
        for (int k = 0; k < 2; ++k) {
            const u32x4 a = *(const u32x4*)(src + k * 8);
#pragma unroll
            for (int e = 0; e < 4; ++e) {
                const int d = dq * 16 + k * 8 + 2 * e;
                const float k0 = __uint_as_float(a[e] << 16) * __expf(bcS[63][d] - bcS[c][d]);
                const float k1 = __uint_as_float(a[e] & 0xFFFF0000u) * __expf(bcS[63][d + 1] - bcS[c][d + 1]);
                *(unsigned short*)(KDT + tile_el(d, c)) = f2bf(k0);
                *(unsigned short*)(KDT + tile_el(d + 1, c)) = f2bf(k1);
            }
        }
    }
    gla_stage_vt(proj, row0, h, VT);
    __syncthreads();
    float* outp = cstate + (size_t)vb * 8192;
#pragma unroll
    for (int vi = 0; vi < 2; ++vi) {
        const int vt = wid * 2 + vi;
        const bf16x8 a0 = *(const bf16x8*)(VT + tile_off(vt * 16 + fr, fq)), a1 = *(const bf16x8*)(VT + tile_off(vt * 16 + fr, 4 + fq));
#pragma unroll
        for (int dt = 0; dt < 4; ++dt) {
            const bf16x8 b0 = *(const bf16x8*)(KDT + tile_off(dt * 16 + fr, fq)), b1 = *(const bf16x8*)(KDT + tile_off(dt * 16 + fr, 4 + fq));
            f32x4 acc = (f32x4){0.f, 0.f, 0.f, 0.f};
            acc = __builtin_amdgcn_mfma_f32_16x16x32_bf16(a0, b0, acc, 0, 0, 0);
            acc = __builtin_amdgcn_mfma_f32_16x16x32_bf16(a1, b1, acc, 0, 0, 0);
#pragma unroll
            for (int i = 0; i < 4; ++i) outp[(vt * 16 + 4 * fq + i) * 64 + dt * 16 + fr] = acc[i];
        }
    }
}

__device__ __forceinline__ void gla_scan_vb2(int vb, const float* __restrict__ bc, float* __restrict__ cstate) {
    const int idx = vb * 512 + threadIdx.x;
    const int e = idx & 8191, bh = idx >> 13, b = bh >> 2, h = bh & 3, d = e & 63;
    float state = 0.f;
    float* base = cstate + (size_t)bh * 64 * 8192 + e;
    const float* bcp = bc + ((size_t)(b * S + 63)) * 256 + h * 64 + d;
#pragma unroll 1
    for (int n0 = 0; n0 < 64; n0 += 16) {
        float upd[16], dec[16];
#pragma unroll
        for (int i = 0; i < 16; ++i) { upd[i] = base[(size_t)(n0 + i) * 8192]; dec[i] = bcp[(size_t)(n0 + i) * 64 * 256]; }
#pragma unroll
        for (int i = 0; i < 16; ++i) { base[(size_t)(n0 + i) * 8192] = state; state = __expf(dec[i]) * state + upd[i]; }
    }
}

__device__ __forceinline__ void gla_c_unit(int vb, const bf16_t* __restrict__ proj, const float* __restrict__ bc, const float* __restrict__ prev,
                                           const float* __restrict__ norm_g, bf16_t* __restrict__ yb, char* smem) {
    char* QI = smem;
    char* KI = smem + 8192;
    char* VT = smem + 16384;
    char* PT = smem + 32768;
    const int tid = HB_TID, lane = tid & 63, wid = tid >> 6, fr = lane & 15, fq = lane >> 4;
    const int n = vb & 63, h = (vb >> 6) & 3, b = vb >> 8;
    const size_t row0 = (size_t)(b * S + n * 64);
    __syncthreads();
    {
        const int c = tid >> 2, dq = tid & 3;
        const bf16_t* qs = proj + (row0 + c) * PP + QB + h * 64 + dq * 16;
        const bf16_t* ks = proj + (row0 + c) * PP + KB + h * 64 + dq * 16;
        const float* bs = bc + (row0 + c) * 256 + h * 64 + dq * 16;
#pragma unroll
        for (int k = 0; k < 2; ++k) {
            const u32x4 qa = *(const u32x4*)(qs + k * 8), ka = *(const u32x4*)(ks + k * 8);
            const f32x4 b0 = *(const f32x4*)(bs + k * 8), b1 = *(const f32x4*)(bs + k * 8 + 4);
            const float bv[8] = {b0[0], b0[1], b0[2], b0[3], b1[0], b1[1], b1[2], b1[3]};
            u32x4 qo, ko;
#pragma unroll
            for (int e = 0; e < 4; ++e) {
                const float e0 = __expf(bv[2 * e]), e1 = __expf(bv[2 * e + 1]);
                qo[e] = pack_bf16(__uint_as_float(qa[e] << 16) * 0.125f * e0, __uint_as_float(qa[e] & 0xFFFF0000u) * 0.125f * e1);
                ko[e] = pack_bf16(__uint_as_float(ka[e] << 16) / e0, __uint_as_float(ka[e] & 0xFFFF0000u) / e1);
            }
            *(u32x4*)(QI + tile_off(c, dq * 2 + k)) = qo;
            *(u32x4*)(KI + tile_off(c, dq * 2 + k)) = ko;
        }
    }
    gla_stage_vt(proj, row0, h, VT);
    {
        const int v = tid >> 1, half = tid & 1;
        const float* ps = prev + (size_t)vb * 8192 + v * 64 + half * 32;
#pragma unroll
        for (int k = 0; k < 4; ++k) {
            const f32x4 a = *(const f32x4*)(ps + k * 8), c2 = *(const f32x4*)(ps + k * 8 + 4);
            u32x4 o; o[0] = pack_bf16(a[0], a[1]); o[1] = pack_bf16(a[2], a[3]); o[2] = pack_bf16(c2[0], c2[1]); o[3] = pack_bf16(c2[2], c2[3]);
            *(u32x4*)(PT + tile_off(v, half * 4 + k)) = o;
        }
    }
    __syncthreads();
    const bf16x8 qf0 = *(const bf16x8*)(QI + tile_off(wid * 16 + fr, fq)), qf1 = *(const bf16x8*)(QI + tile_off(wid * 16 + fr, 4 + fq));
    bf16x8 pf[2];
    const int c = wid * 16 + fr;
#pragma unroll
    for (int p = 0; p < 2; ++p) {
        u32x4 w;
#pragma unroll
        for (int s = 0; s < 2; ++s) {
            const int row = 32 * p + 8 * (fr >> 2) + 4 * s + (fr & 3);
            const bf16x8 k0 = *(const bf16x8*)(KI + tile_off(row, fq)), k1 = *(const bf16x8*)(KI + tile_off(row, 4 + fq));
            f32x4 a = (f32x4){0.f, 0.f, 0.f, 0.f};
            a = __builtin_amdgcn_mfma_f32_16x16x32_bf16(k0, qf0, a, 0, 0, 0);
            a = __builtin_amdgcn_mfma_f32_16x16x32_bf16(k1, qf1, a, 0, 0, 0);
#pragma unroll
            for (int i = 0; i < 4; ++i) { const int j = 32 * p + 8 * fq + 4 * s + i; if (j > c) a[i] = 0.f; }
            w[2 * s] = pack_bf16(a[0], a[1]); w[2 * s + 1] = pack_bf16(a[2], a[3]);
        }
        pf[p] = __builtin_bit_cast(bf16x8, w);
    }
    f32x4 acc[8];
    float ss = 0.f;
#pragma unroll
    for (int vt = 0; vt < 8; ++vt) {
        f32x4 a = (f32x4){0.f, 0.f, 0.f, 0.f};
        a = __builtin_amdgcn_mfma_f32_16x16x32_bf16(*(const bf16x8*)(VT + tile_off(vt * 16 + fr, fq)), pf[0], a, 0, 0, 0);
        a = __builtin_amdgcn_mfma_f32_16x16x32_bf16(*(const bf16x8*)(VT + tile_off(vt * 16 + fr, 4 + fq)), pf[1], a, 0, 0, 0);
        a = __builtin_amdgcn_mfma_f32_16x16x32_bf16(*(const bf16x8*)(PT + tile_off(vt * 16 + fr, fq)), qf0, a, 0, 0, 0);
        a = __builtin_amdgcn_mfma_f32_16x16x32_bf16(*(const bf16x8*)(PT + tile_off(vt * 16 + fr, 4 + fq)), qf1, a, 0, 0, 0);
        acc[vt] = a;
        ss += a[0] * a[0] + a[1] * a[1] + a[2] * a[2] + a[3] * a[3];
    }
    ss += __shfl_xor(ss, 16); ss += __shfl_xor(ss, 32);
    const float r = rsqrtf(ss * (1.0f / 128.0f) + 1e-6f);
    const size_t row = row0 + c;
#pragma unroll
    for (int vt = 0; vt < 8; ++vt) {
        const int col = h * 128 + vt * 16 + 4 * fq;
        const uint2 rr = *(const uint2*)(proj + row * PP + RB + col);
        const f32x4 g4 = *(const f32x4*)(norm_g + col);
        const float r0 = __uint_as_float(rr.x << 16), r1 = __uint_as_float(rr.x & 0xFFFF0000u), r2 = __uint_as_float(rr.y << 16), r3 = __uint_as_float(rr.y & 0xFFFF0000u);
        f32x4 o;
        o[0] = acc[vt][0] * r * g4[0] * (r0 * sigmoidf_(r0)); o[1] = acc[vt][1] * r * g4[1] * (r1 * sigmoidf_(r1));
        o[2] = acc[vt][2] * r * g4[2] * (r2 * sigmoidf_(r2)); o[3] = acc[vt][3] * r * g4[3] * (r3 * sigmoidf_(r3));
        *(uint2*)(yb + row * 512 + col) = pack4(o);
    }
}

constexpr int SMEM_BYTES = 131072;

__global__ void __launch_bounds__(512, 2) k_fwd(Params p) {
    extern __shared__ __attribute__((aligned(16))) char smem_dyn[];
    char* smem = smem_dyn + 16;
    char* smh = smem + (threadIdx.x >> 8) * 65536;
    if (threadIdx.x == 0) *(uint4*)smem_dyn = make_uint4(0u, 0u, 0u, 0u);
    __syncthreads();
    char* ws = p.ws;
    XcdBarrier bar = xcd_barrier_post((unsigned*)(ws + OFF_BAR), (volatile LAS unsigned*)smem_dyn);
    int* ctrl = (int*)(ws + OFF_CTRL);
    bf16_t* proj = (bf16_t*)(ws + OFF_PROJ);
    float* bc = (float*)(ws + OFF_BC);
    float* cstate = (float*)(ws + OFF_CSTATE);
    bf16_t* mrg = (bf16_t*)(ws + OFF_MRG);
    bf16_t* h2 = (bf16_t*)(ws + OFF_H2);
    bf16_t* hid = (bf16_t*)(ws + OFF_HID);
    bf16_t* Y0 = (bf16_t*)(ws + OFF_Y0);
    bf16_t* Y1 = (bf16_t*)(ws + OFF_Y1);
    bf16_t* ya = (bf16_t*)(ws + OFF_YA);
    bf16_t* yb = (bf16_t*)(ws + OFF_YB);
    bf16_t* kcb = (bf16_t*)(ws + OFF_KCB);
    bf16_t* vcb = (bf16_t*)(ws + OFF_VCB);
    bf16_t* h = (bf16_t*)p.out;
    const int G = gridDim.x;

    ph_prep(p, smh);
    xcd_barrier(bar);
    { g8::StaticOrder S; S.init(T, 3072, G, (int)blockIdx.x); const g8::AddrPlain AD{(const char*)h, (const char*)(ws + OFF_WINT), 2048u, 2048u, 16};
      g8::gemm_phase(smem, S, AD, g8::EpiProj{proj}); }
    xcd_barrier(bar);
    ph_cmp1(proj, ws, smh);
    {
        const int nc = G > 32 ? 16 : 0, gb = (int)blockIdx.x - nc, gs = G - nc;
        if (gb >= 0) {
            for (int pr = gb; pr < 512; pr += gs) vtrans_tile(2 * pr + HB_ID, proj, ws, smh);
            for (int pr = gb; pr < 512; pr += gs) gla_a_unit(2 * pr + HB_ID, proj, p.w_alpha, p.b_alpha, bc, cstate, smh);
        }
    }
    xcd_barrier(bar);
    ph_cmp2(ws, ws, smh);
    for (int vb = blockIdx.x; vb < 256; vb += G) gla_scan_vb2(vb, bc, cstate);
    ph_prep_experts(p, smh);
    xcd_barrier(bar);
    for (int vb = HB_FIRST; vb < 1024; vb += HB_STEP) gla_c_unit(vb, proj, bc, cstate, p.norm_g, yb, smh);
    for (int r = 0; r * G < 512; ++r) {
        const int u = r * G + ((r & 1) ? (G - 1 - (int)blockIdx.x) : (int)blockIdx.x);
        if (u < 512) nsa_unit(u, proj, ws, p.rel_bias, ya, smem);
    }
    xcd_barrier(bar);
    {
        g8::MergeOrder MO; MO.so.init(T, 1024, G, (int)blockIdx.x);
        const g8::AddrMerge AD{(const char*)h, (const char*)(ws + OFF_WINT), (const char*)ya, (const char*)yb, (const char*)(ws + OFF_WAT), (const char*)(ws + OFF_WBT)};
        g8::gemm_phase(smem, MO, AD, g8::EpiMergeAll{mrg, (bf16_t*)(ws + OFF_R1)});
    }
    xcd_barrier(bar);
    { g8::StaticOrder S; S.init(T, 1024, G, (int)blockIdx.x); const g8::AddrPlain AD{(const char*)mrg, (const char*)(ws + OFF_WOT), 2048u, 2048u, 16};
      g8::gemm_phase(smem, S, AD, g8::EpiResid{p.x, p.out}); }
    xcd_barrier(bar);
    for (int grp = HB_FIRST; grp < 512; grp += HB_STEP) {
        for (int tt = 0; tt < 2; ++tt) router_unit(grp * 2 + tt, p.out, p.g_ffn, (const bf16_t*)(ws + OFF_WRT), p.b_rg, p.b_re, h2, (float*)(ws + OFF_RSTD), smh);
        router_append(grp, (int*)(ws + OFF_LTOK), (float*)(ws + OFF_LW), ctrl, smh);
    }
    xcd_barrier(bar);
    ph_moe1(h2, (const bf16_t*)(ws + OFF_WGT), (const bf16_t*)(ws + OFF_WUT), ctrl, (const int*)(ws + OFF_LTOK), (const float*)(ws + OFF_LW), (const float*)(ws + OFF_RSTD), hid, smh);
    ph_prep_experts_down(p, ctrl, smh);
    xcd_barrier(bar);
    ph_moe2(hid, (const bf16_t*)(ws + OFF_WDT), ctrl, (const int*)(ws + OFF_LTOK), Y0, smh);
    xcd_barrier(bar);
    { int t_ = threadIdx.x; asm volatile("" : "+v"(t_)); for (int row = blockIdx.x * 8 + (t_ >> 6); row < T; row += G * 8) final_row(row, p.out, Y0, Y1, p.g_final, t_ & 63); }
}

extern "C" void kernel_launch(void* const* d_in, const int* in_sizes, int n_in, void* d_out, int out_size, void* d_ws, size_t ws_size, hipStream_t stream) {
    static int grid = 0;
    constexpr int kDynLds = SMEM_BYTES + 16;
    if (!grid) {
        int dev = 0, cus = 0, per_cu = 0;
        (void)hipGetDevice(&dev);
        (void)hipDeviceGetAttribute(&cus, hipDeviceAttributeMultiprocessorCount, dev);
        (void)hipFuncSetAttribute((const void*)k_fwd, hipFuncAttributeMaxDynamicSharedMemorySize, kDynLds);
        (void)hipOccupancyMaxActiveBlocksPerMultiprocessor(&per_cu, k_fwd, 512, kDynLds);
        if (per_cu > 1) per_cu = 1;
        if (per_cu < 1) per_cu = 1;
        grid = cus * per_cu;
    }
    char* ws = (char*)d_ws;
    (void)hipMemsetAsync(ws + OFF_CTRL, 0, 16384, stream);
    (void)hipMemsetAsync(ws + OFF_BAR, 0, 16384, stream);
    Params p{};
    const float** pf = (const float**)&p;
    for (int i = 0; i < 25; ++i) pf[i] = (const float*)d_in[i];
    p.out = (float*)d_out; p.ws = ws;
    k_fwd<<<grid, 512, kDynLds, stream>>>(p);
}
```

```cpp
#include <hip/hip_runtime.h>
#include <stdint.h>

typedef unsigned short bf16_t;
typedef short bf16x8 __attribute__((ext_vector_type(8)));
typedef float f32x4 __attribute__((ext_vector_type(4)));
typedef unsigned u32x4 __attribute__((ext_vector_type(4)));
__device__ __forceinline__ float bf2f(bf16_t v) { return __uint_as_float(((unsigned)v) << 16); }
__device__ __forceinline__ bf16_t f2bf(float f) { unsigned u = __float_as_uint(f); u += 0x7FFFu + ((u >> 16) & 1u); return (bf16_t)(u >> 16); }
__device__ __forceinline__ unsigned pack_bf16(float lo, float hi) { unsigned r; asm volatile("v_cvt_pk_bf16_f32 %0, %1, %2" : "=v"(r) : "v"(lo), "v"(hi)); return r; }

constexpr int Bn = 4, S = 4096, T = Bn * S, D = 1024, NIN = 4904, PP = 2880;
constexpr int QA = 0, KC = 512, VC = 640, KS = 768, VS = 896, KW = 1024, VW = 1152, GA = 1280, QB = 1304, KB = 1560, VB = 1816, AB = 2328, RB = 2344, MGA = 2856, MGB = 3880;
constexpr int NPROJ = 2856;
constexpr int MSLOT = 36864;

constexpr size_t OFF_CTRL = 0;
constexpr size_t OFF_BAR = 16384;
constexpr size_t OFF_ROUTE_E = 32768;
constexpr size_t OFF_ROUTE_W = OFF_ROUTE_E + 32768 * 4;
constexpr size_t OFF_SLOT_TOK = OFF_ROUTE_W + 32768 * 4;
constexpr size_t OFF_SLOT_W = OFF_SLOT_TOK + (size_t)MSLOT * 4;
constexpr size_t OFF_BIAS1 = OFF_SLOT_W + (size_t)MSLOT * 4;
constexpr size_t OFF_RSTD = OFF_BIAS1 + 1024;
constexpr size_t OFF_SLOT_RS = OFF_RSTD + (size_t)T * 4;
constexpr size_t OFF_WRT = OFF_SLOT_RS + (size_t)MSLOT * 4;
static_assert(OFF_WRT + 2 * 48 * 1024 * 2 <= (1u << 20), "ctrl overflow");
constexpr size_t OFF_R1 = 1u << 20;
constexpr size_t SZ_PROJ = (size_t)T * PP * 2;
constexpr size_t OFF_PROJ = OFF_R1;
constexpr size_t OFF_BC = OFF_PROJ + SZ_PROJ;
constexpr size_t OFF_CSTATE = OFF_BC + (size_t)T * 256 * 4;
constexpr size_t OFF_R1_END = OFF_CSTATE + (size_t)1024 * 8192 * 4;
constexpr size_t OFF_MRG = OFF_R1 + (size_t)T * 2048 * 2;
constexpr size_t OFF_H2 = OFF_R1;
constexpr size_t OFF_HID = OFF_H2 + (size_t)T * 1024 * 2;
constexpr size_t OFF_Y0 = OFF_HID + (size_t)2 * T * 256 * 2;
constexpr size_t OFF_Y1 = OFF_Y0 + (size_t)T * 1024 * 2;
static_assert(OFF_MRG + (size_t)T * 1024 * 2 <= OFF_R1_END, "alias overflow");
static_assert(OFF_Y1 + (size_t)T * 1024 * 2 <= OFF_R1_END, "alias overflow");
constexpr size_t OFF_YA = OFF_R1_END;
constexpr size_t OFF_YB = OFF_YA + (size_t)T * 512 * 2;
constexpr size_t OFF_KCB = OFF_YB + (size_t)T * 512 * 2;
constexpr size_t OFF_VCB = OFF_KCB + 8 * 256 * 64 * 2;
constexpr size_t OFF_VCBT = OFF_VCB + 8 * 256 * 64 * 2;
constexpr size_t OFF_HIDC = OFF_VCBT + 8 * 256 * 64 * 2;
constexpr size_t OFF_VST = OFF_HIDC + 2 * 2048 * 128 * 2;
constexpr size_t OFF_VWT = OFF_VST + (size_t)8 * 64 * S * 2;
constexpr size_t OFF_WINT = OFF_VWT + (size_t)8 * 64 * S * 2;
constexpr size_t OFF_CK1T = OFF_WINT + (size_t)NIN * 1024 * 2;
constexpr size_t OFF_CV1T = OFF_CK1T + 128 * 2048 * 2;
constexpr size_t OFF_CK2T = OFF_CV1T + 128 * 2048 * 2;
constexpr size_t OFF_CV2T = OFF_CK2T + 128 * 128 * 2;
constexpr size_t OFF_WAT = OFF_CV2T + 128 * 128 * 2;
constexpr size_t OFF_WBT = OFF_WAT + 1024 * 512 * 2;
constexpr size_t OFF_WOT = OFF_WBT + 1024 * 512 * 2;
constexpr size_t OFF_WGT = OFF_WOT + 1024 * 1024 * 2;
constexpr size_t OFF_WUT = OFF_WGT + (size_t)32 * 256 * 1024 * 2;
constexpr size_t OFF_WDT = OFF_WUT + (size_t)32 * 256 * 1024 * 2;
constexpr size_t OFF_LTOK = OFF_WDT + (size_t)32 * 1024 * 256 * 2;
constexpr size_t OFF_LW = OFF_LTOK + (size_t)32 * 16384 * 4;
constexpr size_t OFF_END = OFF_LW + (size_t)32 * 16384 * 4;
static_assert(OFF_END <= (size_t)256 << 20, "workspace overflow");

#define XB_TMO      128
#define XB_XCNT(j)  (256  + 64 * (j))
#define XB_XSUB(j)  (1280 + 64 * (j))
#define XB_XGEN(j)  (2304 + 64 * (j))
#define XB_TOP      3328
#define XB_TOPGEN   3392
#define XCD_BAR_WORDS 3456
#define XB_SPIN_CAP (1u << 18)
#define LAS __attribute__((address_space(3)))

__device__ __forceinline__ unsigned xb_ld(unsigned* p)              { return __hip_atomic_load(p, __ATOMIC_RELAXED, __HIP_MEMORY_SCOPE_AGENT); }
__device__ __forceinline__ unsigned xb_add(unsigned* p, unsigned v) { return __hip_atomic_fetch_add(p, v, __ATOMIC_RELAXED, __HIP_MEMORY_SCOPE_AGENT); }
__device__ __forceinline__ unsigned xb_xcc_id() { return (unsigned)__builtin_amdgcn_s_getreg((3 << 11) | 20) & 0xFu; }
#define XB_SPIN(cond, bar) do { unsigned _sp = 0; while (cond) { __builtin_amdgcn_s_sleep(1); \
    if ((++_sp & 255u) == 0u) { if (xb_ld(&(bar)[XB_TMO])) break; if (_sp > XB_SPIN_CAP) { atomicAdd(&(bar)[XB_TMO], 1u); break; } } } } while (0)

struct XcdBarrier { unsigned* bar; unsigned x; volatile LAS unsigned* st; };

__device__ __forceinline__ XcdBarrier xcd_barrier_post(unsigned* bar, volatile LAS unsigned* st) {
    XcdBarrier b; b.bar = bar; b.x = xb_xcc_id(); b.st = st;
    if (threadIdx.x == 0) (void)xb_add(&bar[XB_XCNT(b.x)], 1u);
    return b;
}
__device__ __forceinline__ void xcd_barrier_complete(unsigned* bar, unsigned x, unsigned& nloc, unsigned& nx) {
    const unsigned G = gridDim.x * gridDim.y * gridDim.z;
    unsigned sum, cnt, mine, sp = 0u;
    for (;;) {
        sum = 0u; cnt = 0u; mine = 0u;
#pragma unroll
        for (unsigned j = 0; j < 16; ++j) { const unsigned c = xb_ld(&bar[XB_XCNT(j)]); sum += c; cnt += (c > 0u) ? 1u : 0u; mine = (j == x) ? c : mine; }
        if (sum == G) break;
        __builtin_amdgcn_s_sleep(1);
        if ((++sp & 255u) == 0u) { if (xb_ld(&bar[XB_TMO])) break; if (sp > XB_SPIN_CAP) { atomicAdd(&bar[XB_TMO], 1u); break; } }
    }
    nloc = mine > 0u ? mine : 1u; nx = cnt > 0u ? cnt : 1u;
}
__device__ __forceinline__ void xcd_barrier(const XcdBarrier& b) {
    asm volatile("s_waitcnt vmcnt(0)" ::: "memory");
    __syncthreads();
    if (threadIdx.x == 0) {
        unsigned* bar = b.bar;
        __builtin_amdgcn_s_waitcnt(0);
        unsigned nloc = b.st[0], nx = b.st[1];
        if (nloc == 0u) { xcd_barrier_complete(bar, b.x, nloc, nx); b.st[0] = nloc; b.st[1] = nx; }
        const unsigned old = xb_add(&bar[XB_XSUB(b.x)], 1u);
        const unsigned gen = old / nloc;
        if (old + 1u == (gen + 1u) * nloc) {
            __builtin_amdgcn_fence(__ATOMIC_RELEASE, "agent");
            asm volatile("s_waitcnt vmcnt(0)" ::: "memory");
            const unsigned og = xb_add(&bar[XB_TOP], 1u);
            const unsigned tg = og / nx;
            if (og + 1u == (tg + 1u) * nx) xb_add(&bar[XB_TOPGEN], 1u);
            else XB_SPIN(xb_ld(&bar[XB_TOPGEN]) == tg, bar);
            __builtin_amdgcn_fence(__ATOMIC_ACQUIRE, "agent");
            xb_add(&bar[XB_XGEN(b.x)], 1u);
            asm volatile("s_waitcnt vmcnt(0)" ::: "memory");
        } else {
            XB_SPIN(xb_ld(&bar[XB_XGEN(b.x)]) == gen, bar);
            __builtin_amdgcn_fence(__ATOMIC_ACQUIRE, "agent");
            asm volatile("s_waitcnt vmcnt(0)" ::: "memory");
        }
    }
    __syncthreads();
}


__device__ __forceinline__ int hb_tid_() { int t = threadIdx.x; asm volatile("" : "+v"(t)); return t & 255; }
#define HB_TID (hb_tid_())
#define HB_ID ((int)(threadIdx.x >> 8))
#define HB_FIRST (2 * (int)blockIdx.x + HB_ID)
#define HB_STEP (2 * (int)gridDim.x)
struct Params {
    const float *x, *g_mix, *w_in, *pe_k, *ck1, *ck2, *pe_v, *cv1, *cv2, *rel_bias, *w_alpha, *b_alpha, *norm_g, *w_ba, *w_bb, *w_out, *g_ffn,
                *w_rg, *b_rg, *w_re, *b_re, *w_eg, *w_eu, *w_ed, *g_final;
    float* out; char* ws;
};

__device__ __forceinline__ float wave_max(float v) { for (int o = 32; o > 0; o >>= 1) v = fmaxf(v, __shfl_xor(v, o)); return v; }
__device__ __forceinline__ float wave_sum(float v) { for (int o = 32; o > 0; o >>= 1) v += __shfl_xor(v, o); return v; }
__device__ __forceinline__ void wave_lds_sync() { asm volatile("s_waitcnt lgkmcnt(0)" ::: "memory"); }


__device__ __forceinline__ void rms_h_row(int row, const float* __restrict__ x, const float* __restrict__ g, bf16_t* __restrict__ h, int lane) {
    const float* xr = x + (size_t)row * D + lane * 4;
    f32x4 v[4]; float s = 0.f;
#pragma unroll
    for (int i = 0; i < 4; ++i) { v[i] = *(const f32x4*)(xr + 256 * i); s += v[i][0] * v[i][0] + v[i][1] * v[i][1] + v[i][2] * v[i][2] + v[i][3] * v[i][3]; }
    s = wave_sum(s);
    const float r = rsqrtf(s * (1.0f / D) + 1e-6f);
#pragma unroll
    for (int i = 0; i < 4; ++i) {
        const f32x4 gg = *(const f32x4*)(g + lane * 4 + 256 * i);
        uint2 o; o.x = pack_bf16(v[i][0] * r * gg[0], v[i][1] * r * gg[1]); o.y = pack_bf16(v[i][2] * r * gg[2], v[i][3] * r * gg[3]);
        *(uint2*)(h + (size_t)row * D + lane * 4 + 256 * i) = o;
    }
}
__device__ __forceinline__ void final_row(int row, float* __restrict__ x2out, const bf16_t* __restrict__ Y0, const bf16_t* __restrict__ Y1, const float* __restrict__ g, int lane) {
    float* xr = x2out + (size_t)row * D + lane * 4;
    f32x4 v[4]; float s = 0.f;
#pragma unroll
    for (int i = 0; i < 4; ++i) {
        v[i] = *(const f32x4*)(xr + 256 * i);
        const uint2 a = *(const uint2*)(Y0 + (size_t)row * D + lane * 4 + 256 * i), c = *(const uint2*)(Y1 + (size_t)row * D + lane * 4 + 256 * i);
        v[i][0] += __uint_as_float(a.x << 16) + __uint_as_float(c.x << 16);
        v[i][1] += __uint_as_float(a.x & 0xFFFF0000u) + __uint_as_float(c.x & 0xFFFF0000u);
        v[i][2] += __uint_as_float(a.y << 16) + __uint_as_float(c.y << 16);
        v[i][3] += __uint_as_float(a.y & 0xFFFF0000u) + __uint_as_float(c.y & 0xFFFF0000u);
        s += v[i][0] * v[i][0] + v[i][1] * v[i][1] + v[i][2] * v[i][2] + v[i][3] * v[i][3];
    }
    s = wave_sum(s);
    const float r = rsqrtf(s * (1.0f / D) + 1e-6f);
#pragma unroll
    for (int i = 0; i < 4; ++i) {
        const f32x4 gg = *(const f32x4*)(g + lane * 4 + 256 * i);
        *(f32x4*)(xr + 256 * i) = (f32x4){v[i][0] * r * gg[0], v[i][1] * r * gg[1], v[i][2] * r * gg[2], v[i][3] * r * gg[3]};
    }
}

__device__ __forceinline__ void prep_router_w(const float* __restrict__ w_rg, const float* __restrict__ w_re, bf16_t* __restrict__ WrT) {
    for (int idx = blockIdx.x * 512 + threadIdx.x; idx < 48 * 1024; idx += gridDim.x * 512) {
        const int n = idx >> 10, k = idx & 1023;
        const float w = n < 4 ? w_rg[k * 4 + n] : (n < 36 ? w_re[k * 32 + n - 4] : 0.f);
        const bf16_t hi = f2bf(w);
        WrT[idx] = hi; WrT[48 * 1024 + idx] = f2bf(w - bf2f(hi));
    }
}

__device__ __forceinline__ void router_unit(int task, const float* __restrict__ x2, const float* __restrict__ g, const bf16_t* __restrict__ WrT,
                                            const float* __restrict__ b_rg, const float* __restrict__ b_re, bf16_t* __restrict__ h2, float* __restrict__ rstd_out,
                                            char* smem) {
    float (*part)[16][49] = (float (*)[16][49])smem;
    int* dec_e = (int*)(smem + 14336); float* dec_w = (float*)(smem + 14336 + 512);
    float (*ssp)[16] = (float (*)[16])(smem + 4 * 16 * 49 * 4);
    const int tid = HB_TID, lane = tid & 63, w4 = tid >> 6, fr = lane & 15, fq = lane >> 4, r0 = task * 16;
    const float* xr = x2 + (size_t)(r0 + fr) * D + fq * 8 + w4 * 256;
    bf16_t* hr = h2 + (size_t)(r0 + fr) * D + fq * 8 + w4 * 256;
    const bf16_t* wh = WrT + (size_t)fr * 1024 + fq * 8 + w4 * 256;
    const float* gp = g + fq * 8 + w4 * 256;
    f32x4 acc[3];
#pragma unroll
    for (int nt = 0; nt < 3; ++nt) acc[nt] = (f32x4){0.f, 0.f, 0.f, 0.f};
    float ssq = 0.f;
#pragma unroll 4
    for (int ks = 0; ks < 8; ++ks) {
        const f32x4 x0 = *(const f32x4*)(xr + ks * 32), x1 = *(const f32x4*)(xr + ks * 32 + 4);
        const f32x4 g0 = *(const f32x4*)(gp + ks * 32), g1 = *(const f32x4*)(gp + ks * 32 + 4);
        float xg[8];
#pragma unroll
        for (int e = 0; e < 4; ++e) { xg[e] = x0[e] * g0[e]; xg[4 + e] = x1[e] * g1[e]; ssq += x0[e] * x0[e] + x1[e] * x1[e]; }
        u32x4 hi, lo;
#pragma unroll
        for (int e = 0; e < 4; ++e) {
            hi[e] = pack_bf16(xg[2 * e], xg[2 * e + 1]);
            lo[e] = pack_bf16(xg[2 * e] - __uint_as_float(hi[e] << 16), xg[2 * e + 1] - __uint_as_float(hi[e] & 0xFFFF0000u));
        }
        *(u32x4*)(hr + ks * 32) = hi;
        const bf16x8 ah = __builtin_bit_cast(bf16x8, hi), al = __builtin_bit_cast(bf16x8, lo);
#pragma unroll
        for (int nt = 0; nt < 3; ++nt) {
            const bf16x8 bh = *(const bf16x8*)(wh + (size_t)nt * 16 * 1024 + ks * 32), bl = *(const bf16x8*)(wh + (size_t)(48 + nt * 16) * 1024 + ks * 32);
            acc[nt] = __builtin_amdgcn_mfma_f32_16x16x32_bf16(ah, bh, acc[nt], 0, 0, 0);
            acc[nt] = __builtin_amdgcn_mfma_f32_16x16x32_bf16(al, bh, acc[nt], 0, 0, 0);
            acc[nt] = __builtin_amdgcn_mfma_f32_16x16x32_bf16(ah, bl, acc[nt], 0, 0, 0);
        }
    }
    ssq += __shfl_xor(ssq, 16); ssq += __shfl_xor(ssq, 32);
    __syncthreads();
    if (fq == 0) ssp[w4][fr] = ssq;
#pragma unroll
    for (int nt = 0; nt < 3; ++nt)
#pragma unroll
        for (int i = 0; i < 4; ++i) part[w4][4 * fq + i][nt * 16 + fr] = acc[nt][i];
    __syncthreads();
    if (tid < 16) {
        const int row = r0 + tid;
        const float rsv = rsqrtf((ssp[0][tid] + ssp[1][tid] + ssp[2][tid] + ssp[3][tid]) * (1.0f / D) + 1e-6f);
        rstd_out[row] = rsv;
        float l4[4];
#pragma unroll
        for (int j = 0; j < 4; ++j) l4[j] = (part[0][tid][j] + part[1][tid][j] + part[2][tid][j] + part[3][tid][j]) * rsv + b_rg[j];
        int gs = 0; float mx = l4[0];
#pragma unroll
        for (int j = 1; j < 4; ++j) if (l4[j] > mx) { mx = l4[j]; gs = j; }
        float den = 0.f;
#pragma unroll
        for (int j = 0; j < 4; ++j) den += __expf(l4[j] - mx);
        const float gpb = 1.f / den;
        float v0 = -3e38f, v1 = -3e38f; int i0 = 0, i1 = 0;
        for (int j = 0; j < 8; ++j) {
            const int c = 4 + gs * 8 + j;
            const float l = (part[0][tid][c] + part[1][tid][c] + part[2][tid][c] + part[3][tid][c]) * rsv + b_re[gs * 8 + j];
            if (l > v0) { v1 = v0; i1 = i0; v0 = l; i0 = j; }
            else if (l > v1) { v1 = l; i1 = j; }
        }
        const float e1 = __expf(v1 - v0);
        const int lr = (task & 1) * 16 + tid;
        dec_e[lr * 2] = gs * 8 + i0; dec_e[lr * 2 + 1] = gs * 8 + i1;
        dec_w[lr * 2] = gpb / (1.f + e1); dec_w[lr * 2 + 1] = gpb * e1 / (1.f + e1);
    }
}
__device__ __forceinline__ void router_append(int group, int* __restrict__ ltok, float* __restrict__ lw, int* __restrict__ cnt, char* smem) {
    int* dec_e = (int*)(smem + 14336); float* dec_w = (float*)(smem + 14336 + 512);
    int* hist = (int*)(smem + 14336 + 1024); int* base = hist + 32;
    const int tid = HB_TID;
    if (tid < 32) hist[tid] = 0;
    __syncthreads();
    int e = 0, lpos = 0;
    if (tid < 64) { e = dec_e[tid]; lpos = atomicAdd(&hist[e], 1); }
    __syncthreads();
    if (tid < 32) { const int hcount = hist[tid]; base[tid] = hcount ? atomicAdd(&cnt[tid * 64], hcount) : 0; }
    __syncthreads();
    if (tid < 64) { const int pos = e * 16384 + base[e] + lpos; ltok[pos] = (group * 32 + (tid >> 1)) * 2 + (tid & 1); lw[pos] = dec_w[tid]; }
    __syncthreads();
}

__device__ __forceinline__ void transpose_tile(const float* __restrict__ src, int ld_src, int N, bf16_t* __restrict__ dst, int ld_dst, int kt, int nt, char* smem) {
    float (*tl)[65] = (float (*)[65])smem;
    const int tid = HB_TID;
    const int c4 = (tid & 15) * 4, r0 = tid >> 4;
#pragma unroll
    for (int i = 0; i < 4; ++i) {
        const int k = r0 + 16 * i, n = nt * 64 + c4;
        float4 v = make_float4(0.f, 0.f, 0.f, 0.f);
        if (n < N) v = *(const float4*)(src + (size_t)(kt * 64 + k) * ld_src + n);
        tl[k][c4] = v.x; tl[k][c4 + 1] = v.y; tl[k][c4 + 2] = v.z; tl[k][c4 + 3] = v.w;
    }
    __syncthreads();
    const int kc = (tid & 7) * 8, n0 = tid >> 3;
#pragma unroll
    for (int i = 0; i < 2; ++i) {
        const int nl = n0 + 32 * i, n = nt * 64 + nl;
        if (n < N) {
            uint4 o;
            o.x = pack_bf16(tl[kc][nl], tl[kc + 1][nl]); o.y = pack_bf16(tl[kc + 2][nl], tl[kc + 3][nl]);
            o.z = pack_bf16(tl[kc + 4][nl], tl[kc + 5][nl]); o.w = pack_bf16(tl[kc + 6][nl], tl[kc + 7][nl]);
            *(uint4*)(dst + (size_t)n * ld_dst + kt * 64 + kc) = o;
        }
    }
    __syncthreads();
}

__device__ __forceinline__ void ph_prep_experts(const Params& p, char* smem) {
    char* ws = p.ws;
    for (int t = HB_FIRST; t < 4096; t += HB_STEP) {
        const int e = (t & 2047) >> 6, r = t & 63;
        if (t < 2048) transpose_tile(p.w_eg + (size_t)e * 1024 * 256, 256, 256, (bf16_t*)(ws + OFF_WGT) + (size_t)e * 256 * 1024, 1024, r >> 2, r & 3, smem);
        else transpose_tile(p.w_eu + (size_t)e * 1024 * 256, 256, 256, (bf16_t*)(ws + OFF_WUT) + (size_t)e * 256 * 1024, 1024, r >> 2, r & 3, smem);
    }
}
__device__ __forceinline__ int moe_tile_decode(const int* __restrict__ cnt, int t, int& e, int& i);
__device__ __forceinline__ void ph_prep_experts_down(const Params& p, const int* __restrict__ cnt, char* smem) {
    char* ws = p.ws;
    int e_, ti_; const int nu = moe_tile_decode(cnt, 0, e_, ti_) * 4, rem = nu % HB_STEP, k = HB_FIRST - rem, st = HB_STEP - rem;
    if (k < 0) return;
    for (int t = k; t < 2048; t += st) {
        const int e = t >> 6, r = t & 63;
        transpose_tile(p.w_ed + (size_t)e * 256 * 1024, 1024, 1024, (bf16_t*)(ws + OFF_WDT) + (size_t)e * 1024 * 256, 256, r >> 4, r & 15, smem);
    }
}
__device__ __forceinline__ void ph_prep(const Params& p, char* smem) {
    char* ws = p.ws;
    constexpr int N0 = 16 * 77, N1 = N0 + 64, N2 = N1 + 64, N3 = N2 + 2, N4 = N3 + 2, N5 = N4 + 128, N6 = N5 + 128, N7 = N6 + 256;
    for (int t = HB_FIRST; t < N7; t += HB_STEP) {
        if (t < N0) transpose_tile(p.w_in, NIN, NIN, (bf16_t*)(ws + OFF_WINT), 1024, t / 77, t % 77, smem);
        else if (t < N1) { const int q = t - N0; transpose_tile(p.ck1, 128, 128, (bf16_t*)(ws + OFF_CK1T), 2048, q >> 1, q & 1, smem); }
        else if (t < N2) { const int q = t - N1; transpose_tile(p.cv1, 128, 128, (bf16_t*)(ws + OFF_CV1T), 2048, q >> 1, q & 1, smem); }
        else if (t < N3) { const int q = t - N2; transpose_tile(p.ck2, 64, 64, (bf16_t*)(ws + OFF_CK2T), 128, q, 0, smem); }
        else if (t < N4) { const int q = t - N3; transpose_tile(p.cv2, 64, 64, (bf16_t*)(ws + OFF_CV2T), 128, q, 0, smem); }
        else if (t < N5) { const int q = t - N4; transpose_tile(p.w_ba, 1024, 1024, (bf16_t*)(ws + OFF_WAT), 512, q >> 4, q & 15, smem); }
        else if (t < N6) { const int q = t - N5; transpose_tile(p.w_bb, 1024, 1024, (bf16_t*)(ws + OFF_WBT), 512, q >> 4, q & 15, smem); }
        else { const int q = t - N6; transpose_tile(p.w_out, 1024, 1024, (bf16_t*)(ws + OFF_WOT), 1024, q >> 4, q & 15, smem); }
    }
    for (int t = HB_FIRST; t < 8; t += HB_STEP) {
        const int which = t >> 2, n = (t & 3) * 32 + (HB_TID & 31), ksp = HB_TID >> 5;
        const float* pe = which ? p.pe_v : p.pe_k; const float* w1 = which ? p.cv1 : p.ck1;
        float a = 0.f;
        for (int k = ksp * 256; k < ksp * 256 + 256; ++k) a += pe[k] * w1[(size_t)k * 128 + n];
        float* red = (float*)smem;
        red[HB_TID] = a;
        __syncthreads();
        if (HB_TID < 32) {
            float s = 0.f;
#pragma unroll
            for (int j = 0; j < 8; ++j) s += red[j * 32 + HB_TID];
            ((float*)(ws + OFF_BIAS1))[which * 128 + n] = s;
        }
        __syncthreads();
    }
    prep_router_w(p.w_rg, p.w_re, (bf16_t*)(ws + OFF_WRT));
    for (int row = blockIdx.x * 8 + (threadIdx.x >> 6); row < T; row += gridDim.x * 8) rms_h_row(row, p.x, p.g_mix, (bf16_t*)p.out, threadIdx.x & 63);
}

__device__ __forceinline__ int tile_off(int row, int chunk) { return row * 128 + ((chunk ^ (row & 7)) << 4); }

__device__ __forceinline__ void glds16(const void* g, char* l) {
    __builtin_amdgcn_global_load_lds((const __attribute__((address_space(1))) unsigned*)g, (__attribute__((address_space(3))) unsigned*)l, 16, 0, 0);
}
__device__ __forceinline__ void gemm_kloop(f32x4 (&acc)[4][4], const bf16_t* const (&pa)[4], const bf16_t* const (&pb)[4], int ka, int kb, int nk, char* smem) {
    int tid_ = HB_TID; asm volatile("" : "+v"(tid_));
    const int tid = tid_, lane = tid & 63, wid = tid >> 6, wr = wid >> 1, wc = wid & 1, fr = lane & 15, fq = lane >> 4;
    const int offA = (wr * 64 + fr) * 128, offB = 16384 + (wc * 64 + fr) * 128, x = fr & 7;
    __syncthreads();
#pragma unroll
    for (int i = 0; i < 4; ++i) { glds16(pa[i], smem + i * 4096 + tid * 16); glds16(pb[i], smem + 16384 + i * 4096 + tid * 16); }
    asm volatile("s_waitcnt vmcnt(0)" ::: "memory");
    __syncthreads();
    for (int kt = 0; kt < nk; ++kt) {
        const int cur = kt & 1;
        if (kt + 1 < nk) {
            char* st = smem + (cur ^ 1) * 32768 + tid * 16;
#pragma unroll
            for (int i = 0; i < 4; ++i) { glds16(pa[i] + (size_t)(kt + 1) * ka, st + i * 4096); glds16(pb[i] + (size_t)(kt + 1) * kb, st + 16384 + i * 4096); }
        }
        const char* sa = smem + cur * 32768 + offA;
        const char* sb = smem + cur * 32768 + offB;
#pragma unroll
        for (int ks = 0; ks < 2; ++ks) {
            const int ch = ((ks * 4 + fq) ^ x) << 4;
            bf16x8 af[4], bfr[4];
#pragma unroll
            for (int mi = 0; mi < 4; ++mi) af[mi] = *(const bf16x8*)(sa + mi * 2048 + ch);
#pragma unroll
            for (int ni = 0; ni < 4; ++ni) bfr[ni] = *(const bf16x8*)(sb + ni * 2048 + ch);
#pragma unroll
            for (int mi = 0; mi < 4; ++mi)
#pragma unroll
                for (int ni = 0; ni < 4; ++ni) acc[mi][ni] = __builtin_amdgcn_mfma_f32_16x16x32_bf16(bfr[ni], af[mi], acc[mi][ni], 0, 0, 0);
        }
        asm volatile("s_waitcnt vmcnt(0)" ::: "memory");
        __syncthreads();
    }
}
__device__ __forceinline__ void acc_zero(f32x4 (&acc)[4][4]) {
#pragma unroll
    for (int mi = 0; mi < 4; ++mi)
#pragma unroll
        for (int ni = 0; ni < 4; ++ni) acc[mi][ni] = (f32x4){0.f, 0.f, 0.f, 0.f};
}
#define GEMM_LANE_VARS const int tid = HB_TID, lane = tid & 63, wid = tid >> 6, wr = wid >> 1, wc = wid & 1, fr = lane & 15, fq = lane >> 4, lrow = tid >> 3, lch8 = ((tid & 7) ^ ((tid >> 3) & 7)) * 8; (void)wr; (void)wc; (void)fr; (void)fq; (void)lrow; (void)lch8;
__device__ __forceinline__ uint2 pack4(f32x4 v) { uint2 o; o.x = pack_bf16(v[0], v[1]); o.y = pack_bf16(v[2], v[3]); return o; }
__device__ __forceinline__ float sigmoidf_(float a) { return 1.f / (1.f + __expf(-a)); }

__device__ __forceinline__ void ph_cmp1(const bf16_t* __restrict__ proj, const char* ws, char* smem) {
    GEMM_LANE_VARS
    for (int u = HB_FIRST; u < 32; u += HB_STEP) {
        const int which = u >> 4, tm = u & 15;
        const bf16_t* W1T = (const bf16_t*)(ws + (which ? OFF_CV1T : OFF_CK1T));
        const float* bias1 = (const float*)(ws + OFF_BIAS1) + which * 128;
        bf16_t* hid = (bf16_t*)(ws + OFF_HIDC) + (size_t)which * 2048 * 128;
        const int col0 = which ? VC : KC;
        const bf16_t* pa[4]; const bf16_t* pb[4];
#pragma unroll
        for (int i = 0; i < 4; ++i) {
            const int m = tm * 128 + lrow + 32 * i, bg = m >> 8, c = (m & 255) > 254 ? 254 : (m & 255), b = bg >> 1, g = bg & 1;
            pa[i] = proj + (size_t)(b * S + 16 * c) * PP + col0 + g * 64 + lch8;
            pb[i] = W1T + (size_t)(lrow + 32 * i) * 2048 + lch8;
        }
        f32x4 acc[4][4]; acc_zero(acc);
        gemm_kloop(acc, pa, pb, PP, 64, 32, smem);
#pragma unroll
        for (int mi = 0; mi < 4; ++mi)
#pragma unroll
            for (int ni = 0; ni < 4; ++ni) {
                const int m = tm * 128 + wr * 64 + mi * 16 + fr, n = wc * 64 + ni * 16 + 4 * fq;
                f32x4 v = acc[mi][ni];
#pragma unroll
                for (int j = 0; j < 4; ++j) { const float a = v[j] + bias1[n + j]; const float t = 0.7978845608028654f * (a + 0.044715f * a * a * a); v[j] = 0.5f * a * (1.f + tanhf(t)); }
                *(uint2*)(hid + (size_t)m * 128 + n) = pack4(v);
            }
    }
}

__device__ __forceinline__ void ph_cmp2(const char* ws_c, char* ws, char* smem) {
    GEMM_LANE_VARS
    for (int u = HB_FIRST; u < 32; u += HB_STEP) {
        const int which = u >> 4, tm = u & 15;
        const bf16_t* W2T = (const bf16_t*)(ws_c + (which ? OFF_CV2T : OFF_CK2T));
        const bf16_t* hid = (const bf16_t*)(ws_c + OFF_HIDC) + (size_t)which * 2048 * 128;
        const bf16_t* pa[4]; const bf16_t* pb[4];
#pragma unroll
        for (int i = 0; i < 4; ++i) { pa[i] = hid + (size_t)(tm * 128 + lrow + 32 * i) * 128 + lch8; pb[i] = W2T + (size_t)(lrow + 32 * i) * 128 + lch8; }
        f32x4 acc[4][4]; acc_zero(acc);
        gemm_kloop(acc, pa, pb, 64, 64, 2, smem);
        if (wc == 0) {
            bf16_t* outp = (bf16_t*)(ws + (which ? OFF_VCB : OFF_KCB));
            bf16_t* outT = (bf16_t*)(ws + OFF_VCBT);
#pragma unroll
            for (int mi = 0; mi < 4; ++mi)
#pragma unroll
                for (int ni = 0; ni < 4; ++ni) {
                    const int m = tm * 128 + wr * 64 + mi * 16 + fr, n = ni * 16 + 4 * fq, c = m & 255, bg = m >> 8;
                    f32x4 v = acc[mi][ni];
                    if (c == 255) v = (f32x4){0.f, 0.f, 0.f, 0.f};
                    *(uint2*)(outp + (size_t)m * 64 + n) = pack4(v);
                    if (which) {
#pragma unroll
                        for (int j = 0; j < 4; ++j) outT[((size_t)bg * 64 + n + j) * 256 + c] = f2bf(v[j]);
                    }
                }
        }
    }
}

__device__ __forceinline__ int moe_tile_decode(const int* __restrict__ cnt, int t, int& e, int& i) {
    int acc = 0; e = 0; i = 0;
    for (int ee = 0; ee < 32; ++ee) { const int nt = (cnt[ee * 64] + 127) >> 7; if (t >= acc && t < acc + nt) { e = ee; i = t - acc; } acc += nt; }
    return acc;
}

__device__ __forceinline__ void ph_moe1(const bf16_t* __restrict__ h2, const bf16_t* __restrict__ WgT, const bf16_t* __restrict__ WuT, const int* __restrict__ cnt,
                                        const int* __restrict__ ltok, const float* __restrict__ lw, const float* __restrict__ rstd, bf16_t* __restrict__ hid, char* smem) {
    GEMM_LANE_VARS
    int e, ti;
    const int nu = moe_tile_decode(cnt, 0, e, ti) * 4;
    for (int u = HB_FIRST; u < nu; u += HB_STEP) {
        const int ft = u & 3;
        (void)moe_tile_decode(cnt, u >> 2, e, ti);
        const int ne = cnt[e * 64];
        const bf16_t* pa[4]; const bf16_t* pb[4];
#pragma unroll
        for (int i = 0; i < 4; ++i) {
            const int rr = lrow + 32 * i, idx = ti * 128 + rr;
            const int tk = idx < ne ? ltok[e * 16384 + idx] : 0;
            pa[i] = h2 + (size_t)(tk >> 1) * 1024 + lch8;
            const int bwc = rr >> 6, bni = (rr >> 4) & 3, bj = rr & 15;
            const int f = ft * 64 + bwc * 32 + (bni >> 1) * 16 + bj;
            pb[i] = ((bni & 1) ? WuT : WgT) + ((size_t)e * 256 + f) * 1024 + lch8;
        }
        f32x4 acc[4][4]; acc_zero(acc);
        gemm_kloop(acc, pa, pb, 64, 64, 16, smem);
#pragma unroll
        for (int mi = 0; mi < 4; ++mi) {
            const int idx = ti * 128 + wr * 64 + mi * 16 + fr;
            if (idx < ne) {
                const int tk = ltok[e * 16384 + idx];
                const float w = lw[e * 16384 + idx], rsv = rstd[tk >> 1];
#pragma unroll
                for (int q = 0; q < 2; ++q) {
                    const int f = ft * 64 + wc * 32 + q * 16 + 4 * fq;
                    f32x4 v;
#pragma unroll
                    for (int j = 0; j < 4; ++j) { const float a = acc[mi][2 * q][j] * rsv, uu = acc[mi][2 * q + 1][j] * rsv; v[j] = a * sigmoidf_(a) * uu * w; }
                    *(uint2*)(hid + (size_t)tk * 256 + f) = pack4(v);
                }
            }
        }
    }
}

__device__ __forceinline__ void ph_moe2(const bf16_t* __restrict__ hid, const bf16_t* __restrict__ WdT, const int* __restrict__ cnt, const int* __restrict__ ltok,
                                        bf16_t* __restrict__ Y, char* smem) {
    GEMM_LANE_VARS
    int e, ti;
    const int nu = moe_tile_decode(cnt, 0, e, ti) * 8;
    for (int u = HB_FIRST; u < nu; u += HB_STEP) {
        const int tn = u & 7;
        (void)moe_tile_decode(cnt, u >> 3, e, ti);
        const int ne = cnt[e * 64];
        const bf16_t* pa[4]; const bf16_t* pb[4];
#pragma unroll
        for (int i = 0; i < 4; ++i) {
            const int idx = ti * 128 + lrow + 32 * i;
            const int tk = idx < ne ? ltok[e * 16384 + idx] : 0;
            pa[i] = hid + (size_t)tk * 256 + lch8;
            pb[i] = WdT + ((size_t)e * 1024 + tn * 128 + lrow + 32 * i) * 256 + lch8;
        }
        f32x4 acc[4][4]; acc_zero(acc);
        gemm_kloop(acc, pa, pb, 64, 64, 4, smem);
#pragma unroll
        for (int mi = 0; mi < 4; ++mi) {
            const int idx = ti * 128 + wr * 64 + mi * 16 + fr;
            if (idx < ne) {
                const int tk = ltok[e * 16384 + idx];
                bf16_t* yr = Y + ((size_t)(tk & 1) * T + (size_t)(tk >> 1)) * 1024 + tn * 128 + wc * 64 + 4 * fq;
#pragma unroll
                for (int ni = 0; ni < 4; ++ni) *(uint2*)(yr + ni * 16) = pack4(acc[mi][ni]);
            }
        }
    }
}

namespace g8 {
constexpr int HTB = 128 * 64 * 2;
__device__ __forceinline__ int lds_byte(int r, int c) { const int st = (r >> 4) * 2 + (c >> 5), rr = r & 15, cc = c & 31, ob = rr * 64 + cc * 2; return st * 1024 + (ob ^ (((ob >> 9) & 1) << 5)); }
__device__ __forceinline__ void stage_rc(int b, int& R, int& C) { const int st = b / 1024, sb = b % 1024, swz = sb ^ (((sb >> 9) & 1) << 5); R = (st >> 1) * 16 + swz / 64; C = (st & 1) * 32 + (swz % 64) / 2; }
__device__ __forceinline__ int perm32(int rho) { const int n = rho >> 4, i = rho & 15; return 8 * (i >> 2) + 4 * n + (i & 3); }
struct Unit { int pm, pn, e; };
struct StaticOrder {
    int nM, nN, nwg, G, c;
    __device__ __forceinline__ void init(int M, int N, int G_, int c_) { nM = M / 256; nN = N / 256; nwg = nM * nN; G = G_; c = c_; }
    __device__ __forceinline__ bool next(int i, Unit& u) const {
        const long L = (long)i * G + c; if (L >= nwg) return false;
        int wgid = (int)L; { const int q = nwg / 8, r = nwg % 8, xcd = wgid % 8, off = wgid / 8; wgid = (xcd < r ? xcd * (q + 1) : r * (q + 1) + (xcd - r) * q) + off; }
        const int nig = 8 * nN, gid = wgid / nig, fm = gid * 8, gsz = (nM - fm) < 8 ? (nM - fm) : 8;
        u.pm = fm + ((wgid % nig) % gsz); u.pn = (wgid % nig) / gsz; u.e = 0; return true;
    }
};
struct AddrPlain {
    const char* A; const char* Bt; unsigned lda2, ldb2; int ntiles;
    __device__ __forceinline__ const char* a_base(const Unit&) const { return A; }
    __device__ __forceinline__ const char* b_base(const Unit&) const { return Bt; }
    __device__ __forceinline__ int nt(const Unit&) const { return ntiles; }
    __device__ __forceinline__ int a_row0(const Unit& u) const { return u.pm * 256; }
    __device__ __forceinline__ int b_row0(const Unit& u) const { return u.pn * 256; }
    __device__ __forceinline__ unsigned a_ld(const Unit&) const { return lda2; }
    __device__ __forceinline__ unsigned b_ld(const Unit&) const { return ldb2; }
};

template <class Epi, class Sched, class Addr>
__device__ __forceinline__ void gemm_phase(char* ldsc, const Sched& S, const Addr& AD, const Epi& E) {
    __attribute__((address_space(3))) unsigned char* lds = (__attribute__((address_space(3))) unsigned char*)ldsc;
    int tid_ = threadIdx.x; asm volatile("" : "+v"(tid_));
    const int tid = tid_, wid = __builtin_amdgcn_readfirstlane(tid >> 6), lane = tid & 63, wr = wid >> 2, wc = wid & 3, fr = lane & 15, fq = lane >> 4;
    int R[2], C2[2], Rb[2];
#pragma unroll
    for (int i = 0; i < 2; ++i) { int r_, c_; stage_rc(tid * 16 + i * 8192, r_, c_); R[i] = r_; C2[i] = c_ * 2; Rb[i] = Epi::PERM ? ((r_ & ~31) + perm32(r_ & 31)) : r_; }
    const unsigned ldsw = (unsigned)wid * 1024u;
    const int aoff = lds_byte(wr * 64 + fr, fq * 8), boff = lds_byte(wc * 32 + fr, fq * 8);
#define G8_SA(b, h) (((b) * 2 + (h)) * HTB)
#define G8_SB(b, h) ((4 + (b) * 2 + (h)) * HTB)
#define G8_STAGE(bufoff, base, rowv, row0, ld, h, kb) do { _Pragma("unroll") for (int _i = 0; _i < 2; ++_i) \
        __builtin_amdgcn_global_load_lds((const __attribute__((address_space(1))) unsigned*)((base) + (size_t)((unsigned)((row0) + (h) * 128 + (rowv)[_i]) * (ld) + (unsigned)C2[_i] + (unsigned)(kb))), \
                                         (__attribute__((address_space(3))) unsigned*)(lds + (bufoff) + ldsw + _i * 8192), 16, 0, 0); } while (0)
#define G8_LDA(dst, b, h) do { _Pragma("unroll") for (int m = 0; m < 4; ++m) _Pragma("unroll") for (int k = 0; k < 2; ++k) dst[m][k] = *(const __attribute__((address_space(3))) bf16x8*)(lds + G8_SA(b, h) + aoff + m * 2048 + k * 1024); } while (0)
#define G8_LDB(dst, b, h) do { _Pragma("unroll") for (int n = 0; n < 2; ++n) _Pragma("unroll") for (int k = 0; k < 2; ++k) dst[n][k] = *(const __attribute__((address_space(3))) bf16x8*)(lds + G8_SB(b, h) + boff + n * 2048 + k * 1024); } while (0)
#define G8_MMA(ai, bj, At, Bt) do { __builtin_amdgcn_s_setprio(1); _Pragma("unroll") for (int m = 0; m < 4; ++m) _Pragma("unroll") for (int n = 0; n < 2; ++n) _Pragma("unroll") for (int k = 0; k < 2; ++k) \
        acc[ai][bj][m][n] = __builtin_amdgcn_mfma_f32_16x16x32_bf16(Bt[n][k], At[m][k], acc[ai][bj][m][n], 0, 0, 0); __builtin_amdgcn_s_setprio(0); } while (0)
#define G8_WAIT_V(n) asm volatile("s_waitcnt vmcnt(" #n ")" ::: "memory")
#define G8_WAIT_L(n) asm volatile("s_waitcnt lgkmcnt(" #n ")" ::: "memory")
#define G8_BAR __builtin_amdgcn_s_barrier()
#define G8_SCHED __builtin_amdgcn_sched_barrier(0)
    Unit cur, nxt; int ui = 0;
    if (!S.next(0, cur)) return;
    f32x4 acc[2][2][4][2];
#pragma unroll
    for (int a = 0; a < 2; ++a)
#pragma unroll
        for (int b = 0; b < 2; ++b)
#pragma unroll
            for (int m = 0; m < 4; ++m)
#pragma unroll
                for (int n = 0; n < 2; ++n) acc[a][b][m][n] = (f32x4){0.f, 0.f, 0.f, 0.f};
    bf16x8 At[4][2], B0[2][2], B1[2][2];
    const char* Ab = AD.a_base(cur); const char* Bb = AD.b_base(cur);
    int ar0 = AD.a_row0(cur), br0 = AD.b_row0(cur); unsigned ald = AD.a_ld(cur), bld = AD.b_ld(cur);
    __syncthreads();
    G8_STAGE(G8_SB(0, 0), Bb, Rb, br0, bld, 0, 0); G8_STAGE(G8_SA(0, 0), Ab, R, ar0, ald, 0, 0); G8_STAGE(G8_SB(0, 1), Bb, Rb, br0, bld, 1, 0); G8_STAGE(G8_SA(0, 1), Ab, R, ar0, ald, 1, 0);
    if (wr == 1) G8_BAR;
    G8_WAIT_V(4); G8_BAR;
    G8_STAGE(G8_SB(1, 0), Bb, Rb, br0, bld, 0, 128); G8_STAGE(G8_SA(1, 0), Ab, R, ar0, ald, 0, 128); G8_STAGE(G8_SB(1, 1), Bb, Rb, br0, bld, 1, 128);
    G8_WAIT_V(6); G8_BAR;
    for (;;) {
        const bool has_next = S.next(ui + 1, nxt);
        const int nt = AD.nt(cur);
        const char* nAb = has_next ? AD.a_base(nxt) : Ab; const char* nBb = has_next ? AD.b_base(nxt) : Bb;
        const int nar0 = has_next ? AD.a_row0(nxt) : ar0, nbr0 = has_next ? AD.b_row0(nxt) : br0;
        const unsigned nald = has_next ? AD.a_ld(nxt) : ald, nbld = has_next ? AD.b_ld(nxt) : bld;
        for (int t = 0; t < nt; t += 2) {
            const bool last = (t == nt - 2);
            const int kb1 = (t + 1) * 128, kb2 = last ? 0 : (t + 2) * 128, kb3 = kb2 + 128;
            const char* sAb = last ? nAb : Ab; const char* sBb = last ? nBb : Bb;
            const int sar0 = last ? nar0 : ar0, sbr0 = last ? nbr0 : br0; const unsigned sald = last ? nald : ald, sbld = last ? nbld : bld;
            G8_LDB(B0, 0, 0); G8_SCHED; G8_LDA(At, 0, 0); G8_STAGE(G8_SA(1, 1), Ab, R, ar0, ald, 1, kb1);
            G8_WAIT_L(8); G8_BAR; G8_WAIT_L(0); G8_MMA(0, 0, At, B0); G8_BAR; G8_SCHED;
            G8_LDB(B1, 0, 1); G8_STAGE(G8_SB(0, 0), sBb, Rb, sbr0, sbld, 0, kb2);
            G8_BAR; G8_WAIT_L(0); G8_MMA(0, 1, At, B1); G8_BAR;
            G8_LDA(At, 0, 1); G8_STAGE(G8_SA(0, 0), sAb, R, sar0, sald, 0, kb2);
            G8_BAR; G8_WAIT_L(0); G8_MMA(1, 0, At, B0); G8_BAR; G8_SCHED;
            G8_STAGE(G8_SB(0, 1), sBb, Rb, sbr0, sbld, 1, kb2);
            G8_WAIT_V(6); G8_BAR; G8_MMA(1, 1, At, B1); G8_BAR;
            G8_LDB(B0, 1, 0); G8_SCHED; G8_LDA(At, 1, 0); G8_STAGE(G8_SA(0, 1), sAb, R, sar0, sald, 1, kb2);
            G8_WAIT_L(8); G8_BAR; G8_WAIT_L(0); G8_MMA(0, 0, At, B0); G8_BAR; G8_SCHED;
            G8_LDB(B1, 1, 1); G8_STAGE(G8_SB(1, 0), sBb, Rb, sbr0, sbld, 0, kb3);
            G8_BAR; G8_WAIT_L(0); G8_MMA(0, 1, At, B1); G8_BAR;
            G8_LDA(At, 1, 1); G8_STAGE(G8_SA(1, 0), sAb, R, sar0, sald, 0, kb3);
            G8_BAR; G8_WAIT_L(0); G8_MMA(1, 0, At, B0); G8_BAR; G8_SCHED;
            G8_STAGE(G8_SB(1, 1), sBb, Rb, sbr0, sbld, 1, kb3);
            G8_WAIT_V(6); G8_BAR; G8_MMA(1, 1, At, B1); G8_BAR;
        }
        E(acc, cur, wr, wc, fr, fq);
        if (!has_next) break;
#pragma unroll
        for (int a = 0; a < 2; ++a)
#pragma unroll
            for (int b = 0; b < 2; ++b)
#pragma unroll
                for (int m = 0; m < 4; ++m)
#pragma unroll
                    for (int n = 0; n < 2; ++n) acc[a][b][m][n] = (f32x4){0.f, 0.f, 0.f, 0.f};
        cur = nxt; Ab = nAb; Bb = nBb; ar0 = nar0; br0 = nbr0; ald = nald; bld = nbld; ++ui;
    }
    G8_WAIT_V(0);
    if (wr == 0) G8_BAR;
    G8_BAR;
#undef G8_SA
#undef G8_SB
#undef G8_STAGE
#undef G8_LDA
#undef G8_LDB
#undef G8_MMA
#undef G8_WAIT_V
#undef G8_WAIT_L
#undef G8_BAR
#undef G8_SCHED
}

struct EpiProj {
    static constexpr bool PERM = true;
    bf16_t* proj;
    __device__ __forceinline__ void operator()(const f32x4 (&acc)[2][2][4][2], const Unit& u, int wr, int wc, int fr, int fq) const {
#pragma unroll
        for (int ai = 0; ai < 2; ++ai)
#pragma unroll
            for (int m = 0; m < 4; ++m) {
                const int r = u.pm * 256 + ai * 128 + wr * 64 + m * 16 + fr;
#pragma unroll
                for (int bj = 0; bj < 2; ++bj) {
                    const int c = u.pn * 256 + bj * 128 + wc * 32 + 8 * fq;
                    if (c < NPROJ) {
                        u32x4 w; w[0] = pack_bf16(acc[ai][bj][m][0][0], acc[ai][bj][m][0][1]); w[1] = pack_bf16(acc[ai][bj][m][0][2], acc[ai][bj][m][0][3]);
                        w[2] = pack_bf16(acc[ai][bj][m][1][0], acc[ai][bj][m][1][1]); w[3] = pack_bf16(acc[ai][bj][m][1][2], acc[ai][bj][m][1][3]);
                        *(u32x4*)(proj + (size_t)r * PP + c) = w;
                    }
                }
            }
    }
};
struct EpiResid {
    static constexpr bool PERM = false;
    const float* x; float* x2;
    __device__ __forceinline__ void operator()(const f32x4 (&acc)[2][2][4][2], const Unit& u, int wr, int wc, int fr, int fq) const {
#pragma unroll
        for (int ai = 0; ai < 2; ++ai)
#pragma unroll
            for (int m = 0; m < 4; ++m) {
                const int r = u.pm * 256 + ai * 128 + wr * 64 + m * 16 + fr;
#pragma unroll
                for (int bj = 0; bj < 2; ++bj)
#pragma unroll
                    for (int n = 0; n < 2; ++n) {
                        const int c = u.pn * 256 + bj * 128 + wc * 32 + 16 * n + 4 * fq;
                        const f32x4 xv = *(const f32x4*)(x + (size_t)r * 1024 + c);
                        *(f32x4*)(x2 + (size_t)r * 1024 + c) = xv + acc[ai][bj][m][n];
                    }
            }
    }
};
struct OneUnit { Unit u; __device__ __forceinline__ bool next(int i, Unit& o) const { if (i) return false; o = u; return true; } };
template <int OP>
struct EpiMerge {
    static constexpr bool PERM = true;
    bf16_t* dst; const bf16_t* src2;
    __device__ __forceinline__ void operator()(const f32x4 (&acc)[2][2][4][2], const Unit& u, int wr, int wc, int fr, int fq) const {
#pragma unroll
        for (int ai = 0; ai < 2; ++ai)
#pragma unroll
            for (int m = 0; m < 4; ++m) {
                const int r = u.pm * 256 + ai * 128 + wr * 64 + m * 16 + fr;
#pragma unroll
                for (int bj = 0; bj < 2; ++bj) {
                    const size_t o = (size_t)r * 1024 + u.pn * 256 + bj * 128 + wc * 32 + 8 * fq;
                    float v[8];
#pragma unroll
                    for (int j = 0; j < 4; ++j) { v[j] = acc[ai][bj][m][0][j]; v[4 + j] = acc[ai][bj][m][1][j]; }
                    if (OP == 0) {
#pragma unroll
                        for (int j = 0; j < 8; ++j) v[j] = sigmoidf_(v[j]);
                    } else {
                        const u32x4 d = *(const u32x4*)(dst + o);
                        float dv[8];
#pragma unroll
                        for (int j = 0; j < 4; ++j) { dv[2 * j] = __uint_as_float(d[j] << 16); dv[2 * j + 1] = __uint_as_float(d[j] & 0xFFFF0000u); }
                        if (OP == 1) {
#pragma unroll
                            for (int j = 0; j < 8; ++j) v[j] = dv[j] * v[j];
                        } else {
                            const u32x4 s = *(const u32x4*)(src2 + o);
#pragma unroll
                            for (int j = 0; j < 4; ++j) { v[2 * j] = dv[2 * j] + __uint_as_float(s[j] << 16) * v[2 * j]; v[2 * j + 1] = dv[2 * j + 1] + __uint_as_float(s[j] & 0xFFFF0000u) * v[2 * j + 1]; }
                        }
                    }
                    u32x4 w; w[0] = pack_bf16(v[0], v[1]); w[1] = pack_bf16(v[2], v[3]); w[2] = pack_bf16(v[4], v[5]); w[3] = pack_bf16(v[6], v[7]);
                    *(u32x4*)(dst + o) = w;
                }
            }
    }
};
struct MergeOrder { StaticOrder so; __device__ __forceinline__ bool next(int i, Unit& u) const { if (!so.next(i >> 2, u)) return false; u.e = i & 3; return true; } };
struct AddrMerge {
    const char* h; const char* WinT; const char* ya; const char* yb; const char* WaT; const char* WbT;
    __device__ __forceinline__ const char* a_base(const Unit& u) const {
        const unsigned long long ph = (unsigned long long)h, pa = (unsigned long long)ya, pb = (unsigned long long)yb, o = (unsigned long long)(u.e & 1), t = (unsigned long long)((u.e >> 1) & 1);
        return (const char*)(ph + o * ((pa - ph) + t * (pb - pa))); }
    __device__ __forceinline__ const char* b_base(const Unit& u) const {
        const unsigned long long pg = (unsigned long long)(WinT + (size_t)MGA * 2048), pa = (unsigned long long)WaT, pb = (unsigned long long)WbT, o = (unsigned long long)(u.e & 1), t = (unsigned long long)((u.e >> 1) & 1);
        const unsigned long long g = pg + t * (unsigned long long)((size_t)(MGB - MGA) * 2048), y = pa + t * (pb - pa);
        return (const char*)(g + o * (y - g)); }
    __device__ __forceinline__ int nt(const Unit& u) const { return (u.e & 1) ? 8 : 16; }
    __device__ __forceinline__ int a_row0(const Unit& u) const { return u.pm * 256; }
    __device__ __forceinline__ int b_row0(const Unit& u) const { return u.pn * 256; }
    __device__ __forceinline__ unsigned a_ld(const Unit& u) const { return (u.e & 1) ? 1024u : 2048u; }
    __device__ __forceinline__ unsigned b_ld(const Unit& u) const { return (u.e & 1) ? 1024u : 2048u; }
};
struct EpiMergeAll {
    static constexpr bool PERM = true;
    bf16_t* mrg; bf16_t* sg2;
    __device__ __forceinline__ void operator()(const f32x4 (&acc)[2][2][4][2], const Unit& u, int wr, int wc, int fr, int fq) const {
        if (u.e == 0) EpiMerge<0>{mrg, nullptr}(acc, u, wr, wc, fr, fq);
        else if (u.e == 1) EpiMerge<1>{mrg, nullptr}(acc, u, wr, wc, fr, fq);
        else if (u.e == 2) EpiMerge<0>{sg2, nullptr}(acc, u, wr, wc, fr, fq);
        else EpiMerge<2>{mrg, sg2}(acc, u, wr, wc, fr, fq);
    }
};
}

constexpr float LOG2E = 1.4426950408889634f;
constexpr float NEGV = -3.0e38f;
constexpr int NSA_TB = 32768;
constexpr int NSA_IMPA = 34816;
constexpr int NSA_IMPB = NSA_IMPA + 16640;
constexpr int NSA_SELM = NSA_IMPB + 16640;

__device__ __forceinline__ int t5_bucket2(int n) {
    if (n < 16) return n;
    const int l = 16 + (int)(logf((float)n / 16.0f) / logf(8.0f) * 16.0f);
    return l < 31 ? l : 31;
}

template <int MODE, bool A0, bool A1>
__device__ __forceinline__ void nsa_tile(const char* Kst, const char* Vst, int j, bool fast, const float* tbias, const bf16x8 (&qf)[2][2], const int (&qidx)[2],
                                         const unsigned long long (&selq)[2], f32x4 (&O)[4][2], float (&m)[2], float (&l)[2], const float (&invl)[2],
                                         char* smem, int fr, int fq, int hp, int wid) {
    const float b127 = tbias[127];
    bf16x8 pf[2][2];
    bool started = true;
    if (MODE != 3) started = __builtin_amdgcn_ballot_w64((A0 && m[0] < -1e29f) || (A1 && m[1] < -1e29f)) == 0ull;
    const bool quick = (MODE != 3) && fast && started;
    f32x4 sall[2][2][2];
#pragma unroll
    for (int p = 0; p < 2; ++p)
#pragma unroll
        for (int s = 0; s < 2; ++s) {
            const int row = 32 * p + 16 * s + fr;
            const bf16x8 k0 = *(const bf16x8*)(Kst + tile_off(row, fq)), k1 = *(const bf16x8*)(Kst + tile_off(row, 4 + fq));
#pragma unroll
            for (int ct = 0; ct < 2; ++ct) {
                if ((ct == 0 && !A0) || (ct == 1 && !A1)) continue;
                float i0 = 0.f;
                if (quick) { const bool sel = (MODE == 1) ? (((selq[ct] >> j) & 1ull) != 0ull) : true; i0 = (sel ? b127 : NEGV) - m[ct]; }
                f32x4 a = (f32x4){i0, i0, i0, i0};
                a = __builtin_amdgcn_mfma_f32_16x16x32_bf16(k0, qf[ct][0], a, 0, 0, 0);
                a = __builtin_amdgcn_mfma_f32_16x16x32_bf16(k1, qf[ct][1], a, 0, 0, 0);
                sall[ct][p][s] = a;
            }
        }
#pragma unroll
    for (int ct = 0; ct < 2; ++ct) {
        if ((ct == 0 && !A0) || (ct == 1 && !A1)) continue;
        f32x4 (&sacc)[2][2] = sall[ct];
        const int q = qidx[ct];
        const bool sel = (MODE == 1) ? (((selq[ct] >> j) & 1ull) != 0ull) : true;
        if (MODE != 3) {
            const float mct = m[ct];
            if (!quick) {
                const float ref = started ? mct : 0.f;
#pragma unroll
                for (int p = 0; p < 2; ++p)
#pragma unroll
                    for (int s = 0; s < 2; ++s)
#pragma unroll
                        for (int i = 0; i < 4; ++i) {
                            const int kk = 64 * j + 32 * p + 8 * fq + 4 * s + i;
                            int rel; bool valid;
                            if (MODE == 0) { rel = q - (16 * kk + 31); valid = rel >= 0; }
                            else if (MODE == 1) { rel = q - kk; valid = (rel >= 0) && sel; }
                            else { rel = q - kk; valid = (rel >= 0) && (rel < 512); }
                            const int rc = rel < 0 ? 0 : (rel > 127 ? 127 : rel);
                            sacc[p][s][i] = valid ? sacc[p][s][i] + (tbias[rc] - ref) : NEGV;
                        }
            }
            float pv[2][8]; float psum = 0.f;
            bool redo = !started;
            if (started) {
#pragma unroll
                for (int p = 0; p < 2; ++p)
#pragma unroll
                    for (int s = 0; s < 2; ++s)
#pragma unroll
                        for (int i = 0; i < 4; ++i) { pv[p][s * 4 + i] = __builtin_amdgcn_exp2f(sacc[p][s][i]); psum += pv[p][s * 4 + i]; }
                if (__builtin_amdgcn_ballot_w64(!(psum <= 256.0f)) != 0ull) {
                    redo = true;
#pragma unroll
                    for (int p = 0; p < 2; ++p)
#pragma unroll
                        for (int s = 0; s < 2; ++s)
#pragma unroll
                            for (int i = 0; i < 4; ++i) sacc[p][s][i] += mct;
                }
            }
            if (redo) {
                float mloc = NEGV;
#pragma unroll
                for (int p = 0; p < 2; ++p)
#pragma unroll
                    for (int s = 0; s < 2; ++s)
#pragma unroll
                        for (int i = 0; i < 4; ++i) mloc = fmaxf(mloc, sacc[p][s][i]);
                mloc = fmaxf(mloc, __shfl_xor(mloc, 16)); mloc = fmaxf(mloc, __shfl_xor(mloc, 32));
                const float mnew = fmaxf(mct, mloc);
                const float alpha = __builtin_amdgcn_exp2f(mct - mnew);
                m[ct] = mnew; l[ct] *= alpha;
#pragma unroll
                for (int dt = 0; dt < 4; ++dt) O[dt][ct] = O[dt][ct] * alpha;
                psum = 0.f;
#pragma unroll
                for (int p = 0; p < 2; ++p)
#pragma unroll
                    for (int s = 0; s < 2; ++s)
#pragma unroll
                        for (int i = 0; i < 4; ++i) { pv[p][s * 4 + i] = __builtin_amdgcn_exp2f(sacc[p][s][i] - mnew); psum += pv[p][s * 4 + i]; }
            }
#pragma unroll
            for (int p = 0; p < 2; ++p) {
                u32x4 w; w[0] = pack_bf16(pv[p][0], pv[p][1]); w[1] = pack_bf16(pv[p][2], pv[p][3]); w[2] = pack_bf16(pv[p][4], pv[p][5]); w[3] = pack_bf16(pv[p][6], pv[p][7]);
                pf[ct][p] = __builtin_bit_cast(bf16x8, w);
            }
            l[ct] += psum;
        } else {
#pragma unroll
            for (int p = 0; p < 2; ++p)
#pragma unroll
                for (int s = 0; s < 2; ++s)
#pragma unroll
                    for (int i = 0; i < 4; ++i) {
                        const int kk = 64 * j + 32 * p + 8 * fq + 4 * s + i;
                        const int rel = q - (16 * kk + 31);
                        const int rc = rel < 0 ? 0 : (rel > 127 ? 127 : rel);
                        sacc[p][s][i] = (rel >= 0) ? sacc[p][s][i] + tbias[rc] : NEGV;
                    }
            float* impA = (float*)(smem + NSA_IMPA); float* impB = (float*)(smem + NSA_IMPB);
            const int ql = wid * 8 + ct * 4 + (fr >> 2);
#pragma unroll
            for (int p = 0; p < 2; ++p)
#pragma unroll
                for (int s = 0; s < 2; ++s) {
                    float p3 = __builtin_amdgcn_exp2f(sacc[p][s][3] - m[ct]) * invl[ct];
                    float pa = __builtin_amdgcn_exp2f(sacc[p][s][0] - m[ct]) * invl[ct] + __builtin_amdgcn_exp2f(sacc[p][s][1] - m[ct]) * invl[ct]
                             + __builtin_amdgcn_exp2f(sacc[p][s][2] - m[ct]) * invl[ct] + p3;
                    pa += __shfl_xor(pa, 1); pa += __shfl_xor(pa, 2);
                    p3 += __shfl_xor(p3, 1); p3 += __shfl_xor(p3, 2);
                    const int jj = 16 * j + 8 * p + 2 * fq + s;
                    if (hp == 0) { impA[ql * 65 + jj] = pa; impB[ql * 65 + jj + 1] = p3; }
                }
        }
    }
    if (MODE != 3) {
#pragma unroll
        for (int dt = 0; dt < 4; ++dt)
#pragma unroll
            for (int p = 0; p < 2; ++p) {
                const bf16x8 vf = *(const bf16x8*)(Vst + tile_off(dt * 16 + fr, p * 4 + fq));
                if (A0) O[dt][0] = __builtin_amdgcn_mfma_f32_16x16x32_bf16(vf, pf[0][p], O[dt][0], 0, 0, 0);
                if (A1) O[dt][1] = __builtin_amdgcn_mfma_f32_16x16x32_bf16(vf, pf[1][p], O[dt][1], 0, 0, 0);
            }
    }
}

template <int MODE>
__device__ __forceinline__ void nsa_branch(const bf16_t* __restrict__ Kb, size_t kstride, const bf16_t* __restrict__ Vb, size_t vstride, int j0, int ntiles, int t0,
                                           const bf16x8 (&qf)[2][2], const int (&qidx)[2], const unsigned long long (&selq)[2], unsigned long long selor0, unsigned long long selor1,
                                           f32x4 (&O)[4][2], float (&m)[2], float (&l)[2], const float (&invl)[2], char* smem) {
    int tid_ = threadIdx.x; asm volatile("" : "+v"(tid_));
    const int tid = tid_, lane = tid & 63, wid = tid >> 6, fr = lane & 15, fq = lane >> 4, hp = fr & 3;
    const int lrow = tid >> 3;
    const float* tbias = (const float*)(smem + NSA_TB) + hp * 128;
    const int sch8 = ((tid & 7) ^ (lrow & 7)) * 8;
    const int krow = 32 * (lrow >> 5) + 8 * ((lrow & 15) >> 2) + 4 * ((lrow >> 4) & 1) + (lrow & 3);
    const bf16_t* kp = Kb + (size_t)krow * kstride + sch8;
    const bf16_t* vp = Vb + (size_t)lrow * vstride + sch8;
    __syncthreads();
    glds16(kp, smem + tid * 16); if (MODE != 3) glds16(vp, smem + 8192 + tid * 16);
    asm volatile("s_waitcnt vmcnt(0)" ::: "memory");
    __syncthreads();
    for (int it = 0; it < ntiles; ++it) {
        const int cur = it & 1, j = j0 + it;
        if (it + 1 < ntiles) {
            char* st = smem + (cur ^ 1) * 16384 + tid * 16;
            glds16(kp + (size_t)(it + 1) * 64 * kstride, st); if (MODE != 3) glds16(vp + (size_t)(it + 1) * 64, st + 8192);
        }
        const char* Kst = smem + cur * 16384;
        const char* Vst = Kst + 8192;
        bool fast;
        if (MODE == 0 || MODE == 3) fast = (t0 - (16 * (64 * j + 63) + 31)) >= 128;
        else if (MODE == 1) fast = (t0 - (64 * j + 63)) >= 128;
        else fast = ((t0 - (64 * j + 63)) >= 128) && ((t0 + 63 - 64 * j) < 512);
        if (MODE == 1) {
            const bool a0 = ((selor0 >> j) & 1ull) != 0ull, a1 = ((selor1 >> j) & 1ull) != 0ull;
            if (a0 && a1) nsa_tile<MODE, true, true>(Kst, Vst, j, fast, tbias, qf, qidx, selq, O, m, l, invl, smem, fr, fq, hp, wid);
            else if (a0) nsa_tile<MODE, true, false>(Kst, Vst, j, fast, tbias, qf, qidx, selq, O, m, l, invl, smem, fr, fq, hp, wid);
            else if (a1) nsa_tile<MODE, false, true>(Kst, Vst, j, fast, tbias, qf, qidx, selq, O, m, l, invl, smem, fr, fq, hp, wid);
        } else {
            nsa_tile<MODE, true, true>(Kst, Vst, j, fast, tbias, qf, qidx, selq, O, m, l, invl, smem, fr, fq, hp, wid);
        }
        asm volatile("s_waitcnt vmcnt(0)" ::: "memory");
        __syncthreads();
    }
}

__device__ __forceinline__ void osum_add(uint2& acc, f32x4 o, float sc) {
    f32x4 v;
    v[0] = __uint_as_float(acc.x << 16) + o[0] * sc; v[1] = __uint_as_float(acc.x & 0xFFFF0000u) + o[1] * sc;
    v[2] = __uint_as_float(acc.y << 16) + o[2] * sc; v[3] = __uint_as_float(acc.y & 0xFFFF0000u) + o[3] * sc;
    acc = pack4(v);
}
__device__ __forceinline__ float nsa_gate(const bf16_t* __restrict__ pb, int q, int br, int head) { return sigmoidf_(bf2f(pb[(size_t)q * PP + GA + br * 8 + head])); }

__device__ __forceinline__ void nsa_unit(int u, const bf16_t* __restrict__ proj, const char* __restrict__ ws, const float* __restrict__ rel_bias, bf16_t* __restrict__ ya, char* smem) {
    int tid_ = threadIdx.x; asm volatile("" : "+v"(tid_));
    const int tid = tid_, lane = tid & 63, wid = tid >> 6, fr = lane & 15, fq = lane >> 4, hp = fr & 3;
    const int bg = u & 7, qb = 63 - (u >> 3), b = bg >> 1, g = bg & 1, t0 = qb * 64, tb = qb;
    const bf16_t* kcb = (const bf16_t*)(ws + OFF_KCB) + (size_t)bg * 256 * 64;
    const bf16_t* vcbT = (const bf16_t*)(ws + OFF_VCBT) + (size_t)bg * 64 * 256;
    const bf16_t* VsT = (const bf16_t*)(ws + OFF_VST) + (size_t)bg * 64 * S;
    const bf16_t* VwT = (const bf16_t*)(ws + OFF_VWT) + (size_t)bg * 64 * S;
    const bf16_t* pb = proj + (size_t)b * S * PP;
    __syncthreads();
    {
        float* tbl = (float*)(smem + NSA_TB);
        { const int e = tid, h4 = e >> 7, n = e & 127; tbl[e] = rel_bias[t5_bucket2(n) * 8 + g * 4 + h4] * LOG2E; }
        float* imp = (float*)(smem + NSA_IMPA);
        for (int e = tid; e < 2 * 4160; e += 512) imp[e] = 0.f;
    }
    int qidx[2]; bf16x8 qf[2][2];
    const int head = g * 4 + hp;
#pragma unroll
    for (int ct = 0; ct < 2; ++ct) {
        qidx[ct] = t0 + wid * 8 + ct * 4 + (fr >> 2);
        const bf16_t* qr = pb + (size_t)qidx[ct] * PP;
#pragma unroll
        for (int ks = 0; ks < 2; ++ks) {
            const u32x4 raw = *(const u32x4*)(qr + QA + head * 64 + ks * 32 + fq * 8);
            u32x4 w;
#pragma unroll
            for (int e = 0; e < 4; ++e) w[e] = pack_bf16(__uint_as_float(raw[e] << 16) * (0.125f * LOG2E), __uint_as_float(raw[e] & 0xFFFF0000u) * (0.125f * LOG2E));
            qf[ct][ks] = __builtin_bit_cast(bf16x8, w);
        }
    }
    uint2 osum[4][2];
#pragma unroll
    for (int dt = 0; dt < 4; ++dt)
#pragma unroll
        for (int ct = 0; ct < 2; ++ct) osum[dt][ct] = make_uint2(0u, 0u);
    unsigned long long selq[2] = {0ull, 0ull};
    float invl0[2] = {0.f, 0.f};
    const int ntc = (((t0 + 32) >> 4) + 1 + 63) >> 6;
    float mC[2], invC[2];
    {
        f32x4 O[4][2]; float m[2] = {-1e30f, -1e30f}, l[2] = {0.f, 0.f};
#pragma unroll
        for (int dt = 0; dt < 4; ++dt)
#pragma unroll
            for (int ct = 0; ct < 2; ++ct) O[dt][ct] = (f32x4){0.f, 0.f, 0.f, 0.f};
        nsa_branch<0>(kcb, 64, vcbT, 256, 0, ntc, t0, qf, qidx, selq, 0ull, 0ull, O, m, l, invl0, smem);
#pragma unroll
        for (int ct = 0; ct < 2; ++ct) {
            float lt = l[ct]; lt += __shfl_xor(lt, 16); lt += __shfl_xor(lt, 32);
            invC[ct] = lt > 0.f ? 1.f / lt : 0.f; mC[ct] = m[ct];
#pragma unroll
            for (int dt = 0; dt < 4; ++dt) osum_add(osum[dt][ct], O[dt][ct], nsa_gate(pb, qidx[ct], 0, head) * invC[ct]);
        }
        nsa_branch<3>(kcb, 64, vcbT, 256, 0, ntc, t0, qf, qidx, selq, 0ull, 0ull, O, mC, l, invC, smem);
    }
    {
        const float* impA = (const float*)(smem + NSA_IMPA); const float* impB = (const float*)(smem + NSA_IMPB);
        unsigned long long* selm = (unsigned long long*)(smem + NSA_SELM);
#pragma unroll 1
        for (int qq = 0; qq < 8; ++qq) {
            const int ql = wid * 8 + qq;
            const float val = impA[ql * 65 + lane] + impB[ql * 65 + lane];
            const bool forced = (lane == 0) || (lane == tb) || (lane == tb - 1);
            unsigned key = forced ? 0xFFFFFFC0u : (lane > tb ? 0u : (__float_as_uint(val) & 0xFFFFFFC0u));
            key |= (unsigned)(63 - lane);
            int rank = 0;
#pragma unroll
            for (int jp = 0; jp < 64; ++jp) rank += ((unsigned)__builtin_amdgcn_readlane((int)key, jp) > key) ? 1 : 0;
            const unsigned long long msk = __ballot(rank < 16);
            if (lane == 0) selm[ql] = msk;
        }
        wave_lds_sync();
        unsigned long long so0 = 0ull, so1 = 0ull;
#pragma unroll
        for (int qq = 0; qq < 4; ++qq) { so0 |= selm[wid * 8 + qq]; so1 |= selm[wid * 8 + 4 + qq]; }
        const unsigned long long selor0 = ((unsigned long long)(unsigned)__builtin_amdgcn_readfirstlane((int)(unsigned)(so0 >> 32)) << 32) | (unsigned)__builtin_amdgcn_readfirstlane((int)(unsigned)so0);
        const unsigned long long selor1 = ((unsigned long long)(unsigned)__builtin_amdgcn_readfirstlane((int)(unsigned)(so1 >> 32)) << 32) | (unsigned)__builtin_amdgcn_readfirstlane((int)(unsigned)so1);
        selq[0] = selm[wid * 8 + (fr >> 2)]; selq[1] = selm[wid * 8 + 4 + (fr >> 2)];
        {
            f32x4 O[4][2]; float m[2] = {-1e30f, -1e30f}, l[2] = {0.f, 0.f};
#pragma unroll
            for (int dt = 0; dt < 4; ++dt)
#pragma unroll
                for (int ct = 0; ct < 2; ++ct) O[dt][ct] = (f32x4){0.f, 0.f, 0.f, 0.f};
            nsa_branch<1>(pb + KS + g * 64, PP, VsT, S, 0, tb + 1, t0, qf, qidx, selq, selor0, selor1, O, m, l, invl0, smem);
#pragma unroll
            for (int ct = 0; ct < 2; ++ct) {
                float lt = l[ct]; lt += __shfl_xor(lt, 16); lt += __shfl_xor(lt, 32);
                const float inv = lt > 0.f ? 1.f / lt : 0.f;
#pragma unroll
                for (int dt = 0; dt < 4; ++dt) osum_add(osum[dt][ct], O[dt][ct], nsa_gate(pb, qidx[ct], 1, head) * inv);
            }
        }
    }
    {
        f32x4 O[4][2]; float m[2] = {-1e30f, -1e30f}, l[2] = {0.f, 0.f};
#pragma unroll
        for (int dt = 0; dt < 4; ++dt)
#pragma unroll
            for (int ct = 0; ct < 2; ++ct) O[dt][ct] = (f32x4){0.f, 0.f, 0.f, 0.f};
        const int jw0 = (t0 - 511 < 0 ? 0 : t0 - 511) >> 6;
        nsa_branch<2>(pb + (size_t)jw0 * 64 * PP + KW + g * 64, PP, VwT + jw0 * 64, S, jw0, tb - jw0 + 1, t0, qf, qidx, selq, 0ull, 0ull, O, m, l, invl0, smem);
#pragma unroll
        for (int ct = 0; ct < 2; ++ct) {
            float lt = l[ct]; lt += __shfl_xor(lt, 16); lt += __shfl_xor(lt, 32);
            const float inv = lt > 0.f ? 1.f / lt : 0.f;
#pragma unroll
            for (int dt = 0; dt < 4; ++dt) osum_add(osum[dt][ct], O[dt][ct], nsa_gate(pb, qidx[ct], 2, head) * inv);
        }
    }
#pragma unroll
    for (int ct = 0; ct < 2; ++ct) {
        bf16_t* yr = ya + (size_t)(b * S + qidx[ct]) * 512 + head * 64 + 4 * fq;
#pragma unroll
        for (int dt = 0; dt < 4; ++dt) *(uint2*)(yr + dt * 16) = osum[dt][ct];
    }
}

__device__ __forceinline__ void vtrans_tile(int task, const bf16_t* __restrict__ proj, char* ws, char* smem) {
    unsigned short (*tl)[66] = (unsigned short (*)[66])smem;
    const int tid = HB_TID, which = task >> 9, bg = (task >> 6) & 7, tt = task & 63, b = bg >> 1, g = bg & 1;
    const int r = tid >> 2, q4 = tid & 3;
    const bf16_t* src = proj + (size_t)(b * S + tt * 64 + r) * PP + (which ? VW : VS) + g * 64 + q4 * 16;
    const uint4 a0 = *(const uint4*)src, a1 = *(const uint4*)(src + 8);
    unsigned* trow = (unsigned*)&tl[r][q4 * 16];
    trow[0] = a0.x; trow[1] = a0.y; trow[2] = a0.z; trow[3] = a0.w; trow[4] = a1.x; trow[5] = a1.y; trow[6] = a1.z; trow[7] = a1.w;
    __syncthreads();
    bf16_t* dst = (bf16_t*)(ws + (which ? OFF_VWT : OFF_VST)) + ((size_t)bg * 64 + r) * S + tt * 64 + q4 * 16;
    unsigned o[8];
#pragma unroll
    for (int k = 0; k < 8; ++k) o[k] = (unsigned)tl[q4 * 16 + 2 * k][r] | ((unsigned)tl[q4 * 16 + 2 * k + 1][r] << 16);
    *(uint4*)dst = make_uint4(o[0], o[1], o[2], o[3]);
    *(uint4*)(dst + 8) = make_uint4(o[4], o[5], o[6], o[7]);
    __syncthreads();
}

__device__ __forceinline__ int tile_el(int row, int col) { return tile_off(row, col >> 3) + ((col & 7) << 1); }

__device__ __forceinline__ void gla_stage_vt(const bf16_t* __restrict__ proj, size_t row0, int h, char* vt_base) {
    const int tid = HB_TID, c = tid >> 2, vq = tid & 3;
    const bf16_t* src = proj + (row0 + c) * PP + VB + h * 128 + vq * 32;
#pragma unroll
    for (int k = 0; k < 4; ++k) {
        const u32x4 a = *(const u32x4*)(src + k * 8);
#pragma unroll
        for (int e = 0; e < 4; ++e) {
            const int v = vq * 32 + k * 8 + 2 * e;
            *(unsigned short*)(vt_base + tile_el(v, c)) = (unsigned short)(a[e] & 0xFFFFu);
            *(unsigned short*)(vt_base + tile_el(v + 1, c)) = (unsigned short)(a[e] >> 16);
        }
    }
}

__device__ __forceinline__ void gla_a_unit(int vb, const bf16_t* __restrict__ proj, const float* __restrict__ w_alpha, const float* __restrict__ b_alpha,
                                           float* __restrict__ bc, float* __restrict__ cstate, char* smem) {
    float (*bcS)[64] = (float (*)[64])smem;
    float (*tot)[64] = (float (*)[64])(smem + 16384);
    char* KDT = smem + 17408;
    char* VT = smem + 17408 + 8192;
    const int tid = HB_TID, lane = tid & 63, wid = tid >> 6, fr = lane & 15, fq = lane >> 4;
    const int n = vb & 63, h = (vb >> 6) & 3, b = vb >> 8;
    const size_t row0 = (size_t)(b * S + n * 64);
    __syncthreads();
    {
        const int d = tid & 63, cq = tid >> 6, col = h * 64 + d;
        float w[16];
#pragma unroll
        for (int r = 0; r < 16; ++r) w[r] = w_alpha[r * 256 + col];
        const float bias = b_alpha[col];
        float cum = 0.f;
        for (int i = 0; i < 16; ++i) {
            const int c = cq * 16 + i;
            const u32x4 a0 = *(const u32x4*)(proj + (row0 + c) * PP + AB), a1 = *(const u32x4*)(proj + (row0 + c) * PP + AB + 8);
            float z = bias;
#pragma unroll
            for (int e = 0; e < 4; ++e) {
                z += __uint_as_float(a0[e] << 16) * w[2 * e] + __uint_as_float(a0[e] & 0xFFFF0000u) * w[2 * e + 1];
                z += __uint_as_float(a1[e] << 16) * w[8 + 2 * e] + __uint_as_float(a1[e] & 0xFFFF0000u) * w[8 + 2 * e + 1];
            }
            const float ls = fminf(z, 0.f) - log1pf(__expf(-fabsf(z)));
            cum += ls * (1.0f / 16.0f);
            bcS[c][d] = cum;
        }
        tot[cq][d] = cum;
        __syncthreads();
        float pre = 0.f;
        for (int q = 0; q < cq; ++q) pre += tot[q][d];
        for (int i = 0; i < 16; ++i) {
            const int c = cq * 16 + i;
            const float v = bcS[c][d] + pre;
            bcS[c][d] = v;
            bc[(row0 + c) * 256 + col] = v;
        }
    }
    __syncthreads();
    {
        const int c = tid >> 2, dq = tid & 3;
        const bf16_t* src = proj + (row0 + c) * PP + KB + h * 64 + dq * 16;
#pragma unroll
        for (int k = 0; k < 2; ++k) {
            const u32x4 a = *(const u32x4*)(src + k * 8);
#pragma unroll
            for (int e = 0; e < 4; ++e) {
                const int d = dq * 16 + k * 8 + 2 * e;
                const float k0 = __uint_as_float(a[e] << 16) * __expf(bcS[63][d] - bcS[c][d]);
                const float k1 = __uint_as_float(a[e] & 0xFFFF0000u) * __expf(bcS[63][d + 1] - bcS[c][d + 1]);
                *(unsigned short*)(KDT + tile_el(d, c)) = f2bf(k0);
                *(unsigned short*)(KDT + tile_el(d + 1, c)) = f2bf(k1);
            }
        }
    }
    gla_stage_vt(proj, row0, h, VT);
    __syncthreads();
    float* outp = cstate + (size_t)vb * 8192;
#pragma unroll
    for (int vi = 0; vi < 2; ++vi) {
        const int vt = wid * 2 + vi;
        const bf16x8 a0 = *(const bf16x8*)(VT + tile_off(vt * 16 + fr, fq)), a1 = *(const bf16x8*)(VT + tile_off(vt * 16 + fr, 4 + fq));
#pragma unroll
        for (int dt = 0; dt < 4; ++dt) {
            const bf16x8 b0 = *(const bf16x8*)(KDT + tile_off(dt * 16 + fr, fq)), b1 = *(const bf16x8*)(KDT + tile_off(dt * 16 + fr, 4 + fq));
            f32x4 acc = (f32x4){0.f, 0.f, 0.f, 0.f};
            acc = __builtin_amdgcn_mfma_f32_16x16x32_bf16(a0, b0, acc, 0, 0, 0);
            acc = __builtin_amdgcn_mfma_f32_16x16x32_bf16(a1, b1, acc, 0, 0, 0);
#pragma unroll
            for (int i = 0; i < 4; ++i) outp[(vt * 16 + 4 * fq + i) * 64 + dt * 16 + fr] = acc[i];
        }
    }
}

__device__ __forceinline__ void gla_scan_vb2(int vb, const float* __restrict__ bc, float* __restrict__ cstate) {
    const int idx = vb * 512 + threadIdx.x;
    const int e = idx & 8191, bh = idx >> 13, b = bh >> 2, h = bh & 3, d = e & 63;
    float state = 0.f;
    float* base = cstate + (size_t)bh * 64 * 8192 + e;
    const float* bcp = bc + ((size_t)(b * S + 63)) * 256 + h * 64 + d;
#pragma unroll 1
    for (int n0 = 0; n0 < 64; n0 += 16) {
        float upd[16], dec[16];
#pragma unroll
        for (int i = 0; i < 16; ++i) { upd[i] = base[(size_t)(n0 + i) * 8192]; dec[i] = bcp[(size_t)(n0 + i) * 64 * 256]; }
#pragma unroll
        for (int i = 0; i < 16; ++i) { base[(size_t)(n0 + i) * 8192] = state; state = __expf(dec[i]) * state + upd[i]; }
    }
}

__device__ __forceinline__ void gla_c_unit(int vb, const bf16_t* __restrict__ proj, const float* __restrict__ bc, const float* __restrict__ prev,
                                           const float* __restrict__ norm_g, bf16_t* __restrict__ yb, char* smem) {
    char* QI = smem;
    char* KI = smem + 8192;
    char* VT = smem + 16384;
    char* PT = smem + 32768;
    const int tid = HB_TID, lane = tid & 63, wid = tid >> 6, fr = lane & 15, fq = lane >> 4;
    const int n = vb & 63, h = (vb >> 6) & 3, b = vb >> 8;
    const size_t row0 = (size_t)(b * S + n * 64);
    __syncthreads();
    {
        const int c = tid >> 2, dq = tid & 3;
        const bf16_t* qs = proj + (row0 + c) * PP + QB + h * 64 + dq * 16;
        const bf16_t* ks = proj + (row0 + c) * PP + KB + h * 64 + dq * 16;
        const float* bs = bc + (row0 + c) * 256 + h * 64 + dq * 16;
#pragma unroll
        for (int k = 0; k < 2; ++k) {
            const u32x4 qa = *(const u32x4*)(qs + k * 8), ka = *(const u32x4*)(ks + k * 8);
            const f32x4 b0 = *(const f32x4*)(bs + k * 8), b1 = *(const f32x4*)(bs + k * 8 + 4);
            const float bv[8] = {b0[0], b0[1], b0[2], b0[3], b1[0], b1[1], b1[2], b1[3]};
            u32x4 qo, ko;
#pragma unroll
            for (int e = 0; e < 4; ++e) {
                const float e0 = __expf(bv[2 * e]), e1 = __expf(bv[2 * e + 1]);
                qo[e] = pack_bf16(__uint_as_float(qa[e] << 16) * 0.125f * e0, __uint_as_float(qa[e] & 0xFFFF0000u) * 0.125f * e1);
                ko[e] = pack_bf16(__uint_as_float(ka[e] << 16) / e0, __uint_as_float(ka[e] & 0xFFFF0000u) / e1);
            }
            *(u32x4*)(QI + tile_off(c, dq * 2 + k)) = qo;
            *(u32x4*)(KI + tile_off(c, dq * 2 + k)) = ko;
        }
    }
    gla_stage_vt(proj, row0, h, VT);
    {
        const int v = tid >> 1, half = tid & 1;
        const float* ps = prev + (size_t)vb * 8192 + v * 64 + half * 32;
#pragma unroll
        for (int k = 0; k < 4; ++k) {
            const f32x4 a = *(const f32x4*)(ps + k * 8), c2 = *(const f32x4*)(ps + k * 8 + 4);
            u32x4 o; o[0] = pack_bf16(a[0], a[1]); o[1] = pack_bf16(a[2], a[3]); o[2] = pack_bf16(c2[0], c2[1]); o[3] = pack_bf16(c2[2], c2[3]);
            *(u32x4*)(PT + tile_off(v, half * 4 + k)) = o;
        }
    }
    __syncthreads();
    const bf16x8 qf0 = *(const bf16x8*)(QI + tile_off(wid * 16 + fr, fq)), qf1 = *(const bf16x8*)(QI + tile_off(wid * 16 + fr, 4 + fq));
    bf16x8 pf[2];
    const int c = wid * 16 + fr;
#pragma unroll
    for (int p = 0; p < 2; ++p) {
        u32x4 w;
#pragma unroll
        for (int s = 0; s < 2; ++s) {
            const int row = 32 * p + 8 * (fr >> 2) + 4 * s + (fr & 3);
            const bf16x8 k0 = *(const bf16x8*)(KI + tile_off(row, fq)), k1 = *(const bf16x8*)(KI + tile_off(row, 4 + fq));
            f32x4 a = (f32x4){0.f, 0.f, 0.f, 0.f};
            a = __builtin_amdgcn_mfma_f32_16x16x32_bf16(k0, qf0, a, 0, 0, 0);
            a = __builtin_amdgcn_mfma_f32_16x16x32_bf16(k1, qf1, a, 0, 0, 0);
#pragma unroll
            for (int i = 0; i < 4; ++i) { const int j = 32 * p + 8 * fq + 4 * s + i; if (j > c) a[i] = 0.f; }
            w[2 * s] = pack_bf16(a[0], a[1]); w[2 * s + 1] = pack_bf16(a[2], a[3]);
        }
        pf[p] = __builtin_bit_cast(bf16x8, w);
    }
    f32x4 acc[8];
    float ss = 0.f;
#pragma unroll
    for (int vt = 0; vt < 8; ++vt) {
        f32x4 a = (f32x4){0.f, 0.f, 0.f, 0.f};
        a = __builtin_amdgcn_mfma_f32_16x16x32_bf16(*(const bf16x8*)(VT + tile_off(vt * 16 + fr, fq)), pf[0], a, 0, 0, 0);
        a = __builtin_amdgcn_mfma_f32_16x16x32_bf16(*(const bf16x8*)(VT + tile_off(vt * 16 + fr, 4 + fq)), pf[1], a, 0, 0, 0);
        a = __builtin_amdgcn_mfma_f32_16x16x32_bf16(*(const bf16x8*)(PT + tile_off(vt * 16 + fr, fq)), qf0, a, 0, 0, 0);
        a = __builtin_amdgcn_mfma_f32_16x16x32_bf16(*(const bf16x8*)(PT + tile_off(vt * 16 + fr, 4 + fq)), qf1, a, 0, 0, 0);
        acc[vt] = a;
        ss += a[0] * a[0] + a[1] * a[1] + a[2] * a[2] + a[3] * a[3];
    }
    ss += __shfl_xor(ss, 16); ss += __shfl_xor(ss, 32);
    const float r = rsqrtf(ss * (1.0f / 128.0f) + 1e-6f);
    const size_t row = row0 + c;
#pragma unroll
    for (int vt = 0; vt < 8; ++vt) {
        const int col = h * 128 + vt * 16 + 4 * fq;
        const uint2 rr = *(const uint2*)(proj + row * PP + RB + col);
        const f32x4 g4 = *(const f32x4*)(norm_g + col);
        const float r0 = __uint_as_float(rr.x << 16), r1 = __uint_as_float(rr.x & 0xFFFF0000u), r2 = __uint_as_float(rr.y << 16), r3 = __uint_as_float(rr.y & 0xFFFF0000u);
        f32x4 o;
        o[0] = acc[vt][0] * r * g4[0] * (r0 * sigmoidf_(r0)); o[1] = acc[vt][1] * r * g4[1] * (r1 * sigmoidf_(r1));
        o[2] = acc[vt][2] * r * g4[2] * (r2 * sigmoidf_(r2)); o[3] = acc[vt][3] * r * g4[3] * (r3 * sigmoidf_(r3));
        *(uint2*)(yb + row * 512 + col) = pack4(o);
    }
}

constexpr int SMEM_BYTES = 131072;

__global__ void __launch_bounds__(512, 2) k_fwd(Params p) {
    extern __shared__ __attribute__((aligned(16))) char smem_dyn[];
    char* smem = smem_dyn + 16;
    char* smh = smem + (threadIdx.x >> 8) * 65536;
    if (threadIdx.x == 0) *(uint4*)smem_dyn = make_uint4(0u, 0u, 0u, 0u);
    __syncthreads();
    char* ws = p.ws;
    XcdBarrier bar = xcd_barrier_post((unsigned*)(ws + OFF_BAR), (volatile LAS unsigned*)smem_dyn);
    int* ctrl = (int*)(ws + OFF_CTRL);
    bf16_t* proj = (bf16_t*)(ws + OFF_PROJ);
    float* bc = (float*)(ws + OFF_BC);
    float* cstate = (float*)(ws + OFF_CSTATE);
    bf16_t* mrg = (bf16_t*)(ws + OFF_MRG);
    bf16_t* h2 = (bf16_t*)(ws + OFF_H2);
    bf16_t* hid = (bf16_t*)(ws + OFF_HID);
    bf16_t* Y0 = (bf16_t*)(ws + OFF_Y0);
    bf16_t* Y1 = (bf16_t*)(ws + OFF_Y1);
    bf16_t* ya = (bf16_t*)(ws + OFF_YA);
    bf16_t* yb = (bf16_t*)(ws + OFF_YB);
    bf16_t* kcb = (bf16_t*)(ws + OFF_KCB);
    bf16_t* vcb = (bf16_t*)(ws + OFF_VCB);
    bf16_t* h = (bf16_t*)p.out;
    const int G = gridDim.x;

    ph_prep(p, smh);
    xcd_barrier(bar);
    { g8::StaticOrder S; S.init(T, 3072, G, (int)blockIdx.x); const g8::AddrPlain AD{(const char*)h, (const char*)(ws + OFF_WINT), 2048u, 2048u, 16};
      g8::gemm_phase(smem, S, AD, g8::EpiProj{proj}); }
    xcd_barrier(bar);
    ph_cmp1(proj, ws, smh);
    {
        const int nc = G > 32 ? 16 : 0, gb = (int)blockIdx.x - nc, gs = G - nc;
        if (gb >= 0) {
            for (int pr = gb; pr < 512; pr += gs) vtrans_tile(2 * pr + HB_ID, proj, ws, smh);
            for (int pr = gb; pr < 512; pr += gs) gla_a_unit(2 * pr + HB_ID, proj, p.w_alpha, p.b_alpha, bc, cstate, smh);
        }
    }
    xcd_barrier(bar);
    ph_cmp2(ws, ws, smh);
    for (int vb = blockIdx.x; vb < 256; vb += G) gla_scan_vb2(vb, bc, cstate);
    ph_prep_experts(p, smh);
    xcd_barrier(bar);
    for (int vb = HB_FIRST; vb < 1024; vb += HB_STEP) gla_c_unit(vb, proj, bc, cstate, p.norm_g, yb, smh);
    for (int r = 0; r * G < 512; ++r) {
        const int u = r * G + ((r & 1) ? (G - 1 - (int)blockIdx.x) : (int)blockIdx.x);
        if (u < 512) nsa_unit(u, proj, ws, p.rel_bias, ya, smem);
    }
    xcd_barrier(bar);
    {
        g8::MergeOrder MO; MO.so.init(T, 1024, G, (int)blockIdx.x);
        const g8::AddrMerge AD{(const char*)h, (const char*)(ws + OFF_WINT), (const char*)ya, (const char*)yb, (const char*)(ws + OFF_WAT), (const char*)(ws + OFF_WBT)};
        g8::gemm_phase(smem, MO, AD, g8::EpiMergeAll{mrg, (bf16_t*)(ws + OFF_R1)});
    }
    xcd_barrier(bar);
    { g8::StaticOrder S; S.init(T, 1024, G, (int)blockIdx.x); const g8::AddrPlain AD{(const char*)mrg, (const char*)(ws + OFF_WOT), 2048u, 2048u, 16};
      g8::gemm_phase(smem, S, AD, g8::EpiResid{p.x, p.out}); }
    xcd_barrier(bar);
    for (int grp = HB_FIRST; grp < 512; grp += HB_STEP) {
        for (int tt = 0; tt < 2; ++tt) router_unit(grp * 2 + tt, p.out, p.g_ffn, (const bf16_t*)(ws + OFF_WRT), p.b_rg, p.b_re, h2, (float*)(ws + OFF_RSTD), smh);
        router_append(grp, (int*)(ws + OFF_LTOK), (float*)(ws + OFF_LW), ctrl, smh);
    }
    xcd_barrier(bar);
    ph_moe1(h2, (const bf16_t*)(ws + OFF_WGT), (const bf16_t*)(ws + OFF_WUT), ctrl, (const int*)(ws + OFF_LTOK), (const float*)(ws + OFF_LW), (const float*)(ws + OFF_RSTD), hid, smh);
    ph_prep_experts_down(p, ctrl, smh);
    xcd_barrier(bar);
    ph_moe2(hid, (const bf16_t*)(ws + OFF_WDT), ctrl, (const int*)(ws + OFF_LTOK), Y0, smh);
    xcd_barrier(bar);
    { int t_ = threadIdx.x; asm volatile("" : "+v"(t_)); for (int row = blockIdx.x * 8 + (t_ >> 6); row < T; row += G * 8) final_row(row, p.out, Y0, Y1, p.g_final, t_ & 63); }
}

extern "C" void kernel_launch(void* const* d_in, const int* in_sizes, int n_in, void* d_out, int out_size, void* d_ws, size_t ws_size, hipStream_t stream) {
    static int grid = 0;
    constexpr int kDynLds = SMEM_BYTES + 16;
    if (!grid) {
        int dev = 0, cus = 0, per_cu = 0;
        (void)hipGetDevice(&dev);
        (void)hipDeviceGetAttribute(&cus, hipDeviceAttributeMultiprocessorCount, dev);
        (void)hipFuncSetAttribute((const void*)k_fwd, hipFuncAttributeMaxDynamicSharedMemorySize, kDynLds);
        (void)hipOccupancyMaxActiveBlocksPerMultiprocessor(&per_cu, k_fwd, 512, kDynLds);
        if (per_cu > 1) per_cu = 1;
        if (per_cu < 1) per_cu = 1;
        grid = cus * per_cu;
    }
    char* ws = (char*)d_ws;
    (void)hipMemsetAsync(ws + OFF_CTRL, 0, 32768, stream);
    Params p{};
    const float** pf = (const float**)&p;
    for (int i = 0; i < 25; ++i) pf[i] = (const float*)d_in[i];
    p.out = (float*)d_out; p.ws = ws;
    k_fwd<<<grid, 512, kDynLds, stream>>>(p);
}
```

```cpp
#include <hip/hip_runtime.h>
#include <stdint.h>

typedef unsigned short bf16_t;
typedef short bf16x8 __attribute__((ext_vector_type(8)));
typedef float f32x4 __attribute__((ext_vector_type(4)));
typedef unsigned u32x4 __attribute__((ext_vector_type(4)));
__device__ __forceinline__ float bf2f(bf16_t v) { return __uint_as_float(((unsigned)v) << 16); }
__device__ __forceinline__ bf16_t f2bf(float f) { unsigned u = __float_as_uint(f); u += 0x7FFFu + ((u >> 16) & 1u); return (bf16_t)(u >> 16); }
__device__ __forceinline__ unsigned pack_bf16(float lo, float hi) { unsigned r; asm volatile("v_cvt_pk_bf16_f32 %0, %1, %2" : "=v"(r) : "v"(lo), "v"(hi)); return r; }

constexpr int Bn = 4, S = 4096, T = Bn * S, D = 1024, NIN = 4904, PP = 2880;
constexpr int QA = 0, KC = 512, VC = 640, KS = 768, VS = 896, KW = 1024, VW = 1152, GA = 1280, QB = 1304, KB = 1560, VB = 1816, AB = 2328, RB = 2344, MGA = 2856, MGB = 3880;
constexpr int NPROJ = 2856;
constexpr int MSLOT = 36864;

constexpr size_t OFF_CTRL = 0;
constexpr size_t OFF_BAR = 16384;
constexpr size_t OFF_ROUTE_E = 32768;
constexpr size_t OFF_ROUTE_W = OFF_ROUTE_E + 32768 * 4;
constexpr size_t OFF_SLOT_TOK = OFF_ROUTE_W + 32768 * 4;
constexpr size_t OFF_SLOT_W = OFF_SLOT_TOK + (size_t)MSLOT * 4;
constexpr size_t OFF_BIAS1 = OFF_SLOT_W + (size_t)MSLOT * 4;
constexpr size_t OFF_RSTD = OFF_BIAS1 + 1024;
constexpr size_t OFF_SLOT_RS = OFF_RSTD + (size_t)T * 4;
constexpr size_t OFF_WRT = OFF_SLOT_RS + (size_t)MSLOT * 4;
static_assert(OFF_WRT + 2 * 48 * 1024 * 2 <= (1u << 20), "ctrl overflow");
constexpr size_t OFF_R1 = 1u << 20;
constexpr size_t SZ_PROJ = (size_t)T * PP * 2;
constexpr size_t OFF_PROJ = OFF_R1;
constexpr size_t OFF_BC = OFF_PROJ + SZ_PROJ;
constexpr size_t OFF_CSTATE = OFF_BC + (size_t)T * 256 * 4;
constexpr size_t OFF_R1_END = OFF_CSTATE + (size_t)1024 * 8192 * 4;
constexpr size_t OFF_MRG = OFF_R1 + (size_t)T * 2048 * 2;
constexpr size_t OFF_H2 = OFF_R1;
constexpr size_t OFF_HID = OFF_H2 + (size_t)T * 1024 * 2;
constexpr size_t OFF_Y0 = OFF_HID + (size_t)2 * T * 256 * 2;
constexpr size_t OFF_Y1 = OFF_Y0 + (size_t)T * 1024 * 2;
static_assert(OFF_MRG + (size_t)T * 1024 * 2 <= OFF_R1_END, "alias overflow");
static_assert(OFF_Y1 + (size_t)T * 1024 * 2 <= OFF_R1_END, "alias overflow");
constexpr size_t OFF_YA = OFF_R1_END;
constexpr size_t OFF_YB = OFF_YA + (size_t)T * 512 * 2;
constexpr size_t OFF_KCB = OFF_YB + (size_t)T * 512 * 2;
constexpr size_t OFF_VCB = OFF_KCB + 8 * 256 * 64 * 2;
constexpr size_t OFF_VCBT = OFF_VCB + 8 * 256 * 64 * 2;
constexpr size_t OFF_HIDC = OFF_VCBT + 8 * 256 * 64 * 2;
constexpr size_t OFF_VST = OFF_HIDC + 2 * 2048 * 128 * 2;
constexpr size_t OFF_VWT = OFF_VST + (size_t)8 * 64 * S * 2;
constexpr size_t OFF_WINT = OFF_VWT + (size_t)8 * 64 * S * 2;
constexpr size_t OFF_CK1T = OFF_WINT + (size_t)NIN * 1024 * 2;
constexpr size_t OFF_CV1T = OFF_CK1T + 128 * 2048 * 2;
constexpr size_t OFF_CK2T = OFF_CV1T + 128 * 2048 * 2;
constexpr size_t OFF_CV2T = OFF_CK2T + 128 * 128 * 2;
constexpr size_t OFF_WAT = OFF_CV2T + 128 * 128 * 2;
constexpr size_t OFF_WBT = OFF_WAT + 1024 * 512 * 2;
constexpr size_t OFF_WOT = OFF_WBT + 1024 * 512 * 2;
constexpr size_t OFF_WGT = OFF_WOT + 1024 * 1024 * 2;
constexpr size_t OFF_WUT = OFF_WGT + (size_t)32 * 256 * 1024 * 2;
constexpr size_t OFF_WDT = OFF_WUT + (size_t)32 * 256 * 1024 * 2;
constexpr size_t OFF_LTOK = OFF_WDT + (size_t)32 * 1024 * 256 * 2;
constexpr size_t OFF_LW = OFF_LTOK + (size_t)32 * 16384 * 4;
constexpr size_t OFF_END = OFF_LW + (size_t)32 * 16384 * 4;
static_assert(OFF_END <= (size_t)256 << 20, "workspace overflow");

#define XB_TMO      128
#define XB_XCNT(j)  (256  + 64 * (j))
#define XB_XSUB(j)  (1280 + 64 * (j))
#define XB_XGEN(j)  (2304 + 64 * (j))
#define XB_TOP      3328
#define XB_TOPGEN   3392
#define XCD_BAR_WORDS 3456
#define XB_SPIN_CAP (1u << 18)
#define LAS __attribute__((address_space(3)))

__device__ __forceinline__ unsigned xb_ld(unsigned* p)              { return __hip_atomic_load(p, __ATOMIC_RELAXED, __HIP_MEMORY_SCOPE_AGENT); }
__device__ __forceinline__ unsigned xb_add(unsigned* p, unsigned v) { return __hip_atomic_fetch_add(p, v, __ATOMIC_RELAXED, __HIP_MEMORY_SCOPE_AGENT); }
__device__ __forceinline__ unsigned xb_xcc_id() { return (unsigned)__builtin_amdgcn_s_getreg((3 << 11) | 20) & 0xFu; }
#define XB_SPIN(cond, bar) do { unsigned _sp = 0; while (cond) { __builtin_amdgcn_s_sleep(1); \
    if ((++_sp & 255u) == 0u) { if (xb_ld(&(bar)[XB_TMO])) break; if (_sp > XB_SPIN_CAP) { atomicAdd(&(bar)[XB_TMO], 1u); break; } } } } while (0)

struct XcdBarrier { unsigned* bar; unsigned x; volatile LAS unsigned* st; };

__device__ __forceinline__ XcdBarrier xcd_barrier_post(unsigned* bar, volatile LAS unsigned* st) {
    XcdBarrier b; b.bar = bar; b.x = xb_xcc_id(); b.st = st;
    if (threadIdx.x == 0) (void)xb_add(&bar[XB_XCNT(b.x)], 1u);
    return b;
}
__device__ __forceinline__ void xcd_barrier_complete(unsigned* bar, unsigned x, unsigned& nloc, unsigned& nx) {
    const unsigned G = gridDim.x * gridDim.y * gridDim.z;
    unsigned sum, cnt, mine, sp = 0u;
    for (;;) {
        sum = 0u; cnt = 0u; mine = 0u;
#pragma unroll
        for (unsigned j = 0; j < 16; ++j) { const unsigned c = xb_ld(&bar[XB_XCNT(j)]); sum += c; cnt += (c > 0u) ? 1u : 0u; mine = (j == x) ? c : mine; }
        if (sum == G) break;
        __builtin_amdgcn_s_sleep(1);
        if ((++sp & 255u) == 0u) { if (xb_ld(&bar[XB_TMO])) break; if (sp > XB_SPIN_CAP) { atomicAdd(&bar[XB_TMO], 1u); break; } }
    }
    nloc = mine > 0u ? mine : 1u; nx = cnt > 0u ? cnt : 1u;
}
__device__ __forceinline__ void xcd_barrier(const XcdBarrier& b) {
    asm volatile("s_waitcnt vmcnt(0)" ::: "memory");
    __syncthreads();
    if (threadIdx.x == 0) {
        unsigned* bar = b.bar;
        __builtin_amdgcn_s_waitcnt(0);
        unsigned nloc = b.st[0], nx = b.st[1];
        if (nloc == 0u) { xcd_barrier_complete(bar, b.x, nloc, nx); b.st[0] = nloc; b.st[1] = nx; }
        const unsigned old = xb_add(&bar[XB_XSUB(b.x)], 1u);
        const unsigned gen = old / nloc;
        if (old + 1u == (gen + 1u) * nloc) {
            __builtin_amdgcn_fence(__ATOMIC_RELEASE, "agent");
            asm volatile("s_waitcnt vmcnt(0)" ::: "memory");
            const unsigned og = xb_add(&bar[XB_TOP], 1u);
            const unsigned tg = og / nx;
            if (og + 1u == (tg + 1u) * nx) xb_add(&bar[XB_TOPGEN], 1u);
            else XB_SPIN(xb_ld(&bar[XB_TOPGEN]) == tg, bar);
            __builtin_amdgcn_fence(__ATOMIC_ACQUIRE, "agent");
            xb_add(&bar[XB_XGEN(b.x)], 1u);
            asm volatile("s_waitcnt vmcnt(0)" ::: "memory");
        } else {
            XB_SPIN(xb_ld(&bar[XB_XGEN(b.x)]) == gen, bar);
            __builtin_amdgcn_fence(__ATOMIC_ACQUIRE, "agent");
            asm volatile("s_waitcnt vmcnt(0)" ::: "memory");
        }
    }
    __syncthreads();
}


__device__ __forceinline__ int hb_tid_() { int t = threadIdx.x; asm volatile("" : "+v"(t)); return t & 255; }
#define HB_TID (hb_tid_())
#define HB_ID ((int)(threadIdx.x >> 8))
#define HB_FIRST (2 * (int)blockIdx.x + HB_ID)
#define HB_STEP (2 * (int)gridDim.x)
struct Params {
    const float *x, *g_mix, *w_in, *pe_k, *ck1, *ck2, *pe_v, *cv1, *cv2, *rel_bias, *w_alpha, *b_alpha, *norm_g, *w_ba, *w_bb, *w_out, *g_ffn,
                *w_rg, *b_rg, *w_re, *b_re, *w_eg, *w_eu, *w_ed, *g_final;
    float* out; char* ws;
};

__device__ __forceinline__ float wave_max(float v) { for (int o = 32; o > 0; o >>= 1) v = fmaxf(v, __shfl_xor(v, o)); return v; }
__device__ __forceinline__ float wave_sum(float v) { for (int o = 32; o > 0; o >>= 1) v += __shfl_xor(v, o); return v; }
__device__ __forceinline__ void wave_lds_sync() { asm volatile("s_waitcnt lgkmcnt(0)" ::: "memory"); }


__device__ __forceinline__ void rms_h_row(int row, const float* __restrict__ x, const float* __restrict__ g, bf16_t* __restrict__ h, int lane) {
    const float* xr = x + (size_t)row * D + lane * 4;
    f32x4 v[4]; float s = 0.f;
#pragma unroll
    for (int i = 0; i < 4; ++i) { v[i] = *(const f32x4*)(xr + 256 * i); s += v[i][0] * v[i][0] + v[i][1] * v[i][1] + v[i][2] * v[i][2] + v[i][3] * v[i][3]; }
    s = wave_sum(s);
    const float r = rsqrtf(s * (1.0f / D) + 1e-6f);
#pragma unroll
    for (int i = 0; i < 4; ++i) {
        const f32x4 gg = *(const f32x4*)(g + lane * 4 + 256 * i);
        uint2 o; o.x = pack_bf16(v[i][0] * r * gg[0], v[i][1] * r * gg[1]); o.y = pack_bf16(v[i][2] * r * gg[2], v[i][3] * r * gg[3]);
        *(uint2*)(h + (size_t)row * D + lane * 4 + 256 * i) = o;
    }
}
__device__ __forceinline__ void final_row(int row, const float* __restrict__ x, const bf16_t* __restrict__ dl, float* __restrict__ outp, const bf16_t* __restrict__ Y0, const bf16_t* __restrict__ Y1, const float* __restrict__ g, int lane) {
    const float* xr = x + (size_t)row * D + lane * 4;
    f32x4 v[4]; float s = 0.f;
#pragma unroll
    for (int i = 0; i < 4; ++i) {
        v[i] = *(const f32x4*)(xr + 256 * i);
        const uint2 a = *(const uint2*)(Y0 + (size_t)row * D + lane * 4 + 256 * i), c = *(const uint2*)(Y1 + (size_t)row * D + lane * 4 + 256 * i);
        const uint2 e = *(const uint2*)(dl + (size_t)row * D + lane * 4 + 256 * i);
        v[i][0] += __uint_as_float(e.x << 16); v[i][1] += __uint_as_float(e.x & 0xFFFF0000u); v[i][2] += __uint_as_float(e.y << 16); v[i][3] += __uint_as_float(e.y & 0xFFFF0000u);
        v[i][0] += __uint_as_float(a.x << 16) + __uint_as_float(c.x << 16);
        v[i][1] += __uint_as_float(a.x & 0xFFFF0000u) + __uint_as_float(c.x & 0xFFFF0000u);
        v[i][2] += __uint_as_float(a.y << 16) + __uint_as_float(c.y << 16);
        v[i][3] += __uint_as_float(a.y & 0xFFFF0000u) + __uint_as_float(c.y & 0xFFFF0000u);
        s += v[i][0] * v[i][0] + v[i][1] * v[i][1] + v[i][2] * v[i][2] + v[i][3] * v[i][3];
    }
    s = wave_sum(s);
    const float r = rsqrtf(s * (1.0f / D) + 1e-6f);
#pragma unroll
    for (int i = 0; i < 4; ++i) {
        const f32x4 gg = *(const f32x4*)(g + lane * 4 + 256 * i);
        *(f32x4*)(outp + (size_t)row * D + lane * 4 + 256 * i) = (f32x4){v[i][0] * r * gg[0], v[i][1] * r * gg[1], v[i][2] * r * gg[2], v[i][3] * r * gg[3]};
    }
}

__device__ __forceinline__ void prep_router_w(const float* __restrict__ w_rg, const float* __restrict__ w_re, bf16_t* __restrict__ WrT) {
    for (int idx = blockIdx.x * 512 + threadIdx.x; idx < 48 * 1024; idx += gridDim.x * 512) {
        const int n = idx >> 10, k = idx & 1023;
        const float w = n < 4 ? w_rg[k * 4 + n] : (n < 36 ? w_re[k * 32 + n - 4] : 0.f);
        const bf16_t hi = f2bf(w);
        WrT[idx] = hi; WrT[48 * 1024 + idx] = f2bf(w - bf2f(hi));
    }
}

__device__ __forceinline__ void router_unit(int task, const float* __restrict__ x, const bf16_t* __restrict__ dl, const float* __restrict__ g, const bf16_t* __restrict__ WrT,
                                            const float* __restrict__ b_rg, const float* __restrict__ b_re, bf16_t* __restrict__ h2, float* __restrict__ rstd_out,
                                            char* smem) {
    float (*part)[16][49] = (float (*)[16][49])smem;
    int* dec_e = (int*)(smem + 14336); float* dec_w = (float*)(smem + 14336 + 512);
    float (*ssp)[16] = (float (*)[16])(smem + 4 * 16 * 49 * 4);
    const int tid = HB_TID, lane = tid & 63, w4 = tid >> 6, fr = lane & 15, fq = lane >> 4, r0 = task * 16;
    const float* xr = x + (size_t)(r0 + fr) * D + fq * 8 + w4 * 256;
    const bf16_t* dr = dl + (size_t)(r0 + fr) * D + fq * 8 + w4 * 256;
    bf16_t* hr = h2 + (size_t)(r0 + fr) * D + fq * 8 + w4 * 256;
    const bf16_t* wh = WrT + (size_t)fr * 1024 + fq * 8 + w4 * 256;
    const float* gp = g + fq * 8 + w4 * 256;
    f32x4 acc[3];
#pragma unroll
    for (int nt = 0; nt < 3; ++nt) acc[nt] = (f32x4){0.f, 0.f, 0.f, 0.f};
    float ssq = 0.f;
#pragma unroll 4
    for (int ks = 0; ks < 8; ++ks) {
        f32x4 x0 = *(const f32x4*)(xr + ks * 32), x1 = *(const f32x4*)(xr + ks * 32 + 4);
        { const u32x4 dd = *(const u32x4*)(dr + ks * 32);
          x0[0] += __uint_as_float(dd[0] << 16); x0[1] += __uint_as_float(dd[0] & 0xFFFF0000u); x0[2] += __uint_as_float(dd[1] << 16); x0[3] += __uint_as_float(dd[1] & 0xFFFF0000u);
          x1[0] += __uint_as_float(dd[2] << 16); x1[1] += __uint_as_float(dd[2] & 0xFFFF0000u); x1[2] += __uint_as_float(dd[3] << 16); x1[3] += __uint_as_float(dd[3] & 0xFFFF0000u); }
        const f32x4 g0 = *(const f32x4*)(gp + ks * 32), g1 = *(const f32x4*)(gp + ks * 32 + 4);
        float xg[8];
#pragma unroll
        for (int e = 0; e < 4; ++e) { xg[e] = x0[e] * g0[e]; xg[4 + e] = x1[e] * g1[e]; ssq += x0[e] * x0[e] + x1[e] * x1[e]; }
        u32x4 hi, lo;
#pragma unroll
        for (int e = 0; e < 4; ++e) {
            hi[e] = pack_bf16(xg[2 * e], xg[2 * e + 1]);
            lo[e] = pack_bf16(xg[2 * e] - __uint_as_float(hi[e] << 16), xg[2 * e + 1] - __uint_as_float(hi[e] & 0xFFFF0000u));
        }
        *(u32x4*)(hr + ks * 32) = hi;
        const bf16x8 ah = __builtin_bit_cast(bf16x8, hi), al = __builtin_bit_cast(bf16x8, lo);
#pragma unroll
        for (int nt = 0; nt < 3; ++nt) {
            const bf16x8 bh = *(const bf16x8*)(wh + (size_t)nt * 16 * 1024 + ks * 32), bl = *(const bf16x8*)(wh + (size_t)(48 + nt * 16) * 1024 + ks * 32);
            acc[nt] = __builtin_amdgcn_mfma_f32_16x16x32_bf16(ah, bh, acc[nt], 0, 0, 0);
            acc[nt] = __builtin_amdgcn_mfma_f32_16x16x32_bf16(al, bh, acc[nt], 0, 0, 0);
            acc[nt] = __builtin_amdgcn_mfma_f32_16x16x32_bf16(ah, bl, acc[nt], 0, 0, 0);
        }
    }
    ssq += __shfl_xor(ssq, 16); ssq += __shfl_xor(ssq, 32);
    __syncthreads();
    if (fq == 0) ssp[w4][fr] = ssq;
#pragma unroll
    for (int nt = 0; nt < 3; ++nt)
#pragma unroll
        for (int i = 0; i < 4; ++i) part[w4][4 * fq + i][nt * 16 + fr] = acc[nt][i];
    __syncthreads();
    if (tid < 16) {
        const int row = r0 + tid;
        const float rsv = rsqrtf((ssp[0][tid] + ssp[1][tid] + ssp[2][tid] + ssp[3][tid]) * (1.0f / D) + 1e-6f);
        rstd_out[row] = rsv;
        float l4[4];
#pragma unroll
        for (int j = 0; j < 4; ++j) l4[j] = (part[0][tid][j] + part[1][tid][j] + part[2][tid][j] + part[3][tid][j]) * rsv + b_rg[j];
        int gs = 0; float mx = l4[0];
#pragma unroll
        for (int j = 1; j < 4; ++j) if (l4[j] > mx) { mx = l4[j]; gs = j; }
        float den = 0.f;
#pragma unroll
        for (int j = 0; j < 4; ++j) den += __expf(l4[j] - mx);
        const float gpb = 1.f / den;
        float v0 = -3e38f, v1 = -3e38f; int i0 = 0, i1 = 0;
        for (int j = 0; j < 8; ++j) {
            const int c = 4 + gs * 8 + j;
            const float l = (part[0][tid][c] + part[1][tid][c] + part[2][tid][c] + part[3][tid][c]) * rsv + b_re[gs * 8 + j];
            if (l > v0) { v1 = v0; i1 = i0; v0 = l; i0 = j; }
            else if (l > v1) { v1 = l; i1 = j; }
        }
        const float e1 = __expf(v1 - v0);
        const int lr = (task & 1) * 16 + tid;
        dec_e[lr * 2] = gs * 8 + i0; dec_e[lr * 2 + 1] = gs * 8 + i1;
        dec_w[lr * 2] = gpb / (1.f + e1); dec_w[lr * 2 + 1] = gpb * e1 / (1.f + e1);
    }
}
__device__ __forceinline__ void router_append(int group, int* __restrict__ ltok, float* __restrict__ lw, int* __restrict__ cnt, char* smem) {
    int* dec_e = (int*)(smem + 14336); float* dec_w = (float*)(smem + 14336 + 512);
    int* hist = (int*)(smem + 14336 + 1024); int* base = hist + 32;
    const int tid = HB_TID;
    if (tid < 32) hist[tid] = 0;
    __syncthreads();
    int e = 0, lpos = 0;
    if (tid < 64) { e = dec_e[tid]; lpos = atomicAdd(&hist[e], 1); }
    __syncthreads();
    if (tid < 32) { const int hcount = hist[tid]; base[tid] = hcount ? atomicAdd(&cnt[tid * 64], hcount) : 0; }
    __syncthreads();
    if (tid < 64) { const int pos = e * 16384 + base[e] + lpos; ltok[pos] = (group * 32 + (tid >> 1)) * 2 + (tid & 1); lw[pos] = dec_w[tid]; }
    __syncthreads();
}

__device__ __forceinline__ void transpose_tile(const float* __restrict__ src, int ld_src, int N, bf16_t* __restrict__ dst, int ld_dst, int kt, int nt, char* smem) {
    float (*tl)[65] = (float (*)[65])smem;
    const int tid = HB_TID;
    const int c4 = (tid & 15) * 4, r0 = tid >> 4;
#pragma unroll
    for (int i = 0; i < 4; ++i) {
        const int k = r0 + 16 * i, n = nt * 64 + c4;
        float4 v = make_float4(0.f, 0.f, 0.f, 0.f);
        if (n < N) v = *(const float4*)(src + (size_t)(kt * 64 + k) * ld_src + n);
        tl[k][c4] = v.x; tl[k][c4 + 1] = v.y; tl[k][c4 + 2] = v.z; tl[k][c4 + 3] = v.w;
    }
    __syncthreads();
    const int kc = (tid & 7) * 8, n0 = tid >> 3;
#pragma unroll
    for (int i = 0; i < 2; ++i) {
        const int nl = n0 + 32 * i, n = nt * 64 + nl;
        if (n < N) {
            uint4 o;
            o.x = pack_bf16(tl[kc][nl], tl[kc + 1][nl]); o.y = pack_bf16(tl[kc + 2][nl], tl[kc + 3][nl]);
            o.z = pack_bf16(tl[kc + 4][nl], tl[kc + 5][nl]); o.w = pack_bf16(tl[kc + 6][nl], tl[kc + 7][nl]);
            *(uint4*)(dst + (size_t)n * ld_dst + kt * 64 + kc) = o;
        }
    }
    __syncthreads();
}

__device__ __forceinline__ void ph_prep_experts(const Params& p, char* smem) {
    char* ws = p.ws;
    for (int t = HB_FIRST; t < 4096; t += HB_STEP) {
        const int e = (t & 2047) >> 6, r = t & 63;
        if (t < 2048) transpose_tile(p.w_eg + (size_t)e * 1024 * 256, 256, 256, (bf16_t*)(ws + OFF_WGT) + (size_t)e * 256 * 1024, 1024, r >> 2, r & 3, smem);
        else transpose_tile(p.w_eu + (size_t)e * 1024 * 256, 256, 256, (bf16_t*)(ws + OFF_WUT) + (size_t)e * 256 * 1024, 1024, r >> 2, r & 3, smem);
    }
}
__device__ __forceinline__ int moe_tile_decode(const int* __restrict__ cnt, int t, int& e, int& i);
__device__ __forceinline__ void ph_prep_experts_down(const Params& p, const int* __restrict__ cnt, char* smem) {
    char* ws = p.ws;
    int e_, ti_; const int nu = moe_tile_decode(cnt, 0, e_, ti_) * 4, rem = nu % HB_STEP, k = HB_FIRST - rem, st = HB_STEP - rem;
    if (k < 0) return;
    for (int t = k; t < 2048; t += st) {
        const int e = t >> 6, r = t & 63;
        transpose_tile(p.w_ed + (size_t)e * 256 * 1024, 1024, 1024, (bf16_t*)(ws + OFF_WDT) + (size_t)e * 1024 * 256, 256, r >> 4, r & 15, smem);
    }
}
__device__ __forceinline__ void ph_prep(const Params& p, char* smem) {
    char* ws = p.ws;
    constexpr int N0 = 16 * 77, N1 = N0 + 64, N2 = N1 + 64, N3 = N2 + 2, N4 = N3 + 2, N5 = N4 + 128, N6 = N5 + 128, N7 = N6 + 256;
    for (int t = HB_FIRST; t < N7; t += HB_STEP) {
        if (t < N0) transpose_tile(p.w_in, NIN, NIN, (bf16_t*)(ws + OFF_WINT), 1024, t / 77, t % 77, smem);
        else if (t < N1) { const int q = t - N0; transpose_tile(p.ck1, 128, 128, (bf16_t*)(ws + OFF_CK1T), 2048, q >> 1, q & 1, smem); }
        else if (t < N2) { const int q = t - N1; transpose_tile(p.cv1, 128, 128, (bf16_t*)(ws + OFF_CV1T), 2048, q >> 1, q & 1, smem); }
        else if (t < N3) { const int q = t - N2; transpose_tile(p.ck2, 64, 64, (bf16_t*)(ws + OFF_CK2T), 128, q, 0, smem); }
        else if (t < N4) { const int q = t - N3; transpose_tile(p.cv2, 64, 64, (bf16_t*)(ws + OFF_CV2T), 128, q, 0, smem); }
        else if (t < N5) { const int q = t - N4; transpose_tile(p.w_ba, 1024, 1024, (bf16_t*)(ws + OFF_WAT), 512, q >> 4, q & 15, smem); }
        else if (t < N6) { const int q = t - N5; transpose_tile(p.w_bb, 1024, 1024, (bf16_t*)(ws + OFF_WBT), 512, q >> 4, q & 15, smem); }
        else { const int q = t - N6; transpose_tile(p.w_out, 1024, 1024, (bf16_t*)(ws + OFF_WOT), 1024, q >> 4, q & 15, smem); }
    }
    for (int t = HB_FIRST; t < 8; t += HB_STEP) {
        const int which = t >> 2, n = (t & 3) * 32 + (HB_TID & 31), ksp = HB_TID >> 5;
        const float* pe = which ? p.pe_v : p.pe_k; const float* w1 = which ? p.cv1 : p.ck1;
        float a = 0.f;
        for (int k = ksp * 256; k < ksp * 256 + 256; ++k) a += pe[k] * w1[(size_t)k * 128 + n];
        float* red = (float*)smem;
        red[HB_TID] = a;
        __syncthreads();
        if (HB_TID < 32) {
            float s = 0.f;
#pragma unroll
            for (int j = 0; j < 8; ++j) s += red[j * 32 + HB_TID];
            ((float*)(ws + OFF_BIAS1))[which * 128 + n] = s;
        }
        __syncthreads();
    }
    prep_router_w(p.w_rg, p.w_re, (bf16_t*)(ws + OFF_WRT));
    for (int row = blockIdx.x * 8 + (threadIdx.x >> 6); row < T; row += gridDim.x * 8) rms_h_row(row, p.x, p.g_mix, (bf16_t*)p.out, threadIdx.x & 63);
}

__device__ __forceinline__ int tile_off(int row, int chunk) { return row * 128 + ((chunk ^ (row & 7)) << 4); }

__device__ __forceinline__ void glds16(const void* g, char* l) {
    __builtin_amdgcn_global_load_lds((const __attribute__((address_space(1))) unsigned*)g, (__attribute__((address_space(3))) unsigned*)l, 16, 0, 0);
}
__device__ __forceinline__ void gemm_kloop(f32x4 (&acc)[4][4], const bf16_t* const (&pa)[4], const bf16_t* const (&pb)[4], int ka, int kb, int nk, char* smem) {
    int tid_ = HB_TID; asm volatile("" : "+v"(tid_));
    const int tid = tid_, lane = tid & 63, wid = tid >> 6, wr = wid >> 1, wc = wid & 1, fr = lane & 15, fq = lane >> 4;
    const int offA = (wr * 64 + fr) * 128, offB = 16384 + (wc * 64 + fr) * 128, x = fr & 7;
    __syncthreads();
#pragma unroll
    for (int i = 0; i < 4; ++i) { glds16(pa[i], smem + i * 4096 + tid * 16); glds16(pb[i], smem + 16384 + i * 4096 + tid * 16); }
    asm volatile("s_waitcnt vmcnt(0)" ::: "memory");
    __syncthreads();
    for (int kt = 0; kt < nk; ++kt) {
        const int cur = kt & 1;
        if (kt + 1 < nk) {
            char* st = smem + (cur ^ 1) * 32768 + tid * 16;
#pragma unroll
            for (int i = 0; i < 4; ++i) { glds16(pa[i] + (size_t)(kt + 1) * ka, st + i * 4096); glds16(pb[i] + (size_t)(kt + 1) * kb, st + 16384 + i * 4096); }
        }
        const char* sa = smem + cur * 32768 + offA;
        const char* sb = smem + cur * 32768 + offB;
#pragma unroll
        for (int ks = 0; ks < 2; ++ks) {
            const int ch = ((ks * 4 + fq) ^ x) << 4;
            bf16x8 af[4], bfr[4];
#pragma unroll
            for (int mi = 0; mi < 4; ++mi) af[mi] = *(const bf16x8*)(sa + mi * 2048 + ch);
#pragma unroll
            for (int ni = 0; ni < 4; ++ni) bfr[ni] = *(const bf16x8*)(sb + ni * 2048 + ch);
#pragma unroll
            for (int mi = 0; mi < 4; ++mi)
#pragma unroll
                for (int ni = 0; ni < 4; ++ni) acc[mi][ni] = __builtin_amdgcn_mfma_f32_16x16x32_bf16(bfr[ni], af[mi], acc[mi][ni], 0, 0, 0);
        }
        asm volatile("s_waitcnt vmcnt(0)" ::: "memory");
        __syncthreads();
    }
}
__device__ __forceinline__ void acc_zero(f32x4 (&acc)[4][4]) {
#pragma unroll
    for (int mi = 0; mi < 4; ++mi)
#pragma unroll
        for (int ni = 0; ni < 4; ++ni) acc[mi][ni] = (f32x4){0.f, 0.f, 0.f, 0.f};
}
#define GEMM_LANE_VARS const int tid = HB_TID, lane = tid & 63, wid = tid >> 6, wr = wid >> 1, wc = wid & 1, fr = lane & 15, fq = lane >> 4, lrow = tid >> 3, lch8 = ((tid & 7) ^ ((tid >> 3) & 7)) * 8; (void)wr; (void)wc; (void)fr; (void)fq; (void)lrow; (void)lch8;
__device__ __forceinline__ uint2 pack4(f32x4 v) { uint2 o; o.x = pack_bf16(v[0], v[1]); o.y = pack_bf16(v[2], v[3]); return o; }
__device__ __forceinline__ float sigmoidf_(float a) { return 1.f / (1.f + __expf(-a)); }

__device__ __forceinline__ void ph_cmp1(const bf16_t* __restrict__ proj, const char* ws, char* smem) {
    GEMM_LANE_VARS
    for (int u = HB_FIRST; u < 32; u += HB_STEP) {
        const int which = u >> 4, tm = u & 15;
        const bf16_t* W1T = (const bf16_t*)(ws + (which ? OFF_CV1T : OFF_CK1T));
        const float* bias1 = (const float*)(ws + OFF_BIAS1) + which * 128;
        bf16_t* hid = (bf16_t*)(ws + OFF_HIDC) + (size_t)which * 2048 * 128;
        const int col0 = which ? VC : KC;
        const bf16_t* pa[4]; const bf16_t* pb[4];
#pragma unroll
        for (int i = 0; i < 4; ++i) {
            const int m = tm * 128 + lrow + 32 * i, bg = m >> 8, c = (m & 255) > 254 ? 254 : (m & 255), b = bg >> 1, g = bg & 1;
            pa[i] = proj + (size_t)(b * S + 16 * c) * PP + col0 + g * 64 + lch8;
            pb[i] = W1T + (size_t)(lrow + 32 * i) * 2048 + lch8;
        }
        f32x4 acc[4][4]; acc_zero(acc);
        gemm_kloop(acc, pa, pb, PP, 64, 32, smem);
#pragma unroll
        for (int mi = 0; mi < 4; ++mi)
#pragma unroll
            for (int ni = 0; ni < 4; ++ni) {
                const int m = tm * 128 + wr * 64 + mi * 16 + fr, n = wc * 64 + ni * 16 + 4 * fq;
                f32x4 v = acc[mi][ni];
#pragma unroll
                for (int j = 0; j < 4; ++j) { const float a = v[j] + bias1[n + j]; const float t = 0.7978845608028654f * (a + 0.044715f * a * a * a); v[j] = 0.5f * a * (1.f + tanhf(t)); }
                *(uint2*)(hid + (size_t)m * 128 + n) = pack4(v);
            }
    }
}

__device__ __forceinline__ void ph_cmp2(const char* ws_c, char* ws, char* smem) {
    GEMM_LANE_VARS
    for (int u = HB_FIRST; u < 32; u += HB_STEP) {
        const int which = u >> 4, tm = u & 15;
        const bf16_t* W2T = (const bf16_t*)(ws_c + (which ? OFF_CV2T : OFF_CK2T));
        const bf16_t* hid = (const bf16_t*)(ws_c + OFF_HIDC) + (size_t)which * 2048 * 128;
        const bf16_t* pa[4]; const bf16_t* pb[4];
#pragma unroll
        for (int i = 0; i < 4; ++i) { pa[i] = hid + (size_t)(tm * 128 + lrow + 32 * i) * 128 + lch8; pb[i] = W2T + (size_t)(lrow + 32 * i) * 128 + lch8; }
        f32x4 acc[4][4]; acc_zero(acc);
        gemm_kloop(acc, pa, pb, 64, 64, 2, smem);
        if (wc == 0) {
            bf16_t* outp = (bf16_t*)(ws + (which ? OFF_VCB : OFF_KCB));
            bf16_t* outT = (bf16_t*)(ws + OFF_VCBT);
#pragma unroll
            for (int mi = 0; mi < 4; ++mi)
#pragma unroll
                for (int ni = 0; ni < 4; ++ni) {
                    const int m = tm * 128 + wr * 64 + mi * 16 + fr, n = ni * 16 + 4 * fq, c = m & 255, bg = m >> 8;
                    f32x4 v = acc[mi][ni];
                    if (c == 255) v = (f32x4){0.f, 0.f, 0.f, 0.f};
                    *(uint2*)(outp + (size_t)m * 64 + n) = pack4(v);
                    if (which) {
#pragma unroll
                        for (int j = 0; j < 4; ++j) outT[((size_t)bg * 64 + n + j) * 256 + c] = f2bf(v[j]);
                    }
                }
        }
    }
}

__device__ __forceinline__ int moe_tile_decode(const int* __restrict__ cnt, int t, int& e, int& i) {
    int acc = 0; e = 0; i = 0;
    for (int ee = 0; ee < 32; ++ee) { const int nt = (cnt[ee * 64] + 127) >> 7; if (t >= acc && t < acc + nt) { e = ee; i = t - acc; } acc += nt; }
    return acc;
}

__device__ __forceinline__ void ph_moe1(const bf16_t* __restrict__ h2, const bf16_t* __restrict__ WgT, const bf16_t* __restrict__ WuT, const int* __restrict__ cnt,
                                        const int* __restrict__ ltok, const float* __restrict__ lw, const float* __restrict__ rstd, bf16_t* __restrict__ hid, char* smem) {
    GEMM_LANE_VARS
    int e, ti;
    const int nu = moe_tile_decode(cnt, 0, e, ti) * 4;
    for (int u = HB_FIRST; u < nu; u += HB_STEP) {
        const int ft = u & 3;
        (void)moe_tile_decode(cnt, u >> 2, e, ti);
        const int ne = cnt[e * 64];
        const bf16_t* pa[4]; const bf16_t* pb[4];
#pragma unroll
        for (int i = 0; i < 4; ++i) {
            const int rr = lrow + 32 * i, idx = ti * 128 + rr;
            const int tk = idx < ne ? ltok[e * 16384 + idx] : 0;
            pa[i] = h2 + (size_t)(tk >> 1) * 1024 + lch8;
            const int bwc = rr >> 6, bni = (rr >> 4) & 3, bj = rr & 15;
            const int f = ft * 64 + bwc * 32 + (bni >> 1) * 16 + bj;
            pb[i] = ((bni & 1) ? WuT : WgT) + ((size_t)e * 256 + f) * 1024 + lch8;
        }
        f32x4 acc[4][4]; acc_zero(acc);
        gemm_kloop(acc, pa, pb, 64, 64, 16, smem);
#pragma unroll
        for (int mi = 0; mi < 4; ++mi) {
            const int idx = ti * 128 + wr * 64 + mi * 16 + fr;
            if (idx < ne) {
                const int tk = ltok[e * 16384 + idx];
                const float w = lw[e * 16384 + idx], rsv = rstd[tk >> 1];
#pragma unroll
                for (int q = 0; q < 2; ++q) {
                    const int f = ft * 64 + wc * 32 + q * 16 + 4 * fq;
                    f32x4 v;
#pragma unroll
                    for (int j = 0; j < 4; ++j) { const float a = acc[mi][2 * q][j] * rsv, uu = acc[mi][2 * q + 1][j] * rsv; v[j] = a * sigmoidf_(a) * uu * w; }
                    *(uint2*)(hid + (size_t)tk * 256 + f) = pack4(v);
                }
            }
        }
    }
}

__device__ __forceinline__ void ph_moe2(const bf16_t* __restrict__ hid, const bf16_t* __restrict__ WdT, const int* __restrict__ cnt, const int* __restrict__ ltok,
                                        bf16_t* __restrict__ Y, char* smem) {
    GEMM_LANE_VARS
    int e, ti;
    const int nu = moe_tile_decode(cnt, 0, e, ti) * 8;
    for (int u = HB_FIRST; u < nu; u += HB_STEP) {
        const int tn = u & 7;
        (void)moe_tile_decode(cnt, u >> 3, e, ti);
        const int ne = cnt[e * 64];
        const bf16_t* pa[4]; const bf16_t* pb[4];
#pragma unroll
        for (int i = 0; i < 4; ++i) {
            const int idx = ti * 128 + lrow + 32 * i;
            const int tk = idx < ne ? ltok[e * 16384 + idx] : 0;
            pa[i] = hid + (size_t)tk * 256 + lch8;
            pb[i] = WdT + ((size_t)e * 1024 + tn * 128 + lrow + 32 * i) * 256 + lch8;
        }
        f32x4 acc[4][4]; acc_zero(acc);
        gemm_kloop(acc, pa, pb, 64, 64, 4, smem);
#pragma unroll
        for (int mi = 0; mi < 4; ++mi) {
            const int idx = ti * 128 + wr * 64 + mi * 16 + fr;
            if (idx < ne) {
                const int tk = ltok[e * 16384 + idx];
                bf16_t* yr = Y + ((size_t)(tk & 1) * T + (size_t)(tk >> 1)) * 1024 + tn * 128 + wc * 64 + 4 * fq;
#pragma unroll
                for (int ni = 0; ni < 4; ++ni) *(uint2*)(yr + ni * 16) = pack4(acc[mi][ni]);
            }
        }
    }
}

namespace g8 {
constexpr int HTB = 128 * 64 * 2;
__device__ __forceinline__ int lds_byte(int r, int c) { const int st = (r >> 4) * 2 + (c >> 5), rr = r & 15, cc = c & 31, ob = rr * 64 + cc * 2; return st * 1024 + (ob ^ (((ob >> 9) & 1) << 5)); }
__device__ __forceinline__ void stage_rc(int b, int& R, int& C) { const int st = b / 1024, sb = b % 1024, swz = sb ^ (((sb >> 9) & 1) << 5); R = (st >> 1) * 16 + swz / 64; C = (st & 1) * 32 + (swz % 64) / 2; }
__device__ __forceinline__ int perm32(int rho) { const int n = rho >> 4, i = rho & 15; return 8 * (i >> 2) + 4 * n + (i & 3); }
struct Unit { int pm, pn, e; };
struct StaticOrder {
    int nM, nN, nwg, G, c;
    __device__ __forceinline__ void init(int M, int N, int G_, int c_) { nM = M / 256; nN = N / 256; nwg = nM * nN; G = G_; c = c_; }
    __device__ __forceinline__ bool next(int i, Unit& u) const {
        const long L = (long)i * G + c; if (L >= nwg) return false;
        int wgid = (int)L; { const int q = nwg / 8, r = nwg % 8, xcd = wgid % 8, off = wgid / 8; wgid = (xcd < r ? xcd * (q + 1) : r * (q + 1) + (xcd - r) * q) + off; }
        const int nig = 8 * nN, gid = wgid / nig, fm = gid * 8, gsz = (nM - fm) < 8 ? (nM - fm) : 8;
        u.pm = fm + ((wgid % nig) % gsz); u.pn = (wgid % nig) / gsz; u.e = 0; return true;
    }
};
struct AddrPlain {
    const char* A; const char* Bt; unsigned lda2, ldb2; int ntiles;
    __device__ __forceinline__ const char* a_base(const Unit&) const { return A; }
    __device__ __forceinline__ const char* b_base(const Unit&) const { return Bt; }
    __device__ __forceinline__ int nt(const Unit&) const { return ntiles; }
    __device__ __forceinline__ int a_row0(const Unit& u) const { return u.pm * 256; }
    __device__ __forceinline__ int b_row0(const Unit& u) const { return u.pn * 256; }
    __device__ __forceinline__ unsigned a_ld(const Unit&) const { return lda2; }
    __device__ __forceinline__ unsigned b_ld(const Unit&) const { return ldb2; }
};

template <class Epi, class Sched, class Addr>
__device__ __forceinline__ void gemm_phase(char* ldsc, const Sched& S, const Addr& AD, const Epi& E) {
    __attribute__((address_space(3))) unsigned char* lds = (__attribute__((address_space(3))) unsigned char*)ldsc;
    int tid_ = threadIdx.x; asm volatile("" : "+v"(tid_));
    const int tid = tid_, wid = __builtin_amdgcn_readfirstlane(tid >> 6), lane = tid & 63, wr = wid >> 2, wc = wid & 3, fr = lane & 15, fq = lane >> 4;
    int R[2], C2[2], Rb[2];
#pragma unroll
    for (int i = 0; i < 2; ++i) { int r_, c_; stage_rc(tid * 16 + i * 8192, r_, c_); R[i] = r_; C2[i] = c_ * 2; Rb[i] = Epi::PERM ? ((r_ & ~31) + perm32(r_ & 31)) : r_; }
    const unsigned ldsw = (unsigned)wid * 1024u;
    const int aoff = lds_byte(wr * 64 + fr, fq * 8), boff = lds_byte(wc * 32 + fr, fq * 8);
#define G8_SA(b, h) (((b) * 2 + (h)) * HTB)
#define G8_SB(b, h) ((4 + (b) * 2 + (h)) * HTB)
#define G8_STAGE(bufoff, base, rowv, row0, ld, h, kb) do { _Pragma("unroll") for (int _i = 0; _i < 2; ++_i) \
        __builtin_amdgcn_global_load_lds((const __attribute__((address_space(1))) unsigned*)((base) + (size_t)((unsigned)((row0) + (h) * 128 + (rowv)[_i]) * (ld) + (unsigned)C2[_i] + (unsigned)(kb))), \
                                         (__attribute__((address_space(3))) unsigned*)(lds + (bufoff) + ldsw + _i * 8192), 16, 0, 0); } while (0)
#define G8_LDA(dst, b, h) do { _Pragma("unroll") for (int m = 0; m < 4; ++m) _Pragma("unroll") for (int k = 0; k < 2; ++k) dst[m][k] = *(const __attribute__((address_space(3))) bf16x8*)(lds + G8_SA(b, h) + aoff + m * 2048 + k * 1024); } while (0)
#define G8_LDB(dst, b, h) do { _Pragma("unroll") for (int n = 0; n < 2; ++n) _Pragma("unroll") for (int k = 0; k < 2; ++k) dst[n][k] = *(const __attribute__((address_space(3))) bf16x8*)(lds + G8_SB(b, h) + boff + n * 2048 + k * 1024); } while (0)
#define G8_MMA(ai, bj, At, Bt) do { __builtin_amdgcn_s_setprio(1); _Pragma("unroll") for (int m = 0; m < 4; ++m) _Pragma("unroll") for (int n = 0; n < 2; ++n) _Pragma("unroll") for (int k = 0; k < 2; ++k) \
        acc[ai][bj][m][n] = __builtin_amdgcn_mfma_f32_16x16x32_bf16(Bt[n][k], At[m][k], acc[ai][bj][m][n], 0, 0, 0); __builtin_amdgcn_s_setprio(0); } while (0)
#define G8_WAIT_V(n) asm volatile("s_waitcnt vmcnt(" #n ")" ::: "memory")
#define G8_WAIT_L(n) asm volatile("s_waitcnt lgkmcnt(" #n ")" ::: "memory")
#define G8_BAR __builtin_amdgcn_s_barrier()
#define G8_SCHED __builtin_amdgcn_sched_barrier(0)
    Unit cur, nxt; int ui = 0;
    if (!S.next(0, cur)) return;
    f32x4 acc[2][2][4][2];
#pragma unroll
    for (int a = 0; a < 2; ++a)
#pragma unroll
        for (int b = 0; b < 2; ++b)
#pragma unroll
            for (int m = 0; m < 4; ++m)
#pragma unroll
                for (int n = 0; n < 2; ++n) acc[a][b][m][n] = (f32x4){0.f, 0.f, 0.f, 0.f};
    bf16x8 At[4][2], B0[2][2], B1[2][2];
    const char* Ab = AD.a_base(cur); const char* Bb = AD.b_base(cur);
    int ar0 = AD.a_row0(cur), br0 = AD.b_row0(cur); unsigned ald = AD.a_ld(cur), bld = AD.b_ld(cur);
    __syncthreads();
    G8_STAGE(G8_SB(0, 0), Bb, Rb, br0, bld, 0, 0); G8_STAGE(G8_SA(0, 0), Ab, R, ar0, ald, 0, 0); G8_STAGE(G8_SB(0, 1), Bb, Rb, br0, bld, 1, 0); G8_STAGE(G8_SA(0, 1), Ab, R, ar0, ald, 1, 0);
    if (wr == 1) G8_BAR;
    G8_WAIT_V(4); G8_BAR;
    G8_STAGE(G8_SB(1, 0), Bb, Rb, br0, bld, 0, 128); G8_STAGE(G8_SA(1, 0), Ab, R, ar0, ald, 0, 128); G8_STAGE(G8_SB(1, 1), Bb, Rb, br0, bld, 1, 128);
    G8_WAIT_V(6); G8_BAR;
    for (;;) {
        const bool has_next = S.next(ui + 1, nxt);
        const int nt = AD.nt(cur);
        const char* nAb = has_next ? AD.a_base(nxt) : Ab; const char* nBb = has_next ? AD.b_base(nxt) : Bb;
        const int nar0 = has_next ? AD.a_row0(nxt) : ar0, nbr0 = has_next ? AD.b_row0(nxt) : br0;
        const unsigned nald = has_next ? AD.a_ld(nxt) : ald, nbld = has_next ? AD.b_ld(nxt) : bld;
        for (int t = 0; t < nt; t += 2) {
            const bool last = (t == nt - 2);
            const int kb1 = (t + 1) * 128, kb2 = last ? 0 : (t + 2) * 128, kb3 = kb2 + 128;
            const char* sAb = last ? nAb : Ab; const char* sBb = last ? nBb : Bb;
            const int sar0 = last ? nar0 : ar0, sbr0 = last ? nbr0 : br0; const unsigned sald = last ? nald : ald, sbld = last ? nbld : bld;
            G8_LDB(B0, 0, 0); G8_SCHED; G8_LDA(At, 0, 0); G8_STAGE(G8_SA(1, 1), Ab, R, ar0, ald, 1, kb1);
            G8_WAIT_L(8); G8_BAR; G8_WAIT_L(0); G8_MMA(0, 0, At, B0); G8_BAR; G8_SCHED;
            G8_LDB(B1, 0, 1); G8_STAGE(G8_SB(0, 0), sBb, Rb, sbr0, sbld, 0, kb2);
            G8_BAR; G8_WAIT_L(0); G8_MMA(0, 1, At, B1); G8_BAR;
            G8_LDA(At, 0, 1); G8_STAGE(G8_SA(0, 0), sAb, R, sar0, sald, 0, kb2);
            G8_BAR; G8_WAIT_L(0); G8_MMA(1, 0, At, B0); G8_BAR; G8_SCHED;
            G8_STAGE(G8_SB(0, 1), sBb, Rb, sbr0, sbld, 1, kb2);
            G8_WAIT_V(6); G8_BAR; G8_MMA(1, 1, At, B1); G8_BAR;
            G8_LDB(B0, 1, 0); G8_SCHED; G8_LDA(At, 1, 0); G8_STAGE(G8_SA(0, 1), sAb, R, sar0, sald, 1, kb2);
            G8_WAIT_L(8); G8_BAR; G8_WAIT_L(0); G8_MMA(0, 0, At, B0); G8_BAR; G8_SCHED;
            G8_LDB(B1, 1, 1); G8_STAGE(G8_SB(1, 0), sBb, Rb, sbr0, sbld, 0, kb3);
            G8_BAR; G8_WAIT_L(0); G8_MMA(0, 1, At, B1); G8_BAR;
            G8_LDA(At, 1, 1); G8_STAGE(G8_SA(1, 0), sAb, R, sar0, sald, 0, kb3);
            G8_BAR; G8_WAIT_L(0); G8_MMA(1, 0, At, B0); G8_BAR; G8_SCHED;
            G8_STAGE(G8_SB(1, 1), sBb, Rb, sbr0, sbld, 1, kb3);
            G8_WAIT_V(6); G8_BAR; G8_MMA(1, 1, At, B1); G8_BAR;
        }
        E(acc, cur, wr, wc, fr, fq);
        if (!has_next) break;
#pragma unroll
        for (int a = 0; a < 2; ++a)
#pragma unroll
            for (int b = 0; b < 2; ++b)
#pragma unroll
                for (int m = 0; m < 4; ++m)
#pragma unroll
                    for (int n = 0; n < 2; ++n) acc[a][b][m][n] = (f32x4){0.f, 0.f, 0.f, 0.f};
        cur = nxt; Ab = nAb; Bb = nBb; ar0 = nar0; br0 = nbr0; ald = nald; bld = nbld; ++ui;
    }
    G8_WAIT_V(0);
    if (wr == 0) G8_BAR;
    G8_BAR;
#undef G8_SA
#undef G8_SB
#undef G8_STAGE
#undef G8_LDA
#undef G8_LDB
#undef G8_MMA
#undef G8_WAIT_V
#undef G8_WAIT_L
#undef G8_BAR
#undef G8_SCHED
}

struct EpiProj {
    static constexpr bool PERM = true;
    bf16_t* proj;
    __device__ __forceinline__ void operator()(const f32x4 (&acc)[2][2][4][2], const Unit& u, int wr, int wc, int fr, int fq) const {
#pragma unroll
        for (int ai = 0; ai < 2; ++ai)
#pragma unroll
            for (int m = 0; m < 4; ++m) {
                const int r = u.pm * 256 + ai * 128 + wr * 64 + m * 16 + fr;
#pragma unroll
                for (int bj = 0; bj < 2; ++bj) {
                    const int c = u.pn * 256 + bj * 128 + wc * 32 + 8 * fq;
                    if (c < NPROJ) {
                        u32x4 w; w[0] = pack_bf16(acc[ai][bj][m][0][0], acc[ai][bj][m][0][1]); w[1] = pack_bf16(acc[ai][bj][m][0][2], acc[ai][bj][m][0][3]);
                        w[2] = pack_bf16(acc[ai][bj][m][1][0], acc[ai][bj][m][1][1]); w[3] = pack_bf16(acc[ai][bj][m][1][2], acc[ai][bj][m][1][3]);
                        *(u32x4*)(proj + (size_t)r * PP + c) = w;
                    }
                }
            }
    }
};
struct EpiDelta {
    static constexpr bool PERM = true;
    bf16_t* dl;
    __device__ __forceinline__ void operator()(const f32x4 (&acc)[2][2][4][2], const Unit& u, int wr, int wc, int fr, int fq) const {
#pragma unroll
        for (int ai = 0; ai < 2; ++ai)
#pragma unroll
            for (int m = 0; m < 4; ++m) {
                const int r = u.pm * 256 + ai * 128 + wr * 64 + m * 16 + fr;
#pragma unroll
                for (int bj = 0; bj < 2; ++bj) {
                    const int c = u.pn * 256 + bj * 128 + wc * 32 + 8 * fq;
                    u32x4 w; w[0] = pack_bf16(acc[ai][bj][m][0][0], acc[ai][bj][m][0][1]); w[1] = pack_bf16(acc[ai][bj][m][0][2], acc[ai][bj][m][0][3]);
                    w[2] = pack_bf16(acc[ai][bj][m][1][0], acc[ai][bj][m][1][1]); w[3] = pack_bf16(acc[ai][bj][m][1][2], acc[ai][bj][m][1][3]);
                    *(u32x4*)(dl + (size_t)r * 1024 + c) = w;
                }
            }
    }
};
struct OneUnit { Unit u; __device__ __forceinline__ bool next(int i, Unit& o) const { if (i) return false; o = u; return true; } };
template <int OP>
struct EpiMerge {
    static constexpr bool PERM = true;
    bf16_t* dst; const bf16_t* src2;
    __device__ __forceinline__ void operator()(const f32x4 (&acc)[2][2][4][2], const Unit& u, int wr, int wc, int fr, int fq) const {
#pragma unroll
        for (int ai = 0; ai < 2; ++ai)
#pragma unroll
            for (int m = 0; m < 4; ++m) {
                const int r = u.pm * 256 + ai * 128 + wr * 64 + m * 16 + fr;
#pragma unroll
                for (int bj = 0; bj < 2; ++bj) {
                    const size_t o = (size_t)r * 1024 + u.pn * 256 + bj * 128 + wc * 32 + 8 * fq;
                    float v[8];
#pragma unroll
                    for (int j = 0; j < 4; ++j) { v[j] = acc[ai][bj][m][0][j]; v[4 + j] = acc[ai][bj][m][1][j]; }
                    if (OP == 0) {
#pragma unroll
                        for (int j = 0; j < 8; ++j) v[j] = sigmoidf_(v[j]);
                    } else {
                        const u32x4 d = *(const u32x4*)(dst + o);
                        float dv[8];
#pragma unroll
                        for (int j = 0; j < 4; ++j) { dv[2 * j] = __uint_as_float(d[j] << 16); dv[2 * j + 1] = __uint_as_float(d[j] & 0xFFFF0000u); }
                        if (OP == 1) {
#pragma unroll
                            for (int j = 0; j < 8; ++j) v[j] = dv[j] * v[j];
                        } else {
                            const u32x4 s = *(const u32x4*)(src2 + o);
#pragma unroll
                            for (int j = 0; j < 4; ++j) { v[2 * j] = dv[2 * j] + __uint_as_float(s[j] << 16) * v[2 * j]; v[2 * j + 1] = dv[2 * j + 1] + __uint_as_float(s[j] & 0xFFFF0000u) * v[2 * j + 1]; }
                        }
                    }
                    u32x4 w; w[0] = pack_bf16(v[0], v[1]); w[1] = pack_bf16(v[2], v[3]); w[2] = pack_bf16(v[4], v[5]); w[3] = pack_bf16(v[6], v[7]);
                    *(u32x4*)(dst + o) = w;
                }
            }
    }
};
struct MergeOrder { StaticOrder so; __device__ __forceinline__ bool next(int i, Unit& u) const { if (!so.next(i >> 2, u)) return false; u.e = i & 3; return true; } };
struct AddrMerge {
    const char* h; const char* WinT; const char* ya; const char* yb; const char* WaT; const char* WbT;
    __device__ __forceinline__ const char* a_base(const Unit& u) const {
        const unsigned long long ph = (unsigned long long)h, pa = (unsigned long long)ya, pb = (unsigned long long)yb, o = (unsigned long long)(u.e & 1), t = (unsigned long long)((u.e >> 1) & 1);
        return (const char*)(ph + o * ((pa - ph) + t * (pb - pa))); }
    __device__ __forceinline__ const char* b_base(const Unit& u) const {
        const unsigned long long pg = (unsigned long long)(WinT + (size_t)MGA * 2048), pa = (unsigned long long)WaT, pb = (unsigned long long)WbT, o = (unsigned long long)(u.e & 1), t = (unsigned long long)((u.e >> 1) & 1);
        const unsigned long long g = pg + t * (unsigned long long)((size_t)(MGB - MGA) * 2048), y = pa + t * (pb - pa);
        return (const char*)(g + o * (y - g)); }
    __device__ __forceinline__ int nt(const Unit& u) const { return (u.e & 1) ? 8 : 16; }
    __device__ __forceinline__ int a_row0(const Unit& u) const { return u.pm * 256; }
    __device__ __forceinline__ int b_row0(const Unit& u) const { return u.pn * 256; }
    __device__ __forceinline__ unsigned a_ld(const Unit& u) const { return (u.e & 1) ? 1024u : 2048u; }
    __device__ __forceinline__ unsigned b_ld(const Unit& u) const { return (u.e & 1) ? 1024u : 2048u; }
};
struct EpiMergeAll {
    static constexpr bool PERM = true;
    bf16_t* mrg; bf16_t* sg2;
    __device__ __forceinline__ void operator()(const f32x4 (&acc)[2][2][4][2], const Unit& u, int wr, int wc, int fr, int fq) const {
        if (u.e == 0) EpiMerge<0>{mrg, nullptr}(acc, u, wr, wc, fr, fq);
        else if (u.e == 1) EpiMerge<1>{mrg, nullptr}(acc, u, wr, wc, fr, fq);
        else if (u.e == 2) EpiMerge<0>{sg2, nullptr}(acc, u, wr, wc, fr, fq);
        else EpiMerge<2>{mrg, sg2}(acc, u, wr, wc, fr, fq);
    }
};
}

constexpr float LOG2E = 1.4426950408889634f;
constexpr float NEGV = -3.0e38f;
constexpr int NSA_TB = 32768;
constexpr int NSA_IMPA = 34816;
constexpr int NSA_IMPB = NSA_IMPA + 16640;
constexpr int NSA_SELM = NSA_IMPB + 16640;

__device__ __forceinline__ int t5_bucket2(int n) {
    if (n < 16) return n;
    const int l = 16 + (int)(logf((float)n / 16.0f) / logf(8.0f) * 16.0f);
    return l < 31 ? l : 31;
}

template <int MODE, bool A0, bool A1>
__device__ __forceinline__ void nsa_tile(const char* Kst, const char* Vst, int j, bool fast, const float* tbias, const bf16x8 (&qf)[2][2], const int (&qidx)[2],
                                         const unsigned long long (&selq)[2], f32x4 (&O)[4][2], float (&m)[2], float (&l)[2], const float (&invl)[2],
                                         char* smem, int fr, int fq, int hp, int wid) {
    const float b127 = tbias[127];
    bf16x8 pf[2][2];
    bool started = true;
    if (MODE != 3) started = __builtin_amdgcn_ballot_w64((A0 && m[0] < -1e29f) || (A1 && m[1] < -1e29f)) == 0ull;
    const bool quick = (MODE != 3) && fast && started;
    f32x4 sall[2][2][2];
#pragma unroll
    for (int p = 0; p < 2; ++p)
#pragma unroll
        for (int s = 0; s < 2; ++s) {
            const int row = 32 * p + 16 * s + fr;
            const bf16x8 k0 = *(const bf16x8*)(Kst + tile_off(row, fq)), k1 = *(const bf16x8*)(Kst + tile_off(row, 4 + fq));
#pragma unroll
            for (int ct = 0; ct < 2; ++ct) {
                if ((ct == 0 && !A0) || (ct == 1 && !A1)) continue;
                float i0 = 0.f;
                if (quick) { const bool sel = (MODE == 1) ? (((selq[ct] >> j) & 1ull) != 0ull) : true; i0 = (sel ? b127 : NEGV) - m[ct]; }
                f32x4 a = (f32x4){i0, i0, i0, i0};
                a = __builtin_amdgcn_mfma_f32_16x16x32_bf16(k0, qf[ct][0], a, 0, 0, 0);
                a = __builtin_amdgcn_mfma_f32_16x16x32_bf16(k1, qf[ct][1], a, 0, 0, 0);
                sall[ct][p][s] = a;
            }
        }
#pragma unroll
    for (int ct = 0; ct < 2; ++ct) {
        if ((ct == 0 && !A0) || (ct == 1 && !A1)) continue;
        f32x4 (&sacc)[2][2] = sall[ct];
        const int q = qidx[ct];
        const bool sel = (MODE == 1) ? (((selq[ct] >> j) & 1ull) != 0ull) : true;
        if (MODE != 3) {
            const float mct = m[ct];
            if (!quick) {
                const float ref = started ? mct : 0.f;
#pragma unroll
                for (int p = 0; p < 2; ++p)
#pragma unroll
                    for (int s = 0; s < 2; ++s)
#pragma unroll
                        for (int i = 0; i < 4; ++i) {
                            const int kk = 64 * j + 32 * p + 8 * fq + 4 * s + i;
                            int rel; bool valid;
                            if (MODE == 0) { rel = q - (16 * kk + 31); valid = rel >= 0; }
                            else if (MODE == 1) { rel = q - kk; valid = (rel >= 0) && sel; }
                            else { rel = q - kk; valid = (rel >= 0) && (rel < 512); }
                            const int rc = rel < 0 ? 0 : (rel > 127 ? 127 : rel);
                            sacc[p][s][i] = valid ? sacc[p][s][i] + (tbias[rc] - ref) : NEGV;
                        }
            }
            float pv[2][8]; float psum = 0.f;
            bool redo = !started;
            if (started) {
#pragma unroll
                for (int p = 0; p < 2; ++p)
#pragma unroll
                    for (int s = 0; s < 2; ++s)
#pragma unroll
                        for (int i = 0; i < 4; ++i) { pv[p][s * 4 + i] = __builtin_amdgcn_exp2f(sacc[p][s][i]); psum += pv[p][s * 4 + i]; }
                if (__builtin_amdgcn_ballot_w64(!(psum <= 256.0f)) != 0ull) {
                    redo = true;
#pragma unroll
                    for (int p = 0; p < 2; ++p)
#pragma unroll
                        for (int s = 0; s < 2; ++s)
#pragma unroll
                            for (int i = 0; i < 4; ++i) sacc[p][s][i] += mct;
                }
            }
            if (redo) {
                float mloc = NEGV;
#pragma unroll
                for (int p = 0; p < 2; ++p)
#pragma unroll
                    for (int s = 0; s < 2; ++s)
#pragma unroll
                        for (int i = 0; i < 4; ++i) mloc = fmaxf(mloc, sacc[p][s][i]);
                mloc = fmaxf(mloc, __shfl_xor(mloc, 16)); mloc = fmaxf(mloc, __shfl_xor(mloc, 32));
                const float mnew = fmaxf(mct, mloc);
                const float alpha = __builtin_amdgcn_exp2f(mct - mnew);
                m[ct] = mnew; l[ct] *= alpha;
#pragma unroll
                for (int dt = 0; dt < 4; ++dt) O[dt][ct] = O[dt][ct] * alpha;
                psum = 0.f;
#pragma unroll
                for (int p = 0; p < 2; ++p)
#pragma unroll
                    for (int s = 0; s < 2; ++s)
#pragma unroll
                        for (int i = 0; i < 4; ++i) { pv[p][s * 4 + i] = __builtin_amdgcn_exp2f(sacc[p][s][i] - mnew); psum += pv[p][s * 4 + i]; }
            }
#pragma unroll
            for (int p = 0; p < 2; ++p) {
                u32x4 w; w[0] = pack_bf16(pv[p][0], pv[p][1]); w[1] = pack_bf16(pv[p][2], pv[p][3]); w[2] = pack_bf16(pv[p][4], pv[p][5]); w[3] = pack_bf16(pv[p][6], pv[p][7]);
                pf[ct][p] = __builtin_bit_cast(bf16x8, w);
            }
            l[ct] += psum;
        } else {
#pragma unroll
            for (int p = 0; p < 2; ++p)
#pragma unroll
                for (int s = 0; s < 2; ++s)
#pragma unroll
                    for (int i = 0; i < 4; ++i) {
                        const int kk = 64 * j + 32 * p + 8 * fq + 4 * s + i;
                        const int rel = q - (16 * kk + 31);
                        const int rc = rel < 0 ? 0 : (rel > 127 ? 127 : rel);
                        sacc[p][s][i] = (rel >= 0) ? sacc[p][s][i] + tbias[rc] : NEGV;
                    }
            float* impA = (float*)(smem + NSA_IMPA); float* impB = (float*)(smem + NSA_IMPB);
            const int ql = wid * 8 + ct * 4 + (fr >> 2);
#pragma unroll
            for (int p = 0; p < 2; ++p)
#pragma unroll
                for (int s = 0; s < 2; ++s) {
                    float p3 = __builtin_amdgcn_exp2f(sacc[p][s][3] - m[ct]) * invl[ct];
                    float pa = __builtin_amdgcn_exp2f(sacc[p][s][0] - m[ct]) * invl[ct] + __builtin_amdgcn_exp2f(sacc[p][s][1] - m[ct]) * invl[ct]
                             + __builtin_amdgcn_exp2f(sacc[p][s][2] - m[ct]) * invl[ct] + p3;
                    pa += __shfl_xor(pa, 1); pa += __shfl_xor(pa, 2);
                    p3 += __shfl_xor(p3, 1); p3 += __shfl_xor(p3, 2);
                    const int jj = 16 * j + 8 * p + 2 * fq + s;
                    if (hp == 0) { impA[ql * 65 + jj] = pa; impB[ql * 65 + jj + 1] = p3; }
                }
        }
    }
    if (MODE != 3) {
#pragma unroll
        for (int dt = 0; dt < 4; ++dt)
#pragma unroll
            for (int p = 0; p < 2; ++p) {
                const bf16x8 vf = *(const bf16x8*)(Vst + tile_off(dt * 16 + fr, p * 4 + fq));
                if (A0) O[dt][0] = __builtin_amdgcn_mfma_f32_16x16x32_bf16(vf, pf[0][p], O[dt][0], 0, 0, 0);
                if (A1) O[dt][1] = __builtin_amdgcn_mfma_f32_16x16x32_bf16(vf, pf[1][p], O[dt][1], 0, 0, 0);
            }
    }
}

template <int MODE>
__device__ __forceinline__ void nsa_branch(const bf16_t* __restrict__ Kb, size_t kstride, const bf16_t* __restrict__ Vb, size_t vstride, int j0, int ntiles, int t0,
                                           const bf16x8 (&qf)[2][2], const int (&qidx)[2], const unsigned long long (&selq)[2], unsigned long long selor0, unsigned long long selor1,
                                           f32x4 (&O)[4][2], float (&m)[2], float (&l)[2], const float (&invl)[2], char* smem) {
    int tid_ = threadIdx.x; asm volatile("" : "+v"(tid_));
    const int tid = tid_, lane = tid & 63, wid = tid >> 6, fr = lane & 15, fq = lane >> 4, hp = fr & 3;
    const int lrow = tid >> 3;
    const float* tbias = (const float*)(smem + NSA_TB) + hp * 128;
    const int sch8 = ((tid & 7) ^ (lrow & 7)) * 8;
    const int krow = 32 * (lrow >> 5) + 8 * ((lrow & 15) >> 2) + 4 * ((lrow >> 4) & 1) + (lrow & 3);
    const bf16_t* kp = Kb + (size_t)krow * kstride + sch8;
    const bf16_t* vp = Vb + (size_t)lrow * vstride + sch8;
    __syncthreads();
    glds16(kp, smem + tid * 16); if (MODE != 3) glds16(vp, smem + 8192 + tid * 16);
    asm volatile("s_waitcnt vmcnt(0)" ::: "memory");
    __syncthreads();
    for (int it = 0; it < ntiles; ++it) {
        const int cur = it & 1, j = j0 + it;
        if (it + 1 < ntiles) {
            char* st = smem + (cur ^ 1) * 16384 + tid * 16;
            glds16(kp + (size_t)(it + 1) * 64 * kstride, st); if (MODE != 3) glds16(vp + (size_t)(it + 1) * 64, st + 8192);
        }
        const char* Kst = smem + cur * 16384;
        const char* Vst = Kst + 8192;
        bool fast;
        if (MODE == 0 || MODE == 3) fast = (t0 - (16 * (64 * j + 63) + 31)) >= 128;
        else if (MODE == 1) fast = (t0 - (64 * j + 63)) >= 128;
        else fast = ((t0 - (64 * j + 63)) >= 128) && ((t0 + 63 - 64 * j) < 512);
        if (MODE == 1) {
            const bool a0 = ((selor0 >> j) & 1ull) != 0ull, a1 = ((selor1 >> j) & 1ull) != 0ull;
            if (a0 && a1) nsa_tile<MODE, true, true>(Kst, Vst, j, fast, tbias, qf, qidx, selq, O, m, l, invl, smem, fr, fq, hp, wid);
            else if (a0) nsa_tile<MODE, true, false>(Kst, Vst, j, fast, tbias, qf, qidx, selq, O, m, l, invl, smem, fr, fq, hp, wid);
            else if (a1) nsa_tile<MODE, false, true>(Kst, Vst, j, fast, tbias, qf, qidx, selq, O, m, l, invl, smem, fr, fq, hp, wid);
        } else {
            nsa_tile<MODE, true, true>(Kst, Vst, j, fast, tbias, qf, qidx, selq, O, m, l, invl, smem, fr, fq, hp, wid);
        }
        asm volatile("s_waitcnt vmcnt(0)" ::: "memory");
        __syncthreads();
    }
}

__device__ __forceinline__ void osum_add(uint2& acc, f32x4 o, float sc) {
    f32x4 v;
    v[0] = __uint_as_float(acc.x << 16) + o[0] * sc; v[1] = __uint_as_float(acc.x & 0xFFFF0000u) + o[1] * sc;
    v[2] = __uint_as_float(acc.y << 16) + o[2] * sc; v[3] = __uint_as_float(acc.y & 0xFFFF0000u) + o[3] * sc;
    acc = pack4(v);
}
__device__ __forceinline__ float nsa_gate(const bf16_t* __restrict__ pb, int q, int br, int head) { return sigmoidf_(bf2f(pb[(size_t)q * PP + GA + br * 8 + head])); }

__device__ __forceinline__ void nsa_unit(int u, const bf16_t* __restrict__ proj, const char* __restrict__ ws, const float* __restrict__ rel_bias, bf16_t* __restrict__ ya, char* smem) {
    int tid_ = threadIdx.x; asm volatile("" : "+v"(tid_));
    const int tid = tid_, lane = tid & 63, wid = tid >> 6, fr = lane & 15, fq = lane >> 4, hp = fr & 3;
    const int bg = u & 7, qb = 63 - (u >> 3), b = bg >> 1, g = bg & 1, t0 = qb * 64, tb = qb;
    const bf16_t* kcb = (const bf16_t*)(ws + OFF_KCB) + (size_t)bg * 256 * 64;
    const bf16_t* vcbT = (const bf16_t*)(ws + OFF_VCBT) + (size_t)bg * 64 * 256;
    const bf16_t* VsT = (const bf16_t*)(ws + OFF_VST) + (size_t)bg * 64 * S;
    const bf16_t* VwT = (const bf16_t*)(ws + OFF_VWT) + (size_t)bg * 64 * S;
    const bf16_t* pb = proj + (size_t)b * S * PP;
    __syncthreads();
    {
        float* tbl = (float*)(smem + NSA_TB);
        { const int e = tid, h4 = e >> 7, n = e & 127; tbl[e] = rel_bias[t5_bucket2(n) * 8 + g * 4 + h4] * LOG2E; }
        float* imp = (float*)(smem + NSA_IMPA);
        for (int e = tid; e < 2 * 4160; e += 512) imp[e] = 0.f;
    }
    int qidx[2]; bf16x8 qf[2][2];
    const int head = g * 4 + hp;
#pragma unroll
    for (int ct = 0; ct < 2; ++ct) {
        qidx[ct] = t0 + wid * 8 + ct * 4 + (fr >> 2);
        const bf16_t* qr = pb + (size_t)qidx[ct] * PP;
#pragma unroll
        for (int ks = 0; ks < 2; ++ks) {
            const u32x4 raw = *(const u32x4*)(qr + QA + head * 64 + ks * 32 + fq * 8);
            u32x4 w;
#pragma unroll
            for (int e = 0; e < 4; ++e) w[e] = pack_bf16(__uint_as_float(raw[e] << 16) * (0.125f * LOG2E), __uint_as_float(raw[e] & 0xFFFF0000u) * (0.125f * LOG2E));
            qf[ct][ks] = __builtin_bit_cast(bf16x8, w);
        }
    }
    uint2 osum[4][2];
#pragma unroll
    for (int dt = 0; dt < 4; ++dt)
#pragma unroll
        for (int ct = 0; ct < 2; ++ct) osum[dt][ct] = make_uint2(0u, 0u);
    unsigned long long selq[2] = {0ull, 0ull};
    float invl0[2] = {0.f, 0.f};
    const int ntc = (((t0 + 32) >> 4) + 1 + 63) >> 6;
    float mC[2], invC[2];
    {
        f32x4 O[4][2]; float m[2] = {-1e30f, -1e30f}, l[2] = {0.f, 0.f};
#pragma unroll
        for (int dt = 0; dt < 4; ++dt)
#pragma unroll
            for (int ct = 0; ct < 2; ++ct) O[dt][ct] = (f32x4){0.f, 0.f, 0.f, 0.f};
        nsa_branch<0>(kcb, 64, vcbT, 256, 0, ntc, t0, qf, qidx, selq, 0ull, 0ull, O, m, l, invl0, smem);
#pragma unroll
        for (int ct = 0; ct < 2; ++ct) {
            float lt = l[ct]; lt += __shfl_xor(lt, 16); lt += __shfl_xor(lt, 32);
            invC[ct] = lt > 0.f ? 1.f / lt : 0.f; mC[ct] = m[ct];
#pragma unroll
            for (int dt = 0; dt < 4; ++dt) osum_add(osum[dt][ct], O[dt][ct], nsa_gate(pb, qidx[ct], 0, head) * invC[ct]);
        }
        nsa_branch<3>(kcb, 64, vcbT, 256, 0, ntc, t0, qf, qidx, selq, 0ull, 0ull, O, mC, l, invC, smem);
    }
    {
        const float* impA = (const float*)(smem + NSA_IMPA); const float* impB = (const float*)(smem + NSA_IMPB);
        unsigned long long* selm = (unsigned long long*)(smem + NSA_SELM);
#pragma unroll 1
        for (int qq = 0; qq < 8; ++qq) {
            const int ql = wid * 8 + qq;
            const float val = impA[ql * 65 + lane] + impB[ql * 65 + lane];
            const bool forced = (lane == 0) || (lane == tb) || (lane == tb - 1);
            unsigned key = forced ? 0xFFFFFFC0u : (lane > tb ? 0u : (__float_as_uint(val) & 0xFFFFFFC0u));
            key |= (unsigned)(63 - lane);
            int rank = 0;
#pragma unroll
            for (int jp = 0; jp < 64; ++jp) rank += ((unsigned)__builtin_amdgcn_readlane((int)key, jp) > key) ? 1 : 0;
            const unsigned long long msk = __ballot(rank < 16);
            if (lane == 0) selm[ql] = msk;
        }
        wave_lds_sync();
        unsigned long long so0 = 0ull, so1 = 0ull;
#pragma unroll
        for (int qq = 0; qq < 4; ++qq) { so0 |= selm[wid * 8 + qq]; so1 |= selm[wid * 8 + 4 + qq]; }
        const unsigned long long selor0 = ((unsigned long long)(unsigned)__builtin_amdgcn_readfirstlane((int)(unsigned)(so0 >> 32)) << 32) | (unsigned)__builtin_amdgcn_readfirstlane((int)(unsigned)so0);
        const unsigned long long selor1 = ((unsigned long long)(unsigned)__builtin_amdgcn_readfirstlane((int)(unsigned)(so1 >> 32)) << 32) | (unsigned)__builtin_amdgcn_readfirstlane((int)(unsigned)so1);
        selq[0] = selm[wid * 8 + (fr >> 2)]; selq[1] = selm[wid * 8 + 4 + (fr >> 2)];
        {
            f32x4 O[4][2]; float m[2] = {-1e30f, -1e30f}, l[2] = {0.f, 0.f};
#pragma unroll
            for (int dt = 0; dt < 4; ++dt)
#pragma unroll
                for (int ct = 0; ct < 2; ++ct) O[dt][ct] = (f32x4){0.f, 0.f, 0.f, 0.f};
            nsa_branch<1>(pb + KS + g * 64, PP, VsT, S, 0, tb + 1, t0, qf, qidx, selq, selor0, selor1, O, m, l, invl0, smem);
#pragma unroll
            for (int ct = 0; ct < 2; ++ct) {
                float lt = l[ct]; lt += __shfl_xor(lt, 16); lt += __shfl_xor(lt, 32);
                const float inv = lt > 0.f ? 1.f / lt : 0.f;
#pragma unroll
                for (int dt = 0; dt < 4; ++dt) osum_add(osum[dt][ct], O[dt][ct], nsa_gate(pb, qidx[ct], 1, head) * inv);
            }
        }
    }
    {
        f32x4 O[4][2]; float m[2] = {-1e30f, -1e30f}, l[2] = {0.f, 0.f};
#pragma unroll
        for (int dt = 0; dt < 4; ++dt)
#pragma unroll
            for (int ct = 0; ct < 2; ++ct) O[dt][ct] = (f32x4){0.f, 0.f, 0.f, 0.f};
        const int jw0 = (t0 - 511 < 0 ? 0 : t0 - 511) >> 6;
        nsa_branch<2>(pb + (size_t)jw0 * 64 * PP + KW + g * 64, PP, VwT + jw0 * 64, S, jw0, tb - jw0 + 1, t0, qf, qidx, selq, 0ull, 0ull, O, m, l, invl0, smem);
#pragma unroll
        for (int ct = 0; ct < 2; ++ct) {
            float lt = l[ct]; lt += __shfl_xor(lt, 16); lt += __shfl_xor(lt, 32);
            const float inv = lt > 0.f ? 1.f / lt : 0.f;
#pragma unroll
            for (int dt = 0; dt < 4; ++dt) osum_add(osum[dt][ct], O[dt][ct], nsa_gate(pb, qidx[ct], 2, head) * inv);
        }
    }
#pragma unroll
    for (int ct = 0; ct < 2; ++ct) {
        bf16_t* yr = ya + (size_t)(b * S + qidx[ct]) * 512 + head * 64 + 4 * fq;
#pragma unroll
        for (int dt = 0; dt < 4; ++dt) *(uint2*)(yr + dt * 16) = osum[dt][ct];
    }
}

__device__ __forceinline__ void vtrans_tile(int task, const bf16_t* __restrict__ proj, char* ws, char* smem) {
    unsigned short (*tl)[66] = (unsigned short (*)[66])smem;
    const int tid = HB_TID, which = task >> 9, bg = (task >> 6) & 7, tt = task & 63, b = bg >> 1, g = bg & 1;
    const int r = tid >> 2, q4 = tid & 3;
    const bf16_t* src = proj + (size_t)(b * S + tt * 64 + r) * PP + (which ? VW : VS) + g * 64 + q4 * 16;
    const uint4 a0 = *(const uint4*)src, a1 = *(const uint4*)(src + 8);
    unsigned* trow = (unsigned*)&tl[r][q4 * 16];
    trow[0] = a0.x; trow[1] = a0.y; trow[2] = a0.z; trow[3] = a0.w; trow[4] = a1.x; trow[5] = a1.y; trow[6] = a1.z; trow[7] = a1.w;
    __syncthreads();
    bf16_t* dst = (bf16_t*)(ws + (which ? OFF_VWT : OFF_VST)) + ((size_t)bg * 64 + r) * S + tt * 64 + q4 * 16;
    unsigned o[8];
#pragma unroll
    for (int k = 0; k < 8; ++k) o[k] = (unsigned)tl[q4 * 16 + 2 * k][r] | ((unsigned)tl[q4 * 16 + 2 * k + 1][r] << 16);
    *(uint4*)dst = make_uint4(o[0], o[1], o[2], o[3]);
    *(uint4*)(dst + 8) = make_uint4(o[4], o[5], o[6], o[7]);
    __syncthreads();
}

__device__ __forceinline__ int tile_el(int row, int col) { return tile_off(row, col >> 3) + ((col & 7) << 1); }

__device__ __forceinline__ void gla_stage_vt(const bf16_t* __restrict__ proj, size_t row0, int h, char* vt_base) {
    const int tid = HB_TID, c = tid >> 2, vq = tid & 3;
    const bf16_t* src = proj + (row0 + c) * PP + VB + h * 128 + vq * 32;
#pragma unroll
    for (int k = 0; k < 4; ++k) {
        const u32x4 a = *(const u32x4*)(src + k * 8);
#pragma unroll
        for (int e = 0; e < 4; ++e) {
            const int v = vq * 32 + k * 8 + 2 * e;
            *(unsigned short*)(vt_base + tile_el(v, c)) = (unsigned short)(a[e] & 0xFFFFu);
            *(unsigned short*)(vt_base + tile_el(v + 1, c)) = (unsigned short)(a[e] >> 16);
        }
    }
}

__device__ __forceinline__ void gla_a_unit(int vb, const bf16_t* __restrict__ proj, const float* __restrict__ w_alpha, const float* __restrict__ b_alpha,
                                           float* __restrict__ bc, float* __restrict__ cstate, char* smem) {
    float (*bcS)[64] = (float (*)[64])smem;
    float (*tot)[64] = (float (*)[64])(smem + 16384);
    char* KDT = smem + 17408;
    char* VT = smem + 17408 + 8192;
    const int tid = HB_TID, lane = tid & 63, wid = tid >> 6, fr = lane & 15, fq = lane >> 4;
    const int n = vb & 63, h = (vb >> 6) & 3, b = vb >> 8;
    const size_t row0 = (size_t)(b * S + n * 64);
    __syncthreads();
    {
        const int d = tid & 63, cq = tid >> 6, col = h * 64 + d;
        float w[16];
#pragma unroll
        for (int r = 0; r < 16; ++r) w[r] = w_alpha[r * 256 + col];
        const float bias = b_alpha[col];
        float cum = 0.f;
        for (int i = 0; i < 16; ++i) {
            const int c = cq * 16 + i;
            const u32x4 a0 = *(const u32x4*)(proj + (row0 + c) * PP + AB), a1 = *(const u32x4*)(proj + (row0 + c) * PP + AB + 8);
            float z = bias;
#pragma unroll
            for (int e = 0; e < 4; ++e) {
                z += __uint_as_float(a0[e] << 16) * w[2 * e] + __uint_as_float(a0[e] & 0xFFFF0000u) * w[2 * e + 1];
                z += __uint_as_float(a1[e] << 16) * w[8 + 2 * e] + __uint_as_float(a1[e] & 0xFFFF0000u) * w[8 + 2 * e + 1];
            }
            const float ls = fminf(z, 0.f) - log1pf(__expf(-fabsf(z)));
            cum += ls * (1.0f / 16.0f);
            bcS[c][d] = cum;
        }
        tot[cq][d] = cum;
        __syncthreads();
        float pre = 0.f;
        for (int q = 0; q < cq; ++q) pre += tot[q][d];
        for (int i = 0; i < 16; ++i) {
            const int c = cq * 16 + i;
            const float v = bcS[c][d] + pre;
            bcS[c][d] = v;
            bc[(row0 + c) * 256 + col] = v;
        }
    }
    __syncthreads();
    {
        const int c = tid >> 2, dq = tid & 3;
        const bf16_t* src = proj + (row0 + c) * PP + KB + h * 64 + dq * 16;
#pragma unroll
        for (int k = 0; k < 2; ++k) {
            const u32x4 a = *(const u32x4*)(src + k * 8);
#pragma unroll
            for (int e = 0; e < 4; ++e) {
                const int d = dq * 16 + k * 8 + 2 * e;
                const float k0 = __uint_as_float(a[e] << 16) * __expf(bcS[63][d] - bcS[c][d]);
                const float k1 = __uint_as_float(a[e] & 0xFFFF0000u) * __expf(bcS[63][d + 1] - bcS[c][d + 1]);
                *(unsigned short*)(KDT + tile_el(d, c)) = f2bf(k0);
                *(unsigned short*)(KDT + tile_el(d + 1, c)) = f2bf(k1);
            }
        }
    }
    gla_stage_vt(proj, row0, h, VT);
    __syncthreads();
    float* outp = cstate + (size_t)vb * 8192;
#pragma unroll
    for (int vi = 0; vi < 2; ++vi) {
        const int vt = wid * 2 + vi;
        const bf16x8 a0 = *(const bf16x8*)(VT + tile_off(vt * 16 + fr, fq)), a1 = *(const bf16x8*)(VT + tile_off(vt * 16 + fr, 4 + fq));
#pragma unroll
        for (int dt = 0; dt < 4; ++dt) {
            const bf16x8 b0 = *(const bf16x8*)(KDT + tile_off(dt * 16 + fr, fq)), b1 = *(const bf16x8*)(KDT + tile_off(dt * 16 + fr, 4 + fq));
            f32x4 acc = (f32x4){0.f, 0.f, 0.f, 0.f};
            acc = __builtin_amdgcn_mfma_f32_16x16x32_bf16(a0, b0, acc, 0, 0, 0);
            acc = __builtin_amdgcn_mfma_f32_16x16x32_bf16(a1, b1, acc, 0, 0, 0);
#pragma unroll
            for (int i = 0; i < 4; ++i) outp[(vt * 16 + 4 * fq + i) * 64 + dt * 16 + fr] = acc[i];
        }
    }
}

__device__ __forceinline__ void gla_scan_vb2(int vb, const float* __restrict__ bc, float* __restrict__ cstate) {
    const int idx = vb * 512 + threadIdx.x;
    const int e = idx & 8191, bh = idx >> 13, b = bh >> 2, h = bh & 3, d = e & 63;
    float state = 0.f;
    float* base = cstate + (size_t)bh * 64 * 8192 + e;
    const float* bcp = bc + ((size_t)(b * S + 63)) * 256 + h * 64 + d;
#pragma unroll 1
    for (int n0 = 0; n0 < 64; n0 += 16) {
        float upd[16], dec[16];
#pragma unroll
        for (int i = 0; i < 16; ++i) { upd[i] = base[(size_t)(n0 + i) * 8192]; dec[i] = bcp[(size_t)(n0 + i) * 64 * 256]; }
#pragma unroll
        for (int i = 0; i < 16; ++i) { base[(size_t)(n0 + i) * 8192] = state; state = __expf(dec[i]) * state + upd[i]; }
    }
}

__device__ __forceinline__ void gla_c_unit(int vb, const bf16_t* __restrict__ proj, const float* __restrict__ bc, const float* __restrict__ prev,
                                           const float* __restrict__ norm_g, bf16_t* __restrict__ yb, char* smem) {
    char* QI = smem;
    char* KI = smem + 8192;
    char* VT = smem + 16384;
    char* PT = smem + 32768;
    const int tid = HB_TID, lane = tid & 63, wid = tid >> 6, fr = lane & 15, fq = lane >> 4;
    const int n = vb & 63, h = (vb >> 6) & 3, b = vb >> 8;
    const size_t row0 = (size_t)(b * S + n * 64);
    __syncthreads();
    {
        const int c = tid >> 2, dq = tid & 3;
        const bf16_t* qs = proj + (row0 + c) * PP + QB + h * 64 + dq * 16;
        const bf16_t* ks = proj + (row0 + c) * PP + KB + h * 64 + dq * 16;
        const float* bs = bc + (row0 + c) * 256 + h * 64 + dq * 16;
#pragma unroll
        for (int k = 0; k < 2; ++k) {
            const u32x4 qa = *(const u32x4*)(qs + k * 8), ka = *(const u32x4*)(ks + k * 8);
            const f32x4 b0 = *(const f32x4*)(bs + k * 8), b1 = *(const f32x4*)(bs + k * 8 + 4);
            const float bv[8] = {b0[0], b0[1], b0[2], b0[3], b1[0], b1[1], b1[2], b1[3]};
            u32x4 qo, ko;
#pragma unroll
            for (int e = 0; e < 4; ++e) {
                const float e0 = __expf(bv[2 * e]), e1 = __expf(bv[2 * e + 1]);
                qo[e] = pack_bf16(__uint_as_float(qa[e] << 16) * 0.125f * e0, __uint_as_float(qa[e] & 0xFFFF0000u) * 0.125f * e1);
                ko[e] = pack_bf16(__uint_as_float(ka[e] << 16) / e0, __uint_as_float(ka[e] & 0xFFFF0000u) / e1);
            }
            *(u32x4*)(QI + tile_off(c, dq * 2 + k)) = qo;
            *(u32x4*)(KI + tile_off(c, dq * 2 + k)) = ko;
        }
    }
    gla_stage_vt(proj, row0, h, VT);
    {
        const int v = tid >> 1, half = tid & 1;
        const float* ps = prev + (size_t)vb * 8192 + v * 64 + half * 32;
#pragma unroll
        for (int k = 0; k < 4; ++k) {
            const f32x4 a = *(const f32x4*)(ps + k * 8), c2 = *(const f32x4*)(ps + k * 8 + 4);
            u32x4 o; o[0] = pack_bf16(a[0], a[1]); o[1] = pack_bf16(a[2], a[3]); o[2] = pack_bf16(c2[0], c2[1]); o[3] = pack_bf16(c2[2], c2[3]);
            *(u32x4*)(PT + tile_off(v, half * 4 + k)) = o;
        }
    }
    __syncthreads();
    const bf16x8 qf0 = *(const bf16x8*)(QI + tile_off(wid * 16 + fr, fq)), qf1 = *(const bf16x8*)(QI + tile_off(wid * 16 + fr, 4 + fq));
    bf16x8 pf[2];
    const int c = wid * 16 + fr;
#pragma unroll
    for (int p = 0; p < 2; ++p) {
        u32x4 w;
#pragma unroll
        for (int s = 0; s < 2; ++s) {
            const int row = 32 * p + 8 * (fr >> 2) + 4 * s + (fr & 3);
            const bf16x8 k0 = *(const bf16x8*)(KI + tile_off(row, fq)), k1 = *(const bf16x8*)(KI + tile_off(row, 4 + fq));
            f32x4 a = (f32x4){0.f, 0.f, 0.f, 0.f};
            a = __builtin_amdgcn_mfma_f32_16x16x32_bf16(k0, qf0, a, 0, 0, 0);
            a = __builtin_amdgcn_mfma_f32_16x16x32_bf16(k1, qf1, a, 0, 0, 0);
#pragma unroll
            for (int i = 0; i < 4; ++i) { const int j = 32 * p + 8 * fq + 4 * s + i; if (j > c) a[i] = 0.f; }
            w[2 * s] = pack_bf16(a[0], a[1]); w[2 * s + 1] = pack_bf16(a[2], a[3]);
        }
        pf[p] = __builtin_bit_cast(bf16x8, w);
    }
    f32x4 acc[8];
    float ss = 0.f;
#pragma unroll
    for (int vt = 0; vt < 8; ++vt) {
        f32x4 a = (f32x4){0.f, 0.f, 0.f, 0.f};
        a = __builtin_amdgcn_mfma_f32_16x16x32_bf16(*(const bf16x8*)(VT + tile_off(vt * 16 + fr, fq)), pf[0], a, 0, 0, 0);
        a = __builtin_amdgcn_mfma_f32_16x16x32_bf16(*(const bf16x8*)(VT + tile_off(vt * 16 + fr, 4 + fq)), pf[1], a, 0, 0, 0);
        a = __builtin_amdgcn_mfma_f32_16x16x32_bf16(*(const bf16x8*)(PT + tile_off(vt * 16 + fr, fq)), qf0, a, 0, 0, 0);
        a = __builtin_amdgcn_mfma_f32_16x16x32_bf16(*(const bf16x8*)(PT + tile_off(vt * 16 + fr, 4 + fq)), qf1, a, 0, 0, 0);
        acc[vt] = a;
        ss += a[0] * a[0] + a[1] * a[1] + a[2] * a[2] + a[3] * a[3];
    }
    ss += __shfl_xor(ss, 16); ss += __shfl_xor(ss, 32);
    const float r = rsqrtf(ss * (1.0f / 128.0f) + 1e-6f);
    const size_t row = row0 + c;
#pragma unroll
    for (int vt = 0; vt < 8; ++vt) {
        const int col = h * 128 + vt * 16 + 4 * fq;
        const uint2 rr = *(const uint2*)(proj + row * PP + RB + col);
        const f32x4 g4 = *(const f32x4*)(norm_g + col);
        const float r0 = __uint_as_float(rr.x << 16), r1 = __uint_as_float(rr.x & 0xFFFF0000u), r2 = __uint_as_float(rr.y << 16), r3 = __uint_as_float(rr.y & 0xFFFF0000u);
        f32x4 o;
        o[0] = acc[vt][0] * r * g4[0] * (r0 * sigmoidf_(r0)); o[1] = acc[vt][1] * r * g4[1] * (r1 * sigmoidf_(r1));
        o[2] = acc[vt][2] * r * g4[2] * (r2 * sigmoidf_(r2)); o[3] = acc[vt][3] * r * g4[3] * (r3 * sigmoidf_(r3));
        *(uint2*)(yb + row * 512 + col) = pack4(o);
    }
}

constexpr int SMEM_BYTES = 131072;

__global__ void __launch_bounds__(512, 2) k_fwd(Params p) {
    extern __shared__ __attribute__((aligned(16))) char smem_dyn[];
    char* smem = smem_dyn + 16;
    char* smh = smem + (threadIdx.x >> 8) * 65536;
    if (threadIdx.x == 0) *(uint4*)smem_dyn = make_uint4(0u, 0u, 0u, 0u);
    __syncthreads();
    char* ws = p.ws;
    XcdBarrier bar = xcd_barrier_post((unsigned*)(ws + OFF_BAR), (volatile LAS unsigned*)smem_dyn);
    int* ctrl = (int*)(ws + OFF_CTRL);
    bf16_t* proj = (bf16_t*)(ws + OFF_PROJ);
    float* bc = (float*)(ws + OFF_BC);
    float* cstate = (float*)(ws + OFF_CSTATE);
    bf16_t* mrg = (bf16_t*)(ws + OFF_MRG);
    bf16_t* h2 = (bf16_t*)(ws + OFF_H2);
    bf16_t* hid = (bf16_t*)(ws + OFF_HID);
    bf16_t* Y0 = (bf16_t*)(ws + OFF_Y0);
    bf16_t* Y1 = (bf16_t*)(ws + OFF_Y1);
    bf16_t* ya = (bf16_t*)(ws + OFF_YA);
    bf16_t* yb = (bf16_t*)(ws + OFF_YB);
    bf16_t* kcb = (bf16_t*)(ws + OFF_KCB);
    bf16_t* vcb = (bf16_t*)(ws + OFF_VCB);
    bf16_t* h = (bf16_t*)p.out;
    const int G = gridDim.x;

    ph_prep(p, smh);
    xcd_barrier(bar);
    { g8::StaticOrder S; S.init(T, 3072, G, (int)blockIdx.x); const g8::AddrPlain AD{(const char*)h, (const char*)(ws + OFF_WINT), 2048u, 2048u, 16};
      g8::gemm_phase(smem, S, AD, g8::EpiProj{proj}); }
    xcd_barrier(bar);
    ph_cmp1(proj, ws, smh);
    {
        const int nc = G > 32 ? 16 : 0, gb = (int)blockIdx.x - nc, gs = G - nc;
        if (gb >= 0) {
            for (int pr = gb; pr < 512; pr += gs) vtrans_tile(2 * pr + HB_ID, proj, ws, smh);
            for (int pr = gb; pr < 512; pr += gs) gla_a_unit(2 * pr + HB_ID, proj, p.w_alpha, p.b_alpha, bc, cstate, smh);
        }
    }
    xcd_barrier(bar);
    ph_cmp2(ws, ws, smh);
    for (int vb = blockIdx.x; vb < 256; vb += G) gla_scan_vb2(vb, bc, cstate);
    ph_prep_experts(p, smh);
    xcd_barrier(bar);
    for (int vb = HB_FIRST; vb < 1024; vb += HB_STEP) gla_c_unit(vb, proj, bc, cstate, p.norm_g, yb, smh);
    for (int r = 0; r * G < 512; ++r) {
        const int u = r * G + ((r & 1) ? (G - 1 - (int)blockIdx.x) : (int)blockIdx.x);
        if (u < 512) nsa_unit(u, proj, ws, p.rel_bias, ya, smem);
    }
    xcd_barrier(bar);
    {
        g8::MergeOrder MO; MO.so.init(T, 1024, G, (int)blockIdx.x);
        const g8::AddrMerge AD{(const char*)h, (const char*)(ws + OFF_WINT), (const char*)ya, (const char*)yb, (const char*)(ws + OFF_WAT), (const char*)(ws + OFF_WBT)};
        g8::gemm_phase(smem, MO, AD, g8::EpiMergeAll{mrg, (bf16_t*)(ws + OFF_R1)});
    }
    xcd_barrier(bar);
    { g8::StaticOrder S; S.init(T, 1024, G, (int)blockIdx.x); const g8::AddrPlain AD{(const char*)mrg, (const char*)(ws + OFF_WOT), 2048u, 2048u, 16};
      g8::gemm_phase(smem, S, AD, g8::EpiDelta{ya}); }
    xcd_barrier(bar);
    for (int grp = HB_FIRST; grp < 512; grp += HB_STEP) {
        for (int tt = 0; tt < 2; ++tt) router_unit(grp * 2 + tt, p.x, ya, p.g_ffn, (const bf16_t*)(ws + OFF_WRT), p.b_rg, p.b_re, h2, (float*)(ws + OFF_RSTD), smh);
        router_append(grp, (int*)(ws + OFF_LTOK), (float*)(ws + OFF_LW), ctrl, smh);
    }
    xcd_barrier(bar);
    ph_moe1(h2, (const bf16_t*)(ws + OFF_WGT), (const bf16_t*)(ws + OFF_WUT), ctrl, (const int*)(ws + OFF_LTOK), (const float*)(ws + OFF_LW), (const float*)(ws + OFF_RSTD), hid, smh);
    ph_prep_experts_down(p, ctrl, smh);
    xcd_barrier(bar);
    ph_moe2(hid, (const bf16_t*)(ws + OFF_WDT), ctrl, (const int*)(ws + OFF_LTOK), Y0, smh);
    xcd_barrier(bar);
    { int t_ = threadIdx.x; asm volatile("" : "+v"(t_)); for (int row = blockIdx.x * 8 + (t_ >> 6); row < T; row += G * 8) final_row(row, p.x, ya, p.out, Y0, Y1, p.g_final, t_ & 63); }
}

extern "C" void kernel_launch(void* const* d_in, const int* in_sizes, int n_in, void* d_out, int out_size, void* d_ws, size_t ws_size, hipStream_t stream) {
    static int grid = 0;
    constexpr int kDynLds = SMEM_BYTES + 16;
    if (!grid) {
        int dev = 0, cus = 0, per_cu = 0;
        (void)hipGetDevice(&dev);
        (void)hipDeviceGetAttribute(&cus, hipDeviceAttributeMultiprocessorCount, dev);
        (void)hipFuncSetAttribute((const void*)k_fwd, hipFuncAttributeMaxDynamicSharedMemorySize, kDynLds);
        (void)hipOccupancyMaxActiveBlocksPerMultiprocessor(&per_cu, k_fwd, 512, kDynLds);
        if (per_cu > 1) per_cu = 1;
        if (per_cu < 1) per_cu = 1;
        grid = cus * per_cu;
    }
    char* ws = (char*)d_ws;
    (void)hipMemsetAsync(ws + OFF_CTRL, 0, 32768, stream);
    Params p{};
    const float** pf = (const float**)&p;
    for (int i = 0; i < 25; ++i) pf[i] = (const float*)d_in[i];
    p.out = (float*)d_out; p.ws = ws;
    k_fwd<<<grid, 512, kDynLds, stream>>>(p);
}
```

```cpp
#include <hip/hip_runtime.h>
#include <stdint.h>

typedef unsigned short bf16_t;
typedef short bf16x8 __attribute__((ext_vector_type(8)));
typedef float f32x4 __attribute__((ext_vector_type(4)));
typedef unsigned u32x4 __attribute__((ext_vector_type(4)));
__device__ __forceinline__ float bf2f(bf16_t v) { return __uint_as_float(((unsigned)v) << 16); }
__device__ __forceinline__ bf16_t f2bf(float f) { unsigned u = __float_as_uint(f); u += 0x7FFFu + ((u >> 16) & 1u); return (bf16_t)(u >> 16); }
__device__ __forceinline__ unsigned pack_bf16(float lo, float hi) { unsigned r; asm volatile("v_cvt_pk_bf16_f32 %0, %1, %2" : "=v"(r) : "v"(lo), "v"(hi)); return r; }

constexpr int Bn = 4, S = 4096, T = Bn * S, D = 1024, NIN = 4904, PP = 2880;
constexpr int QA = 0, KC = 512, VC = 640, KS = 768, VS = 896, KW = 1024, VW = 1152, GA = 1280, QB = 1304, KB = 1560, VB = 1816, AB = 2328, RB = 2344, MGA = 2856, MGB = 3880;
constexpr int NPROJ = 2856;
constexpr int MSLOT = 36864;

constexpr size_t OFF_CTRL = 0;
constexpr size_t OFF_BAR = 16384;
constexpr size_t OFF_ROUTE_E = 32768;
constexpr size_t OFF_ROUTE_W = OFF_ROUTE_E + 32768 * 4;
constexpr size_t OFF_SLOT_TOK = OFF_ROUTE_W + 32768 * 4;
constexpr size_t OFF_SLOT_W = OFF_SLOT_TOK + (size_t)MSLOT * 4;
constexpr size_t OFF_BIAS1 = OFF_SLOT_W + (size_t)MSLOT * 4;
constexpr size_t OFF_RSTD = OFF_BIAS1 + 8192;
constexpr size_t OFF_SLOT_RS = OFF_RSTD + (size_t)T * 4;
constexpr size_t OFF_WRT = OFF_SLOT_RS + (size_t)MSLOT * 4;
static_assert(OFF_WRT + 2 * 48 * 1024 * 2 <= (1u << 20), "ctrl overflow");
constexpr size_t OFF_R1 = 1u << 20;
constexpr size_t SZ_PROJ = (size_t)T * PP * 2;
constexpr size_t OFF_PROJ = OFF_R1;
constexpr size_t OFF_BC = OFF_PROJ + SZ_PROJ;
constexpr size_t OFF_CSTATE = OFF_BC + (size_t)T * 256 * 4;
constexpr size_t OFF_R1_END = OFF_CSTATE + (size_t)1024 * 8192 * 4;
constexpr size_t OFF_MRG = OFF_R1 + (size_t)T * 2048 * 2;
constexpr size_t OFF_H2 = OFF_R1;
constexpr size_t OFF_HID = OFF_H2 + (size_t)T * 1024 * 2;
constexpr size_t OFF_Y0 = OFF_HID + (size_t)2 * T * 256 * 2;
constexpr size_t OFF_Y1 = OFF_Y0 + (size_t)T * 1024 * 2;
static_assert(OFF_MRG + (size_t)T * 1024 * 2 <= OFF_R1_END, "alias overflow");
static_assert(OFF_Y1 + (size_t)T * 1024 * 2 <= OFF_R1_END, "alias overflow");
constexpr size_t OFF_YA = OFF_R1_END;
constexpr size_t OFF_YB = OFF_YA + (size_t)T * 512 * 2;
constexpr size_t OFF_KCB = OFF_YB + (size_t)T * 512 * 2;
constexpr size_t OFF_VCB = OFF_KCB + 8 * 256 * 64 * 2;
constexpr size_t OFF_VCBT = OFF_VCB + 8 * 256 * 64 * 2;
constexpr size_t OFF_HIDC = OFF_VCBT + 8 * 256 * 64 * 2;
constexpr size_t OFF_VST = OFF_HIDC + 2 * 2048 * 128 * 2;
constexpr size_t OFF_VWT = OFF_VST + (size_t)8 * 64 * S * 2;
constexpr size_t OFF_WINT = OFF_VWT + (size_t)8 * 64 * S * 2;
constexpr size_t OFF_CK1T = OFF_WINT + (size_t)NIN * 1024 * 2;
constexpr size_t OFF_CV1T = OFF_CK1T + 128 * 2048 * 2;
constexpr size_t OFF_CK2T = OFF_CV1T + 128 * 2048 * 2;
constexpr size_t OFF_CV2T = OFF_CK2T + 128 * 128 * 2;
constexpr size_t OFF_WAT = OFF_CV2T + 128 * 128 * 2;
constexpr size_t OFF_WBT = OFF_WAT + 1024 * 512 * 2;
constexpr size_t OFF_WOT = OFF_WBT + 1024 * 512 * 2;
constexpr size_t OFF_WGT = OFF_WOT + 1024 * 1024 * 2;
constexpr size_t OFF_WUT = OFF_WGT + (size_t)32 * 256 * 1024 * 2;
constexpr size_t OFF_WDT = OFF_WUT + (size_t)32 * 256 * 1024 * 2;
constexpr size_t OFF_LTOK = OFF_WDT + (size_t)32 * 1024 * 256 * 2;
constexpr size_t OFF_LW = OFF_LTOK + (size_t)32 * 16384 * 4;
constexpr size_t OFF_END = OFF_LW + (size_t)32 * 16384 * 4;
static_assert(OFF_END <= (size_t)256 << 20, "workspace overflow");

#define XB_TMO      128
#define XB_XCNT(j)  (256  + 64 * (j))
#define XB_XSUB(j)  (1280 + 64 * (j))
#define XB_XGEN(j)  (2304 + 64 * (j))
#define XB_TOP      3328
#define XB_TOPGEN   3392
#define XCD_BAR_WORDS 3456
#define XB_SPIN_CAP (1u << 18)
#define LAS __attribute__((address_space(3)))

__device__ __forceinline__ unsigned xb_ld(unsigned* p)              { return __hip_atomic_load(p, __ATOMIC_RELAXED, __HIP_MEMORY_SCOPE_AGENT); }
__device__ __forceinline__ unsigned xb_add(unsigned* p, unsigned v) { return __hip_atomic_fetch_add(p, v, __ATOMIC_RELAXED, __HIP_MEMORY_SCOPE_AGENT); }
__device__ __forceinline__ unsigned xb_xcc_id() { return (unsigned)__builtin_amdgcn_s_getreg((3 << 11) | 20) & 0xFu; }
#define XB_SPIN(cond, bar) do { unsigned _sp = 0; while (cond) { __builtin_amdgcn_s_sleep(1); \
    if ((++_sp & 255u) == 0u) { if (xb_ld(&(bar)[XB_TMO])) break; if (_sp > XB_SPIN_CAP) { atomicAdd(&(bar)[XB_TMO], 1u); break; } } } } while (0)

struct XcdBarrier { unsigned* bar; unsigned x; volatile LAS unsigned* st; };

__device__ __forceinline__ XcdBarrier xcd_barrier_post(unsigned* bar, volatile LAS unsigned* st) {
    XcdBarrier b; b.bar = bar; b.x = xb_xcc_id(); b.st = st;
    if (threadIdx.x == 0) (void)xb_add(&bar[XB_XCNT(b.x)], 1u);
    return b;
}
__device__ __forceinline__ void xcd_barrier_complete(unsigned* bar, unsigned x, unsigned& nloc, unsigned& nx) {
    const unsigned G = gridDim.x * gridDim.y * gridDim.z;
    unsigned sum, cnt, mine, sp = 0u;
    for (;;) {
        sum = 0u; cnt = 0u; mine = 0u;
#pragma unroll
        for (unsigned j = 0; j < 16; ++j) { const unsigned c = xb_ld(&bar[XB_XCNT(j)]); sum += c; cnt += (c > 0u) ? 1u : 0u; mine = (j == x) ? c : mine; }
        if (sum == G) break;
        __builtin_amdgcn_s_sleep(1);
        if ((++sp & 255u) == 0u) { if (xb_ld(&bar[XB_TMO])) break; if (sp > XB_SPIN_CAP) { atomicAdd(&bar[XB_TMO], 1u); break; } }
    }
    nloc = mine > 0u ? mine : 1u; nx = cnt > 0u ? cnt : 1u;
}
__device__ __forceinline__ void xcd_barrier(const XcdBarrier& b) {
    asm volatile("s_waitcnt vmcnt(0)" ::: "memory");
    __syncthreads();
    if (threadIdx.x == 0) {
        unsigned* bar = b.bar;
        __builtin_amdgcn_s_waitcnt(0);
        unsigned nloc = b.st[0], nx = b.st[1];
        if (nloc == 0u) { xcd_barrier_complete(bar, b.x, nloc, nx); b.st[0] = nloc; b.st[1] = nx; }
        const unsigned old = xb_add(&bar[XB_XSUB(b.x)], 1u);
        const unsigned gen = old / nloc;
        if (old + 1u == (gen + 1u) * nloc) {
            __builtin_amdgcn_fence(__ATOMIC_RELEASE, "agent");
            asm volatile("s_waitcnt vmcnt(0)" ::: "memory");
            const unsigned og = xb_add(&bar[XB_TOP], 1u);
            const unsigned tg = og / nx;
            if (og + 1u == (tg + 1u) * nx) xb_add(&bar[XB_TOPGEN], 1u);
            else XB_SPIN(xb_ld(&bar[XB_TOPGEN]) == tg, bar);
            __builtin_amdgcn_fence(__ATOMIC_ACQUIRE, "agent");
            xb_add(&bar[XB_XGEN(b.x)], 1u);
            asm volatile("s_waitcnt vmcnt(0)" ::: "memory");
        } else {
            XB_SPIN(xb_ld(&bar[XB_XGEN(b.x)]) == gen, bar);
            __builtin_amdgcn_fence(__ATOMIC_ACQUIRE, "agent");
            asm volatile("s_waitcnt vmcnt(0)" ::: "memory");
        }
    }
    __syncthreads();
}


__device__ __forceinline__ int hb_tid_() { int t = threadIdx.x; asm volatile("" : "+v"(t)); return t & 255; }
#define HB_TID (hb_tid_())
#define HB_ID ((int)(threadIdx.x >> 8))
#define HB_FIRST (2 * (int)blockIdx.x + HB_ID)
#define HB_STEP (2 * (int)gridDim.x)
struct Params {
    const float *x, *g_mix, *w_in, *pe_k, *ck1, *ck2, *pe_v, *cv1, *cv2, *rel_bias, *w_alpha, *b_alpha, *norm_g, *w_ba, *w_bb, *w_out, *g_ffn,
                *w_rg, *b_rg, *w_re, *b_re, *w_eg, *w_eu, *w_ed, *g_final;
    float* out; char* ws;
};

__device__ __forceinline__ float wave_max(float v) { for (int o = 32; o > 0; o >>= 1) v = fmaxf(v, __shfl_xor(v, o)); return v; }
__device__ __forceinline__ float wave_sum(float v) { for (int o = 32; o > 0; o >>= 1) v += __shfl_xor(v, o); return v; }
__device__ __forceinline__ void wave_lds_sync() { asm volatile("s_waitcnt lgkmcnt(0)" ::: "memory"); }


__device__ __forceinline__ void rms_h_row(int row, const float* __restrict__ x, const float* __restrict__ g, bf16_t* __restrict__ h, int lane) {
    const float* xr = x + (size_t)row * D + lane * 4;
    f32x4 v[4]; float s = 0.f;
#pragma unroll
    for (int i = 0; i < 4; ++i) { v[i] = *(const f32x4*)(xr + 256 * i); s += v[i][0] * v[i][0] + v[i][1] * v[i][1] + v[i][2] * v[i][2] + v[i][3] * v[i][3]; }
    s = wave_sum(s);
    const float r = rsqrtf(s * (1.0f / D) + 1e-6f);
#pragma unroll
    for (int i = 0; i < 4; ++i) {
        const f32x4 gg = *(const f32x4*)(g + lane * 4 + 256 * i);
        uint2 o; o.x = pack_bf16(v[i][0] * r * gg[0], v[i][1] * r * gg[1]); o.y = pack_bf16(v[i][2] * r * gg[2], v[i][3] * r * gg[3]);
        *(uint2*)(h + (size_t)row * D + lane * 4 + 256 * i) = o;
    }
}
__device__ __forceinline__ void final_row(int row, const float* __restrict__ x, const bf16_t* __restrict__ dl, float* __restrict__ outp, const bf16_t* __restrict__ Y0, const bf16_t* __restrict__ Y1, const float* __restrict__ g, int lane) {
    const float* xr = x + (size_t)row * D + lane * 4;
    f32x4 v[4]; float s = 0.f;
#pragma unroll
    for (int i = 0; i < 4; ++i) {
        v[i] = *(const f32x4*)(xr + 256 * i);
        const uint2 a = *(const uint2*)(Y0 + (size_t)row * D + lane * 4 + 256 * i), c = *(const uint2*)(Y1 + (size_t)row * D + lane * 4 + 256 * i);
        const uint2 e = *(const uint2*)(dl + (size_t)row * D + lane * 4 + 256 * i);
        v[i][0] += __uint_as_float(e.x << 16); v[i][1] += __uint_as_float(e.x & 0xFFFF0000u); v[i][2] += __uint_as_float(e.y << 16); v[i][3] += __uint_as_float(e.y & 0xFFFF0000u);
        v[i][0] += __uint_as_float(a.x << 16) + __uint_as_float(c.x << 16);
        v[i][1] += __uint_as_float(a.x & 0xFFFF0000u) + __uint_as_float(c.x & 0xFFFF0000u);
        v[i][2] += __uint_as_float(a.y << 16) + __uint_as_float(c.y << 16);
        v[i][3] += __uint_as_float(a.y & 0xFFFF0000u) + __uint_as_float(c.y & 0xFFFF0000u);
        s += v[i][0] * v[i][0] + v[i][1] * v[i][1] + v[i][2] * v[i][2] + v[i][3] * v[i][3];
    }
    s = wave_sum(s);
    const float r = rsqrtf(s * (1.0f / D) + 1e-6f);
#pragma unroll
    for (int i = 0; i < 4; ++i) {
        const f32x4 gg = *(const f32x4*)(g + lane * 4 + 256 * i);
        *(f32x4*)(outp + (size_t)row * D + lane * 4 + 256 * i) = (f32x4){v[i][0] * r * gg[0], v[i][1] * r * gg[1], v[i][2] * r * gg[2], v[i][3] * r * gg[3]};
    }
}

__device__ __forceinline__ void prep_router_w(const float* __restrict__ w_rg, const float* __restrict__ w_re, bf16_t* __restrict__ WrT) {
    for (int idx = blockIdx.x * 512 + threadIdx.x; idx < 48 * 1024; idx += gridDim.x * 512) {
        const int n = idx >> 10, k = idx & 1023;
        const float w = n < 4 ? w_rg[k * 4 + n] : (n < 36 ? w_re[k * 32 + n - 4] : 0.f);
        const bf16_t hi = f2bf(w);
        WrT[idx] = hi; WrT[48 * 1024 + idx] = f2bf(w - bf2f(hi));
    }
}

__device__ __forceinline__ void router_unit(int task, const float* __restrict__ x, const bf16_t* __restrict__ dl, const float* __restrict__ g, const bf16_t* __restrict__ WrT,
                                            const float* __restrict__ b_rg, const float* __restrict__ b_re, bf16_t* __restrict__ h2, float* __restrict__ rstd_out,
                                            char* smem) {
    float (*part)[16][49] = (float (*)[16][49])smem;
    int* dec_e = (int*)(smem + 14336); float* dec_w = (float*)(smem + 14336 + 512);
    float (*ssp)[16] = (float (*)[16])(smem + 4 * 16 * 49 * 4);
    const int tid = HB_TID, lane = tid & 63, w4 = tid >> 6, fr = lane & 15, fq = lane >> 4, r0 = task * 16;
    const float* xr = x + (size_t)(r0 + fr) * D + fq * 8 + w4 * 256;
    const bf16_t* dr = dl + (size_t)(r0 + fr) * D + fq * 8 + w4 * 256;
    bf16_t* hr = h2 + (size_t)(r0 + fr) * D + fq * 8 + w4 * 256;
    const bf16_t* wh = WrT + (size_t)fr * 1024 + fq * 8 + w4 * 256;
    const float* gp = g + fq * 8 + w4 * 256;
    f32x4 acc[3];
#pragma unroll
    for (int nt = 0; nt < 3; ++nt) acc[nt] = (f32x4){0.f, 0.f, 0.f, 0.f};
    float ssq = 0.f;
#pragma unroll 4
    for (int ks = 0; ks < 8; ++ks) {
        f32x4 x0 = *(const f32x4*)(xr + ks * 32), x1 = *(const f32x4*)(xr + ks * 32 + 4);
        { const u32x4 dd = *(const u32x4*)(dr + ks * 32);
          x0[0] += __uint_as_float(dd[0] << 16); x0[1] += __uint_as_float(dd[0] & 0xFFFF0000u); x0[2] += __uint_as_float(dd[1] << 16); x0[3] += __uint_as_float(dd[1] & 0xFFFF0000u);
          x1[0] += __uint_as_float(dd[2] << 16); x1[1] += __uint_as_float(dd[2] & 0xFFFF0000u); x1[2] += __uint_as_float(dd[3] << 16); x1[3] += __uint_as_float(dd[3] & 0xFFFF0000u); }
        const f32x4 g0 = *(const f32x4*)(gp + ks * 32), g1 = *(const f32x4*)(gp + ks * 32 + 4);
        float xg[8];
#pragma unroll
        for (int e = 0; e < 4; ++e) { xg[e] = x0[e] * g0[e]; xg[4 + e] = x1[e] * g1[e]; ssq += x0[e] * x0[e] + x1[e] * x1[e]; }
        u32x4 hi, lo;
#pragma unroll
        for (int e = 0; e < 4; ++e) {
            hi[e] = pack_bf16(xg[2 * e], xg[2 * e + 1]);
            lo[e] = pack_bf16(xg[2 * e] - __uint_as_float(hi[e] << 16), xg[2 * e + 1] - __uint_as_float(hi[e] & 0xFFFF0000u));
        }
        *(u32x4*)(hr + ks * 32) = hi;
        const bf16x8 ah = __builtin_bit_cast(bf16x8, hi), al = __builtin_bit_cast(bf16x8, lo);
#pragma unroll
        for (int nt = 0; nt < 3; ++nt) {
            const bf16x8 bh = *(const bf16x8*)(wh + (size_t)nt * 16 * 1024 + ks * 32), bl = *(const bf16x8*)(wh + (size_t)(48 + nt * 16) * 1024 + ks * 32);
            acc[nt] = __builtin_amdgcn_mfma_f32_16x16x32_bf16(ah, bh, acc[nt], 0, 0, 0);
            acc[nt] = __builtin_amdgcn_mfma_f32_16x16x32_bf16(al, bh, acc[nt], 0, 0, 0);
            acc[nt] = __builtin_amdgcn_mfma_f32_16x16x32_bf16(ah, bl, acc[nt], 0, 0, 0);
        }
    }
    ssq += __shfl_xor(ssq, 16); ssq += __shfl_xor(ssq, 32);
    __syncthreads();
    if (fq == 0) ssp[w4][fr] = ssq;
#pragma unroll
    for (int nt = 0; nt < 3; ++nt)
#pragma unroll
        for (int i = 0; i < 4; ++i) part[w4][4 * fq + i][nt * 16 + fr] = acc[nt][i];
    __syncthreads();
    if (tid < 16) {
        const int row = r0 + tid;
        const float rsv = rsqrtf((ssp[0][tid] + ssp[1][tid] + ssp[2][tid] + ssp[3][tid]) * (1.0f / D) + 1e-6f);
        rstd_out[row] = rsv;
        float l4[4];
#pragma unroll
        for (int j = 0; j < 4; ++j) l4[j] = (part[0][tid][j] + part[1][tid][j] + part[2][tid][j] + part[3][tid][j]) * rsv + b_rg[j];
        int gs = 0; float mx = l4[0];
#pragma unroll
        for (int j = 1; j < 4; ++j) if (l4[j] > mx) { mx = l4[j]; gs = j; }
        float den = 0.f;
#pragma unroll
        for (int j = 0; j < 4; ++j) den += __expf(l4[j] - mx);
        const float gpb = 1.f / den;
        float v0 = -3e38f, v1 = -3e38f; int i0 = 0, i1 = 0;
        for (int j = 0; j < 8; ++j) {
            const int c = 4 + gs * 8 + j;
            const float l = (part[0][tid][c] + part[1][tid][c] + part[2][tid][c] + part[3][tid][c]) * rsv + b_re[gs * 8 + j];
            if (l > v0) { v1 = v0; i1 = i0; v0 = l; i0 = j; }
            else if (l > v1) { v1 = l; i1 = j; }
        }
        const float e1 = __expf(v1 - v0);
        const int lr = (task & 1) * 16 + tid;
        dec_e[lr * 2] = gs * 8 + i0; dec_e[lr * 2 + 1] = gs * 8 + i1;
        dec_w[lr * 2] = gpb / (1.f + e1); dec_w[lr * 2 + 1] = gpb * e1 / (1.f + e1);
    }
}
__device__ __forceinline__ void router_append(int group, int* __restrict__ ltok, float* __restrict__ lw, int* __restrict__ cnt, char* smem) {
    int* dec_e = (int*)(smem + 14336); float* dec_w = (float*)(smem + 14336 + 512);
    int* hist = (int*)(smem + 14336 + 1024); int* base = hist + 32;
    const int tid = HB_TID;
    if (tid < 32) hist[tid] = 0;
    __syncthreads();
    int e = 0, lpos = 0;
    if (tid < 64) { e = dec_e[tid]; lpos = atomicAdd(&hist[e], 1); }
    __syncthreads();
    if (tid < 32) { const int hcount = hist[tid]; base[tid] = hcount ? atomicAdd(&cnt[tid * 64], hcount) : 0; }
    __syncthreads();
    if (tid < 64) { const int pos = e * 16384 + base[e] + lpos; ltok[pos] = (group * 32 + (tid >> 1)) * 2 + (tid & 1); lw[pos] = dec_w[tid]; }
    __syncthreads();
}

__device__ __forceinline__ void transpose_tile(const float* __restrict__ src, int ld_src, int N, bf16_t* __restrict__ dst, int ld_dst, int kt, int nt, char* smem) {
    float (*tl)[65] = (float (*)[65])smem;
    const int tid = HB_TID;
    const int c4 = (tid & 15) * 4, r0 = tid >> 4;
#pragma unroll
    for (int i = 0; i < 4; ++i) {
        const int k = r0 + 16 * i, n = nt * 64 + c4;
        float4 v = make_float4(0.f, 0.f, 0.f, 0.f);
        if (n < N) v = *(const float4*)(src + (size_t)(kt * 64 + k) * ld_src + n);
        tl[k][c4] = v.x; tl[k][c4 + 1] = v.y; tl[k][c4 + 2] = v.z; tl[k][c4 + 3] = v.w;
    }
    __syncthreads();
    const int kc = (tid & 7) * 8, n0 = tid >> 3;
#pragma unroll
    for (int i = 0; i < 2; ++i) {
        const int nl = n0 + 32 * i, n = nt * 64 + nl;
        if (n < N) {
            uint4 o;
            o.x = pack_bf16(tl[kc][nl], tl[kc + 1][nl]); o.y = pack_bf16(tl[kc + 2][nl], tl[kc + 3][nl]);
            o.z = pack_bf16(tl[kc + 4][nl], tl[kc + 5][nl]); o.w = pack_bf16(tl[kc + 6][nl], tl[kc + 7][nl]);
            *(uint4*)(dst + (size_t)n * ld_dst + kt * 64 + kc) = o;
        }
    }
    __syncthreads();
}

__device__ __forceinline__ void ph_prep_experts(const Params& p, char* smem) {
    char* ws = p.ws;
    for (int t = HB_FIRST; t < 4096; t += HB_STEP) {
        const int e = (t & 2047) >> 6, r = t & 63;
        if (t < 2048) transpose_tile(p.w_eg + (size_t)e * 1024 * 256, 256, 256, (bf16_t*)(ws + OFF_WGT) + (size_t)e * 256 * 1024, 1024, r >> 2, r & 3, smem);
        else transpose_tile(p.w_eu + (size_t)e * 1024 * 256, 256, 256, (bf16_t*)(ws + OFF_WUT) + (size_t)e * 256 * 1024, 1024, r >> 2, r & 3, smem);
    }
}
__device__ __forceinline__ int moe_tile_decode(const int* __restrict__ cnt, int t, int& e, int& i);
__device__ __forceinline__ void ph_prep_experts_down(const Params& p, const int* __restrict__ cnt, char* smem) {
    char* ws = p.ws;
    int e_, ti_; const int nu = moe_tile_decode(cnt, 0, e_, ti_) * 4, rem = nu % HB_STEP, k = HB_FIRST - rem, st = HB_STEP - rem;
    if (k < 0) return;
    for (int t = k; t < 2048; t += st) {
        const int e = t >> 6, r = t & 63;
        transpose_tile(p.w_ed + (size_t)e * 256 * 1024, 1024, 1024, (bf16_t*)(ws + OFF_WDT) + (size_t)e * 1024 * 256, 256, r >> 4, r & 15, smem);
    }
}
__device__ __forceinline__ void ph_prep(const Params& p, char* smem) {
    char* ws = p.ws;
    constexpr int N0 = 16 * 77, N1 = N0 + 64, N2 = N1 + 64, N3 = N2 + 2, N4 = N3 + 2, N5 = N4 + 128, N6 = N5 + 128, N7 = N6 + 256;
    for (int t = HB_FIRST; t < N7; t += HB_STEP) {
        if (t < N0) transpose_tile(p.w_in, NIN, NIN, (bf16_t*)(ws + OFF_WINT), 1024, t / 77, t % 77, smem);
        else if (t < N1) { const int q = t - N0; transpose_tile(p.ck1, 128, 128, (bf16_t*)(ws + OFF_CK1T), 2048, q >> 1, q & 1, smem); }
        else if (t < N2) { const int q = t - N1; transpose_tile(p.cv1, 128, 128, (bf16_t*)(ws + OFF_CV1T), 2048, q >> 1, q & 1, smem); }
        else if (t < N3) { const int q = t - N2; transpose_tile(p.ck2, 64, 64, (bf16_t*)(ws + OFF_CK2T), 128, q, 0, smem); }
        else if (t < N4) { const int q = t - N3; transpose_tile(p.cv2, 64, 64, (bf16_t*)(ws + OFF_CV2T), 128, q, 0, smem); }
        else if (t < N5) { const int q = t - N4; transpose_tile(p.w_ba, 1024, 1024, (bf16_t*)(ws + OFF_WAT), 512, q >> 4, q & 15, smem); }
        else if (t < N6) { const int q = t - N5; transpose_tile(p.w_bb, 1024, 1024, (bf16_t*)(ws + OFF_WBT), 512, q >> 4, q & 15, smem); }
        else { const int q = t - N6; transpose_tile(p.w_out, 1024, 1024, (bf16_t*)(ws + OFF_WOT), 1024, q >> 4, q & 15, smem); }
    }
    for (int t = HB_FIRST; t < 64; t += HB_STEP) {
        const int htid = HB_TID, which = t >> 5, kq = (t >> 2) & 7, n = (t & 3) * 32 + (htid & 31), ksp = htid >> 5;
        const float* pe = which ? p.pe_v : p.pe_k; const float* w1 = which ? p.cv1 : p.ck1;
        float a = 0.f;
#pragma unroll 8
        for (int k = kq * 256 + ksp * 32; k < kq * 256 + ksp * 32 + 32; ++k) a += pe[k] * w1[(size_t)k * 128 + n];
        float* red = (float*)smem;
        red[htid] = a;
        __syncthreads();
        if (htid < 32) {
            float s = 0.f;
#pragma unroll
            for (int j = 0; j < 8; ++j) s += red[j * 32 + htid];
            ((float*)(ws + OFF_BIAS1))[(which * 8 + kq) * 128 + n] = s;
        }
        __syncthreads();
    }
    prep_router_w(p.w_rg, p.w_re, (bf16_t*)(ws + OFF_WRT));
    for (int row = blockIdx.x * 8 + (threadIdx.x >> 6); row < T; row += gridDim.x * 8) rms_h_row(row, p.x, p.g_mix, (bf16_t*)p.out, threadIdx.x & 63);
}

__device__ __forceinline__ int tile_off(int row, int chunk) { return row * 128 + ((chunk ^ (row & 7)) << 4); }

__device__ __forceinline__ void glds16(const void* g, char* l) {
    __builtin_amdgcn_global_load_lds((const __attribute__((address_space(1))) unsigned*)g, (__attribute__((address_space(3))) unsigned*)l, 16, 0, 0);
}
__device__ __forceinline__ void gemm_kloop(f32x4 (&acc)[4][4], const bf16_t* const (&pa)[4], const bf16_t* const (&pb)[4], int ka, int kb, int nk, char* smem) {
    int tid_ = HB_TID; asm volatile("" : "+v"(tid_));
    const int tid = tid_, lane = tid & 63, wid = tid >> 6, wr = wid >> 1, wc = wid & 1, fr = lane & 15, fq = lane >> 4;
    const int offA = (wr * 64 + fr) * 128, offB = 16384 + (wc * 64 + fr) * 128, x = fr & 7;
    __syncthreads();
#pragma unroll
    for (int i = 0; i < 4; ++i) { glds16(pa[i], smem + i * 4096 + tid * 16); glds16(pb[i], smem + 16384 + i * 4096 + tid * 16); }
    asm volatile("s_waitcnt vmcnt(0)" ::: "memory");
    __syncthreads();
    for (int kt = 0; kt < nk; ++kt) {
        const int cur = kt & 1;
        if (kt + 1 < nk) {
            char* st = smem + (cur ^ 1) * 32768 + tid * 16;
#pragma unroll
            for (int i = 0; i < 4; ++i) { glds16(pa[i] + (size_t)(kt + 1) * ka, st + i * 4096); glds16(pb[i] + (size_t)(kt + 1) * kb, st + 16384 + i * 4096); }
        }
        const char* sa = smem + cur * 32768 + offA;
        const char* sb = smem + cur * 32768 + offB;
#pragma unroll
        for (int ks = 0; ks < 2; ++ks) {
            const int ch = ((ks * 4 + fq) ^ x) << 4;
            bf16x8 af[4], bfr[4];
#pragma unroll
            for (int mi = 0; mi < 4; ++mi) af[mi] = *(const bf16x8*)(sa + mi * 2048 + ch);
#pragma unroll
            for (int ni = 0; ni < 4; ++ni) bfr[ni] = *(const bf16x8*)(sb + ni * 2048 + ch);
#pragma unroll
            for (int mi = 0; mi < 4; ++mi)
#pragma unroll
                for (int ni = 0; ni < 4; ++ni) acc[mi][ni] = __builtin_amdgcn_mfma_f32_16x16x32_bf16(bfr[ni], af[mi], acc[mi][ni], 0, 0, 0);
        }
        asm volatile("s_waitcnt vmcnt(0)" ::: "memory");
        __syncthreads();
    }
}
__device__ __forceinline__ void acc_zero(f32x4 (&acc)[4][4]) {
#pragma unroll
    for (int mi = 0; mi < 4; ++mi)
#pragma unroll
        for (int ni = 0; ni < 4; ++ni) acc[mi][ni] = (f32x4){0.f, 0.f, 0.f, 0.f};
}
#define GEMM_LANE_VARS const int tid = HB_TID, lane = tid & 63, wid = tid >> 6, wr = wid >> 1, wc = wid & 1, fr = lane & 15, fq = lane >> 4, lrow = tid >> 3, lch8 = ((tid & 7) ^ ((tid >> 3) & 7)) * 8; (void)wr; (void)wc; (void)fr; (void)fq; (void)lrow; (void)lch8;
__device__ __forceinline__ uint2 pack4(f32x4 v) { uint2 o; o.x = pack_bf16(v[0], v[1]); o.y = pack_bf16(v[2], v[3]); return o; }
__device__ __forceinline__ float sigmoidf_(float a) { return 1.f / (1.f + __expf(-a)); }

__device__ __forceinline__ void ph_cmp1(const bf16_t* __restrict__ proj, const char* ws, char* smem) {
    GEMM_LANE_VARS
    for (int u = HB_FIRST; u < 32; u += HB_STEP) {
        const int which = u >> 4, tm = u & 15;
        const bf16_t* W1T = (const bf16_t*)(ws + (which ? OFF_CV1T : OFF_CK1T));
        const float* bias1 = (const float*)(ws + OFF_BIAS1) + which * 8 * 128;
        bf16_t* hid = (bf16_t*)(ws + OFF_HIDC) + (size_t)which * 2048 * 128;
        const int col0 = which ? VC : KC;
        const bf16_t* pa[4]; const bf16_t* pb[4];
#pragma unroll
        for (int i = 0; i < 4; ++i) {
            const int m = tm * 128 + lrow + 32 * i, bg = m >> 8, c = (m & 255) > 254 ? 254 : (m & 255), b = bg >> 1, g = bg & 1;
            pa[i] = proj + (size_t)(b * S + 16 * c) * PP + col0 + g * 64 + lch8;
            pb[i] = W1T + (size_t)(lrow + 32 * i) * 2048 + lch8;
        }
        f32x4 acc[4][4]; acc_zero(acc);
        gemm_kloop(acc, pa, pb, PP, 64, 32, smem);
#pragma unroll
        for (int mi = 0; mi < 4; ++mi)
#pragma unroll
            for (int ni = 0; ni < 4; ++ni) {
                const int m = tm * 128 + wr * 64 + mi * 16 + fr, n = wc * 64 + ni * 16 + 4 * fq;
                f32x4 v = acc[mi][ni];
#pragma unroll
                for (int j = 0; j < 4; ++j) { float bsum = 0.f;
#pragma unroll
                    for (int q8 = 0; q8 < 8; ++q8) bsum += bias1[q8 * 128 + n + j];
                    const float a = v[j] + bsum; const float t = 0.7978845608028654f * (a + 0.044715f * a * a * a); v[j] = 0.5f * a * (1.f + tanhf(t)); }
                *(uint2*)(hid + (size_t)m * 128 + n) = pack4(v);
            }
    }
}

__device__ __forceinline__ void ph_cmp2(const char* ws_c, char* ws, char* smem) {
    GEMM_LANE_VARS
    for (int u = HB_FIRST; u < 32; u += HB_STEP) {
        const int which = u >> 4, tm = u & 15;
        const bf16_t* W2T = (const bf16_t*)(ws_c + (which ? OFF_CV2T : OFF_CK2T));
        const bf16_t* hid = (const bf16_t*)(ws_c + OFF_HIDC) + (size_t)which * 2048 * 128;
        const bf16_t* pa[4]; const bf16_t* pb[4];
#pragma unroll
        for (int i = 0; i < 4; ++i) { pa[i] = hid + (size_t)(tm * 128 + lrow + 32 * i) * 128 + lch8; pb[i] = W2T + (size_t)(lrow + 32 * i) * 128 + lch8; }
        f32x4 acc[4][4]; acc_zero(acc);
        gemm_kloop(acc, pa, pb, 64, 64, 2, smem);
        if (wc == 0) {
            bf16_t* outp = (bf16_t*)(ws + (which ? OFF_VCB : OFF_KCB));
            bf16_t* outT = (bf16_t*)(ws + OFF_VCBT);
#pragma unroll
            for (int mi = 0; mi < 4; ++mi)
#pragma unroll
                for (int ni = 0; ni < 4; ++ni) {
                    const int m = tm * 128 + wr * 64 + mi * 16 + fr, n = ni * 16 + 4 * fq, c = m & 255, bg = m >> 8;
                    f32x4 v = acc[mi][ni];
                    if (c == 255) v = (f32x4){0.f, 0.f, 0.f, 0.f};
                    *(uint2*)(outp + (size_t)m * 64 + n) = pack4(v);
                    if (which) {
#pragma unroll
                        for (int j = 0; j < 4; ++j) outT[((size_t)bg * 64 + n + j) * 256 + c] = f2bf(v[j]);
                    }
                }
        }
    }
}

__device__ __forceinline__ int moe_tile_decode(const int* __restrict__ cnt, int t, int& e, int& i) {
    int acc = 0; e = 0; i = 0;
    for (int ee = 0; ee < 32; ++ee) { const int nt = (cnt[ee * 64] + 127) >> 7; if (t >= acc && t < acc + nt) { e = ee; i = t - acc; } acc += nt; }
    return acc;
}

__device__ __forceinline__ void ph_moe1(const bf16_t* __restrict__ h2, const bf16_t* __restrict__ WgT, const bf16_t* __restrict__ WuT, const int* __restrict__ cnt,
                                        const int* __restrict__ ltok, const float* __restrict__ lw, const float* __restrict__ rstd, bf16_t* __restrict__ hid, char* smem) {
    GEMM_LANE_VARS
    int e, ti;
    const int nu = moe_tile_decode(cnt, 0, e, ti) * 4;
    for (int u = HB_FIRST; u < nu; u += HB_STEP) {
        const int ft = u & 3;
        (void)moe_tile_decode(cnt, u >> 2, e, ti);
        const int ne = cnt[e * 64];
        const bf16_t* pa[4]; const bf16_t* pb[4];
#pragma unroll
        for (int i = 0; i < 4; ++i) {
            const int rr = lrow + 32 * i, idx = ti * 128 + rr;
            const int tk = idx < ne ? ltok[e * 16384 + idx] : 0;
            pa[i] = h2 + (size_t)(tk >> 1) * 1024 + lch8;
            const int bwc = rr >> 6, bni = (rr >> 4) & 3, bj = rr & 15;
            const int f = ft * 64 + bwc * 32 + (bni >> 1) * 16 + bj;
            pb[i] = ((bni & 1) ? WuT : WgT) + ((size_t)e * 256 + f) * 1024 + lch8;
        }
        f32x4 acc[4][4]; acc_zero(acc);
        gemm_kloop(acc, pa, pb, 64, 64, 16, smem);
#pragma unroll
        for (int mi = 0; mi < 4; ++mi) {
            const int idx = ti * 128 + wr * 64 + mi * 16 + fr;
            if (idx < ne) {
                const int tk = ltok[e * 16384 + idx];
                const float w = lw[e * 16384 + idx], rsv = rstd[tk >> 1];
#pragma unroll
                for (int q = 0; q < 2; ++q) {
                    const int f = ft * 64 + wc * 32 + q * 16 + 4 * fq;
                    f32x4 v;
#pragma unroll
                    for (int j = 0; j < 4; ++j) { const float a = acc[mi][2 * q][j] * rsv, uu = acc[mi][2 * q + 1][j] * rsv; v[j] = a * sigmoidf_(a) * uu * w; }
                    *(uint2*)(hid + (size_t)tk * 256 + f) = pack4(v);
                }
            }
        }
    }
}

__device__ __forceinline__ void ph_moe2(const bf16_t* __restrict__ hid, const bf16_t* __restrict__ WdT, const int* __restrict__ cnt, const int* __restrict__ ltok,
                                        bf16_t* __restrict__ Y, char* smem) {
    GEMM_LANE_VARS
    int e, ti;
    const int nu = moe_tile_decode(cnt, 0, e, ti) * 8;
    for (int u = HB_FIRST; u < nu; u += HB_STEP) {
        const int tn = u & 7;
        (void)moe_tile_decode(cnt, u >> 3, e, ti);
        const int ne = cnt[e * 64];
        const bf16_t* pa[4]; const bf16_t* pb[4];
#pragma unroll
        for (int i = 0; i < 4; ++i) {
            const int idx = ti * 128 + lrow + 32 * i;
            const int tk = idx < ne ? ltok[e * 16384 + idx] : 0;
            pa[i] = hid + (size_t)tk * 256 + lch8;
            pb[i] = WdT + ((size_t)e * 1024 + tn * 128 + lrow + 32 * i) * 256 + lch8;
        }
        f32x4 acc[4][4]; acc_zero(acc);
        gemm_kloop(acc, pa, pb, 64, 64, 4, smem);
#pragma unroll
        for (int mi = 0; mi < 4; ++mi) {
            const int idx = ti * 128 + wr * 64 + mi * 16 + fr;
            if (idx < ne) {
                const int tk = ltok[e * 16384 + idx];
                bf16_t* yr = Y + ((size_t)(tk & 1) * T + (size_t)(tk >> 1)) * 1024 + tn * 128 + wc * 64 + 4 * fq;
#pragma unroll
                for (int ni = 0; ni < 4; ++ni) *(uint2*)(yr + ni * 16) = pack4(acc[mi][ni]);
            }
        }
    }
}

namespace g8 {
constexpr int HTB = 128 * 64 * 2;
__device__ __forceinline__ int lds_byte(int r, int c) { const int st = (r >> 4) * 2 + (c >> 5), rr = r & 15, cc = c & 31, ob = rr * 64 + cc * 2; return st * 1024 + (ob ^ (((ob >> 9) & 1) << 5)); }
__device__ __forceinline__ void stage_rc(int b, int& R, int& C) { const int st = b / 1024, sb = b % 1024, swz = sb ^ (((sb >> 9) & 1) << 5); R = (st >> 1) * 16 + swz / 64; C = (st & 1) * 32 + (swz % 64) / 2; }
__device__ __forceinline__ int perm32(int rho) { const int n = rho >> 4, i = rho & 15; return 8 * (i >> 2) + 4 * n + (i & 3); }
struct Unit { int pm, pn, e; };
struct StaticOrder {
    int nM, nN, nwg, G, c;
    __device__ __forceinline__ void init(int M, int N, int G_, int c_) { nM = M / 256; nN = N / 256; nwg = nM * nN; G = G_; c = c_; }
    __device__ __forceinline__ bool next(int i, Unit& u) const {
        const long L = (long)i * G + c; if (L >= nwg) return false;
        int wgid = (int)L; { const int q = nwg / 8, r = nwg % 8, xcd = wgid % 8, off = wgid / 8; wgid = (xcd < r ? xcd * (q + 1) : r * (q + 1) + (xcd - r) * q) + off; }
        const int nig = 8 * nN, gid = wgid / nig, fm = gid * 8, gsz = (nM - fm) < 8 ? (nM - fm) : 8;
        u.pm = fm + ((wgid % nig) % gsz); u.pn = (wgid % nig) / gsz; u.e = 0; return true;
    }
};
struct AddrPlain {
    const char* A; const char* Bt; unsigned lda2, ldb2; int ntiles;
    __device__ __forceinline__ const char* a_base(const Unit&) const { return A; }
    __device__ __forceinline__ const char* b_base(const Unit&) const { return Bt; }
    __device__ __forceinline__ int nt(const Unit&) const { return ntiles; }
    __device__ __forceinline__ int a_row0(const Unit& u) const { return u.pm * 256; }
    __device__ __forceinline__ int b_row0(const Unit& u) const { return u.pn * 256; }
    __device__ __forceinline__ unsigned a_ld(const Unit&) const { return lda2; }
    __device__ __forceinline__ unsigned b_ld(const Unit&) const { return ldb2; }
};

template <class Epi, class Sched, class Addr>
__device__ __forceinline__ void gemm_phase(char* ldsc, const Sched& S, const Addr& AD, const Epi& E) {
    __attribute__((address_space(3))) unsigned char* lds = (__attribute__((address_space(3))) unsigned char*)ldsc;
    int tid_ = threadIdx.x; asm volatile("" : "+v"(tid_));
    const int tid = tid_, wid = __builtin_amdgcn_readfirstlane(tid >> 6), lane = tid & 63, wr = wid >> 2, wc = wid & 3, fr = lane & 15, fq = lane >> 4;
    int R[2], C2[2], Rb[2];
#pragma unroll
    for (int i = 0; i < 2; ++i) { int r_, c_; stage_rc(tid * 16 + i * 8192, r_, c_); R[i] = r_; C2[i] = c_ * 2; Rb[i] = Epi::PERM ? ((r_ & ~31) + perm32(r_ & 31)) : r_; }
    const unsigned ldsw = (unsigned)wid * 1024u;
    const int aoff = lds_byte(wr * 64 + fr, fq * 8), boff = lds_byte(wc * 32 + fr, fq * 8);
#define G8_SA(b, h) (((b) * 2 + (h)) * HTB)
#define G8_SB(b, h) ((4 + (b) * 2 + (h)) * HTB)
#define G8_STAGE(bufoff, base, rowv, row0, ld, h, kb) do { _Pragma("unroll") for (int _i = 0; _i < 2; ++_i) \
        __builtin_amdgcn_global_load_lds((const __attribute__((address_space(1))) unsigned*)((base) + (size_t)((unsigned)((row0) + (h) * 128 + (rowv)[_i]) * (ld) + (unsigned)C2[_i] + (unsigned)(kb))), \
                                         (__attribute__((address_space(3))) unsigned*)(lds + (bufoff) + ldsw + _i * 8192), 16, 0, 0); } while (0)
#define G8_LDA(dst, b, h) do { _Pragma("unroll") for (int m = 0; m < 4; ++m) _Pragma("unroll") for (int k = 0; k < 2; ++k) dst[m][k] = *(const __attribute__((address_space(3))) bf16x8*)(lds + G8_SA(b, h) + aoff + m * 2048 + k * 1024); } while (0)
#define G8_LDB(dst, b, h) do { _Pragma("unroll") for (int n = 0; n < 2; ++n) _Pragma("unroll") for (int k = 0; k < 2; ++k) dst[n][k] = *(const __attribute__((address_space(3))) bf16x8*)(lds + G8_SB(b, h) + boff + n * 2048 + k * 1024); } while (0)
#define G8_MMA(ai, bj, At, Bt) do { __builtin_amdgcn_s_setprio(1); _Pragma("unroll") for (int m = 0; m < 4; ++m) _Pragma("unroll") for (int n = 0; n < 2; ++n) _Pragma("unroll") for (int k = 0; k < 2; ++k) \
        acc[ai][bj][m][n] = __builtin_amdgcn_mfma_f32_16x16x32_bf16(Bt[n][k], At[m][k], acc[ai][bj][m][n], 0, 0, 0); __builtin_amdgcn_s_setprio(0); } while (0)
#define G8_WAIT_V(n) asm volatile("s_waitcnt vmcnt(" #n ")" ::: "memory")
#define G8_WAIT_L(n) asm volatile("s_waitcnt lgkmcnt(" #n ")" ::: "memory")
#define G8_BAR __builtin_amdgcn_s_barrier()
#define G8_SCHED __builtin_amdgcn_sched_barrier(0)
    Unit cur, nxt; int ui = 0;
    if (!S.next(0, cur)) return;
    f32x4 acc[2][2][4][2];
#pragma unroll
    for (int a = 0; a < 2; ++a)
#pragma unroll
        for (int b = 0; b < 2; ++b)
#pragma unroll
            for (int m = 0; m < 4; ++m)
#pragma unroll
                for (int n = 0; n < 2; ++n) acc[a][b][m][n] = (f32x4){0.f, 0.f, 0.f, 0.f};
    bf16x8 At[4][2], B0[2][2], B1[2][2];
    const char* Ab = AD.a_base(cur); const char* Bb = AD.b_base(cur);
    int ar0 = AD.a_row0(cur), br0 = AD.b_row0(cur); unsigned ald = AD.a_ld(cur), bld = AD.b_ld(cur);
    __syncthreads();
    G8_STAGE(G8_SB(0, 0), Bb, Rb, br0, bld, 0, 0); G8_STAGE(G8_SA(0, 0), Ab, R, ar0, ald, 0, 0); G8_STAGE(G8_SB(0, 1), Bb, Rb, br0, bld, 1, 0); G8_STAGE(G8_SA(0, 1), Ab, R, ar0, ald, 1, 0);
    if (wr == 1) G8_BAR;
    G8_WAIT_V(4); G8_BAR;
    G8_STAGE(G8_SB(1, 0), Bb, Rb, br0, bld, 0, 128); G8_STAGE(G8_SA(1, 0), Ab, R, ar0, ald, 0, 128); G8_STAGE(G8_SB(1, 1), Bb, Rb, br0, bld, 1, 128);
    G8_WAIT_V(6); G8_BAR;
    for (;;) {
        const bool has_next = S.next(ui + 1, nxt);
        const int nt = AD.nt(cur);
        const char* nAb = has_next ? AD.a_base(nxt) : Ab; const char* nBb = has_next ? AD.b_base(nxt) : Bb;
        const int nar0 = has_next ? AD.a_row0(nxt) : ar0, nbr0 = has_next ? AD.b_row0(nxt) : br0;
        const unsigned nald = has_next ? AD.a_ld(nxt) : ald, nbld = has_next ? AD.b_ld(nxt) : bld;
        for (int t = 0; t < nt; t += 2) {
            const bool last = (t == nt - 2);
            const int kb1 = (t + 1) * 128, kb2 = last ? 0 : (t + 2) * 128, kb3 = kb2 + 128;
            const char* sAb = last ? nAb : Ab; const char* sBb = last ? nBb : Bb;
            const int sar0 = last ? nar0 : ar0, sbr0 = last ? nbr0 : br0; const unsigned sald = last ? nald : ald, sbld = last ? nbld : bld;
            G8_LDB(B0, 0, 0); G8_SCHED; G8_LDA(At, 0, 0); G8_STAGE(G8_SA(1, 1), Ab, R, ar0, ald, 1, kb1);
            G8_WAIT_L(8); G8_BAR; G8_WAIT_L(0); G8_MMA(0, 0, At, B0); G8_BAR; G8_SCHED;
            G8_LDB(B1, 0, 1); G8_STAGE(G8_SB(0, 0), sBb, Rb, sbr0, sbld, 0, kb2);
            G8_BAR; G8_WAIT_L(0); G8_MMA(0, 1, At, B1); G8_BAR;
            G8_LDA(At, 0, 1); G8_STAGE(G8_SA(0, 0), sAb, R, sar0, sald, 0, kb2);
            G8_BAR; G8_WAIT_L(0); G8_MMA(1, 0, At, B0); G8_BAR; G8_SCHED;
            G8_STAGE(G8_SB(0, 1), sBb, Rb, sbr0, sbld, 1, kb2);
            G8_WAIT_V(6); G8_BAR; G8_MMA(1, 1, At, B1); G8_BAR;
            G8_LDB(B0, 1, 0); G8_SCHED; G8_LDA(At, 1, 0); G8_STAGE(G8_SA(0, 1), sAb, R, sar0, sald, 1, kb2);
            G8_WAIT_L(8); G8_BAR; G8_WAIT_L(0); G8_MMA(0, 0, At, B0); G8_BAR; G8_SCHED;
            G8_LDB(B1, 1, 1); G8_STAGE(G8_SB(1, 0), sBb, Rb, sbr0, sbld, 0, kb3);
            G8_BAR; G8_WAIT_L(0); G8_MMA(0, 1, At, B1); G8_BAR;
            G8_LDA(At, 1, 1); G8_STAGE(G8_SA(1, 0), sAb, R, sar0, sald, 0, kb3);
            G8_BAR; G8_WAIT_L(0); G8_MMA(1, 0, At, B0); G8_BAR; G8_SCHED;
            G8_STAGE(G8_SB(1, 1), sBb, Rb, sbr0, sbld, 1, kb3);
            G8_WAIT_V(6); G8_BAR; G8_MMA(1, 1, At, B1); G8_BAR;
        }
        E(acc, cur, wr, wc, fr, fq);
        if (!has_next) break;
#pragma unroll
        for (int a = 0; a < 2; ++a)
#pragma unroll
            for (int b = 0; b < 2; ++b)
#pragma unroll
                for (int m = 0; m < 4; ++m)
#pragma unroll
                    for (int n = 0; n < 2; ++n) acc[a][b][m][n] = (f32x4){0.f, 0.f, 0.f, 0.f};
        cur = nxt; Ab = nAb; Bb = nBb; ar0 = nar0; br0 = nbr0; ald = nald; bld = nbld; ++ui;
    }
    G8_WAIT_V(0);
    if (wr == 0) G8_BAR;
    G8_BAR;
#undef G8_SA
#undef G8_SB
#undef G8_STAGE
#undef G8_LDA
#undef G8_LDB
#undef G8_MMA
#undef G8_WAIT_V
#undef G8_WAIT_L
#undef G8_BAR
#undef G8_SCHED
}

struct EpiProj {
    static constexpr bool PERM = true;
    bf16_t* proj;
    __device__ __forceinline__ void operator()(const f32x4 (&acc)[2][2][4][2], const Unit& u, int wr, int wc, int fr, int fq) const {
#pragma unroll
        for (int ai = 0; ai < 2; ++ai)
#pragma unroll
            for (int m = 0; m < 4; ++m) {
                const int r = u.pm * 256 + ai * 128 + wr * 64 + m * 16 + fr;
#pragma unroll
                for (int bj = 0; bj < 2; ++bj) {
                    const int c = u.pn * 256 + bj * 128 + wc * 32 + 8 * fq;
                    if (c < NPROJ) {
                        u32x4 w; w[0] = pack_bf16(acc[ai][bj][m][0][0], acc[ai][bj][m][0][1]); w[1] = pack_bf16(acc[ai][bj][m][0][2], acc[ai][bj][m][0][3]);
                        w[2] = pack_bf16(acc[ai][bj][m][1][0], acc[ai][bj][m][1][1]); w[3] = pack_bf16(acc[ai][bj][m][1][2], acc[ai][bj][m][1][3]);
                        *(u32x4*)(proj + (size_t)r * PP + c) = w;
                    }
                }
            }
    }
};
struct EpiDelta {
    static constexpr bool PERM = true;
    bf16_t* dl;
    __device__ __forceinline__ void operator()(const f32x4 (&acc)[2][2][4][2], const Unit& u, int wr, int wc, int fr, int fq) const {
#pragma unroll
        for (int ai = 0; ai < 2; ++ai)
#pragma unroll
            for (int m = 0; m < 4; ++m) {
                const int r = u.pm * 256 + ai * 128 + wr * 64 + m * 16 + fr;
#pragma unroll
                for (int bj = 0; bj < 2; ++bj) {
                    const int c = u.pn * 256 + bj * 128 + wc * 32 + 8 * fq;
                    u32x4 w; w[0] = pack_bf16(acc[ai][bj][m][0][0], acc[ai][bj][m][0][1]); w[1] = pack_bf16(acc[ai][bj][m][0][2], acc[ai][bj][m][0][3]);
                    w[2] = pack_bf16(acc[ai][bj][m][1][0], acc[ai][bj][m][1][1]); w[3] = pack_bf16(acc[ai][bj][m][1][2], acc[ai][bj][m][1][3]);
                    *(u32x4*)(dl + (size_t)r * 1024 + c) = w;
                }
            }
    }
};
struct OneUnit { Unit u; __device__ __forceinline__ bool next(int i, Unit& o) const { if (i) return false; o = u; return true; } };
template <int OP>
struct EpiMerge {
    static constexpr bool PERM = true;
    bf16_t* dst; const bf16_t* src2;
    __device__ __forceinline__ void operator()(const f32x4 (&acc)[2][2][4][2], const Unit& u, int wr, int wc, int fr, int fq) const {
#pragma unroll
        for (int ai = 0; ai < 2; ++ai)
#pragma unroll
            for (int m = 0; m < 4; ++m) {
                const int r = u.pm * 256 + ai * 128 + wr * 64 + m * 16 + fr;
#pragma unroll
                for (int bj = 0; bj < 2; ++bj) {
                    const size_t o = (size_t)r * 1024 + u.pn * 256 + bj * 128 + wc * 32 + 8 * fq;
                    float v[8];
#pragma unroll
                    for (int j = 0; j < 4; ++j) { v[j] = acc[ai][bj][m][0][j]; v[4 + j] = acc[ai][bj][m][1][j]; }
                    if (OP == 0) {
#pragma unroll
                        for (int j = 0; j < 8; ++j) v[j] = sigmoidf_(v[j]);
                    } else {
                        const u32x4 d = *(const u32x4*)(dst + o);
                        float dv[8];
#pragma unroll
                        for (int j = 0; j < 4; ++j) { dv[2 * j] = __uint_as_float(d[j] << 16); dv[2 * j + 1] = __uint_as_float(d[j] & 0xFFFF0000u); }
                        if (OP == 1) {
#pragma unroll
                            for (int j = 0; j < 8; ++j) v[j] = dv[j] * v[j];
                        } else {
                            const u32x4 s = *(const u32x4*)(src2 + o);
#pragma unroll
                            for (int j = 0; j < 4; ++j) { v[2 * j] = dv[2 * j] + __uint_as_float(s[j] << 16) * v[2 * j]; v[2 * j + 1] = dv[2 * j + 1] + __uint_as_float(s[j] & 0xFFFF0000u) * v[2 * j + 1]; }
                        }
                    }
                    u32x4 w; w[0] = pack_bf16(v[0], v[1]); w[1] = pack_bf16(v[2], v[3]); w[2] = pack_bf16(v[4], v[5]); w[3] = pack_bf16(v[6], v[7]);
                    *(u32x4*)(dst + o) = w;
                }
            }
    }
};
struct MergeOrder { StaticOrder so; __device__ __forceinline__ bool next(int i, Unit& u) const { if (!so.next(i >> 2, u)) return false; u.e = i & 3; return true; } };
struct AddrMerge {
    const char* h; const char* WinT; const char* ya; const char* yb; const char* WaT; const char* WbT;
    __device__ __forceinline__ const char* a_base(const Unit& u) const {
        const unsigned long long ph = (unsigned long long)h, pa = (unsigned long long)ya, pb = (unsigned long long)yb, o = (unsigned long long)(u.e & 1), t = (unsigned long long)((u.e >> 1) & 1);
        return (const char*)(ph + o * ((pa - ph) + t * (pb - pa))); }
    __device__ __forceinline__ const char* b_base(const Unit& u) const {
        const unsigned long long pg = (unsigned long long)(WinT + (size_t)MGA * 2048), pa = (unsigned long long)WaT, pb = (unsigned long long)WbT, o = (unsigned long long)(u.e & 1), t = (unsigned long long)((u.e >> 1) & 1);
        const unsigned long long g = pg + t * (unsigned long long)((size_t)(MGB - MGA) * 2048), y = pa + t * (pb - pa);
        return (const char*)(g + o * (y - g)); }
    __device__ __forceinline__ int nt(const Unit& u) const { return (u.e & 1) ? 8 : 16; }
    __device__ __forceinline__ int a_row0(const Unit& u) const { return u.pm * 256; }
    __device__ __forceinline__ int b_row0(const Unit& u) const { return u.pn * 256; }
    __device__ __forceinline__ unsigned a_ld(const Unit& u) const { return (u.e & 1) ? 1024u : 2048u; }
    __device__ __forceinline__ unsigned b_ld(const Unit& u) const { return (u.e & 1) ? 1024u : 2048u; }
};
struct EpiMergeAll {
    static constexpr bool PERM = true;
    bf16_t* mrg; bf16_t* sg2;
    __device__ __forceinline__ void operator()(const f32x4 (&acc)[2][2][4][2], const Unit& u, int wr, int wc, int fr, int fq) const {
        if (u.e == 0) EpiMerge<0>{mrg, nullptr}(acc, u, wr, wc, fr, fq);
        else if (u.e == 1) EpiMerge<1>{mrg, nullptr}(acc, u, wr, wc, fr, fq);
        else if (u.e == 2) EpiMerge<0>{sg2, nullptr}(acc, u, wr, wc, fr, fq);
        else EpiMerge<2>{mrg, sg2}(acc, u, wr, wc, fr, fq);
    }
};
}

constexpr float LOG2E = 1.4426950408889634f;
constexpr float NEGV = -3.0e38f;
constexpr int NSA_TB = 32768;
constexpr int NSA_IMPA = 34816;
constexpr int NSA_IMPB = NSA_IMPA + 16640;
constexpr int NSA_SELM = NSA_IMPB + 16640;

__device__ __forceinline__ int t5_bucket2(int n) {
    if (n < 16) return n;
    const int l = 16 + (int)(logf((float)n / 16.0f) / logf(8.0f) * 16.0f);
    return l < 31 ? l : 31;
}

template <int MODE, bool A0, bool A1>
__device__ __forceinline__ void nsa_tile(const char* Kst, const char* Vst, int j, bool fast, const float* tbias, const bf16x8 (&qf)[2][2], const int (&qidx)[2],
                                         const unsigned long long (&selq)[2], f32x4 (&O)[4][2], float (&m)[2], float (&l)[2], const float (&invl)[2],
                                         char* smem, int fr, int fq, int hp, int wid) {
    const float b127 = tbias[127];
    bf16x8 pf[2][2];
    bool started = true;
    if (MODE != 3) started = __builtin_amdgcn_ballot_w64((A0 && m[0] < -1e29f) || (A1 && m[1] < -1e29f)) == 0ull;
    const bool quick = (MODE != 3) && fast && started;
    f32x4 sall[2][2][2];
#pragma unroll
    for (int p = 0; p < 2; ++p)
#pragma unroll
        for (int s = 0; s < 2; ++s) {
            const int row = 32 * p + 16 * s + fr;
            const bf16x8 k0 = *(const bf16x8*)(Kst + tile_off(row, fq)), k1 = *(const bf16x8*)(Kst + tile_off(row, 4 + fq));
#pragma unroll
            for (int ct = 0; ct < 2; ++ct) {
                if ((ct == 0 && !A0) || (ct == 1 && !A1)) continue;
                float i0 = 0.f;
                if (quick) { const bool sel = (MODE == 1) ? (((selq[ct] >> j) & 1ull) != 0ull) : true; i0 = (sel ? b127 : NEGV) - m[ct]; }
                f32x4 a = (f32x4){i0, i0, i0, i0};
                a = __builtin_amdgcn_mfma_f32_16x16x32_bf16(k0, qf[ct][0], a, 0, 0, 0);
                a = __builtin_amdgcn_mfma_f32_16x16x32_bf16(k1, qf[ct][1], a, 0, 0, 0);
                sall[ct][p][s] = a;
            }
        }
#pragma unroll
    for (int ct = 0; ct < 2; ++ct) {
        if ((ct == 0 && !A0) || (ct == 1 && !A1)) continue;
        f32x4 (&sacc)[2][2] = sall[ct];
        const int q = qidx[ct];
        const bool sel = (MODE == 1) ? (((selq[ct] >> j) & 1ull) != 0ull) : true;
        if (MODE != 3) {
            const float mct = m[ct];
            if (!quick) {
                const float ref = started ? mct : 0.f;
#pragma unroll
                for (int p = 0; p < 2; ++p)
#pragma unroll
                    for (int s = 0; s < 2; ++s)
#pragma unroll
                        for (int i = 0; i < 4; ++i) {
                            const int kk = 64 * j + 32 * p + 8 * fq + 4 * s + i;
                            int rel; bool valid;
                            if (MODE == 0) { rel = q - (16 * kk + 31); valid = rel >= 0; }
                            else if (MODE == 1) { rel = q - kk; valid = (rel >= 0) && sel; }
                            else { rel = q - kk; valid = (rel >= 0) && (rel < 512); }
                            const int rc = rel < 0 ? 0 : (rel > 127 ? 127 : rel);
                            sacc[p][s][i] = valid ? sacc[p][s][i] + (tbias[rc] - ref) : NEGV;
                        }
            }
            float pv[2][8]; float psum = 0.f;
            bool redo = !started;
            if (started) {
#pragma unroll
                for (int p = 0; p < 2; ++p)
#pragma unroll
                    for (int s = 0; s < 2; ++s)
#pragma unroll
                        for (int i = 0; i < 4; ++i) { pv[p][s * 4 + i] = __builtin_amdgcn_exp2f(sacc[p][s][i]); psum += pv[p][s * 4 + i]; }
                if (__builtin_amdgcn_ballot_w64(!(psum <= 256.0f)) != 0ull) {
                    redo = true;
#pragma unroll
                    for (int p = 0; p < 2; ++p)
#pragma unroll
                        for (int s = 0; s < 2; ++s)
#pragma unroll
                            for (int i = 0; i < 4; ++i) sacc[p][s][i] += mct;
                }
            }
            if (redo) {
                float mloc = NEGV;
#pragma unroll
                for (int p = 0; p < 2; ++p)
#pragma unroll
                    for (int s = 0; s < 2; ++s)
#pragma unroll
                        for (int i = 0; i < 4; ++i) mloc = fmaxf(mloc, sacc[p][s][i]);
                mloc = fmaxf(mloc, __shfl_xor(mloc, 16)); mloc = fmaxf(mloc, __shfl_xor(mloc, 32));
                const float mnew = fmaxf(mct, mloc);
                const float alpha = __builtin_amdgcn_exp2f(mct - mnew);
                m[ct] = mnew; l[ct] *= alpha;
#pragma unroll
                for (int dt = 0; dt < 4; ++dt) O[dt][ct] = O[dt][ct] * alpha;
                psum = 0.f;
#pragma unroll
                for (int p = 0; p < 2; ++p)
#pragma unroll
                    for (int s = 0; s < 2; ++s)
#pragma unroll
                        for (int i = 0; i < 4; ++i) { pv[p][s * 4 + i] = __builtin_amdgcn_exp2f(sacc[p][s][i] - mnew); psum += pv[p][s * 4 + i]; }
            }
#pragma unroll
            for (int p = 0; p < 2; ++p) {
                u32x4 w; w[0] = pack_bf16(pv[p][0], pv[p][1]); w[1] = pack_bf16(pv[p][2], pv[p][3]); w[2] = pack_bf16(pv[p][4], pv[p][5]); w[3] = pack_bf16(pv[p][6], pv[p][7]);
                pf[ct][p] = __builtin_bit_cast(bf16x8, w);
            }
            l[ct] += psum;
        } else {
#pragma unroll
            for (int p = 0; p < 2; ++p)
#pragma unroll
                for (int s = 0; s < 2; ++s)
#pragma unroll
                    for (int i = 0; i < 4; ++i) {
                        const int kk = 64 * j + 32 * p + 8 * fq + 4 * s + i;
                        const int rel = q - (16 * kk + 31);
                        const int rc = rel < 0 ? 0 : (rel > 127 ? 127 : rel);
                        sacc[p][s][i] = (rel >= 0) ? sacc[p][s][i] + tbias[rc] : NEGV;
                    }
            float* impA = (float*)(smem + NSA_IMPA); float* impB = (float*)(smem + NSA_IMPB);
            const int ql = wid * 8 + ct * 4 + (fr >> 2);
#pragma unroll
            for (int p = 0; p < 2; ++p)
#pragma unroll
                for (int s = 0; s < 2; ++s) {
                    float p3 = __builtin_amdgcn_exp2f(sacc[p][s][3] - m[ct]) * invl[ct];
                    float pa = __builtin_amdgcn_exp2f(sacc[p][s][0] - m[ct]) * invl[ct] + __builtin_amdgcn_exp2f(sacc[p][s][1] - m[ct]) * invl[ct]
                             + __builtin_amdgcn_exp2f(sacc[p][s][2] - m[ct]) * invl[ct] + p3;
                    pa += __shfl_xor(pa, 1); pa += __shfl_xor(pa, 2);
                    p3 += __shfl_xor(p3, 1); p3 += __shfl_xor(p3, 2);
                    const int jj = 16 * j + 8 * p + 2 * fq + s;
                    if (hp == 0) { impA[ql * 65 + jj] = pa; impB[ql * 65 + jj + 1] = p3; }
                }
        }
    }
    if (MODE != 3) {
#pragma unroll
        for (int dt = 0; dt < 4; ++dt)
#pragma unroll
            for (int p = 0; p < 2; ++p) {
                const bf16x8 vf = *(const bf16x8*)(Vst + tile_off(dt * 16 + fr, p * 4 + fq));
                if (A0) O[dt][0] = __builtin_amdgcn_mfma_f32_16x16x32_bf16(vf, pf[0][p], O[dt][0], 0, 0, 0);
                if (A1) O[dt][1] = __builtin_amdgcn_mfma_f32_16x16x32_bf16(vf, pf[1][p], O[dt][1], 0, 0, 0);
            }
    }
}

template <int MODE>
__device__ __forceinline__ void nsa_branch(const bf16_t* __restrict__ Kb, size_t kstride, const bf16_t* __restrict__ Vb, size_t vstride, int j0, int ntiles, int t0,
                                           const bf16x8 (&qf)[2][2], const int (&qidx)[2], const unsigned long long (&selq)[2], unsigned long long selor0, unsigned long long selor1,
                                           f32x4 (&O)[4][2], float (&m)[2], float (&l)[2], const float (&invl)[2], char* smem) {
    int tid_ = threadIdx.x; asm volatile("" : "+v"(tid_));
    const int tid = tid_, lane = tid & 63, wid = tid >> 6, fr = lane & 15, fq = lane >> 4, hp = fr & 3;
    const int lrow = tid >> 3;
    const float* tbias = (const float*)(smem + NSA_TB) + hp * 128;
    const int sch8 = ((tid & 7) ^ (lrow & 7)) * 8;
    const int krow = 32 * (lrow >> 5) + 8 * ((lrow & 15) >> 2) + 4 * ((lrow >> 4) & 1) + (lrow & 3);
    const bf16_t* kp = Kb + (size_t)krow * kstride + sch8;
    const bf16_t* vp = Vb + (size_t)lrow * vstride + sch8;
    __syncthreads();
    glds16(kp, smem + tid * 16); if (MODE != 3) glds16(vp, smem + 8192 + tid * 16);
    asm volatile("s_waitcnt vmcnt(0)" ::: "memory");
    __syncthreads();
    for (int it = 0; it < ntiles; ++it) {
        const int cur = it & 1, j = j0 + it;
        if (it + 1 < ntiles) {
            char* st = smem + (cur ^ 1) * 16384 + tid * 16;
            glds16(kp + (size_t)(it + 1) * 64 * kstride, st); if (MODE != 3) glds16(vp + (size_t)(it + 1) * 64, st + 8192);
        }
        const char* Kst = smem + cur * 16384;
        const char* Vst = Kst + 8192;
        bool fast;
        if (MODE == 0 || MODE == 3) fast = (t0 - (16 * (64 * j + 63) + 31)) >= 128;
        else if (MODE == 1) fast = (t0 - (64 * j + 63)) >= 128;
        else fast = ((t0 - (64 * j + 63)) >= 128) && ((t0 + 63 - 64 * j) < 512);
        if (MODE == 1) {
            const bool a0 = ((selor0 >> j) & 1ull) != 0ull, a1 = ((selor1 >> j) & 1ull) != 0ull;
            if (a0 && a1) nsa_tile<MODE, true, true>(Kst, Vst, j, fast, tbias, qf, qidx, selq, O, m, l, invl, smem, fr, fq, hp, wid);
            else if (a0) nsa_tile<MODE, true, false>(Kst, Vst, j, fast, tbias, qf, qidx, selq, O, m, l, invl, smem, fr, fq, hp, wid);
            else if (a1) nsa_tile<MODE, false, true>(Kst, Vst, j, fast, tbias, qf, qidx, selq, O, m, l, invl, smem, fr, fq, hp, wid);
        } else {
            nsa_tile<MODE, true, true>(Kst, Vst, j, fast, tbias, qf, qidx, selq, O, m, l, invl, smem, fr, fq, hp, wid);
        }
        asm volatile("s_waitcnt vmcnt(0)" ::: "memory");
        __syncthreads();
    }
}

__device__ __forceinline__ void osum_add(uint2& acc, f32x4 o, float sc) {
    f32x4 v;
    v[0] = __uint_as_float(acc.x << 16) + o[0] * sc; v[1] = __uint_as_float(acc.x & 0xFFFF0000u) + o[1] * sc;
    v[2] = __uint_as_float(acc.y << 16) + o[2] * sc; v[3] = __uint_as_float(acc.y & 0xFFFF0000u) + o[3] * sc;
    acc = pack4(v);
}
__device__ __forceinline__ float nsa_gate(const bf16_t* __restrict__ pb, int q, int br, int head) { return sigmoidf_(bf2f(pb[(size_t)q * PP + GA + br * 8 + head])); }

__device__ __forceinline__ void nsa_unit(int u, const bf16_t* __restrict__ proj, const char* __restrict__ ws, const float* __restrict__ rel_bias, bf16_t* __restrict__ ya, char* smem) {
    int tid_ = threadIdx.x; asm volatile("" : "+v"(tid_));
    const int tid = tid_, lane = tid & 63, wid = tid >> 6, fr = lane & 15, fq = lane >> 4, hp = fr & 3;
    const int bg = u & 7, qb = 63 - (u >> 3), b = bg >> 1, g = bg & 1, t0 = qb * 64, tb = qb;
    const bf16_t* kcb = (const bf16_t*)(ws + OFF_KCB) + (size_t)bg * 256 * 64;
    const bf16_t* vcbT = (const bf16_t*)(ws + OFF_VCBT) + (size_t)bg * 64 * 256;
    const bf16_t* VsT = (const bf16_t*)(ws + OFF_VST) + (size_t)bg * 64 * S;
    const bf16_t* VwT = (const bf16_t*)(ws + OFF_VWT) + (size_t)bg * 64 * S;
    const bf16_t* pb = proj + (size_t)b * S * PP;
    __syncthreads();
    {
        float* tbl = (float*)(smem + NSA_TB);
        { const int e = tid, h4 = e >> 7, n = e & 127; tbl[e] = rel_bias[t5_bucket2(n) * 8 + g * 4 + h4] * LOG2E; }
        float* imp = (float*)(smem + NSA_IMPA);
        for (int e = tid; e < 2 * 4160; e += 512) imp[e] = 0.f;
    }
    int qidx[2]; bf16x8 qf[2][2];
    const int head = g * 4 + hp;
#pragma unroll
    for (int ct = 0; ct < 2; ++ct) {
        qidx[ct] = t0 + wid * 8 + ct * 4 + (fr >> 2);
        const bf16_t* qr = pb + (size_t)qidx[ct] * PP;
#pragma unroll
        for (int ks = 0; ks < 2; ++ks) {
            const u32x4 raw = *(const u32x4*)(qr + QA + head * 64 + ks * 32 + fq * 8);
            u32x4 w;
#pragma unroll
            for (int e = 0; e < 4; ++e) w[e] = pack_bf16(__uint_as_float(raw[e] << 16) * (0.125f * LOG2E), __uint_as_float(raw[e] & 0xFFFF0000u) * (0.125f * LOG2E));
            qf[ct][ks] = __builtin_bit_cast(bf16x8, w);
        }
    }
    uint2 osum[4][2];
#pragma unroll
    for (int dt = 0; dt < 4; ++dt)
#pragma unroll
        for (int ct = 0; ct < 2; ++ct) osum[dt][ct] = make_uint2(0u, 0u);
    unsigned long long selq[2] = {0ull, 0ull};
    float invl0[2] = {0.f, 0.f};
    const int ntc = (((t0 + 32) >> 4) + 1 + 63) >> 6;
    float mC[2], invC[2];
    {
        f32x4 O[4][2]; float m[2] = {-1e30f, -1e30f}, l[2] = {0.f, 0.f};
#pragma unroll
        for (int dt = 0; dt < 4; ++dt)
#pragma unroll
            for (int ct = 0; ct < 2; ++ct) O[dt][ct] = (f32x4){0.f, 0.f, 0.f, 0.f};
        nsa_branch<0>(kcb, 64, vcbT, 256, 0, ntc, t0, qf, qidx, selq, 0ull, 0ull, O, m, l, invl0, smem);
#pragma unroll
        for (int ct = 0; ct < 2; ++ct) {
            float lt = l[ct]; lt += __shfl_xor(lt, 16); lt += __shfl_xor(lt, 32);
            invC[ct] = lt > 0.f ? 1.f / lt : 0.f; mC[ct] = m[ct];
#pragma unroll
            for (int dt = 0; dt < 4; ++dt) osum_add(osum[dt][ct], O[dt][ct], nsa_gate(pb, qidx[ct], 0, head) * invC[ct]);
        }
        nsa_branch<3>(kcb, 64, vcbT, 256, 0, ntc, t0, qf, qidx, selq, 0ull, 0ull, O, mC, l, invC, smem);
    }
    {
        const float* impA = (const float*)(smem + NSA_IMPA); const float* impB = (const float*)(smem + NSA_IMPB);
        unsigned long long* selm = (unsigned long long*)(smem + NSA_SELM);
#pragma unroll 1
        for (int qq = 0; qq < 8; ++qq) {
            const int ql = wid * 8 + qq;
            const float val = impA[ql * 65 + lane] + impB[ql * 65 + lane];
            const bool forced = (lane == 0) || (lane == tb) || (lane == tb - 1);
            unsigned key = forced ? 0xFFFFFFC0u : (lane > tb ? 0u : (__float_as_uint(val) & 0xFFFFFFC0u));
            key |= (unsigned)(63 - lane);
            int rank = 0;
#pragma unroll
            for (int jp = 0; jp < 64; ++jp) rank += ((unsigned)__builtin_amdgcn_readlane((int)key, jp) > key) ? 1 : 0;
            const unsigned long long msk = __ballot(rank < 16);
            if (lane == 0) selm[ql] = msk;
        }
        wave_lds_sync();
        unsigned long long so0 = 0ull, so1 = 0ull;
#pragma unroll
        for (int qq = 0; qq < 4; ++qq) { so0 |= selm[wid * 8 + qq]; so1 |= selm[wid * 8 + 4 + qq]; }
        const unsigned long long selor0 = ((unsigned long long)(unsigned)__builtin_amdgcn_readfirstlane((int)(unsigned)(so0 >> 32)) << 32) | (unsigned)__builtin_amdgcn_readfirstlane((int)(unsigned)so0);
        const unsigned long long selor1 = ((unsigned long long)(unsigned)__builtin_amdgcn_readfirstlane((int)(unsigned)(so1 >> 32)) << 32) | (unsigned)__builtin_amdgcn_readfirstlane((int)(unsigned)so1);
        selq[0] = selm[wid * 8 + (fr >> 2)]; selq[1] = selm[wid * 8 + 4 + (fr >> 2)];
        {
            f32x4 O[4][2]; float m[2] = {-1e30f, -1e30f}, l[2] = {0.f, 0.f};
#pragma unroll
            for (int dt = 0; dt < 4; ++dt)
#pragma unroll
                for (int ct = 0; ct < 2; ++ct) O[dt][ct] = (f32x4){0.f, 0.f, 0.f, 0.f};
            nsa_branch<1>(pb + KS + g * 64, PP, VsT, S, 0, tb + 1, t0, qf, qidx, selq, selor0, selor1, O, m, l, invl0, smem);
#pragma unroll
            for (int ct = 0; ct < 2; ++ct) {
                float lt = l[ct]; lt += __shfl_xor(lt, 16); lt += __shfl_xor(lt, 32);
                const float inv = lt > 0.f ? 1.f / lt : 0.f;
#pragma unroll
                for (int dt = 0; dt < 4; ++dt) osum_add(osum[dt][ct], O[dt][ct], nsa_gate(pb, qidx[ct], 1, head) * inv);
            }
        }
    }
    {
        f32x4 O[4][2]; float m[2] = {-1e30f, -1e30f}, l[2] = {0.f, 0.f};
#pragma unroll
        for (int dt = 0; dt < 4; ++dt)
#pragma unroll
            for (int ct = 0; ct < 2; ++ct) O[dt][ct] = (f32x4){0.f, 0.f, 0.f, 0.f};
        const int jw0 = (t0 - 511 < 0 ? 0 : t0 - 511) >> 6;
        nsa_branch<2>(pb + (size_t)jw0 * 64 * PP + KW + g * 64, PP, VwT + jw0 * 64, S, jw0, tb - jw0 + 1, t0, qf, qidx, selq, 0ull, 0ull, O, m, l, invl0, smem);
#pragma unroll
        for (int ct = 0; ct < 2; ++ct) {
            float lt = l[ct]; lt += __shfl_xor(lt, 16); lt += __shfl_xor(lt, 32);
            const float inv = lt > 0.f ? 1.f / lt : 0.f;
#pragma unroll
            for (int dt = 0; dt < 4; ++dt) osum_add(osum[dt][ct], O[dt][ct], nsa_gate(pb, qidx[ct], 2, head) * inv);
        }
    }
#pragma unroll
    for (int ct = 0; ct < 2; ++ct) {
        bf16_t* yr = ya + (size_t)(b * S + qidx[ct]) * 512 + head * 64 + 4 * fq;
#pragma unroll
        for (int dt = 0; dt < 4; ++dt) *(uint2*)(yr + dt * 16) = osum[dt][ct];
    }
}

__device__ __forceinline__ void vtrans_tile(int task, const bf16_t* __restrict__ proj, char* ws, char* smem) {
    unsigned short (*tl)[66] = (unsigned short (*)[66])smem;
    const int tid = HB_TID, which = task >> 9, bg = (task >> 6) & 7, tt = task & 63, b = bg >> 1, g = bg & 1;
    const int r = tid >> 2, q4 = tid & 3;
    const bf16_t* src = proj + (size_t)(b * S + tt * 64 + r) * PP + (which ? VW : VS) + g * 64 + q4 * 16;
    const uint4 a0 = *(const uint4*)src, a1 = *(const uint4*)(src + 8);
    unsigned* trow = (unsigned*)&tl[r][q4 * 16];
    trow[0] = a0.x; trow[1] = a0.y; trow[2] = a0.z; trow[3] = a0.w; trow[4] = a1.x; trow[5] = a1.y; trow[6] = a1.z; trow[7] = a1.w;
    __syncthreads();
    bf16_t* dst = (bf16_t*)(ws + (which ? OFF_VWT : OFF_VST)) + ((size_t)bg * 64 + r) * S + tt * 64 + q4 * 16;
    unsigned o[8];
#pragma unroll
    for (int k = 0; k < 8; ++k) o[k] = (unsigned)tl[q4 * 16 + 2 * k][r] | ((unsigned)tl[q4 * 16 + 2 * k + 1][r] << 16);
    *(uint4*)dst = make_uint4(o[0], o[1], o[2], o[3]);
    *(uint4*)(dst + 8) = make_uint4(o[4], o[5], o[6], o[7]);
    __syncthreads();
}

__device__ __forceinline__ int tile_el(int row, int col) { return tile_off(row, col >> 3) + ((col & 7) << 1); }

__device__ __forceinline__ void gla_stage_vt(const bf16_t* __restrict__ proj, size_t row0, int h, char* vt_base) {
    const int tid = HB_TID, c = tid >> 2, vq = tid & 3;
    const bf16_t* src = proj + (row0 + c) * PP + VB + h * 128 + vq * 32;
#pragma unroll
    for (int k = 0; k < 4; ++k) {
        const u32x4 a = *(const u32x4*)(src + k * 8);
#pragma unroll
        for (int e = 0; e < 4; ++e) {
            const int v = vq * 32 + k * 8 + 2 * e;
            *(unsigned short*)(vt_base + tile_el(v, c)) = (unsigned short)(a[e] & 0xFFFFu);
            *(unsigned short*)(vt_base + tile_el(v + 1, c)) = (unsigned short)(a[e] >> 16);
        }
    }
}

__device__ __forceinline__ void gla_a_unit(int vb, const bf16_t* __restrict__ proj, const float* __restrict__ w_alpha, const float* __restrict__ b_alpha,
                                           float* __restrict__ bc, float* __restrict__ cstate, char* smem) {
    float (*bcS)[64] = (float (*)[64])smem;
    float (*tot)[64] = (float (*)[64])(smem + 16384);
    char* KDT = smem + 17408;
    char* VT = smem + 17408 + 8192;
    const int tid = HB_TID, lane = tid & 63, wid = tid >> 6, fr = lane & 15, fq = lane >> 4;
    const int n = vb & 63, h = (vb >> 6) & 3, b = vb >> 8;
    const size_t row0 = (size_t)(b * S + n * 64);
    __syncthreads();
    {
        const int d = tid & 63, cq = tid >> 6, col = h * 64 + d;
        float w[16];
#pragma unroll
        for (int r = 0; r < 16; ++r) w[r] = w_alpha[r * 256 + col];
        const float bias = b_alpha[col];
        float cum = 0.f;
        for (int i = 0; i < 16; ++i) {
            const int c = cq * 16 + i;
            const u32x4 a0 = *(const u32x4*)(proj + (row0 + c) * PP + AB), a1 = *(const u32x4*)(proj + (row0 + c) * PP + AB + 8);
            float z = bias;
#pragma unroll
            for (int e = 0; e < 4; ++e) {
                z += __uint_as_float(a0[e] << 16) * w[2 * e] + __uint_as_float(a0[e] & 0xFFFF0000u) * w[2 * e + 1];
                z += __uint_as_float(a1[e] << 16) * w[8 + 2 * e] + __uint_as_float(a1[e] & 0xFFFF0000u) * w[8 + 2 * e + 1];
            }
            const float ls = fminf(z, 0.f) - log1pf(__expf(-fabsf(z)));
            cum += ls * (1.0f / 16.0f);
            bcS[c][d] = cum;
        }
        tot[cq][d] = cum;
        __syncthreads();
        float pre = 0.f;
        for (int q = 0; q < cq; ++q) pre += tot[q][d];
        for (int i = 0; i < 16; ++i) {
            const int c = cq * 16 + i;
            const float v = bcS[c][d] + pre;
            bcS[c][d] = v;
            bc[(row0 + c) * 256 + col] = v;
        }
    }
    __syncthreads();
    {
        const int c = tid >> 2, dq = tid & 3;
        const bf16_t* src = proj + (row0 + c) * PP + KB + h * 64 + dq * 16;
#pragma unroll
        for (int k = 0; k < 2; ++k) {
            const u32x4 a = *(const u32x4*)(src + k * 8);
#pragma unroll
            for (int e = 0; e < 4; ++e) {
                const int d = dq * 16 + k * 8 + 2 * e;
                const float k0 = __uint_as_float(a[e] << 16) * __expf(bcS[63][d] - bcS[c][d]);
                const float k1 = __uint_as_float(a[e] & 0xFFFF0000u) * __expf(bcS[63][d + 1] - bcS[c][d + 1]);
                *(unsigned short*)(KDT + tile_el(d, c)) = f2bf(k0);
                *(unsigned short*)(KDT + tile_el(d + 1, c)) = f2bf(k1);
            }
        }
    }
    gla_stage_vt(proj, row0, h, VT);
    __syncthreads();
    float* outp = cstate + (size_t)vb * 8192;
#pragma unroll
    for (int vi = 0; vi < 2; ++vi) {
        const int vt = wid * 2 + vi;
        const bf16x8 a0 = *(const bf16x8*)(VT + tile_off(vt * 16 + fr, fq)), a1 = *(const bf16x8*)(VT + tile_off(vt * 16 + fr, 4 + fq));
#pragma unroll
        for (int dt = 0; dt < 4; ++dt) {
            const bf16x8 b0 = *(const bf16x8*)(KDT + tile_off(dt * 16 + fr, fq)), b1 = *(const bf16x8*)(KDT + tile_off(dt * 16 + fr, 4 + fq));
            f32x4 acc = (f32x4){0.f, 0.f, 0.f, 0.f};
            acc = __builtin_amdgcn_mfma_f32_16x16x32_bf16(a0, b0, acc, 0, 0, 0);
            acc = __builtin_amdgcn_mfma_f32_16x16x32_bf16(a1, b1, acc, 0, 0, 0);
#pragma unroll
            for (int i = 0; i < 4; ++i) outp[(vt * 16 + 4 * fq + i) * 64 + dt * 16 + fr] = acc[i];
        }
    }
}

__device__ __forceinline__ void gla_scan_vb2(int vb, const float* __restrict__ bc, float* __restrict__ cstate) {
    const int idx = vb * 512 + threadIdx.x;
    const int e = idx & 8191, bh = idx >> 13, b = bh >> 2, h = bh & 3, d = e & 63;
    float state = 0.f;
    float* base = cstate + (size_t)bh * 64 * 8192 + e;
    const float* bcp = bc + ((size_t)(b * S + 63)) * 256 + h * 64 + d;
#pragma unroll 1
    for (int n0 = 0; n0 < 64; n0 += 16) {
        float upd[16], dec[16];
#pragma unroll
        for (int i = 0; i < 16; ++i) { upd[i] = base[(size_t)(n0 + i) * 8192]; dec[i] = bcp[(size_t)(n0 + i) * 64 * 256]; }
#pragma unroll
        for (int i = 0; i < 16; ++i) { base[(size_t)(n0 + i) * 8192] = state; state = __expf(dec[i]) * state + upd[i]; }
    }
}

__device__ __forceinline__ void gla_c_unit(int vb, const bf16_t* __restrict__ proj, const float* __restrict__ bc, const float* __restrict__ prev,
                                           const float* __restrict__ norm_g, bf16_t* __restrict__ yb, char* smem) {
    char* QI = smem;
    char* KI = smem + 8192;
    char* VT = smem + 16384;
    char* PT = smem + 32768;
    const int tid = HB_TID, lane = tid & 63, wid = tid >> 6, fr = lane & 15, fq = lane >> 4;
    const int n = vb & 63, h = (vb >> 6) & 3, b = vb >> 8;
    const size_t row0 = (size_t)(b * S + n * 64);
    __syncthreads();
    {
        const int c = tid >> 2, dq = tid & 3;
        const bf16_t* qs = proj + (row0 + c) * PP + QB + h * 64 + dq * 16;
        const bf16_t* ks = proj + (row0 + c) * PP + KB + h * 64 + dq * 16;
        const float* bs = bc + (row0 + c) * 256 + h * 64 + dq * 16;
#pragma unroll
        for (int k = 0; k < 2; ++k) {
            const u32x4 qa = *(const u32x4*)(qs + k * 8), ka = *(const u32x4*)(ks + k * 8);
            const f32x4 b0 = *(const f32x4*)(bs + k * 8), b1 = *(const f32x4*)(bs + k * 8 + 4);
            const float bv[8] = {b0[0], b0[1], b0[2], b0[3], b1[0], b1[1], b1[2], b1[3]};
            u32x4 qo, ko;
#pragma unroll
            for (int e = 0; e < 4; ++e) {
                const float e0 = __expf(bv[2 * e]), e1 = __expf(bv[2 * e + 1]);
                qo[e] = pack_bf16(__uint_as_float(qa[e] << 16) * 0.125f * e0, __uint_as_float(qa[e] & 0xFFFF0000u) * 0.125f * e1);
                ko[e] = pack_bf16(__uint_as_float(ka[e] << 16) / e0, __uint_as_float(ka[e] & 0xFFFF0000u) / e1);
            }
            *(u32x4*)(QI + tile_off(c, dq * 2 + k)) = qo;
            *(u32x4*)(KI + tile_off(c, dq * 2 + k)) = ko;
        }
    }
    gla_stage_vt(proj, row0, h, VT);
    {
        const int v = tid >> 1, half = tid & 1;
        const float* ps = prev + (size_t)vb * 8192 + v * 64 + half * 32;
#pragma unroll
        for (int k = 0; k < 4; ++k) {
            const f32x4 a = *(const f32x4*)(ps + k * 8), c2 = *(const f32x4*)(ps + k * 8 + 4);
            u32x4 o; o[0] = pack_bf16(a[0], a[1]); o[1] = pack_bf16(a[2], a[3]); o[2] = pack_bf16(c2[0], c2[1]); o[3] = pack_bf16(c2[2], c2[3]);
            *(u32x4*)(PT + tile_off(v, half * 4 + k)) = o;
        }
    }
    __syncthreads();
    const bf16x8 qf0 = *(const bf16x8*)(QI + tile_off(wid * 16 + fr, fq)), qf1 = *(const bf16x8*)(QI + tile_off(wid * 16 + fr, 4 + fq));
    bf16x8 pf[2];
    const int c = wid * 16 + fr;
#pragma unroll
    for (int p = 0; p < 2; ++p) {
        u32x4 w;
#pragma unroll
        for (int s = 0; s < 2; ++s) {
            const int row = 32 * p + 8 * (fr >> 2) + 4 * s + (fr & 3);
            const bf16x8 k0 = *(const bf16x8*)(KI + tile_off(row, fq)), k1 = *(const bf16x8*)(KI + tile_off(row, 4 + fq));
            f32x4 a = (f32x4){0.f, 0.f, 0.f, 0.f};
            a = __builtin_amdgcn_mfma_f32_16x16x32_bf16(k0, qf0, a, 0, 0, 0);
            a = __builtin_amdgcn_mfma_f32_16x16x32_bf16(k1, qf1, a, 0, 0, 0);
#pragma unroll
            for (int i = 0; i < 4; ++i) { const int j = 32 * p + 8 * fq + 4 * s + i; if (j > c) a[i] = 0.f; }
            w[2 * s] = pack_bf16(a[0], a[1]); w[2 * s + 1] = pack_bf16(a[2], a[3]);
        }
        pf[p] = __builtin_bit_cast(bf16x8, w);
    }
    f32x4 acc[8];
    float ss = 0.f;
#pragma unroll
    for (int vt = 0; vt < 8; ++vt) {
        f32x4 a = (f32x4){0.f, 0.f, 0.f, 0.f};
        a = __builtin_amdgcn_mfma_f32_16x16x32_bf16(*(const bf16x8*)(VT + tile_off(vt * 16 + fr, fq)), pf[0], a, 0, 0, 0);
        a = __builtin_amdgcn_mfma_f32_16x16x32_bf16(*(const bf16x8*)(VT + tile_off(vt * 16 + fr, 4 + fq)), pf[1], a, 0, 0, 0);
        a = __builtin_amdgcn_mfma_f32_16x16x32_bf16(*(const bf16x8*)(PT + tile_off(vt * 16 + fr, fq)), qf0, a, 0, 0, 0);
        a = __builtin_amdgcn_mfma_f32_16x16x32_bf16(*(const bf16x8*)(PT + tile_off(vt * 16 + fr, 4 + fq)), qf1, a, 0, 0, 0);
        acc[vt] = a;
        ss += a[0] * a[0] + a[1] * a[1] + a[2] * a[2] + a[3] * a[3];
    }
    ss += __shfl_xor(ss, 16); ss += __shfl_xor(ss, 32);
    const float r = rsqrtf(ss * (1.0f / 128.0f) + 1e-6f);
    const size_t row = row0 + c;
#pragma unroll
    for (int vt = 0; vt < 8; ++vt) {
        const int col = h * 128 + vt * 16 + 4 * fq;
        const uint2 rr = *(const uint2*)(proj + row * PP + RB + col);
        const f32x4 g4 = *(const f32x4*)(norm_g + col);
        const float r0 = __uint_as_float(rr.x << 16), r1 = __uint_as_float(rr.x & 0xFFFF0000u), r2 = __uint_as_float(rr.y << 16), r3 = __uint_as_float(rr.y & 0xFFFF0000u);
        f32x4 o;
        o[0] = acc[vt][0] * r * g4[0] * (r0 * sigmoidf_(r0)); o[1] = acc[vt][1] * r * g4[1] * (r1 * sigmoidf_(r1));
        o[2] = acc[vt][2] * r * g4[2] * (r2 * sigmoidf_(r2)); o[3] = acc[vt][3] * r * g4[3] * (r3 * sigmoidf_(r3));
        *(uint2*)(yb + row * 512 + col) = pack4(o);
    }
}

constexpr int SMEM_BYTES = 131072;

__global__ void __launch_bounds__(512, 2) k_fwd(Params p) {
    extern __shared__ __attribute__((aligned(16))) char smem_dyn[];
    char* smem = smem_dyn + 16;
    char* smh = smem + (threadIdx.x >> 8) * 65536;
    if (threadIdx.x == 0) *(uint4*)smem_dyn = make_uint4(0u, 0u, 0u, 0u);
    __syncthreads();
    char* ws = p.ws;
    XcdBarrier bar = xcd_barrier_post((unsigned*)(ws + OFF_BAR), (volatile LAS unsigned*)smem_dyn);
    int* ctrl = (int*)(ws + OFF_CTRL);
    bf16_t* proj = (bf16_t*)(ws + OFF_PROJ);
    float* bc = (float*)(ws + OFF_BC);
    float* cstate = (float*)(ws + OFF_CSTATE);
    bf16_t* mrg = (bf16_t*)(ws + OFF_MRG);
    bf16_t* h2 = (bf16_t*)(ws + OFF_H2);
    bf16_t* hid = (bf16_t*)(ws + OFF_HID);
    bf16_t* Y0 = (bf16_t*)(ws + OFF_Y0);
    bf16_t* Y1 = (bf16_t*)(ws + OFF_Y1);
    bf16_t* ya = (bf16_t*)(ws + OFF_YA);
    bf16_t* yb = (bf16_t*)(ws + OFF_YB);
    bf16_t* kcb = (bf16_t*)(ws + OFF_KCB);
    bf16_t* vcb = (bf16_t*)(ws + OFF_VCB);
    bf16_t* h = (bf16_t*)p.out;
    const int G = gridDim.x;

    ph_prep(p, smh);
    xcd_barrier(bar);
    { g8::StaticOrder S; S.init(T, 3072, G, (int)blockIdx.x); const g8::AddrPlain AD{(const char*)h, (const char*)(ws + OFF_WINT), 2048u, 2048u, 16};
      g8::gemm_phase(smem, S, AD, g8::EpiProj{proj}); }
    xcd_barrier(bar);
    ph_cmp1(proj, ws, smh);
    {
        const int nc = G > 32 ? 16 : 0, gb = (int)blockIdx.x - nc, gs = G - nc;
        if (gb >= 0) {
            for (int pr = gb; pr < 512; pr += gs) vtrans_tile(2 * pr + HB_ID, proj, ws, smh);
            for (int pr = gb; pr < 512; pr += gs) gla_a_unit(2 * pr + HB_ID, proj, p.w_alpha, p.b_alpha, bc, cstate, smh);
        }
    }
    xcd_barrier(bar);
    ph_cmp2(ws, ws, smh);
    for (int vb = blockIdx.x; vb < 256; vb += G) gla_scan_vb2(vb, bc, cstate);
    ph_prep_experts(p, smh);
    xcd_barrier(bar);
    for (int vb = HB_FIRST; vb < 1024; vb += HB_STEP) gla_c_unit(vb, proj, bc, cstate, p.norm_g, yb, smh);
    for (int r = 0; r * G < 512; ++r) {
        const int u = r * G + ((r & 1) ? (G - 1 - (int)blockIdx.x) : (int)blockIdx.x);
        if (u < 512) nsa_unit(u, proj, ws, p.rel_bias, ya, smem);
    }
    xcd_barrier(bar);
    {
        g8::MergeOrder MO; MO.so.init(T, 1024, G, (int)blockIdx.x);
        const g8::AddrMerge AD{(const char*)h, (const char*)(ws + OFF_WINT), (const char*)ya, (const char*)yb, (const char*)(ws + OFF_WAT), (const char*)(ws + OFF_WBT)};
        g8::gemm_phase(smem, MO, AD, g8::EpiMergeAll{mrg, (bf16_t*)(ws + OFF_R1)});
    }
    xcd_barrier(bar);
    { g8::StaticOrder S; S.init(T, 1024, G, (int)blockIdx.x); const g8::AddrPlain AD{(const char*)mrg, (const char*)(ws + OFF_WOT), 2048u, 2048u, 16};
      g8::gemm_phase(smem, S, AD, g8::EpiDelta{ya}); }
    xcd_barrier(bar);
    for (int grp = HB_FIRST; grp < 512; grp += HB_STEP) {
        for (int tt = 0; tt < 2; ++tt) router_unit(grp * 2 + tt, p.x, ya, p.g_ffn, (const bf16_t*)(ws + OFF_WRT), p.b_rg, p.b_re, h2, (float*)(ws + OFF_RSTD), smh);
        router_append(grp, (int*)(ws + OFF_LTOK), (float*)(ws + OFF_LW), ctrl, smh);
    }
    xcd_barrier(bar);
    ph_moe1(h2, (const bf16_t*)(ws + OFF_WGT), (const bf16_t*)(ws + OFF_WUT), ctrl, (const int*)(ws + OFF_LTOK), (const float*)(ws + OFF_LW), (const float*)(ws + OFF_RSTD), hid, smh);
    ph_prep_experts_down(p, ctrl, smh);
    xcd_barrier(bar);
    ph_moe2(hid, (const bf16_t*)(ws + OFF_WDT), ctrl, (const int*)(ws + OFF_LTOK), Y0, smh);
    xcd_barrier(bar);
    { int t_ = threadIdx.x; asm volatile("" : "+v"(t_)); for (int row = blockIdx.x * 8 + (t_ >> 6); row < T; row += G * 8) final_row(row, p.x, ya, p.out, Y0, Y1, p.g_final, t_ & 63); }
}

extern "C" void kernel_launch(void* const* d_in, const int* in_sizes, int n_in, void* d_out, int out_size, void* d_ws, size_t ws_size, hipStream_t stream) {
    static int grid = 0;
    constexpr int kDynLds = SMEM_BYTES + 16;
    if (!grid) {
        int dev = 0, cus = 0, per_cu = 0;
        (void)hipGetDevice(&dev);
        (void)hipDeviceGetAttribute(&cus, hipDeviceAttributeMultiprocessorCount, dev);
        (void)hipFuncSetAttribute((const void*)k_fwd, hipFuncAttributeMaxDynamicSharedMemorySize, kDynLds);
        (void)hipOccupancyMaxActiveBlocksPerMultiprocessor(&per_cu, k_fwd, 512, kDynLds);
        if (per_cu > 1) per_cu = 1;
        if (per_cu < 1) per_cu = 1;
        grid = cus * per_cu;
    }
    char* ws = (char*)d_ws;
    (void)hipMemsetAsync(ws + OFF_CTRL, 0, 32768, stream);
    Params p{};
    const float** pf = (const float**)&p;
    for (int i = 0; i < 25; ++i) pf[i] = (const float*)d_in[i];
    p.out = (float*)d_out; p.ws = ws;
    k_fwd<<<grid, 512, kDynLds, stream>>>(p);
}
```

```cpp
#include <hip/hip_runtime.h>
#include <stdint.h>

typedef unsigned short bf16_t;
typedef short bf16x8 __attribute__((ext_vector_type(8)));
typedef float f32x4 __attribute__((ext_vector_type(4)));
typedef unsigned u32x4 __attribute__((ext_vector_type(4)));
__device__ __forceinline__ float bf2f(bf16_t v) { return __uint_as_float(((unsigned)v) << 16); }
__device__ __forceinline__ bf16_t f2bf(float f) { unsigned u = __float_as_uint(f); u += 0x7FFFu + ((u >> 16) & 1u); return (bf16_t)(u >> 16); }
typedef float f32x2c_t __attribute__((ext_vector_type(2)));
typedef __bf16 bf16x2c_t __attribute__((ext_vector_type(2)));
__device__ __forceinline__ unsigned pack_bf16(float lo, float hi) { const f32x2c_t v = {lo, hi}; return __builtin_bit_cast(unsigned, __builtin_convertvector(v, bf16x2c_t)); }

constexpr int Bn = 4, S = 4096, T = Bn * S, D = 1024, NIN = 4904, PP = 2880;
constexpr int QA = 0, KC = 512, VC = 640, KS = 768, VS = 896, KW = 1024, VW = 1152, GA = 1280, QB = 1304, KB = 1560, VB = 1816, AB = 2328, RB = 2344, MGA = 2856, MGB = 3880;
constexpr int NPROJ = 2856;
constexpr int MSLOT = 36864;

constexpr size_t OFF_CTRL = 0;
constexpr size_t OFF_BAR = 16384;
constexpr size_t OFF_ROUTE_E = 49152;
constexpr size_t OFF_ROUTE_W = OFF_ROUTE_E + 32768 * 4;
constexpr size_t OFF_SLOT_TOK = OFF_ROUTE_W + 32768 * 4;
constexpr size_t OFF_SLOT_W = OFF_SLOT_TOK + (size_t)MSLOT * 4;
constexpr size_t OFF_BIAS1 = OFF_SLOT_W + (size_t)MSLOT * 4;
constexpr size_t OFF_RSTD = OFF_BIAS1 + 8192;
constexpr size_t OFF_SLOT_RS = OFF_RSTD + (size_t)T * 4;
constexpr size_t OFF_WRT = OFF_SLOT_RS + (size_t)MSLOT * 4;
static_assert(OFF_WRT + 2 * 48 * 1024 * 2 <= (1u << 20), "ctrl overflow");
constexpr size_t OFF_R1 = 1u << 20;
constexpr size_t SZ_PROJ = (size_t)T * PP * 2;
constexpr size_t OFF_PROJ = OFF_R1;
constexpr size_t OFF_BC = OFF_PROJ + SZ_PROJ;
constexpr size_t OFF_CSTATE = OFF_BC + (size_t)T * 256 * 4;
constexpr size_t OFF_R1_END = OFF_CSTATE + (size_t)1024 * 8192 * 4;
constexpr size_t OFF_MRG = OFF_R1 + (size_t)T * 2048 * 2;
constexpr size_t OFF_H2 = OFF_R1;
constexpr size_t OFF_HID = OFF_H2 + (size_t)T * 1024 * 2;
constexpr size_t OFF_Y0 = OFF_HID + (size_t)2 * T * 256 * 2;
constexpr size_t OFF_Y1 = OFF_Y0 + (size_t)T * 1024 * 2;
static_assert(OFF_MRG + (size_t)T * 1024 * 2 <= OFF_R1_END, "alias overflow");
static_assert(OFF_Y1 + (size_t)T * 1024 * 2 <= OFF_R1_END, "alias overflow");
constexpr size_t OFF_YA = OFF_R1_END;
constexpr size_t OFF_YB = OFF_YA + (size_t)T * 512 * 2;
constexpr size_t OFF_KCB = OFF_YB + (size_t)T * 512 * 2;
constexpr size_t OFF_VCB = OFF_KCB + 8 * 256 * 64 * 2;
constexpr size_t OFF_VCBT = OFF_VCB + 8 * 256 * 64 * 2;
constexpr size_t OFF_HIDC = OFF_VCBT + 8 * 256 * 64 * 2;
constexpr size_t OFF_VST = OFF_HIDC + 2 * 2048 * 128 * 2;
constexpr size_t OFF_VWT = OFF_VST + (size_t)8 * 64 * S * 2;
constexpr size_t OFF_WINT = OFF_VWT + (size_t)8 * 64 * S * 2;
constexpr size_t OFF_CK1T = OFF_WINT + (size_t)NIN * 1024 * 2;
constexpr size_t OFF_CV1T = OFF_CK1T + 128 * 2048 * 2;
constexpr size_t OFF_CK2T = OFF_CV1T + 128 * 2048 * 2;
constexpr size_t OFF_CV2T = OFF_CK2T + 128 * 128 * 2;
constexpr size_t OFF_WAT = OFF_CV2T + 128 * 128 * 2;
constexpr size_t OFF_WBT = OFF_WAT + 1024 * 512 * 2;
constexpr size_t OFF_WOT = OFF_WBT + 1024 * 512 * 2;
constexpr size_t OFF_WGT = OFF_WOT + 1024 * 1024 * 2;
constexpr size_t OFF_WUT = OFF_WGT + (size_t)32 * 256 * 1024 * 2;
constexpr size_t OFF_WDT = OFF_WUT + (size_t)32 * 256 * 1024 * 2;
constexpr size_t OFF_LTOK = OFF_WDT + (size_t)32 * 1024 * 256 * 2;
constexpr size_t OFF_LW = OFF_LTOK + (size_t)32 * 16384 * 4;
constexpr size_t OFF_END = OFF_LW + (size_t)32 * 16384 * 4;
static_assert(OFF_END <= (size_t)256 << 20, "workspace overflow");

#define XB_TMO      128
#define XB_XCNT(j)  (256  + 64 * (j))
#define XB_XSUB(j)  (1280 + 64 * (j))
#define XB_XGEN(j)  (2304 + 64 * (j))
#define XB_TOP      3328
#define XB_TOPGEN   3392
#define XCD_BAR_WORDS 3456
#define XB_SPIN_CAP (1u << 18)
#define LAS __attribute__((address_space(3)))

__device__ __forceinline__ unsigned xb_ld(unsigned* p)              { return __hip_atomic_load(p, __ATOMIC_RELAXED, __HIP_MEMORY_SCOPE_AGENT); }
__device__ __forceinline__ unsigned xb_add(unsigned* p, unsigned v) { return __hip_atomic_fetch_add(p, v, __ATOMIC_RELAXED, __HIP_MEMORY_SCOPE_AGENT); }
__device__ __forceinline__ unsigned xb_xcc_id() { return (unsigned)__builtin_amdgcn_s_getreg((3 << 11) | 20) & 0xFu; }
#define XB_SPIN(cond, bar) do { unsigned _sp = 0; while (cond) { __builtin_amdgcn_s_sleep(1); \
    if ((++_sp & 255u) == 0u) { if (xb_ld(&(bar)[XB_TMO])) break; if (_sp > XB_SPIN_CAP) { atomicAdd(&(bar)[XB_TMO], 1u); break; } } } } while (0)

struct XcdBarrier { unsigned* bar; unsigned x; volatile LAS unsigned* st; };

__device__ __forceinline__ XcdBarrier xcd_barrier_post(unsigned* bar, volatile LAS unsigned* st) {
    XcdBarrier b; b.bar = bar; b.x = xb_xcc_id(); b.st = st;
    if (threadIdx.x == 0) (void)xb_add(&bar[XB_XCNT(b.x)], 1u);
    return b;
}
__device__ __forceinline__ void xcd_barrier_complete(unsigned* bar, unsigned x, unsigned& nloc, unsigned& nx) {
    const unsigned G = gridDim.x * gridDim.y * gridDim.z;
    unsigned sum, cnt, mine, sp = 0u;
    for (;;) {
        sum = 0u; cnt = 0u; mine = 0u;
#pragma unroll
        for (unsigned j = 0; j < 16; ++j) { const unsigned c = xb_ld(&bar[XB_XCNT(j)]); sum += c; cnt += (c > 0u) ? 1u : 0u; mine = (j == x) ? c : mine; }
        if (sum == G) break;
        __builtin_amdgcn_s_sleep(1);
        if ((++sp & 255u) == 0u) { if (xb_ld(&bar[XB_TMO])) break; if (sp > XB_SPIN_CAP) { atomicAdd(&bar[XB_TMO], 1u); break; } }
    }
    nloc = mine > 0u ? mine : 1u; nx = cnt > 0u ? cnt : 1u;
}
__device__ __forceinline__ void xcd_barrier(const XcdBarrier& b) {
    asm volatile("s_waitcnt vmcnt(0)" ::: "memory");
    __syncthreads();
    if (threadIdx.x == 0) {
        unsigned* bar = b.bar;
        __builtin_amdgcn_s_waitcnt(0);
        unsigned nloc = b.st[0], nx = b.st[1];
        if (nloc == 0u) { xcd_barrier_complete(bar, b.x, nloc, nx); b.st[0] = nloc; b.st[1] = nx; }
        const unsigned old = xb_add(&bar[XB_XSUB(b.x)], 1u);
        const unsigned gen = old / nloc;
        if (old + 1u == (gen + 1u) * nloc) {
            __builtin_amdgcn_fence(__ATOMIC_RELEASE, "agent");
            asm volatile("s_waitcnt vmcnt(0)" ::: "memory");
            const unsigned og = xb_add(&bar[XB_TOP], 1u);
            const unsigned tg = og / nx;
            if (og + 1u == (tg + 1u) * nx) xb_add(&bar[XB_TOPGEN], 1u);
            else XB_SPIN(xb_ld(&bar[XB_TOPGEN]) == tg, bar);
            __builtin_amdgcn_fence(__ATOMIC_ACQUIRE, "agent");
            xb_add(&bar[XB_XGEN(b.x)], 1u);
            asm volatile("s_waitcnt vmcnt(0)" ::: "memory");
        } else {
            XB_SPIN(xb_ld(&bar[XB_XGEN(b.x)]) == gen, bar);
            __builtin_amdgcn_fence(__ATOMIC_ACQUIRE, "agent");
            asm volatile("s_waitcnt vmcnt(0)" ::: "memory");
        }
    }
    __syncthreads();
}

#define XB2_XSUB(j) (4096 + 64 * (j))
#define XB2_TOP     5120
#define XB2_TOPGEN  5184
__device__ __forceinline__ void xcd_arrive2(const XcdBarrier& b) {
    asm volatile("s_waitcnt vmcnt(0)" ::: "memory");
    __syncthreads();
    if (threadIdx.x == 0) {
        unsigned* bar = b.bar;
        __builtin_amdgcn_s_waitcnt(0);
        unsigned nloc = b.st[0], nx = b.st[1];
        if (nloc == 0u) { xcd_barrier_complete(bar, b.x, nloc, nx); b.st[0] = nloc; b.st[1] = nx; }
        const unsigned old = xb_add(&bar[XB2_XSUB(b.x)], 1u);
        const unsigned gen = old / nloc;
        if (old + 1u == (gen + 1u) * nloc) {
            __builtin_amdgcn_fence(__ATOMIC_RELEASE, "agent");
            asm volatile("s_waitcnt vmcnt(0)" ::: "memory");
            const unsigned og = xb_add(&bar[XB2_TOP], 1u);
            const unsigned tg = og / nx;
            if (og + 1u == (tg + 1u) * nx) xb_add(&bar[XB2_TOPGEN], 1u);
        }
        b.st[2] = gen;
    }
}
__device__ __forceinline__ void xcd_wait2(const XcdBarrier& b) {
    if (threadIdx.x == 0) {
        unsigned* bar = b.bar;
        const unsigned gen = b.st[2];
        XB_SPIN(xb_ld(&bar[XB2_TOPGEN]) <= gen, bar);
        __builtin_amdgcn_fence(__ATOMIC_ACQUIRE, "agent");
        asm volatile("s_waitcnt vmcnt(0)" ::: "memory");
    }
    __syncthreads();
}


__device__ __forceinline__ int hb_tid_() { int t = threadIdx.x; asm volatile("" : "+v"(t)); return t & 255; }
#define HB_TID (hb_tid_())
#define HB_ID ((int)(threadIdx.x >> 8))
#define HB_FIRST (2 * (int)blockIdx.x + HB_ID)
#define HB_STEP (2 * (int)gridDim.x)
struct Params {
    const float *x, *g_mix, *w_in, *pe_k, *ck1, *ck2, *pe_v, *cv1, *cv2, *rel_bias, *w_alpha, *b_alpha, *norm_g, *w_ba, *w_bb, *w_out, *g_ffn,
                *w_rg, *b_rg, *w_re, *b_re, *w_eg, *w_eu, *w_ed, *g_final;
    float* out; char* ws;
};

__device__ __forceinline__ float wave_max(float v) { for (int o = 32; o > 0; o >>= 1) v = fmaxf(v, __shfl_xor(v, o)); return v; }
__device__ __forceinline__ float wave_sum(float v) { for (int o = 32; o > 0; o >>= 1) v += __shfl_xor(v, o); return v; }
__device__ __forceinline__ void wave_lds_sync() { asm volatile("s_waitcnt lgkmcnt(0)" ::: "memory"); }


__device__ __forceinline__ void rms_h_row(int row, const float* __restrict__ x, const float* __restrict__ g, bf16_t* __restrict__ h, int lane) {
    const float* xr = x + (size_t)row * D + lane * 4;
    f32x4 v[4]; float s = 0.f;
#pragma unroll
    for (int i = 0; i < 4; ++i) { v[i] = *(const f32x4*)(xr + 256 * i); s += v[i][0] * v[i][0] + v[i][1] * v[i][1] + v[i][2] * v[i][2] + v[i][3] * v[i][3]; }
    s = wave_sum(s);
    const float r = rsqrtf(s * (1.0f / D) + 1e-6f);
#pragma unroll
    for (int i = 0; i < 4; ++i) {
        const f32x4 gg = *(const f32x4*)(g + lane * 4 + 256 * i);
        uint2 o; o.x = pack_bf16(v[i][0] * r * gg[0], v[i][1] * r * gg[1]); o.y = pack_bf16(v[i][2] * r * gg[2], v[i][3] * r * gg[3]);
        *(uint2*)(h + (size_t)row * D + lane * 4 + 256 * i) = o;
    }
}
__device__ __forceinline__ void final_row(int row, const float* __restrict__ x, const bf16_t* __restrict__ dl, float* __restrict__ outp, const bf16_t* __restrict__ Y0, const bf16_t* __restrict__ Y1, const float* __restrict__ g, int lane) {
    const float* xr = x + (size_t)row * D + lane * 4;
    f32x4 v[4]; float s = 0.f;
#pragma unroll
    for (int i = 0; i < 4; ++i) {
        v[i] = *(const f32x4*)(xr + 256 * i);
        const uint2 a = *(const uint2*)(Y0 + (size_t)row * D + lane * 4 + 256 * i), c = *(const uint2*)(Y1 + (size_t)row * D + lane * 4 + 256 * i);
        const uint2 e = *(const uint2*)(dl + (size_t)row * D + lane * 4 + 256 * i);
        v[i][0] += __uint_as_float(e.x << 16); v[i][1] += __uint_as_float(e.x & 0xFFFF0000u); v[i][2] += __uint_as_float(e.y << 16); v[i][3] += __uint_as_float(e.y & 0xFFFF0000u);
        v[i][0] += __uint_as_float(a.x << 16) + __uint_as_float(c.x << 16);
        v[i][1] += __uint_as_float(a.x & 0xFFFF0000u) + __uint_as_float(c.x & 0xFFFF0000u);
        v[i][2] += __uint_as_float(a.y << 16) + __uint_as_float(c.y << 16);
        v[i][3] += __uint_as_float(a.y & 0xFFFF0000u) + __uint_as_float(c.y & 0xFFFF0000u);
        s += v[i][0] * v[i][0] + v[i][1] * v[i][1] + v[i][2] * v[i][2] + v[i][3] * v[i][3];
    }
    s = wave_sum(s);
    const float r = rsqrtf(s * (1.0f / D) + 1e-6f);
#pragma unroll
    for (int i = 0; i < 4; ++i) {
        const f32x4 gg = *(const f32x4*)(g + lane * 4 + 256 * i);
        *(f32x4*)(outp + (size_t)row * D + lane * 4 + 256 * i) = (f32x4){v[i][0] * r * gg[0], v[i][1] * r * gg[1], v[i][2] * r * gg[2], v[i][3] * r * gg[3]};
    }
}

__device__ __forceinline__ void prep_router_w(const float* __restrict__ w_rg, const float* __restrict__ w_re, bf16_t* __restrict__ WrT) {
    for (int idx = blockIdx.x * 512 + threadIdx.x; idx < 48 * 1024; idx += gridDim.x * 512) {
        const int n = idx >> 10, k = idx & 1023;
        const float w = n < 4 ? w_rg[k * 4 + n] : (n < 36 ? w_re[k * 32 + n - 4] : 0.f);
        const bf16_t hi = f2bf(w);
        const int fi = ((((n >> 4) * 32 + (k >> 5)) * 64 + ((k >> 3) & 3) * 16 + (n & 15)) << 3) + (k & 7);
        WrT[fi] = hi; WrT[48 * 1024 + fi] = f2bf(w - bf2f(hi));
    }
}

__device__ __forceinline__ void router_unit(int task, const float* __restrict__ x, const bf16_t* __restrict__ dl, const float* __restrict__ g, const bf16_t* __restrict__ WrT,
                                            const float* __restrict__ b_rg, const float* __restrict__ b_re, bf16_t* __restrict__ h2, float* __restrict__ rstd_out,
                                            char* smem) {
    float (*part)[16][49] = (float (*)[16][49])smem;
    int* dec_e = (int*)(smem + 14336); float* dec_w = (float*)(smem + 14336 + 512);
    float (*ssp)[16] = (float (*)[16])(smem + 4 * 16 * 49 * 4);
    const int tid = HB_TID, lane = tid & 63, w4 = tid >> 6, fr = lane & 15, fq = lane >> 4, r0 = task * 16;
    const float* xr = x + (size_t)(r0 + fr) * D + fq * 8 + w4 * 256;
    const bf16_t* dr = dl + (size_t)(r0 + fr) * D + fq * 8 + w4 * 256;
    bf16_t* hr = h2 + (size_t)(r0 + fr) * D + fq * 8 + w4 * 256;
    const bf16_t* wh = WrT + ((size_t)(w4 * 8) * 64 + lane) * 8;
    const float* gp = g + fq * 8 + w4 * 256;
    f32x4 acc[3];
#pragma unroll
    for (int nt = 0; nt < 3; ++nt) acc[nt] = (f32x4){0.f, 0.f, 0.f, 0.f};
    float ssq = 0.f;
    f32x4 xa[8][2]; u32x4 dda[8];
#pragma unroll
    for (int ks = 0; ks < 8; ++ks) { xa[ks][0] = *(const f32x4*)(xr + ks * 32); xa[ks][1] = *(const f32x4*)(xr + ks * 32 + 4); dda[ks] = *(const u32x4*)(dr + ks * 32); }
    bf16x8 bhb[2][3], blb[2][3]; f32x4 gb[2][2];
#define RT_LOADW(ks_, b_) do { _Pragma("unroll") for (int nt = 0; nt < 3; ++nt) { bhb[b_][nt] = *(const bf16x8*)(wh + (size_t)(nt * 32 + (ks_)) * 512); \
            blb[b_][nt] = *(const bf16x8*)(wh + 48 * 1024 + (size_t)(nt * 32 + (ks_)) * 512); } \
        gb[b_][0] = *(const f32x4*)(gp + (ks_) * 32); gb[b_][1] = *(const f32x4*)(gp + (ks_) * 32 + 4); } while (0)
    RT_LOADW(0, 0);
#pragma unroll
    for (int ks = 0; ks < 8; ++ks) {
        const int cb = ks & 1;
        if (ks + 1 < 8) RT_LOADW(ks + 1, cb ^ 1);
        f32x4 x0 = xa[ks][0], x1 = xa[ks][1];
        { const u32x4 dd = dda[ks];
          x0[0] += __uint_as_float(dd[0] << 16); x0[1] += __uint_as_float(dd[0] & 0xFFFF0000u); x0[2] += __uint_as_float(dd[1] << 16); x0[3] += __uint_as_float(dd[1] & 0xFFFF0000u);
          x1[0] += __uint_as_float(dd[2] << 16); x1[1] += __uint_as_float(dd[2] & 0xFFFF0000u); x1[2] += __uint_as_float(dd[3] << 16); x1[3] += __uint_as_float(dd[3] & 0xFFFF0000u); }
        const f32x4 g0 = gb[cb][0], g1 = gb[cb][1];
        float xg[8];
#pragma unroll
        for (int e = 0; e < 4; ++e) { xg[e] = x0[e] * g0[e]; xg[4 + e] = x1[e] * g1[e]; ssq += x0[e] * x0[e] + x1[e] * x1[e]; }
        u32x4 hi, lo;
#pragma unroll
        for (int e = 0; e < 4; ++e) {
            hi[e] = pack_bf16(xg[2 * e], xg[2 * e + 1]);
            lo[e] = pack_bf16(xg[2 * e] - __uint_as_float(hi[e] << 16), xg[2 * e + 1] - __uint_as_float(hi[e] & 0xFFFF0000u));
        }
        *(u32x4*)(hr + ks * 32) = hi;
        const bf16x8 ah = __builtin_bit_cast(bf16x8, hi), al = __builtin_bit_cast(bf16x8, lo);
#pragma unroll
        for (int nt = 0; nt < 3; ++nt) {
            acc[nt] = __builtin_amdgcn_mfma_f32_16x16x32_bf16(ah, bhb[cb][nt], acc[nt], 0, 0, 0);
            acc[nt] = __builtin_amdgcn_mfma_f32_16x16x32_bf16(al, bhb[cb][nt], acc[nt], 0, 0, 0);
            acc[nt] = __builtin_amdgcn_mfma_f32_16x16x32_bf16(ah, blb[cb][nt], acc[nt], 0, 0, 0);
        }
    }
#undef RT_LOADW
    ssq += __shfl_xor(ssq, 16); ssq += __shfl_xor(ssq, 32);
    __syncthreads();
    if (fq == 0) ssp[w4][fr] = ssq;
#pragma unroll
    for (int nt = 0; nt < 3; ++nt)
#pragma unroll
        for (int i = 0; i < 4; ++i) part[w4][4 * fq + i][nt * 16 + fr] = acc[nt][i];
    __syncthreads();
    if (tid < 16) {
        const int row = r0 + tid;
        const float rsv = rsqrtf((ssp[0][tid] + ssp[1][tid] + ssp[2][tid] + ssp[3][tid]) * (1.0f / D) + 1e-6f);
        rstd_out[row] = rsv;
        float l4[4];
#pragma unroll
        for (int j = 0; j < 4; ++j) l4[j] = (part[0][tid][j] + part[1][tid][j] + part[2][tid][j] + part[3][tid][j]) * rsv + b_rg[j];
        int gs = 0; float mx = l4[0];
#pragma unroll
        for (int j = 1; j < 4; ++j) if (l4[j] > mx) { mx = l4[j]; gs = j; }
        float den = 0.f;
#pragma unroll
        for (int j = 0; j < 4; ++j) den += __expf(l4[j] - mx);
        const float gpb = 1.f / den;
        float v0 = -3e38f, v1 = -3e38f; int i0 = 0, i1 = 0;
        for (int j = 0; j < 8; ++j) {
            const int c = 4 + gs * 8 + j;
            const float l = (part[0][tid][c] + part[1][tid][c] + part[2][tid][c] + part[3][tid][c]) * rsv + b_re[gs * 8 + j];
            if (l > v0) { v1 = v0; i1 = i0; v0 = l; i0 = j; }
            else if (l > v1) { v1 = l; i1 = j; }
        }
        const float e1 = __expf(v1 - v0);
        const int lr = (task & 1) * 16 + tid;
        dec_e[lr * 2] = gs * 8 + i0; dec_e[lr * 2 + 1] = gs * 8 + i1;
        dec_w[lr * 2] = gpb / (1.f + e1); dec_w[lr * 2 + 1] = gpb * e1 / (1.f + e1);
    }
}
__device__ __forceinline__ void router_append(int group, int* __restrict__ ltok, float* __restrict__ lw, int* __restrict__ cnt, char* smem) {
    int* dec_e = (int*)(smem + 14336); float* dec_w = (float*)(smem + 14336 + 512);
    int* hist = (int*)(smem + 14336 + 1024); int* base = hist + 32;
    const int tid = HB_TID;
    if (tid < 32) hist[tid] = 0;
    __syncthreads();
    int e = 0, lpos = 0;
    if (tid < 64) { e = dec_e[tid]; lpos = atomicAdd(&hist[e], 1); }
    __syncthreads();
    if (tid < 32) { const int hcount = hist[tid]; base[tid] = hcount ? atomicAdd(&cnt[tid * 64], hcount) : 0; }
    __syncthreads();
    if (tid < 64) { const int pos = e * 16384 + base[e] + lpos; ltok[pos] = (group * 32 + (tid >> 1)) * 2 + (tid & 1); lw[pos] = dec_w[tid]; }
    __syncthreads();
}

__device__ __forceinline__ void transpose_tile(const float* __restrict__ src, int ld_src, int N, bf16_t* __restrict__ dst, int ld_dst, int kt, int nt, char* smem) {
    float (*tl)[65] = (float (*)[65])smem;
    const int tid = HB_TID;
    const int c4 = (tid & 15) * 4, r0 = tid >> 4;
#pragma unroll
    for (int i = 0; i < 4; ++i) {
        const int k = r0 + 16 * i, n = nt * 64 + c4;
        float4 v = make_float4(0.f, 0.f, 0.f, 0.f);
        if (n < N) v = *(const float4*)(src + (size_t)(kt * 64 + k) * ld_src + n);
        tl[k][c4] = v.x; tl[k][c4 + 1] = v.y; tl[k][c4 + 2] = v.z; tl[k][c4 + 3] = v.w;
    }
    __syncthreads();
    const int kc = (tid & 7) * 8, n0 = tid >> 3;
#pragma unroll
    for (int i = 0; i < 2; ++i) {
        const int nl = n0 + 32 * i, n = nt * 64 + nl;
        if (n < N) {
            uint4 o;
            o.x = pack_bf16(tl[kc][nl], tl[kc + 1][nl]); o.y = pack_bf16(tl[kc + 2][nl], tl[kc + 3][nl]);
            o.z = pack_bf16(tl[kc + 4][nl], tl[kc + 5][nl]); o.w = pack_bf16(tl[kc + 6][nl], tl[kc + 7][nl]);
            *(uint4*)(dst + (size_t)n * ld_dst + kt * 64 + kc) = o;
        }
    }
    __syncthreads();
}

__device__ __forceinline__ void filler_pair(const Params& p, int pr, char* smem) {
    char* ws = p.ws;
    const int t = 2 * pr + HB_ID;
    if (t < 128) transpose_tile(p.w_ba, 1024, 1024, (bf16_t*)(ws + OFF_WAT), 512, t >> 4, t & 15, smem);
    else if (t < 256) { const int q = t - 128; transpose_tile(p.w_bb, 1024, 1024, (bf16_t*)(ws + OFF_WBT), 512, q >> 4, q & 15, smem); }
    else if (t < 512) { const int q = t - 256; transpose_tile(p.w_out, 1024, 1024, (bf16_t*)(ws + OFF_WOT), 1024, q >> 4, q & 15, smem); }
    else { const int q = t - 512, e = (q & 2047) >> 6, r = q & 63;
        if (q < 2048) transpose_tile(p.w_eg + (size_t)e * 1024 * 256, 256, 256, (bf16_t*)(ws + OFF_WGT) + (size_t)e * 256 * 1024, 1024, r >> 2, r & 3, smem);
        else transpose_tile(p.w_eu + (size_t)e * 1024 * 256, 256, 256, (bf16_t*)(ws + OFF_WUT) + (size_t)e * 256 * 1024, 1024, r >> 2, r & 3, smem); }
}
__device__ __forceinline__ void ph_filler(const Params& p, int lo, int hi, char* smem) {
    for (int i = lo; i < hi; ++i) { const int pr = (int)blockIdx.x + i * (int)gridDim.x; if (pr < 2304) filler_pair(p, pr, smem); }
}
__device__ __forceinline__ void ph_prep_experts(const Params& p, char* smem) {
    char* ws = p.ws;
    for (int t = HB_FIRST; t < 4096; t += HB_STEP) {
        const int e = (t & 2047) >> 6, r = t & 63;
        if (t < 2048) transpose_tile(p.w_eg + (size_t)e * 1024 * 256, 256, 256, (bf16_t*)(ws + OFF_WGT) + (size_t)e * 256 * 1024, 1024, r >> 2, r & 3, smem);
        else transpose_tile(p.w_eu + (size_t)e * 1024 * 256, 256, 256, (bf16_t*)(ws + OFF_WUT) + (size_t)e * 256 * 1024, 1024, r >> 2, r & 3, smem);
    }
}
struct MoeTab { int c, pr, pt; };
__device__ __forceinline__ MoeTab moe_tab(const int* __restrict__ cnt) {
    int l_ = threadIdx.x; asm volatile("" : "+v"(l_));
    const int el = l_ & 31;
    MoeTab t; t.c = cnt[el * 64]; t.pr = t.c; t.pt = (t.c + 127) >> 7;
#pragma unroll
    for (int o = 1; o < 32; o <<= 1) {
        const int a = __shfl_up(t.pr, o, 32), b = __shfl_up(t.pt, o, 32);
        if (el >= o) { t.pr += a; t.pt += b; }
    }
    return t;
}
__device__ __forceinline__ int moe_ntiles(const MoeTab& t) { return __builtin_amdgcn_readlane(t.pt, 31); }
__device__ __forceinline__ void moe_decode(const MoeTab& t, int tile, int& e, int& ti, int& ebase, int& ne) {
    const unsigned long long m = __builtin_amdgcn_ballot_w64(t.pt <= tile);
    e = __builtin_popcount((unsigned)m);
    e = e > 31 ? 31 : e;
    const int em = e > 0 ? e - 1 : 0;
    const int ptm = __builtin_amdgcn_readlane(t.pt, em), prm = __builtin_amdgcn_readlane(t.pr, em);
    ti = tile - (e > 0 ? ptm : 0); ebase = e > 0 ? prm : 0; ne = __builtin_amdgcn_readlane(t.c, e);
}
__device__ __forceinline__ void moe_expert(const MoeTab& t, int e, int& ebase, int& ne) {
    const int em = e > 0 ? e - 1 : 0;
    const int prm = __builtin_amdgcn_readlane(t.pr, em);
    ebase = e > 0 ? prm : 0; ne = __builtin_amdgcn_readlane(t.c, e);
}
struct MoeMap { int lo, hi, j, nj, x; };
__device__ __forceinline__ MoeMap moe_map(int nu) {
    MoeMap m; const int G = gridDim.x;
    if ((G & 7) == 0) {
        m.x = (int)blockIdx.x & 7; m.j = 2 * ((int)blockIdx.x >> 3) + HB_ID; m.nj = G >> 2;
        m.lo = ((m.x * (nu >> 1)) >> 3) << 1; m.hi = (m.x == 7) ? nu : ((((m.x + 1) * (nu >> 1)) >> 3) << 1);
    } else { m.x = -1; m.j = HB_FIRST; m.nj = HB_STEP; m.lo = 0; m.hi = nu; }
    return m;
}
__device__ __forceinline__ void ph_prep_experts_down(const Params& p, const int* __restrict__ cnt, char* smem) {
    char* ws = p.ws;
    const MoeTab mt = moe_tab(cnt); const int nu = moe_ntiles(mt) * 4;
    const MoeMap mm = moe_map(nu);
    const int L = mm.hi - mm.lo;
    int rem = L % mm.nj; if (mm.nj - rem < mm.nj / 2) rem = 0;
    const int k = mm.j - rem, st = mm.nj - rem;
    if (k < 0) return;
    const int t0 = mm.x < 0 ? 0 : mm.x * 256, t1 = mm.x < 0 ? 2048 : t0 + 256;
    for (int t = t0 + k; t < t1; t += st) {
        const int e = t >> 6, r = t & 63;
        transpose_tile(p.w_ed + (size_t)e * 256 * 1024, 1024, 1024, (bf16_t*)(ws + OFF_WDT) + (size_t)e * 1024 * 256, 256, r >> 4, r & 15, smem);
    }
}
__device__ __forceinline__ void ph_prep(const Params& p, char* smem) {
    char* ws = p.ws;
    constexpr int N0 = 16 * 77, N1 = N0 + 64, N2 = N1 + 64, N3 = N2 + 2, N4 = N3 + 2, N5 = N4 + 128, N6 = N5 + 128, N7 = N6 + 256;
    for (int t = HB_FIRST; t < N4; t += HB_STEP) {
        if (t < N0) transpose_tile(p.w_in, NIN, NIN, (bf16_t*)(ws + OFF_WINT), 1024, t / 77, t % 77, smem);
        else if (t < N1) { const int q = t - N0; transpose_tile(p.ck1, 128, 128, (bf16_t*)(ws + OFF_CK1T), 2048, q >> 1, q & 1, smem); }
        else if (t < N2) { const int q = t - N1; transpose_tile(p.cv1, 128, 128, (bf16_t*)(ws + OFF_CV1T), 2048, q >> 1, q & 1, smem); }
        else if (t < N3) { const int q = t - N2; transpose_tile(p.ck2, 64, 64, (bf16_t*)(ws + OFF_CK2T), 128, q, 0, smem); }
        else { const int q = t - N3; transpose_tile(p.cv2, 64, 64, (bf16_t*)(ws + OFF_CV2T), 128, q, 0, smem); }
    }
    for (int t = HB_FIRST; t < 64; t += HB_STEP) {
        const int htid = HB_TID, which = t >> 5, kq = (t >> 2) & 7, n = (t & 3) * 32 + (htid & 31), ksp = htid >> 5;
        const float* pe = which ? p.pe_v : p.pe_k; const float* w1 = which ? p.cv1 : p.ck1;
        float a = 0.f;
#pragma unroll 8
        for (int k = kq * 256 + ksp * 32; k < kq * 256 + ksp * 32 + 32; ++k) a += pe[k] * w1[(size_t)k * 128 + n];
        float* red = (float*)smem;
        red[htid] = a;
        __syncthreads();
        if (htid < 32) {
            float s = 0.f;
#pragma unroll
            for (int j = 0; j < 8; ++j) s += red[j * 32 + htid];
            ((float*)(ws + OFF_BIAS1))[(which * 8 + kq) * 128 + n] = s;
        }
        __syncthreads();
    }
    prep_router_w(p.w_rg, p.w_re, (bf16_t*)(ws + OFF_WRT));
    for (int row = blockIdx.x * 8 + (threadIdx.x >> 6); row < T; row += gridDim.x * 8) rms_h_row(row, p.x, p.g_mix, (bf16_t*)p.out, threadIdx.x & 63);
}

__device__ __forceinline__ int tile_off(int row, int chunk) { return row * 128 + ((chunk ^ (row & 7)) << 4); }

__device__ __forceinline__ void glds16(const void* g, char* l) {
    __builtin_amdgcn_global_load_lds((const __attribute__((address_space(1))) unsigned*)g, (__attribute__((address_space(3))) unsigned*)l, 16, 0, 0);
}
__device__ __forceinline__ void gemm_kloop(f32x4 (&acc)[4][4], const bf16_t* const (&pa)[4], const bf16_t* const (&pb)[4], int ka, int kb, int nk, char* smem) {
    int tid_ = HB_TID; asm volatile("" : "+v"(tid_));
    const int tid = tid_, lane = tid & 63, wid = tid >> 6, wr = wid >> 1, wc = wid & 1, fr = lane & 15, fq = lane >> 4;
    const int offA = (wr * 64 + fr) * 128, offB = 16384 + (wc * 64 + fr) * 128, x = fr & 7;
    __syncthreads();
#pragma unroll
    for (int i = 0; i < 4; ++i) { glds16(pa[i], smem + i * 4096 + tid * 16); glds16(pb[i], smem + 16384 + i * 4096 + tid * 16); }
    asm volatile("s_waitcnt vmcnt(0)" ::: "memory");
    __syncthreads();
    for (int kt = 0; kt < nk; ++kt) {
        const int cur = kt & 1;
        if (kt + 1 < nk) {
            char* st = smem + (cur ^ 1) * 32768 + tid * 16;
#pragma unroll
            for (int i = 0; i < 4; ++i) { glds16(pa[i] + (size_t)(kt + 1) * ka, st + i * 4096); glds16(pb[i] + (size_t)(kt + 1) * kb, st + 16384 + i * 4096); }
        }
        const char* sa = smem + cur * 32768 + offA;
        const char* sb = smem + cur * 32768 + offB;
#pragma unroll
        for (int ks = 0; ks < 2; ++ks) {
            const int ch = ((ks * 4 + fq) ^ x) << 4;
            bf16x8 af[4], bfr[4];
#pragma unroll
            for (int mi = 0; mi < 4; ++mi) af[mi] = *(const bf16x8*)(sa + mi * 2048 + ch);
#pragma unroll
            for (int ni = 0; ni < 4; ++ni) bfr[ni] = *(const bf16x8*)(sb + ni * 2048 + ch);
#pragma unroll
            for (int mi = 0; mi < 4; ++mi)
#pragma unroll
                for (int ni = 0; ni < 4; ++ni) acc[mi][ni] = __builtin_amdgcn_mfma_f32_16x16x32_bf16(bfr[ni], af[mi], acc[mi][ni], 0, 0, 0);
        }
        asm volatile("s_waitcnt vmcnt(0)" ::: "memory");
        __syncthreads();
    }
}
__device__ __forceinline__ void acc_zero(f32x4 (&acc)[4][4]) {
#pragma unroll
    for (int mi = 0; mi < 4; ++mi)
#pragma unroll
        for (int ni = 0; ni < 4; ++ni) acc[mi][ni] = (f32x4){0.f, 0.f, 0.f, 0.f};
}
#define GEMM_LANE_VARS const int tid = HB_TID, lane = tid & 63, wid = tid >> 6, wr = wid >> 1, wc = wid & 1, fr = lane & 15, fq = lane >> 4, lrow = tid >> 3, lch8 = ((tid & 7) ^ ((tid >> 3) & 7)) * 8; (void)wr; (void)wc; (void)fr; (void)fq; (void)lrow; (void)lch8;
__device__ __forceinline__ uint2 pack4(f32x4 v) { uint2 o; o.x = pack_bf16(v[0], v[1]); o.y = pack_bf16(v[2], v[3]); return o; }
__device__ __forceinline__ float sigmoidf_(float a) { return __builtin_amdgcn_rcpf(1.f + __expf(-a)); }

__device__ __forceinline__ void ph_cmp1(const bf16_t* __restrict__ proj, const char* ws, float* __restrict__ part, char* smem) {
    GEMM_LANE_VARS
    for (int u = HB_FIRST; u < 64; u += HB_STEP) {
        const int kq = u & 1, which = (u >> 1) >> 4, tm = (u >> 1) & 15;
        const bf16_t* W1T = (const bf16_t*)(ws + (which ? OFF_CV1T : OFF_CK1T));
        const int col0 = which ? VC : KC;
        const bf16_t* pa[4]; const bf16_t* pb[4];
#pragma unroll
        for (int i = 0; i < 4; ++i) {
            const int m = tm * 128 + lrow + 32 * i, bg = m >> 8, c = (m & 255) > 254 ? 254 : (m & 255), b = bg >> 1, g = bg & 1;
            pa[i] = proj + (size_t)(b * S + 16 * c + 16 * kq) * PP + col0 + g * 64 + lch8;
            pb[i] = W1T + (size_t)(lrow + 32 * i) * 2048 + kq * 1024 + lch8;
        }
        f32x4 acc[4][4]; acc_zero(acc);
        gemm_kloop(acc, pa, pb, PP, 64, 16, smem);
        float* pt = part + ((size_t)(kq * 2 + which) * 2048) * 128;
#pragma unroll
        for (int mi = 0; mi < 4; ++mi)
#pragma unroll
            for (int ni = 0; ni < 4; ++ni) {
                const int m = tm * 128 + wr * 64 + mi * 16 + fr, n = wc * 64 + ni * 16 + 4 * fq;
                *(f32x4*)(pt + (size_t)m * 128 + n) = acc[mi][ni];
            }
    }
}
__device__ __forceinline__ void ph_cmp2(const char* ws_c, char* ws, const float* __restrict__ part, char* smem) {
    GEMM_LANE_VARS
    for (int u = HB_FIRST; u < 32; u += HB_STEP) {
        const int which = u >> 4, tm = u & 15;
        const bf16_t* W2T = (const bf16_t*)(ws_c + (which ? OFF_CV2T : OFF_CK2T));
        const bf16_t* hid = (const bf16_t*)(ws_c + OFF_HIDC) + (size_t)which * 2048 * 128;
        {
            const float* bias1 = (const float*)(ws_c + OFF_BIAS1) + which * 8 * 128;
            bf16_t* hw = (bf16_t*)(ws + OFF_HIDC) + (size_t)which * 2048 * 128;
            const int n4 = (tid & 31) * 4;
            float bs[4];
#pragma unroll
            for (int j = 0; j < 4; ++j) { float b_ = 0.f;
#pragma unroll
                for (int q8 = 0; q8 < 8; ++q8) b_ += bias1[q8 * 128 + n4 + j];
                bs[j] = b_; }
#pragma unroll 4
            for (int r = tid >> 5; r < 128; r += 8) {
                const size_t off = (size_t)(tm * 128 + r) * 128 + n4;
                f32x4 v = *(const f32x4*)(part + ((size_t)(0 * 2 + which) * 2048) * 128 + off);
#pragma unroll
                for (int kq = 1; kq < 2; ++kq) { const f32x4 w_ = *(const f32x4*)(part + ((size_t)(kq * 2 + which) * 2048) * 128 + off); v[0] += w_[0]; v[1] += w_[1]; v[2] += w_[2]; v[3] += w_[3]; }
#pragma unroll
                for (int j = 0; j < 4; ++j) { const float a = v[j] + bs[j]; const float t = 0.7978845608028654f * (a + 0.044715f * a * a * a); v[j] = a * __builtin_amdgcn_rcpf(1.f + __expf(-2.f * t)); }
                *(uint2*)(hw + off) = pack4(v);
            }
            asm volatile("s_waitcnt vmcnt(0)" ::: "memory");
            __syncthreads();
        }
        const bf16_t* pa[4]; const bf16_t* pb[4];
#pragma unroll
        for (int i = 0; i < 4; ++i) { pa[i] = hid + (size_t)(tm * 128 + lrow + 32 * i) * 128 + lch8; pb[i] = W2T + (size_t)(lrow + 32 * i) * 128 + lch8; }
        f32x4 acc[4][4]; acc_zero(acc);
        gemm_kloop(acc, pa, pb, 64, 64, 2, smem);
        if (wc == 0) {
            bf16_t* outp = (bf16_t*)(ws + (which ? OFF_VCB : OFF_KCB));
            bf16_t* outT = (bf16_t*)(ws + OFF_VCBT);
#pragma unroll
            for (int mi = 0; mi < 4; ++mi)
#pragma unroll
                for (int ni = 0; ni < 4; ++ni) {
                    const int m = tm * 128 + wr * 64 + mi * 16 + fr, n = ni * 16 + 4 * fq, c = m & 255, bg = m >> 8;
                    f32x4 v = acc[mi][ni];
                    if (c == 255) v = (f32x4){0.f, 0.f, 0.f, 0.f};
                    *(uint2*)(outp + (size_t)m * 64 + n) = pack4(v);
                    if (which) {
#pragma unroll
                        for (int j = 0; j < 4; ++j) outT[((size_t)bg * 64 + n + j) * 256 + c] = f2bf(v[j]);
                    }
                }
        }
    }
}


__device__ __forceinline__ void ph_moe1(const bf16_t* __restrict__ h2, const bf16_t* __restrict__ WgT, const bf16_t* __restrict__ WuT, const int* __restrict__ cnt,
                                        const int* __restrict__ ltok, const float* __restrict__ lw, const float* __restrict__ rstd, bf16_t* __restrict__ hid, char* smem) {
    GEMM_LANE_VARS
    const MoeTab mt = moe_tab(cnt);
    const int nu = moe_ntiles(mt) * 4;
    const MoeMap mm = moe_map(nu);
    for (int u = mm.lo + mm.j; u < mm.hi; u += mm.nj) {
        const int ft = u & 3;
        int e, ti, ebase, ne;
        moe_decode(mt, u >> 2, e, ti, ebase, ne);
        const bf16_t* pa[4]; const bf16_t* pb[4];
#pragma unroll
        for (int i = 0; i < 4; ++i) {
            const int rr = lrow + 32 * i, idx = ti * 128 + rr;
            const int tk = idx < ne ? ltok[e * 16384 + idx] : 0;
            pa[i] = h2 + (size_t)(tk >> 1) * 1024 + lch8;
            const int bwc = rr >> 6, bni = (rr >> 4) & 3, bj = rr & 15;
            const int f = ft * 64 + bwc * 32 + (bni >> 1) * 16 + bj;
            pb[i] = ((bni & 1) ? WuT : WgT) + ((size_t)e * 256 + f) * 1024 + lch8;
        }
        f32x4 acc[4][4]; acc_zero(acc);
        gemm_kloop(acc, pa, pb, 64, 64, 16, smem);
#pragma unroll
        for (int mi = 0; mi < 4; ++mi) {
            const int idx = ti * 128 + wr * 64 + mi * 16 + fr;
            if (idx < ne) {
                const int tk = ltok[e * 16384 + idx];
                const float w = lw[e * 16384 + idx], rsv = rstd[tk >> 1];
#pragma unroll
                for (int q = 0; q < 2; ++q) {
                    const int f = ft * 64 + wc * 32 + q * 16 + 4 * fq;
                    f32x4 v;
#pragma unroll
                    for (int j = 0; j < 4; ++j) { const float a = acc[mi][2 * q][j] * rsv, uu = acc[mi][2 * q + 1][j] * rsv; v[j] = a * sigmoidf_(a) * uu * w; }
                    *(uint2*)(hid + (size_t)(ebase + idx) * 256 + f) = pack4(v);
                }
            }
        }
    }
}


constexpr int M2_SLOT = 32768, M2_TOK = 3 * M2_SLOT;
__device__ __forceinline__ void ph_moe2w(const bf16_t* __restrict__ hid, const bf16_t* __restrict__ WdT, const int* __restrict__ cnt, const int* __restrict__ ltok,
                                         bf16_t* __restrict__ Y, char* dummy, char* smem) {
    int t_ = threadIdx.x; asm volatile("" : "+v"(t_));
    const int tid = t_, lane = tid & 63, wid = tid >> 6, fr = lane & 15, fq = lane >> 4, wm = wid >> 2, wn = wid & 3;
    const MoeTab mt = moe_tab(cnt);
    for (int v = blockIdx.x; v < 256; v += gridDim.x) {
        const int u = (v & 7) * 32 + (v >> 3);
        const int e = u >> 3, nt = u & 7;
        int ebase, ne; moe_expert(mt, e, ebase, ne);
        const int ntile = (ne + 127) >> 7, NS = 2 * ntile;
        if (NS == 0) continue;
        bf16x8 bw[2][8];
#pragma unroll
        for (int nf = 0; nf < 2; ++nf)
#pragma unroll
            for (int kf = 0; kf < 8; ++kf) bw[nf][kf] = *(const bf16x8*)(WdT + ((size_t)e * 1024 + nt * 128 + wn * 32 + nf * 16 + fr) * 256 + kf * 32 + fq * 8);
        const int lr = tid >> 4, lc8 = ((tid & 15) ^ (lr & 15)) * 8;
        const bf16_t* asrc = hid + (size_t)(ebase + lr) * 256 + lc8;
        const int* tsrc = ltok + e * 16384 + 4 * lane;
        {
            const char* pb = (const char*)(hid + (size_t)ebase * 256) + (size_t)nt * ne * 64;
            for (int off = tid * 128; off < ne * 64; off += 512 * 128) { unsigned dmy; asm volatile("global_load_dword %0, %1, off" : "=v"(dmy) : "v"(pb + off) : "memory"); }
        }
        __syncthreads();
#define M2_ISSUE(s_, slot_) do { const bf16_t* g_ = asrc + (size_t)((s_) >> 1) * 128 * 256 + ((s_) & 1) * 128; char* d_ = smem + (slot_) * M2_SLOT + tid * 16; \
            glds16(g_, d_); glds16(g_ + 32 * 256, d_ + 8192); glds16(g_ + 64 * 256, d_ + 16384); glds16(g_ + 96 * 256, d_ + 24576); \
            if (((s_) & 1) == 0) glds16(tsrc + ((s_) >> 1) * 128, smem + M2_TOK + (((s_) >> 1) & 1) * 1024 + lane * 16); } while (0)
#define M2_WAIT(n_) do { if ((n_) == 13) asm volatile("s_waitcnt vmcnt(13)" ::: "memory"); else if ((n_) == 12) asm volatile("s_waitcnt vmcnt(12)" ::: "memory"); \
            else if ((n_) == 8) asm volatile("s_waitcnt vmcnt(8)" ::: "memory"); else if ((n_) == 5) asm volatile("s_waitcnt vmcnt(5)" ::: "memory"); \
            else if ((n_) == 4) asm volatile("s_waitcnt vmcnt(4)" ::: "memory"); else asm volatile("s_waitcnt vmcnt(0)" ::: "memory"); \
            asm volatile("s_waitcnt lgkmcnt(0)" ::: "memory"); __builtin_amdgcn_s_barrier(); asm volatile("" ::: "memory"); } while (0)
#define M2_COMPUTE(kh_, slot_) do { const char* st_ = smem + (slot_) * M2_SLOT; \
            _Pragma("unroll") for (int kf = 0; kf < 4; ++kf) { bf16x8 a_[4]; \
                _Pragma("unroll") for (int mf = 0; mf < 4; ++mf) a_[mf] = *(const bf16x8*)(st_ + (64 * wm + 16 * mf + fr) * 256 + (((kf * 4 + fq) ^ fr) << 4)); \
                _Pragma("unroll") for (int mf = 0; mf < 4; ++mf) { \
                    acc[mf][0] = __builtin_amdgcn_mfma_f32_16x16x32_bf16(bw[0][(kh_) * 4 + kf], a_[mf], acc[mf][0], 0, 0, 0); \
                    acc[mf][1] = __builtin_amdgcn_mfma_f32_16x16x32_bf16(bw[1][(kh_) * 4 + kf], a_[mf], acc[mf][1], 0, 0, 0); } } } while (0)
        M2_ISSUE(0, 0); M2_ISSUE(1, 1);
        f32x4 acc[4][2];
#pragma unroll
        for (int mf = 0; mf < 4; ++mf) { acc[mf][0] = (f32x4){0.f, 0.f, 0.f, 0.f}; acc[mf][1] = (f32x4){0.f, 0.f, 0.f, 0.f}; }
        int s0 = 0;
        for (int rt = 0; rt < ntile; ++rt) {
            const int s1 = (s0 == 2) ? 0 : s0 + 1, s2 = (s1 == 2) ? 0 : s1 + 1;
            { const int n = (rt == 0) ? 4 : 12; M2_WAIT(n); }
            if (rt + 1 < ntile) M2_ISSUE(2 * rt + 2, s2);
            M2_COMPUTE(0, s0);
            { const int n = (rt == 0) ? ((ntile > 1) ? 5 : 0) : ((rt + 1 < ntile) ? 13 : 8); M2_WAIT(n); }
            if (rt + 1 < ntile) M2_ISSUE(2 * rt + 3, s0);
            M2_COMPUTE(1, s1);
            const int* tl = (const int*)(smem + M2_TOK + (rt & 1) * 1024);
#pragma unroll
            for (int mf = 0; mf < 4; ++mf) {
                const int rl = 64 * wm + 16 * mf + fr, idx = rt * 128 + rl;
                const int tk = tl[rl];
                if (idx < ne) {
                    bf16_t* yr = Y + ((size_t)(tk & 1) * T + (size_t)(tk >> 1)) * 1024 + nt * 128 + wn * 32 + 4 * fq;
#pragma unroll
                    for (int nf = 0; nf < 2; ++nf) *(uint2*)(yr + nf * 16) = pack4(acc[mf][nf]);
                }
                acc[mf][0] = (f32x4){0.f, 0.f, 0.f, 0.f}; acc[mf][1] = (f32x4){0.f, 0.f, 0.f, 0.f};
            }
            s0 = s2;
        }
#undef M2_ISSUE
#undef M2_WAIT
#undef M2_COMPUTE
        asm volatile("s_waitcnt vmcnt(0)" ::: "memory");
    }
}

__device__ __forceinline__ void ph_moe2(const bf16_t* __restrict__ hid, const bf16_t* __restrict__ WdT, const int* __restrict__ cnt, const int* __restrict__ ltok,
                                        bf16_t* __restrict__ Y, char* smem) {
    GEMM_LANE_VARS
    const MoeTab mt = moe_tab(cnt);
    const int nu = moe_ntiles(mt) * 8;
    for (int u = HB_FIRST; u < nu; u += HB_STEP) {
        const int tn = u & 7;
        int e, ti, ebase, ne; moe_decode(mt, u >> 3, e, ti, ebase, ne); (void)ebase;
        const bf16_t* pa[4]; const bf16_t* pb[4];
#pragma unroll
        for (int i = 0; i < 4; ++i) {
            const int idx = ti * 128 + lrow + 32 * i;
            const int tk = idx < ne ? ltok[e * 16384 + idx] : 0;
            pa[i] = hid + (size_t)tk * 256 + lch8;
            pb[i] = WdT + ((size_t)e * 1024 + tn * 128 + lrow + 32 * i) * 256 + lch8;
        }
        f32x4 acc[4][4]; acc_zero(acc);
        gemm_kloop(acc, pa, pb, 64, 64, 4, smem);
#pragma unroll
        for (int mi = 0; mi < 4; ++mi) {
            const int idx = ti * 128 + wr * 64 + mi * 16 + fr;
            if (idx < ne) {
                const int tk = ltok[e * 16384 + idx];
                bf16_t* yr = Y + ((size_t)(tk & 1) * T + (size_t)(tk >> 1)) * 1024 + tn * 128 + wc * 64 + 4 * fq;
#pragma unroll
                for (int ni = 0; ni < 4; ++ni) *(uint2*)(yr + ni * 16) = pack4(acc[mi][ni]);
            }
        }
    }
}

namespace g8 {
constexpr int HTB = 128 * 64 * 2;
__device__ __forceinline__ int lds_byte(int r, int c) { const int st = (r >> 4) * 2 + (c >> 5), rr = r & 15, cc = c & 31, ob = rr * 64 + cc * 2; return st * 1024 + (ob ^ (((ob >> 9) & 1) << 5)); }
__device__ __forceinline__ void stage_rc(int b, int& R, int& C) { const int st = b / 1024, sb = b % 1024, swz = sb ^ (((sb >> 9) & 1) << 5); R = (st >> 1) * 16 + swz / 64; C = (st & 1) * 32 + (swz % 64) / 2; }
__device__ __forceinline__ int perm32(int rho) { const int n = rho >> 4, i = rho & 15; return 8 * (i >> 2) + 4 * n + (i & 3); }
struct Unit { int pm, pn, e; };
struct StaticOrder {
    int nM, nN, nwg, G, c;
    __device__ __forceinline__ void init(int M, int N, int G_, int c_) { nM = M / 256; nN = N / 256; nwg = nM * nN; G = G_; c = c_; }
    __device__ __forceinline__ bool next(int i, Unit& u) const {
        const long L = (long)i * G + c; if (L >= nwg) return false;
        int wgid = (int)L; { const int q = nwg / 8, r = nwg % 8, xcd = wgid % 8, off = wgid / 8; wgid = (xcd < r ? xcd * (q + 1) : r * (q + 1) + (xcd - r) * q) + off; }
        const int nig = 8 * nN, gid = wgid / nig, fm = gid * 8, gsz = (nM - fm) < 8 ? (nM - fm) : 8;
        u.pm = fm + ((wgid % nig) % gsz); u.pn = (wgid % nig) / gsz; u.e = 0; return true;
    }
    __device__ __forceinline__ void a_ready(const Unit&, int) const {}
};
struct AddrPlain {
    const char* A; const char* Bt; unsigned lda2, ldb2; int ntiles;
    __device__ __forceinline__ const char* a_base(const Unit&) const { return A; }
    __device__ __forceinline__ const char* b_base(const Unit&) const { return Bt; }
    __device__ __forceinline__ int nt(const Unit&) const { return ntiles; }
    __device__ __forceinline__ int a_row0(const Unit& u) const { return u.pm * 256; }
    __device__ __forceinline__ int b_row0(const Unit& u) const { return u.pn * 256; }
    __device__ __forceinline__ unsigned a_ld(const Unit&) const { return lda2; }
    __device__ __forceinline__ unsigned b_ld(const Unit&) const { return ldb2; }
};

template <class Epi, class Sched, class Addr>
__device__ __forceinline__ void gemm_phase(char* ldsc, const Sched& S, const Addr& AD, const Epi& E) {
    __attribute__((address_space(3))) unsigned char* lds = (__attribute__((address_space(3))) unsigned char*)ldsc;
    int tid_ = threadIdx.x; asm volatile("" : "+v"(tid_));
    const int tid = tid_, wid = __builtin_amdgcn_readfirstlane(tid >> 6), lane = tid & 63, wr = wid >> 2, wc = wid & 3, fr = lane & 15, fq = lane >> 4;
    int R[2], C2[2], Rb[2];
#pragma unroll
    for (int i = 0; i < 2; ++i) { int r_, c_; stage_rc(tid * 16 + i * 8192, r_, c_); R[i] = r_; C2[i] = c_ * 2; Rb[i] = Epi::PERM ? ((r_ & ~31) + perm32(r_ & 31)) : r_; }
    const unsigned ldsw = (unsigned)wid * 1024u;
    const int aoff = lds_byte(wr * 64 + fr, fq * 8), boff = lds_byte(wc * 32 + fr, fq * 8);
#define G8_SA(b, h) (((b) * 2 + (h)) * HTB)
#define G8_SB(b, h) ((4 + (b) * 2 + (h)) * HTB)
#define G8_STAGE(bufoff, base, rowv, row0, ld, h, kb) do { _Pragma("unroll") for (int _i = 0; _i < 2; ++_i) \
        __builtin_amdgcn_global_load_lds((const __attribute__((address_space(1))) unsigned*)((base) + (size_t)((unsigned)((row0) + (h) * 128 + (rowv)[_i]) * (ld) + (unsigned)C2[_i] + (unsigned)(kb))), \
                                         (__attribute__((address_space(3))) unsigned*)(lds + (bufoff) + ldsw + _i * 8192), 16, 0, 0); } while (0)
#define G8_LDA(dst, b, h) do { _Pragma("unroll") for (int m = 0; m < 4; ++m) _Pragma("unroll") for (int k = 0; k < 2; ++k) dst[m][k] = *(const __attribute__((address_space(3))) bf16x8*)(lds + G8_SA(b, h) + aoff + m * 2048 + k * 1024); } while (0)
#define G8_LDB(dst, b, h) do { _Pragma("unroll") for (int n = 0; n < 2; ++n) _Pragma("unroll") for (int k = 0; k < 2; ++k) dst[n][k] = *(const __attribute__((address_space(3))) bf16x8*)(lds + G8_SB(b, h) + boff + n * 2048 + k * 1024); } while (0)
#define G8_MMA(ai, bj, At, Bt) do { __builtin_amdgcn_s_setprio(1); _Pragma("unroll") for (int m = 0; m < 4; ++m) _Pragma("unroll") for (int n = 0; n < 2; ++n) _Pragma("unroll") for (int k = 0; k < 2; ++k) \
        acc[ai][bj][m][n] = __builtin_amdgcn_mfma_f32_16x16x32_bf16(Bt[n][k], At[m][k], acc[ai][bj][m][n], 0, 0, 0); __builtin_amdgcn_s_setprio(0); } while (0)
#define G8_WAIT_V(n) asm volatile("s_waitcnt vmcnt(" #n ")" ::: "memory")
#define G8_WAIT_L(n) asm volatile("s_waitcnt lgkmcnt(" #n ")" ::: "memory")
#define G8_BAR __builtin_amdgcn_s_barrier()
#define G8_SCHED __builtin_amdgcn_sched_barrier(0)
    Unit cur, nxt; int ui = 0;
    if (!S.next(0, cur)) return;
    f32x4 acc[2][2][4][2];
#pragma unroll
    for (int a = 0; a < 2; ++a)
#pragma unroll
        for (int b = 0; b < 2; ++b)
#pragma unroll
            for (int m = 0; m < 4; ++m)
#pragma unroll
                for (int n = 0; n < 2; ++n) acc[a][b][m][n] = (f32x4){0.f, 0.f, 0.f, 0.f};
    bf16x8 At[4][2], B0[2][2], B1[2][2];
    const char* Ab = AD.a_base(cur); const char* Bb = AD.b_base(cur);
    int ar0 = AD.a_row0(cur), br0 = AD.b_row0(cur); unsigned ald = AD.a_ld(cur), bld = AD.b_ld(cur);
    __syncthreads();
    G8_STAGE(G8_SB(0, 0), Bb, Rb, br0, bld, 0, 0); G8_STAGE(G8_SA(0, 0), Ab, R, ar0, ald, 0, 0); G8_STAGE(G8_SB(0, 1), Bb, Rb, br0, bld, 1, 0); G8_STAGE(G8_SA(0, 1), Ab, R, ar0, ald, 1, 0);
    if (wr == 1) G8_BAR;
    G8_WAIT_V(4); G8_BAR;
    G8_STAGE(G8_SB(1, 0), Bb, Rb, br0, bld, 0, 128); G8_STAGE(G8_SA(1, 0), Ab, R, ar0, ald, 0, 128); G8_STAGE(G8_SB(1, 1), Bb, Rb, br0, bld, 1, 128);
    G8_WAIT_V(6); G8_BAR;
    for (;;) {
        const bool has_next = S.next(ui + 1, nxt);
        const int nt = AD.nt(cur);
        const char* nAb = has_next ? AD.a_base(nxt) : Ab; const char* nBb = has_next ? AD.b_base(nxt) : Bb;
        const int nar0 = has_next ? AD.a_row0(nxt) : ar0, nbr0 = has_next ? AD.b_row0(nxt) : br0;
        const unsigned nald = has_next ? AD.a_ld(nxt) : ald, nbld = has_next ? AD.b_ld(nxt) : bld;
        for (int t = 0; t < nt; t += 2) {
            const bool last = (t == nt - 2);
            if (last && has_next) S.a_ready(nxt, wid);
            const int kb1 = (t + 1) * 128, kb2 = last ? 0 : (t + 2) * 128, kb3 = kb2 + 128;
            const char* sAb = last ? nAb : Ab; const char* sBb = last ? nBb : Bb;
            const int sar0 = last ? nar0 : ar0, sbr0 = last ? nbr0 : br0; const unsigned sald = last ? nald : ald, sbld = last ? nbld : bld;
            G8_LDB(B0, 0, 0); G8_SCHED; G8_LDA(At, 0, 0); G8_STAGE(G8_SA(1, 1), Ab, R, ar0, ald, 1, kb1);
            G8_WAIT_L(8); G8_BAR; G8_WAIT_L(0); G8_MMA(0, 0, At, B0); G8_BAR; G8_SCHED;
            G8_LDB(B1, 0, 1); G8_STAGE(G8_SB(0, 0), sBb, Rb, sbr0, sbld, 0, kb2);
            G8_BAR; G8_WAIT_L(0); G8_MMA(0, 1, At, B1); G8_BAR;
            G8_LDA(At, 0, 1); G8_STAGE(G8_SA(0, 0), sAb, R, sar0, sald, 0, kb2);
            G8_BAR; G8_WAIT_L(0); G8_MMA(1, 0, At, B0); G8_BAR; G8_SCHED;
            G8_STAGE(G8_SB(0, 1), sBb, Rb, sbr0, sbld, 1, kb2);
            G8_WAIT_V(6); G8_BAR; G8_MMA(1, 1, At, B1); G8_BAR;
            G8_LDB(B0, 1, 0); G8_SCHED; G8_LDA(At, 1, 0); G8_STAGE(G8_SA(0, 1), sAb, R, sar0, sald, 1, kb2);
            G8_WAIT_L(8); G8_BAR; G8_WAIT_L(0); G8_MMA(0, 0, At, B0); G8_BAR; G8_SCHED;
            G8_LDB(B1, 1, 1); G8_STAGE(G8_SB(1, 0), sBb, Rb, sbr0, sbld, 0, kb3);
            G8_BAR; G8_WAIT_L(0); G8_MMA(0, 1, At, B1); G8_BAR;
            G8_LDA(At, 1, 1); G8_STAGE(G8_SA(1, 0), sAb, R, sar0, sald, 0, kb3);
            G8_BAR; G8_WAIT_L(0); G8_MMA(1, 0, At, B0); G8_BAR; G8_SCHED;
            G8_STAGE(G8_SB(1, 1), sBb, Rb, sbr0, sbld, 1, kb3);
            G8_WAIT_V(6); G8_BAR; G8_MMA(1, 1, At, B1); G8_BAR;
        }
        E(acc, cur, wr, wc, fr, fq);
        if (!has_next) break;
#pragma unroll
        for (int a = 0; a < 2; ++a)
#pragma unroll
            for (int b = 0; b < 2; ++b)
#pragma unroll
                for (int m = 0; m < 4; ++m)
#pragma unroll
                    for (int n = 0; n < 2; ++n) acc[a][b][m][n] = (f32x4){0.f, 0.f, 0.f, 0.f};
        cur = nxt; Ab = nAb; Bb = nBb; ar0 = nar0; br0 = nbr0; ald = nald; bld = nbld; ++ui;
    }
    G8_WAIT_V(0);
    if (wr == 0) G8_BAR;
    G8_BAR;
#undef G8_SA
#undef G8_SB
#undef G8_STAGE
#undef G8_LDA
#undef G8_LDB
#undef G8_MMA
#undef G8_WAIT_V
#undef G8_WAIT_L
#undef G8_BAR
#undef G8_SCHED
}

struct EpiProj {
    static constexpr bool PERM = true;
    bf16_t* proj;
    __device__ __forceinline__ void operator()(const f32x4 (&acc)[2][2][4][2], const Unit& u, int wr, int wc, int fr, int fq) const {
#pragma unroll
        for (int ai = 0; ai < 2; ++ai)
#pragma unroll
            for (int m = 0; m < 4; ++m) {
                const int r = u.pm * 256 + ai * 128 + wr * 64 + m * 16 + fr;
#pragma unroll
                for (int bj = 0; bj < 2; ++bj) {
                    const int c = u.pn * 256 + bj * 128 + wc * 32 + 8 * fq;
                    if (c < NPROJ) {
                        u32x4 w; w[0] = pack_bf16(acc[ai][bj][m][0][0], acc[ai][bj][m][0][1]); w[1] = pack_bf16(acc[ai][bj][m][0][2], acc[ai][bj][m][0][3]);
                        w[2] = pack_bf16(acc[ai][bj][m][1][0], acc[ai][bj][m][1][1]); w[3] = pack_bf16(acc[ai][bj][m][1][2], acc[ai][bj][m][1][3]);
                        *(u32x4*)(proj + (size_t)r * PP + c) = w;
                    }
                }
            }
    }
};
struct EpiDelta {
    static constexpr bool PERM = true;
    bf16_t* dl;
    __device__ __forceinline__ void operator()(const f32x4 (&acc)[2][2][4][2], const Unit& u, int wr, int wc, int fr, int fq) const {
#pragma unroll
        for (int ai = 0; ai < 2; ++ai)
#pragma unroll
            for (int m = 0; m < 4; ++m) {
                const int r = u.pm * 256 + ai * 128 + wr * 64 + m * 16 + fr;
#pragma unroll
                for (int bj = 0; bj < 2; ++bj) {
                    const int c = u.pn * 256 + bj * 128 + wc * 32 + 8 * fq;
                    u32x4 w; w[0] = pack_bf16(acc[ai][bj][m][0][0], acc[ai][bj][m][0][1]); w[1] = pack_bf16(acc[ai][bj][m][0][2], acc[ai][bj][m][0][3]);
                    w[2] = pack_bf16(acc[ai][bj][m][1][0], acc[ai][bj][m][1][1]); w[3] = pack_bf16(acc[ai][bj][m][1][2], acc[ai][bj][m][1][3]);
                    *(u32x4*)(dl + (size_t)r * 1024 + c) = w;
                }
            }
    }
};
struct OneUnit { Unit u; __device__ __forceinline__ bool next(int i, Unit& o) const { if (i) return false; o = u; return true; }
    __device__ __forceinline__ void a_ready(const Unit&, int) const {} };
template <int OP>
struct EpiMerge {
    static constexpr bool PERM = true;
    bf16_t* dst; const bf16_t* src2;
    __device__ __forceinline__ void operator()(const f32x4 (&acc)[2][2][4][2], const Unit& u, int wr, int wc, int fr, int fq) const {
#pragma unroll
        for (int ai = 0; ai < 2; ++ai)
#pragma unroll
            for (int m = 0; m < 4; ++m) {
                const int r = u.pm * 256 + ai * 128 + wr * 64 + m * 16 + fr;
#pragma unroll
                for (int bj = 0; bj < 2; ++bj) {
                    const size_t o = (size_t)r * 1024 + u.pn * 256 + bj * 128 + wc * 32 + 8 * fq;
                    float v[8];
#pragma unroll
                    for (int j = 0; j < 4; ++j) { v[j] = acc[ai][bj][m][0][j]; v[4 + j] = acc[ai][bj][m][1][j]; }
                    if (OP == 0) {
#pragma unroll
                        for (int j = 0; j < 8; ++j) v[j] = sigmoidf_(v[j]);
                    } else {
                        const u32x4 d = *(const u32x4*)(dst + o);
                        float dv[8];
#pragma unroll
                        for (int j = 0; j < 4; ++j) { dv[2 * j] = __uint_as_float(d[j] << 16); dv[2 * j + 1] = __uint_as_float(d[j] & 0xFFFF0000u); }
                        if (OP == 1) {
#pragma unroll
                            for (int j = 0; j < 8; ++j) v[j] = dv[j] * v[j];
                        } else {
                            const u32x4 s = *(const u32x4*)(src2 + o);
#pragma unroll
                            for (int j = 0; j < 4; ++j) { v[2 * j] = dv[2 * j] + __uint_as_float(s[j] << 16) * v[2 * j]; v[2 * j + 1] = dv[2 * j + 1] + __uint_as_float(s[j] & 0xFFFF0000u) * v[2 * j + 1]; }
                        }
                    }
                    u32x4 w; w[0] = pack_bf16(v[0], v[1]); w[1] = pack_bf16(v[2], v[3]); w[2] = pack_bf16(v[4], v[5]); w[3] = pack_bf16(v[6], v[7]);
                    *(u32x4*)(dst + o) = w;
                }
            }
    }
};
struct MergeOrder {
    StaticOrder so; unsigned* bar; volatile __attribute__((address_space(3))) unsigned* st;
    __device__ __forceinline__ bool next(int i, Unit& u) const { if (!so.next(i >> 2, u)) return false; u.e = i & 3; return true; }
    __device__ __forceinline__ void a_ready(const Unit& u, int wid) const {
        if (u.e != 1) return;
        if (wid == 0) {
            const unsigned gen = st[2];
            XB_SPIN(xb_ld(&bar[XB2_TOPGEN]) <= gen, bar);
            __builtin_amdgcn_fence(__ATOMIC_ACQUIRE, "agent");
            asm volatile("s_waitcnt vmcnt(0)" ::: "memory");
        }
        __builtin_amdgcn_s_barrier();
    }
};
struct AddrMerge {
    const char* h; const char* WinT; const char* ya; const char* yb; const char* WaT; const char* WbT;
    __device__ __forceinline__ const char* a_base(const Unit& u) const {
        const unsigned long long ph = (unsigned long long)h, pa = (unsigned long long)ya, pb = (unsigned long long)yb, o = (unsigned long long)(u.e & 1), t = (unsigned long long)((u.e >> 1) & 1);
        return (const char*)(ph + o * ((pa - ph) + t * (pb - pa))); }
    __device__ __forceinline__ const char* b_base(const Unit& u) const {
        const unsigned long long pg = (unsigned long long)(WinT + (size_t)MGA * 2048), pa = (unsigned long long)WaT, pb = (unsigned long long)WbT, o = (unsigned long long)(u.e & 1), t = (unsigned long long)((u.e >> 1) & 1);
        const unsigned long long g = pg + t * (unsigned long long)((size_t)(MGB - MGA) * 2048), y = pa + t * (pb - pa);
        return (const char*)(g + o * (y - g)); }
    __device__ __forceinline__ int nt(const Unit& u) const { return (u.e & 1) ? 8 : 16; }
    __device__ __forceinline__ int a_row0(const Unit& u) const { return u.pm * 256; }
    __device__ __forceinline__ int b_row0(const Unit& u) const { return u.pn * 256; }
    __device__ __forceinline__ unsigned a_ld(const Unit& u) const { return (u.e & 1) ? 1024u : 2048u; }
    __device__ __forceinline__ unsigned b_ld(const Unit& u) const { return (u.e & 1) ? 1024u : 2048u; }
};
struct EpiMergeAll {
    static constexpr bool PERM = true;
    bf16_t* mrg; bf16_t* sg2;
    __device__ __forceinline__ void operator()(const f32x4 (&acc)[2][2][4][2], const Unit& u, int wr, int wc, int fr, int fq) const {
        if (u.e == 0) EpiMerge<0>{mrg, nullptr}(acc, u, wr, wc, fr, fq);
        else if (u.e == 1) EpiMerge<1>{mrg, nullptr}(acc, u, wr, wc, fr, fq);
        else if (u.e == 2) EpiMerge<0>{sg2, nullptr}(acc, u, wr, wc, fr, fq);
        else EpiMerge<2>{mrg, sg2}(acc, u, wr, wc, fr, fq);
    }
};
}

constexpr float LOG2E = 1.4426950408889634f;
constexpr float NEGV = -3.0e38f;
constexpr int NSA_TB = 49152;
constexpr int NSA_TBW = 224;
constexpr int NSA_IMPA = NSA_TB + 4 * NSA_TBW * 4;
constexpr int NSA_IMPB = NSA_IMPA + 16640;
constexpr int NSA_SELM = NSA_IMPB + 16640;
constexpr int NSA_OSUM = NSA_SELM + 512;

__device__ __forceinline__ int t5_bucket2(int n) {
    if (n < 16) return n;
    const int l = 16 + (int)(logf((float)n / 16.0f) / logf(8.0f) * 16.0f);
    return l < 31 ? l : 31;
}


typedef float f32x2 __attribute__((ext_vector_type(2)));
template <int STR>
__device__ __forceinline__ void tb_read16(unsigned a0, unsigned a1, unsigned a2, unsigned a3, f32x2 (&t)[8]) {
    asm volatile(
        "ds_read2_b32 %0, %8 offset0:%12 offset1:%13\n\t"
        "ds_read2_b32 %1, %8 offset0:%14\n\t"
        "ds_read2_b32 %2, %9 offset0:%12 offset1:%13\n\t"
        "ds_read2_b32 %3, %9 offset0:%14\n\t"
        "ds_read2_b32 %4, %10 offset0:%12 offset1:%13\n\t"
        "ds_read2_b32 %5, %10 offset0:%14\n\t"
        "ds_read2_b32 %6, %11 offset0:%12 offset1:%13\n\t"
        "ds_read2_b32 %7, %11 offset0:%14\n\t"
        "s_waitcnt lgkmcnt(0)"
        : "=&v"(t[0]), "=&v"(t[1]), "=&v"(t[2]), "=&v"(t[3]), "=&v"(t[4]), "=&v"(t[5]), "=&v"(t[6]), "=&v"(t[7])
        : "v"(a0), "v"(a1), "v"(a2), "v"(a3), "n"(3 * STR), "n"(2 * STR), "n"(STR));
}

template <int MODE, bool A0, bool A1>
__device__ __forceinline__ void nsa_tile(const char* Kst, const char* Vst, int j, bool fast, const float* tbias, const bf16x8 (&qf)[2][2], const int (&qidx)[2],
                                         const unsigned long long (&selq)[2], f32x4 (&O)[4][2], float (&m)[2], float (&l)[2], const float (&invl)[2],
                                         char* smem, int fr, int fq, int hp, int wid) {
    const float b127 = tbias[127];
    bf16x8 pf[2][2];
    bool started = true;
    if (MODE != 3) started = __builtin_amdgcn_ballot_w64((A0 && m[0] < -1e29f) || (A1 && m[1] < -1e29f)) == 0ull;
    const bool quick = fast;
    constexpr int STR = (MODE == 0 || MODE == 3) ? 16 : 1;
    const unsigned tboff = (unsigned)(size_t)(const __attribute__((address_space(3))) float*)tbias;
    f32x4 sall[2][2][2];
#pragma unroll
    for (int p = 0; p < 2; ++p)
#pragma unroll
        for (int s = 0; s < 2; ++s) {
            const int row = 32 * p + 16 * s + fr;
            const bf16x8 k0 = *(const bf16x8*)(Kst + tile_off(row, fq)), k1 = *(const bf16x8*)(Kst + tile_off(row, 4 + fq));
#pragma unroll
            for (int ct = 0; ct < 2; ++ct) {
                if ((ct == 0 && !A0) || (ct == 1 && !A1)) continue;
                float i0 = 0.f;
                if (quick) { const bool sel = (MODE == 1) ? (((selq[ct] >> j) & 1ull) != 0ull) : true; i0 = (MODE == 3) ? b127 : (sel ? b127 : NEGV) - (started ? m[ct] : 0.f); }
                f32x4 a = (f32x4){i0, i0, i0, i0};
                a = __builtin_amdgcn_mfma_f32_16x16x32_bf16(k0, qf[ct][0], a, 0, 0, 0);
                a = __builtin_amdgcn_mfma_f32_16x16x32_bf16(k1, qf[ct][1], a, 0, 0, 0);
                sall[ct][p][s] = a;
            }
        }
#pragma unroll
    for (int ct = 0; ct < 2; ++ct) {
        if ((ct == 0 && !A0) || (ct == 1 && !A1)) continue;
        f32x4 (&sacc)[2][2] = sall[ct];
        const int q = qidx[ct];
        const bool sel = (MODE == 1) ? (((selq[ct] >> j) & 1ull) != 0ull) : true;
        if (MODE != 3) {
            const float mct = m[ct];
            if (!quick) {
                const float ref = started ? mct : 0.f;
                int base[4]; unsigned ad[4];
#pragma unroll
                for (int gi = 0; gi < 4; ++gi) {
                    const int k0 = 64 * j + 32 * (gi >> 1) + 8 * fq + 4 * (gi & 1);
                    base[gi] = (MODE == 0) ? q - (16 * k0 + 31) : q - k0;
                    const int bc = base[gi] < 0 ? 0 : (base[gi] > 127 + 3 * STR ? 127 + 3 * STR : base[gi]);
                    ad[gi] = tboff + (unsigned)(bc - 3 * STR) * 4u;
                }
                f32x2 tv[8];
                tb_read16<STR>(ad[0], ad[1], ad[2], ad[3], tv);
#pragma unroll
                for (int p = 0; p < 2; ++p)
#pragma unroll
                    for (int s = 0; s < 2; ++s)
#pragma unroll
                        for (int i = 0; i < 4; ++i) {
                            const int rel = base[2 * p + s] - i * STR;
                            bool valid;
                            if (MODE == 0) valid = rel >= 0;
                            else if (MODE == 1) valid = (rel >= 0) && sel;
                            else valid = (rel >= 0) && (rel < 512);
                            const float tb = tv[(2 * p + s) * 2 + (i >> 1)][i & 1];
                            sacc[p][s][i] = valid ? sacc[p][s][i] + (tb - ref) : NEGV;
                        }
            }
            float pv[2][8]; float psum = 0.f;
            bool redo = !started;
            if (started) {
#pragma unroll
                for (int p = 0; p < 2; ++p)
#pragma unroll
                    for (int s = 0; s < 2; ++s)
#pragma unroll
                        for (int i = 0; i < 4; ++i) { pv[p][s * 4 + i] = __builtin_amdgcn_exp2f(sacc[p][s][i]); psum += pv[p][s * 4 + i]; }
                if (__builtin_amdgcn_ballot_w64(!(psum <= 256.0f)) != 0ull) {
                    redo = true;
#pragma unroll
                    for (int p = 0; p < 2; ++p)
#pragma unroll
                        for (int s = 0; s < 2; ++s)
#pragma unroll
                            for (int i = 0; i < 4; ++i) sacc[p][s][i] += mct;
                }
            }
            if (redo) {
                float mloc = NEGV;
#pragma unroll
                for (int p = 0; p < 2; ++p)
#pragma unroll
                    for (int s = 0; s < 2; ++s)
#pragma unroll
                        for (int i = 0; i < 4; ++i) mloc = fmaxf(mloc, sacc[p][s][i]);
                mloc = fmaxf(mloc, __shfl_xor(mloc, 16)); mloc = fmaxf(mloc, __shfl_xor(mloc, 32));
                const float mnew = fmaxf(mct, mloc);
                const float alpha = __builtin_amdgcn_exp2f(mct - mnew);
                m[ct] = mnew; l[ct] *= alpha;
#pragma unroll
                for (int dt = 0; dt < 4; ++dt) O[dt][ct] = O[dt][ct] * alpha;
                psum = 0.f;
#pragma unroll
                for (int p = 0; p < 2; ++p)
#pragma unroll
                    for (int s = 0; s < 2; ++s)
#pragma unroll
                        for (int i = 0; i < 4; ++i) { pv[p][s * 4 + i] = __builtin_amdgcn_exp2f(sacc[p][s][i] - mnew); psum += pv[p][s * 4 + i]; }
            }
#pragma unroll
            for (int p = 0; p < 2; ++p) {
                u32x4 w; w[0] = pack_bf16(pv[p][0], pv[p][1]); w[1] = pack_bf16(pv[p][2], pv[p][3]); w[2] = pack_bf16(pv[p][4], pv[p][5]); w[3] = pack_bf16(pv[p][6], pv[p][7]);
                pf[ct][p] = __builtin_bit_cast(bf16x8, w);
            }
            l[ct] += psum;
        } else {
            if (!quick) {
                int base[4]; unsigned ad[4];
#pragma unroll
                for (int gi = 0; gi < 4; ++gi) {
                    const int k0 = 64 * j + 32 * (gi >> 1) + 8 * fq + 4 * (gi & 1);
                    base[gi] = q - (16 * k0 + 31);
                    const int bc = base[gi] < 0 ? 0 : (base[gi] > 127 + 3 * STR ? 127 + 3 * STR : base[gi]);
                    ad[gi] = tboff + (unsigned)(bc - 3 * STR) * 4u;
                }
                f32x2 tv[8];
                tb_read16<STR>(ad[0], ad[1], ad[2], ad[3], tv);
#pragma unroll
                for (int p = 0; p < 2; ++p)
#pragma unroll
                    for (int s = 0; s < 2; ++s)
#pragma unroll
                        for (int i = 0; i < 4; ++i) {
                            const int rel = base[2 * p + s] - i * STR;
                            const float tb = tv[(2 * p + s) * 2 + (i >> 1)][i & 1];
                            sacc[p][s][i] = (rel >= 0) ? sacc[p][s][i] + tb : NEGV;
                        }
            }
            float* impA = (float*)(smem + NSA_IMPA); float* impB = (float*)(smem + NSA_IMPB);
            const int ql = wid * 8 + ct * 4 + (fr >> 2);
#pragma unroll
            for (int p = 0; p < 2; ++p)
#pragma unroll
                for (int s = 0; s < 2; ++s) {
                    float p3 = __builtin_amdgcn_exp2f(sacc[p][s][3] - m[ct]) * invl[ct];
                    float pa = __builtin_amdgcn_exp2f(sacc[p][s][0] - m[ct]) * invl[ct] + __builtin_amdgcn_exp2f(sacc[p][s][1] - m[ct]) * invl[ct]
                             + __builtin_amdgcn_exp2f(sacc[p][s][2] - m[ct]) * invl[ct] + p3;
                    pa += __shfl_xor(pa, 1); pa += __shfl_xor(pa, 2);
                    p3 += __shfl_xor(p3, 1); p3 += __shfl_xor(p3, 2);
                    const int jj = 16 * j + 8 * p + 2 * fq + s;
                    if (hp == 0) { impA[ql * 65 + jj] = pa; impB[ql * 65 + jj + 1] = p3; }
                }
        }
    }
    if (MODE != 3) {
#pragma unroll
        for (int dt = 0; dt < 4; ++dt)
#pragma unroll
            for (int p = 0; p < 2; ++p) {
                const bf16x8 vf = *(const bf16x8*)(Vst + tile_off(dt * 16 + fr, p * 4 + fq));
                if (A0) O[dt][0] = __builtin_amdgcn_mfma_f32_16x16x32_bf16(vf, pf[0][p], O[dt][0], 0, 0, 0);
                if (A1) O[dt][1] = __builtin_amdgcn_mfma_f32_16x16x32_bf16(vf, pf[1][p], O[dt][1], 0, 0, 0);
            }
    }
}

template <int MODE>
__device__ __forceinline__ void nsa_branch(const bf16_t* __restrict__ Kb, size_t kstride, const bf16_t* __restrict__ Vb, size_t vstride, int j0, int ntiles, int t0,
                                           const bf16x8 (&qf)[2][2], const int (&qidx)[2], const unsigned long long (&selq)[2], unsigned long long selor0, unsigned long long selor1,
                                           f32x4 (&O)[4][2], float (&m)[2], float (&l)[2], const float (&invl)[2], char* smem) {
    int tid_ = threadIdx.x; asm volatile("" : "+v"(tid_));
    const int tid = tid_, lane = tid & 63, wid = tid >> 6, fr = lane & 15, fq = lane >> 4, hp = fr & 3;
    const int lrow = tid >> 3;
    const float* tbias = (const float*)(smem + NSA_TB) + hp * NSA_TBW + 48;
    const int sch8 = ((tid & 7) ^ (lrow & 7)) * 8;
    const int krow = 32 * (lrow >> 5) + 8 * ((lrow & 15) >> 2) + 4 * ((lrow >> 4) & 1) + (lrow & 3);
    const bf16_t* kp = Kb + (size_t)krow * kstride + sch8;
    const bf16_t* vp = Vb + (size_t)lrow * vstride + sch8;
    __syncthreads();
    glds16(kp, smem + tid * 16); if (MODE != 3) glds16(vp, smem + 8192 + tid * 16);
    asm volatile("s_waitcnt vmcnt(0)" ::: "memory");
    __syncthreads();
    for (int it = 0; it < ntiles; ++it) {
        const int cur = it & 1, j = j0 + it;
        if (it + 1 < ntiles) {
            char* st = smem + (cur ^ 1) * 16384 + tid * 16;
            glds16(kp + (size_t)(it + 1) * 64 * kstride, st); if (MODE != 3) glds16(vp + (size_t)(it + 1) * 64, st + 8192);
        }
        const char* Kst = smem + cur * 16384;
        const char* Vst = Kst + 8192;
        bool fast;
        if (MODE == 0 || MODE == 3) fast = (t0 - (16 * (64 * j + 63) + 31)) >= 128;
        else if (MODE == 1) fast = (t0 - (64 * j + 63)) >= 128;
        else fast = ((t0 - (64 * j + 63)) >= 128) && ((t0 + 63 - 64 * j) < 512);
        if (MODE == 1) {
            const bool a0 = ((selor0 >> j) & 1ull) != 0ull, a1 = ((selor1 >> j) & 1ull) != 0ull;
            if (a0 && a1) nsa_tile<MODE, true, true>(Kst, Vst, j, fast, tbias, qf, qidx, selq, O, m, l, invl, smem, fr, fq, hp, wid);
            else if (a0) nsa_tile<MODE, true, false>(Kst, Vst, j, fast, tbias, qf, qidx, selq, O, m, l, invl, smem, fr, fq, hp, wid);
            else if (a1) nsa_tile<MODE, false, true>(Kst, Vst, j, fast, tbias, qf, qidx, selq, O, m, l, invl, smem, fr, fq, hp, wid);
        } else {
            nsa_tile<MODE, true, true>(Kst, Vst, j, fast, tbias, qf, qidx, selq, O, m, l, invl, smem, fr, fq, hp, wid);
        }
        asm volatile("s_waitcnt vmcnt(0)" ::: "memory");
        __syncthreads();
    }
}


__device__ __forceinline__ unsigned pack_bf16_p(float lo, float hi) { return pack_bf16(lo, hi); }

__device__ __forceinline__ void nsa_pv_mfma(const char* Vst, const bf16x8 (&pf)[2][2], f32x4 (&O)[4][2], int fr, int fq) {
#pragma unroll
    for (int p = 0; p < 2; ++p)
#pragma unroll
        for (int dt = 0; dt < 4; ++dt) {
            const bf16x8 vf = *(const bf16x8*)(Vst + tile_off(dt * 16 + fr, p * 4 + fq));
            O[dt][0] = __builtin_amdgcn_mfma_f32_16x16x32_bf16(vf, pf[0][p], O[dt][0], 0, 0, 0);
            O[dt][1] = __builtin_amdgcn_mfma_f32_16x16x32_bf16(vf, pf[1][p], O[dt][1], 0, 0, 0);
        }
}

template <int STR>
__device__ __forceinline__ void tb_read8(unsigned a0, unsigned a1, f32x2 (&t)[4]) {
    asm volatile(
        "ds_read2_b32 %0, %4 offset0:%6 offset1:%7\n\t"
        "ds_read2_b32 %1, %4 offset0:%8\n\t"
        "ds_read2_b32 %2, %5 offset0:%6 offset1:%7\n\t"
        "ds_read2_b32 %3, %5 offset0:%8\n\t"
        "s_waitcnt lgkmcnt(0)"
        : "=&v"(t[0]), "=&v"(t[1]), "=&v"(t[2]), "=&v"(t[3])
        : "v"(a0), "v"(a1), "n"(3 * STR), "n"(2 * STR), "n"(STR));
}

template <int MODE, bool PEND, bool EDGE>
__device__ __forceinline__ void nsa_step_impl(const char* Kst, const char* Vprev, int j, const float* tbias, const bf16x8 (&qf)[2][2], const int (&qidx)[2],
                                         const unsigned long long (&selq)[2], bf16x8 (&pf)[2][2], f32x4 (&O)[4][2], float (&m)[2], float (&l)[2], int fr, int fq) {
    constexpr int STR = (MODE == 0) ? 16 : 1;
    const float b127 = tbias[127];
    f32x4 Sc[2][2][2];
    float mref[2], i0[2]; bool sel[2];
#pragma unroll
    for (int ct = 0; ct < 2; ++ct) {
        mref[ct] = m[ct] < -1e29f ? 0.f : m[ct];
        sel[ct] = (MODE == 1) ? (((selq[ct] >> j) & 1ull) != 0ull) : true;
        i0[ct] = (EDGE ? 0.f : (sel[ct] ? b127 : NEGV)) - mref[ct];
    }
    {
        bf16x8 kf[4][2];
        __builtin_amdgcn_sched_barrier(0);
#pragma unroll
        for (int g = 0; g < 4; ++g) {
            const int row = 32 * (g >> 1) + 16 * (g & 1) + fr;
            kf[g][0] = *(const bf16x8*)(Kst + tile_off(row, fq)); kf[g][1] = *(const bf16x8*)(Kst + tile_off(row, 4 + fq));
        }
        __builtin_amdgcn_sched_barrier(0);
#pragma unroll
        for (int g = 0; g < 4; ++g)
#pragma unroll
            for (int ct = 0; ct < 2; ++ct) {
                f32x4 a = (f32x4){i0[ct], i0[ct], i0[ct], i0[ct]};
                a = __builtin_amdgcn_mfma_f32_16x16x32_bf16(kf[g][0], qf[ct][0], a, 0, 0, 0);
                a = __builtin_amdgcn_mfma_f32_16x16x32_bf16(kf[g][1], qf[ct][1], a, 0, 0, 0);
                Sc[ct][g >> 1][g & 1] = a;
            }
    }
    if (EDGE) {
        const unsigned tboff = (unsigned)(size_t)(const __attribute__((address_space(3))) float*)tbias;
#pragma unroll
        for (int ct = 0; ct < 2; ++ct)
#pragma unroll
            for (int p = 0; p < 2; ++p) {
                int base[2]; unsigned ad[2];
#pragma unroll
                for (int s = 0; s < 2; ++s) {
                    const int k0 = 64 * j + 32 * p + 8 * fq + 4 * s;
                    base[s] = (MODE == 0) ? qidx[ct] - (16 * k0 + 31) : qidx[ct] - k0;
                    const int bc = base[s] < 0 ? 0 : (base[s] > 127 + 3 * STR ? 127 + 3 * STR : base[s]);
                    ad[s] = tboff + (unsigned)(bc - 3 * STR) * 4u;
                }
                f32x2 tv[4];
                tb_read8<STR>(ad[0], ad[1], tv);
#pragma unroll
                for (int s = 0; s < 2; ++s)
#pragma unroll
                    for (int i = 0; i < 4; ++i) {
                        const int rel = base[s] - i * STR;
                        bool valid;
                        if (MODE == 0) valid = rel >= 0;
                        else if (MODE == 1) valid = (rel >= 0) && sel[ct];
                        else valid = (rel >= 0) && (rel < 512);
                        const float tb = tv[s * 2 + (i >> 1)][i & 1];
                        Sc[ct][p][s][i] = valid ? Sc[ct][p][s][i] + tb : NEGV;
                    }
            }
    }
    bool need = false; float mx[2];
#pragma unroll
    for (int ct = 0; ct < 2; ++ct) {
        float x = fmaxf(fmaxf(Sc[ct][0][0][0], Sc[ct][0][0][1]), Sc[ct][0][0][2]);
        x = fmaxf(fmaxf(x, Sc[ct][0][0][3]), Sc[ct][0][1][0]); x = fmaxf(fmaxf(x, Sc[ct][0][1][1]), Sc[ct][0][1][2]);
        x = fmaxf(fmaxf(x, Sc[ct][0][1][3]), Sc[ct][1][0][0]); x = fmaxf(fmaxf(x, Sc[ct][1][0][1]), Sc[ct][1][0][2]);
        x = fmaxf(fmaxf(x, Sc[ct][1][0][3]), Sc[ct][1][1][0]); x = fmaxf(fmaxf(x, Sc[ct][1][1][1]), Sc[ct][1][1][2]);
        x = fmaxf(x, Sc[ct][1][1][3]);
        mx[ct] = x;
        need = need || (x > 8.0f) || (m[ct] < -1e29f);
    }
    const bool slow = __builtin_amdgcn_ballot_w64(need) != 0ull;
    float alpha[2] = {1.f, 1.f};
    if (slow) {
#pragma unroll
        for (int ct = 0; ct < 2; ++ct) {
            const float mct = m[ct];
            float mloc = mx[ct] + mref[ct];
            mloc = fmaxf(mloc, __shfl_xor(mloc, 16)); mloc = fmaxf(mloc, __shfl_xor(mloc, 32));
            const float mn = fmaxf(mct, mloc);
            alpha[ct] = __builtin_amdgcn_exp2f(mct - mn);
            const float dlt = mref[ct] - mn;
            m[ct] = mn;
#pragma unroll
            for (int p = 0; p < 2; ++p)
#pragma unroll
                for (int s = 0; s < 2; ++s)
#pragma unroll
                    for (int i = 0; i < 4; ++i) Sc[ct][p][s][i] += dlt;
        }
    }
    float e[32];
    if (PEND) {
        bf16x8 vf[8];
#define NSA_VRD(f_) vf[f_] = *(const bf16x8*)(Vprev + tile_off(((f_) & 3) * 16 + fr, ((f_) >> 2) * 4 + fq))
        __builtin_amdgcn_sched_barrier(0);
        NSA_VRD(0); NSA_VRD(1);
        __builtin_amdgcn_sched_barrier(0);
#pragma unroll
        for (int k = 0; k < 16; ++k) {
            const int f = k >> 1, ct = k & 1, p = f >> 2, dt = f & 3;
            if (ct == 0 && f + 2 < 8) NSA_VRD(f + 2);
            O[dt][ct] = __builtin_amdgcn_mfma_f32_16x16x32_bf16(vf[f], pf[ct][p], O[dt][ct], 0, 0, 0);
#pragma unroll
            for (int x = 0; x < 2; ++x) {
                const int idx = 2 * k + x;
                e[idx] = __builtin_amdgcn_exp2f(Sc[idx >> 4][(idx >> 3) & 1][(idx >> 2) & 1][idx & 3]);
                asm volatile("" : "+v"(e[idx]));
            }
            __builtin_amdgcn_sched_barrier(0);
        }
#undef NSA_VRD
    } else {
#pragma unroll
        for (int idx = 0; idx < 32; ++idx) e[idx] = __builtin_amdgcn_exp2f(Sc[idx >> 4][(idx >> 3) & 1][(idx >> 2) & 1][idx & 3]);
    }
    if (slow) {
#pragma unroll
        for (int ct = 0; ct < 2; ++ct) {
            l[ct] *= alpha[ct];
#pragma unroll
            for (int dt = 0; dt < 4; ++dt) O[dt][ct] = O[dt][ct] * alpha[ct];
        }
    }
#pragma unroll
    for (int ct = 0; ct < 2; ++ct) {
        float ps0 = 0.f, ps1 = 0.f;
#pragma unroll
        for (int p = 0; p < 2; ++p) {
            const int eb = ct * 16 + p * 8;
#pragma unroll
            for (int i = 0; i < 4; ++i) { ps0 += e[eb + i]; ps1 += e[eb + 4 + i]; }
            u32x4 w;
            w[0] = pack_bf16_p(e[eb], e[eb + 1]); w[1] = pack_bf16_p(e[eb + 2], e[eb + 3]); w[2] = pack_bf16_p(e[eb + 4], e[eb + 5]); w[3] = pack_bf16_p(e[eb + 6], e[eb + 7]);
            pf[ct][p] = __builtin_bit_cast(bf16x8, w);
        }
        l[ct] += ps0 + ps1;
    }
}

template <int MODE, bool PEND>
__device__ __forceinline__ void nsa_step(const char* Kst, const char* Vprev, int j, bool fast, const float* tbias, const bf16x8 (&qf)[2][2], const int (&qidx)[2],
                                         const unsigned long long (&selq)[2], bf16x8 (&pf)[2][2], f32x4 (&O)[4][2], float (&m)[2], float (&l)[2], int fr, int fq) {
    if (fast) nsa_step_impl<MODE, PEND, false>(Kst, Vprev, j, tbias, qf, qidx, selq, pf, O, m, l, fr, fq);
    else nsa_step_impl<MODE, PEND, true>(Kst, Vprev, j, tbias, qf, qidx, selq, pf, O, m, l, fr, fq);
}

template <int MODE>
__device__ __forceinline__ void nsa_branch_p(const bf16_t* __restrict__ Kb, size_t kstride, const bf16_t* __restrict__ Vb, size_t vstride, int j0, int ntiles, int t0,
                                             const bf16x8 (&qf)[2][2], const int (&qidx)[2], const unsigned long long (&selq)[2],
                                             f32x4 (&O)[4][2], float (&m)[2], float (&l)[2], char* smem) {
    int tid_ = threadIdx.x; asm volatile("" : "+v"(tid_));
    const int tid = tid_, lane = tid & 63, fr = lane & 15, fq = lane >> 4, hp = fr & 3;
    const int lrow = tid >> 3;
    const float* tbias = (const float*)(smem + NSA_TB) + hp * NSA_TBW + 48;
    const int sch8 = ((tid & 7) ^ (lrow & 7)) * 8;
    const int krow = 32 * (lrow >> 5) + 8 * ((lrow & 15) >> 2) + 4 * ((lrow >> 4) & 1) + (lrow & 3);
    const bf16_t* kp = Kb + (size_t)krow * kstride + sch8;
    const bf16_t* vp = Vb + (size_t)lrow * vstride + sch8;
#define NSA_FAST(j_) ((MODE == 0) ? ((t0 - (16 * (64 * (j_) + 63) + 31)) >= 128) : (MODE == 1) ? ((t0 - (64 * (j_) + 63)) >= 128) : (((t0 - (64 * (j_) + 63)) >= 128) && ((t0 + 63 - 64 * (j_)) < 512)))
#define NSA_KLD(t_, st_) glds16(kp + (size_t)(t_) * 64 * kstride, smem + (st_) * 16384 + tid * 16)
#define NSA_VLD(t_, st_) glds16(vp + (size_t)(t_) * 64, smem + (st_) * 16384 + 8192 + tid * 16)
#define NSA_WAITBAR(n_) do { if ((n_) >= 2) asm volatile("s_waitcnt vmcnt(2) lgkmcnt(0)" ::: "memory"); else if ((n_) == 1) asm volatile("s_waitcnt vmcnt(1) lgkmcnt(0)" ::: "memory"); \
                             else asm volatile("s_waitcnt vmcnt(0) lgkmcnt(0)" ::: "memory"); __builtin_amdgcn_s_barrier(); asm volatile("" ::: "memory"); } while (0)
    __syncthreads();
    NSA_KLD(0, 0);
    if (ntiles > 1) NSA_KLD(1, 1);
    NSA_VLD(0, 0);
    NSA_WAITBAR(ntiles > 1 ? 2 : 1);
    bf16x8 pf[2][2];
    {
        int n = 0;
        if (2 < ntiles) { NSA_KLD(2, 2); ++n; }
        if (1 < ntiles) { NSA_VLD(1, 1); ++n; }
        nsa_step<MODE, false>(smem, smem, j0, NSA_FAST(j0), tbias, qf, qidx, selq, pf, O, m, l, fr, fq);
        NSA_WAITBAR(n);
    }
    int cur = 1, prv = 0, nx2 = 0;
    for (int it = 1; it < ntiles; ++it) {
        int n = 0;
        if (it + 2 < ntiles) { NSA_KLD(it + 2, nx2); ++n; }
        const int nx1 = (cur == 2) ? 0 : cur + 1;
        if (it + 1 < ntiles) { NSA_VLD(it + 1, nx1); ++n; }
        nsa_step<MODE, true>(smem + cur * 16384, smem + prv * 16384 + 8192, j0 + it, NSA_FAST(j0 + it), tbias, qf, qidx, selq, pf, O, m, l, fr, fq);
        NSA_WAITBAR(n);
        prv = cur; cur = nx1; nx2 = (nx2 == 2) ? 0 : nx2 + 1;
    }
    nsa_pv_mfma(smem + prv * 16384 + 8192, pf, O, fr, fq);
#undef NSA_KLD
#undef NSA_VLD
#undef NSA_WAITBAR
#undef NSA_FAST
}

__device__ __forceinline__ void osum_add(uint2& acc, f32x4 o, float sc) {
    f32x4 v;
    v[0] = __uint_as_float(acc.x << 16) + o[0] * sc; v[1] = __uint_as_float(acc.x & 0xFFFF0000u) + o[1] * sc;
    v[2] = __uint_as_float(acc.y << 16) + o[2] * sc; v[3] = __uint_as_float(acc.y & 0xFFFF0000u) + o[3] * sc;
    acc = pack4(v);
}
__device__ __forceinline__ float nsa_gate(const bf16_t* __restrict__ pb, int q, int br, int head) { return sigmoidf_(bf2f(pb[(size_t)q * PP + GA + br * 8 + head])); }

__device__ __forceinline__ void nsa_unit(int u, const bf16_t* __restrict__ proj, const char* __restrict__ ws, const float* __restrict__ rel_bias, bf16_t* __restrict__ ya, char* smem) {
    int tid_ = threadIdx.x; asm volatile("" : "+v"(tid_));
    const int tid = tid_, lane = tid & 63, wid = tid >> 6, fr = lane & 15, fq = lane >> 4, hp = fr & 3;
    const int bg = u & 7, qb = 63 - (u >> 3), b = bg >> 1, g = bg & 1, t0 = qb * 64, tb = qb;
    const bf16_t* kcb = (const bf16_t*)(ws + OFF_KCB) + (size_t)bg * 256 * 64;
    const bf16_t* vcbT = (const bf16_t*)(ws + OFF_VCBT) + (size_t)bg * 64 * 256;
    const bf16_t* VsT = (const bf16_t*)(ws + OFF_VST) + (size_t)bg * 64 * S;
    const bf16_t* VwT = (const bf16_t*)(ws + OFF_VWT) + (size_t)bg * 64 * S;
    const bf16_t* pb = proj + (size_t)b * S * PP;
    __syncthreads();
    {
        float* tbl = (float*)(smem + NSA_TB);
        for (int e = tid; e < 4 * NSA_TBW; e += 512) {
            const int h4 = e / NSA_TBW, x = e - h4 * NSA_TBW - 48, n = x < 0 ? 0 : (x > 127 ? 127 : x);
            tbl[e] = rel_bias[t5_bucket2(n) * 8 + g * 4 + h4] * LOG2E;
        }
        float* imp = (float*)(smem + NSA_IMPA);
        for (int e = tid; e < 2 * 4160; e += 512) imp[e] = 0.f;
    }
    int qidx[2]; bf16x8 qf[2][2];
    const int head = g * 4 + hp;
#pragma unroll
    for (int ct = 0; ct < 2; ++ct) {
        qidx[ct] = t0 + wid * 8 + ct * 4 + (fr >> 2);
        const bf16_t* qr = pb + (size_t)qidx[ct] * PP;
#pragma unroll
        for (int ks = 0; ks < 2; ++ks) {
            const u32x4 raw = *(const u32x4*)(qr + QA + head * 64 + ks * 32 + fq * 8);
            u32x4 w;
#pragma unroll
            for (int e = 0; e < 4; ++e) w[e] = pack_bf16(__uint_as_float(raw[e] << 16) * (0.125f * LOG2E), __uint_as_float(raw[e] & 0xFFFF0000u) * (0.125f * LOG2E));
            qf[ct][ks] = __builtin_bit_cast(bf16x8, w);
        }
    }
    uint2* osl = (uint2*)(smem + NSA_OSUM) + tid;
    unsigned long long selq[2] = {0ull, 0ull};
    float invl0[2] = {0.f, 0.f};
    const int ntc = (((t0 + 32) >> 4) + 1 + 63) >> 6;
    float mC[2], invC[2];
    {
        f32x4 O[4][2]; float m[2] = {-1e30f, -1e30f}, l[2] = {0.f, 0.f};
#pragma unroll
        for (int dt = 0; dt < 4; ++dt)
#pragma unroll
            for (int ct = 0; ct < 2; ++ct) O[dt][ct] = (f32x4){0.f, 0.f, 0.f, 0.f};
        nsa_branch_p<0>(kcb, 64, vcbT, 256, 0, ntc, t0, qf, qidx, selq, O, m, l, smem);
#pragma unroll
        for (int ct = 0; ct < 2; ++ct) {
            float lt = l[ct]; lt += __shfl_xor(lt, 16); lt += __shfl_xor(lt, 32);
            invC[ct] = lt > 0.f ? 1.f / lt : 0.f; mC[ct] = m[ct];
#pragma unroll
            for (int dt = 0; dt < 4; ++dt) { uint2 a = make_uint2(0u, 0u); osum_add(a, O[dt][ct], nsa_gate(pb, qidx[ct], 0, head) * invC[ct]); osl[(dt * 2 + ct) * 512] = a; }
        }
        nsa_branch<3>(kcb, 64, vcbT, 256, 0, ntc, t0, qf, qidx, selq, 0ull, 0ull, O, mC, l, invC, smem);
    }
    {
        const float* impA = (const float*)(smem + NSA_IMPA); const float* impB = (const float*)(smem + NSA_IMPB);
        unsigned long long* selm = (unsigned long long*)(smem + NSA_SELM);
#pragma unroll 1
        for (int qq = 0; qq < 8; ++qq) {
            const int ql = wid * 8 + qq;
            const float val = impA[ql * 65 + lane] + impB[ql * 65 + lane];
            const bool forced = (lane == 0) || (lane == tb) || (lane == tb - 1);
            unsigned key = forced ? 0xFFFFFFC0u : (lane > tb ? 0u : (__float_as_uint(val) & 0xFFFFFFC0u));
            key |= (unsigned)(63 - lane);
            int rank = 0;
#pragma unroll
            for (int jp = 0; jp < 64; ++jp) rank += ((unsigned)__builtin_amdgcn_readlane((int)key, jp) > key) ? 1 : 0;
            const unsigned long long msk = __ballot(rank < 16);
            if (lane == 0) selm[ql] = msk;
        }
        wave_lds_sync();
        unsigned long long so0 = 0ull, so1 = 0ull;
#pragma unroll
        for (int qq = 0; qq < 4; ++qq) { so0 |= selm[wid * 8 + qq]; so1 |= selm[wid * 8 + 4 + qq]; }
        const unsigned long long selor0 = ((unsigned long long)(unsigned)__builtin_amdgcn_readfirstlane((int)(unsigned)(so0 >> 32)) << 32) | (unsigned)__builtin_amdgcn_readfirstlane((int)(unsigned)so0);
        const unsigned long long selor1 = ((unsigned long long)(unsigned)__builtin_amdgcn_readfirstlane((int)(unsigned)(so1 >> 32)) << 32) | (unsigned)__builtin_amdgcn_readfirstlane((int)(unsigned)so1);
        selq[0] = selm[wid * 8 + (fr >> 2)]; selq[1] = selm[wid * 8 + 4 + (fr >> 2)];
        {
            f32x4 O[4][2]; float m[2] = {-1e30f, -1e30f}, l[2] = {0.f, 0.f};
#pragma unroll
            for (int dt = 0; dt < 4; ++dt)
#pragma unroll
                for (int ct = 0; ct < 2; ++ct) O[dt][ct] = (f32x4){0.f, 0.f, 0.f, 0.f};
            nsa_branch_p<1>(pb + KS + g * 64, PP, VsT, S, 0, tb + 1, t0, qf, qidx, selq, O, m, l, smem);
#pragma unroll
            for (int ct = 0; ct < 2; ++ct) {
                float lt = l[ct]; lt += __shfl_xor(lt, 16); lt += __shfl_xor(lt, 32);
                const float inv = lt > 0.f ? 1.f / lt : 0.f;
#pragma unroll
                for (int dt = 0; dt < 4; ++dt) { uint2 a = osl[(dt * 2 + ct) * 512]; osum_add(a, O[dt][ct], nsa_gate(pb, qidx[ct], 1, head) * inv); osl[(dt * 2 + ct) * 512] = a; }
            }
        }
    }
    {
        f32x4 O[4][2]; float m[2] = {-1e30f, -1e30f}, l[2] = {0.f, 0.f};
#pragma unroll
        for (int dt = 0; dt < 4; ++dt)
#pragma unroll
            for (int ct = 0; ct < 2; ++ct) O[dt][ct] = (f32x4){0.f, 0.f, 0.f, 0.f};
        const int jw0 = (t0 - 511 < 0 ? 0 : t0 - 511) >> 6;
        nsa_branch_p<2>(pb + (size_t)jw0 * 64 * PP + KW + g * 64, PP, VwT + jw0 * 64, S, jw0, tb - jw0 + 1, t0, qf, qidx, selq, O, m, l, smem);
#pragma unroll
        for (int ct = 0; ct < 2; ++ct) {
            float lt = l[ct]; lt += __shfl_xor(lt, 16); lt += __shfl_xor(lt, 32);
            const float inv = lt > 0.f ? 1.f / lt : 0.f;
            bf16_t* yr = ya + (size_t)(b * S + qidx[ct]) * 512 + head * 64 + 4 * fq;
#pragma unroll
            for (int dt = 0; dt < 4; ++dt) { uint2 a = osl[(dt * 2 + ct) * 512]; osum_add(a, O[dt][ct], nsa_gate(pb, qidx[ct], 2, head) * inv); *(uint2*)(yr + dt * 16) = a; }
        }
    }
}

__device__ __forceinline__ void vtrans_tile(int task, const bf16_t* __restrict__ proj, char* ws, char* smem) {
    unsigned short (*tl)[66] = (unsigned short (*)[66])smem;
    const int tid = HB_TID, which = task >> 9, bg = (task >> 6) & 7, tt = task & 63, b = bg >> 1, g = bg & 1;
    const int r = tid >> 2, q4 = tid & 3;
    const bf16_t* src = proj + (size_t)(b * S + tt * 64 + r) * PP + (which ? VW : VS) + g * 64 + q4 * 16;
    const uint4 a0 = *(const uint4*)src, a1 = *(const uint4*)(src + 8);
    unsigned* trow = (unsigned*)&tl[r][q4 * 16];
    trow[0] = a0.x; trow[1] = a0.y; trow[2] = a0.z; trow[3] = a0.w; trow[4] = a1.x; trow[5] = a1.y; trow[6] = a1.z; trow[7] = a1.w;
    __syncthreads();
    bf16_t* dst = (bf16_t*)(ws + (which ? OFF_VWT : OFF_VST)) + ((size_t)bg * 64 + r) * S + tt * 64 + q4 * 16;
    unsigned o[8];
#pragma unroll
    for (int k = 0; k < 8; ++k) o[k] = (unsigned)tl[q4 * 16 + 2 * k][r] | ((unsigned)tl[q4 * 16 + 2 * k + 1][r] << 16);
    *(uint4*)dst = make_uint4(o[0], o[1], o[2], o[3]);
    *(uint4*)(dst + 8) = make_uint4(o[4], o[5], o[6], o[7]);
    __syncthreads();
}

__device__ __forceinline__ int tile_el(int row, int col) { return tile_off(row, col >> 3) + ((col & 7) << 1); }

__device__ __forceinline__ void gla_stage_vt(const bf16_t* __restrict__ proj, size_t row0, int h, char* vt_base) {
    const int tid = HB_TID, c = tid >> 2, vq = tid & 3;
    const bf16_t* src = proj + (row0 + c) * PP + VB + h * 128 + vq * 32;
#pragma unroll
    for (int k = 0; k < 4; ++k) {
        const u32x4 a = *(const u32x4*)(src + k * 8);
#pragma unroll
        for (int e = 0; e < 4; ++e) {
            const int v = vq * 32 + k * 8 + 2 * e;
            *(unsigned short*)(vt_base + tile_el(v, c)) = (unsigned short)(a[e] & 0xFFFFu);
            *(unsigned short*)(vt_base + tile_el(v + 1, c)) = (unsigned short)(a[e] >> 16);
        }
    }
}

__device__ __forceinline__ void gla_a_unit(int vb, const bf16_t* __restrict__ proj, const float* __restrict__ w_alpha, const float* __restrict__ b_alpha,
                                           float* __restrict__ bc, float* __restrict__ cstate, char* smem) {
    float (*bcS)[64] = (float (*)[64])smem;
    float (*tot)[64] = (float (*)[64])(smem + 16384);
    char* KDT = smem + 17408;
    char* VT = smem + 17408 + 8192;
    const int tid = HB_TID, lane = tid & 63, wid = tid >> 6, fr = lane & 15, fq = lane >> 4;
    const int n = vb & 63, h = (vb >> 6) & 3, b = vb >> 8;
    const size_t row0 = (size_t)(b * S + n * 64);
    u32x4* abS = (u32x4*)(smem + 45056);
    __syncthreads();
    if (tid < 128) abS[tid] = *(const u32x4*)(proj + (row0 + (tid >> 1)) * PP + AB + (tid & 1) * 8);
    __syncthreads();
    {
        const int d = tid & 63, cq = tid >> 6, col = h * 64 + d;
        float w[16];
#pragma unroll
        for (int r = 0; r < 16; ++r) w[r] = w_alpha[r * 256 + col];
        const float bias = b_alpha[col];
        float cum = 0.f;
        for (int i = 0; i < 16; ++i) {
            const int c = cq * 16 + i;
            const u32x4 a0 = abS[c * 2], a1 = abS[c * 2 + 1];
            float z = bias;
#pragma unroll
            for (int e = 0; e < 4; ++e) {
                z += __uint_as_float(a0[e] << 16) * w[2 * e] + __uint_as_float(a0[e] & 0xFFFF0000u) * w[2 * e + 1];
                z += __uint_as_float(a1[e] << 16) * w[8 + 2 * e] + __uint_as_float(a1[e] & 0xFFFF0000u) * w[8 + 2 * e + 1];
            }
            const float ls = fminf(z, 0.f) - __logf(1.f + __expf(-fabsf(z)));
            cum += ls * (1.0f / 16.0f);
            bcS[c][d] = cum;
        }
        tot[cq][d] = cum;
        __syncthreads();
        float pre = 0.f;
        for (int q = 0; q < cq; ++q) pre += tot[q][d];
        for (int i = 0; i < 16; ++i) {
            const int c = cq * 16 + i;
            const float v = bcS[c][d] + pre;
            bcS[c][d] = v;
            bc[(row0 + c) * 256 + col] = v;
        }
    }
    __syncthreads();
    {
        const int c = tid >> 2, dq = tid & 3;
        const bf16_t* src = proj + (row0 + c) * PP + KB + h * 64 + dq * 16;
#pragma unroll
        for (int k = 0; k < 2; ++k) {
            const u32x4 a = *(const u32x4*)(src + k * 8);
#pragma unroll
            for (int e = 0; e < 4; ++e) {
                const int d = dq * 16 + k * 8 + 2 * e;
                const float k0 = __uint_as_float(a[e] << 16) * __expf(bcS[63][d] - bcS[c][d]);
                const float k1 = __uint_as_float(a[e] & 0xFFFF0000u) * __expf(bcS[63][d + 1] - bcS[c][d + 1]);
                *(unsigned short*)(KDT + tile_el(d, c)) = f2bf(k0);
                *(unsigned short*)(KDT + tile_el(d + 1, c)) = f2bf(k1);
            }
        }
    }
    gla_stage_vt(proj, row0, h, VT);
    __syncthreads();
    float* outp = cstate + (size_t)vb * 8192;
#pragma unroll
    for (int vi = 0; vi < 2; ++vi) {
        const int vt = wid * 2 + vi;
        const bf16x8 a0 = *(const bf16x8*)(VT + tile_off(vt * 16 + fr, fq)), a1 = *(const bf16x8*)(VT + tile_off(vt * 16 + fr, 4 + fq));
#pragma unroll
        for (int dt = 0; dt < 4; ++dt) {
            const bf16x8 b0 = *(const bf16x8*)(KDT + tile_off(dt * 16 + fr, fq)), b1 = *(const bf16x8*)(KDT + tile_off(dt * 16 + fr, 4 + fq));
            f32x4 acc = (f32x4){0.f, 0.f, 0.f, 0.f};
            acc = __builtin_amdgcn_mfma_f32_16x16x32_bf16(b0, a0, acc, 0, 0, 0);
            acc = __builtin_amdgcn_mfma_f32_16x16x32_bf16(b1, a1, acc, 0, 0, 0);
            *(f32x4*)(outp + (vt * 16 + fr) * 64 + dt * 16 + 4 * fq) = acc;
        }
    }
}

__device__ __forceinline__ void gla_scan_vb2(int vb, const float* __restrict__ bc, float* __restrict__ cstate) {
    const int idx = vb * 512 + threadIdx.x;
    const int e = idx & 8191, bh = idx >> 13, b = bh >> 2, h = bh & 3, d = e & 63;
    float state = 0.f;
    float* base = cstate + (size_t)bh * 64 * 8192 + e;
    const float* bcp = bc + ((size_t)(b * S + 63)) * 256 + h * 64 + d;
#pragma unroll 1
    for (int n0 = 0; n0 < 64; n0 += 16) {
        float upd[16], dec[16];
#pragma unroll
        for (int i = 0; i < 16; ++i) { upd[i] = base[(size_t)(n0 + i) * 8192]; dec[i] = bcp[(size_t)(n0 + i) * 64 * 256]; }
#pragma unroll
        for (int i = 0; i < 16; ++i) { base[(size_t)(n0 + i) * 8192] = state; state = __expf(dec[i]) * state + upd[i]; }
    }
}

__device__ __forceinline__ void gla_c_unit(int vb, const bf16_t* __restrict__ proj, const float* __restrict__ bc, const float* __restrict__ prev,
                                           const float* __restrict__ norm_g, bf16_t* __restrict__ yb, char* smem) {
    char* QI = smem;
    char* KI = smem + 8192;
    char* VT = smem + 16384;
    char* PT = smem + 32768;
    const int tid = HB_TID, lane = tid & 63, wid = tid >> 6, fr = lane & 15, fq = lane >> 4;
    const int n = vb & 63, h = (vb >> 6) & 3, b = vb >> 8;
    const size_t row0 = (size_t)(b * S + n * 64);
    __syncthreads();
    {
        const int c = tid >> 2, dq = tid & 3;
        const bf16_t* qs = proj + (row0 + c) * PP + QB + h * 64 + dq * 16;
        const bf16_t* ks = proj + (row0 + c) * PP + KB + h * 64 + dq * 16;
        const float* bs = bc + (row0 + c) * 256 + h * 64 + dq * 16;
#pragma unroll
        for (int k = 0; k < 2; ++k) {
            const u32x4 qa = *(const u32x4*)(qs + k * 8), ka = *(const u32x4*)(ks + k * 8);
            const f32x4 b0 = *(const f32x4*)(bs + k * 8), b1 = *(const f32x4*)(bs + k * 8 + 4);
            const float bv[8] = {b0[0], b0[1], b0[2], b0[3], b1[0], b1[1], b1[2], b1[3]};
            u32x4 qo, ko;
#pragma unroll
            for (int e = 0; e < 4; ++e) {
                const float e0 = __expf(bv[2 * e]), e1 = __expf(bv[2 * e + 1]);
                qo[e] = pack_bf16(__uint_as_float(qa[e] << 16) * 0.125f * e0, __uint_as_float(qa[e] & 0xFFFF0000u) * 0.125f * e1);
                ko[e] = pack_bf16(__uint_as_float(ka[e] << 16) / e0, __uint_as_float(ka[e] & 0xFFFF0000u) / e1);
            }
            *(u32x4*)(QI + tile_off(c, dq * 2 + k)) = qo;
            *(u32x4*)(KI + tile_off(c, dq * 2 + k)) = ko;
        }
    }
    gla_stage_vt(proj, row0, h, VT);
    {
        const int v = tid >> 1, half = tid & 1;
        const float* ps = prev + (size_t)vb * 8192 + v * 64 + half * 32;
#pragma unroll
        for (int k = 0; k < 4; ++k) {
            const f32x4 a = *(const f32x4*)(ps + k * 8), c2 = *(const f32x4*)(ps + k * 8 + 4);
            u32x4 o; o[0] = pack_bf16(a[0], a[1]); o[1] = pack_bf16(a[2], a[3]); o[2] = pack_bf16(c2[0], c2[1]); o[3] = pack_bf16(c2[2], c2[3]);
            *(u32x4*)(PT + tile_off(v, half * 4 + k)) = o;
        }
    }
    __syncthreads();
    const bf16x8 qf0 = *(const bf16x8*)(QI + tile_off(wid * 16 + fr, fq)), qf1 = *(const bf16x8*)(QI + tile_off(wid * 16 + fr, 4 + fq));
    bf16x8 pf[2];
    const int c = wid * 16 + fr;
#pragma unroll
    for (int p = 0; p < 2; ++p) {
        u32x4 w;
#pragma unroll
        for (int s = 0; s < 2; ++s) {
            const int row = 32 * p + 8 * (fr >> 2) + 4 * s + (fr & 3);
            const bf16x8 k0 = *(const bf16x8*)(KI + tile_off(row, fq)), k1 = *(const bf16x8*)(KI + tile_off(row, 4 + fq));
            f32x4 a = (f32x4){0.f, 0.f, 0.f, 0.f};
            a = __builtin_amdgcn_mfma_f32_16x16x32_bf16(k0, qf0, a, 0, 0, 0);
            a = __builtin_amdgcn_mfma_f32_16x16x32_bf16(k1, qf1, a, 0, 0, 0);
#pragma unroll
            for (int i = 0; i < 4; ++i) { const int j = 32 * p + 8 * fq + 4 * s + i; if (j > c) a[i] = 0.f; }
            w[2 * s] = pack_bf16(a[0], a[1]); w[2 * s + 1] = pack_bf16(a[2], a[3]);
        }
        pf[p] = __builtin_bit_cast(bf16x8, w);
    }
    f32x4 acc[8];
    float ss = 0.f;
#pragma unroll
    for (int vt = 0; vt < 8; ++vt) {
        f32x4 a = (f32x4){0.f, 0.f, 0.f, 0.f};
        a = __builtin_amdgcn_mfma_f32_16x16x32_bf16(*(const bf16x8*)(VT + tile_off(vt * 16 + fr, fq)), pf[0], a, 0, 0, 0);
        a = __builtin_amdgcn_mfma_f32_16x16x32_bf16(*(const bf16x8*)(VT + tile_off(vt * 16 + fr, 4 + fq)), pf[1], a, 0, 0, 0);
        a = __builtin_amdgcn_mfma_f32_16x16x32_bf16(*(const bf16x8*)(PT + tile_off(vt * 16 + fr, fq)), qf0, a, 0, 0, 0);
        a = __builtin_amdgcn_mfma_f32_16x16x32_bf16(*(const bf16x8*)(PT + tile_off(vt * 16 + fr, 4 + fq)), qf1, a, 0, 0, 0);
        acc[vt] = a;
        ss += a[0] * a[0] + a[1] * a[1] + a[2] * a[2] + a[3] * a[3];
    }
    ss += __shfl_xor(ss, 16); ss += __shfl_xor(ss, 32);
    const float r = rsqrtf(ss * (1.0f / 128.0f) + 1e-6f);
    const size_t row = row0 + c;
#pragma unroll
    for (int vt = 0; vt < 8; ++vt) {
        const int col = h * 128 + vt * 16 + 4 * fq;
        const uint2 rr = *(const uint2*)(proj + row * PP + RB + col);
        const f32x4 g4 = *(const f32x4*)(norm_g + col);
        const float r0 = __uint_as_float(rr.x << 16), r1 = __uint_as_float(rr.x & 0xFFFF0000u), r2 = __uint_as_float(rr.y << 16), r3 = __uint_as_float(rr.y & 0xFFFF0000u);
        f32x4 o;
        o[0] = acc[vt][0] * r * g4[0] * (r0 * sigmoidf_(r0)); o[1] = acc[vt][1] * r * g4[1] * (r1 * sigmoidf_(r1));
        o[2] = acc[vt][2] * r * g4[2] * (r2 * sigmoidf_(r2)); o[3] = acc[vt][3] * r * g4[3] * (r3 * sigmoidf_(r3));
        *(uint2*)(yb + row * 512 + col) = pack4(o);
    }
}

constexpr int SMEM_BYTES = 131072;

__global__ void __launch_bounds__(512, 2) k_fwd(Params p) {
    extern __shared__ __attribute__((aligned(16))) char smem_dyn[];
    char* smem = smem_dyn + 16;
    char* smh = smem + (threadIdx.x >> 8) * 65536;
    if (threadIdx.x == 0) *(uint4*)smem_dyn = make_uint4(0u, 0u, 0u, 0u);
    __syncthreads();
    char* ws = p.ws;
    XcdBarrier bar = xcd_barrier_post((unsigned*)(ws + OFF_BAR), (volatile LAS unsigned*)smem_dyn);
    int* ctrl = (int*)(ws + OFF_CTRL);
    bf16_t* proj = (bf16_t*)(ws + OFF_PROJ);
    float* bc = (float*)(ws + OFF_BC);
    float* cstate = (float*)(ws + OFF_CSTATE);
    bf16_t* mrg = (bf16_t*)p.out + (size_t)T * 1024;
    bf16_t* h2 = (bf16_t*)(ws + OFF_H2);
    bf16_t* hid = (bf16_t*)(ws + OFF_HID);
    bf16_t* Y0 = (bf16_t*)(ws + OFF_Y0);
    bf16_t* Y1 = (bf16_t*)(ws + OFF_Y1);
    bf16_t* ya = (bf16_t*)(ws + OFF_YA);
    bf16_t* yb = (bf16_t*)(ws + OFF_YB);
    bf16_t* kcb = (bf16_t*)(ws + OFF_KCB);
    bf16_t* vcb = (bf16_t*)(ws + OFF_VCB);
    bf16_t* h = (bf16_t*)p.out;
    const int G = gridDim.x;

    ph_prep(p, smh);
    const int fsh = (2304 + G - 1) / G;
    xcd_arrive2(bar); ph_filler(p, 0, fsh / 4, smh); xcd_wait2(bar);
    { g8::StaticOrder S; S.init(T, 3072, G, (int)blockIdx.x); const g8::AddrPlain AD{(const char*)h, (const char*)(ws + OFF_WINT), 2048u, 2048u, 16};
      g8::gemm_phase(smem, S, AD, g8::EpiProj{proj}); }
    xcd_arrive2(bar); ph_filler(p, fsh / 4, fsh / 2, smh); xcd_wait2(bar);
    ph_cmp1(proj, ws, (float*)(ws + OFF_YA), smh);
    {
        const int nc = G > 64 ? 32 : 0, gb = (int)blockIdx.x - nc, gs = G - nc;
        if (gb >= 0) {
            for (int pr = gb; pr < 512; pr += gs) vtrans_tile(2 * pr + HB_ID, proj, ws, smh);
            for (int pr = gb; pr < 512; pr += gs) gla_a_unit(2 * pr + HB_ID, proj, p.w_alpha, p.b_alpha, bc, cstate, smh);
        }
    }
    xcd_arrive2(bar); ph_filler(p, fsh / 2, (3 * fsh) / 4, smh); xcd_wait2(bar);
    ph_cmp2(ws, ws, (const float*)(ws + OFF_YA), smh);
    for (int vb = blockIdx.x; vb < 256; vb += G) gla_scan_vb2(vb, bc, cstate);
    xcd_arrive2(bar); ph_filler(p, (3 * fsh) / 4, fsh, smh); xcd_wait2(bar);
    for (int vb = HB_FIRST; vb < 1024; vb += HB_STEP) gla_c_unit(vb, proj, bc, cstate, p.norm_g, yb, smh);
    for (int r = 0; r * G < 512; ++r) {
        const int u = r * G + ((r & 1) ? (G - 1 - (int)blockIdx.x) : (int)blockIdx.x);
        if (u < 512) nsa_unit(u, proj, ws, p.rel_bias, ya, smem);
    }
    xcd_arrive2(bar);
    {
        g8::MergeOrder MO; MO.so.init(T, 1024, G, (int)blockIdx.x); MO.bar = (unsigned*)(ws + OFF_BAR); MO.st = (volatile LAS unsigned*)smem_dyn;
        const g8::AddrMerge AD{(const char*)h, (const char*)(ws + OFF_WINT), (const char*)ya, (const char*)yb, (const char*)(ws + OFF_WAT), (const char*)(ws + OFF_WBT)};
        g8::gemm_phase(smem, MO, AD, g8::EpiMergeAll{mrg, (bf16_t*)(ws + OFF_R1)});
    }
    xcd_barrier(bar);
    { g8::StaticOrder S; S.init(T, 1024, G, (int)blockIdx.x); const g8::AddrPlain AD{(const char*)mrg, (const char*)(ws + OFF_WOT), 2048u, 2048u, 16};
      g8::gemm_phase(smem, S, AD, g8::EpiDelta{ya}); }
    xcd_barrier(bar);
    for (int grp = HB_FIRST; grp < 512; grp += HB_STEP) {
        for (int tt = 0; tt < 2; ++tt) router_unit(grp * 2 + tt, p.x, ya, p.g_ffn, (const bf16_t*)(ws + OFF_WRT), p.b_rg, p.b_re, h2, (float*)(ws + OFF_RSTD), smh);
        router_append(grp, (int*)(ws + OFF_LTOK), (float*)(ws + OFF_LW), ctrl, smh);
    }
    xcd_barrier(bar);
    ph_moe1(h2, (const bf16_t*)(ws + OFF_WGT), (const bf16_t*)(ws + OFF_WUT), ctrl, (const int*)(ws + OFF_LTOK), (const float*)(ws + OFF_LW), (const float*)(ws + OFF_RSTD), hid, smh);
    ph_prep_experts_down(p, ctrl, smh);
    xcd_barrier(bar);
    ph_moe2w(hid, (const bf16_t*)(ws + OFF_WDT), ctrl, (const int*)(ws + OFF_LTOK), Y0, ws + OFF_KCB, smem);
    xcd_barrier(bar);
    { int t_ = threadIdx.x; asm volatile("" : "+v"(t_)); for (int row = blockIdx.x * 8 + (t_ >> 6); row < T; row += G * 8) final_row(row, p.x, ya, p.out, Y0, Y1, p.g_final, t_ & 63); }
}

extern "C" void kernel_launch(void* const* d_in, const int* in_sizes, int n_in, void* d_out, int out_size, void* d_ws, size_t ws_size, hipStream_t stream) {
    static int grid = 0;
    constexpr int kDynLds = SMEM_BYTES + 16;
    if (!grid) {
        int dev = 0, cus = 0, per_cu = 0;
        (void)hipGetDevice(&dev);
        (void)hipDeviceGetAttribute(&cus, hipDeviceAttributeMultiprocessorCount, dev);
        (void)hipFuncSetAttribute((const void*)k_fwd, hipFuncAttributeMaxDynamicSharedMemorySize, kDynLds);
        (void)hipOccupancyMaxActiveBlocksPerMultiprocessor(&per_cu, k_fwd, 512, kDynLds);
        if (per_cu > 1) per_cu = 1;
        if (per_cu < 1) per_cu = 1;
        grid = cus * per_cu;
    }
    char* ws = (char*)d_ws;
    (void)hipMemsetAsync(ws + OFF_CTRL, 0, 49152, stream);
    Params p{};
    const float** pf = (const float**)&p;
    for (int i = 0; i < 25; ++i) pf[i] = (const float*)d_in[i];
    p.out = (float*)d_out; p.ws = ws;
    k_fwd<<<grid, 512, kDynLds, stream>>>(p);
}
```

```cpp
#include <hip/hip_runtime.h>
#include <stdint.h>

typedef unsigned short bf16_t;
typedef short bf16x8 __attribute__((ext_vector_type(8)));
typedef float f32x4 __attribute__((ext_vector_type(4)));
typedef unsigned u32x4 __attribute__((ext_vector_type(4)));
__device__ __forceinline__ float bf2f(bf16_t v) { return __uint_as_float(((unsigned)v) << 16); }
__device__ __forceinline__ bf16_t f2bf(float f) { unsigned u = __float_as_uint(f); u += 0x7FFFu + ((u >> 16) & 1u); return (bf16_t)(u >> 16); }
typedef float f32x2c_t __attribute__((ext_vector_type(2)));
typedef __bf16 bf16x2c_t __attribute__((ext_vector_type(2)));
__device__ __forceinline__ unsigned pack_bf16(float lo, float hi) { const f32x2c_t v = {lo, hi}; return __builtin_bit_cast(unsigned, __builtin_convertvector(v, bf16x2c_t)); }

constexpr int Bn = 4, S = 4096, T = Bn * S, D = 1024, NIN = 4904, PP = 2880;
constexpr int QA = 0, KC = 512, VC = 640, KS = 768, VS = 896, KW = 1024, VW = 1152, GA = 1280, QB = 1304, KB = 1560, VB = 1816, AB = 2328, RB = 2344, MGA = 2856, MGB = 3880;
constexpr int NPROJ = 2856;
constexpr int MSLOT = 36864;

constexpr size_t OFF_CTRL = 0;
constexpr size_t OFF_BAR = 16384;
constexpr size_t OFF_ROUTE_E = 49152;
constexpr size_t OFF_ROUTE_W = OFF_ROUTE_E + 32768 * 4;
constexpr size_t OFF_SLOT_TOK = OFF_ROUTE_W + 32768 * 4;
constexpr size_t OFF_SLOT_W = OFF_SLOT_TOK + (size_t)MSLOT * 4;
constexpr size_t OFF_BIAS1 = OFF_SLOT_W + (size_t)MSLOT * 4;
constexpr size_t OFF_RSTD = OFF_BIAS1 + 8192;
constexpr size_t OFF_SLOT_RS = OFF_RSTD + (size_t)T * 4;
constexpr size_t OFF_WRT = OFF_SLOT_RS + (size_t)MSLOT * 4;
static_assert(OFF_WRT + 2 * 48 * 1024 * 2 <= (1u << 20), "ctrl overflow");
constexpr size_t OFF_R1 = 1u << 20;
constexpr size_t SZ_PROJ = (size_t)T * PP * 2;
constexpr size_t OFF_PROJ = OFF_R1;
constexpr size_t OFF_BC = OFF_PROJ + SZ_PROJ;
constexpr size_t OFF_CSTATE = OFF_BC + (size_t)T * 256 * 4;
constexpr size_t OFF_R1_END = OFF_CSTATE + (size_t)1024 * 8192 * 4;
constexpr size_t OFF_MRG = OFF_R1 + (size_t)T * 2048 * 2;
constexpr size_t OFF_H2 = OFF_R1;
constexpr size_t OFF_HID = OFF_H2 + (size_t)T * 1024 * 2;
constexpr size_t OFF_Y0 = OFF_HID + (size_t)2 * T * 256 * 2;
constexpr size_t OFF_Y1 = OFF_Y0 + (size_t)T * 1024 * 2;
static_assert(OFF_MRG + (size_t)T * 1024 * 2 <= OFF_R1_END, "alias overflow");
static_assert(OFF_Y1 + (size_t)T * 1024 * 2 <= OFF_R1_END, "alias overflow");
constexpr size_t OFF_YA = OFF_R1_END;
constexpr size_t OFF_YB = OFF_YA + (size_t)T * 512 * 2;
constexpr size_t OFF_KCB = OFF_YB + (size_t)T * 512 * 2;
constexpr size_t OFF_VCB = OFF_KCB + 8 * 256 * 64 * 2;
constexpr size_t OFF_VCBT = OFF_VCB + 8 * 256 * 64 * 2;
constexpr size_t OFF_HIDC = OFF_VCBT + 8 * 256 * 64 * 2;
constexpr size_t OFF_VST = OFF_HIDC + 2 * 2048 * 128 * 2;
constexpr size_t OFF_VWT = OFF_VST + (size_t)8 * 64 * S * 2;
constexpr size_t OFF_WINT = OFF_VWT + (size_t)8 * 64 * S * 2;
constexpr size_t OFF_CK1T = OFF_WINT + (size_t)NIN * 1024 * 2;
constexpr size_t OFF_CV1T = OFF_CK1T + 128 * 2048 * 2;
constexpr size_t OFF_CK2T = OFF_CV1T + 128 * 2048 * 2;
constexpr size_t OFF_CV2T = OFF_CK2T + 128 * 128 * 2;
constexpr size_t OFF_WAT = OFF_CV2T + 128 * 128 * 2;
constexpr size_t OFF_WBT = OFF_WAT + 1024 * 512 * 2;
constexpr size_t OFF_WOT = OFF_WBT + 1024 * 512 * 2;
constexpr size_t OFF_WGT = OFF_WOT + 1024 * 1024 * 2;
constexpr size_t OFF_WUT = OFF_WGT + (size_t)32 * 256 * 1024 * 2;
constexpr size_t OFF_WDT = OFF_WUT + (size_t)32 * 256 * 1024 * 2;
constexpr size_t OFF_LTOK = OFF_WDT + (size_t)32 * 1024 * 256 * 2;
constexpr size_t OFF_LW = OFF_LTOK + (size_t)32 * 16384 * 4;
constexpr size_t OFF_END = OFF_LW + (size_t)32 * 16384 * 4;
static_assert(OFF_END <= (size_t)256 << 20, "workspace overflow");

#define XB_TMO      128
#define XB_XCNT(j)  (256  + 64 * (j))
#define XB_XSUB(j)  (1280 + 64 * (j))
#define XB_XGEN(j)  (2304 + 64 * (j))
#define XB_TOP      3328
#define XB_TOPGEN   3392
#define XCD_BAR_WORDS 3456
#define XB_SPIN_CAP (1u << 18)
#define LAS __attribute__((address_space(3)))

__device__ __forceinline__ unsigned xb_ld(unsigned* p)              { return __hip_atomic_load(p, __ATOMIC_RELAXED, __HIP_MEMORY_SCOPE_AGENT); }
__device__ __forceinline__ unsigned xb_add(unsigned* p, unsigned v) { return __hip_atomic_fetch_add(p, v, __ATOMIC_RELAXED, __HIP_MEMORY_SCOPE_AGENT); }
__device__ __forceinline__ unsigned xb_xcc_id() { return (unsigned)__builtin_amdgcn_s_getreg((3 << 11) | 20) & 0xFu; }
#define XB_SPIN(cond, bar) do { unsigned _sp = 0; while (cond) { __builtin_amdgcn_s_sleep(1); \
    if ((++_sp & 255u) == 0u) { if (xb_ld(&(bar)[XB_TMO])) break; if (_sp > XB_SPIN_CAP) { atomicAdd(&(bar)[XB_TMO], 1u); break; } } } } while (0)

struct XcdBarrier { unsigned* bar; unsigned x; volatile LAS unsigned* st; };

__device__ __forceinline__ XcdBarrier xcd_barrier_post(unsigned* bar, volatile LAS unsigned* st) {
    XcdBarrier b; b.bar = bar; b.x = xb_xcc_id(); b.st = st;
    if (threadIdx.x == 0) (void)xb_add(&bar[XB_XCNT(b.x)], 1u);
    return b;
}
__device__ __forceinline__ void xcd_barrier_complete(unsigned* bar, unsigned x, unsigned& nloc, unsigned& nx) {
    const unsigned G = gridDim.x * gridDim.y * gridDim.z;
    unsigned sum, cnt, mine, sp = 0u;
    for (;;) {
        sum = 0u; cnt = 0u; mine = 0u;
#pragma unroll
        for (unsigned j = 0; j < 16; ++j) { const unsigned c = xb_ld(&bar[XB_XCNT(j)]); sum += c; cnt += (c > 0u) ? 1u : 0u; mine = (j == x) ? c : mine; }
        if (sum == G) break;
        __builtin_amdgcn_s_sleep(1);
        if ((++sp & 255u) == 0u) { if (xb_ld(&bar[XB_TMO])) break; if (sp > XB_SPIN_CAP) { atomicAdd(&bar[XB_TMO], 1u); break; } }
    }
    nloc = mine > 0u ? mine : 1u; nx = cnt > 0u ? cnt : 1u;
}
__device__ __forceinline__ void xcd_barrier(const XcdBarrier& b) {
    asm volatile("s_waitcnt vmcnt(0)" ::: "memory");
    __syncthreads();
    if (threadIdx.x == 0) {
        unsigned* bar = b.bar;
        __builtin_amdgcn_s_waitcnt(0);
        unsigned nloc = b.st[0], nx = b.st[1];
        if (nloc == 0u) { xcd_barrier_complete(bar, b.x, nloc, nx); b.st[0] = nloc; b.st[1] = nx; }
        const unsigned old = xb_add(&bar[XB_XSUB(b.x)], 1u);
        const unsigned gen = old / nloc;
        if (old + 1u == (gen + 1u) * nloc) {
            __builtin_amdgcn_fence(__ATOMIC_RELEASE, "agent");
            asm volatile("s_waitcnt vmcnt(0)" ::: "memory");
            const unsigned og = xb_add(&bar[XB_TOP], 1u);
            const unsigned tg = og / nx;
            if (og + 1u == (tg + 1u) * nx) xb_add(&bar[XB_TOPGEN], 1u);
            else XB_SPIN(xb_ld(&bar[XB_TOPGEN]) == tg, bar);
            __builtin_amdgcn_fence(__ATOMIC_ACQUIRE, "agent");
            xb_add(&bar[XB_XGEN(b.x)], 1u);
            asm volatile("s_waitcnt vmcnt(0)" ::: "memory");
        } else {
            XB_SPIN(xb_ld(&bar[XB_XGEN(b.x)]) == gen, bar);
            __builtin_amdgcn_fence(__ATOMIC_ACQUIRE, "agent");
            asm volatile("s_waitcnt vmcnt(0)" ::: "memory");
        }
    }
    __syncthreads();
}

#define XB2_XSUB(j) (4096 + 64 * (j))
#define XB2_TOP     5120
#define XB2_TOPGEN  5184
__device__ __forceinline__ void xcd_arrive2(const XcdBarrier& b) {
    asm volatile("s_waitcnt vmcnt(0)" ::: "memory");
    __syncthreads();
    if (threadIdx.x == 0) {
        unsigned* bar = b.bar;
        __builtin_amdgcn_s_waitcnt(0);
        unsigned nloc = b.st[0], nx = b.st[1];
        if (nloc == 0u) { xcd_barrier_complete(bar, b.x, nloc, nx); b.st[0] = nloc; b.st[1] = nx; }
        const unsigned old = xb_add(&bar[XB2_XSUB(b.x)], 1u);
        const unsigned gen = old / nloc;
        if (old + 1u == (gen + 1u) * nloc) {
            __builtin_amdgcn_fence(__ATOMIC_RELEASE, "agent");
            asm volatile("s_waitcnt vmcnt(0)" ::: "memory");
            const unsigned og = xb_add(&bar[XB2_TOP], 1u);
            const unsigned tg = og / nx;
            if (og + 1u == (tg + 1u) * nx) xb_add(&bar[XB2_TOPGEN], 1u);
        }
        b.st[2] = gen;
    }
}
__device__ __forceinline__ void xcd_wait2(const XcdBarrier& b) {
    if (threadIdx.x == 0) {
        unsigned* bar = b.bar;
        const unsigned gen = b.st[2];
        XB_SPIN(xb_ld(&bar[XB2_TOPGEN]) <= gen, bar);
        __builtin_amdgcn_fence(__ATOMIC_ACQUIRE, "agent");
        asm volatile("s_waitcnt vmcnt(0)" ::: "memory");
    }
    __syncthreads();
}


__device__ __forceinline__ int hb_tid_() { int t = threadIdx.x; asm volatile("" : "+v"(t)); return t & 255; }
#define HB_TID (hb_tid_())
#define HB_ID ((int)(threadIdx.x >> 8))
#define HB_FIRST (2 * (int)blockIdx.x + HB_ID)
#define HB_STEP (2 * (int)gridDim.x)
struct Params {
    const float *x, *g_mix, *w_in, *pe_k, *ck1, *ck2, *pe_v, *cv1, *cv2, *rel_bias, *w_alpha, *b_alpha, *norm_g, *w_ba, *w_bb, *w_out, *g_ffn,
                *w_rg, *b_rg, *w_re, *b_re, *w_eg, *w_eu, *w_ed, *g_final;
    float* out; char* ws;
};

__device__ __forceinline__ float wave_max(float v) { for (int o = 32; o > 0; o >>= 1) v = fmaxf(v, __shfl_xor(v, o)); return v; }
__device__ __forceinline__ float wave_sum(float v) { for (int o = 32; o > 0; o >>= 1) v += __shfl_xor(v, o); return v; }
__device__ __forceinline__ void wave_lds_sync() { asm volatile("s_waitcnt lgkmcnt(0)" ::: "memory"); }


__device__ __forceinline__ void rms_h_row(int row, const float* __restrict__ x, const float* __restrict__ g, bf16_t* __restrict__ h, int lane) {
    const float* xr = x + (size_t)row * D + lane * 4;
    f32x4 v[4]; float s = 0.f;
#pragma unroll
    for (int i = 0; i < 4; ++i) { v[i] = *(const f32x4*)(xr + 256 * i); s += v[i][0] * v[i][0] + v[i][1] * v[i][1] + v[i][2] * v[i][2] + v[i][3] * v[i][3]; }
    s = wave_sum(s);
    const float r = rsqrtf(s * (1.0f / D) + 1e-6f);
#pragma unroll
    for (int i = 0; i < 4; ++i) {
        const f32x4 gg = *(const f32x4*)(g + lane * 4 + 256 * i);
        uint2 o; o.x = pack_bf16(v[i][0] * r * gg[0], v[i][1] * r * gg[1]); o.y = pack_bf16(v[i][2] * r * gg[2], v[i][3] * r * gg[3]);
        *(uint2*)(h + (size_t)row * D + lane * 4 + 256 * i) = o;
    }
}
__device__ __forceinline__ void final_row(int row, const float* __restrict__ x, const bf16_t* __restrict__ dl, float* __restrict__ outp, const bf16_t* __restrict__ Y0, const bf16_t* __restrict__ Y1, const float* __restrict__ g, int lane) {
    const float* xr = x + (size_t)row * D + lane * 4;
    f32x4 v[4]; float s = 0.f;
#pragma unroll
    for (int i = 0; i < 4; ++i) {
        v[i] = *(const f32x4*)(xr + 256 * i);
        const uint2 a = *(const uint2*)(Y0 + (size_t)row * D + lane * 4 + 256 * i), c = *(const uint2*)(Y1 + (size_t)row * D + lane * 4 + 256 * i);
        const uint2 e = *(const uint2*)(dl + (size_t)row * D + lane * 4 + 256 * i);
        v[i][0] += __uint_as_float(e.x << 16); v[i][1] += __uint_as_float(e.x & 0xFFFF0000u); v[i][2] += __uint_as_float(e.y << 16); v[i][3] += __uint_as_float(e.y & 0xFFFF0000u);
        v[i][0] += __uint_as_float(a.x << 16) + __uint_as_float(c.x << 16);
        v[i][1] += __uint_as_float(a.x & 0xFFFF0000u) + __uint_as_float(c.x & 0xFFFF0000u);
        v[i][2] += __uint_as_float(a.y << 16) + __uint_as_float(c.y << 16);
        v[i][3] += __uint_as_float(a.y & 0xFFFF0000u) + __uint_as_float(c.y & 0xFFFF0000u);
        s += v[i][0] * v[i][0] + v[i][1] * v[i][1] + v[i][2] * v[i][2] + v[i][3] * v[i][3];
    }
    s = wave_sum(s);
    const float r = rsqrtf(s * (1.0f / D) + 1e-6f);
#pragma unroll
    for (int i = 0; i < 4; ++i) {
        const f32x4 gg = *(const f32x4*)(g + lane * 4 + 256 * i);
        *(f32x4*)(outp + (size_t)row * D + lane * 4 + 256 * i) = (f32x4){v[i][0] * r * gg[0], v[i][1] * r * gg[1], v[i][2] * r * gg[2], v[i][3] * r * gg[3]};
    }
}

__device__ __forceinline__ void prep_router_w(const float* __restrict__ w_rg, const float* __restrict__ w_re, bf16_t* __restrict__ WrT) {
    for (int idx = blockIdx.x * 512 + threadIdx.x; idx < 48 * 1024; idx += gridDim.x * 512) {
        const int n = idx >> 10, k = idx & 1023;
        const float w = n < 4 ? w_rg[k * 4 + n] : (n < 36 ? w_re[k * 32 + n - 4] : 0.f);
        const bf16_t hi = f2bf(w);
        const int fi = ((((n >> 4) * 32 + (k >> 5)) * 64 + ((k >> 3) & 3) * 16 + (n & 15)) << 3) + (k & 7);
        WrT[fi] = hi; WrT[48 * 1024 + fi] = f2bf(w - bf2f(hi));
    }
}

__device__ __forceinline__ void router_unit(int task, const float* __restrict__ x, const bf16_t* __restrict__ dl, const float* __restrict__ g, const bf16_t* __restrict__ WrT,
                                            const float* __restrict__ b_rg, const float* __restrict__ b_re, bf16_t* __restrict__ h2, float* __restrict__ rstd_out,
                                            char* smem) {
    float (*part)[16][49] = (float (*)[16][49])smem;
    int* dec_e = (int*)(smem + 14336); float* dec_w = (float*)(smem + 14336 + 512);
    float (*ssp)[16] = (float (*)[16])(smem + 4 * 16 * 49 * 4);
    const int tid = HB_TID, lane = tid & 63, w4 = tid >> 6, fr = lane & 15, fq = lane >> 4, r0 = task * 16;
    const float* xr = x + (size_t)(r0 + fr) * D + fq * 8 + w4 * 256;
    const bf16_t* dr = dl + (size_t)(r0 + fr) * D + fq * 8 + w4 * 256;
    bf16_t* hr = h2 + (size_t)(r0 + fr) * D + fq * 8 + w4 * 256;
    const bf16_t* wh = WrT + ((size_t)(w4 * 8) * 64 + lane) * 8;
    const float* gp = g + fq * 8 + w4 * 256;
    f32x4 acc[3];
#pragma unroll
    for (int nt = 0; nt < 3; ++nt) acc[nt] = (f32x4){0.f, 0.f, 0.f, 0.f};
    float ssq = 0.f;
    f32x4 xa[8][2]; u32x4 dda[8];
#pragma unroll
    for (int ks = 0; ks < 8; ++ks) { xa[ks][0] = *(const f32x4*)(xr + ks * 32); xa[ks][1] = *(const f32x4*)(xr + ks * 32 + 4); dda[ks] = *(const u32x4*)(dr + ks * 32); }
    bf16x8 bhb[2][3], blb[2][3]; f32x4 gb[2][2];
#define RT_LOADW(ks_, b_) do { _Pragma("unroll") for (int nt = 0; nt < 3; ++nt) { bhb[b_][nt] = *(const bf16x8*)(wh + (size_t)(nt * 32 + (ks_)) * 512); \
            blb[b_][nt] = *(const bf16x8*)(wh + 48 * 1024 + (size_t)(nt * 32 + (ks_)) * 512); } \
        gb[b_][0] = *(const f32x4*)(gp + (ks_) * 32); gb[b_][1] = *(const f32x4*)(gp + (ks_) * 32 + 4); } while (0)
    RT_LOADW(0, 0);
#pragma unroll
    for (int ks = 0; ks < 8; ++ks) {
        const int cb = ks & 1;
        if (ks + 1 < 8) RT_LOADW(ks + 1, cb ^ 1);
        f32x4 x0 = xa[ks][0], x1 = xa[ks][1];
        { const u32x4 dd = dda[ks];
          x0[0] += __uint_as_float(dd[0] << 16); x0[1] += __uint_as_float(dd[0] & 0xFFFF0000u); x0[2] += __uint_as_float(dd[1] << 16); x0[3] += __uint_as_float(dd[1] & 0xFFFF0000u);
          x1[0] += __uint_as_float(dd[2] << 16); x1[1] += __uint_as_float(dd[2] & 0xFFFF0000u); x1[2] += __uint_as_float(dd[3] << 16); x1[3] += __uint_as_float(dd[3] & 0xFFFF0000u); }
        const f32x4 g0 = gb[cb][0], g1 = gb[cb][1];
        float xg[8];
#pragma unroll
        for (int e = 0; e < 4; ++e) { xg[e] = x0[e] * g0[e]; xg[4 + e] = x1[e] * g1[e]; ssq += x0[e] * x0[e] + x1[e] * x1[e]; }
        u32x4 hi, lo;
#pragma unroll
        for (int e = 0; e < 4; ++e) {
            hi[e] = pack_bf16(xg[2 * e], xg[2 * e + 1]);
            lo[e] = pack_bf16(xg[2 * e] - __uint_as_float(hi[e] << 16), xg[2 * e + 1] - __uint_as_float(hi[e] & 0xFFFF0000u));
        }
        *(u32x4*)(hr + ks * 32) = hi;
        const bf16x8 ah = __builtin_bit_cast(bf16x8, hi), al = __builtin_bit_cast(bf16x8, lo);
#pragma unroll
        for (int nt = 0; nt < 3; ++nt) {
            acc[nt] = __builtin_amdgcn_mfma_f32_16x16x32_bf16(ah, bhb[cb][nt], acc[nt], 0, 0, 0);
            acc[nt] = __builtin_amdgcn_mfma_f32_16x16x32_bf16(al, bhb[cb][nt], acc[nt], 0, 0, 0);
            acc[nt] = __builtin_amdgcn_mfma_f32_16x16x32_bf16(ah, blb[cb][nt], acc[nt], 0, 0, 0);
        }
    }
#undef RT_LOADW
    ssq += __shfl_xor(ssq, 16); ssq += __shfl_xor(ssq, 32);
    __syncthreads();
    if (fq == 0) ssp[w4][fr] = ssq;
#pragma unroll
    for (int nt = 0; nt < 3; ++nt)
#pragma unroll
        for (int i = 0; i < 4; ++i) part[w4][4 * fq + i][nt * 16 + fr] = acc[nt][i];
    __syncthreads();
    if (tid < 16) {
        const int row = r0 + tid;
        const float rsv = rsqrtf((ssp[0][tid] + ssp[1][tid] + ssp[2][tid] + ssp[3][tid]) * (1.0f / D) + 1e-6f);
        rstd_out[row] = rsv;
        float l4[4];
#pragma unroll
        for (int j = 0; j < 4; ++j) l4[j] = (part[0][tid][j] + part[1][tid][j] + part[2][tid][j] + part[3][tid][j]) * rsv + b_rg[j];
        int gs = 0; float mx = l4[0];
#pragma unroll
        for (int j = 1; j < 4; ++j) if (l4[j] > mx) { mx = l4[j]; gs = j; }
        float den = 0.f;
#pragma unroll
        for (int j = 0; j < 4; ++j) den += __expf(l4[j] - mx);
        const float gpb = 1.f / den;
        float v0 = -3e38f, v1 = -3e38f; int i0 = 0, i1 = 0;
        for (int j = 0; j < 8; ++j) {
            const int c = 4 + gs * 8 + j;
            const float l = (part[0][tid][c] + part[1][tid][c] + part[2][tid][c] + part[3][tid][c]) * rsv + b_re[gs * 8 + j];
            if (l > v0) { v1 = v0; i1 = i0; v0 = l; i0 = j; }
            else if (l > v1) { v1 = l; i1 = j; }
        }
        const float e1 = __expf(v1 - v0);
        const int lr = (task & 1) * 16 + tid;
        dec_e[lr * 2] = gs * 8 + i0; dec_e[lr * 2 + 1] = gs * 8 + i1;
        dec_w[lr * 2] = gpb / (1.f + e1); dec_w[lr * 2 + 1] = gpb * e1 / (1.f + e1);
    }
}
__device__ __forceinline__ void router_append(int group, int* __restrict__ ltok, float* __restrict__ lw, int* __restrict__ cnt, char* smem) {
    int* dec_e = (int*)(smem + 14336); float* dec_w = (float*)(smem + 14336 + 512);
    int* hist = (int*)(smem + 14336 + 1024); int* base = hist + 32;
    const int tid = HB_TID;
    if (tid < 32) hist[tid] = 0;
    __syncthreads();
    int e = 0, lpos = 0;
    if (tid < 64) { e = dec_e[tid]; lpos = atomicAdd(&hist[e], 1); }
    __syncthreads();
    if (tid < 32) { const int hcount = hist[tid]; base[tid] = hcount ? atomicAdd(&cnt[tid * 64], hcount) : 0; }
    __syncthreads();
    if (tid < 64) { const int pos = e * 16384 + base[e] + lpos; ltok[pos] = (group * 32 + (tid >> 1)) * 2 + (tid & 1); lw[pos] = dec_w[tid]; }
    __syncthreads();
}

__device__ __forceinline__ void transpose_tile(const float* __restrict__ src, int ld_src, int N, bf16_t* __restrict__ dst, int ld_dst, int kt, int nt, char* smem) {
    float (*tl)[65] = (float (*)[65])smem;
    const int tid = HB_TID;
    const int c4 = (tid & 15) * 4, r0 = tid >> 4;
#pragma unroll
    for (int i = 0; i < 4; ++i) {
        const int k = r0 + 16 * i, n = nt * 64 + c4;
        float4 v = make_float4(0.f, 0.f, 0.f, 0.f);
        if (n < N) v = *(const float4*)(src + (size_t)(kt * 64 + k) * ld_src + n);
        tl[k][c4] = v.x; tl[k][c4 + 1] = v.y; tl[k][c4 + 2] = v.z; tl[k][c4 + 3] = v.w;
    }
    __syncthreads();
    const int kc = (tid & 7) * 8, n0 = tid >> 3;
#pragma unroll
    for (int i = 0; i < 2; ++i) {
        const int nl = n0 + 32 * i, n = nt * 64 + nl;
        if (n < N) {
            uint4 o;
            o.x = pack_bf16(tl[kc][nl], tl[kc + 1][nl]); o.y = pack_bf16(tl[kc + 2][nl], tl[kc + 3][nl]);
            o.z = pack_bf16(tl[kc + 4][nl], tl[kc + 5][nl]); o.w = pack_bf16(tl[kc + 6][nl], tl[kc + 7][nl]);
            *(uint4*)(dst + (size_t)n * ld_dst + kt * 64 + kc) = o;
        }
    }
    __syncthreads();
}

__device__ __forceinline__ void filler_pair(const Params& p, int pr, char* smem) {
    char* ws = p.ws;
    const int t = 2 * pr + HB_ID;
    if (t < 128) transpose_tile(p.w_ba, 1024, 1024, (bf16_t*)(ws + OFF_WAT), 512, t >> 4, t & 15, smem);
    else if (t < 256) { const int q = t - 128; transpose_tile(p.w_bb, 1024, 1024, (bf16_t*)(ws + OFF_WBT), 512, q >> 4, q & 15, smem); }
    else if (t < 512) { const int q = t - 256; transpose_tile(p.w_out, 1024, 1024, (bf16_t*)(ws + OFF_WOT), 1024, q >> 4, q & 15, smem); }
    else { const int q = t - 512, e = (q & 2047) >> 6, r = q & 63;
        if (q < 2048) transpose_tile(p.w_eg + (size_t)e * 1024 * 256, 256, 256, (bf16_t*)(ws + OFF_WGT) + (size_t)e * 256 * 1024, 1024, r >> 2, r & 3, smem);
        else transpose_tile(p.w_eu + (size_t)e * 1024 * 256, 256, 256, (bf16_t*)(ws + OFF_WUT) + (size_t)e * 256 * 1024, 1024, r >> 2, r & 3, smem); }
}
__device__ __forceinline__ void ph_filler(const Params& p, int lo, int hi, char* smem) {
    for (int i = lo; i < hi; ++i) { const int pr = (int)blockIdx.x + i * (int)gridDim.x; if (pr < 2304) filler_pair(p, pr, smem); }
}
__device__ __forceinline__ void ph_prep_experts(const Params& p, char* smem) {
    char* ws = p.ws;
    for (int t = HB_FIRST; t < 4096; t += HB_STEP) {
        const int e = (t & 2047) >> 6, r = t & 63;
        if (t < 2048) transpose_tile(p.w_eg + (size_t)e * 1024 * 256, 256, 256, (bf16_t*)(ws + OFF_WGT) + (size_t)e * 256 * 1024, 1024, r >> 2, r & 3, smem);
        else transpose_tile(p.w_eu + (size_t)e * 1024 * 256, 256, 256, (bf16_t*)(ws + OFF_WUT) + (size_t)e * 256 * 1024, 1024, r >> 2, r & 3, smem);
    }
}
struct MoeTab { int c, pr, pt; };
__device__ __forceinline__ MoeTab moe_tab(const int* __restrict__ cnt) {
    int l_ = threadIdx.x; asm volatile("" : "+v"(l_));
    const int el = l_ & 31;
    MoeTab t; t.c = cnt[el * 64]; t.pr = t.c; t.pt = (t.c + 127) >> 7;
#pragma unroll
    for (int o = 1; o < 32; o <<= 1) {
        const int a = __shfl_up(t.pr, o, 32), b = __shfl_up(t.pt, o, 32);
        if (el >= o) { t.pr += a; t.pt += b; }
    }
    return t;
}
__device__ __forceinline__ int moe_ntiles(const MoeTab& t) { return __builtin_amdgcn_readlane(t.pt, 31); }
__device__ __forceinline__ void moe_decode(const MoeTab& t, int tile, int& e, int& ti, int& ebase, int& ne) {
    const unsigned long long m = __builtin_amdgcn_ballot_w64(t.pt <= tile);
    e = __builtin_popcount((unsigned)m);
    e = e > 31 ? 31 : e;
    const int em = e > 0 ? e - 1 : 0;
    const int ptm = __builtin_amdgcn_readlane(t.pt, em), prm = __builtin_amdgcn_readlane(t.pr, em);
    ti = tile - (e > 0 ? ptm : 0); ebase = e > 0 ? prm : 0; ne = __builtin_amdgcn_readlane(t.c, e);
}
__device__ __forceinline__ void moe_expert(const MoeTab& t, int e, int& ebase, int& ne) {
    const int em = e > 0 ? e - 1 : 0;
    const int prm = __builtin_amdgcn_readlane(t.pr, em);
    ebase = e > 0 ? prm : 0; ne = __builtin_amdgcn_readlane(t.c, e);
}
struct MoeMap { int lo, hi, j, nj, x; };
__device__ __forceinline__ MoeMap moe_map(int nbu) {
    MoeMap m; const int G = gridDim.x;
    if ((G & 7) == 0) {
        m.x = (int)blockIdx.x & 7; m.j = (int)blockIdx.x >> 3; m.nj = G >> 3;
        m.lo = (m.x * nbu) >> 3; m.hi = (m.x == 7) ? nbu : (((m.x + 1) * nbu) >> 3);
    } else { m.x = -1; m.j = (int)blockIdx.x; m.nj = G; m.lo = 0; m.hi = nbu; }
    return m;
}
__device__ __forceinline__ void ph_prep_experts_down(const Params& p, const int* __restrict__ cnt, char* smem) {
    char* ws = p.ws;
    const MoeTab mt = moe_tab(cnt); const int nbu = moe_ntiles(mt) * 2;
    const MoeMap mm = moe_map(nbu);
    const int L = mm.hi - mm.lo;
    int rem = L % mm.nj; if (mm.nj - rem < mm.nj / 2) rem = 0;
    const int k = 2 * (mm.j - rem) + HB_ID, st = 2 * (mm.nj - rem);
    if (mm.j < rem) return;
    const int t0 = mm.x < 0 ? 0 : mm.x * 256, t1 = mm.x < 0 ? 2048 : t0 + 256;
    for (int t = t0 + k; t < t1; t += st) {
        const int e = t >> 6, r = t & 63;
        transpose_tile(p.w_ed + (size_t)e * 256 * 1024, 1024, 1024, (bf16_t*)(ws + OFF_WDT) + (size_t)e * 1024 * 256, 256, r >> 4, r & 15, smem);
    }
}
__device__ __forceinline__ void ph_prep(const Params& p, char* smem) {
    char* ws = p.ws;
    constexpr int N0 = 16 * 77, N1 = N0 + 64, N2 = N1 + 64, N3 = N2 + 2, N4 = N3 + 2, N5 = N4 + 128, N6 = N5 + 128, N7 = N6 + 256;
    for (int t = HB_FIRST; t < N4; t += HB_STEP) {
        if (t < N0) transpose_tile(p.w_in, NIN, NIN, (bf16_t*)(ws + OFF_WINT), 1024, t / 77, t % 77, smem);
        else if (t < N1) { const int q = t - N0; transpose_tile(p.ck1, 128, 128, (bf16_t*)(ws + OFF_CK1T), 2048, q >> 1, q & 1, smem); }
        else if (t < N2) { const int q = t - N1; transpose_tile(p.cv1, 128, 128, (bf16_t*)(ws + OFF_CV1T), 2048, q >> 1, q & 1, smem); }
        else if (t < N3) { const int q = t - N2; transpose_tile(p.ck2, 64, 64, (bf16_t*)(ws + OFF_CK2T), 128, q, 0, smem); }
        else { const int q = t - N3; transpose_tile(p.cv2, 64, 64, (bf16_t*)(ws + OFF_CV2T), 128, q, 0, smem); }
    }
    for (int t = HB_FIRST; t < 64; t += HB_STEP) {
        const int htid = HB_TID, which = t >> 5, kq = (t >> 2) & 7, n = (t & 3) * 32 + (htid & 31), ksp = htid >> 5;
        const float* pe = which ? p.pe_v : p.pe_k; const float* w1 = which ? p.cv1 : p.ck1;
        float a = 0.f;
#pragma unroll 8
        for (int k = kq * 256 + ksp * 32; k < kq * 256 + ksp * 32 + 32; ++k) a += pe[k] * w1[(size_t)k * 128 + n];
        float* red = (float*)smem;
        red[htid] = a;
        __syncthreads();
        if (htid < 32) {
            float s = 0.f;
#pragma unroll
            for (int j = 0; j < 8; ++j) s += red[j * 32 + htid];
            ((float*)(ws + OFF_BIAS1))[(which * 8 + kq) * 128 + n] = s;
        }
        __syncthreads();
    }
    prep_router_w(p.w_rg, p.w_re, (bf16_t*)(ws + OFF_WRT));
    for (int row = blockIdx.x * 8 + (threadIdx.x >> 6); row < T; row += gridDim.x * 8) rms_h_row(row, p.x, p.g_mix, (bf16_t*)p.out, threadIdx.x & 63);
}

__device__ __forceinline__ int tile_off(int row, int chunk) { return row * 128 + ((chunk ^ (row & 7)) << 4); }

__device__ __forceinline__ void glds16(const void* g, char* l) {
    __builtin_amdgcn_global_load_lds((const __attribute__((address_space(1))) unsigned*)g, (__attribute__((address_space(3))) unsigned*)l, 16, 0, 0);
}
__device__ __forceinline__ void gemm_kloop(f32x4 (&acc)[4][4], const bf16_t* const (&pa)[4], const bf16_t* const (&pb)[4], int ka, int kb, int nk, char* smem) {
    int tid_ = HB_TID; asm volatile("" : "+v"(tid_));
    const int tid = tid_, lane = tid & 63, wid = tid >> 6, wr = wid >> 1, wc = wid & 1, fr = lane & 15, fq = lane >> 4;
    const int offA = (wr * 64 + fr) * 128, offB = 16384 + (wc * 64 + fr) * 128, x = fr & 7;
    __syncthreads();
#pragma unroll
    for (int i = 0; i < 4; ++i) { glds16(pa[i], smem + i * 4096 + tid * 16); glds16(pb[i], smem + 16384 + i * 4096 + tid * 16); }
    asm volatile("s_waitcnt vmcnt(0)" ::: "memory");
    __syncthreads();
    for (int kt = 0; kt < nk; ++kt) {
        const int cur = kt & 1;
        if (kt + 1 < nk) {
            char* st = smem + (cur ^ 1) * 32768 + tid * 16;
#pragma unroll
            for (int i = 0; i < 4; ++i) { glds16(pa[i] + (size_t)(kt + 1) * ka, st + i * 4096); glds16(pb[i] + (size_t)(kt + 1) * kb, st + 16384 + i * 4096); }
        }
        const char* sa = smem + cur * 32768 + offA;
        const char* sb = smem + cur * 32768 + offB;
#pragma unroll
        for (int ks = 0; ks < 2; ++ks) {
            const int ch = ((ks * 4 + fq) ^ x) << 4;
            bf16x8 af[4], bfr[4];
#pragma unroll
            for (int mi = 0; mi < 4; ++mi) af[mi] = *(const bf16x8*)(sa + mi * 2048 + ch);
#pragma unroll
            for (int ni = 0; ni < 4; ++ni) bfr[ni] = *(const bf16x8*)(sb + ni * 2048 + ch);
#pragma unroll
            for (int mi = 0; mi < 4; ++mi)
#pragma unroll
                for (int ni = 0; ni < 4; ++ni) acc[mi][ni] = __builtin_amdgcn_mfma_f32_16x16x32_bf16(bfr[ni], af[mi], acc[mi][ni], 0, 0, 0);
        }
        asm volatile("s_waitcnt vmcnt(0)" ::: "memory");
        __syncthreads();
    }
}
__device__ __forceinline__ void acc_zero(f32x4 (&acc)[4][4]) {
#pragma unroll
    for (int mi = 0; mi < 4; ++mi)
#pragma unroll
        for (int ni = 0; ni < 4; ++ni) acc[mi][ni] = (f32x4){0.f, 0.f, 0.f, 0.f};
}
#define GEMM_LANE_VARS const int tid = HB_TID, lane = tid & 63, wid = tid >> 6, wr = wid >> 1, wc = wid & 1, fr = lane & 15, fq = lane >> 4, lrow = tid >> 3, lch8 = ((tid & 7) ^ ((tid >> 3) & 7)) * 8; (void)wr; (void)wc; (void)fr; (void)fq; (void)lrow; (void)lch8;
__device__ __forceinline__ uint2 pack4(f32x4 v) { uint2 o; o.x = pack_bf16(v[0], v[1]); o.y = pack_bf16(v[2], v[3]); return o; }
__device__ __forceinline__ float sigmoidf_(float a) { return __builtin_amdgcn_rcpf(1.f + __expf(-a)); }

__device__ __forceinline__ void ph_cmp1(const bf16_t* __restrict__ proj, const char* ws, float* __restrict__ part, char* smem) {
    GEMM_LANE_VARS
    for (int u = HB_FIRST; u < 64; u += HB_STEP) {
        const int kq = u & 1, which = (u >> 1) >> 4, tm = (u >> 1) & 15;
        const bf16_t* W1T = (const bf16_t*)(ws + (which ? OFF_CV1T : OFF_CK1T));
        const int col0 = which ? VC : KC;
        const bf16_t* pa[4]; const bf16_t* pb[4];
#pragma unroll
        for (int i = 0; i < 4; ++i) {
            const int m = tm * 128 + lrow + 32 * i, bg = m >> 8, c = (m & 255) > 254 ? 254 : (m & 255), b = bg >> 1, g = bg & 1;
            pa[i] = proj + (size_t)(b * S + 16 * c + 16 * kq) * PP + col0 + g * 64 + lch8;
            pb[i] = W1T + (size_t)(lrow + 32 * i) * 2048 + kq * 1024 + lch8;
        }
        f32x4 acc[4][4]; acc_zero(acc);
        gemm_kloop(acc, pa, pb, PP, 64, 16, smem);
        float* pt = part + ((size_t)(kq * 2 + which) * 2048) * 128;
#pragma unroll
        for (int mi = 0; mi < 4; ++mi)
#pragma unroll
            for (int ni = 0; ni < 4; ++ni) {
                const int m = tm * 128 + wr * 64 + mi * 16 + fr, n = wc * 64 + ni * 16 + 4 * fq;
                *(f32x4*)(pt + (size_t)m * 128 + n) = acc[mi][ni];
            }
    }
}
__device__ __forceinline__ void ph_cmp2(const char* ws_c, char* ws, const float* __restrict__ part, char* smem) {
    GEMM_LANE_VARS
    for (int u = HB_FIRST; u < 32; u += HB_STEP) {
        const int which = u >> 4, tm = u & 15;
        const bf16_t* W2T = (const bf16_t*)(ws_c + (which ? OFF_CV2T : OFF_CK2T));
        const bf16_t* hid = (const bf16_t*)(ws_c + OFF_HIDC) + (size_t)which * 2048 * 128;
        {
            const float* bias1 = (const float*)(ws_c + OFF_BIAS1) + which * 8 * 128;
            bf16_t* hw = (bf16_t*)(ws + OFF_HIDC) + (size_t)which * 2048 * 128;
            const int n4 = (tid & 31) * 4;
            float bs[4];
#pragma unroll
            for (int j = 0; j < 4; ++j) { float b_ = 0.f;
#pragma unroll
                for (int q8 = 0; q8 < 8; ++q8) b_ += bias1[q8 * 128 + n4 + j];
                bs[j] = b_; }
#pragma unroll 4
            for (int r = tid >> 5; r < 128; r += 8) {
                const size_t off = (size_t)(tm * 128 + r) * 128 + n4;
                f32x4 v = *(const f32x4*)(part + ((size_t)(0 * 2 + which) * 2048) * 128 + off);
#pragma unroll
                for (int kq = 1; kq < 2; ++kq) { const f32x4 w_ = *(const f32x4*)(part + ((size_t)(kq * 2 + which) * 2048) * 128 + off); v[0] += w_[0]; v[1] += w_[1]; v[2] += w_[2]; v[3] += w_[3]; }
#pragma unroll
                for (int j = 0; j < 4; ++j) { const float a = v[j] + bs[j]; const float t = 0.7978845608028654f * (a + 0.044715f * a * a * a); v[j] = a * __builtin_amdgcn_rcpf(1.f + __expf(-2.f * t)); }
                *(uint2*)(hw + off) = pack4(v);
            }
            asm volatile("s_waitcnt vmcnt(0)" ::: "memory");
            __syncthreads();
        }
        const bf16_t* pa[4]; const bf16_t* pb[4];
#pragma unroll
        for (int i = 0; i < 4; ++i) { pa[i] = hid + (size_t)(tm * 128 + lrow + 32 * i) * 128 + lch8; pb[i] = W2T + (size_t)(lrow + 32 * i) * 128 + lch8; }
        f32x4 acc[4][4]; acc_zero(acc);
        gemm_kloop(acc, pa, pb, 64, 64, 2, smem);
        if (wc == 0) {
            bf16_t* outp = (bf16_t*)(ws + (which ? OFF_VCB : OFF_KCB));
            bf16_t* outT = (bf16_t*)(ws + OFF_VCBT);
#pragma unroll
            for (int mi = 0; mi < 4; ++mi)
#pragma unroll
                for (int ni = 0; ni < 4; ++ni) {
                    const int m = tm * 128 + wr * 64 + mi * 16 + fr, n = ni * 16 + 4 * fq, c = m & 255, bg = m >> 8;
                    f32x4 v = acc[mi][ni];
                    if (c == 255) v = (f32x4){0.f, 0.f, 0.f, 0.f};
                    *(uint2*)(outp + (size_t)m * 64 + n) = pack4(v);
                    if (which) {
#pragma unroll
                        for (int j = 0; j < 4; ++j) outT[((size_t)bg * 64 + n + j) * 256 + c] = f2bf(v[j]);
                    }
                }
        }
    }
}


__device__ __forceinline__ void ph_moe1(const bf16_t* __restrict__ h2, const bf16_t* __restrict__ WgT, const bf16_t* __restrict__ WuT, const int* __restrict__ cnt,
                                        const int* __restrict__ ltok, const float* __restrict__ lw, const float* __restrict__ rstd, bf16_t* __restrict__ hid, char* smemB) {
    GEMM_LANE_VARS
    int bt_ = threadIdx.x; asm volatile("" : "+v"(bt_));
    const int btid = bt_, hb = btid >> 8;
    const int arow = btid >> 3, ach8 = ((btid & 7) ^ (arow & 7)) * 8;
    const MoeTab mt = moe_tab(cnt);
    const int nbu = moe_ntiles(mt) * 2;
    const MoeMap mm = moe_map(nbu);
    const int offA = (wr * 64 + fr) * 128, offB = 16384 + hb * 16384 + (wc * 64 + fr) * 128, x = fr & 7;
    for (int bu = mm.lo + mm.j; bu < mm.hi; bu += mm.nj) {
        const int ft = (bu & 1) * 2 + hb;
        int e, ti, ebase, ne;
        moe_decode(mt, bu >> 1, e, ti, ebase, ne);
        const bf16_t* pa[2]; const bf16_t* pb[4];
#pragma unroll
        for (int i = 0; i < 2; ++i) {
            const int idx = ti * 128 + arow + 64 * i;
            const int tk = idx < ne ? ltok[e * 16384 + idx] : 0;
            pa[i] = h2 + (size_t)(tk >> 1) * 1024 + ach8;
        }
#pragma unroll
        for (int i = 0; i < 4; ++i) {
            const int rr = lrow + 32 * i;
            const int bwc = rr >> 6, bni = (rr >> 4) & 3, bj = rr & 15;
            const int f = ft * 64 + bwc * 32 + (bni >> 1) * 16 + bj;
            pb[i] = ((bni & 1) ? WuT : WgT) + ((size_t)e * 256 + f) * 1024 + lch8;
        }
        f32x4 acc[4][4]; acc_zero(acc);
        {
#define M1_ISSUE(kt_, st_) do { char* d_ = smemB + (st_) * 49152; \
            glds16(pa[0] + (size_t)(kt_) * 64, d_ + btid * 16); glds16(pa[1] + (size_t)(kt_) * 64, d_ + 8192 + btid * 16); \
            _Pragma("unroll") for (int i = 0; i < 4; ++i) glds16(pb[i] + (size_t)(kt_) * 64, d_ + 16384 + hb * 16384 + i * 4096 + tid * 16); } while (0)
            __syncthreads();
            M1_ISSUE(0, 0);
            asm volatile("s_waitcnt vmcnt(0)" ::: "memory");
            __syncthreads();
            for (int kt = 0; kt < 16; ++kt) {
                const int cur = kt & 1;
                if (kt + 1 < 16) M1_ISSUE(kt + 1, cur ^ 1);
                const char* sa = smemB + cur * 49152 + offA;
                const char* sb = smemB + cur * 49152 + offB;
#pragma unroll
                for (int ks = 0; ks < 2; ++ks) {
                    const int ch = ((ks * 4 + fq) ^ x) << 4;
                    bf16x8 af[4], bfr[4];
#pragma unroll
                    for (int mi = 0; mi < 4; ++mi) af[mi] = *(const bf16x8*)(sa + mi * 2048 + ch);
#pragma unroll
                    for (int ni = 0; ni < 4; ++ni) bfr[ni] = *(const bf16x8*)(sb + ni * 2048 + ch);
#pragma unroll
                    for (int mi = 0; mi < 4; ++mi)
#pragma unroll
                        for (int ni = 0; ni < 4; ++ni) acc[mi][ni] = __builtin_amdgcn_mfma_f32_16x16x32_bf16(bfr[ni], af[mi], acc[mi][ni], 0, 0, 0);
                }
                asm volatile("s_waitcnt vmcnt(0)" ::: "memory");
                __syncthreads();
            }
#undef M1_ISSUE
        }
#pragma unroll
        for (int mi = 0; mi < 4; ++mi) {
            const int idx = ti * 128 + wr * 64 + mi * 16 + fr;
            if (idx < ne) {
                const int tk = ltok[e * 16384 + idx];
                const float w = lw[e * 16384 + idx], rsv = rstd[tk >> 1];
#pragma unroll
                for (int q = 0; q < 2; ++q) {
                    const int f = ft * 64 + wc * 32 + q * 16 + 4 * fq;
                    f32x4 v;
#pragma unroll
                    for (int j = 0; j < 4; ++j) { const float a = acc[mi][2 * q][j] * rsv, uu = acc[mi][2 * q + 1][j] * rsv; v[j] = a * sigmoidf_(a) * uu * w; }
                    *(uint2*)(hid + (size_t)(ebase + idx) * 256 + f) = pack4(v);
                }
            }
        }
    }
}

constexpr int M2_SLOT = 32768, M2_TOK = 3 * M2_SLOT;
__device__ __forceinline__ void ph_moe2w(const bf16_t* __restrict__ hid, const bf16_t* __restrict__ WdT, const int* __restrict__ cnt, const int* __restrict__ ltok,
                                         bf16_t* __restrict__ Y, char* dummy, char* smem) {
    int t_ = threadIdx.x; asm volatile("" : "+v"(t_));
    const int tid = t_, lane = tid & 63, wid = tid >> 6, fr = lane & 15, fq = lane >> 4, wm = wid >> 2, wn = wid & 3;
    const MoeTab mt = moe_tab(cnt);
    for (int v = blockIdx.x; v < 256; v += gridDim.x) {
        const int u = (v & 7) * 32 + (v >> 3);
        const int e = u >> 3, nt = u & 7;
        int ebase, ne; moe_expert(mt, e, ebase, ne);
        const int ntile = (ne + 127) >> 7, NS = 2 * ntile;
        if (NS == 0) continue;
        bf16x8 bw[2][8];
#pragma unroll
        for (int nf = 0; nf < 2; ++nf)
#pragma unroll
            for (int kf = 0; kf < 8; ++kf) bw[nf][kf] = *(const bf16x8*)(WdT + ((size_t)e * 1024 + nt * 128 + wn * 32 + nf * 16 + fr) * 256 + kf * 32 + fq * 8);
        const int lr = tid >> 4, lc8 = ((tid & 15) ^ (lr & 15)) * 8;
        const bf16_t* asrc = hid + (size_t)(ebase + lr) * 256 + lc8;
        const int* tsrc = ltok + e * 16384 + 4 * lane;
        {
            const char* pb = (const char*)(hid + (size_t)ebase * 256) + (size_t)nt * ne * 64;
            for (int off = tid * 128; off < ne * 64; off += 512 * 128) { unsigned dmy; asm volatile("global_load_dword %0, %1, off" : "=v"(dmy) : "v"(pb + off) : "memory"); }
        }
        __syncthreads();
#define M2_ISSUE(s_, slot_) do { const bf16_t* g_ = asrc + (size_t)((s_) >> 1) * 128 * 256 + ((s_) & 1) * 128; char* d_ = smem + (slot_) * M2_SLOT + tid * 16; \
            glds16(g_, d_); glds16(g_ + 32 * 256, d_ + 8192); glds16(g_ + 64 * 256, d_ + 16384); glds16(g_ + 96 * 256, d_ + 24576); \
            if (((s_) & 1) == 0) glds16(tsrc + ((s_) >> 1) * 128, smem + M2_TOK + (((s_) >> 1) & 1) * 1024 + lane * 16); } while (0)
#define M2_WAIT(n_) do { if ((n_) == 13) asm volatile("s_waitcnt vmcnt(13)" ::: "memory"); else if ((n_) == 12) asm volatile("s_waitcnt vmcnt(12)" ::: "memory"); \
            else if ((n_) == 8) asm volatile("s_waitcnt vmcnt(8)" ::: "memory"); else if ((n_) == 5) asm volatile("s_waitcnt vmcnt(5)" ::: "memory"); \
            else if ((n_) == 4) asm volatile("s_waitcnt vmcnt(4)" ::: "memory"); else asm volatile("s_waitcnt vmcnt(0)" ::: "memory"); \
            asm volatile("s_waitcnt lgkmcnt(0)" ::: "memory"); __builtin_amdgcn_s_barrier(); asm volatile("" ::: "memory"); } while (0)
#define M2_COMPUTE(kh_, slot_) do { const char* st_ = smem + (slot_) * M2_SLOT; \
            _Pragma("unroll") for (int kf = 0; kf < 4; ++kf) { bf16x8 a_[4]; \
                _Pragma("unroll") for (int mf = 0; mf < 4; ++mf) a_[mf] = *(const bf16x8*)(st_ + (64 * wm + 16 * mf + fr) * 256 + (((kf * 4 + fq) ^ fr) << 4)); \
                _Pragma("unroll") for (int mf = 0; mf < 4; ++mf) { \
                    acc[mf][0] = __builtin_amdgcn_mfma_f32_16x16x32_bf16(bw[0][(kh_) * 4 + kf], a_[mf], acc[mf][0], 0, 0, 0); \
                    acc[mf][1] = __builtin_amdgcn_mfma_f32_16x16x32_bf16(bw[1][(kh_) * 4 + kf], a_[mf], acc[mf][1], 0, 0, 0); } } } while (0)
        M2_ISSUE(0, 0); M2_ISSUE(1, 1);
        f32x4 acc[4][2];
#pragma unroll
        for (int mf = 0; mf < 4; ++mf) { acc[mf][0] = (f32x4){0.f, 0.f, 0.f, 0.f}; acc[mf][1] = (f32x4){0.f, 0.f, 0.f, 0.f}; }
        int s0 = 0;
        for (int rt = 0; rt < ntile; ++rt) {
            const int s1 = (s0 == 2) ? 0 : s0 + 1, s2 = (s1 == 2) ? 0 : s1 + 1;
            { const int n = (rt == 0) ? 4 : 12; M2_WAIT(n); }
            if (rt + 1 < ntile) M2_ISSUE(2 * rt + 2, s2);
            M2_COMPUTE(0, s0);
            { const int n = (rt == 0) ? ((ntile > 1) ? 5 : 0) : ((rt + 1 < ntile) ? 13 : 8); M2_WAIT(n); }
            if (rt + 1 < ntile) M2_ISSUE(2 * rt + 3, s0);
            M2_COMPUTE(1, s1);
            const int* tl = (const int*)(smem + M2_TOK + (rt & 1) * 1024);
#pragma unroll
            for (int mf = 0; mf < 4; ++mf) {
                const int rl = 64 * wm + 16 * mf + fr, idx = rt * 128 + rl;
                const int tk = tl[rl];
                if (idx < ne) {
                    bf16_t* yr = Y + ((size_t)(tk & 1) * T + (size_t)(tk >> 1)) * 1024 + nt * 128 + wn * 32 + 4 * fq;
#pragma unroll
                    for (int nf = 0; nf < 2; ++nf) *(uint2*)(yr + nf * 16) = pack4(acc[mf][nf]);
                }
                acc[mf][0] = (f32x4){0.f, 0.f, 0.f, 0.f}; acc[mf][1] = (f32x4){0.f, 0.f, 0.f, 0.f};
            }
            s0 = s2;
        }
#undef M2_ISSUE
#undef M2_WAIT
#undef M2_COMPUTE
        asm volatile("s_waitcnt vmcnt(0)" ::: "memory");
    }
}

__device__ __forceinline__ void ph_moe2(const bf16_t* __restrict__ hid, const bf16_t* __restrict__ WdT, const int* __restrict__ cnt, const int* __restrict__ ltok,
                                        bf16_t* __restrict__ Y, char* smem) {
    GEMM_LANE_VARS
    const MoeTab mt = moe_tab(cnt);
    const int nu = moe_ntiles(mt) * 8;
    for (int u = HB_FIRST; u < nu; u += HB_STEP) {
        const int tn = u & 7;
        int e, ti, ebase, ne; moe_decode(mt, u >> 3, e, ti, ebase, ne); (void)ebase;
        const bf16_t* pa[4]; const bf16_t* pb[4];
#pragma unroll
        for (int i = 0; i < 4; ++i) {
            const int idx = ti * 128 + lrow + 32 * i;
            const int tk = idx < ne ? ltok[e * 16384 + idx] : 0;
            pa[i] = hid + (size_t)tk * 256 + lch8;
            pb[i] = WdT + ((size_t)e * 1024 + tn * 128 + lrow + 32 * i) * 256 + lch8;
        }
        f32x4 acc[4][4]; acc_zero(acc);
        gemm_kloop(acc, pa, pb, 64, 64, 4, smem);
#pragma unroll
        for (int mi = 0; mi < 4; ++mi) {
            const int idx = ti * 128 + wr * 64 + mi * 16 + fr;
            if (idx < ne) {
                const int tk = ltok[e * 16384 + idx];
                bf16_t* yr = Y + ((size_t)(tk & 1) * T + (size_t)(tk >> 1)) * 1024 + tn * 128 + wc * 64 + 4 * fq;
#pragma unroll
                for (int ni = 0; ni < 4; ++ni) *(uint2*)(yr + ni * 16) = pack4(acc[mi][ni]);
            }
        }
    }
}

namespace g8 {
constexpr int HTB = 128 * 64 * 2;
__device__ __forceinline__ int lds_byte(int r, int c) { const int st = (r >> 4) * 2 + (c >> 5), rr = r & 15, cc = c & 31, ob = rr * 64 + cc * 2; return st * 1024 + (ob ^ (((ob >> 9) & 1) << 5)); }
__device__ __forceinline__ void stage_rc(int b, int& R, int& C) { const int st = b / 1024, sb = b % 1024, swz = sb ^ (((sb >> 9) & 1) << 5); R = (st >> 1) * 16 + swz / 64; C = (st & 1) * 32 + (swz % 64) / 2; }
__device__ __forceinline__ int perm32(int rho) { const int n = rho >> 4, i = rho & 15; return 8 * (i >> 2) + 4 * n + (i & 3); }
struct Unit { int pm, pn, e; };
struct StaticOrder {
    int nM, nN, nwg, G, c;
    __device__ __forceinline__ void init(int M, int N, int G_, int c_) { nM = M / 256; nN = N / 256; nwg = nM * nN; G = G_; c = c_; }
    __device__ __forceinline__ bool next(int i, Unit& u) const {
        const long L = (long)i * G + c; if (L >= nwg) return false;
        int wgid = (int)L; { const int q = nwg / 8, r = nwg % 8, xcd = wgid % 8, off = wgid / 8; wgid = (xcd < r ? xcd * (q + 1) : r * (q + 1) + (xcd - r) * q) + off; }
        const int nig = 8 * nN, gid = wgid / nig, fm = gid * 8, gsz = (nM - fm) < 8 ? (nM - fm) : 8;
        u.pm = fm + ((wgid % nig) % gsz); u.pn = (wgid % nig) / gsz; u.e = 0; return true;
    }
    __device__ __forceinline__ void a_ready(const Unit&, int) const {}
};
struct AddrPlain {
    const char* A; const char* Bt; unsigned lda2, ldb2; int ntiles;
    __device__ __forceinline__ const char* a_base(const Unit&) const { return A; }
    __device__ __forceinline__ const char* b_base(const Unit&) const { return Bt; }
    __device__ __forceinline__ int nt(const Unit&) const { return ntiles; }
    __device__ __forceinline__ int a_row0(const Unit& u) const { return u.pm * 256; }
    __device__ __forceinline__ int b_row0(const Unit& u) const { return u.pn * 256; }
    __device__ __forceinline__ unsigned a_ld(const Unit&) const { return lda2; }
    __device__ __forceinline__ unsigned b_ld(const Unit&) const { return ldb2; }
};

template <class Epi, class Sched, class Addr>
__device__ __forceinline__ void gemm_phase(char* ldsc, const Sched& S, const Addr& AD, const Epi& E) {
    __attribute__((address_space(3))) unsigned char* lds = (__attribute__((address_space(3))) unsigned char*)ldsc;
    int tid_ = threadIdx.x; asm volatile("" : "+v"(tid_));
    const int tid = tid_, wid = __builtin_amdgcn_readfirstlane(tid >> 6), lane = tid & 63, wr = wid >> 2, wc = wid & 3, fr = lane & 15, fq = lane >> 4;
    int R[2], C2[2], Rb[2];
#pragma unroll
    for (int i = 0; i < 2; ++i) { int r_, c_; stage_rc(tid * 16 + i * 8192, r_, c_); R[i] = r_; C2[i] = c_ * 2; Rb[i] = Epi::PERM ? ((r_ & ~31) + perm32(r_ & 31)) : r_; }
    const unsigned ldsw = (unsigned)wid * 1024u;
    const int aoff = lds_byte(wr * 64 + fr, fq * 8), boff = lds_byte(wc * 32 + fr, fq * 8);
#define G8_SA(b, h) (((b) * 2 + (h)) * HTB)
#define G8_SB(b, h) ((4 + (b) * 2 + (h)) * HTB)
#define G8_STAGE(bufoff, base, rowv, row0, ld, h, kb) do { _Pragma("unroll") for (int _i = 0; _i < 2; ++_i) \
        __builtin_amdgcn_global_load_lds((const __attribute__((address_space(1))) unsigned*)((base) + (size_t)((unsigned)((row0) + (h) * 128 + (rowv)[_i]) * (ld) + (unsigned)C2[_i] + (unsigned)(kb))), \
                                         (__attribute__((address_space(3))) unsigned*)(lds + (bufoff) + ldsw + _i * 8192), 16, 0, 0); } while (0)
#define G8_LDA(dst, b, h) do { _Pragma("unroll") for (int m = 0; m < 4; ++m) _Pragma("unroll") for (int k = 0; k < 2; ++k) dst[m][k] = *(const __attribute__((address_space(3))) bf16x8*)(lds + G8_SA(b, h) + aoff + m * 2048 + k * 1024); } while (0)
#define G8_LDB(dst, b, h) do { _Pragma("unroll") for (int n = 0; n < 2; ++n) _Pragma("unroll") for (int k = 0; k < 2; ++k) dst[n][k] = *(const __attribute__((address_space(3))) bf16x8*)(lds + G8_SB(b, h) + boff + n * 2048 + k * 1024); } while (0)
#define G8_MMA(ai, bj, At, Bt) do { __builtin_amdgcn_s_setprio(1); _Pragma("unroll") for (int m = 0; m < 4; ++m) _Pragma("unroll") for (int n = 0; n < 2; ++n) _Pragma("unroll") for (int k = 0; k < 2; ++k) \
        acc[ai][bj][m][n] = __builtin_amdgcn_mfma_f32_16x16x32_bf16(Bt[n][k], At[m][k], acc[ai][bj][m][n], 0, 0, 0); __builtin_amdgcn_s_setprio(0); } while (0)
#define G8_WAIT_V(n) asm volatile("s_waitcnt vmcnt(" #n ")" ::: "memory")
#define G8_WAIT_L(n) asm volatile("s_waitcnt lgkmcnt(" #n ")" ::: "memory")
#define G8_BAR __builtin_amdgcn_s_barrier()
#define G8_SCHED __builtin_amdgcn_sched_barrier(0)
    Unit cur, nxt; int ui = 0;
    if (!S.next(0, cur)) return;
    f32x4 acc[2][2][4][2];
#pragma unroll
    for (int a = 0; a < 2; ++a)
#pragma unroll
        for (int b = 0; b < 2; ++b)
#pragma unroll
            for (int m = 0; m < 4; ++m)
#pragma unroll
                for (int n = 0; n < 2; ++n) acc[a][b][m][n] = (f32x4){0.f, 0.f, 0.f, 0.f};
    bf16x8 At[4][2], B0[2][2], B1[2][2];
    const char* Ab = AD.a_base(cur); const char* Bb = AD.b_base(cur);
    int ar0 = AD.a_row0(cur), br0 = AD.b_row0(cur); unsigned ald = AD.a_ld(cur), bld = AD.b_ld(cur);
    __syncthreads();
    G8_STAGE(G8_SB(0, 0), Bb, Rb, br0, bld, 0, 0); G8_STAGE(G8_SA(0, 0), Ab, R, ar0, ald, 0, 0); G8_STAGE(G8_SB(0, 1), Bb, Rb, br0, bld, 1, 0); G8_STAGE(G8_SA(0, 1), Ab, R, ar0, ald, 1, 0);
    if (wr == 1) G8_BAR;
    G8_WAIT_V(4); G8_BAR;
    G8_STAGE(G8_SB(1, 0), Bb, Rb, br0, bld, 0, 128); G8_STAGE(G8_SA(1, 0), Ab, R, ar0, ald, 0, 128); G8_STAGE(G8_SB(1, 1), Bb, Rb, br0, bld, 1, 128);
    G8_WAIT_V(6); G8_BAR;
    for (;;) {
        const bool has_next = S.next(ui + 1, nxt);
        const int nt = AD.nt(cur);
        const char* nAb = has_next ? AD.a_base(nxt) : Ab; const char* nBb = has_next ? AD.b_base(nxt) : Bb;
        const int nar0 = has_next ? AD.a_row0(nxt) : ar0, nbr0 = has_next ? AD.b_row0(nxt) : br0;
        const unsigned nald = has_next ? AD.a_ld(nxt) : ald, nbld = has_next ? AD.b_ld(nxt) : bld;
        for (int t = 0; t < nt; t += 2) {
            const bool last = (t == nt - 2);
            if (last && has_next) S.a_ready(nxt, wid);
            const int kb1 = (t + 1) * 128, kb2 = last ? 0 : (t + 2) * 128, kb3 = kb2 + 128;
            const char* sAb = last ? nAb : Ab; const char* sBb = last ? nBb : Bb;
            const int sar0 = last ? nar0 : ar0, sbr0 = last ? nbr0 : br0; const unsigned sald = last ? nald : ald, sbld = last ? nbld : bld;
            G8_LDB(B0, 0, 0); G8_SCHED; G8_LDA(At, 0, 0); G8_STAGE(G8_SA(1, 1), Ab, R, ar0, ald, 1, kb1);
            G8_WAIT_L(8); G8_BAR; G8_WAIT_L(0); G8_MMA(0, 0, At, B0); G8_BAR; G8_SCHED;
            G8_LDB(B1, 0, 1); G8_STAGE(G8_SB(0, 0), sBb, Rb, sbr0, sbld, 0, kb2);
            G8_BAR; G8_WAIT_L(0); G8_MMA(0, 1, At, B1); G8_BAR;
            G8_LDA(At, 0, 1); G8_STAGE(G8_SA(0, 0), sAb, R, sar0, sald, 0, kb2);
            G8_BAR; G8_WAIT_L(0); G8_MMA(1, 0, At, B0); G8_BAR; G8_SCHED;
            G8_STAGE(G8_SB(0, 1), sBb, Rb, sbr0, sbld, 1, kb2);
            G8_WAIT_V(6); G8_BAR; G8_MMA(1, 1, At, B1); G8_BAR;
            G8_LDB(B0, 1, 0); G8_SCHED; G8_LDA(At, 1, 0); G8_STAGE(G8_SA(0, 1), sAb, R, sar0, sald, 1, kb2);
            G8_WAIT_L(8); G8_BAR; G8_WAIT_L(0); G8_MMA(0, 0, At, B0); G8_BAR; G8_SCHED;
            G8_LDB(B1, 1, 1); G8_STAGE(G8_SB(1, 0), sBb, Rb, sbr0, sbld, 0, kb3);
            G8_BAR; G8_WAIT_L(0); G8_MMA(0, 1, At, B1); G8_BAR;
            G8_LDA(At, 1, 1); G8_STAGE(G8_SA(1, 0), sAb, R, sar0, sald, 0, kb3);
            G8_BAR; G8_WAIT_L(0); G8_MMA(1, 0, At, B0); G8_BAR; G8_SCHED;
            G8_STAGE(G8_SB(1, 1), sBb, Rb, sbr0, sbld, 1, kb3);
            G8_WAIT_V(6); G8_BAR; G8_MMA(1, 1, At, B1); G8_BAR;
        }
        E(acc, cur, wr, wc, fr, fq);
        if (!has_next) break;
#pragma unroll
        for (int a = 0; a < 2; ++a)
#pragma unroll
            for (int b = 0; b < 2; ++b)
#pragma unroll
                for (int m = 0; m < 4; ++m)
#pragma unroll
                    for (int n = 0; n < 2; ++n) acc[a][b][m][n] = (f32x4){0.f, 0.f, 0.f, 0.f};
        cur = nxt; Ab = nAb; Bb = nBb; ar0 = nar0; br0 = nbr0; ald = nald; bld = nbld; ++ui;
    }
    G8_WAIT_V(0);
    if (wr == 0) G8_BAR;
    G8_BAR;
#undef G8_SA
#undef G8_SB
#undef G8_STAGE
#undef G8_LDA
#undef G8_LDB
#undef G8_MMA
#undef G8_WAIT_V
#undef G8_WAIT_L
#undef G8_BAR
#undef G8_SCHED
}

struct EpiProj {
    static constexpr bool PERM = true;
    bf16_t* proj;
    __device__ __forceinline__ void operator()(const f32x4 (&acc)[2][2][4][2], const Unit& u, int wr, int wc, int fr, int fq) const {
#pragma unroll
        for (int ai = 0; ai < 2; ++ai)
#pragma unroll
            for (int m = 0; m < 4; ++m) {
                const int r = u.pm * 256 + ai * 128 + wr * 64 + m * 16 + fr;
#pragma unroll
                for (int bj = 0; bj < 2; ++bj) {
                    const int c = u.pn * 256 + bj * 128 + wc * 32 + 8 * fq;
                    if (c < NPROJ) {
                        u32x4 w; w[0] = pack_bf16(acc[ai][bj][m][0][0], acc[ai][bj][m][0][1]); w[1] = pack_bf16(acc[ai][bj][m][0][2], acc[ai][bj][m][0][3]);
                        w[2] = pack_bf16(acc[ai][bj][m][1][0], acc[ai][bj][m][1][1]); w[3] = pack_bf16(acc[ai][bj][m][1][2], acc[ai][bj][m][1][3]);
                        *(u32x4*)(proj + (size_t)r * PP + c) = w;
                    }
                }
            }
    }
};
struct EpiDelta {
    static constexpr bool PERM = true;
    bf16_t* dl;
    __device__ __forceinline__ void operator()(const f32x4 (&acc)[2][2][4][2], const Unit& u, int wr, int wc, int fr, int fq) const {
#pragma unroll
        for (int ai = 0; ai < 2; ++ai)
#pragma unroll
            for (int m = 0; m < 4; ++m) {
                const int r = u.pm * 256 + ai * 128 + wr * 64 + m * 16 + fr;
#pragma unroll
                for (int bj = 0; bj < 2; ++bj) {
                    const int c = u.pn * 256 + bj * 128 + wc * 32 + 8 * fq;
                    u32x4 w; w[0] = pack_bf16(acc[ai][bj][m][0][0], acc[ai][bj][m][0][1]); w[1] = pack_bf16(acc[ai][bj][m][0][2], acc[ai][bj][m][0][3]);
                    w[2] = pack_bf16(acc[ai][bj][m][1][0], acc[ai][bj][m][1][1]); w[3] = pack_bf16(acc[ai][bj][m][1][2], acc[ai][bj][m][1][3]);
                    *(u32x4*)(dl + (size_t)r * 1024 + c) = w;
                }
            }
    }
};
struct OneUnit { Unit u; __device__ __forceinline__ bool next(int i, Unit& o) const { if (i) return false; o = u; return true; }
    __device__ __forceinline__ void a_ready(const Unit&, int) const {} };
template <int OP>
struct EpiMerge {
    static constexpr bool PERM = true;
    bf16_t* dst; const bf16_t* src2;
    __device__ __forceinline__ void operator()(const f32x4 (&acc)[2][2][4][2], const Unit& u, int wr, int wc, int fr, int fq) const {
#pragma unroll
        for (int ai = 0; ai < 2; ++ai)
#pragma unroll
            for (int m = 0; m < 4; ++m) {
                const int r = u.pm * 256 + ai * 128 + wr * 64 + m * 16 + fr;
#pragma unroll
                for (int bj = 0; bj < 2; ++bj) {
                    const size_t o = (size_t)r * 1024 + u.pn * 256 + bj * 128 + wc * 32 + 8 * fq;
                    float v[8];
#pragma unroll
                    for (int j = 0; j < 4; ++j) { v[j] = acc[ai][bj][m][0][j]; v[4 + j] = acc[ai][bj][m][1][j]; }
                    if (OP == 0) {
#pragma unroll
                        for (int j = 0; j < 8; ++j) v[j] = sigmoidf_(v[j]);
                    } else {
                        const u32x4 d = *(const u32x4*)(dst + o);
                        float dv[8];
#pragma unroll
                        for (int j = 0; j < 4; ++j) { dv[2 * j] = __uint_as_float(d[j] << 16); dv[2 * j + 1] = __uint_as_float(d[j] & 0xFFFF0000u); }
                        if (OP == 1) {
#pragma unroll
                            for (int j = 0; j < 8; ++j) v[j] = dv[j] * v[j];
                        } else {
                            const u32x4 s = *(const u32x4*)(src2 + o);
#pragma unroll
                            for (int j = 0; j < 4; ++j) { v[2 * j] = dv[2 * j] + __uint_as_float(s[j] << 16) * v[2 * j]; v[2 * j + 1] = dv[2 * j + 1] + __uint_as_float(s[j] & 0xFFFF0000u) * v[2 * j + 1]; }
                        }
                    }
                    u32x4 w; w[0] = pack_bf16(v[0], v[1]); w[1] = pack_bf16(v[2], v[3]); w[2] = pack_bf16(v[4], v[5]); w[3] = pack_bf16(v[6], v[7]);
                    *(u32x4*)(dst + o) = w;
                }
            }
    }
};
struct MergeOrder {
    StaticOrder so; unsigned* bar; volatile __attribute__((address_space(3))) unsigned* st;
    __device__ __forceinline__ bool next(int i, Unit& u) const { if (!so.next(i >> 2, u)) return false; u.e = i & 3; return true; }
    __device__ __forceinline__ void a_ready(const Unit& u, int wid) const {
        if (u.e != 1) return;
        if (wid == 0) {
            const unsigned gen = st[2];
            XB_SPIN(xb_ld(&bar[XB2_TOPGEN]) <= gen, bar);
            __builtin_amdgcn_fence(__ATOMIC_ACQUIRE, "agent");
            asm volatile("s_waitcnt vmcnt(0)" ::: "memory");
        }
        __builtin_amdgcn_s_barrier();
    }
};
struct AddrMerge {
    const char* h; const char* WinT; const char* ya; const char* yb; const char* WaT; const char* WbT;
    __device__ __forceinline__ const char* a_base(const Unit& u) const {
        const unsigned long long ph = (unsigned long long)h, pa = (unsigned long long)ya, pb = (unsigned long long)yb, o = (unsigned long long)(u.e & 1), t = (unsigned long long)((u.e >> 1) & 1);
        return (const char*)(ph + o * ((pa - ph) + t * (pb - pa))); }
    __device__ __forceinline__ const char* b_base(const Unit& u) const {
        const unsigned long long pg = (unsigned long long)(WinT + (size_t)MGA * 2048), pa = (unsigned long long)WaT, pb = (unsigned long long)WbT, o = (unsigned long long)(u.e & 1), t = (unsigned long long)((u.e >> 1) & 1);
        const unsigned long long g = pg + t * (unsigned long long)((size_t)(MGB - MGA) * 2048), y = pa + t * (pb - pa);
        return (const char*)(g + o * (y - g)); }
    __device__ __forceinline__ int nt(const Unit& u) const { return (u.e & 1) ? 8 : 16; }
    __device__ __forceinline__ int a_row0(const Unit& u) const { return u.pm * 256; }
    __device__ __forceinline__ int b_row0(const Unit& u) const { return u.pn * 256; }
    __device__ __forceinline__ unsigned a_ld(const Unit& u) const { return (u.e & 1) ? 1024u : 2048u; }
    __device__ __forceinline__ unsigned b_ld(const Unit& u) const { return (u.e & 1) ? 1024u : 2048u; }
};
struct EpiMergeAll {
    static constexpr bool PERM = true;
    bf16_t* mrg; bf16_t* sg2;
    __device__ __forceinline__ void operator()(const f32x4 (&acc)[2][2][4][2], const Unit& u, int wr, int wc, int fr, int fq) const {
        if (u.e == 0) EpiMerge<0>{mrg, nullptr}(acc, u, wr, wc, fr, fq);
        else if (u.e == 1) EpiMerge<1>{mrg, nullptr}(acc, u, wr, wc, fr, fq);
        else if (u.e == 2) EpiMerge<0>{sg2, nullptr}(acc, u, wr, wc, fr, fq);
        else EpiMerge<2>{mrg, sg2}(acc, u, wr, wc, fr, fq);
    }
};
}

constexpr float LOG2E = 1.4426950408889634f;
constexpr float NEGV = -3.0e38f;
constexpr int NSA_TB = 49152;
constexpr int NSA_TBW = 224;
constexpr int NSA_IMPA = NSA_TB + 4 * NSA_TBW * 4;
constexpr int NSA_IMPB = NSA_IMPA + 16640;
constexpr int NSA_SELM = NSA_IMPB + 16640;
constexpr int NSA_OSUM = NSA_SELM + 512;

__device__ __forceinline__ int t5_bucket2(int n) {
    if (n < 16) return n;
    const int l = 16 + (int)(logf((float)n / 16.0f) / logf(8.0f) * 16.0f);
    return l < 31 ? l : 31;
}


typedef float f32x2 __attribute__((ext_vector_type(2)));
template <int STR>
__device__ __forceinline__ void tb_read16(unsigned a0, unsigned a1, unsigned a2, unsigned a3, f32x2 (&t)[8]) {
    asm volatile(
        "ds_read2_b32 %0, %8 offset0:%12 offset1:%13\n\t"
        "ds_read2_b32 %1, %8 offset0:%14\n\t"
        "ds_read2_b32 %2, %9 offset0:%12 offset1:%13\n\t"
        "ds_read2_b32 %3, %9 offset0:%14\n\t"
        "ds_read2_b32 %4, %10 offset0:%12 offset1:%13\n\t"
        "ds_read2_b32 %5, %10 offset0:%14\n\t"
        "ds_read2_b32 %6, %11 offset0:%12 offset1:%13\n\t"
        "ds_read2_b32 %7, %11 offset0:%14\n\t"
        "s_waitcnt lgkmcnt(0)"
        : "=&v"(t[0]), "=&v"(t[1]), "=&v"(t[2]), "=&v"(t[3]), "=&v"(t[4]), "=&v"(t[5]), "=&v"(t[6]), "=&v"(t[7])
        : "v"(a0), "v"(a1), "v"(a2), "v"(a3), "n"(3 * STR), "n"(2 * STR), "n"(STR));
}

template <int MODE, bool A0, bool A1>
__device__ __forceinline__ void nsa_tile(const char* Kst, const char* Vst, int j, bool fast, const float* tbias, const bf16x8 (&qf)[2][2], const int (&qidx)[2],
                                         const unsigned long long (&selq)[2], f32x4 (&O)[4][2], float (&m)[2], float (&l)[2], const float (&invl)[2],
                                         char* smem, int fr, int fq, int hp, int wid) {
    const float b127 = tbias[127];
    bf16x8 pf[2][2];
    bool started = true;
    if (MODE != 3) started = __builtin_amdgcn_ballot_w64((A0 && m[0] < -1e29f) || (A1 && m[1] < -1e29f)) == 0ull;
    const bool quick = fast;
    constexpr int STR = (MODE == 0 || MODE == 3) ? 16 : 1;
    const unsigned tboff = (unsigned)(size_t)(const __attribute__((address_space(3))) float*)tbias;
    f32x4 sall[2][2][2];
#pragma unroll
    for (int p = 0; p < 2; ++p)
#pragma unroll
        for (int s = 0; s < 2; ++s) {
            const int row = 32 * p + 16 * s + fr;
            const bf16x8 k0 = *(const bf16x8*)(Kst + tile_off(row, fq)), k1 = *(const bf16x8*)(Kst + tile_off(row, 4 + fq));
#pragma unroll
            for (int ct = 0; ct < 2; ++ct) {
                if ((ct == 0 && !A0) || (ct == 1 && !A1)) continue;
                float i0 = 0.f;
                if (quick) { const bool sel = (MODE == 1) ? (((selq[ct] >> j) & 1ull) != 0ull) : true; i0 = (MODE == 3) ? b127 : (sel ? b127 : NEGV) - (started ? m[ct] : 0.f); }
                f32x4 a = (f32x4){i0, i0, i0, i0};
                a = __builtin_amdgcn_mfma_f32_16x16x32_bf16(k0, qf[ct][0], a, 0, 0, 0);
                a = __builtin_amdgcn_mfma_f32_16x16x32_bf16(k1, qf[ct][1], a, 0, 0, 0);
                sall[ct][p][s] = a;
            }
        }
#pragma unroll
    for (int ct = 0; ct < 2; ++ct) {
        if ((ct == 0 && !A0) || (ct == 1 && !A1)) continue;
        f32x4 (&sacc)[2][2] = sall[ct];
        const int q = qidx[ct];
        const bool sel = (MODE == 1) ? (((selq[ct] >> j) & 1ull) != 0ull) : true;
        if (MODE != 3) {
            const float mct = m[ct];
            if (!quick) {
                const float ref = started ? mct : 0.f;
                int base[4]; unsigned ad[4];
#pragma unroll
                for (int gi = 0; gi < 4; ++gi) {
                    const int k0 = 64 * j + 32 * (gi >> 1) + 8 * fq + 4 * (gi & 1);
                    base[gi] = (MODE == 0) ? q - (16 * k0 + 31) : q - k0;
                    const int bc = base[gi] < 0 ? 0 : (base[gi] > 127 + 3 * STR ? 127 + 3 * STR : base[gi]);
                    ad[gi] = tboff + (unsigned)(bc - 3 * STR) * 4u;
                }
                f32x2 tv[8];
                tb_read16<STR>(ad[0], ad[1], ad[2], ad[3], tv);
#pragma unroll
                for (int p = 0; p < 2; ++p)
#pragma unroll
                    for (int s = 0; s < 2; ++s)
#pragma unroll
                        for (int i = 0; i < 4; ++i) {
                            const int rel = base[2 * p + s] - i * STR;
                            bool valid;
                            if (MODE == 0) valid = rel >= 0;
                            else if (MODE == 1) valid = (rel >= 0) && sel;
                            else valid = (rel >= 0) && (rel < 512);
                            const float tb = tv[(2 * p + s) * 2 + (i >> 1)][i & 1];
                            sacc[p][s][i] = valid ? sacc[p][s][i] + (tb - ref) : NEGV;
                        }
            }
            float pv[2][8]; float psum = 0.f;
            bool redo = !started;
            if (started) {
#pragma unroll
                for (int p = 0; p < 2; ++p)
#pragma unroll
                    for (int s = 0; s < 2; ++s)
#pragma unroll
                        for (int i = 0; i < 4; ++i) { pv[p][s * 4 + i] = __builtin_amdgcn_exp2f(sacc[p][s][i]); psum += pv[p][s * 4 + i]; }
                if (__builtin_amdgcn_ballot_w64(!(psum <= 256.0f)) != 0ull) {
                    redo = true;
#pragma unroll
                    for (int p = 0; p < 2; ++p)
#pragma unroll
                        for (int s = 0; s < 2; ++s)
#pragma unroll
                            for (int i = 0; i < 4; ++i) sacc[p][s][i] += mct;
                }
            }
            if (redo) {
                float mloc = NEGV;
#pragma unroll
                for (int p = 0; p < 2; ++p)
#pragma unroll
                    for (int s = 0; s < 2; ++s)
#pragma unroll
                        for (int i = 0; i < 4; ++i) mloc = fmaxf(mloc, sacc[p][s][i]);
                mloc = fmaxf(mloc, __shfl_xor(mloc, 16)); mloc = fmaxf(mloc, __shfl_xor(mloc, 32));
                const float mnew = fmaxf(mct, mloc);
                const float alpha = __builtin_amdgcn_exp2f(mct - mnew);
                m[ct] = mnew; l[ct] *= alpha;
#pragma unroll
                for (int dt = 0; dt < 4; ++dt) O[dt][ct] = O[dt][ct] * alpha;
                psum = 0.f;
#pragma unroll
                for (int p = 0; p < 2; ++p)
#pragma unroll
                    for (int s = 0; s < 2; ++s)
#pragma unroll
                        for (int i = 0; i < 4; ++i) { pv[p][s * 4 + i] = __builtin_amdgcn_exp2f(sacc[p][s][i] - mnew); psum += pv[p][s * 4 + i]; }
            }
#pragma unroll
            for (int p = 0; p < 2; ++p) {
                u32x4 w; w[0] = pack_bf16(pv[p][0], pv[p][1]); w[1] = pack_bf16(pv[p][2], pv[p][3]); w[2] = pack_bf16(pv[p][4], pv[p][5]); w[3] = pack_bf16(pv[p][6], pv[p][7]);
                pf[ct][p] = __builtin_bit_cast(bf16x8, w);
            }
            l[ct] += psum;
        } else {
            if (!quick) {
                int base[4]; unsigned ad[4];
#pragma unroll
                for (int gi = 0; gi < 4; ++gi) {
                    const int k0 = 64 * j + 32 * (gi >> 1) + 8 * fq + 4 * (gi & 1);
                    base[gi] = q - (16 * k0 + 31);
                    const int bc = base[gi] < 0 ? 0 : (base[gi] > 127 + 3 * STR ? 127 + 3 * STR : base[gi]);
                    ad[gi] = tboff + (unsigned)(bc - 3 * STR) * 4u;
                }
                f32x2 tv[8];
                tb_read16<STR>(ad[0], ad[1], ad[2], ad[3], tv);
#pragma unroll
                for (int p = 0; p < 2; ++p)
#pragma unroll
                    for (int s = 0; s < 2; ++s)
#pragma unroll
                        for (int i = 0; i < 4; ++i) {
                            const int rel = base[2 * p + s] - i * STR;
                            const float tb = tv[(2 * p + s) * 2 + (i >> 1)][i & 1];
                            sacc[p][s][i] = (rel >= 0) ? sacc[p][s][i] + tb : NEGV;
                        }
            }
            float* impA = (float*)(smem + NSA_IMPA); float* impB = (float*)(smem + NSA_IMPB);
            const int ql = wid * 8 + ct * 4 + (fr >> 2);
#pragma unroll
            for (int p = 0; p < 2; ++p)
#pragma unroll
                for (int s = 0; s < 2; ++s) {
                    float p3 = __builtin_amdgcn_exp2f(sacc[p][s][3] - m[ct]) * invl[ct];
                    float pa = __builtin_amdgcn_exp2f(sacc[p][s][0] - m[ct]) * invl[ct] + __builtin_amdgcn_exp2f(sacc[p][s][1] - m[ct]) * invl[ct]
                             + __builtin_amdgcn_exp2f(sacc[p][s][2] - m[ct]) * invl[ct] + p3;
                    pa += __shfl_xor(pa, 1); pa += __shfl_xor(pa, 2);
                    p3 += __shfl_xor(p3, 1); p3 += __shfl_xor(p3, 2);
                    const int jj = 16 * j + 8 * p + 2 * fq + s;
                    if (hp == 0) { impA[ql * 65 + jj] = pa; impB[ql * 65 + jj + 1] = p3; }
                }
        }
    }
    if (MODE != 3) {
#pragma unroll
        for (int dt = 0; dt < 4; ++dt)
#pragma unroll
            for (int p = 0; p < 2; ++p) {
                const bf16x8 vf = *(const bf16x8*)(Vst + tile_off(dt * 16 + fr, p * 4 + fq));
                if (A0) O[dt][0] = __builtin_amdgcn_mfma_f32_16x16x32_bf16(vf, pf[0][p], O[dt][0], 0, 0, 0);
                if (A1) O[dt][1] = __builtin_amdgcn_mfma_f32_16x16x32_bf16(vf, pf[1][p], O[dt][1], 0, 0, 0);
            }
    }
}

template <int MODE>
__device__ __forceinline__ void nsa_branch(const bf16_t* __restrict__ Kb, size_t kstride, const bf16_t* __restrict__ Vb, size_t vstride, int j0, int ntiles, int t0,
                                           const bf16x8 (&qf)[2][2], const int (&qidx)[2], const unsigned long long (&selq)[2], unsigned long long selor0, unsigned long long selor1,
                                           f32x4 (&O)[4][2], float (&m)[2], float (&l)[2], const float (&invl)[2], char* smem) {
    int tid_ = threadIdx.x; asm volatile("" : "+v"(tid_));
    const int tid = tid_, lane = tid & 63, wid = tid >> 6, fr = lane & 15, fq = lane >> 4, hp = fr & 3;
    const int lrow = tid >> 3;
    const float* tbias = (const float*)(smem + NSA_TB) + hp * NSA_TBW + 48;
    const int sch8 = ((tid & 7) ^ (lrow & 7)) * 8;
    const int krow = 32 * (lrow >> 5) + 8 * ((lrow & 15) >> 2) + 4 * ((lrow >> 4) & 1) + (lrow & 3);
    const bf16_t* kp = Kb + (size_t)krow * kstride + sch8;
    const bf16_t* vp = Vb + (size_t)lrow * vstride + sch8;
    __syncthreads();
    glds16(kp, smem + tid * 16); if (MODE != 3) glds16(vp, smem + 8192 + tid * 16);
    asm volatile("s_waitcnt vmcnt(0)" ::: "memory");
    __syncthreads();
    for (int it = 0; it < ntiles; ++it) {
        const int cur = it & 1, j = j0 + it;
        if (it + 1 < ntiles) {
            char* st = smem + (cur ^ 1) * 16384 + tid * 16;
            glds16(kp + (size_t)(it + 1) * 64 * kstride, st); if (MODE != 3) glds16(vp + (size_t)(it + 1) * 64, st + 8192);
        }
        const char* Kst = smem + cur * 16384;
        const char* Vst = Kst + 8192;
        bool fast;
        if (MODE == 0 || MODE == 3) fast = (t0 - (16 * (64 * j + 63) + 31)) >= 128;
        else if (MODE == 1) fast = (t0 - (64 * j + 63)) >= 128;
        else fast = ((t0 - (64 * j + 63)) >= 128) && ((t0 + 63 - 64 * j) < 512);
        if (MODE == 1) {
            const bool a0 = ((selor0 >> j) & 1ull) != 0ull, a1 = ((selor1 >> j) & 1ull) != 0ull;
            if (a0 && a1) nsa_tile<MODE, true, true>(Kst, Vst, j, fast, tbias, qf, qidx, selq, O, m, l, invl, smem, fr, fq, hp, wid);
            else if (a0) nsa_tile<MODE, true, false>(Kst, Vst, j, fast, tbias, qf, qidx, selq, O, m, l, invl, smem, fr, fq, hp, wid);
            else if (a1) nsa_tile<MODE, false, true>(Kst, Vst, j, fast, tbias, qf, qidx, selq, O, m, l, invl, smem, fr, fq, hp, wid);
        } else {
            nsa_tile<MODE, true, true>(Kst, Vst, j, fast, tbias, qf, qidx, selq, O, m, l, invl, smem, fr, fq, hp, wid);
        }
        asm volatile("s_waitcnt vmcnt(0)" ::: "memory");
        __syncthreads();
    }
}


__device__ __forceinline__ unsigned pack_bf16_p(float lo, float hi) { return pack_bf16(lo, hi); }

__device__ __forceinline__ void nsa_pv_mfma(const char* Vst, const bf16x8 (&pf)[2][2], f32x4 (&O)[4][2], int fr, int fq) {
#pragma unroll
    for (int p = 0; p < 2; ++p)
#pragma unroll
        for (int dt = 0; dt < 4; ++dt) {
            const bf16x8 vf = *(const bf16x8*)(Vst + tile_off(dt * 16 + fr, p * 4 + fq));
            O[dt][0] = __builtin_amdgcn_mfma_f32_16x16x32_bf16(vf, pf[0][p], O[dt][0], 0, 0, 0);
            O[dt][1] = __builtin_amdgcn_mfma_f32_16x16x32_bf16(vf, pf[1][p], O[dt][1], 0, 0, 0);
        }
}

template <int STR>
__device__ __forceinline__ void tb_read8(unsigned a0, unsigned a1, f32x2 (&t)[4]) {
    asm volatile(
        "ds_read2_b32 %0, %4 offset0:%6 offset1:%7\n\t"
        "ds_read2_b32 %1, %4 offset0:%8\n\t"
        "ds_read2_b32 %2, %5 offset0:%6 offset1:%7\n\t"
        "ds_read2_b32 %3, %5 offset0:%8\n\t"
        "s_waitcnt lgkmcnt(0)"
        : "=&v"(t[0]), "=&v"(t[1]), "=&v"(t[2]), "=&v"(t[3])
        : "v"(a0), "v"(a1), "n"(3 * STR), "n"(2 * STR), "n"(STR));
}

template <int MODE, bool PEND, bool EDGE>
__device__ __forceinline__ void nsa_step_impl(const char* Kst, const char* Vprev, int j, const float* tbias, const bf16x8 (&qf)[2][2], const int (&qidx)[2],
                                         const unsigned long long (&selq)[2], bf16x8 (&pf)[2][2], f32x4 (&O)[4][2], float (&m)[2], float (&l)[2], int fr, int fq) {
    constexpr int STR = (MODE == 0) ? 16 : 1;
    const float b127 = tbias[127];
    f32x4 Sc[2][2][2];
    float mref[2], i0[2]; bool sel[2];
#pragma unroll
    for (int ct = 0; ct < 2; ++ct) {
        mref[ct] = m[ct] < -1e29f ? 0.f : m[ct];
        sel[ct] = (MODE == 1) ? (((selq[ct] >> j) & 1ull) != 0ull) : true;
        i0[ct] = (EDGE ? 0.f : (sel[ct] ? b127 : NEGV)) - mref[ct];
    }
    {
        bf16x8 kf[4][2];
        __builtin_amdgcn_sched_barrier(0);
#pragma unroll
        for (int g = 0; g < 4; ++g) {
            const int row = 32 * (g >> 1) + 16 * (g & 1) + fr;
            kf[g][0] = *(const bf16x8*)(Kst + tile_off(row, fq)); kf[g][1] = *(const bf16x8*)(Kst + tile_off(row, 4 + fq));
        }
        __builtin_amdgcn_sched_barrier(0);
#pragma unroll
        for (int g = 0; g < 4; ++g)
#pragma unroll
            for (int ct = 0; ct < 2; ++ct) {
                f32x4 a = (f32x4){i0[ct], i0[ct], i0[ct], i0[ct]};
                a = __builtin_amdgcn_mfma_f32_16x16x32_bf16(kf[g][0], qf[ct][0], a, 0, 0, 0);
                a = __builtin_amdgcn_mfma_f32_16x16x32_bf16(kf[g][1], qf[ct][1], a, 0, 0, 0);
                Sc[ct][g >> 1][g & 1] = a;
            }
    }
    if (EDGE) {
        const unsigned tboff = (unsigned)(size_t)(const __attribute__((address_space(3))) float*)tbias;
#pragma unroll
        for (int ct = 0; ct < 2; ++ct)
#pragma unroll
            for (int p = 0; p < 2; ++p) {
                int base[2]; unsigned ad[2];
#pragma unroll
                for (int s = 0; s < 2; ++s) {
                    const int k0 = 64 * j + 32 * p + 8 * fq + 4 * s;
                    base[s] = (MODE == 0) ? qidx[ct] - (16 * k0 + 31) : qidx[ct] - k0;
                    const int bc = base[s] < 0 ? 0 : (base[s] > 127 + 3 * STR ? 127 + 3 * STR : base[s]);
                    ad[s] = tboff + (unsigned)(bc - 3 * STR) * 4u;
                }
                f32x2 tv[4];
                tb_read8<STR>(ad[0], ad[1], tv);
#pragma unroll
                for (int s = 0; s < 2; ++s)
#pragma unroll
                    for (int i = 0; i < 4; ++i) {
                        const int rel = base[s] - i * STR;
                        bool valid;
                        if (MODE == 0) valid = rel >= 0;
                        else if (MODE == 1) valid = (rel >= 0) && sel[ct];
                        else valid = (rel >= 0) && (rel < 512);
                        const float tb = tv[s * 2 + (i >> 1)][i & 1];
                        Sc[ct][p][s][i] = valid ? Sc[ct][p][s][i] + tb : NEGV;
                    }
            }
    }
    bool need = false; float mx[2];
#pragma unroll
    for (int ct = 0; ct < 2; ++ct) {
        float x = fmaxf(fmaxf(Sc[ct][0][0][0], Sc[ct][0][0][1]), Sc[ct][0][0][2]);
        x = fmaxf(fmaxf(x, Sc[ct][0][0][3]), Sc[ct][0][1][0]); x = fmaxf(fmaxf(x, Sc[ct][0][1][1]), Sc[ct][0][1][2]);
        x = fmaxf(fmaxf(x, Sc[ct][0][1][3]), Sc[ct][1][0][0]); x = fmaxf(fmaxf(x, Sc[ct][1][0][1]), Sc[ct][1][0][2]);
        x = fmaxf(fmaxf(x, Sc[ct][1][0][3]), Sc[ct][1][1][0]); x = fmaxf(fmaxf(x, Sc[ct][1][1][1]), Sc[ct][1][1][2]);
        x = fmaxf(x, Sc[ct][1][1][3]);
        mx[ct] = x;
        need = need || (x > 8.0f) || (m[ct] < -1e29f);
    }
    const bool slow = __builtin_amdgcn_ballot_w64(need) != 0ull;
    float alpha[2] = {1.f, 1.f};
    if (slow) {
#pragma unroll
        for (int ct = 0; ct < 2; ++ct) {
            const float mct = m[ct];
            float mloc = mx[ct] + mref[ct];
            mloc = fmaxf(mloc, __shfl_xor(mloc, 16)); mloc = fmaxf(mloc, __shfl_xor(mloc, 32));
            const float mn = fmaxf(mct, mloc);
            alpha[ct] = __builtin_amdgcn_exp2f(mct - mn);
            const float dlt = mref[ct] - mn;
            m[ct] = mn;
#pragma unroll
            for (int p = 0; p < 2; ++p)
#pragma unroll
                for (int s = 0; s < 2; ++s)
#pragma unroll
                    for (int i = 0; i < 4; ++i) Sc[ct][p][s][i] += dlt;
        }
    }
    float e[32];
    if (PEND) {
        bf16x8 vf[8];
#define NSA_VRD(f_) vf[f_] = *(const bf16x8*)(Vprev + tile_off(((f_) & 3) * 16 + fr, ((f_) >> 2) * 4 + fq))
        __builtin_amdgcn_sched_barrier(0);
        NSA_VRD(0); NSA_VRD(1);
        __builtin_amdgcn_sched_barrier(0);
#pragma unroll
        for (int k = 0; k < 16; ++k) {
            const int f = k >> 1, ct = k & 1, p = f >> 2, dt = f & 3;
            if (ct == 0 && f + 2 < 8) NSA_VRD(f + 2);
            O[dt][ct] = __builtin_amdgcn_mfma_f32_16x16x32_bf16(vf[f], pf[ct][p], O[dt][ct], 0, 0, 0);
#pragma unroll
            for (int x = 0; x < 2; ++x) {
                const int idx = 2 * k + x;
                e[idx] = __builtin_amdgcn_exp2f(Sc[idx >> 4][(idx >> 3) & 1][(idx >> 2) & 1][idx & 3]);
                asm volatile("" : "+v"(e[idx]));
            }
            __builtin_amdgcn_sched_barrier(0);
        }
#undef NSA_VRD
    } else {
#pragma unroll
        for (int idx = 0; idx < 32; ++idx) e[idx] = __builtin_amdgcn_exp2f(Sc[idx >> 4][(idx >> 3) & 1][(idx >> 2) & 1][idx & 3]);
    }
    if (slow) {
#pragma unroll
        for (int ct = 0; ct < 2; ++ct) {
            l[ct] *= alpha[ct];
#pragma unroll
            for (int dt = 0; dt < 4; ++dt) O[dt][ct] = O[dt][ct] * alpha[ct];
        }
    }
#pragma unroll
    for (int ct = 0; ct < 2; ++ct) {
        float ps0 = 0.f, ps1 = 0.f;
#pragma unroll
        for (int p = 0; p < 2; ++p) {
            const int eb = ct * 16 + p * 8;
#pragma unroll
            for (int i = 0; i < 4; ++i) { ps0 += e[eb + i]; ps1 += e[eb + 4 + i]; }
            u32x4 w;
            w[0] = pack_bf16_p(e[eb], e[eb + 1]); w[1] = pack_bf16_p(e[eb + 2], e[eb + 3]); w[2] = pack_bf16_p(e[eb + 4], e[eb + 5]); w[3] = pack_bf16_p(e[eb + 6], e[eb + 7]);
            pf[ct][p] = __builtin_bit_cast(bf16x8, w);
        }
        l[ct] += ps0 + ps1;
    }
}

template <int MODE, bool PEND>
__device__ __forceinline__ void nsa_step(const char* Kst, const char* Vprev, int j, bool fast, const float* tbias, const bf16x8 (&qf)[2][2], const int (&qidx)[2],
                                         const unsigned long long (&selq)[2], bf16x8 (&pf)[2][2], f32x4 (&O)[4][2], float (&m)[2], float (&l)[2], int fr, int fq) {
    if (fast) nsa_step_impl<MODE, PEND, false>(Kst, Vprev, j, tbias, qf, qidx, selq, pf, O, m, l, fr, fq);
    else nsa_step_impl<MODE, PEND, true>(Kst, Vprev, j, tbias, qf, qidx, selq, pf, O, m, l, fr, fq);
}

template <int MODE>
__device__ __forceinline__ void nsa_branch_p(const bf16_t* __restrict__ Kb, size_t kstride, const bf16_t* __restrict__ Vb, size_t vstride, int j0, int ntiles, int t0,
                                             const bf16x8 (&qf)[2][2], const int (&qidx)[2], const unsigned long long (&selq)[2],
                                             f32x4 (&O)[4][2], float (&m)[2], float (&l)[2], char* smem) {
    int tid_ = threadIdx.x; asm volatile("" : "+v"(tid_));
    const int tid = tid_, lane = tid & 63, fr = lane & 15, fq = lane >> 4, hp = fr & 3;
    const int lrow = tid >> 3;
    const float* tbias = (const float*)(smem + NSA_TB) + hp * NSA_TBW + 48;
    const int sch8 = ((tid & 7) ^ (lrow & 7)) * 8;
    const int krow = 32 * (lrow >> 5) + 8 * ((lrow & 15) >> 2) + 4 * ((lrow >> 4) & 1) + (lrow & 3);
    const bf16_t* kp = Kb + (size_t)krow * kstride + sch8;
    const bf16_t* vp = Vb + (size_t)lrow * vstride + sch8;
#define NSA_FAST(j_) ((MODE == 0) ? ((t0 - (16 * (64 * (j_) + 63) + 31)) >= 128) : (MODE == 1) ? ((t0 - (64 * (j_) + 63)) >= 128) : (((t0 - (64 * (j_) + 63)) >= 128) && ((t0 + 63 - 64 * (j_)) < 512)))
#define NSA_KLD(t_, st_) glds16(kp + (size_t)(t_) * 64 * kstride, smem + (st_) * 16384 + tid * 16)
#define NSA_VLD(t_, st_) glds16(vp + (size_t)(t_) * 64, smem + (st_) * 16384 + 8192 + tid * 16)
#define NSA_WAITBAR(n_) do { if ((n_) >= 2) asm volatile("s_waitcnt vmcnt(2) lgkmcnt(0)" ::: "memory"); else if ((n_) == 1) asm volatile("s_waitcnt vmcnt(1) lgkmcnt(0)" ::: "memory"); \
                             else asm volatile("s_waitcnt vmcnt(0) lgkmcnt(0)" ::: "memory"); __builtin_amdgcn_s_barrier(); asm volatile("" ::: "memory"); } while (0)
    __syncthreads();
    NSA_KLD(0, 0);
    if (ntiles > 1) NSA_KLD(1, 1);
    NSA_VLD(0, 0);
    NSA_WAITBAR(ntiles > 1 ? 2 : 1);
    bf16x8 pf[2][2];
    {
        int n = 0;
        if (2 < ntiles) { NSA_KLD(2, 2); ++n; }
        if (1 < ntiles) { NSA_VLD(1, 1); ++n; }
        nsa_step<MODE, false>(smem, smem, j0, NSA_FAST(j0), tbias, qf, qidx, selq, pf, O, m, l, fr, fq);
        NSA_WAITBAR(n);
    }
    int cur = 1, prv = 0, nx2 = 0;
    for (int it = 1; it < ntiles; ++it) {
        int n = 0;
        if (it + 2 < ntiles) { NSA_KLD(it + 2, nx2); ++n; }
        const int nx1 = (cur == 2) ? 0 : cur + 1;
        if (it + 1 < ntiles) { NSA_VLD(it + 1, nx1); ++n; }
        nsa_step<MODE, true>(smem + cur * 16384, smem + prv * 16384 + 8192, j0 + it, NSA_FAST(j0 + it), tbias, qf, qidx, selq, pf, O, m, l, fr, fq);
        NSA_WAITBAR(n);
        prv = cur; cur = nx1; nx2 = (nx2 == 2) ? 0 : nx2 + 1;
    }
    nsa_pv_mfma(smem + prv * 16384 + 8192, pf, O, fr, fq);
#undef NSA_KLD
#undef NSA_VLD
#undef NSA_WAITBAR
#undef NSA_FAST
}

__device__ __forceinline__ void osum_add(uint2& acc, f32x4 o, float sc) {
    f32x4 v;
    v[0] = __uint_as_float(acc.x << 16) + o[0] * sc; v[1] = __uint_as_float(acc.x & 0xFFFF0000u) + o[1] * sc;
    v[2] = __uint_as_float(acc.y << 16) + o[2] * sc; v[3] = __uint_as_float(acc.y & 0xFFFF0000u) + o[3] * sc;
    acc = pack4(v);
}
__device__ __forceinline__ float nsa_gate(const bf16_t* __restrict__ pb, int q, int br, int head) { return sigmoidf_(bf2f(pb[(size_t)q * PP + GA + br * 8 + head])); }

__device__ __forceinline__ void nsa_unit(int u, const bf16_t* __restrict__ proj, const char* __restrict__ ws, const float* __restrict__ rel_bias, bf16_t* __restrict__ ya, char* smem) {
    int tid_ = threadIdx.x; asm volatile("" : "+v"(tid_));
    const int tid = tid_, lane = tid & 63, wid = tid >> 6, fr = lane & 15, fq = lane >> 4, hp = fr & 3;
    const int bg = u & 7, qb = 63 - (u >> 3), b = bg >> 1, g = bg & 1, t0 = qb * 64, tb = qb;
    const bf16_t* kcb = (const bf16_t*)(ws + OFF_KCB) + (size_t)bg * 256 * 64;
    const bf16_t* vcbT = (const bf16_t*)(ws + OFF_VCBT) + (size_t)bg * 64 * 256;
    const bf16_t* VsT = (const bf16_t*)(ws + OFF_VST) + (size_t)bg * 64 * S;
    const bf16_t* VwT = (const bf16_t*)(ws + OFF_VWT) + (size_t)bg * 64 * S;
    const bf16_t* pb = proj + (size_t)b * S * PP;
    __syncthreads();
    {
        float* tbl = (float*)(smem + NSA_TB);
        for (int e = tid; e < 4 * NSA_TBW; e += 512) {
            const int h4 = e / NSA_TBW, x = e - h4 * NSA_TBW - 48, n = x < 0 ? 0 : (x > 127 ? 127 : x);
            tbl[e] = rel_bias[t5_bucket2(n) * 8 + g * 4 + h4] * LOG2E;
        }
        float* imp = (float*)(smem + NSA_IMPA);
        for (int e = tid; e < 2 * 4160; e += 512) imp[e] = 0.f;
    }
    int qidx[2]; bf16x8 qf[2][2];
    const int head = g * 4 + hp;
#pragma unroll
    for (int ct = 0; ct < 2; ++ct) {
        qidx[ct] = t0 + wid * 8 + ct * 4 + (fr >> 2);
        const bf16_t* qr = pb + (size_t)qidx[ct] * PP;
#pragma unroll
        for (int ks = 0; ks < 2; ++ks) {
            const u32x4 raw = *(const u32x4*)(qr + QA + head * 64 + ks * 32 + fq * 8);
            u32x4 w;
#pragma unroll
            for (int e = 0; e < 4; ++e) w[e] = pack_bf16(__uint_as_float(raw[e] << 16) * (0.125f * LOG2E), __uint_as_float(raw[e] & 0xFFFF0000u) * (0.125f * LOG2E));
            qf[ct][ks] = __builtin_bit_cast(bf16x8, w);
        }
    }
    uint2* osl = (uint2*)(smem + NSA_OSUM) + tid;
    unsigned long long selq[2] = {0ull, 0ull};
    float invl0[2] = {0.f, 0.f};
    const int ntc = (((t0 + 32) >> 4) + 1 + 63) >> 6;
    float mC[2], invC[2];
    {
        f32x4 O[4][2]; float m[2] = {-1e30f, -1e30f}, l[2] = {0.f, 0.f};
#pragma unroll
        for (int dt = 0; dt < 4; ++dt)
#pragma unroll
            for (int ct = 0; ct < 2; ++ct) O[dt][ct] = (f32x4){0.f, 0.f, 0.f, 0.f};
        nsa_branch_p<0>(kcb, 64, vcbT, 256, 0, ntc, t0, qf, qidx, selq, O, m, l, smem);
#pragma unroll
        for (int ct = 0; ct < 2; ++ct) {
            float lt = l[ct]; lt += __shfl_xor(lt, 16); lt += __shfl_xor(lt, 32);
            invC[ct] = lt > 0.f ? 1.f / lt : 0.f; mC[ct] = m[ct];
#pragma unroll
            for (int dt = 0; dt < 4; ++dt) { uint2 a = make_uint2(0u, 0u); osum_add(a, O[dt][ct], nsa_gate(pb, qidx[ct], 0, head) * invC[ct]); osl[(dt * 2 + ct) * 512] = a; }
        }
        nsa_branch<3>(kcb, 64, vcbT, 256, 0, ntc, t0, qf, qidx, selq, 0ull, 0ull, O, mC, l, invC, smem);
    }
    {
        const float* impA = (const float*)(smem + NSA_IMPA); const float* impB = (const float*)(smem + NSA_IMPB);
        unsigned long long* selm = (unsigned long long*)(smem + NSA_SELM);
#pragma unroll 1
        for (int qq = 0; qq < 8; ++qq) {
            const int ql = wid * 8 + qq;
            const float val = impA[ql * 65 + lane] + impB[ql * 65 + lane];
            const bool forced = (lane == 0) || (lane == tb) || (lane == tb - 1);
            unsigned key = forced ? 0xFFFFFFC0u : (lane > tb ? 0u : (__float_as_uint(val) & 0xFFFFFFC0u));
            key |= (unsigned)(63 - lane);
            int rank = 0;
#pragma unroll
            for (int jp = 0; jp < 64; ++jp) rank += ((unsigned)__builtin_amdgcn_readlane((int)key, jp) > key) ? 1 : 0;
            const unsigned long long msk = __ballot(rank < 16);
            if (lane == 0) selm[ql] = msk;
        }
        wave_lds_sync();
        unsigned long long so0 = 0ull, so1 = 0ull;
#pragma unroll
        for (int qq = 0; qq < 4; ++qq) { so0 |= selm[wid * 8 + qq]; so1 |= selm[wid * 8 + 4 + qq]; }
        const unsigned long long selor0 = ((unsigned long long)(unsigned)__builtin_amdgcn_readfirstlane((int)(unsigned)(so0 >> 32)) << 32) | (unsigned)__builtin_amdgcn_readfirstlane((int)(unsigned)so0);
        const unsigned long long selor1 = ((unsigned long long)(unsigned)__builtin_amdgcn_readfirstlane((int)(unsigned)(so1 >> 32)) << 32) | (unsigned)__builtin_amdgcn_readfirstlane((int)(unsigned)so1);
        selq[0] = selm[wid * 8 + (fr >> 2)]; selq[1] = selm[wid * 8 + 4 + (fr >> 2)];
        {
            f32x4 O[4][2]; float m[2] = {-1e30f, -1e30f}, l[2] = {0.f, 0.f};
#pragma unroll
            for (int dt = 0; dt < 4; ++dt)
#pragma unroll
                for (int ct = 0; ct < 2; ++ct) O[dt][ct] = (f32x4){0.f, 0.f, 0.f, 0.f};
            nsa_branch_p<1>(pb + KS + g * 64, PP, VsT, S, 0, tb + 1, t0, qf, qidx, selq, O, m, l, smem);
#pragma unroll
            for (int ct = 0; ct < 2; ++ct) {
                float lt = l[ct]; lt += __shfl_xor(lt, 16); lt += __shfl_xor(lt, 32);
                const float inv = lt > 0.f ? 1.f / lt : 0.f;
#pragma unroll
                for (int dt = 0; dt < 4; ++dt) { uint2 a = osl[(dt * 2 + ct) * 512]; osum_add(a, O[dt][ct], nsa_gate(pb, qidx[ct], 1, head) * inv); osl[(dt * 2 + ct) * 512] = a; }
            }
        }
    }
    {
        f32x4 O[4][2]; float m[2] = {-1e30f, -1e30f}, l[2] = {0.f, 0.f};
#pragma unroll
        for (int dt = 0; dt < 4; ++dt)
#pragma unroll
            for (int ct = 0; ct < 2; ++ct) O[dt][ct] = (f32x4){0.f, 0.f, 0.f, 0.f};
        const int jw0 = (t0 - 511 < 0 ? 0 : t0 - 511) >> 6;
        nsa_branch_p<2>(pb + (size_t)jw0 * 64 * PP + KW + g * 64, PP, VwT + jw0 * 64, S, jw0, tb - jw0 + 1, t0, qf, qidx, selq, O, m, l, smem);
#pragma unroll
        for (int ct = 0; ct < 2; ++ct) {
            float lt = l[ct]; lt += __shfl_xor(lt, 16); lt += __shfl_xor(lt, 32);
            const float inv = lt > 0.f ? 1.f / lt : 0.f;
            bf16_t* yr = ya + (size_t)(b * S + qidx[ct]) * 512 + head * 64 + 4 * fq;
#pragma unroll
            for (int dt = 0; dt < 4; ++dt) { uint2 a = osl[(dt * 2 + ct) * 512]; osum_add(a, O[dt][ct], nsa_gate(pb, qidx[ct], 2, head) * inv); *(uint2*)(yr + dt * 16) = a; }
        }
    }
}

__device__ __forceinline__ void vtrans_tile(int task, const bf16_t* __restrict__ proj, char* ws, char* smem) {
    unsigned short (*tl)[66] = (unsigned short (*)[66])smem;
    const int tid = HB_TID, which = task >> 9, bg = (task >> 6) & 7, tt = task & 63, b = bg >> 1, g = bg & 1;
    const int r = tid >> 2, q4 = tid & 3;
    const bf16_t* src = proj + (size_t)(b * S + tt * 64 + r) * PP + (which ? VW : VS) + g * 64 + q4 * 16;
    const uint4 a0 = *(const uint4*)src, a1 = *(const uint4*)(src + 8);
    unsigned* trow = (unsigned*)&tl[r][q4 * 16];
    trow[0] = a0.x; trow[1] = a0.y; trow[2] = a0.z; trow[3] = a0.w; trow[4] = a1.x; trow[5] = a1.y; trow[6] = a1.z; trow[7] = a1.w;
    __syncthreads();
    bf16_t* dst = (bf16_t*)(ws + (which ? OFF_VWT : OFF_VST)) + ((size_t)bg * 64 + r) * S + tt * 64 + q4 * 16;
    unsigned o[8];
#pragma unroll
    for (int k = 0; k < 8; ++k) o[k] = (unsigned)tl[q4 * 16 + 2 * k][r] | ((unsigned)tl[q4 * 16 + 2 * k + 1][r] << 16);
    *(uint4*)dst = make_uint4(o[0], o[1], o[2], o[3]);
    *(uint4*)(dst + 8) = make_uint4(o[4], o[5], o[6], o[7]);
    __syncthreads();
}

__device__ __forceinline__ int tile_el(int row, int col) { return tile_off(row, col >> 3) + ((col & 7) << 1); }

__device__ __forceinline__ void gla_stage_vt(const bf16_t* __restrict__ proj, size_t row0, int h, char* vt_base) {
    const int tid = HB_TID, c = tid >> 2, vq = tid & 3;
    const bf16_t* src = proj + (row0 + c) * PP + VB + h * 128 + vq * 32;
#pragma unroll
    for (int k = 0; k < 4; ++k) {
        const u32x4 a = *(const u32x4*)(src + k * 8);
#pragma unroll
        for (int e = 0; e < 4; ++e) {
            const int v = vq * 32 + k * 8 + 2 * e;
            *(unsigned short*)(vt_base + tile_el(v, c)) = (unsigned short)(a[e] & 0xFFFFu);
            *(unsigned short*)(vt_base + tile_el(v + 1, c)) = (unsigned short)(a[e] >> 16);
        }
    }
}

__device__ __forceinline__ void gla_a_unit(int vb, const bf16_t* __restrict__ proj, const float* __restrict__ w_alpha, const float* __restrict__ b_alpha,
                                           float* __restrict__ bc, float* __restrict__ cstate, char* smem) {
    float (*bcS)[64] = (float (*)[64])smem;
    float (*tot)[64] = (float (*)[64])(smem + 16384);
    char* KDT = smem + 17408;
    char* VT = smem + 17408 + 8192;
    const int tid = HB_TID, lane = tid & 63, wid = tid >> 6, fr = lane & 15, fq = lane >> 4;
    const int n = vb & 63, h = (vb >> 6) & 3, b = vb >> 8;
    const size_t row0 = (size_t)(b * S + n * 64);
    u32x4* abS = (u32x4*)(smem + 45056);
    __syncthreads();
    if (tid < 128) abS[tid] = *(const u32x4*)(proj + (row0 + (tid >> 1)) * PP + AB + (tid & 1) * 8);
    __syncthreads();
    {
        const int d = tid & 63, cq = tid >> 6, col = h * 64 + d;
        float w[16];
#pragma unroll
        for (int r = 0; r < 16; ++r) w[r] = w_alpha[r * 256 + col];
        const float bias = b_alpha[col];
        float cum = 0.f;
        for (int i = 0; i < 16; ++i) {
            const int c = cq * 16 + i;
            const u32x4 a0 = abS[c * 2], a1 = abS[c * 2 + 1];
            float z = bias;
#pragma unroll
            for (int e = 0; e < 4; ++e) {
                z += __uint_as_float(a0[e] << 16) * w[2 * e] + __uint_as_float(a0[e] & 0xFFFF0000u) * w[2 * e + 1];
                z += __uint_as_float(a1[e] << 16) * w[8 + 2 * e] + __uint_as_float(a1[e] & 0xFFFF0000u) * w[8 + 2 * e + 1];
            }
            const float ls = fminf(z, 0.f) - __logf(1.f + __expf(-fabsf(z)));
            cum += ls * (1.0f / 16.0f);
            bcS[c][d] = cum;
        }
        tot[cq][d] = cum;
        __syncthreads();
        float pre = 0.f;
        for (int q = 0; q < cq; ++q) pre += tot[q][d];
        for (int i = 0; i < 16; ++i) {
            const int c = cq * 16 + i;
            const float v = bcS[c][d] + pre;
            bcS[c][d] = v;
            bc[(row0 + c) * 256 + col] = v;
        }
    }
    __syncthreads();
    {
        const int c = tid >> 2, dq = tid & 3;
        const bf16_t* src = proj + (row0 + c) * PP + KB + h * 64 + dq * 16;
#pragma unroll
        for (int k = 0; k < 2; ++k) {
            const u32x4 a = *(const u32x4*)(src + k * 8);
#pragma unroll
            for (int e = 0; e < 4; ++e) {
                const int d = dq * 16 + k * 8 + 2 * e;
                const float k0 = __uint_as_float(a[e] << 16) * __expf(bcS[63][d] - bcS[c][d]);
                const float k1 = __uint_as_float(a[e] & 0xFFFF0000u) * __expf(bcS[63][d + 1] - bcS[c][d + 1]);
                *(unsigned short*)(KDT + tile_el(d, c)) = f2bf(k0);
                *(unsigned short*)(KDT + tile_el(d + 1, c)) = f2bf(k1);
            }
        }
    }
    gla_stage_vt(proj, row0, h, VT);
    __syncthreads();
    float* outp = cstate + (size_t)vb * 8192;
#pragma unroll
    for (int vi = 0; vi < 2; ++vi) {
        const int vt = wid * 2 + vi;
        const bf16x8 a0 = *(const bf16x8*)(VT + tile_off(vt * 16 + fr, fq)), a1 = *(const bf16x8*)(VT + tile_off(vt * 16 + fr, 4 + fq));
#pragma unroll
        for (int dt = 0; dt < 4; ++dt) {
            const bf16x8 b0 = *(const bf16x8*)(KDT + tile_off(dt * 16 + fr, fq)), b1 = *(const bf16x8*)(KDT + tile_off(dt * 16 + fr, 4 + fq));
            f32x4 acc = (f32x4){0.f, 0.f, 0.f, 0.f};
            acc = __builtin_amdgcn_mfma_f32_16x16x32_bf16(b0, a0, acc, 0, 0, 0);
            acc = __builtin_amdgcn_mfma_f32_16x16x32_bf16(b1, a1, acc, 0, 0, 0);
            *(f32x4*)(outp + (vt * 16 + fr) * 64 + dt * 16 + 4 * fq) = acc;
        }
    }
}

__device__ __forceinline__ void gla_scan_vb2(int vb, const float* __restrict__ bc, float* __restrict__ cstate) {
    const int idx = vb * 512 + threadIdx.x;
    const int e = idx & 8191, bh = idx >> 13, b = bh >> 2, h = bh & 3, d = e & 63;
    float state = 0.f;
    float* base = cstate + (size_t)bh * 64 * 8192 + e;
    const float* bcp = bc + ((size_t)(b * S + 63)) * 256 + h * 64 + d;
#pragma unroll 1
    for (int n0 = 0; n0 < 64; n0 += 16) {
        float upd[16], dec[16];
#pragma unroll
        for (int i = 0; i < 16; ++i) { upd[i] = base[(size_t)(n0 + i) * 8192]; dec[i] = bcp[(size_t)(n0 + i) * 64 * 256]; }
#pragma unroll
        for (int i = 0; i < 16; ++i) { base[(size_t)(n0 + i) * 8192] = state; state = __expf(dec[i]) * state + upd[i]; }
    }
}

__device__ __forceinline__ void gla_c_unit(int vb, const bf16_t* __restrict__ proj, const float* __restrict__ bc, const float* __restrict__ prev,
                                           const float* __restrict__ norm_g, bf16_t* __restrict__ yb, char* smem) {
    char* QI = smem;
    char* KI = smem + 8192;
    char* VT = smem + 16384;
    char* PT = smem + 32768;
    const int tid = HB_TID, lane = tid & 63, wid = tid >> 6, fr = lane & 15, fq = lane >> 4;
    const int n = vb & 63, h = (vb >> 6) & 3, b = vb >> 8;
    const size_t row0 = (size_t)(b * S + n * 64);
    __syncthreads();
    {
        const int c = tid >> 2, dq = tid & 3;
        const bf16_t* qs = proj + (row0 + c) * PP + QB + h * 64 + dq * 16;
        const bf16_t* ks = proj + (row0 + c) * PP + KB + h * 64 + dq * 16;
        const float* bs = bc + (row0 + c) * 256 + h * 64 + dq * 16;
#pragma unroll
        for (int k = 0; k < 2; ++k) {
            const u32x4 qa = *(const u32x4*)(qs + k * 8), ka = *(const u32x4*)(ks + k * 8);
            const f32x4 b0 = *(const f32x4*)(bs + k * 8), b1 = *(const f32x4*)(bs + k * 8 + 4);
            const float bv[8] = {b0[0], b0[1], b0[2], b0[3], b1[0], b1[1], b1[2], b1[3]};
            u32x4 qo, ko;
#pragma unroll
            for (int e = 0; e < 4; ++e) {
                const float e0 = __expf(bv[2 * e]), e1 = __expf(bv[2 * e + 1]);
                qo[e] = pack_bf16(__uint_as_float(qa[e] << 16) * 0.125f * e0, __uint_as_float(qa[e] & 0xFFFF0000u) * 0.125f * e1);
                ko[e] = pack_bf16(__uint_as_float(ka[e] << 16) / e0, __uint_as_float(ka[e] & 0xFFFF0000u) / e1);
            }
            *(u32x4*)(QI + tile_off(c, dq * 2 + k)) = qo;
            *(u32x4*)(KI + tile_off(c, dq * 2 + k)) = ko;
        }
    }
    gla_stage_vt(proj, row0, h, VT);
    {
        const int v = tid >> 1, half = tid & 1;
        const float* ps = prev + (size_t)vb * 8192 + v * 64 + half * 32;
#pragma unroll
        for (int k = 0; k < 4; ++k) {
            const f32x4 a = *(const f32x4*)(ps + k * 8), c2 = *(const f32x4*)(ps + k * 8 + 4);
            u32x4 o; o[0] = pack_bf16(a[0], a[1]); o[1] = pack_bf16(a[2], a[3]); o[2] = pack_bf16(c2[0], c2[1]); o[3] = pack_bf16(c2[2], c2[3]);
            *(u32x4*)(PT + tile_off(v, half * 4 + k)) = o;
        }
    }
    __syncthreads();
    const bf16x8 qf0 = *(const bf16x8*)(QI + tile_off(wid * 16 + fr, fq)), qf1 = *(const bf16x8*)(QI + tile_off(wid * 16 + fr, 4 + fq));
    bf16x8 pf[2];
    const int c = wid * 16 + fr;
#pragma unroll
    for (int p = 0; p < 2; ++p) {
        u32x4 w;
#pragma unroll
        for (int s = 0; s < 2; ++s) {
            const int row = 32 * p + 8 * (fr >> 2) + 4 * s + (fr & 3);
            const bf16x8 k0 = *(const bf16x8*)(KI + tile_off(row, fq)), k1 = *(const bf16x8*)(KI + tile_off(row, 4 + fq));
            f32x4 a = (f32x4){0.f, 0.f, 0.f, 0.f};
            a = __builtin_amdgcn_mfma_f32_16x16x32_bf16(k0, qf0, a, 0, 0, 0);
            a = __builtin_amdgcn_mfma_f32_16x16x32_bf16(k1, qf1, a, 0, 0, 0);
#pragma unroll
            for (int i = 0; i < 4; ++i) { const int j = 32 * p + 8 * fq + 4 * s + i; if (j > c) a[i] = 0.f; }
            w[2 * s] = pack_bf16(a[0], a[1]); w[2 * s + 1] = pack_bf16(a[2], a[3]);
        }
        pf[p] = __builtin_bit_cast(bf16x8, w);
    }
    f32x4 acc[8];
    float ss = 0.f;
#pragma unroll
    for (int vt = 0; vt < 8; ++vt) {
        f32x4 a = (f32x4){0.f, 0.f, 0.f, 0.f};
        a = __builtin_amdgcn_mfma_f32_16x16x32_bf16(*(const bf16x8*)(VT + tile_off(vt * 16 + fr, fq)), pf[0], a, 0, 0, 0);
        a = __builtin_amdgcn_mfma_f32_16x16x32_bf16(*(const bf16x8*)(VT + tile_off(vt * 16 + fr, 4 + fq)), pf[1], a, 0, 0, 0);
        a = __builtin_amdgcn_mfma_f32_16x16x32_bf16(*(const bf16x8*)(PT + tile_off(vt * 16 + fr, fq)), qf0, a, 0, 0, 0);
        a = __builtin_amdgcn_mfma_f32_16x16x32_bf16(*(const bf16x8*)(PT + tile_off(vt * 16 + fr, 4 + fq)), qf1, a, 0, 0, 0);
        acc[vt] = a;
        ss += a[0] * a[0] + a[1] * a[1] + a[2] * a[2] + a[3] * a[3];
    }
    ss += __shfl_xor(ss, 16); ss += __shfl_xor(ss, 32);
    const float r = rsqrtf(ss * (1.0f / 128.0f) + 1e-6f);
    const size_t row = row0 + c;
#pragma unroll
    for (int vt = 0; vt < 8; ++vt) {
        const int col = h * 128 + vt * 16 + 4 * fq;
        const uint2 rr = *(const uint2*)(proj + row * PP + RB + col);
        const f32x4 g4 = *(const f32x4*)(norm_g + col);
        const float r0 = __uint_as_float(rr.x << 16), r1 = __uint_as_float(rr.x & 0xFFFF0000u), r2 = __uint_as_float(rr.y << 16), r3 = __uint_as_float(rr.y & 0xFFFF0000u);
        f32x4 o;
        o[0] = acc[vt][0] * r * g4[0] * (r0 * sigmoidf_(r0)); o[1] = acc[vt][1] * r * g4[1] * (r1 * sigmoidf_(r1));
        o[2] = acc[vt][2] * r * g4[2] * (r2 * sigmoidf_(r2)); o[3] = acc[vt][3] * r * g4[3] * (r3 * sigmoidf_(r3));
        *(uint2*)(yb + row * 512 + col) = pack4(o);
    }
}

constexpr int SMEM_BYTES = 131072;

__global__ void __launch_bounds__(512, 2) k_fwd(Params p) {
    extern __shared__ __attribute__((aligned(16))) char smem_dyn[];
    char* smem = smem_dyn + 16;
    char* smh = smem + (threadIdx.x >> 8) * 65536;
    if (threadIdx.x == 0) *(uint4*)smem_dyn = make_uint4(0u, 0u, 0u, 0u);
    __syncthreads();
    char* ws = p.ws;
    XcdBarrier bar = xcd_barrier_post((unsigned*)(ws + OFF_BAR), (volatile LAS unsigned*)smem_dyn);
    int* ctrl = (int*)(ws + OFF_CTRL);
    bf16_t* proj = (bf16_t*)(ws + OFF_PROJ);
    float* bc = (float*)(ws + OFF_BC);
    float* cstate = (float*)(ws + OFF_CSTATE);
    bf16_t* mrg = (bf16_t*)p.out + (size_t)T * 1024;
    bf16_t* h2 = (bf16_t*)(ws + OFF_H2);
    bf16_t* hid = (bf16_t*)(ws + OFF_HID);
    bf16_t* Y0 = (bf16_t*)(ws + OFF_Y0);
    bf16_t* Y1 = (bf16_t*)(ws + OFF_Y1);
    bf16_t* ya = (bf16_t*)(ws + OFF_YA);
    bf16_t* yb = (bf16_t*)(ws + OFF_YB);
    bf16_t* kcb = (bf16_t*)(ws + OFF_KCB);
    bf16_t* vcb = (bf16_t*)(ws + OFF_VCB);
    bf16_t* h = (bf16_t*)p.out;
    const int G = gridDim.x;

    ph_prep(p, smh);
    const int fsh = (2304 + G - 1) / G;
    xcd_arrive2(bar); ph_filler(p, 0, fsh / 4, smh); xcd_wait2(bar);
    { g8::StaticOrder S; S.init(T, 3072, G, (int)blockIdx.x); const g8::AddrPlain AD{(const char*)h, (const char*)(ws + OFF_WINT), 2048u, 2048u, 16};
      g8::gemm_phase(smem, S, AD, g8::EpiProj{proj}); }
    xcd_arrive2(bar); ph_filler(p, fsh / 4, fsh / 2, smh); xcd_wait2(bar);
    ph_cmp1(proj, ws, (float*)(ws + OFF_YA), smh);
    {
        const int nc = G > 64 ? 32 : 0, gb = (int)blockIdx.x - nc, gs = G - nc;
        if (gb >= 0) {
            for (int pr = gb; pr < 512; pr += gs) vtrans_tile(2 * pr + HB_ID, proj, ws, smh);
            for (int pr = gb; pr < 512; pr += gs) gla_a_unit(2 * pr + HB_ID, proj, p.w_alpha, p.b_alpha, bc, cstate, smh);
        }
    }
    xcd_arrive2(bar); ph_filler(p, fsh / 2, (3 * fsh) / 4, smh); xcd_wait2(bar);
    ph_cmp2(ws, ws, (const float*)(ws + OFF_YA), smh);
    for (int vb = blockIdx.x; vb < 256; vb += G) gla_scan_vb2(vb, bc, cstate);
    xcd_arrive2(bar); ph_filler(p, (3 * fsh) / 4, fsh, smh); xcd_wait2(bar);
    for (int vb = HB_FIRST; vb < 1024; vb += HB_STEP) gla_c_unit(vb, proj, bc, cstate, p.norm_g, yb, smh);
    for (int r = 0; r * G < 512; ++r) {
        const int u = r * G + ((r & 1) ? (G - 1 - (int)blockIdx.x) : (int)blockIdx.x);
        if (u < 512) nsa_unit(u, proj, ws, p.rel_bias, ya, smem);
    }
    xcd_arrive2(bar);
    {
        g8::MergeOrder MO; MO.so.init(T, 1024, G, (int)blockIdx.x); MO.bar = (unsigned*)(ws + OFF_BAR); MO.st = (volatile LAS unsigned*)smem_dyn;
        const g8::AddrMerge AD{(const char*)h, (const char*)(ws + OFF_WINT), (const char*)ya, (const char*)yb, (const char*)(ws + OFF_WAT), (const char*)(ws + OFF_WBT)};
        g8::gemm_phase(smem, MO, AD, g8::EpiMergeAll{mrg, (bf16_t*)(ws + OFF_R1)});
    }
    xcd_barrier(bar);
    { g8::StaticOrder S; S.init(T, 1024, G, (int)blockIdx.x); const g8::AddrPlain AD{(const char*)mrg, (const char*)(ws + OFF_WOT), 2048u, 2048u, 16};
      g8::gemm_phase(smem, S, AD, g8::EpiDelta{ya}); }
    xcd_barrier(bar);
    for (int grp = HB_FIRST; grp < 512; grp += HB_STEP) {
        for (int tt = 0; tt < 2; ++tt) router_unit(grp * 2 + tt, p.x, ya, p.g_ffn, (const bf16_t*)(ws + OFF_WRT), p.b_rg, p.b_re, h2, (float*)(ws + OFF_RSTD), smh);
        router_append(grp, (int*)(ws + OFF_LTOK), (float*)(ws + OFF_LW), ctrl, smh);
    }
    xcd_barrier(bar);
    ph_moe1(h2, (const bf16_t*)(ws + OFF_WGT), (const bf16_t*)(ws + OFF_WUT), ctrl, (const int*)(ws + OFF_LTOK), (const float*)(ws + OFF_LW), (const float*)(ws + OFF_RSTD), hid, smem);
    ph_prep_experts_down(p, ctrl, smh);
    xcd_barrier(bar);
    ph_moe2w(hid, (const bf16_t*)(ws + OFF_WDT), ctrl, (const int*)(ws + OFF_LTOK), Y0, ws + OFF_KCB, smem);
    xcd_barrier(bar);
    { int t_ = threadIdx.x; asm volatile("" : "+v"(t_)); for (int row = blockIdx.x * 8 + (t_ >> 6); row < T; row += G * 8) final_row(row, p.x, ya, p.out, Y0, Y1, p.g_final, t_ & 63); }
}

extern "C" void kernel_launch(void* const* d_in, const int* in_sizes, int n_in, void* d_out, int out_size, void* d_ws, size_t ws_size, hipStream_t stream) {
    static int grid = 0;
    constexpr int kDynLds = SMEM_BYTES + 16;
    if (!grid) {
        int dev = 0, cus = 0, per_cu = 0;
        (void)hipGetDevice(&dev);
        (void)hipDeviceGetAttribute(&cus, hipDeviceAttributeMultiprocessorCount, dev);
        (void)hipFuncSetAttribute((const void*)k_fwd, hipFuncAttributeMaxDynamicSharedMemorySize, kDynLds);
        (void)hipOccupancyMaxActiveBlocksPerMultiprocessor(&per_cu, k_fwd, 512, kDynLds);
        if (per_cu > 1) per_cu = 1;
        if (per_cu < 1) per_cu = 1;
        grid = cus * per_cu;
    }
    char* ws = (char*)d_ws;
    (void)hipMemsetAsync(ws + OFF_CTRL, 0, 49152, stream);
    Params p{};
    const float** pf = (const float**)&p;
    for (int i = 0; i < 25; ++i) pf[i] = (const float*)d_in[i];
    p.out = (float*)d_out; p.ws = ws;
    k_fwd<<<grid, 512, kDynLds, stream>>>(p);
}
```

```cpp
#include <hip/hip_runtime.h>
#include <stdint.h>

typedef unsigned short bf16_t;
typedef short bf16x8 __attribute__((ext_vector_type(8)));
typedef float f32x4 __attribute__((ext_vector_type(4)));
typedef unsigned u32x4 __attribute__((ext_vector_type(4)));
__device__ __forceinline__ float bf2f(bf16_t v) { return __uint_as_float(((unsigned)v) << 16); }
__device__ __forceinline__ bf16_t f2bf(float f) { unsigned u = __float_as_uint(f); u += 0x7FFFu + ((u >> 16) & 1u); return (bf16_t)(u >> 16); }
typedef float f32x2c_t __attribute__((ext_vector_type(2)));
typedef __bf16 bf16x2c_t __attribute__((ext_vector_type(2)));
__device__ __forceinline__ unsigned pack_bf16(float lo, float hi) { const f32x2c_t v = {lo, hi}; return __builtin_bit_cast(unsigned, __builtin_convertvector(v, bf16x2c_t)); }

constexpr int Bn = 4, S = 4096, T = Bn * S, D = 1024, NIN = 4904, PP = 2880;
constexpr int QA = 0, KC = 512, VC = 640, KS = 768, VS = 896, KW = 1024, VW = 1152, GA = 1280, QB = 1304, KB = 1560, VB = 1816, AB = 2328, RB = 2344, MGA = 2856, MGB = 3880;
constexpr int NPROJ = 2856;
constexpr int MSLOT = 36864;

constexpr size_t OFF_CTRL = 0;
constexpr size_t OFF_BAR = 16384;
constexpr size_t OFF_ROUTE_E = 49152;
constexpr size_t OFF_ROUTE_W = OFF_ROUTE_E + 32768 * 4;
constexpr size_t OFF_SLOT_TOK = OFF_ROUTE_W + 32768 * 4;
constexpr size_t OFF_SLOT_W = OFF_SLOT_TOK + (size_t)MSLOT * 4;
constexpr size_t OFF_BIAS1 = OFF_SLOT_W + (size_t)MSLOT * 4;
constexpr size_t OFF_RSTD = OFF_BIAS1 + 8192;
constexpr size_t OFF_SLOT_RS = OFF_RSTD + (size_t)T * 4;
constexpr size_t OFF_WRT = OFF_SLOT_RS + (size_t)MSLOT * 4;
static_assert(OFF_WRT + 2 * 48 * 1024 * 2 <= (1u << 20), "ctrl overflow");
constexpr size_t OFF_R1 = 1u << 20;
constexpr size_t SZ_PROJ = (size_t)T * PP * 2;
constexpr size_t OFF_PROJ = OFF_R1;
constexpr size_t OFF_BC = OFF_PROJ + SZ_PROJ;
constexpr size_t OFF_CSTATE = OFF_BC + (size_t)T * 256 * 4;
constexpr size_t OFF_R1_END = OFF_CSTATE + (size_t)1024 * 8192 * 4;
constexpr size_t OFF_MRG = OFF_R1 + (size_t)T * 2048 * 2;
constexpr size_t OFF_H2 = OFF_R1;
constexpr size_t OFF_HID = OFF_H2 + (size_t)T * 1024 * 2;
constexpr size_t OFF_Y0 = OFF_HID + (size_t)2 * T * 256 * 2;
constexpr size_t OFF_Y1 = OFF_Y0 + (size_t)T * 1024 * 2;
static_assert(OFF_MRG + (size_t)T * 1024 * 2 <= OFF_R1_END, "alias overflow");
static_assert(OFF_Y1 + (size_t)T * 1024 * 2 <= OFF_R1_END, "alias overflow");
constexpr size_t OFF_YA = OFF_R1_END;
constexpr size_t OFF_YB = OFF_YA + (size_t)T * 512 * 2;
constexpr size_t OFF_KCB = OFF_YB + (size_t)T * 512 * 2;
constexpr size_t OFF_VCB = OFF_KCB + 8 * 256 * 64 * 2;
constexpr size_t OFF_VCBT = OFF_VCB + 8 * 256 * 64 * 2;
constexpr size_t OFF_HIDC = OFF_VCBT + 8 * 256 * 64 * 2;
constexpr size_t OFF_VST = OFF_HIDC + 2 * 2048 * 128 * 2;
constexpr size_t OFF_VWT = OFF_VST + (size_t)8 * 64 * S * 2;
constexpr size_t OFF_WINT = OFF_VWT + (size_t)8 * 64 * S * 2;
constexpr size_t OFF_CK1T = OFF_WINT + (size_t)NIN * 1024 * 2;
constexpr size_t OFF_CV1T = OFF_CK1T + 128 * 2048 * 2;
constexpr size_t OFF_CK2T = OFF_CV1T + 128 * 2048 * 2;
constexpr size_t OFF_CV2T = OFF_CK2T + 128 * 128 * 2;
constexpr size_t OFF_WAT = OFF_CV2T + 128 * 128 * 2;
constexpr size_t OFF_WBT = OFF_WAT + 1024 * 512 * 2;
constexpr size_t OFF_WOT = OFF_WBT + 1024 * 512 * 2;
constexpr size_t OFF_WGT = OFF_WOT + 1024 * 1024 * 2;
constexpr size_t OFF_WUT = OFF_WGT + (size_t)32 * 256 * 1024 * 2;
constexpr size_t OFF_WDT = OFF_WUT + (size_t)32 * 256 * 1024 * 2;
constexpr size_t OFF_LTOK = OFF_WDT + (size_t)32 * 1024 * 256 * 2;
constexpr size_t OFF_LW = OFF_LTOK + (size_t)32 * 16384 * 4;
constexpr size_t OFF_END = OFF_LW + (size_t)32 * 16384 * 4;
static_assert(OFF_END <= (size_t)256 << 20, "workspace overflow");

#define XB_TMO      128
#define XB_XCNT(j)  (256  + 64 * (j))
#define XB_XSUB(j)  (1280 + 64 * (j))
#define XB_XGEN(j)  (2304 + 64 * (j))
#define XB_TOP      3328
#define XB_TOPGEN   3392
#define XCD_BAR_WORDS 3456
#define XB_SPIN_CAP (1u << 18)
#define LAS __attribute__((address_space(3)))

__device__ __forceinline__ unsigned xb_ld(unsigned* p)              { return __hip_atomic_load(p, __ATOMIC_RELAXED, __HIP_MEMORY_SCOPE_AGENT); }
__device__ __forceinline__ unsigned xb_add(unsigned* p, unsigned v) { return __hip_atomic_fetch_add(p, v, __ATOMIC_RELAXED, __HIP_MEMORY_SCOPE_AGENT); }
__device__ __forceinline__ unsigned xb_xcc_id() { return (unsigned)__builtin_amdgcn_s_getreg((3 << 11) | 20) & 0xFu; }
#define XB_SPIN(cond, bar) do { unsigned _sp = 0; while (cond) { __builtin_amdgcn_s_sleep(1); \
    if ((++_sp & 255u) == 0u) { if (xb_ld(&(bar)[XB_TMO])) break; if (_sp > XB_SPIN_CAP) { atomicAdd(&(bar)[XB_TMO], 1u); break; } } } } while (0)

struct XcdBarrier { unsigned* bar; unsigned x; volatile LAS unsigned* st; };

__device__ __forceinline__ XcdBarrier xcd_barrier_post(unsigned* bar, volatile LAS unsigned* st) {
    XcdBarrier b; b.bar = bar; b.x = xb_xcc_id(); b.st = st;
    if (threadIdx.x == 0) (void)xb_add(&bar[XB_XCNT(b.x)], 1u);
    return b;
}
__device__ __forceinline__ void xcd_barrier_complete(unsigned* bar, unsigned x, unsigned& nloc, unsigned& nx) {
    const unsigned G = gridDim.x * gridDim.y * gridDim.z;
    unsigned sum, cnt, mine, sp = 0u;
    for (;;) {
        sum = 0u; cnt = 0u; mine = 0u;
#pragma unroll
        for (unsigned j = 0; j < 16; ++j) { const unsigned c = xb_ld(&bar[XB_XCNT(j)]); sum += c; cnt += (c > 0u) ? 1u : 0u; mine = (j == x) ? c : mine; }
        if (sum == G) break;
        __builtin_amdgcn_s_sleep(1);
        if ((++sp & 255u) == 0u) { if (xb_ld(&bar[XB_TMO])) break; if (sp > XB_SPIN_CAP) { atomicAdd(&bar[XB_TMO], 1u); break; } }
    }
    nloc = mine > 0u ? mine : 1u; nx = cnt > 0u ? cnt : 1u;
}
__device__ __forceinline__ void xcd_barrier(const XcdBarrier& b) {
    asm volatile("s_waitcnt vmcnt(0)" ::: "memory");
    __syncthreads();
    if (threadIdx.x == 0) {
        unsigned* bar = b.bar;
        __builtin_amdgcn_s_waitcnt(0);
        unsigned nloc = b.st[0], nx = b.st[1];
        if (nloc == 0u) { xcd_barrier_complete(bar, b.x, nloc, nx); b.st[0] = nloc; b.st[1] = nx; }
        const unsigned old = xb_add(&bar[XB_XSUB(b.x)], 1u);
        const unsigned gen = old / nloc;
        if (nloc > 2u && old == gen * nloc + (nloc >> 1)) asm volatile("buffer_wbl2 sc1" ::: "memory");
        if (old + 1u == (gen + 1u) * nloc) {
            __builtin_amdgcn_fence(__ATOMIC_RELEASE, "agent");
            asm volatile("s_waitcnt vmcnt(0)" ::: "memory");
            const unsigned og = xb_add(&bar[XB_TOP], 1u);
            const unsigned tg = og / nx;
            if (og + 1u == (tg + 1u) * nx) xb_add(&bar[XB_TOPGEN], 1u);
            else XB_SPIN(xb_ld(&bar[XB_TOPGEN]) == tg, bar);
            __builtin_amdgcn_fence(__ATOMIC_ACQUIRE, "agent");
            xb_add(&bar[XB_XGEN(b.x)], 1u);
            asm volatile("s_waitcnt vmcnt(0)" ::: "memory");
        } else {
            XB_SPIN(xb_ld(&bar[XB_XGEN(b.x)]) == gen, bar);
            __builtin_amdgcn_fence(__ATOMIC_ACQUIRE, "agent");
            asm volatile("s_waitcnt vmcnt(0)" ::: "memory");
        }
    }
    __syncthreads();
}

#define XB2_XSUB(j) (4096 + 64 * (j))
#define XB2_TOP     5120
#define XB2_TOPGEN  5184
__device__ __forceinline__ void xcd_arrive2(const XcdBarrier& b) {
    asm volatile("s_waitcnt vmcnt(0)" ::: "memory");
    __syncthreads();
    if (threadIdx.x == 0) {
        unsigned* bar = b.bar;
        __builtin_amdgcn_s_waitcnt(0);
        unsigned nloc = b.st[0], nx = b.st[1];
        if (nloc == 0u) { xcd_barrier_complete(bar, b.x, nloc, nx); b.st[0] = nloc; b.st[1] = nx; }
        const unsigned old = xb_add(&bar[XB2_XSUB(b.x)], 1u);
        const unsigned gen = old / nloc;
        if (old + 1u == (gen + 1u) * nloc) {
            __builtin_amdgcn_fence(__ATOMIC_RELEASE, "agent");
            asm volatile("s_waitcnt vmcnt(0)" ::: "memory");
            const unsigned og = xb_add(&bar[XB2_TOP], 1u);
            const unsigned tg = og / nx;
            if (og + 1u == (tg + 1u) * nx) xb_add(&bar[XB2_TOPGEN], 1u);
        }
        b.st[2] = gen;
    }
}
__device__ __forceinline__ void xcd_wait2(const XcdBarrier& b) {
    if (threadIdx.x == 0) {
        unsigned* bar = b.bar;
        const unsigned gen = b.st[2];
        XB_SPIN(xb_ld(&bar[XB2_TOPGEN]) <= gen, bar);
        __builtin_amdgcn_fence(__ATOMIC_ACQUIRE, "agent");
        asm volatile("s_waitcnt vmcnt(0)" ::: "memory");
    }
    __syncthreads();
}


__device__ __forceinline__ int hb_tid_() { int t = threadIdx.x; asm volatile("" : "+v"(t)); return t & 255; }
#define HB_TID (hb_tid_())
#define HB_ID ((int)(threadIdx.x >> 8))
#define HB_FIRST (2 * (int)blockIdx.x + HB_ID)
#define HB_STEP (2 * (int)gridDim.x)
struct Params {
    const float *x, *g_mix, *w_in, *pe_k, *ck1, *ck2, *pe_v, *cv1, *cv2, *rel_bias, *w_alpha, *b_alpha, *norm_g, *w_ba, *w_bb, *w_out, *g_ffn,
                *w_rg, *b_rg, *w_re, *b_re, *w_eg, *w_eu, *w_ed, *g_final;
    float* out; char* ws;
};

__device__ __forceinline__ float wave_max(float v) { for (int o = 32; o > 0; o >>= 1) v = fmaxf(v, __shfl_xor(v, o)); return v; }
__device__ __forceinline__ float wave_sum(float v) { for (int o = 32; o > 0; o >>= 1) v += __shfl_xor(v, o); return v; }
__device__ __forceinline__ void wave_lds_sync() { asm volatile("s_waitcnt lgkmcnt(0)" ::: "memory"); }


__device__ __forceinline__ void rms_h_row(int row, const float* __restrict__ x, const float* __restrict__ g, bf16_t* __restrict__ h, int lane) {
    const float* xr = x + (size_t)row * D + lane * 4;
    f32x4 v[4]; float s = 0.f;
#pragma unroll
    for (int i = 0; i < 4; ++i) { v[i] = *(const f32x4*)(xr + 256 * i); s += v[i][0] * v[i][0] + v[i][1] * v[i][1] + v[i][2] * v[i][2] + v[i][3] * v[i][3]; }
    s = wave_sum(s);
    const float r = rsqrtf(s * (1.0f / D) + 1e-6f);
#pragma unroll
    for (int i = 0; i < 4; ++i) {
        const f32x4 gg = *(const f32x4*)(g + lane * 4 + 256 * i);
        uint2 o; o.x = pack_bf16(v[i][0] * r * gg[0], v[i][1] * r * gg[1]); o.y = pack_bf16(v[i][2] * r * gg[2], v[i][3] * r * gg[3]);
        *(uint2*)(h + (size_t)row * D + lane * 4 + 256 * i) = o;
    }
}
__device__ __forceinline__ void final_row(int row, const bf16_t* __restrict__ x2b, float* __restrict__ outp, const bf16_t* __restrict__ Y0, const bf16_t* __restrict__ Y1, const float* __restrict__ g, int lane) {
    f32x4 v[4]; float s = 0.f;
#pragma unroll
    for (int i = 0; i < 4; ++i) {
        const size_t off = (size_t)row * D + lane * 4 + 256 * i;
        const uint2 a = *(const uint2*)(Y0 + off), c = *(const uint2*)(Y1 + off), e = *(const uint2*)(x2b + off);
        v[i][0] = __uint_as_float(e.x << 16) + (__uint_as_float(a.x << 16) + __uint_as_float(c.x << 16));
        v[i][1] = __uint_as_float(e.x & 0xFFFF0000u) + (__uint_as_float(a.x & 0xFFFF0000u) + __uint_as_float(c.x & 0xFFFF0000u));
        v[i][2] = __uint_as_float(e.y << 16) + (__uint_as_float(a.y << 16) + __uint_as_float(c.y << 16));
        v[i][3] = __uint_as_float(e.y & 0xFFFF0000u) + (__uint_as_float(a.y & 0xFFFF0000u) + __uint_as_float(c.y & 0xFFFF0000u));
        s += v[i][0] * v[i][0] + v[i][1] * v[i][1] + v[i][2] * v[i][2] + v[i][3] * v[i][3];
    }
    s = wave_sum(s);
    const float r = rsqrtf(s * (1.0f / D) + 1e-6f);
#pragma unroll
    for (int i = 0; i < 4; ++i) {
        const f32x4 gg = *(const f32x4*)(g + lane * 4 + 256 * i);
        *(f32x4*)(outp + (size_t)row * D + lane * 4 + 256 * i) = (f32x4){v[i][0] * r * gg[0], v[i][1] * r * gg[1], v[i][2] * r * gg[2], v[i][3] * r * gg[3]};
    }
}

__device__ __forceinline__ void prep_router_w(const float* __restrict__ w_rg, const float* __restrict__ w_re, const float* __restrict__ g, bf16_t* __restrict__ WrT) {
    for (int idx = blockIdx.x * 512 + threadIdx.x; idx < 48 * 1024; idx += gridDim.x * 512) {
        const int n = idx >> 10, k = idx & 1023;
        const float w = (n < 4 ? w_rg[k * 4 + n] : (n < 36 ? w_re[k * 32 + n - 4] : 0.f)) * g[k];
        const bf16_t hi = f2bf(w);
        const int fi = ((((n >> 4) * 32 + (k >> 5)) * 64 + ((k >> 3) & 3) * 16 + (n & 15)) << 3) + (k & 7);
        WrT[fi] = hi; WrT[48 * 1024 + fi] = f2bf(w - bf2f(hi));
    }
}

constexpr int RT_PART = 0, RT_SSP = 2 * 4 * 16 * 49 * 4, RT_BL = RT_SSP + 512, RT_DEC = RT_BL + 256;
__device__ __forceinline__ void router_pair(int grp, const bf16_t* __restrict__ x2b, const bf16_t* __restrict__ WrT,
                                            const float* __restrict__ b_rg, const float* __restrict__ b_re, float* __restrict__ rstd_out, char* smem) {
    float (*part)[4][16][49] = (float (*)[4][16][49])(smem + RT_PART);
    float (*ssp)[4][16] = (float (*)[4][16])(smem + RT_SSP);
    float* bl = (float*)(smem + RT_BL);
    int* dec_e = (int*)(smem + RT_DEC); float* dec_w = (float*)(smem + RT_DEC + 512);
    const int tid = HB_TID, lane = tid & 63, w4 = tid >> 6, fr = lane & 15, fq = lane >> 4, r0 = grp * 32;
    const bf16_t* wh = WrT + ((size_t)(w4 * 8) * 64 + lane) * 8;
    u32x4 xa[2][8];
#pragma unroll
    for (int t = 0; t < 2; ++t) {
        const bf16_t* xr = x2b + (size_t)(r0 + 16 * t + fr) * D + fq * 8 + w4 * 256;
#pragma unroll
        for (int ks = 0; ks < 8; ++ks) xa[t][ks] = *(const u32x4*)(xr + ks * 32);
    }
    f32x4 acc[2][3];
#pragma unroll
    for (int t = 0; t < 2; ++t)
#pragma unroll
        for (int nt = 0; nt < 3; ++nt) acc[t][nt] = (f32x4){0.f, 0.f, 0.f, 0.f};
    float ssq[2] = {0.f, 0.f};
    bf16x8 bhb[2][3], blb[2][3];
#define RT_LOADW(ks_, b_) do { _Pragma("unroll") for (int nt = 0; nt < 3; ++nt) { bhb[b_][nt] = *(const bf16x8*)(wh + (size_t)(nt * 32 + (ks_)) * 512); \
            blb[b_][nt] = *(const bf16x8*)(wh + 48 * 1024 + (size_t)(nt * 32 + (ks_)) * 512); } } while (0)
    RT_LOADW(0, 0);
#pragma unroll
    for (int ks = 0; ks < 8; ++ks) {
        const int cb = ks & 1;
        if (ks + 1 < 8) RT_LOADW(ks + 1, cb ^ 1);
#pragma unroll
        for (int t = 0; t < 2; ++t) {
            const u32x4 a = xa[t][ks];
#pragma unroll
            for (int e = 0; e < 4; ++e) { const float v0 = __uint_as_float(a[e] << 16), v1 = __uint_as_float(a[e] & 0xFFFF0000u); ssq[t] += v0 * v0 + v1 * v1; }
            const bf16x8 af = __builtin_bit_cast(bf16x8, a);
#pragma unroll
            for (int nt = 0; nt < 3; ++nt) {
                acc[t][nt] = __builtin_amdgcn_mfma_f32_16x16x32_bf16(af, bhb[cb][nt], acc[t][nt], 0, 0, 0);
                acc[t][nt] = __builtin_amdgcn_mfma_f32_16x16x32_bf16(af, blb[cb][nt], acc[t][nt], 0, 0, 0);
            }
        }
    }
#undef RT_LOADW
#pragma unroll
    for (int t = 0; t < 2; ++t) { ssq[t] += __shfl_xor(ssq[t], 16); ssq[t] += __shfl_xor(ssq[t], 32); }
    __syncthreads();
    if (tid < 36) bl[tid] = tid < 4 ? b_rg[tid] : b_re[tid - 4];
#pragma unroll
    for (int t = 0; t < 2; ++t) {
        if (fq == 0) ssp[t][w4][fr] = ssq[t];
#pragma unroll
        for (int nt = 0; nt < 3; ++nt)
#pragma unroll
            for (int i = 0; i < 4; ++i) part[t][w4][4 * fq + i][nt * 16 + fr] = acc[t][nt][i];
    }
    __syncthreads();
    if (tid < 32) {
        const int t = tid >> 4, rl = tid & 15, row = r0 + tid;
        const float rsv = rsqrtf((ssp[t][0][rl] + ssp[t][1][rl] + ssp[t][2][rl] + ssp[t][3][rl]) * (1.0f / D) + 1e-6f);
        rstd_out[row] = rsv;
        float l4[4];
#pragma unroll
        for (int j = 0; j < 4; ++j) l4[j] = (part[t][0][rl][j] + part[t][1][rl][j] + part[t][2][rl][j] + part[t][3][rl][j]) * rsv + bl[j];
        int gs = 0; float mx = l4[0];
#pragma unroll
        for (int j = 1; j < 4; ++j) if (l4[j] > mx) { mx = l4[j]; gs = j; }
        float den = 0.f;
#pragma unroll
        for (int j = 0; j < 4; ++j) den += __expf(l4[j] - mx);
        const float gpb = 1.f / den;
        float v0 = -3e38f, v1 = -3e38f; int i0 = 0, i1 = 0;
#pragma unroll
        for (int j = 0; j < 8; ++j) {
            const int c = 4 + gs * 8 + j;
            const float l = (part[t][0][rl][c] + part[t][1][rl][c] + part[t][2][rl][c] + part[t][3][rl][c]) * rsv + bl[c];
            if (l > v0) { v1 = v0; i1 = i0; v0 = l; i0 = j; }
            else if (l > v1) { v1 = l; i1 = j; }
        }
        const float e1 = __expf(v1 - v0);
        dec_e[tid * 2] = gs * 8 + i0; dec_e[tid * 2 + 1] = gs * 8 + i1;
        dec_w[tid * 2] = gpb / (1.f + e1); dec_w[tid * 2 + 1] = gpb * e1 / (1.f + e1);
    }
}
template <bool PAIR = false>
__device__ __forceinline__ void router_append(int group, int* __restrict__ ltok, float* __restrict__ lw, int* __restrict__ cnt, char* smem) {
    int* dec_e = (int*)(smem + RT_DEC); float* dec_w = (float*)(smem + RT_DEC + 512);
    int* hist = (int*)(smem + RT_DEC + 1024); int* base = hist + 32;
    const int tid = HB_TID;
    if (tid < 32) hist[tid] = 0;
    __syncthreads();
    int e = 0, lpos = 0;
    if (tid < 64) { e = dec_e[tid]; lpos = atomicAdd(&hist[e], 1); }
    __syncthreads();
    if (PAIR) {
        if (HB_ID == 0 && tid < 32) {
            int* hist1 = (int*)(smem + 65536 + RT_DEC + 1024); int* base1 = hist1 + 32;
            const int h0 = hist[tid], h1 = hist1[tid], tot = h0 + h1;
            const int b0 = tot ? atomicAdd(&cnt[tid * 64], tot) : 0;
            base[tid] = b0; base1[tid] = b0 + h0;
        }
    } else if (tid < 32) { const int hcount = hist[tid]; base[tid] = hcount ? atomicAdd(&cnt[tid * 64], hcount) : 0; }
    __syncthreads();
    if (tid < 64) { const int pos = e * 16384 + base[e] + lpos; ltok[pos] = (group * 32 + (tid >> 1)) * 2 + (tid & 1); lw[pos] = dec_w[tid]; }
    __syncthreads();
}

__device__ __forceinline__ void transpose_tile(const float* __restrict__ src, int ld_src, int N, bf16_t* __restrict__ dst, int ld_dst, int kt, int nt, char* smem, const float* __restrict__ ksc = nullptr) {
    float (*tl)[65] = (float (*)[65])smem;
    const int tid = HB_TID;
    const int c4 = (tid & 15) * 4, r0 = tid >> 4;
#pragma unroll
    for (int i = 0; i < 4; ++i) {
        const int k = r0 + 16 * i, n = nt * 64 + c4;
        float4 v = make_float4(0.f, 0.f, 0.f, 0.f);
        if (n < N) v = *(const float4*)(src + (size_t)(kt * 64 + k) * ld_src + n);
        if (ksc) { const float sc = ksc[kt * 64 + k]; v.x *= sc; v.y *= sc; v.z *= sc; v.w *= sc; }
        tl[k][c4] = v.x; tl[k][c4 + 1] = v.y; tl[k][c4 + 2] = v.z; tl[k][c4 + 3] = v.w;
    }
    __syncthreads();
    const int kc = (tid & 7) * 8, n0 = tid >> 3;
#pragma unroll
    for (int i = 0; i < 2; ++i) {
        const int nl = n0 + 32 * i, n = nt * 64 + nl;
        if (n < N) {
            uint4 o;
            o.x = pack_bf16(tl[kc][nl], tl[kc + 1][nl]); o.y = pack_bf16(tl[kc + 2][nl], tl[kc + 3][nl]);
            o.z = pack_bf16(tl[kc + 4][nl], tl[kc + 5][nl]); o.w = pack_bf16(tl[kc + 6][nl], tl[kc + 7][nl]);
            *(uint4*)(dst + (size_t)n * ld_dst + kt * 64 + kc) = o;
        }
    }
    __syncthreads();
}

__device__ __forceinline__ void filler_pair(const Params& p, int pr, char* smem) {
    char* ws = p.ws;
    const int t = 2 * pr + HB_ID;
    if (t < 128) transpose_tile(p.w_ba, 1024, 1024, (bf16_t*)(ws + OFF_WAT), 512, t >> 4, t & 15, smem);
    else if (t < 256) { const int q = t - 128; transpose_tile(p.w_bb, 1024, 1024, (bf16_t*)(ws + OFF_WBT), 512, q >> 4, q & 15, smem); }
    else if (t < 512) { const int q = t - 256; transpose_tile(p.w_out, 1024, 1024, (bf16_t*)(ws + OFF_WOT), 1024, q >> 4, q & 15, smem); }
    else { const int q = t - 512, e = (q & 2047) >> 6, r = q & 63;
        if (q < 2048) transpose_tile(p.w_eg + (size_t)e * 1024 * 256, 256, 256, (bf16_t*)(ws + OFF_WGT) + (size_t)e * 256 * 1024, 1024, r >> 2, r & 3, smem, p.g_ffn);
        else transpose_tile(p.w_eu + (size_t)e * 1024 * 256, 256, 256, (bf16_t*)(ws + OFF_WUT) + (size_t)e * 256 * 1024, 1024, r >> 2, r & 3, smem, p.g_ffn); }
}
__device__ __forceinline__ void ph_filler(const Params& p, int lo, int hi, char* smem) {
    for (int i = lo; i < hi; ++i) { const int pr = (int)blockIdx.x + i * (int)gridDim.x; if (pr < 2304) filler_pair(p, pr, smem); }
}
__device__ __forceinline__ void ph_prep_experts(const Params& p, char* smem) {
    char* ws = p.ws;
    for (int t = HB_FIRST; t < 4096; t += HB_STEP) {
        const int e = (t & 2047) >> 6, r = t & 63;
        if (t < 2048) transpose_tile(p.w_eg + (size_t)e * 1024 * 256, 256, 256, (bf16_t*)(ws + OFF_WGT) + (size_t)e * 256 * 1024, 1024, r >> 2, r & 3, smem);
        else transpose_tile(p.w_eu + (size_t)e * 1024 * 256, 256, 256, (bf16_t*)(ws + OFF_WUT) + (size_t)e * 256 * 1024, 1024, r >> 2, r & 3, smem);
    }
}
struct MoeTab { int c, pr, pt; };
template <int R = 128>
__device__ __forceinline__ MoeTab moe_tab(const int* __restrict__ cnt) {
    int l_ = threadIdx.x; asm volatile("" : "+v"(l_));
    const int el = l_ & 31;
    MoeTab t; t.c = cnt[el * 64]; t.pr = t.c; t.pt = (t.c + R - 1) / R;
#pragma unroll
    for (int o = 1; o < 32; o <<= 1) {
        const int a = __shfl_up(t.pr, o, 32), b = __shfl_up(t.pt, o, 32);
        if (el >= o) { t.pr += a; t.pt += b; }
    }
    return t;
}
__device__ __forceinline__ int moe_ntiles(const MoeTab& t) { return __builtin_amdgcn_readlane(t.pt, 31); }
__device__ __forceinline__ void moe_decode(const MoeTab& t, int tile, int& e, int& ti, int& ebase, int& ne) {
    const unsigned long long m = __builtin_amdgcn_ballot_w64(t.pt <= tile);
    e = __builtin_popcount((unsigned)m);
    e = e > 31 ? 31 : e;
    const int em = e > 0 ? e - 1 : 0;
    const int ptm = __builtin_amdgcn_readlane(t.pt, em), prm = __builtin_amdgcn_readlane(t.pr, em);
    ti = tile - (e > 0 ? ptm : 0); ebase = e > 0 ? prm : 0; ne = __builtin_amdgcn_readlane(t.c, e);
}
__device__ __forceinline__ void moe_expert(const MoeTab& t, int e, int& ebase, int& ne) {
    const int em = e > 0 ? e - 1 : 0;
    const int prm = __builtin_amdgcn_readlane(t.pr, em);
    ebase = e > 0 ? prm : 0; ne = __builtin_amdgcn_readlane(t.c, e);
}
struct MoeMap { int lo, hi, j, nj, x; };
__device__ __forceinline__ MoeMap moe_map(int nbu) {
    MoeMap m; const int G = gridDim.x;
    if ((G & 7) == 0) {
        m.x = (int)blockIdx.x & 7; m.j = (int)blockIdx.x >> 3; m.nj = G >> 3;
        m.lo = (m.x * nbu) >> 3; m.hi = (m.x == 7) ? nbu : (((m.x + 1) * nbu) >> 3);
    } else { m.x = -1; m.j = (int)blockIdx.x; m.nj = G; m.lo = 0; m.hi = nbu; }
    return m;
}
__device__ __forceinline__ void ph_prep_experts_down(const Params& p, const int* __restrict__ cnt, char* smem) {
    char* ws = p.ws;
    const MoeTab mt = moe_tab(cnt); const int nbu = moe_ntiles(mt) * 2;
    const MoeMap mm = moe_map(nbu);
    const int L = mm.hi - mm.lo;
    int rem = L % mm.nj; if (mm.nj - rem < mm.nj / 2) rem = 0;
    const int k = 2 * (mm.j - rem) + HB_ID, st = 2 * (mm.nj - rem);
    if (mm.j < rem) return;
    const int t0 = mm.x < 0 ? 0 : mm.x * 256, t1 = mm.x < 0 ? 2048 : t0 + 256;
    for (int t = t0 + k; t < t1; t += st) {
        const int e = t >> 6, r = t & 63;
        transpose_tile(p.w_ed + (size_t)e * 256 * 1024, 1024, 1024, (bf16_t*)(ws + OFF_WDT) + (size_t)e * 1024 * 256, 256, r >> 4, r & 15, smem);
    }
}
__device__ __forceinline__ void ph_prep(const Params& p, char* smem) {
    char* ws = p.ws;
    constexpr int N0 = 16 * 77, N1 = N0 + 64, N2 = N1 + 64, N3 = N2 + 2, N4 = N3 + 2, N5 = N4 + 128, N6 = N5 + 128, N7 = N6 + 256;
    for (int t = HB_FIRST; t < N4; t += HB_STEP) {
        if (t < N0) transpose_tile(p.w_in, NIN, NIN, (bf16_t*)(ws + OFF_WINT), 1024, t / 77, t % 77, smem);
        else if (t < N1) { const int q = t - N0; transpose_tile(p.ck1, 128, 128, (bf16_t*)(ws + OFF_CK1T), 2048, q >> 1, q & 1, smem); }
        else if (t < N2) { const int q = t - N1; transpose_tile(p.cv1, 128, 128, (bf16_t*)(ws + OFF_CV1T), 2048, q >> 1, q & 1, smem); }
        else if (t < N3) { const int q = t - N2; transpose_tile(p.ck2, 64, 64, (bf16_t*)(ws + OFF_CK2T), 128, q, 0, smem); }
        else { const int q = t - N3; transpose_tile(p.cv2, 64, 64, (bf16_t*)(ws + OFF_CV2T), 128, q, 0, smem); }
    }
    for (int t = HB_FIRST; t < 64; t += HB_STEP) {
        const int htid = HB_TID, which = t >> 5, kq = (t >> 2) & 7, n = (t & 3) * 32 + (htid & 31), ksp = htid >> 5;
        const float* pe = which ? p.pe_v : p.pe_k; const float* w1 = which ? p.cv1 : p.ck1;
        float a = 0.f;
#pragma unroll 8
        for (int k = kq * 256 + ksp * 32; k < kq * 256 + ksp * 32 + 32; ++k) a += pe[k] * w1[(size_t)k * 128 + n];
        float* red = (float*)smem;
        red[htid] = a;
        __syncthreads();
        if (htid < 32) {
            float s = 0.f;
#pragma unroll
            for (int j = 0; j < 8; ++j) s += red[j * 32 + htid];
            ((float*)(ws + OFF_BIAS1))[(which * 8 + kq) * 128 + n] = s;
        }
        __syncthreads();
    }
    prep_router_w(p.w_rg, p.w_re, p.g_ffn, (bf16_t*)(ws + OFF_WRT));
    for (int row = blockIdx.x * 8 + (threadIdx.x >> 6); row < T; row += gridDim.x * 8) rms_h_row(row, p.x, p.g_mix, (bf16_t*)p.out, threadIdx.x & 63);
}

__device__ __forceinline__ int tile_off(int row, int chunk) { return row * 128 + ((chunk ^ (row & 7)) << 4); }

__device__ __forceinline__ void glds16(const void* g, char* l) {
    __builtin_amdgcn_global_load_lds((const __attribute__((address_space(1))) unsigned*)g, (__attribute__((address_space(3))) unsigned*)l, 16, 0, 0);
}
__device__ __forceinline__ void gemm_kloop(f32x4 (&acc)[4][4], const bf16_t* const (&pa)[4], const bf16_t* const (&pb)[4], int ka, int kb, int nk, char* smem) {
    int tid_ = HB_TID; asm volatile("" : "+v"(tid_));
    const int tid = tid_, lane = tid & 63, wid = tid >> 6, wr = wid >> 1, wc = wid & 1, fr = lane & 15, fq = lane >> 4;
    const int offA = (wr * 64 + fr) * 128, offB = 16384 + (wc * 64 + fr) * 128, x = fr & 7;
    __syncthreads();
#pragma unroll
    for (int i = 0; i < 4; ++i) { glds16(pa[i], smem + i * 4096 + tid * 16); glds16(pb[i], smem + 16384 + i * 4096 + tid * 16); }
    asm volatile("s_waitcnt vmcnt(0)" ::: "memory");
    __syncthreads();
    for (int kt = 0; kt < nk; ++kt) {
        const int cur = kt & 1;
        if (kt + 1 < nk) {
            char* st = smem + (cur ^ 1) * 32768 + tid * 16;
#pragma unroll
            for (int i = 0; i < 4; ++i) { glds16(pa[i] + (size_t)(kt + 1) * ka, st + i * 4096); glds16(pb[i] + (size_t)(kt + 1) * kb, st + 16384 + i * 4096); }
        }
        const char* sa = smem + cur * 32768 + offA;
        const char* sb = smem + cur * 32768 + offB;
#pragma unroll
        for (int ks = 0; ks < 2; ++ks) {
            const int ch = ((ks * 4 + fq) ^ x) << 4;
            bf16x8 af[4], bfr[4];
#pragma unroll
            for (int mi = 0; mi < 4; ++mi) af[mi] = *(const bf16x8*)(sa + mi * 2048 + ch);
#pragma unroll
            for (int ni = 0; ni < 4; ++ni) bfr[ni] = *(const bf16x8*)(sb + ni * 2048 + ch);
#pragma unroll
            for (int mi = 0; mi < 4; ++mi)
#pragma unroll
                for (int ni = 0; ni < 4; ++ni) acc[mi][ni] = __builtin_amdgcn_mfma_f32_16x16x32_bf16(bfr[ni], af[mi], acc[mi][ni], 0, 0, 0);
        }
        asm volatile("s_waitcnt vmcnt(0)" ::: "memory");
        __syncthreads();
    }
}
__device__ __forceinline__ void acc_zero(f32x4 (&acc)[4][4]) {
#pragma unroll
    for (int mi = 0; mi < 4; ++mi)
#pragma unroll
        for (int ni = 0; ni < 4; ++ni) acc[mi][ni] = (f32x4){0.f, 0.f, 0.f, 0.f};
}
#define GEMM_LANE_VARS const int tid = HB_TID, lane = tid & 63, wid = tid >> 6, wr = wid >> 1, wc = wid & 1, fr = lane & 15, fq = lane >> 4, lrow = tid >> 3, lch8 = ((tid & 7) ^ ((tid >> 3) & 7)) * 8; (void)wr; (void)wc; (void)fr; (void)fq; (void)lrow; (void)lch8;
__device__ __forceinline__ uint2 pack4(f32x4 v) { uint2 o; o.x = pack_bf16(v[0], v[1]); o.y = pack_bf16(v[2], v[3]); return o; }
__device__ __forceinline__ float sigmoidf_(float a) { return __builtin_amdgcn_rcpf(1.f + __expf(-a)); }

__device__ __forceinline__ void ph_cmp1(const bf16_t* __restrict__ proj, const char* ws, float* __restrict__ part, char* smem) {
    GEMM_LANE_VARS
    for (int u = HB_FIRST; u < 64; u += HB_STEP) {
        const int kq = u & 1, which = (u >> 1) >> 4, tm = (u >> 1) & 15;
        const bf16_t* W1T = (const bf16_t*)(ws + (which ? OFF_CV1T : OFF_CK1T));
        const int col0 = which ? VC : KC;
        const bf16_t* pa[4]; const bf16_t* pb[4];
#pragma unroll
        for (int i = 0; i < 4; ++i) {
            const int m = tm * 128 + lrow + 32 * i, bg = m >> 8, c = (m & 255) > 254 ? 254 : (m & 255), b = bg >> 1, g = bg & 1;
            pa[i] = proj + (size_t)(b * S + 16 * c + 16 * kq) * PP + col0 + g * 64 + lch8;
            pb[i] = W1T + (size_t)(lrow + 32 * i) * 2048 + kq * 1024 + lch8;
        }
        f32x4 acc[4][4]; acc_zero(acc);
        gemm_kloop(acc, pa, pb, PP, 64, 16, smem);
        float* pt = part + ((size_t)(kq * 2 + which) * 2048) * 128;
#pragma unroll
        for (int mi = 0; mi < 4; ++mi)
#pragma unroll
            for (int ni = 0; ni < 4; ++ni) {
                const int m = tm * 128 + wr * 64 + mi * 16 + fr, n = wc * 64 + ni * 16 + 4 * fq;
                *(f32x4*)(pt + (size_t)m * 128 + n) = acc[mi][ni];
            }
    }
}
__device__ __forceinline__ void ph_cmp2(const char* ws_c, char* ws, const float* __restrict__ part, char* smem) {
    GEMM_LANE_VARS
    for (int u = HB_FIRST; u < 32; u += HB_STEP) {
        const int which = u >> 4, tm = u & 15;
        const bf16_t* W2T = (const bf16_t*)(ws_c + (which ? OFF_CV2T : OFF_CK2T));
        const bf16_t* hid = (const bf16_t*)(ws_c + OFF_HIDC) + (size_t)which * 2048 * 128;
        {
            const float* bias1 = (const float*)(ws_c + OFF_BIAS1) + which * 8 * 128;
            bf16_t* hw = (bf16_t*)(ws + OFF_HIDC) + (size_t)which * 2048 * 128;
            const int n4 = (tid & 31) * 4;
            float bs[4];
#pragma unroll
            for (int j = 0; j < 4; ++j) { float b_ = 0.f;
#pragma unroll
                for (int q8 = 0; q8 < 8; ++q8) b_ += bias1[q8 * 128 + n4 + j];
                bs[j] = b_; }
#pragma unroll 4
            for (int r = tid >> 5; r < 128; r += 8) {
                const size_t off = (size_t)(tm * 128 + r) * 128 + n4;
                f32x4 v = *(const f32x4*)(part + ((size_t)(0 * 2 + which) * 2048) * 128 + off);
#pragma unroll
                for (int kq = 1; kq < 2; ++kq) { const f32x4 w_ = *(const f32x4*)(part + ((size_t)(kq * 2 + which) * 2048) * 128 + off); v[0] += w_[0]; v[1] += w_[1]; v[2] += w_[2]; v[3] += w_[3]; }
#pragma unroll
                for (int j = 0; j < 4; ++j) { const float a = v[j] + bs[j]; const float t = 0.7978845608028654f * (a + 0.044715f * a * a * a); v[j] = a * __builtin_amdgcn_rcpf(1.f + __expf(-2.f * t)); }
                *(uint2*)(hw + off) = pack4(v);
            }
            asm volatile("s_waitcnt vmcnt(0)" ::: "memory");
            __syncthreads();
        }
        const bf16_t* pa[4]; const bf16_t* pb[4];
#pragma unroll
        for (int i = 0; i < 4; ++i) { pa[i] = hid + (size_t)(tm * 128 + lrow + 32 * i) * 128 + lch8; pb[i] = W2T + (size_t)(lrow + 32 * i) * 128 + lch8; }
        f32x4 acc[4][4]; acc_zero(acc);
        gemm_kloop(acc, pa, pb, 64, 64, 2, smem);
        if (wc == 0) {
            bf16_t* outp = (bf16_t*)(ws + (which ? OFF_VCB : OFF_KCB));
            bf16_t* outT = (bf16_t*)(ws + OFF_VCBT);
#pragma unroll
            for (int mi = 0; mi < 4; ++mi)
#pragma unroll
                for (int ni = 0; ni < 4; ++ni) {
                    const int m = tm * 128 + wr * 64 + mi * 16 + fr, n = ni * 16 + 4 * fq, c = m & 255, bg = m >> 8;
                    f32x4 v = acc[mi][ni];
                    if (c == 255) v = (f32x4){0.f, 0.f, 0.f, 0.f};
                    *(uint2*)(outp + (size_t)m * 64 + n) = pack4(v);
                    if (which) {
#pragma unroll
                        for (int j = 0; j < 4; ++j) outT[((size_t)bg * 64 + n + j) * 256 + c] = f2bf(v[j]);
                    }
                }
        }
    }
}


__device__ __forceinline__ void ph_moe1(const bf16_t* __restrict__ h2, const bf16_t* __restrict__ WgT, const bf16_t* __restrict__ WuT, const int* __restrict__ cnt,
                                        const int* __restrict__ ltok, const float* __restrict__ lw, const float* __restrict__ rstd, bf16_t* __restrict__ hid, char* smemB) {
    GEMM_LANE_VARS
    int bt_ = threadIdx.x; asm volatile("" : "+v"(bt_));
    const int btid = bt_, hb = btid >> 8;
    const int arow = btid >> 3, ach8 = ((btid & 7) ^ (arow & 7)) * 8;
    constexpr int M1R = 96;
    const MoeTab mt = moe_tab<M1R>(cnt);
    const int nbu = moe_ntiles(mt) * 2;
    const MoeMap mm = moe_map(nbu);
    const int offA = (wr * 48 + fr) * 128, offB = 16384 + hb * 16384 + (wc * 64 + fr) * 128, x = fr & 7;
    for (int bu = mm.lo + mm.j; bu < mm.hi; bu += mm.nj) {
        const int ft = (bu & 1) * 2 + hb;
        int e, ti, ebase, ne;
        moe_decode(mt, bu >> 1, e, ti, ebase, ne);
        const bf16_t* pa[2]; const bf16_t* pb[4];
#pragma unroll
        for (int i = 0; i < 2; ++i) {
            const int idx = ti * M1R + arow + 64 * i;
            const int tk = idx < ne ? ltok[e * 16384 + idx] : 0;
            pa[i] = h2 + (size_t)(tk >> 1) * 1024 + ach8;
        }
#pragma unroll
        for (int i = 0; i < 4; ++i) {
            const int rr = lrow + 32 * i;
            const int bwc = rr >> 6, bni = (rr >> 4) & 3, bj = rr & 15;
            const int f = ft * 64 + bwc * 32 + (bni >> 1) * 16 + bj;
            pb[i] = ((bni & 1) ? WuT : WgT) + ((size_t)e * 256 + f) * 1024 + lch8;
        }
        f32x4 acc[4][4]; acc_zero(acc);
        {
#define M1_ISSUE(kt_, st_) do { char* d_ = smemB + (st_) * 49152; \
            glds16(pa[0] + (size_t)(kt_) * 64, d_ + btid * 16); if (hb == 0) glds16(pa[1] + (size_t)(kt_) * 64, d_ + 8192 + btid * 16);     \
            _Pragma("unroll") for (int i = 0; i < 4; ++i) glds16(pb[i] + (size_t)(kt_) * 64, d_ + 16384 + hb * 16384 + i * 4096 + tid * 16); } while (0)
            __syncthreads();
            M1_ISSUE(0, 0); M1_ISSUE(1, 1);
            int cur = 0;
            for (int kt = 0; kt < 16; ++kt) {
                if (kt + 1 < 16) { if (hb == 0) asm volatile("s_waitcnt vmcnt(6)" ::: "memory"); else asm volatile("s_waitcnt vmcnt(5)" ::: "memory"); }
                else asm volatile("s_waitcnt vmcnt(0)" ::: "memory");
                asm volatile("s_waitcnt lgkmcnt(0)" ::: "memory"); __builtin_amdgcn_s_barrier(); asm volatile("" ::: "memory");
                const int nx1 = (cur == 2) ? 0 : cur + 1, nx2 = (nx1 == 2) ? 0 : nx1 + 1;
                if (kt + 2 < 16) M1_ISSUE(kt + 2, nx2);
                const char* sa = smemB + cur * 49152 + offA;
                const char* sb = smemB + cur * 49152 + offB;
                cur = nx1;
#pragma unroll
                for (int ks = 0; ks < 2; ++ks) {
                    const int ch = ((ks * 4 + fq) ^ x) << 4;
                    bf16x8 af[3], bfr[4];
#pragma unroll
                    for (int mi = 0; mi < 3; ++mi) af[mi] = *(const bf16x8*)(sa + mi * 2048 + ch);
#pragma unroll
                    for (int ni = 0; ni < 4; ++ni) bfr[ni] = *(const bf16x8*)(sb + ni * 2048 + ch);
#pragma unroll
                    for (int mi = 0; mi < 3; ++mi)
#pragma unroll
                        for (int ni = 0; ni < 4; ++ni) acc[mi][ni] = __builtin_amdgcn_mfma_f32_16x16x32_bf16(bfr[ni], af[mi], acc[mi][ni], 0, 0, 0);
                }
            }
#undef M1_ISSUE
        }
        {
            int tk4[3]; float w4[3], rs4[3];
#pragma unroll
            for (int mi = 0; mi < 3; ++mi) {
                const int idx = ti * M1R + wr * 48 + mi * 16 + fr, ic = idx < ne ? idx : 0;
                tk4[mi] = ltok[e * 16384 + ic]; w4[mi] = lw[e * 16384 + ic];
            }
#pragma unroll
            for (int mi = 0; mi < 3; ++mi) rs4[mi] = rstd[tk4[mi] >> 1];
#pragma unroll
            for (int mi = 0; mi < 3; ++mi) {
                const int idx = ti * M1R + wr * 48 + mi * 16 + fr;
                if (idx < ne) {
                    const float w = w4[mi], rsv = rs4[mi];
#pragma unroll
                    for (int q = 0; q < 2; ++q) {
                        const int f = ft * 64 + wc * 32 + q * 16 + 4 * fq;
                        f32x4 v;
#pragma unroll
                        for (int j = 0; j < 4; ++j) { const float a = acc[mi][2 * q][j] * rsv, uu = acc[mi][2 * q + 1][j] * rsv; v[j] = a * sigmoidf_(a) * uu * w; }
                        *(uint2*)(hid + (size_t)(ebase + idx) * 256 + f) = pack4(v);
                    }
                }
            }
        }
    }
}

__device__ __forceinline__ void moe2w_wload(const float* __restrict__ Wd, int v, float (&wv)[64]) {
    int t_ = threadIdx.x; asm volatile("" : "+v"(t_));
    const int u = (v & 7) * 32 + (v >> 3), e = u >> 3, nt = u & 7;
    const float* src_ = Wd + ((size_t)e * 256 + (t_ >> 7) * 64) * 1024 + nt * 128 + (t_ & 127);
#pragma unroll
    for (int i = 0; i < 64; ++i) wv[i] = src_[(size_t)i * 1024];
}
constexpr int M2_SLOT = 32768, M2_TOK = 3 * M2_SLOT;
__device__ __forceinline__ void ph_moe2w(const bf16_t* __restrict__ hid, const float* __restrict__ Wd, const int* __restrict__ cnt, const int* __restrict__ ltok,
                                         bf16_t* __restrict__ Y, char* dummy, char* smem, const float (&wv0)[64]) {
    int t_ = threadIdx.x; asm volatile("" : "+v"(t_));
    const int tid = t_, lane = tid & 63, wid = tid >> 6, fr = lane & 15, fq = lane >> 4, wm = wid >> 2, wn = wid & 3;
    const MoeTab mt = moe_tab(cnt);
    for (int v = blockIdx.x; v < 256; v += gridDim.x) {
        const int u = (v & 7) * 32 + (v >> 3);
        const int e = u >> 3, nt = u & 7;
        int ebase, ne; moe_expert(mt, e, ebase, ne);
        const int ntile = (ne + 127) >> 7, NS = 2 * ntile;
        if (NS == 0) continue;
        const int nfull = ne >> 7, toff = (nt * nfull) >> 3;
        bf16x8 bw[2][8];
        {
            const int n_ = tid & 127, kq_ = tid >> 7;
            float wv_[64];
            if (v == (int)blockIdx.x) {
#pragma unroll
                for (int i = 0; i < 64; ++i) wv_[i] = wv0[i];
            } else moe2w_wload(Wd, v, wv_);
            __syncthreads();
#pragma unroll
            for (int q = 0; q < 8; ++q) {
                u32x4 w_;
#pragma unroll
                for (int j = 0; j < 4; ++j) w_[j] = pack_bf16(wv_[8 * q + 2 * j], wv_[8 * q + 2 * j + 1]);
                *(u32x4*)(smem + n_ * 528 + kq_ * 128 + q * 16) = w_;
            }
            __syncthreads();
#pragma unroll
            for (int nf = 0; nf < 2; ++nf)
#pragma unroll
                for (int kf = 0; kf < 8; ++kf) bw[nf][kf] = *(const bf16x8*)(smem + (wn * 32 + nf * 16 + fr) * 528 + kf * 64 + fq * 16);
        }
        const int lr = tid >> 4, lc8 = ((tid & 15) ^ (lr & 15)) * 8;
        const bf16_t* asrc = hid + (size_t)(ebase + lr) * 256 + lc8;
        const int* tsrc = ltok + e * 16384 + 4 * lane;
        {
            const char* pb = (const char*)(hid + (size_t)ebase * 256) + (size_t)nt * ne * 64;
            for (int off = tid * 128; off < ne * 64; off += 512 * 128) { const unsigned dmy = *(const volatile unsigned*)(pb + off); asm volatile("" :: "v"(dmy)); }
        }
        __syncthreads();
#define M2_TILE(i_) (((i_) < nfull) ? (((i_) + toff >= nfull) ? (i_) + toff - nfull : (i_) + toff) : (i_))
#define M2_ISSUE(s_, slot_) do { const bf16_t* g_ = asrc + (size_t)M2_TILE((s_) >> 1) * 128 * 256 + ((s_) & 1) * 128; char* d_ = smem + (slot_) * M2_SLOT + tid * 16; \
            glds16(g_, d_); glds16(g_ + 32 * 256, d_ + 8192); glds16(g_ + 64 * 256, d_ + 16384); glds16(g_ + 96 * 256, d_ + 24576); \
            if (((s_) & 1) == 0) glds16(tsrc + M2_TILE((s_) >> 1) * 128, smem + M2_TOK + (((s_) >> 1) & 1) * 1024 + lane * 16); } while (0)
#define M2_WAIT(n_) do { if ((n_) == 9) asm volatile("s_waitcnt vmcnt(9)" ::: "memory"); else if ((n_) == 8) asm volatile("s_waitcnt vmcnt(8)" ::: "memory"); \
            else if ((n_) == 5) asm volatile("s_waitcnt vmcnt(5)" ::: "memory"); \
            else if ((n_) == 4) asm volatile("s_waitcnt vmcnt(4)" ::: "memory"); else asm volatile("s_waitcnt vmcnt(0)" ::: "memory"); \
            asm volatile("s_waitcnt lgkmcnt(0)" ::: "memory"); __builtin_amdgcn_s_barrier(); asm volatile("" ::: "memory"); } while (0)
#define M2_COMPUTE(kh_, slot_) do { const char* st_ = smem + (slot_) * M2_SLOT; \
            _Pragma("unroll") for (int kf = 0; kf < 4; ++kf) { bf16x8 a_[4]; \
                _Pragma("unroll") for (int mf = 0; mf < 4; ++mf) a_[mf] = *(const bf16x8*)(st_ + (64 * wm + 16 * mf + fr) * 256 + (((kf * 4 + fq) ^ fr) << 4)); \
                _Pragma("unroll") for (int mf = 0; mf < 4; ++mf) { \
                    acc[mf][0] = __builtin_amdgcn_mfma_f32_16x16x32_bf16(bw[0][(kh_) * 4 + kf], a_[mf], acc[mf][0], 0, 0, 0); \
                    acc[mf][1] = __builtin_amdgcn_mfma_f32_16x16x32_bf16(bw[1][(kh_) * 4 + kf], a_[mf], acc[mf][1], 0, 0, 0); } } } while (0)
        M2_ISSUE(0, 0); M2_ISSUE(1, 1);
        f32x4 acc[4][2];
#pragma unroll
        for (int mf = 0; mf < 4; ++mf) { acc[mf][0] = (f32x4){0.f, 0.f, 0.f, 0.f}; acc[mf][1] = (f32x4){0.f, 0.f, 0.f, 0.f}; }
        int s0 = 0;
        for (int rt = 0; rt < ntile; ++rt) {
            const int s1 = (s0 == 2) ? 0 : s0 + 1, s2 = (s1 == 2) ? 0 : s1 + 1;
            { const int n = (rt == 0) ? 4 : 8; M2_WAIT(n); }
            if (rt + 1 < ntile) M2_ISSUE(2 * rt + 2, s2);
            M2_COMPUTE(0, s0);
            { const int n = (rt == 0) ? ((ntile > 1) ? 5 : 0) : ((rt + 1 < ntile) ? 9 : 4); M2_WAIT(n); }
            if (rt + 1 < ntile) M2_ISSUE(2 * rt + 3, s0);
            M2_COMPUTE(1, s1);
            asm volatile("s_waitcnt lgkmcnt(0)" ::: "memory"); __builtin_amdgcn_s_barrier(); asm volatile("" ::: "memory");
            char* stg = smem + s1 * M2_SLOT;
#pragma unroll
            for (int mf = 0; mf < 4; ++mf)
#pragma unroll
                for (int nf = 0; nf < 2; ++nf) {
                    const int row = 64 * wm + 16 * mf + fr, chunk = 4 * wn + 2 * nf + (fq >> 1);
                    *(uint2*)(stg + row * 256 + ((chunk ^ (row & 15)) << 4) + (fq & 1) * 8) = pack4(acc[mf][nf]);
                    acc[mf][nf] = (f32x4){0.f, 0.f, 0.f, 0.f};
                }
            asm volatile("s_waitcnt lgkmcnt(0)" ::: "memory"); __builtin_amdgcn_s_barrier(); asm volatile("" ::: "memory");
            const int* tl = (const int*)(smem + M2_TOK + (rt & 1) * 1024);
#pragma unroll
            for (int q = 0; q < 4; ++q) {
                const int row = q * 32 + (tid >> 4), c16 = tid & 15, idx = M2_TILE(rt) * 128 + row;
                const int tk = tl[row];
                const u32x4 v = *(const u32x4*)(stg + row * 256 + ((c16 ^ (row & 15)) << 4));
                if (idx < ne)
                    __builtin_nontemporal_store(v, (u32x4*)(Y + ((size_t)(tk & 1) * T + (size_t)(tk >> 1)) * 1024 + nt * 128 + c16 * 8));
            }
            s0 = s2;
        }
#undef M2_ISSUE
#undef M2_TILE
#undef M2_WAIT
#undef M2_COMPUTE
        asm volatile("s_waitcnt vmcnt(0)" ::: "memory");
    }
}

__device__ __forceinline__ void ph_moe2(const bf16_t* __restrict__ hid, const bf16_t* __restrict__ WdT, const int* __restrict__ cnt, const int* __restrict__ ltok,
                                        bf16_t* __restrict__ Y, char* smem) {
    GEMM_LANE_VARS
    const MoeTab mt = moe_tab(cnt);
    const int nu = moe_ntiles(mt) * 8;
    for (int u = HB_FIRST; u < nu; u += HB_STEP) {
        const int tn = u & 7;
        int e, ti, ebase, ne; moe_decode(mt, u >> 3, e, ti, ebase, ne); (void)ebase;
        const bf16_t* pa[4]; const bf16_t* pb[4];
#pragma unroll
        for (int i = 0; i < 4; ++i) {
            const int idx = ti * 128 + lrow + 32 * i;
            const int tk = idx < ne ? ltok[e * 16384 + idx] : 0;
            pa[i] = hid + (size_t)tk * 256 + lch8;
            pb[i] = WdT + ((size_t)e * 1024 + tn * 128 + lrow + 32 * i) * 256 + lch8;
        }
        f32x4 acc[4][4]; acc_zero(acc);
        gemm_kloop(acc, pa, pb, 64, 64, 4, smem);
#pragma unroll
        for (int mi = 0; mi < 4; ++mi) {
            const int idx = ti * 128 + wr * 64 + mi * 16 + fr;
            if (idx < ne) {
                const int tk = ltok[e * 16384 + idx];
                bf16_t* yr = Y + ((size_t)(tk & 1) * T + (size_t)(tk >> 1)) * 1024 + tn * 128 + wc * 64 + 4 * fq;
#pragma unroll
                for (int ni = 0; ni < 4; ++ni) *(uint2*)(yr + ni * 16) = pack4(acc[mi][ni]);
            }
        }
    }
}

namespace g8 {
constexpr int HTB = 128 * 64 * 2;
__device__ __forceinline__ int lds_byte(int r, int c) { const int st = (r >> 4) * 2 + (c >> 5), rr = r & 15, cc = c & 31, ob = rr * 64 + cc * 2; return st * 1024 + (ob ^ (((ob >> 9) & 1) << 5)); }
__device__ __forceinline__ void stage_rc(int b, int& R, int& C) { const int st = b / 1024, sb = b % 1024, swz = sb ^ (((sb >> 9) & 1) << 5); R = (st >> 1) * 16 + swz / 64; C = (st & 1) * 32 + (swz % 64) / 2; }
__device__ __forceinline__ int perm32(int rho) { const int n = rho >> 4, i = rho & 15; return 8 * (i >> 2) + 4 * n + (i & 3); }
struct Unit { int pm, pn, e; };
struct StaticOrder {
    int nM, nN, nwg, G, c;
    __device__ __forceinline__ void init(int M, int N, int G_, int c_) { nM = M / 256; nN = N / 256; nwg = nM * nN; G = G_; c = c_; }
    __device__ __forceinline__ bool next(int i, Unit& u) const {
        const long L = (long)i * G + c; if (L >= nwg) return false;
        int wgid = (int)L; { const int q = nwg / 8, r = nwg % 8, xcd = wgid % 8, off = wgid / 8; wgid = (xcd < r ? xcd * (q + 1) : r * (q + 1) + (xcd - r) * q) + off; }
        const int nig = 8 * nN, gid = wgid / nig, fm = gid * 8, gsz = (nM - fm) < 8 ? (nM - fm) : 8;
        u.pm = fm + ((wgid % nig) % gsz); u.pn = (wgid % nig) / gsz; u.e = 0; return true;
    }
    __device__ __forceinline__ void a_ready(const Unit&, int) const {}
};
struct AddrPlain {
    const char* A; const char* Bt; unsigned lda2, ldb2; int ntiles;
    __device__ __forceinline__ const char* a_base(const Unit&) const { return A; }
    __device__ __forceinline__ const char* b_base(const Unit&) const { return Bt; }
    __device__ __forceinline__ int nt(const Unit&) const { return ntiles; }
    __device__ __forceinline__ int a_row0(const Unit& u) const { return u.pm * 256; }
    __device__ __forceinline__ int b_row0(const Unit& u) const { return u.pn * 256; }
    __device__ __forceinline__ unsigned a_ld(const Unit&) const { return lda2; }
    __device__ __forceinline__ unsigned b_ld(const Unit&) const { return ldb2; }
};

template <class Epi, class Sched, class Addr>
__device__ __forceinline__ void gemm_phase(char* ldsc, const Sched& S, const Addr& AD, const Epi& E) {
    __attribute__((address_space(3))) unsigned char* lds = (__attribute__((address_space(3))) unsigned char*)ldsc;
    int tid_ = threadIdx.x; asm volatile("" : "+v"(tid_));
    const int tid = tid_, wid = __builtin_amdgcn_readfirstlane(tid >> 6), lane = tid & 63, wr = wid >> 2, wc = wid & 3, fr = lane & 15, fq = lane >> 4;
    int R[2], C2[2], Rb[2];
#pragma unroll
    for (int i = 0; i < 2; ++i) { int r_, c_; stage_rc(tid * 16 + i * 8192, r_, c_); R[i] = r_; C2[i] = c_ * 2; Rb[i] = Epi::PERM ? ((r_ & ~31) + perm32(r_ & 31)) : r_; }
    const unsigned ldsw = (unsigned)wid * 1024u;
    const int aoff = lds_byte(wr * 64 + fr, fq * 8), boff = lds_byte(wc * 32 + fr, fq * 8);
#define G8_SA(b, h) (((b) * 2 + (h)) * HTB)
#define G8_SB(b, h) ((4 + (b) * 2 + (h)) * HTB)
#define G8_STAGE(bufoff, base, rowv, row0, ld, h, kb) do { _Pragma("unroll") for (int _i = 0; _i < 2; ++_i) \
        __builtin_amdgcn_global_load_lds((const __attribute__((address_space(1))) unsigned*)((base) + (size_t)((unsigned)((row0) + (h) * 128 + (rowv)[_i]) * (ld) + (unsigned)C2[_i] + (unsigned)(kb))), \
                                         (__attribute__((address_space(3))) unsigned*)(lds + (bufoff) + ldsw + _i * 8192), 16, 0, 0); } while (0)
#define G8_LDA(dst, b, h) do { _Pragma("unroll") for (int m = 0; m < 4; ++m) _Pragma("unroll") for (int k = 0; k < 2; ++k) dst[m][k] = *(const __attribute__((address_space(3))) bf16x8*)(lds + G8_SA(b, h) + aoff + m * 2048 + k * 1024); } while (0)
#define G8_LDB(dst, b, h) do { _Pragma("unroll") for (int n = 0; n < 2; ++n) _Pragma("unroll") for (int k = 0; k < 2; ++k) dst[n][k] = *(const __attribute__((address_space(3))) bf16x8*)(lds + G8_SB(b, h) + boff + n * 2048 + k * 1024); } while (0)
#define G8_MMA(ai, bj, At, Bt) do { __builtin_amdgcn_s_setprio(1); _Pragma("unroll") for (int m = 0; m < 4; ++m) _Pragma("unroll") for (int n = 0; n < 2; ++n) _Pragma("unroll") for (int k = 0; k < 2; ++k) \
        acc[ai][bj][m][n] = __builtin_amdgcn_mfma_f32_16x16x32_bf16(Bt[n][k], At[m][k], acc[ai][bj][m][n], 0, 0, 0); __builtin_amdgcn_s_setprio(0); } while (0)
#define G8_WAIT_V(n) asm volatile("s_waitcnt vmcnt(" #n ")" ::: "memory")
#define G8_WAIT_L(n) asm volatile("s_waitcnt lgkmcnt(" #n ")" ::: "memory")
#define G8_BAR __builtin_amdgcn_s_barrier()
#define G8_SCHED __builtin_amdgcn_sched_barrier(0)
    Unit cur, nxt; int ui = 0;
    if (!S.next(0, cur)) return;
    f32x4 acc[2][2][4][2];
#pragma unroll
    for (int a = 0; a < 2; ++a)
#pragma unroll
        for (int b = 0; b < 2; ++b)
#pragma unroll
            for (int m = 0; m < 4; ++m)
#pragma unroll
                for (int n = 0; n < 2; ++n) acc[a][b][m][n] = (f32x4){0.f, 0.f, 0.f, 0.f};
    bf16x8 At[4][2], B0[2][2], B1[2][2];
    const char* Ab = AD.a_base(cur); const char* Bb = AD.b_base(cur);
    int ar0 = AD.a_row0(cur), br0 = AD.b_row0(cur); unsigned ald = AD.a_ld(cur), bld = AD.b_ld(cur);
    __syncthreads();
    G8_STAGE(G8_SB(0, 0), Bb, Rb, br0, bld, 0, 0); G8_STAGE(G8_SA(0, 0), Ab, R, ar0, ald, 0, 0); G8_STAGE(G8_SB(0, 1), Bb, Rb, br0, bld, 1, 0); G8_STAGE(G8_SA(0, 1), Ab, R, ar0, ald, 1, 0);
    if (wr == 1) G8_BAR;
    G8_WAIT_V(4); G8_BAR;
    G8_STAGE(G8_SB(1, 0), Bb, Rb, br0, bld, 0, 128); G8_STAGE(G8_SA(1, 0), Ab, R, ar0, ald, 0, 128); G8_STAGE(G8_SB(1, 1), Bb, Rb, br0, bld, 1, 128);
    G8_WAIT_V(6); G8_BAR;
    for (;;) {
        const bool has_next = S.next(ui + 1, nxt);
        const int nt = AD.nt(cur);
        const char* nAb = has_next ? AD.a_base(nxt) : Ab; const char* nBb = has_next ? AD.b_base(nxt) : Bb;
        const int nar0 = has_next ? AD.a_row0(nxt) : ar0, nbr0 = has_next ? AD.b_row0(nxt) : br0;
        const unsigned nald = has_next ? AD.a_ld(nxt) : ald, nbld = has_next ? AD.b_ld(nxt) : bld;
        for (int t = 0; t < nt; t += 2) {
            const bool last = (t == nt - 2);
            if (last && has_next) S.a_ready(nxt, wid);
            const int kb1 = (t + 1) * 128, kb2 = last ? 0 : (t + 2) * 128, kb3 = kb2 + 128;
            const char* sAb = last ? nAb : Ab; const char* sBb = last ? nBb : Bb;
            const int sar0 = last ? nar0 : ar0, sbr0 = last ? nbr0 : br0; const unsigned sald = last ? nald : ald, sbld = last ? nbld : bld;
            G8_LDB(B0, 0, 0); G8_SCHED; G8_LDA(At, 0, 0); G8_STAGE(G8_SA(1, 1), Ab, R, ar0, ald, 1, kb1);
            G8_WAIT_L(8); G8_BAR; G8_WAIT_L(0); G8_MMA(0, 0, At, B0); G8_BAR; G8_SCHED;
            G8_LDB(B1, 0, 1); G8_STAGE(G8_SB(0, 0), sBb, Rb, sbr0, sbld, 0, kb2);
            G8_BAR; G8_WAIT_L(0); G8_MMA(0, 1, At, B1); G8_BAR;
            G8_LDA(At, 0, 1); G8_STAGE(G8_SA(0, 0), sAb, R, sar0, sald, 0, kb2);
            G8_BAR; G8_WAIT_L(0); G8_MMA(1, 0, At, B0); G8_BAR; G8_SCHED;
            G8_STAGE(G8_SB(0, 1), sBb, Rb, sbr0, sbld, 1, kb2);
            G8_WAIT_V(6); G8_BAR; G8_MMA(1, 1, At, B1); G8_BAR;
            G8_LDB(B0, 1, 0); G8_SCHED; G8_LDA(At, 1, 0); G8_STAGE(G8_SA(0, 1), sAb, R, sar0, sald, 1, kb2);
            G8_WAIT_L(8); G8_BAR; G8_WAIT_L(0); G8_MMA(0, 0, At, B0); G8_BAR; G8_SCHED;
            G8_LDB(B1, 1, 1); G8_STAGE(G8_SB(1, 0), sBb, Rb, sbr0, sbld, 0, kb3);
            G8_BAR; G8_WAIT_L(0); G8_MMA(0, 1, At, B1); G8_BAR;
            G8_LDA(At, 1, 1); G8_STAGE(G8_SA(1, 0), sAb, R, sar0, sald, 0, kb3);
            G8_BAR; G8_WAIT_L(0); G8_MMA(1, 0, At, B0); G8_BAR; G8_SCHED;
            G8_STAGE(G8_SB(1, 1), sBb, Rb, sbr0, sbld, 1, kb3);
            G8_WAIT_V(6); G8_BAR; G8_MMA(1, 1, At, B1); G8_BAR;
        }
        E(acc, cur, wr, wc, fr, fq);
        if (!has_next) break;
#pragma unroll
        for (int a = 0; a < 2; ++a)
#pragma unroll
            for (int b = 0; b < 2; ++b)
#pragma unroll
                for (int m = 0; m < 4; ++m)
#pragma unroll
                    for (int n = 0; n < 2; ++n) acc[a][b][m][n] = (f32x4){0.f, 0.f, 0.f, 0.f};
        cur = nxt; Ab = nAb; Bb = nBb; ar0 = nar0; br0 = nbr0; ald = nald; bld = nbld; ++ui;
    }
    G8_WAIT_V(0);
    if (wr == 0) G8_BAR;
    G8_BAR;
#undef G8_SA
#undef G8_SB
#undef G8_STAGE
#undef G8_LDA
#undef G8_LDB
#undef G8_MMA
#undef G8_WAIT_V
#undef G8_WAIT_L
#undef G8_BAR
#undef G8_SCHED
}

struct EpiProj {
    static constexpr bool PERM = true;
    bf16_t* proj;
    __device__ __forceinline__ void operator()(const f32x4 (&acc)[2][2][4][2], const Unit& u, int wr, int wc, int fr, int fq) const {
#pragma unroll
        for (int ai = 0; ai < 2; ++ai)
#pragma unroll
            for (int m = 0; m < 4; ++m) {
                const int r = u.pm * 256 + ai * 128 + wr * 64 + m * 16 + fr;
#pragma unroll
                for (int bj = 0; bj < 2; ++bj) {
                    const int c = u.pn * 256 + bj * 128 + wc * 32 + 8 * fq;
                    if (c < NPROJ) {
                        u32x4 w; w[0] = pack_bf16(acc[ai][bj][m][0][0], acc[ai][bj][m][0][1]); w[1] = pack_bf16(acc[ai][bj][m][0][2], acc[ai][bj][m][0][3]);
                        w[2] = pack_bf16(acc[ai][bj][m][1][0], acc[ai][bj][m][1][1]); w[3] = pack_bf16(acc[ai][bj][m][1][2], acc[ai][bj][m][1][3]);
                        *(u32x4*)(proj + (size_t)r * PP + c) = w;
                    }
                }
            }
    }
};
struct EpiX2 {
    static constexpr bool PERM = true;
    const float* x; bf16_t* x2b;
    __device__ __forceinline__ void operator()(const f32x4 (&acc)[2][2][4][2], const Unit& u, int wr, int wc, int fr, int fq) const {
#pragma unroll
        for (int ai = 0; ai < 2; ++ai)
#pragma unroll
            for (int bj = 0; bj < 2; ++bj) {
                const int c = u.pn * 256 + bj * 128 + wc * 32 + 8 * fq;
                f32x4 xa[4], xb[4];
#pragma unroll
                for (int m = 0; m < 4; ++m) {
                    const int r = u.pm * 256 + ai * 128 + wr * 64 + m * 16 + fr;
                    xa[m] = *(const f32x4*)(x + (size_t)r * 1024 + c); xb[m] = *(const f32x4*)(x + (size_t)r * 1024 + c + 4);
                }
                __builtin_amdgcn_sched_barrier(0);
#pragma unroll
                for (int m = 0; m < 4; ++m) {
                    const int r = u.pm * 256 + ai * 128 + wr * 64 + m * 16 + fr;
                    u32x4 w; w[0] = pack_bf16(acc[ai][bj][m][0][0] + xa[m][0], acc[ai][bj][m][0][1] + xa[m][1]); w[1] = pack_bf16(acc[ai][bj][m][0][2] + xa[m][2], acc[ai][bj][m][0][3] + xa[m][3]);
                    w[2] = pack_bf16(acc[ai][bj][m][1][0] + xb[m][0], acc[ai][bj][m][1][1] + xb[m][1]); w[3] = pack_bf16(acc[ai][bj][m][1][2] + xb[m][2], acc[ai][bj][m][1][3] + xb[m][3]);
                    *(u32x4*)(x2b + (size_t)r * 1024 + c) = w;
                }
            }
    }
};
struct OneUnit { Unit u; __device__ __forceinline__ bool next(int i, Unit& o) const { if (i) return false; o = u; return true; }
    __device__ __forceinline__ void a_ready(const Unit&, int) const {} };
template <int OP>
struct EpiMerge {
    static constexpr bool PERM = true;
    bf16_t* dst; const bf16_t* src2;
    __device__ __forceinline__ void operator()(const f32x4 (&acc)[2][2][4][2], const Unit& u, int wr, int wc, int fr, int fq) const {
#pragma unroll
        for (int ai = 0; ai < 2; ++ai)
#pragma unroll
            for (int m = 0; m < 4; ++m) {
                const int r = u.pm * 256 + ai * 128 + wr * 64 + m * 16 + fr;
#pragma unroll
                for (int bj = 0; bj < 2; ++bj) {
                    const size_t o = (size_t)r * 1024 + u.pn * 256 + bj * 128 + wc * 32 + 8 * fq;
                    float v[8];
#pragma unroll
                    for (int j = 0; j < 4; ++j) { v[j] = acc[ai][bj][m][0][j]; v[4 + j] = acc[ai][bj][m][1][j]; }
                    if (OP == 0) {
#pragma unroll
                        for (int j = 0; j < 8; ++j) v[j] = sigmoidf_(v[j]);
                    } else {
                        const u32x4 d = *(const u32x4*)(dst + o);
                        float dv[8];
#pragma unroll
                        for (int j = 0; j < 4; ++j) { dv[2 * j] = __uint_as_float(d[j] << 16); dv[2 * j + 1] = __uint_as_float(d[j] & 0xFFFF0000u); }
                        if (OP == 1) {
#pragma unroll
                            for (int j = 0; j < 8; ++j) v[j] = dv[j] * v[j];
                        } else {
                            const u32x4 s = *(const u32x4*)(src2 + o);
#pragma unroll
                            for (int j = 0; j < 4; ++j) { v[2 * j] = dv[2 * j] + __uint_as_float(s[j] << 16) * v[2 * j]; v[2 * j + 1] = dv[2 * j + 1] + __uint_as_float(s[j] & 0xFFFF0000u) * v[2 * j + 1]; }
                        }
                    }
                    u32x4 w; w[0] = pack_bf16(v[0], v[1]); w[1] = pack_bf16(v[2], v[3]); w[2] = pack_bf16(v[4], v[5]); w[3] = pack_bf16(v[6], v[7]);
                    *(u32x4*)(dst + o) = w;
                }
            }
    }
};
struct MergeOrder {
    StaticOrder so; unsigned* bar; volatile __attribute__((address_space(3))) unsigned* st;
    __device__ __forceinline__ bool next(int i, Unit& u) const { if (!so.next(i >> 2, u)) return false; u.e = i & 3; return true; }
    __device__ __forceinline__ void a_ready(const Unit& u, int wid) const {
        if (u.e != 1) return;
        if (wid == 0) {
            const unsigned gen = st[2];
            XB_SPIN(xb_ld(&bar[XB2_TOPGEN]) <= gen, bar);
            __builtin_amdgcn_fence(__ATOMIC_ACQUIRE, "agent");
            asm volatile("s_waitcnt vmcnt(0)" ::: "memory");
        }
        __builtin_amdgcn_s_barrier();
    }
};
struct AddrMerge {
    const char* h; const char* WinT; const char* ya; const char* yb; const char* WaT; const char* WbT;
    __device__ __forceinline__ const char* a_base(const Unit& u) const {
        const unsigned long long ph = (unsigned long long)h, pa = (unsigned long long)ya, pb = (unsigned long long)yb, o = (unsigned long long)(u.e & 1), t = (unsigned long long)((u.e >> 1) & 1);
        return (const char*)(ph + o * ((pa - ph) + t * (pb - pa))); }
    __device__ __forceinline__ const char* b_base(const Unit& u) const {
        const unsigned long long pg = (unsigned long long)(WinT + (size_t)MGA * 2048), pa = (unsigned long long)WaT, pb = (unsigned long long)WbT, o = (unsigned long long)(u.e & 1), t = (unsigned long long)((u.e >> 1) & 1);
        const unsigned long long g = pg + t * (unsigned long long)((size_t)(MGB - MGA) * 2048), y = pa + t * (pb - pa);
        return (const char*)(g + o * (y - g)); }
    __device__ __forceinline__ int nt(const Unit& u) const { return (u.e & 1) ? 8 : 16; }
    __device__ __forceinline__ int a_row0(const Unit& u) const { return u.pm * 256; }
    __device__ __forceinline__ int b_row0(const Unit& u) const { return u.pn * 256; }
    __device__ __forceinline__ unsigned a_ld(const Unit& u) const { return (u.e & 1) ? 1024u : 2048u; }
    __device__ __forceinline__ unsigned b_ld(const Unit& u) const { return (u.e & 1) ? 1024u : 2048u; }
};
struct EpiMergeAll {
    static constexpr bool PERM = true;
    bf16_t* mrg; bf16_t* sg2;
    __device__ __forceinline__ void operator()(const f32x4 (&acc)[2][2][4][2], const Unit& u, int wr, int wc, int fr, int fq) const {
        if (u.e == 0) EpiMerge<0>{mrg, nullptr}(acc, u, wr, wc, fr, fq);
        else if (u.e == 1) EpiMerge<1>{mrg, nullptr}(acc, u, wr, wc, fr, fq);
        else if (u.e == 2) EpiMerge<0>{sg2, nullptr}(acc, u, wr, wc, fr, fq);
        else EpiMerge<2>{mrg, sg2}(acc, u, wr, wc, fr, fq);
    }
};
}

constexpr float LOG2E = 1.4426950408889634f;
constexpr float NEGV = -3.0e38f;
constexpr int NSA_TB = 49152;
constexpr int NSA_TBW = 224;
constexpr int NSA_IMPA = NSA_TB + 4 * NSA_TBW * 4;
constexpr int NSA_IMPB = NSA_IMPA + 16640;
constexpr int NSA_SELM = NSA_IMPB + 16640;
constexpr int NSA_PA16 = NSA_IMPA;
constexpr int NSA_OSUM = NSA_SELM + 512;
constexpr int NSA_P316 = NSA_OSUM;
constexpr int NSA_EREF = NSA_OSUM + 32768;

__device__ __forceinline__ int t5_bucket2(int n) {
    if (n < 16) return n;
    const int l = 16 + (int)(logf((float)n / 16.0f) / logf(8.0f) * 16.0f);
    return l < 31 ? l : 31;
}


typedef float f32x2 __attribute__((ext_vector_type(2)));
template <int STR>
__device__ __forceinline__ void tb_read16(unsigned a0, unsigned a1, unsigned a2, unsigned a3, f32x2 (&t)[8]) {
    asm volatile(
        "ds_read2_b32 %0, %8 offset0:%12 offset1:%13\n\t"
        "ds_read2_b32 %1, %8 offset0:%14\n\t"
        "ds_read2_b32 %2, %9 offset0:%12 offset1:%13\n\t"
        "ds_read2_b32 %3, %9 offset0:%14\n\t"
        "ds_read2_b32 %4, %10 offset0:%12 offset1:%13\n\t"
        "ds_read2_b32 %5, %10 offset0:%14\n\t"
        "ds_read2_b32 %6, %11 offset0:%12 offset1:%13\n\t"
        "ds_read2_b32 %7, %11 offset0:%14\n\t"
        "s_waitcnt lgkmcnt(0)"
        : "=&v"(t[0]), "=&v"(t[1]), "=&v"(t[2]), "=&v"(t[3]), "=&v"(t[4]), "=&v"(t[5]), "=&v"(t[6]), "=&v"(t[7])
        : "v"(a0), "v"(a1), "v"(a2), "v"(a3), "n"(3 * STR), "n"(2 * STR), "n"(STR));
}

template <int MODE, bool A0, bool A1>
__device__ __forceinline__ void nsa_tile(const char* Kst, const char* Vst, int j, bool fast, const float* tbias, const bf16x8 (&qf)[2][2], const int (&qidx)[2],
                                         const unsigned long long (&selq)[2], f32x4 (&O)[4][2], float (&m)[2], float (&l)[2], const float (&invl)[2],
                                         char* smem, int fr, int fq, int hp, int wid) {
    const float b127 = tbias[127];
    bf16x8 pf[2][2];
    bool started = true;
    if (MODE != 3) started = __builtin_amdgcn_ballot_w64((A0 && m[0] < -1e29f) || (A1 && m[1] < -1e29f)) == 0ull;
    const bool quick = fast;
    constexpr int STR = (MODE == 0 || MODE == 3) ? 16 : 1;
    const unsigned tboff = (unsigned)(size_t)(const __attribute__((address_space(3))) float*)tbias;
    f32x4 sall[2][2][2];
#pragma unroll
    for (int p = 0; p < 2; ++p)
#pragma unroll
        for (int s = 0; s < 2; ++s) {
            const int row = 32 * p + 16 * s + fr;
            const bf16x8 k0 = *(const bf16x8*)(Kst + tile_off(row, fq)), k1 = *(const bf16x8*)(Kst + tile_off(row, 4 + fq));
#pragma unroll
            for (int ct = 0; ct < 2; ++ct) {
                if ((ct == 0 && !A0) || (ct == 1 && !A1)) continue;
                float i0 = 0.f;
                if (quick) { const bool sel = (MODE == 1) ? (((selq[ct] >> j) & 1ull) != 0ull) : true; i0 = (MODE == 3) ? b127 : (sel ? b127 : NEGV) - (started ? m[ct] : 0.f); }
                f32x4 a = (f32x4){i0, i0, i0, i0};
                a = __builtin_amdgcn_mfma_f32_16x16x32_bf16(k0, qf[ct][0], a, 0, 0, 0);
                a = __builtin_amdgcn_mfma_f32_16x16x32_bf16(k1, qf[ct][1], a, 0, 0, 0);
                sall[ct][p][s] = a;
            }
        }
#pragma unroll
    for (int ct = 0; ct < 2; ++ct) {
        if ((ct == 0 && !A0) || (ct == 1 && !A1)) continue;
        f32x4 (&sacc)[2][2] = sall[ct];
        const int q = qidx[ct];
        const bool sel = (MODE == 1) ? (((selq[ct] >> j) & 1ull) != 0ull) : true;
        if (MODE != 3) {
            const float mct = m[ct];
            if (!quick) {
                const float ref = started ? mct : 0.f;
                int base[4]; unsigned ad[4];
#pragma unroll
                for (int gi = 0; gi < 4; ++gi) {
                    const int k0 = 64 * j + 32 * (gi >> 1) + 8 * fq + 4 * (gi & 1);
                    base[gi] = (MODE == 0) ? q - (16 * k0 + 31) : q - k0;
                    const int bc = base[gi] < 0 ? 0 : (base[gi] > 127 + 3 * STR ? 127 + 3 * STR : base[gi]);
                    ad[gi] = tboff + (unsigned)(bc - 3 * STR) * 4u;
                }
                f32x2 tv[8];
                tb_read16<STR>(ad[0], ad[1], ad[2], ad[3], tv);
#pragma unroll
                for (int p = 0; p < 2; ++p)
#pragma unroll
                    for (int s = 0; s < 2; ++s)
#pragma unroll
                        for (int i = 0; i < 4; ++i) {
                            const int rel = base[2 * p + s] - i * STR;
                            bool valid;
                            if (MODE == 0) valid = rel >= 0;
                            else if (MODE == 1) valid = (rel >= 0) && sel;
                            else valid = (rel >= 0) && (rel < 512);
                            const float tb = tv[(2 * p + s) * 2 + (i >> 1)][i & 1];
                            sacc[p][s][i] = valid ? sacc[p][s][i] + (tb - ref) : NEGV;
                        }
            }
            float pv[2][8]; float psum = 0.f;
            bool redo = !started;
            if (started) {
#pragma unroll
                for (int p = 0; p < 2; ++p)
#pragma unroll
                    for (int s = 0; s < 2; ++s)
#pragma unroll
                        for (int i = 0; i < 4; ++i) { pv[p][s * 4 + i] = __builtin_amdgcn_exp2f(sacc[p][s][i]); psum += pv[p][s * 4 + i]; }
                if (__builtin_amdgcn_ballot_w64(!(psum <= 256.0f)) != 0ull) {
                    redo = true;
#pragma unroll
                    for (int p = 0; p < 2; ++p)
#pragma unroll
                        for (int s = 0; s < 2; ++s)
#pragma unroll
                            for (int i = 0; i < 4; ++i) sacc[p][s][i] += mct;
                }
            }
            if (redo) {
                float mloc = NEGV;
#pragma unroll
                for (int p = 0; p < 2; ++p)
#pragma unroll
                    for (int s = 0; s < 2; ++s)
#pragma unroll
                        for (int i = 0; i < 4; ++i) mloc = fmaxf(mloc, sacc[p][s][i]);
                mloc = fmaxf(mloc, __shfl_xor(mloc, 16)); mloc = fmaxf(mloc, __shfl_xor(mloc, 32));
                const float mnew = fmaxf(mct, mloc);
                const float alpha = __builtin_amdgcn_exp2f(mct - mnew);
                m[ct] = mnew; l[ct] *= alpha;
#pragma unroll
                for (int dt = 0; dt < 4; ++dt) O[dt][ct] = O[dt][ct] * alpha;
                psum = 0.f;
#pragma unroll
                for (int p = 0; p < 2; ++p)
#pragma unroll
                    for (int s = 0; s < 2; ++s)
#pragma unroll
                        for (int i = 0; i < 4; ++i) { pv[p][s * 4 + i] = __builtin_amdgcn_exp2f(sacc[p][s][i] - mnew); psum += pv[p][s * 4 + i]; }
            }
#pragma unroll
            for (int p = 0; p < 2; ++p) {
                u32x4 w; w[0] = pack_bf16(pv[p][0], pv[p][1]); w[1] = pack_bf16(pv[p][2], pv[p][3]); w[2] = pack_bf16(pv[p][4], pv[p][5]); w[3] = pack_bf16(pv[p][6], pv[p][7]);
                pf[ct][p] = __builtin_bit_cast(bf16x8, w);
            }
            l[ct] += psum;
        } else {
            if (!quick) {
                int base[4]; unsigned ad[4];
#pragma unroll
                for (int gi = 0; gi < 4; ++gi) {
                    const int k0 = 64 * j + 32 * (gi >> 1) + 8 * fq + 4 * (gi & 1);
                    base[gi] = q - (16 * k0 + 31);
                    const int bc = base[gi] < 0 ? 0 : (base[gi] > 127 + 3 * STR ? 127 + 3 * STR : base[gi]);
                    ad[gi] = tboff + (unsigned)(bc - 3 * STR) * 4u;
                }
                f32x2 tv[8];
                tb_read16<STR>(ad[0], ad[1], ad[2], ad[3], tv);
#pragma unroll
                for (int p = 0; p < 2; ++p)
#pragma unroll
                    for (int s = 0; s < 2; ++s)
#pragma unroll
                        for (int i = 0; i < 4; ++i) {
                            const int rel = base[2 * p + s] - i * STR;
                            const float tb = tv[(2 * p + s) * 2 + (i >> 1)][i & 1];
                            sacc[p][s][i] = (rel >= 0) ? sacc[p][s][i] + tb : NEGV;
                        }
            }
            float* impA = (float*)(smem + NSA_IMPA); float* impB = (float*)(smem + NSA_IMPB);
            const int ql = wid * 8 + ct * 4 + (fr >> 2);
#pragma unroll
            for (int p = 0; p < 2; ++p)
#pragma unroll
                for (int s = 0; s < 2; ++s) {
                    float p3 = __builtin_amdgcn_exp2f(sacc[p][s][3] - m[ct]) * invl[ct];
                    float pa = __builtin_amdgcn_exp2f(sacc[p][s][0] - m[ct]) * invl[ct] + __builtin_amdgcn_exp2f(sacc[p][s][1] - m[ct]) * invl[ct]
                             + __builtin_amdgcn_exp2f(sacc[p][s][2] - m[ct]) * invl[ct] + p3;
                    pa += __shfl_xor(pa, 1); pa += __shfl_xor(pa, 2);
                    p3 += __shfl_xor(p3, 1); p3 += __shfl_xor(p3, 2);
                    const int jj = 16 * j + 8 * p + 2 * fq + s;
                    if (hp == 0) { impA[ql * 65 + jj] = pa; impB[ql * 65 + jj + 1] = p3; }
                }
        }
    }
    if (MODE != 3) {
#pragma unroll
        for (int dt = 0; dt < 4; ++dt)
#pragma unroll
            for (int p = 0; p < 2; ++p) {
                const bf16x8 vf = *(const bf16x8*)(Vst + tile_off(dt * 16 + fr, p * 4 + fq));
                if (A0) O[dt][0] = __builtin_amdgcn_mfma_f32_16x16x32_bf16(vf, pf[0][p], O[dt][0], 0, 0, 0);
                if (A1) O[dt][1] = __builtin_amdgcn_mfma_f32_16x16x32_bf16(vf, pf[1][p], O[dt][1], 0, 0, 0);
            }
    }
}

template <int MODE>
__device__ __forceinline__ void nsa_branch(const bf16_t* __restrict__ Kb, size_t kstride, const bf16_t* __restrict__ Vb, size_t vstride, int j0, int ntiles, int t0,
                                           const bf16x8 (&qf)[2][2], const int (&qidx)[2], const unsigned long long (&selq)[2], unsigned long long selor0, unsigned long long selor1,
                                           f32x4 (&O)[4][2], float (&m)[2], float (&l)[2], const float (&invl)[2], char* smem) {
    int tid_ = threadIdx.x; asm volatile("" : "+v"(tid_));
    const int tid = tid_, lane = tid & 63, wid = tid >> 6, fr = lane & 15, fq = lane >> 4, hp = fr & 3;
    const int lrow = tid >> 3;
    const float* tbias = (const float*)(smem + NSA_TB) + hp * NSA_TBW + 48;
    const int sch8 = ((tid & 7) ^ (lrow & 7)) * 8;
    const int krow = 32 * (lrow >> 5) + 8 * ((lrow & 15) >> 2) + 4 * ((lrow >> 4) & 1) + (lrow & 3);
    const bf16_t* kp = Kb + (size_t)krow * kstride + sch8;
    const bf16_t* vp = Vb + (size_t)lrow * vstride + sch8;
    __syncthreads();
    glds16(kp, smem + tid * 16); if (MODE != 3) glds16(vp, smem + 8192 + tid * 16);
    asm volatile("s_waitcnt vmcnt(0)" ::: "memory");
    __syncthreads();
    for (int it = 0; it < ntiles; ++it) {
        const int cur = it & 1, j = j0 + it;
        if (it + 1 < ntiles) {
            char* st = smem + (cur ^ 1) * 16384 + tid * 16;
            glds16(kp + (size_t)(it + 1) * 64 * kstride, st); if (MODE != 3) glds16(vp + (size_t)(it + 1) * 64, st + 8192);
        }
        const char* Kst = smem + cur * 16384;
        const char* Vst = Kst + 8192;
        bool fast;
        if (MODE == 0 || MODE == 3) fast = (t0 - (16 * (64 * j + 63) + 31)) >= 128;
        else if (MODE == 1) fast = (t0 - (64 * j + 63)) >= 128;
        else fast = ((t0 - (64 * j + 63)) >= 128) && ((t0 + 63 - 64 * j) < 512);
        if (MODE == 1) {
            const bool a0 = ((selor0 >> j) & 1ull) != 0ull, a1 = ((selor1 >> j) & 1ull) != 0ull;
            if (a0 && a1) nsa_tile<MODE, true, true>(Kst, Vst, j, fast, tbias, qf, qidx, selq, O, m, l, invl, smem, fr, fq, hp, wid);
            else if (a0) nsa_tile<MODE, true, false>(Kst, Vst, j, fast, tbias, qf, qidx, selq, O, m, l, invl, smem, fr, fq, hp, wid);
            else if (a1) nsa_tile<MODE, false, true>(Kst, Vst, j, fast, tbias, qf, qidx, selq, O, m, l, invl, smem, fr, fq, hp, wid);
        } else {
            nsa_tile<MODE, true, true>(Kst, Vst, j, fast, tbias, qf, qidx, selq, O, m, l, invl, smem, fr, fq, hp, wid);
        }
        asm volatile("s_waitcnt vmcnt(0)" ::: "memory");
        __syncthreads();
    }
}


__device__ __forceinline__ unsigned pack_bf16_p(float lo, float hi) { return pack_bf16(lo, hi); }


__device__ __forceinline__ unsigned nsa_pk_f16(float a, float b) { return __builtin_bit_cast(unsigned, __builtin_amdgcn_cvt_pkrtz(a, b)); }
__device__ __forceinline__ float nsa_f16(const char* p) { return (float)*(const _Float16*)p; }
__device__ __forceinline__ bf16x8 nsa_ones() { const u32x4 o = (u32x4){0x3F803F80u, 0x3F803F80u, 0x3F803F80u, 0x3F803F80u}; return __builtin_bit_cast(bf16x8, o); }
__device__ __forceinline__ void nsa_pv_mfma(const char* Vst, const bf16x8 (&pf)[2][2], f32x4 (&O)[4][2], f32x4 (&Ol)[2], int fr, int fq) {
    const bf16x8 one = nsa_ones();
#pragma unroll
    for (int p = 0; p < 2; ++p) {
#pragma unroll
        for (int dt = 0; dt < 4; ++dt) {
            const bf16x8 vf = *(const bf16x8*)(Vst + tile_off(dt * 16 + fr, p * 4 + fq));
            O[dt][0] = __builtin_amdgcn_mfma_f32_16x16x32_bf16(vf, pf[0][p], O[dt][0], 0, 0, 0);
            O[dt][1] = __builtin_amdgcn_mfma_f32_16x16x32_bf16(vf, pf[1][p], O[dt][1], 0, 0, 0);
        }
        Ol[0] = __builtin_amdgcn_mfma_f32_16x16x32_bf16(one, pf[0][p], Ol[0], 0, 0, 0);
        Ol[1] = __builtin_amdgcn_mfma_f32_16x16x32_bf16(one, pf[1][p], Ol[1], 0, 0, 0);
    }
}

template <int STR>
__device__ __forceinline__ void tb_read8(unsigned a0, unsigned a1, f32x2 (&t)[4]) {
    asm volatile(
        "ds_read2_b32 %0, %4 offset0:%6 offset1:%7\n\t"
        "ds_read2_b32 %1, %4 offset0:%8\n\t"
        "ds_read2_b32 %2, %5 offset0:%6 offset1:%7\n\t"
        "ds_read2_b32 %3, %5 offset0:%8\n\t"
        "s_waitcnt lgkmcnt(0)"
        : "=&v"(t[0]), "=&v"(t[1]), "=&v"(t[2]), "=&v"(t[3])
        : "v"(a0), "v"(a1), "n"(3 * STR), "n"(2 * STR), "n"(STR));
}

template <int MODE, bool PEND, bool EDGE>
__device__ __forceinline__ void nsa_step_impl(const char* Kst, const char* Vprev, int j, const float* tbias, const bf16x8 (&qf)[2][2], const int (&qidx)[2],
                                         const unsigned long long (&selq)[2], bf16x8 (&pf)[2][2], f32x4 (&O)[4][2], float (&m)[2], f32x4 (&Ol)[2], int fr, int fq, char* lds, const unsigned (&impo)[2]) {
    constexpr int STR = (MODE == 0) ? 16 : 1;
    const float b127 = tbias[127];
    f32x4 Sc[2][2][2];
    float mref[2], i0[2]; bool sel[2];
#pragma unroll
    for (int ct = 0; ct < 2; ++ct) {
        mref[ct] = m[ct] < -1e29f ? 0.f : m[ct];
        sel[ct] = (MODE == 1) ? (((selq[ct] >> j) & 1ull) != 0ull) : true;
        i0[ct] = (EDGE ? 0.f : (sel[ct] ? b127 : NEGV)) - mref[ct];
    }
    {
        bf16x8 kf[4][2];
        __builtin_amdgcn_sched_barrier(0);
#pragma unroll
        for (int g = 0; g < 4; ++g) {
            const int row = 32 * (g >> 1) + 16 * (g & 1) + fr;
            kf[g][0] = *(const bf16x8*)(Kst + tile_off(row, fq)); kf[g][1] = *(const bf16x8*)(Kst + tile_off(row, 4 + fq));
        }
        __builtin_amdgcn_sched_barrier(0);
#pragma unroll
        for (int g = 0; g < 4; ++g)
#pragma unroll
            for (int ct = 0; ct < 2; ++ct) {
                f32x4 a = (f32x4){i0[ct], i0[ct], i0[ct], i0[ct]};
                a = __builtin_amdgcn_mfma_f32_16x16x32_bf16(kf[g][0], qf[ct][0], a, 0, 0, 0);
                a = __builtin_amdgcn_mfma_f32_16x16x32_bf16(kf[g][1], qf[ct][1], a, 0, 0, 0);
                Sc[ct][g >> 1][g & 1] = a;
            }
    }
    if (EDGE) {
        const unsigned tboff = (unsigned)(size_t)(const __attribute__((address_space(3))) float*)tbias;
#pragma unroll
        for (int ct = 0; ct < 2; ++ct)
#pragma unroll
            for (int p = 0; p < 2; ++p) {
                int base[2]; unsigned ad[2];
#pragma unroll
                for (int s = 0; s < 2; ++s) {
                    const int k0 = 64 * j + 32 * p + 8 * fq + 4 * s;
                    base[s] = (MODE == 0) ? qidx[ct] - (16 * k0 + 31) : qidx[ct] - k0;
                    const int bc = base[s] < 0 ? 0 : (base[s] > 127 + 3 * STR ? 127 + 3 * STR : base[s]);
                    ad[s] = tboff + (unsigned)(bc - 3 * STR) * 4u;
                }
                f32x2 tv[4];
                tb_read8<STR>(ad[0], ad[1], tv);
#pragma unroll
                for (int s = 0; s < 2; ++s)
#pragma unroll
                    for (int i = 0; i < 4; ++i) {
                        const int rel = base[s] - i * STR;
                        bool valid;
                        if (MODE == 0) valid = rel >= 0;
                        else if (MODE == 1) valid = (rel >= 0) && sel[ct];
                        else valid = (rel >= 0) && (rel < 512);
                        const float tb = tv[s * 2 + (i >> 1)][i & 1];
                        Sc[ct][p][s][i] = valid ? Sc[ct][p][s][i] + tb : NEGV;
                    }
            }
    }
    bool need = false; float mx[2];
#pragma unroll
    for (int ct = 0; ct < 2; ++ct) {
        float x = fmaxf(fmaxf(Sc[ct][0][0][0], Sc[ct][0][0][1]), Sc[ct][0][0][2]);
        x = fmaxf(fmaxf(x, Sc[ct][0][0][3]), Sc[ct][0][1][0]); x = fmaxf(fmaxf(x, Sc[ct][0][1][1]), Sc[ct][0][1][2]);
        x = fmaxf(fmaxf(x, Sc[ct][0][1][3]), Sc[ct][1][0][0]); x = fmaxf(fmaxf(x, Sc[ct][1][0][1]), Sc[ct][1][0][2]);
        x = fmaxf(fmaxf(x, Sc[ct][1][0][3]), Sc[ct][1][1][0]); x = fmaxf(fmaxf(x, Sc[ct][1][1][1]), Sc[ct][1][1][2]);
        x = fmaxf(x, Sc[ct][1][1][3]);
        mx[ct] = x;
        need = need || (x > 8.0f) || (m[ct] < -1e29f);
    }
    const bool slow = __builtin_amdgcn_ballot_w64(need) != 0ull;
    float alpha[2] = {1.f, 1.f};
    if (slow) {
#pragma unroll
        for (int ct = 0; ct < 2; ++ct) {
            const float mct = m[ct];
            float mloc = mx[ct] + mref[ct];
            mloc = fmaxf(mloc, __shfl_xor(mloc, 16)); mloc = fmaxf(mloc, __shfl_xor(mloc, 32));
            const float mn = fmaxf(mct, mloc);
            alpha[ct] = __builtin_amdgcn_exp2f(mct - mn);
            const float dlt = mref[ct] - mn;
            m[ct] = mn;
#pragma unroll
            for (int p = 0; p < 2; ++p)
#pragma unroll
                for (int s = 0; s < 2; ++s)
#pragma unroll
                    for (int i = 0; i < 4; ++i) Sc[ct][p][s][i] += dlt;
        }
    }
    float e[32];
    if (PEND) {
        bf16x8 vf[8];
#define NSA_VRD(f_) vf[f_] = *(const bf16x8*)(Vprev + tile_off(((f_) & 3) * 16 + fr, ((f_) >> 2) * 4 + fq))
        __builtin_amdgcn_sched_barrier(0);
        NSA_VRD(0); NSA_VRD(1);
        __builtin_amdgcn_sched_barrier(0);
#pragma unroll
        for (int k = 0; k < 16; ++k) {
            const int f = k >> 1, ct = k & 1, p = f >> 2, dt = f & 3;
            if (ct == 0 && f + 2 < 8) NSA_VRD(f + 2);
            O[dt][ct] = __builtin_amdgcn_mfma_f32_16x16x32_bf16(vf[f], pf[ct][p], O[dt][ct], 0, 0, 0);
            if (k >= 12) Ol[k & 1] = __builtin_amdgcn_mfma_f32_16x16x32_bf16(nsa_ones(), pf[k & 1][(k >> 1) & 1], Ol[k & 1], 0, 0, 0);
#pragma unroll
            for (int x = 0; x < 2; ++x) {
                const int idx = 2 * k + x;
                e[idx] = __builtin_amdgcn_exp2f(Sc[idx >> 4][(idx >> 3) & 1][(idx >> 2) & 1][idx & 3]);
                asm volatile("" : "+v"(e[idx]));
            }
            __builtin_amdgcn_sched_barrier(0);
        }
#undef NSA_VRD
    } else {
#pragma unroll
        for (int idx = 0; idx < 32; ++idx) e[idx] = __builtin_amdgcn_exp2f(Sc[idx >> 4][(idx >> 3) & 1][(idx >> 2) & 1][idx & 3]);
    }
    if (slow) {
#pragma unroll
        for (int ct = 0; ct < 2; ++ct) {
            Ol[ct] = Ol[ct] * alpha[ct];
#pragma unroll
            for (int dt = 0; dt < 4; ++dt) O[dt][ct] = O[dt][ct] * alpha[ct];
        }
    }
    if (MODE == 0) {
#pragma unroll
        for (int ct = 0; ct < 2; ++ct) {
#pragma unroll
            for (int p = 0; p < 2; ++p) {
                const int eb = ct * 16 + p * 8;
                const float pa0 = (e[eb] + e[eb + 1]) + (e[eb + 2] + e[eb + 3]), pa1 = (e[eb + 4] + e[eb + 5]) + (e[eb + 6] + e[eb + 7]);
                const unsigned off = ((unsigned)j * 4096u + impo[ct] + 8u * p) * 2u;
                *(unsigned*)(lds + NSA_PA16 + off) = nsa_pk_f16(pa0, pa1);
                *(unsigned*)(lds + NSA_P316 + off) = nsa_pk_f16(e[eb + 3], e[eb + 7]);
            }
            if (fq == 0) *(float*)(lds + NSA_EREF + ((unsigned)j * 256u + (impo[ct] >> 4)) * 4u) = m[ct];
        }
    }
#pragma unroll
    for (int ct = 0; ct < 2; ++ct) {
#pragma unroll
        for (int p = 0; p < 2; ++p) {
            const int eb = ct * 16 + p * 8;
            u32x4 w;
            w[0] = pack_bf16_p(e[eb], e[eb + 1]); w[1] = pack_bf16_p(e[eb + 2], e[eb + 3]); w[2] = pack_bf16_p(e[eb + 4], e[eb + 5]); w[3] = pack_bf16_p(e[eb + 6], e[eb + 7]);
            pf[ct][p] = __builtin_bit_cast(bf16x8, w);
        }
    }
}

template <int MODE, bool PEND>
__device__ __forceinline__ void nsa_step(const char* Kst, const char* Vprev, int j, bool fast, const float* tbias, const bf16x8 (&qf)[2][2], const int (&qidx)[2],
                                         const unsigned long long (&selq)[2], bf16x8 (&pf)[2][2], f32x4 (&O)[4][2], float (&m)[2], f32x4 (&Ol)[2], int fr, int fq, char* lds, const unsigned (&impo)[2]) {
    if (fast) nsa_step_impl<MODE, PEND, false>(Kst, Vprev, j, tbias, qf, qidx, selq, pf, O, m, Ol, fr, fq, lds, impo);
    else nsa_step_impl<MODE, PEND, true>(Kst, Vprev, j, tbias, qf, qidx, selq, pf, O, m, Ol, fr, fq, lds, impo);
}

__device__ __forceinline__ void nsa_branch_pre(const bf16_t* __restrict__ Kb, size_t kstride, const bf16_t* __restrict__ Vb, size_t vstride, int ntiles, char* smem) {
    int tid_ = threadIdx.x; asm volatile("" : "+v"(tid_));
    const int tid = tid_, lrow = tid >> 3;
    const int sch8 = ((tid & 7) ^ (lrow & 7)) * 8;
    const int krow = 32 * (lrow >> 5) + 8 * ((lrow & 15) >> 2) + 4 * ((lrow >> 4) & 1) + (lrow & 3);
    const bf16_t* kp = Kb + (size_t)krow * kstride + sch8;
    const bf16_t* vp = Vb + (size_t)lrow * vstride + sch8;
    __syncthreads();
    glds16(kp, smem + tid * 16);
    if (ntiles > 1) glds16(kp + (size_t)64 * kstride, smem + 16384 + tid * 16);
    glds16(vp, smem + 8192 + tid * 16);
}

template <int MODE>
__device__ __forceinline__ void nsa_branch_p(const bf16_t* __restrict__ Kb, size_t kstride, const bf16_t* __restrict__ Vb, size_t vstride, int j0, int ntiles, int t0,
                                             const bf16x8 (&qf)[2][2], const int (&qidx)[2], const unsigned long long (&selq)[2],
                                             f32x4 (&O)[4][2], float (&m)[2], float (&l)[2], char* smem, bool pre, const unsigned (&impo)[2]) {
    int tid_ = threadIdx.x; asm volatile("" : "+v"(tid_));
    const int tid = tid_, lane = tid & 63, fr = lane & 15, fq = lane >> 4, hp = fr & 3;
    const int lrow = tid >> 3;
    const float* tbias = (const float*)(smem + NSA_TB) + hp * NSA_TBW + 48;
    const int sch8 = ((tid & 7) ^ (lrow & 7)) * 8;
    const int krow = 32 * (lrow >> 5) + 8 * ((lrow & 15) >> 2) + 4 * ((lrow >> 4) & 1) + (lrow & 3);
    const bf16_t* kp = Kb + (size_t)krow * kstride + sch8;
    const bf16_t* vp = Vb + (size_t)lrow * vstride + sch8;
#define NSA_FAST(j_) ((MODE == 0) ? ((t0 - (16 * (64 * (j_) + 63) + 31)) >= 128) : (MODE == 1) ? ((t0 - (64 * (j_) + 63)) >= 128) : (((t0 - (64 * (j_) + 63)) >= 128) && ((t0 + 63 - 64 * (j_)) < 512)))
#define NSA_KLD(t_, st_) glds16(kp + (size_t)(t_) * 64 * kstride, smem + (st_) * 16384 + tid * 16)
#define NSA_VLD(t_, st_) glds16(vp + (size_t)(t_) * 64, smem + (st_) * 16384 + 8192 + tid * 16)
#define NSA_WAITBAR(n_) do { if ((n_) >= 2) asm volatile("s_waitcnt vmcnt(2) lgkmcnt(0)" ::: "memory"); else if ((n_) == 1) asm volatile("s_waitcnt vmcnt(1) lgkmcnt(0)" ::: "memory"); \
                             else asm volatile("s_waitcnt vmcnt(0) lgkmcnt(0)" ::: "memory"); __builtin_amdgcn_s_barrier(); asm volatile("" ::: "memory"); } while (0)
    if (!pre) {
        __syncthreads();
        NSA_KLD(0, 0);
        if (ntiles > 1) NSA_KLD(1, 1);
        NSA_VLD(0, 0);
    }
    NSA_WAITBAR(ntiles > 1 ? 2 : 1);
    bf16x8 pf[2][2];
    f32x4 Ol[2] = {(f32x4){0.f, 0.f, 0.f, 0.f}, (f32x4){0.f, 0.f, 0.f, 0.f}};
    {
        int n = 0;
        if (2 < ntiles) { NSA_KLD(2, 2); ++n; }
        if (1 < ntiles) { NSA_VLD(1, 1); ++n; }
        nsa_step<MODE, false>(smem, smem, j0, NSA_FAST(j0), tbias, qf, qidx, selq, pf, O, m, Ol, fr, fq, smem, impo);
        NSA_WAITBAR(n);
    }
    int cur = 1, prv = 0, nx2 = 0;
    for (int it = 1; it < ntiles; ++it) {
        int n = 0;
        if (it + 2 < ntiles) { NSA_KLD(it + 2, nx2); ++n; }
        const int nx1 = (cur == 2) ? 0 : cur + 1;
        if (it + 1 < ntiles) { NSA_VLD(it + 1, nx1); ++n; }
        nsa_step<MODE, true>(smem + cur * 16384, smem + prv * 16384 + 8192, j0 + it, NSA_FAST(j0 + it), tbias, qf, qidx, selq, pf, O, m, Ol, fr, fq, smem, impo);
        NSA_WAITBAR(n);
        prv = cur; cur = nx1; nx2 = (nx2 == 2) ? 0 : nx2 + 1;
    }
    nsa_pv_mfma(smem + prv * 16384 + 8192, pf, O, Ol, fr, fq);
    l[0] = Ol[0][0] * 0.25f; l[1] = Ol[1][0] * 0.25f;
#undef NSA_KLD
#undef NSA_VLD
#undef NSA_WAITBAR
#undef NSA_FAST
}

__device__ __forceinline__ void osum_add(uint2& acc, f32x4 o, float sc) {
    f32x4 v;
    v[0] = __uint_as_float(acc.x << 16) + o[0] * sc; v[1] = __uint_as_float(acc.x & 0xFFFF0000u) + o[1] * sc;
    v[2] = __uint_as_float(acc.y << 16) + o[2] * sc; v[3] = __uint_as_float(acc.y & 0xFFFF0000u) + o[3] * sc;
    acc = pack4(v);
}
__device__ __forceinline__ float nsa_gate(const bf16_t* __restrict__ pb, int q, int br, int head) { return sigmoidf_(bf2f(pb[(size_t)q * PP + GA + br * 8 + head])); }

__device__ __forceinline__ void nsa_unit(int u, const bf16_t* __restrict__ proj, const char* __restrict__ ws, const float* __restrict__ rel_bias, bf16_t* __restrict__ ya, char* smem) {
    int tid_ = threadIdx.x; asm volatile("" : "+v"(tid_));
    const int tid = tid_, lane = tid & 63, wid = tid >> 6, fr = lane & 15, fq = lane >> 4, hp = fr & 3;
    const int bg = u & 7, qb = 63 - (u >> 3), b = bg >> 1, g = bg & 1, t0 = qb * 64, tb = qb;
    const bf16_t* kcb = (const bf16_t*)(ws + OFF_KCB) + (size_t)bg * 256 * 64;
    const bf16_t* vcbT = (const bf16_t*)(ws + OFF_VCBT) + (size_t)bg * 64 * 256;
    const bf16_t* VsT = (const bf16_t*)(ws + OFF_VST) + (size_t)bg * 64 * S;
    const bf16_t* VwT = (const bf16_t*)(ws + OFF_VWT) + (size_t)bg * 64 * S;
    const bf16_t* pb = proj + (size_t)b * S * PP;
    __syncthreads();
    const int ntc = (((t0 + 32) >> 4) + 1 + 63) >> 6;
    nsa_branch_pre(kcb, 64, vcbT, 256, ntc, smem);
    {
        float* tbl = (float*)(smem + NSA_TB);
        for (int e = tid; e < 4 * NSA_TBW; e += 512) {
            const int h4 = e / NSA_TBW, x = e - h4 * NSA_TBW - 48, n = x < 0 ? 0 : (x > 127 ? 127 : x);
            tbl[e] = rel_bias[t5_bucket2(n) * 8 + g * 4 + h4] * LOG2E;
        }
    }
    int qidx[2]; bf16x8 qf[2][2];
    const int head = g * 4 + hp;
#pragma unroll
    for (int ct = 0; ct < 2; ++ct) {
        qidx[ct] = t0 + wid * 8 + ct * 4 + (fr >> 2);
        const bf16_t* qr = pb + (size_t)qidx[ct] * PP;
#pragma unroll
        for (int ks = 0; ks < 2; ++ks) {
            const u32x4 raw = *(const u32x4*)(qr + QA + head * 64 + ks * 32 + fq * 8);
            u32x4 w;
#pragma unroll
            for (int e = 0; e < 4; ++e) w[e] = pack_bf16(__uint_as_float(raw[e] << 16) * (0.125f * LOG2E), __uint_as_float(raw[e] & 0xFFFF0000u) * (0.125f * LOG2E));
            qf[ct][ks] = __builtin_bit_cast(bf16x8, w);
        }
    }
    uint2* osl = (uint2*)(smem + NSA_OSUM) + tid;
    unsigned impo[2];
#pragma unroll
    for (int ct = 0; ct < 2; ++ct) impo[ct] = (unsigned)(((wid * 8 + ct * 4 + (fr >> 2)) * 4 + hp) * 16 + 2 * fq);
    unsigned graw[2][2];
#pragma unroll
    for (int ct = 0; ct < 2; ++ct) {
        const bf16_t* gp_ = pb + (size_t)qidx[ct] * PP + GA + head;
        graw[ct][0] = (unsigned)gp_[0] | ((unsigned)gp_[8] << 16); graw[ct][1] = (unsigned)gp_[16];
    }
#define NSA_GATE(ct_, br_) sigmoidf_(__uint_as_float((br_) == 0 ? (graw[ct_][0] << 16) : (br_) == 1 ? (graw[ct_][0] & 0xFFFF0000u) : (graw[ct_][1] << 16)))
    unsigned long long selq[2] = {0ull, 0ull};
    float invl0[2] = {0.f, 0.f};
    float mC[2], invC[2], impv[8];
    {
        f32x4 O[4][2]; float m[2] = {-1e30f, -1e30f}, l[2] = {0.f, 0.f};
#pragma unroll
        for (int dt = 0; dt < 4; ++dt)
#pragma unroll
            for (int ct = 0; ct < 2; ++ct) O[dt][ct] = (f32x4){0.f, 0.f, 0.f, 0.f};
        nsa_branch_p<0>(kcb, 64, vcbT, 256, 0, ntc, t0, qf, qidx, selq, O, m, l, smem, true, impo);
#pragma unroll
        for (int ct = 0; ct < 2; ++ct) {
            float lt = l[ct]; lt += __shfl_xor(lt, 16); lt += __shfl_xor(lt, 32);
            invC[ct] = lt > 0.f ? 1.f / lt : 0.f; mC[ct] = m[ct];
        }
        wave_lds_sync();
        if (fq == 0) {
#pragma unroll
            for (int ct = 0; ct < 2; ++ct)
                for (int t = 0; t < ntc; ++t) {
                    float* er = (float*)(smem + NSA_EREF) + t * 256 + (impo[ct] >> 4);
                    *er = __builtin_amdgcn_exp2f(*er - mC[ct]) * invC[ct];
                }
        }
        wave_lds_sync();
#pragma unroll
        for (int qq = 0; qq < 8; ++qq) {
            const int ql = wid * 8 + qq;
            float val = 0.f;
            { const int t = lane >> 4;
              if (t < ntc) {
                  const char* pa = smem + NSA_PA16 + (((t * 64 + ql) * 4) * 16 + (lane & 15)) * 2; const float* fc = (const float*)(smem + NSA_EREF) + (t * 64 + ql) * 4;
#pragma unroll
                  for (int h = 0; h < 4; ++h) val += nsa_f16(pa + h * 32) * fc[h];
              } }
            if (lane > 0) { const int j1 = lane - 1, t1 = j1 >> 4;
              if (t1 < ntc) {
                  const char* p3 = smem + NSA_P316 + (((t1 * 64 + ql) * 4) * 16 + (j1 & 15)) * 2; const float* fc = (const float*)(smem + NSA_EREF) + (t1 * 64 + ql) * 4;
#pragma unroll
                  for (int h = 0; h < 4; ++h) val += nsa_f16(p3 + h * 32) * fc[h];
              } }
            impv[qq] = val;
        }
        __syncthreads();
#pragma unroll
        for (int ct = 0; ct < 2; ++ct) {
#pragma unroll
            for (int dt = 0; dt < 4; ++dt) { uint2 a = make_uint2(0u, 0u); osum_add(a, O[dt][ct], NSA_GATE(ct, 0) * invC[ct]); osl[(dt * 2 + ct) * 512] = a; }
        }
    }
    const int jw0 = (t0 - 511 < 0 ? 0 : t0 - 511) >> 6;
    nsa_branch_pre(pb + KS + g * 64, PP, VsT, S, tb + 1, smem);
    {
        unsigned long long* selm = (unsigned long long*)(smem + NSA_SELM);
#pragma unroll
        for (int qq = 0; qq < 8; ++qq) {
            const int ql = wid * 8 + qq;
            const float val = impv[qq];
            const bool forced = (lane == 0) || (lane == tb) || (lane == tb - 1);
            unsigned key = forced ? 0xFFFFFFC0u : (lane > tb ? 0u : (__float_as_uint(val) & 0xFFFFFFC0u));
            key |= (unsigned)(63 - lane);
            int rank = 0;
#pragma unroll
            for (int jp = 0; jp < 64; ++jp) rank += ((unsigned)__builtin_amdgcn_readlane((int)key, jp) > key) ? 1 : 0;
            const unsigned long long msk = __ballot(rank < 16);
            if (lane == 0) selm[ql] = msk;
        }
        wave_lds_sync();
        unsigned long long so0 = 0ull, so1 = 0ull;
#pragma unroll
        for (int qq = 0; qq < 4; ++qq) { so0 |= selm[wid * 8 + qq]; so1 |= selm[wid * 8 + 4 + qq]; }
        const unsigned long long selor0 = ((unsigned long long)(unsigned)__builtin_amdgcn_readfirstlane((int)(unsigned)(so0 >> 32)) << 32) | (unsigned)__builtin_amdgcn_readfirstlane((int)(unsigned)so0);
        const unsigned long long selor1 = ((unsigned long long)(unsigned)__builtin_amdgcn_readfirstlane((int)(unsigned)(so1 >> 32)) << 32) | (unsigned)__builtin_amdgcn_readfirstlane((int)(unsigned)so1);
        selq[0] = selm[wid * 8 + (fr >> 2)]; selq[1] = selm[wid * 8 + 4 + (fr >> 2)];
        {
            f32x4 O[4][2]; float m[2] = {-1e30f, -1e30f}, l[2] = {0.f, 0.f};
#pragma unroll
            for (int dt = 0; dt < 4; ++dt)
#pragma unroll
                for (int ct = 0; ct < 2; ++ct) O[dt][ct] = (f32x4){0.f, 0.f, 0.f, 0.f};
            nsa_branch_p<1>(pb + KS + g * 64, PP, VsT, S, 0, tb + 1, t0, qf, qidx, selq, O, m, l, smem, true, impo);
            nsa_branch_pre(pb + (size_t)jw0 * 64 * PP + KW + g * 64, PP, VwT + jw0 * 64, S, tb - jw0 + 1, smem);
#pragma unroll
            for (int ct = 0; ct < 2; ++ct) {
                float lt = l[ct]; lt += __shfl_xor(lt, 16); lt += __shfl_xor(lt, 32);
                const float inv = lt > 0.f ? 1.f / lt : 0.f;
#pragma unroll
                for (int dt = 0; dt < 4; ++dt) { uint2 a = osl[(dt * 2 + ct) * 512]; osum_add(a, O[dt][ct], NSA_GATE(ct, 1) * inv); osl[(dt * 2 + ct) * 512] = a; }
            }
        }
    }
    {
        f32x4 O[4][2]; float m[2] = {-1e30f, -1e30f}, l[2] = {0.f, 0.f};
#pragma unroll
        for (int dt = 0; dt < 4; ++dt)
#pragma unroll
            for (int ct = 0; ct < 2; ++ct) O[dt][ct] = (f32x4){0.f, 0.f, 0.f, 0.f};
        nsa_branch_p<2>(pb + (size_t)jw0 * 64 * PP + KW + g * 64, PP, VwT + jw0 * 64, S, jw0, tb - jw0 + 1, t0, qf, qidx, selq, O, m, l, smem, true, impo);
#pragma unroll
        for (int ct = 0; ct < 2; ++ct) {
            float lt = l[ct]; lt += __shfl_xor(lt, 16); lt += __shfl_xor(lt, 32);
            const float inv = lt > 0.f ? 1.f / lt : 0.f;
            bf16_t* yr = ya + (size_t)(b * S + qidx[ct]) * 512 + head * 64 + 4 * fq;
#pragma unroll
            for (int dt = 0; dt < 4; ++dt) { uint2 a = osl[(dt * 2 + ct) * 512]; osum_add(a, O[dt][ct], NSA_GATE(ct, 2) * inv); *(uint2*)(yr + dt * 16) = a; }
        }
    }
}

__device__ __forceinline__ void vtrans_tile(int task, const bf16_t* __restrict__ proj, char* ws, char* smem) {
    unsigned short (*tl)[66] = (unsigned short (*)[66])smem;
    const int tid = HB_TID, which = task >> 9, bg = (task >> 6) & 7, tt = task & 63, b = bg >> 1, g = bg & 1;
    const int r = tid >> 2, q4 = tid & 3;
    const bf16_t* src = proj + (size_t)(b * S + tt * 64 + r) * PP + (which ? VW : VS) + g * 64 + q4 * 16;
    const uint4 a0 = *(const uint4*)src, a1 = *(const uint4*)(src + 8);
    unsigned* trow = (unsigned*)&tl[r][q4 * 16];
    trow[0] = a0.x; trow[1] = a0.y; trow[2] = a0.z; trow[3] = a0.w; trow[4] = a1.x; trow[5] = a1.y; trow[6] = a1.z; trow[7] = a1.w;
    __syncthreads();
    bf16_t* dst = (bf16_t*)(ws + (which ? OFF_VWT : OFF_VST)) + ((size_t)bg * 64 + r) * S + tt * 64 + q4 * 16;
    unsigned o[8];
#pragma unroll
    for (int k = 0; k < 8; ++k) o[k] = (unsigned)tl[q4 * 16 + 2 * k][r] | ((unsigned)tl[q4 * 16 + 2 * k + 1][r] << 16);
    *(uint4*)dst = make_uint4(o[0], o[1], o[2], o[3]);
    *(uint4*)(dst + 8) = make_uint4(o[4], o[5], o[6], o[7]);
    __syncthreads();
}

__device__ __forceinline__ int tile_el(int row, int col) { return tile_off(row, col >> 3) + ((col & 7) << 1); }

__device__ __forceinline__ void gla_stage_vt(const bf16_t* __restrict__ proj, size_t row0, int h, char* vt_base) {
    const int tid = HB_TID, c = tid >> 2, vq = tid & 3;
    const bf16_t* src = proj + (row0 + c) * PP + VB + h * 128 + vq * 32;
#pragma unroll
    for (int k = 0; k < 4; ++k) {
        const u32x4 a = *(const u32x4*)(src + k * 8);
#pragma unroll
        for (int e = 0; e < 4; ++e) {
            const int v = vq * 32 + k * 8 + 2 * e;
            *(unsigned short*)(vt_base + tile_el(v, c)) = (unsigned short)(a[e] & 0xFFFFu);
            *(unsigned short*)(vt_base + tile_el(v + 1, c)) = (unsigned short)(a[e] >> 16);
        }
    }
}

__device__ __forceinline__ void gla_a_unit(int vb, const bf16_t* __restrict__ proj, const float* __restrict__ w_alpha, const float* __restrict__ b_alpha,
                                           float* __restrict__ bc, bf16_t* __restrict__ cstate, char* smem) {
    float (*bcS)[64] = (float (*)[64])smem;
    float (*tot)[64] = (float (*)[64])(smem + 16384);
    char* KDT = smem + 17408;
    char* VT = smem + 17408 + 8192;
    const int tid = HB_TID, lane = tid & 63, wid = tid >> 6, fr = lane & 15, fq = lane >> 4;
    const int n = vb & 63, h = (vb >> 6) & 3, b = vb >> 8;
    const size_t row0 = (size_t)(b * S + n * 64);
    u32x4* abS = (u32x4*)(smem + 45056);
    __syncthreads();
    if (tid < 128) abS[tid] = *(const u32x4*)(proj + (row0 + (tid >> 1)) * PP + AB + (tid & 1) * 8);
    __syncthreads();
    {
        const int d = tid & 63, cq = tid >> 6, col = h * 64 + d;
        float w[16];
#pragma unroll
        for (int r = 0; r < 16; ++r) w[r] = w_alpha[r * 256 + col];
        const float bias = b_alpha[col];
        float cum = 0.f;
        for (int i = 0; i < 16; ++i) {
            const int c = cq * 16 + i;
            const u32x4 a0 = abS[c * 2], a1 = abS[c * 2 + 1];
            float z = bias;
#pragma unroll
            for (int e = 0; e < 4; ++e) {
                z += __uint_as_float(a0[e] << 16) * w[2 * e] + __uint_as_float(a0[e] & 0xFFFF0000u) * w[2 * e + 1];
                z += __uint_as_float(a1[e] << 16) * w[8 + 2 * e] + __uint_as_float(a1[e] & 0xFFFF0000u) * w[8 + 2 * e + 1];
            }
            const float ls = fminf(z, 0.f) - __logf(1.f + __expf(-fabsf(z)));
            cum += ls * (1.0f / 16.0f);
            bcS[c][d] = cum;
        }
        tot[cq][d] = cum;
        __syncthreads();
        float pre = 0.f;
        for (int q = 0; q < cq; ++q) pre += tot[q][d];
        for (int i = 0; i < 16; ++i) {
            const int c = cq * 16 + i;
            const float v = bcS[c][d] + pre;
            bcS[c][d] = v;
            bc[(row0 + c) * 256 + col] = v;
        }
    }
    __syncthreads();
    {
        const int c = tid >> 2, dq = tid & 3;
        const bf16_t* src = proj + (row0 + c) * PP + KB + h * 64 + dq * 16;
#pragma unroll
        for (int k = 0; k < 2; ++k) {
            const u32x4 a = *(const u32x4*)(src + k * 8);
#pragma unroll
            for (int e = 0; e < 4; ++e) {
                const int d = dq * 16 + k * 8 + 2 * e;
                const float k0 = __uint_as_float(a[e] << 16) * __expf(bcS[63][d] - bcS[c][d]);
                const float k1 = __uint_as_float(a[e] & 0xFFFF0000u) * __expf(bcS[63][d + 1] - bcS[c][d + 1]);
                *(unsigned short*)(KDT + tile_el(d, c)) = f2bf(k0);
                *(unsigned short*)(KDT + tile_el(d + 1, c)) = f2bf(k1);
            }
        }
    }
    gla_stage_vt(proj, row0, h, VT);
    __syncthreads();
    bf16_t* outp = cstate + (size_t)vb * 8192;
#pragma unroll
    for (int vi = 0; vi < 2; ++vi) {
        const int vt = wid * 2 + vi;
        const bf16x8 a0 = *(const bf16x8*)(VT + tile_off(vt * 16 + fr, fq)), a1 = *(const bf16x8*)(VT + tile_off(vt * 16 + fr, 4 + fq));
#pragma unroll
        for (int dt = 0; dt < 4; ++dt) {
            const bf16x8 b0 = *(const bf16x8*)(KDT + tile_off(dt * 16 + fr, fq)), b1 = *(const bf16x8*)(KDT + tile_off(dt * 16 + fr, 4 + fq));
            f32x4 acc = (f32x4){0.f, 0.f, 0.f, 0.f};
            acc = __builtin_amdgcn_mfma_f32_16x16x32_bf16(b0, a0, acc, 0, 0, 0);
            acc = __builtin_amdgcn_mfma_f32_16x16x32_bf16(b1, a1, acc, 0, 0, 0);
            *(uint2*)(outp + (vt * 16 + fr) * 64 + dt * 16 + 4 * fq) = pack4(acc);
        }
    }
}

__device__ __forceinline__ void gla_scan_vb2(int vb, const float* __restrict__ bc, bf16_t* __restrict__ cstate) {
    if (threadIdx.x >= 256) return;
    for (int pi = vb * 256 + (int)threadIdx.x; pi < 16 * 4096; pi += 16 * 4096) {
        const int e2 = pi & 4095, bh = pi >> 12, b = bh >> 2, h = bh & 3, d = (2 * e2) & 63;
        float s0 = 0.f, s1 = 0.f;
        unsigned* base = (unsigned*)(cstate + (size_t)bh * 64 * 8192) + e2;
        const float* bcp = bc + ((size_t)(b * S + 63)) * 256 + h * 64 + d;
#pragma unroll 1
        for (int n0 = 0; n0 < 64; n0 += 16) {
            unsigned upd[16]; float dc0[16], dc1[16];
#pragma unroll
            for (int i = 0; i < 16; ++i) { upd[i] = base[(size_t)(n0 + i) * 4096]; const float* q = bcp + (size_t)(n0 + i) * 64 * 256; dc0[i] = q[0]; dc1[i] = q[1]; }
#pragma unroll
            for (int i = 0; i < 16; ++i) {
                base[(size_t)(n0 + i) * 4096] = pack_bf16(s0, s1);
                s0 = __expf(dc0[i]) * s0 + __uint_as_float(upd[i] << 16); s1 = __expf(dc1[i]) * s1 + __uint_as_float(upd[i] & 0xFFFF0000u);
            }
        }
    }
}

__device__ __forceinline__ void gla_c_unit(int vb, const bf16_t* __restrict__ proj, const float* __restrict__ bc, const bf16_t* __restrict__ prev,
                                           const float* __restrict__ norm_g, bf16_t* __restrict__ yb, char* smem) {
    char* QI = smem;
    char* KI = smem + 8192;
    char* VT = smem + 16384;
    char* PT = smem + 32768;
    const int tid = HB_TID, lane = tid & 63, wid = tid >> 6, fr = lane & 15, fq = lane >> 4;
    const int n = vb & 63, h = (vb >> 6) & 3, b = vb >> 8;
    const size_t row0 = (size_t)(b * S + n * 64);
    __syncthreads();
    {
        const int c = tid >> 2, dq = tid & 3;
        const bf16_t* qs = proj + (row0 + c) * PP + QB + h * 64 + dq * 16;
        const bf16_t* ks = proj + (row0 + c) * PP + KB + h * 64 + dq * 16;
        const float* bs = bc + (row0 + c) * 256 + h * 64 + dq * 16;
#pragma unroll
        for (int k = 0; k < 2; ++k) {
            const u32x4 qa = *(const u32x4*)(qs + k * 8), ka = *(const u32x4*)(ks + k * 8);
            const f32x4 b0 = *(const f32x4*)(bs + k * 8), b1 = *(const f32x4*)(bs + k * 8 + 4);
            const float bv[8] = {b0[0], b0[1], b0[2], b0[3], b1[0], b1[1], b1[2], b1[3]};
            u32x4 qo, ko;
#pragma unroll
            for (int e = 0; e < 4; ++e) {
                const float e0 = __expf(bv[2 * e]), e1 = __expf(bv[2 * e + 1]);
                qo[e] = pack_bf16(__uint_as_float(qa[e] << 16) * 0.125f * e0, __uint_as_float(qa[e] & 0xFFFF0000u) * 0.125f * e1);
                ko[e] = pack_bf16(__uint_as_float(ka[e] << 16) / e0, __uint_as_float(ka[e] & 0xFFFF0000u) / e1);
            }
            *(u32x4*)(QI + tile_off(c, dq * 2 + k)) = qo;
            *(u32x4*)(KI + tile_off(c, dq * 2 + k)) = ko;
        }
    }
    gla_stage_vt(proj, row0, h, VT);
    {
        const int v = tid >> 1, half = tid & 1;
        const bf16_t* ps = prev + (size_t)vb * 8192 + v * 64 + half * 32;
#pragma unroll
        for (int k = 0; k < 4; ++k) *(u32x4*)(PT + tile_off(v, half * 4 + k)) = *(const u32x4*)(ps + k * 8);
    }
    __syncthreads();
    const bf16x8 qf0 = *(const bf16x8*)(QI + tile_off(wid * 16 + fr, fq)), qf1 = *(const bf16x8*)(QI + tile_off(wid * 16 + fr, 4 + fq));
    bf16x8 pf[2];
    const int c = wid * 16 + fr;
#pragma unroll
    for (int p = 0; p < 2; ++p) {
        u32x4 w;
#pragma unroll
        for (int s = 0; s < 2; ++s) {
            const int row = 32 * p + 8 * (fr >> 2) + 4 * s + (fr & 3);
            const bf16x8 k0 = *(const bf16x8*)(KI + tile_off(row, fq)), k1 = *(const bf16x8*)(KI + tile_off(row, 4 + fq));
            f32x4 a = (f32x4){0.f, 0.f, 0.f, 0.f};
            a = __builtin_amdgcn_mfma_f32_16x16x32_bf16(k0, qf0, a, 0, 0, 0);
            a = __builtin_amdgcn_mfma_f32_16x16x32_bf16(k1, qf1, a, 0, 0, 0);
#pragma unroll
            for (int i = 0; i < 4; ++i) { const int j = 32 * p + 8 * fq + 4 * s + i; if (j > c) a[i] = 0.f; }
            w[2 * s] = pack_bf16(a[0], a[1]); w[2 * s + 1] = pack_bf16(a[2], a[3]);
        }
        pf[p] = __builtin_bit_cast(bf16x8, w);
    }
    f32x4 acc[8];
    float ss = 0.f;
#pragma unroll
    for (int vt = 0; vt < 8; ++vt) {
        f32x4 a = (f32x4){0.f, 0.f, 0.f, 0.f};
        a = __builtin_amdgcn_mfma_f32_16x16x32_bf16(*(const bf16x8*)(VT + tile_off(vt * 16 + fr, fq)), pf[0], a, 0, 0, 0);
        a = __builtin_amdgcn_mfma_f32_16x16x32_bf16(*(const bf16x8*)(VT + tile_off(vt * 16 + fr, 4 + fq)), pf[1], a, 0, 0, 0);
        a = __builtin_amdgcn_mfma_f32_16x16x32_bf16(*(const bf16x8*)(PT + tile_off(vt * 16 + fr, fq)), qf0, a, 0, 0, 0);
        a = __builtin_amdgcn_mfma_f32_16x16x32_bf16(*(const bf16x8*)(PT + tile_off(vt * 16 + fr, 4 + fq)), qf1, a, 0, 0, 0);
        acc[vt] = a;
        ss += a[0] * a[0] + a[1] * a[1] + a[2] * a[2] + a[3] * a[3];
    }
    ss += __shfl_xor(ss, 16); ss += __shfl_xor(ss, 32);
    const float r = rsqrtf(ss * (1.0f / 128.0f) + 1e-6f);
    const size_t row = row0 + c;
#pragma unroll
    for (int vt = 0; vt < 8; ++vt) {
        const int col = h * 128 + vt * 16 + 4 * fq;
        const uint2 rr = *(const uint2*)(proj + row * PP + RB + col);
        const f32x4 g4 = *(const f32x4*)(norm_g + col);
        const float r0 = __uint_as_float(rr.x << 16), r1 = __uint_as_float(rr.x & 0xFFFF0000u), r2 = __uint_as_float(rr.y << 16), r3 = __uint_as_float(rr.y & 0xFFFF0000u);
        f32x4 o;
        o[0] = acc[vt][0] * r * g4[0] * (r0 * sigmoidf_(r0)); o[1] = acc[vt][1] * r * g4[1] * (r1 * sigmoidf_(r1));
        o[2] = acc[vt][2] * r * g4[2] * (r2 * sigmoidf_(r2)); o[3] = acc[vt][3] * r * g4[3] * (r3 * sigmoidf_(r3));
        *(uint2*)(yb + row * 512 + col) = pack4(o);
    }
}

constexpr int SMEM_BYTES = 147456;

__global__ void __launch_bounds__(512, 2) k_fwd(Params p) {
    extern __shared__ __attribute__((aligned(16))) char smem_dyn[];
    char* smem = smem_dyn + 16;
    char* smh = smem + (threadIdx.x >> 8) * 65536;
    if (threadIdx.x == 0) *(uint4*)smem_dyn = make_uint4(0u, 0u, 0u, 0u);
    __syncthreads();
    char* ws = p.ws;
    XcdBarrier bar = xcd_barrier_post((unsigned*)(ws + OFF_BAR), (volatile LAS unsigned*)smem_dyn);
    int* ctrl = (int*)(ws + OFF_CTRL);
    bf16_t* proj = (bf16_t*)(ws + OFF_PROJ);
    float* bc = (float*)(ws + OFF_BC);
    bf16_t* cstate = (bf16_t*)(ws + OFF_CSTATE);
    bf16_t* mrg = (bf16_t*)p.out + (size_t)T * 1024;
    bf16_t* h2 = (bf16_t*)(ws + OFF_H2);
    bf16_t* hid = (bf16_t*)(ws + OFF_HID);
    bf16_t* Y0 = (bf16_t*)(ws + OFF_Y0);
    bf16_t* Y1 = (bf16_t*)(ws + OFF_Y1);
    bf16_t* ya = (bf16_t*)(ws + OFF_YA);
    bf16_t* yb = (bf16_t*)(ws + OFF_YB);
    bf16_t* kcb = (bf16_t*)(ws + OFF_KCB);
    bf16_t* vcb = (bf16_t*)(ws + OFF_VCB);
    bf16_t* h = (bf16_t*)p.out;
    const int G = gridDim.x;

    ph_prep(p, smh);
    const int fsh = (2304 + G - 1) / G;
    xcd_arrive2(bar); ph_filler(p, 0, fsh / 4, smh); xcd_wait2(bar);
    { g8::StaticOrder S; S.init(T, 3072, G, (int)blockIdx.x); const g8::AddrPlain AD{(const char*)h, (const char*)(ws + OFF_WINT), 2048u, 2048u, 16};
      g8::gemm_phase(smem, S, AD, g8::EpiProj{proj}); }
    xcd_arrive2(bar); ph_filler(p, fsh / 4, fsh / 2, smh); xcd_wait2(bar);
    ph_cmp1(proj, ws, (float*)(ws + OFF_YA), smh);
    {
        const int nc = G > 64 ? 32 : 0, gb = (int)blockIdx.x - nc, gs = G - nc;
        if (gb >= 0) {
            for (int pr = gb; pr < 512; pr += gs) vtrans_tile(2 * pr + HB_ID, proj, ws, smh);
            for (int pr = gb; pr < 512; pr += gs) gla_a_unit(2 * pr + HB_ID, proj, p.w_alpha, p.b_alpha, bc, cstate, smh);
        }
    }
    xcd_arrive2(bar); ph_filler(p, fsh / 2, (3 * fsh) / 4, smh); xcd_wait2(bar);
    ph_cmp2(ws, ws, (const float*)(ws + OFF_YA), smh);
    for (int vb = blockIdx.x; vb < 256; vb += G) gla_scan_vb2(vb, bc, cstate);
    xcd_arrive2(bar); ph_filler(p, (3 * fsh) / 4, fsh, smh); xcd_wait2(bar);
    {
        const int nr = (512 + G - 1) / G, slot = (int)(blockIdx.x >> 3) % (nr + 1);
        if (__builtin_amdgcn_readfirstlane((int)threadIdx.x) >= 256) __builtin_amdgcn_s_setprio(1);
        for (int r = 0; r <= nr; ++r) {
            if (r == slot) for (int vb = HB_FIRST; vb < 1024; vb += HB_STEP) gla_c_unit(vb, proj, bc, cstate, p.norm_g, yb, smh);
            if (r < nr) {
                const int u = r * G + ((r & 1) ? (G - 1 - (int)blockIdx.x) : (int)blockIdx.x);
                if (u < 512) nsa_unit(u, proj, ws, p.rel_bias, ya, smem);
            }
        }
        __builtin_amdgcn_s_setprio(0);
    }
    xcd_arrive2(bar);
    {
        g8::MergeOrder MO; MO.so.init(T, 1024, G, (int)blockIdx.x); MO.bar = (unsigned*)(ws + OFF_BAR); MO.st = (volatile LAS unsigned*)smem_dyn;
        const g8::AddrMerge AD{(const char*)h, (const char*)(ws + OFF_WINT), (const char*)ya, (const char*)yb, (const char*)(ws + OFF_WAT), (const char*)(ws + OFF_WBT)};
        g8::gemm_phase(smem, MO, AD, g8::EpiMergeAll{mrg, (bf16_t*)(ws + OFF_R1)});
    }
    if (G == 256) {
        const int pm = 8 * ((int)blockIdx.x & 7) + (((int)blockIdx.x >> 3) & 7);
        asm volatile("s_waitcnt vmcnt(0)" ::: "memory");
        __syncthreads();
        if (threadIdx.x == 0) {
            unsigned* pc = (unsigned*)(ctrl + 3072 + pm * 16);
            const unsigned xcc = xb_xcc_id();
            (void)xb_add(pc, 1u + (xcc < 8u ? (1u << (8u + 3u * xcc)) : 0u));
            XB_SPIN((xb_ld(pc) & 0xFFu) < 4u, bar.bar);
            const unsigned vv = xb_ld(pc);
            const bool same = xcc < 8u && ((vv >> (8u + 3u * xcc)) & 7u) == 4u;
            if (!same) {
                __builtin_amdgcn_fence(__ATOMIC_RELEASE, "agent");
                asm volatile("s_waitcnt vmcnt(0)" ::: "memory");
                (void)xb_add(pc + 1, 1u);
                XB_SPIN(xb_ld(pc + 1) < 4u, bar.bar);
            }
            __builtin_amdgcn_fence(__ATOMIC_ACQUIRE, "agent");
            asm volatile("s_waitcnt vmcnt(0)" ::: "memory");
        }
        __syncthreads();
    } else xcd_barrier(bar);
    { g8::StaticOrder S; S.init(T, 1024, G, (int)blockIdx.x); const g8::AddrPlain AD{(const char*)mrg, (const char*)(ws + OFF_WOT), 2048u, 2048u, 16};
      g8::gemm_phase(smem, S, AD, g8::EpiX2{p.x, h2}); }
    if (G == 256) {
        const int pm = 8 * ((int)blockIdx.x & 7) + (((int)blockIdx.x >> 3) & 7), pn = (int)blockIdx.x >> 6;
        asm volatile("s_waitcnt vmcnt(0)" ::: "memory");
        __syncthreads();
        if (threadIdx.x == 0) {
            unsigned* pc = (unsigned*)(ctrl + 2048 + pm * 16);
            const unsigned xcc = xb_xcc_id();
            (void)xb_add(pc, 1u + (xcc < 8u ? (1u << (8u + 3u * xcc)) : 0u));
            XB_SPIN((xb_ld(pc) & 0xFFu) < 4u, bar.bar);
            const unsigned vv = xb_ld(pc);
            const bool same = xcc < 8u && ((vv >> (8u + 3u * xcc)) & 7u) == 4u;
            if (!same) {
                __builtin_amdgcn_fence(__ATOMIC_RELEASE, "agent");
                asm volatile("s_waitcnt vmcnt(0)" ::: "memory");
                (void)xb_add(pc + 1, 1u);
                XB_SPIN(xb_ld(pc + 1) < 4u, bar.bar);
            }
            __builtin_amdgcn_fence(__ATOMIC_ACQUIRE, "agent");
            asm volatile("s_waitcnt vmcnt(0)" ::: "memory");
        }
        __syncthreads();
        const int grp = 8 * pm + 2 * pn + HB_ID;
        router_pair(grp, h2, (const bf16_t*)(ws + OFF_WRT), p.b_rg, p.b_re, (float*)(ws + OFF_RSTD), smh);
        router_append<true>(grp, (int*)(ws + OFF_LTOK), (float*)(ws + OFF_LW), ctrl, smh);
    } else {
        xcd_barrier(bar);
        for (int gi = HB_FIRST; gi < 512; gi += HB_STEP) {
            router_pair(gi, h2, (const bf16_t*)(ws + OFF_WRT), p.b_rg, p.b_re, (float*)(ws + OFF_RSTD), smh);
            router_append(gi, (int*)(ws + OFF_LTOK), (float*)(ws + OFF_LW), ctrl, smh);
        }
    }
    xcd_barrier(bar);
    ph_moe1(h2, (const bf16_t*)(ws + OFF_WGT), (const bf16_t*)(ws + OFF_WUT), ctrl, (const int*)(ws + OFF_LTOK), (const float*)(ws + OFF_LW), (const float*)(ws + OFF_RSTD), hid, smem);
    float wv0[64];
    xcd_arrive2(bar);
    moe2w_wload(p.w_ed, (int)blockIdx.x < 256 ? (int)blockIdx.x : 255, wv0);
    xcd_wait2(bar);
    ph_moe2w(hid, p.w_ed, ctrl, (const int*)(ws + OFF_LTOK), Y0, ws + OFF_KCB, smem, wv0);
    xcd_barrier(bar);
    { int t_ = threadIdx.x; asm volatile("" : "+v"(t_)); for (int row = blockIdx.x * 8 + (t_ >> 6); row < T; row += G * 8) final_row(row, h2, p.out, Y0, Y1, p.g_final, t_ & 63); }
}

extern "C" void kernel_launch(void* const* d_in, const int* in_sizes, int n_in, void* d_out, int out_size, void* d_ws, size_t ws_size, hipStream_t stream) {
    static int grid = 0;
    constexpr int kDynLds = SMEM_BYTES + 16;
    if (!grid) {
        int dev = 0, cus = 0, per_cu = 0;
        (void)hipGetDevice(&dev);
        (void)hipDeviceGetAttribute(&cus, hipDeviceAttributeMultiprocessorCount, dev);
        (void)hipFuncSetAttribute((const void*)k_fwd, hipFuncAttributeMaxDynamicSharedMemorySize, kDynLds);
        (void)hipOccupancyMaxActiveBlocksPerMultiprocessor(&per_cu, k_fwd, 512, kDynLds);
        if (per_cu > 1) per_cu = 1;
        if (per_cu < 1) per_cu = 1;
        grid = cus * per_cu;
    }
    char* ws = (char*)d_ws;
    (void)hipMemsetAsync(ws + OFF_CTRL, 0, 49152, stream);
    Params p{};
    const float** pf = (const float**)&p;
    for (int i = 0; i < 25; ++i) pf[i] = (const float*)d_in[i];
    p.out = (float*)d_out; p.ws = ws;
    k_fwd<<<grid, 512, kDynLds, stream>>>(p);
}
```
